# Optimizing an MI355X kernel written in HIP

```python
import jax, jax.numpy as jnp
from jax import lax
import numpy as np

D_MODEL = 2048
BATCH = 1
SEQ = 8192
DEPTH = 2

BRANCH_WIDTH = D_MODEL // 4
NSA_HEADS = 8
NSA_KV_HEADS = 2
NSA_HD = BRANCH_WIDTH // NSA_HEADS
CMP_LEN = 32
CMP_STRIDE = 16
SLC_LEN = 64
SLC_TOP = 16
WINDOW = 512
Q_BLOCK = 128
HG_HEADS = 4
HG_DK = BRANCH_WIDTH // HG_HEADS
HG_DV = BRANCH_WIDTH // HG_HEADS
GLA_HEADS = 4
GLA_DK = BRANCH_WIDTH // 8
GLA_DV = BRANCH_WIDTH // GLA_HEADS
GLA_RANK = 16
GLA_TAU = 16.0
CHUNK = 64
N_GROUPS = 4
EXPERTS_PER_GROUP = 8
N_EXPERTS = N_GROUPS * EXPERTS_PER_GROUP
TOP_K = 2
D_FF_EXPERT = D_MODEL // 4
EPS = 1e-6
NEG = -1e30
FORCE = 1e4
TINY = 1e-30

IN_SPLITS = (
    ("nsa_q", NSA_HEADS * NSA_HD),
    ("nsa_k_cmp", NSA_KV_HEADS * NSA_HD), ("nsa_v_cmp", NSA_KV_HEADS * NSA_HD),
    ("nsa_k_slc", NSA_KV_HEADS * NSA_HD), ("nsa_v_slc", NSA_KV_HEADS * NSA_HD),
    ("nsa_k_win", NSA_KV_HEADS * NSA_HD), ("nsa_v_win", NSA_KV_HEADS * NSA_HD),
    ("nsa_gate", 3 * NSA_HEADS),
    ("hg_q", HG_HEADS * HG_DK), ("hg_f", HG_HEADS * HG_DK),
    ("hg_i", HG_HEADS * HG_DV), ("hg_g", HG_HEADS * HG_DV),
    ("gla_q", GLA_HEADS * GLA_DK), ("gla_k", GLA_HEADS * GLA_DK),
    ("gla_v", GLA_HEADS * GLA_DV), ("gla_r", GLA_HEADS * GLA_DV),
    ("gla_a", GLA_RANK),
    ("merge_gate", 3 * D_MODEL),
)
IN_COLS = sum(size for _, size in IN_SPLITS)

kernel_name = "hybrid_nsa_hgrn2_gla_hmoe"


def rmsnorm(x, gain):
    xf = x.astype(jnp.float32)
    y = xf * lax.rsqrt(jnp.mean(xf * xf, axis=-1, keepdims=True) + EPS)
    return (y * gain.astype(jnp.float32)).astype(x.dtype)


def split_cols(h):
    parts, off = {}, 0
    for name, size in IN_SPLITS:
        parts[name] = h[..., off:off + size]
        off += size
    return parts


def to_heads(a, n):
    B, T, _ = a.shape
    return a.reshape(B, T, n, -1).transpose(0, 2, 1, 3)


def from_heads(a):
    B, H, T, d = a.shape
    return a.transpose(0, 2, 1, 3).reshape(B, T, H * d)


def alibi_slopes(n):
    return jnp.exp2(-8.0 * jnp.arange(1, n + 1, dtype=jnp.float32) / n)


def compress_blocks(a, pe, w1, w2):
    B, G, T, hd = a.shape
    n_cmp = (T - CMP_LEN) // CMP_STRIDE + 1
    idx = jnp.arange(n_cmp)[:, None] * CMP_STRIDE + jnp.arange(CMP_LEN)[None, :]
    blocks = (a[:, :, idx, :] + pe).reshape(B, G, n_cmp, CMP_LEN * hd)
    return jax.nn.gelu(blocks @ w1) @ w2


def nsa_mixer(p, cmp_pe, cmp_w1, cmp_w2, q_gain, k_gain, slopes):
    B, T, _ = p["nsa_q"].shape
    G, R, hd = NSA_KV_HEADS, NSA_HEADS // NSA_KV_HEADS, NSA_HD
    scale = hd ** -0.5
    m = slopes.reshape(G, R)[None, :, :, None, None]
    q = rmsnorm(to_heads(p["nsa_q"], NSA_HEADS), q_gain).reshape(B, G, R, T, hd)
    t_pos = jnp.arange(T)

    kc = rmsnorm(compress_blocks(to_heads(p["nsa_k_cmp"], G), cmp_pe[0], cmp_w1[0], cmp_w2[0]), k_gain[0])
    vc = compress_blocks(to_heads(p["nsa_v_cmp"], G), cmp_pe[1], cmp_w1[1], cmp_w2[1])
    n_cmp = kc.shape[2]
    c_end = jnp.arange(n_cmp) * CMP_STRIDE + CMP_LEN - 1
    dist_c = (t_pos[:, None] - c_end[None, :]).astype(jnp.float32)
    vis_c = dist_c >= 0
    s = jnp.einsum('bgrtd,bgnd->bgrtn', q, kc).astype(jnp.float32) * scale - m * dist_c
    p_cmp = jax.nn.softmax(jnp.where(vis_c, s, NEG), axis=-1) * vis_c
    o_cmp = jnp.einsum('bgrtn,bgnd->bgrtd', p_cmp.astype(vc.dtype), vc)

    imp = p_cmp.sum(axis=2)
    n_slc = T // SLC_LEN
    ratio, span = SLC_LEN // CMP_STRIDE, CMP_LEN // CMP_STRIDE
    pad_l = span - 1
    pad_r = ratio * n_slc + ratio - 1 - n_cmp
    imp = jnp.pad(imp, ((0, 0), (0, 0), (0, 0), (pad_l, pad_r)))
    score = jnp.zeros((B, G, T, n_slc), jnp.float32)
    for mm in range(ratio):
        for nn in range(span):
            st = pad_l + mm - nn
            score = score + imp[..., st:st + ratio * n_slc:ratio]
    blk = jnp.arange(n_slc)[None, :]
    cur = (t_pos // SLC_LEN)[:, None]
    forced = (blk == 0) | (blk == cur) | (blk == cur - 1)
    score = jnp.where(forced, FORCE, score)
    score = jnp.where(blk <= cur, score, -1.0)
    n_top = min(SLC_TOP, n_slc)
    _, sel = lax.top_k(score, n_top)

    ks = rmsnorm(to_heads(p["nsa_k_slc"], G), k_gain[1]).reshape(B, G, n_slc, SLC_LEN, hd)
    vs = to_heads(p["nsa_v_slc"], G).reshape(B, G, n_slc, SLC_LEN, hd)
    nq = T // Q_BLOCK
    q_blocks = q.reshape(B, G, R, nq, Q_BLOCK, hd).transpose(3, 0, 1, 2, 4, 5)
    sel_blocks = sel.reshape(B, G, nq, Q_BLOCK, n_top).transpose(2, 0, 1, 3, 4)
    starts = jnp.arange(nq) * Q_BLOCK
    bi = jnp.arange(B)[:, None, None, None]
    gi = jnp.arange(G)[None, :, None, None]
    offs = jnp.arange(SLC_LEN)

    def attend_selected(args):
        qb, ib, st = args
        kb = ks[bi, gi, ib].reshape(B, G, Q_BLOCK, n_top * SLC_LEN, hd)
        vb = vs[bi, gi, ib].reshape(B, G, Q_BLOCK, n_top * SLC_LEN, hd)
        qpos = st + jnp.arange(Q_BLOCK)
        kpos = (ib[..., None] * SLC_LEN + offs).reshape(B, G, Q_BLOCK, n_top * SLC_LEN)
        dist = (qpos[:, None] - kpos).astype(jnp.float32)[:, :, None]
        sb = jnp.einsum('bgrqd,bgqkd->bgrqk', qb, kb).astype(jnp.float32) * scale - m * dist
        pb = jax.nn.softmax(jnp.where(dist >= 0, sb, NEG), axis=-1)
        return jnp.einsum('bgrqk,bgqkd->bgrqd', pb.astype(vb.dtype), vb)

    o_slc = lax.map(attend_selected, (q_blocks, sel_blocks, starts))
    o_slc = o_slc.transpose(1, 2, 3, 0, 4, 5).reshape(B, G, R, T, hd)

    kw = rmsnorm(to_heads(p["nsa_k_win"], G), k_gain[2])
    vw = to_heads(p["nsa_v_win"], G)
    nb = WINDOW // Q_BLOCK

    def band(a):
        a = jnp.pad(a, ((0, 0), (0, 0), (WINDOW, 0), (0, 0))).reshape(B, G, nq + nb, Q_BLOCK, hd)
        return jnp.concatenate([a[:, :, i:i + nq] for i in range(nb + 1)], axis=3)

    kbw, vbw = band(kw), band(vw)
    qw = q.reshape(B, G, R, nq, Q_BLOCK, hd)
    qpos = jnp.arange(nq)[:, None] * Q_BLOCK + jnp.arange(Q_BLOCK)[None, :]
    kpos = (jnp.arange(nq)[:, None] - nb) * Q_BLOCK + jnp.arange((nb + 1) * Q_BLOCK)[None, :]
    dist = qpos[:, :, None] - kpos[:, None, :]
    mask_w = (dist >= 0) & (dist < WINDOW) & (kpos[:, None, :] >= 0)
    sw = jnp.einsum('bgrcqd,bgckd->bgrcqk', qw, kbw).astype(jnp.float32) * scale \
        - m[..., None] * dist.astype(jnp.float32)
    pw = jax.nn.softmax(jnp.where(mask_w, sw, NEG), axis=-1)
    o_win = jnp.einsum('bgrcqk,bgckd->bgrcqd', pw.astype(vbw.dtype), vbw).reshape(B, G, R, T, hd)

    gates = jax.nn.sigmoid(p["nsa_gate"].astype(jnp.float32)).reshape(B, T, 3, G, R)
    gates = gates.transpose(2, 0, 3, 4, 1)[..., None]
    o = gates[0] * o_cmp + gates[1] * o_slc + gates[2] * o_win
    return o.transpose(0, 3, 1, 2, 4).reshape(B, T, NSA_HEADS * hd)


def gated_linear_recurrence(q, k, v, log_f):
    B, H, T, dk = q.shape
    dv = v.shape[-1]
    n = T // CHUNK

    def chunks(a):
        return a.astype(jnp.float32).reshape(B, H, n, CHUNK, a.shape[-1]).transpose(2, 0, 1, 3, 4)

    causal = jnp.tril(jnp.ones((CHUNK, CHUNK), dtype=bool))[:, :, None]

    def step(S, inp):
        qc, kc, vc, gc = inp
        b = jnp.cumsum(gc, axis=2)
        diff = b[:, :, :, None, :] - b[:, :, None, :, :]
        decay = jnp.where(causal, jnp.exp(jnp.where(causal, diff, 0.0)), 0.0)
        scores = jnp.einsum('bhid,bhjd,bhijd->bhij', qc, kc, decay)
        o = scores @ vc + jnp.einsum('bhid,bhdv->bhiv', qc * jnp.exp(b), S)
        b_end = b[:, :, -1:, :]
        S = jnp.exp(b_end[:, :, 0, :, None]) * S + jnp.einsum('bhjd,bhjv->bhdv', kc * jnp.exp(b_end - b), vc)
        return S, o

    S0 = jnp.zeros((B, H, dk, dv), jnp.float32)
    _, o = lax.scan(step, S0, (chunks(q), chunks(k), chunks(v), chunks(log_f)))
    return o.transpose(1, 2, 0, 3, 4).reshape(B, H, T, dv).astype(v.dtype)


def hgrn2_mixer(p, lower_bound, norm_gain):
    q = to_heads(p["hg_q"], HG_HEADS)
    z = to_heads(p["hg_f"], HG_HEADS).astype(jnp.float32)
    i = to_heads(p["hg_i"], HG_HEADS)
    lb = lower_bound.astype(jnp.float32).reshape(HG_HEADS, 1, HG_DK)
    f = lb + (1.0 - lb) * jax.nn.sigmoid(z)
    log_f = jnp.log(jnp.maximum(f, TINY))
    k = (1.0 - lb) * jax.nn.sigmoid(-z)
    o = gated_linear_recurrence(q, k, i, log_f)
    o = rmsnorm(o, norm_gain) * jax.nn.sigmoid(to_heads(p["hg_g"], HG_HEADS))
    return from_heads(o)


def gla_mixer(p, w_a2, b_a, norm_gain):
    q = to_heads(p["gla_q"], GLA_HEADS) * (GLA_DK ** -0.5)
    k = to_heads(p["gla_k"], GLA_HEADS)
    v = to_heads(p["gla_v"], GLA_HEADS)
    a = (p["gla_a"] @ w_a2 + b_a).astype(jnp.float32)
    log_a = to_heads(jax.nn.log_sigmoid(a) / GLA_TAU, GLA_HEADS)
    o = gated_linear_recurrence(q, k, v, log_a)
    o = rmsnorm(o, norm_gain) * jax.nn.silu(to_heads(p["gla_r"], GLA_HEADS))
    return from_heads(o)


def hybrid_mixer(h, w_in, cmp_pe, cmp_w1, cmp_w2, q_gain, k_gain, lower_bound, hg_norm,
                 gla_w_a2, gla_b_a, gla_norm, w_branch, w_out, slopes):
    B, T, D = h.shape
    p = split_cols(h @ w_in)
    o_a = nsa_mixer(p, cmp_pe, cmp_w1, cmp_w2, q_gain, k_gain, slopes).astype(h.dtype)
    o_b = hgrn2_mixer(p, lower_bound, hg_norm).astype(h.dtype)
    o_c = gla_mixer(p, gla_w_a2, gla_b_a, gla_norm).astype(h.dtype)
    branches = jnp.stack([o_a, o_b, o_c])
    proj = jnp.einsum('nbtw,nwd->nbtd', branches, w_branch)
    gates = jax.nn.sigmoid(p["merge_gate"].reshape(B, T, 3, D)).transpose(2, 0, 1, 3)
    merged = jnp.sum(gates * proj, axis=0)
    return (merged @ w_out).astype(h.dtype)


def hierarchical_moe(h, w_grp, b_grp, w_exp, b_exp, w_gate_up, w_down):
    B, T, D = h.shape
    N = B * T
    xt = h.reshape(N, D)
    grp_prob = jax.nn.softmax((xt @ w_grp).astype(jnp.float32) + b_grp, axis=-1)
    grp_w, grp_idx = lax.top_k(grp_prob, 1)
    exp_logits = ((xt @ w_exp).astype(jnp.float32) + b_exp).reshape(N, N_GROUPS, EXPERTS_PER_GROUP)
    exp_logits = jnp.take_along_axis(exp_logits, grp_idx[:, :, None], axis=1)[:, 0]
    top_w, top_idx = lax.top_k(jax.nn.softmax(exp_logits, axis=-1), TOP_K)
    top_w = top_w / jnp.sum(top_w, axis=-1, keepdims=True)
    weights = grp_w * top_w
    expert_id = grp_idx * EXPERTS_PER_GROUP + top_idx
    combine = jnp.zeros((N, N_EXPERTS), jnp.float32).at[jnp.arange(N)[:, None], expert_id].add(weights)
    y = jnp.zeros((N, D), jnp.float32)
    for g in range(N_GROUPS):
        sl = slice(g * EXPERTS_PER_GROUP, (g + 1) * EXPERTS_PER_GROUP)
        gu = jnp.einsum('nd,edf->nef', xt, w_gate_up[sl])
        gate, up = jnp.split(gu, 2, axis=-1)
        act = jax.nn.silu(gate) * up * combine[:, sl, None].astype(gu.dtype)
        y = y + jnp.einsum('nef,efd->nd', act, w_down[sl])
    return y.reshape(B, T, D).astype(h.dtype)


def setup_inputs(seed: int = 0) -> dict:
    key = jax.random.key(seed)
    ks = jax.random.split(key, 24)
    f32 = jnp.float32
    L, D = DEPTH, D_MODEL

    def nrm(k, shape, scale):
        return jax.random.normal(k, shape, f32) * scale

    return {
        "x": nrm(ks[0], (BATCH, SEQ, D), 1.0),
        "norm_mix": 1.0 + nrm(ks[1], (L, D), 0.02),
        "w_in": nrm(ks[2], (L, D, IN_COLS), D ** -0.5),
        "cmp_pe": nrm(ks[3], (L, 2, CMP_LEN, NSA_HD), 0.1),
        "cmp_w1": nrm(ks[4], (L, 2, CMP_LEN * NSA_HD, NSA_HD), (CMP_LEN * NSA_HD) ** -0.5),
        "cmp_w2": nrm(ks[5], (L, 2, NSA_HD, NSA_HD), NSA_HD ** -0.5),
        "q_norm": 1.0 + nrm(ks[6], (L, NSA_HD), 0.02),
        "k_norm": 1.0 + nrm(ks[7], (L, 3, NSA_HD), 0.02),
        "hg_lb_logits": nrm(ks[8], (L, HG_HEADS * HG_DK), 0.1),
        "hg_norm": 1.0 + nrm(ks[9], (L, HG_DV), 0.02),
        "gla_w_a2": nrm(ks[10], (L, GLA_RANK, GLA_HEADS * GLA_DK), GLA_RANK ** -0.5),
        "gla_b_a": nrm(ks[11], (L, GLA_HEADS * GLA_DK), 0.1),
        "gla_norm": 1.0 + nrm(ks[12], (L, GLA_DV), 0.02),
        "w_branch": nrm(ks[13], (L, 3, BRANCH_WIDTH, D), BRANCH_WIDTH ** -0.5),
        "w_out": nrm(ks[14], (L, D, D), D ** -0.5),
        "norm_ffn": 1.0 + nrm(ks[15], (L, D), 0.02),
        "w_grp": nrm(ks[16], (L, D, N_GROUPS), D ** -0.5),
        "b_grp": nrm(ks[17], (L, N_GROUPS), 0.01),
        "w_exp": nrm(ks[18], (L, D, N_EXPERTS), D ** -0.5),
        "b_exp": nrm(ks[19], (L, N_EXPERTS), 0.01),
        "w_gate_up": nrm(ks[20], (L, N_EXPERTS, D, 2 * D_FF_EXPERT), D ** -0.5),
        "w_down": nrm(ks[21], (L, N_EXPERTS, D_FF_EXPERT, D), D_FF_EXPERT ** -0.5),
    }


def reference(x, norm_mix, w_in, cmp_pe, cmp_w1, cmp_w2, q_norm, k_norm, hg_lb_logits, hg_norm,
              gla_w_a2, gla_b_a, gla_norm, w_branch, w_out, norm_ffn, w_grp, b_grp, w_exp, b_exp,
              w_gate_up, w_down):
    slopes = alibi_slopes(NSA_HEADS)
    P = jax.nn.softmax(hg_lb_logits.astype(jnp.float32), axis=0)
    lower_bounds = jnp.cumsum(P, axis=0) - P[0]
    for l in range(DEPTH):
        h = rmsnorm(x, norm_mix[l])
        x = x + hybrid_mixer(h, w_in[l], cmp_pe[l], cmp_w1[l], cmp_w2[l], q_norm[l], k_norm[l],
                             lower_bounds[l], hg_norm[l], gla_w_a2[l], gla_b_a[l], gla_norm[l],
                             w_branch[l], w_out[l], slopes)
        h = rmsnorm(x, norm_ffn[l])
        x = x + hierarchical_moe(h, w_grp[l], b_grp[l], w_exp[l], b_exp[l], w_gate_up[l], w_down[l])
    return x
```

```cpp
#include <hip/hip_runtime.h>
#include <cstdio>
#include <cstdint>

#define GAS __attribute__((address_space(1)))
#define LAS __attribute__((address_space(3)))
typedef unsigned short bf16;
typedef short bf16x8 __attribute__((ext_vector_type(8)));
typedef float f32x4 __attribute__((ext_vector_type(4)));
typedef float f32x2 __attribute__((ext_vector_type(2)));
typedef unsigned u32x4 __attribute__((ext_vector_type(4)));
typedef unsigned u32x2 __attribute__((ext_vector_type(2)));

constexpr int T = 8192, D = 2048, NL = 2, INC = 11048, NPAD = 11264;
constexpr int NE = 32, FF = 512;
constexpr float EPS = 1e-6f, NEGB = -1e30f;
constexpr int C_Q = 0, C_KC = 512, C_VC = 640, C_KS = 768, C_VS = 896, C_KW = 1024, C_VW = 1152;
constexpr int C_HQ = 1280, C_HF = 1792, C_HI = 2304, C_HG = 2816, C_GQ = 3328, C_GK = 3584, C_GV = 3840, C_GR = 4352;
constexpr int C_MG = 4864, C_NG = 11008, C_GA = 11032;

constexpr size_t MiB = 1u << 20;
constexpr size_t WS_CTL = 0, CTL_ZERO_BYTES = 1 * MiB;
constexpr size_t WS_WIN = 2 * MiB;
constexpr size_t WS_WBR = 90 * MiB;
constexpr size_t WS_WOUT = 102 * MiB;
constexpr size_t WS_WGU = 118 * MiB;
constexpr size_t WS_WDN = 374 * MiB;
constexpr size_t WS_H = 502 * MiB;
constexpr size_t WS_P = 534 * MiB;
constexpr size_t WS_OCAT = 710 * MiB;
constexpr size_t WS_PROJ = 734 * MiB;
constexpr size_t WS_MERGED = 830 * MiB;
constexpr size_t WS_X1 = 862 * MiB;
constexpr size_t WS_XRES = 926 * MiB;
constexpr size_t WS_CONTRIB = 990 * MiB;
constexpr size_t WS_ACT = 1054 * MiB;
constexpr size_t WS_QN = 1078 * MiB;
constexpr size_t WS_KV = 1094 * MiB;
constexpr size_t WS_KC = 1118 * MiB;
constexpr size_t WS_ORAW = 1119 * MiB;
constexpr size_t WS_ROUTE = 1151 * MiB;
constexpr size_t WS_END = 1153 * MiB;
constexpr size_t KV_STRIDE = (size_t)2 * T * 64;
constexpr int CW_BAR = 4096;

constexpr int RING_BYTES = 131072;
constexpr int MISC_OFF = RING_BYTES;
constexpr int LDS_BYTES = 147456;

#define LDS_WAIT() asm volatile("s_waitcnt lgkmcnt(0)" ::: "memory")
#define VM_WAIT() asm volatile("s_waitcnt vmcnt(0)" ::: "memory")
#define WSYNC() asm volatile("s_waitcnt lgkmcnt(0)" ::: "memory")

__device__ __forceinline__ unsigned f2bf(float f) { unsigned u = __builtin_bit_cast(unsigned, f); return (u + 0x7fffu + ((u >> 16) & 1u)) >> 16; }
__device__ __forceinline__ unsigned pk2(float lo, float hi) { return f2bf(lo) | (f2bf(hi) << 16); }
__device__ __forceinline__ float bf2f(unsigned b) { return __builtin_bit_cast(float, (b & 0xffffu) << 16); }
__device__ __forceinline__ float bflo(unsigned w) { return __builtin_bit_cast(float, w << 16); }
__device__ __forceinline__ float bfhi(unsigned w) { return __builtin_bit_cast(float, w & 0xffff0000u); }
__device__ __forceinline__ float wave_sum(float v) {
#pragma unroll
    for (int o = 1; o < 64; o <<= 1) v += __shfl_xor(v, o);
    return v;
}
__device__ __forceinline__ float wave_max(float v) {
#pragma unroll
    for (int o = 1; o < 64; o <<= 1) v = fmaxf(v, __shfl_xor(v, o));
    return v;
}
__device__ __forceinline__ int ltid() { int t = threadIdx.x; asm volatile("" : "+v"(t)); return t; }
__device__ __forceinline__ int lbid() { int b = blockIdx.x; asm volatile("" : "+s"(b)); return b; }
__device__ __forceinline__ float sigmoidf_(float x) { return 1.0f / (1.0f + expf(-x)); }

#define XB_TMO      128
#define XB_XCNT(j)  (256  + 64 * (j))
#define XB_XSUB(j)  (1280 + 64 * (j))
#define XB_XGEN(j)  (2304 + 64 * (j))
#define XB_TOP      3328
#define XB_TOPGEN   3392
#define XCD_BAR_WORDS 3456
#define XB_SPIN_CAP (1u << 25)

__device__ __forceinline__ unsigned xb_ld(unsigned* p)              { return __hip_atomic_load(p, __ATOMIC_RELAXED, __HIP_MEMORY_SCOPE_AGENT); }
__device__ __forceinline__ unsigned xb_add(unsigned* p, unsigned v) { return __hip_atomic_fetch_add(p, v, __ATOMIC_RELAXED, __HIP_MEMORY_SCOPE_AGENT); }
__device__ __forceinline__ unsigned xb_xcc_id() { return (unsigned)__builtin_amdgcn_s_getreg((3 << 11) | 20) & 0xFu; }
#define XB_SPIN(cond, bar) do { unsigned _sp = 0; while (cond) { __builtin_amdgcn_s_sleep(1); \
    if ((++_sp & 255u) == 0u) { if (xb_ld(&(bar)[XB_TMO])) break; if (_sp > XB_SPIN_CAP) { atomicAdd(&(bar)[XB_TMO], 1u); break; } } } } while (0)

struct XcdBarrier { unsigned* bar; unsigned x; volatile LAS unsigned* st; };

__device__ __forceinline__ XcdBarrier xcd_barrier_post(unsigned* bar, volatile LAS unsigned* st) {
    XcdBarrier b; b.bar = bar; b.x = xb_xcc_id(); b.st = st;
    if (threadIdx.x == 0) (void)xb_add(&bar[XB_XCNT(b.x)], 1u);
    return b;
}
__device__ __forceinline__ void xcd_barrier_complete(unsigned* bar, unsigned x, unsigned& nloc, unsigned& nx) {
    const unsigned G = gridDim.x * gridDim.y * gridDim.z;
    unsigned sum, cnt, mine, sp = 0u;
    for (;;) {
        sum = 0u; cnt = 0u; mine = 0u;
#pragma unroll
        for (unsigned j = 0; j < 16; ++j) { const unsigned c = xb_ld(&bar[XB_XCNT(j)]); sum += c; cnt += (c > 0u) ? 1u : 0u; mine = (j == x) ? c : mine; }
        if (sum == G) break;
        __builtin_amdgcn_s_sleep(1);
        if ((++sp & 255u) == 0u) { if (xb_ld(&bar[XB_TMO])) break; if (sp > XB_SPIN_CAP) { atomicAdd(&bar[XB_TMO], 1u); break; } }
    }
    nloc = mine > 0u ? mine : 1u; nx = cnt > 0u ? cnt : 1u;
}
__device__ __forceinline__ void xcd_barrier(const XcdBarrier& b) {
    asm volatile("s_waitcnt vmcnt(0)" ::: "memory");
    __syncthreads();
    if (threadIdx.x == 0) {
        unsigned* bar = b.bar;
        __builtin_amdgcn_s_waitcnt(0);
        unsigned nloc = b.st[0], nx = b.st[1];
        if (nloc == 0u) { xcd_barrier_complete(bar, b.x, nloc, nx); b.st[0] = nloc; b.st[1] = nx; }
        const unsigned old = xb_add(&bar[XB_XSUB(b.x)], 1u);
        const unsigned gen = old / nloc;
        if (old + 1u == (gen + 1u) * nloc) {
            __builtin_amdgcn_fence(__ATOMIC_RELEASE, "agent");
            asm volatile("s_waitcnt vmcnt(0)" ::: "memory");
            const unsigned og = xb_add(&bar[XB_TOP], 1u);
            const unsigned tg = og / nx;
            if (og + 1u == (tg + 1u) * nx) xb_add(&bar[XB_TOPGEN], 1u);
            else XB_SPIN(xb_ld(&bar[XB_TOPGEN]) == tg, bar);
            __builtin_amdgcn_fence(__ATOMIC_ACQUIRE, "agent");
            xb_add(&bar[XB_XGEN(b.x)], 1u);
            asm volatile("s_waitcnt vmcnt(0)" ::: "memory");
        } else {
            XB_SPIN(xb_ld(&bar[XB_XGEN(b.x)]) == gen, bar);
            __builtin_amdgcn_fence(__ATOMIC_ACQUIRE, "agent");
            asm volatile("s_waitcnt vmcnt(0)" ::: "memory");
        }
    }
    __syncthreads();
}

namespace pg8 {
constexpr int BM = 256, BK = 64, HALF = 128, HTB = HALF * BK * 2, STAGE_BYTES = 8 * HTB, NXCD = 8, WGM = 8;
__host__ __device__ __forceinline__ int lds_byte(int r, int c) { const int st = (r >> 4) * 2 + (c >> 5), rr = r & 15, cc = c & 31, ob = rr * 64 + cc * 2; return st * 1024 + (ob ^ (((ob >> 9) & 1) << 5)); }
__host__ __device__ __forceinline__ void stage_rc(int b, int& R, int& C) { const int st = b / 1024, sb = b % 1024, swz = sb ^ (((sb >> 9) & 1) << 5); R = (st >> 1) * 16 + swz / 64; C = (st & 1) * 32 + (swz % 64) / 2; }
__host__ __device__ __forceinline__ int perm32(int rho) { const int n = rho >> 4, i = rho & 15; return 8 * (i >> 2) + 4 * n + (i & 3); }

struct Unit { int pm, pn, e, nvalid, slot0; const char *A0, *A1, *B0, *B1; unsigned va[2][2]; };

__device__ __forceinline__ unsigned cvt_pk_bf16(float lo, float hi) { unsigned r; asm volatile("v_cvt_pk_bf16_f32 %0, %1, %2" : "=v"(r) : "v"(lo), "v"(hi)); return r; }

template <class Epi, class Sched, bool ALIGN_EPI>
__device__ __forceinline__ void gemm_phase(LAS unsigned char* lds, const int K, const Sched& S, const Epi& E) {
    const int tid = ltid(), wid = __builtin_amdgcn_readfirstlane(tid >> 6), lane = tid & 63, wr = wid >> 2, wc = wid & 3, fr = lane & 15, fq = lane >> 4;
    const int nt = K / BK;
    unsigned voffB[2];
#pragma unroll
    for (int i = 0; i < 2; ++i) { int R, C; stage_rc(tid * 16 + i * 8192, R, C); const int Rb = Epi::PERM ? ((R & ~31) + perm32(R & 31)) : R; voffB[i] = (unsigned)(Rb * K + C) * 2u; }
    const size_t kstep = (size_t)(BK * 2);
    const unsigned ldsw = (unsigned)wid * 1024u;
    const int aoff = lds_byte(wr * 64 + fr, fq * 8), boff = lds_byte(wc * 32 + fr, fq * 8);
#define PG8_SA(b, h) (((b) * 2 + (h)) * HTB)
#define PG8_SB(b, h) ((4 + (b) * 2 + (h)) * HTB)
#define PG8_STAGE(bufoff, gbase, voff) do { _Pragma("unroll") for (int _i = 0; _i < 2; ++_i) \
        __builtin_amdgcn_global_load_lds((const unsigned*)((const char*)(gbase) + (voff)[_i]), (LAS unsigned*)(lds + (bufoff) + ldsw + _i * 8192), 16, 0, 0); } while (0)
#define PG8_LDA(dst, b, h) do { _Pragma("unroll") for (int m = 0; m < 4; ++m) _Pragma("unroll") for (int k = 0; k < 2; ++k) dst[m][k] = *(const LAS bf16x8*)(lds + PG8_SA(b, h) + aoff + m * 2048 + k * 1024); } while (0)
#define PG8_LDB(dst, b, h) do { _Pragma("unroll") for (int n = 0; n < 2; ++n) _Pragma("unroll") for (int k = 0; k < 2; ++k) dst[n][k] = *(const LAS bf16x8*)(lds + PG8_SB(b, h) + boff + n * 2048 + k * 1024); } while (0)
#define PG8_MMA(ai, bj, At, Bt) do { __builtin_amdgcn_s_setprio(1); _Pragma("unroll") for (int m = 0; m < 4; ++m) _Pragma("unroll") for (int n = 0; n < 2; ++n) _Pragma("unroll") for (int k = 0; k < 2; ++k) \
        acc[ai][bj][m][n] = __builtin_amdgcn_mfma_f32_16x16x32_bf16(Bt[n][k], At[m][k], acc[ai][bj][m][n], 0, 0, 0); __builtin_amdgcn_s_setprio(0); } while (0)
#define PG8_WAIT_V(n) asm volatile("s_waitcnt vmcnt(" #n ")" ::: "memory")
#define PG8_WAIT_L(n) asm volatile("s_waitcnt lgkmcnt(" #n ")" ::: "memory")
#define PG8_BAR __builtin_amdgcn_s_barrier()
#define PG8_SCHED __builtin_amdgcn_sched_barrier(0)
#define VA(u, h) (Sched::GATHER ? (u).va[h] : S.va)
    Unit cur, nxt; int ui = 0;
    if (!S.next(0, cur)) return;
    f32x4 acc[2][2][4][2];
#pragma unroll
    for (int a = 0; a < 2; ++a)
#pragma unroll
        for (int b = 0; b < 2; ++b)
#pragma unroll
            for (int m = 0; m < 4; ++m)
#pragma unroll
                for (int n = 0; n < 2; ++n) acc[a][b][m][n] = (f32x4){0.f, 0.f, 0.f, 0.f};
    bf16x8 At[4][2], B0[2][2], B1[2][2];
    PG8_STAGE(PG8_SB(0, 0), cur.B0, voffB); PG8_STAGE(PG8_SB(0, 1), cur.B1, voffB); PG8_STAGE(PG8_SA(0, 0), cur.A0, VA(cur, 0)); PG8_STAGE(PG8_SA(0, 1), cur.A1, VA(cur, 1));
    if (wr == 1) PG8_BAR;
    PG8_WAIT_V(2); PG8_BAR;
    PG8_STAGE(PG8_SB(1, 0), cur.B0 + kstep, voffB); PG8_STAGE(PG8_SA(1, 0), cur.A0 + kstep, VA(cur, 0)); PG8_STAGE(PG8_SB(1, 1), cur.B1 + kstep, voffB);
    PG8_WAIT_V(6); PG8_BAR;
    for (;;) {
        const bool has_next = S.next(ui + 1, nxt);
        if (!has_next) nxt = cur;
        for (int t = 0; t < nt; t += 2) {
            const bool last = (t == nt - 2);
            const char* a1h1 = cur.A1 + (size_t)(t + 1) * kstep;
            const char* a2h0 = last ? nxt.A0 : cur.A0 + (size_t)(t + 2) * kstep; const char* a2h1 = last ? nxt.A1 : cur.A1 + (size_t)(t + 2) * kstep;
            const char* b2h0 = last ? nxt.B0 : cur.B0 + (size_t)(t + 2) * kstep; const char* b2h1 = last ? nxt.B1 : cur.B1 + (size_t)(t + 2) * kstep;
            unsigned v2h0[2], v2h1[2];
#pragma unroll
            for (int i = 0; i < 2; ++i) { if constexpr (Sched::GATHER) { v2h0[i] = last ? nxt.va[0][i] : cur.va[0][i]; v2h1[i] = last ? nxt.va[1][i] : cur.va[1][i]; } else { v2h0[i] = S.va[i]; v2h1[i] = S.va[i]; } }
            PG8_LDB(B0, 0, 0); PG8_LDB(B1, 0, 1); PG8_SCHED; PG8_LDA(At, 0, 0); PG8_STAGE(PG8_SA(1, 1), a1h1, VA(cur, 1));
            PG8_WAIT_V(8); PG8_WAIT_L(0); PG8_BAR; PG8_MMA(0, 0, At, B0); PG8_MMA(0, 1, At, B1); PG8_BAR; PG8_SCHED;
            PG8_LDA(At, 0, 1); PG8_STAGE(PG8_SB(0, 0), b2h0, voffB); PG8_STAGE(PG8_SB(0, 1), b2h1, voffB); PG8_STAGE(PG8_SA(0, 0), a2h0, v2h0);
            PG8_WAIT_V(8); PG8_WAIT_L(0); PG8_BAR; PG8_MMA(1, 0, At, B0); PG8_MMA(1, 1, At, B1); PG8_BAR; PG8_SCHED;
            PG8_LDB(B0, 1, 0); PG8_LDB(B1, 1, 1); PG8_SCHED; PG8_LDA(At, 1, 0); PG8_STAGE(PG8_SA(0, 1), a2h1, v2h1);
            PG8_WAIT_V(8); PG8_WAIT_L(0); PG8_BAR; PG8_MMA(0, 0, At, B0); PG8_MMA(0, 1, At, B1); PG8_BAR; PG8_SCHED;
            PG8_LDA(At, 1, 1); PG8_STAGE(PG8_SB(1, 0), b2h0 + kstep, voffB); PG8_STAGE(PG8_SB(1, 1), b2h1 + kstep, voffB); PG8_STAGE(PG8_SA(1, 0), a2h0 + kstep, v2h0);
            PG8_WAIT_V(8); PG8_WAIT_L(0); PG8_BAR; PG8_MMA(1, 0, At, B0); PG8_MMA(1, 1, At, B1); PG8_BAR; PG8_SCHED;
        }
        if constexpr (ALIGN_EPI) { if (wr == 0) PG8_BAR; }
        E(acc, cur, wr, wc, fr, fq);
        if (!has_next) break;
#pragma unroll
        for (int a = 0; a < 2; ++a)
#pragma unroll
            for (int b = 0; b < 2; ++b)
#pragma unroll
                for (int m = 0; m < 4; ++m)
#pragma unroll
                    for (int n = 0; n < 2; ++n) acc[a][b][m][n] = (f32x4){0.f, 0.f, 0.f, 0.f};
        cur = nxt; ++ui;
        if constexpr (ALIGN_EPI) { if (wr == 1) PG8_BAR; }
    }
    PG8_WAIT_V(0);
    if constexpr (!ALIGN_EPI) { if (wr == 0) PG8_BAR; }
    PG8_BAR;
#undef VA
#undef PG8_SA
#undef PG8_SB
#undef PG8_STAGE
#undef PG8_LDA
#undef PG8_LDB
#undef PG8_MMA
#undef PG8_WAIT_V
#undef PG8_WAIT_L
#undef PG8_BAR
#undef PG8_SCHED
}

struct PlainSched {
    static constexpr bool GATHER = false;
    int nM, nN, nwg, G, c, lda, K; const char* A; const char* Bt; unsigned va[2];
    __device__ __forceinline__ void init(const bf16* A_, int lda_, const bf16* Bt_, int M, int N, int K_, int G_, int c_) {
        nM = M / BM; nN = N / BM; nwg = nM * nN; G = G_; c = c_; lda = lda_; K = K_; A = (const char*)A_; Bt = (const char*)Bt_;
#pragma unroll
        for (int i = 0; i < 2; ++i) { int R, C; stage_rc((int)ltid() * 16 + i * 8192, R, C); va[i] = (unsigned)(R * lda + C) * 2u; }
    }
    __device__ __forceinline__ bool next(int i, Unit& u) const {
        const long L = (long)i * G + c; if (L >= nwg) return false;
        int wgid = (int)L; { const int q = nwg / NXCD, r = nwg % NXCD, xcd = wgid % NXCD, off = wgid / NXCD; wgid = (xcd < r ? xcd * (q + 1) : r * (q + 1) + (xcd - r) * q) + off; }
        const int nig = WGM * nN, gid = wgid / nig, fm = gid * WGM, gsz = (nM - fm) < WGM ? (nM - fm) : WGM;
        u.pm = fm + ((wgid % nig) % gsz); u.pn = (wgid % nig) / gsz; u.e = 0; u.nvalid = 256; u.slot0 = 0; u.va[0][0] = 0u; u.va[0][1] = 0u; u.va[1][0] = 0u; u.va[1][1] = 0u;
        u.A0 = A + (size_t)u.pm * BM * lda * 2; u.A1 = u.A0 + (size_t)HALF * lda * 2;
        u.B0 = Bt + (size_t)u.pn * BM * K * 2; u.B1 = u.B0 + (size_t)HALF * K * 2;
        return true;
    }
};
template <int MODE> struct MoeSched {
    static constexpr int NPN = MODE == 1 ? 4 : 8;
    static constexpr bool GATHER = MODE == 1;
    int G, c; const LAS int* tb; const int* cnt; const int* list; const char* A; const char* W; unsigned va[2];
    __device__ __forceinline__ void init(int G_, int c_, const LAS int* tb_, const int* cnt_, const int* list_, const void* A_, const void* W_) {
        G = G_; c = c_; tb = tb_; cnt = cnt_; list = list_; A = (const char*)A_; W = (const char*)W_;
#pragma unroll
        for (int i = 0; i < 2; ++i) { int R, C; stage_rc((int)ltid() * 16 + i * 8192, R, C); va[i] = (unsigned)(R * FF + C) * 2u; }
    }
    __device__ __forceinline__ bool next(int i, Unit& u) const {
        const int L = i * G + c, ntile = __builtin_amdgcn_readfirstlane(tb[NE]); if (L >= ntile * NPN) return false;
        const int tl = L / NPN, pn = L % NPN; int e = 0;
        while (e < NE - 1 && __builtin_amdgcn_readfirstlane(tb[e + 1]) <= tl) ++e;
        const int pm = tl - __builtin_amdgcn_readfirstlane(tb[e]), ne = __builtin_amdgcn_readfirstlane(cnt[e]);
        u.pm = pm; u.pn = pn; u.e = e; u.nvalid = ne - pm * 256; u.slot0 = tl * 256;
        if (MODE == 1) {
            u.A0 = A; u.A1 = A;
#pragma unroll
            for (int h = 0; h < 2; ++h)
#pragma unroll
                for (int k = 0; k < 2; ++k) { int Rk, Ck; stage_rc((int)ltid() * 16 + k * 8192, Rk, Ck); int idx = pm * 256 + h * 128 + Rk; idx = idx < ne ? idx : ne - 1; const int entry = list[e * 8192 + idx]; u.va[h][k] = (unsigned)(entry >> 1) * (unsigned)(D * 2) + (unsigned)Ck * 2u; }
            const char* we = W + (size_t)e * 1024 * D * 2;
            u.B0 = we + (size_t)(pn * 128) * D * 2; u.B1 = we + (size_t)(512 + pn * 128) * D * 2;
        } else {
            u.va[0][0] = 0u; u.va[0][1] = 0u; u.va[1][0] = 0u; u.va[1][1] = 0u;
            u.A0 = A + (size_t)tl * 256 * FF * 2; u.A1 = u.A0 + (size_t)HALF * FF * 2;
            const char* we = W + (size_t)e * D * FF * 2;
            u.B0 = we + (size_t)(pn * 256) * FF * 2; u.B1 = u.B0 + (size_t)HALF * FF * 2;
        }
        return true;
    }
};

struct EpiBf16 {
    static constexpr bool PERM = true;
    bf16* O; int ldc;
    __device__ __forceinline__ void operator()(const f32x4 (&acc)[2][2][4][2], const Unit& u, int wr, int wc, int fr, int fq) const {
        const int row0 = u.pm * BM + wr * 64 + fr, col0 = u.pn * BM + wc * 32 + 8 * fq;
#pragma unroll
        for (int ai = 0; ai < 2; ++ai)
#pragma unroll
            for (int m = 0; m < 4; ++m) { bf16* rowp = O + (size_t)(row0 + ai * HALF + m * 16) * ldc + col0;
#pragma unroll
                for (int bj = 0; bj < 2; ++bj) { const f32x4 v0 = acc[ai][bj][m][0], v1 = acc[ai][bj][m][1];
                    u32x4 w; w.x = cvt_pk_bf16(v0[0], v0[1]); w.y = cvt_pk_bf16(v0[2], v0[3]); w.z = cvt_pk_bf16(v1[0], v1[1]); w.w = cvt_pk_bf16(v1[2], v1[3]);
                    *(u32x4*)(rowp + bj * HALF) = w; } }
    }
};
struct EpiResF32 {
    static constexpr bool PERM = false;
    const float* R; float* O; int ldc;
    __device__ __forceinline__ void operator()(const f32x4 (&acc)[2][2][4][2], const Unit& u, int wr, int wc, int fr, int fq) const {
        const int row0 = u.pm * BM + wr * 64 + fr, col0 = u.pn * BM + wc * 32 + 4 * fq;
#pragma unroll
        for (int ai = 0; ai < 2; ++ai)
#pragma unroll
            for (int m = 0; m < 4; ++m) { const size_t off = (size_t)(row0 + ai * HALF + m * 16) * ldc + col0;
#pragma unroll
                for (int bj = 0; bj < 2; ++bj)
#pragma unroll
                    for (int n = 0; n < 2; ++n) { const f32x4 r = *(const f32x4*)(R + off + bj * HALF + n * 16); *(f32x4*)(O + off + bj * HALF + n * 16) = acc[ai][bj][m][n] + r; } }
    }
};
struct EpiMoe1 {
    static constexpr bool PERM = true;
    bf16* ACT; const int* list; const float* ew;
    __device__ __forceinline__ void operator()(const f32x4 (&acc)[2][2][4][2], const Unit& u, int wr, int wc, int fr, int fq) const {
        const int col0 = u.pn * 128 + wc * 32 + 8 * fq;
#pragma unroll
        for (int ai = 0; ai < 2; ++ai)
#pragma unroll
            for (int m = 0; m < 4; ++m) { const int r = ai * HALF + wr * 64 + m * 16 + fr; float w = 0.f;
                if (r < u.nvalid) { const int entry = list[u.e * 8192 + u.pm * 256 + r]; w = ew[entry]; }
                float o[8];
#pragma unroll
                for (int n = 0; n < 2; ++n)
#pragma unroll
                    for (int j = 0; j < 4; ++j) { const float g = acc[ai][0][m][n][j], up = acc[ai][1][m][n][j]; o[n * 4 + j] = g / (1.0f + __expf(-g)) * up * w; }
                u32x4 pk; pk.x = cvt_pk_bf16(o[0], o[1]); pk.y = cvt_pk_bf16(o[2], o[3]); pk.z = cvt_pk_bf16(o[4], o[5]); pk.w = cvt_pk_bf16(o[6], o[7]);
                *(u32x4*)(ACT + (size_t)(u.slot0 + r) * FF + col0) = pk; }
    }
};
struct EpiMoe2 {
    static constexpr bool PERM = true;
    bf16* CO; const int* list;
    __device__ __forceinline__ void operator()(const f32x4 (&acc)[2][2][4][2], const Unit& u, int wr, int wc, int fr, int fq) const {
        const int col0 = u.pn * BM + wc * 32 + 8 * fq;
#pragma unroll
        for (int ai = 0; ai < 2; ++ai)
#pragma unroll
            for (int m = 0; m < 4; ++m) { const int r = ai * HALF + wr * 64 + m * 16 + fr;
                if (r < u.nvalid) { const int entry = list[u.e * 8192 + u.pm * 256 + r]; bf16* rowp = CO + (size_t)entry * D + col0;
#pragma unroll
                    for (int bj = 0; bj < 2; ++bj) { const f32x4 v0 = acc[ai][bj][m][0], v1 = acc[ai][bj][m][1];
                        u32x4 w; w.x = cvt_pk_bf16(v0[0], v0[1]); w.y = cvt_pk_bf16(v0[2], v0[3]); w.z = cvt_pk_bf16(v1[0], v1[1]); w.w = cvt_pk_bf16(v1[2], v1[3]);
                        *(u32x4*)(rowp + bj * HALF) = w; } } }
    }
};
}

struct Frame {
    LAS unsigned char* lds; volatile LAS unsigned* MISC;
    int tid, lane, wave, vcu, G, gw, NGW, bid;
};
struct Args { const GAS float* in[22]; GAS float* out; GAS unsigned char* ws; int ph_lo, ph_hi, li, pad; };
typedef const __attribute__((address_space(4))) Args KArgs;
__device__ __forceinline__ KArgs* ka_fresh() { unsigned long long p = (unsigned long long)__builtin_amdgcn_kernarg_segment_ptr(); asm volatile("" : "+s"(p)); return (KArgs*)p; }
#define KA KArgs* const ka = ka_fresh()
#define KIN(i) ((const float*)ka->in[i])
#define KWS ((unsigned char*)ka->ws)
#define KOUT ((float*)ka->out)
enum { I_X = 0, I_NMIX, I_WIN, I_PE, I_W1, I_W2, I_QN, I_KN, I_LB, I_HGN, I_WA2, I_BA, I_GLAN, I_WBR, I_WOUT, I_NFFN, I_WGRP, I_BGRP, I_WEXP, I_BEXP, I_WGU, I_WDN };

__device__ __forceinline__ void tr_item(const float* W, size_t ldw, int c0, int nv, bf16* WT, size_t ldt, int r0, int k0, LAS float* scr, int lane) {
    const int nn = lane & 31;
#pragma unroll 8
    for (int i = 0; i < 32; ++i) { const int kk = 2 * i + (lane >> 5); scr[kk * 33 + nn] = nn < nv ? W[(size_t)(k0 + kk) * ldw + c0 + nn] : 0.f; }
    LDS_WAIT();
    const int c = lane & 7;
#pragma unroll
    for (int j = 0; j < 4; ++j) { const int n = (lane >> 3) + 8 * j; const LAS float* s = scr + (8 * c) * 33 + n;
        u32x4 o; o.x = pk2(s[0 * 33], s[1 * 33]); o.y = pk2(s[2 * 33], s[3 * 33]); o.z = pk2(s[4 * 33], s[5 * 33]); o.w = pk2(s[6 * 33], s[7 * 33]);
        if (n < nv) *(u32x4*)(WT + (size_t)(r0 + n) * ldt + k0 + 8 * c) = o; }
    LDS_WAIT();
}
__device__ __forceinline__ void phase_prologue(Frame& F) {
    KA;
    LAS float* scr = (LAS float*)(F.lds + F.wave * 16384);
    constexpr int IT_WIN = 32 * 346, IT_WBR = 3 * 8 * 64, IT_WOUT = 32 * 64, IT_WGU = 32 * 32 * 32, IT_WDN = 32 * 8 * 64, IT_L = IT_WIN + IT_WBR + IT_WOUT + IT_WGU + IT_WDN;
    for (int it = F.gw; it < NL * IT_L; it += F.NGW) {
        const int l = it / IT_L; int r = it % IT_L;
        if (r < IT_WIN) { const int kb = r / 346, nb = r % 346; int src, dst, nv = 32;
            if (nb < 40) { src = nb * 32; dst = nb * 32; }
            else if (nb == 40) { src = 1280; dst = C_NG; nv = 24; }
            else if (nb < 153) { src = 1304 + 32 * (nb - 41); dst = 1280 + 32 * (nb - 41); }
            else if (nb == 153) { src = 4888; dst = C_GA; nv = 16; }
            else { src = 4904 + 32 * (nb - 154); dst = C_MG + 32 * (nb - 154); }
            tr_item(KIN(I_WIN) + (size_t)l * D * INC, INC, src, nv, (bf16*)(KWS + WS_WIN) + (size_t)l * NPAD * D, D, dst, kb * 64, scr, F.lane); continue; }
        r -= IT_WIN;
        if (r < IT_WBR) { const int n = r / 512, q = r % 512, kb = q / 64, nb = q % 64;
            tr_item(KIN(I_WBR) + ((size_t)l * 3 + n) * 512 * D, D, nb * 32, 32, (bf16*)(KWS + WS_WBR) + ((size_t)l * 3 + n) * D * 512, 512, nb * 32, kb * 64, scr, F.lane); continue; }
        r -= IT_WBR;
        if (r < IT_WOUT) { const int kb = r / 64, nb = r % 64;
            tr_item(KIN(I_WOUT) + (size_t)l * D * D, D, nb * 32, 32, (bf16*)(KWS + WS_WOUT) + (size_t)l * D * D, D, nb * 32, kb * 64, scr, F.lane); continue; }
        r -= IT_WOUT;
        if (r < IT_WGU) { const int e = r / 1024, q = r % 1024, kb = q / 32, nb = q % 32;
            tr_item(KIN(I_WGU) + ((size_t)l * NE + e) * D * 1024, 1024, nb * 32, 32, (bf16*)(KWS + WS_WGU) + ((size_t)l * NE + e) * 1024 * D, D, nb * 32, kb * 64, scr, F.lane); continue; }
        r -= IT_WGU;
        { const int e = r / 512, q = r % 512, kb = q / 64, nb = q % 64;
            tr_item(KIN(I_WDN) + ((size_t)l * NE + e) * FF * D, D, nb * 32, 32, (bf16*)(KWS + WS_WDN) + ((size_t)l * NE + e) * D * FF, FF, nb * 32, kb * 64, scr, F.lane); }
    }
}

template <int MODE> __device__ __forceinline__ void phase_norm1(Frame& F, const float* xin, const bf16* contrib, float* xout, const float* gain, bf16* H) {
    for (int t = F.gw; t < T; t += F.NGW) {
        const f32x4* xr = (const f32x4*)(xin + (size_t)t * D) + F.lane;
        f32x4 v[8]; float ss = 0.f;
#pragma unroll
        for (int j = 0; j < 8; ++j) { v[j] = xr[64 * j];
            if (MODE != 0) { const u32x2 c0 = *((const u32x2*)(contrib + (size_t)(2 * t) * D) + F.lane + 64 * j), c1 = *((const u32x2*)(contrib + (size_t)(2 * t + 1) * D) + F.lane + 64 * j);
                v[j].x += bflo(c0.x) + bflo(c1.x); v[j].y += bfhi(c0.x) + bfhi(c1.x); v[j].z += bflo(c0.y) + bflo(c1.y); v[j].w += bfhi(c0.y) + bfhi(c1.y);
                *((f32x4*)(xout + (size_t)t * D) + F.lane + 64 * j) = v[j]; }
            ss += v[j].x * v[j].x + v[j].y * v[j].y + v[j].z * v[j].z + v[j].w * v[j].w; }
        if (MODE != 2) {
            const float rstd = 1.0f / sqrtf(wave_sum(ss) * (1.0f / D) + EPS);
#pragma unroll
            for (int j = 0; j < 8; ++j) { const f32x4 g = *((const f32x4*)gain + F.lane + 64 * j);
                u32x2 o; o.x = pk2(v[j].x * rstd * g.x, v[j].y * rstd * g.y); o.y = pk2(v[j].z * rstd * g.z, v[j].w * rstd * g.w);
                *((u32x2*)(H + (size_t)t * D) + F.lane + 64 * j) = o; }
        }
    }
}

__device__ __forceinline__ void phase_prep(Frame& F, int l) {
    KA;
    const bf16* P = (const bf16*)(KWS + WS_P);
    float* QN = (float*)(KWS + WS_QN); float* KV = (float*)(KWS + WS_KV);
    const float* qg = KIN(I_QN) + l * 64; const float* kg = KIN(I_KN) + l * 192;
    for (int it = F.gw; it < T * 20; it += F.NGW) {
        const int t = it / 20, v = it % 20;
        float x = bf2f(P[(size_t)t * NPAD + v * 64 + F.lane]);
        const bool isq = v < 8, nk1 = (v == 12 || v == 13), nk2 = (v == 16 || v == 17);
        if (isq || nk1 || nk2) { const float ss = wave_sum(x * x); const float g = isq ? qg[F.lane] : (nk1 ? kg[64 + F.lane] : kg[128 + F.lane]); x = x * (1.0f / sqrtf(ss * (1.0f / 64.0f) + EPS)) * g; }
        if (isq) QN[((size_t)v * T + t) * 64 + F.lane] = x;
        else { const int w = v - 8, tens = w >> 1, g = w & 1; KV[(size_t)tens * KV_STRIDE + ((size_t)g * T + t) * 64 + F.lane] = x; }
    }
}
__device__ __forceinline__ float gelu_tanh(float x) { const float u = 0.7978845608028654f * (x + 0.044715f * x * x * x); return 0.5f * x * (1.0f + tanhf(u)); }
__device__ __forceinline__ void phase_compress(Frame& F, int l) {
    KA;
    LAS float* av = (LAS float*)(F.lds + F.wave * 16384);
    const float* KV = (const float*)(KWS + WS_KV); float* KC = (float*)(KWS + WS_KC);
    for (int it = F.gw; it < 2 * 2 * 511; it += F.NGW) {
        const int kind = it / 1022, q = it % 1022, g = q / 511, n = q % 511;
        const float* src = KV + (size_t)kind * KV_STRIDE + ((size_t)g * T + 16 * n) * 64;
        const float* pe = KIN(I_PE) + ((size_t)l * 2 + kind) * 2048;
        const float* w1 = KIN(I_W1) + ((size_t)l * 2 + kind) * 2048 * 64;
        const float* w2 = KIN(I_W2) + ((size_t)l * 2 + kind) * 64 * 64;
#pragma unroll 4
        for (int c = 0; c < 32; ++c) av[c * 64 + F.lane] = src[c * 64 + F.lane] + pe[c * 64 + F.lane];
        WSYNC();
        float acc = 0.f;
#pragma unroll 8
        for (int i = 0; i < 2048; ++i) acc += av[i] * w1[i * 64 + F.lane];
        const float hid = gelu_tanh(acc);
        WSYNC();
        av[F.lane] = hid;
        WSYNC();
        float o = 0.f;
#pragma unroll 8
        for (int i = 0; i < 64; ++i) o += av[i] * w2[i * 64 + F.lane];
        WSYNC();
        if (kind == 0) { const float ss = wave_sum(o * o); o = o * (1.0f / sqrtf(ss * (1.0f / 64.0f) + EPS)) * KIN(I_KN)[l * 192 + F.lane]; }
        KC[(size_t)kind * (2 * 512 * 64) + ((size_t)g * 512 + n) * 64 + F.lane] = o;
    }
}
__device__ __forceinline__ void phase_recur(Frame& F, int l) {
    KA;
    const bf16* P = (const bf16*)(KWS + WS_P); float* ORAW = (float*)(KWS + WS_ORAW);
    for (int it = F.gw; it < 1024; it += F.NGW) {
        const int kind = it >> 9, head = (it >> 7) & 3, j = it & 127;
        if (kind == 0) {
            const int d0 = F.lane, d1 = F.lane + 64;
            const float* lbl = KIN(I_LB);
            float lb0, lb1;
            { const float a0 = lbl[head * 128 + d0], b0 = lbl[512 + head * 128 + d0], a1 = lbl[head * 128 + d1], b1 = lbl[512 + head * 128 + d1];
              lb0 = l == 0 ? 0.f : 1.0f / (1.0f + expf(a0 - b0)); lb1 = l == 0 ? 0.f : 1.0f / (1.0f + expf(a1 - b1)); }
            const bf16* Pq = P + C_HQ + head * 128; const bf16* Pf = P + C_HF + head * 128; const bf16* Pi = P + C_HI + head * 128 + j;
            float S0 = 0.f, S1 = 0.f;
            for (int t0 = 0; t0 < T; t0 += 8) {
                bf16 zq0[8], zq1[8], zf0[8], zf1[8], vi[8];
#pragma unroll
                for (int u = 0; u < 8; ++u) { const size_t row = (size_t)(t0 + u) * NPAD; zq0[u] = Pq[row + d0]; zq1[u] = Pq[row + d1]; zf0[u] = Pf[row + d0]; zf1[u] = Pf[row + d1]; vi[u] = Pi[row]; }
                float part[8];
#pragma unroll
                for (int u = 0; u < 8; ++u) { const float v = bf2f(vi[u]);
                    const float s0 = sigmoidf_(bf2f(zf0[u])), s1 = sigmoidf_(bf2f(zf1[u]));
                    const float f0 = lb0 + (1.0f - lb0) * s0, f1 = lb1 + (1.0f - lb1) * s1;
                    const float k0 = (1.0f - lb0) * (1.0f - s0), k1 = (1.0f - lb1) * (1.0f - s1);
                    S0 = f0 * S0 + k0 * v; S1 = f1 * S1 + k1 * v;
                    part[u] = bf2f(zq0[u]) * S0 + bf2f(zq1[u]) * S1; }
                float mine = 0.f;
#pragma unroll
                for (int u = 0; u < 8; ++u) { const float s = wave_sum(part[u]); mine = (F.lane == u) ? s : mine; }
                if (F.lane < 8) ORAW[(size_t)(t0 + F.lane) * 1024 + head * 128 + j] = mine;
            }
        } else {
            const int d = F.lane, c = head * 64 + d;
            float wa[16];
#pragma unroll
            for (int r = 0; r < 16; ++r) wa[r] = KIN(I_WA2)[((size_t)l * 16 + r) * 256 + c];
            const float ba = KIN(I_BA)[l * 256 + c];
            const bf16* Pq = P + C_GQ + c; const bf16* Pk = P + C_GK + c; const bf16* Pv = P + C_GV + head * 128 + j; const bf16* Pa = P + C_GA;
            float S = 0.f;
            for (int t0 = 0; t0 < T; t0 += 8) {
                bf16 zq[8], zk[8], zv[8]; u32x4 ga0[8], ga1[8];
#pragma unroll
                for (int u = 0; u < 8; ++u) { const size_t row = (size_t)(t0 + u) * NPAD; zq[u] = Pq[row]; zk[u] = Pk[row]; zv[u] = Pv[row]; ga0[u] = *(const u32x4*)(Pa + row); ga1[u] = *(const u32x4*)(Pa + row + 8); }
                float part[8];
#pragma unroll
                for (int u = 0; u < 8; ++u) {
                    float a = ba;
                    a += bflo(ga0[u].x) * wa[0] + bfhi(ga0[u].x) * wa[1] + bflo(ga0[u].y) * wa[2] + bfhi(ga0[u].y) * wa[3] + bflo(ga0[u].z) * wa[4] + bfhi(ga0[u].z) * wa[5] + bflo(ga0[u].w) * wa[6] + bfhi(ga0[u].w) * wa[7];
                    a += bflo(ga1[u].x) * wa[8] + bfhi(ga1[u].x) * wa[9] + bflo(ga1[u].y) * wa[10] + bfhi(ga1[u].y) * wa[11] + bflo(ga1[u].z) * wa[12] + bfhi(ga1[u].z) * wa[13] + bflo(ga1[u].w) * wa[14] + bfhi(ga1[u].w) * wa[15];
                    const float ls = fminf(a, 0.f) - log1pf(expf(-fabsf(a)));
                    const float f = expf(ls * (1.0f / 16.0f));
                    S = f * S + bf2f(zk[u]) * bf2f(zv[u]);
                    part[u] = bf2f(zq[u]) * 0.125f * S; }
                float mine = 0.f;
#pragma unroll
                for (int u = 0; u < 8; ++u) { const float s = wave_sum(part[u]); mine = (F.lane == u) ? s : mine; }
                if (F.lane < 8) ORAW[(size_t)(t0 + F.lane) * 1024 + 512 + head * 128 + j] = mine;
            }
        }
    }
}
__device__ __forceinline__ void phase_recur_out(Frame& F, int l) {
    KA;
    const bf16* P = (const bf16*)(KWS + WS_P); const float* ORAW = (const float*)(KWS + WS_ORAW); bf16* OCAT = (bf16*)(KWS + WS_OCAT);
    for (int it = F.gw; it < T * 8; it += F.NGW) {
        const int t = it >> 3, kind = (it >> 2) & 1, head = it & 3;
        const float* gn = (kind == 0 ? KIN(I_HGN) : KIN(I_GLAN)) + l * 128;
        const int cg = (kind == 0 ? C_HG : C_GR) + head * 128;
        const float r0 = ORAW[(size_t)t * 1024 + kind * 512 + head * 128 + F.lane], r1 = ORAW[(size_t)t * 1024 + kind * 512 + head * 128 + 64 + F.lane];
        const float rstd = 1.0f / sqrtf(wave_sum(r0 * r0 + r1 * r1) * (1.0f / 128.0f) + EPS);
        const float g0 = bf2f(P[(size_t)t * NPAD + cg + F.lane]), g1 = bf2f(P[(size_t)t * NPAD + cg + 64 + F.lane]);
        const float a0 = kind == 0 ? sigmoidf_(g0) : g0 * sigmoidf_(g0), a1 = kind == 0 ? sigmoidf_(g1) : g1 * sigmoidf_(g1);
        OCAT[(size_t)t * 1536 + 512 + kind * 512 + head * 128 + F.lane] = (bf16)f2bf(r0 * rstd * gn[F.lane] * a0);
        OCAT[(size_t)t * 1536 + 512 + kind * 512 + head * 128 + 64 + F.lane] = (bf16)f2bf(r1 * rstd * gn[64 + F.lane] * a1);
    }
}

template <bool WIN> __device__ __forceinline__ void nsa_block(const float* Kg, const float* Vg, int j, int t, int lane, const LAS float* qs, LAS float* pb, const float (&slope)[4], float (&M)[4], float (&L)[4], float (&o)[4]) {
    const int pos = 64 * j + lane, dist = t - pos;
    const bool valid = WIN ? (dist >= 0 && dist < 512) : (dist >= 0);
    float dot[4] = {0.f, 0.f, 0.f, 0.f};
    const f32x4* kr = (const f32x4*)(Kg + (size_t)pos * 64);
#pragma unroll 2
    for (int c = 0; c < 16; ++c) { const f32x4 kv = kr[c];
#pragma unroll
        for (int r = 0; r < 4; ++r) { const f32x4 qv = *(const LAS f32x4*)(qs + r * 64 + c * 4); dot[r] += kv.x * qv.x + kv.y * qv.y + kv.z * qv.z + kv.w * qv.w; } }
#pragma unroll
    for (int r = 0; r < 4; ++r) {
        const float s = valid ? dot[r] * 0.125f - slope[r] * (float)dist : NEGB;
        const float nm = fmaxf(M[r], wave_max(s)), sc = expf(M[r] - nm), p = valid ? expf(s - nm) : 0.f;
        L[r] = L[r] * sc + wave_sum(p); o[r] *= sc; M[r] = nm; pb[r * 64 + lane] = p;
    }
    WSYNC();
#pragma unroll 4
    for (int k = 0; k < 64; ++k) { const float v = Vg[(size_t)(64 * j + k) * 64 + lane];
#pragma unroll
        for (int r = 0; r < 4; ++r) o[r] += pb[r * 64 + k] * v; }
    WSYNC();
}
__device__ __forceinline__ void phase_nsa(Frame& F, int l) {
    KA;
    LAS float* qs = (LAS float*)(F.lds + F.wave * 8192);
    LAS float* pbuf = qs + 256;
    LAS float* scb = pbuf + 512;
    LAS float* pb = scb + 128;
    LAS float* impb = pb + 256;
    LAS float* ocb = impb + 512;
    const bf16* P = (const bf16*)(KWS + WS_P); bf16* OCAT = (bf16*)(KWS + WS_OCAT);
    const float* QN = (const float*)(KWS + WS_QN); const float* KV = (const float*)(KWS + WS_KV); const float* KC = (const float*)(KWS + WS_KC);
    const int lane = F.lane;
    for (int it = F.gw; it < T * 2; it += F.NGW) {
        const int t = it >> 1, g = it & 1;
        float slope[4];
#pragma unroll
        for (int r = 0; r < 4; ++r) { slope[r] = exp2f(-(float)(g * 4 + r + 1)); qs[r * 64 + lane] = QN[((size_t)(g * 4 + r) * T + t) * 64 + lane]; }
        WSYNC();
        int nvis = t >= 31 ? (t - 31) / 16 + 1 : 0; nvis = nvis > 511 ? 511 : nvis;
        const float* KCg = KC + (size_t)g * 512 * 64; const float* VCg = KC + (size_t)(2 * 512 * 64) + (size_t)g * 512 * 64;
#pragma unroll 1
        for (int i = 0; i < 8; ++i) impb[lane + 64 * i] = 0.f;
#pragma unroll 1
        for (int r = 0; r < 4; ++r) {
            const float sl = exp2f(-(float)(g * 4 + r + 1));
            float mx = NEGB;
#pragma unroll 1
            for (int i = 0; i < 8; ++i) { const int n = lane + 64 * i; float sv = NEGB;
                if (n < nvis) { const f32x4* kr = (const f32x4*)(KCg + (size_t)n * 64); float dot = 0.f;
#pragma unroll 4
                    for (int c = 0; c < 16; ++c) { const f32x4 kv = kr[c]; const f32x4 qv = *(const LAS f32x4*)(qs + r * 64 + c * 4); dot += kv.x * qv.x + kv.y * qv.y + kv.z * qv.z + kv.w * qv.w; }
                    sv = dot * 0.125f - sl * (float)(t - 16 * n - 31); }
                pbuf[n] = sv; mx = fmaxf(mx, sv); }
            mx = wave_max(mx);
            float sum = 0.f;
#pragma unroll 1
            for (int i = 0; i < 8; ++i) { const int n = lane + 64 * i; const float e = n < nvis ? expf(pbuf[n] - mx) : 0.f; pbuf[n] = e; sum += e; }
            sum = wave_sum(sum);
            const float inv = nvis > 0 ? 1.0f / sum : 0.f;
#pragma unroll 1
            for (int i = 0; i < 8; ++i) { const int n = lane + 64 * i; const float p = pbuf[n] * inv; pbuf[n] = p; impb[n] += p; }
            WSYNC();
            float oc = 0.f;
#pragma unroll 4
            for (int n = 0; n < nvis; ++n) oc += pbuf[n] * VCg[(size_t)n * 64 + lane];
            ocb[r * 64 + lane] = oc;
            WSYNC();
        }
        const int cur = t >> 6;
        float sc2[2];
#pragma unroll
        for (int jj = 0; jj < 2; ++jj) { const int j = lane + 64 * jj;
            float v = (j > 0 ? impb[4 * j - 1] : 0.f) + 2.0f * (impb[4 * j] + impb[4 * j + 1] + impb[4 * j + 2]) + impb[4 * j + 3];
            if (j == 0 || j == cur || j == cur - 1) v = 1e4f;
            if (j > cur) v = -1.0f;
            sc2[jj] = v; scb[j] = v; }
        WSYNC();
        unsigned long long msk[2];
#pragma unroll
        for (int jj = 0; jj < 2; ++jj) { const int j = lane + 64 * jj; int rank = 0;
#pragma unroll 4
            for (int i = 0; i < 128; ++i) { const float si = scb[i]; rank += (si > sc2[jj] || (si == sc2[jj] && i < j)) ? 1 : 0; }
            msk[jj] = __ballot(rank < 16); }
        WSYNC();
        float M[4], L[4], os[4], ow[4];
#pragma unroll
        for (int r = 0; r < 4; ++r) { M[r] = NEGB; L[r] = 0.f; os[r] = 0.f; }
        { const float* Kg = KV + 2 * KV_STRIDE + (size_t)g * T * 64; const float* Vg = KV + 3 * KV_STRIDE + (size_t)g * T * 64;
#pragma unroll 1
          for (int j = 0; j <= cur; ++j) { const bool sel = ((j < 64 ? msk[0] >> j : msk[1] >> (j - 64)) & 1ull) != 0ull; if (sel) nsa_block<false>(Kg, Vg, j, t, lane, qs, pb, slope, M, L, os); } }
#pragma unroll
        for (int r = 0; r < 4; ++r) { os[r] = os[r] / L[r]; M[r] = NEGB; L[r] = 0.f; ow[r] = 0.f; }
        { const float* Kg = KV + 4 * KV_STRIDE + (size_t)g * T * 64; const float* Vg = KV + 5 * KV_STRIDE + (size_t)g * T * 64;
          const int j0 = t >= 511 ? (t - 511) >> 6 : 0;
#pragma unroll 1
          for (int j = j0; j <= cur; ++j) nsa_block<true>(Kg, Vg, j, t, lane, qs, pb, slope, M, L, ow); }
#pragma unroll
        for (int r = 0; r < 4; ++r) { const int h = g * 4 + r;
            const float g0 = sigmoidf_(bf2f(P[(size_t)t * NPAD + C_NG + h])), g1 = sigmoidf_(bf2f(P[(size_t)t * NPAD + C_NG + 8 + h])), g2 = sigmoidf_(bf2f(P[(size_t)t * NPAD + C_NG + 16 + h]));
            OCAT[(size_t)t * 1536 + h * 64 + lane] = (bf16)f2bf(g0 * ocb[r * 64 + lane] + g1 * os[r] + g2 * (ow[r] / L[r])); }
        WSYNC();
    }
}
__device__ __forceinline__ void phase_merge(Frame& F) {
    KA;
    const bf16* P = (const bf16*)(KWS + WS_P); const bf16* PROJ = (const bf16*)(KWS + WS_PROJ); bf16* MG = (bf16*)(KWS + WS_MERGED);
    const size_t total = (size_t)T * D / 8;
    for (size_t it = (size_t)F.gw * 64 + F.lane; it < total; it += (size_t)F.NGW * 64) {
        const size_t t = it / (D / 8); const int d = (int)(it % (D / 8)) * 8;
        float acc[8];
#pragma unroll
        for (int k = 0; k < 8; ++k) acc[k] = 0.f;
#pragma unroll
        for (int n = 0; n < 3; ++n) { const u32x4 gq = *(const u32x4*)(P + t * NPAD + C_MG + n * D + d); const u32x4 pq = *(const u32x4*)(PROJ + ((size_t)n * T + t) * D + d);
            acc[0] += sigmoidf_(bflo(gq.x)) * bflo(pq.x); acc[1] += sigmoidf_(bfhi(gq.x)) * bfhi(pq.x); acc[2] += sigmoidf_(bflo(gq.y)) * bflo(pq.y); acc[3] += sigmoidf_(bfhi(gq.y)) * bfhi(pq.y);
            acc[4] += sigmoidf_(bflo(gq.z)) * bflo(pq.z); acc[5] += sigmoidf_(bfhi(gq.z)) * bfhi(pq.z); acc[6] += sigmoidf_(bflo(gq.w)) * bflo(pq.w); acc[7] += sigmoidf_(bfhi(gq.w)) * bfhi(pq.w); }
        u32x4 o; o.x = pk2(acc[0], acc[1]); o.y = pk2(acc[2], acc[3]); o.z = pk2(acc[4], acc[5]); o.w = pk2(acc[6], acc[7]);
        *(u32x4*)(MG + t * D + d) = o;
    }
}
__device__ __forceinline__ void phase_router(Frame& F, int l) {
    KA;
    const float* X1 = (const float*)(KWS + WS_X1); bf16* H = (bf16*)(KWS + WS_H);
    int* EID = (int*)(KWS + WS_ROUTE); float* EW = (float*)(KWS + WS_ROUTE + 65536);
    const float* gain = KIN(I_NFFN) + (size_t)l * D; const float* wg = KIN(I_WGRP) + (size_t)l * D * 4; const float* we = KIN(I_WEXP) + (size_t)l * D * 32;
    const float* bg = KIN(I_BGRP) + l * 4; const float* be = KIN(I_BEXP) + l * 32;
    for (int t = F.gw; t < T; t += F.NGW) {
        const float* xrow = X1 + (size_t)t * D;
        float ss = 0.f;
#pragma unroll 4
        for (int k = 0; k < 32; ++k) { const float x = xrow[F.lane + 64 * k]; ss += x * x; }
        const float rstd = 1.0f / sqrtf(wave_sum(ss) * (1.0f / D) + EPS);
        float ag[4] = {0.f, 0.f, 0.f, 0.f}, ae[32];
#pragma unroll
        for (int e = 0; e < 32; ++e) ae[e] = 0.f;
#pragma unroll 1
        for (int k = 0; k < 32; ++k) { const int d = F.lane + 64 * k;
            const float hv = xrow[d] * rstd * gain[d];
            H[(size_t)t * D + d] = (bf16)f2bf(hv);
            const f32x4 w4 = *(const f32x4*)(wg + (size_t)d * 4);
            ag[0] += hv * w4.x; ag[1] += hv * w4.y; ag[2] += hv * w4.z; ag[3] += hv * w4.w;
#pragma unroll
            for (int c = 0; c < 8; ++c) { const f32x4 w = *(const f32x4*)(we + (size_t)d * 32 + c * 4); ae[c * 4] += hv * w.x; ae[c * 4 + 1] += hv * w.y; ae[c * 4 + 2] += hv * w.z; ae[c * 4 + 3] += hv * w.w; } }
#pragma unroll
        for (int e = 0; e < 4; ++e) ag[e] = wave_sum(ag[e]) + bg[e];
#pragma unroll
        for (int e = 0; e < 32; ++e) ae[e] = wave_sum(ae[e]) + be[e];
        int gi = 0; float gm = ag[0];
#pragma unroll
        for (int e = 1; e < 4; ++e) if (ag[e] > gm) { gm = ag[e]; gi = e; }
        float gs = 0.f;
#pragma unroll
        for (int e = 0; e < 4; ++e) gs += expf(ag[e] - gm);
        const float gw_ = 1.0f / gs;
        float el[8];
#pragma unroll
        for (int e = 0; e < 8; ++e) { el[e] = gi == 0 ? ae[e] : (gi == 1 ? ae[8 + e] : (gi == 2 ? ae[16 + e] : ae[24 + e])); }
        int i1 = 0; float m1 = el[0];
#pragma unroll
        for (int e = 1; e < 8; ++e) if (el[e] > m1) { m1 = el[e]; i1 = e; }
        int i2 = -1; float m2 = -3.0e38f;
#pragma unroll
        for (int e = 0; e < 8; ++e) if (e != i1 && el[e] > m2) { m2 = el[e]; i2 = e; }
        const float p2 = expf(m2 - m1);
        const float w1 = 1.0f / (1.0f + p2), w2 = p2 / (1.0f + p2);
        if (F.lane == 0) { EID[2 * t] = gi * 8 + i1; EID[2 * t + 1] = gi * 8 + i2; EW[2 * t] = gw_ * w1; EW[2 * t + 1] = gw_ * w2; }
    }
}
__device__ __forceinline__ void phase_lists(Frame& F) {
    KA;
    const int e = F.bid;
    if (e >= NE) return;
    const int* EID = (const int*)(KWS + WS_ROUTE); int* CNT = (int*)(KWS + WS_ROUTE + 131072); int* LIST = (int*)(KWS + WS_ROUTE + 262144);
    LAS int* wc = (LAS int*)F.lds;
    int run = 0;
    for (int base = 0; base < 2 * T; base += 512) {
        const int idx = base + F.tid; const bool match = EID[idx] == e;
        const unsigned long long b = __ballot(match);
        if (F.lane == 0) wc[F.wave] = __popcll(b);
        __syncthreads();
        int pre = 0, tot = 0;
#pragma unroll
        for (int w = 0; w < 8; ++w) { const int c = wc[w]; pre += w < F.wave ? c : 0; tot += c; }
        if (match) LIST[e * 8192 + run + pre + __popcll(b & ((1ull << F.lane) - 1ull))] = idx;
        run += tot;
        __syncthreads();
    }
    if (F.tid == 0) CNT[e] = run;
}
__device__ __forceinline__ void moe_table(Frame& F, LAS int* tb) {
    KA;
    const int* CNT = (const int*)(KWS + WS_ROUTE + 131072);
    if (F.tid == 0) { int a = 0; for (int e = 0; e < NE; ++e) { tb[e] = a; a += (CNT[e] + 255) / 256; } tb[NE] = a; }
    __syncthreads();
}

constexpr int PH_PER_LAYER = 11, N_PHASES = 1 + NL * PH_PER_LAYER + 1;

__global__ void __launch_bounds__(512, 2) mk_fwd(Args args) {
    extern __shared__ __attribute__((aligned(16))) unsigned char lds_raw[];
#define FRAME Frame F; F.lds = (LAS unsigned char*)lds_raw; F.MISC = (volatile LAS unsigned*)(F.lds + MISC_OFF); F.tid = ltid(); F.lane = F.tid & 63; F.wave = __builtin_amdgcn_readfirstlane(F.tid >> 6); \
    F.G = gridDim.x; F.bid = lbid(); F.vcu = (F.G % 8 == 0) ? (F.bid % 8) * (F.G / 8) + F.bid / 8 : F.bid; F.gw = F.bid * 8 + F.wave; F.NGW = F.G * 8;
    unsigned* const ctl = (unsigned*)((unsigned char*)args.ws + WS_CTL);
    for (int u = threadIdx.x; u < (LDS_BYTES - MISC_OFF) / 4; u += 512) ((LAS unsigned*)(lds_raw + MISC_OFF))[u] = 0u;
    __syncthreads();
    const int lo = args.ph_lo, hi = args.ph_hi;
    XcdBarrier bar; bar.bar = ctl + CW_BAR + args.li * XCD_BAR_WORDS; bar.x = 0; bar.st = nullptr;
    if (hi - lo > 1) bar = xcd_barrier_post(ctl + CW_BAR + args.li * XCD_BAR_WORDS, (volatile LAS unsigned*)((LAS unsigned char*)lds_raw + MISC_OFF));
    int ph = 0;
#define RUN(k) ((k) >= lo && (k) < hi)
#define SEAM(k) do { if ((k) + 1 < hi) xcd_barrier(bar); } while (0)
    LAS int* const tb = (LAS int*)((LAS unsigned char*)lds_raw + MISC_OFF + 64);

    if (RUN(ph)) { KA; FRAME; phase_prologue(F); phase_norm1<0>(F, KIN(I_X), nullptr, nullptr, KIN(I_NMIX), (bf16*)(KWS + WS_H)); SEAM(ph); }
    ++ph;
    for (int l = 0; l < NL; ++l) {
        if (RUN(ph)) { KA; FRAME; pg8::PlainSched S; S.init((const bf16*)(KWS + WS_H), D, (const bf16*)(KWS + WS_WIN) + (size_t)l * NPAD * D, T, NPAD, D, F.G, F.bid);
            pg8::EpiBf16 E{(bf16*)(KWS + WS_P), NPAD};
            pg8::gemm_phase<pg8::EpiBf16, pg8::PlainSched, true>(F.lds, D, S, E); SEAM(ph); }
        ++ph;
        if (RUN(ph)) { KA; FRAME; phase_prep(F, l); SEAM(ph); }
        ++ph;
        if (RUN(ph)) { KA; FRAME; phase_compress(F, l); phase_recur(F, l); SEAM(ph); }
        ++ph;
        if (RUN(ph)) { KA; FRAME; phase_nsa(F, l); phase_recur_out(F, l); SEAM(ph); }
        ++ph;
        if (RUN(ph)) { KA; FRAME;
            for (int n = 0; n < 3; ++n) { pg8::PlainSched S; S.init((const bf16*)(KWS + WS_OCAT) + n * 512, 1536, (const bf16*)(KWS + WS_WBR) + ((size_t)l * 3 + n) * D * 512, T, D, 512, F.G, F.bid);
                pg8::EpiBf16 E{(bf16*)(KWS + WS_PROJ) + (size_t)n * T * D, D};
                pg8::gemm_phase<pg8::EpiBf16, pg8::PlainSched, true>(F.lds, 512, S, E); __syncthreads(); }
            SEAM(ph); }
        ++ph;
        if (RUN(ph)) { KA; FRAME; phase_merge(F); SEAM(ph); }
        ++ph;
        if (RUN(ph)) { KA; FRAME; pg8::PlainSched S; S.init((const bf16*)(KWS + WS_MERGED), D, (const bf16*)(KWS + WS_WOUT) + (size_t)l * D * D, T, D, D, F.G, F.bid);
            pg8::EpiResF32 E{l == 0 ? KIN(I_X) : (const float*)(KWS + WS_XRES), (float*)(KWS + WS_X1), D};
            pg8::gemm_phase<pg8::EpiResF32, pg8::PlainSched, false>(F.lds, D, S, E); SEAM(ph); }
        ++ph;
        if (RUN(ph)) { KA; FRAME; phase_router(F, l); SEAM(ph); }
        ++ph;
        if (RUN(ph)) { KA; FRAME; phase_lists(F); SEAM(ph); }
        ++ph;
        if (RUN(ph)) { KA; FRAME; moe_table(F, tb);
            pg8::MoeSched<1> S; S.init(F.G, F.bid, tb, (const int*)(KWS + WS_ROUTE + 131072), (const int*)(KWS + WS_ROUTE + 262144), KWS + WS_H, (const bf16*)(KWS + WS_WGU) + (size_t)l * NE * 1024 * D);
            pg8::EpiMoe1 E{(bf16*)(KWS + WS_ACT), (const int*)(KWS + WS_ROUTE + 262144), (const float*)(KWS + WS_ROUTE + 65536)};
            pg8::gemm_phase<pg8::EpiMoe1, pg8::MoeSched<1>, true>(F.lds, D, S, E); SEAM(ph); }
        ++ph;
        if (RUN(ph)) { KA; FRAME; moe_table(F, tb);
            pg8::MoeSched<2> S; S.init(F.G, F.bid, tb, (const int*)(KWS + WS_ROUTE + 131072), (const int*)(KWS + WS_ROUTE + 262144), KWS + WS_ACT, (const bf16*)(KWS + WS_WDN) + (size_t)l * NE * D * FF);
            pg8::EpiMoe2 E{(bf16*)(KWS + WS_CONTRIB), (const int*)(KWS + WS_ROUTE + 262144)};
            pg8::gemm_phase<pg8::EpiMoe2, pg8::MoeSched<2>, true>(F.lds, FF, S, E); SEAM(ph); }
        ++ph;
        if (l + 1 < NL) { if (RUN(ph)) { KA; FRAME; phase_norm1<1>(F, (const float*)(KWS + WS_X1), (const bf16*)(KWS + WS_CONTRIB), (float*)(KWS + WS_XRES), KIN(I_NMIX) + (size_t)(l + 1) * D, (bf16*)(KWS + WS_H)); SEAM(ph); } ++ph; }
    }
    if (RUN(ph)) { KA; FRAME; phase_norm1<2>(F, (const float*)(KWS + WS_X1), (const bf16*)(KWS + WS_CONTRIB), KOUT, nullptr, nullptr); }
#undef RUN
#undef SEAM
}

#ifndef MK_PER_PHASE
#define MK_PER_PHASE 0
#endif
extern "C" void kernel_launch(void* const* d_in, const int* in_sizes, int n_in, void* d_out, int out_size, void* d_ws, size_t ws_size, hipStream_t stream) {
    static int grid = 0;
    if (grid == 0) {
        if (n_in != 22 || out_size != T * D || ws_size < WS_END) { fprintf(stderr, "kernel_launch: unexpected sizes (n_in %d out %d ws %zu)\n", n_in, out_size, ws_size); grid = -1; return; }
        int dev = 0, cus = 0, per_cu = 0;
        if (hipGetDevice(&dev) != hipSuccess || hipDeviceGetAttribute(&cus, hipDeviceAttributeMultiprocessorCount, dev) != hipSuccess) { grid = -1; return; }
        if (hipFuncSetAttribute((const void*)mk_fwd, hipFuncAttributeMaxDynamicSharedMemorySize, LDS_BYTES) != hipSuccess) { fprintf(stderr, "kernel_launch: hipFuncSetAttribute failed\n"); grid = -1; return; }
        if (hipOccupancyMaxActiveBlocksPerMultiprocessor(&per_cu, (const void*)mk_fwd, 512, LDS_BYTES) != hipSuccess || per_cu < 1) { fprintf(stderr, "kernel_launch: occupancy query says %d\n", per_cu); }
        (void)hipGetLastError();
        grid = cus;
    }
    if (grid < 0) return;
    if (hipMemsetAsync((char*)d_ws + WS_CTL, 0, CTL_ZERO_BYTES, stream) != hipSuccess) return;
    Args a{};
    for (int i = 0; i < 22; ++i) a.in[i] = (const GAS float*)d_in[i];
    a.out = (GAS float*)d_out; a.ws = (GAS unsigned char*)d_ws;
#if MK_PER_PHASE
    const int total = 1 + NL * PH_PER_LAYER + (NL - 1) + 1;
    for (int k = 0; k < total; ++k) { a.ph_lo = k; a.ph_hi = k + 1; a.li = 0; hipLaunchKernelGGL(mk_fwd, dim3(grid), dim3(512), LDS_BYTES, stream, a); }
#else
    a.ph_lo = 0; a.ph_hi = 1000; a.li = 0;
    hipLaunchKernelGGL(mk_fwd, dim3(grid), dim3(512), LDS_BYTES, stream, a);
#endif
    const hipError_t le = hipPeekAtLastError();
    if (le != hipSuccess) fprintf(stderr, "kernel_launch: launch failed: %s\n", hipGetErrorName(le));
}
```

```cpp
#include <hip/hip_runtime.h>
#include <cstdio>
#include <cstdint>

#define GAS __attribute__((address_space(1)))
#define LAS __attribute__((address_space(3)))
typedef unsigned short bf16;
typedef short bf16x8 __attribute__((ext_vector_type(8)));
typedef float f32x4 __attribute__((ext_vector_type(4)));
typedef float f32x2 __attribute__((ext_vector_type(2)));
typedef unsigned u32x4 __attribute__((ext_vector_type(4)));
typedef unsigned u32x2 __attribute__((ext_vector_type(2)));

constexpr int T = 8192, D = 2048, NL = 2, INC = 11048, NPAD = 11264;
constexpr int NE = 32, FF = 512, NCH = T / 64;
constexpr float EPS = 1e-6f, NEGB = -1e30f;
constexpr int C_Q = 0, C_KC = 512, C_VC = 640, C_KS = 768, C_VS = 896, C_KW = 1024, C_VW = 1152;
constexpr int C_HQ = 1280, C_HF = 1792, C_HI = 2304, C_HG = 2816, C_GQ = 3328, C_GK = 3584, C_GV = 3840, C_GR = 4352;
constexpr int C_MG = 4864, C_NG = 11008, C_GA = 11032;

constexpr size_t MiB = 1u << 20;
constexpr size_t WS_CTL = 0, CTL_ZERO_BYTES = 1 * MiB;
constexpr size_t WS_WIN = 2 * MiB;
constexpr size_t WS_WBR = 90 * MiB;
constexpr size_t WS_WOUT = 102 * MiB;
constexpr size_t WS_WGU = 118 * MiB;
constexpr size_t WS_WDN = 374 * MiB;
constexpr size_t WS_H = 502 * MiB;
constexpr size_t WS_P = 534 * MiB;
constexpr size_t WS_OCAT = 710 * MiB;
constexpr size_t WS_PROJ = 734 * MiB;
constexpr size_t WS_MERGED = 830 * MiB;
constexpr size_t WS_X1 = 862 * MiB;
constexpr size_t WS_XRES = 926 * MiB;
constexpr size_t WS_CONTRIB = 990 * MiB;
constexpr size_t WS_ACT = 1054 * MiB;
constexpr size_t WS_QN = 1078 * MiB;
constexpr size_t WS_KV = 1094 * MiB;
constexpr size_t WS_KC = 1118 * MiB;
constexpr size_t WS_ORAW = 1119 * MiB;
constexpr size_t WS_ROUTE = 1151 * MiB;
constexpr size_t WS_SLOC_HG = 1153 * MiB;
constexpr size_t WS_SLOC_GL = 1185 * MiB;
constexpr size_t WS_SPREV_HG = 1201 * MiB;
constexpr size_t WS_SPREV_GL = 1217 * MiB;
constexpr size_t WS_DEC = 1225 * MiB;
constexpr size_t WS_QS = 1226 * MiB;
constexpr size_t WS_KS2 = 1234 * MiB;
constexpr size_t WS_KW2 = 1236 * MiB;
constexpr size_t WS_VST = 1238 * MiB;
constexpr size_t WS_VWT = 1240 * MiB;
constexpr size_t WS_KCB = 1242 * MiB;
constexpr size_t WS_END = 1243 * MiB;
constexpr size_t KV_STRIDE = (size_t)2 * T * 64;
constexpr int CW_BAR = 4096;

constexpr int RING_BYTES = 131072;
constexpr int MISC_OFF = RING_BYTES;
constexpr int LDS_BYTES = 147456;

#define LDS_WAIT() asm volatile("s_waitcnt lgkmcnt(0)" ::: "memory")
#define VM_WAIT() asm volatile("s_waitcnt vmcnt(0)" ::: "memory")
#define WSYNC() asm volatile("s_waitcnt lgkmcnt(0)" ::: "memory")

__device__ __forceinline__ unsigned f2bf(float f) { unsigned u = __builtin_bit_cast(unsigned, f); return (u + 0x7fffu + ((u >> 16) & 1u)) >> 16; }
__device__ __forceinline__ unsigned pk2(float lo, float hi) { return f2bf(lo) | (f2bf(hi) << 16); }
__device__ __forceinline__ float bf2f(unsigned b) { return __builtin_bit_cast(float, (b & 0xffffu) << 16); }
__device__ __forceinline__ float bflo(unsigned w) { return __builtin_bit_cast(float, w << 16); }
__device__ __forceinline__ float bfhi(unsigned w) { return __builtin_bit_cast(float, w & 0xffff0000u); }
__device__ __forceinline__ float wave_sum(float v) {
#pragma unroll
    for (int o = 1; o < 64; o <<= 1) v += __shfl_xor(v, o);
    return v;
}
__device__ __forceinline__ float wave_max(float v) {
#pragma unroll
    for (int o = 1; o < 64; o <<= 1) v = fmaxf(v, __shfl_xor(v, o));
    return v;
}
__device__ __forceinline__ int ltid() { int t = threadIdx.x; asm volatile("" : "+v"(t)); return t; }
__device__ __forceinline__ int lbid() { int b = blockIdx.x; asm volatile("" : "+s"(b)); return b; }
__device__ __forceinline__ float sigmoidf_(float x) { return 1.0f / (1.0f + expf(-x)); }

#define XB_TMO      128
#define XB_XCNT(j)  (256  + 64 * (j))
#define XB_XSUB(j)  (1280 + 64 * (j))
#define XB_XGEN(j)  (2304 + 64 * (j))
#define XB_TOP      3328
#define XB_TOPGEN   3392
#define XCD_BAR_WORDS 3456
#define XB_SPIN_CAP (1u << 25)

__device__ __forceinline__ unsigned xb_ld(unsigned* p)              { return __hip_atomic_load(p, __ATOMIC_RELAXED, __HIP_MEMORY_SCOPE_AGENT); }
__device__ __forceinline__ unsigned xb_add(unsigned* p, unsigned v) { return __hip_atomic_fetch_add(p, v, __ATOMIC_RELAXED, __HIP_MEMORY_SCOPE_AGENT); }
__device__ __forceinline__ unsigned xb_xcc_id() { return (unsigned)__builtin_amdgcn_s_getreg((3 << 11) | 20) & 0xFu; }
#define XB_SPIN(cond, bar) do { unsigned _sp = 0; while (cond) { __builtin_amdgcn_s_sleep(1); \
    if ((++_sp & 255u) == 0u) { if (xb_ld(&(bar)[XB_TMO])) break; if (_sp > XB_SPIN_CAP) { atomicAdd(&(bar)[XB_TMO], 1u); break; } } } } while (0)

struct XcdBarrier { unsigned* bar; unsigned x; volatile LAS unsigned* st; };

__device__ __forceinline__ XcdBarrier xcd_barrier_post(unsigned* bar, volatile LAS unsigned* st) {
    XcdBarrier b; b.bar = bar; b.x = xb_xcc_id(); b.st = st;
    if (threadIdx.x == 0) (void)xb_add(&bar[XB_XCNT(b.x)], 1u);
    return b;
}
__device__ __forceinline__ void xcd_barrier_complete(unsigned* bar, unsigned x, unsigned& nloc, unsigned& nx) {
    const unsigned G = gridDim.x * gridDim.y * gridDim.z;
    unsigned sum, cnt, mine, sp = 0u;
    for (;;) {
        sum = 0u; cnt = 0u; mine = 0u;
#pragma unroll
        for (unsigned j = 0; j < 16; ++j) { const unsigned c = xb_ld(&bar[XB_XCNT(j)]); sum += c; cnt += (c > 0u) ? 1u : 0u; mine = (j == x) ? c : mine; }
        if (sum == G) break;
        __builtin_amdgcn_s_sleep(1);
        if ((++sp & 255u) == 0u) { if (xb_ld(&bar[XB_TMO])) break; if (sp > XB_SPIN_CAP) { atomicAdd(&bar[XB_TMO], 1u); break; } }
    }
    nloc = mine > 0u ? mine : 1u; nx = cnt > 0u ? cnt : 1u;
}
__device__ __forceinline__ void xcd_barrier(const XcdBarrier& b) {
    asm volatile("s_waitcnt vmcnt(0)" ::: "memory");
    __syncthreads();
    if (threadIdx.x == 0) {
        unsigned* bar = b.bar;
        __builtin_amdgcn_s_waitcnt(0);
        unsigned nloc = b.st[0], nx = b.st[1];
        if (nloc == 0u) { xcd_barrier_complete(bar, b.x, nloc, nx); b.st[0] = nloc; b.st[1] = nx; }
        const unsigned old = xb_add(&bar[XB_XSUB(b.x)], 1u);
        const unsigned gen = old / nloc;
        if (old + 1u == (gen + 1u) * nloc) {
            __builtin_amdgcn_fence(__ATOMIC_RELEASE, "agent");
            asm volatile("s_waitcnt vmcnt(0)" ::: "memory");
            const unsigned og = xb_add(&bar[XB_TOP], 1u);
            const unsigned tg = og / nx;
            if (og + 1u == (tg + 1u) * nx) xb_add(&bar[XB_TOPGEN], 1u);
            else XB_SPIN(xb_ld(&bar[XB_TOPGEN]) == tg, bar);
            __builtin_amdgcn_fence(__ATOMIC_ACQUIRE, "agent");
            xb_add(&bar[XB_XGEN(b.x)], 1u);
            asm volatile("s_waitcnt vmcnt(0)" ::: "memory");
        } else {
            XB_SPIN(xb_ld(&bar[XB_XGEN(b.x)]) == gen, bar);
            __builtin_amdgcn_fence(__ATOMIC_ACQUIRE, "agent");
            asm volatile("s_waitcnt vmcnt(0)" ::: "memory");
        }
    }
    __syncthreads();
}

namespace pg8 {
constexpr int BM = 256, BK = 64, HALF = 128, HTB = HALF * BK * 2, STAGE_BYTES = 8 * HTB, NXCD = 8, WGM = 8;
__host__ __device__ __forceinline__ int lds_byte(int r, int c) { const int st = (r >> 4) * 2 + (c >> 5), rr = r & 15, cc = c & 31, ob = rr * 64 + cc * 2; return st * 1024 + (ob ^ (((ob >> 9) & 1) << 5)); }
__host__ __device__ __forceinline__ void stage_rc(int b, int& R, int& C) { const int st = b / 1024, sb = b % 1024, swz = sb ^ (((sb >> 9) & 1) << 5); R = (st >> 1) * 16 + swz / 64; C = (st & 1) * 32 + (swz % 64) / 2; }
__host__ __device__ __forceinline__ int perm32(int rho) { const int n = rho >> 4, i = rho & 15; return 8 * (i >> 2) + 4 * n + (i & 3); }

struct Unit { int pm, pn, e, nvalid, slot0; const char *A0, *A1, *B0, *B1; unsigned va[2][2]; };

__device__ __forceinline__ unsigned cvt_pk_bf16(float lo, float hi) { unsigned r; asm volatile("v_cvt_pk_bf16_f32 %0, %1, %2" : "=v"(r) : "v"(lo), "v"(hi)); return r; }

template <class Epi, class Sched, bool ALIGN_EPI>
__device__ __forceinline__ void gemm_phase(LAS unsigned char* lds, const int K, const Sched& S, const Epi& E) {
    const int tid = ltid(), wid = __builtin_amdgcn_readfirstlane(tid >> 6), lane = tid & 63, wr = wid >> 2, wc = wid & 3, fr = lane & 15, fq = lane >> 4;
    const int nt = K / BK;
    unsigned voffB[2];
#pragma unroll
    for (int i = 0; i < 2; ++i) { int R, C; stage_rc(tid * 16 + i * 8192, R, C); const int Rb = Epi::PERM ? ((R & ~31) + perm32(R & 31)) : R; voffB[i] = (unsigned)(Rb * K + C) * 2u; }
    const size_t kstep = (size_t)(BK * 2);
    const unsigned ldsw = (unsigned)wid * 1024u;
    const int aoff = lds_byte(wr * 64 + fr, fq * 8), boff = lds_byte(wc * 32 + fr, fq * 8);
#define PG8_SA(b, h) (((b) * 2 + (h)) * HTB)
#define PG8_SB(b, h) ((4 + (b) * 2 + (h)) * HTB)
#define PG8_STAGE(bufoff, gbase, voff) do { _Pragma("unroll") for (int _i = 0; _i < 2; ++_i) \
        __builtin_amdgcn_global_load_lds((const unsigned*)((const char*)(gbase) + (voff)[_i]), (LAS unsigned*)(lds + (bufoff) + ldsw + _i * 8192), 16, 0, 0); } while (0)
#define PG8_LDA(dst, b, h) do { _Pragma("unroll") for (int m = 0; m < 4; ++m) _Pragma("unroll") for (int k = 0; k < 2; ++k) dst[m][k] = *(const LAS bf16x8*)(lds + PG8_SA(b, h) + aoff + m * 2048 + k * 1024); } while (0)
#define PG8_LDB(dst, b, h) do { _Pragma("unroll") for (int n = 0; n < 2; ++n) _Pragma("unroll") for (int k = 0; k < 2; ++k) dst[n][k] = *(const LAS bf16x8*)(lds + PG8_SB(b, h) + boff + n * 2048 + k * 1024); } while (0)
#define PG8_MMA(ai, bj, At, Bt) do { __builtin_amdgcn_s_setprio(1); _Pragma("unroll") for (int m = 0; m < 4; ++m) _Pragma("unroll") for (int n = 0; n < 2; ++n) _Pragma("unroll") for (int k = 0; k < 2; ++k) \
        acc[ai][bj][m][n] = __builtin_amdgcn_mfma_f32_16x16x32_bf16(Bt[n][k], At[m][k], acc[ai][bj][m][n], 0, 0, 0); __builtin_amdgcn_s_setprio(0); } while (0)
#define PG8_WAIT_V(n) asm volatile("s_waitcnt vmcnt(" #n ")" ::: "memory")
#define PG8_WAIT_L(n) asm volatile("s_waitcnt lgkmcnt(" #n ")" ::: "memory")
#define PG8_BAR __builtin_amdgcn_s_barrier()
#define PG8_SCHED __builtin_amdgcn_sched_barrier(0)
#define VA(u, h) (Sched::GATHER ? (u).va[h] : S.va)
    Unit cur, nxt; int ui = 0;
    if (!S.next(0, cur)) return;
    f32x4 acc[2][2][4][2];
#pragma unroll
    for (int a = 0; a < 2; ++a)
#pragma unroll
        for (int b = 0; b < 2; ++b)
#pragma unroll
            for (int m = 0; m < 4; ++m)
#pragma unroll
                for (int n = 0; n < 2; ++n) acc[a][b][m][n] = (f32x4){0.f, 0.f, 0.f, 0.f};
    bf16x8 At[4][2], B0[2][2], B1[2][2];
    PG8_STAGE(PG8_SB(0, 0), cur.B0, voffB); PG8_STAGE(PG8_SB(0, 1), cur.B1, voffB); PG8_STAGE(PG8_SA(0, 0), cur.A0, VA(cur, 0)); PG8_STAGE(PG8_SA(0, 1), cur.A1, VA(cur, 1));
    if (wr == 1) PG8_BAR;
    PG8_WAIT_V(2); PG8_BAR;
    PG8_STAGE(PG8_SB(1, 0), cur.B0 + kstep, voffB); PG8_STAGE(PG8_SA(1, 0), cur.A0 + kstep, VA(cur, 0)); PG8_STAGE(PG8_SB(1, 1), cur.B1 + kstep, voffB);
    PG8_WAIT_V(6); PG8_BAR;
    for (;;) {
        const bool has_next = S.next(ui + 1, nxt);
        if (!has_next) nxt = cur;
        for (int t = 0; t < nt; t += 2) {
            const bool last = (t == nt - 2);
            const char* a1h1 = cur.A1 + (size_t)(t + 1) * kstep;
            const char* a2h0 = last ? nxt.A0 : cur.A0 + (size_t)(t + 2) * kstep; const char* a2h1 = last ? nxt.A1 : cur.A1 + (size_t)(t + 2) * kstep;
            const char* b2h0 = last ? nxt.B0 : cur.B0 + (size_t)(t + 2) * kstep; const char* b2h1 = last ? nxt.B1 : cur.B1 + (size_t)(t + 2) * kstep;
            unsigned v2h0[2], v2h1[2];
#pragma unroll
            for (int i = 0; i < 2; ++i) { if constexpr (Sched::GATHER) { v2h0[i] = last ? nxt.va[0][i] : cur.va[0][i]; v2h1[i] = last ? nxt.va[1][i] : cur.va[1][i]; } else { v2h0[i] = S.va[i]; v2h1[i] = S.va[i]; } }
            PG8_LDB(B0, 0, 0); PG8_LDB(B1, 0, 1); PG8_SCHED; PG8_LDA(At, 0, 0); PG8_STAGE(PG8_SA(1, 1), a1h1, VA(cur, 1));
            PG8_WAIT_V(8); PG8_WAIT_L(0); PG8_BAR; PG8_MMA(0, 0, At, B0); PG8_MMA(0, 1, At, B1); PG8_BAR; PG8_SCHED;
            PG8_LDA(At, 0, 1); PG8_STAGE(PG8_SB(0, 0), b2h0, voffB); PG8_STAGE(PG8_SB(0, 1), b2h1, voffB); PG8_STAGE(PG8_SA(0, 0), a2h0, v2h0);
            PG8_WAIT_V(8); PG8_WAIT_L(0); PG8_BAR; PG8_MMA(1, 0, At, B0); PG8_MMA(1, 1, At, B1); PG8_BAR; PG8_SCHED;
            PG8_LDB(B0, 1, 0); PG8_LDB(B1, 1, 1); PG8_SCHED; PG8_LDA(At, 1, 0); PG8_STAGE(PG8_SA(0, 1), a2h1, v2h1);
            PG8_WAIT_V(8); PG8_WAIT_L(0); PG8_BAR; PG8_MMA(0, 0, At, B0); PG8_MMA(0, 1, At, B1); PG8_BAR; PG8_SCHED;
            PG8_LDA(At, 1, 1); PG8_STAGE(PG8_SB(1, 0), b2h0 + kstep, voffB); PG8_STAGE(PG8_SB(1, 1), b2h1 + kstep, voffB); PG8_STAGE(PG8_SA(1, 0), a2h0 + kstep, v2h0);
            PG8_WAIT_V(8); PG8_WAIT_L(0); PG8_BAR; PG8_MMA(1, 0, At, B0); PG8_MMA(1, 1, At, B1); PG8_BAR; PG8_SCHED;
        }
        if constexpr (ALIGN_EPI) { if (wr == 0) PG8_BAR; }
        E(acc, cur, wr, wc, fr, fq);
        if (!has_next) break;
#pragma unroll
        for (int a = 0; a < 2; ++a)
#pragma unroll
            for (int b = 0; b < 2; ++b)
#pragma unroll
                for (int m = 0; m < 4; ++m)
#pragma unroll
                    for (int n = 0; n < 2; ++n) acc[a][b][m][n] = (f32x4){0.f, 0.f, 0.f, 0.f};
        cur = nxt; ++ui;
        if constexpr (ALIGN_EPI) { if (wr == 1) PG8_BAR; }
    }
    PG8_WAIT_V(0);
    if constexpr (!ALIGN_EPI) { if (wr == 0) PG8_BAR; }
    PG8_BAR;
#undef VA
#undef PG8_SA
#undef PG8_SB
#undef PG8_STAGE
#undef PG8_LDA
#undef PG8_LDB
#undef PG8_MMA
#undef PG8_WAIT_V
#undef PG8_WAIT_L
#undef PG8_BAR
#undef PG8_SCHED
}

struct PlainSched {
    static constexpr bool GATHER = false;
    int nM, nN, nwg, G, c, lda, K; const char* A; const char* Bt; unsigned va[2];
    __device__ __forceinline__ void init(const bf16* A_, int lda_, const bf16* Bt_, int M, int N, int K_, int G_, int c_) {
        nM = M / BM; nN = N / BM; nwg = nM * nN; G = G_; c = c_; lda = lda_; K = K_; A = (const char*)A_; Bt = (const char*)Bt_;
#pragma unroll
        for (int i = 0; i < 2; ++i) { int R, C; stage_rc((int)ltid() * 16 + i * 8192, R, C); va[i] = (unsigned)(R * lda + C) * 2u; }
    }
    __device__ __forceinline__ bool next(int i, Unit& u) const {
        const long L = (long)i * G + c; if (L >= nwg) return false;
        int wgid = (int)L; { const int q = nwg / NXCD, r = nwg % NXCD, xcd = wgid % NXCD, off = wgid / NXCD; wgid = (xcd < r ? xcd * (q + 1) : r * (q + 1) + (xcd - r) * q) + off; }
        const int nig = WGM * nN, gid = wgid / nig, fm = gid * WGM, gsz = (nM - fm) < WGM ? (nM - fm) : WGM;
        u.pm = fm + ((wgid % nig) % gsz); u.pn = (wgid % nig) / gsz; u.e = 0; u.nvalid = 256; u.slot0 = 0; u.va[0][0] = 0u; u.va[0][1] = 0u; u.va[1][0] = 0u; u.va[1][1] = 0u;
        u.A0 = A + (size_t)u.pm * BM * lda * 2; u.A1 = u.A0 + (size_t)HALF * lda * 2;
        u.B0 = Bt + (size_t)u.pn * BM * K * 2; u.B1 = u.B0 + (size_t)HALF * K * 2;
        return true;
    }
};
template <int MODE> struct MoeSched {
    static constexpr int NPN = MODE == 1 ? 4 : 8;
    static constexpr bool GATHER = MODE == 1;
    int G, c; const LAS int* tb; const int* cnt; const int* list; const char* A; const char* W; unsigned va[2];
    __device__ __forceinline__ void init(int G_, int c_, const LAS int* tb_, const int* cnt_, const int* list_, const void* A_, const void* W_) {
        G = G_; c = c_; tb = tb_; cnt = cnt_; list = list_; A = (const char*)A_; W = (const char*)W_;
#pragma unroll
        for (int i = 0; i < 2; ++i) { int R, C; stage_rc((int)ltid() * 16 + i * 8192, R, C); va[i] = (unsigned)(R * FF + C) * 2u; }
    }
    __device__ __forceinline__ bool next(int i, Unit& u) const {
        const int L = i * G + c, ntile = __builtin_amdgcn_readfirstlane(tb[NE]); if (L >= ntile * NPN) return false;
        const int tl = L / NPN, pn = L % NPN; int e = 0;
        while (e < NE - 1 && __builtin_amdgcn_readfirstlane(tb[e + 1]) <= tl) ++e;
        const int pm = tl - __builtin_amdgcn_readfirstlane(tb[e]), ne = __builtin_amdgcn_readfirstlane(cnt[e]);
        u.pm = pm; u.pn = pn; u.e = e; u.nvalid = ne - pm * 256; u.slot0 = tl * 256;
        if (MODE == 1) {
            u.A0 = A; u.A1 = A;
#pragma unroll
            for (int h = 0; h < 2; ++h)
#pragma unroll
                for (int k = 0; k < 2; ++k) { int Rk, Ck; stage_rc((int)ltid() * 16 + k * 8192, Rk, Ck); int idx = pm * 256 + h * 128 + Rk; idx = idx < ne ? idx : ne - 1; const int entry = list[e * 8192 + idx]; u.va[h][k] = (unsigned)(entry >> 1) * (unsigned)(D * 2) + (unsigned)Ck * 2u; }
            const char* we = W + (size_t)e * 1024 * D * 2;
            u.B0 = we + (size_t)(pn * 128) * D * 2; u.B1 = we + (size_t)(512 + pn * 128) * D * 2;
        } else {
            u.va[0][0] = 0u; u.va[0][1] = 0u; u.va[1][0] = 0u; u.va[1][1] = 0u;
            u.A0 = A + (size_t)tl * 256 * FF * 2; u.A1 = u.A0 + (size_t)HALF * FF * 2;
            const char* we = W + (size_t)e * D * FF * 2;
            u.B0 = we + (size_t)(pn * 256) * FF * 2; u.B1 = u.B0 + (size_t)HALF * FF * 2;
        }
        return true;
    }
};

struct EpiBf16 {
    static constexpr bool PERM = true;
    bf16* O; int ldc;
    __device__ __forceinline__ void operator()(const f32x4 (&acc)[2][2][4][2], const Unit& u, int wr, int wc, int fr, int fq) const {
        const int row0 = u.pm * BM + wr * 64 + fr, col0 = u.pn * BM + wc * 32 + 8 * fq;
#pragma unroll
        for (int ai = 0; ai < 2; ++ai)
#pragma unroll
            for (int m = 0; m < 4; ++m) { bf16* rowp = O + (size_t)(row0 + ai * HALF + m * 16) * ldc + col0;
#pragma unroll
                for (int bj = 0; bj < 2; ++bj) { const f32x4 v0 = acc[ai][bj][m][0], v1 = acc[ai][bj][m][1];
                    u32x4 w; w.x = cvt_pk_bf16(v0[0], v0[1]); w.y = cvt_pk_bf16(v0[2], v0[3]); w.z = cvt_pk_bf16(v1[0], v1[1]); w.w = cvt_pk_bf16(v1[2], v1[3]);
                    *(u32x4*)(rowp + bj * HALF) = w; } }
    }
};
struct EpiResF32 {
    static constexpr bool PERM = false;
    const float* R; float* O; int ldc;
    __device__ __forceinline__ void operator()(const f32x4 (&acc)[2][2][4][2], const Unit& u, int wr, int wc, int fr, int fq) const {
        const int row0 = u.pm * BM + wr * 64 + fr, col0 = u.pn * BM + wc * 32 + 4 * fq;
#pragma unroll
        for (int ai = 0; ai < 2; ++ai)
#pragma unroll
            for (int m = 0; m < 4; ++m) { const size_t off = (size_t)(row0 + ai * HALF + m * 16) * ldc + col0;
#pragma unroll
                for (int bj = 0; bj < 2; ++bj)
#pragma unroll
                    for (int n = 0; n < 2; ++n) { const f32x4 r = *(const f32x4*)(R + off + bj * HALF + n * 16); *(f32x4*)(O + off + bj * HALF + n * 16) = acc[ai][bj][m][n] + r; } }
    }
};
struct EpiMoe1 {
    static constexpr bool PERM = true;
    bf16* ACT; const int* list; const float* ew;
    __device__ __forceinline__ void operator()(const f32x4 (&acc)[2][2][4][2], const Unit& u, int wr, int wc, int fr, int fq) const {
        const int col0 = u.pn * 128 + wc * 32 + 8 * fq;
#pragma unroll
        for (int ai = 0; ai < 2; ++ai)
#pragma unroll
            for (int m = 0; m < 4; ++m) { const int r = ai * HALF + wr * 64 + m * 16 + fr; float w = 0.f;
                if (r < u.nvalid) { const int entry = list[u.e * 8192 + u.pm * 256 + r]; w = ew[entry]; }
                float o[8];
#pragma unroll
                for (int n = 0; n < 2; ++n)
#pragma unroll
                    for (int j = 0; j < 4; ++j) { const float g = acc[ai][0][m][n][j], up = acc[ai][1][m][n][j]; o[n * 4 + j] = g / (1.0f + __expf(-g)) * up * w; }
                u32x4 pk; pk.x = cvt_pk_bf16(o[0], o[1]); pk.y = cvt_pk_bf16(o[2], o[3]); pk.z = cvt_pk_bf16(o[4], o[5]); pk.w = cvt_pk_bf16(o[6], o[7]);
                *(u32x4*)(ACT + (size_t)(u.slot0 + r) * FF + col0) = pk; }
    }
};
struct EpiMoe2 {
    static constexpr bool PERM = true;
    bf16* CO; const int* list;
    __device__ __forceinline__ void operator()(const f32x4 (&acc)[2][2][4][2], const Unit& u, int wr, int wc, int fr, int fq) const {
        const int col0 = u.pn * BM + wc * 32 + 8 * fq;
#pragma unroll
        for (int ai = 0; ai < 2; ++ai)
#pragma unroll
            for (int m = 0; m < 4; ++m) { const int r = ai * HALF + wr * 64 + m * 16 + fr;
                if (r < u.nvalid) { const int entry = list[u.e * 8192 + u.pm * 256 + r]; bf16* rowp = CO + (size_t)entry * D + col0;
#pragma unroll
                    for (int bj = 0; bj < 2; ++bj) { const f32x4 v0 = acc[ai][bj][m][0], v1 = acc[ai][bj][m][1];
                        u32x4 w; w.x = cvt_pk_bf16(v0[0], v0[1]); w.y = cvt_pk_bf16(v0[2], v0[3]); w.z = cvt_pk_bf16(v1[0], v1[1]); w.w = cvt_pk_bf16(v1[2], v1[3]);
                        *(u32x4*)(rowp + bj * HALF) = w; } } }
    }
};
}

struct Frame {
    LAS unsigned char* lds; volatile LAS unsigned* MISC;
    int tid, lane, wave, vcu, G, gw, NGW, bid;
};
struct Args { const GAS float* in[22]; GAS float* out; GAS unsigned char* ws; int ph_lo, ph_hi, li, pad; };
typedef const __attribute__((address_space(4))) Args KArgs;
__device__ __forceinline__ KArgs* ka_fresh() { unsigned long long p = (unsigned long long)__builtin_amdgcn_kernarg_segment_ptr(); asm volatile("" : "+s"(p)); return (KArgs*)p; }
#define KA KArgs* const ka = ka_fresh()
#define KIN(i) ((const float*)ka->in[i])
#define KWS ((unsigned char*)ka->ws)
#define KOUT ((float*)ka->out)
enum { I_X = 0, I_NMIX, I_WIN, I_PE, I_W1, I_W2, I_QN, I_KN, I_LB, I_HGN, I_WA2, I_BA, I_GLAN, I_WBR, I_WOUT, I_NFFN, I_WGRP, I_BGRP, I_WEXP, I_BEXP, I_WGU, I_WDN };

__device__ __forceinline__ void tr_item(const float* W, size_t ldw, int c0, int nv, bf16* WT, size_t ldt, int r0, int k0, LAS float* scr, int lane) {
    const int nn = lane & 31;
#pragma unroll 8
    for (int i = 0; i < 32; ++i) { const int kk = 2 * i + (lane >> 5); scr[kk * 33 + nn] = nn < nv ? W[(size_t)(k0 + kk) * ldw + c0 + nn] : 0.f; }
    LDS_WAIT();
    const int c = lane & 7;
#pragma unroll
    for (int j = 0; j < 4; ++j) { const int n = (lane >> 3) + 8 * j; const LAS float* s = scr + (8 * c) * 33 + n;
        u32x4 o; o.x = pk2(s[0 * 33], s[1 * 33]); o.y = pk2(s[2 * 33], s[3 * 33]); o.z = pk2(s[4 * 33], s[5 * 33]); o.w = pk2(s[6 * 33], s[7 * 33]);
        if (n < nv) *(u32x4*)(WT + (size_t)(r0 + n) * ldt + k0 + 8 * c) = o; }
    LDS_WAIT();
}
__device__ __forceinline__ void phase_prologue(Frame& F) {
    KA;
    LAS float* scr = (LAS float*)(F.lds + F.wave * 16384);
    constexpr int IT_WIN = 32 * 346, IT_WBR = 3 * 8 * 64, IT_WOUT = 32 * 64, IT_WGU = 32 * 32 * 32, IT_WDN = 32 * 8 * 64, IT_L = IT_WIN + IT_WBR + IT_WOUT + IT_WGU + IT_WDN;
    for (int it = F.gw; it < NL * IT_L; it += F.NGW) {
        const int l = it / IT_L; int r = it % IT_L;
        if (r < IT_WIN) { const int kb = r / 346, nb = r % 346; int src, dst, nv = 32;
            if (nb < 40) { src = nb * 32; dst = nb * 32; }
            else if (nb == 40) { src = 1280; dst = C_NG; nv = 24; }
            else if (nb < 153) { src = 1304 + 32 * (nb - 41); dst = 1280 + 32 * (nb - 41); }
            else if (nb == 153) { src = 4888; dst = C_GA; nv = 16; }
            else { src = 4904 + 32 * (nb - 154); dst = C_MG + 32 * (nb - 154); }
            tr_item(KIN(I_WIN) + (size_t)l * D * INC, INC, src, nv, (bf16*)(KWS + WS_WIN) + (size_t)l * NPAD * D, D, dst, kb * 64, scr, F.lane); continue; }
        r -= IT_WIN;
        if (r < IT_WBR) { const int n = r / 512, q = r % 512, kb = q / 64, nb = q % 64;
            tr_item(KIN(I_WBR) + ((size_t)l * 3 + n) * 512 * D, D, nb * 32, 32, (bf16*)(KWS + WS_WBR) + ((size_t)l * 3 + n) * D * 512, 512, nb * 32, kb * 64, scr, F.lane); continue; }
        r -= IT_WBR;
        if (r < IT_WOUT) { const int kb = r / 64, nb = r % 64;
            tr_item(KIN(I_WOUT) + (size_t)l * D * D, D, nb * 32, 32, (bf16*)(KWS + WS_WOUT) + (size_t)l * D * D, D, nb * 32, kb * 64, scr, F.lane); continue; }
        r -= IT_WOUT;
        if (r < IT_WGU) { const int e = r / 1024, q = r % 1024, kb = q / 32, nb = q % 32;
            tr_item(KIN(I_WGU) + ((size_t)l * NE + e) * D * 1024, 1024, nb * 32, 32, (bf16*)(KWS + WS_WGU) + ((size_t)l * NE + e) * 1024 * D, D, nb * 32, kb * 64, scr, F.lane); continue; }
        r -= IT_WGU;
        { const int e = r / 512, q = r % 512, kb = q / 64, nb = q % 64;
            tr_item(KIN(I_WDN) + ((size_t)l * NE + e) * FF * D, D, nb * 32, 32, (bf16*)(KWS + WS_WDN) + ((size_t)l * NE + e) * D * FF, FF, nb * 32, kb * 64, scr, F.lane); }
    }
}

template <int MODE> __device__ __forceinline__ void phase_norm1(Frame& F, const float* xin, const bf16* contrib, float* xout, const float* gain, bf16* H) {
    for (int t = F.gw; t < T; t += F.NGW) {
        const f32x4* xr = (const f32x4*)(xin + (size_t)t * D) + F.lane;
        f32x4 v[8]; float ss = 0.f;
#pragma unroll
        for (int j = 0; j < 8; ++j) { v[j] = xr[64 * j];
            if (MODE != 0) { const u32x2 c0 = *((const u32x2*)(contrib + (size_t)(2 * t) * D) + F.lane + 64 * j), c1 = *((const u32x2*)(contrib + (size_t)(2 * t + 1) * D) + F.lane + 64 * j);
                v[j].x += bflo(c0.x) + bflo(c1.x); v[j].y += bfhi(c0.x) + bfhi(c1.x); v[j].z += bflo(c0.y) + bflo(c1.y); v[j].w += bfhi(c0.y) + bfhi(c1.y);
                *((f32x4*)(xout + (size_t)t * D) + F.lane + 64 * j) = v[j]; }
            ss += v[j].x * v[j].x + v[j].y * v[j].y + v[j].z * v[j].z + v[j].w * v[j].w; }
        if (MODE != 2) {
            const float rstd = 1.0f / sqrtf(wave_sum(ss) * (1.0f / D) + EPS);
#pragma unroll
            for (int j = 0; j < 8; ++j) { const f32x4 g = *((const f32x4*)gain + F.lane + 64 * j);
                u32x2 o; o.x = pk2(v[j].x * rstd * g.x, v[j].y * rstd * g.y); o.y = pk2(v[j].z * rstd * g.z, v[j].w * rstd * g.w);
                *((u32x2*)(H + (size_t)t * D) + F.lane + 64 * j) = o; }
        }
    }
}

__device__ __forceinline__ void phase_prep(Frame& F, int l) {
    KA;
    const bf16* P = (const bf16*)(KWS + WS_P);
    float* QN = (float*)(KWS + WS_QN); float* KV = (float*)(KWS + WS_KV);
    const float* qg = KIN(I_QN) + l * 64; const float* kg = KIN(I_KN) + l * 192;
    for (int it = F.gw; it < T * 20; it += F.NGW) {
        const int t = it / 20, v = it % 20;
        float x = bf2f(P[(size_t)t * NPAD + v * 64 + F.lane]);
        const bool isq = v < 8, nk1 = (v == 12 || v == 13), nk2 = (v == 16 || v == 17);
        if (isq || nk1 || nk2) { const float ss = wave_sum(x * x); const float g = isq ? qg[F.lane] : (nk1 ? kg[64 + F.lane] : kg[128 + F.lane]); x = x * (1.0f / sqrtf(ss * (1.0f / 64.0f) + EPS)) * g; }
        if (isq) QN[((size_t)v * T + t) * 64 + F.lane] = x;
        else { const int w = v - 8, tens = w >> 1, g = w & 1; KV[(size_t)tens * KV_STRIDE + ((size_t)g * T + t) * 64 + F.lane] = x; }
    }
}
__device__ __forceinline__ float gelu_tanh(float x) { const float u = 0.7978845608028654f * (x + 0.044715f * x * x * x); return 0.5f * x * (1.0f + tanhf(u)); }
__device__ __forceinline__ void phase_compress(Frame& F, int l) {
    KA;
    LAS float* av = (LAS float*)(F.lds + F.wave * 16384);
    const float* KV = (const float*)(KWS + WS_KV); float* KC = (float*)(KWS + WS_KC);
    for (int it = F.gw; it < 2 * 2 * 511; it += F.NGW) {
        const int kind = it / 1022, q = it % 1022, g = q / 511, n = q % 511;
        const float* src = KV + (size_t)kind * KV_STRIDE + ((size_t)g * T + 16 * n) * 64;
        const float* pe = KIN(I_PE) + ((size_t)l * 2 + kind) * 2048;
        const float* w1 = KIN(I_W1) + ((size_t)l * 2 + kind) * 2048 * 64;
        const float* w2 = KIN(I_W2) + ((size_t)l * 2 + kind) * 64 * 64;
#pragma unroll 4
        for (int c = 0; c < 32; ++c) av[c * 64 + F.lane] = src[c * 64 + F.lane] + pe[c * 64 + F.lane];
        WSYNC();
        float acc = 0.f;
#pragma unroll 8
        for (int i = 0; i < 2048; ++i) acc += av[i] * w1[i * 64 + F.lane];
        const float hid = gelu_tanh(acc);
        WSYNC();
        av[F.lane] = hid;
        WSYNC();
        float o = 0.f;
#pragma unroll 8
        for (int i = 0; i < 64; ++i) o += av[i] * w2[i * 64 + F.lane];
        WSYNC();
        if (kind == 0) { const float ss = wave_sum(o * o); o = o * (1.0f / sqrtf(ss * (1.0f / 64.0f) + EPS)) * KIN(I_KN)[l * 192 + F.lane]; }
        KC[(size_t)kind * (2 * 512 * 64) + ((size_t)g * 512 + n) * 64 + F.lane] = o;
    }
}
__device__ __forceinline__ void phase_recur(Frame& F, int l) {
    KA;
    const bf16* P = (const bf16*)(KWS + WS_P); float* ORAW = (float*)(KWS + WS_ORAW);
    for (int it = F.gw; it < 1024; it += F.NGW) {
        const int kind = it >> 9, head = (it >> 7) & 3, j = it & 127;
        if (kind == 0) {
            const int d0 = F.lane, d1 = F.lane + 64;
            const float* lbl = KIN(I_LB);
            float lb0, lb1;
            { const float a0 = lbl[head * 128 + d0], b0 = lbl[512 + head * 128 + d0], a1 = lbl[head * 128 + d1], b1 = lbl[512 + head * 128 + d1];
              lb0 = l == 0 ? 0.f : 1.0f / (1.0f + expf(a0 - b0)); lb1 = l == 0 ? 0.f : 1.0f / (1.0f + expf(a1 - b1)); }
            const bf16* Pq = P + C_HQ + head * 128; const bf16* Pf = P + C_HF + head * 128; const bf16* Pi = P + C_HI + head * 128 + j;
            float S0 = 0.f, S1 = 0.f;
            for (int t0 = 0; t0 < T; t0 += 8) {
                bf16 zq0[8], zq1[8], zf0[8], zf1[8], vi[8];
#pragma unroll
                for (int u = 0; u < 8; ++u) { const size_t row = (size_t)(t0 + u) * NPAD; zq0[u] = Pq[row + d0]; zq1[u] = Pq[row + d1]; zf0[u] = Pf[row + d0]; zf1[u] = Pf[row + d1]; vi[u] = Pi[row]; }
                float part[8];
#pragma unroll
                for (int u = 0; u < 8; ++u) { const float v = bf2f(vi[u]);
                    const float s0 = sigmoidf_(bf2f(zf0[u])), s1 = sigmoidf_(bf2f(zf1[u]));
                    const float f0 = lb0 + (1.0f - lb0) * s0, f1 = lb1 + (1.0f - lb1) * s1;
                    const float k0 = (1.0f - lb0) * (1.0f - s0), k1 = (1.0f - lb1) * (1.0f - s1);
                    S0 = f0 * S0 + k0 * v; S1 = f1 * S1 + k1 * v;
                    part[u] = bf2f(zq0[u]) * S0 + bf2f(zq1[u]) * S1; }
                float mine = 0.f;
#pragma unroll
                for (int u = 0; u < 8; ++u) { const float s = wave_sum(part[u]); mine = (F.lane == u) ? s : mine; }
                if (F.lane < 8) ORAW[(size_t)(t0 + F.lane) * 1024 + head * 128 + j] = mine;
            }
        } else {
            const int d = F.lane, c = head * 64 + d;
            float wa[16];
#pragma unroll
            for (int r = 0; r < 16; ++r) wa[r] = KIN(I_WA2)[((size_t)l * 16 + r) * 256 + c];
            const float ba = KIN(I_BA)[l * 256 + c];
            const bf16* Pq = P + C_GQ + c; const bf16* Pk = P + C_GK + c; const bf16* Pv = P + C_GV + head * 128 + j; const bf16* Pa = P + C_GA;
            float S = 0.f;
            for (int t0 = 0; t0 < T; t0 += 8) {
                bf16 zq[8], zk[8], zv[8]; u32x4 ga0[8], ga1[8];
#pragma unroll
                for (int u = 0; u < 8; ++u) { const size_t row = (size_t)(t0 + u) * NPAD; zq[u] = Pq[row]; zk[u] = Pk[row]; zv[u] = Pv[row]; ga0[u] = *(const u32x4*)(Pa + row); ga1[u] = *(const u32x4*)(Pa + row + 8); }
                float part[8];
#pragma unroll
                for (int u = 0; u < 8; ++u) {
                    float a = ba;
                    a += bflo(ga0[u].x) * wa[0] + bfhi(ga0[u].x) * wa[1] + bflo(ga0[u].y) * wa[2] + bfhi(ga0[u].y) * wa[3] + bflo(ga0[u].z) * wa[4] + bfhi(ga0[u].z) * wa[5] + bflo(ga0[u].w) * wa[6] + bfhi(ga0[u].w) * wa[7];
                    a += bflo(ga1[u].x) * wa[8] + bfhi(ga1[u].x) * wa[9] + bflo(ga1[u].y) * wa[10] + bfhi(ga1[u].y) * wa[11] + bflo(ga1[u].z) * wa[12] + bfhi(ga1[u].z) * wa[13] + bflo(ga1[u].w) * wa[14] + bfhi(ga1[u].w) * wa[15];
                    const float ls = fminf(a, 0.f) - log1pf(expf(-fabsf(a)));
                    const float f = expf(ls * (1.0f / 16.0f));
                    S = f * S + bf2f(zk[u]) * bf2f(zv[u]);
                    part[u] = bf2f(zq[u]) * 0.125f * S; }
                float mine = 0.f;
#pragma unroll
                for (int u = 0; u < 8; ++u) { const float s = wave_sum(part[u]); mine = (F.lane == u) ? s : mine; }
                if (F.lane < 8) ORAW[(size_t)(t0 + F.lane) * 1024 + 512 + head * 128 + j] = mine;
            }
        }
    }
}
__device__ __forceinline__ void phase_recur_out(Frame& F, int l) {
    KA;
    const bf16* P = (const bf16*)(KWS + WS_P); const float* ORAW = (const float*)(KWS + WS_ORAW); bf16* OCAT = (bf16*)(KWS + WS_OCAT);
    for (int it = F.gw; it < T * 8; it += F.NGW) {
        const int t = it >> 3, kind = (it >> 2) & 1, head = it & 3;
        const float* gn = (kind == 0 ? KIN(I_HGN) : KIN(I_GLAN)) + l * 128;
        const int cg = (kind == 0 ? C_HG : C_GR) + head * 128;
        const float r0 = ORAW[(size_t)t * 1024 + kind * 512 + head * 128 + F.lane], r1 = ORAW[(size_t)t * 1024 + kind * 512 + head * 128 + 64 + F.lane];
        const float rstd = 1.0f / sqrtf(wave_sum(r0 * r0 + r1 * r1) * (1.0f / 128.0f) + EPS);
        const float g0 = bf2f(P[(size_t)t * NPAD + cg + F.lane]), g1 = bf2f(P[(size_t)t * NPAD + cg + 64 + F.lane]);
        const float a0 = kind == 0 ? sigmoidf_(g0) : g0 * sigmoidf_(g0), a1 = kind == 0 ? sigmoidf_(g1) : g1 * sigmoidf_(g1);
        OCAT[(size_t)t * 1536 + 512 + kind * 512 + head * 128 + F.lane] = (bf16)f2bf(r0 * rstd * gn[F.lane] * a0);
        OCAT[(size_t)t * 1536 + 512 + kind * 512 + head * 128 + 64 + F.lane] = (bf16)f2bf(r1 * rstd * gn[64 + F.lane] * a1);
    }
}


template <int KIND> struct RecCfg { static constexpr int DK = KIND == 0 ? 128 : 64, NSEG = 512 / DK, TPS = 64 / NSEG, QROW = (DK + 8) * 2; };
constexpr int REC_VT_OFF = 0;
constexpr int REC_KD_OFF = 18432;
constexpr int REC_QS_OFF = 36864;
constexpr int REC_KS_OFF = 54272;
constexpr int REC_QD_OFF = 71680;
constexpr int REC_RED_OFF = 89088;
constexpr int REC_TOT_OFF = 91136;
__device__ __forceinline__ float expc(float x) { return __expf(fminf(x, 80.0f)); }
template <int KIND> __device__ __forceinline__ void rec_elem(KArgs* ka, int l, int head, int chunk, int tid, LAS float* tot,
        float (&qv)[RecCfg<KIND>::TPS], float (&kv)[RecCfg<KIND>::TPS], float (&bv)[RecCfg<KIND>::TPS], float& bend, float& bref) {
    constexpr int DK = RecCfg<KIND>::DK, NSEG = RecCfg<KIND>::NSEG, TPS = RecCfg<KIND>::TPS;
    const int d = tid % DK, seg = tid / DK, t0 = chunk * 64 + seg * TPS;
    const bf16* P = (const bf16*)(KWS + WS_P);
    float run = 0.f;
    if (KIND == 0) {
        const int c = head * 128 + d;
        float lb = 0.f;
        if (l > 0) { const float a0 = KIN(I_LB)[c], b0 = KIN(I_LB)[512 + c]; lb = 1.0f / (1.0f + expf(a0 - b0)); }
#pragma unroll
        for (int u = 0; u < TPS; ++u) { const size_t row = (size_t)(t0 + u) * NPAD;
            const float z = bf2f(P[row + C_HF + c]); qv[u] = bf2f(P[row + C_HQ + c]);
            const float sg = 1.0f / (1.0f + __expf(-z)), f = lb + (1.0f - lb) * sg;
            kv[u] = (1.0f - lb) * (1.0f - sg); run += __logf(fmaxf(f, 1e-30f)); bv[u] = run; }
    } else {
        const int c = head * 64 + d;
        float wa[16];
#pragma unroll
        for (int r = 0; r < 16; ++r) wa[r] = KIN(I_WA2)[((size_t)l * 16 + r) * 256 + c];
        const float ba = KIN(I_BA)[l * 256 + c];
#pragma unroll
        for (int u = 0; u < TPS; ++u) { const size_t row = (size_t)(t0 + u) * NPAD;
            const u32x4 g0 = *(const u32x4*)(P + row + C_GA), g1 = *(const u32x4*)(P + row + C_GA + 8);
            float a = ba;
            a += bflo(g0.x) * wa[0] + bfhi(g0.x) * wa[1] + bflo(g0.y) * wa[2] + bfhi(g0.y) * wa[3] + bflo(g0.z) * wa[4] + bfhi(g0.z) * wa[5] + bflo(g0.w) * wa[6] + bfhi(g0.w) * wa[7];
            a += bflo(g1.x) * wa[8] + bfhi(g1.x) * wa[9] + bflo(g1.y) * wa[10] + bfhi(g1.y) * wa[11] + bflo(g1.z) * wa[12] + bfhi(g1.z) * wa[13] + bflo(g1.w) * wa[14] + bfhi(g1.w) * wa[15];
            const float ls = fminf(a, 0.f) - log1pf(__expf(-fabsf(a)));
            qv[u] = bf2f(P[row + C_GQ + c]) * 0.125f; kv[u] = bf2f(P[row + C_GK + c]);
            run += ls * (1.0f / 16.0f); bv[u] = run; }
    }
    tot[seg * DK + d] = run;
    __syncthreads();
    float off = 0.f; bend = 0.f; bref = 0.f;
#pragma unroll
    for (int sgi = 0; sgi < NSEG; ++sgi) { const float v = tot[sgi * DK + d]; off += sgi < seg ? v : 0.f; bref += sgi < NSEG / 2 ? v : 0.f; bend += v; }
#pragma unroll
    for (int u = 0; u < TPS; ++u) bv[u] += off;
}
template <int KIND> __device__ __forceinline__ void rec_vt(KArgs* ka, int head, int chunk, int tid, LAS unsigned char* lds) {
    const bf16* P = (const bf16*)(KWS + WS_P) + (KIND == 0 ? C_HI : C_GV) + head * 128;
    const int v = tid & 127, sv = tid >> 7; unsigned w[8];
#pragma unroll
    for (int u = 0; u < 8; ++u) { const unsigned a = P[(size_t)(chunk * 64 + sv * 16 + 2 * u) * NPAD + v], b = P[(size_t)(chunk * 64 + sv * 16 + 2 * u + 1) * NPAD + v]; w[u] = a | (b << 16); }
    LAS u32x4* dst = (LAS u32x4*)(lds + REC_VT_OFF + v * 144 + sv * 32);
    dst[0] = (u32x4){w[0], w[1], w[2], w[3]}; dst[1] = (u32x4){w[4], w[5], w[6], w[7]};
}
template <int KIND> __device__ __forceinline__ void rec_local_unit(KArgs* ka, Frame& F, int l, int head, int chunk) {
    constexpr int DK = RecCfg<KIND>::DK, TPS = RecCfg<KIND>::TPS;
    LAS unsigned char* lds = F.lds; LAS float* tot = (LAS float*)(lds + REC_TOT_OFF);
    float qv[TPS], kv[TPS], bv[TPS], bend, bref;
    rec_elem<KIND>(ka, l, head, chunk, F.tid, tot, qv, kv, bv, bend, bref);
    const int d = F.tid % DK, seg = F.tid / DK, unit = chunk * 4 + head;
    { unsigned w[TPS / 2];
#pragma unroll
      for (int u = 0; u < TPS / 2; ++u) w[u] = pk2(kv[2 * u] * expc(bend - bv[2 * u]), kv[2 * u + 1] * expc(bend - bv[2 * u + 1]));
      LAS u32x4* dst = (LAS u32x4*)(lds + REC_KD_OFF + d * 144 + seg * TPS * 2);
      dst[0] = (u32x4){w[0], w[1], w[2], w[3]};
      if constexpr (TPS == 16) dst[1] = (u32x4){w[4], w[5], w[6], w[7]}; }
    if (seg == 0) ((float*)(KWS + WS_DEC + (KIND == 0 ? 0 : 262144)))[(size_t)unit * DK + d] = __expf(bend);
    rec_vt<KIND>(ka, head, chunk, F.tid, lds);
    __syncthreads();
    const int r = F.lane & 15, kq = F.lane >> 4;
    const int dt = KIND == 0 ? F.wave : (F.wave & 3), vt0 = KIND == 0 ? 0 : (F.wave >> 2) * 4, nvt = KIND == 0 ? 8 : 4;
    bf16x8 a[2];
#pragma unroll
    for (int ks = 0; ks < 2; ++ks) a[ks] = *(const LAS bf16x8*)(lds + REC_KD_OFF + (16 * dt + r) * 144 + (32 * ks + 8 * kq) * 2);
    float* Sl = (float*)(KWS + (KIND == 0 ? WS_SLOC_HG : WS_SLOC_GL)) + (size_t)unit * 128 * DK;
#pragma unroll
    for (int vi = 0; vi < nvt; ++vi) { const int vt = vt0 + vi; f32x4 acc = {0.f, 0.f, 0.f, 0.f};
#pragma unroll
        for (int ks = 0; ks < 2; ++ks) { const bf16x8 b = *(const LAS bf16x8*)(lds + REC_VT_OFF + (16 * vt + r) * 144 + (32 * ks + 8 * kq) * 2); acc = __builtin_amdgcn_mfma_f32_16x16x32_bf16(a[ks], b, acc, 0, 0, 0); }
        *(f32x4*)(Sl + (size_t)(16 * vt + r) * DK + 16 * dt + 4 * kq) = acc; }
    __syncthreads();
}
__device__ __forceinline__ void phase_rec_local(Frame& F, int l) {
    KA;
    for (int it = F.bid; it < 1024; it += F.G) { const int kind = it >> 9, chunk = (it >> 2) & 127, head = it & 3;
        if (kind == 0) rec_local_unit<0>(ka, F, l, head, chunk); else rec_local_unit<1>(ka, F, l, head, chunk); }
}
__device__ __forceinline__ void phase_rec_scan(Frame& F) {
    KA;
    const int gt = F.bid * 512 + F.tid;
    if (gt >= 49152) return;
    const bool hg = gt < 32768; const int q = hg ? gt : gt - 32768;
    const int DK = hg ? 128 : 64, dp = q % (DK / 2), v = (q / (DK / 2)) & 127, head = q / (DK / 2 * 128);
    const float* Sl = (const float*)(KWS + (hg ? WS_SLOC_HG : WS_SLOC_GL)) + ((size_t)head * 128 + v) * DK + 2 * dp;
    bf16* Sp = (bf16*)(KWS + (hg ? WS_SPREV_HG : WS_SPREV_GL)) + ((size_t)head * 128 + v) * DK + 2 * dp;
    const float* De = (const float*)(KWS + WS_DEC + (hg ? 0 : 262144)) + (size_t)head * DK + 2 * dp;
    const size_t ustr = (size_t)4 * 128 * DK, dstr = (size_t)4 * DK;
    float s0 = 0.f, s1 = 0.f;
    for (int c0 = 0; c0 < NCH; c0 += 8) { f32x2 x[8], dc[8];
#pragma unroll
        for (int u = 0; u < 8; ++u) { x[u] = *(const f32x2*)(Sl + (size_t)(c0 + u) * ustr); dc[u] = *(const f32x2*)(De + (size_t)(c0 + u) * dstr); }
#pragma unroll
        for (int u = 0; u < 8; ++u) { *(unsigned*)(Sp + (size_t)(c0 + u) * ustr) = pk2(s0, s1); s0 = dc[u].x * s0 + x[u].x; s1 = dc[u].y * s1 + x[u].y; } }
}
template <int KIND> __device__ __forceinline__ void rec_out_unit(KArgs* ka, Frame& F, int l, int head, int chunk) {
    constexpr int DK = RecCfg<KIND>::DK, TPS = RecCfg<KIND>::TPS, QROW = RecCfg<KIND>::QROW, NKS = DK / 32;
    LAS unsigned char* lds = F.lds; LAS float* tot = (LAS float*)(lds + REC_TOT_OFF); LAS float* red = (LAS float*)(lds + REC_RED_OFF);
    const int r = F.lane & 15, kq = F.lane >> 4, unit = chunk * 4 + head, vt = F.wave;
    bf16x8 sa[NKS];
    { const bf16* Sp = (const bf16*)(KWS + (KIND == 0 ? WS_SPREV_HG : WS_SPREV_GL)) + (size_t)unit * 128 * DK + (size_t)(16 * vt + r) * DK + 8 * kq;
#pragma unroll
      for (int ks = 0; ks < NKS; ++ks) sa[ks] = *(const bf16x8*)(Sp + 32 * ks); }
    float qv[TPS], kv[TPS], bv[TPS], bend, bref;
    rec_elem<KIND>(ka, l, head, chunk, F.tid, tot, qv, kv, bv, bend, bref);
    { const int d = F.tid % DK, seg = F.tid / DK;
#pragma unroll
      for (int u = 0; u < TPS; ++u) { const int tok = seg * TPS + u; const int o = tok * QROW + d * 2;
          *(LAS bf16*)(lds + REC_QS_OFF + o) = (bf16)f2bf(qv[u] * expc(bv[u] - bref));
          *(LAS bf16*)(lds + REC_KS_OFF + o) = (bf16)f2bf(kv[u] * expc(bref - bv[u]));
          *(LAS bf16*)(lds + REC_QD_OFF + o) = (bf16)f2bf(qv[u] * __expf(bv[u])); } }
    rec_vt<KIND>(ka, head, chunk, F.tid, lds);
    __syncthreads();
#pragma unroll
    for (int tt = 0; tt < 2; ++tt) { const int tile = F.wave * 2 + tt, jt = tile >> 2, it = tile & 3; f32x4 acc = {0.f, 0.f, 0.f, 0.f};
        if (jt <= it) {
#pragma unroll
            for (int ks = 0; ks < NKS; ++ks) { const bf16x8 a = *(const LAS bf16x8*)(lds + REC_KS_OFF + (16 * jt + r) * QROW + (32 * ks + 8 * kq) * 2), b = *(const LAS bf16x8*)(lds + REC_QS_OFF + (16 * it + r) * QROW + (32 * ks + 8 * kq) * 2);
                acc = __builtin_amdgcn_mfma_f32_16x16x32_bf16(a, b, acc, 0, 0, 0); } }
        const int i = 16 * it + r, j0 = 16 * jt + 4 * kq;
        u32x2 w; w.x = pk2(j0 <= i ? acc[0] : 0.f, j0 + 1 <= i ? acc[1] : 0.f); w.y = pk2(j0 + 2 <= i ? acc[2] : 0.f, j0 + 3 <= i ? acc[3] : 0.f);
        *(LAS u32x2*)(lds + REC_KD_OFF + i * 144 + j0 * 2) = w; }
    __syncthreads();
    f32x4 acc[4];
#pragma unroll
    for (int it = 0; it < 4; ++it) acc[it] = (f32x4){0.f, 0.f, 0.f, 0.f};
#pragma unroll
    for (int ks = 0; ks < 2; ++ks) { const bf16x8 a = *(const LAS bf16x8*)(lds + REC_VT_OFF + (16 * vt + r) * 144 + (32 * ks + 8 * kq) * 2);
#pragma unroll
        for (int it = 0; it < 4; ++it) { const bf16x8 b = *(const LAS bf16x8*)(lds + REC_KD_OFF + (16 * it + r) * 144 + (32 * ks + 8 * kq) * 2); acc[it] = __builtin_amdgcn_mfma_f32_16x16x32_bf16(a, b, acc[it], 0, 0, 0); } }
#pragma unroll
    for (int ks = 0; ks < NKS; ++ks) {
#pragma unroll
        for (int it = 0; it < 4; ++it) { const bf16x8 b = *(const LAS bf16x8*)(lds + REC_QD_OFF + (16 * it + r) * QROW + (32 * ks + 8 * kq) * 2); acc[it] = __builtin_amdgcn_mfma_f32_16x16x32_bf16(sa[ks], b, acc[it], 0, 0, 0); } }
#pragma unroll
    for (int it = 0; it < 4; ++it) { float ss = acc[it][0] * acc[it][0] + acc[it][1] * acc[it][1] + acc[it][2] * acc[it][2] + acc[it][3] * acc[it][3];
        ss += __shfl_xor(ss, 16); ss += __shfl_xor(ss, 32);
        if (kq == 0) red[F.wave * 64 + 16 * it + r] = ss; }
    __syncthreads();
    const bf16* P = (const bf16*)(KWS + WS_P); bf16* OCAT = (bf16*)(KWS + WS_OCAT);
    const int v0 = 16 * vt + 4 * kq;
    const f32x4 gn = *(const f32x4*)((KIND == 0 ? KIN(I_HGN) : KIN(I_GLAN)) + l * 128 + v0);
#pragma unroll
    for (int it = 0; it < 4; ++it) { const int i = 16 * it + r, t = chunk * 64 + i; float tot_ = 0.f;
#pragma unroll
        for (int w = 0; w < 8; ++w) tot_ += red[w * 64 + i];
        const float rstd = 1.0f / sqrtf(tot_ * (1.0f / 128.0f) + EPS);
        const u32x2 gq = *(const u32x2*)(P + (size_t)t * NPAD + (KIND == 0 ? C_HG : C_GR) + head * 128 + v0);
        float gt[4] = {bflo(gq.x), bfhi(gq.x), bflo(gq.y), bfhi(gq.y)}, o[4];
#pragma unroll
        for (int e = 0; e < 4; ++e) { const float sg = 1.0f / (1.0f + __expf(-gt[e])); o[e] = acc[it][e] * rstd * gn[e] * (KIND == 0 ? sg : gt[e] * sg); }
        u32x2 w; w.x = pk2(o[0], o[1]); w.y = pk2(o[2], o[3]);
        *(u32x2*)(OCAT + (size_t)t * 1536 + 512 + KIND * 512 + head * 128 + v0) = w; }
    __syncthreads();
}
__device__ __forceinline__ void phase_rec_out(Frame& F, int l) {
    KA;
    for (int it = F.bid; it < 1024; it += F.G) { const int kind = it >> 9, chunk = (it >> 2) & 127, head = it & 3;
        if (kind == 0) rec_out_unit<0>(ka, F, l, head, chunk); else rec_out_unit<1>(ka, F, l, head, chunk); }
}

template <bool WIN> __device__ __forceinline__ void nsa_block(const float* Kg, const float* Vg, int j, int t, int lane, const LAS float* qs, LAS float* pb, const float (&slope)[4], float (&M)[4], float (&L)[4], float (&o)[4]) {
    const int pos = 64 * j + lane, dist = t - pos;
    const bool valid = WIN ? (dist >= 0 && dist < 512) : (dist >= 0);
    float dot[4] = {0.f, 0.f, 0.f, 0.f};
    const f32x4* kr = (const f32x4*)(Kg + (size_t)pos * 64);
#pragma unroll 2
    for (int c = 0; c < 16; ++c) { const f32x4 kv = kr[c];
#pragma unroll
        for (int r = 0; r < 4; ++r) { const f32x4 qv = *(const LAS f32x4*)(qs + r * 64 + c * 4); dot[r] += kv.x * qv.x + kv.y * qv.y + kv.z * qv.z + kv.w * qv.w; } }
#pragma unroll
    for (int r = 0; r < 4; ++r) {
        const float s = valid ? dot[r] * 0.125f - slope[r] * (float)dist : NEGB;
        const float nm = fmaxf(M[r], wave_max(s)), sc = expf(M[r] - nm), p = valid ? expf(s - nm) : 0.f;
        L[r] = L[r] * sc + wave_sum(p); o[r] *= sc; M[r] = nm; pb[r * 64 + lane] = p;
    }
    WSYNC();
#pragma unroll 4
    for (int k = 0; k < 64; ++k) { const float v = Vg[(size_t)(64 * j + k) * 64 + lane];
#pragma unroll
        for (int r = 0; r < 4; ++r) o[r] += pb[r * 64 + k] * v; }
    WSYNC();
}
__device__ __forceinline__ void phase_nsa(Frame& F, int l) {
    KA;
    LAS float* qs = (LAS float*)(F.lds + F.wave * 8192);
    LAS float* pbuf = qs + 256;
    LAS float* scb = pbuf + 512;
    LAS float* pb = scb + 128;
    LAS float* impb = pb + 256;
    LAS float* ocb = impb + 512;
    const bf16* P = (const bf16*)(KWS + WS_P); bf16* OCAT = (bf16*)(KWS + WS_OCAT);
    const float* QN = (const float*)(KWS + WS_QN); const float* KV = (const float*)(KWS + WS_KV); const float* KC = (const float*)(KWS + WS_KC);
    const int lane = F.lane;
    for (int it = F.gw; it < T * 2; it += F.NGW) {
        const int t = it >> 1, g = it & 1;
        float slope[4];
#pragma unroll
        for (int r = 0; r < 4; ++r) { slope[r] = exp2f(-(float)(g * 4 + r + 1)); qs[r * 64 + lane] = QN[((size_t)(g * 4 + r) * T + t) * 64 + lane]; }
        WSYNC();
        int nvis = t >= 31 ? (t - 31) / 16 + 1 : 0; nvis = nvis > 511 ? 511 : nvis;
        const float* KCg = KC + (size_t)g * 512 * 64; const float* VCg = KC + (size_t)(2 * 512 * 64) + (size_t)g * 512 * 64;
#pragma unroll 1
        for (int i = 0; i < 8; ++i) impb[lane + 64 * i] = 0.f;
#pragma unroll 1
        for (int r = 0; r < 4; ++r) {
            const float sl = exp2f(-(float)(g * 4 + r + 1));
            float mx = NEGB;
#pragma unroll 1
            for (int i = 0; i < 8; ++i) { const int n = lane + 64 * i; float sv = NEGB;
                if (n < nvis) { const f32x4* kr = (const f32x4*)(KCg + (size_t)n * 64); float dot = 0.f;
#pragma unroll 4
                    for (int c = 0; c < 16; ++c) { const f32x4 kv = kr[c]; const f32x4 qv = *(const LAS f32x4*)(qs + r * 64 + c * 4); dot += kv.x * qv.x + kv.y * qv.y + kv.z * qv.z + kv.w * qv.w; }
                    sv = dot * 0.125f - sl * (float)(t - 16 * n - 31); }
                pbuf[n] = sv; mx = fmaxf(mx, sv); }
            mx = wave_max(mx);
            float sum = 0.f;
#pragma unroll 1
            for (int i = 0; i < 8; ++i) { const int n = lane + 64 * i; const float e = n < nvis ? expf(pbuf[n] - mx) : 0.f; pbuf[n] = e; sum += e; }
            sum = wave_sum(sum);
            const float inv = nvis > 0 ? 1.0f / sum : 0.f;
#pragma unroll 1
            for (int i = 0; i < 8; ++i) { const int n = lane + 64 * i; const float p = pbuf[n] * inv; pbuf[n] = p; impb[n] += p; }
            WSYNC();
            float oc = 0.f;
#pragma unroll 4
            for (int n = 0; n < nvis; ++n) oc += pbuf[n] * VCg[(size_t)n * 64 + lane];
            ocb[r * 64 + lane] = oc;
            WSYNC();
        }
        const int cur = t >> 6;
        float sc2[2];
#pragma unroll
        for (int jj = 0; jj < 2; ++jj) { const int j = lane + 64 * jj;
            float v = (j > 0 ? impb[4 * j - 1] : 0.f) + 2.0f * (impb[4 * j] + impb[4 * j + 1] + impb[4 * j + 2]) + impb[4 * j + 3];
            if (j == 0 || j == cur || j == cur - 1) v = 1e4f;
            if (j > cur) v = -1.0f;
            sc2[jj] = v; scb[j] = v; }
        WSYNC();
        unsigned long long msk[2];
#pragma unroll
        for (int jj = 0; jj < 2; ++jj) { const int j = lane + 64 * jj; int rank = 0;
#pragma unroll 4
            for (int i = 0; i < 128; ++i) { const float si = scb[i]; rank += (si > sc2[jj] || (si == sc2[jj] && i < j)) ? 1 : 0; }
            msk[jj] = __ballot(rank < 16); }
        WSYNC();
        float M[4], L[4], os[4], ow[4];
#pragma unroll
        for (int r = 0; r < 4; ++r) { M[r] = NEGB; L[r] = 0.f; os[r] = 0.f; }
        { const float* Kg = KV + 2 * KV_STRIDE + (size_t)g * T * 64; const float* Vg = KV + 3 * KV_STRIDE + (size_t)g * T * 64;
#pragma unroll 1
          for (int j = 0; j <= cur; ++j) { const bool sel = ((j < 64 ? msk[0] >> j : msk[1] >> (j - 64)) & 1ull) != 0ull; if (sel) nsa_block<false>(Kg, Vg, j, t, lane, qs, pb, slope, M, L, os); } }
#pragma unroll
        for (int r = 0; r < 4; ++r) { os[r] = os[r] / L[r]; M[r] = NEGB; L[r] = 0.f; ow[r] = 0.f; }
        { const float* Kg = KV + 4 * KV_STRIDE + (size_t)g * T * 64; const float* Vg = KV + 5 * KV_STRIDE + (size_t)g * T * 64;
          const int j0 = t >= 511 ? (t - 511) >> 6 : 0;
#pragma unroll 1
          for (int j = j0; j <= cur; ++j) nsa_block<true>(Kg, Vg, j, t, lane, qs, pb, slope, M, L, ow); }
#pragma unroll
        for (int r = 0; r < 4; ++r) { const int h = g * 4 + r;
            const float g0 = sigmoidf_(bf2f(P[(size_t)t * NPAD + C_NG + h])), g1 = sigmoidf_(bf2f(P[(size_t)t * NPAD + C_NG + 8 + h])), g2 = sigmoidf_(bf2f(P[(size_t)t * NPAD + C_NG + 16 + h]));
            OCAT[(size_t)t * 1536 + h * 64 + lane] = (bf16)f2bf(g0 * ocb[r * 64 + lane] + g1 * os[r] + g2 * (ow[r] / L[r])); }
        WSYNC();
    }
}

typedef float f32x16 __attribute__((ext_vector_type(16)));
typedef __bf16 bf16x2_t __attribute__((ext_vector_type(2)));
__device__ __forceinline__ unsigned pkbf(float lo, float hi) { const f32x2 v = {lo, hi}; return __builtin_bit_cast(unsigned, __builtin_convertvector(v, bf16x2_t)); }
constexpr float LOG2E = 1.4426950408889634f, NSA_SHIFT2 = 8.0f;
__device__ __forceinline__ int perm16(int b) { return (b & 3) | ((b & 4) << 1) | ((b & 8) >> 1); }
__device__ __forceinline__ void phase_prep2(Frame& F, int l) {
    KA;
    const bf16* P = (const bf16*)(KWS + WS_P);
    bf16* QS = (bf16*)(KWS + WS_QS); bf16* KS2 = (bf16*)(KWS + WS_KS2); bf16* KW2 = (bf16*)(KWS + WS_KW2);
    const float* qg = KIN(I_QN) + l * 64; const float* kg = KIN(I_KN) + l * 192;
    for (int it = F.gw; it < T * 12; it += F.NGW) {
        const int t = it / 12, v = it % 12;
        const int col = v < 8 ? v * 64 : (v < 10 ? C_KS + (v - 8) * 64 : C_KW + (v - 10) * 64);
        float x = bf2f(P[(size_t)t * NPAD + col + F.lane]);
        const float ss = wave_sum(x * x);
        const float g = v < 8 ? qg[F.lane] * (0.125f * LOG2E) : (v < 10 ? kg[64 + F.lane] : kg[128 + F.lane]);
        x = x * (1.0f / sqrtf(ss * (1.0f / 64.0f) + EPS)) * g;
        bf16* dst = v < 8 ? QS + ((size_t)v * T + t) * 64 : (v < 10 ? KS2 + ((size_t)(v - 8) * T + t) * 64 : KW2 + ((size_t)(v - 10) * T + t) * 64);
        dst[F.lane] = (bf16)f2bf(x);
    }
    LAS bf16* tile = (LAS bf16*)(F.lds + F.wave * 16384);
    for (int it = F.gw; it < 2 * 2 * (T / 64); it += F.NGW) {
        const int kind = it / (2 * (T / 64)), q = it % (2 * (T / 64)), g = q / (T / 64), tb = q % (T / 64);
        const bf16* src = P + (size_t)(tb * 64) * NPAD + (kind == 0 ? C_VS : C_VW) + g * 64;
        bf16* dst = (bf16*)(KWS + (kind == 0 ? WS_VST : WS_VWT)) + (size_t)g * 64 * T + tb * 64;
#pragma unroll 4
        for (int r = 0; r < 64; ++r) tile[r * 66 + F.lane] = src[(size_t)r * NPAD + F.lane];
        WSYNC();
        const int pl = (F.lane & ~15) | perm16(F.lane & 15);
#pragma unroll 4
        for (int d = 0; d < 64; ++d) dst[(size_t)d * T + pl] = tile[F.lane * 66 + d];
        WSYNC();
    }
}
__device__ __forceinline__ void phase_compress2(Frame& F, int l) {
    KA;
    LAS float* av = (LAS float*)(F.lds + F.wave * 16384);
    const bf16* P = (const bf16*)(KWS + WS_P);
    bf16* KCB = (bf16*)(KWS + WS_KCB); bf16* VCT = (bf16*)(KWS + WS_KCB + 131072);
    for (int it = F.gw; it < 2 * 2 * 512; it += F.NGW) {
        const int kind = it >> 10, g = (it >> 9) & 1, n = it & 511;
        if (n == 511) { if (kind == 0) KCB[((size_t)g * 512 + 511) * 64 + F.lane] = 0; else VCT[((size_t)g * 64 + F.lane) * 512 + 511] = 0; continue; }
        const bf16* src = P + (size_t)(16 * n) * NPAD + (kind == 0 ? C_KC : C_VC) + g * 64;
        const float* pe = KIN(I_PE) + ((size_t)l * 2 + kind) * 2048;
        const float* w1 = KIN(I_W1) + ((size_t)l * 2 + kind) * 2048 * 64;
        const float* w2 = KIN(I_W2) + ((size_t)l * 2 + kind) * 64 * 64;
#pragma unroll 4
        for (int c = 0; c < 32; ++c) av[c * 64 + F.lane] = bf2f(src[(size_t)c * NPAD + F.lane]) + pe[c * 64 + F.lane];
        WSYNC();
        float acc = 0.f;
#pragma unroll 8
        for (int i = 0; i < 2048; ++i) acc += av[i] * w1[i * 64 + F.lane];
        const float hid = gelu_tanh(acc);
        WSYNC();
        av[F.lane] = hid;
        WSYNC();
        float o = 0.f;
#pragma unroll 8
        for (int i = 0; i < 64; ++i) o += av[i] * w2[i * 64 + F.lane];
        WSYNC();
        if (kind == 0) { const float ss = wave_sum(o * o); o = o * (1.0f / sqrtf(ss * (1.0f / 64.0f) + EPS)) * KIN(I_KN)[l * 192 + F.lane]; KCB[((size_t)g * 512 + n) * 64 + F.lane] = (bf16)f2bf(o); }
        else VCT[((size_t)g * 64 + F.lane) * 512 + ((n & ~15) | perm16(n & 15))] = (bf16)f2bf(o);
    }
}
constexpr int NSA_KB0 = 0, NSA_VB0 = 9216, NSA_KB1 = 18432, NSA_VB1 = 27648;
constexpr int NSA_SCA = 36864, NSA_SCB = 70656;
constexpr int NSA_QM = 104448, NSA_UM = 105472;
__device__ __forceinline__ int next_set(unsigned long long m0, unsigned long long m1, int from) {
    if (from < 64) { const unsigned long long x = m0 & (~0ull << from); if (x) return __builtin_ctzll(x); from = 64; }
    if (from < 128) { const unsigned long long x = m1 & (~0ull << (from - 64)); if (x) return 64 + __builtin_ctzll(x); }
    return 128;
}
template <int MODE> __device__ __forceinline__ void nsa_branch(Frame& F, const bf16* Kg, const bf16* VTg, int vt_len, unsigned long long m0, unsigned long long m1,
        const bf16x8 (&Qf)[4], int t, int cblk, float slope2, float inv_l, const unsigned (&qsel)[4], int hi_cmp, unsigned wm_lo_dummy, f32x16 (&oacc)[2], float& lsum) {
    LAS unsigned char* lds = F.lds;
    const int lane = F.lane, c32 = lane & 31, h = lane >> 5, tid = F.tid;
    const int lrow = tid >> 3, lch = tid & 7;
    int j = next_set(m0, m1, 0);
    if (j >= 128) return;
    u32x4 rk = *(const u32x4*)(Kg + (size_t)(64 * j + lrow) * 64 + lch * 8), rv = *(const u32x4*)(VTg + (size_t)lrow * vt_len + 64 * j + lch * 8);
    *(LAS u32x4*)(lds + NSA_KB0 + lrow * 144 + lch * 16) = rk; *(LAS u32x4*)(lds + NSA_VB0 + lrow * 144 + lch * 16) = rv;
    __syncthreads();
    int b = 0;
    const float kslope2 = (MODE < 2) ? 16.0f * slope2 : slope2;
    const float qpos = (MODE < 2) ? (float)(t - 31) : (float)t;
    while (j < 128) {
        const int jn = next_set(m0, m1, j + 1);
        if (jn < 128) { rk = *(const u32x4*)(Kg + (size_t)(64 * jn + lrow) * 64 + lch * 8); rv = *(const u32x4*)(VTg + (size_t)lrow * vt_len + 64 * jn + lch * 8); }
        bool need = true;
        if (MODE == 2) { const unsigned myw = j < 32 ? qsel[0] : (j < 64 ? qsel[1] : (j < 96 ? qsel[2] : qsel[3])); need = __any((myw >> (j & 31)) & 1u); }
        if (need) {
            const int kb = b ? NSA_KB1 : NSA_KB0, vb = b ? NSA_VB1 : NSA_VB0;
            const int kbase = 64 * j;
            float lb2 = -slope2 * qpos + kslope2 * (float)(kbase + 4 * h) - NSA_SHIFT2;
            if (MODE == 2) { const unsigned myw = j < 32 ? qsel[0] : (j < 64 ? qsel[1] : (j < 96 ? qsel[2] : qsel[3])); if (!((myw >> (j & 31)) & 1u)) lb2 = -1e30f; }
            f32x16 sacc[2];
#pragma unroll
            for (int sub = 0; sub < 2; ++sub)
#pragma unroll
                for (int i = 0; i < 16; ++i) sacc[sub][i] = fmaf(kslope2, (float)(32 * sub + (i & 3) + 8 * (i >> 2)), lb2);
#pragma unroll
            for (int sub = 0; sub < 2; ++sub) {
#pragma unroll
                for (int ks = 0; ks < 4; ++ks) { const bf16x8 a = *(const LAS bf16x8*)(lds + kb + (32 * sub + c32) * 144 + (16 * ks + 8 * h) * 2); sacc[sub] = __builtin_amdgcn_mfma_f32_32x32x16_bf16(a, Qf[ks], sacc[sub], 0, 0, 0); }
                asm volatile("" ::: "memory"); }
#pragma unroll
            for (int sub = 0; sub < 2; ++sub)
#pragma unroll
                for (int i = 0; i < 16; ++i) sacc[sub][i] = __builtin_amdgcn_exp2f(sacc[sub][i]);
            bool mhi = false, mlo = false; int hi = 0, lo = 0;
            if (MODE < 2) { mhi = true; hi = hi_cmp; }
            if (MODE == 2) { mhi = (j == cblk); hi = t; }
            if (MODE == 3) { mhi = (j == cblk); hi = t; mlo = (j == cblk - 8); lo = t - 511; }
            if (mhi || mlo) {
#pragma unroll
                for (int sub = 0; sub < 2; ++sub)
#pragma unroll
                    for (int i = 0; i < 16; ++i) { const int idx = kbase + 4 * h + 32 * sub + (i & 3) + 8 * (i >> 2); if ((mhi && idx > hi) || (mlo && idx < lo)) sacc[sub][i] = 0.f; }
            }
            float ls = 0.f;
#pragma unroll
            for (int sub = 0; sub < 2; ++sub)
#pragma unroll
                for (int i = 0; i < 16; ++i) ls += sacc[sub][i];
            lsum += ls;
            if (MODE == 1) {
                LAS float* scA = (LAS float*)(lds + NSA_SCA); LAS float* scB = (LAS float*)(lds + NSA_SCB);
                const int q = F.wave * 8 + (c32 >> 2);
#pragma unroll
                for (int sub = 0; sub < 2; ++sub)
#pragma unroll
                    for (int g4 = 0; g4 < 4; ++g4) { float x[4];
#pragma unroll
                        for (int e = 0; e < 4; ++e) { float v = sacc[sub][4 * g4 + e] * inv_l; v += __shfl_xor(v, 1); v += __shfl_xor(v, 2); x[e] = v; }
                        const int jb = 16 * j + 8 * sub + 2 * g4 + h;
                        if ((c32 & 3) == 0) { scA[q * 132 + jb] = 2.0f * (x[0] + x[1] + x[2]) + x[3]; scB[q * 132 + jb + 1] = x[3]; } }
            }
            if (MODE != 0) {
                bf16x8 pf[2][2];
#pragma unroll
                for (int sub = 0; sub < 2; ++sub)
#pragma unroll
                    for (int s2 = 0; s2 < 2; ++s2) { u32x4 w; w.x = pkbf(sacc[sub][8 * s2], sacc[sub][8 * s2 + 1]); w.y = pkbf(sacc[sub][8 * s2 + 2], sacc[sub][8 * s2 + 3]); w.z = pkbf(sacc[sub][8 * s2 + 4], sacc[sub][8 * s2 + 5]); w.w = pkbf(sacc[sub][8 * s2 + 6], sacc[sub][8 * s2 + 7]);
                        pf[sub][s2] = __builtin_bit_cast(bf16x8, w); }
                asm volatile("" ::: "memory");
#pragma unroll
                for (int ds = 0; ds < 2; ++ds) {
#pragma unroll
                    for (int sub = 0; sub < 2; ++sub)
#pragma unroll
                        for (int s2 = 0; s2 < 2; ++s2) { const bf16x8 a = *(const LAS bf16x8*)(lds + vb + (32 * ds + c32) * 144 + (32 * sub + 16 * s2 + 8 * h) * 2); oacc[ds] = __builtin_amdgcn_mfma_f32_32x32x16_bf16(a, pf[sub][s2], oacc[ds], 0, 0, 0); }
                    asm volatile("" ::: "memory"); }
            }
        }
        if (jn < 128) { const int kb = b ? NSA_KB0 : NSA_KB1, vb = b ? NSA_VB0 : NSA_VB1; *(LAS u32x4*)(lds + kb + lrow * 144 + lch * 16) = rk; *(LAS u32x4*)(lds + vb + lrow * 144 + lch * 16) = rv; }
        __syncthreads();
        j = jn; b ^= 1;
    }
}
__device__ __forceinline__ void nsa_stash_put(LAS unsigned char* lds, int wave, int lane, const f32x16 (&o)[2], float sc) {
    LAS unsigned* st = (LAS unsigned*)(lds + NSA_SCA) + wave * 1024 + lane;
#pragma unroll
    for (int ds = 0; ds < 2; ++ds)
#pragma unroll
        for (int k = 0; k < 8; ++k) st[(ds * 8 + k) * 64] = pkbf(o[ds][2 * k] * sc, o[ds][2 * k + 1] * sc);
}
__device__ __forceinline__ void phase_nsa2(Frame& F, int l) {
    KA;
    LAS unsigned char* lds = F.lds;
    const bf16* P = (const bf16*)(KWS + WS_P); bf16* OCAT = (bf16*)(KWS + WS_OCAT);
    const bf16* QS = (const bf16*)(KWS + WS_QS);
    const int lane = F.lane, c32 = lane & 31, h = lane >> 5, q8 = c32 >> 2, r = c32 & 3;
    for (int unit = F.bid; unit < 256; unit += F.G) {
        const int g = unit & 1, cblk = unit >> 1, t0 = cblk * 64, head = g * 4 + r, t = t0 + F.wave * 8 + q8;
        const float slope2 = exp2f(-(float)(head + 1)) * LOG2E;
        bf16x8 Qf[4];
#pragma unroll
        for (int ks = 0; ks < 4; ++ks) Qf[ks] = *(const bf16x8*)(QS + ((size_t)head * T + t) * 64 + 16 * ks + 8 * h);
        for (int u = F.tid; u < (NSA_UM + 16 - NSA_SCA) / 4; u += 512) ((LAS unsigned*)(lds + NSA_SCA))[u] = 0u;
        __syncthreads();
        f32x16 oacc[2];
#pragma unroll
        for (int ds = 0; ds < 2; ++ds)
#pragma unroll
            for (int i = 0; i < 16; ++i) oacc[ds][i] = 0.f;
        unsigned qsel[4] = {0u, 0u, 0u, 0u};
        float sc_cmp;
        {
            const int ntile = (4 * cblk + 2) / 64 + 1;
            const unsigned long long cm0 = ntile >= 64 ? ~0ull : ((1ull << ntile) - 1ull);
            const int hi_cmp = t >= 31 ? (t - 31) / 16 : -1;
            const bf16* Kg = (const bf16*)(KWS + WS_KCB) + (size_t)g * 512 * 64; const bf16* VTg = (const bf16*)(KWS + WS_KCB + 131072) + (size_t)g * 64 * 512;
            float l1 = 0.f;
            nsa_branch<0>(F, Kg, VTg, 512, cm0, 0ull, Qf, t, cblk, slope2, 0.f, qsel, hi_cmp, 0u, oacc, l1);
            l1 += __shfl_xor(l1, 32);
            const float inv_l = l1 > 0.f ? 1.0f / l1 : 0.f;
            float l2 = 0.f;
            nsa_branch<1>(F, Kg, VTg, 512, cm0, 0ull, Qf, t, cblk, slope2, inv_l, qsel, hi_cmp, 0u, oacc, l2);
            sc_cmp = sigmoidf_(bf2f(P[(size_t)t * NPAD + C_NG + head])) * inv_l;
        }
        {
            LAS float* scA = (LAS float*)(lds + NSA_SCA); LAS float* scB = (LAS float*)(lds + NSA_SCB);
            LAS unsigned* qm = (LAS unsigned*)(lds + NSA_QM); LAS unsigned* um = (LAS unsigned*)(lds + NSA_UM);
            WSYNC();
            const int qq = F.wave * 8 + (lane >> 3), jj = lane & 7;
            unsigned key[16];
#pragma unroll
            for (int m = 0; m < 16; ++m) { const int jb = jj + 8 * m; float sv = scA[qq * 132 + jb] + scB[qq * 132 + jb];
                if (jb == 0 || jb == cblk || jb == cblk - 1) sv = 1e4f;
                key[m] = (__builtin_bit_cast(unsigned, sv) & ~127u) | (unsigned)(127 - jb); }
            WSYNC();
#pragma unroll
            for (int m = 0; m < 16; ++m) ((LAS unsigned*)scA)[qq * 132 + jj + 8 * m] = key[m];
            WSYNC();
            unsigned bits[4] = {0u, 0u, 0u, 0u};
#pragma unroll
            for (int half = 0; half < 2; ++half) { int rank[8];
#pragma unroll
                for (int m = 0; m < 8; ++m) rank[m] = 0;
#pragma unroll 2
                for (int i = 0; i <= cblk; ++i) { const unsigned ki = ((const LAS unsigned*)scA)[qq * 132 + i];
#pragma unroll
                    for (int m = 0; m < 8; ++m) rank[m] += ki > key[8 * half + m] ? 1 : 0; }
#pragma unroll
                for (int m = 0; m < 8; ++m) { const int jb = jj + 8 * (8 * half + m); if (jb <= cblk && rank[m] < 16) bits[(8 * half + m) >> 2] |= 1u << (jb & 31); } }
#pragma unroll
            for (int w = 0; w < 4; ++w) if (bits[w]) { atomicOr((unsigned*)(qm + qq * 4 + w), bits[w]); atomicOr((unsigned*)(um + w), bits[w]); }
            __syncthreads();
#pragma unroll
            for (int w = 0; w < 4; ++w) qsel[w] = qm[(F.wave * 8 + q8) * 4 + w];
        }
        nsa_stash_put(lds, F.wave, lane, oacc, sc_cmp);
#pragma unroll
        for (int ds = 0; ds < 2; ++ds)
#pragma unroll
            for (int i = 0; i < 16; ++i) oacc[ds][i] = 0.f;
        {
            LAS unsigned* um = (LAS unsigned*)(lds + NSA_UM);
            const unsigned long long sm0 = (unsigned long long)__builtin_amdgcn_readfirstlane(um[0]) | ((unsigned long long)__builtin_amdgcn_readfirstlane(um[1]) << 32);
            const unsigned long long sm1 = (unsigned long long)__builtin_amdgcn_readfirstlane(um[2]) | ((unsigned long long)__builtin_amdgcn_readfirstlane(um[3]) << 32);
            float ls = 0.f;
            nsa_branch<2>(F, (const bf16*)(KWS + WS_KS2) + (size_t)g * T * 64, (const bf16*)(KWS + WS_VST) + (size_t)g * 64 * T, T, sm0, sm1, Qf, t, cblk, slope2, 0.f, qsel, 0, 0u, oacc, ls);
            ls += __shfl_xor(ls, 32);
            const float sc = sigmoidf_(bf2f(P[(size_t)t * NPAD + C_NG + 8 + head])) / ls;
            LAS unsigned* st = (LAS unsigned*)(lds + NSA_SCA) + F.wave * 1024 + lane;
#pragma unroll
            for (int ds = 0; ds < 2; ++ds)
#pragma unroll
                for (int k = 0; k < 8; ++k) { const unsigned w = st[(ds * 8 + k) * 64]; st[(ds * 8 + k) * 64] = pkbf(bflo(w) + sc * oacc[ds][2 * k], bfhi(w) + sc * oacc[ds][2 * k + 1]); oacc[ds][2 * k] = 0.f; oacc[ds][2 * k + 1] = 0.f; }
        }
        {
            const int j0 = cblk >= 8 ? cblk - 8 : 0;
            unsigned long long wm0 = 0ull, wm1 = 0ull;
            for (int jb = j0; jb <= cblk; ++jb) { if (jb < 64) wm0 |= 1ull << jb; else wm1 |= 1ull << (jb - 64); }
            float ls = 0.f;
            nsa_branch<3>(F, (const bf16*)(KWS + WS_KW2) + (size_t)g * T * 64, (const bf16*)(KWS + WS_VWT) + (size_t)g * 64 * T, T, wm0, wm1, Qf, t, cblk, slope2, 0.f, qsel, 0, 0u, oacc, ls);
            ls += __shfl_xor(ls, 32);
            const float sc = sigmoidf_(bf2f(P[(size_t)t * NPAD + C_NG + 16 + head])) / ls;
            const LAS unsigned* st = (const LAS unsigned*)(lds + NSA_SCA) + F.wave * 1024 + lane;
#pragma unroll
            for (int ds = 0; ds < 2; ++ds)
#pragma unroll
                for (int g4 = 0; g4 < 4; ++g4) { const unsigned w0 = st[(ds * 8 + 2 * g4) * 64], w1 = st[(ds * 8 + 2 * g4 + 1) * 64];
                    u32x2 w; w.x = pkbf(bflo(w0) + sc * oacc[ds][4 * g4], bfhi(w0) + sc * oacc[ds][4 * g4 + 1]); w.y = pkbf(bflo(w1) + sc * oacc[ds][4 * g4 + 2], bfhi(w1) + sc * oacc[ds][4 * g4 + 3]);
                    *(u32x2*)(OCAT + (size_t)t * 1536 + head * 64 + 32 * ds + 8 * g4 + 4 * h) = w; }
        }
        __syncthreads();
    }
}

__device__ __forceinline__ void phase_merge(Frame& F) {
    KA;
    const bf16* P = (const bf16*)(KWS + WS_P); const bf16* PROJ = (const bf16*)(KWS + WS_PROJ); bf16* MG = (bf16*)(KWS + WS_MERGED);
    const size_t total = (size_t)T * D / 8;
    for (size_t it = (size_t)F.gw * 64 + F.lane; it < total; it += (size_t)F.NGW * 64) {
        const size_t t = it / (D / 8); const int d = (int)(it % (D / 8)) * 8;
        float acc[8];
#pragma unroll
        for (int k = 0; k < 8; ++k) acc[k] = 0.f;
#pragma unroll
        for (int n = 0; n < 3; ++n) { const u32x4 gq = *(const u32x4*)(P + t * NPAD + C_MG + n * D + d); const u32x4 pq = *(const u32x4*)(PROJ + ((size_t)n * T + t) * D + d);
            acc[0] += sigmoidf_(bflo(gq.x)) * bflo(pq.x); acc[1] += sigmoidf_(bfhi(gq.x)) * bfhi(pq.x); acc[2] += sigmoidf_(bflo(gq.y)) * bflo(pq.y); acc[3] += sigmoidf_(bfhi(gq.y)) * bfhi(pq.y);
            acc[4] += sigmoidf_(bflo(gq.z)) * bflo(pq.z); acc[5] += sigmoidf_(bfhi(gq.z)) * bfhi(pq.z); acc[6] += sigmoidf_(bflo(gq.w)) * bflo(pq.w); acc[7] += sigmoidf_(bfhi(gq.w)) * bfhi(pq.w); }
        u32x4 o; o.x = pk2(acc[0], acc[1]); o.y = pk2(acc[2], acc[3]); o.z = pk2(acc[4], acc[5]); o.w = pk2(acc[6], acc[7]);
        *(u32x4*)(MG + t * D + d) = o;
    }
}
__device__ __forceinline__ void phase_router(Frame& F, int l) {
    KA;
    const float* X1 = (const float*)(KWS + WS_X1); bf16* H = (bf16*)(KWS + WS_H);
    int* EID = (int*)(KWS + WS_ROUTE); float* EW = (float*)(KWS + WS_ROUTE + 65536);
    const float* gain = KIN(I_NFFN) + (size_t)l * D; const float* wg = KIN(I_WGRP) + (size_t)l * D * 4; const float* we = KIN(I_WEXP) + (size_t)l * D * 32;
    const float* bg = KIN(I_BGRP) + l * 4; const float* be = KIN(I_BEXP) + l * 32;
    for (int t = F.gw; t < T; t += F.NGW) {
        const float* xrow = X1 + (size_t)t * D;
        float ss = 0.f;
#pragma unroll 4
        for (int k = 0; k < 32; ++k) { const float x = xrow[F.lane + 64 * k]; ss += x * x; }
        const float rstd = 1.0f / sqrtf(wave_sum(ss) * (1.0f / D) + EPS);
        float ag[4] = {0.f, 0.f, 0.f, 0.f}, ae[32];
#pragma unroll
        for (int e = 0; e < 32; ++e) ae[e] = 0.f;
#pragma unroll 1
        for (int k = 0; k < 32; ++k) { const int d = F.lane + 64 * k;
            const float hv = xrow[d] * rstd * gain[d];
            H[(size_t)t * D + d] = (bf16)f2bf(hv);
            const f32x4 w4 = *(const f32x4*)(wg + (size_t)d * 4);
            ag[0] += hv * w4.x; ag[1] += hv * w4.y; ag[2] += hv * w4.z; ag[3] += hv * w4.w;
#pragma unroll
            for (int c = 0; c < 8; ++c) { const f32x4 w = *(const f32x4*)(we + (size_t)d * 32 + c * 4); ae[c * 4] += hv * w.x; ae[c * 4 + 1] += hv * w.y; ae[c * 4 + 2] += hv * w.z; ae[c * 4 + 3] += hv * w.w; } }
#pragma unroll
        for (int e = 0; e < 4; ++e) ag[e] = wave_sum(ag[e]) + bg[e];
#pragma unroll
        for (int e = 0; e < 32; ++e) ae[e] = wave_sum(ae[e]) + be[e];
        int gi = 0; float gm = ag[0];
#pragma unroll
        for (int e = 1; e < 4; ++e) if (ag[e] > gm) { gm = ag[e]; gi = e; }
        float gs = 0.f;
#pragma unroll
        for (int e = 0; e < 4; ++e) gs += expf(ag[e] - gm);
        const float gw_ = 1.0f / gs;
        float el[8];
#pragma unroll
        for (int e = 0; e < 8; ++e) { el[e] = gi == 0 ? ae[e] : (gi == 1 ? ae[8 + e] : (gi == 2 ? ae[16 + e] : ae[24 + e])); }
        int i1 = 0; float m1 = el[0];
#pragma unroll
        for (int e = 1; e < 8; ++e) if (el[e] > m1) { m1 = el[e]; i1 = e; }
        int i2 = -1; float m2 = -3.0e38f;
#pragma unroll
        for (int e = 0; e < 8; ++e) if (e != i1 && el[e] > m2) { m2 = el[e]; i2 = e; }
        const float p2 = expf(m2 - m1);
        const float w1 = 1.0f / (1.0f + p2), w2 = p2 / (1.0f + p2);
        if (F.lane == 0) { EID[2 * t] = gi * 8 + i1; EID[2 * t + 1] = gi * 8 + i2; EW[2 * t] = gw_ * w1; EW[2 * t + 1] = gw_ * w2; }
    }
}
__device__ __forceinline__ void phase_lists(Frame& F) {
    KA;
    const int e = F.bid;
    if (e >= NE) return;
    const int* EID = (const int*)(KWS + WS_ROUTE); int* CNT = (int*)(KWS + WS_ROUTE + 131072); int* LIST = (int*)(KWS + WS_ROUTE + 262144);
    LAS int* wc = (LAS int*)F.lds;
    int run = 0;
    for (int base = 0; base < 2 * T; base += 512) {
        const int idx = base + F.tid; const bool match = EID[idx] == e;
        const unsigned long long b = __ballot(match);
        if (F.lane == 0) wc[F.wave] = __popcll(b);
        __syncthreads();
        int pre = 0, tot = 0;
#pragma unroll
        for (int w = 0; w < 8; ++w) { const int c = wc[w]; pre += w < F.wave ? c : 0; tot += c; }
        if (match) LIST[e * 8192 + run + pre + __popcll(b & ((1ull << F.lane) - 1ull))] = idx;
        run += tot;
        __syncthreads();
    }
    if (F.tid == 0) CNT[e] = run;
}
__device__ __forceinline__ void moe_table(Frame& F, LAS int* tb) {
    KA;
    const int* CNT = (const int*)(KWS + WS_ROUTE + 131072);
    if (F.tid == 0) { int a = 0; for (int e = 0; e < NE; ++e) { tb[e] = a; a += (CNT[e] + 255) / 256; } tb[NE] = a; }
    __syncthreads();
}

constexpr int PH_PER_LAYER = 12, N_PHASES = 1 + NL * PH_PER_LAYER + 1;

__global__ void __launch_bounds__(512, 2) mk_fwd(Args args) {
    extern __shared__ __attribute__((aligned(16))) unsigned char lds_raw[];
#define FRAME Frame F; F.lds = (LAS unsigned char*)lds_raw; F.MISC = (volatile LAS unsigned*)(F.lds + MISC_OFF); F.tid = ltid(); F.lane = F.tid & 63; F.wave = __builtin_amdgcn_readfirstlane(F.tid >> 6); \
    F.G = gridDim.x; F.bid = lbid(); F.vcu = (F.G % 8 == 0) ? (F.bid % 8) * (F.G / 8) + F.bid / 8 : F.bid; F.gw = F.bid * 8 + F.wave; F.NGW = F.G * 8;
    unsigned* const ctl = (unsigned*)((unsigned char*)args.ws + WS_CTL);
    for (int u = threadIdx.x; u < (LDS_BYTES - MISC_OFF) / 4; u += 512) ((LAS unsigned*)(lds_raw + MISC_OFF))[u] = 0u;
    __syncthreads();
    const int lo = args.ph_lo, hi = args.ph_hi;
    XcdBarrier bar; bar.bar = ctl + CW_BAR + args.li * XCD_BAR_WORDS; bar.x = 0; bar.st = nullptr;
    if (hi - lo > 1) bar = xcd_barrier_post(ctl + CW_BAR + args.li * XCD_BAR_WORDS, (volatile LAS unsigned*)((LAS unsigned char*)lds_raw + MISC_OFF));
    int ph = 0;
#define RUN(k) ((k) >= lo && (k) < hi)
#define SEAM(k) do { if ((k) + 1 < hi) xcd_barrier(bar); } while (0)
    LAS int* const tb = (LAS int*)((LAS unsigned char*)lds_raw + MISC_OFF + 64);

    if (RUN(ph)) { KA; FRAME; phase_prologue(F); phase_norm1<0>(F, KIN(I_X), nullptr, nullptr, KIN(I_NMIX), (bf16*)(KWS + WS_H)); SEAM(ph); }
    ++ph;
    for (int l = 0; l < NL; ++l) {
        if (RUN(ph)) { KA; FRAME; pg8::PlainSched S; S.init((const bf16*)(KWS + WS_H), D, (const bf16*)(KWS + WS_WIN) + (size_t)l * NPAD * D, T, NPAD, D, F.G, F.bid);
            pg8::EpiBf16 E{(bf16*)(KWS + WS_P), NPAD};
            pg8::gemm_phase<pg8::EpiBf16, pg8::PlainSched, true>(F.lds, D, S, E); SEAM(ph); }
        ++ph;
        if (RUN(ph)) { KA; FRAME; phase_prep2(F, l); SEAM(ph); }
        ++ph;
        if (RUN(ph)) { KA; FRAME; phase_compress2(F, l); phase_rec_local(F, l); SEAM(ph); }
        ++ph;
        if (RUN(ph)) { KA; FRAME; phase_rec_scan(F); SEAM(ph); }
        ++ph;
        if (RUN(ph)) { KA; FRAME; phase_nsa2(F, l); phase_rec_out(F, l); SEAM(ph); }
        ++ph;
        if (RUN(ph)) { KA; FRAME;
            for (int n = 0; n < 3; ++n) { pg8::PlainSched S; S.init((const bf16*)(KWS + WS_OCAT) + n * 512, 1536, (const bf16*)(KWS + WS_WBR) + ((size_t)l * 3 + n) * D * 512, T, D, 512, F.G, F.bid);
                pg8::EpiBf16 E{(bf16*)(KWS + WS_PROJ) + (size_t)n * T * D, D};
                pg8::gemm_phase<pg8::EpiBf16, pg8::PlainSched, true>(F.lds, 512, S, E); __syncthreads(); }
            SEAM(ph); }
        ++ph;
        if (RUN(ph)) { KA; FRAME; phase_merge(F); SEAM(ph); }
        ++ph;
        if (RUN(ph)) { KA; FRAME; pg8::PlainSched S; S.init((const bf16*)(KWS + WS_MERGED), D, (const bf16*)(KWS + WS_WOUT) + (size_t)l * D * D, T, D, D, F.G, F.bid);
            pg8::EpiResF32 E{l == 0 ? KIN(I_X) : (const float*)(KWS + WS_XRES), (float*)(KWS + WS_X1), D};
            pg8::gemm_phase<pg8::EpiResF32, pg8::PlainSched, false>(F.lds, D, S, E); SEAM(ph); }
        ++ph;
        if (RUN(ph)) { KA; FRAME; phase_router(F, l); SEAM(ph); }
        ++ph;
        if (RUN(ph)) { KA; FRAME; phase_lists(F); SEAM(ph); }
        ++ph;
        if (RUN(ph)) { KA; FRAME; moe_table(F, tb);
            pg8::MoeSched<1> S; S.init(F.G, F.bid, tb, (const int*)(KWS + WS_ROUTE + 131072), (const int*)(KWS + WS_ROUTE + 262144), KWS + WS_H, (const bf16*)(KWS + WS_WGU) + (size_t)l * NE * 1024 * D);
            pg8::EpiMoe1 E{(bf16*)(KWS + WS_ACT), (const int*)(KWS + WS_ROUTE + 262144), (const float*)(KWS + WS_ROUTE + 65536)};
            pg8::gemm_phase<pg8::EpiMoe1, pg8::MoeSched<1>, true>(F.lds, D, S, E); SEAM(ph); }
        ++ph;
        if (RUN(ph)) { KA; FRAME; moe_table(F, tb);
            pg8::MoeSched<2> S; S.init(F.G, F.bid, tb, (const int*)(KWS + WS_ROUTE + 131072), (const int*)(KWS + WS_ROUTE + 262144), KWS + WS_ACT, (const bf16*)(KWS + WS_WDN) + (size_t)l * NE * D * FF);
            pg8::EpiMoe2 E{(bf16*)(KWS + WS_CONTRIB), (const int*)(KWS + WS_ROUTE + 262144)};
            pg8::gemm_phase<pg8::EpiMoe2, pg8::MoeSched<2>, true>(F.lds, FF, S, E); SEAM(ph); }
        ++ph;
        if (l + 1 < NL) { if (RUN(ph)) { KA; FRAME; phase_norm1<1>(F, (const float*)(KWS + WS_X1), (const bf16*)(KWS + WS_CONTRIB), (float*)(KWS + WS_XRES), KIN(I_NMIX) + (size_t)(l + 1) * D, (bf16*)(KWS + WS_H)); SEAM(ph); } ++ph; }
    }
    if (RUN(ph)) { KA; FRAME; phase_norm1<2>(F, (const float*)(KWS + WS_X1), (const bf16*)(KWS + WS_CONTRIB), KOUT, nullptr, nullptr); }
#undef RUN
#undef SEAM
}

#ifndef MK_PER_PHASE
#define MK_PER_PHASE 0
#endif
extern "C" void kernel_launch(void* const* d_in, const int* in_sizes, int n_in, void* d_out, int out_size, void* d_ws, size_t ws_size, hipStream_t stream) {
    static int grid = 0;
    if (grid == 0) {
        if (n_in != 22 || out_size != T * D || ws_size < WS_END) { fprintf(stderr, "kernel_launch: unexpected sizes (n_in %d out %d ws %zu)\n", n_in, out_size, ws_size); grid = -1; return; }
        int dev = 0, cus = 0, per_cu = 0;
        if (hipGetDevice(&dev) != hipSuccess || hipDeviceGetAttribute(&cus, hipDeviceAttributeMultiprocessorCount, dev) != hipSuccess) { grid = -1; return; }
        if (hipFuncSetAttribute((const void*)mk_fwd, hipFuncAttributeMaxDynamicSharedMemorySize, LDS_BYTES) != hipSuccess) { fprintf(stderr, "kernel_launch: hipFuncSetAttribute failed\n"); grid = -1; return; }
        if (hipOccupancyMaxActiveBlocksPerMultiprocessor(&per_cu, (const void*)mk_fwd, 512, LDS_BYTES) != hipSuccess || per_cu < 1) { fprintf(stderr, "kernel_launch: occupancy query says %d\n", per_cu); }
        (void)hipGetLastError();
        grid = cus;
    }
    if (grid < 0) return;
    if (hipMemsetAsync((char*)d_ws + WS_CTL, 0, CTL_ZERO_BYTES, stream) != hipSuccess) return;
    Args a{};
    for (int i = 0; i < 22; ++i) a.in[i] = (const GAS float*)d_in[i];
    a.out = (GAS float*)d_out; a.ws = (GAS unsigned char*)d_ws;
#if MK_PER_PHASE
    const int total = 1 + NL * PH_PER_LAYER + (NL - 1) + 1;
    for (int k = 0; k < total; ++k) { a.ph_lo = k; a.ph_hi = k + 1; a.li = 0; hipLaunchKernelGGL(mk_fwd, dim3(grid), dim3(512), LDS_BYTES, stream, a); }
#else
    a.ph_lo = 0; a.ph_hi = 1000; a.li = 0;
    hipLaunchKernelGGL(mk_fwd, dim3(grid), dim3(512), LDS_BYTES, stream, a);
#endif
    const hipError_t le = hipPeekAtLastError();
    if (le != hipSuccess) fprintf(stderr, "kernel_launch: launch failed: %s\n", hipGetErrorName(le));
}
```

```cpp
#include <hip/hip_runtime.h>
#include <cstdio>
#include <cstdint>

#define GAS __attribute__((address_space(1)))
#define LAS __attribute__((address_space(3)))
typedef unsigned short bf16;
typedef short bf16x8 __attribute__((ext_vector_type(8)));
typedef float f32x4 __attribute__((ext_vector_type(4)));
typedef float f32x2 __attribute__((ext_vector_type(2)));
typedef unsigned u32x4 __attribute__((ext_vector_type(4)));
typedef unsigned u32x2 __attribute__((ext_vector_type(2)));

constexpr int T = 8192, D = 2048, NL = 2, INC = 11048, NPAD = 11264;
constexpr int NE = 32, FF = 512, NCH = T / 64;
constexpr float EPS = 1e-6f, NEGB = -1e30f;
constexpr int C_Q = 0, C_KC = 512, C_VC = 640, C_KS = 768, C_VS = 896, C_KW = 1024, C_VW = 1152;
constexpr int C_HQ = 1280, C_HF = 1792, C_HI = 2304, C_HG = 2816, C_GQ = 3328, C_GK = 3584, C_GV = 3840, C_GR = 4352;
constexpr int C_MG = 4864, C_NG = 11008, C_GA = 11032;

constexpr size_t MiB = 1u << 20;
constexpr size_t WS_CTL = 0, CTL_ZERO_BYTES = 1 * MiB;
constexpr size_t WS_WIN = 2 * MiB;
constexpr size_t WS_WBR = 90 * MiB;
constexpr size_t WS_WOUT = 102 * MiB;
constexpr size_t WS_WGU = 118 * MiB;
constexpr size_t WS_WDN = 374 * MiB;
constexpr size_t WS_H = 502 * MiB;
constexpr size_t WS_P = 534 * MiB;
constexpr size_t WS_OCAT = 710 * MiB;
constexpr size_t WS_PROJ = 734 * MiB;
constexpr size_t WS_MERGED = 830 * MiB;
constexpr size_t WS_X1 = 862 * MiB;
constexpr size_t WS_XRES = 926 * MiB;
constexpr size_t WS_CONTRIB = 990 * MiB;
constexpr size_t WS_ACT = 1054 * MiB;
constexpr size_t WS_QN = 1078 * MiB;
constexpr size_t WS_KV = 1094 * MiB;
constexpr size_t WS_KC = 1118 * MiB;
constexpr size_t WS_ORAW = 1119 * MiB;
constexpr size_t WS_ROUTE = 1151 * MiB;
constexpr size_t WS_SLOC_HG = 1153 * MiB;
constexpr size_t WS_SLOC_GL = 1185 * MiB;
constexpr size_t WS_SPREV_HG = 1201 * MiB;
constexpr size_t WS_SPREV_GL = 1217 * MiB;
constexpr size_t WS_DEC = 1225 * MiB;
constexpr size_t WS_QS = 1226 * MiB;
constexpr size_t WS_KS2 = 1234 * MiB;
constexpr size_t WS_KW2 = 1236 * MiB;
constexpr size_t WS_VST = 1238 * MiB;
constexpr size_t WS_VWT = 1240 * MiB;
constexpr size_t WS_KCB = 1242 * MiB;
constexpr size_t WS_WRT = 1243 * MiB;
constexpr size_t WS_HIST = 1244 * MiB;
constexpr size_t WS_END = 1245 * MiB;
constexpr size_t KV_STRIDE = (size_t)2 * T * 64;
constexpr int CW_BAR = 4096;

constexpr int RING_BYTES = 131072;
constexpr int MISC_OFF = RING_BYTES;
constexpr int LDS_BYTES = 147456;

#define LDS_WAIT() asm volatile("s_waitcnt lgkmcnt(0)" ::: "memory")
#define VM_WAIT() asm volatile("s_waitcnt vmcnt(0)" ::: "memory")
#define WSYNC() asm volatile("s_waitcnt lgkmcnt(0)" ::: "memory")

__device__ __forceinline__ unsigned f2bf(float f) { unsigned u = __builtin_bit_cast(unsigned, f); return (u + 0x7fffu + ((u >> 16) & 1u)) >> 16; }
__device__ __forceinline__ unsigned pk2(float lo, float hi) { return f2bf(lo) | (f2bf(hi) << 16); }
__device__ __forceinline__ float bf2f(unsigned b) { return __builtin_bit_cast(float, (b & 0xffffu) << 16); }
__device__ __forceinline__ float bflo(unsigned w) { return __builtin_bit_cast(float, w << 16); }
__device__ __forceinline__ float bfhi(unsigned w) { return __builtin_bit_cast(float, w & 0xffff0000u); }
__device__ __forceinline__ float wave_sum(float v) {
#pragma unroll
    for (int o = 1; o < 64; o <<= 1) v += __shfl_xor(v, o);
    return v;
}
__device__ __forceinline__ float wave_max(float v) {
#pragma unroll
    for (int o = 1; o < 64; o <<= 1) v = fmaxf(v, __shfl_xor(v, o));
    return v;
}
__device__ __forceinline__ int ltid() { int t = threadIdx.x; asm volatile("" : "+v"(t)); return t; }
__device__ __forceinline__ int lbid() { int b = blockIdx.x; asm volatile("" : "+s"(b)); return b; }
__device__ __forceinline__ float sigmoidf_(float x) { return 1.0f / (1.0f + expf(-x)); }

#define XB_TMO      128
#define XB_XCNT(j)  (256  + 64 * (j))
#define XB_XSUB(j)  (1280 + 64 * (j))
#define XB_XGEN(j)  (2304 + 64 * (j))
#define XB_TOP      3328
#define XB_TOPGEN   3392
#define XCD_BAR_WORDS 3456
#define XB_SPIN_CAP (1u << 25)

__device__ __forceinline__ unsigned xb_ld(unsigned* p)              { return __hip_atomic_load(p, __ATOMIC_RELAXED, __HIP_MEMORY_SCOPE_AGENT); }
__device__ __forceinline__ unsigned xb_add(unsigned* p, unsigned v) { return __hip_atomic_fetch_add(p, v, __ATOMIC_RELAXED, __HIP_MEMORY_SCOPE_AGENT); }
__device__ __forceinline__ unsigned xb_xcc_id() { return (unsigned)__builtin_amdgcn_s_getreg((3 << 11) | 20) & 0xFu; }
#define XB_SPIN(cond, bar) do { unsigned _sp = 0; while (cond) { __builtin_amdgcn_s_sleep(1); \
    if ((++_sp & 255u) == 0u) { if (xb_ld(&(bar)[XB_TMO])) break; if (_sp > XB_SPIN_CAP) { atomicAdd(&(bar)[XB_TMO], 1u); break; } } } } while (0)

struct XcdBarrier { unsigned* bar; unsigned x; volatile LAS unsigned* st; };

__device__ __forceinline__ XcdBarrier xcd_barrier_post(unsigned* bar, volatile LAS unsigned* st) {
    XcdBarrier b; b.bar = bar; b.x = xb_xcc_id(); b.st = st;
    if (threadIdx.x == 0) (void)xb_add(&bar[XB_XCNT(b.x)], 1u);
    return b;
}
__device__ __forceinline__ void xcd_barrier_complete(unsigned* bar, unsigned x, unsigned& nloc, unsigned& nx) {
    const unsigned G = gridDim.x * gridDim.y * gridDim.z;
    unsigned sum, cnt, mine, sp = 0u;
    for (;;) {
        sum = 0u; cnt = 0u; mine = 0u;
#pragma unroll
        for (unsigned j = 0; j < 16; ++j) { const unsigned c = xb_ld(&bar[XB_XCNT(j)]); sum += c; cnt += (c > 0u) ? 1u : 0u; mine = (j == x) ? c : mine; }
        if (sum == G) break;
        __builtin_amdgcn_s_sleep(1);
        if ((++sp & 255u) == 0u) { if (xb_ld(&bar[XB_TMO])) break; if (sp > XB_SPIN_CAP) { atomicAdd(&bar[XB_TMO], 1u); break; } }
    }
    nloc = mine > 0u ? mine : 1u; nx = cnt > 0u ? cnt : 1u;
}
__device__ __forceinline__ void xcd_barrier(const XcdBarrier& b) {
    asm volatile("s_waitcnt vmcnt(0)" ::: "memory");
    __syncthreads();
    if (threadIdx.x == 0) {
        unsigned* bar = b.bar;
        __builtin_amdgcn_s_waitcnt(0);
        unsigned nloc = b.st[0], nx = b.st[1];
        if (nloc == 0u) { xcd_barrier_complete(bar, b.x, nloc, nx); b.st[0] = nloc; b.st[1] = nx; }
        const unsigned old = xb_add(&bar[XB_XSUB(b.x)], 1u);
        const unsigned gen = old / nloc;
        if (old + 1u == (gen + 1u) * nloc) {
            __builtin_amdgcn_fence(__ATOMIC_RELEASE, "agent");
            asm volatile("s_waitcnt vmcnt(0)" ::: "memory");
            const unsigned og = xb_add(&bar[XB_TOP], 1u);
            const unsigned tg = og / nx;
            if (og + 1u == (tg + 1u) * nx) xb_add(&bar[XB_TOPGEN], 1u);
            else XB_SPIN(xb_ld(&bar[XB_TOPGEN]) == tg, bar);
            __builtin_amdgcn_fence(__ATOMIC_ACQUIRE, "agent");
            xb_add(&bar[XB_XGEN(b.x)], 1u);
            asm volatile("s_waitcnt vmcnt(0)" ::: "memory");
        } else {
            XB_SPIN(xb_ld(&bar[XB_XGEN(b.x)]) == gen, bar);
            __builtin_amdgcn_fence(__ATOMIC_ACQUIRE, "agent");
            asm volatile("s_waitcnt vmcnt(0)" ::: "memory");
        }
    }
    __syncthreads();
}

namespace pg8 {
constexpr int BM = 256, BK = 64, HALF = 128, HTB = HALF * BK * 2, STAGE_BYTES = 8 * HTB, NXCD = 8, WGM = 8;
__host__ __device__ __forceinline__ int lds_byte(int r, int c) { const int st = (r >> 4) * 2 + (c >> 5), rr = r & 15, cc = c & 31, ob = rr * 64 + cc * 2; return st * 1024 + (ob ^ (((ob >> 9) & 1) << 5)); }
__host__ __device__ __forceinline__ void stage_rc(int b, int& R, int& C) { const int st = b / 1024, sb = b % 1024, swz = sb ^ (((sb >> 9) & 1) << 5); R = (st >> 1) * 16 + swz / 64; C = (st & 1) * 32 + (swz % 64) / 2; }
__host__ __device__ __forceinline__ int perm32(int rho) { const int n = rho >> 4, i = rho & 15; return 8 * (i >> 2) + 4 * n + (i & 3); }

struct Unit { int pm, pn, e, nvalid, slot0; const char *A0, *A1, *B0, *B1; unsigned va[2][2]; };

__device__ __forceinline__ unsigned cvt_pk_bf16(float lo, float hi) { unsigned r; asm volatile("v_cvt_pk_bf16_f32 %0, %1, %2" : "=v"(r) : "v"(lo), "v"(hi)); return r; }

template <class Epi, class Sched, bool ALIGN_EPI>
__device__ __forceinline__ void gemm_phase(LAS unsigned char* lds, const int K, const Sched& S, const Epi& E) {
    const int tid = ltid(), wid = __builtin_amdgcn_readfirstlane(tid >> 6), lane = tid & 63, wr = wid >> 2, wc = wid & 3, fr = lane & 15, fq = lane >> 4;
    const int nt = K / BK;
    unsigned voffB[2];
#pragma unroll
    for (int i = 0; i < 2; ++i) { int R, C; stage_rc(tid * 16 + i * 8192, R, C); const int Rb = Epi::PERM ? ((R & ~31) + perm32(R & 31)) : R; voffB[i] = (unsigned)(Rb * K + C) * 2u; }
    const size_t kstep = (size_t)(BK * 2);
    const unsigned ldsw = (unsigned)wid * 1024u;
    const int aoff = lds_byte(wr * 64 + fr, fq * 8), boff = lds_byte(wc * 32 + fr, fq * 8);
#define PG8_SA(b, h) (((b) * 2 + (h)) * HTB)
#define PG8_SB(b, h) ((4 + (b) * 2 + (h)) * HTB)
#define PG8_STAGE(bufoff, gbase, voff) do { _Pragma("unroll") for (int _i = 0; _i < 2; ++_i) \
        __builtin_amdgcn_global_load_lds((const unsigned*)((const char*)(gbase) + (voff)[_i]), (LAS unsigned*)(lds + (bufoff) + ldsw + _i * 8192), 16, 0, 0); } while (0)
#define PG8_LDA(dst, b, h) do { _Pragma("unroll") for (int m = 0; m < 4; ++m) _Pragma("unroll") for (int k = 0; k < 2; ++k) dst[m][k] = *(const LAS bf16x8*)(lds + PG8_SA(b, h) + aoff + m * 2048 + k * 1024); } while (0)
#define PG8_LDB(dst, b, h) do { _Pragma("unroll") for (int n = 0; n < 2; ++n) _Pragma("unroll") for (int k = 0; k < 2; ++k) dst[n][k] = *(const LAS bf16x8*)(lds + PG8_SB(b, h) + boff + n * 2048 + k * 1024); } while (0)
#define PG8_MMA(ai, bj, At, Bt) do { __builtin_amdgcn_s_setprio(1); _Pragma("unroll") for (int m = 0; m < 4; ++m) _Pragma("unroll") for (int n = 0; n < 2; ++n) _Pragma("unroll") for (int k = 0; k < 2; ++k) \
        acc[ai][bj][m][n] = __builtin_amdgcn_mfma_f32_16x16x32_bf16(Bt[n][k], At[m][k], acc[ai][bj][m][n], 0, 0, 0); __builtin_amdgcn_s_setprio(0); } while (0)
#define PG8_WAIT_V(n) asm volatile("s_waitcnt vmcnt(" #n ")" ::: "memory")
#define PG8_WAIT_L(n) asm volatile("s_waitcnt lgkmcnt(" #n ")" ::: "memory")
#define PG8_BAR __builtin_amdgcn_s_barrier()
#define PG8_SCHED __builtin_amdgcn_sched_barrier(0)
#define VA(u, h) (Sched::GATHER ? (u).va[h] : S.va)
    Unit cur, nxt; int ui = 0;
    if (!S.next(0, cur)) return;
    f32x4 acc[2][2][4][2];
#pragma unroll
    for (int a = 0; a < 2; ++a)
#pragma unroll
        for (int b = 0; b < 2; ++b)
#pragma unroll
            for (int m = 0; m < 4; ++m)
#pragma unroll
                for (int n = 0; n < 2; ++n) acc[a][b][m][n] = (f32x4){0.f, 0.f, 0.f, 0.f};
    bf16x8 At[4][2], B0[2][2], B1[2][2];
    PG8_STAGE(PG8_SB(0, 0), cur.B0, voffB); PG8_STAGE(PG8_SB(0, 1), cur.B1, voffB); PG8_STAGE(PG8_SA(0, 0), cur.A0, VA(cur, 0)); PG8_STAGE(PG8_SA(0, 1), cur.A1, VA(cur, 1));
    if (wr == 1) PG8_BAR;
    PG8_WAIT_V(2); PG8_BAR;
    PG8_STAGE(PG8_SB(1, 0), cur.B0 + kstep, voffB); PG8_STAGE(PG8_SA(1, 0), cur.A0 + kstep, VA(cur, 0)); PG8_STAGE(PG8_SB(1, 1), cur.B1 + kstep, voffB);
    PG8_WAIT_V(6); PG8_BAR;
    for (;;) {
        const bool has_next = S.next(ui + 1, nxt);
        if (!has_next) nxt = cur;
        for (int t = 0; t < nt; t += 2) {
            const bool last = (t == nt - 2);
            const char* a1h1 = cur.A1 + (size_t)(t + 1) * kstep;
            const char* a2h0 = last ? nxt.A0 : cur.A0 + (size_t)(t + 2) * kstep; const char* a2h1 = last ? nxt.A1 : cur.A1 + (size_t)(t + 2) * kstep;
            const char* b2h0 = last ? nxt.B0 : cur.B0 + (size_t)(t + 2) * kstep; const char* b2h1 = last ? nxt.B1 : cur.B1 + (size_t)(t + 2) * kstep;
            unsigned v2h0[2], v2h1[2];
#pragma unroll
            for (int i = 0; i < 2; ++i) { if constexpr (Sched::GATHER) { v2h0[i] = last ? nxt.va[0][i] : cur.va[0][i]; v2h1[i] = last ? nxt.va[1][i] : cur.va[1][i]; } else { v2h0[i] = S.va[i]; v2h1[i] = S.va[i]; } }
            PG8_LDB(B0, 0, 0); PG8_LDB(B1, 0, 1); PG8_SCHED; PG8_LDA(At, 0, 0); PG8_STAGE(PG8_SA(1, 1), a1h1, VA(cur, 1));
            PG8_WAIT_V(8); PG8_WAIT_L(0); PG8_BAR; PG8_MMA(0, 0, At, B0); PG8_MMA(0, 1, At, B1); PG8_BAR; PG8_SCHED;
            PG8_LDA(At, 0, 1); PG8_STAGE(PG8_SB(0, 0), b2h0, voffB); PG8_STAGE(PG8_SB(0, 1), b2h1, voffB); PG8_STAGE(PG8_SA(0, 0), a2h0, v2h0);
            PG8_WAIT_V(8); PG8_WAIT_L(0); PG8_BAR; PG8_MMA(1, 0, At, B0); PG8_MMA(1, 1, At, B1); PG8_BAR; PG8_SCHED;
            PG8_LDB(B0, 1, 0); PG8_LDB(B1, 1, 1); PG8_SCHED; PG8_LDA(At, 1, 0); PG8_STAGE(PG8_SA(0, 1), a2h1, v2h1);
            PG8_WAIT_V(8); PG8_WAIT_L(0); PG8_BAR; PG8_MMA(0, 0, At, B0); PG8_MMA(0, 1, At, B1); PG8_BAR; PG8_SCHED;
            PG8_LDA(At, 1, 1); PG8_STAGE(PG8_SB(1, 0), b2h0 + kstep, voffB); PG8_STAGE(PG8_SB(1, 1), b2h1 + kstep, voffB); PG8_STAGE(PG8_SA(1, 0), a2h0 + kstep, v2h0);
            PG8_WAIT_V(8); PG8_WAIT_L(0); PG8_BAR; PG8_MMA(1, 0, At, B0); PG8_MMA(1, 1, At, B1); PG8_BAR; PG8_SCHED;
        }
        if constexpr (ALIGN_EPI) { if (wr == 0) PG8_BAR; }
        E(acc, cur, wr, wc, fr, fq);
        if (!has_next) break;
#pragma unroll
        for (int a = 0; a < 2; ++a)
#pragma unroll
            for (int b = 0; b < 2; ++b)
#pragma unroll
                for (int m = 0; m < 4; ++m)
#pragma unroll
                    for (int n = 0; n < 2; ++n) acc[a][b][m][n] = (f32x4){0.f, 0.f, 0.f, 0.f};
        cur = nxt; ++ui;
        if constexpr (ALIGN_EPI) { if (wr == 1) PG8_BAR; }
    }
    PG8_WAIT_V(0);
    if constexpr (!ALIGN_EPI) { if (wr == 0) PG8_BAR; }
    PG8_BAR;
#undef VA
#undef PG8_SA
#undef PG8_SB
#undef PG8_STAGE
#undef PG8_LDA
#undef PG8_LDB
#undef PG8_MMA
#undef PG8_WAIT_V
#undef PG8_WAIT_L
#undef PG8_BAR
#undef PG8_SCHED
}

struct PlainSched {
    static constexpr bool GATHER = false;
    int nM, nN, nwg, G, c, lda, K; const char* A; const char* Bt; unsigned va[2];
    __device__ __forceinline__ void init(const bf16* A_, int lda_, const bf16* Bt_, int M, int N, int K_, int G_, int c_) {
        nM = M / BM; nN = N / BM; nwg = nM * nN; G = G_; c = c_; lda = lda_; K = K_; A = (const char*)A_; Bt = (const char*)Bt_;
#pragma unroll
        for (int i = 0; i < 2; ++i) { int R, C; stage_rc((int)ltid() * 16 + i * 8192, R, C); va[i] = (unsigned)(R * lda + C) * 2u; }
    }
    __device__ __forceinline__ bool next(int i, Unit& u) const {
        const long L = (long)i * G + c; if (L >= nwg) return false;
        int wgid = (int)L; { const int q = nwg / NXCD, r = nwg % NXCD, xcd = wgid % NXCD, off = wgid / NXCD; wgid = (xcd < r ? xcd * (q + 1) : r * (q + 1) + (xcd - r) * q) + off; }
        const int nig = WGM * nN, gid = wgid / nig, fm = gid * WGM, gsz = (nM - fm) < WGM ? (nM - fm) : WGM;
        u.pm = fm + ((wgid % nig) % gsz); u.pn = (wgid % nig) / gsz; u.e = 0; u.nvalid = 256; u.slot0 = 0; u.va[0][0] = 0u; u.va[0][1] = 0u; u.va[1][0] = 0u; u.va[1][1] = 0u;
        u.A0 = A + (size_t)u.pm * BM * lda * 2; u.A1 = u.A0 + (size_t)HALF * lda * 2;
        u.B0 = Bt + (size_t)u.pn * BM * K * 2; u.B1 = u.B0 + (size_t)HALF * K * 2;
        return true;
    }
};
template <int MODE> struct MoeSched {
    static constexpr int NPN = MODE == 1 ? 4 : 8;
    static constexpr bool GATHER = MODE == 1;
    int G, c; const LAS int* tb; const int* cnt; const int* list; const char* A; const char* W; unsigned va[2];
    __device__ __forceinline__ void init(int G_, int c_, const LAS int* tb_, const int* cnt_, const int* list_, const void* A_, const void* W_) {
        G = G_; c = c_; tb = tb_; cnt = cnt_; list = list_; A = (const char*)A_; W = (const char*)W_;
#pragma unroll
        for (int i = 0; i < 2; ++i) { int R, C; stage_rc((int)ltid() * 16 + i * 8192, R, C); va[i] = (unsigned)(R * FF + C) * 2u; }
    }
    __device__ __forceinline__ bool next(int i, Unit& u) const {
        const int L = i * G + c, ntile = __builtin_amdgcn_readfirstlane(tb[NE]); if (L >= ntile * NPN) return false;
        const int tl = L / NPN, pn = L % NPN; int e = 0;
        while (e < NE - 1 && __builtin_amdgcn_readfirstlane(tb[e + 1]) <= tl) ++e;
        const int pm = tl - __builtin_amdgcn_readfirstlane(tb[e]), ne = __builtin_amdgcn_readfirstlane(cnt[e]);
        u.pm = pm; u.pn = pn; u.e = e; u.nvalid = ne - pm * 256; u.slot0 = tl * 256;
        if (MODE == 1) {
            u.A0 = A; u.A1 = A;
#pragma unroll
            for (int h = 0; h < 2; ++h)
#pragma unroll
                for (int k = 0; k < 2; ++k) { int Rk, Ck; stage_rc((int)ltid() * 16 + k * 8192, Rk, Ck); int idx = pm * 256 + h * 128 + Rk; idx = idx < ne ? idx : ne - 1; const int entry = list[e * 8192 + idx]; u.va[h][k] = (unsigned)(entry >> 1) * (unsigned)(D * 2) + (unsigned)Ck * 2u; }
            const char* we = W + (size_t)e * 1024 * D * 2;
            u.B0 = we + (size_t)(pn * 128) * D * 2; u.B1 = we + (size_t)(512 + pn * 128) * D * 2;
        } else {
            u.va[0][0] = 0u; u.va[0][1] = 0u; u.va[1][0] = 0u; u.va[1][1] = 0u;
            u.A0 = A + (size_t)tl * 256 * FF * 2; u.A1 = u.A0 + (size_t)HALF * FF * 2;
            const char* we = W + (size_t)e * D * FF * 2;
            u.B0 = we + (size_t)(pn * 256) * FF * 2; u.B1 = u.B0 + (size_t)HALF * FF * 2;
        }
        return true;
    }
};

struct EpiBf16 {
    static constexpr bool PERM = true;
    bf16* O; int ldc;
    __device__ __forceinline__ void operator()(const f32x4 (&acc)[2][2][4][2], const Unit& u, int wr, int wc, int fr, int fq) const {
        const int row0 = u.pm * BM + wr * 64 + fr, col0 = u.pn * BM + wc * 32 + 8 * fq;
#pragma unroll
        for (int ai = 0; ai < 2; ++ai)
#pragma unroll
            for (int m = 0; m < 4; ++m) { bf16* rowp = O + (size_t)(row0 + ai * HALF + m * 16) * ldc + col0;
#pragma unroll
                for (int bj = 0; bj < 2; ++bj) { const f32x4 v0 = acc[ai][bj][m][0], v1 = acc[ai][bj][m][1];
                    u32x4 w; w.x = cvt_pk_bf16(v0[0], v0[1]); w.y = cvt_pk_bf16(v0[2], v0[3]); w.z = cvt_pk_bf16(v1[0], v1[1]); w.w = cvt_pk_bf16(v1[2], v1[3]);
                    *(u32x4*)(rowp + bj * HALF) = w; } }
    }
};
struct EpiResF32 {
    static constexpr bool PERM = false;
    const float* R; float* O; int ldc;
    __device__ __forceinline__ void operator()(const f32x4 (&acc)[2][2][4][2], const Unit& u, int wr, int wc, int fr, int fq) const {
        const int row0 = u.pm * BM + wr * 64 + fr, col0 = u.pn * BM + wc * 32 + 4 * fq;
#pragma unroll
        for (int ai = 0; ai < 2; ++ai)
#pragma unroll
            for (int m = 0; m < 4; ++m) { const size_t off = (size_t)(row0 + ai * HALF + m * 16) * ldc + col0;
#pragma unroll
                for (int bj = 0; bj < 2; ++bj)
#pragma unroll
                    for (int n = 0; n < 2; ++n) { const f32x4 r = *(const f32x4*)(R + off + bj * HALF + n * 16); *(f32x4*)(O + off + bj * HALF + n * 16) = acc[ai][bj][m][n] + r; } }
    }
};
struct EpiMoe1 {
    static constexpr bool PERM = true;
    bf16* ACT; const int* list; const float* ew;
    __device__ __forceinline__ void operator()(const f32x4 (&acc)[2][2][4][2], const Unit& u, int wr, int wc, int fr, int fq) const {
        const int col0 = u.pn * 128 + wc * 32 + 8 * fq;
#pragma unroll
        for (int ai = 0; ai < 2; ++ai)
#pragma unroll
            for (int m = 0; m < 4; ++m) { const int r = ai * HALF + wr * 64 + m * 16 + fr; float w = 0.f;
                if (r < u.nvalid) { const int entry = list[u.e * 8192 + u.pm * 256 + r]; w = ew[entry]; }
                float o[8];
#pragma unroll
                for (int n = 0; n < 2; ++n)
#pragma unroll
                    for (int j = 0; j < 4; ++j) { const float g = acc[ai][0][m][n][j], up = acc[ai][1][m][n][j]; o[n * 4 + j] = g / (1.0f + __expf(-g)) * up * w; }
                u32x4 pk; pk.x = cvt_pk_bf16(o[0], o[1]); pk.y = cvt_pk_bf16(o[2], o[3]); pk.z = cvt_pk_bf16(o[4], o[5]); pk.w = cvt_pk_bf16(o[6], o[7]);
                *(u32x4*)(ACT + (size_t)(u.slot0 + r) * FF + col0) = pk; }
    }
};
struct EpiMoe2 {
    static constexpr bool PERM = true;
    bf16* CO; const int* list;
    __device__ __forceinline__ void operator()(const f32x4 (&acc)[2][2][4][2], const Unit& u, int wr, int wc, int fr, int fq) const {
        const int col0 = u.pn * BM + wc * 32 + 8 * fq;
#pragma unroll
        for (int ai = 0; ai < 2; ++ai)
#pragma unroll
            for (int m = 0; m < 4; ++m) { const int r = ai * HALF + wr * 64 + m * 16 + fr;
                if (r < u.nvalid) { const int entry = list[u.e * 8192 + u.pm * 256 + r]; bf16* rowp = CO + (size_t)entry * D + col0;
#pragma unroll
                    for (int bj = 0; bj < 2; ++bj) { const f32x4 v0 = acc[ai][bj][m][0], v1 = acc[ai][bj][m][1];
                        u32x4 w; w.x = cvt_pk_bf16(v0[0], v0[1]); w.y = cvt_pk_bf16(v0[2], v0[3]); w.z = cvt_pk_bf16(v1[0], v1[1]); w.w = cvt_pk_bf16(v1[2], v1[3]);
                        *(u32x4*)(rowp + bj * HALF) = w; } } }
    }
};
}

struct Frame {
    LAS unsigned char* lds; volatile LAS unsigned* MISC;
    int tid, lane, wave, vcu, G, gw, NGW, bid;
};
struct Args { const GAS float* in[22]; GAS float* out; GAS unsigned char* ws; int ph_lo, ph_hi, li, pad; };
typedef const __attribute__((address_space(4))) Args KArgs;
__device__ __forceinline__ KArgs* ka_fresh() { unsigned long long p = (unsigned long long)__builtin_amdgcn_kernarg_segment_ptr(); asm volatile("" : "+s"(p)); return (KArgs*)p; }
#define KA KArgs* const ka = ka_fresh()
#define KIN(i) ((const float*)ka->in[i])
#define KWS ((unsigned char*)ka->ws)
#define KOUT ((float*)ka->out)
enum { I_X = 0, I_NMIX, I_WIN, I_PE, I_W1, I_W2, I_QN, I_KN, I_LB, I_HGN, I_WA2, I_BA, I_GLAN, I_WBR, I_WOUT, I_NFFN, I_WGRP, I_BGRP, I_WEXP, I_BEXP, I_WGU, I_WDN };

__device__ __forceinline__ void tr_item(const float* W, size_t ldw, int c0, int nv, bf16* WT, size_t ldt, int r0, int k0, LAS float* scr, int lane) {
    const int nn = lane & 31;
#pragma unroll 8
    for (int i = 0; i < 32; ++i) { const int kk = 2 * i + (lane >> 5); scr[kk * 33 + nn] = nn < nv ? W[(size_t)(k0 + kk) * ldw + c0 + nn] : 0.f; }
    LDS_WAIT();
    const int c = lane & 7;
#pragma unroll
    for (int j = 0; j < 4; ++j) { const int n = (lane >> 3) + 8 * j; const LAS float* s = scr + (8 * c) * 33 + n;
        u32x4 o; o.x = pk2(s[0 * 33], s[1 * 33]); o.y = pk2(s[2 * 33], s[3 * 33]); o.z = pk2(s[4 * 33], s[5 * 33]); o.w = pk2(s[6 * 33], s[7 * 33]);
        if (n < nv) *(u32x4*)(WT + (size_t)(r0 + n) * ldt + k0 + 8 * c) = o; }
    LDS_WAIT();
}
__device__ __forceinline__ void phase_prologue(Frame& F) {
    KA;
    { float* WRT = (float*)(KWS + WS_WRT);
      for (int i = F.bid * 512 + F.tid; i < NL * 48 * D; i += F.G * 512) { const int l = i / (48 * D), n = (i / D) % 48, k = i % D; const float g = KIN(I_NFFN)[l * D + k];
          WRT[i] = n < 32 ? g * KIN(I_WEXP)[((size_t)l * D + k) * 32 + n] : (n < 36 ? g * KIN(I_WGRP)[((size_t)l * D + k) * 4 + (n - 32)] : 0.f); } }
    LAS float* scr = (LAS float*)(F.lds + F.wave * 16384);
    constexpr int IT_WIN = 32 * 346, IT_WBR = 3 * 8 * 64, IT_WOUT = 32 * 64, IT_WGU = 32 * 32 * 32, IT_WDN = 32 * 8 * 64, IT_L = IT_WIN + IT_WBR + IT_WOUT + IT_WGU + IT_WDN;
    for (int it = F.gw; it < NL * IT_L; it += F.NGW) {
        const int l = it / IT_L; int r = it % IT_L;
        if (r < IT_WIN) { const int kb = r / 346, nb = r % 346; int src, dst, nv = 32;
            if (nb < 40) { src = nb * 32; dst = nb * 32; }
            else if (nb == 40) { src = 1280; dst = C_NG; nv = 24; }
            else if (nb < 153) { src = 1304 + 32 * (nb - 41); dst = 1280 + 32 * (nb - 41); }
            else if (nb == 153) { src = 4888; dst = C_GA; nv = 16; }
            else { src = 4904 + 32 * (nb - 154); dst = C_MG + 32 * (nb - 154); }
            tr_item(KIN(I_WIN) + (size_t)l * D * INC, INC, src, nv, (bf16*)(KWS + WS_WIN) + (size_t)l * NPAD * D, D, dst, kb * 64, scr, F.lane); continue; }
        r -= IT_WIN;
        if (r < IT_WBR) { const int n = r / 512, q = r % 512, kb = q / 64, nb = q % 64;
            tr_item(KIN(I_WBR) + ((size_t)l * 3 + n) * 512 * D, D, nb * 32, 32, (bf16*)(KWS + WS_WBR) + ((size_t)l * 3 + n) * D * 512, 512, nb * 32, kb * 64, scr, F.lane); continue; }
        r -= IT_WBR;
        if (r < IT_WOUT) { const int kb = r / 64, nb = r % 64;
            tr_item(KIN(I_WOUT) + (size_t)l * D * D, D, nb * 32, 32, (bf16*)(KWS + WS_WOUT) + (size_t)l * D * D, D, nb * 32, kb * 64, scr, F.lane); continue; }
        r -= IT_WOUT;
        if (r < IT_WGU) { const int e = r / 1024, q = r % 1024, kb = q / 32, nb = q % 32;
            tr_item(KIN(I_WGU) + ((size_t)l * NE + e) * D * 1024, 1024, nb * 32, 32, (bf16*)(KWS + WS_WGU) + ((size_t)l * NE + e) * 1024 * D, D, nb * 32, kb * 64, scr, F.lane); continue; }
        r -= IT_WGU;
        { const int e = r / 512, q = r % 512, kb = q / 64, nb = q % 64;
            tr_item(KIN(I_WDN) + ((size_t)l * NE + e) * FF * D, D, nb * 32, 32, (bf16*)(KWS + WS_WDN) + ((size_t)l * NE + e) * D * FF, FF, nb * 32, kb * 64, scr, F.lane); }
    }
}

template <int MODE> __device__ __forceinline__ void phase_norm1(Frame& F, const float* xin, const bf16* contrib, float* xout, const float* gain, bf16* H) {
    for (int t = F.gw; t < T; t += F.NGW) {
        const f32x4* xr = (const f32x4*)(xin + (size_t)t * D) + F.lane;
        f32x4 v[8]; float ss = 0.f;
#pragma unroll
        for (int j = 0; j < 8; ++j) { v[j] = xr[64 * j];
            if (MODE != 0) { const u32x2 c0 = *((const u32x2*)(contrib + (size_t)(2 * t) * D) + F.lane + 64 * j), c1 = *((const u32x2*)(contrib + (size_t)(2 * t + 1) * D) + F.lane + 64 * j);
                v[j].x += bflo(c0.x) + bflo(c1.x); v[j].y += bfhi(c0.x) + bfhi(c1.x); v[j].z += bflo(c0.y) + bflo(c1.y); v[j].w += bfhi(c0.y) + bfhi(c1.y);
                *((f32x4*)(xout + (size_t)t * D) + F.lane + 64 * j) = v[j]; }
            ss += v[j].x * v[j].x + v[j].y * v[j].y + v[j].z * v[j].z + v[j].w * v[j].w; }
        if (MODE != 2) {
            const float rstd = 1.0f / sqrtf(wave_sum(ss) * (1.0f / D) + EPS);
#pragma unroll
            for (int j = 0; j < 8; ++j) { const f32x4 g = *((const f32x4*)gain + F.lane + 64 * j);
                u32x2 o; o.x = pk2(v[j].x * rstd * g.x, v[j].y * rstd * g.y); o.y = pk2(v[j].z * rstd * g.z, v[j].w * rstd * g.w);
                *((u32x2*)(H + (size_t)t * D) + F.lane + 64 * j) = o; }
        }
    }
}

__device__ __forceinline__ void phase_prep(Frame& F, int l) {
    KA;
    const bf16* P = (const bf16*)(KWS + WS_P);
    float* QN = (float*)(KWS + WS_QN); float* KV = (float*)(KWS + WS_KV);
    const float* qg = KIN(I_QN) + l * 64; const float* kg = KIN(I_KN) + l * 192;
    for (int it = F.gw; it < T * 20; it += F.NGW) {
        const int t = it / 20, v = it % 20;
        float x = bf2f(P[(size_t)t * NPAD + v * 64 + F.lane]);
        const bool isq = v < 8, nk1 = (v == 12 || v == 13), nk2 = (v == 16 || v == 17);
        if (isq || nk1 || nk2) { const float ss = wave_sum(x * x); const float g = isq ? qg[F.lane] : (nk1 ? kg[64 + F.lane] : kg[128 + F.lane]); x = x * (1.0f / sqrtf(ss * (1.0f / 64.0f) + EPS)) * g; }
        if (isq) QN[((size_t)v * T + t) * 64 + F.lane] = x;
        else { const int w = v - 8, tens = w >> 1, g = w & 1; KV[(size_t)tens * KV_STRIDE + ((size_t)g * T + t) * 64 + F.lane] = x; }
    }
}
__device__ __forceinline__ float gelu_tanh(float x) { const float u = 0.7978845608028654f * (x + 0.044715f * x * x * x); return 0.5f * x * (1.0f + tanhf(u)); }
__device__ __forceinline__ void phase_compress(Frame& F, int l) {
    KA;
    LAS float* av = (LAS float*)(F.lds + F.wave * 16384);
    const float* KV = (const float*)(KWS + WS_KV); float* KC = (float*)(KWS + WS_KC);
    for (int it = F.gw; it < 2 * 2 * 511; it += F.NGW) {
        const int kind = it / 1022, q = it % 1022, g = q / 511, n = q % 511;
        const float* src = KV + (size_t)kind * KV_STRIDE + ((size_t)g * T + 16 * n) * 64;
        const float* pe = KIN(I_PE) + ((size_t)l * 2 + kind) * 2048;
        const float* w1 = KIN(I_W1) + ((size_t)l * 2 + kind) * 2048 * 64;
        const float* w2 = KIN(I_W2) + ((size_t)l * 2 + kind) * 64 * 64;
#pragma unroll 4
        for (int c = 0; c < 32; ++c) av[c * 64 + F.lane] = src[c * 64 + F.lane] + pe[c * 64 + F.lane];
        WSYNC();
        float acc = 0.f;
#pragma unroll 8
        for (int i = 0; i < 2048; ++i) acc += av[i] * w1[i * 64 + F.lane];
        const float hid = gelu_tanh(acc);
        WSYNC();
        av[F.lane] = hid;
        WSYNC();
        float o = 0.f;
#pragma unroll 8
        for (int i = 0; i < 64; ++i) o += av[i] * w2[i * 64 + F.lane];
        WSYNC();
        if (kind == 0) { const float ss = wave_sum(o * o); o = o * (1.0f / sqrtf(ss * (1.0f / 64.0f) + EPS)) * KIN(I_KN)[l * 192 + F.lane]; }
        KC[(size_t)kind * (2 * 512 * 64) + ((size_t)g * 512 + n) * 64 + F.lane] = o;
    }
}
__device__ __forceinline__ void phase_recur(Frame& F, int l) {
    KA;
    const bf16* P = (const bf16*)(KWS + WS_P); float* ORAW = (float*)(KWS + WS_ORAW);
    for (int it = F.gw; it < 1024; it += F.NGW) {
        const int kind = it >> 9, head = (it >> 7) & 3, j = it & 127;
        if (kind == 0) {
            const int d0 = F.lane, d1 = F.lane + 64;
            const float* lbl = KIN(I_LB);
            float lb0, lb1;
            { const float a0 = lbl[head * 128 + d0], b0 = lbl[512 + head * 128 + d0], a1 = lbl[head * 128 + d1], b1 = lbl[512 + head * 128 + d1];
              lb0 = l == 0 ? 0.f : 1.0f / (1.0f + expf(a0 - b0)); lb1 = l == 0 ? 0.f : 1.0f / (1.0f + expf(a1 - b1)); }
            const bf16* Pq = P + C_HQ + head * 128; const bf16* Pf = P + C_HF + head * 128; const bf16* Pi = P + C_HI + head * 128 + j;
            float S0 = 0.f, S1 = 0.f;
            for (int t0 = 0; t0 < T; t0 += 8) {
                bf16 zq0[8], zq1[8], zf0[8], zf1[8], vi[8];
#pragma unroll
                for (int u = 0; u < 8; ++u) { const size_t row = (size_t)(t0 + u) * NPAD; zq0[u] = Pq[row + d0]; zq1[u] = Pq[row + d1]; zf0[u] = Pf[row + d0]; zf1[u] = Pf[row + d1]; vi[u] = Pi[row]; }
                float part[8];
#pragma unroll
                for (int u = 0; u < 8; ++u) { const float v = bf2f(vi[u]);
                    const float s0 = sigmoidf_(bf2f(zf0[u])), s1 = sigmoidf_(bf2f(zf1[u]));
                    const float f0 = lb0 + (1.0f - lb0) * s0, f1 = lb1 + (1.0f - lb1) * s1;
                    const float k0 = (1.0f - lb0) * (1.0f - s0), k1 = (1.0f - lb1) * (1.0f - s1);
                    S0 = f0 * S0 + k0 * v; S1 = f1 * S1 + k1 * v;
                    part[u] = bf2f(zq0[u]) * S0 + bf2f(zq1[u]) * S1; }
                float mine = 0.f;
#pragma unroll
                for (int u = 0; u < 8; ++u) { const float s = wave_sum(part[u]); mine = (F.lane == u) ? s : mine; }
                if (F.lane < 8) ORAW[(size_t)(t0 + F.lane) * 1024 + head * 128 + j] = mine;
            }
        } else {
            const int d = F.lane, c = head * 64 + d;
            float wa[16];
#pragma unroll
            for (int r = 0; r < 16; ++r) wa[r] = KIN(I_WA2)[((size_t)l * 16 + r) * 256 + c];
            const float ba = KIN(I_BA)[l * 256 + c];
            const bf16* Pq = P + C_GQ + c; const bf16* Pk = P + C_GK + c; const bf16* Pv = P + C_GV + head * 128 + j; const bf16* Pa = P + C_GA;
            float S = 0.f;
            for (int t0 = 0; t0 < T; t0 += 8) {
                bf16 zq[8], zk[8], zv[8]; u32x4 ga0[8], ga1[8];
#pragma unroll
                for (int u = 0; u < 8; ++u) { const size_t row = (size_t)(t0 + u) * NPAD; zq[u] = Pq[row]; zk[u] = Pk[row]; zv[u] = Pv[row]; ga0[u] = *(const u32x4*)(Pa + row); ga1[u] = *(const u32x4*)(Pa + row + 8); }
                float part[8];
#pragma unroll
                for (int u = 0; u < 8; ++u) {
                    float a = ba;
                    a += bflo(ga0[u].x) * wa[0] + bfhi(ga0[u].x) * wa[1] + bflo(ga0[u].y) * wa[2] + bfhi(ga0[u].y) * wa[3] + bflo(ga0[u].z) * wa[4] + bfhi(ga0[u].z) * wa[5] + bflo(ga0[u].w) * wa[6] + bfhi(ga0[u].w) * wa[7];
                    a += bflo(ga1[u].x) * wa[8] + bfhi(ga1[u].x) * wa[9] + bflo(ga1[u].y) * wa[10] + bfhi(ga1[u].y) * wa[11] + bflo(ga1[u].z) * wa[12] + bfhi(ga1[u].z) * wa[13] + bflo(ga1[u].w) * wa[14] + bfhi(ga1[u].w) * wa[15];
                    const float ls = fminf(a, 0.f) - log1pf(expf(-fabsf(a)));
                    const float f = expf(ls * (1.0f / 16.0f));
                    S = f * S + bf2f(zk[u]) * bf2f(zv[u]);
                    part[u] = bf2f(zq[u]) * 0.125f * S; }
                float mine = 0.f;
#pragma unroll
                for (int u = 0; u < 8; ++u) { const float s = wave_sum(part[u]); mine = (F.lane == u) ? s : mine; }
                if (F.lane < 8) ORAW[(size_t)(t0 + F.lane) * 1024 + 512 + head * 128 + j] = mine;
            }
        }
    }
}
__device__ __forceinline__ void phase_recur_out(Frame& F, int l) {
    KA;
    const bf16* P = (const bf16*)(KWS + WS_P); const float* ORAW = (const float*)(KWS + WS_ORAW); bf16* OCAT = (bf16*)(KWS + WS_OCAT);
    for (int it = F.gw; it < T * 8; it += F.NGW) {
        const int t = it >> 3, kind = (it >> 2) & 1, head = it & 3;
        const float* gn = (kind == 0 ? KIN(I_HGN) : KIN(I_GLAN)) + l * 128;
        const int cg = (kind == 0 ? C_HG : C_GR) + head * 128;
        const float r0 = ORAW[(size_t)t * 1024 + kind * 512 + head * 128 + F.lane], r1 = ORAW[(size_t)t * 1024 + kind * 512 + head * 128 + 64 + F.lane];
        const float rstd = 1.0f / sqrtf(wave_sum(r0 * r0 + r1 * r1) * (1.0f / 128.0f) + EPS);
        const float g0 = bf2f(P[(size_t)t * NPAD + cg + F.lane]), g1 = bf2f(P[(size_t)t * NPAD + cg + 64 + F.lane]);
        const float a0 = kind == 0 ? sigmoidf_(g0) : g0 * sigmoidf_(g0), a1 = kind == 0 ? sigmoidf_(g1) : g1 * sigmoidf_(g1);
        OCAT[(size_t)t * 1536 + 512 + kind * 512 + head * 128 + F.lane] = (bf16)f2bf(r0 * rstd * gn[F.lane] * a0);
        OCAT[(size_t)t * 1536 + 512 + kind * 512 + head * 128 + 64 + F.lane] = (bf16)f2bf(r1 * rstd * gn[64 + F.lane] * a1);
    }
}


template <int KIND> struct RecCfg { static constexpr int DK = KIND == 0 ? 128 : 64, NSEG = 512 / DK, TPS = 64 / NSEG, QROW = (DK + 8) * 2; };
constexpr int REC_VT_OFF = 0;
constexpr int REC_KD_OFF = 18432;
constexpr int REC_QS_OFF = 36864;
constexpr int REC_KS_OFF = 54272;
constexpr int REC_QD_OFF = 71680;
constexpr int REC_RED_OFF = 89088;
constexpr int REC_TOT_OFF = 91136;
__device__ __forceinline__ float expc(float x) { return __expf(fminf(x, 80.0f)); }
template <int KIND> __device__ __forceinline__ void rec_elem(KArgs* ka, int l, int head, int chunk, int tid, LAS float* tot,
        float (&qv)[RecCfg<KIND>::TPS], float (&kv)[RecCfg<KIND>::TPS], float (&bv)[RecCfg<KIND>::TPS], float& bend, float& bref) {
    constexpr int DK = RecCfg<KIND>::DK, NSEG = RecCfg<KIND>::NSEG, TPS = RecCfg<KIND>::TPS;
    const int d = tid % DK, seg = tid / DK, t0 = chunk * 64 + seg * TPS;
    const bf16* P = (const bf16*)(KWS + WS_P);
    float run = 0.f;
    if (KIND == 0) {
        const int c = head * 128 + d;
        float lb = 0.f;
        if (l > 0) { const float a0 = KIN(I_LB)[c], b0 = KIN(I_LB)[512 + c]; lb = 1.0f / (1.0f + expf(a0 - b0)); }
#pragma unroll
        for (int u = 0; u < TPS; ++u) { const size_t row = (size_t)(t0 + u) * NPAD;
            const float z = bf2f(P[row + C_HF + c]); qv[u] = bf2f(P[row + C_HQ + c]);
            const float sg = 1.0f / (1.0f + __expf(-z)), f = lb + (1.0f - lb) * sg;
            kv[u] = (1.0f - lb) * (1.0f - sg); run += __logf(fmaxf(f, 1e-30f)); bv[u] = run; }
    } else {
        const int c = head * 64 + d;
        float wa[16];
#pragma unroll
        for (int r = 0; r < 16; ++r) wa[r] = KIN(I_WA2)[((size_t)l * 16 + r) * 256 + c];
        const float ba = KIN(I_BA)[l * 256 + c];
#pragma unroll
        for (int u = 0; u < TPS; ++u) { const size_t row = (size_t)(t0 + u) * NPAD;
            const u32x4 g0 = *(const u32x4*)(P + row + C_GA), g1 = *(const u32x4*)(P + row + C_GA + 8);
            float a = ba;
            a += bflo(g0.x) * wa[0] + bfhi(g0.x) * wa[1] + bflo(g0.y) * wa[2] + bfhi(g0.y) * wa[3] + bflo(g0.z) * wa[4] + bfhi(g0.z) * wa[5] + bflo(g0.w) * wa[6] + bfhi(g0.w) * wa[7];
            a += bflo(g1.x) * wa[8] + bfhi(g1.x) * wa[9] + bflo(g1.y) * wa[10] + bfhi(g1.y) * wa[11] + bflo(g1.z) * wa[12] + bfhi(g1.z) * wa[13] + bflo(g1.w) * wa[14] + bfhi(g1.w) * wa[15];
            const float ls = fminf(a, 0.f) - log1pf(__expf(-fabsf(a)));
            qv[u] = bf2f(P[row + C_GQ + c]) * 0.125f; kv[u] = bf2f(P[row + C_GK + c]);
            run += ls * (1.0f / 16.0f); bv[u] = run; }
    }
    tot[seg * DK + d] = run;
    __syncthreads();
    float off = 0.f; bend = 0.f; bref = 0.f;
#pragma unroll
    for (int sgi = 0; sgi < NSEG; ++sgi) { const float v = tot[sgi * DK + d]; off += sgi < seg ? v : 0.f; bref += sgi < NSEG / 2 ? v : 0.f; bend += v; }
#pragma unroll
    for (int u = 0; u < TPS; ++u) bv[u] += off;
}
template <int KIND> __device__ __forceinline__ void rec_vt(KArgs* ka, int head, int chunk, int tid, LAS unsigned char* lds) {
    const bf16* P = (const bf16*)(KWS + WS_P) + (KIND == 0 ? C_HI : C_GV) + head * 128;
    const int v = tid & 127, sv = tid >> 7; unsigned w[8];
#pragma unroll
    for (int u = 0; u < 8; ++u) { const unsigned a = P[(size_t)(chunk * 64 + sv * 16 + 2 * u) * NPAD + v], b = P[(size_t)(chunk * 64 + sv * 16 + 2 * u + 1) * NPAD + v]; w[u] = a | (b << 16); }
    LAS u32x4* dst = (LAS u32x4*)(lds + REC_VT_OFF + v * 144 + sv * 32);
    dst[0] = (u32x4){w[0], w[1], w[2], w[3]}; dst[1] = (u32x4){w[4], w[5], w[6], w[7]};
}
template <int KIND> __device__ __forceinline__ void rec_local_unit(KArgs* ka, Frame& F, int l, int head, int chunk) {
    constexpr int DK = RecCfg<KIND>::DK, TPS = RecCfg<KIND>::TPS;
    LAS unsigned char* lds = F.lds; LAS float* tot = (LAS float*)(lds + REC_TOT_OFF);
    float qv[TPS], kv[TPS], bv[TPS], bend, bref;
    rec_elem<KIND>(ka, l, head, chunk, F.tid, tot, qv, kv, bv, bend, bref);
    const int d = F.tid % DK, seg = F.tid / DK, unit = chunk * 4 + head;
    { unsigned w[TPS / 2];
#pragma unroll
      for (int u = 0; u < TPS / 2; ++u) w[u] = pk2(kv[2 * u] * expc(bend - bv[2 * u]), kv[2 * u + 1] * expc(bend - bv[2 * u + 1]));
      LAS u32x4* dst = (LAS u32x4*)(lds + REC_KD_OFF + d * 144 + seg * TPS * 2);
      dst[0] = (u32x4){w[0], w[1], w[2], w[3]};
      if constexpr (TPS == 16) dst[1] = (u32x4){w[4], w[5], w[6], w[7]}; }
    if (seg == 0) ((float*)(KWS + WS_DEC + (KIND == 0 ? 0 : 262144)))[(size_t)unit * DK + d] = __expf(bend);
    rec_vt<KIND>(ka, head, chunk, F.tid, lds);
    __syncthreads();
    const int r = F.lane & 15, kq = F.lane >> 4;
    const int dt = KIND == 0 ? F.wave : (F.wave & 3), vt0 = KIND == 0 ? 0 : (F.wave >> 2) * 4, nvt = KIND == 0 ? 8 : 4;
    bf16x8 a[2];
#pragma unroll
    for (int ks = 0; ks < 2; ++ks) a[ks] = *(const LAS bf16x8*)(lds + REC_KD_OFF + (16 * dt + r) * 144 + (32 * ks + 8 * kq) * 2);
    float* Sl = (float*)(KWS + (KIND == 0 ? WS_SLOC_HG : WS_SLOC_GL)) + (size_t)unit * 128 * DK;
#pragma unroll
    for (int vi = 0; vi < nvt; ++vi) { const int vt = vt0 + vi; f32x4 acc = {0.f, 0.f, 0.f, 0.f};
#pragma unroll
        for (int ks = 0; ks < 2; ++ks) { const bf16x8 b = *(const LAS bf16x8*)(lds + REC_VT_OFF + (16 * vt + r) * 144 + (32 * ks + 8 * kq) * 2); acc = __builtin_amdgcn_mfma_f32_16x16x32_bf16(a[ks], b, acc, 0, 0, 0); }
        *(f32x4*)(Sl + (size_t)(16 * vt + r) * DK + 16 * dt + 4 * kq) = acc; }
    __syncthreads();
}
__device__ __forceinline__ void phase_rec_local(Frame& F, int l) {
    KA;
    for (int it = F.bid; it < 1024; it += F.G) { const int kind = it >> 9, chunk = (it >> 2) & 127, head = it & 3;
        if (kind == 0) rec_local_unit<0>(ka, F, l, head, chunk); else rec_local_unit<1>(ka, F, l, head, chunk); }
}
__device__ __forceinline__ void phase_rec_scan(Frame& F) {
    KA;
    const int gt = F.bid * 512 + F.tid;
    if (gt >= 49152) return;
    const bool hg = gt < 32768; const int q = hg ? gt : gt - 32768;
    const int DK = hg ? 128 : 64, dp = q % (DK / 2), v = (q / (DK / 2)) & 127, head = q / (DK / 2 * 128);
    const float* Sl = (const float*)(KWS + (hg ? WS_SLOC_HG : WS_SLOC_GL)) + ((size_t)head * 128 + v) * DK + 2 * dp;
    bf16* Sp = (bf16*)(KWS + (hg ? WS_SPREV_HG : WS_SPREV_GL)) + ((size_t)head * 128 + v) * DK + 2 * dp;
    const float* De = (const float*)(KWS + WS_DEC + (hg ? 0 : 262144)) + (size_t)head * DK + 2 * dp;
    const size_t ustr = (size_t)4 * 128 * DK, dstr = (size_t)4 * DK;
    float s0 = 0.f, s1 = 0.f;
    for (int c0 = 0; c0 < NCH; c0 += 8) { f32x2 x[8], dc[8];
#pragma unroll
        for (int u = 0; u < 8; ++u) { x[u] = *(const f32x2*)(Sl + (size_t)(c0 + u) * ustr); dc[u] = *(const f32x2*)(De + (size_t)(c0 + u) * dstr); }
#pragma unroll
        for (int u = 0; u < 8; ++u) { *(unsigned*)(Sp + (size_t)(c0 + u) * ustr) = pk2(s0, s1); s0 = dc[u].x * s0 + x[u].x; s1 = dc[u].y * s1 + x[u].y; } }
}
template <int KIND> __device__ __forceinline__ void rec_out_unit(KArgs* ka, Frame& F, int l, int head, int chunk) {
    constexpr int DK = RecCfg<KIND>::DK, TPS = RecCfg<KIND>::TPS, QROW = RecCfg<KIND>::QROW, NKS = DK / 32;
    LAS unsigned char* lds = F.lds; LAS float* tot = (LAS float*)(lds + REC_TOT_OFF); LAS float* red = (LAS float*)(lds + REC_RED_OFF);
    const int r = F.lane & 15, kq = F.lane >> 4, unit = chunk * 4 + head, vt = F.wave;
    bf16x8 sa[NKS];
    { const bf16* Sp = (const bf16*)(KWS + (KIND == 0 ? WS_SPREV_HG : WS_SPREV_GL)) + (size_t)unit * 128 * DK + (size_t)(16 * vt + r) * DK + 8 * kq;
#pragma unroll
      for (int ks = 0; ks < NKS; ++ks) sa[ks] = *(const bf16x8*)(Sp + 32 * ks); }
    float qv[TPS], kv[TPS], bv[TPS], bend, bref;
    rec_elem<KIND>(ka, l, head, chunk, F.tid, tot, qv, kv, bv, bend, bref);
    { const int d = F.tid % DK, seg = F.tid / DK;
#pragma unroll
      for (int u = 0; u < TPS; ++u) { const int tok = seg * TPS + u; const int o = tok * QROW + d * 2;
          *(LAS bf16*)(lds + REC_QS_OFF + o) = (bf16)f2bf(qv[u] * expc(bv[u] - bref));
          *(LAS bf16*)(lds + REC_KS_OFF + o) = (bf16)f2bf(kv[u] * expc(bref - bv[u]));
          *(LAS bf16*)(lds + REC_QD_OFF + o) = (bf16)f2bf(qv[u] * __expf(bv[u])); } }
    rec_vt<KIND>(ka, head, chunk, F.tid, lds);
    __syncthreads();
#pragma unroll
    for (int tt = 0; tt < 2; ++tt) { const int tile = F.wave * 2 + tt, jt = tile >> 2, it = tile & 3; f32x4 acc = {0.f, 0.f, 0.f, 0.f};
        if (jt <= it) {
#pragma unroll
            for (int ks = 0; ks < NKS; ++ks) { const bf16x8 a = *(const LAS bf16x8*)(lds + REC_KS_OFF + (16 * jt + r) * QROW + (32 * ks + 8 * kq) * 2), b = *(const LAS bf16x8*)(lds + REC_QS_OFF + (16 * it + r) * QROW + (32 * ks + 8 * kq) * 2);
                acc = __builtin_amdgcn_mfma_f32_16x16x32_bf16(a, b, acc, 0, 0, 0); } }
        const int i = 16 * it + r, j0 = 16 * jt + 4 * kq;
        u32x2 w; w.x = pk2(j0 <= i ? acc[0] : 0.f, j0 + 1 <= i ? acc[1] : 0.f); w.y = pk2(j0 + 2 <= i ? acc[2] : 0.f, j0 + 3 <= i ? acc[3] : 0.f);
        *(LAS u32x2*)(lds + REC_KD_OFF + i * 144 + j0 * 2) = w; }
    __syncthreads();
    f32x4 acc[4];
#pragma unroll
    for (int it = 0; it < 4; ++it) acc[it] = (f32x4){0.f, 0.f, 0.f, 0.f};
#pragma unroll
    for (int ks = 0; ks < 2; ++ks) { const bf16x8 a = *(const LAS bf16x8*)(lds + REC_VT_OFF + (16 * vt + r) * 144 + (32 * ks + 8 * kq) * 2);
#pragma unroll
        for (int it = 0; it < 4; ++it) { const bf16x8 b = *(const LAS bf16x8*)(lds + REC_KD_OFF + (16 * it + r) * 144 + (32 * ks + 8 * kq) * 2); acc[it] = __builtin_amdgcn_mfma_f32_16x16x32_bf16(a, b, acc[it], 0, 0, 0); } }
#pragma unroll
    for (int ks = 0; ks < NKS; ++ks) {
#pragma unroll
        for (int it = 0; it < 4; ++it) { const bf16x8 b = *(const LAS bf16x8*)(lds + REC_QD_OFF + (16 * it + r) * QROW + (32 * ks + 8 * kq) * 2); acc[it] = __builtin_amdgcn_mfma_f32_16x16x32_bf16(sa[ks], b, acc[it], 0, 0, 0); } }
#pragma unroll
    for (int it = 0; it < 4; ++it) { float ss = acc[it][0] * acc[it][0] + acc[it][1] * acc[it][1] + acc[it][2] * acc[it][2] + acc[it][3] * acc[it][3];
        ss += __shfl_xor(ss, 16); ss += __shfl_xor(ss, 32);
        if (kq == 0) red[F.wave * 64 + 16 * it + r] = ss; }
    __syncthreads();
    const bf16* P = (const bf16*)(KWS + WS_P); bf16* OCAT = (bf16*)(KWS + WS_OCAT);
    const int v0 = 16 * vt + 4 * kq;
    const f32x4 gn = *(const f32x4*)((KIND == 0 ? KIN(I_HGN) : KIN(I_GLAN)) + l * 128 + v0);
#pragma unroll
    for (int it = 0; it < 4; ++it) { const int i = 16 * it + r, t = chunk * 64 + i; float tot_ = 0.f;
#pragma unroll
        for (int w = 0; w < 8; ++w) tot_ += red[w * 64 + i];
        const float rstd = 1.0f / sqrtf(tot_ * (1.0f / 128.0f) + EPS);
        const u32x2 gq = *(const u32x2*)(P + (size_t)t * NPAD + (KIND == 0 ? C_HG : C_GR) + head * 128 + v0);
        float gt[4] = {bflo(gq.x), bfhi(gq.x), bflo(gq.y), bfhi(gq.y)}, o[4];
#pragma unroll
        for (int e = 0; e < 4; ++e) { const float sg = 1.0f / (1.0f + __expf(-gt[e])); o[e] = acc[it][e] * rstd * gn[e] * (KIND == 0 ? sg : gt[e] * sg); }
        u32x2 w; w.x = pk2(o[0], o[1]); w.y = pk2(o[2], o[3]);
        *(u32x2*)(OCAT + (size_t)t * 1536 + 512 + KIND * 512 + head * 128 + v0) = w; }
    __syncthreads();
}
__device__ __forceinline__ void phase_rec_out(Frame& F, int l) {
    KA;
    for (int it = F.bid; it < 1024; it += F.G) { const int kind = it >> 9, chunk = (it >> 2) & 127, head = it & 3;
        if (kind == 0) rec_out_unit<0>(ka, F, l, head, chunk); else rec_out_unit<1>(ka, F, l, head, chunk); }
}

template <bool WIN> __device__ __forceinline__ void nsa_block(const float* Kg, const float* Vg, int j, int t, int lane, const LAS float* qs, LAS float* pb, const float (&slope)[4], float (&M)[4], float (&L)[4], float (&o)[4]) {
    const int pos = 64 * j + lane, dist = t - pos;
    const bool valid = WIN ? (dist >= 0 && dist < 512) : (dist >= 0);
    float dot[4] = {0.f, 0.f, 0.f, 0.f};
    const f32x4* kr = (const f32x4*)(Kg + (size_t)pos * 64);
#pragma unroll 2
    for (int c = 0; c < 16; ++c) { const f32x4 kv = kr[c];
#pragma unroll
        for (int r = 0; r < 4; ++r) { const f32x4 qv = *(const LAS f32x4*)(qs + r * 64 + c * 4); dot[r] += kv.x * qv.x + kv.y * qv.y + kv.z * qv.z + kv.w * qv.w; } }
#pragma unroll
    for (int r = 0; r < 4; ++r) {
        const float s = valid ? dot[r] * 0.125f - slope[r] * (float)dist : NEGB;
        const float nm = fmaxf(M[r], wave_max(s)), sc = expf(M[r] - nm), p = valid ? expf(s - nm) : 0.f;
        L[r] = L[r] * sc + wave_sum(p); o[r] *= sc; M[r] = nm; pb[r * 64 + lane] = p;
    }
    WSYNC();
#pragma unroll 4
    for (int k = 0; k < 64; ++k) { const float v = Vg[(size_t)(64 * j + k) * 64 + lane];
#pragma unroll
        for (int r = 0; r < 4; ++r) o[r] += pb[r * 64 + k] * v; }
    WSYNC();
}
__device__ __forceinline__ void phase_nsa(Frame& F, int l) {
    KA;
    LAS float* qs = (LAS float*)(F.lds + F.wave * 8192);
    LAS float* pbuf = qs + 256;
    LAS float* scb = pbuf + 512;
    LAS float* pb = scb + 128;
    LAS float* impb = pb + 256;
    LAS float* ocb = impb + 512;
    const bf16* P = (const bf16*)(KWS + WS_P); bf16* OCAT = (bf16*)(KWS + WS_OCAT);
    const float* QN = (const float*)(KWS + WS_QN); const float* KV = (const float*)(KWS + WS_KV); const float* KC = (const float*)(KWS + WS_KC);
    const int lane = F.lane;
    for (int it = F.gw; it < T * 2; it += F.NGW) {
        const int t = it >> 1, g = it & 1;
        float slope[4];
#pragma unroll
        for (int r = 0; r < 4; ++r) { slope[r] = exp2f(-(float)(g * 4 + r + 1)); qs[r * 64 + lane] = QN[((size_t)(g * 4 + r) * T + t) * 64 + lane]; }
        WSYNC();
        int nvis = t >= 31 ? (t - 31) / 16 + 1 : 0; nvis = nvis > 511 ? 511 : nvis;
        const float* KCg = KC + (size_t)g * 512 * 64; const float* VCg = KC + (size_t)(2 * 512 * 64) + (size_t)g * 512 * 64;
#pragma unroll 1
        for (int i = 0; i < 8; ++i) impb[lane + 64 * i] = 0.f;
#pragma unroll 1
        for (int r = 0; r < 4; ++r) {
            const float sl = exp2f(-(float)(g * 4 + r + 1));
            float mx = NEGB;
#pragma unroll 1
            for (int i = 0; i < 8; ++i) { const int n = lane + 64 * i; float sv = NEGB;
                if (n < nvis) { const f32x4* kr = (const f32x4*)(KCg + (size_t)n * 64); float dot = 0.f;
#pragma unroll 4
                    for (int c = 0; c < 16; ++c) { const f32x4 kv = kr[c]; const f32x4 qv = *(const LAS f32x4*)(qs + r * 64 + c * 4); dot += kv.x * qv.x + kv.y * qv.y + kv.z * qv.z + kv.w * qv.w; }
                    sv = dot * 0.125f - sl * (float)(t - 16 * n - 31); }
                pbuf[n] = sv; mx = fmaxf(mx, sv); }
            mx = wave_max(mx);
            float sum = 0.f;
#pragma unroll 1
            for (int i = 0; i < 8; ++i) { const int n = lane + 64 * i; const float e = n < nvis ? expf(pbuf[n] - mx) : 0.f; pbuf[n] = e; sum += e; }
            sum = wave_sum(sum);
            const float inv = nvis > 0 ? 1.0f / sum : 0.f;
#pragma unroll 1
            for (int i = 0; i < 8; ++i) { const int n = lane + 64 * i; const float p = pbuf[n] * inv; pbuf[n] = p; impb[n] += p; }
            WSYNC();
            float oc = 0.f;
#pragma unroll 4
            for (int n = 0; n < nvis; ++n) oc += pbuf[n] * VCg[(size_t)n * 64 + lane];
            ocb[r * 64 + lane] = oc;
            WSYNC();
        }
        const int cur = t >> 6;
        float sc2[2];
#pragma unroll
        for (int jj = 0; jj < 2; ++jj) { const int j = lane + 64 * jj;
            float v = (j > 0 ? impb[4 * j - 1] : 0.f) + 2.0f * (impb[4 * j] + impb[4 * j + 1] + impb[4 * j + 2]) + impb[4 * j + 3];
            if (j == 0 || j == cur || j == cur - 1) v = 1e4f;
            if (j > cur) v = -1.0f;
            sc2[jj] = v; scb[j] = v; }
        WSYNC();
        unsigned long long msk[2];
#pragma unroll
        for (int jj = 0; jj < 2; ++jj) { const int j = lane + 64 * jj; int rank = 0;
#pragma unroll 4
            for (int i = 0; i < 128; ++i) { const float si = scb[i]; rank += (si > sc2[jj] || (si == sc2[jj] && i < j)) ? 1 : 0; }
            msk[jj] = __ballot(rank < 16); }
        WSYNC();
        float M[4], L[4], os[4], ow[4];
#pragma unroll
        for (int r = 0; r < 4; ++r) { M[r] = NEGB; L[r] = 0.f; os[r] = 0.f; }
        { const float* Kg = KV + 2 * KV_STRIDE + (size_t)g * T * 64; const float* Vg = KV + 3 * KV_STRIDE + (size_t)g * T * 64;
#pragma unroll 1
          for (int j = 0; j <= cur; ++j) { const bool sel = ((j < 64 ? msk[0] >> j : msk[1] >> (j - 64)) & 1ull) != 0ull; if (sel) nsa_block<false>(Kg, Vg, j, t, lane, qs, pb, slope, M, L, os); } }
#pragma unroll
        for (int r = 0; r < 4; ++r) { os[r] = os[r] / L[r]; M[r] = NEGB; L[r] = 0.f; ow[r] = 0.f; }
        { const float* Kg = KV + 4 * KV_STRIDE + (size_t)g * T * 64; const float* Vg = KV + 5 * KV_STRIDE + (size_t)g * T * 64;
          const int j0 = t >= 511 ? (t - 511) >> 6 : 0;
#pragma unroll 1
          for (int j = j0; j <= cur; ++j) nsa_block<true>(Kg, Vg, j, t, lane, qs, pb, slope, M, L, ow); }
#pragma unroll
        for (int r = 0; r < 4; ++r) { const int h = g * 4 + r;
            const float g0 = sigmoidf_(bf2f(P[(size_t)t * NPAD + C_NG + h])), g1 = sigmoidf_(bf2f(P[(size_t)t * NPAD + C_NG + 8 + h])), g2 = sigmoidf_(bf2f(P[(size_t)t * NPAD + C_NG + 16 + h]));
            OCAT[(size_t)t * 1536 + h * 64 + lane] = (bf16)f2bf(g0 * ocb[r * 64 + lane] + g1 * os[r] + g2 * (ow[r] / L[r])); }
        WSYNC();
    }
}

typedef float f32x16 __attribute__((ext_vector_type(16)));
typedef __bf16 bf16x2_t __attribute__((ext_vector_type(2)));
__device__ __forceinline__ unsigned pkbf(float lo, float hi) { const f32x2 v = {lo, hi}; return __builtin_bit_cast(unsigned, __builtin_convertvector(v, bf16x2_t)); }
constexpr float LOG2E = 1.4426950408889634f, NSA_SHIFT2 = 8.0f;
__device__ __forceinline__ int perm16(int b) { return (b & 3) | ((b & 4) << 1) | ((b & 8) >> 1); }
__device__ __forceinline__ void phase_prep2(Frame& F, int l) {
    KA;
    const bf16* P = (const bf16*)(KWS + WS_P);
    bf16* QS = (bf16*)(KWS + WS_QS); bf16* KS2 = (bf16*)(KWS + WS_KS2); bf16* KW2 = (bf16*)(KWS + WS_KW2);
    const float* qg = KIN(I_QN) + l * 64; const float* kg = KIN(I_KN) + l * 192;
    for (int it = F.gw; it < T * 12; it += F.NGW) {
        const int t = it / 12, v = it % 12;
        const int col = v < 8 ? v * 64 : (v < 10 ? C_KS + (v - 8) * 64 : C_KW + (v - 10) * 64);
        float x = bf2f(P[(size_t)t * NPAD + col + F.lane]);
        const float ss = wave_sum(x * x);
        const float g = v < 8 ? qg[F.lane] * (0.125f * LOG2E) : (v < 10 ? kg[64 + F.lane] : kg[128 + F.lane]);
        x = x * (1.0f / sqrtf(ss * (1.0f / 64.0f) + EPS)) * g;
        bf16* dst = v < 8 ? QS + ((size_t)v * T + t) * 64 : (v < 10 ? KS2 + ((size_t)(v - 8) * T + t) * 64 : KW2 + ((size_t)(v - 10) * T + t) * 64);
        dst[F.lane] = (bf16)f2bf(x);
    }
    LAS bf16* tile = (LAS bf16*)(F.lds + F.wave * 16384);
    for (int it = F.gw; it < 2 * 2 * (T / 64); it += F.NGW) {
        const int kind = it / (2 * (T / 64)), q = it % (2 * (T / 64)), g = q / (T / 64), tb = q % (T / 64);
        const bf16* src = P + (size_t)(tb * 64) * NPAD + (kind == 0 ? C_VS : C_VW) + g * 64;
        bf16* dst = (bf16*)(KWS + (kind == 0 ? WS_VST : WS_VWT)) + (size_t)g * 64 * T + tb * 64;
#pragma unroll 4
        for (int r = 0; r < 64; ++r) tile[r * 66 + F.lane] = src[(size_t)r * NPAD + F.lane];
        WSYNC();
        const int pl = (F.lane & ~15) | perm16(F.lane & 15);
#pragma unroll 4
        for (int d = 0; d < 64; ++d) dst[(size_t)d * T + pl] = tile[F.lane * 66 + d];
        WSYNC();
    }
}
__device__ __forceinline__ void phase_compress2(Frame& F, int l) {
    KA;
    LAS float* av = (LAS float*)(F.lds + F.wave * 16384);
    const bf16* P = (const bf16*)(KWS + WS_P);
    bf16* KCB = (bf16*)(KWS + WS_KCB); bf16* VCT = (bf16*)(KWS + WS_KCB + 131072);
    for (int it = F.gw; it < 2 * 2 * 512; it += F.NGW) {
        const int kind = it >> 10, g = (it >> 9) & 1, n = it & 511;
        if (n == 511) { if (kind == 0) KCB[((size_t)g * 512 + 511) * 64 + F.lane] = 0; else VCT[((size_t)g * 64 + F.lane) * 512 + 511] = 0; continue; }
        const bf16* src = P + (size_t)(16 * n) * NPAD + (kind == 0 ? C_KC : C_VC) + g * 64;
        const float* pe = KIN(I_PE) + ((size_t)l * 2 + kind) * 2048;
        const float* w1 = KIN(I_W1) + ((size_t)l * 2 + kind) * 2048 * 64;
        const float* w2 = KIN(I_W2) + ((size_t)l * 2 + kind) * 64 * 64;
#pragma unroll 4
        for (int c = 0; c < 32; ++c) av[c * 64 + F.lane] = bf2f(src[(size_t)c * NPAD + F.lane]) + pe[c * 64 + F.lane];
        WSYNC();
        float acc = 0.f;
#pragma unroll 8
        for (int i = 0; i < 2048; ++i) acc += av[i] * w1[i * 64 + F.lane];
        const float hid = gelu_tanh(acc);
        WSYNC();
        av[F.lane] = hid;
        WSYNC();
        float o = 0.f;
#pragma unroll 8
        for (int i = 0; i < 64; ++i) o += av[i] * w2[i * 64 + F.lane];
        WSYNC();
        if (kind == 0) { const float ss = wave_sum(o * o); o = o * (1.0f / sqrtf(ss * (1.0f / 64.0f) + EPS)) * KIN(I_KN)[l * 192 + F.lane]; KCB[((size_t)g * 512 + n) * 64 + F.lane] = (bf16)f2bf(o); }
        else VCT[((size_t)g * 64 + F.lane) * 512 + ((n & ~15) | perm16(n & 15))] = (bf16)f2bf(o);
    }
}
constexpr int NSA_KB0 = 0, NSA_VB0 = 9216, NSA_KB1 = 18432, NSA_VB1 = 27648;
constexpr int NSA_SCA = 36864, NSA_SCB = 70656;
constexpr int NSA_QM = 104448, NSA_UM = 105472;
__device__ __forceinline__ int next_set(unsigned long long m0, unsigned long long m1, int from) {
    if (from < 64) { const unsigned long long x = m0 & (~0ull << from); if (x) return __builtin_ctzll(x); from = 64; }
    if (from < 128) { const unsigned long long x = m1 & (~0ull << (from - 64)); if (x) return 64 + __builtin_ctzll(x); }
    return 128;
}
template <int MODE> __device__ __forceinline__ void nsa_branch(Frame& F, const bf16* Kg, const bf16* VTg, int vt_len, unsigned long long m0, unsigned long long m1,
        const bf16x8 (&Qf)[4], int t, int cblk, float slope2, float inv_l, const unsigned (&qsel)[4], int hi_cmp, unsigned wm_lo_dummy, f32x16 (&oacc)[2], float& lsum) {
    LAS unsigned char* lds = F.lds;
    const int lane = F.lane, c32 = lane & 31, h = lane >> 5, tid = F.tid;
    const int lrow = tid >> 3, lch = tid & 7;
    int j = next_set(m0, m1, 0);
    if (j >= 128) return;
    u32x4 rk = *(const u32x4*)(Kg + (size_t)(64 * j + lrow) * 64 + lch * 8), rv = *(const u32x4*)(VTg + (size_t)lrow * vt_len + 64 * j + lch * 8);
    *(LAS u32x4*)(lds + NSA_KB0 + lrow * 144 + lch * 16) = rk; *(LAS u32x4*)(lds + NSA_VB0 + lrow * 144 + lch * 16) = rv;
    __syncthreads();
    int b = 0;
    const float kslope2 = (MODE < 2) ? 16.0f * slope2 : slope2;
    const float qpos = (MODE < 2) ? (float)(t - 31) : (float)t;
    while (j < 128) {
        const int jn = next_set(m0, m1, j + 1);
        if (jn < 128) { rk = *(const u32x4*)(Kg + (size_t)(64 * jn + lrow) * 64 + lch * 8); rv = *(const u32x4*)(VTg + (size_t)lrow * vt_len + 64 * jn + lch * 8); }
        bool need = true;
        if (MODE == 2) { const unsigned myw = j < 32 ? qsel[0] : (j < 64 ? qsel[1] : (j < 96 ? qsel[2] : qsel[3])); need = __any((myw >> (j & 31)) & 1u); }
        if (need) {
            const int kb = b ? NSA_KB1 : NSA_KB0, vb = b ? NSA_VB1 : NSA_VB0;
            const int kbase = 64 * j;
            float lb2 = -slope2 * qpos + kslope2 * (float)(kbase + 4 * h) - NSA_SHIFT2;
            if (MODE == 2) { const unsigned myw = j < 32 ? qsel[0] : (j < 64 ? qsel[1] : (j < 96 ? qsel[2] : qsel[3])); if (!((myw >> (j & 31)) & 1u)) lb2 = -1e30f; }
            f32x16 sacc[2];
#pragma unroll
            for (int sub = 0; sub < 2; ++sub)
#pragma unroll
                for (int i = 0; i < 16; ++i) sacc[sub][i] = fmaf(kslope2, (float)(32 * sub + (i & 3) + 8 * (i >> 2)), lb2);
#pragma unroll
            for (int sub = 0; sub < 2; ++sub) {
#pragma unroll
                for (int ks = 0; ks < 4; ++ks) { const bf16x8 a = *(const LAS bf16x8*)(lds + kb + (32 * sub + c32) * 144 + (16 * ks + 8 * h) * 2); sacc[sub] = __builtin_amdgcn_mfma_f32_32x32x16_bf16(a, Qf[ks], sacc[sub], 0, 0, 0); }
                asm volatile("" ::: "memory"); }
#pragma unroll
            for (int sub = 0; sub < 2; ++sub)
#pragma unroll
                for (int i = 0; i < 16; ++i) sacc[sub][i] = __builtin_amdgcn_exp2f(sacc[sub][i]);
            bool mhi = false, mlo = false; int hi = 0, lo = 0;
            if (MODE < 2) { mhi = true; hi = hi_cmp; }
            if (MODE == 2) { mhi = (j == cblk); hi = t; }
            if (MODE == 3) { mhi = (j == cblk); hi = t; mlo = (j == cblk - 8); lo = t - 511; }
            if (mhi || mlo) {
#pragma unroll
                for (int sub = 0; sub < 2; ++sub)
#pragma unroll
                    for (int i = 0; i < 16; ++i) { const int idx = kbase + 4 * h + 32 * sub + (i & 3) + 8 * (i >> 2); if ((mhi && idx > hi) || (mlo && idx < lo)) sacc[sub][i] = 0.f; }
            }
            float ls = 0.f;
#pragma unroll
            for (int sub = 0; sub < 2; ++sub)
#pragma unroll
                for (int i = 0; i < 16; ++i) ls += sacc[sub][i];
            lsum += ls;
            if (MODE == 1) {
                LAS float* scA = (LAS float*)(lds + NSA_SCA); LAS float* scB = (LAS float*)(lds + NSA_SCB);
                const int q = F.wave * 8 + (c32 >> 2);
#pragma unroll
                for (int sub = 0; sub < 2; ++sub)
#pragma unroll
                    for (int g4 = 0; g4 < 4; ++g4) { float x[4];
#pragma unroll
                        for (int e = 0; e < 4; ++e) { float v = sacc[sub][4 * g4 + e] * inv_l; v += __shfl_xor(v, 1); v += __shfl_xor(v, 2); x[e] = v; }
                        const int jb = 16 * j + 8 * sub + 2 * g4 + h;
                        if ((c32 & 3) == 0) { scA[q * 132 + jb] = 2.0f * (x[0] + x[1] + x[2]) + x[3]; scB[q * 132 + jb + 1] = x[3]; } }
            }
            if (MODE != 0) {
                bf16x8 pf[2][2];
#pragma unroll
                for (int sub = 0; sub < 2; ++sub)
#pragma unroll
                    for (int s2 = 0; s2 < 2; ++s2) { u32x4 w; w.x = pkbf(sacc[sub][8 * s2], sacc[sub][8 * s2 + 1]); w.y = pkbf(sacc[sub][8 * s2 + 2], sacc[sub][8 * s2 + 3]); w.z = pkbf(sacc[sub][8 * s2 + 4], sacc[sub][8 * s2 + 5]); w.w = pkbf(sacc[sub][8 * s2 + 6], sacc[sub][8 * s2 + 7]);
                        pf[sub][s2] = __builtin_bit_cast(bf16x8, w); }
                asm volatile("" ::: "memory");
#pragma unroll
                for (int ds = 0; ds < 2; ++ds) {
#pragma unroll
                    for (int sub = 0; sub < 2; ++sub)
#pragma unroll
                        for (int s2 = 0; s2 < 2; ++s2) { const bf16x8 a = *(const LAS bf16x8*)(lds + vb + (32 * ds + c32) * 144 + (32 * sub + 16 * s2 + 8 * h) * 2); oacc[ds] = __builtin_amdgcn_mfma_f32_32x32x16_bf16(a, pf[sub][s2], oacc[ds], 0, 0, 0); }
                    asm volatile("" ::: "memory"); }
            }
        }
        if (jn < 128) { const int kb = b ? NSA_KB0 : NSA_KB1, vb = b ? NSA_VB0 : NSA_VB1; *(LAS u32x4*)(lds + kb + lrow * 144 + lch * 16) = rk; *(LAS u32x4*)(lds + vb + lrow * 144 + lch * 16) = rv; }
        __syncthreads();
        j = jn; b ^= 1;
    }
}
__device__ __forceinline__ void nsa_stash_put(LAS unsigned char* lds, int wave, int lane, const f32x16 (&o)[2], float sc) {
    LAS unsigned* st = (LAS unsigned*)(lds + NSA_SCA) + wave * 1024 + lane;
#pragma unroll
    for (int ds = 0; ds < 2; ++ds)
#pragma unroll
        for (int k = 0; k < 8; ++k) st[(ds * 8 + k) * 64] = pkbf(o[ds][2 * k] * sc, o[ds][2 * k + 1] * sc);
}
__device__ __forceinline__ void phase_nsa2(Frame& F, int l) {
    KA;
    LAS unsigned char* lds = F.lds;
    const bf16* P = (const bf16*)(KWS + WS_P); bf16* OCAT = (bf16*)(KWS + WS_OCAT);
    const bf16* QS = (const bf16*)(KWS + WS_QS);
    const int lane = F.lane, c32 = lane & 31, h = lane >> 5, q8 = c32 >> 2, r = c32 & 3;
    for (int unit = F.bid; unit < 256; unit += F.G) {
        const int g = unit & 1, cblk = unit >> 1, t0 = cblk * 64, head = g * 4 + r, t = t0 + F.wave * 8 + q8;
        const float slope2 = exp2f(-(float)(head + 1)) * LOG2E;
        bf16x8 Qf[4];
#pragma unroll
        for (int ks = 0; ks < 4; ++ks) Qf[ks] = *(const bf16x8*)(QS + ((size_t)head * T + t) * 64 + 16 * ks + 8 * h);
        for (int u = F.tid; u < (NSA_UM + 16 - NSA_SCA) / 4; u += 512) ((LAS unsigned*)(lds + NSA_SCA))[u] = 0u;
        __syncthreads();
        f32x16 oacc[2];
#pragma unroll
        for (int ds = 0; ds < 2; ++ds)
#pragma unroll
            for (int i = 0; i < 16; ++i) oacc[ds][i] = 0.f;
        unsigned qsel[4] = {0u, 0u, 0u, 0u};
        float sc_cmp;
        {
            const int ntile = (4 * cblk + 2) / 64 + 1;
            const unsigned long long cm0 = ntile >= 64 ? ~0ull : ((1ull << ntile) - 1ull);
            const int hi_cmp = t >= 31 ? (t - 31) / 16 : -1;
            const bf16* Kg = (const bf16*)(KWS + WS_KCB) + (size_t)g * 512 * 64; const bf16* VTg = (const bf16*)(KWS + WS_KCB + 131072) + (size_t)g * 64 * 512;
            float l1 = 0.f;
            nsa_branch<0>(F, Kg, VTg, 512, cm0, 0ull, Qf, t, cblk, slope2, 0.f, qsel, hi_cmp, 0u, oacc, l1);
            l1 += __shfl_xor(l1, 32);
            const float inv_l = l1 > 0.f ? 1.0f / l1 : 0.f;
            float l2 = 0.f;
            nsa_branch<1>(F, Kg, VTg, 512, cm0, 0ull, Qf, t, cblk, slope2, inv_l, qsel, hi_cmp, 0u, oacc, l2);
            sc_cmp = sigmoidf_(bf2f(P[(size_t)t * NPAD + C_NG + head])) * inv_l;
        }
        {
            LAS float* scA = (LAS float*)(lds + NSA_SCA); LAS float* scB = (LAS float*)(lds + NSA_SCB);
            LAS unsigned* qm = (LAS unsigned*)(lds + NSA_QM); LAS unsigned* um = (LAS unsigned*)(lds + NSA_UM);
            WSYNC();
            const int qq = F.wave * 8 + (lane >> 3), jj = lane & 7;
            unsigned key[16];
#pragma unroll
            for (int m = 0; m < 16; ++m) { const int jb = jj + 8 * m; float sv = scA[qq * 132 + jb] + scB[qq * 132 + jb];
                if (jb == 0 || jb == cblk || jb == cblk - 1) sv = 1e4f;
                key[m] = (__builtin_bit_cast(unsigned, sv) & ~127u) | (unsigned)(127 - jb); }
            WSYNC();
#pragma unroll
            for (int m = 0; m < 16; ++m) ((LAS unsigned*)scA)[qq * 132 + jj + 8 * m] = key[m];
            WSYNC();
            unsigned bits[4] = {0u, 0u, 0u, 0u};
#pragma unroll
            for (int half = 0; half < 2; ++half) { int rank[8];
#pragma unroll
                for (int m = 0; m < 8; ++m) rank[m] = 0;
#pragma unroll 2
                for (int i = 0; i <= cblk; ++i) { const unsigned ki = ((const LAS unsigned*)scA)[qq * 132 + i];
#pragma unroll
                    for (int m = 0; m < 8; ++m) rank[m] += ki > key[8 * half + m] ? 1 : 0; }
#pragma unroll
                for (int m = 0; m < 8; ++m) { const int jb = jj + 8 * (8 * half + m); if (jb <= cblk && rank[m] < 16) bits[(8 * half + m) >> 2] |= 1u << (jb & 31); } }
#pragma unroll
            for (int w = 0; w < 4; ++w) if (bits[w]) { atomicOr((unsigned*)(qm + qq * 4 + w), bits[w]); atomicOr((unsigned*)(um + w), bits[w]); }
            __syncthreads();
#pragma unroll
            for (int w = 0; w < 4; ++w) qsel[w] = qm[(F.wave * 8 + q8) * 4 + w];
        }
        nsa_stash_put(lds, F.wave, lane, oacc, sc_cmp);
#pragma unroll
        for (int ds = 0; ds < 2; ++ds)
#pragma unroll
            for (int i = 0; i < 16; ++i) oacc[ds][i] = 0.f;
        {
            LAS unsigned* um = (LAS unsigned*)(lds + NSA_UM);
            const unsigned long long sm0 = (unsigned long long)__builtin_amdgcn_readfirstlane(um[0]) | ((unsigned long long)__builtin_amdgcn_readfirstlane(um[1]) << 32);
            const unsigned long long sm1 = (unsigned long long)__builtin_amdgcn_readfirstlane(um[2]) | ((unsigned long long)__builtin_amdgcn_readfirstlane(um[3]) << 32);
            float ls = 0.f;
            nsa_branch<2>(F, (const bf16*)(KWS + WS_KS2) + (size_t)g * T * 64, (const bf16*)(KWS + WS_VST) + (size_t)g * 64 * T, T, sm0, sm1, Qf, t, cblk, slope2, 0.f, qsel, 0, 0u, oacc, ls);
            ls += __shfl_xor(ls, 32);
            const float sc = sigmoidf_(bf2f(P[(size_t)t * NPAD + C_NG + 8 + head])) / ls;
            LAS unsigned* st = (LAS unsigned*)(lds + NSA_SCA) + F.wave * 1024 + lane;
#pragma unroll
            for (int ds = 0; ds < 2; ++ds)
#pragma unroll
                for (int k = 0; k < 8; ++k) { const unsigned w = st[(ds * 8 + k) * 64]; st[(ds * 8 + k) * 64] = pkbf(bflo(w) + sc * oacc[ds][2 * k], bfhi(w) + sc * oacc[ds][2 * k + 1]); oacc[ds][2 * k] = 0.f; oacc[ds][2 * k + 1] = 0.f; }
        }
        {
            const int j0 = cblk >= 8 ? cblk - 8 : 0;
            unsigned long long wm0 = 0ull, wm1 = 0ull;
            for (int jb = j0; jb <= cblk; ++jb) { if (jb < 64) wm0 |= 1ull << jb; else wm1 |= 1ull << (jb - 64); }
            float ls = 0.f;
            nsa_branch<3>(F, (const bf16*)(KWS + WS_KW2) + (size_t)g * T * 64, (const bf16*)(KWS + WS_VWT) + (size_t)g * 64 * T, T, wm0, wm1, Qf, t, cblk, slope2, 0.f, qsel, 0, 0u, oacc, ls);
            ls += __shfl_xor(ls, 32);
            const float sc = sigmoidf_(bf2f(P[(size_t)t * NPAD + C_NG + 16 + head])) / ls;
            const LAS unsigned* st = (const LAS unsigned*)(lds + NSA_SCA) + F.wave * 1024 + lane;
#pragma unroll
            for (int ds = 0; ds < 2; ++ds)
#pragma unroll
                for (int g4 = 0; g4 < 4; ++g4) { const unsigned w0 = st[(ds * 8 + 2 * g4) * 64], w1 = st[(ds * 8 + 2 * g4 + 1) * 64];
                    u32x2 w; w.x = pkbf(bflo(w0) + sc * oacc[ds][4 * g4], bfhi(w0) + sc * oacc[ds][4 * g4 + 1]); w.y = pkbf(bflo(w1) + sc * oacc[ds][4 * g4 + 2], bfhi(w1) + sc * oacc[ds][4 * g4 + 3]);
                    *(u32x2*)(OCAT + (size_t)t * 1536 + head * 64 + 32 * ds + 8 * g4 + 4 * h) = w; }
        }
        __syncthreads();
    }
}

__device__ __forceinline__ void phase_merge(Frame& F) {
    KA;
    const bf16* P = (const bf16*)(KWS + WS_P); const bf16* PROJ = (const bf16*)(KWS + WS_PROJ); bf16* MG = (bf16*)(KWS + WS_MERGED);
    const size_t total = (size_t)T * D / 8;
    for (size_t it = (size_t)F.gw * 64 + F.lane; it < total; it += (size_t)F.NGW * 64) {
        const size_t t = it / (D / 8); const int d = (int)(it % (D / 8)) * 8;
        float acc[8];
#pragma unroll
        for (int k = 0; k < 8; ++k) acc[k] = 0.f;
#pragma unroll
        for (int n = 0; n < 3; ++n) { const u32x4 gq = *(const u32x4*)(P + t * NPAD + C_MG + n * D + d); const u32x4 pq = *(const u32x4*)(PROJ + ((size_t)n * T + t) * D + d);
            acc[0] += sigmoidf_(bflo(gq.x)) * bflo(pq.x); acc[1] += sigmoidf_(bfhi(gq.x)) * bfhi(pq.x); acc[2] += sigmoidf_(bflo(gq.y)) * bflo(pq.y); acc[3] += sigmoidf_(bfhi(gq.y)) * bfhi(pq.y);
            acc[4] += sigmoidf_(bflo(gq.z)) * bflo(pq.z); acc[5] += sigmoidf_(bfhi(gq.z)) * bfhi(pq.z); acc[6] += sigmoidf_(bflo(gq.w)) * bflo(pq.w); acc[7] += sigmoidf_(bfhi(gq.w)) * bfhi(pq.w); }
        u32x4 o; o.x = pk2(acc[0], acc[1]); o.y = pk2(acc[2], acc[3]); o.z = pk2(acc[4], acc[5]); o.w = pk2(acc[6], acc[7]);
        *(u32x4*)(MG + t * D + d) = o;
    }
}
__device__ __forceinline__ void phase_router(Frame& F, int l) {
    KA;
    const float* X1 = (const float*)(KWS + WS_X1); bf16* H = (bf16*)(KWS + WS_H);
    int* EID = (int*)(KWS + WS_ROUTE); float* EW = (float*)(KWS + WS_ROUTE + 65536);
    const float* gain = KIN(I_NFFN) + (size_t)l * D; const float* wg = KIN(I_WGRP) + (size_t)l * D * 4; const float* we = KIN(I_WEXP) + (size_t)l * D * 32;
    const float* bg = KIN(I_BGRP) + l * 4; const float* be = KIN(I_BEXP) + l * 32;
    for (int t = F.gw; t < T; t += F.NGW) {
        const float* xrow = X1 + (size_t)t * D;
        float ss = 0.f;
#pragma unroll 4
        for (int k = 0; k < 32; ++k) { const float x = xrow[F.lane + 64 * k]; ss += x * x; }
        const float rstd = 1.0f / sqrtf(wave_sum(ss) * (1.0f / D) + EPS);
        float ag[4] = {0.f, 0.f, 0.f, 0.f}, ae[32];
#pragma unroll
        for (int e = 0; e < 32; ++e) ae[e] = 0.f;
#pragma unroll 1
        for (int k = 0; k < 32; ++k) { const int d = F.lane + 64 * k;
            const float hv = xrow[d] * rstd * gain[d];
            H[(size_t)t * D + d] = (bf16)f2bf(hv);
            const f32x4 w4 = *(const f32x4*)(wg + (size_t)d * 4);
            ag[0] += hv * w4.x; ag[1] += hv * w4.y; ag[2] += hv * w4.z; ag[3] += hv * w4.w;
#pragma unroll
            for (int c = 0; c < 8; ++c) { const f32x4 w = *(const f32x4*)(we + (size_t)d * 32 + c * 4); ae[c * 4] += hv * w.x; ae[c * 4 + 1] += hv * w.y; ae[c * 4 + 2] += hv * w.z; ae[c * 4 + 3] += hv * w.w; } }
#pragma unroll
        for (int e = 0; e < 4; ++e) ag[e] = wave_sum(ag[e]) + bg[e];
#pragma unroll
        for (int e = 0; e < 32; ++e) ae[e] = wave_sum(ae[e]) + be[e];
        int gi = 0; float gm = ag[0];
#pragma unroll
        for (int e = 1; e < 4; ++e) if (ag[e] > gm) { gm = ag[e]; gi = e; }
        float gs = 0.f;
#pragma unroll
        for (int e = 0; e < 4; ++e) gs += expf(ag[e] - gm);
        const float gw_ = 1.0f / gs;
        float el[8];
#pragma unroll
        for (int e = 0; e < 8; ++e) { el[e] = gi == 0 ? ae[e] : (gi == 1 ? ae[8 + e] : (gi == 2 ? ae[16 + e] : ae[24 + e])); }
        int i1 = 0; float m1 = el[0];
#pragma unroll
        for (int e = 1; e < 8; ++e) if (el[e] > m1) { m1 = el[e]; i1 = e; }
        int i2 = -1; float m2 = -3.0e38f;
#pragma unroll
        for (int e = 0; e < 8; ++e) if (e != i1 && el[e] > m2) { m2 = el[e]; i2 = e; }
        const float p2 = expf(m2 - m1);
        const float w1 = 1.0f / (1.0f + p2), w2 = p2 / (1.0f + p2);
        if (F.lane == 0) { EID[2 * t] = gi * 8 + i1; EID[2 * t + 1] = gi * 8 + i2; EW[2 * t] = gw_ * w1; EW[2 * t + 1] = gw_ * w2; }
    }
}

__device__ __forceinline__ void phase_router2(Frame& F, int l) {
    KA;
    const float* X1 = (const float*)(KWS + WS_X1); bf16* H = (bf16*)(KWS + WS_H);
    int* EID = (int*)(KWS + WS_ROUTE); float* EW = (float*)(KWS + WS_ROUTE + 65536); int* HIST = (int*)(KWS + WS_HIST);
    const float* WRT = (const float*)(KWS + WS_WRT) + (size_t)l * 48 * D;
    const float* gain = KIN(I_NFFN) + (size_t)l * D; const float* bg = KIN(I_BGRP) + l * 4; const float* be = KIN(I_BEXP) + l * 32;
    LAS float* red = (LAS float*)F.lds;
    LAS float* ssq = (LAS float*)(F.lds + 24576);
    LAS float* lg = (LAS float*)(F.lds + 25088);
    LAS float* rs = (LAS float*)(F.lds + 30208);
    LAS int* eidl = (LAS int*)(F.lds + 30336);
    const int r16 = F.lane & 15, kq = F.lane >> 4, tg = F.wave >> 2, kq4 = F.wave & 3;
    for (int blk = F.bid; blk < T / 32; blk += F.G) {
        const int tok0 = blk * 32;
        const float* xa = X1 + (size_t)(tok0 + 16 * tg + r16) * D + kq4 * 512 + 4 * kq;
        const float* wb = WRT + (size_t)r16 * D + kq4 * 512 + 4 * kq;
        f32x4 acc[3]; float sq = 0.f;
#pragma unroll
        for (int nt = 0; nt < 3; ++nt) acc[nt] = (f32x4){0.f, 0.f, 0.f, 0.f};
#pragma unroll 2
        for (int s = 0; s < 32; ++s) { const f32x4 a = *(const f32x4*)(xa + 16 * s);
            f32x4 b[3];
#pragma unroll
            for (int nt = 0; nt < 3; ++nt) b[nt] = *(const f32x4*)(wb + (size_t)(16 * nt) * D + 16 * s);
            sq += a.x * a.x + a.y * a.y + a.z * a.z + a.w * a.w;
#pragma unroll
            for (int j = 0; j < 4; ++j)
#pragma unroll
                for (int nt = 0; nt < 3; ++nt) acc[nt] = __builtin_amdgcn_mfma_f32_16x16x4f32(a[j], b[nt][j], acc[nt], 0, 0, 0); }
        sq += __shfl_xor(sq, 16); sq += __shfl_xor(sq, 32);
#pragma unroll
        for (int nt = 0; nt < 3; ++nt) *(LAS f32x4*)(red + ((F.wave * 3 + nt) * 64 + F.lane) * 4) = acc[nt];
        if (kq == 0) ssq[F.wave * 16 + r16] = sq;
        __syncthreads();
        if (F.tid < 384) { const int tg2 = F.tid / 192, rem = F.tid % 192, nt = rem / 64, ln = rem % 64; f32x4 v = {0.f, 0.f, 0.f, 0.f};
#pragma unroll
            for (int q = 0; q < 4; ++q) v += *(const LAS f32x4*)(red + (((tg2 * 4 + q) * 3 + nt) * 64 + ln) * 4);
            const int col = 16 * nt + (ln & 15);
            if (col < 36) {
#pragma unroll
                for (int i = 0; i < 4; ++i) lg[(16 * tg2 + 4 * (ln >> 4) + i) * 40 + col] = v[i]; } }
        if (F.tid >= 384 && F.tid < 416) { const int tk = F.tid - 384, tg2 = tk >> 4, rr = tk & 15; float q2 = 0.f;
#pragma unroll
            for (int q = 0; q < 4; ++q) q2 += ssq[(tg2 * 4 + q) * 16 + rr];
            rs[tk] = 1.0f / sqrtf(q2 * (1.0f / D) + EPS); }
        __syncthreads();
        if (F.tid < 32) { const int tk = F.tid, t = tok0 + tk; const float rstd = rs[tk];
            float ag[4], el[8];
#pragma unroll
            for (int e = 0; e < 4; ++e) ag[e] = lg[tk * 40 + 32 + e] * rstd + bg[e];
            int gi = 0; float gm = ag[0];
#pragma unroll
            for (int e = 1; e < 4; ++e) if (ag[e] > gm) { gm = ag[e]; gi = e; }
            float gs = 0.f;
#pragma unroll
            for (int e = 0; e < 4; ++e) gs += expf(ag[e] - gm);
            const float gw_ = 1.0f / gs;
#pragma unroll
            for (int e = 0; e < 8; ++e) el[e] = lg[tk * 40 + gi * 8 + e] * rstd + be[gi * 8 + e];
            int i1 = 0; float m1 = el[0];
#pragma unroll
            for (int e = 1; e < 8; ++e) if (el[e] > m1) { m1 = el[e]; i1 = e; }
            int i2 = -1; float m2 = -3.0e38f;
#pragma unroll
            for (int e = 0; e < 8; ++e) if (e != i1 && el[e] > m2) { m2 = el[e]; i2 = e; }
            const float p2 = expf(m2 - m1), w1 = 1.0f / (1.0f + p2), w2 = p2 / (1.0f + p2);
            EID[2 * t] = gi * 8 + i1; EID[2 * t + 1] = gi * 8 + i2; EW[2 * t] = gw_ * w1; EW[2 * t + 1] = gw_ * w2;
            eidl[2 * tk] = gi * 8 + i1; eidl[2 * tk + 1] = gi * 8 + i2; }
        __syncthreads();
        if (F.tid < 32) { int c = 0;
#pragma unroll 8
            for (int i = 0; i < 64; ++i) c += eidl[i] == F.tid ? 1 : 0;
            HIST[blk * 32 + F.tid] = c; }
#pragma unroll 1
        for (int q = 0; q < 4; ++q) { const int tk = F.wave * 4 + q; const float rstd = rs[tk];
            const f32x4* xr = (const f32x4*)(X1 + (size_t)(tok0 + tk) * D) + F.lane;
#pragma unroll
            for (int j = 0; j < 8; ++j) { const f32x4 v = xr[64 * j]; const f32x4 g = *((const f32x4*)gain + F.lane + 64 * j);
                u32x2 o; o.x = pk2(v.x * rstd * g.x, v.y * rstd * g.y); o.y = pk2(v.z * rstd * g.z, v.w * rstd * g.w);
                *((u32x2*)(H + (size_t)(tok0 + tk) * D) + F.lane + 64 * j) = o; } }
        __syncthreads();
    }
}
__device__ __forceinline__ void phase_lists2(Frame& F) {
    KA;
    const int* EID = (const int*)(KWS + WS_ROUTE); int* CNT = (int*)(KWS + WS_ROUTE + 131072); int* LIST = (int*)(KWS + WS_ROUTE + 262144); const int* HIST = (const int*)(KWS + WS_HIST);
    LAS int* off = (LAS int*)F.lds; LAS int* eidl = off + 32;
    for (int blk = F.bid; blk < T / 32; blk += F.G) {
        if (F.tid < 32) { int a = 0;
#pragma unroll 8
            for (int b2 = 0; b2 < blk; ++b2) a += HIST[b2 * 32 + F.tid];
            off[F.tid] = a;
            if (blk == T / 32 - 1) CNT[F.tid] = a + HIST[blk * 32 + F.tid]; }
        if (F.tid >= 64 && F.tid < 128) eidl[F.tid - 64] = EID[blk * 64 + F.tid - 64];
        __syncthreads();
        if (F.tid < 64) { const int e = eidl[F.tid]; int rk = 0;
            for (int i = 0; i < F.tid; ++i) rk += eidl[i] == e ? 1 : 0;
            LIST[e * 8192 + off[e] + rk] = blk * 64 + F.tid; }
        __syncthreads();
    }
}

__device__ __forceinline__ void phase_lists(Frame& F) {
    KA;
    const int e = F.bid;
    if (e >= NE) return;
    const int* EID = (const int*)(KWS + WS_ROUTE); int* CNT = (int*)(KWS + WS_ROUTE + 131072); int* LIST = (int*)(KWS + WS_ROUTE + 262144);
    LAS int* wc = (LAS int*)F.lds;
    int run = 0;
    for (int base = 0; base < 2 * T; base += 512) {
        const int idx = base + F.tid; const bool match = EID[idx] == e;
        const unsigned long long b = __ballot(match);
        if (F.lane == 0) wc[F.wave] = __popcll(b);
        __syncthreads();
        int pre = 0, tot = 0;
#pragma unroll
        for (int w = 0; w < 8; ++w) { const int c = wc[w]; pre += w < F.wave ? c : 0; tot += c; }
        if (match) LIST[e * 8192 + run + pre + __popcll(b & ((1ull << F.lane) - 1ull))] = idx;
        run += tot;
        __syncthreads();
    }
    if (F.tid == 0) CNT[e] = run;
}
__device__ __forceinline__ void moe_table(Frame& F, LAS int* tb) {
    KA;
    const int* CNT = (const int*)(KWS + WS_ROUTE + 131072);
    if (F.tid == 0) { int a = 0; for (int e = 0; e < NE; ++e) { tb[e] = a; a += (CNT[e] + 255) / 256; } tb[NE] = a; }
    __syncthreads();
}

constexpr int PH_PER_LAYER = 12, N_PHASES = 1 + NL * PH_PER_LAYER + 1;

__global__ void __launch_bounds__(512, 2) mk_fwd(Args args) {
    extern __shared__ __attribute__((aligned(16))) unsigned char lds_raw[];
#define FRAME Frame F; F.lds = (LAS unsigned char*)lds_raw; F.MISC = (volatile LAS unsigned*)(F.lds + MISC_OFF); F.tid = ltid(); F.lane = F.tid & 63; F.wave = __builtin_amdgcn_readfirstlane(F.tid >> 6); \
    F.G = gridDim.x; F.bid = lbid(); F.vcu = (F.G % 8 == 0) ? (F.bid % 8) * (F.G / 8) + F.bid / 8 : F.bid; F.gw = F.bid * 8 + F.wave; F.NGW = F.G * 8;
    unsigned* const ctl = (unsigned*)((unsigned char*)args.ws + WS_CTL);
    for (int u = threadIdx.x; u < (LDS_BYTES - MISC_OFF) / 4; u += 512) ((LAS unsigned*)(lds_raw + MISC_OFF))[u] = 0u;
    __syncthreads();
    const int lo = args.ph_lo, hi = args.ph_hi;
    XcdBarrier bar; bar.bar = ctl + CW_BAR + args.li * XCD_BAR_WORDS; bar.x = 0; bar.st = nullptr;
    if (hi - lo > 1) bar = xcd_barrier_post(ctl + CW_BAR + args.li * XCD_BAR_WORDS, (volatile LAS unsigned*)((LAS unsigned char*)lds_raw + MISC_OFF));
    int ph = 0;
#define RUN(k) ((k) >= lo && (k) < hi)
#ifndef MK_PROBE_MASK
#define MK_PROBE_MASK 0
#endif
    volatile LAS unsigned long long* const tacc = (volatile LAS unsigned long long*)((LAS unsigned char*)lds_raw + MISC_OFF + 512);
    if (MK_PROBE_MASK != 0 && blockIdx.x == 0 && threadIdx.x == 0) tacc[16] = wall_clock64();
#define STAMP(slot) do { if (MK_PROBE_MASK != 0 && lbid() == 0 && ltid() == 0) { const unsigned long long _n = wall_clock64(); tacc[slot] += _n - tacc[16]; tacc[16] = _n; } } while (0)
#define SEAM(k, slot) do { if ((k) + 1 < hi) xcd_barrier(bar); STAMP(slot); } while (0)
    LAS int* const tb = (LAS int*)((LAS unsigned char*)lds_raw + MISC_OFF + 64);

    if (RUN(ph)) { KA; FRAME; phase_prologue(F); phase_norm1<0>(F, KIN(I_X), nullptr, nullptr, KIN(I_NMIX), (bf16*)(KWS + WS_H)); SEAM(ph, 0); }
    ++ph;
    for (int l = 0; l < NL; ++l) {
        if (RUN(ph)) { KA; FRAME; pg8::PlainSched S; S.init((const bf16*)(KWS + WS_H), D, (const bf16*)(KWS + WS_WIN) + (size_t)l * NPAD * D, T, NPAD, D, F.G, F.bid);
            pg8::EpiBf16 E{(bf16*)(KWS + WS_P), NPAD};
            pg8::gemm_phase<pg8::EpiBf16, pg8::PlainSched, true>(F.lds, D, S, E); SEAM(ph, 1); }
        ++ph;
        if (RUN(ph)) { KA; FRAME; phase_prep2(F, l); SEAM(ph, 2); }
        ++ph;
        if (RUN(ph)) { KA; FRAME; phase_compress2(F, l); phase_rec_local(F, l); SEAM(ph, 3); }
        ++ph;
        if (RUN(ph)) { KA; FRAME; phase_rec_scan(F); SEAM(ph, 4); }
        ++ph;
        if (RUN(ph)) { KA; FRAME; phase_nsa2(F, l); phase_rec_out(F, l); SEAM(ph, 5); }
        ++ph;
        if (RUN(ph)) { KA; FRAME;
            for (int n = 0; n < 3; ++n) { pg8::PlainSched S; S.init((const bf16*)(KWS + WS_OCAT) + n * 512, 1536, (const bf16*)(KWS + WS_WBR) + ((size_t)l * 3 + n) * D * 512, T, D, 512, F.G, F.bid);
                pg8::EpiBf16 E{(bf16*)(KWS + WS_PROJ) + (size_t)n * T * D, D};
                pg8::gemm_phase<pg8::EpiBf16, pg8::PlainSched, true>(F.lds, 512, S, E); __syncthreads(); }
            SEAM(ph, 6); }
        ++ph;
        if (RUN(ph)) { KA; FRAME; phase_merge(F); SEAM(ph, 7); }
        ++ph;
        if (RUN(ph)) { KA; FRAME; pg8::PlainSched S; S.init((const bf16*)(KWS + WS_MERGED), D, (const bf16*)(KWS + WS_WOUT) + (size_t)l * D * D, T, D, D, F.G, F.bid);
            pg8::EpiResF32 E{l == 0 ? KIN(I_X) : (const float*)(KWS + WS_XRES), (float*)(KWS + WS_X1), D};
            pg8::gemm_phase<pg8::EpiResF32, pg8::PlainSched, false>(F.lds, D, S, E); SEAM(ph, 8); }
        ++ph;
        if (RUN(ph)) { KA; FRAME; phase_router2(F, l); SEAM(ph, 9); }
        ++ph;
        if (RUN(ph)) { KA; FRAME; phase_lists2(F); SEAM(ph, 10); }
        ++ph;
        if (RUN(ph)) { KA; FRAME; moe_table(F, tb);
            pg8::MoeSched<1> S; S.init(F.G, F.bid, tb, (const int*)(KWS + WS_ROUTE + 131072), (const int*)(KWS + WS_ROUTE + 262144), KWS + WS_H, (const bf16*)(KWS + WS_WGU) + (size_t)l * NE * 1024 * D);
            pg8::EpiMoe1 E{(bf16*)(KWS + WS_ACT), (const int*)(KWS + WS_ROUTE + 262144), (const float*)(KWS + WS_ROUTE + 65536)};
            pg8::gemm_phase<pg8::EpiMoe1, pg8::MoeSched<1>, true>(F.lds, D, S, E); SEAM(ph, 11); }
        ++ph;
        if (RUN(ph)) { KA; FRAME; moe_table(F, tb);
            pg8::MoeSched<2> S; S.init(F.G, F.bid, tb, (const int*)(KWS + WS_ROUTE + 131072), (const int*)(KWS + WS_ROUTE + 262144), KWS + WS_ACT, (const bf16*)(KWS + WS_WDN) + (size_t)l * NE * D * FF);
            pg8::EpiMoe2 E{(bf16*)(KWS + WS_CONTRIB), (const int*)(KWS + WS_ROUTE + 262144)};
            pg8::gemm_phase<pg8::EpiMoe2, pg8::MoeSched<2>, true>(F.lds, FF, S, E); SEAM(ph, 12); }
        ++ph;
        if (l + 1 < NL) { if (RUN(ph)) { KA; FRAME; phase_norm1<1>(F, (const float*)(KWS + WS_X1), (const bf16*)(KWS + WS_CONTRIB), (float*)(KWS + WS_XRES), KIN(I_NMIX) + (size_t)(l + 1) * D, (bf16*)(KWS + WS_H)); SEAM(ph, 13); } ++ph; }
    }
    if (RUN(ph)) { KA; FRAME; phase_norm1<2>(F, (const float*)(KWS + WS_X1), (const bf16*)(KWS + WS_CONTRIB), KOUT, nullptr, nullptr); }
    if (MK_PROBE_MASK != 0 && lbid() == 0 && ltid() == 0) {
        asm volatile("s_waitcnt vmcnt(0)" ::: "memory"); STAMP(15);
        unsigned long long tot = 0ull;
        for (int k2 = 0; k2 < 16; ++k2) if ((MK_PROBE_MASK >> k2) & 1) tot += tacc[k2];
        const unsigned long long t_end = wall_clock64() + 4ull * tot;
        while (wall_clock64() < t_end) __builtin_amdgcn_s_sleep(8);
    }
#undef RUN
#undef SEAM
}

#ifndef MK_PER_PHASE
#define MK_PER_PHASE 0
#endif
extern "C" void kernel_launch(void* const* d_in, const int* in_sizes, int n_in, void* d_out, int out_size, void* d_ws, size_t ws_size, hipStream_t stream) {
    static int grid = 0;
    if (grid == 0) {
        if (n_in != 22 || out_size != T * D || ws_size < WS_END) { fprintf(stderr, "kernel_launch: unexpected sizes (n_in %d out %d ws %zu)\n", n_in, out_size, ws_size); grid = -1; return; }
        int dev = 0, cus = 0, per_cu = 0;
        if (hipGetDevice(&dev) != hipSuccess || hipDeviceGetAttribute(&cus, hipDeviceAttributeMultiprocessorCount, dev) != hipSuccess) { grid = -1; return; }
        if (hipFuncSetAttribute((const void*)mk_fwd, hipFuncAttributeMaxDynamicSharedMemorySize, LDS_BYTES) != hipSuccess) { fprintf(stderr, "kernel_launch: hipFuncSetAttribute failed\n"); grid = -1; return; }
        if (hipOccupancyMaxActiveBlocksPerMultiprocessor(&per_cu, (const void*)mk_fwd, 512, LDS_BYTES) != hipSuccess || per_cu < 1) { fprintf(stderr, "kernel_launch: occupancy query says %d\n", per_cu); }
        (void)hipGetLastError();
        grid = cus;
    }
    if (grid < 0) return;
    if (hipMemsetAsync((char*)d_ws + WS_CTL, 0, CTL_ZERO_BYTES, stream) != hipSuccess) return;
    Args a{};
    for (int i = 0; i < 22; ++i) a.in[i] = (const GAS float*)d_in[i];
    a.out = (GAS float*)d_out; a.ws = (GAS unsigned char*)d_ws;
#if MK_PER_PHASE
    const int total = 1 + NL * PH_PER_LAYER + (NL - 1) + 1;
    for (int k = 0; k < total; ++k) { a.ph_lo = k; a.ph_hi = k + 1; a.li = 0; hipLaunchKernelGGL(mk_fwd, dim3(grid), dim3(512), LDS_BYTES, stream, a); }
#else
    a.ph_lo = 0; a.ph_hi = 1000; a.li = 0;
    hipLaunchKernelGGL(mk_fwd, dim3(grid), dim3(512), LDS_BYTES, stream, a);
#endif
    const hipError_t le = hipPeekAtLastError();
    if (le != hipSuccess) fprintf(stderr, "kernel_launch: launch failed: %s\n", hipGetErrorName(le));
}
```

```cpp
#include <hip/hip_runtime.h>
#include <cstdio>
#include <cstdint>

#define GAS __attribute__((address_space(1)))
#define LAS __attribute__((address_space(3)))
typedef unsigned short bf16;
typedef short bf16x8 __attribute__((ext_vector_type(8)));
typedef float f32x4 __attribute__((ext_vector_type(4)));
typedef float f32x2 __attribute__((ext_vector_type(2)));
typedef unsigned u32x4 __attribute__((ext_vector_type(4)));
typedef unsigned u32x2 __attribute__((ext_vector_type(2)));

constexpr int T = 8192, D = 2048, NL = 2, INC = 11048, NPAD = 11264;
constexpr int NE = 32, FF = 512, NCH = T / 64;
constexpr float EPS = 1e-6f, NEGB = -1e30f;
constexpr int C_Q = 0, C_KC = 512, C_VC = 640, C_KS = 768, C_VS = 896, C_KW = 1024, C_VW = 1152;
constexpr int C_HQ = 1280, C_HF = 1792, C_HI = 2304, C_HG = 2816, C_GQ = 3328, C_GK = 3584, C_GV = 3840, C_GR = 4352;
constexpr int C_MG = 4864, C_NG = 11008, C_GA = 11032;

constexpr size_t MiB = 1u << 20;
constexpr size_t WS_CTL = 0, CTL_ZERO_BYTES = 1 * MiB;
constexpr size_t WS_WIN = 2 * MiB;
constexpr size_t WS_WBR = 90 * MiB;
constexpr size_t WS_WOUT = 102 * MiB;
constexpr size_t WS_WGU = 118 * MiB;
constexpr size_t WS_WDN = 374 * MiB;
constexpr size_t WS_H = 502 * MiB;
constexpr size_t WS_P = 534 * MiB;
constexpr size_t WS_OCAT = 710 * MiB;
constexpr size_t WS_PROJ = 734 * MiB;
constexpr size_t WS_MERGED = 830 * MiB;
constexpr size_t WS_X1 = 862 * MiB;
constexpr size_t WS_XRES = 926 * MiB;
constexpr size_t WS_CONTRIB = 990 * MiB;
constexpr size_t WS_ACT = 1054 * MiB;
constexpr size_t WS_QN = 1078 * MiB;
constexpr size_t WS_KV = 1094 * MiB;
constexpr size_t WS_KC = 1118 * MiB;
constexpr size_t WS_ORAW = 1119 * MiB;
constexpr size_t WS_ROUTE = 1151 * MiB;
constexpr size_t WS_SLOC_HG = 1153 * MiB;
constexpr size_t WS_SLOC_GL = 1185 * MiB;
constexpr size_t WS_SPREV_HG = 1201 * MiB;
constexpr size_t WS_SPREV_GL = 1217 * MiB;
constexpr size_t WS_DEC = 1225 * MiB;
constexpr size_t WS_QS = 1226 * MiB;
constexpr size_t WS_KS2 = 1234 * MiB;
constexpr size_t WS_KW2 = 1236 * MiB;
constexpr size_t WS_VST = 1238 * MiB;
constexpr size_t WS_VWT = 1240 * MiB;
constexpr size_t WS_KCB = 1242 * MiB;
constexpr size_t WS_WRT = 1243 * MiB;
constexpr size_t WS_HIST = 1244 * MiB;
constexpr size_t WS_CW = 1245 * MiB;
constexpr size_t WS_END = 1247 * MiB;
constexpr size_t KV_STRIDE = (size_t)2 * T * 64;
constexpr int CW_BAR = 4096;

constexpr int RING_BYTES = 131072;
constexpr int MISC_OFF = RING_BYTES;
constexpr int LDS_BYTES = 147456;

#define LDS_WAIT() asm volatile("s_waitcnt lgkmcnt(0)" ::: "memory")
#define VM_WAIT() asm volatile("s_waitcnt vmcnt(0)" ::: "memory")
#define WSYNC() asm volatile("s_waitcnt lgkmcnt(0)" ::: "memory")

__device__ __forceinline__ unsigned f2bf(float f) { unsigned u = __builtin_bit_cast(unsigned, f); return (u + 0x7fffu + ((u >> 16) & 1u)) >> 16; }
__device__ __forceinline__ unsigned pk2(float lo, float hi) { return f2bf(lo) | (f2bf(hi) << 16); }
__device__ __forceinline__ float bf2f(unsigned b) { return __builtin_bit_cast(float, (b & 0xffffu) << 16); }
__device__ __forceinline__ float bflo(unsigned w) { return __builtin_bit_cast(float, w << 16); }
__device__ __forceinline__ float bfhi(unsigned w) { return __builtin_bit_cast(float, w & 0xffff0000u); }
__device__ __forceinline__ float wave_sum(float v) {
#pragma unroll
    for (int o = 1; o < 64; o <<= 1) v += __shfl_xor(v, o);
    return v;
}
__device__ __forceinline__ float wave_max(float v) {
#pragma unroll
    for (int o = 1; o < 64; o <<= 1) v = fmaxf(v, __shfl_xor(v, o));
    return v;
}
__device__ __forceinline__ int ltid() { int t = threadIdx.x; asm volatile("" : "+v"(t)); return t; }
__device__ __forceinline__ int lbid() { int b = blockIdx.x; asm volatile("" : "+s"(b)); return b; }
__device__ __forceinline__ float sigmoidf_(float x) { return 1.0f / (1.0f + expf(-x)); }

#define XB_TMO      128
#define XB_XCNT(j)  (256  + 64 * (j))
#define XB_XSUB(j)  (1280 + 64 * (j))
#define XB_XGEN(j)  (2304 + 64 * (j))
#define XB_TOP      3328
#define XB_TOPGEN   3392
#define XCD_BAR_WORDS 3456
#define XB_SPIN_CAP (1u << 25)

__device__ __forceinline__ unsigned xb_ld(unsigned* p)              { return __hip_atomic_load(p, __ATOMIC_RELAXED, __HIP_MEMORY_SCOPE_AGENT); }
__device__ __forceinline__ unsigned xb_add(unsigned* p, unsigned v) { return __hip_atomic_fetch_add(p, v, __ATOMIC_RELAXED, __HIP_MEMORY_SCOPE_AGENT); }
__device__ __forceinline__ unsigned xb_xcc_id() { return (unsigned)__builtin_amdgcn_s_getreg((3 << 11) | 20) & 0xFu; }
#define XB_SPIN(cond, bar) do { unsigned _sp = 0; while (cond) { __builtin_amdgcn_s_sleep(1); \
    if ((++_sp & 255u) == 0u) { if (xb_ld(&(bar)[XB_TMO])) break; if (_sp > XB_SPIN_CAP) { atomicAdd(&(bar)[XB_TMO], 1u); break; } } } } while (0)

struct XcdBarrier { unsigned* bar; unsigned x; volatile LAS unsigned* st; };

__device__ __forceinline__ XcdBarrier xcd_barrier_post(unsigned* bar, volatile LAS unsigned* st) {
    XcdBarrier b; b.bar = bar; b.x = xb_xcc_id(); b.st = st;
    if (threadIdx.x == 0) (void)xb_add(&bar[XB_XCNT(b.x)], 1u);
    return b;
}
__device__ __forceinline__ void xcd_barrier_complete(unsigned* bar, unsigned x, unsigned& nloc, unsigned& nx) {
    const unsigned G = gridDim.x * gridDim.y * gridDim.z;
    unsigned sum, cnt, mine, sp = 0u;
    for (;;) {
        sum = 0u; cnt = 0u; mine = 0u;
#pragma unroll
        for (unsigned j = 0; j < 16; ++j) { const unsigned c = xb_ld(&bar[XB_XCNT(j)]); sum += c; cnt += (c > 0u) ? 1u : 0u; mine = (j == x) ? c : mine; }
        if (sum == G) break;
        __builtin_amdgcn_s_sleep(1);
        if ((++sp & 255u) == 0u) { if (xb_ld(&bar[XB_TMO])) break; if (sp > XB_SPIN_CAP) { atomicAdd(&bar[XB_TMO], 1u); break; } }
    }
    nloc = mine > 0u ? mine : 1u; nx = cnt > 0u ? cnt : 1u;
}
__device__ __forceinline__ void xcd_barrier(const XcdBarrier& b) {
    asm volatile("s_waitcnt vmcnt(0)" ::: "memory");
    __syncthreads();
    if (threadIdx.x == 0) {
        unsigned* bar = b.bar;
        __builtin_amdgcn_s_waitcnt(0);
        unsigned nloc = b.st[0], nx = b.st[1];
        if (nloc == 0u) { xcd_barrier_complete(bar, b.x, nloc, nx); b.st[0] = nloc; b.st[1] = nx; }
        const unsigned old = xb_add(&bar[XB_XSUB(b.x)], 1u);
        const unsigned gen = old / nloc;
        if (old + 1u == (gen + 1u) * nloc) {
            __builtin_amdgcn_fence(__ATOMIC_RELEASE, "agent");
            asm volatile("s_waitcnt vmcnt(0)" ::: "memory");
            const unsigned og = xb_add(&bar[XB_TOP], 1u);
            const unsigned tg = og / nx;
            if (og + 1u == (tg + 1u) * nx) xb_add(&bar[XB_TOPGEN], 1u);
            else XB_SPIN(xb_ld(&bar[XB_TOPGEN]) == tg, bar);
            __builtin_amdgcn_fence(__ATOMIC_ACQUIRE, "agent");
            xb_add(&bar[XB_XGEN(b.x)], 1u);
            asm volatile("s_waitcnt vmcnt(0)" ::: "memory");
        } else {
            XB_SPIN(xb_ld(&bar[XB_XGEN(b.x)]) == gen, bar);
            __builtin_amdgcn_fence(__ATOMIC_ACQUIRE, "agent");
            asm volatile("s_waitcnt vmcnt(0)" ::: "memory");
        }
    }
    __syncthreads();
}

namespace pg8 {
constexpr int BM = 256, BK = 64, HALF = 128, HTB = HALF * BK * 2, STAGE_BYTES = 8 * HTB, NXCD = 8, WGM = 8;
__host__ __device__ __forceinline__ int lds_byte(int r, int c) { const int st = (r >> 4) * 2 + (c >> 5), rr = r & 15, cc = c & 31, ob = rr * 64 + cc * 2; return st * 1024 + (ob ^ (((ob >> 9) & 1) << 5)); }
__host__ __device__ __forceinline__ void stage_rc(int b, int& R, int& C) { const int st = b / 1024, sb = b % 1024, swz = sb ^ (((sb >> 9) & 1) << 5); R = (st >> 1) * 16 + swz / 64; C = (st & 1) * 32 + (swz % 64) / 2; }
__host__ __device__ __forceinline__ int perm32(int rho) { const int n = rho >> 4, i = rho & 15; return 8 * (i >> 2) + 4 * n + (i & 3); }

struct Unit { int pm, pn, e, nvalid, slot0; const char *A0, *A1, *B0, *B1; unsigned va[2][2]; };

__device__ __forceinline__ unsigned cvt_pk_bf16(float lo, float hi) { unsigned r; asm volatile("v_cvt_pk_bf16_f32 %0, %1, %2" : "=v"(r) : "v"(lo), "v"(hi)); return r; }

template <class Epi, class Sched, bool ALIGN_EPI>
__device__ __forceinline__ void gemm_phase(LAS unsigned char* lds, const int K, const Sched& S, const Epi& E) {
    const int tid = ltid(), wid = __builtin_amdgcn_readfirstlane(tid >> 6), lane = tid & 63, wr = wid >> 2, wc = wid & 3, fr = lane & 15, fq = lane >> 4;
    const int nt = K / BK;
    unsigned voffB[2];
#pragma unroll
    for (int i = 0; i < 2; ++i) { int R, C; stage_rc(tid * 16 + i * 8192, R, C); const int Rb = Epi::PERM ? ((R & ~31) + perm32(R & 31)) : R; voffB[i] = (unsigned)(Rb * K + C) * 2u; }
    const size_t kstep = (size_t)(BK * 2);
    const unsigned ldsw = (unsigned)wid * 1024u;
    const int aoff = lds_byte(wr * 64 + fr, fq * 8), boff = lds_byte(wc * 32 + fr, fq * 8);
#define PG8_SA(b, h) (((b) * 2 + (h)) * HTB)
#define PG8_SB(b, h) ((4 + (b) * 2 + (h)) * HTB)
#define PG8_STAGE(bufoff, gbase, voff) do { _Pragma("unroll") for (int _i = 0; _i < 2; ++_i) \
        __builtin_amdgcn_global_load_lds((const unsigned*)((const char*)(gbase) + (voff)[_i]), (LAS unsigned*)(lds + (bufoff) + ldsw + _i * 8192), 16, 0, 0); } while (0)
#define PG8_LDA(dst, b, h) do { _Pragma("unroll") for (int m = 0; m < 4; ++m) _Pragma("unroll") for (int k = 0; k < 2; ++k) dst[m][k] = *(const LAS bf16x8*)(lds + PG8_SA(b, h) + aoff + m * 2048 + k * 1024); } while (0)
#define PG8_LDB(dst, b, h) do { _Pragma("unroll") for (int n = 0; n < 2; ++n) _Pragma("unroll") for (int k = 0; k < 2; ++k) dst[n][k] = *(const LAS bf16x8*)(lds + PG8_SB(b, h) + boff + n * 2048 + k * 1024); } while (0)
#define PG8_MMA(ai, bj, At, Bt) do { __builtin_amdgcn_s_setprio(1); _Pragma("unroll") for (int m = 0; m < 4; ++m) _Pragma("unroll") for (int n = 0; n < 2; ++n) _Pragma("unroll") for (int k = 0; k < 2; ++k) \
        acc[ai][bj][m][n] = __builtin_amdgcn_mfma_f32_16x16x32_bf16(Bt[n][k], At[m][k], acc[ai][bj][m][n], 0, 0, 0); __builtin_amdgcn_s_setprio(0); } while (0)
#define PG8_WAIT_V(n) asm volatile("s_waitcnt vmcnt(" #n ")" ::: "memory")
#define PG8_WAIT_L(n) asm volatile("s_waitcnt lgkmcnt(" #n ")" ::: "memory")
#define PG8_BAR __builtin_amdgcn_s_barrier()
#define PG8_SCHED __builtin_amdgcn_sched_barrier(0)
#define VA(u, h) (Sched::GATHER ? (u).va[h] : S.va)
    Unit cur, nxt; int ui = 0;
    if (!S.next(0, cur)) return;
    f32x4 acc[2][2][4][2];
#pragma unroll
    for (int a = 0; a < 2; ++a)
#pragma unroll
        for (int b = 0; b < 2; ++b)
#pragma unroll
            for (int m = 0; m < 4; ++m)
#pragma unroll
                for (int n = 0; n < 2; ++n) acc[a][b][m][n] = (f32x4){0.f, 0.f, 0.f, 0.f};
    bf16x8 At[4][2], B0[2][2], B1[2][2];
    PG8_STAGE(PG8_SB(0, 0), cur.B0, voffB); PG8_STAGE(PG8_SB(0, 1), cur.B1, voffB); PG8_STAGE(PG8_SA(0, 0), cur.A0, VA(cur, 0)); PG8_STAGE(PG8_SA(0, 1), cur.A1, VA(cur, 1));
    if (wr == 1) PG8_BAR;
    PG8_WAIT_V(2); PG8_BAR;
    PG8_STAGE(PG8_SB(1, 0), cur.B0 + kstep, voffB); PG8_STAGE(PG8_SA(1, 0), cur.A0 + kstep, VA(cur, 0)); PG8_STAGE(PG8_SB(1, 1), cur.B1 + kstep, voffB);
    PG8_WAIT_V(6); PG8_BAR;
    for (;;) {
        const bool has_next = S.next(ui + 1, nxt);
        if (!has_next) nxt = cur;
        for (int t = 0; t < nt; t += 2) {
            const bool last = (t == nt - 2);
            const char* a1h1 = cur.A1 + (size_t)(t + 1) * kstep;
            const char* a2h0 = last ? nxt.A0 : cur.A0 + (size_t)(t + 2) * kstep; const char* a2h1 = last ? nxt.A1 : cur.A1 + (size_t)(t + 2) * kstep;
            const char* b2h0 = last ? nxt.B0 : cur.B0 + (size_t)(t + 2) * kstep; const char* b2h1 = last ? nxt.B1 : cur.B1 + (size_t)(t + 2) * kstep;
            unsigned v2h0[2], v2h1[2];
#pragma unroll
            for (int i = 0; i < 2; ++i) { if constexpr (Sched::GATHER) { v2h0[i] = last ? nxt.va[0][i] : cur.va[0][i]; v2h1[i] = last ? nxt.va[1][i] : cur.va[1][i]; } else { v2h0[i] = S.va[i]; v2h1[i] = S.va[i]; } }
            PG8_LDB(B0, 0, 0); PG8_LDB(B1, 0, 1); PG8_SCHED; PG8_LDA(At, 0, 0); PG8_STAGE(PG8_SA(1, 1), a1h1, VA(cur, 1));
            PG8_WAIT_V(8); PG8_WAIT_L(0); PG8_BAR; PG8_MMA(0, 0, At, B0); PG8_MMA(0, 1, At, B1); PG8_BAR; PG8_SCHED;
            PG8_LDA(At, 0, 1); PG8_STAGE(PG8_SB(0, 0), b2h0, voffB); PG8_STAGE(PG8_SB(0, 1), b2h1, voffB); PG8_STAGE(PG8_SA(0, 0), a2h0, v2h0);
            PG8_WAIT_V(8); PG8_WAIT_L(0); PG8_BAR; PG8_MMA(1, 0, At, B0); PG8_MMA(1, 1, At, B1); PG8_BAR; PG8_SCHED;
            PG8_LDB(B0, 1, 0); PG8_LDB(B1, 1, 1); PG8_SCHED; PG8_LDA(At, 1, 0); PG8_STAGE(PG8_SA(0, 1), a2h1, v2h1);
            PG8_WAIT_V(8); PG8_WAIT_L(0); PG8_BAR; PG8_MMA(0, 0, At, B0); PG8_MMA(0, 1, At, B1); PG8_BAR; PG8_SCHED;
            PG8_LDA(At, 1, 1); PG8_STAGE(PG8_SB(1, 0), b2h0 + kstep, voffB); PG8_STAGE(PG8_SB(1, 1), b2h1 + kstep, voffB); PG8_STAGE(PG8_SA(1, 0), a2h0 + kstep, v2h0);
            PG8_WAIT_V(8); PG8_WAIT_L(0); PG8_BAR; PG8_MMA(1, 0, At, B0); PG8_MMA(1, 1, At, B1); PG8_BAR; PG8_SCHED;
        }
        if constexpr (ALIGN_EPI) { if (wr == 0) PG8_BAR; }
        E(acc, cur, wr, wc, fr, fq);
        if (!has_next) break;
#pragma unroll
        for (int a = 0; a < 2; ++a)
#pragma unroll
            for (int b = 0; b < 2; ++b)
#pragma unroll
                for (int m = 0; m < 4; ++m)
#pragma unroll
                    for (int n = 0; n < 2; ++n) acc[a][b][m][n] = (f32x4){0.f, 0.f, 0.f, 0.f};
        cur = nxt; ++ui;
        if constexpr (ALIGN_EPI) { if (wr == 1) PG8_BAR; }
    }
    PG8_WAIT_V(0);
    if constexpr (!ALIGN_EPI) { if (wr == 0) PG8_BAR; }
    PG8_BAR;
#undef VA
#undef PG8_SA
#undef PG8_SB
#undef PG8_STAGE
#undef PG8_LDA
#undef PG8_LDB
#undef PG8_MMA
#undef PG8_WAIT_V
#undef PG8_WAIT_L
#undef PG8_BAR
#undef PG8_SCHED
}

struct PlainSched {
    static constexpr bool GATHER = false;
    int nM, nN, nwg, G, c, lda, K; const char* A; const char* Bt; unsigned va[2];
    __device__ __forceinline__ void init(const bf16* A_, int lda_, const bf16* Bt_, int M, int N, int K_, int G_, int c_) {
        nM = M / BM; nN = N / BM; nwg = nM * nN; G = G_; c = c_; lda = lda_; K = K_; A = (const char*)A_; Bt = (const char*)Bt_;
#pragma unroll
        for (int i = 0; i < 2; ++i) { int R, C; stage_rc((int)ltid() * 16 + i * 8192, R, C); va[i] = (unsigned)(R * lda + C) * 2u; }
    }
    __device__ __forceinline__ bool next(int i, Unit& u) const {
        const long L = (long)i * G + c; if (L >= nwg) return false;
        int wgid = (int)L; { const int q = nwg / NXCD, r = nwg % NXCD, xcd = wgid % NXCD, off = wgid / NXCD; wgid = (xcd < r ? xcd * (q + 1) : r * (q + 1) + (xcd - r) * q) + off; }
        const int nig = WGM * nN, gid = wgid / nig, fm = gid * WGM, gsz = (nM - fm) < WGM ? (nM - fm) : WGM;
        u.pm = fm + ((wgid % nig) % gsz); u.pn = (wgid % nig) / gsz; u.e = 0; u.nvalid = 256; u.slot0 = 0; u.va[0][0] = 0u; u.va[0][1] = 0u; u.va[1][0] = 0u; u.va[1][1] = 0u;
        u.A0 = A + (size_t)u.pm * BM * lda * 2; u.A1 = u.A0 + (size_t)HALF * lda * 2;
        u.B0 = Bt + (size_t)u.pn * BM * K * 2; u.B1 = u.B0 + (size_t)HALF * K * 2;
        return true;
    }
};
template <int MODE> struct MoeSched {
    static constexpr int NPN = MODE == 1 ? 4 : 8;
    static constexpr bool GATHER = MODE == 1;
    int G, c; const LAS int* tb; const int* cnt; const int* list; const char* A; const char* W; unsigned va[2];
    __device__ __forceinline__ void init(int G_, int c_, const LAS int* tb_, const int* cnt_, const int* list_, const void* A_, const void* W_) {
        G = G_; c = c_; tb = tb_; cnt = cnt_; list = list_; A = (const char*)A_; W = (const char*)W_;
#pragma unroll
        for (int i = 0; i < 2; ++i) { int R, C; stage_rc((int)ltid() * 16 + i * 8192, R, C); va[i] = (unsigned)(R * FF + C) * 2u; }
    }
    __device__ __forceinline__ bool next(int i, Unit& u) const {
        const int L = i * G + c, ntile = __builtin_amdgcn_readfirstlane(tb[NE]); if (L >= ntile * NPN) return false;
        const int tl = L / NPN, pn = L % NPN; int e = 0;
        while (e < NE - 1 && __builtin_amdgcn_readfirstlane(tb[e + 1]) <= tl) ++e;
        const int pm = tl - __builtin_amdgcn_readfirstlane(tb[e]), ne = __builtin_amdgcn_readfirstlane(cnt[e]);
        u.pm = pm; u.pn = pn; u.e = e; u.nvalid = ne - pm * 256; u.slot0 = tl * 256;
        if (MODE == 1) {
            u.A0 = A; u.A1 = A;
#pragma unroll
            for (int h = 0; h < 2; ++h)
#pragma unroll
                for (int k = 0; k < 2; ++k) { int Rk, Ck; stage_rc((int)ltid() * 16 + k * 8192, Rk, Ck); int idx = pm * 256 + h * 128 + Rk; idx = idx < ne ? idx : ne - 1; const int entry = list[e * 8192 + idx]; u.va[h][k] = (unsigned)(entry >> 1) * (unsigned)(D * 2) + (unsigned)Ck * 2u; }
            const char* we = W + (size_t)e * 1024 * D * 2;
            u.B0 = we + (size_t)(pn * 128) * D * 2; u.B1 = we + (size_t)(512 + pn * 128) * D * 2;
        } else {
            u.va[0][0] = 0u; u.va[0][1] = 0u; u.va[1][0] = 0u; u.va[1][1] = 0u;
            u.A0 = A + (size_t)tl * 256 * FF * 2; u.A1 = u.A0 + (size_t)HALF * FF * 2;
            const char* we = W + (size_t)e * D * FF * 2;
            u.B0 = we + (size_t)(pn * 256) * FF * 2; u.B1 = u.B0 + (size_t)HALF * FF * 2;
        }
        return true;
    }
};

struct EpiBf16 {
    static constexpr bool PERM = true;
    bf16* O; int ldc;
    __device__ __forceinline__ void operator()(const f32x4 (&acc)[2][2][4][2], const Unit& u, int wr, int wc, int fr, int fq) const {
        const int row0 = u.pm * BM + wr * 64 + fr, col0 = u.pn * BM + wc * 32 + 8 * fq;
#pragma unroll
        for (int ai = 0; ai < 2; ++ai)
#pragma unroll
            for (int m = 0; m < 4; ++m) { bf16* rowp = O + (size_t)(row0 + ai * HALF + m * 16) * ldc + col0;
#pragma unroll
                for (int bj = 0; bj < 2; ++bj) { const f32x4 v0 = acc[ai][bj][m][0], v1 = acc[ai][bj][m][1];
                    u32x4 w; w.x = cvt_pk_bf16(v0[0], v0[1]); w.y = cvt_pk_bf16(v0[2], v0[3]); w.z = cvt_pk_bf16(v1[0], v1[1]); w.w = cvt_pk_bf16(v1[2], v1[3]);
                    *(u32x4*)(rowp + bj * HALF) = w; } }
    }
};
struct EpiMerge {
    static constexpr bool PERM = true;
    bf16* MG; const bf16* gate; int first;
    __device__ __forceinline__ void operator()(const f32x4 (&acc)[2][2][4][2], const Unit& u, int wr, int wc, int fr, int fq) const {
        const int row0 = u.pm * BM + wr * 64 + fr, col0 = u.pn * BM + wc * 32 + 8 * fq;
#pragma unroll
        for (int ai = 0; ai < 2; ++ai)
#pragma unroll
            for (int m = 0; m < 4; ++m) { const size_t row = (size_t)(row0 + ai * HALF + m * 16);
#pragma unroll
                for (int bj = 0; bj < 2; ++bj) { const u32x4 gq = *(const u32x4*)(gate + row * NPAD + col0 + bj * HALF); u32x4 pv = {0u, 0u, 0u, 0u};
                    if (!first) pv = *(const u32x4*)(MG + row * D + col0 + bj * HALF);
                    const f32x4 v0 = acc[ai][bj][m][0], v1 = acc[ai][bj][m][1]; float o[8];
                    const unsigned gw[4] = {gq.x, gq.y, gq.z, gq.w}, pw[4] = {pv.x, pv.y, pv.z, pv.w};
#pragma unroll
                    for (int k = 0; k < 4; ++k) { const float a0 = k < 2 ? v0[2 * k] : v1[2 * k - 4], a1 = k < 2 ? v0[2 * k + 1] : v1[2 * k - 3];
                        const float g0 = __builtin_bit_cast(float, gw[k] << 16), g1 = __builtin_bit_cast(float, gw[k] & 0xffff0000u);
                        o[2 * k] = __builtin_bit_cast(float, pw[k] << 16) + a0 / (1.0f + __expf(-g0)); o[2 * k + 1] = __builtin_bit_cast(float, pw[k] & 0xffff0000u) + a1 / (1.0f + __expf(-g1)); }
                    u32x4 w; w.x = cvt_pk_bf16(o[0], o[1]); w.y = cvt_pk_bf16(o[2], o[3]); w.z = cvt_pk_bf16(o[4], o[5]); w.w = cvt_pk_bf16(o[6], o[7]);
                    *(u32x4*)(MG + row * D + col0 + bj * HALF) = w; } }
    }
};
struct EpiResF32 {
    static constexpr bool PERM = false;
    const float* R; float* O; int ldc;
    __device__ __forceinline__ void operator()(const f32x4 (&acc)[2][2][4][2], const Unit& u, int wr, int wc, int fr, int fq) const {
        const int row0 = u.pm * BM + wr * 64 + fr, col0 = u.pn * BM + wc * 32 + 4 * fq;
#pragma unroll
        for (int ai = 0; ai < 2; ++ai)
#pragma unroll
            for (int m = 0; m < 4; ++m) { const size_t off = (size_t)(row0 + ai * HALF + m * 16) * ldc + col0;
#pragma unroll
                for (int bj = 0; bj < 2; ++bj)
#pragma unroll
                    for (int n = 0; n < 2; ++n) { const f32x4 r = *(const f32x4*)(R + off + bj * HALF + n * 16); *(f32x4*)(O + off + bj * HALF + n * 16) = acc[ai][bj][m][n] + r; } }
    }
};
struct EpiMoe1 {
    static constexpr bool PERM = true;
    bf16* ACT; const int* list; const float* ew;
    __device__ __forceinline__ void operator()(const f32x4 (&acc)[2][2][4][2], const Unit& u, int wr, int wc, int fr, int fq) const {
        const int col0 = u.pn * 128 + wc * 32 + 8 * fq;
#pragma unroll
        for (int ai = 0; ai < 2; ++ai)
#pragma unroll
            for (int m = 0; m < 4; ++m) { const int r = ai * HALF + wr * 64 + m * 16 + fr; float w = 0.f;
                if (r < u.nvalid) { const int entry = list[u.e * 8192 + u.pm * 256 + r]; w = ew[entry]; }
                float o[8];
#pragma unroll
                for (int n = 0; n < 2; ++n)
#pragma unroll
                    for (int j = 0; j < 4; ++j) { const float g = acc[ai][0][m][n][j], up = acc[ai][1][m][n][j]; o[n * 4 + j] = g / (1.0f + __expf(-g)) * up * w; }
                u32x4 pk; pk.x = cvt_pk_bf16(o[0], o[1]); pk.y = cvt_pk_bf16(o[2], o[3]); pk.z = cvt_pk_bf16(o[4], o[5]); pk.w = cvt_pk_bf16(o[6], o[7]);
                *(u32x4*)(ACT + (size_t)(u.slot0 + r) * FF + col0) = pk; }
    }
};
struct EpiMoe2 {
    static constexpr bool PERM = true;
    bf16* CO; const int* list;
    __device__ __forceinline__ void operator()(const f32x4 (&acc)[2][2][4][2], const Unit& u, int wr, int wc, int fr, int fq) const {
        const int col0 = u.pn * BM + wc * 32 + 8 * fq;
#pragma unroll
        for (int ai = 0; ai < 2; ++ai)
#pragma unroll
            for (int m = 0; m < 4; ++m) { const int r = ai * HALF + wr * 64 + m * 16 + fr;
                if (r < u.nvalid) { const int entry = list[u.e * 8192 + u.pm * 256 + r]; bf16* rowp = CO + (size_t)entry * D + col0;
#pragma unroll
                    for (int bj = 0; bj < 2; ++bj) { const f32x4 v0 = acc[ai][bj][m][0], v1 = acc[ai][bj][m][1];
                        u32x4 w; w.x = cvt_pk_bf16(v0[0], v0[1]); w.y = cvt_pk_bf16(v0[2], v0[3]); w.z = cvt_pk_bf16(v1[0], v1[1]); w.w = cvt_pk_bf16(v1[2], v1[3]);
                        *(u32x4*)(rowp + bj * HALF) = w; } } }
    }
};
}

struct Frame {
    LAS unsigned char* lds; volatile LAS unsigned* MISC;
    int tid, lane, wave, vcu, G, gw, NGW, bid;
};
struct Args { const GAS float* in[22]; GAS float* out; GAS unsigned char* ws; int ph_lo, ph_hi, li, pad; };
typedef const __attribute__((address_space(4))) Args KArgs;
__device__ __forceinline__ KArgs* ka_fresh() { unsigned long long p = (unsigned long long)__builtin_amdgcn_kernarg_segment_ptr(); asm volatile("" : "+s"(p)); return (KArgs*)p; }
#define KA KArgs* const ka = ka_fresh()
#define KIN(i) ((const float*)ka->in[i])
#define KWS ((unsigned char*)ka->ws)
#define KOUT ((float*)ka->out)
enum { I_X = 0, I_NMIX, I_WIN, I_PE, I_W1, I_W2, I_QN, I_KN, I_LB, I_HGN, I_WA2, I_BA, I_GLAN, I_WBR, I_WOUT, I_NFFN, I_WGRP, I_BGRP, I_WEXP, I_BEXP, I_WGU, I_WDN };

__device__ __forceinline__ void tr_item(const float* W, size_t ldw, int c0, int nv, bf16* WT, size_t ldt, int r0, int k0, LAS float* scr, int lane) {
    const int nn = lane & 31;
    float tv[32];
#pragma unroll
    for (int i = 0; i < 32; ++i) { const int kk = 2 * i + (lane >> 5); tv[i] = nn < nv ? W[(size_t)(k0 + kk) * ldw + c0 + nn] : 0.f; }
#pragma unroll
    for (int i = 0; i < 32; ++i) { const int kk = 2 * i + (lane >> 5); scr[kk * 33 + nn] = tv[i]; }
    LDS_WAIT();
    const int c = lane & 7;
#pragma unroll
    for (int j = 0; j < 4; ++j) { const int n = (lane >> 3) + 8 * j; const LAS float* s = scr + (8 * c) * 33 + n;
        u32x4 o; o.x = pk2(s[0 * 33], s[1 * 33]); o.y = pk2(s[2 * 33], s[3 * 33]); o.z = pk2(s[4 * 33], s[5 * 33]); o.w = pk2(s[6 * 33], s[7 * 33]);
        if (n < nv) *(u32x4*)(WT + (size_t)(r0 + n) * ldt + k0 + 8 * c) = o; }
    LDS_WAIT();
}
__device__ __forceinline__ void phase_prologue(Frame& F) {
    KA;
    {
      bf16* W1T = (bf16*)(KWS + WS_CW); bf16* W2T = (bf16*)(KWS + WS_CW + 1048576); float* B1 = (float*)(KWS + WS_CW + 1572864);
      for (int i = F.bid * 512 + F.tid; i < NL * 2 * 64 * 2048; i += F.G * 512) { const int lk = i / (64 * 2048), j = (i / 2048) % 64, c = i % 2048; W1T[i] = (bf16)f2bf(KIN(I_W1)[((size_t)lk * 2048 + c) * 64 + j]); }
      for (int i = F.bid * 512 + F.tid; i < NL * 2 * 64 * 64; i += F.G * 512) { const int lk = i / 4096, j2 = (i / 64) % 64, j = i % 64; W2T[i] = (bf16)f2bf(KIN(I_W2)[((size_t)lk * 64 + j) * 64 + j2]); }
      if (F.bid < NL * 2) { const int lk = F.bid, j = F.tid & 63, part = F.tid >> 6; float a = 0.f;
#pragma unroll 8
          for (int c = part * 256; c < part * 256 + 256; ++c) a += KIN(I_PE)[(size_t)lk * 2048 + c] * KIN(I_W1)[((size_t)lk * 2048 + c) * 64 + j];
          LAS float* rd = (LAS float*)F.lds; rd[F.tid] = a; __syncthreads();
          if (F.tid < 64) { float t2 = 0.f;
#pragma unroll
              for (int p = 0; p < 8; ++p) t2 += rd[p * 64 + F.tid];
              B1[lk * 64 + F.tid] = t2; }
          __syncthreads(); } }
    { float* WRT = (float*)(KWS + WS_WRT);
      for (int i = F.bid * 512 + F.tid; i < NL * 48 * D; i += F.G * 512) { const int l = i / (48 * D), n = (i / D) % 48, k = i % D; const float g = KIN(I_NFFN)[l * D + k];
          WRT[i] = n < 32 ? g * KIN(I_WEXP)[((size_t)l * D + k) * 32 + n] : (n < 36 ? g * KIN(I_WGRP)[((size_t)l * D + k) * 4 + (n - 32)] : 0.f); } }
    LAS float* scr = (LAS float*)(F.lds + F.wave * 16384);
    constexpr int IT_WIN = 32 * 346, IT_WBR = 3 * 8 * 64, IT_WOUT = 32 * 64, IT_WGU = 32 * 32 * 32, IT_WDN = 32 * 8 * 64, IT_L = IT_WIN + IT_WBR + IT_WOUT + IT_WGU + IT_WDN;
    for (int it = F.gw; it < NL * IT_L; it += F.NGW) {
        const int l = it / IT_L; int r = it % IT_L;
        if (r < IT_WIN) { const int kb = r / 346, nb = r % 346; int src, dst, nv = 32;
            if (nb < 40) { src = nb * 32; dst = nb * 32; }
            else if (nb == 40) { src = 1280; dst = C_NG; nv = 24; }
            else if (nb < 153) { src = 1304 + 32 * (nb - 41); dst = 1280 + 32 * (nb - 41); }
            else if (nb == 153) { src = 4888; dst = C_GA; nv = 16; }
            else { src = 4904 + 32 * (nb - 154); dst = C_MG + 32 * (nb - 154); }
            tr_item(KIN(I_WIN) + (size_t)l * D * INC, INC, src, nv, (bf16*)(KWS + WS_WIN) + (size_t)l * NPAD * D, D, dst, kb * 64, scr, F.lane); continue; }
        r -= IT_WIN;
        if (r < IT_WBR) { const int n = r / 512, q = r % 512, kb = q / 64, nb = q % 64;
            tr_item(KIN(I_WBR) + ((size_t)l * 3 + n) * 512 * D, D, nb * 32, 32, (bf16*)(KWS + WS_WBR) + ((size_t)l * 3 + n) * D * 512, 512, nb * 32, kb * 64, scr, F.lane); continue; }
        r -= IT_WBR;
        if (r < IT_WOUT) { const int kb = r / 64, nb = r % 64;
            tr_item(KIN(I_WOUT) + (size_t)l * D * D, D, nb * 32, 32, (bf16*)(KWS + WS_WOUT) + (size_t)l * D * D, D, nb * 32, kb * 64, scr, F.lane); continue; }
        r -= IT_WOUT;
        if (r < IT_WGU) { const int e = r / 1024, q = r % 1024, kb = q / 32, nb = q % 32;
            tr_item(KIN(I_WGU) + ((size_t)l * NE + e) * D * 1024, 1024, nb * 32, 32, (bf16*)(KWS + WS_WGU) + ((size_t)l * NE + e) * 1024 * D, D, nb * 32, kb * 64, scr, F.lane); continue; }
        r -= IT_WGU;
        { const int e = r / 512, q = r % 512, kb = q / 64, nb = q % 64;
            tr_item(KIN(I_WDN) + ((size_t)l * NE + e) * FF * D, D, nb * 32, 32, (bf16*)(KWS + WS_WDN) + ((size_t)l * NE + e) * D * FF, FF, nb * 32, kb * 64, scr, F.lane); }
    }
}

template <int MODE> __device__ __forceinline__ void phase_norm1(Frame& F, const float* xin, const bf16* contrib, float* xout, const float* gain, bf16* H) {
    for (int t = F.gw; t < T; t += F.NGW) {
        const f32x4* xr = (const f32x4*)(xin + (size_t)t * D) + F.lane;
        f32x4 v[8]; float ss = 0.f;
#pragma unroll
        for (int j = 0; j < 8; ++j) { v[j] = xr[64 * j];
            if (MODE != 0) { const u32x2 c0 = *((const u32x2*)(contrib + (size_t)(2 * t) * D) + F.lane + 64 * j), c1 = *((const u32x2*)(contrib + (size_t)(2 * t + 1) * D) + F.lane + 64 * j);
                v[j].x += bflo(c0.x) + bflo(c1.x); v[j].y += bfhi(c0.x) + bfhi(c1.x); v[j].z += bflo(c0.y) + bflo(c1.y); v[j].w += bfhi(c0.y) + bfhi(c1.y);
                *((f32x4*)(xout + (size_t)t * D) + F.lane + 64 * j) = v[j]; }
            ss += v[j].x * v[j].x + v[j].y * v[j].y + v[j].z * v[j].z + v[j].w * v[j].w; }
        if (MODE != 2) {
            const float rstd = 1.0f / sqrtf(wave_sum(ss) * (1.0f / D) + EPS);
#pragma unroll
            for (int j = 0; j < 8; ++j) { const f32x4 g = *((const f32x4*)gain + F.lane + 64 * j);
                u32x2 o; o.x = pk2(v[j].x * rstd * g.x, v[j].y * rstd * g.y); o.y = pk2(v[j].z * rstd * g.z, v[j].w * rstd * g.w);
                *((u32x2*)(H + (size_t)t * D) + F.lane + 64 * j) = o; }
        }
    }
}

__device__ __forceinline__ void phase_prep(Frame& F, int l) {
    KA;
    const bf16* P = (const bf16*)(KWS + WS_P);
    float* QN = (float*)(KWS + WS_QN); float* KV = (float*)(KWS + WS_KV);
    const float* qg = KIN(I_QN) + l * 64; const float* kg = KIN(I_KN) + l * 192;
    for (int it = F.gw; it < T * 20; it += F.NGW) {
        const int t = it / 20, v = it % 20;
        float x = bf2f(P[(size_t)t * NPAD + v * 64 + F.lane]);
        const bool isq = v < 8, nk1 = (v == 12 || v == 13), nk2 = (v == 16 || v == 17);
        if (isq || nk1 || nk2) { const float ss = wave_sum(x * x); const float g = isq ? qg[F.lane] : (nk1 ? kg[64 + F.lane] : kg[128 + F.lane]); x = x * (1.0f / sqrtf(ss * (1.0f / 64.0f) + EPS)) * g; }
        if (isq) QN[((size_t)v * T + t) * 64 + F.lane] = x;
        else { const int w = v - 8, tens = w >> 1, g = w & 1; KV[(size_t)tens * KV_STRIDE + ((size_t)g * T + t) * 64 + F.lane] = x; }
    }
}
__device__ __forceinline__ float gelu_tanh(float x) { const float u = 0.7978845608028654f * (x + 0.044715f * x * x * x); return 0.5f * x * (1.0f + tanhf(u)); }
__device__ __forceinline__ void phase_compress(Frame& F, int l) {
    KA;
    LAS float* av = (LAS float*)(F.lds + F.wave * 16384);
    const float* KV = (const float*)(KWS + WS_KV); float* KC = (float*)(KWS + WS_KC);
    for (int it = F.gw; it < 2 * 2 * 511; it += F.NGW) {
        const int kind = it / 1022, q = it % 1022, g = q / 511, n = q % 511;
        const float* src = KV + (size_t)kind * KV_STRIDE + ((size_t)g * T + 16 * n) * 64;
        const float* pe = KIN(I_PE) + ((size_t)l * 2 + kind) * 2048;
        const float* w1 = KIN(I_W1) + ((size_t)l * 2 + kind) * 2048 * 64;
        const float* w2 = KIN(I_W2) + ((size_t)l * 2 + kind) * 64 * 64;
#pragma unroll 4
        for (int c = 0; c < 32; ++c) av[c * 64 + F.lane] = src[c * 64 + F.lane] + pe[c * 64 + F.lane];
        WSYNC();
        float acc = 0.f;
#pragma unroll 8
        for (int i = 0; i < 2048; ++i) acc += av[i] * w1[i * 64 + F.lane];
        const float hid = gelu_tanh(acc);
        WSYNC();
        av[F.lane] = hid;
        WSYNC();
        float o = 0.f;
#pragma unroll 8
        for (int i = 0; i < 64; ++i) o += av[i] * w2[i * 64 + F.lane];
        WSYNC();
        if (kind == 0) { const float ss = wave_sum(o * o); o = o * (1.0f / sqrtf(ss * (1.0f / 64.0f) + EPS)) * KIN(I_KN)[l * 192 + F.lane]; }
        KC[(size_t)kind * (2 * 512 * 64) + ((size_t)g * 512 + n) * 64 + F.lane] = o;
    }
}
__device__ __forceinline__ void phase_recur(Frame& F, int l) {
    KA;
    const bf16* P = (const bf16*)(KWS + WS_P); float* ORAW = (float*)(KWS + WS_ORAW);
    for (int it = F.gw; it < 1024; it += F.NGW) {
        const int kind = it >> 9, head = (it >> 7) & 3, j = it & 127;
        if (kind == 0) {
            const int d0 = F.lane, d1 = F.lane + 64;
            const float* lbl = KIN(I_LB);
            float lb0, lb1;
            { const float a0 = lbl[head * 128 + d0], b0 = lbl[512 + head * 128 + d0], a1 = lbl[head * 128 + d1], b1 = lbl[512 + head * 128 + d1];
              lb0 = l == 0 ? 0.f : 1.0f / (1.0f + expf(a0 - b0)); lb1 = l == 0 ? 0.f : 1.0f / (1.0f + expf(a1 - b1)); }
            const bf16* Pq = P + C_HQ + head * 128; const bf16* Pf = P + C_HF + head * 128; const bf16* Pi = P + C_HI + head * 128 + j;
            float S0 = 0.f, S1 = 0.f;
            for (int t0 = 0; t0 < T; t0 += 8) {
                bf16 zq0[8], zq1[8], zf0[8], zf1[8], vi[8];
#pragma unroll
                for (int u = 0; u < 8; ++u) { const size_t row = (size_t)(t0 + u) * NPAD; zq0[u] = Pq[row + d0]; zq1[u] = Pq[row + d1]; zf0[u] = Pf[row + d0]; zf1[u] = Pf[row + d1]; vi[u] = Pi[row]; }
                float part[8];
#pragma unroll
                for (int u = 0; u < 8; ++u) { const float v = bf2f(vi[u]);
                    const float s0 = sigmoidf_(bf2f(zf0[u])), s1 = sigmoidf_(bf2f(zf1[u]));
                    const float f0 = lb0 + (1.0f - lb0) * s0, f1 = lb1 + (1.0f - lb1) * s1;
                    const float k0 = (1.0f - lb0) * (1.0f - s0), k1 = (1.0f - lb1) * (1.0f - s1);
                    S0 = f0 * S0 + k0 * v; S1 = f1 * S1 + k1 * v;
                    part[u] = bf2f(zq0[u]) * S0 + bf2f(zq1[u]) * S1; }
                float mine = 0.f;
#pragma unroll
                for (int u = 0; u < 8; ++u) { const float s = wave_sum(part[u]); mine = (F.lane == u) ? s : mine; }
                if (F.lane < 8) ORAW[(size_t)(t0 + F.lane) * 1024 + head * 128 + j] = mine;
            }
        } else {
            const int d = F.lane, c = head * 64 + d;
            float wa[16];
#pragma unroll
            for (int r = 0; r < 16; ++r) wa[r] = KIN(I_WA2)[((size_t)l * 16 + r) * 256 + c];
            const float ba = KIN(I_BA)[l * 256 + c];
            const bf16* Pq = P + C_GQ + c; const bf16* Pk = P + C_GK + c; const bf16* Pv = P + C_GV + head * 128 + j; const bf16* Pa = P + C_GA;
            float S = 0.f;
            for (int t0 = 0; t0 < T; t0 += 8) {
                bf16 zq[8], zk[8], zv[8]; u32x4 ga0[8], ga1[8];
#pragma unroll
                for (int u = 0; u < 8; ++u) { const size_t row = (size_t)(t0 + u) * NPAD; zq[u] = Pq[row]; zk[u] = Pk[row]; zv[u] = Pv[row]; ga0[u] = *(const u32x4*)(Pa + row); ga1[u] = *(const u32x4*)(Pa + row + 8); }
                float part[8];
#pragma unroll
                for (int u = 0; u < 8; ++u) {
                    float a = ba;
                    a += bflo(ga0[u].x) * wa[0] + bfhi(ga0[u].x) * wa[1] + bflo(ga0[u].y) * wa[2] + bfhi(ga0[u].y) * wa[3] + bflo(ga0[u].z) * wa[4] + bfhi(ga0[u].z) * wa[5] + bflo(ga0[u].w) * wa[6] + bfhi(ga0[u].w) * wa[7];
                    a += bflo(ga1[u].x) * wa[8] + bfhi(ga1[u].x) * wa[9] + bflo(ga1[u].y) * wa[10] + bfhi(ga1[u].y) * wa[11] + bflo(ga1[u].z) * wa[12] + bfhi(ga1[u].z) * wa[13] + bflo(ga1[u].w) * wa[14] + bfhi(ga1[u].w) * wa[15];
                    const float ls = fminf(a, 0.f) - log1pf(expf(-fabsf(a)));
                    const float f = expf(ls * (1.0f / 16.0f));
                    S = f * S + bf2f(zk[u]) * bf2f(zv[u]);
                    part[u] = bf2f(zq[u]) * 0.125f * S; }
                float mine = 0.f;
#pragma unroll
                for (int u = 0; u < 8; ++u) { const float s = wave_sum(part[u]); mine = (F.lane == u) ? s : mine; }
                if (F.lane < 8) ORAW[(size_t)(t0 + F.lane) * 1024 + 512 + head * 128 + j] = mine;
            }
        }
    }
}
__device__ __forceinline__ void phase_recur_out(Frame& F, int l) {
    KA;
    const bf16* P = (const bf16*)(KWS + WS_P); const float* ORAW = (const float*)(KWS + WS_ORAW); bf16* OCAT = (bf16*)(KWS + WS_OCAT);
    for (int it = F.gw; it < T * 8; it += F.NGW) {
        const int t = it >> 3, kind = (it >> 2) & 1, head = it & 3;
        const float* gn = (kind == 0 ? KIN(I_HGN) : KIN(I_GLAN)) + l * 128;
        const int cg = (kind == 0 ? C_HG : C_GR) + head * 128;
        const float r0 = ORAW[(size_t)t * 1024 + kind * 512 + head * 128 + F.lane], r1 = ORAW[(size_t)t * 1024 + kind * 512 + head * 128 + 64 + F.lane];
        const float rstd = 1.0f / sqrtf(wave_sum(r0 * r0 + r1 * r1) * (1.0f / 128.0f) + EPS);
        const float g0 = bf2f(P[(size_t)t * NPAD + cg + F.lane]), g1 = bf2f(P[(size_t)t * NPAD + cg + 64 + F.lane]);
        const float a0 = kind == 0 ? sigmoidf_(g0) : g0 * sigmoidf_(g0), a1 = kind == 0 ? sigmoidf_(g1) : g1 * sigmoidf_(g1);
        OCAT[(size_t)t * 1536 + 512 + kind * 512 + head * 128 + F.lane] = (bf16)f2bf(r0 * rstd * gn[F.lane] * a0);
        OCAT[(size_t)t * 1536 + 512 + kind * 512 + head * 128 + 64 + F.lane] = (bf16)f2bf(r1 * rstd * gn[64 + F.lane] * a1);
    }
}


template <int KIND> struct RecCfg { static constexpr int DK = KIND == 0 ? 128 : 64, NSEG = 512 / DK, TPS = 64 / NSEG, QROW = (DK + 8) * 2; };
constexpr int REC_VT_OFF = 0;
constexpr int REC_KD_OFF = 18432;
constexpr int REC_QS_OFF = 36864;
constexpr int REC_KS_OFF = 54272;
constexpr int REC_QD_OFF = 71680;
constexpr int REC_RED_OFF = 89088;
constexpr int REC_TOT_OFF = 91136;
__device__ __forceinline__ float expc(float x) { return __expf(fminf(x, 80.0f)); }
template <int KIND> __device__ __forceinline__ void rec_elem(KArgs* ka, int l, int head, int chunk, int tid, LAS float* tot,
        float (&qv)[RecCfg<KIND>::TPS], float (&kv)[RecCfg<KIND>::TPS], float (&bv)[RecCfg<KIND>::TPS], float& bend, float& bref) {
    constexpr int DK = RecCfg<KIND>::DK, NSEG = RecCfg<KIND>::NSEG, TPS = RecCfg<KIND>::TPS;
    const int d = tid % DK, seg = tid / DK, t0 = chunk * 64 + seg * TPS;
    const bf16* P = (const bf16*)(KWS + WS_P);
    float run = 0.f;
    if (KIND == 0) {
        const int c = head * 128 + d;
        float lb = 0.f;
        if (l > 0) { const float a0 = KIN(I_LB)[c], b0 = KIN(I_LB)[512 + c]; lb = 1.0f / (1.0f + expf(a0 - b0)); }
#pragma unroll
        for (int u = 0; u < TPS; ++u) { const size_t row = (size_t)(t0 + u) * NPAD;
            const float z = bf2f(P[row + C_HF + c]); qv[u] = bf2f(P[row + C_HQ + c]);
            const float sg = 1.0f / (1.0f + __expf(-z)), f = lb + (1.0f - lb) * sg;
            kv[u] = (1.0f - lb) * (1.0f - sg); run += __logf(fmaxf(f, 1e-30f)); bv[u] = run; }
    } else {
        const int c = head * 64 + d;
        float wa[16];
#pragma unroll
        for (int r = 0; r < 16; ++r) wa[r] = KIN(I_WA2)[((size_t)l * 16 + r) * 256 + c];
        const float ba = KIN(I_BA)[l * 256 + c];
#pragma unroll
        for (int u = 0; u < TPS; ++u) { const size_t row = (size_t)(t0 + u) * NPAD;
            const u32x4 g0 = *(const u32x4*)(P + row + C_GA), g1 = *(const u32x4*)(P + row + C_GA + 8);
            float a = ba;
            a += bflo(g0.x) * wa[0] + bfhi(g0.x) * wa[1] + bflo(g0.y) * wa[2] + bfhi(g0.y) * wa[3] + bflo(g0.z) * wa[4] + bfhi(g0.z) * wa[5] + bflo(g0.w) * wa[6] + bfhi(g0.w) * wa[7];
            a += bflo(g1.x) * wa[8] + bfhi(g1.x) * wa[9] + bflo(g1.y) * wa[10] + bfhi(g1.y) * wa[11] + bflo(g1.z) * wa[12] + bfhi(g1.z) * wa[13] + bflo(g1.w) * wa[14] + bfhi(g1.w) * wa[15];
            const float ls = fminf(a, 0.f) - log1pf(__expf(-fabsf(a)));
            qv[u] = bf2f(P[row + C_GQ + c]) * 0.125f; kv[u] = bf2f(P[row + C_GK + c]);
            run += ls * (1.0f / 16.0f); bv[u] = run; }
    }
    tot[seg * DK + d] = run;
    __syncthreads();
    float off = 0.f; bend = 0.f; bref = 0.f;
#pragma unroll
    for (int sgi = 0; sgi < NSEG; ++sgi) { const float v = tot[sgi * DK + d]; off += sgi < seg ? v : 0.f; bref += sgi < NSEG / 2 ? v : 0.f; bend += v; }
#pragma unroll
    for (int u = 0; u < TPS; ++u) bv[u] += off;
}
template <int KIND> __device__ __forceinline__ void rec_vt(KArgs* ka, int head, int chunk, int tid, LAS unsigned char* lds) {
    const bf16* P = (const bf16*)(KWS + WS_P) + (KIND == 0 ? C_HI : C_GV) + head * 128;
    const int v = tid & 127, sv = tid >> 7; unsigned w[8];
#pragma unroll
    for (int u = 0; u < 8; ++u) { const unsigned a = P[(size_t)(chunk * 64 + sv * 16 + 2 * u) * NPAD + v], b = P[(size_t)(chunk * 64 + sv * 16 + 2 * u + 1) * NPAD + v]; w[u] = a | (b << 16); }
    LAS u32x4* dst = (LAS u32x4*)(lds + REC_VT_OFF + v * 144 + sv * 32);
    dst[0] = (u32x4){w[0], w[1], w[2], w[3]}; dst[1] = (u32x4){w[4], w[5], w[6], w[7]};
}
template <int KIND> __device__ __forceinline__ void rec_local_unit(KArgs* ka, Frame& F, int l, int head, int chunk) {
    constexpr int DK = RecCfg<KIND>::DK, TPS = RecCfg<KIND>::TPS;
    LAS unsigned char* lds = F.lds; LAS float* tot = (LAS float*)(lds + REC_TOT_OFF);
    float qv[TPS], kv[TPS], bv[TPS], bend, bref;
    rec_elem<KIND>(ka, l, head, chunk, F.tid, tot, qv, kv, bv, bend, bref);
    const int d = F.tid % DK, seg = F.tid / DK, unit = chunk * 4 + head;
    { unsigned w[TPS / 2];
#pragma unroll
      for (int u = 0; u < TPS / 2; ++u) w[u] = pk2(kv[2 * u] * expc(bend - bv[2 * u]), kv[2 * u + 1] * expc(bend - bv[2 * u + 1]));
      LAS u32x4* dst = (LAS u32x4*)(lds + REC_KD_OFF + d * 144 + seg * TPS * 2);
      dst[0] = (u32x4){w[0], w[1], w[2], w[3]};
      if constexpr (TPS == 16) dst[1] = (u32x4){w[4], w[5], w[6], w[7]}; }
    if (seg == 0) ((float*)(KWS + WS_DEC + (KIND == 0 ? 0 : 262144)))[(size_t)unit * DK + d] = __expf(bend);
    rec_vt<KIND>(ka, head, chunk, F.tid, lds);
    __syncthreads();
    const int r = F.lane & 15, kq = F.lane >> 4;
    const int dt = KIND == 0 ? F.wave : (F.wave & 3), vt0 = KIND == 0 ? 0 : (F.wave >> 2) * 4, nvt = KIND == 0 ? 8 : 4;
    bf16x8 a[2];
#pragma unroll
    for (int ks = 0; ks < 2; ++ks) a[ks] = *(const LAS bf16x8*)(lds + REC_KD_OFF + (16 * dt + r) * 144 + (32 * ks + 8 * kq) * 2);
    float* Sl = (float*)(KWS + (KIND == 0 ? WS_SLOC_HG : WS_SLOC_GL)) + (size_t)unit * 128 * DK;
#pragma unroll
    for (int vi = 0; vi < nvt; ++vi) { const int vt = vt0 + vi; f32x4 acc = {0.f, 0.f, 0.f, 0.f};
#pragma unroll
        for (int ks = 0; ks < 2; ++ks) { const bf16x8 b = *(const LAS bf16x8*)(lds + REC_VT_OFF + (16 * vt + r) * 144 + (32 * ks + 8 * kq) * 2); acc = __builtin_amdgcn_mfma_f32_16x16x32_bf16(a[ks], b, acc, 0, 0, 0); }
        *(f32x4*)(Sl + (size_t)(16 * vt + r) * DK + 16 * dt + 4 * kq) = acc; }
    __syncthreads();
}
__device__ __forceinline__ void phase_rec_local(Frame& F, int l) {
    KA;
    for (int it = F.bid; it < 1024; it += F.G) { const int kind = it >> 9, chunk = (it >> 2) & 127, head = it & 3;
        if (kind == 0) rec_local_unit<0>(ka, F, l, head, chunk); else rec_local_unit<1>(ka, F, l, head, chunk); }
}
__device__ __forceinline__ void phase_rec_scan(Frame& F) {
    KA;
    const int gt = F.bid * 512 + F.tid;
    if (gt >= 49152) return;
    const bool hg = gt < 32768; const int q = hg ? gt : gt - 32768;
    const int DK = hg ? 128 : 64, dp = q % (DK / 2), v = (q / (DK / 2)) & 127, head = q / (DK / 2 * 128);
    const float* Sl = (const float*)(KWS + (hg ? WS_SLOC_HG : WS_SLOC_GL)) + ((size_t)head * 128 + v) * DK + 2 * dp;
    bf16* Sp = (bf16*)(KWS + (hg ? WS_SPREV_HG : WS_SPREV_GL)) + ((size_t)head * 128 + v) * DK + 2 * dp;
    const float* De = (const float*)(KWS + WS_DEC + (hg ? 0 : 262144)) + (size_t)head * DK + 2 * dp;
    const size_t ustr = (size_t)4 * 128 * DK, dstr = (size_t)4 * DK;
    float s0 = 0.f, s1 = 0.f;
    for (int c0 = 0; c0 < NCH; c0 += 8) { f32x2 x[8], dc[8];
#pragma unroll
        for (int u = 0; u < 8; ++u) { x[u] = *(const f32x2*)(Sl + (size_t)(c0 + u) * ustr); dc[u] = *(const f32x2*)(De + (size_t)(c0 + u) * dstr); }
#pragma unroll
        for (int u = 0; u < 8; ++u) { *(unsigned*)(Sp + (size_t)(c0 + u) * ustr) = pk2(s0, s1); s0 = dc[u].x * s0 + x[u].x; s1 = dc[u].y * s1 + x[u].y; } }
}
template <int KIND> __device__ __forceinline__ void rec_out_unit(KArgs* ka, Frame& F, int l, int head, int chunk) {
    constexpr int DK = RecCfg<KIND>::DK, TPS = RecCfg<KIND>::TPS, QROW = RecCfg<KIND>::QROW, NKS = DK / 32;
    LAS unsigned char* lds = F.lds; LAS float* tot = (LAS float*)(lds + REC_TOT_OFF); LAS float* red = (LAS float*)(lds + REC_RED_OFF);
    const int r = F.lane & 15, kq = F.lane >> 4, unit = chunk * 4 + head, vt = F.wave;
    bf16x8 sa[NKS];
    { const bf16* Sp = (const bf16*)(KWS + (KIND == 0 ? WS_SPREV_HG : WS_SPREV_GL)) + (size_t)unit * 128 * DK + (size_t)(16 * vt + r) * DK + 8 * kq;
#pragma unroll
      for (int ks = 0; ks < NKS; ++ks) sa[ks] = *(const bf16x8*)(Sp + 32 * ks); }
    float qv[TPS], kv[TPS], bv[TPS], bend, bref;
    rec_elem<KIND>(ka, l, head, chunk, F.tid, tot, qv, kv, bv, bend, bref);
    { const int d = F.tid % DK, seg = F.tid / DK;
#pragma unroll
      for (int u = 0; u < TPS; ++u) { const int tok = seg * TPS + u; const int o = tok * QROW + d * 2;
          *(LAS bf16*)(lds + REC_QS_OFF + o) = (bf16)f2bf(qv[u] * expc(bv[u] - bref));
          *(LAS bf16*)(lds + REC_KS_OFF + o) = (bf16)f2bf(kv[u] * expc(bref - bv[u]));
          *(LAS bf16*)(lds + REC_QD_OFF + o) = (bf16)f2bf(qv[u] * __expf(bv[u])); } }
    rec_vt<KIND>(ka, head, chunk, F.tid, lds);
    __syncthreads();
#pragma unroll
    for (int tt = 0; tt < 2; ++tt) { const int tile = F.wave * 2 + tt, jt = tile >> 2, it = tile & 3; f32x4 acc = {0.f, 0.f, 0.f, 0.f};
        if (jt <= it) {
#pragma unroll
            for (int ks = 0; ks < NKS; ++ks) { const bf16x8 a = *(const LAS bf16x8*)(lds + REC_KS_OFF + (16 * jt + r) * QROW + (32 * ks + 8 * kq) * 2), b = *(const LAS bf16x8*)(lds + REC_QS_OFF + (16 * it + r) * QROW + (32 * ks + 8 * kq) * 2);
                acc = __builtin_amdgcn_mfma_f32_16x16x32_bf16(a, b, acc, 0, 0, 0); } }
        const int i = 16 * it + r, j0 = 16 * jt + 4 * kq;
        u32x2 w; w.x = pk2(j0 <= i ? acc[0] : 0.f, j0 + 1 <= i ? acc[1] : 0.f); w.y = pk2(j0 + 2 <= i ? acc[2] : 0.f, j0 + 3 <= i ? acc[3] : 0.f);
        *(LAS u32x2*)(lds + REC_KD_OFF + i * 144 + j0 * 2) = w; }
    __syncthreads();
    f32x4 acc[4];
#pragma unroll
    for (int it = 0; it < 4; ++it) acc[it] = (f32x4){0.f, 0.f, 0.f, 0.f};
#pragma unroll
    for (int ks = 0; ks < 2; ++ks) { const bf16x8 a = *(const LAS bf16x8*)(lds + REC_VT_OFF + (16 * vt + r) * 144 + (32 * ks + 8 * kq) * 2);
#pragma unroll
        for (int it = 0; it < 4; ++it) { const bf16x8 b = *(const LAS bf16x8*)(lds + REC_KD_OFF + (16 * it + r) * 144 + (32 * ks + 8 * kq) * 2); acc[it] = __builtin_amdgcn_mfma_f32_16x16x32_bf16(a, b, acc[it], 0, 0, 0); } }
#pragma unroll
    for (int ks = 0; ks < NKS; ++ks) {
#pragma unroll
        for (int it = 0; it < 4; ++it) { const bf16x8 b = *(const LAS bf16x8*)(lds + REC_QD_OFF + (16 * it + r) * QROW + (32 * ks + 8 * kq) * 2); acc[it] = __builtin_amdgcn_mfma_f32_16x16x32_bf16(sa[ks], b, acc[it], 0, 0, 0); } }
#pragma unroll
    for (int it = 0; it < 4; ++it) { float ss = acc[it][0] * acc[it][0] + acc[it][1] * acc[it][1] + acc[it][2] * acc[it][2] + acc[it][3] * acc[it][3];
        ss += __shfl_xor(ss, 16); ss += __shfl_xor(ss, 32);
        if (kq == 0) red[F.wave * 64 + 16 * it + r] = ss; }
    __syncthreads();
    const bf16* P = (const bf16*)(KWS + WS_P); bf16* OCAT = (bf16*)(KWS + WS_OCAT);
    const int v0 = 16 * vt + 4 * kq;
    const f32x4 gn = *(const f32x4*)((KIND == 0 ? KIN(I_HGN) : KIN(I_GLAN)) + l * 128 + v0);
#pragma unroll
    for (int it = 0; it < 4; ++it) { const int i = 16 * it + r, t = chunk * 64 + i; float tot_ = 0.f;
#pragma unroll
        for (int w = 0; w < 8; ++w) tot_ += red[w * 64 + i];
        const float rstd = 1.0f / sqrtf(tot_ * (1.0f / 128.0f) + EPS);
        const u32x2 gq = *(const u32x2*)(P + (size_t)t * NPAD + (KIND == 0 ? C_HG : C_GR) + head * 128 + v0);
        float gt[4] = {bflo(gq.x), bfhi(gq.x), bflo(gq.y), bfhi(gq.y)}, o[4];
#pragma unroll
        for (int e = 0; e < 4; ++e) { const float sg = 1.0f / (1.0f + __expf(-gt[e])); o[e] = acc[it][e] * rstd * gn[e] * (KIND == 0 ? sg : gt[e] * sg); }
        u32x2 w; w.x = pk2(o[0], o[1]); w.y = pk2(o[2], o[3]);
        *(u32x2*)(OCAT + (size_t)t * 1536 + 512 + KIND * 512 + head * 128 + v0) = w; }
    __syncthreads();
}
__device__ __forceinline__ void phase_rec_out(Frame& F, int l) {
    KA;
    for (int it = F.bid; it < 1024; it += F.G) { const int kind = it >> 9, chunk = (it >> 2) & 127, head = it & 3;
        if (kind == 0) rec_out_unit<0>(ka, F, l, head, chunk); else rec_out_unit<1>(ka, F, l, head, chunk); }
}

template <bool WIN> __device__ __forceinline__ void nsa_block(const float* Kg, const float* Vg, int j, int t, int lane, const LAS float* qs, LAS float* pb, const float (&slope)[4], float (&M)[4], float (&L)[4], float (&o)[4]) {
    const int pos = 64 * j + lane, dist = t - pos;
    const bool valid = WIN ? (dist >= 0 && dist < 512) : (dist >= 0);
    float dot[4] = {0.f, 0.f, 0.f, 0.f};
    const f32x4* kr = (const f32x4*)(Kg + (size_t)pos * 64);
#pragma unroll 2
    for (int c = 0; c < 16; ++c) { const f32x4 kv = kr[c];
#pragma unroll
        for (int r = 0; r < 4; ++r) { const f32x4 qv = *(const LAS f32x4*)(qs + r * 64 + c * 4); dot[r] += kv.x * qv.x + kv.y * qv.y + kv.z * qv.z + kv.w * qv.w; } }
#pragma unroll
    for (int r = 0; r < 4; ++r) {
        const float s = valid ? dot[r] * 0.125f - slope[r] * (float)dist : NEGB;
        const float nm = fmaxf(M[r], wave_max(s)), sc = expf(M[r] - nm), p = valid ? expf(s - nm) : 0.f;
        L[r] = L[r] * sc + wave_sum(p); o[r] *= sc; M[r] = nm; pb[r * 64 + lane] = p;
    }
    WSYNC();
#pragma unroll 4
    for (int k = 0; k < 64; ++k) { const float v = Vg[(size_t)(64 * j + k) * 64 + lane];
#pragma unroll
        for (int r = 0; r < 4; ++r) o[r] += pb[r * 64 + k] * v; }
    WSYNC();
}
__device__ __forceinline__ void phase_nsa(Frame& F, int l) {
    KA;
    LAS float* qs = (LAS float*)(F.lds + F.wave * 8192);
    LAS float* pbuf = qs + 256;
    LAS float* scb = pbuf + 512;
    LAS float* pb = scb + 128;
    LAS float* impb = pb + 256;
    LAS float* ocb = impb + 512;
    const bf16* P = (const bf16*)(KWS + WS_P); bf16* OCAT = (bf16*)(KWS + WS_OCAT);
    const float* QN = (const float*)(KWS + WS_QN); const float* KV = (const float*)(KWS + WS_KV); const float* KC = (const float*)(KWS + WS_KC);
    const int lane = F.lane;
    for (int it = F.gw; it < T * 2; it += F.NGW) {
        const int t = it >> 1, g = it & 1;
        float slope[4];
#pragma unroll
        for (int r = 0; r < 4; ++r) { slope[r] = exp2f(-(float)(g * 4 + r + 1)); qs[r * 64 + lane] = QN[((size_t)(g * 4 + r) * T + t) * 64 + lane]; }
        WSYNC();
        int nvis = t >= 31 ? (t - 31) / 16 + 1 : 0; nvis = nvis > 511 ? 511 : nvis;
        const float* KCg = KC + (size_t)g * 512 * 64; const float* VCg = KC + (size_t)(2 * 512 * 64) + (size_t)g * 512 * 64;
#pragma unroll 1
        for (int i = 0; i < 8; ++i) impb[lane + 64 * i] = 0.f;
#pragma unroll 1
        for (int r = 0; r < 4; ++r) {
            const float sl = exp2f(-(float)(g * 4 + r + 1));
            float mx = NEGB;
#pragma unroll 1
            for (int i = 0; i < 8; ++i) { const int n = lane + 64 * i; float sv = NEGB;
                if (n < nvis) { const f32x4* kr = (const f32x4*)(KCg + (size_t)n * 64); float dot = 0.f;
#pragma unroll 4
                    for (int c = 0; c < 16; ++c) { const f32x4 kv = kr[c]; const f32x4 qv = *(const LAS f32x4*)(qs + r * 64 + c * 4); dot += kv.x * qv.x + kv.y * qv.y + kv.z * qv.z + kv.w * qv.w; }
                    sv = dot * 0.125f - sl * (float)(t - 16 * n - 31); }
                pbuf[n] = sv; mx = fmaxf(mx, sv); }
            mx = wave_max(mx);
            float sum = 0.f;
#pragma unroll 1
            for (int i = 0; i < 8; ++i) { const int n = lane + 64 * i; const float e = n < nvis ? expf(pbuf[n] - mx) : 0.f; pbuf[n] = e; sum += e; }
            sum = wave_sum(sum);
            const float inv = nvis > 0 ? 1.0f / sum : 0.f;
#pragma unroll 1
            for (int i = 0; i < 8; ++i) { const int n = lane + 64 * i; const float p = pbuf[n] * inv; pbuf[n] = p; impb[n] += p; }
            WSYNC();
            float oc = 0.f;
#pragma unroll 4
            for (int n = 0; n < nvis; ++n) oc += pbuf[n] * VCg[(size_t)n * 64 + lane];
            ocb[r * 64 + lane] = oc;
            WSYNC();
        }
        const int cur = t >> 6;
        float sc2[2];
#pragma unroll
        for (int jj = 0; jj < 2; ++jj) { const int j = lane + 64 * jj;
            float v = (j > 0 ? impb[4 * j - 1] : 0.f) + 2.0f * (impb[4 * j] + impb[4 * j + 1] + impb[4 * j + 2]) + impb[4 * j + 3];
            if (j == 0 || j == cur || j == cur - 1) v = 1e4f;
            if (j > cur) v = -1.0f;
            sc2[jj] = v; scb[j] = v; }
        WSYNC();
        unsigned long long msk[2];
#pragma unroll
        for (int jj = 0; jj < 2; ++jj) { const int j = lane + 64 * jj; int rank = 0;
#pragma unroll 4
            for (int i = 0; i < 128; ++i) { const float si = scb[i]; rank += (si > sc2[jj] || (si == sc2[jj] && i < j)) ? 1 : 0; }
            msk[jj] = __ballot(rank < 16); }
        WSYNC();
        float M[4], L[4], os[4], ow[4];
#pragma unroll
        for (int r = 0; r < 4; ++r) { M[r] = NEGB; L[r] = 0.f; os[r] = 0.f; }
        { const float* Kg = KV + 2 * KV_STRIDE + (size_t)g * T * 64; const float* Vg = KV + 3 * KV_STRIDE + (size_t)g * T * 64;
#pragma unroll 1
          for (int j = 0; j <= cur; ++j) { const bool sel = ((j < 64 ? msk[0] >> j : msk[1] >> (j - 64)) & 1ull) != 0ull; if (sel) nsa_block<false>(Kg, Vg, j, t, lane, qs, pb, slope, M, L, os); } }
#pragma unroll
        for (int r = 0; r < 4; ++r) { os[r] = os[r] / L[r]; M[r] = NEGB; L[r] = 0.f; ow[r] = 0.f; }
        { const float* Kg = KV + 4 * KV_STRIDE + (size_t)g * T * 64; const float* Vg = KV + 5 * KV_STRIDE + (size_t)g * T * 64;
          const int j0 = t >= 511 ? (t - 511) >> 6 : 0;
#pragma unroll 1
          for (int j = j0; j <= cur; ++j) nsa_block<true>(Kg, Vg, j, t, lane, qs, pb, slope, M, L, ow); }
#pragma unroll
        for (int r = 0; r < 4; ++r) { const int h = g * 4 + r;
            const float g0 = sigmoidf_(bf2f(P[(size_t)t * NPAD + C_NG + h])), g1 = sigmoidf_(bf2f(P[(size_t)t * NPAD + C_NG + 8 + h])), g2 = sigmoidf_(bf2f(P[(size_t)t * NPAD + C_NG + 16 + h]));
            OCAT[(size_t)t * 1536 + h * 64 + lane] = (bf16)f2bf(g0 * ocb[r * 64 + lane] + g1 * os[r] + g2 * (ow[r] / L[r])); }
        WSYNC();
    }
}

typedef float f32x16 __attribute__((ext_vector_type(16)));
typedef __bf16 bf16x2_t __attribute__((ext_vector_type(2)));
__device__ __forceinline__ unsigned pkbf(float lo, float hi) { const f32x2 v = {lo, hi}; return __builtin_bit_cast(unsigned, __builtin_convertvector(v, bf16x2_t)); }
constexpr float LOG2E = 1.4426950408889634f, NSA_SHIFT2 = 8.0f;
__device__ __forceinline__ int perm16(int b) { return (b & 3) | ((b & 4) << 1) | ((b & 8) >> 1); }
__device__ __forceinline__ void phase_prep2(Frame& F, int l) {
    KA;
    const bf16* P = (const bf16*)(KWS + WS_P);
    bf16* QS = (bf16*)(KWS + WS_QS); bf16* KS2 = (bf16*)(KWS + WS_KS2); bf16* KW2 = (bf16*)(KWS + WS_KW2);
    const float* qg = KIN(I_QN) + l * 64; const float* kg = KIN(I_KN) + l * 192;
    for (int it = F.gw; it < T * 12; it += F.NGW) {
        const int t = it / 12, v = it % 12;
        const int col = v < 8 ? v * 64 : (v < 10 ? C_KS + (v - 8) * 64 : C_KW + (v - 10) * 64);
        float x = bf2f(P[(size_t)t * NPAD + col + F.lane]);
        const float ss = wave_sum(x * x);
        const float g = v < 8 ? qg[F.lane] * (0.125f * LOG2E) : (v < 10 ? kg[64 + F.lane] : kg[128 + F.lane]);
        x = x * (1.0f / sqrtf(ss * (1.0f / 64.0f) + EPS)) * g;
        bf16* dst = v < 8 ? QS + ((size_t)v * T + t) * 64 : (v < 10 ? KS2 + ((size_t)(v - 8) * T + t) * 64 : KW2 + ((size_t)(v - 10) * T + t) * 64);
        dst[F.lane] = (bf16)f2bf(x);
    }
    LAS bf16* tile = (LAS bf16*)(F.lds + F.wave * 16384);
    for (int it = F.gw; it < 2 * 2 * (T / 64); it += F.NGW) {
        const int kind = it / (2 * (T / 64)), q = it % (2 * (T / 64)), g = q / (T / 64), tb = q % (T / 64);
        const bf16* src = P + (size_t)(tb * 64) * NPAD + (kind == 0 ? C_VS : C_VW) + g * 64;
        bf16* dst = (bf16*)(KWS + (kind == 0 ? WS_VST : WS_VWT)) + (size_t)g * 64 * T + tb * 64;
#pragma unroll 4
        for (int r = 0; r < 64; ++r) tile[r * 66 + F.lane] = src[(size_t)r * NPAD + F.lane];
        WSYNC();
        const int pl = (F.lane & ~15) | perm16(F.lane & 15);
#pragma unroll 4
        for (int d = 0; d < 64; ++d) dst[(size_t)d * T + pl] = tile[F.lane * 66 + d];
        WSYNC();
    }
}

__device__ __forceinline__ void phase_prep3(Frame& F, int l) {
    KA;
    const bf16* P = (const bf16*)(KWS + WS_P);
    bf16* QS = (bf16*)(KWS + WS_QS); bf16* KS2 = (bf16*)(KWS + WS_KS2); bf16* KW2 = (bf16*)(KWS + WS_KW2);
    const float* qg = KIN(I_QN) + l * 64; const float* kg = KIN(I_KN) + l * 192;
    const int vec = F.lane >> 3, part = F.lane & 7;
    for (int t = F.gw; t < T; t += F.NGW) {
#pragma unroll
        for (int pass = 0; pass < 2; ++pass) {
            if (pass == 1 && vec >= 4) continue;
            const int col = pass == 0 ? vec * 64 : (vec < 2 ? C_KS + vec * 64 : C_KW + (vec - 2) * 64);
            const float* gp = pass == 0 ? qg : (vec < 2 ? kg + 64 : kg + 128);
            const float gs = pass == 0 ? 0.125f * LOG2E : 1.0f;
            bf16* dst = pass == 0 ? QS + ((size_t)vec * T + t) * 64 : (vec < 2 ? KS2 + ((size_t)vec * T + t) * 64 : KW2 + ((size_t)(vec - 2) * T + t) * 64);
            const u32x4 raw = *(const u32x4*)(P + (size_t)t * NPAD + col + part * 8);
            float x[8] = {bflo(raw.x), bfhi(raw.x), bflo(raw.y), bfhi(raw.y), bflo(raw.z), bfhi(raw.z), bflo(raw.w), bfhi(raw.w)};
            float ss = 0.f;
#pragma unroll
            for (int e = 0; e < 8; ++e) ss += x[e] * x[e];
            ss += __shfl_xor(ss, 1); ss += __shfl_xor(ss, 2); ss += __shfl_xor(ss, 4);
            const float rstd = gs / sqrtf(ss * (1.0f / 64.0f) + EPS);
            const f32x4 g0 = *(const f32x4*)(gp + part * 8), g1 = *(const f32x4*)(gp + part * 8 + 4);
            u32x4 o; o.x = pk2(x[0] * rstd * g0.x, x[1] * rstd * g0.y); o.y = pk2(x[2] * rstd * g0.z, x[3] * rstd * g0.w); o.z = pk2(x[4] * rstd * g1.x, x[5] * rstd * g1.y); o.w = pk2(x[6] * rstd * g1.z, x[7] * rstd * g1.w);
            *(u32x4*)(dst + part * 8) = o;
        }
    }
    LAS bf16* tile = (LAS bf16*)(F.lds + F.wave * 16384);
    for (int it = F.gw; it < 2 * 2 * (T / 64); it += F.NGW) {
        const int kind = it / (2 * (T / 64)), q = it % (2 * (T / 64)), g = q / (T / 64), tb = q % (T / 64);
        const bf16* src = P + (size_t)(tb * 64) * NPAD + (kind == 0 ? C_VS : C_VW) + g * 64;
        bf16* dst = (bf16*)(KWS + (kind == 0 ? WS_VST : WS_VWT)) + (size_t)g * 64 * T + tb * 64;
#pragma unroll
        for (int i = 0; i < 8; ++i) { const int tok = vec + 8 * i; *(LAS u32x4*)(tile + tok * 72 + part * 8) = *(const u32x4*)(src + (size_t)tok * NPAD + part * 8); }
        WSYNC();
#pragma unroll
        for (int c = 0; c < 8; ++c) { unsigned w[4];
#pragma unroll
            for (int k = 0; k < 4; ++k) { const int p0 = (c & 1) * 8 + 2 * k, p1 = p0 + 1;
                const int k0 = (c >> 1) * 16 + ((p0 & 3) | ((p0 & 4) << 1) | ((p0 & 8) >> 1)), k1 = (c >> 1) * 16 + ((p1 & 3) | ((p1 & 4) << 1) | ((p1 & 8) >> 1));
                w[k] = (unsigned)tile[k0 * 72 + F.lane] | ((unsigned)tile[k1 * 72 + F.lane] << 16); }
            *(u32x4*)(dst + (size_t)F.lane * T + c * 8) = (u32x4){w[0], w[1], w[2], w[3]}; }
        WSYNC();
    }
}

__device__ __forceinline__ void phase_compress2(Frame& F, int l) {
    KA;
    LAS float* av = (LAS float*)(F.lds + F.wave * 16384);
    const bf16* P = (const bf16*)(KWS + WS_P);
    bf16* KCB = (bf16*)(KWS + WS_KCB); bf16* VCT = (bf16*)(KWS + WS_KCB + 131072);
    for (int it = F.gw; it < 2 * 2 * 512; it += F.NGW) {
        const int kind = it >> 10, g = (it >> 9) & 1, n = it & 511;
        if (n == 511) { if (kind == 0) KCB[((size_t)g * 512 + 511) * 64 + F.lane] = 0; else VCT[((size_t)g * 64 + F.lane) * 512 + 511] = 0; continue; }
        const bf16* src = P + (size_t)(16 * n) * NPAD + (kind == 0 ? C_KC : C_VC) + g * 64;
        const float* pe = KIN(I_PE) + ((size_t)l * 2 + kind) * 2048;
        const float* w1 = KIN(I_W1) + ((size_t)l * 2 + kind) * 2048 * 64;
        const float* w2 = KIN(I_W2) + ((size_t)l * 2 + kind) * 64 * 64;
#pragma unroll 4
        for (int c = 0; c < 32; ++c) av[c * 64 + F.lane] = bf2f(src[(size_t)c * NPAD + F.lane]) + pe[c * 64 + F.lane];
        WSYNC();
        float acc = 0.f;
#pragma unroll 8
        for (int i = 0; i < 2048; ++i) acc += av[i] * w1[i * 64 + F.lane];
        const float hid = gelu_tanh(acc);
        WSYNC();
        av[F.lane] = hid;
        WSYNC();
        float o = 0.f;
#pragma unroll 8
        for (int i = 0; i < 64; ++i) o += av[i] * w2[i * 64 + F.lane];
        WSYNC();
        if (kind == 0) { const float ss = wave_sum(o * o); o = o * (1.0f / sqrtf(ss * (1.0f / 64.0f) + EPS)) * KIN(I_KN)[l * 192 + F.lane]; KCB[((size_t)g * 512 + n) * 64 + F.lane] = (bf16)f2bf(o); }
        else VCT[((size_t)g * 64 + F.lane) * 512 + ((n & ~15) | perm16(n & 15))] = (bf16)f2bf(o);
    }
}

__device__ __forceinline__ void phase_compress3(Frame& F, int l) {
    KA;
    const bf16* P = (const bf16*)(KWS + WS_P);
    bf16* KCB = (bf16*)(KWS + WS_KCB); bf16* VCT = (bf16*)(KWS + WS_KCB + 131072);
    LAS float* red = (LAS float*)F.lds;
    LAS bf16* hid = (LAS bf16*)(F.lds + 32768);
    const int r16 = F.lane & 15, kq = F.lane >> 4;
    for (int unit = F.bid; unit < 128; unit += F.G) {
        const int kind = unit >> 6, mt = unit & 63, g = mt >> 5, n0 = (mt & 31) * 16;
        const bf16* W1T = (const bf16*)(KWS + WS_CW) + (size_t)(l * 2 + kind) * 64 * 2048; const bf16* W2T = (const bf16*)(KWS + WS_CW + 1048576) + (size_t)(l * 2 + kind) * 4096;
        const float* B1 = (const float*)(KWS + WS_CW + 1572864) + (l * 2 + kind) * 64;
        const bf16* arow = P + (size_t)(16 * (n0 + r16)) * NPAD + (kind == 0 ? C_KC : C_VC) + g * 64;
        f32x4 acc[4];
#pragma unroll
        for (int nt = 0; nt < 4; ++nt) acc[nt] = (f32x4){0.f, 0.f, 0.f, 0.f};
#pragma unroll 2
        for (int ks = 0; ks < 8; ++ks) { const int c0 = F.wave * 256 + 32 * ks + 8 * kq;
            const bf16x8 a = *(const bf16x8*)(arow + (size_t)(c0 >> 6) * NPAD + (c0 & 63));
#pragma unroll
            for (int nt = 0; nt < 4; ++nt) { const bf16x8 b = *(const bf16x8*)(W1T + (size_t)(16 * nt + r16) * 2048 + c0); acc[nt] = __builtin_amdgcn_mfma_f32_16x16x32_bf16(a, b, acc[nt], 0, 0, 0); } }
#pragma unroll
        for (int nt = 0; nt < 4; ++nt) *(LAS f32x4*)(red + ((F.wave * 4 + nt) * 64 + F.lane) * 4) = acc[nt];
        __syncthreads();
        if (F.tid < 256) { const int nt = F.tid >> 6, ln = F.tid & 63; f32x4 v = {0.f, 0.f, 0.f, 0.f};
#pragma unroll
            for (int w = 0; w < 8; ++w) v += *(const LAS f32x4*)(red + ((w * 4 + nt) * 64 + ln) * 4);
            const int col = 16 * nt + (ln & 15); const float b1 = B1[col];
#pragma unroll
            for (int i = 0; i < 4; ++i) hid[(4 * (ln >> 4) + i) * 72 + col] = (bf16)f2bf(gelu_tanh(v[i] + b1)); }
        __syncthreads();
        if (F.wave == 0) {
            f32x4 o[4];
#pragma unroll
            for (int nt = 0; nt < 4; ++nt) o[nt] = (f32x4){0.f, 0.f, 0.f, 0.f};
#pragma unroll
            for (int ks = 0; ks < 2; ++ks) { const bf16x8 a = *(const LAS bf16x8*)(hid + r16 * 72 + 32 * ks + 8 * kq);
#pragma unroll
                for (int nt = 0; nt < 4; ++nt) { const bf16x8 b = *(const bf16x8*)(W2T + (16 * nt + r16) * 64 + 32 * ks + 8 * kq); o[nt] = __builtin_amdgcn_mfma_f32_16x16x32_bf16(a, b, o[nt], 0, 0, 0); } }
            if (kind == 0) {
#pragma unroll
                for (int i = 0; i < 4; ++i) { float ss = o[0][i] * o[0][i] + o[1][i] * o[1][i] + o[2][i] * o[2][i] + o[3][i] * o[3][i];
                    ss += __shfl_xor(ss, 1); ss += __shfl_xor(ss, 2); ss += __shfl_xor(ss, 4); ss += __shfl_xor(ss, 8);
                    const float rstd = 1.0f / sqrtf(ss * (1.0f / 64.0f) + EPS); const int n = n0 + 4 * kq + i;
#pragma unroll
                    for (int nt = 0; nt < 4; ++nt) { const int col = 16 * nt + r16; KCB[((size_t)g * 512 + n) * 64 + col] = n < 511 ? (bf16)f2bf(o[nt][i] * rstd * KIN(I_KN)[l * 192 + col]) : (bf16)0; } }
            } else {
#pragma unroll
                for (int i = 0; i < 4; ++i) { const int n = n0 + 4 * kq + i;
#pragma unroll
                    for (int nt = 0; nt < 4; ++nt) { const int col = 16 * nt + r16; VCT[((size_t)g * 64 + col) * 512 + ((n & ~15) | perm16(n & 15))] = n < 511 ? (bf16)f2bf(o[nt][i]) : (bf16)0; } }
            }
        }
        __syncthreads();
    }
}

constexpr int NSA_KB0 = 0, NSA_VB0 = 9216, NSA_KB1 = 18432, NSA_VB1 = 27648;
constexpr int NSA_SCA = 36864, NSA_SCB = 70656;
constexpr int NSA_QM = 104448, NSA_UM = 105472;
__device__ __forceinline__ int next_set(unsigned long long m0, unsigned long long m1, int from) {
    if (from < 64) { const unsigned long long x = m0 & (~0ull << from); if (x) return __builtin_ctzll(x); from = 64; }
    if (from < 128) { const unsigned long long x = m1 & (~0ull << (from - 64)); if (x) return 64 + __builtin_ctzll(x); }
    return 128;
}
template <int MODE> __device__ __forceinline__ void nsa_branch(Frame& F, const bf16* Kg, const bf16* VTg, int vt_len, unsigned long long m0, unsigned long long m1,
        const bf16x8 (&Qf)[4], int t, int cblk, float slope2, float inv_l, const unsigned (&qsel)[4], int hi_cmp, unsigned wm_lo_dummy, f32x16 (&oacc)[2], float& lsum) {
    LAS unsigned char* lds = F.lds;
    const int lane = F.lane, c32 = lane & 31, h = lane >> 5, tid = F.tid;
    const int lrow = tid >> 3, lch = tid & 7;
    int j = next_set(m0, m1, 0);
    if (j >= 128) return;
    u32x4 rk = *(const u32x4*)(Kg + (size_t)(64 * j + lrow) * 64 + lch * 8), rv = *(const u32x4*)(VTg + (size_t)lrow * vt_len + 64 * j + lch * 8);
    *(LAS u32x4*)(lds + NSA_KB0 + lrow * 144 + lch * 16) = rk; *(LAS u32x4*)(lds + NSA_VB0 + lrow * 144 + lch * 16) = rv;
    __syncthreads();
    int b = 0;
    const float kslope2 = (MODE < 2) ? 16.0f * slope2 : slope2;
    const float qpos = (MODE < 2) ? (float)(t - 31) : (float)t;
    while (j < 128) {
        const int jn = next_set(m0, m1, j + 1);
        if (jn < 128) { rk = *(const u32x4*)(Kg + (size_t)(64 * jn + lrow) * 64 + lch * 8); rv = *(const u32x4*)(VTg + (size_t)lrow * vt_len + 64 * jn + lch * 8); }
        bool need = true;
        if (MODE == 2) { const unsigned myw = j < 32 ? qsel[0] : (j < 64 ? qsel[1] : (j < 96 ? qsel[2] : qsel[3])); need = __any((myw >> (j & 31)) & 1u); }
        if (need) {
            const int kb = b ? NSA_KB1 : NSA_KB0, vb = b ? NSA_VB1 : NSA_VB0;
            const int kbase = 64 * j;
            float lb2 = -slope2 * qpos + kslope2 * (float)(kbase + 4 * h) - NSA_SHIFT2;
            if (MODE == 2) { const unsigned myw = j < 32 ? qsel[0] : (j < 64 ? qsel[1] : (j < 96 ? qsel[2] : qsel[3])); if (!((myw >> (j & 31)) & 1u)) lb2 = -1e30f; }
            f32x16 sacc[2];
#pragma unroll
            for (int sub = 0; sub < 2; ++sub)
#pragma unroll
                for (int i = 0; i < 16; ++i) sacc[sub][i] = fmaf(kslope2, (float)(32 * sub + (i & 3) + 8 * (i >> 2)), lb2);
#pragma unroll
            for (int sub = 0; sub < 2; ++sub) {
#pragma unroll
                for (int ks = 0; ks < 4; ++ks) { const bf16x8 a = *(const LAS bf16x8*)(lds + kb + (32 * sub + c32) * 144 + (16 * ks + 8 * h) * 2); sacc[sub] = __builtin_amdgcn_mfma_f32_32x32x16_bf16(a, Qf[ks], sacc[sub], 0, 0, 0); }
                asm volatile("" ::: "memory"); }
#pragma unroll
            for (int sub = 0; sub < 2; ++sub)
#pragma unroll
                for (int i = 0; i < 16; ++i) sacc[sub][i] = __builtin_amdgcn_exp2f(sacc[sub][i]);
            bool mhi = false, mlo = false; int hi = 0, lo = 0;
            if (MODE < 2) { mhi = true; hi = hi_cmp; }
            if (MODE == 2) { mhi = (j == cblk); hi = t; }
            if (MODE == 3) { mhi = (j == cblk); hi = t; mlo = (j == cblk - 8); lo = t - 511; }
            if (mhi || mlo) {
#pragma unroll
                for (int sub = 0; sub < 2; ++sub)
#pragma unroll
                    for (int i = 0; i < 16; ++i) { const int idx = kbase + 4 * h + 32 * sub + (i & 3) + 8 * (i >> 2); if ((mhi && idx > hi) || (mlo && idx < lo)) sacc[sub][i] = 0.f; }
            }
            float ls = 0.f;
#pragma unroll
            for (int sub = 0; sub < 2; ++sub)
#pragma unroll
                for (int i = 0; i < 16; ++i) ls += sacc[sub][i];
            lsum += ls;
            if (MODE == 1) {
                LAS float* scA = (LAS float*)(lds + NSA_SCA); LAS float* scB = (LAS float*)(lds + NSA_SCB);
                const int q = F.wave * 8 + (c32 >> 2);
#pragma unroll
                for (int sub = 0; sub < 2; ++sub)
#pragma unroll
                    for (int g4 = 0; g4 < 4; ++g4) { float x[4];
#pragma unroll
                        for (int e = 0; e < 4; ++e) { float v = sacc[sub][4 * g4 + e] * inv_l; v += __shfl_xor(v, 1); v += __shfl_xor(v, 2); x[e] = v; }
                        const int jb = 16 * j + 8 * sub + 2 * g4 + h;
                        if ((c32 & 3) == 0) { scA[q * 132 + jb] = 2.0f * (x[0] + x[1] + x[2]) + x[3]; scB[q * 132 + jb + 1] = x[3]; } }
            }
            if (MODE != 0) {
                bf16x8 pf[2][2];
#pragma unroll
                for (int sub = 0; sub < 2; ++sub)
#pragma unroll
                    for (int s2 = 0; s2 < 2; ++s2) { u32x4 w; w.x = pkbf(sacc[sub][8 * s2], sacc[sub][8 * s2 + 1]); w.y = pkbf(sacc[sub][8 * s2 + 2], sacc[sub][8 * s2 + 3]); w.z = pkbf(sacc[sub][8 * s2 + 4], sacc[sub][8 * s2 + 5]); w.w = pkbf(sacc[sub][8 * s2 + 6], sacc[sub][8 * s2 + 7]);
                        pf[sub][s2] = __builtin_bit_cast(bf16x8, w); }
                asm volatile("" ::: "memory");
#pragma unroll
                for (int ds = 0; ds < 2; ++ds) {
#pragma unroll
                    for (int sub = 0; sub < 2; ++sub)
#pragma unroll
                        for (int s2 = 0; s2 < 2; ++s2) { const bf16x8 a = *(const LAS bf16x8*)(lds + vb + (32 * ds + c32) * 144 + (32 * sub + 16 * s2 + 8 * h) * 2); oacc[ds] = __builtin_amdgcn_mfma_f32_32x32x16_bf16(a, pf[sub][s2], oacc[ds], 0, 0, 0); }
                    asm volatile("" ::: "memory"); }
            }
        }
        if (jn < 128) { const int kb = b ? NSA_KB0 : NSA_KB1, vb = b ? NSA_VB0 : NSA_VB1; *(LAS u32x4*)(lds + kb + lrow * 144 + lch * 16) = rk; *(LAS u32x4*)(lds + vb + lrow * 144 + lch * 16) = rv; }
        __syncthreads();
        j = jn; b ^= 1;
    }
}
__device__ __forceinline__ void nsa_stash_put(LAS unsigned char* lds, int wave, int lane, const f32x16 (&o)[2], float sc) {
    LAS unsigned* st = (LAS unsigned*)(lds + NSA_SCA) + wave * 1024 + lane;
#pragma unroll
    for (int ds = 0; ds < 2; ++ds)
#pragma unroll
        for (int k = 0; k < 8; ++k) st[(ds * 8 + k) * 64] = pkbf(o[ds][2 * k] * sc, o[ds][2 * k + 1] * sc);
}
__device__ __forceinline__ void phase_nsa2(Frame& F, int l) {
    KA;
    LAS unsigned char* lds = F.lds;
    const bf16* P = (const bf16*)(KWS + WS_P); bf16* OCAT = (bf16*)(KWS + WS_OCAT);
    const bf16* QS = (const bf16*)(KWS + WS_QS);
    const int lane = F.lane, c32 = lane & 31, h = lane >> 5, q8 = c32 >> 2, r = c32 & 3;
    for (int unit = F.bid; unit < 256; unit += F.G) {
        const int g = unit & 1, cblk = unit >> 1, t0 = cblk * 64, head = g * 4 + r, t = t0 + F.wave * 8 + q8;
        const float slope2 = exp2f(-(float)(head + 1)) * LOG2E;
        bf16x8 Qf[4];
#pragma unroll
        for (int ks = 0; ks < 4; ++ks) Qf[ks] = *(const bf16x8*)(QS + ((size_t)head * T + t) * 64 + 16 * ks + 8 * h);
        for (int u = F.tid; u < (NSA_UM + 16 - NSA_SCA) / 4; u += 512) ((LAS unsigned*)(lds + NSA_SCA))[u] = 0u;
        __syncthreads();
        f32x16 oacc[2];
#pragma unroll
        for (int ds = 0; ds < 2; ++ds)
#pragma unroll
            for (int i = 0; i < 16; ++i) oacc[ds][i] = 0.f;
        unsigned qsel[4] = {0u, 0u, 0u, 0u};
        float sc_cmp;
        {
            const int ntile = (4 * cblk + 2) / 64 + 1;
            const unsigned long long cm0 = ntile >= 64 ? ~0ull : ((1ull << ntile) - 1ull);
            const int hi_cmp = t >= 31 ? (t - 31) / 16 : -1;
            const bf16* Kg = (const bf16*)(KWS + WS_KCB) + (size_t)g * 512 * 64; const bf16* VTg = (const bf16*)(KWS + WS_KCB + 131072) + (size_t)g * 64 * 512;
            float l1 = 0.f;
            nsa_branch<0>(F, Kg, VTg, 512, cm0, 0ull, Qf, t, cblk, slope2, 0.f, qsel, hi_cmp, 0u, oacc, l1);
            l1 += __shfl_xor(l1, 32);
            const float inv_l = l1 > 0.f ? 1.0f / l1 : 0.f;
            float l2 = 0.f;
            nsa_branch<1>(F, Kg, VTg, 512, cm0, 0ull, Qf, t, cblk, slope2, inv_l, qsel, hi_cmp, 0u, oacc, l2);
            sc_cmp = sigmoidf_(bf2f(P[(size_t)t * NPAD + C_NG + head])) * inv_l;
        }
        {
            LAS float* scA = (LAS float*)(lds + NSA_SCA); LAS float* scB = (LAS float*)(lds + NSA_SCB);
            LAS unsigned* qm = (LAS unsigned*)(lds + NSA_QM); LAS unsigned* um = (LAS unsigned*)(lds + NSA_UM);
            WSYNC();
            const int qq = F.wave * 8 + (lane >> 3), jj = lane & 7;
            unsigned key[16];
#pragma unroll
            for (int m = 0; m < 16; ++m) { const int jb = jj + 8 * m; float sv = scA[qq * 132 + jb] + scB[qq * 132 + jb];
                if (jb == 0 || jb == cblk || jb == cblk - 1) sv = 1e4f;
                key[m] = (__builtin_bit_cast(unsigned, sv) & ~127u) | (unsigned)(127 - jb); }
            WSYNC();
#pragma unroll
            for (int m = 0; m < 16; ++m) ((LAS unsigned*)scA)[qq * 132 + jj + 8 * m] = key[m];
            WSYNC();
            unsigned bits[4] = {0u, 0u, 0u, 0u};
#pragma unroll
            for (int half = 0; half < 2; ++half) { int rank[8];
#pragma unroll
                for (int m = 0; m < 8; ++m) rank[m] = 0;
#pragma unroll 2
                for (int i = 0; i <= cblk; ++i) { const unsigned ki = ((const LAS unsigned*)scA)[qq * 132 + i];
#pragma unroll
                    for (int m = 0; m < 8; ++m) rank[m] += ki > key[8 * half + m] ? 1 : 0; }
#pragma unroll
                for (int m = 0; m < 8; ++m) { const int jb = jj + 8 * (8 * half + m); if (jb <= cblk && rank[m] < 16) bits[(8 * half + m) >> 2] |= 1u << (jb & 31); } }
#pragma unroll
            for (int w = 0; w < 4; ++w) if (bits[w]) { atomicOr((unsigned*)(qm + qq * 4 + w), bits[w]); atomicOr((unsigned*)(um + w), bits[w]); }
            __syncthreads();
#pragma unroll
            for (int w = 0; w < 4; ++w) qsel[w] = qm[(F.wave * 8 + q8) * 4 + w];
        }
        nsa_stash_put(lds, F.wave, lane, oacc, sc_cmp);
#pragma unroll
        for (int ds = 0; ds < 2; ++ds)
#pragma unroll
            for (int i = 0; i < 16; ++i) oacc[ds][i] = 0.f;
        {
            LAS unsigned* um = (LAS unsigned*)(lds + NSA_UM);
            const unsigned long long sm0 = (unsigned long long)__builtin_amdgcn_readfirstlane(um[0]) | ((unsigned long long)__builtin_amdgcn_readfirstlane(um[1]) << 32);
            const unsigned long long sm1 = (unsigned long long)__builtin_amdgcn_readfirstlane(um[2]) | ((unsigned long long)__builtin_amdgcn_readfirstlane(um[3]) << 32);
            float ls = 0.f;
            nsa_branch<2>(F, (const bf16*)(KWS + WS_KS2) + (size_t)g * T * 64, (const bf16*)(KWS + WS_VST) + (size_t)g * 64 * T, T, sm0, sm1, Qf, t, cblk, slope2, 0.f, qsel, 0, 0u, oacc, ls);
            ls += __shfl_xor(ls, 32);
            const float sc = sigmoidf_(bf2f(P[(size_t)t * NPAD + C_NG + 8 + head])) / ls;
            LAS unsigned* st = (LAS unsigned*)(lds + NSA_SCA) + F.wave * 1024 + lane;
#pragma unroll
            for (int ds = 0; ds < 2; ++ds)
#pragma unroll
                for (int k = 0; k < 8; ++k) { const unsigned w = st[(ds * 8 + k) * 64]; st[(ds * 8 + k) * 64] = pkbf(bflo(w) + sc * oacc[ds][2 * k], bfhi(w) + sc * oacc[ds][2 * k + 1]); oacc[ds][2 * k] = 0.f; oacc[ds][2 * k + 1] = 0.f; }
        }
        {
            const int j0 = cblk >= 8 ? cblk - 8 : 0;
            unsigned long long wm0 = 0ull, wm1 = 0ull;
            for (int jb = j0; jb <= cblk; ++jb) { if (jb < 64) wm0 |= 1ull << jb; else wm1 |= 1ull << (jb - 64); }
            float ls = 0.f;
            nsa_branch<3>(F, (const bf16*)(KWS + WS_KW2) + (size_t)g * T * 64, (const bf16*)(KWS + WS_VWT) + (size_t)g * 64 * T, T, wm0, wm1, Qf, t, cblk, slope2, 0.f, qsel, 0, 0u, oacc, ls);
            ls += __shfl_xor(ls, 32);
            const float sc = sigmoidf_(bf2f(P[(size_t)t * NPAD + C_NG + 16 + head])) / ls;
            const LAS unsigned* st = (const LAS unsigned*)(lds + NSA_SCA) + F.wave * 1024 + lane;
#pragma unroll
            for (int ds = 0; ds < 2; ++ds)
#pragma unroll
                for (int g4 = 0; g4 < 4; ++g4) { const unsigned w0 = st[(ds * 8 + 2 * g4) * 64], w1 = st[(ds * 8 + 2 * g4 + 1) * 64];
                    u32x2 w; w.x = pkbf(bflo(w0) + sc * oacc[ds][4 * g4], bfhi(w0) + sc * oacc[ds][4 * g4 + 1]); w.y = pkbf(bflo(w1) + sc * oacc[ds][4 * g4 + 2], bfhi(w1) + sc * oacc[ds][4 * g4 + 3]);
                    *(u32x2*)(OCAT + (size_t)t * 1536 + head * 64 + 32 * ds + 8 * g4 + 4 * h) = w; }
        }
        __syncthreads();
    }
}

__device__ __forceinline__ void phase_merge(Frame& F) {
    KA;
    const bf16* P = (const bf16*)(KWS + WS_P); const bf16* PROJ = (const bf16*)(KWS + WS_PROJ); bf16* MG = (bf16*)(KWS + WS_MERGED);
    const size_t total = (size_t)T * D / 8;
    for (size_t it = (size_t)F.gw * 64 + F.lane; it < total; it += (size_t)F.NGW * 64) {
        const size_t t = it / (D / 8); const int d = (int)(it % (D / 8)) * 8;
        float acc[8];
#pragma unroll
        for (int k = 0; k < 8; ++k) acc[k] = 0.f;
#pragma unroll
        for (int n = 0; n < 3; ++n) { const u32x4 gq = *(const u32x4*)(P + t * NPAD + C_MG + n * D + d); const u32x4 pq = *(const u32x4*)(PROJ + ((size_t)n * T + t) * D + d);
            acc[0] += sigmoidf_(bflo(gq.x)) * bflo(pq.x); acc[1] += sigmoidf_(bfhi(gq.x)) * bfhi(pq.x); acc[2] += sigmoidf_(bflo(gq.y)) * bflo(pq.y); acc[3] += sigmoidf_(bfhi(gq.y)) * bfhi(pq.y);
            acc[4] += sigmoidf_(bflo(gq.z)) * bflo(pq.z); acc[5] += sigmoidf_(bfhi(gq.z)) * bfhi(pq.z); acc[6] += sigmoidf_(bflo(gq.w)) * bflo(pq.w); acc[7] += sigmoidf_(bfhi(gq.w)) * bfhi(pq.w); }
        u32x4 o; o.x = pk2(acc[0], acc[1]); o.y = pk2(acc[2], acc[3]); o.z = pk2(acc[4], acc[5]); o.w = pk2(acc[6], acc[7]);
        *(u32x4*)(MG + t * D + d) = o;
    }
}
__device__ __forceinline__ void phase_router(Frame& F, int l) {
    KA;
    const float* X1 = (const float*)(KWS + WS_X1); bf16* H = (bf16*)(KWS + WS_H);
    int* EID = (int*)(KWS + WS_ROUTE); float* EW = (float*)(KWS + WS_ROUTE + 65536);
    const float* gain = KIN(I_NFFN) + (size_t)l * D; const float* wg = KIN(I_WGRP) + (size_t)l * D * 4; const float* we = KIN(I_WEXP) + (size_t)l * D * 32;
    const float* bg = KIN(I_BGRP) + l * 4; const float* be = KIN(I_BEXP) + l * 32;
    for (int t = F.gw; t < T; t += F.NGW) {
        const float* xrow = X1 + (size_t)t * D;
        float ss = 0.f;
#pragma unroll 4
        for (int k = 0; k < 32; ++k) { const float x = xrow[F.lane + 64 * k]; ss += x * x; }
        const float rstd = 1.0f / sqrtf(wave_sum(ss) * (1.0f / D) + EPS);
        float ag[4] = {0.f, 0.f, 0.f, 0.f}, ae[32];
#pragma unroll
        for (int e = 0; e < 32; ++e) ae[e] = 0.f;
#pragma unroll 1
        for (int k = 0; k < 32; ++k) { const int d = F.lane + 64 * k;
            const float hv = xrow[d] * rstd * gain[d];
            H[(size_t)t * D + d] = (bf16)f2bf(hv);
            const f32x4 w4 = *(const f32x4*)(wg + (size_t)d * 4);
            ag[0] += hv * w4.x; ag[1] += hv * w4.y; ag[2] += hv * w4.z; ag[3] += hv * w4.w;
#pragma unroll
            for (int c = 0; c < 8; ++c) { const f32x4 w = *(const f32x4*)(we + (size_t)d * 32 + c * 4); ae[c * 4] += hv * w.x; ae[c * 4 + 1] += hv * w.y; ae[c * 4 + 2] += hv * w.z; ae[c * 4 + 3] += hv * w.w; } }
#pragma unroll
        for (int e = 0; e < 4; ++e) ag[e] = wave_sum(ag[e]) + bg[e];
#pragma unroll
        for (int e = 0; e < 32; ++e) ae[e] = wave_sum(ae[e]) + be[e];
        int gi = 0; float gm = ag[0];
#pragma unroll
        for (int e = 1; e < 4; ++e) if (ag[e] > gm) { gm = ag[e]; gi = e; }
        float gs = 0.f;
#pragma unroll
        for (int e = 0; e < 4; ++e) gs += expf(ag[e] - gm);
        const float gw_ = 1.0f / gs;
        float el[8];
#pragma unroll
        for (int e = 0; e < 8; ++e) { el[e] = gi == 0 ? ae[e] : (gi == 1 ? ae[8 + e] : (gi == 2 ? ae[16 + e] : ae[24 + e])); }
        int i1 = 0; float m1 = el[0];
#pragma unroll
        for (int e = 1; e < 8; ++e) if (el[e] > m1) { m1 = el[e]; i1 = e; }
        int i2 = -1; float m2 = -3.0e38f;
#pragma unroll
        for (int e = 0; e < 8; ++e) if (e != i1 && el[e] > m2) { m2 = el[e]; i2 = e; }
        const float p2 = expf(m2 - m1);
        const float w1 = 1.0f / (1.0f + p2), w2 = p2 / (1.0f + p2);
        if (F.lane == 0) { EID[2 * t] = gi * 8 + i1; EID[2 * t + 1] = gi * 8 + i2; EW[2 * t] = gw_ * w1; EW[2 * t + 1] = gw_ * w2; }
    }
}

__device__ __forceinline__ void phase_router2(Frame& F, int l) {
    KA;
    const float* X1 = (const float*)(KWS + WS_X1); bf16* H = (bf16*)(KWS + WS_H);
    int* EID = (int*)(KWS + WS_ROUTE); float* EW = (float*)(KWS + WS_ROUTE + 65536); int* HIST = (int*)(KWS + WS_HIST);
    const float* WRT = (const float*)(KWS + WS_WRT) + (size_t)l * 48 * D;
    const float* gain = KIN(I_NFFN) + (size_t)l * D; const float* bg = KIN(I_BGRP) + l * 4; const float* be = KIN(I_BEXP) + l * 32;
    LAS float* red = (LAS float*)F.lds;
    LAS float* ssq = (LAS float*)(F.lds + 24576);
    LAS float* lg = (LAS float*)(F.lds + 25088);
    LAS float* rs = (LAS float*)(F.lds + 30208);
    LAS int* eidl = (LAS int*)(F.lds + 30336);
    const int r16 = F.lane & 15, kq = F.lane >> 4, tg = F.wave >> 2, kq4 = F.wave & 3;
    for (int blk = F.bid; blk < T / 32; blk += F.G) {
        const int tok0 = blk * 32;
        const float* xa = X1 + (size_t)(tok0 + 16 * tg + r16) * D + kq4 * 512 + 4 * kq;
        const float* wb = WRT + (size_t)r16 * D + kq4 * 512 + 4 * kq;
        f32x4 acc[3]; float sq = 0.f;
#pragma unroll
        for (int nt = 0; nt < 3; ++nt) acc[nt] = (f32x4){0.f, 0.f, 0.f, 0.f};
#pragma unroll 2
        for (int s = 0; s < 32; ++s) { const f32x4 a = *(const f32x4*)(xa + 16 * s);
            f32x4 b[3];
#pragma unroll
            for (int nt = 0; nt < 3; ++nt) b[nt] = *(const f32x4*)(wb + (size_t)(16 * nt) * D + 16 * s);
            sq += a.x * a.x + a.y * a.y + a.z * a.z + a.w * a.w;
#pragma unroll
            for (int j = 0; j < 4; ++j)
#pragma unroll
                for (int nt = 0; nt < 3; ++nt) acc[nt] = __builtin_amdgcn_mfma_f32_16x16x4f32(a[j], b[nt][j], acc[nt], 0, 0, 0); }
        sq += __shfl_xor(sq, 16); sq += __shfl_xor(sq, 32);
#pragma unroll
        for (int nt = 0; nt < 3; ++nt) *(LAS f32x4*)(red + ((F.wave * 3 + nt) * 64 + F.lane) * 4) = acc[nt];
        if (kq == 0) ssq[F.wave * 16 + r16] = sq;
        __syncthreads();
        if (F.tid < 384) { const int tg2 = F.tid / 192, rem = F.tid % 192, nt = rem / 64, ln = rem % 64; f32x4 v = {0.f, 0.f, 0.f, 0.f};
#pragma unroll
            for (int q = 0; q < 4; ++q) v += *(const LAS f32x4*)(red + (((tg2 * 4 + q) * 3 + nt) * 64 + ln) * 4);
            const int col = 16 * nt + (ln & 15);
            if (col < 36) {
#pragma unroll
                for (int i = 0; i < 4; ++i) lg[(16 * tg2 + 4 * (ln >> 4) + i) * 40 + col] = v[i]; } }
        if (F.tid >= 384 && F.tid < 416) { const int tk = F.tid - 384, tg2 = tk >> 4, rr = tk & 15; float q2 = 0.f;
#pragma unroll
            for (int q = 0; q < 4; ++q) q2 += ssq[(tg2 * 4 + q) * 16 + rr];
            rs[tk] = 1.0f / sqrtf(q2 * (1.0f / D) + EPS); }
        __syncthreads();
        if (F.tid < 32) { const int tk = F.tid, t = tok0 + tk; const float rstd = rs[tk];
            float ag[4], el[8];
#pragma unroll
            for (int e = 0; e < 4; ++e) ag[e] = lg[tk * 40 + 32 + e] * rstd + bg[e];
            int gi = 0; float gm = ag[0];
#pragma unroll
            for (int e = 1; e < 4; ++e) if (ag[e] > gm) { gm = ag[e]; gi = e; }
            float gs = 0.f;
#pragma unroll
            for (int e = 0; e < 4; ++e) gs += expf(ag[e] - gm);
            const float gw_ = 1.0f / gs;
#pragma unroll
            for (int e = 0; e < 8; ++e) el[e] = lg[tk * 40 + gi * 8 + e] * rstd + be[gi * 8 + e];
            int i1 = 0; float m1 = el[0];
#pragma unroll
            for (int e = 1; e < 8; ++e) if (el[e] > m1) { m1 = el[e]; i1 = e; }
            int i2 = -1; float m2 = -3.0e38f;
#pragma unroll
            for (int e = 0; e < 8; ++e) if (e != i1 && el[e] > m2) { m2 = el[e]; i2 = e; }
            const float p2 = expf(m2 - m1), w1 = 1.0f / (1.0f + p2), w2 = p2 / (1.0f + p2);
            EID[2 * t] = gi * 8 + i1; EID[2 * t + 1] = gi * 8 + i2; EW[2 * t] = gw_ * w1; EW[2 * t + 1] = gw_ * w2;
            eidl[2 * tk] = gi * 8 + i1; eidl[2 * tk + 1] = gi * 8 + i2; }
        __syncthreads();
        if (F.tid < 32) { int c = 0;
#pragma unroll 8
            for (int i = 0; i < 64; ++i) c += eidl[i] == F.tid ? 1 : 0;
            HIST[blk * 32 + F.tid] = c; }
#pragma unroll 1
        for (int q = 0; q < 4; ++q) { const int tk = F.wave * 4 + q; const float rstd = rs[tk];
            const f32x4* xr = (const f32x4*)(X1 + (size_t)(tok0 + tk) * D) + F.lane;
#pragma unroll
            for (int j = 0; j < 8; ++j) { const f32x4 v = xr[64 * j]; const f32x4 g = *((const f32x4*)gain + F.lane + 64 * j);
                u32x2 o; o.x = pk2(v.x * rstd * g.x, v.y * rstd * g.y); o.y = pk2(v.z * rstd * g.z, v.w * rstd * g.w);
                *((u32x2*)(H + (size_t)(tok0 + tk) * D) + F.lane + 64 * j) = o; } }
        __syncthreads();
    }
}
__device__ __forceinline__ void phase_lists2(Frame& F) {
    KA;
    const int* EID = (const int*)(KWS + WS_ROUTE); int* CNT = (int*)(KWS + WS_ROUTE + 131072); int* LIST = (int*)(KWS + WS_ROUTE + 262144); const int* HIST = (const int*)(KWS + WS_HIST);
    LAS int* off = (LAS int*)F.lds; LAS int* eidl = off + 32;
    for (int blk = F.bid; blk < T / 32; blk += F.G) {
        if (F.tid < 32) { int a = 0;
#pragma unroll 8
            for (int b2 = 0; b2 < blk; ++b2) a += HIST[b2 * 32 + F.tid];
            off[F.tid] = a;
            if (blk == T / 32 - 1) CNT[F.tid] = a + HIST[blk * 32 + F.tid]; }
        if (F.tid >= 64 && F.tid < 128) eidl[F.tid - 64] = EID[blk * 64 + F.tid - 64];
        __syncthreads();
        if (F.tid < 64) { const int e = eidl[F.tid]; int rk = 0;
            for (int i = 0; i < F.tid; ++i) rk += eidl[i] == e ? 1 : 0;
            LIST[e * 8192 + off[e] + rk] = blk * 64 + F.tid; }
        __syncthreads();
    }
}

__device__ __forceinline__ void phase_lists(Frame& F) {
    KA;
    const int e = F.bid;
    if (e >= NE) return;
    const int* EID = (const int*)(KWS + WS_ROUTE); int* CNT = (int*)(KWS + WS_ROUTE + 131072); int* LIST = (int*)(KWS + WS_ROUTE + 262144);
    LAS int* wc = (LAS int*)F.lds;
    int run = 0;
    for (int base = 0; base < 2 * T; base += 512) {
        const int idx = base + F.tid; const bool match = EID[idx] == e;
        const unsigned long long b = __ballot(match);
        if (F.lane == 0) wc[F.wave] = __popcll(b);
        __syncthreads();
        int pre = 0, tot = 0;
#pragma unroll
        for (int w = 0; w < 8; ++w) { const int c = wc[w]; pre += w < F.wave ? c : 0; tot += c; }
        if (match) LIST[e * 8192 + run + pre + __popcll(b & ((1ull << F.lane) - 1ull))] = idx;
        run += tot;
        __syncthreads();
    }
    if (F.tid == 0) CNT[e] = run;
}
__device__ __forceinline__ void moe_table(Frame& F, LAS int* tb) {
    KA;
    const int* CNT = (const int*)(KWS + WS_ROUTE + 131072);
    if (F.tid == 0) { int a = 0; for (int e = 0; e < NE; ++e) { tb[e] = a; a += (CNT[e] + 255) / 256; } tb[NE] = a; }
    __syncthreads();
}

constexpr int PH_PER_LAYER = 11, N_PHASES = 1 + NL * PH_PER_LAYER + 1;

__global__ void __launch_bounds__(512, 2) mk_fwd(Args args) {
    extern __shared__ __attribute__((aligned(16))) unsigned char lds_raw[];
#define FRAME Frame F; F.lds = (LAS unsigned char*)lds_raw; F.MISC = (volatile LAS unsigned*)(F.lds + MISC_OFF); F.tid = ltid(); F.lane = F.tid & 63; F.wave = __builtin_amdgcn_readfirstlane(F.tid >> 6); \
    F.G = gridDim.x; F.bid = lbid(); F.vcu = (F.G % 8 == 0) ? (F.bid % 8) * (F.G / 8) + F.bid / 8 : F.bid; F.gw = F.bid * 8 + F.wave; F.NGW = F.G * 8;
    unsigned* const ctl = (unsigned*)((unsigned char*)args.ws + WS_CTL);
    for (int u = threadIdx.x; u < (LDS_BYTES - MISC_OFF) / 4; u += 512) ((LAS unsigned*)(lds_raw + MISC_OFF))[u] = 0u;
    __syncthreads();
    const int lo = args.ph_lo, hi = args.ph_hi;
    XcdBarrier bar; bar.bar = ctl + CW_BAR + args.li * XCD_BAR_WORDS; bar.x = 0; bar.st = nullptr;
    if (hi - lo > 1) bar = xcd_barrier_post(ctl + CW_BAR + args.li * XCD_BAR_WORDS, (volatile LAS unsigned*)((LAS unsigned char*)lds_raw + MISC_OFF));
    int ph = 0;
#define RUN(k) ((k) >= lo && (k) < hi)
#ifndef MK_PROBE_MASK
#define MK_PROBE_MASK 0
#endif
    volatile LAS unsigned long long* const tacc = (volatile LAS unsigned long long*)((LAS unsigned char*)lds_raw + MISC_OFF + 512);
    if (MK_PROBE_MASK != 0 && blockIdx.x == 0 && threadIdx.x == 0) tacc[16] = wall_clock64();
#define STAMP(slot) do { if (MK_PROBE_MASK != 0 && lbid() == 0 && ltid() == 0) { const unsigned long long _n = wall_clock64(); tacc[slot] += _n - tacc[16]; tacc[16] = _n; } } while (0)
#define SEAM(k, slot) do { if ((k) + 1 < hi) xcd_barrier(bar); STAMP(slot); } while (0)
    LAS int* const tb = (LAS int*)((LAS unsigned char*)lds_raw + MISC_OFF + 64);

    if (RUN(ph)) { KA; FRAME; phase_prologue(F); phase_norm1<0>(F, KIN(I_X), nullptr, nullptr, KIN(I_NMIX), (bf16*)(KWS + WS_H)); SEAM(ph, 0); }
    ++ph;
    for (int l = 0; l < NL; ++l) {
        if (RUN(ph)) { KA; FRAME; pg8::PlainSched S; S.init((const bf16*)(KWS + WS_H), D, (const bf16*)(KWS + WS_WIN) + (size_t)l * NPAD * D, T, NPAD, D, F.G, F.bid);
            pg8::EpiBf16 E{(bf16*)(KWS + WS_P), NPAD};
            pg8::gemm_phase<pg8::EpiBf16, pg8::PlainSched, true>(F.lds, D, S, E); SEAM(ph, 1); }
        ++ph;
        if (RUN(ph)) { KA; FRAME; phase_prep3(F, l); SEAM(ph, 2); }
        ++ph;
        if (RUN(ph)) { KA; FRAME; phase_compress3(F, l); phase_rec_local(F, l); SEAM(ph, 3); }
        ++ph;
        if (RUN(ph)) { KA; FRAME; phase_rec_scan(F); SEAM(ph, 4); }
        ++ph;
        if (RUN(ph)) { KA; FRAME; phase_nsa2(F, l); phase_rec_out(F, l); SEAM(ph, 5); }
        ++ph;
        if (RUN(ph)) { KA; FRAME;
            for (int n = 0; n < 3; ++n) { pg8::PlainSched S; S.init((const bf16*)(KWS + WS_OCAT) + n * 512, 1536, (const bf16*)(KWS + WS_WBR) + ((size_t)l * 3 + n) * D * 512, T, D, 512, F.G, F.bid);
                pg8::EpiMerge E{(bf16*)(KWS + WS_MERGED), (const bf16*)(KWS + WS_P) + C_MG + n * D, n == 0 ? 1 : 0};
                pg8::gemm_phase<pg8::EpiMerge, pg8::PlainSched, true>(F.lds, 512, S, E); __syncthreads(); }
            SEAM(ph, 6); }
        ++ph;

        if (RUN(ph)) { KA; FRAME; pg8::PlainSched S; S.init((const bf16*)(KWS + WS_MERGED), D, (const bf16*)(KWS + WS_WOUT) + (size_t)l * D * D, T, D, D, F.G, F.bid);
            pg8::EpiResF32 E{l == 0 ? KIN(I_X) : (const float*)(KWS + WS_XRES), (float*)(KWS + WS_X1), D};
            pg8::gemm_phase<pg8::EpiResF32, pg8::PlainSched, false>(F.lds, D, S, E); SEAM(ph, 8); }
        ++ph;
        if (RUN(ph)) { KA; FRAME; phase_router2(F, l); SEAM(ph, 9); }
        ++ph;
        if (RUN(ph)) { KA; FRAME; phase_lists2(F); SEAM(ph, 10); }
        ++ph;
        if (RUN(ph)) { KA; FRAME; moe_table(F, tb);
            pg8::MoeSched<1> S; S.init(F.G, F.bid, tb, (const int*)(KWS + WS_ROUTE + 131072), (const int*)(KWS + WS_ROUTE + 262144), KWS + WS_H, (const bf16*)(KWS + WS_WGU) + (size_t)l * NE * 1024 * D);
            pg8::EpiMoe1 E{(bf16*)(KWS + WS_ACT), (const int*)(KWS + WS_ROUTE + 262144), (const float*)(KWS + WS_ROUTE + 65536)};
            pg8::gemm_phase<pg8::EpiMoe1, pg8::MoeSched<1>, true>(F.lds, D, S, E); SEAM(ph, 11); }
        ++ph;
        if (RUN(ph)) { KA; FRAME; moe_table(F, tb);
            pg8::MoeSched<2> S; S.init(F.G, F.bid, tb, (const int*)(KWS + WS_ROUTE + 131072), (const int*)(KWS + WS_ROUTE + 262144), KWS + WS_ACT, (const bf16*)(KWS + WS_WDN) + (size_t)l * NE * D * FF);
            pg8::EpiMoe2 E{(bf16*)(KWS + WS_CONTRIB), (const int*)(KWS + WS_ROUTE + 262144)};
            pg8::gemm_phase<pg8::EpiMoe2, pg8::MoeSched<2>, true>(F.lds, FF, S, E); SEAM(ph, 12); }
        ++ph;
        if (l + 1 < NL) { if (RUN(ph)) { KA; FRAME; phase_norm1<1>(F, (const float*)(KWS + WS_X1), (const bf16*)(KWS + WS_CONTRIB), (float*)(KWS + WS_XRES), KIN(I_NMIX) + (size_t)(l + 1) * D, (bf16*)(KWS + WS_H)); SEAM(ph, 13); } ++ph; }
    }
    if (RUN(ph)) { KA; FRAME; phase_norm1<2>(F, (const float*)(KWS + WS_X1), (const bf16*)(KWS + WS_CONTRIB), KOUT, nullptr, nullptr); }
    if (MK_PROBE_MASK != 0 && lbid() == 0 && ltid() == 0) {
        asm volatile("s_waitcnt vmcnt(0)" ::: "memory"); STAMP(15);
        unsigned long long tot = 0ull;
        for (int k2 = 0; k2 < 16; ++k2) if ((MK_PROBE_MASK >> k2) & 1) tot += tacc[k2];
        const unsigned long long t_end = wall_clock64() + 4ull * tot;
        while (wall_clock64() < t_end) __builtin_amdgcn_s_sleep(8);
    }
#undef RUN
#undef SEAM
}

#ifndef MK_PER_PHASE
#define MK_PER_PHASE 0
#endif
extern "C" void kernel_launch(void* const* d_in, const int* in_sizes, int n_in, void* d_out, int out_size, void* d_ws, size_t ws_size, hipStream_t stream) {
    static int grid = 0;
    if (grid == 0) {
        if (n_in != 22 || out_size != T * D || ws_size < WS_END) { fprintf(stderr, "kernel_launch: unexpected sizes (n_in %d out %d ws %zu)\n", n_in, out_size, ws_size); grid = -1; return; }
        int dev = 0, cus = 0, per_cu = 0;
        if (hipGetDevice(&dev) != hipSuccess || hipDeviceGetAttribute(&cus, hipDeviceAttributeMultiprocessorCount, dev) != hipSuccess) { grid = -1; return; }
        if (hipFuncSetAttribute((const void*)mk_fwd, hipFuncAttributeMaxDynamicSharedMemorySize, LDS_BYTES) != hipSuccess) { fprintf(stderr, "kernel_launch: hipFuncSetAttribute failed\n"); grid = -1; return; }
        if (hipOccupancyMaxActiveBlocksPerMultiprocessor(&per_cu, (const void*)mk_fwd, 512, LDS_BYTES) != hipSuccess || per_cu < 1) { fprintf(stderr, "kernel_launch: occupancy query says %d\n", per_cu); }
        (void)hipGetLastError();
        grid = cus;
    }
    if (grid < 0) return;
    if (hipMemsetAsync((char*)d_ws + WS_CTL, 0, CTL_ZERO_BYTES, stream) != hipSuccess) return;
    Args a{};
    for (int i = 0; i < 22; ++i) a.in[i] = (const GAS float*)d_in[i];
    a.out = (GAS float*)d_out; a.ws = (GAS unsigned char*)d_ws;
#if MK_PER_PHASE
    const int total = 1 + NL * PH_PER_LAYER + (NL - 1) + 1;
    for (int k = 0; k < total; ++k) { a.ph_lo = k; a.ph_hi = k + 1; a.li = 0; hipLaunchKernelGGL(mk_fwd, dim3(grid), dim3(512), LDS_BYTES, stream, a); }
#else
    a.ph_lo = 0; a.ph_hi = 1000; a.li = 0;
    hipLaunchKernelGGL(mk_fwd, dim3(grid), dim3(512), LDS_BYTES, stream, a);
#endif
    const hipError_t le = hipPeekAtLastError();
    if (le != hipSuccess) fprintf(stderr, "kernel_launch: launch failed: %s\n", hipGetErrorName(le));
}
```

```cpp
#include <hip/hip_runtime.h>
#include <cstdio>
#include <cstdint>

#define GAS __attribute__((address_space(1)))
#define LAS __attribute__((address_space(3)))
typedef unsigned short bf16;
typedef short bf16x8 __attribute__((ext_vector_type(8)));
typedef float f32x4 __attribute__((ext_vector_type(4)));
typedef float f32x2 __attribute__((ext_vector_type(2)));
typedef unsigned u32x4 __attribute__((ext_vector_type(4)));
typedef unsigned u32x2 __attribute__((ext_vector_type(2)));

constexpr int T = 8192, D = 2048, NL = 2, INC = 11048, NPAD = 11264;
constexpr int NE = 32, FF = 512, NCH = T / 64;
constexpr float EPS = 1e-6f, NEGB = -1e30f;
constexpr int C_Q = 0, C_KC = 512, C_VC = 640, C_KS = 768, C_VS = 896, C_KW = 1024, C_VW = 1152;
constexpr int C_HQ = 1280, C_HF = 1792, C_HI = 2304, C_HG = 2816, C_GQ = 3328, C_GK = 3584, C_GV = 3840, C_GR = 4352;
constexpr int C_MG = 4864, C_NG = 11008, C_GA = 11032;

constexpr size_t MiB = 1u << 20;
constexpr size_t WS_CTL = 0, CTL_ZERO_BYTES = 1 * MiB;
constexpr size_t WS_WIN = 2 * MiB;
constexpr size_t WS_WBR = 90 * MiB;
constexpr size_t WS_WOUT = 102 * MiB;
constexpr size_t WS_WGU = 118 * MiB;
constexpr size_t WS_WDN = 374 * MiB;
constexpr size_t WS_H = 502 * MiB;
constexpr size_t WS_P = 534 * MiB;
constexpr size_t WS_OCAT = 710 * MiB;
constexpr size_t WS_PROJ = 734 * MiB;
constexpr size_t WS_MERGED = 830 * MiB;
constexpr size_t WS_X1 = 862 * MiB;
constexpr size_t WS_XRES = 926 * MiB;
constexpr size_t WS_CONTRIB = 990 * MiB;
constexpr size_t WS_ACT = 1054 * MiB;
constexpr size_t WS_QN = 1078 * MiB;
constexpr size_t WS_KV = 1094 * MiB;
constexpr size_t WS_KC = 1118 * MiB;
constexpr size_t WS_ORAW = 1119 * MiB;
constexpr size_t WS_ROUTE = 1151 * MiB;
constexpr size_t WS_SLOC_HG = 1153 * MiB;
constexpr size_t WS_SLOC_GL = 1185 * MiB;
constexpr size_t WS_SPREV_HG = 1201 * MiB;
constexpr size_t WS_SPREV_GL = 1217 * MiB;
constexpr size_t WS_DEC = 1225 * MiB;
constexpr size_t WS_QS = 1226 * MiB;
constexpr size_t WS_KS2 = 1234 * MiB;
constexpr size_t WS_KW2 = 1236 * MiB;
constexpr size_t WS_VST = 1238 * MiB;
constexpr size_t WS_VWT = 1240 * MiB;
constexpr size_t WS_KCB = 1242 * MiB;
constexpr size_t WS_WRT = 1243 * MiB;
constexpr size_t WS_HIST = 1244 * MiB;
constexpr size_t WS_CW = 1245 * MiB;
constexpr size_t WS_END = 1247 * MiB;
constexpr size_t KV_STRIDE = (size_t)2 * T * 64;
constexpr int CW_BAR = 4096;

constexpr int RING_BYTES = 131072;
constexpr int LDS_BYTES = 147456;
constexpr int MISC_OFF = LDS_BYTES - 2048;

#define LDS_WAIT() asm volatile("s_waitcnt lgkmcnt(0)" ::: "memory")
#define VM_WAIT() asm volatile("s_waitcnt vmcnt(0)" ::: "memory")
#define WSYNC() asm volatile("s_waitcnt lgkmcnt(0)" ::: "memory")

__device__ __forceinline__ unsigned f2bf(float f) { unsigned u = __builtin_bit_cast(unsigned, f); return (u + 0x7fffu + ((u >> 16) & 1u)) >> 16; }
__device__ __forceinline__ unsigned pk2(float lo, float hi) { return f2bf(lo) | (f2bf(hi) << 16); }
__device__ __forceinline__ float bf2f(unsigned b) { return __builtin_bit_cast(float, (b & 0xffffu) << 16); }
__device__ __forceinline__ float bflo(unsigned w) { return __builtin_bit_cast(float, w << 16); }
__device__ __forceinline__ float bfhi(unsigned w) { return __builtin_bit_cast(float, w & 0xffff0000u); }
__device__ __forceinline__ float wave_sum(float v) {
#pragma unroll
    for (int o = 1; o < 64; o <<= 1) v += __shfl_xor(v, o);
    return v;
}
__device__ __forceinline__ float wave_max(float v) {
#pragma unroll
    for (int o = 1; o < 64; o <<= 1) v = fmaxf(v, __shfl_xor(v, o));
    return v;
}
__device__ __forceinline__ int ltid() { int t = threadIdx.x; asm volatile("" : "+v"(t)); return t; }
__device__ __forceinline__ int lbid() { int b = blockIdx.x; asm volatile("" : "+s"(b)); return b; }
typedef __bf16 bf16x2_t __attribute__((ext_vector_type(2)));
__device__ __forceinline__ unsigned pkbf(float lo, float hi) { const f32x2 v = {lo, hi}; return __builtin_bit_cast(unsigned, __builtin_convertvector(v, bf16x2_t)); }
constexpr float LOG2E = 1.4426950408889634f;
__device__ __forceinline__ float sigmoidf_(float x) { return 1.0f / (1.0f + expf(-x)); }

#define XB_TMO      128
#define XB_XCNT(j)  (256  + 64 * (j))
#define XB_XSUB(j)  (1280 + 64 * (j))
#define XB_XGEN(j)  (2304 + 64 * (j))
#define XB_TOP      3328
#define XB_TOPGEN   3392
#define XCD_BAR_WORDS 3456
#define XB_SPIN_CAP (1u << 25)

__device__ __forceinline__ unsigned xb_ld(unsigned* p)              { return __hip_atomic_load(p, __ATOMIC_RELAXED, __HIP_MEMORY_SCOPE_AGENT); }
__device__ __forceinline__ unsigned xb_add(unsigned* p, unsigned v) { return __hip_atomic_fetch_add(p, v, __ATOMIC_RELAXED, __HIP_MEMORY_SCOPE_AGENT); }
__device__ __forceinline__ unsigned xb_xcc_id() { return (unsigned)__builtin_amdgcn_s_getreg((3 << 11) | 20) & 0xFu; }
#define XB_SPIN(cond, bar) do { unsigned _sp = 0; while (cond) { __builtin_amdgcn_s_sleep(1); \
    if ((++_sp & 255u) == 0u) { if (xb_ld(&(bar)[XB_TMO])) break; if (_sp > XB_SPIN_CAP) { atomicAdd(&(bar)[XB_TMO], 1u); break; } } } } while (0)

struct XcdBarrier { unsigned* bar; unsigned x; volatile LAS unsigned* st; };

__device__ __forceinline__ XcdBarrier xcd_barrier_post(unsigned* bar, volatile LAS unsigned* st) {
    XcdBarrier b; b.bar = bar; b.x = xb_xcc_id(); b.st = st;
    if (threadIdx.x == 0) (void)xb_add(&bar[XB_XCNT(b.x)], 1u);
    return b;
}
__device__ __forceinline__ void xcd_barrier_complete(unsigned* bar, unsigned x, unsigned& nloc, unsigned& nx) {
    const unsigned G = gridDim.x * gridDim.y * gridDim.z;
    unsigned sum, cnt, mine, sp = 0u;
    for (;;) {
        sum = 0u; cnt = 0u; mine = 0u;
#pragma unroll
        for (unsigned j = 0; j < 16; ++j) { const unsigned c = xb_ld(&bar[XB_XCNT(j)]); sum += c; cnt += (c > 0u) ? 1u : 0u; mine = (j == x) ? c : mine; }
        if (sum == G) break;
        __builtin_amdgcn_s_sleep(1);
        if ((++sp & 255u) == 0u) { if (xb_ld(&bar[XB_TMO])) break; if (sp > XB_SPIN_CAP) { atomicAdd(&bar[XB_TMO], 1u); break; } }
    }
    nloc = mine > 0u ? mine : 1u; nx = cnt > 0u ? cnt : 1u;
}
__device__ __forceinline__ void xcd_barrier(const XcdBarrier& b) {
    asm volatile("s_waitcnt vmcnt(0)" ::: "memory");
    __syncthreads();
    if (threadIdx.x == 0) {
        unsigned* bar = b.bar;
        __builtin_amdgcn_s_waitcnt(0);
        unsigned nloc = b.st[0], nx = b.st[1];
        if (nloc == 0u) { xcd_barrier_complete(bar, b.x, nloc, nx); b.st[0] = nloc; b.st[1] = nx; }
        const unsigned old = xb_add(&bar[XB_XSUB(b.x)], 1u);
        const unsigned gen = old / nloc;
        if (old + 1u == (gen + 1u) * nloc) {
            __builtin_amdgcn_fence(__ATOMIC_RELEASE, "agent");
            asm volatile("s_waitcnt vmcnt(0)" ::: "memory");
            const unsigned og = xb_add(&bar[XB_TOP], 1u);
            const unsigned tg = og / nx;
            if (og + 1u == (tg + 1u) * nx) xb_add(&bar[XB_TOPGEN], 1u);
            else XB_SPIN(xb_ld(&bar[XB_TOPGEN]) == tg, bar);
            __builtin_amdgcn_fence(__ATOMIC_ACQUIRE, "agent");
            xb_add(&bar[XB_XGEN(b.x)], 1u);
            asm volatile("s_waitcnt vmcnt(0)" ::: "memory");
        } else {
            XB_SPIN(xb_ld(&bar[XB_XGEN(b.x)]) == gen, bar);
            __builtin_amdgcn_fence(__ATOMIC_ACQUIRE, "agent");
            asm volatile("s_waitcnt vmcnt(0)" ::: "memory");
        }
    }
    __syncthreads();
}

namespace pg8 {
constexpr int BM = 256, BK = 64, HALF = 128, HTB = HALF * BK * 2, STAGE_BYTES = 8 * HTB, NXCD = 8, WGM = 8;
__host__ __device__ __forceinline__ int lds_byte(int r, int c) { const int st = (r >> 4) * 2 + (c >> 5), rr = r & 15, cc = c & 31, ob = rr * 64 + cc * 2; return st * 1024 + (ob ^ (((ob >> 9) & 1) << 5)); }
__host__ __device__ __forceinline__ void stage_rc(int b, int& R, int& C) { const int st = b / 1024, sb = b % 1024, swz = sb ^ (((sb >> 9) & 1) << 5); R = (st >> 1) * 16 + swz / 64; C = (st & 1) * 32 + (swz % 64) / 2; }
__host__ __device__ __forceinline__ int perm32(int rho) { const int n = rho >> 4, i = rho & 15; return 8 * (i >> 2) + 4 * n + (i & 3); }

struct Unit { int pm, pn, e, nvalid, slot0, half, row0; const char *A0, *A1, *B0, *B1; unsigned va[2][2]; };

__device__ __forceinline__ unsigned cvt_pk_bf16(float lo, float hi) { unsigned r; asm volatile("v_cvt_pk_bf16_f32 %0, %1, %2" : "=v"(r) : "v"(lo), "v"(hi)); return r; }

template <class Epi, class Sched, bool ALIGN_EPI>
__device__ __forceinline__ void gemm_phase(LAS unsigned char* lds, const int K, const Sched& S, const Epi& E) {
    const int tid = ltid(), wid = __builtin_amdgcn_readfirstlane(tid >> 6), lane = tid & 63, wr = wid >> 2, wc = wid & 3, fr = lane & 15, fq = lane >> 4;
    const int nt = K / BK;
    unsigned voffB[2];
#pragma unroll
    for (int i = 0; i < 2; ++i) { int R, C; stage_rc(tid * 16 + i * 8192, R, C); const int Rb = Epi::PERM ? ((R & ~31) + perm32(R & 31)) : R; voffB[i] = (unsigned)(Rb * K + C) * 2u; }
    const size_t kstep = (size_t)(BK * 2);
    const unsigned ldsw = (unsigned)wid * 1024u;
    const int aoff = lds_byte(wr * 64 + fr, fq * 8), boff = lds_byte(wc * 32 + fr, fq * 8);
#define PG8_SA(b, h) (((b) * 2 + (h)) * HTB)
#define PG8_SB(b, h) ((4 + (b) * 2 + (h)) * HTB)
#define PG8_STAGE(bufoff, gbase, voff) do { _Pragma("unroll") for (int _i = 0; _i < 2; ++_i) \
        __builtin_amdgcn_global_load_lds((const unsigned*)((const char*)(gbase) + (voff)[_i]), (LAS unsigned*)(lds + (bufoff) + ldsw + _i * 8192), 16, 0, 0); } while (0)
#define PG8_LDA(dst, b, h) do { _Pragma("unroll") for (int m = 0; m < 4; ++m) _Pragma("unroll") for (int k = 0; k < 2; ++k) dst[m][k] = *(const LAS bf16x8*)(lds + PG8_SA(b, h) + aoff + m * 2048 + k * 1024); } while (0)
#define PG8_LDB(dst, b, h) do { _Pragma("unroll") for (int n = 0; n < 2; ++n) _Pragma("unroll") for (int k = 0; k < 2; ++k) dst[n][k] = *(const LAS bf16x8*)(lds + PG8_SB(b, h) + boff + n * 2048 + k * 1024); } while (0)
#define PG8_MMA(ai, bj, At, Bt) do { __builtin_amdgcn_s_setprio(1); _Pragma("unroll") for (int m = 0; m < 4; ++m) _Pragma("unroll") for (int n = 0; n < 2; ++n) _Pragma("unroll") for (int k = 0; k < 2; ++k) \
        acc[ai][bj][m][n] = __builtin_amdgcn_mfma_f32_16x16x32_bf16(Bt[n][k], At[m][k], acc[ai][bj][m][n], 0, 0, 0); __builtin_amdgcn_s_setprio(0); } while (0)
#define PG8_WAIT_V(n) asm volatile("s_waitcnt vmcnt(" #n ")" ::: "memory")
#define PG8_WAIT_L(n) asm volatile("s_waitcnt lgkmcnt(" #n ")" ::: "memory")
#define PG8_BAR __builtin_amdgcn_s_barrier()
#define PG8_SCHED __builtin_amdgcn_sched_barrier(0)
#define VA(u, h) (Sched::GATHER ? (u).va[h] : S.va)
    Unit cur, nxt; int ui = 0;
    if (!S.next(0, cur)) return;
    f32x4 acc[2][2][4][2];
#pragma unroll
    for (int a = 0; a < 2; ++a)
#pragma unroll
        for (int b = 0; b < 2; ++b)
#pragma unroll
            for (int m = 0; m < 4; ++m)
#pragma unroll
                for (int n = 0; n < 2; ++n) acc[a][b][m][n] = (f32x4){0.f, 0.f, 0.f, 0.f};
    bf16x8 At[4][2], B0[2][2], B1[2][2];
    PG8_STAGE(PG8_SB(0, 0), cur.B0, voffB); PG8_STAGE(PG8_SB(0, 1), cur.B1, voffB); PG8_STAGE(PG8_SA(0, 0), cur.A0, VA(cur, 0)); PG8_STAGE(PG8_SA(0, 1), cur.A1, VA(cur, 1));
    if (wr == 1) PG8_BAR;
    PG8_WAIT_V(2); PG8_BAR;
    PG8_STAGE(PG8_SB(1, 0), cur.B0 + kstep, voffB); PG8_STAGE(PG8_SA(1, 0), cur.A0 + kstep, VA(cur, 0)); PG8_STAGE(PG8_SB(1, 1), cur.B1 + kstep, voffB);
    PG8_WAIT_V(6); PG8_BAR;
    for (;;) {
        const bool has_next = S.next(ui + 1, nxt);
        if (!has_next) nxt = cur;
        for (int t = 0; t < nt; t += 2) {
            const bool last = (t == nt - 2);
            const char* a1h1 = cur.A1 + (size_t)(t + 1) * kstep;
            const char* a2h0 = last ? nxt.A0 : cur.A0 + (size_t)(t + 2) * kstep; const char* a2h1 = last ? nxt.A1 : cur.A1 + (size_t)(t + 2) * kstep;
            const char* b2h0 = last ? nxt.B0 : cur.B0 + (size_t)(t + 2) * kstep; const char* b2h1 = last ? nxt.B1 : cur.B1 + (size_t)(t + 2) * kstep;
            unsigned v2h0[2], v2h1[2];
#pragma unroll
            for (int i = 0; i < 2; ++i) { if constexpr (Sched::GATHER) { v2h0[i] = last ? nxt.va[0][i] : cur.va[0][i]; v2h1[i] = last ? nxt.va[1][i] : cur.va[1][i]; } else { v2h0[i] = S.va[i]; v2h1[i] = S.va[i]; } }
            PG8_LDB(B0, 0, 0); PG8_LDB(B1, 0, 1); PG8_SCHED; PG8_LDA(At, 0, 0); PG8_STAGE(PG8_SA(1, 1), a1h1, VA(cur, 1));
            PG8_WAIT_V(8); PG8_WAIT_L(0); PG8_BAR; PG8_MMA(0, 0, At, B0); PG8_MMA(0, 1, At, B1); PG8_BAR; PG8_SCHED;
            if (!cur.half) PG8_LDA(At, 0, 1);
            PG8_STAGE(PG8_SB(0, 0), b2h0, voffB); PG8_STAGE(PG8_SB(0, 1), b2h1, voffB); PG8_STAGE(PG8_SA(0, 0), a2h0, v2h0);
            PG8_WAIT_V(8); PG8_WAIT_L(0); PG8_BAR; if (!cur.half) { PG8_MMA(1, 0, At, B0); PG8_MMA(1, 1, At, B1); } PG8_BAR; PG8_SCHED;
            PG8_LDB(B0, 1, 0); PG8_LDB(B1, 1, 1); PG8_SCHED; PG8_LDA(At, 1, 0); PG8_STAGE(PG8_SA(0, 1), a2h1, v2h1);
            PG8_WAIT_V(8); PG8_WAIT_L(0); PG8_BAR; PG8_MMA(0, 0, At, B0); PG8_MMA(0, 1, At, B1); PG8_BAR; PG8_SCHED;
            if (!cur.half) PG8_LDA(At, 1, 1);
            PG8_STAGE(PG8_SB(1, 0), b2h0 + kstep, voffB); PG8_STAGE(PG8_SB(1, 1), b2h1 + kstep, voffB); PG8_STAGE(PG8_SA(1, 0), a2h0 + kstep, v2h0);
            PG8_WAIT_V(8); PG8_WAIT_L(0); PG8_BAR; if (!cur.half) { PG8_MMA(1, 0, At, B0); PG8_MMA(1, 1, At, B1); } PG8_BAR; PG8_SCHED;
        }
        if constexpr (ALIGN_EPI) { if (wr == 0) PG8_BAR; }
        E(acc, cur, wr, wc, fr, fq);
        if (!has_next) break;
#pragma unroll
        for (int a = 0; a < 2; ++a)
#pragma unroll
            for (int b = 0; b < 2; ++b)
#pragma unroll
                for (int m = 0; m < 4; ++m)
#pragma unroll
                    for (int n = 0; n < 2; ++n) acc[a][b][m][n] = (f32x4){0.f, 0.f, 0.f, 0.f};
        cur = nxt; ++ui;
        if constexpr (ALIGN_EPI) { if (wr == 1) PG8_BAR; }
    }
    PG8_WAIT_V(0);
    if constexpr (!ALIGN_EPI) { if (wr == 0) PG8_BAR; }
    PG8_BAR;
#undef VA
#undef PG8_SA
#undef PG8_SB
#undef PG8_STAGE
#undef PG8_LDA
#undef PG8_LDB
#undef PG8_MMA
#undef PG8_WAIT_V
#undef PG8_WAIT_L
#undef PG8_BAR
#undef PG8_SCHED
}

struct PlainSched {
    static constexpr bool GATHER = false;
    int nM, nN, nwg, G, c, lda, K, nNh; const char* A; const char* Bt; unsigned va[2];
    __device__ __forceinline__ void init(const bf16* A_, int lda_, const bf16* Bt_, int M, int N, int K_, int G_, int c_, int nNh_ = 0) {
        nM = M / BM; nN = N / BM - nNh_; nNh = nNh_; nwg = nM * nN; G = G_; c = c_; lda = lda_; K = K_; A = (const char*)A_; Bt = (const char*)Bt_;
#pragma unroll
        for (int i = 0; i < 2; ++i) { int R, C; stage_rc((int)ltid() * 16 + i * 8192, R, C); va[i] = (unsigned)(R * lda + C) * 2u; }
    }
    __device__ __forceinline__ bool next(int i, Unit& u) const {
        const long L = (long)i * G + c;
        u.e = 0; u.nvalid = 256; u.slot0 = 0; u.va[0][0] = 0u; u.va[0][1] = 0u; u.va[1][0] = 0u; u.va[1][1] = 0u;
        if (L >= nwg) { const int hL = (int)(L - nwg); if (hL >= 2 * nM * nNh) return false;
            const int hm = hL / nNh, pn = nN + hL % nNh;
            u.pm = hm >> 1; u.pn = pn; u.half = 1; u.row0 = hm * HALF;
            u.A0 = A + (size_t)hm * HALF * lda * 2; u.A1 = u.A0;
            u.B0 = Bt + (size_t)pn * BM * K * 2; u.B1 = u.B0 + (size_t)HALF * K * 2;
            return true; }
        int wgid = (int)L; { const int q = nwg / NXCD, r = nwg % NXCD, xcd = wgid % NXCD, off = wgid / NXCD; wgid = (xcd < r ? xcd * (q + 1) : r * (q + 1) + (xcd - r) * q) + off; }
        const int nig = WGM * nN, gid = wgid / nig, fm = gid * WGM, gsz = (nM - fm) < WGM ? (nM - fm) : WGM;
        u.pm = fm + ((wgid % nig) % gsz); u.pn = (wgid % nig) / gsz; u.half = 0; u.row0 = u.pm * BM;
        u.A0 = A + (size_t)u.pm * BM * lda * 2; u.A1 = u.A0 + (size_t)HALF * lda * 2;
        u.B0 = Bt + (size_t)u.pn * BM * K * 2; u.B1 = u.B0 + (size_t)HALF * K * 2;
        return true;
    }
};
template <int MODE> struct MoeSched {
    static constexpr int NPN = MODE == 1 ? 4 : 8;
    static constexpr bool GATHER = MODE == 1;
    int G, c; const LAS int* tb; const int* cnt; const int* list; const char* A; const char* W; unsigned va[2];
    __device__ __forceinline__ void init(int G_, int c_, const LAS int* tb_, const int* cnt_, const int* list_, const void* A_, const void* W_) {
        G = G_; c = c_; tb = tb_; cnt = cnt_; list = list_; A = (const char*)A_; W = (const char*)W_;
#pragma unroll
        for (int i = 0; i < 2; ++i) { int R, C; stage_rc((int)ltid() * 16 + i * 8192, R, C); va[i] = (unsigned)(R * FF + C) * 2u; }
    }
    __device__ __forceinline__ bool next(int i, Unit& u) const {
        const int L = i * G + c, nfull = __builtin_amdgcn_readfirstlane(tb[33 + NE]), nhalf = __builtin_amdgcn_readfirstlane(tb[66 + NE]);
        if (L >= (nfull + nhalf) * NPN) return false;
        const bool half = L >= nfull * NPN; const int Lr = half ? L - nfull * NPN : L, base = half ? 66 : 33;
        const int tq = Lr / NPN, pn = Lr % NPN; int e = 0;
        while (e < NE - 1 && __builtin_amdgcn_readfirstlane(tb[base + e + 1]) <= tq) ++e;
        const int ne = __builtin_amdgcn_readfirstlane(cnt[e]);
        const int pm = half ? (ne - 1) / 256 : tq - __builtin_amdgcn_readfirstlane(tb[33 + e]);
        const int tl = __builtin_amdgcn_readfirstlane(tb[e]) + pm;
        u.pm = pm; u.pn = pn; u.e = e; u.nvalid = ne - pm * 256; u.slot0 = tl * 256; u.half = half ? 1 : 0; u.row0 = 0;
        if (MODE == 1) {
            u.A0 = A; u.A1 = A;
#pragma unroll
            for (int h = 0; h < 2; ++h)
#pragma unroll
                for (int k = 0; k < 2; ++k) { int Rk, Ck; stage_rc((int)ltid() * 16 + k * 8192, Rk, Ck); int idx = pm * 256 + h * 128 + Rk; idx = idx < ne ? idx : ne - 1; const int entry = list[e * 8192 + idx]; u.va[h][k] = (unsigned)(entry >> 1) * (unsigned)(D * 2) + (unsigned)Ck * 2u; }
            const char* we = W + (size_t)e * 1024 * D * 2;
            u.B0 = we + (size_t)(pn * 128) * D * 2; u.B1 = we + (size_t)(512 + pn * 128) * D * 2;
        } else {
            u.va[0][0] = 0u; u.va[0][1] = 0u; u.va[1][0] = 0u; u.va[1][1] = 0u;
            u.A0 = A + (size_t)tl * 256 * FF * 2; u.A1 = u.A0 + (size_t)HALF * FF * 2;
            const char* we = W + (size_t)e * D * FF * 2;
            u.B0 = we + (size_t)(pn * 256) * FF * 2; u.B1 = u.B0 + (size_t)HALF * FF * 2;
        }
        return true;
    }
};

struct EpiBf16 {
    static constexpr bool PERM = true;
    bf16* O; int ldc;
    __device__ __forceinline__ void operator()(const f32x4 (&acc)[2][2][4][2], const Unit& u, int wr, int wc, int fr, int fq) const {
        const int row0 = u.row0 + wr * 64 + fr, col0 = u.pn * BM + wc * 32 + 8 * fq;
#pragma unroll
        for (int ai = 0; ai < 2; ++ai) if (ai == 0 || !u.half)
#pragma unroll
            for (int m = 0; m < 4; ++m) { bf16* rowp = O + (size_t)(row0 + ai * HALF + m * 16) * ldc + col0;
#pragma unroll
                for (int bj = 0; bj < 2; ++bj) { const f32x4 v0 = acc[ai][bj][m][0], v1 = acc[ai][bj][m][1];
                    u32x4 w; w.x = cvt_pk_bf16(v0[0], v0[1]); w.y = cvt_pk_bf16(v0[2], v0[3]); w.z = cvt_pk_bf16(v1[0], v1[1]); w.w = cvt_pk_bf16(v1[2], v1[3]);
                    *(u32x4*)(rowp + bj * HALF) = w; } }
    }
};
struct EpiMerge {
    static constexpr bool PERM = true;
    bf16* MG; const bf16* gate; int first;
    __device__ __forceinline__ void operator()(const f32x4 (&acc)[2][2][4][2], const Unit& u, int wr, int wc, int fr, int fq) const {
        const int row0 = u.row0 + wr * 64 + fr, col0 = u.pn * BM + wc * 32 + 8 * fq;
#pragma unroll
        for (int ai = 0; ai < 2; ++ai) if (ai == 0 || !u.half)
#pragma unroll
            for (int m = 0; m < 4; ++m) { const size_t row = (size_t)(row0 + ai * HALF + m * 16);
#pragma unroll
                for (int bj = 0; bj < 2; ++bj) { const u32x4 gq = *(const u32x4*)(gate + row * NPAD + col0 + bj * HALF); u32x4 pv = {0u, 0u, 0u, 0u};
                    if (!first) pv = *(const u32x4*)(MG + row * D + col0 + bj * HALF);
                    const f32x4 v0 = acc[ai][bj][m][0], v1 = acc[ai][bj][m][1]; float o[8];
                    const unsigned gw[4] = {gq.x, gq.y, gq.z, gq.w}, pw[4] = {pv.x, pv.y, pv.z, pv.w};
#pragma unroll
                    for (int k = 0; k < 4; ++k) { const float a0 = k < 2 ? v0[2 * k] : v1[2 * k - 4], a1 = k < 2 ? v0[2 * k + 1] : v1[2 * k - 3];
                        const float g0 = __builtin_bit_cast(float, gw[k] << 16), g1 = __builtin_bit_cast(float, gw[k] & 0xffff0000u);
                        o[2 * k] = __builtin_bit_cast(float, pw[k] << 16) + a0 / (1.0f + __expf(-g0)); o[2 * k + 1] = __builtin_bit_cast(float, pw[k] & 0xffff0000u) + a1 / (1.0f + __expf(-g1)); }
                    u32x4 w; w.x = cvt_pk_bf16(o[0], o[1]); w.y = cvt_pk_bf16(o[2], o[3]); w.z = cvt_pk_bf16(o[4], o[5]); w.w = cvt_pk_bf16(o[6], o[7]);
                    *(u32x4*)(MG + row * D + col0 + bj * HALF) = w; } }
    }
};
struct EpiResF32 {
    static constexpr bool PERM = false;
    const float* R; float* O; int ldc;
    __device__ __forceinline__ void operator()(const f32x4 (&acc)[2][2][4][2], const Unit& u, int wr, int wc, int fr, int fq) const {
        const int row0 = u.row0 + wr * 64 + fr, col0 = u.pn * BM + wc * 32 + 4 * fq;
#pragma unroll
        for (int ai = 0; ai < 2; ++ai) if (ai == 0 || !u.half)
#pragma unroll
            for (int m = 0; m < 4; ++m) { const size_t off = (size_t)(row0 + ai * HALF + m * 16) * ldc + col0;
#pragma unroll
                for (int bj = 0; bj < 2; ++bj)
#pragma unroll
                    for (int n = 0; n < 2; ++n) { const f32x4 r = *(const f32x4*)(R + off + bj * HALF + n * 16); *(f32x4*)(O + off + bj * HALF + n * 16) = acc[ai][bj][m][n] + r; } }
    }
};
struct EpiMoe1 {
    static constexpr bool PERM = true;
    bf16* ACT; const int* list; const float* ew;
    __device__ __forceinline__ void operator()(const f32x4 (&acc)[2][2][4][2], const Unit& u, int wr, int wc, int fr, int fq) const {
        const int col0 = u.pn * 128 + wc * 32 + 8 * fq;
#pragma unroll
        for (int ai = 0; ai < 2; ++ai) if (ai == 0 || !u.half)
#pragma unroll
            for (int m = 0; m < 4; ++m) { const int r = ai * HALF + wr * 64 + m * 16 + fr; float w = 0.f;
                if (r < u.nvalid) { const int entry = list[u.e * 8192 + u.pm * 256 + r]; w = ew[entry]; }
                float o[8];
#pragma unroll
                for (int n = 0; n < 2; ++n)
#pragma unroll
                    for (int j = 0; j < 4; ++j) { const float g = acc[ai][0][m][n][j], up = acc[ai][1][m][n][j]; o[n * 4 + j] = g / (1.0f + __expf(-g)) * up * w; }
                u32x4 pk; pk.x = cvt_pk_bf16(o[0], o[1]); pk.y = cvt_pk_bf16(o[2], o[3]); pk.z = cvt_pk_bf16(o[4], o[5]); pk.w = cvt_pk_bf16(o[6], o[7]);
                *(u32x4*)(ACT + (size_t)(u.slot0 + r) * FF + col0) = pk; }
    }
};
struct EpiMoe2 {
    static constexpr bool PERM = true;
    bf16* CO; const int* list;
    __device__ __forceinline__ void operator()(const f32x4 (&acc)[2][2][4][2], const Unit& u, int wr, int wc, int fr, int fq) const {
        const int col0 = u.pn * BM + wc * 32 + 8 * fq;
#pragma unroll
        for (int ai = 0; ai < 2; ++ai) if (ai == 0 || !u.half)
#pragma unroll
            for (int m = 0; m < 4; ++m) { const int r = ai * HALF + wr * 64 + m * 16 + fr;
                if (r < u.nvalid) { const int entry = list[u.e * 8192 + u.pm * 256 + r]; bf16* rowp = CO + (size_t)entry * D + col0;
#pragma unroll
                    for (int bj = 0; bj < 2; ++bj) { const f32x4 v0 = acc[ai][bj][m][0], v1 = acc[ai][bj][m][1];
                        u32x4 w; w.x = cvt_pk_bf16(v0[0], v0[1]); w.y = cvt_pk_bf16(v0[2], v0[3]); w.z = cvt_pk_bf16(v1[0], v1[1]); w.w = cvt_pk_bf16(v1[2], v1[3]);
                        *(u32x4*)(rowp + bj * HALF) = w; } } }
    }
};
}

struct Frame {
    LAS unsigned char* lds; volatile LAS unsigned* MISC;
    int tid, lane, wave, vcu, G, gw, NGW, bid;
};
struct Args { const GAS float* in[22]; GAS float* out; GAS unsigned char* ws; int ph_lo, ph_hi, li, pad; };
typedef const __attribute__((address_space(4))) Args KArgs;
__device__ __forceinline__ KArgs* ka_fresh() { unsigned long long p = (unsigned long long)__builtin_amdgcn_kernarg_segment_ptr(); asm volatile("" : "+s"(p)); return (KArgs*)p; }
#define KA KArgs* const ka = ka_fresh()
#define KIN(i) ((const float*)ka->in[i])
#define KWS ((unsigned char*)ka->ws)
#define KOUT ((float*)ka->out)
enum { I_X = 0, I_NMIX, I_WIN, I_PE, I_W1, I_W2, I_QN, I_KN, I_LB, I_HGN, I_WA2, I_BA, I_GLAN, I_WBR, I_WOUT, I_NFFN, I_WGRP, I_BGRP, I_WEXP, I_BEXP, I_WGU, I_WDN };

__device__ __forceinline__ void tr_item(const float* W, size_t ldw, int c0, int nv, bf16* WT, size_t ldt, int r0, int k0, LAS float* scr, int lane) {
    const int nn = lane & 31;
    float tv[32];
#pragma unroll
    for (int i = 0; i < 32; ++i) { const int kk = 2 * i + (lane >> 5); tv[i] = nn < nv ? W[(size_t)(k0 + kk) * ldw + c0 + nn] : 0.f; }
#pragma unroll
    for (int i = 0; i < 32; ++i) { const int kk = 2 * i + (lane >> 5); scr[kk * 33 + nn] = tv[i]; }
    LDS_WAIT();
    const int c = lane & 7;
#pragma unroll
    for (int j = 0; j < 4; ++j) { const int n = (lane >> 3) + 8 * j; const LAS float* s = scr + (8 * c) * 33 + n;
        u32x4 o; o.x = pk2(s[0 * 33], s[1 * 33]); o.y = pk2(s[2 * 33], s[3 * 33]); o.z = pk2(s[4 * 33], s[5 * 33]); o.w = pk2(s[6 * 33], s[7 * 33]);
        if (n < nv) *(u32x4*)(WT + (size_t)(r0 + n) * ldt + k0 + 8 * c) = o; }
    LDS_WAIT();
}
__device__ __forceinline__ void phase_prologue(Frame& F) {
    KA;
    {
      bf16* W1T = (bf16*)(KWS + WS_CW); bf16* W2T = (bf16*)(KWS + WS_CW + 1048576); float* B1 = (float*)(KWS + WS_CW + 1572864);
      for (int i = F.bid * 512 + F.tid; i < NL * 2 * 64 * 2048; i += F.G * 512) { const int lk = i / (64 * 2048), j = (i / 2048) % 64, c = i % 2048; W1T[i] = (bf16)f2bf(KIN(I_W1)[((size_t)lk * 2048 + c) * 64 + j]); }
      for (int i = F.bid * 512 + F.tid; i < NL * 2 * 64 * 64; i += F.G * 512) { const int lk = i / 4096, j2 = (i / 64) % 64, j = i % 64; W2T[i] = (bf16)f2bf(KIN(I_W2)[((size_t)lk * 64 + j) * 64 + j2]); }
      if (F.bid < NL * 2) { const int lk = F.bid, j = F.tid & 63, part = F.tid >> 6; float a = 0.f;
#pragma unroll 8
          for (int c = part * 256; c < part * 256 + 256; ++c) a += KIN(I_PE)[(size_t)lk * 2048 + c] * KIN(I_W1)[((size_t)lk * 2048 + c) * 64 + j];
          LAS float* rd = (LAS float*)F.lds; rd[F.tid] = a; __syncthreads();
          if (F.tid < 64) { float t2 = 0.f;
#pragma unroll
              for (int p = 0; p < 8; ++p) t2 += rd[p * 64 + F.tid];
              B1[lk * 64 + F.tid] = t2; }
          __syncthreads(); } }
    { float* WRT = (float*)(KWS + WS_WRT);
      for (int i = F.bid * 512 + F.tid; i < NL * 48 * D; i += F.G * 512) { const int l = i / (48 * D), n = (i / D) % 48, k = i % D; const float g = KIN(I_NFFN)[l * D + k];
          WRT[i] = n < 32 ? g * KIN(I_WEXP)[((size_t)l * D + k) * 32 + n] : (n < 36 ? g * KIN(I_WGRP)[((size_t)l * D + k) * 4 + (n - 32)] : 0.f); } }
    LAS float* scr = (LAS float*)(F.lds + F.wave * 16384);
    constexpr int IT_WIN = 32 * 346, IT_WBR = 3 * 8 * 64, IT_WOUT = 32 * 64, IT_WGU = 32 * 32 * 32, IT_WDN = 32 * 8 * 64, IT_L = IT_WIN + IT_WBR + IT_WOUT + IT_WGU + IT_WDN;
    for (int it = F.gw; it < NL * IT_L; it += F.NGW) {
        const int l = it / IT_L; int r = it % IT_L;
        if (r < IT_WIN) { const int kb = r / 346, nb = r % 346; int src, dst, nv = 32;
            if (nb < 40) { src = nb * 32; dst = nb * 32; }
            else if (nb == 40) { src = 1280; dst = C_NG; nv = 24; }
            else if (nb < 153) { src = 1304 + 32 * (nb - 41); dst = 1280 + 32 * (nb - 41); }
            else if (nb == 153) { src = 4888; dst = C_GA; nv = 16; }
            else { src = 4904 + 32 * (nb - 154); dst = C_MG + 32 * (nb - 154); }
            tr_item(KIN(I_WIN) + (size_t)l * D * INC, INC, src, nv, (bf16*)(KWS + WS_WIN) + (size_t)l * NPAD * D, D, dst, kb * 64, scr, F.lane); continue; }
        r -= IT_WIN;
        if (r < IT_WBR) { const int n = r / 512, q = r % 512, kb = q / 64, nb = q % 64;
            tr_item(KIN(I_WBR) + ((size_t)l * 3 + n) * 512 * D, D, nb * 32, 32, (bf16*)(KWS + WS_WBR) + ((size_t)l * 3 + n) * D * 512, 512, nb * 32, kb * 64, scr, F.lane); continue; }
        r -= IT_WBR;
        if (r < IT_WOUT) { const int kb = r / 64, nb = r % 64;
            tr_item(KIN(I_WOUT) + (size_t)l * D * D, D, nb * 32, 32, (bf16*)(KWS + WS_WOUT) + (size_t)l * D * D, D, nb * 32, kb * 64, scr, F.lane); continue; }
        r -= IT_WOUT;
        if (r < IT_WGU) { const int e = r / 1024, q = r % 1024, kb = q / 32, nb = q % 32;
            tr_item(KIN(I_WGU) + ((size_t)l * NE + e) * D * 1024, 1024, nb * 32, 32, (bf16*)(KWS + WS_WGU) + ((size_t)l * NE + e) * 1024 * D, D, nb * 32, kb * 64, scr, F.lane); continue; }
        r -= IT_WGU;
        { const int e = r / 512, q = r % 512, kb = q / 64, nb = q % 64;
            tr_item(KIN(I_WDN) + ((size_t)l * NE + e) * FF * D, D, nb * 32, 32, (bf16*)(KWS + WS_WDN) + ((size_t)l * NE + e) * D * FF, FF, nb * 32, kb * 64, scr, F.lane); }
    }
}

template <int MODE> __device__ __forceinline__ void phase_norm1(Frame& F, const float* xin, const bf16* contrib, float* xout, const float* gain, bf16* H) {
    for (int t = F.gw; t < T; t += F.NGW) {
        const f32x4* xr = (const f32x4*)(xin + (size_t)t * D) + F.lane;
        f32x4 v[8]; float ss = 0.f;
#pragma unroll
        for (int j = 0; j < 8; ++j) { v[j] = xr[64 * j];
            if (MODE != 0) { const u32x2 c0 = *((const u32x2*)(contrib + (size_t)(2 * t) * D) + F.lane + 64 * j), c1 = *((const u32x2*)(contrib + (size_t)(2 * t + 1) * D) + F.lane + 64 * j);
                v[j].x += bflo(c0.x) + bflo(c1.x); v[j].y += bfhi(c0.x) + bfhi(c1.x); v[j].z += bflo(c0.y) + bflo(c1.y); v[j].w += bfhi(c0.y) + bfhi(c1.y);
                *((f32x4*)(xout + (size_t)t * D) + F.lane + 64 * j) = v[j]; }
            ss += v[j].x * v[j].x + v[j].y * v[j].y + v[j].z * v[j].z + v[j].w * v[j].w; }
        if (MODE != 2) {
            const float rstd = 1.0f / sqrtf(wave_sum(ss) * (1.0f / D) + EPS);
#pragma unroll
            for (int j = 0; j < 8; ++j) { const f32x4 g = *((const f32x4*)gain + F.lane + 64 * j);
                u32x2 o; o.x = pk2(v[j].x * rstd * g.x, v[j].y * rstd * g.y); o.y = pk2(v[j].z * rstd * g.z, v[j].w * rstd * g.w);
                *((u32x2*)(H + (size_t)t * D) + F.lane + 64 * j) = o; }
        }
    }
}

__device__ __forceinline__ void phase_prep(Frame& F, int l) {
    KA;
    const bf16* P = (const bf16*)(KWS + WS_P);
    float* QN = (float*)(KWS + WS_QN); float* KV = (float*)(KWS + WS_KV);
    const float* qg = KIN(I_QN) + l * 64; const float* kg = KIN(I_KN) + l * 192;
    for (int it = F.gw; it < T * 20; it += F.NGW) {
        const int t = it / 20, v = it % 20;
        float x = bf2f(P[(size_t)t * NPAD + v * 64 + F.lane]);
        const bool isq = v < 8, nk1 = (v == 12 || v == 13), nk2 = (v == 16 || v == 17);
        if (isq || nk1 || nk2) { const float ss = wave_sum(x * x); const float g = isq ? qg[F.lane] : (nk1 ? kg[64 + F.lane] : kg[128 + F.lane]); x = x * (1.0f / sqrtf(ss * (1.0f / 64.0f) + EPS)) * g; }
        if (isq) QN[((size_t)v * T + t) * 64 + F.lane] = x;
        else { const int w = v - 8, tens = w >> 1, g = w & 1; KV[(size_t)tens * KV_STRIDE + ((size_t)g * T + t) * 64 + F.lane] = x; }
    }
}
__device__ __forceinline__ float gelu_tanh(float x) { const float u = 0.7978845608028654f * (x + 0.044715f * x * x * x); return 0.5f * x * (1.0f + tanhf(u)); }
__device__ __forceinline__ void phase_compress(Frame& F, int l) {
    KA;
    LAS float* av = (LAS float*)(F.lds + F.wave * 16384);
    const float* KV = (const float*)(KWS + WS_KV); float* KC = (float*)(KWS + WS_KC);
    for (int it = F.gw; it < 2 * 2 * 511; it += F.NGW) {
        const int kind = it / 1022, q = it % 1022, g = q / 511, n = q % 511;
        const float* src = KV + (size_t)kind * KV_STRIDE + ((size_t)g * T + 16 * n) * 64;
        const float* pe = KIN(I_PE) + ((size_t)l * 2 + kind) * 2048;
        const float* w1 = KIN(I_W1) + ((size_t)l * 2 + kind) * 2048 * 64;
        const float* w2 = KIN(I_W2) + ((size_t)l * 2 + kind) * 64 * 64;
#pragma unroll 4
        for (int c = 0; c < 32; ++c) av[c * 64 + F.lane] = src[c * 64 + F.lane] + pe[c * 64 + F.lane];
        WSYNC();
        float acc = 0.f;
#pragma unroll 8
        for (int i = 0; i < 2048; ++i) acc += av[i] * w1[i * 64 + F.lane];
        const float hid = gelu_tanh(acc);
        WSYNC();
        av[F.lane] = hid;
        WSYNC();
        float o = 0.f;
#pragma unroll 8
        for (int i = 0; i < 64; ++i) o += av[i] * w2[i * 64 + F.lane];
        WSYNC();
        if (kind == 0) { const float ss = wave_sum(o * o); o = o * (1.0f / sqrtf(ss * (1.0f / 64.0f) + EPS)) * KIN(I_KN)[l * 192 + F.lane]; }
        KC[(size_t)kind * (2 * 512 * 64) + ((size_t)g * 512 + n) * 64 + F.lane] = o;
    }
}
__device__ __forceinline__ void phase_recur(Frame& F, int l) {
    KA;
    const bf16* P = (const bf16*)(KWS + WS_P); float* ORAW = (float*)(KWS + WS_ORAW);
    for (int it = F.gw; it < 1024; it += F.NGW) {
        const int kind = it >> 9, head = (it >> 7) & 3, j = it & 127;
        if (kind == 0) {
            const int d0 = F.lane, d1 = F.lane + 64;
            const float* lbl = KIN(I_LB);
            float lb0, lb1;
            { const float a0 = lbl[head * 128 + d0], b0 = lbl[512 + head * 128 + d0], a1 = lbl[head * 128 + d1], b1 = lbl[512 + head * 128 + d1];
              lb0 = l == 0 ? 0.f : 1.0f / (1.0f + expf(a0 - b0)); lb1 = l == 0 ? 0.f : 1.0f / (1.0f + expf(a1 - b1)); }
            const bf16* Pq = P + C_HQ + head * 128; const bf16* Pf = P + C_HF + head * 128; const bf16* Pi = P + C_HI + head * 128 + j;
            float S0 = 0.f, S1 = 0.f;
            for (int t0 = 0; t0 < T; t0 += 8) {
                bf16 zq0[8], zq1[8], zf0[8], zf1[8], vi[8];
#pragma unroll
                for (int u = 0; u < 8; ++u) { const size_t row = (size_t)(t0 + u) * NPAD; zq0[u] = Pq[row + d0]; zq1[u] = Pq[row + d1]; zf0[u] = Pf[row + d0]; zf1[u] = Pf[row + d1]; vi[u] = Pi[row]; }
                float part[8];
#pragma unroll
                for (int u = 0; u < 8; ++u) { const float v = bf2f(vi[u]);
                    const float s0 = sigmoidf_(bf2f(zf0[u])), s1 = sigmoidf_(bf2f(zf1[u]));
                    const float f0 = lb0 + (1.0f - lb0) * s0, f1 = lb1 + (1.0f - lb1) * s1;
                    const float k0 = (1.0f - lb0) * (1.0f - s0), k1 = (1.0f - lb1) * (1.0f - s1);
                    S0 = f0 * S0 + k0 * v; S1 = f1 * S1 + k1 * v;
                    part[u] = bf2f(zq0[u]) * S0 + bf2f(zq1[u]) * S1; }
                float mine = 0.f;
#pragma unroll
                for (int u = 0; u < 8; ++u) { const float s = wave_sum(part[u]); mine = (F.lane == u) ? s : mine; }
                if (F.lane < 8) ORAW[(size_t)(t0 + F.lane) * 1024 + head * 128 + j] = mine;
            }
        } else {
            const int d = F.lane, c = head * 64 + d;
            float wa[16];
#pragma unroll
            for (int r = 0; r < 16; ++r) wa[r] = KIN(I_WA2)[((size_t)l * 16 + r) * 256 + c];
            const float ba = KIN(I_BA)[l * 256 + c];
            const bf16* Pq = P + C_GQ + c; const bf16* Pk = P + C_GK + c; const bf16* Pv = P + C_GV + head * 128 + j; const bf16* Pa = P + C_GA;
            float S = 0.f;
            for (int t0 = 0; t0 < T; t0 += 8) {
                bf16 zq[8], zk[8], zv[8]; u32x4 ga0[8], ga1[8];
#pragma unroll
                for (int u = 0; u < 8; ++u) { const size_t row = (size_t)(t0 + u) * NPAD; zq[u] = Pq[row]; zk[u] = Pk[row]; zv[u] = Pv[row]; ga0[u] = *(const u32x4*)(Pa + row); ga1[u] = *(const u32x4*)(Pa + row + 8); }
                float part[8];
#pragma unroll
                for (int u = 0; u < 8; ++u) {
                    float a = ba;
                    a += bflo(ga0[u].x) * wa[0] + bfhi(ga0[u].x) * wa[1] + bflo(ga0[u].y) * wa[2] + bfhi(ga0[u].y) * wa[3] + bflo(ga0[u].z) * wa[4] + bfhi(ga0[u].z) * wa[5] + bflo(ga0[u].w) * wa[6] + bfhi(ga0[u].w) * wa[7];
                    a += bflo(ga1[u].x) * wa[8] + bfhi(ga1[u].x) * wa[9] + bflo(ga1[u].y) * wa[10] + bfhi(ga1[u].y) * wa[11] + bflo(ga1[u].z) * wa[12] + bfhi(ga1[u].z) * wa[13] + bflo(ga1[u].w) * wa[14] + bfhi(ga1[u].w) * wa[15];
                    const float ls = fminf(a, 0.f) - log1pf(expf(-fabsf(a)));
                    const float f = expf(ls * (1.0f / 16.0f));
                    S = f * S + bf2f(zk[u]) * bf2f(zv[u]);
                    part[u] = bf2f(zq[u]) * 0.125f * S; }
                float mine = 0.f;
#pragma unroll
                for (int u = 0; u < 8; ++u) { const float s = wave_sum(part[u]); mine = (F.lane == u) ? s : mine; }
                if (F.lane < 8) ORAW[(size_t)(t0 + F.lane) * 1024 + 512 + head * 128 + j] = mine;
            }
        }
    }
}
__device__ __forceinline__ void phase_recur_out(Frame& F, int l) {
    KA;
    const bf16* P = (const bf16*)(KWS + WS_P); const float* ORAW = (const float*)(KWS + WS_ORAW); bf16* OCAT = (bf16*)(KWS + WS_OCAT);
    for (int it = F.gw; it < T * 8; it += F.NGW) {
        const int t = it >> 3, kind = (it >> 2) & 1, head = it & 3;
        const float* gn = (kind == 0 ? KIN(I_HGN) : KIN(I_GLAN)) + l * 128;
        const int cg = (kind == 0 ? C_HG : C_GR) + head * 128;
        const float r0 = ORAW[(size_t)t * 1024 + kind * 512 + head * 128 + F.lane], r1 = ORAW[(size_t)t * 1024 + kind * 512 + head * 128 + 64 + F.lane];
        const float rstd = 1.0f / sqrtf(wave_sum(r0 * r0 + r1 * r1) * (1.0f / 128.0f) + EPS);
        const float g0 = bf2f(P[(size_t)t * NPAD + cg + F.lane]), g1 = bf2f(P[(size_t)t * NPAD + cg + 64 + F.lane]);
        const float a0 = kind == 0 ? sigmoidf_(g0) : g0 * sigmoidf_(g0), a1 = kind == 0 ? sigmoidf_(g1) : g1 * sigmoidf_(g1);
        OCAT[(size_t)t * 1536 + 512 + kind * 512 + head * 128 + F.lane] = (bf16)f2bf(r0 * rstd * gn[F.lane] * a0);
        OCAT[(size_t)t * 1536 + 512 + kind * 512 + head * 128 + 64 + F.lane] = (bf16)f2bf(r1 * rstd * gn[64 + F.lane] * a1);
    }
}


template <int KIND> struct RecCfg { static constexpr int DK = KIND == 0 ? 128 : 64, NSEG = 512 / DK, TPS = 64 / NSEG, QROW = (DK + 8) * 2; };
constexpr int REC_VT_OFF = 0;
constexpr int REC_KD_OFF = 18432;
constexpr int REC_QS_OFF = 36864;
constexpr int REC_KS_OFF = 54272;
constexpr int REC_QD_OFF = 71680;
constexpr int REC_RED_OFF = 89088;
constexpr int REC_TOT_OFF = 91136;
__device__ __forceinline__ float expc(float x2) { return __builtin_amdgcn_exp2f(fminf(x2, 110.0f)); }
template <int KIND> __device__ __forceinline__ void rec_elem(KArgs* ka, int l, int head, int chunk, int tid, LAS float* tot,
        float (&qv)[RecCfg<KIND>::TPS], float (&kv)[RecCfg<KIND>::TPS], float (&bv)[RecCfg<KIND>::TPS], float& bend, float& bref) {
    constexpr int DK = RecCfg<KIND>::DK, NSEG = RecCfg<KIND>::NSEG, TPS = RecCfg<KIND>::TPS;
    const int d = tid % DK, seg = tid / DK, t0 = chunk * 64 + seg * TPS;
    const bf16* P = (const bf16*)(KWS + WS_P);
    float run = 0.f;
    if (KIND == 0) {
        const int c = head * 128 + d;
        float lb = 0.f;
        if (l > 0) { const float a0 = KIN(I_LB)[c], b0 = KIN(I_LB)[512 + c]; lb = 1.0f / (1.0f + expf(a0 - b0)); }
        const float omlb = 1.0f - lb;
        unsigned zr[TPS], qr[TPS];
#pragma unroll
        for (int u = 0; u < TPS; ++u) { const size_t row = (size_t)(t0 + u) * NPAD; zr[u] = P[row + C_HF + c]; qr[u] = P[row + C_HQ + c]; }
#pragma unroll
        for (int u = 0; u < TPS; ++u) {
            const float z = bf2f(zr[u]); qv[u] = bf2f(qr[u]);
            const float e = __builtin_amdgcn_exp2f(-LOG2E * z), sg = __builtin_amdgcn_rcpf(1.0f + e), f = fmaf(omlb, sg, lb);
            kv[u] = omlb * (e * sg);
            run += __builtin_amdgcn_logf(fmaxf(f, 1e-30f)); bv[u] = run; }
    } else {
        const int c = head * 64 + d;
        float wa[16];
#pragma unroll
        for (int r = 0; r < 16; ++r) wa[r] = KIN(I_WA2)[((size_t)l * 16 + r) * 256 + c];
        const float ba = KIN(I_BA)[l * 256 + c];
        u32x4 g0r[TPS], g1r[TPS]; unsigned qr[TPS], kr[TPS];
#pragma unroll
        for (int u = 0; u < TPS; ++u) { const size_t row = (size_t)(t0 + u) * NPAD; g0r[u] = *(const u32x4*)(P + row + C_GA); g1r[u] = *(const u32x4*)(P + row + C_GA + 8); qr[u] = P[row + C_GQ + c]; kr[u] = P[row + C_GK + c]; }
#pragma unroll
        for (int u = 0; u < TPS; ++u) { const u32x4 g0 = g0r[u], g1 = g1r[u];
            float a = ba;
            a += bflo(g0.x) * wa[0] + bfhi(g0.x) * wa[1] + bflo(g0.y) * wa[2] + bfhi(g0.y) * wa[3] + bflo(g0.z) * wa[4] + bfhi(g0.z) * wa[5] + bflo(g0.w) * wa[6] + bfhi(g0.w) * wa[7];
            a += bflo(g1.x) * wa[8] + bfhi(g1.x) * wa[9] + bflo(g1.y) * wa[10] + bfhi(g1.y) * wa[11] + bflo(g1.z) * wa[12] + bfhi(g1.z) * wa[13] + bflo(g1.w) * wa[14] + bfhi(g1.w) * wa[15];
            const float ls2 = fminf(a, 0.f) * LOG2E - __builtin_amdgcn_logf(1.0f + __builtin_amdgcn_exp2f(-LOG2E * fabsf(a)));
            qv[u] = bf2f(qr[u]) * 0.125f; kv[u] = bf2f(kr[u]);
            run += ls2 * (1.0f / 16.0f); bv[u] = run; }
    }
    tot[seg * DK + d] = run;
    __syncthreads();
    float off = 0.f; bend = 0.f; bref = 0.f;
#pragma unroll
    for (int sgi = 0; sgi < NSEG; ++sgi) { const float v = tot[sgi * DK + d]; off += sgi < seg ? v : 0.f; bref += sgi < NSEG / 2 ? v : 0.f; bend += v; }
#pragma unroll
    for (int u = 0; u < TPS; ++u) bv[u] += off;
}
template <int KIND> __device__ __forceinline__ void rec_vt_load(KArgs* ka, int head, int chunk, int tid, unsigned (&w)[8]) {
    const bf16* P = (const bf16*)(KWS + WS_P) + (KIND == 0 ? C_HI : C_GV) + head * 128;
    const int v = tid & 127, sv = tid >> 7;
#pragma unroll
    for (int u = 0; u < 8; ++u) { const unsigned a = P[(size_t)(chunk * 64 + sv * 16 + 2 * u) * NPAD + v], b = P[(size_t)(chunk * 64 + sv * 16 + 2 * u + 1) * NPAD + v]; w[u] = a | (b << 16); }
}
__device__ __forceinline__ void rec_vt_store(int tid, LAS unsigned char* lds, const unsigned (&w)[8]) {
    const int v = tid & 127, sv = tid >> 7;
    LAS u32x4* dst = (LAS u32x4*)(lds + REC_VT_OFF + v * 144 + sv * 32);
    dst[0] = (u32x4){w[0], w[1], w[2], w[3]}; dst[1] = (u32x4){w[4], w[5], w[6], w[7]};
}
template <int KIND> __device__ __forceinline__ void rec_local_unit(KArgs* ka, Frame& F, int l, int head, int chunk) {
    constexpr int DK = RecCfg<KIND>::DK, TPS = RecCfg<KIND>::TPS;
    LAS unsigned char* lds = F.lds; LAS float* tot = (LAS float*)(lds + REC_TOT_OFF);
    float qv[TPS], kv[TPS], bv[TPS], bend, bref;
    unsigned vraw[8];
    rec_vt_load<KIND>(ka, head, chunk, F.tid, vraw);
    rec_elem<KIND>(ka, l, head, chunk, F.tid, tot, qv, kv, bv, bend, bref);
    const int d = F.tid % DK, seg = F.tid / DK, unit = chunk * 4 + head;
    { unsigned w[TPS / 2];
#pragma unroll
      for (int u = 0; u < TPS / 2; ++u) w[u] = pkbf(kv[2 * u] * expc(bend - bv[2 * u]), kv[2 * u + 1] * expc(bend - bv[2 * u + 1]));
      LAS u32x4* dst = (LAS u32x4*)(lds + REC_KD_OFF + d * 144 + seg * TPS * 2);
      dst[0] = (u32x4){w[0], w[1], w[2], w[3]};
      if constexpr (TPS == 16) dst[1] = (u32x4){w[4], w[5], w[6], w[7]}; }
    if (seg == 0) ((float*)(KWS + WS_DEC + (KIND == 0 ? 0 : 262144)))[(size_t)unit * DK + d] = __builtin_amdgcn_exp2f(bend);
    rec_vt_store(F.tid, lds, vraw);
    __syncthreads();
    const int r = F.lane & 15, kq = F.lane >> 4;
    const int dt = KIND == 0 ? F.wave : (F.wave & 3), vt0 = KIND == 0 ? 0 : (F.wave >> 2) * 4, nvt = KIND == 0 ? 8 : 4;
    bf16x8 a[2];
#pragma unroll
    for (int ks = 0; ks < 2; ++ks) a[ks] = *(const LAS bf16x8*)(lds + REC_KD_OFF + (16 * dt + r) * 144 + (32 * ks + 8 * kq) * 2);
    float* Sl = (float*)(KWS + (KIND == 0 ? WS_SLOC_HG : WS_SLOC_GL)) + (size_t)unit * 128 * DK;
#pragma unroll
    for (int vi = 0; vi < nvt; ++vi) { const int vt = vt0 + vi; f32x4 acc = {0.f, 0.f, 0.f, 0.f};
#pragma unroll
        for (int ks = 0; ks < 2; ++ks) { const bf16x8 b = *(const LAS bf16x8*)(lds + REC_VT_OFF + (16 * vt + r) * 144 + (32 * ks + 8 * kq) * 2); acc = __builtin_amdgcn_mfma_f32_16x16x32_bf16(a[ks], b, acc, 0, 0, 0); }
        *(f32x4*)(Sl + (size_t)(16 * vt + r) * DK + 16 * dt + 4 * kq) = acc; }
    __syncthreads();
}
__device__ __forceinline__ void phase_rec_local(Frame& F, int l) {
    KA;
    for (int it = F.bid; it < 1024; it += F.G) { const int kind = it >> 9, chunk = (it >> 2) & 127, head = it & 3;
        if (kind == 0) rec_local_unit<0>(ka, F, l, head, chunk); else rec_local_unit<1>(ka, F, l, head, chunk); }
}
__device__ __forceinline__ void phase_rec_scan(Frame& F) {
    KA;
    const int gt = F.bid * 512 + F.tid;
    if (gt >= 49152) return;
    const bool hg = gt < 32768; const int q = hg ? gt : gt - 32768;
    const int DK = hg ? 128 : 64, dp = q % (DK / 2), v = (q / (DK / 2)) & 127, head = q / (DK / 2 * 128);
    const float* Sl = (const float*)(KWS + (hg ? WS_SLOC_HG : WS_SLOC_GL)) + ((size_t)head * 128 + v) * DK + 2 * dp;
    bf16* Sp = (bf16*)(KWS + (hg ? WS_SPREV_HG : WS_SPREV_GL)) + ((size_t)head * 128 + v) * DK + 2 * dp;
    const float* De = (const float*)(KWS + WS_DEC + (hg ? 0 : 262144)) + (size_t)head * DK + 2 * dp;
    const size_t ustr = (size_t)4 * 128 * DK, dstr = (size_t)4 * DK;
    float s0 = 0.f, s1 = 0.f;
    for (int c0 = 0; c0 < NCH; c0 += 8) { f32x2 x[8], dc[8];
#pragma unroll
        for (int u = 0; u < 8; ++u) { x[u] = *(const f32x2*)(Sl + (size_t)(c0 + u) * ustr); dc[u] = *(const f32x2*)(De + (size_t)(c0 + u) * dstr); }
#pragma unroll
        for (int u = 0; u < 8; ++u) { *(unsigned*)(Sp + (size_t)(c0 + u) * ustr) = pk2(s0, s1); s0 = dc[u].x * s0 + x[u].x; s1 = dc[u].y * s1 + x[u].y; } }
}
template <int KIND> __device__ __forceinline__ void rec_out_unit(KArgs* ka, Frame& F, int l, int head, int chunk) {
    constexpr int DK = RecCfg<KIND>::DK, TPS = RecCfg<KIND>::TPS, QROW = RecCfg<KIND>::QROW, NKS = DK / 32;
    LAS unsigned char* lds = F.lds; LAS float* tot = (LAS float*)(lds + REC_TOT_OFF); LAS float* red = (LAS float*)(lds + REC_RED_OFF);
    const int r = F.lane & 15, kq = F.lane >> 4, unit = chunk * 4 + head, vt = F.wave;
    bf16x8 sa[NKS];
    { const bf16* Sp = (const bf16*)(KWS + (KIND == 0 ? WS_SPREV_HG : WS_SPREV_GL)) + (size_t)unit * 128 * DK + (size_t)(16 * vt + r) * DK + 8 * kq;
#pragma unroll
      for (int ks = 0; ks < NKS; ++ks) sa[ks] = *(const bf16x8*)(Sp + 32 * ks); }
    float qv[TPS], kv[TPS], bv[TPS], bend, bref;
    unsigned vraw[8];
    rec_vt_load<KIND>(ka, head, chunk, F.tid, vraw);
    const bf16* P = (const bf16*)(KWS + WS_P); bf16* OCAT = (bf16*)(KWS + WS_OCAT);
    const int v0 = 16 * vt + 4 * kq;
    const f32x4 gn = *(const f32x4*)((KIND == 0 ? KIN(I_HGN) : KIN(I_GLAN)) + l * 128 + v0);
    u32x2 gq4[4];
#pragma unroll
    for (int it = 0; it < 4; ++it) gq4[it] = *(const u32x2*)(P + (size_t)(chunk * 64 + 16 * it + r) * NPAD + (KIND == 0 ? C_HG : C_GR) + head * 128 + v0);
    rec_elem<KIND>(ka, l, head, chunk, F.tid, tot, qv, kv, bv, bend, bref);
    { const int d = F.tid % DK, seg = F.tid / DK;
#pragma unroll
      for (int u = 0; u < TPS; u += 2) { const int o = (seg * TPS + u) * QROW + d * 2;
          const unsigned w0 = pkbf(qv[u] * expc(bv[u] - bref), qv[u + 1] * expc(bv[u + 1] - bref)), w1 = pkbf(kv[u] * expc(bref - bv[u]), kv[u + 1] * expc(bref - bv[u + 1])), w2 = pkbf(qv[u] * __builtin_amdgcn_exp2f(bv[u]), qv[u + 1] * __builtin_amdgcn_exp2f(bv[u + 1]));
          *(LAS bf16*)(lds + REC_QS_OFF + o) = (bf16)w0; *(LAS bf16*)(lds + REC_QS_OFF + o + QROW) = (bf16)(w0 >> 16);
          *(LAS bf16*)(lds + REC_KS_OFF + o) = (bf16)w1; *(LAS bf16*)(lds + REC_KS_OFF + o + QROW) = (bf16)(w1 >> 16);
          *(LAS bf16*)(lds + REC_QD_OFF + o) = (bf16)w2; *(LAS bf16*)(lds + REC_QD_OFF + o + QROW) = (bf16)(w2 >> 16); } }
    rec_vt_store(F.tid, lds, vraw);
    __syncthreads();
#pragma unroll
    for (int tt = 0; tt < 2; ++tt) { const int tile = F.wave * 2 + tt, jt = tile >> 2, it = tile & 3; f32x4 acc = {0.f, 0.f, 0.f, 0.f};
        if (jt <= it) {
#pragma unroll
            for (int ks = 0; ks < NKS; ++ks) { const bf16x8 a = *(const LAS bf16x8*)(lds + REC_KS_OFF + (16 * jt + r) * QROW + (32 * ks + 8 * kq) * 2), b = *(const LAS bf16x8*)(lds + REC_QS_OFF + (16 * it + r) * QROW + (32 * ks + 8 * kq) * 2);
                acc = __builtin_amdgcn_mfma_f32_16x16x32_bf16(a, b, acc, 0, 0, 0); } }
        const int i = 16 * it + r, j0 = 16 * jt + 4 * kq;
        u32x2 w; w.x = pk2(j0 <= i ? acc[0] : 0.f, j0 + 1 <= i ? acc[1] : 0.f); w.y = pk2(j0 + 2 <= i ? acc[2] : 0.f, j0 + 3 <= i ? acc[3] : 0.f);
        *(LAS u32x2*)(lds + REC_KD_OFF + i * 144 + j0 * 2) = w; }
    __syncthreads();
    f32x4 acc[4];
#pragma unroll
    for (int it = 0; it < 4; ++it) acc[it] = (f32x4){0.f, 0.f, 0.f, 0.f};
#pragma unroll
    for (int ks = 0; ks < 2; ++ks) { const bf16x8 a = *(const LAS bf16x8*)(lds + REC_VT_OFF + (16 * vt + r) * 144 + (32 * ks + 8 * kq) * 2);
#pragma unroll
        for (int it = 0; it < 4; ++it) { const bf16x8 b = *(const LAS bf16x8*)(lds + REC_KD_OFF + (16 * it + r) * 144 + (32 * ks + 8 * kq) * 2); acc[it] = __builtin_amdgcn_mfma_f32_16x16x32_bf16(a, b, acc[it], 0, 0, 0); } }
#pragma unroll
    for (int ks = 0; ks < NKS; ++ks) {
#pragma unroll
        for (int it = 0; it < 4; ++it) { const bf16x8 b = *(const LAS bf16x8*)(lds + REC_QD_OFF + (16 * it + r) * QROW + (32 * ks + 8 * kq) * 2); acc[it] = __builtin_amdgcn_mfma_f32_16x16x32_bf16(sa[ks], b, acc[it], 0, 0, 0); } }
#pragma unroll
    for (int it = 0; it < 4; ++it) { float ss = acc[it][0] * acc[it][0] + acc[it][1] * acc[it][1] + acc[it][2] * acc[it][2] + acc[it][3] * acc[it][3];
        ss += __shfl_xor(ss, 16); ss += __shfl_xor(ss, 32);
        if (kq == 0) red[F.wave * 64 + 16 * it + r] = ss; }
    __syncthreads();
#pragma unroll
    for (int it = 0; it < 4; ++it) { const int i = 16 * it + r, t = chunk * 64 + i; float tot_ = 0.f;
#pragma unroll
        for (int w = 0; w < 8; ++w) tot_ += red[w * 64 + i];
        const float rstd = 1.0f / sqrtf(tot_ * (1.0f / 128.0f) + EPS);
        const u32x2 gq = gq4[it];
        float gt[4] = {bflo(gq.x), bfhi(gq.x), bflo(gq.y), bfhi(gq.y)}, o[4];
#pragma unroll
        for (int e = 0; e < 4; ++e) { const float sg = 1.0f / (1.0f + __expf(-gt[e])); o[e] = acc[it][e] * rstd * gn[e] * (KIND == 0 ? sg : gt[e] * sg); }
        u32x2 w; w.x = pk2(o[0], o[1]); w.y = pk2(o[2], o[3]);
        *(u32x2*)(OCAT + (size_t)t * 1536 + 512 + KIND * 512 + head * 128 + v0) = w; }
    __syncthreads();
}
__device__ __forceinline__ void phase_rec_out(Frame& F, int l) {
    KA;
    for (int it = F.bid; it < 1024; it += F.G) { const int kind = it >> 9, chunk = (it >> 2) & 127, head = it & 3;
        if (kind == 0) rec_out_unit<0>(ka, F, l, head, chunk); else rec_out_unit<1>(ka, F, l, head, chunk); }
}

template <bool WIN> __device__ __forceinline__ void nsa_block(const float* Kg, const float* Vg, int j, int t, int lane, const LAS float* qs, LAS float* pb, const float (&slope)[4], float (&M)[4], float (&L)[4], float (&o)[4]) {
    const int pos = 64 * j + lane, dist = t - pos;
    const bool valid = WIN ? (dist >= 0 && dist < 512) : (dist >= 0);
    float dot[4] = {0.f, 0.f, 0.f, 0.f};
    const f32x4* kr = (const f32x4*)(Kg + (size_t)pos * 64);
#pragma unroll 2
    for (int c = 0; c < 16; ++c) { const f32x4 kv = kr[c];
#pragma unroll
        for (int r = 0; r < 4; ++r) { const f32x4 qv = *(const LAS f32x4*)(qs + r * 64 + c * 4); dot[r] += kv.x * qv.x + kv.y * qv.y + kv.z * qv.z + kv.w * qv.w; } }
#pragma unroll
    for (int r = 0; r < 4; ++r) {
        const float s = valid ? dot[r] * 0.125f - slope[r] * (float)dist : NEGB;
        const float nm = fmaxf(M[r], wave_max(s)), sc = expf(M[r] - nm), p = valid ? expf(s - nm) : 0.f;
        L[r] = L[r] * sc + wave_sum(p); o[r] *= sc; M[r] = nm; pb[r * 64 + lane] = p;
    }
    WSYNC();
#pragma unroll 4
    for (int k = 0; k < 64; ++k) { const float v = Vg[(size_t)(64 * j + k) * 64 + lane];
#pragma unroll
        for (int r = 0; r < 4; ++r) o[r] += pb[r * 64 + k] * v; }
    WSYNC();
}
__device__ __forceinline__ void phase_nsa(Frame& F, int l) {
    KA;
    LAS float* qs = (LAS float*)(F.lds + F.wave * 8192);
    LAS float* pbuf = qs + 256;
    LAS float* scb = pbuf + 512;
    LAS float* pb = scb + 128;
    LAS float* impb = pb + 256;
    LAS float* ocb = impb + 512;
    const bf16* P = (const bf16*)(KWS + WS_P); bf16* OCAT = (bf16*)(KWS + WS_OCAT);
    const float* QN = (const float*)(KWS + WS_QN); const float* KV = (const float*)(KWS + WS_KV); const float* KC = (const float*)(KWS + WS_KC);
    const int lane = F.lane;
    for (int it = F.gw; it < T * 2; it += F.NGW) {
        const int t = it >> 1, g = it & 1;
        float slope[4];
#pragma unroll
        for (int r = 0; r < 4; ++r) { slope[r] = exp2f(-(float)(g * 4 + r + 1)); qs[r * 64 + lane] = QN[((size_t)(g * 4 + r) * T + t) * 64 + lane]; }
        WSYNC();
        int nvis = t >= 31 ? (t - 31) / 16 + 1 : 0; nvis = nvis > 511 ? 511 : nvis;
        const float* KCg = KC + (size_t)g * 512 * 64; const float* VCg = KC + (size_t)(2 * 512 * 64) + (size_t)g * 512 * 64;
#pragma unroll 1
        for (int i = 0; i < 8; ++i) impb[lane + 64 * i] = 0.f;
#pragma unroll 1
        for (int r = 0; r < 4; ++r) {
            const float sl = exp2f(-(float)(g * 4 + r + 1));
            float mx = NEGB;
#pragma unroll 1
            for (int i = 0; i < 8; ++i) { const int n = lane + 64 * i; float sv = NEGB;
                if (n < nvis) { const f32x4* kr = (const f32x4*)(KCg + (size_t)n * 64); float dot = 0.f;
#pragma unroll 4
                    for (int c = 0; c < 16; ++c) { const f32x4 kv = kr[c]; const f32x4 qv = *(const LAS f32x4*)(qs + r * 64 + c * 4); dot += kv.x * qv.x + kv.y * qv.y + kv.z * qv.z + kv.w * qv.w; }
                    sv = dot * 0.125f - sl * (float)(t - 16 * n - 31); }
                pbuf[n] = sv; mx = fmaxf(mx, sv); }
            mx = wave_max(mx);
            float sum = 0.f;
#pragma unroll 1
            for (int i = 0; i < 8; ++i) { const int n = lane + 64 * i; const float e = n < nvis ? expf(pbuf[n] - mx) : 0.f; pbuf[n] = e; sum += e; }
            sum = wave_sum(sum);
            const float inv = nvis > 0 ? 1.0f / sum : 0.f;
#pragma unroll 1
            for (int i = 0; i < 8; ++i) { const int n = lane + 64 * i; const float p = pbuf[n] * inv; pbuf[n] = p; impb[n] += p; }
            WSYNC();
            float oc = 0.f;
#pragma unroll 4
            for (int n = 0; n < nvis; ++n) oc += pbuf[n] * VCg[(size_t)n * 64 + lane];
            ocb[r * 64 + lane] = oc;
            WSYNC();
        }
        const int cur = t >> 6;
        float sc2[2];
#pragma unroll
        for (int jj = 0; jj < 2; ++jj) { const int j = lane + 64 * jj;
            float v = (j > 0 ? impb[4 * j - 1] : 0.f) + 2.0f * (impb[4 * j] + impb[4 * j + 1] + impb[4 * j + 2]) + impb[4 * j + 3];
            if (j == 0 || j == cur || j == cur - 1) v = 1e4f;
            if (j > cur) v = -1.0f;
            sc2[jj] = v; scb[j] = v; }
        WSYNC();
        unsigned long long msk[2];
#pragma unroll
        for (int jj = 0; jj < 2; ++jj) { const int j = lane + 64 * jj; int rank = 0;
#pragma unroll 4
            for (int i = 0; i < 128; ++i) { const float si = scb[i]; rank += (si > sc2[jj] || (si == sc2[jj] && i < j)) ? 1 : 0; }
            msk[jj] = __ballot(rank < 16); }
        WSYNC();
        float M[4], L[4], os[4], ow[4];
#pragma unroll
        for (int r = 0; r < 4; ++r) { M[r] = NEGB; L[r] = 0.f; os[r] = 0.f; }
        { const float* Kg = KV + 2 * KV_STRIDE + (size_t)g * T * 64; const float* Vg = KV + 3 * KV_STRIDE + (size_t)g * T * 64;
#pragma unroll 1
          for (int j = 0; j <= cur; ++j) { const bool sel = ((j < 64 ? msk[0] >> j : msk[1] >> (j - 64)) & 1ull) != 0ull; if (sel) nsa_block<false>(Kg, Vg, j, t, lane, qs, pb, slope, M, L, os); } }
#pragma unroll
        for (int r = 0; r < 4; ++r) { os[r] = os[r] / L[r]; M[r] = NEGB; L[r] = 0.f; ow[r] = 0.f; }
        { const float* Kg = KV + 4 * KV_STRIDE + (size_t)g * T * 64; const float* Vg = KV + 5 * KV_STRIDE + (size_t)g * T * 64;
          const int j0 = t >= 511 ? (t - 511) >> 6 : 0;
#pragma unroll 1
          for (int j = j0; j <= cur; ++j) nsa_block<true>(Kg, Vg, j, t, lane, qs, pb, slope, M, L, ow); }
#pragma unroll
        for (int r = 0; r < 4; ++r) { const int h = g * 4 + r;
            const float g0 = sigmoidf_(bf2f(P[(size_t)t * NPAD + C_NG + h])), g1 = sigmoidf_(bf2f(P[(size_t)t * NPAD + C_NG + 8 + h])), g2 = sigmoidf_(bf2f(P[(size_t)t * NPAD + C_NG + 16 + h]));
            OCAT[(size_t)t * 1536 + h * 64 + lane] = (bf16)f2bf(g0 * ocb[r * 64 + lane] + g1 * os[r] + g2 * (ow[r] / L[r])); }
        WSYNC();
    }
}

typedef float f32x16 __attribute__((ext_vector_type(16)));
constexpr float NSA_SHIFT2 = 8.0f;
__device__ __forceinline__ int perm16(int b) { return (b & 3) | ((b & 4) << 1) | ((b & 8) >> 1); }
__device__ __forceinline__ void phase_prep2(Frame& F, int l) {
    KA;
    const bf16* P = (const bf16*)(KWS + WS_P);
    bf16* QS = (bf16*)(KWS + WS_QS); bf16* KS2 = (bf16*)(KWS + WS_KS2); bf16* KW2 = (bf16*)(KWS + WS_KW2);
    const float* qg = KIN(I_QN) + l * 64; const float* kg = KIN(I_KN) + l * 192;
    for (int it = F.gw; it < T * 12; it += F.NGW) {
        const int t = it / 12, v = it % 12;
        const int col = v < 8 ? v * 64 : (v < 10 ? C_KS + (v - 8) * 64 : C_KW + (v - 10) * 64);
        float x = bf2f(P[(size_t)t * NPAD + col + F.lane]);
        const float ss = wave_sum(x * x);
        const float g = v < 8 ? qg[F.lane] * (0.125f * LOG2E) : (v < 10 ? kg[64 + F.lane] : kg[128 + F.lane]);
        x = x * (1.0f / sqrtf(ss * (1.0f / 64.0f) + EPS)) * g;
        bf16* dst = v < 8 ? QS + ((size_t)v * T + t) * 64 : (v < 10 ? KS2 + ((size_t)(v - 8) * T + t) * 64 : KW2 + ((size_t)(v - 10) * T + t) * 64);
        dst[F.lane] = (bf16)f2bf(x);
    }
    LAS bf16* tile = (LAS bf16*)(F.lds + F.wave * 16384);
    for (int it = F.gw; it < 2 * 2 * (T / 64); it += F.NGW) {
        const int kind = it / (2 * (T / 64)), q = it % (2 * (T / 64)), g = q / (T / 64), tb = q % (T / 64);
        const bf16* src = P + (size_t)(tb * 64) * NPAD + (kind == 0 ? C_VS : C_VW) + g * 64;
        bf16* dst = (bf16*)(KWS + (kind == 0 ? WS_VST : WS_VWT)) + (size_t)g * 64 * T + tb * 64;
#pragma unroll 4
        for (int r = 0; r < 64; ++r) tile[r * 66 + F.lane] = src[(size_t)r * NPAD + F.lane];
        WSYNC();
        const int pl = (F.lane & ~15) | perm16(F.lane & 15);
#pragma unroll 4
        for (int d = 0; d < 64; ++d) dst[(size_t)d * T + pl] = tile[F.lane * 66 + d];
        WSYNC();
    }
}

__device__ __forceinline__ void phase_prep3(Frame& F, int l) {
    KA;
    const bf16* P = (const bf16*)(KWS + WS_P);
    bf16* QS = (bf16*)(KWS + WS_QS); bf16* KS2 = (bf16*)(KWS + WS_KS2); bf16* KW2 = (bf16*)(KWS + WS_KW2);
    const float* qg = KIN(I_QN) + l * 64; const float* kg = KIN(I_KN) + l * 192;
    const int vec = F.lane >> 3, part = F.lane & 7;
    for (int t = F.gw; t < T; t += F.NGW) {
#pragma unroll
        for (int pass = 0; pass < 2; ++pass) {
            if (pass == 1 && vec >= 4) continue;
            const int col = pass == 0 ? vec * 64 : (vec < 2 ? C_KS + vec * 64 : C_KW + (vec - 2) * 64);
            const float* gp = pass == 0 ? qg : (vec < 2 ? kg + 64 : kg + 128);
            const float gs = pass == 0 ? 0.125f * LOG2E : 1.0f;
            bf16* dst = pass == 0 ? QS + ((size_t)vec * T + t) * 64 : (vec < 2 ? KS2 + ((size_t)vec * T + t) * 64 : KW2 + ((size_t)(vec - 2) * T + t) * 64);
            const u32x4 raw = *(const u32x4*)(P + (size_t)t * NPAD + col + part * 8);
            float x[8] = {bflo(raw.x), bfhi(raw.x), bflo(raw.y), bfhi(raw.y), bflo(raw.z), bfhi(raw.z), bflo(raw.w), bfhi(raw.w)};
            float ss = 0.f;
#pragma unroll
            for (int e = 0; e < 8; ++e) ss += x[e] * x[e];
            ss += __shfl_xor(ss, 1); ss += __shfl_xor(ss, 2); ss += __shfl_xor(ss, 4);
            const float rstd = gs / sqrtf(ss * (1.0f / 64.0f) + EPS);
            const f32x4 g0 = *(const f32x4*)(gp + part * 8), g1 = *(const f32x4*)(gp + part * 8 + 4);
            u32x4 o; o.x = pk2(x[0] * rstd * g0.x, x[1] * rstd * g0.y); o.y = pk2(x[2] * rstd * g0.z, x[3] * rstd * g0.w); o.z = pk2(x[4] * rstd * g1.x, x[5] * rstd * g1.y); o.w = pk2(x[6] * rstd * g1.z, x[7] * rstd * g1.w);
            *(u32x4*)(dst + part * 8) = o;
        }
    }
    LAS bf16* tile = (LAS bf16*)(F.lds + F.wave * 16384);
    for (int it = F.gw; it < 2 * 2 * (T / 64); it += F.NGW) {
        const int kind = it / (2 * (T / 64)), q = it % (2 * (T / 64)), g = q / (T / 64), tb = q % (T / 64);
        const bf16* src = P + (size_t)(tb * 64) * NPAD + (kind == 0 ? C_VS : C_VW) + g * 64;
        bf16* dst = (bf16*)(KWS + (kind == 0 ? WS_VST : WS_VWT)) + (size_t)g * 64 * T + tb * 64;
#pragma unroll
        for (int i = 0; i < 8; ++i) { const int tok = vec + 8 * i; *(LAS u32x4*)(tile + tok * 72 + part * 8) = *(const u32x4*)(src + (size_t)tok * NPAD + part * 8); }
        WSYNC();
#pragma unroll
        for (int c = 0; c < 8; ++c) { unsigned w[4];
#pragma unroll
            for (int k = 0; k < 4; ++k) { const int p0 = (c & 1) * 8 + 2 * k, p1 = p0 + 1;
                const int k0 = (c >> 1) * 16 + ((p0 & 3) | ((p0 & 4) << 1) | ((p0 & 8) >> 1)), k1 = (c >> 1) * 16 + ((p1 & 3) | ((p1 & 4) << 1) | ((p1 & 8) >> 1));
                w[k] = (unsigned)tile[k0 * 72 + F.lane] | ((unsigned)tile[k1 * 72 + F.lane] << 16); }
            *(u32x4*)(dst + (size_t)F.lane * T + c * 8) = (u32x4){w[0], w[1], w[2], w[3]}; }
        WSYNC();
    }
}

__device__ __forceinline__ void phase_compress2(Frame& F, int l) {
    KA;
    LAS float* av = (LAS float*)(F.lds + F.wave * 16384);
    const bf16* P = (const bf16*)(KWS + WS_P);
    bf16* KCB = (bf16*)(KWS + WS_KCB); bf16* VCT = (bf16*)(KWS + WS_KCB + 131072);
    for (int it = F.gw; it < 2 * 2 * 512; it += F.NGW) {
        const int kind = it >> 10, g = (it >> 9) & 1, n = it & 511;
        if (n == 511) { if (kind == 0) KCB[((size_t)g * 512 + 511) * 64 + F.lane] = 0; else VCT[((size_t)g * 64 + F.lane) * 512 + 511] = 0; continue; }
        const bf16* src = P + (size_t)(16 * n) * NPAD + (kind == 0 ? C_KC : C_VC) + g * 64;
        const float* pe = KIN(I_PE) + ((size_t)l * 2 + kind) * 2048;
        const float* w1 = KIN(I_W1) + ((size_t)l * 2 + kind) * 2048 * 64;
        const float* w2 = KIN(I_W2) + ((size_t)l * 2 + kind) * 64 * 64;
#pragma unroll 4
        for (int c = 0; c < 32; ++c) av[c * 64 + F.lane] = bf2f(src[(size_t)c * NPAD + F.lane]) + pe[c * 64 + F.lane];
        WSYNC();
        float acc = 0.f;
#pragma unroll 8
        for (int i = 0; i < 2048; ++i) acc += av[i] * w1[i * 64 + F.lane];
        const float hid = gelu_tanh(acc);
        WSYNC();
        av[F.lane] = hid;
        WSYNC();
        float o = 0.f;
#pragma unroll 8
        for (int i = 0; i < 64; ++i) o += av[i] * w2[i * 64 + F.lane];
        WSYNC();
        if (kind == 0) { const float ss = wave_sum(o * o); o = o * (1.0f / sqrtf(ss * (1.0f / 64.0f) + EPS)) * KIN(I_KN)[l * 192 + F.lane]; KCB[((size_t)g * 512 + n) * 64 + F.lane] = (bf16)f2bf(o); }
        else VCT[((size_t)g * 64 + F.lane) * 512 + ((n & ~15) | perm16(n & 15))] = (bf16)f2bf(o);
    }
}

__device__ __forceinline__ void phase_compress3(Frame& F, int l) {
    KA;
    const bf16* P = (const bf16*)(KWS + WS_P);
    bf16* KCB = (bf16*)(KWS + WS_KCB); bf16* VCT = (bf16*)(KWS + WS_KCB + 131072);
    LAS float* red = (LAS float*)F.lds;
    LAS bf16* hid = (LAS bf16*)(F.lds + 32768);
    const int r16 = F.lane & 15, kq = F.lane >> 4;
    for (int unit = F.bid; unit < 128; unit += F.G) {
        const int kind = unit >> 6, mt = unit & 63, g = mt >> 5, n0 = (mt & 31) * 16;
        const bf16* W1T = (const bf16*)(KWS + WS_CW) + (size_t)(l * 2 + kind) * 64 * 2048; const bf16* W2T = (const bf16*)(KWS + WS_CW + 1048576) + (size_t)(l * 2 + kind) * 4096;
        const float* B1 = (const float*)(KWS + WS_CW + 1572864) + (l * 2 + kind) * 64;
        const bf16* arow = P + (size_t)(16 * (n0 + r16)) * NPAD + (kind == 0 ? C_KC : C_VC) + g * 64;
        f32x4 acc[4];
#pragma unroll
        for (int nt = 0; nt < 4; ++nt) acc[nt] = (f32x4){0.f, 0.f, 0.f, 0.f};
#pragma unroll 2
        for (int ks = 0; ks < 8; ++ks) { const int c0 = F.wave * 256 + 32 * ks + 8 * kq;
            const bf16x8 a = *(const bf16x8*)(arow + (size_t)(c0 >> 6) * NPAD + (c0 & 63));
#pragma unroll
            for (int nt = 0; nt < 4; ++nt) { const bf16x8 b = *(const bf16x8*)(W1T + (size_t)(16 * nt + r16) * 2048 + c0); acc[nt] = __builtin_amdgcn_mfma_f32_16x16x32_bf16(a, b, acc[nt], 0, 0, 0); } }
#pragma unroll
        for (int nt = 0; nt < 4; ++nt) *(LAS f32x4*)(red + ((F.wave * 4 + nt) * 64 + F.lane) * 4) = acc[nt];
        __syncthreads();
        if (F.tid < 256) { const int nt = F.tid >> 6, ln = F.tid & 63; f32x4 v = {0.f, 0.f, 0.f, 0.f};
#pragma unroll
            for (int w = 0; w < 8; ++w) v += *(const LAS f32x4*)(red + ((w * 4 + nt) * 64 + ln) * 4);
            const int col = 16 * nt + (ln & 15); const float b1 = B1[col];
#pragma unroll
            for (int i = 0; i < 4; ++i) hid[(4 * (ln >> 4) + i) * 72 + col] = (bf16)f2bf(gelu_tanh(v[i] + b1)); }
        __syncthreads();
        if (F.wave == 0) {
            f32x4 o[4];
#pragma unroll
            for (int nt = 0; nt < 4; ++nt) o[nt] = (f32x4){0.f, 0.f, 0.f, 0.f};
#pragma unroll
            for (int ks = 0; ks < 2; ++ks) { const bf16x8 a = *(const LAS bf16x8*)(hid + r16 * 72 + 32 * ks + 8 * kq);
#pragma unroll
                for (int nt = 0; nt < 4; ++nt) { const bf16x8 b = *(const bf16x8*)(W2T + (16 * nt + r16) * 64 + 32 * ks + 8 * kq); o[nt] = __builtin_amdgcn_mfma_f32_16x16x32_bf16(a, b, o[nt], 0, 0, 0); } }
            if (kind == 0) {
#pragma unroll
                for (int i = 0; i < 4; ++i) { float ss = o[0][i] * o[0][i] + o[1][i] * o[1][i] + o[2][i] * o[2][i] + o[3][i] * o[3][i];
                    ss += __shfl_xor(ss, 1); ss += __shfl_xor(ss, 2); ss += __shfl_xor(ss, 4); ss += __shfl_xor(ss, 8);
                    const float rstd = 1.0f / sqrtf(ss * (1.0f / 64.0f) + EPS); const int n = n0 + 4 * kq + i;
#pragma unroll
                    for (int nt = 0; nt < 4; ++nt) { const int col = 16 * nt + r16; KCB[((size_t)g * 512 + n) * 64 + col] = n < 511 ? (bf16)f2bf(o[nt][i] * rstd * KIN(I_KN)[l * 192 + col]) : (bf16)0; } }
            } else {
#pragma unroll
                for (int i = 0; i < 4; ++i) { const int n = n0 + 4 * kq + i;
#pragma unroll
                    for (int nt = 0; nt < 4; ++nt) { const int col = 16 * nt + r16; VCT[((size_t)g * 64 + col) * 512 + ((n & ~15) | perm16(n & 15))] = n < 511 ? (bf16)f2bf(o[nt][i]) : (bf16)0; } }
            }
        }
        __syncthreads();
    }
}

constexpr int NSA_SCA = 65536, NSA_SCB = 99328;
constexpr int NSA_QM = 133120, NSA_UM = 134144;
static_assert(NSA_UM + 16 <= MISC_OFF, "NSA LDS map");
__device__ __forceinline__ int next_set(unsigned long long m0, unsigned long long m1, int from) {
    if (from < 64) { const unsigned long long x = m0 & (~0ull << from); if (x) return __builtin_ctzll(x); from = 64; }
    if (from < 128) { const unsigned long long x = m1 & (~0ull << (from - 64)); if (x) return 64 + __builtin_ctzll(x); }
    return 128;
}
__device__ __forceinline__ void nsa_issue(LAS unsigned char* lds, int slot, const bf16* Kg, const bf16* VTg, int vt_len, int j, int tid, int wave) {
    const int row = tid >> 3, c = (tid & 7) ^ ((row >> 1) & 7);
    __builtin_amdgcn_global_load_lds((const unsigned*)(Kg + (size_t)(64 * j + row) * 64 + c * 8), (LAS unsigned*)(lds + slot * 16384 + wave * 1024), 16, 0, 0);
    __builtin_amdgcn_global_load_lds((const unsigned*)(VTg + (size_t)row * vt_len + 64 * j + c * 8), (LAS unsigned*)(lds + slot * 16384 + 8192 + wave * 1024), 16, 0, 0);
}
template <int MODE> __device__ __forceinline__ void nsa_branch(Frame& F, const bf16* Kg, const bf16* VTg, int vt_len, unsigned long long m0, unsigned long long m1,
        const bf16x8 (&Qf)[4], int t, int cblk, float slope2, float inv_l, const unsigned (&qsel)[4], int hi_cmp, unsigned wm_lo_dummy, f32x16 (&oacc)[2], float& lsum) {
    LAS unsigned char* lds = F.lds;
    const int lane = F.lane, c32 = lane & 31, h = lane >> 5, tid = F.tid;
    const int sw = (c32 >> 1) & 7;
    int j0 = next_set(m0, m1, 0);
    if (j0 >= 128) return;
    int j1 = next_set(m0, m1, j0 + 1), j2 = j1 < 128 ? next_set(m0, m1, j1 + 1) : 128;
    nsa_issue(lds, 0, Kg, VTg, vt_len, j0, tid, F.wave);
    if (j1 < 128) nsa_issue(lds, 1, Kg, VTg, vt_len, j1, tid, F.wave);
    if (j2 < 128) nsa_issue(lds, 2, Kg, VTg, vt_len, j2, tid, F.wave);
    int slot = 0;
    const float kslope2 = (MODE < 2) ? 16.0f * slope2 : slope2;
    const float qpos = (MODE < 2) ? (float)(t - 31) : (float)t;
    while (j0 < 128) {
        const int j = j0;
        if (j2 < 128) asm volatile("s_waitcnt vmcnt(4)" ::: "memory"); else if (j1 < 128) asm volatile("s_waitcnt vmcnt(2)" ::: "memory"); else asm volatile("s_waitcnt vmcnt(0)" ::: "memory");
        __builtin_amdgcn_s_barrier(); asm volatile("" ::: "memory");
        const int j3 = j2 < 128 ? next_set(m0, m1, j2 + 1) : 128;
        if (j3 < 128) nsa_issue(lds, (slot + 3) & 3, Kg, VTg, vt_len, j3, tid, F.wave);
        bool need = true;
        if (MODE == 2) { const unsigned myw = j < 32 ? qsel[0] : (j < 64 ? qsel[1] : (j < 96 ? qsel[2] : qsel[3])); need = __any((myw >> (j & 31)) & 1u); }
        if (need) {
            const int kb = slot * 16384, vb = slot * 16384 + 8192;
            const int kbase = 64 * j;
            float lb2 = -slope2 * qpos + kslope2 * (float)(kbase + 4 * h) - NSA_SHIFT2;
            if (MODE == 2) { const unsigned myw = j < 32 ? qsel[0] : (j < 64 ? qsel[1] : (j < 96 ? qsel[2] : qsel[3])); if (!((myw >> (j & 31)) & 1u)) lb2 = -1e30f; }
            f32x16 sacc[2];
#pragma unroll
            for (int sub = 0; sub < 2; ++sub)
#pragma unroll
                for (int i = 0; i < 16; ++i) sacc[sub][i] = fmaf(kslope2, (float)(32 * sub + (i & 3) + 8 * (i >> 2)), lb2);
#pragma unroll
            for (int sub = 0; sub < 2; ++sub) {
#pragma unroll
                for (int kp = 0; kp < 2; ++kp) { bf16x8 ka2[2];
#pragma unroll
                    for (int k2 = 0; k2 < 2; ++k2) ka2[k2] = *(const LAS bf16x8*)(lds + kb + (32 * sub + c32) * 128 + (((2 * (2 * kp + k2) + h) ^ sw) * 16));
                    asm volatile("" ::: "memory");
#pragma unroll
                    for (int k2 = 0; k2 < 2; ++k2) sacc[sub] = __builtin_amdgcn_mfma_f32_32x32x16_bf16(ka2[k2], Qf[2 * kp + k2], sacc[sub], 0, 0, 0);
                    asm volatile("" ::: "memory"); } }
#pragma unroll
            for (int sub = 0; sub < 2; ++sub)
#pragma unroll
                for (int i = 0; i < 16; ++i) sacc[sub][i] = __builtin_amdgcn_exp2f(sacc[sub][i]);
            bool mhi = false, mlo = false; int hi = 0, lo = 0;
            if (MODE < 2) { mhi = true; hi = hi_cmp; }
            if (MODE == 2) { mhi = (j == cblk); hi = t; }
            if (MODE == 3) { mhi = (j == cblk); hi = t; mlo = (j == cblk - 8); lo = t - 511; }
            if (mhi || mlo) {
#pragma unroll
                for (int sub = 0; sub < 2; ++sub)
#pragma unroll
                    for (int i = 0; i < 16; ++i) { const int idx = kbase + 4 * h + 32 * sub + (i & 3) + 8 * (i >> 2); if ((mhi && idx > hi) || (mlo && idx < lo)) sacc[sub][i] = 0.f; }
            }
            float ls = 0.f;
#pragma unroll
            for (int sub = 0; sub < 2; ++sub)
#pragma unroll
                for (int i = 0; i < 16; ++i) ls += sacc[sub][i];
            lsum += ls;
            if (MODE == 1) {
                LAS float* scA = (LAS float*)(lds + NSA_SCA); LAS float* scB = (LAS float*)(lds + NSA_SCB);
                const int q = F.wave * 8 + (c32 >> 2);
#pragma unroll
                for (int sub = 0; sub < 2; ++sub)
#pragma unroll
                    for (int g4 = 0; g4 < 4; ++g4) { float x[4];
#pragma unroll
                        for (int e = 0; e < 4; ++e) { float v = sacc[sub][4 * g4 + e] * inv_l; v += __shfl_xor(v, 1); v += __shfl_xor(v, 2); x[e] = v; }
                        const int jb = 16 * j + 8 * sub + 2 * g4 + h;
                        if ((c32 & 3) == 0) { scA[q * 132 + jb] = 2.0f * (x[0] + x[1] + x[2]) + x[3]; scB[q * 132 + jb + 1] = x[3]; } }
            }
            if (MODE != 0) {
                bf16x8 pf[2][2];
#pragma unroll
                for (int sub = 0; sub < 2; ++sub)
#pragma unroll
                    for (int s2 = 0; s2 < 2; ++s2) { u32x4 w; w.x = pkbf(sacc[sub][8 * s2], sacc[sub][8 * s2 + 1]); w.y = pkbf(sacc[sub][8 * s2 + 2], sacc[sub][8 * s2 + 3]); w.z = pkbf(sacc[sub][8 * s2 + 4], sacc[sub][8 * s2 + 5]); w.w = pkbf(sacc[sub][8 * s2 + 6], sacc[sub][8 * s2 + 7]);
                        pf[sub][s2] = __builtin_bit_cast(bf16x8, w); }
                asm volatile("" ::: "memory");
#pragma unroll
                for (int ds = 0; ds < 2; ++ds) {
#pragma unroll
                    for (int qp = 0; qp < 2; ++qp) { bf16x8 va2[2];
#pragma unroll
                        for (int k2 = 0; k2 < 2; ++k2) va2[k2] = *(const LAS bf16x8*)(lds + vb + (32 * ds + c32) * 128 + (((2 * (2 * qp + k2) + h) ^ sw) * 16));
                        asm volatile("" ::: "memory");
#pragma unroll
                        for (int k2 = 0; k2 < 2; ++k2) oacc[ds] = __builtin_amdgcn_mfma_f32_32x32x16_bf16(va2[k2], pf[qp][k2], oacc[ds], 0, 0, 0);
                        asm volatile("" ::: "memory"); } }
            }
        }
        j0 = j1; j1 = j2; j2 = j3; slot = (slot + 1) & 3;
    }
    asm volatile("s_waitcnt lgkmcnt(0)" ::: "memory"); __builtin_amdgcn_s_barrier(); asm volatile("" ::: "memory");
}
__device__ __forceinline__ void nsa_stash_put(LAS unsigned char* lds, int wave, int lane, const f32x16 (&o)[2], float sc) {
    LAS unsigned* st = (LAS unsigned*)(lds + NSA_SCA) + wave * 1024 + lane;
#pragma unroll
    for (int ds = 0; ds < 2; ++ds)
#pragma unroll
        for (int k = 0; k < 8; ++k) st[(ds * 8 + k) * 64] = pkbf(o[ds][2 * k] * sc, o[ds][2 * k + 1] * sc);
}
__device__ __forceinline__ void phase_nsa2(Frame& F, int l) {
    KA;
    LAS unsigned char* lds = F.lds;
    const bf16* P = (const bf16*)(KWS + WS_P); bf16* OCAT = (bf16*)(KWS + WS_OCAT);
    const bf16* QS = (const bf16*)(KWS + WS_QS);
    const int lane = F.lane, c32 = lane & 31, h = lane >> 5, q8 = c32 >> 2, r = c32 & 3;
    for (int unit = F.bid; unit < 256; unit += F.G) {
        const int g = unit & 1, cblk = unit >> 1, t0 = cblk * 64, head = g * 4 + r, t = t0 + F.wave * 8 + q8;
        const float slope2 = exp2f(-(float)(head + 1)) * LOG2E;
        bf16x8 Qf[4];
#pragma unroll
        for (int ks = 0; ks < 4; ++ks) Qf[ks] = *(const bf16x8*)(QS + ((size_t)head * T + t) * 64 + 16 * ks + 8 * h);
        for (int u = F.tid; u < (NSA_UM + 16 - NSA_SCA) / 4; u += 512) ((LAS unsigned*)(lds + NSA_SCA))[u] = 0u;
        __syncthreads();
        f32x16 oacc[2];
#pragma unroll
        for (int ds = 0; ds < 2; ++ds)
#pragma unroll
            for (int i = 0; i < 16; ++i) oacc[ds][i] = 0.f;
        unsigned qsel[4] = {0u, 0u, 0u, 0u};
        float sc_cmp;
        {
            const int ntile = (4 * cblk + 2) / 64 + 1;
            const unsigned long long cm0 = ntile >= 64 ? ~0ull : ((1ull << ntile) - 1ull);
            const int hi_cmp = t >= 31 ? (t - 31) / 16 : -1;
            const bf16* Kg = (const bf16*)(KWS + WS_KCB) + (size_t)g * 512 * 64; const bf16* VTg = (const bf16*)(KWS + WS_KCB + 131072) + (size_t)g * 64 * 512;
            float l1 = 0.f;
            nsa_branch<0>(F, Kg, VTg, 512, cm0, 0ull, Qf, t, cblk, slope2, 0.f, qsel, hi_cmp, 0u, oacc, l1);
            l1 += __shfl_xor(l1, 32);
            const float inv_l = l1 > 0.f ? 1.0f / l1 : 0.f;
            float l2 = 0.f;
            nsa_branch<1>(F, Kg, VTg, 512, cm0, 0ull, Qf, t, cblk, slope2, inv_l, qsel, hi_cmp, 0u, oacc, l2);
            sc_cmp = sigmoidf_(bf2f(P[(size_t)t * NPAD + C_NG + head])) * inv_l;
        }
        {
            LAS float* scA = (LAS float*)(lds + NSA_SCA); LAS float* scB = (LAS float*)(lds + NSA_SCB);
            LAS unsigned* qm = (LAS unsigned*)(lds + NSA_QM); LAS unsigned* um = (LAS unsigned*)(lds + NSA_UM);
            WSYNC();
            const int qq = F.wave * 8 + (lane >> 3), jj = lane & 7;
            unsigned key[16];
#pragma unroll
            for (int m = 0; m < 16; ++m) { const int jb = jj + 8 * m; float sv = scA[qq * 132 + jb] + scB[qq * 132 + jb];
                if (jb == 0 || jb == cblk || jb == cblk - 1) sv = 1e4f;
                key[m] = (__builtin_bit_cast(unsigned, sv) & ~127u) | (unsigned)(127 - jb); }
            WSYNC();
#pragma unroll
            for (int m = 0; m < 16; ++m) ((LAS unsigned*)scA)[qq * 132 + jj + 8 * m] = key[m];
            WSYNC();
            unsigned bits[4] = {0u, 0u, 0u, 0u};
#pragma unroll
            for (int half = 0; half < 2; ++half) { int rank[8];
#pragma unroll
                for (int m = 0; m < 8; ++m) rank[m] = 0;
#pragma unroll 2
                for (int i = 0; i <= cblk; ++i) { const unsigned ki = ((const LAS unsigned*)scA)[qq * 132 + i];
#pragma unroll
                    for (int m = 0; m < 8; ++m) rank[m] += ki > key[8 * half + m] ? 1 : 0; }
#pragma unroll
                for (int m = 0; m < 8; ++m) { const int jb = jj + 8 * (8 * half + m); if (jb <= cblk && rank[m] < 16) bits[(8 * half + m) >> 2] |= 1u << (jb & 31); } }
#pragma unroll
            for (int w = 0; w < 4; ++w) if (bits[w]) { atomicOr((unsigned*)(qm + qq * 4 + w), bits[w]); atomicOr((unsigned*)(um + w), bits[w]); }
            __syncthreads();
#pragma unroll
            for (int w = 0; w < 4; ++w) qsel[w] = qm[(F.wave * 8 + q8) * 4 + w];
        }
        nsa_stash_put(lds, F.wave, lane, oacc, sc_cmp);
#pragma unroll
        for (int ds = 0; ds < 2; ++ds)
#pragma unroll
            for (int i = 0; i < 16; ++i) oacc[ds][i] = 0.f;
        {
            LAS unsigned* um = (LAS unsigned*)(lds + NSA_UM);
            const unsigned long long sm0 = (unsigned long long)__builtin_amdgcn_readfirstlane(um[0]) | ((unsigned long long)__builtin_amdgcn_readfirstlane(um[1]) << 32);
            const unsigned long long sm1 = (unsigned long long)__builtin_amdgcn_readfirstlane(um[2]) | ((unsigned long long)__builtin_amdgcn_readfirstlane(um[3]) << 32);
            float ls = 0.f;
            nsa_branch<2>(F, (const bf16*)(KWS + WS_KS2) + (size_t)g * T * 64, (const bf16*)(KWS + WS_VST) + (size_t)g * 64 * T, T, sm0, sm1, Qf, t, cblk, slope2, 0.f, qsel, 0, 0u, oacc, ls);
            ls += __shfl_xor(ls, 32);
            const float sc = sigmoidf_(bf2f(P[(size_t)t * NPAD + C_NG + 8 + head])) / ls;
            LAS unsigned* st = (LAS unsigned*)(lds + NSA_SCA) + F.wave * 1024 + lane;
#pragma unroll
            for (int ds = 0; ds < 2; ++ds)
#pragma unroll
                for (int k = 0; k < 8; ++k) { const unsigned w = st[(ds * 8 + k) * 64]; st[(ds * 8 + k) * 64] = pkbf(bflo(w) + sc * oacc[ds][2 * k], bfhi(w) + sc * oacc[ds][2 * k + 1]); oacc[ds][2 * k] = 0.f; oacc[ds][2 * k + 1] = 0.f; }
        }
        {
            const int j0 = cblk >= 8 ? cblk - 8 : 0;
            unsigned long long wm0 = 0ull, wm1 = 0ull;
            for (int jb = j0; jb <= cblk; ++jb) { if (jb < 64) wm0 |= 1ull << jb; else wm1 |= 1ull << (jb - 64); }
            float ls = 0.f;
            nsa_branch<3>(F, (const bf16*)(KWS + WS_KW2) + (size_t)g * T * 64, (const bf16*)(KWS + WS_VWT) + (size_t)g * 64 * T, T, wm0, wm1, Qf, t, cblk, slope2, 0.f, qsel, 0, 0u, oacc, ls);
            ls += __shfl_xor(ls, 32);
            const float sc = sigmoidf_(bf2f(P[(size_t)t * NPAD + C_NG + 16 + head])) / ls;
            const LAS unsigned* st = (const LAS unsigned*)(lds + NSA_SCA) + F.wave * 1024 + lane;
#pragma unroll
            for (int ds = 0; ds < 2; ++ds)
#pragma unroll
                for (int g4 = 0; g4 < 4; ++g4) { const unsigned w0 = st[(ds * 8 + 2 * g4) * 64], w1 = st[(ds * 8 + 2 * g4 + 1) * 64];
                    u32x2 w; w.x = pkbf(bflo(w0) + sc * oacc[ds][4 * g4], bfhi(w0) + sc * oacc[ds][4 * g4 + 1]); w.y = pkbf(bflo(w1) + sc * oacc[ds][4 * g4 + 2], bfhi(w1) + sc * oacc[ds][4 * g4 + 3]);
                    *(u32x2*)(OCAT + (size_t)t * 1536 + head * 64 + 32 * ds + 8 * g4 + 4 * h) = w; }
        }
        __syncthreads();
    }
}

__device__ __forceinline__ void phase_merge(Frame& F) {
    KA;
    const bf16* P = (const bf16*)(KWS + WS_P); const bf16* PROJ = (const bf16*)(KWS + WS_PROJ); bf16* MG = (bf16*)(KWS + WS_MERGED);
    const size_t total = (size_t)T * D / 8;
    for (size_t it = (size_t)F.gw * 64 + F.lane; it < total; it += (size_t)F.NGW * 64) {
        const size_t t = it / (D / 8); const int d = (int)(it % (D / 8)) * 8;
        float acc[8];
#pragma unroll
        for (int k = 0; k < 8; ++k) acc[k] = 0.f;
#pragma unroll
        for (int n = 0; n < 3; ++n) { const u32x4 gq = *(const u32x4*)(P + t * NPAD + C_MG + n * D + d); const u32x4 pq = *(const u32x4*)(PROJ + ((size_t)n * T + t) * D + d);
            acc[0] += sigmoidf_(bflo(gq.x)) * bflo(pq.x); acc[1] += sigmoidf_(bfhi(gq.x)) * bfhi(pq.x); acc[2] += sigmoidf_(bflo(gq.y)) * bflo(pq.y); acc[3] += sigmoidf_(bfhi(gq.y)) * bfhi(pq.y);
            acc[4] += sigmoidf_(bflo(gq.z)) * bflo(pq.z); acc[5] += sigmoidf_(bfhi(gq.z)) * bfhi(pq.z); acc[6] += sigmoidf_(bflo(gq.w)) * bflo(pq.w); acc[7] += sigmoidf_(bfhi(gq.w)) * bfhi(pq.w); }
        u32x4 o; o.x = pk2(acc[0], acc[1]); o.y = pk2(acc[2], acc[3]); o.z = pk2(acc[4], acc[5]); o.w = pk2(acc[6], acc[7]);
        *(u32x4*)(MG + t * D + d) = o;
    }
}
__device__ __forceinline__ void phase_router(Frame& F, int l) {
    KA;
    const float* X1 = (const float*)(KWS + WS_X1); bf16* H = (bf16*)(KWS + WS_H);
    int* EID = (int*)(KWS + WS_ROUTE); float* EW = (float*)(KWS + WS_ROUTE + 65536);
    const float* gain = KIN(I_NFFN) + (size_t)l * D; const float* wg = KIN(I_WGRP) + (size_t)l * D * 4; const float* we = KIN(I_WEXP) + (size_t)l * D * 32;
    const float* bg = KIN(I_BGRP) + l * 4; const float* be = KIN(I_BEXP) + l * 32;
    for (int t = F.gw; t < T; t += F.NGW) {
        const float* xrow = X1 + (size_t)t * D;
        float ss = 0.f;
#pragma unroll 4
        for (int k = 0; k < 32; ++k) { const float x = xrow[F.lane + 64 * k]; ss += x * x; }
        const float rstd = 1.0f / sqrtf(wave_sum(ss) * (1.0f / D) + EPS);
        float ag[4] = {0.f, 0.f, 0.f, 0.f}, ae[32];
#pragma unroll
        for (int e = 0; e < 32; ++e) ae[e] = 0.f;
#pragma unroll 1
        for (int k = 0; k < 32; ++k) { const int d = F.lane + 64 * k;
            const float hv = xrow[d] * rstd * gain[d];
            H[(size_t)t * D + d] = (bf16)f2bf(hv);
            const f32x4 w4 = *(const f32x4*)(wg + (size_t)d * 4);
            ag[0] += hv * w4.x; ag[1] += hv * w4.y; ag[2] += hv * w4.z; ag[3] += hv * w4.w;
#pragma unroll
            for (int c = 0; c < 8; ++c) { const f32x4 w = *(const f32x4*)(we + (size_t)d * 32 + c * 4); ae[c * 4] += hv * w.x; ae[c * 4 + 1] += hv * w.y; ae[c * 4 + 2] += hv * w.z; ae[c * 4 + 3] += hv * w.w; } }
#pragma unroll
        for (int e = 0; e < 4; ++e) ag[e] = wave_sum(ag[e]) + bg[e];
#pragma unroll
        for (int e = 0; e < 32; ++e) ae[e] = wave_sum(ae[e]) + be[e];
        int gi = 0; float gm = ag[0];
#pragma unroll
        for (int e = 1; e < 4; ++e) if (ag[e] > gm) { gm = ag[e]; gi = e; }
        float gs = 0.f;
#pragma unroll
        for (int e = 0; e < 4; ++e) gs += expf(ag[e] - gm);
        const float gw_ = 1.0f / gs;
        float el[8];
#pragma unroll
        for (int e = 0; e < 8; ++e) { el[e] = gi == 0 ? ae[e] : (gi == 1 ? ae[8 + e] : (gi == 2 ? ae[16 + e] : ae[24 + e])); }
        int i1 = 0; float m1 = el[0];
#pragma unroll
        for (int e = 1; e < 8; ++e) if (el[e] > m1) { m1 = el[e]; i1 = e; }
        int i2 = -1; float m2 = -3.0e38f;
#pragma unroll
        for (int e = 0; e < 8; ++e) if (e != i1 && el[e] > m2) { m2 = el[e]; i2 = e; }
        const float p2 = expf(m2 - m1);
        const float w1 = 1.0f / (1.0f + p2), w2 = p2 / (1.0f + p2);
        if (F.lane == 0) { EID[2 * t] = gi * 8 + i1; EID[2 * t + 1] = gi * 8 + i2; EW[2 * t] = gw_ * w1; EW[2 * t + 1] = gw_ * w2; }
    }
}

__device__ __forceinline__ void phase_router2(Frame& F, int l) {
    KA;
    const float* X1 = (const float*)(KWS + WS_X1); bf16* H = (bf16*)(KWS + WS_H);
    int* EID = (int*)(KWS + WS_ROUTE); float* EW = (float*)(KWS + WS_ROUTE + 65536); int* HIST = (int*)(KWS + WS_HIST);
    const float* WRT = (const float*)(KWS + WS_WRT) + (size_t)l * 48 * D;
    const float* gain = KIN(I_NFFN) + (size_t)l * D; const float* bg = KIN(I_BGRP) + l * 4; const float* be = KIN(I_BEXP) + l * 32;
    LAS float* red = (LAS float*)F.lds;
    LAS float* ssq = (LAS float*)(F.lds + 24576);
    LAS float* lg = (LAS float*)(F.lds + 25088);
    LAS float* rs = (LAS float*)(F.lds + 30208);
    LAS int* eidl = (LAS int*)(F.lds + 30336);
    const int r16 = F.lane & 15, kq = F.lane >> 4, tg = F.wave >> 2, kq4 = F.wave & 3;
    for (int blk = F.bid; blk < T / 32; blk += F.G) {
        const int tok0 = blk * 32;
        const float* xa = X1 + (size_t)(tok0 + 16 * tg + r16) * D + kq4 * 512 + 4 * kq;
        const float* wb = WRT + (size_t)r16 * D + kq4 * 512 + 4 * kq;
        f32x4 acc[3]; float sq = 0.f;
#pragma unroll
        for (int nt = 0; nt < 3; ++nt) acc[nt] = (f32x4){0.f, 0.f, 0.f, 0.f};
#pragma unroll 2
        for (int s = 0; s < 32; ++s) { const f32x4 a = *(const f32x4*)(xa + 16 * s);
            f32x4 b[3];
#pragma unroll
            for (int nt = 0; nt < 3; ++nt) b[nt] = *(const f32x4*)(wb + (size_t)(16 * nt) * D + 16 * s);
            sq += a.x * a.x + a.y * a.y + a.z * a.z + a.w * a.w;
#pragma unroll
            for (int j = 0; j < 4; ++j)
#pragma unroll
                for (int nt = 0; nt < 3; ++nt) acc[nt] = __builtin_amdgcn_mfma_f32_16x16x4f32(a[j], b[nt][j], acc[nt], 0, 0, 0); }
        sq += __shfl_xor(sq, 16); sq += __shfl_xor(sq, 32);
#pragma unroll
        for (int nt = 0; nt < 3; ++nt) *(LAS f32x4*)(red + ((F.wave * 3 + nt) * 64 + F.lane) * 4) = acc[nt];
        if (kq == 0) ssq[F.wave * 16 + r16] = sq;
        __syncthreads();
        if (F.tid < 384) { const int tg2 = F.tid / 192, rem = F.tid % 192, nt = rem / 64, ln = rem % 64; f32x4 v = {0.f, 0.f, 0.f, 0.f};
#pragma unroll
            for (int q = 0; q < 4; ++q) v += *(const LAS f32x4*)(red + (((tg2 * 4 + q) * 3 + nt) * 64 + ln) * 4);
            const int col = 16 * nt + (ln & 15);
            if (col < 36) {
#pragma unroll
                for (int i = 0; i < 4; ++i) lg[(16 * tg2 + 4 * (ln >> 4) + i) * 40 + col] = v[i]; } }
        if (F.tid >= 384 && F.tid < 416) { const int tk = F.tid - 384, tg2 = tk >> 4, rr = tk & 15; float q2 = 0.f;
#pragma unroll
            for (int q = 0; q < 4; ++q) q2 += ssq[(tg2 * 4 + q) * 16 + rr];
            rs[tk] = 1.0f / sqrtf(q2 * (1.0f / D) + EPS); }
        __syncthreads();
        if (F.tid < 32) { const int tk = F.tid, t = tok0 + tk; const float rstd = rs[tk];
            float ag[4], el[8];
#pragma unroll
            for (int e = 0; e < 4; ++e) ag[e] = lg[tk * 40 + 32 + e] * rstd + bg[e];
            int gi = 0; float gm = ag[0];
#pragma unroll
            for (int e = 1; e < 4; ++e) if (ag[e] > gm) { gm = ag[e]; gi = e; }
            float gs = 0.f;
#pragma unroll
            for (int e = 0; e < 4; ++e) gs += expf(ag[e] - gm);
            const float gw_ = 1.0f / gs;
#pragma unroll
            for (int e = 0; e < 8; ++e) el[e] = lg[tk * 40 + gi * 8 + e] * rstd + be[gi * 8 + e];
            int i1 = 0; float m1 = el[0];
#pragma unroll
            for (int e = 1; e < 8; ++e) if (el[e] > m1) { m1 = el[e]; i1 = e; }
            int i2 = -1; float m2 = -3.0e38f;
#pragma unroll
            for (int e = 0; e < 8; ++e) if (e != i1 && el[e] > m2) { m2 = el[e]; i2 = e; }
            const float p2 = expf(m2 - m1), w1 = 1.0f / (1.0f + p2), w2 = p2 / (1.0f + p2);
            EID[2 * t] = gi * 8 + i1; EID[2 * t + 1] = gi * 8 + i2; EW[2 * t] = gw_ * w1; EW[2 * t + 1] = gw_ * w2;
            eidl[2 * tk] = gi * 8 + i1; eidl[2 * tk + 1] = gi * 8 + i2; }
        __syncthreads();
        if (F.tid < 32) { int c = 0;
#pragma unroll 8
            for (int i = 0; i < 64; ++i) c += eidl[i] == F.tid ? 1 : 0;
            HIST[blk * 32 + F.tid] = c; }
#pragma unroll 1
        for (int q = 0; q < 4; ++q) { const int tk = F.wave * 4 + q; const float rstd = rs[tk];
            const f32x4* xr = (const f32x4*)(X1 + (size_t)(tok0 + tk) * D) + F.lane;
#pragma unroll
            for (int j = 0; j < 8; ++j) { const f32x4 v = xr[64 * j]; const f32x4 g = *((const f32x4*)gain + F.lane + 64 * j);
                u32x2 o; o.x = pk2(v.x * rstd * g.x, v.y * rstd * g.y); o.y = pk2(v.z * rstd * g.z, v.w * rstd * g.w);
                *((u32x2*)(H + (size_t)(tok0 + tk) * D) + F.lane + 64 * j) = o; } }
        __syncthreads();
    }
}
__device__ __forceinline__ void phase_lists2(Frame& F) {
    KA;
    const int* EID = (const int*)(KWS + WS_ROUTE); int* CNT = (int*)(KWS + WS_ROUTE + 131072); int* LIST = (int*)(KWS + WS_ROUTE + 262144); const int* HIST = (const int*)(KWS + WS_HIST);
    LAS int* off = (LAS int*)F.lds; LAS int* eidl = off + 32;
    for (int blk = F.bid; blk < T / 32; blk += F.G) {
        if (F.tid < 32) { int a = 0;
#pragma unroll 8
            for (int b2 = 0; b2 < blk; ++b2) a += HIST[b2 * 32 + F.tid];
            off[F.tid] = a;
            if (blk == T / 32 - 1) CNT[F.tid] = a + HIST[blk * 32 + F.tid]; }
        if (F.tid >= 64 && F.tid < 128) eidl[F.tid - 64] = EID[blk * 64 + F.tid - 64];
        __syncthreads();
        if (F.tid < 64) { const int e = eidl[F.tid]; int rk = 0;
            for (int i = 0; i < F.tid; ++i) rk += eidl[i] == e ? 1 : 0;
            LIST[e * 8192 + off[e] + rk] = blk * 64 + F.tid; }
        __syncthreads();
    }
}

__device__ __forceinline__ void phase_lists(Frame& F) {
    KA;
    const int e = F.bid;
    if (e >= NE) return;
    const int* EID = (const int*)(KWS + WS_ROUTE); int* CNT = (int*)(KWS + WS_ROUTE + 131072); int* LIST = (int*)(KWS + WS_ROUTE + 262144);
    LAS int* wc = (LAS int*)F.lds;
    int run = 0;
    for (int base = 0; base < 2 * T; base += 512) {
        const int idx = base + F.tid; const bool match = EID[idx] == e;
        const unsigned long long b = __ballot(match);
        if (F.lane == 0) wc[F.wave] = __popcll(b);
        __syncthreads();
        int pre = 0, tot = 0;
#pragma unroll
        for (int w = 0; w < 8; ++w) { const int c = wc[w]; pre += w < F.wave ? c : 0; tot += c; }
        if (match) LIST[e * 8192 + run + pre + __popcll(b & ((1ull << F.lane) - 1ull))] = idx;
        run += tot;
        __syncthreads();
    }
    if (F.tid == 0) CNT[e] = run;
}
__device__ __forceinline__ void moe_table(Frame& F, LAS int* tb) {
    KA;
    const int* CNT = (const int*)(KWS + WS_ROUTE + 131072);
    if (F.tid == 0) { int a = 0, f = 0, h = 0;
        for (int e = 0; e < NE; ++e) { const int n = CNT[e], nt = (n + 255) / 256, lastv = n - (nt - 1) * 256, hh = (nt > 0 && lastv <= 128) ? 1 : 0;
            tb[e] = a; tb[33 + e] = f; tb[66 + e] = h; a += nt; f += nt - hh; h += hh; }
        tb[NE] = a; tb[33 + NE] = f; tb[66 + NE] = h; }
    __syncthreads();
}

constexpr int PH_PER_LAYER = 11, N_PHASES = 1 + NL * PH_PER_LAYER + 1;

__global__ void __launch_bounds__(512, 2) mk_fwd(Args args) {
    extern __shared__ __attribute__((aligned(16))) unsigned char lds_raw[];
#define FRAME Frame F; F.lds = (LAS unsigned char*)lds_raw; F.MISC = (volatile LAS unsigned*)(F.lds + MISC_OFF); F.tid = ltid(); F.lane = F.tid & 63; F.wave = __builtin_amdgcn_readfirstlane(F.tid >> 6); \
    F.G = gridDim.x; F.bid = lbid(); F.vcu = (F.G % 8 == 0) ? (F.bid % 8) * (F.G / 8) + F.bid / 8 : F.bid; F.gw = F.bid * 8 + F.wave; F.NGW = F.G * 8;
    unsigned* const ctl = (unsigned*)((unsigned char*)args.ws + WS_CTL);
    for (int u = threadIdx.x; u < (LDS_BYTES - MISC_OFF) / 4; u += 512) ((LAS unsigned*)(lds_raw + MISC_OFF))[u] = 0u;
    __syncthreads();
    const int lo = args.ph_lo, hi = args.ph_hi;
    XcdBarrier bar; bar.bar = ctl + CW_BAR + args.li * XCD_BAR_WORDS; bar.x = 0; bar.st = nullptr;
    if (hi - lo > 1) bar = xcd_barrier_post(ctl + CW_BAR + args.li * XCD_BAR_WORDS, (volatile LAS unsigned*)((LAS unsigned char*)lds_raw + MISC_OFF));
    int ph = 0;
#define RUN(k) ((k) >= lo && (k) < hi)
#ifndef MK_PROBE_MASK
#define MK_PROBE_MASK 0
#endif
    volatile LAS unsigned long long* const tacc = (volatile LAS unsigned long long*)((LAS unsigned char*)lds_raw + MISC_OFF + 512);
    if (MK_PROBE_MASK != 0 && blockIdx.x == 0 && threadIdx.x == 0) tacc[16] = wall_clock64();
#define STAMP(slot) do { if (MK_PROBE_MASK != 0 && lbid() == 0 && ltid() == 0) { const unsigned long long _n = wall_clock64(); tacc[slot] += _n - tacc[16]; tacc[16] = _n; } } while (0)
#define SEAM(k, slot) do { if ((k) + 1 < hi) xcd_barrier(bar); STAMP(slot); } while (0)
    LAS int* const tb = (LAS int*)((LAS unsigned char*)lds_raw + MISC_OFF + 64);

    if (RUN(ph)) { KA; FRAME; phase_prologue(F); phase_norm1<0>(F, KIN(I_X), nullptr, nullptr, KIN(I_NMIX), (bf16*)(KWS + WS_H)); SEAM(ph, 0); }
    ++ph;
    for (int l = 0; l < NL; ++l) {
        if (RUN(ph)) { KA; FRAME; pg8::PlainSched S; S.init((const bf16*)(KWS + WS_H), D, (const bf16*)(KWS + WS_WIN) + (size_t)l * NPAD * D, T, NPAD, D, F.G, F.bid, 4);
            pg8::EpiBf16 E{(bf16*)(KWS + WS_P), NPAD};
            pg8::gemm_phase<pg8::EpiBf16, pg8::PlainSched, true>(F.lds, D, S, E); SEAM(ph, 1); }
        ++ph;
        if (RUN(ph)) { KA; FRAME; phase_prep3(F, l); SEAM(ph, 2); }
        ++ph;
        if (RUN(ph)) { KA; FRAME; phase_compress3(F, l); phase_rec_local(F, l); SEAM(ph, 3); }
        ++ph;
        if (RUN(ph)) { KA; FRAME; phase_rec_scan(F); SEAM(ph, 4); }
        ++ph;
        if (RUN(ph)) { KA; FRAME; phase_nsa2(F, l); if (MK_PROBE_MASK != 0) { xcd_barrier(bar); STAMP(7); } phase_rec_out(F, l); SEAM(ph, 5); }
        ++ph;
        if (RUN(ph)) { KA; FRAME;
            for (int n = 0; n < 3; ++n) { pg8::PlainSched S; S.init((const bf16*)(KWS + WS_OCAT) + n * 512, 1536, (const bf16*)(KWS + WS_WBR) + ((size_t)l * 3 + n) * D * 512, T, D, 512, F.G, F.bid);
                pg8::EpiMerge E{(bf16*)(KWS + WS_MERGED), (const bf16*)(KWS + WS_P) + C_MG + n * D, n == 0 ? 1 : 0};
                pg8::gemm_phase<pg8::EpiMerge, pg8::PlainSched, true>(F.lds, 512, S, E); __syncthreads(); }
            SEAM(ph, 6); }
        ++ph;

        if (RUN(ph)) { KA; FRAME; pg8::PlainSched S; S.init((const bf16*)(KWS + WS_MERGED), D, (const bf16*)(KWS + WS_WOUT) + (size_t)l * D * D, T, D, D, F.G, F.bid);
            pg8::EpiResF32 E{l == 0 ? KIN(I_X) : (const float*)(KWS + WS_XRES), (float*)(KWS + WS_X1), D};
            pg8::gemm_phase<pg8::EpiResF32, pg8::PlainSched, false>(F.lds, D, S, E); SEAM(ph, 8); }
        ++ph;
        if (RUN(ph)) { KA; FRAME; phase_router2(F, l); SEAM(ph, 9); }
        ++ph;
        if (RUN(ph)) { KA; FRAME; phase_lists2(F); SEAM(ph, 10); }
        ++ph;
        if (RUN(ph)) { KA; FRAME; moe_table(F, tb);
            pg8::MoeSched<1> S; S.init(F.G, F.bid, tb, (const int*)(KWS + WS_ROUTE + 131072), (const int*)(KWS + WS_ROUTE + 262144), KWS + WS_H, (const bf16*)(KWS + WS_WGU) + (size_t)l * NE * 1024 * D);
            pg8::EpiMoe1 E{(bf16*)(KWS + WS_ACT), (const int*)(KWS + WS_ROUTE + 262144), (const float*)(KWS + WS_ROUTE + 65536)};
            pg8::gemm_phase<pg8::EpiMoe1, pg8::MoeSched<1>, true>(F.lds, D, S, E); SEAM(ph, 11); }
        ++ph;
        if (RUN(ph)) { KA; FRAME; moe_table(F, tb);
            pg8::MoeSched<2> S; S.init(F.G, F.bid, tb, (const int*)(KWS + WS_ROUTE + 131072), (const int*)(KWS + WS_ROUTE + 262144), KWS + WS_ACT, (const bf16*)(KWS + WS_WDN) + (size_t)l * NE * D * FF);
            pg8::EpiMoe2 E{(bf16*)(KWS + WS_CONTRIB), (const int*)(KWS + WS_ROUTE + 262144)};
            pg8::gemm_phase<pg8::EpiMoe2, pg8::MoeSched<2>, true>(F.lds, FF, S, E); SEAM(ph, 12); }
        ++ph;
        if (l + 1 < NL) { if (RUN(ph)) { KA; FRAME; phase_norm1<1>(F, (const float*)(KWS + WS_X1), (const bf16*)(KWS + WS_CONTRIB), (float*)(KWS + WS_XRES), KIN(I_NMIX) + (size_t)(l + 1) * D, (bf16*)(KWS + WS_H)); SEAM(ph, 13); } ++ph; }
    }
    if (RUN(ph)) { KA; FRAME; phase_norm1<2>(F, (const float*)(KWS + WS_X1), (const bf16*)(KWS + WS_CONTRIB), KOUT, nullptr, nullptr); }
    if (MK_PROBE_MASK != 0 && lbid() == 0 && ltid() == 0) {
        asm volatile("s_waitcnt vmcnt(0)" ::: "memory"); STAMP(15);
        unsigned long long tot = 0ull;
        for (int k2 = 0; k2 < 16; ++k2) if ((MK_PROBE_MASK >> k2) & 1) tot += tacc[k2];
        const unsigned long long t_end = wall_clock64() + 4ull * tot;
        while (wall_clock64() < t_end) __builtin_amdgcn_s_sleep(8);
    }
#undef RUN
#undef SEAM
}

#ifndef MK_PER_PHASE
#define MK_PER_PHASE 0
#endif
extern "C" void kernel_launch(void* const* d_in, const int* in_sizes, int n_in, void* d_out, int out_size, void* d_ws, size_t ws_size, hipStream_t stream) {
    static int grid = 0;
    if (grid == 0) {
        if (n_in != 22 || out_size != T * D || ws_size < WS_END) { fprintf(stderr, "kernel_launch: unexpected sizes (n_in %d out %d ws %zu)\n", n_in, out_size, ws_size); grid = -1; return; }
        int dev = 0, cus = 0, per_cu = 0;
        if (hipGetDevice(&dev) != hipSuccess || hipDeviceGetAttribute(&cus, hipDeviceAttributeMultiprocessorCount, dev) != hipSuccess) { grid = -1; return; }
        if (hipFuncSetAttribute((const void*)mk_fwd, hipFuncAttributeMaxDynamicSharedMemorySize, LDS_BYTES) != hipSuccess) { fprintf(stderr, "kernel_launch: hipFuncSetAttribute failed\n"); grid = -1; return; }
        if (hipOccupancyMaxActiveBlocksPerMultiprocessor(&per_cu, (const void*)mk_fwd, 512, LDS_BYTES) != hipSuccess || per_cu < 1) { fprintf(stderr, "kernel_launch: occupancy query says %d\n", per_cu); }
        (void)hipGetLastError();
        grid = cus;
    }
    if (grid < 0) return;
    if (hipMemsetAsync((char*)d_ws + WS_CTL, 0, CTL_ZERO_BYTES, stream) != hipSuccess) return;
    Args a{};
    for (int i = 0; i < 22; ++i) a.in[i] = (const GAS float*)d_in[i];
    a.out = (GAS float*)d_out; a.ws = (GAS unsigned char*)d_ws;
#if MK_PER_PHASE
    const int total = 1 + NL * PH_PER_LAYER + (NL - 1) + 1;
    for (int k = 0; k < total; ++k) { a.ph_lo = k; a.ph_hi = k + 1; a.li = 0; hipLaunchKernelGGL(mk_fwd, dim3(grid), dim3(512), LDS_BYTES, stream, a); }
#else
    a.ph_lo = 0; a.ph_hi = 1000; a.li = 0;
    hipLaunchKernelGGL(mk_fwd, dim3(grid), dim3(512), LDS_BYTES, stream, a);
#endif
    const hipError_t le = hipPeekAtLastError();
    if (le != hipSuccess) fprintf(stderr, "kernel_launch: launch failed: %s\n", hipGetErrorName(le));
}
```

```cpp
#include <hip/hip_runtime.h>
#include <cstdio>
#include <cstdint>

#define GAS __attribute__((address_space(1)))
#define LAS __attribute__((address_space(3)))
typedef unsigned short bf16;
typedef short bf16x8 __attribute__((ext_vector_type(8)));
typedef float f32x4 __attribute__((ext_vector_type(4)));
typedef float f32x2 __attribute__((ext_vector_type(2)));
typedef unsigned u32x4 __attribute__((ext_vector_type(4)));
typedef unsigned u32x2 __attribute__((ext_vector_type(2)));

constexpr int T = 8192, D = 2048, NL = 2, INC = 11048, NPAD = 11264;
constexpr int NE = 32, FF = 512, NCH = T / 64;
constexpr float EPS = 1e-6f, NEGB = -1e30f;
constexpr int C_Q = 0, C_KC = 512, C_VC = 640, C_KS = 768, C_VS = 896, C_KW = 1024, C_VW = 1152;
constexpr int C_HQ = 1280, C_HF = 1792, C_HI = 2304, C_HG = 2816, C_GQ = 3328, C_GK = 3584, C_GV = 3840, C_GR = 4352;
constexpr int C_MG = 4864, C_NG = 11008, C_GA = 11032;

constexpr size_t MiB = 1u << 20;
constexpr size_t WS_CTL = 0, CTL_ZERO_BYTES = 1 * MiB;
constexpr size_t WS_WIN = 2 * MiB;
constexpr size_t WS_WBR = 90 * MiB;
constexpr size_t WS_WOUT = 102 * MiB;
constexpr size_t WS_WGU = 118 * MiB;
constexpr size_t WS_WDN = 374 * MiB;
constexpr size_t WS_H = 502 * MiB;
constexpr size_t WS_P = 534 * MiB;
constexpr size_t WS_OCAT = 710 * MiB;
constexpr size_t WS_PROJ = 734 * MiB;
constexpr size_t WS_MERGED = 830 * MiB;
constexpr size_t WS_X1 = 862 * MiB;
constexpr size_t WS_XRES = 926 * MiB;
constexpr size_t WS_CONTRIB = 990 * MiB;
constexpr size_t WS_ACT = 1054 * MiB;
constexpr size_t WS_QN = 1078 * MiB;
constexpr size_t WS_KV = 1094 * MiB;
constexpr size_t WS_KC = 1118 * MiB;
constexpr size_t WS_ORAW = 1119 * MiB;
constexpr size_t WS_ROUTE = 1151 * MiB;
constexpr size_t WS_SLOC_HG = 1153 * MiB;
constexpr size_t WS_SLOC_GL = 1185 * MiB;
constexpr size_t WS_SPREV_HG = 1201 * MiB;
constexpr size_t WS_SPREV_GL = 1217 * MiB;
constexpr size_t WS_DEC = 1225 * MiB;
constexpr size_t WS_QS = 1226 * MiB;
constexpr size_t WS_KS2 = 1234 * MiB;
constexpr size_t WS_KW2 = 1236 * MiB;
constexpr size_t WS_VST = 1238 * MiB;
constexpr size_t WS_VWT = 1240 * MiB;
constexpr size_t WS_KCB = 1242 * MiB;
constexpr size_t WS_WRT = 1243 * MiB;
constexpr size_t WS_HIST = 1244 * MiB;
constexpr size_t WS_CW = 1245 * MiB;
constexpr size_t WS_END = 1247 * MiB;
constexpr size_t KV_STRIDE = (size_t)2 * T * 64;
constexpr int CW_BAR = 4096;

constexpr int RING_BYTES = 131072;
constexpr int LDS_BYTES = 147456;
constexpr int MISC_OFF = LDS_BYTES - 2048;

#define LDS_WAIT() asm volatile("s_waitcnt lgkmcnt(0)" ::: "memory")
#define VM_WAIT() asm volatile("s_waitcnt vmcnt(0)" ::: "memory")
#define WSYNC() asm volatile("s_waitcnt lgkmcnt(0)" ::: "memory")

__device__ __forceinline__ unsigned f2bf(float f) { unsigned u = __builtin_bit_cast(unsigned, f); return (u + 0x7fffu + ((u >> 16) & 1u)) >> 16; }
__device__ __forceinline__ unsigned pk2(float lo, float hi) { return f2bf(lo) | (f2bf(hi) << 16); }
__device__ __forceinline__ float bf2f(unsigned b) { return __builtin_bit_cast(float, (b & 0xffffu) << 16); }
__device__ __forceinline__ float bflo(unsigned w) { return __builtin_bit_cast(float, w << 16); }
__device__ __forceinline__ float bfhi(unsigned w) { return __builtin_bit_cast(float, w & 0xffff0000u); }
__device__ __forceinline__ float wave_sum(float v) {
#pragma unroll
    for (int o = 1; o < 64; o <<= 1) v += __shfl_xor(v, o);
    return v;
}
__device__ __forceinline__ float wave_max(float v) {
#pragma unroll
    for (int o = 1; o < 64; o <<= 1) v = fmaxf(v, __shfl_xor(v, o));
    return v;
}
__device__ __forceinline__ int ltid() { int t = threadIdx.x; asm volatile("" : "+v"(t)); return t; }
__device__ __forceinline__ int lbid() { int b = blockIdx.x; asm volatile("" : "+s"(b)); return b; }
typedef __bf16 bf16x2_t __attribute__((ext_vector_type(2)));
__device__ __forceinline__ unsigned pkbf(float lo, float hi) { const f32x2 v = {lo, hi}; return __builtin_bit_cast(unsigned, __builtin_convertvector(v, bf16x2_t)); }
constexpr float LOG2E = 1.4426950408889634f;
__device__ __forceinline__ float sigmoidf_(float x) { return 1.0f / (1.0f + expf(-x)); }
__device__ __forceinline__ float fsig(float x) { return __builtin_amdgcn_rcpf(1.0f + __builtin_amdgcn_exp2f(-LOG2E * x)); }

#define XB_TMO      128
#define XB_XCNT(j)  (256  + 64 * (j))
#define XB_XSUB(j)  (1280 + 64 * (j))
#define XB_XGEN(j)  (2304 + 64 * (j))
#define XB_TOP      3328
#define XB_TOPGEN   3392
#define XCD_BAR_WORDS 3456
#define XB_SPIN_CAP (1u << 25)

__device__ __forceinline__ unsigned xb_ld(unsigned* p)              { return __hip_atomic_load(p, __ATOMIC_RELAXED, __HIP_MEMORY_SCOPE_AGENT); }
__device__ __forceinline__ unsigned xb_add(unsigned* p, unsigned v) { return __hip_atomic_fetch_add(p, v, __ATOMIC_RELAXED, __HIP_MEMORY_SCOPE_AGENT); }
__device__ __forceinline__ unsigned xb_xcc_id() { return (unsigned)__builtin_amdgcn_s_getreg((3 << 11) | 20) & 0xFu; }
#define XB_SPIN(cond, bar) do { unsigned _sp = 0; while (cond) { __builtin_amdgcn_s_sleep(1); \
    if ((++_sp & 255u) == 0u) { if (xb_ld(&(bar)[XB_TMO])) break; if (_sp > XB_SPIN_CAP) { atomicAdd(&(bar)[XB_TMO], 1u); break; } } } } while (0)

struct XcdBarrier { unsigned* bar; unsigned x; volatile LAS unsigned* st; };

__device__ __forceinline__ XcdBarrier xcd_barrier_post(unsigned* bar, volatile LAS unsigned* st) {
    XcdBarrier b; b.bar = bar; b.x = xb_xcc_id(); b.st = st;
    if (threadIdx.x == 0) (void)xb_add(&bar[XB_XCNT(b.x)], 1u);
    return b;
}
__device__ __forceinline__ void xcd_barrier_complete(unsigned* bar, unsigned x, unsigned& nloc, unsigned& nx) {
    const unsigned G = gridDim.x * gridDim.y * gridDim.z;
    unsigned sum, cnt, mine, sp = 0u;
    for (;;) {
        sum = 0u; cnt = 0u; mine = 0u;
#pragma unroll
        for (unsigned j = 0; j < 16; ++j) { const unsigned c = xb_ld(&bar[XB_XCNT(j)]); sum += c; cnt += (c > 0u) ? 1u : 0u; mine = (j == x) ? c : mine; }
        if (sum == G) break;
        __builtin_amdgcn_s_sleep(1);
        if ((++sp & 255u) == 0u) { if (xb_ld(&bar[XB_TMO])) break; if (sp > XB_SPIN_CAP) { atomicAdd(&bar[XB_TMO], 1u); break; } }
    }
    nloc = mine > 0u ? mine : 1u; nx = cnt > 0u ? cnt : 1u;
}
__device__ __forceinline__ void xcd_barrier(const XcdBarrier& b) {
    asm volatile("s_waitcnt vmcnt(0)" ::: "memory");
    __syncthreads();
    if (threadIdx.x == 0) {
        unsigned* bar = b.bar;
        __builtin_amdgcn_s_waitcnt(0);
        unsigned nloc = b.st[0], nx = b.st[1];
        if (nloc == 0u) { xcd_barrier_complete(bar, b.x, nloc, nx); b.st[0] = nloc; b.st[1] = nx; }
        const unsigned old = xb_add(&bar[XB_XSUB(b.x)], 1u);
        const unsigned gen = old / nloc;
        if (old + 1u == (gen + 1u) * nloc) {
            __builtin_amdgcn_fence(__ATOMIC_RELEASE, "agent");
            asm volatile("s_waitcnt vmcnt(0)" ::: "memory");
            const unsigned og = xb_add(&bar[XB_TOP], 1u);
            const unsigned tg = og / nx;
            if (og + 1u == (tg + 1u) * nx) xb_add(&bar[XB_TOPGEN], 1u);
            else XB_SPIN(xb_ld(&bar[XB_TOPGEN]) == tg, bar);
            __builtin_amdgcn_fence(__ATOMIC_ACQUIRE, "agent");
            xb_add(&bar[XB_XGEN(b.x)], 1u);
            asm volatile("s_waitcnt vmcnt(0)" ::: "memory");
        } else {
            XB_SPIN(xb_ld(&bar[XB_XGEN(b.x)]) == gen, bar);
            __builtin_amdgcn_fence(__ATOMIC_ACQUIRE, "agent");
            asm volatile("s_waitcnt vmcnt(0)" ::: "memory");
        }
    }
    __syncthreads();
}

namespace pg8 {
constexpr int BM = 256, BK = 64, HALF = 128, HTB = HALF * BK * 2, STAGE_BYTES = 8 * HTB, NXCD = 8, WGM = 8;
__host__ __device__ __forceinline__ int lds_byte(int r, int c) { const int st = (r >> 4) * 2 + (c >> 5), rr = r & 15, cc = c & 31, ob = rr * 64 + cc * 2; return st * 1024 + (ob ^ (((ob >> 9) & 1) << 5)); }
__host__ __device__ __forceinline__ void stage_rc(int b, int& R, int& C) { const int st = b / 1024, sb = b % 1024, swz = sb ^ (((sb >> 9) & 1) << 5); R = (st >> 1) * 16 + swz / 64; C = (st & 1) * 32 + (swz % 64) / 2; }
__host__ __device__ __forceinline__ int perm32(int rho) { const int n = rho >> 4, i = rho & 15; return 8 * (i >> 2) + 4 * n + (i & 3); }

struct Unit { int pm, pn, e, nvalid, slot0, half, row0; const char *A0, *A1, *B0, *B1; unsigned va[2][2]; };

__device__ __forceinline__ unsigned cvt_pk_bf16(float lo, float hi) { unsigned r; asm volatile("v_cvt_pk_bf16_f32 %0, %1, %2" : "=v"(r) : "v"(lo), "v"(hi)); return r; }

template <class Epi, class Sched, bool ALIGN_EPI>
__device__ __forceinline__ void gemm_phase(LAS unsigned char* lds, const int K, const Sched& S, const Epi& E) {
    const int tid = ltid(), wid = __builtin_amdgcn_readfirstlane(tid >> 6), lane = tid & 63, wr = wid >> 2, wc = wid & 3, fr = lane & 15, fq = lane >> 4;
    const int nt = K / BK;
    unsigned voffB[2];
#pragma unroll
    for (int i = 0; i < 2; ++i) { int R, C; stage_rc(tid * 16 + i * 8192, R, C); const int Rb = Epi::PERM ? ((R & ~31) + perm32(R & 31)) : R; voffB[i] = (unsigned)(Rb * K + C) * 2u; }
    const size_t kstep = (size_t)(BK * 2);
    const unsigned ldsw = (unsigned)wid * 1024u;
    const int aoff = lds_byte(wr * 64 + fr, fq * 8), boff = lds_byte(wc * 32 + fr, fq * 8);
#define PG8_SA(b, h) (((b) * 2 + (h)) * HTB)
#define PG8_SB(b, h) ((4 + (b) * 2 + (h)) * HTB)
#define PG8_STAGE(bufoff, gbase, voff) do { _Pragma("unroll") for (int _i = 0; _i < 2; ++_i) \
        __builtin_amdgcn_global_load_lds((const unsigned*)((const char*)(gbase) + (voff)[_i]), (LAS unsigned*)(lds + (bufoff) + ldsw + _i * 8192), 16, 0, 0); } while (0)
#define PG8_LDA(dst, b, h) do { _Pragma("unroll") for (int m = 0; m < 4; ++m) _Pragma("unroll") for (int k = 0; k < 2; ++k) dst[m][k] = *(const LAS bf16x8*)(lds + PG8_SA(b, h) + aoff + m * 2048 + k * 1024); } while (0)
#define PG8_LDB(dst, b, h) do { _Pragma("unroll") for (int n = 0; n < 2; ++n) _Pragma("unroll") for (int k = 0; k < 2; ++k) dst[n][k] = *(const LAS bf16x8*)(lds + PG8_SB(b, h) + boff + n * 2048 + k * 1024); } while (0)
#define PG8_MMA(ai, bj, At, Bt) do { __builtin_amdgcn_s_setprio(1); _Pragma("unroll") for (int m = 0; m < 4; ++m) _Pragma("unroll") for (int n = 0; n < 2; ++n) _Pragma("unroll") for (int k = 0; k < 2; ++k) \
        acc[ai][bj][m][n] = __builtin_amdgcn_mfma_f32_16x16x32_bf16(Bt[n][k], At[m][k], acc[ai][bj][m][n], 0, 0, 0); __builtin_amdgcn_s_setprio(0); } while (0)
#define PG8_WAIT_V(n) asm volatile("s_waitcnt vmcnt(" #n ")" ::: "memory")
#define PG8_WAIT_L(n) asm volatile("s_waitcnt lgkmcnt(" #n ")" ::: "memory")
#define PG8_BAR __builtin_amdgcn_s_barrier()
#define PG8_SCHED __builtin_amdgcn_sched_barrier(0)
#define VA(u, h) (Sched::GATHER ? (u).va[h] : S.va)
    Unit cur, nxt; int ui = 0;
    if (!S.next(0, cur)) return;
    f32x4 acc[2][2][4][2];
#pragma unroll
    for (int a = 0; a < 2; ++a)
#pragma unroll
        for (int b = 0; b < 2; ++b)
#pragma unroll
            for (int m = 0; m < 4; ++m)
#pragma unroll
                for (int n = 0; n < 2; ++n) acc[a][b][m][n] = (f32x4){0.f, 0.f, 0.f, 0.f};
    bf16x8 At[4][2], B0[2][2], B1[2][2];
    PG8_STAGE(PG8_SB(0, 0), cur.B0, voffB); PG8_STAGE(PG8_SB(0, 1), cur.B1, voffB); PG8_STAGE(PG8_SA(0, 0), cur.A0, VA(cur, 0)); PG8_STAGE(PG8_SA(0, 1), cur.A1, VA(cur, 1));
    if (wr == 1) PG8_BAR;
    PG8_WAIT_V(2); PG8_BAR;
    PG8_STAGE(PG8_SB(1, 0), cur.B0 + kstep, voffB); PG8_STAGE(PG8_SA(1, 0), cur.A0 + kstep, VA(cur, 0)); PG8_STAGE(PG8_SB(1, 1), cur.B1 + kstep, voffB);
    PG8_WAIT_V(6); PG8_BAR;
    for (;;) {
        const bool has_next = S.next(ui + 1, nxt);
        if (!has_next) nxt = cur;
        for (int t = 0; t < nt; t += 2) {
            const bool last = (t == nt - 2);
            const char* a1h1 = cur.A1 + (size_t)(t + 1) * kstep;
            const char* a2h0 = last ? nxt.A0 : cur.A0 + (size_t)(t + 2) * kstep; const char* a2h1 = last ? nxt.A1 : cur.A1 + (size_t)(t + 2) * kstep;
            const char* b2h0 = last ? nxt.B0 : cur.B0 + (size_t)(t + 2) * kstep; const char* b2h1 = last ? nxt.B1 : cur.B1 + (size_t)(t + 2) * kstep;
            unsigned v2h0[2], v2h1[2];
#pragma unroll
            for (int i = 0; i < 2; ++i) { if constexpr (Sched::GATHER) { v2h0[i] = last ? nxt.va[0][i] : cur.va[0][i]; v2h1[i] = last ? nxt.va[1][i] : cur.va[1][i]; } else { v2h0[i] = S.va[i]; v2h1[i] = S.va[i]; } }
            PG8_LDB(B0, 0, 0); PG8_LDB(B1, 0, 1); PG8_SCHED; PG8_LDA(At, 0, 0); PG8_STAGE(PG8_SA(1, 1), a1h1, VA(cur, 1));
            PG8_WAIT_V(8); PG8_WAIT_L(0); PG8_BAR; PG8_MMA(0, 0, At, B0); PG8_MMA(0, 1, At, B1); PG8_BAR; PG8_SCHED;
            if (!cur.half) PG8_LDA(At, 0, 1);
            PG8_STAGE(PG8_SB(0, 0), b2h0, voffB); PG8_STAGE(PG8_SB(0, 1), b2h1, voffB); PG8_STAGE(PG8_SA(0, 0), a2h0, v2h0);
            PG8_WAIT_V(8); PG8_WAIT_L(0); PG8_BAR; if (!cur.half) { PG8_MMA(1, 0, At, B0); PG8_MMA(1, 1, At, B1); } PG8_BAR; PG8_SCHED;
            PG8_LDB(B0, 1, 0); PG8_LDB(B1, 1, 1); PG8_SCHED; PG8_LDA(At, 1, 0); PG8_STAGE(PG8_SA(0, 1), a2h1, v2h1);
            PG8_WAIT_V(8); PG8_WAIT_L(0); PG8_BAR; PG8_MMA(0, 0, At, B0); PG8_MMA(0, 1, At, B1); PG8_BAR; PG8_SCHED;
            if (!cur.half) PG8_LDA(At, 1, 1);
            PG8_STAGE(PG8_SB(1, 0), b2h0 + kstep, voffB); PG8_STAGE(PG8_SB(1, 1), b2h1 + kstep, voffB); PG8_STAGE(PG8_SA(1, 0), a2h0 + kstep, v2h0);
            PG8_WAIT_V(8); PG8_WAIT_L(0); PG8_BAR; if (!cur.half) { PG8_MMA(1, 0, At, B0); PG8_MMA(1, 1, At, B1); } PG8_BAR; PG8_SCHED;
        }
        if constexpr (ALIGN_EPI) { if (wr == 0) PG8_BAR; }
        E(acc, cur, wr, wc, fr, fq);
        if (!has_next) break;
#pragma unroll
        for (int a = 0; a < 2; ++a)
#pragma unroll
            for (int b = 0; b < 2; ++b)
#pragma unroll
                for (int m = 0; m < 4; ++m)
#pragma unroll
                    for (int n = 0; n < 2; ++n) acc[a][b][m][n] = (f32x4){0.f, 0.f, 0.f, 0.f};
        cur = nxt; ++ui;
        if constexpr (ALIGN_EPI) { if (wr == 1) PG8_BAR; }
    }
    PG8_WAIT_V(0);
    if constexpr (!ALIGN_EPI) { if (wr == 0) PG8_BAR; }
    PG8_BAR;
#undef VA
#undef PG8_SA
#undef PG8_SB
#undef PG8_STAGE
#undef PG8_LDA
#undef PG8_LDB
#undef PG8_MMA
#undef PG8_WAIT_V
#undef PG8_WAIT_L
#undef PG8_BAR
#undef PG8_SCHED
}

struct PlainSched {
    static constexpr bool GATHER = false;
    int nM, nN, nwg, G, c, lda, K, nNh; const char* A; const char* Bt; unsigned va[2];
    __device__ __forceinline__ void init(const bf16* A_, int lda_, const bf16* Bt_, int M, int N, int K_, int G_, int c_, int nNh_ = 0) {
        nM = M / BM; nN = N / BM - nNh_; nNh = nNh_; nwg = nM * nN; G = G_; c = c_; lda = lda_; K = K_; A = (const char*)A_; Bt = (const char*)Bt_;
#pragma unroll
        for (int i = 0; i < 2; ++i) { int R, C; stage_rc((int)ltid() * 16 + i * 8192, R, C); va[i] = (unsigned)(R * lda + C) * 2u; }
    }
    __device__ __forceinline__ bool next(int i, Unit& u) const {
        const long L = (long)i * G + c;
        u.e = 0; u.nvalid = 256; u.slot0 = 0; u.va[0][0] = 0u; u.va[0][1] = 0u; u.va[1][0] = 0u; u.va[1][1] = 0u;
        if (L >= nwg) { const int hL = (int)(L - nwg); if (hL >= 2 * nM * nNh) return false;
            const int hm = hL / nNh, pn = nN + hL % nNh;
            u.pm = hm >> 1; u.pn = pn; u.half = 1; u.row0 = hm * HALF;
            u.A0 = A + (size_t)hm * HALF * lda * 2; u.A1 = u.A0;
            u.B0 = Bt + (size_t)pn * BM * K * 2; u.B1 = u.B0 + (size_t)HALF * K * 2;
            return true; }
        int wgid = (int)L; { const int q = nwg / NXCD, r = nwg % NXCD, xcd = wgid % NXCD, off = wgid / NXCD; wgid = (xcd < r ? xcd * (q + 1) : r * (q + 1) + (xcd - r) * q) + off; }
        const int nig = WGM * nN, gid = wgid / nig, fm = gid * WGM, gsz = (nM - fm) < WGM ? (nM - fm) : WGM;
        u.pm = fm + ((wgid % nig) % gsz); u.pn = (wgid % nig) / gsz; u.half = 0; u.row0 = u.pm * BM;
        u.A0 = A + (size_t)u.pm * BM * lda * 2; u.A1 = u.A0 + (size_t)HALF * lda * 2;
        u.B0 = Bt + (size_t)u.pn * BM * K * 2; u.B1 = u.B0 + (size_t)HALF * K * 2;
        return true;
    }
};
template <int MODE> struct MoeSched {
    static constexpr int NPN = MODE == 1 ? 4 : 8;
    static constexpr bool GATHER = MODE == 1;
    int G, c; const LAS int* tb; const int* cnt; const int* list; const char* A; const char* W; unsigned va[2];
    __device__ __forceinline__ void init(int G_, int c_, const LAS int* tb_, const int* cnt_, const int* list_, const void* A_, const void* W_) {
        G = G_; c = c_; tb = tb_; cnt = cnt_; list = list_; A = (const char*)A_; W = (const char*)W_;
#pragma unroll
        for (int i = 0; i < 2; ++i) { int R, C; stage_rc((int)ltid() * 16 + i * 8192, R, C); va[i] = (unsigned)(R * FF + C) * 2u; }
    }
    __device__ __forceinline__ bool next(int i, Unit& u) const {
        const int L = i * G + c, nfull = __builtin_amdgcn_readfirstlane(tb[33 + NE]), nhalf = __builtin_amdgcn_readfirstlane(tb[66 + NE]);
        if (L >= (nfull + nhalf) * NPN) return false;
        const bool half = L >= nfull * NPN; const int Lr = half ? L - nfull * NPN : L, base = half ? 66 : 33;
        const int tq = Lr / NPN, pn = Lr % NPN; int e = 0;
        while (e < NE - 1 && __builtin_amdgcn_readfirstlane(tb[base + e + 1]) <= tq) ++e;
        const int ne = __builtin_amdgcn_readfirstlane(cnt[e]);
        const int pm = half ? (ne - 1) / 256 : tq - __builtin_amdgcn_readfirstlane(tb[33 + e]);
        const int tl = __builtin_amdgcn_readfirstlane(tb[e]) + pm;
        u.pm = pm; u.pn = pn; u.e = e; u.nvalid = ne - pm * 256; u.slot0 = tl * 256; u.half = half ? 1 : 0; u.row0 = 0;
        if (MODE == 1) {
            u.A0 = A; u.A1 = A;
#pragma unroll
            for (int h = 0; h < 2; ++h)
#pragma unroll
                for (int k = 0; k < 2; ++k) { int Rk, Ck; stage_rc((int)ltid() * 16 + k * 8192, Rk, Ck); int idx = pm * 256 + h * 128 + Rk; idx = idx < ne ? idx : ne - 1; const int entry = list[e * 8192 + idx]; u.va[h][k] = (unsigned)(entry >> 1) * (unsigned)(D * 2) + (unsigned)Ck * 2u; }
            const char* we = W + (size_t)e * 1024 * D * 2;
            u.B0 = we + (size_t)(pn * 128) * D * 2; u.B1 = we + (size_t)(512 + pn * 128) * D * 2;
        } else {
            u.va[0][0] = 0u; u.va[0][1] = 0u; u.va[1][0] = 0u; u.va[1][1] = 0u;
            u.A0 = A + (size_t)tl * 256 * FF * 2; u.A1 = u.A0 + (size_t)HALF * FF * 2;
            const char* we = W + (size_t)e * D * FF * 2;
            u.B0 = we + (size_t)(pn * 256) * FF * 2; u.B1 = u.B0 + (size_t)HALF * FF * 2;
        }
        return true;
    }
};

struct EpiBf16 {
    static constexpr bool PERM = true;
    bf16* O; int ldc;
    __device__ __forceinline__ void operator()(const f32x4 (&acc)[2][2][4][2], const Unit& u, int wr, int wc, int fr, int fq) const {
        const int row0 = u.row0 + wr * 64 + fr, col0 = u.pn * BM + wc * 32 + 8 * fq;
#pragma unroll
        for (int ai = 0; ai < 2; ++ai) if (ai == 0 || !u.half)
#pragma unroll
            for (int m = 0; m < 4; ++m) { bf16* rowp = O + (size_t)(row0 + ai * HALF + m * 16) * ldc + col0;
#pragma unroll
                for (int bj = 0; bj < 2; ++bj) { const f32x4 v0 = acc[ai][bj][m][0], v1 = acc[ai][bj][m][1];
                    u32x4 w; w.x = cvt_pk_bf16(v0[0], v0[1]); w.y = cvt_pk_bf16(v0[2], v0[3]); w.z = cvt_pk_bf16(v1[0], v1[1]); w.w = cvt_pk_bf16(v1[2], v1[3]);
                    *(u32x4*)(rowp + bj * HALF) = w; } }
    }
};
struct EpiMerge {
    static constexpr bool PERM = true;
    bf16* MG; const bf16* gate; int first;
    __device__ __forceinline__ void operator()(const f32x4 (&acc)[2][2][4][2], const Unit& u, int wr, int wc, int fr, int fq) const {
        const int row0 = u.row0 + wr * 64 + fr, col0 = u.pn * BM + wc * 32 + 8 * fq;
#pragma unroll
        for (int ai = 0; ai < 2; ++ai) if (ai == 0 || !u.half)
#pragma unroll
            for (int m = 0; m < 4; ++m) { const size_t row = (size_t)(row0 + ai * HALF + m * 16);
#pragma unroll
                for (int bj = 0; bj < 2; ++bj) { const u32x4 gq = *(const u32x4*)(gate + row * NPAD + col0 + bj * HALF); u32x4 pv = {0u, 0u, 0u, 0u};
                    if (!first) pv = *(const u32x4*)(MG + row * D + col0 + bj * HALF);
                    const f32x4 v0 = acc[ai][bj][m][0], v1 = acc[ai][bj][m][1]; float o[8];
                    const unsigned gw[4] = {gq.x, gq.y, gq.z, gq.w}, pw[4] = {pv.x, pv.y, pv.z, pv.w};
#pragma unroll
                    for (int k = 0; k < 4; ++k) { const float a0 = k < 2 ? v0[2 * k] : v1[2 * k - 4], a1 = k < 2 ? v0[2 * k + 1] : v1[2 * k - 3];
                        const float g0 = __builtin_bit_cast(float, gw[k] << 16), g1 = __builtin_bit_cast(float, gw[k] & 0xffff0000u);
                        o[2 * k] = fmaf(a0, fsig(g0), __builtin_bit_cast(float, pw[k] << 16)); o[2 * k + 1] = fmaf(a1, fsig(g1), __builtin_bit_cast(float, pw[k] & 0xffff0000u)); }
                    u32x4 w; w.x = cvt_pk_bf16(o[0], o[1]); w.y = cvt_pk_bf16(o[2], o[3]); w.z = cvt_pk_bf16(o[4], o[5]); w.w = cvt_pk_bf16(o[6], o[7]);
                    *(u32x4*)(MG + row * D + col0 + bj * HALF) = w; } }
    }
};
struct EpiResF32 {
    static constexpr bool PERM = false;
    const float* R; float* O; int ldc;
    __device__ __forceinline__ void operator()(const f32x4 (&acc)[2][2][4][2], const Unit& u, int wr, int wc, int fr, int fq) const {
        const int row0 = u.row0 + wr * 64 + fr, col0 = u.pn * BM + wc * 32 + 4 * fq;
#pragma unroll
        for (int ai = 0; ai < 2; ++ai) if (ai == 0 || !u.half)
#pragma unroll
            for (int m = 0; m < 4; ++m) { const size_t off = (size_t)(row0 + ai * HALF + m * 16) * ldc + col0;
#pragma unroll
                for (int bj = 0; bj < 2; ++bj)
#pragma unroll
                    for (int n = 0; n < 2; ++n) { const f32x4 r = *(const f32x4*)(R + off + bj * HALF + n * 16); *(f32x4*)(O + off + bj * HALF + n * 16) = acc[ai][bj][m][n] + r; } }
    }
};
struct EpiMoe1 {
    static constexpr bool PERM = true;
    bf16* ACT; const int* list; const float* ew;
    __device__ __forceinline__ void operator()(const f32x4 (&acc)[2][2][4][2], const Unit& u, int wr, int wc, int fr, int fq) const {
        const int col0 = u.pn * 128 + wc * 32 + 8 * fq;
#pragma unroll
        for (int ai = 0; ai < 2; ++ai) if (ai == 0 || !u.half)
#pragma unroll
            for (int m = 0; m < 4; ++m) { const int r = ai * HALF + wr * 64 + m * 16 + fr; float w = 0.f;
                if (r < u.nvalid) { const int entry = list[u.e * 8192 + u.pm * 256 + r]; w = ew[entry]; }
                float o[8];
#pragma unroll
                for (int n = 0; n < 2; ++n)
#pragma unroll
                    for (int j = 0; j < 4; ++j) { const float g = acc[ai][0][m][n][j], up = acc[ai][1][m][n][j]; o[n * 4 + j] = g * fsig(g) * up * w; }
                u32x4 pk; pk.x = cvt_pk_bf16(o[0], o[1]); pk.y = cvt_pk_bf16(o[2], o[3]); pk.z = cvt_pk_bf16(o[4], o[5]); pk.w = cvt_pk_bf16(o[6], o[7]);
                *(u32x4*)(ACT + (size_t)(u.slot0 + r) * FF + col0) = pk; }
    }
};
struct EpiMoe2 {
    static constexpr bool PERM = true;
    bf16* CO; const int* list;
    __device__ __forceinline__ void operator()(const f32x4 (&acc)[2][2][4][2], const Unit& u, int wr, int wc, int fr, int fq) const {
        const int col0 = u.pn * BM + wc * 32 + 8 * fq;
#pragma unroll
        for (int ai = 0; ai < 2; ++ai) if (ai == 0 || !u.half)
#pragma unroll
            for (int m = 0; m < 4; ++m) { const int r = ai * HALF + wr * 64 + m * 16 + fr;
                if (r < u.nvalid) { const int entry = list[u.e * 8192 + u.pm * 256 + r]; bf16* rowp = CO + (size_t)entry * D + col0;
#pragma unroll
                    for (int bj = 0; bj < 2; ++bj) { const f32x4 v0 = acc[ai][bj][m][0], v1 = acc[ai][bj][m][1];
                        u32x4 w; w.x = cvt_pk_bf16(v0[0], v0[1]); w.y = cvt_pk_bf16(v0[2], v0[3]); w.z = cvt_pk_bf16(v1[0], v1[1]); w.w = cvt_pk_bf16(v1[2], v1[3]);
                        *(u32x4*)(rowp + bj * HALF) = w; } } }
    }
};
}

struct Frame {
    LAS unsigned char* lds; volatile LAS unsigned* MISC;
    int tid, lane, wave, vcu, G, gw, NGW, bid;
};
struct Args { const GAS float* in[22]; GAS float* out; GAS unsigned char* ws; int ph_lo, ph_hi, li, pad; };
typedef const __attribute__((address_space(4))) Args KArgs;
__device__ __forceinline__ KArgs* ka_fresh() { unsigned long long p = (unsigned long long)__builtin_amdgcn_kernarg_segment_ptr(); asm volatile("" : "+s"(p)); return (KArgs*)p; }
#define KA KArgs* const ka = ka_fresh()
#define KIN(i) ((const float*)ka->in[i])
#define KWS ((unsigned char*)ka->ws)
#define KOUT ((float*)ka->out)
enum { I_X = 0, I_NMIX, I_WIN, I_PE, I_W1, I_W2, I_QN, I_KN, I_LB, I_HGN, I_WA2, I_BA, I_GLAN, I_WBR, I_WOUT, I_NFFN, I_WGRP, I_BGRP, I_WEXP, I_BEXP, I_WGU, I_WDN };

__device__ __forceinline__ void tr_item(const float* W, size_t ldw, int c0, int nv, bf16* WT, size_t ldt, int r0, int k0, LAS float* scr, int lane) {
    const int nn = lane & 31;
    float tv[32];
#pragma unroll
    for (int i = 0; i < 32; ++i) { const int kk = 2 * i + (lane >> 5); tv[i] = nn < nv ? W[(size_t)(k0 + kk) * ldw + c0 + nn] : 0.f; }
#pragma unroll
    for (int i = 0; i < 32; ++i) { const int kk = 2 * i + (lane >> 5); scr[kk * 33 + nn] = tv[i]; }
    LDS_WAIT();
    const int c = lane & 7;
#pragma unroll
    for (int j = 0; j < 4; ++j) { const int n = (lane >> 3) + 8 * j; const LAS float* s = scr + (8 * c) * 33 + n;
        u32x4 o; o.x = pk2(s[0 * 33], s[1 * 33]); o.y = pk2(s[2 * 33], s[3 * 33]); o.z = pk2(s[4 * 33], s[5 * 33]); o.w = pk2(s[6 * 33], s[7 * 33]);
        if (n < nv) *(u32x4*)(WT + (size_t)(r0 + n) * ldt + k0 + 8 * c) = o; }
    LDS_WAIT();
}
__device__ __forceinline__ void phase_prologue(Frame& F) {
    KA;
    {
      bf16* W1T = (bf16*)(KWS + WS_CW); bf16* W2T = (bf16*)(KWS + WS_CW + 1048576); float* B1 = (float*)(KWS + WS_CW + 1572864);
      for (int i = F.bid * 512 + F.tid; i < NL * 2 * 64 * 2048; i += F.G * 512) { const int lk = i / (64 * 2048), j = (i / 2048) % 64, c = i % 2048; W1T[i] = (bf16)f2bf(KIN(I_W1)[((size_t)lk * 2048 + c) * 64 + j]); }
      for (int i = F.bid * 512 + F.tid; i < NL * 2 * 64 * 64; i += F.G * 512) { const int lk = i / 4096, j2 = (i / 64) % 64, j = i % 64; W2T[i] = (bf16)f2bf(KIN(I_W2)[((size_t)lk * 64 + j) * 64 + j2]); }
      if (F.bid < NL * 2) { const int lk = F.bid, j = F.tid & 63, part = F.tid >> 6; float a = 0.f;
#pragma unroll 8
          for (int c = part * 256; c < part * 256 + 256; ++c) a += KIN(I_PE)[(size_t)lk * 2048 + c] * KIN(I_W1)[((size_t)lk * 2048 + c) * 64 + j];
          LAS float* rd = (LAS float*)F.lds; rd[F.tid] = a; __syncthreads();
          if (F.tid < 64) { float t2 = 0.f;
#pragma unroll
              for (int p = 0; p < 8; ++p) t2 += rd[p * 64 + F.tid];
              B1[lk * 64 + F.tid] = t2; }
          __syncthreads(); } }
    { float* WRT = (float*)(KWS + WS_WRT);
      for (int i = F.bid * 512 + F.tid; i < NL * 48 * D; i += F.G * 512) { const int l = i / (48 * D), n = (i / D) % 48, k = i % D; const float g = KIN(I_NFFN)[l * D + k];
          WRT[i] = n < 32 ? g * KIN(I_WEXP)[((size_t)l * D + k) * 32 + n] : (n < 36 ? g * KIN(I_WGRP)[((size_t)l * D + k) * 4 + (n - 32)] : 0.f); } }
    LAS float* scr = (LAS float*)(F.lds + F.wave * 16384);
    constexpr int IT_WIN = 32 * 346, IT_WBR = 3 * 8 * 64, IT_WOUT = 32 * 64, IT_WGU = 32 * 32 * 32, IT_WDN = 32 * 8 * 64, IT_L = IT_WIN + IT_WBR + IT_WOUT + IT_WGU + IT_WDN;
    for (int it = F.gw; it < NL * IT_L; it += F.NGW) {
        const int l = it / IT_L; int r = it % IT_L;
        if (r < IT_WIN) { const int kb = r / 346, nb = r % 346; int src, dst, nv = 32;
            if (nb < 40) { src = nb * 32; dst = nb * 32; }
            else if (nb == 40) { src = 1280; dst = C_NG; nv = 24; }
            else if (nb < 153) { src = 1304 + 32 * (nb - 41); dst = 1280 + 32 * (nb - 41); }
            else if (nb == 153) { src = 4888; dst = C_GA; nv = 16; }
            else { src = 4904 + 32 * (nb - 154); dst = C_MG + 32 * (nb - 154); }
            tr_item(KIN(I_WIN) + (size_t)l * D * INC, INC, src, nv, (bf16*)(KWS + WS_WIN) + (size_t)l * NPAD * D, D, dst, kb * 64, scr, F.lane); continue; }
        r -= IT_WIN;
        if (r < IT_WBR) { const int n = r / 512, q = r % 512, kb = q / 64, nb = q % 64;
            tr_item(KIN(I_WBR) + ((size_t)l * 3 + n) * 512 * D, D, nb * 32, 32, (bf16*)(KWS + WS_WBR) + ((size_t)l * 3 + n) * D * 512, 512, nb * 32, kb * 64, scr, F.lane); continue; }
        r -= IT_WBR;
        if (r < IT_WOUT) { const int kb = r / 64, nb = r % 64;
            tr_item(KIN(I_WOUT) + (size_t)l * D * D, D, nb * 32, 32, (bf16*)(KWS + WS_WOUT) + (size_t)l * D * D, D, nb * 32, kb * 64, scr, F.lane); continue; }
        r -= IT_WOUT;
        if (r < IT_WGU) { const int e = r / 1024, q = r % 1024, kb = q / 32, nb = q % 32;
            tr_item(KIN(I_WGU) + ((size_t)l * NE + e) * D * 1024, 1024, nb * 32, 32, (bf16*)(KWS + WS_WGU) + ((size_t)l * NE + e) * 1024 * D, D, nb * 32, kb * 64, scr, F.lane); continue; }
        r -= IT_WGU;
        { const int e = r / 512, q = r % 512, kb = q / 64, nb = q % 64;
            tr_item(KIN(I_WDN) + ((size_t)l * NE + e) * FF * D, D, nb * 32, 32, (bf16*)(KWS + WS_WDN) + ((size_t)l * NE + e) * D * FF, FF, nb * 32, kb * 64, scr, F.lane); }
    }
}

template <int MODE> __device__ __forceinline__ void phase_norm1(Frame& F, const float* xin, const bf16* contrib, float* xout, const float* gain, bf16* H) {
    for (int t = F.gw; t < T; t += F.NGW) {
        const f32x4* xr = (const f32x4*)(xin + (size_t)t * D) + F.lane;
        f32x4 v[8]; float ss = 0.f;
#pragma unroll
        for (int j = 0; j < 8; ++j) { v[j] = xr[64 * j];
            if (MODE != 0) { const u32x2 c0 = *((const u32x2*)(contrib + (size_t)(2 * t) * D) + F.lane + 64 * j), c1 = *((const u32x2*)(contrib + (size_t)(2 * t + 1) * D) + F.lane + 64 * j);
                v[j].x += bflo(c0.x) + bflo(c1.x); v[j].y += bfhi(c0.x) + bfhi(c1.x); v[j].z += bflo(c0.y) + bflo(c1.y); v[j].w += bfhi(c0.y) + bfhi(c1.y);
                *((f32x4*)(xout + (size_t)t * D) + F.lane + 64 * j) = v[j]; }
            ss += v[j].x * v[j].x + v[j].y * v[j].y + v[j].z * v[j].z + v[j].w * v[j].w; }
        if (MODE != 2) {
            const float rstd = 1.0f / sqrtf(wave_sum(ss) * (1.0f / D) + EPS);
#pragma unroll
            for (int j = 0; j < 8; ++j) { const f32x4 g = *((const f32x4*)gain + F.lane + 64 * j);
                u32x2 o; o.x = pk2(v[j].x * rstd * g.x, v[j].y * rstd * g.y); o.y = pk2(v[j].z * rstd * g.z, v[j].w * rstd * g.w);
                *((u32x2*)(H + (size_t)t * D) + F.lane + 64 * j) = o; }
        }
    }
}

__device__ __forceinline__ void phase_prep(Frame& F, int l) {
    KA;
    const bf16* P = (const bf16*)(KWS + WS_P);
    float* QN = (float*)(KWS + WS_QN); float* KV = (float*)(KWS + WS_KV);
    const float* qg = KIN(I_QN) + l * 64; const float* kg = KIN(I_KN) + l * 192;
    for (int it = F.gw; it < T * 20; it += F.NGW) {
        const int t = it / 20, v = it % 20;
        float x = bf2f(P[(size_t)t * NPAD + v * 64 + F.lane]);
        const bool isq = v < 8, nk1 = (v == 12 || v == 13), nk2 = (v == 16 || v == 17);
        if (isq || nk1 || nk2) { const float ss = wave_sum(x * x); const float g = isq ? qg[F.lane] : (nk1 ? kg[64 + F.lane] : kg[128 + F.lane]); x = x * (1.0f / sqrtf(ss * (1.0f / 64.0f) + EPS)) * g; }
        if (isq) QN[((size_t)v * T + t) * 64 + F.lane] = x;
        else { const int w = v - 8, tens = w >> 1, g = w & 1; KV[(size_t)tens * KV_STRIDE + ((size_t)g * T + t) * 64 + F.lane] = x; }
    }
}
__device__ __forceinline__ float gelu_tanh(float x) { const float u = 0.7978845608028654f * (x + 0.044715f * x * x * x); return 0.5f * x * (1.0f + tanhf(u)); }
__device__ __forceinline__ void phase_compress(Frame& F, int l) {
    KA;
    LAS float* av = (LAS float*)(F.lds + F.wave * 16384);
    const float* KV = (const float*)(KWS + WS_KV); float* KC = (float*)(KWS + WS_KC);
    for (int it = F.gw; it < 2 * 2 * 511; it += F.NGW) {
        const int kind = it / 1022, q = it % 1022, g = q / 511, n = q % 511;
        const float* src = KV + (size_t)kind * KV_STRIDE + ((size_t)g * T + 16 * n) * 64;
        const float* pe = KIN(I_PE) + ((size_t)l * 2 + kind) * 2048;
        const float* w1 = KIN(I_W1) + ((size_t)l * 2 + kind) * 2048 * 64;
        const float* w2 = KIN(I_W2) + ((size_t)l * 2 + kind) * 64 * 64;
#pragma unroll 4
        for (int c = 0; c < 32; ++c) av[c * 64 + F.lane] = src[c * 64 + F.lane] + pe[c * 64 + F.lane];
        WSYNC();
        float acc = 0.f;
#pragma unroll 8
        for (int i = 0; i < 2048; ++i) acc += av[i] * w1[i * 64 + F.lane];
        const float hid = gelu_tanh(acc);
        WSYNC();
        av[F.lane] = hid;
        WSYNC();
        float o = 0.f;
#pragma unroll 8
        for (int i = 0; i < 64; ++i) o += av[i] * w2[i * 64 + F.lane];
        WSYNC();
        if (kind == 0) { const float ss = wave_sum(o * o); o = o * (1.0f / sqrtf(ss * (1.0f / 64.0f) + EPS)) * KIN(I_KN)[l * 192 + F.lane]; }
        KC[(size_t)kind * (2 * 512 * 64) + ((size_t)g * 512 + n) * 64 + F.lane] = o;
    }
}
__device__ __forceinline__ void phase_recur(Frame& F, int l) {
    KA;
    const bf16* P = (const bf16*)(KWS + WS_P); float* ORAW = (float*)(KWS + WS_ORAW);
    for (int it = F.gw; it < 1024; it += F.NGW) {
        const int kind = it >> 9, head = (it >> 7) & 3, j = it & 127;
        if (kind == 0) {
            const int d0 = F.lane, d1 = F.lane + 64;
            const float* lbl = KIN(I_LB);
            float lb0, lb1;
            { const float a0 = lbl[head * 128 + d0], b0 = lbl[512 + head * 128 + d0], a1 = lbl[head * 128 + d1], b1 = lbl[512 + head * 128 + d1];
              lb0 = l == 0 ? 0.f : 1.0f / (1.0f + expf(a0 - b0)); lb1 = l == 0 ? 0.f : 1.0f / (1.0f + expf(a1 - b1)); }
            const bf16* Pq = P + C_HQ + head * 128; const bf16* Pf = P + C_HF + head * 128; const bf16* Pi = P + C_HI + head * 128 + j;
            float S0 = 0.f, S1 = 0.f;
            for (int t0 = 0; t0 < T; t0 += 8) {
                bf16 zq0[8], zq1[8], zf0[8], zf1[8], vi[8];
#pragma unroll
                for (int u = 0; u < 8; ++u) { const size_t row = (size_t)(t0 + u) * NPAD; zq0[u] = Pq[row + d0]; zq1[u] = Pq[row + d1]; zf0[u] = Pf[row + d0]; zf1[u] = Pf[row + d1]; vi[u] = Pi[row]; }
                float part[8];
#pragma unroll
                for (int u = 0; u < 8; ++u) { const float v = bf2f(vi[u]);
                    const float s0 = sigmoidf_(bf2f(zf0[u])), s1 = sigmoidf_(bf2f(zf1[u]));
                    const float f0 = lb0 + (1.0f - lb0) * s0, f1 = lb1 + (1.0f - lb1) * s1;
                    const float k0 = (1.0f - lb0) * (1.0f - s0), k1 = (1.0f - lb1) * (1.0f - s1);
                    S0 = f0 * S0 + k0 * v; S1 = f1 * S1 + k1 * v;
                    part[u] = bf2f(zq0[u]) * S0 + bf2f(zq1[u]) * S1; }
                float mine = 0.f;
#pragma unroll
                for (int u = 0; u < 8; ++u) { const float s = wave_sum(part[u]); mine = (F.lane == u) ? s : mine; }
                if (F.lane < 8) ORAW[(size_t)(t0 + F.lane) * 1024 + head * 128 + j] = mine;
            }
        } else {
            const int d = F.lane, c = head * 64 + d;
            float wa[16];
#pragma unroll
            for (int r = 0; r < 16; ++r) wa[r] = KIN(I_WA2)[((size_t)l * 16 + r) * 256 + c];
            const float ba = KIN(I_BA)[l * 256 + c];
            const bf16* Pq = P + C_GQ + c; const bf16* Pk = P + C_GK + c; const bf16* Pv = P + C_GV + head * 128 + j; const bf16* Pa = P + C_GA;
            float S = 0.f;
            for (int t0 = 0; t0 < T; t0 += 8) {
                bf16 zq[8], zk[8], zv[8]; u32x4 ga0[8], ga1[8];
#pragma unroll
                for (int u = 0; u < 8; ++u) { const size_t row = (size_t)(t0 + u) * NPAD; zq[u] = Pq[row]; zk[u] = Pk[row]; zv[u] = Pv[row]; ga0[u] = *(const u32x4*)(Pa + row); ga1[u] = *(const u32x4*)(Pa + row + 8); }
                float part[8];
#pragma unroll
                for (int u = 0; u < 8; ++u) {
                    float a = ba;
                    a += bflo(ga0[u].x) * wa[0] + bfhi(ga0[u].x) * wa[1] + bflo(ga0[u].y) * wa[2] + bfhi(ga0[u].y) * wa[3] + bflo(ga0[u].z) * wa[4] + bfhi(ga0[u].z) * wa[5] + bflo(ga0[u].w) * wa[6] + bfhi(ga0[u].w) * wa[7];
                    a += bflo(ga1[u].x) * wa[8] + bfhi(ga1[u].x) * wa[9] + bflo(ga1[u].y) * wa[10] + bfhi(ga1[u].y) * wa[11] + bflo(ga1[u].z) * wa[12] + bfhi(ga1[u].z) * wa[13] + bflo(ga1[u].w) * wa[14] + bfhi(ga1[u].w) * wa[15];
                    const float ls = fminf(a, 0.f) - log1pf(expf(-fabsf(a)));
                    const float f = expf(ls * (1.0f / 16.0f));
                    S = f * S + bf2f(zk[u]) * bf2f(zv[u]);
                    part[u] = bf2f(zq[u]) * 0.125f * S; }
                float mine = 0.f;
#pragma unroll
                for (int u = 0; u < 8; ++u) { const float s = wave_sum(part[u]); mine = (F.lane == u) ? s : mine; }
                if (F.lane < 8) ORAW[(size_t)(t0 + F.lane) * 1024 + 512 + head * 128 + j] = mine;
            }
        }
    }
}
__device__ __forceinline__ void phase_recur_out(Frame& F, int l) {
    KA;
    const bf16* P = (const bf16*)(KWS + WS_P); const float* ORAW = (const float*)(KWS + WS_ORAW); bf16* OCAT = (bf16*)(KWS + WS_OCAT);
    for (int it = F.gw; it < T * 8; it += F.NGW) {
        const int t = it >> 3, kind = (it >> 2) & 1, head = it & 3;
        const float* gn = (kind == 0 ? KIN(I_HGN) : KIN(I_GLAN)) + l * 128;
        const int cg = (kind == 0 ? C_HG : C_GR) + head * 128;
        const float r0 = ORAW[(size_t)t * 1024 + kind * 512 + head * 128 + F.lane], r1 = ORAW[(size_t)t * 1024 + kind * 512 + head * 128 + 64 + F.lane];
        const float rstd = 1.0f / sqrtf(wave_sum(r0 * r0 + r1 * r1) * (1.0f / 128.0f) + EPS);
        const float g0 = bf2f(P[(size_t)t * NPAD + cg + F.lane]), g1 = bf2f(P[(size_t)t * NPAD + cg + 64 + F.lane]);
        const float a0 = kind == 0 ? sigmoidf_(g0) : g0 * sigmoidf_(g0), a1 = kind == 0 ? sigmoidf_(g1) : g1 * sigmoidf_(g1);
        OCAT[(size_t)t * 1536 + 512 + kind * 512 + head * 128 + F.lane] = (bf16)f2bf(r0 * rstd * gn[F.lane] * a0);
        OCAT[(size_t)t * 1536 + 512 + kind * 512 + head * 128 + 64 + F.lane] = (bf16)f2bf(r1 * rstd * gn[64 + F.lane] * a1);
    }
}


template <int KIND> struct RecCfg { static constexpr int DK = KIND == 0 ? 128 : 64, NSEG = 512 / DK, TPS = 64 / NSEG, QROW = (DK + 8) * 2; };
constexpr int REC_VT_OFF = 0;
constexpr int REC_KD_OFF = 18432;
constexpr int REC_QS_OFF = 36864;
constexpr int REC_KS_OFF = 54272;
constexpr int REC_QD_OFF = 71680;
constexpr int REC_RED_OFF = 89088;
constexpr int REC_TOT_OFF = 91136;
__device__ __forceinline__ float expc(float x2) { return __builtin_amdgcn_exp2f(fminf(x2, 110.0f)); }
template <int KIND> __device__ __forceinline__ void rec_elem(KArgs* ka, int l, int head, int chunk, int tid, LAS float* tot,
        float (&qv)[RecCfg<KIND>::TPS], float (&kv)[RecCfg<KIND>::TPS], float (&bv)[RecCfg<KIND>::TPS], float& bend, float& bref) {
    constexpr int DK = RecCfg<KIND>::DK, NSEG = RecCfg<KIND>::NSEG, TPS = RecCfg<KIND>::TPS;
    const int d = tid % DK, seg = tid / DK, t0 = chunk * 64 + seg * TPS;
    const bf16* P = (const bf16*)(KWS + WS_P);
    float run = 0.f;
    if (KIND == 0) {
        const int c = head * 128 + d;
        float lb = 0.f;
        if (l > 0) { const float a0 = KIN(I_LB)[c], b0 = KIN(I_LB)[512 + c]; lb = 1.0f / (1.0f + expf(a0 - b0)); }
        const float omlb = 1.0f - lb;
        unsigned zr[TPS], qr[TPS];
#pragma unroll
        for (int u = 0; u < TPS; ++u) { const size_t row = (size_t)(t0 + u) * NPAD; zr[u] = P[row + C_HF + c]; qr[u] = P[row + C_HQ + c]; }
#pragma unroll
        for (int u = 0; u < TPS; ++u) {
            const float z = bf2f(zr[u]); qv[u] = bf2f(qr[u]);
            const float e = __builtin_amdgcn_exp2f(-LOG2E * z), sg = __builtin_amdgcn_rcpf(1.0f + e), f = fmaf(omlb, sg, lb);
            kv[u] = omlb * (e * sg);
            run += __builtin_amdgcn_logf(fmaxf(f, 1e-30f)); bv[u] = run; }
    } else {
        const int c = head * 64 + d;
        float wa[16];
#pragma unroll
        for (int r = 0; r < 16; ++r) wa[r] = KIN(I_WA2)[((size_t)l * 16 + r) * 256 + c];
        const float ba = KIN(I_BA)[l * 256 + c];
        u32x4 g0r[TPS], g1r[TPS]; unsigned qr[TPS], kr[TPS];
#pragma unroll
        for (int u = 0; u < TPS; ++u) { const size_t row = (size_t)(t0 + u) * NPAD; g0r[u] = *(const u32x4*)(P + row + C_GA); g1r[u] = *(const u32x4*)(P + row + C_GA + 8); qr[u] = P[row + C_GQ + c]; kr[u] = P[row + C_GK + c]; }
#pragma unroll
        for (int u = 0; u < TPS; ++u) { const u32x4 g0 = g0r[u], g1 = g1r[u];
            float a = ba;
            a += bflo(g0.x) * wa[0] + bfhi(g0.x) * wa[1] + bflo(g0.y) * wa[2] + bfhi(g0.y) * wa[3] + bflo(g0.z) * wa[4] + bfhi(g0.z) * wa[5] + bflo(g0.w) * wa[6] + bfhi(g0.w) * wa[7];
            a += bflo(g1.x) * wa[8] + bfhi(g1.x) * wa[9] + bflo(g1.y) * wa[10] + bfhi(g1.y) * wa[11] + bflo(g1.z) * wa[12] + bfhi(g1.z) * wa[13] + bflo(g1.w) * wa[14] + bfhi(g1.w) * wa[15];
            const float ls2 = fminf(a, 0.f) * LOG2E - __builtin_amdgcn_logf(1.0f + __builtin_amdgcn_exp2f(-LOG2E * fabsf(a)));
            qv[u] = bf2f(qr[u]) * 0.125f; kv[u] = bf2f(kr[u]);
            run += ls2 * (1.0f / 16.0f); bv[u] = run; }
    }
    tot[seg * DK + d] = run;
    __syncthreads();
    float off = 0.f; bend = 0.f; bref = 0.f;
#pragma unroll
    for (int sgi = 0; sgi < NSEG; ++sgi) { const float v = tot[sgi * DK + d]; off += sgi < seg ? v : 0.f; bref += sgi < NSEG / 2 ? v : 0.f; bend += v; }
#pragma unroll
    for (int u = 0; u < TPS; ++u) bv[u] += off;
}
template <int KIND> __device__ __forceinline__ void rec_vt_load(KArgs* ka, int head, int chunk, int tid, unsigned (&w)[8]) {
    const bf16* P = (const bf16*)(KWS + WS_P) + (KIND == 0 ? C_HI : C_GV) + head * 128;
    const int v = tid & 127, sv = tid >> 7;
#pragma unroll
    for (int u = 0; u < 8; ++u) { const unsigned a = P[(size_t)(chunk * 64 + sv * 16 + 2 * u) * NPAD + v], b = P[(size_t)(chunk * 64 + sv * 16 + 2 * u + 1) * NPAD + v]; w[u] = a | (b << 16); }
}
__device__ __forceinline__ void rec_vt_store(int tid, LAS unsigned char* lds, const unsigned (&w)[8]) {
    const int v = tid & 127, sv = tid >> 7;
    LAS u32x4* dst = (LAS u32x4*)(lds + REC_VT_OFF + v * 144 + sv * 32);
    dst[0] = (u32x4){w[0], w[1], w[2], w[3]}; dst[1] = (u32x4){w[4], w[5], w[6], w[7]};
}
template <int KIND> __device__ __forceinline__ void rec_local_unit(KArgs* ka, Frame& F, int l, int head, int chunk) {
    constexpr int DK = RecCfg<KIND>::DK, TPS = RecCfg<KIND>::TPS;
    LAS unsigned char* lds = F.lds; LAS float* tot = (LAS float*)(lds + REC_TOT_OFF);
    float qv[TPS], kv[TPS], bv[TPS], bend, bref;
    unsigned vraw[8];
    rec_vt_load<KIND>(ka, head, chunk, F.tid, vraw);
    rec_elem<KIND>(ka, l, head, chunk, F.tid, tot, qv, kv, bv, bend, bref);
    const int d = F.tid % DK, seg = F.tid / DK, unit = chunk * 4 + head;
    { unsigned w[TPS / 2];
#pragma unroll
      for (int u = 0; u < TPS / 2; ++u) w[u] = pkbf(kv[2 * u] * expc(bend - bv[2 * u]), kv[2 * u + 1] * expc(bend - bv[2 * u + 1]));
      LAS u32x4* dst = (LAS u32x4*)(lds + REC_KD_OFF + d * 144 + seg * TPS * 2);
      dst[0] = (u32x4){w[0], w[1], w[2], w[3]};
      if constexpr (TPS == 16) dst[1] = (u32x4){w[4], w[5], w[6], w[7]}; }
    if (seg == 0) ((float*)(KWS + WS_DEC + (KIND == 0 ? 0 : 262144)))[(size_t)unit * DK + d] = __builtin_amdgcn_exp2f(bend);
    rec_vt_store(F.tid, lds, vraw);
    __syncthreads();
    const int r = F.lane & 15, kq = F.lane >> 4;
    const int dt = KIND == 0 ? F.wave : (F.wave & 3), vt0 = KIND == 0 ? 0 : (F.wave >> 2) * 4, nvt = KIND == 0 ? 8 : 4;
    bf16x8 a[2];
#pragma unroll
    for (int ks = 0; ks < 2; ++ks) a[ks] = *(const LAS bf16x8*)(lds + REC_KD_OFF + (16 * dt + r) * 144 + (32 * ks + 8 * kq) * 2);
    float* Sl = (float*)(KWS + (KIND == 0 ? WS_SLOC_HG : WS_SLOC_GL)) + (size_t)unit * 128 * DK;
#pragma unroll
    for (int vi = 0; vi < nvt; ++vi) { const int vt = vt0 + vi; f32x4 acc = {0.f, 0.f, 0.f, 0.f};
#pragma unroll
        for (int ks = 0; ks < 2; ++ks) { const bf16x8 b = *(const LAS bf16x8*)(lds + REC_VT_OFF + (16 * vt + r) * 144 + (32 * ks + 8 * kq) * 2); acc = __builtin_amdgcn_mfma_f32_16x16x32_bf16(a[ks], b, acc, 0, 0, 0); }
        *(f32x4*)(Sl + (size_t)(16 * vt + r) * DK + 16 * dt + 4 * kq) = acc; }
    __syncthreads();
}
__device__ __forceinline__ void phase_rec_local(Frame& F, int l) {
    KA;
    for (int it = F.bid; it < 1024; it += F.G) { const int kind = it >> 9, chunk = (it >> 2) & 127, head = it & 3;
        if (kind == 0) rec_local_unit<0>(ka, F, l, head, chunk); else rec_local_unit<1>(ka, F, l, head, chunk); }
}
__device__ __forceinline__ void phase_rec_scan(Frame& F) {
    KA;
    const int gt = F.bid * 512 + F.tid;
    if (gt >= 49152) return;
    const bool hg = gt < 32768; const int q = hg ? gt : gt - 32768;
    const int DK = hg ? 128 : 64, dp = q % (DK / 2), v = (q / (DK / 2)) & 127, head = q / (DK / 2 * 128);
    const float* Sl = (const float*)(KWS + (hg ? WS_SLOC_HG : WS_SLOC_GL)) + ((size_t)head * 128 + v) * DK + 2 * dp;
    bf16* Sp = (bf16*)(KWS + (hg ? WS_SPREV_HG : WS_SPREV_GL)) + ((size_t)head * 128 + v) * DK + 2 * dp;
    const float* De = (const float*)(KWS + WS_DEC + (hg ? 0 : 262144)) + (size_t)head * DK + 2 * dp;
    const size_t ustr = (size_t)4 * 128 * DK, dstr = (size_t)4 * DK;
    float s0 = 0.f, s1 = 0.f;
    for (int c0 = 0; c0 < NCH; c0 += 8) { f32x2 x[8], dc[8];
#pragma unroll
        for (int u = 0; u < 8; ++u) { x[u] = *(const f32x2*)(Sl + (size_t)(c0 + u) * ustr); dc[u] = *(const f32x2*)(De + (size_t)(c0 + u) * dstr); }
#pragma unroll
        for (int u = 0; u < 8; ++u) { *(unsigned*)(Sp + (size_t)(c0 + u) * ustr) = pk2(s0, s1); s0 = dc[u].x * s0 + x[u].x; s1 = dc[u].y * s1 + x[u].y; } }
}
template <int KIND> __device__ __forceinline__ void rec_out_unit(KArgs* ka, Frame& F, int l, int head, int chunk) {
    constexpr int DK = RecCfg<KIND>::DK, TPS = RecCfg<KIND>::TPS, QROW = RecCfg<KIND>::QROW, NKS = DK / 32;
    LAS unsigned char* lds = F.lds; LAS float* tot = (LAS float*)(lds + REC_TOT_OFF); LAS float* red = (LAS float*)(lds + REC_RED_OFF);
    const int r = F.lane & 15, kq = F.lane >> 4, unit = chunk * 4 + head, vt = F.wave;
    bf16x8 sa[NKS];
    { const bf16* Sp = (const bf16*)(KWS + (KIND == 0 ? WS_SPREV_HG : WS_SPREV_GL)) + (size_t)unit * 128 * DK + (size_t)(16 * vt + r) * DK + 8 * kq;
#pragma unroll
      for (int ks = 0; ks < NKS; ++ks) sa[ks] = *(const bf16x8*)(Sp + 32 * ks); }
    float qv[TPS], kv[TPS], bv[TPS], bend, bref;
    unsigned vraw[8];
    rec_vt_load<KIND>(ka, head, chunk, F.tid, vraw);
    const bf16* P = (const bf16*)(KWS + WS_P); bf16* OCAT = (bf16*)(KWS + WS_OCAT);
    const int v0 = 16 * vt + 4 * kq;
    const f32x4 gn = *(const f32x4*)((KIND == 0 ? KIN(I_HGN) : KIN(I_GLAN)) + l * 128 + v0);
    u32x2 gq4[4];
#pragma unroll
    for (int it = 0; it < 4; ++it) gq4[it] = *(const u32x2*)(P + (size_t)(chunk * 64 + 16 * it + r) * NPAD + (KIND == 0 ? C_HG : C_GR) + head * 128 + v0);
    rec_elem<KIND>(ka, l, head, chunk, F.tid, tot, qv, kv, bv, bend, bref);
    { const int d = F.tid % DK, seg = F.tid / DK; const float eref = __builtin_amdgcn_exp2f(fmaxf(bref, -120.f));
#pragma unroll
      for (int u = 0; u < TPS; u += 2) { const int o = (seg * TPS + u) * QROW + d * 2;
          const float x0 = __builtin_amdgcn_exp2f(fminf(fmaxf(bv[u] - bref, -110.f), 110.f)), x1 = __builtin_amdgcn_exp2f(fminf(fmaxf(bv[u + 1] - bref, -110.f), 110.f));
          const float qs0 = qv[u] * x0, qs1 = qv[u + 1] * x1;
          const unsigned w0 = pkbf(qs0, qs1), w1 = pkbf(kv[u] * __builtin_amdgcn_rcpf(x0), kv[u + 1] * __builtin_amdgcn_rcpf(x1)), w2 = pkbf(qs0 * eref, qs1 * eref);
          *(LAS bf16*)(lds + REC_QS_OFF + o) = (bf16)w0; *(LAS bf16*)(lds + REC_QS_OFF + o + QROW) = (bf16)(w0 >> 16);
          *(LAS bf16*)(lds + REC_KS_OFF + o) = (bf16)w1; *(LAS bf16*)(lds + REC_KS_OFF + o + QROW) = (bf16)(w1 >> 16);
          *(LAS bf16*)(lds + REC_QD_OFF + o) = (bf16)w2; *(LAS bf16*)(lds + REC_QD_OFF + o + QROW) = (bf16)(w2 >> 16); } }
    rec_vt_store(F.tid, lds, vraw);
    __syncthreads();
#pragma unroll
    for (int tt = 0; tt < 2; ++tt) { const int tile = F.wave * 2 + tt, jt = tile >> 2, it = tile & 3; f32x4 acc = {0.f, 0.f, 0.f, 0.f};
        if (jt <= it) {
#pragma unroll
            for (int ks = 0; ks < NKS; ++ks) { const bf16x8 a = *(const LAS bf16x8*)(lds + REC_KS_OFF + (16 * jt + r) * QROW + (32 * ks + 8 * kq) * 2), b = *(const LAS bf16x8*)(lds + REC_QS_OFF + (16 * it + r) * QROW + (32 * ks + 8 * kq) * 2);
                acc = __builtin_amdgcn_mfma_f32_16x16x32_bf16(a, b, acc, 0, 0, 0); } }
        const int i = 16 * it + r, j0 = 16 * jt + 4 * kq;
        u32x2 w; w.x = pk2(j0 <= i ? acc[0] : 0.f, j0 + 1 <= i ? acc[1] : 0.f); w.y = pk2(j0 + 2 <= i ? acc[2] : 0.f, j0 + 3 <= i ? acc[3] : 0.f);
        *(LAS u32x2*)(lds + REC_KD_OFF + i * 144 + j0 * 2) = w; }
    __syncthreads();
    f32x4 acc[4];
#pragma unroll
    for (int it = 0; it < 4; ++it) acc[it] = (f32x4){0.f, 0.f, 0.f, 0.f};
#pragma unroll
    for (int ks = 0; ks < 2; ++ks) { const bf16x8 a = *(const LAS bf16x8*)(lds + REC_VT_OFF + (16 * vt + r) * 144 + (32 * ks + 8 * kq) * 2);
#pragma unroll
        for (int it = 0; it < 4; ++it) { const bf16x8 b = *(const LAS bf16x8*)(lds + REC_KD_OFF + (16 * it + r) * 144 + (32 * ks + 8 * kq) * 2); acc[it] = __builtin_amdgcn_mfma_f32_16x16x32_bf16(a, b, acc[it], 0, 0, 0); } }
#pragma unroll
    for (int ks = 0; ks < NKS; ++ks) {
#pragma unroll
        for (int it = 0; it < 4; ++it) { const bf16x8 b = *(const LAS bf16x8*)(lds + REC_QD_OFF + (16 * it + r) * QROW + (32 * ks + 8 * kq) * 2); acc[it] = __builtin_amdgcn_mfma_f32_16x16x32_bf16(sa[ks], b, acc[it], 0, 0, 0); } }
#pragma unroll
    for (int it = 0; it < 4; ++it) { float ss = acc[it][0] * acc[it][0] + acc[it][1] * acc[it][1] + acc[it][2] * acc[it][2] + acc[it][3] * acc[it][3];
        ss += __shfl_xor(ss, 16); ss += __shfl_xor(ss, 32);
        if (kq == 0) red[F.wave * 64 + 16 * it + r] = ss; }
    __syncthreads();
#pragma unroll
    for (int it = 0; it < 4; ++it) { const int i = 16 * it + r, t = chunk * 64 + i; float tot_ = 0.f;
#pragma unroll
        for (int w = 0; w < 8; ++w) tot_ += red[w * 64 + i];
        const float rstd = 1.0f / sqrtf(tot_ * (1.0f / 128.0f) + EPS);
        const u32x2 gq = gq4[it];
        float gt[4] = {bflo(gq.x), bfhi(gq.x), bflo(gq.y), bfhi(gq.y)}, o[4];
#pragma unroll
        for (int e = 0; e < 4; ++e) { const float sg = fsig(gt[e]); o[e] = acc[it][e] * rstd * gn[e] * (KIND == 0 ? sg : gt[e] * sg); }
        u32x2 w; w.x = pkbf(o[0], o[1]); w.y = pkbf(o[2], o[3]);
        *(u32x2*)(OCAT + (size_t)t * 1536 + 512 + KIND * 512 + head * 128 + v0) = w; }
    __syncthreads();
}
__device__ __forceinline__ void phase_rec_out(Frame& F, int l) {
    KA;
    for (int it = F.bid; it < 1024; it += F.G) { const int kind = it >> 9, chunk = (it >> 2) & 127, head = it & 3;
        if (kind == 0) rec_out_unit<0>(ka, F, l, head, chunk); else rec_out_unit<1>(ka, F, l, head, chunk); }
}

template <bool WIN> __device__ __forceinline__ void nsa_block(const float* Kg, const float* Vg, int j, int t, int lane, const LAS float* qs, LAS float* pb, const float (&slope)[4], float (&M)[4], float (&L)[4], float (&o)[4]) {
    const int pos = 64 * j + lane, dist = t - pos;
    const bool valid = WIN ? (dist >= 0 && dist < 512) : (dist >= 0);
    float dot[4] = {0.f, 0.f, 0.f, 0.f};
    const f32x4* kr = (const f32x4*)(Kg + (size_t)pos * 64);
#pragma unroll 2
    for (int c = 0; c < 16; ++c) { const f32x4 kv = kr[c];
#pragma unroll
        for (int r = 0; r < 4; ++r) { const f32x4 qv = *(const LAS f32x4*)(qs + r * 64 + c * 4); dot[r] += kv.x * qv.x + kv.y * qv.y + kv.z * qv.z + kv.w * qv.w; } }
#pragma unroll
    for (int r = 0; r < 4; ++r) {
        const float s = valid ? dot[r] * 0.125f - slope[r] * (float)dist : NEGB;
        const float nm = fmaxf(M[r], wave_max(s)), sc = expf(M[r] - nm), p = valid ? expf(s - nm) : 0.f;
        L[r] = L[r] * sc + wave_sum(p); o[r] *= sc; M[r] = nm; pb[r * 64 + lane] = p;
    }
    WSYNC();
#pragma unroll 4
    for (int k = 0; k < 64; ++k) { const float v = Vg[(size_t)(64 * j + k) * 64 + lane];
#pragma unroll
        for (int r = 0; r < 4; ++r) o[r] += pb[r * 64 + k] * v; }
    WSYNC();
}
__device__ __forceinline__ void phase_nsa(Frame& F, int l) {
    KA;
    LAS float* qs = (LAS float*)(F.lds + F.wave * 8192);
    LAS float* pbuf = qs + 256;
    LAS float* scb = pbuf + 512;
    LAS float* pb = scb + 128;
    LAS float* impb = pb + 256;
    LAS float* ocb = impb + 512;
    const bf16* P = (const bf16*)(KWS + WS_P); bf16* OCAT = (bf16*)(KWS + WS_OCAT);
    const float* QN = (const float*)(KWS + WS_QN); const float* KV = (const float*)(KWS + WS_KV); const float* KC = (const float*)(KWS + WS_KC);
    const int lane = F.lane;
    for (int it = F.gw; it < T * 2; it += F.NGW) {
        const int t = it >> 1, g = it & 1;
        float slope[4];
#pragma unroll
        for (int r = 0; r < 4; ++r) { slope[r] = exp2f(-(float)(g * 4 + r + 1)); qs[r * 64 + lane] = QN[((size_t)(g * 4 + r) * T + t) * 64 + lane]; }
        WSYNC();
        int nvis = t >= 31 ? (t - 31) / 16 + 1 : 0; nvis = nvis > 511 ? 511 : nvis;
        const float* KCg = KC + (size_t)g * 512 * 64; const float* VCg = KC + (size_t)(2 * 512 * 64) + (size_t)g * 512 * 64;
#pragma unroll 1
        for (int i = 0; i < 8; ++i) impb[lane + 64 * i] = 0.f;
#pragma unroll 1
        for (int r = 0; r < 4; ++r) {
            const float sl = exp2f(-(float)(g * 4 + r + 1));
            float mx = NEGB;
#pragma unroll 1
            for (int i = 0; i < 8; ++i) { const int n = lane + 64 * i; float sv = NEGB;
                if (n < nvis) { const f32x4* kr = (const f32x4*)(KCg + (size_t)n * 64); float dot = 0.f;
#pragma unroll 4
                    for (int c = 0; c < 16; ++c) { const f32x4 kv = kr[c]; const f32x4 qv = *(const LAS f32x4*)(qs + r * 64 + c * 4); dot += kv.x * qv.x + kv.y * qv.y + kv.z * qv.z + kv.w * qv.w; }
                    sv = dot * 0.125f - sl * (float)(t - 16 * n - 31); }
                pbuf[n] = sv; mx = fmaxf(mx, sv); }
            mx = wave_max(mx);
            float sum = 0.f;
#pragma unroll 1
            for (int i = 0; i < 8; ++i) { const int n = lane + 64 * i; const float e = n < nvis ? expf(pbuf[n] - mx) : 0.f; pbuf[n] = e; sum += e; }
            sum = wave_sum(sum);
            const float inv = nvis > 0 ? 1.0f / sum : 0.f;
#pragma unroll 1
            for (int i = 0; i < 8; ++i) { const int n = lane + 64 * i; const float p = pbuf[n] * inv; pbuf[n] = p; impb[n] += p; }
            WSYNC();
            float oc = 0.f;
#pragma unroll 4
            for (int n = 0; n < nvis; ++n) oc += pbuf[n] * VCg[(size_t)n * 64 + lane];
            ocb[r * 64 + lane] = oc;
            WSYNC();
        }
        const int cur = t >> 6;
        float sc2[2];
#pragma unroll
        for (int jj = 0; jj < 2; ++jj) { const int j = lane + 64 * jj;
            float v = (j > 0 ? impb[4 * j - 1] : 0.f) + 2.0f * (impb[4 * j] + impb[4 * j + 1] + impb[4 * j + 2]) + impb[4 * j + 3];
            if (j == 0 || j == cur || j == cur - 1) v = 1e4f;
            if (j > cur) v = -1.0f;
            sc2[jj] = v; scb[j] = v; }
        WSYNC();
        unsigned long long msk[2];
#pragma unroll
        for (int jj = 0; jj < 2; ++jj) { const int j = lane + 64 * jj; int rank = 0;
#pragma unroll 4
            for (int i = 0; i < 128; ++i) { const float si = scb[i]; rank += (si > sc2[jj] || (si == sc2[jj] && i < j)) ? 1 : 0; }
            msk[jj] = __ballot(rank < 16); }
        WSYNC();
        float M[4], L[4], os[4], ow[4];
#pragma unroll
        for (int r = 0; r < 4; ++r) { M[r] = NEGB; L[r] = 0.f; os[r] = 0.f; }
        { const float* Kg = KV + 2 * KV_STRIDE + (size_t)g * T * 64; const float* Vg = KV + 3 * KV_STRIDE + (size_t)g * T * 64;
#pragma unroll 1
          for (int j = 0; j <= cur; ++j) { const bool sel = ((j < 64 ? msk[0] >> j : msk[1] >> (j - 64)) & 1ull) != 0ull; if (sel) nsa_block<false>(Kg, Vg, j, t, lane, qs, pb, slope, M, L, os); } }
#pragma unroll
        for (int r = 0; r < 4; ++r) { os[r] = os[r] / L[r]; M[r] = NEGB; L[r] = 0.f; ow[r] = 0.f; }
        { const float* Kg = KV + 4 * KV_STRIDE + (size_t)g * T * 64; const float* Vg = KV + 5 * KV_STRIDE + (size_t)g * T * 64;
          const int j0 = t >= 511 ? (t - 511) >> 6 : 0;
#pragma unroll 1
          for (int j = j0; j <= cur; ++j) nsa_block<true>(Kg, Vg, j, t, lane, qs, pb, slope, M, L, ow); }
#pragma unroll
        for (int r = 0; r < 4; ++r) { const int h = g * 4 + r;
            const float g0 = sigmoidf_(bf2f(P[(size_t)t * NPAD + C_NG + h])), g1 = sigmoidf_(bf2f(P[(size_t)t * NPAD + C_NG + 8 + h])), g2 = sigmoidf_(bf2f(P[(size_t)t * NPAD + C_NG + 16 + h]));
            OCAT[(size_t)t * 1536 + h * 64 + lane] = (bf16)f2bf(g0 * ocb[r * 64 + lane] + g1 * os[r] + g2 * (ow[r] / L[r])); }
        WSYNC();
    }
}

typedef float f32x16 __attribute__((ext_vector_type(16)));
constexpr float NSA_SHIFT2 = 8.0f;
__device__ __forceinline__ int perm16(int b) { return (b & 3) | ((b & 4) << 1) | ((b & 8) >> 1); }
__device__ __forceinline__ void phase_prep2(Frame& F, int l) {
    KA;
    const bf16* P = (const bf16*)(KWS + WS_P);
    bf16* QS = (bf16*)(KWS + WS_QS); bf16* KS2 = (bf16*)(KWS + WS_KS2); bf16* KW2 = (bf16*)(KWS + WS_KW2);
    const float* qg = KIN(I_QN) + l * 64; const float* kg = KIN(I_KN) + l * 192;
    for (int it = F.gw; it < T * 12; it += F.NGW) {
        const int t = it / 12, v = it % 12;
        const int col = v < 8 ? v * 64 : (v < 10 ? C_KS + (v - 8) * 64 : C_KW + (v - 10) * 64);
        float x = bf2f(P[(size_t)t * NPAD + col + F.lane]);
        const float ss = wave_sum(x * x);
        const float g = v < 8 ? qg[F.lane] * (0.125f * LOG2E) : (v < 10 ? kg[64 + F.lane] : kg[128 + F.lane]);
        x = x * (1.0f / sqrtf(ss * (1.0f / 64.0f) + EPS)) * g;
        bf16* dst = v < 8 ? QS + ((size_t)v * T + t) * 64 : (v < 10 ? KS2 + ((size_t)(v - 8) * T + t) * 64 : KW2 + ((size_t)(v - 10) * T + t) * 64);
        dst[F.lane] = (bf16)f2bf(x);
    }
    LAS bf16* tile = (LAS bf16*)(F.lds + F.wave * 16384);
    for (int it = F.gw; it < 2 * 2 * (T / 64); it += F.NGW) {
        const int kind = it / (2 * (T / 64)), q = it % (2 * (T / 64)), g = q / (T / 64), tb = q % (T / 64);
        const bf16* src = P + (size_t)(tb * 64) * NPAD + (kind == 0 ? C_VS : C_VW) + g * 64;
        bf16* dst = (bf16*)(KWS + (kind == 0 ? WS_VST : WS_VWT)) + (size_t)g * 64 * T + tb * 64;
#pragma unroll 4
        for (int r = 0; r < 64; ++r) tile[r * 66 + F.lane] = src[(size_t)r * NPAD + F.lane];
        WSYNC();
        const int pl = (F.lane & ~15) | perm16(F.lane & 15);
#pragma unroll 4
        for (int d = 0; d < 64; ++d) dst[(size_t)d * T + pl] = tile[F.lane * 66 + d];
        WSYNC();
    }
}

__device__ __forceinline__ void phase_prep3(Frame& F, int l) {
    KA;
    const bf16* P = (const bf16*)(KWS + WS_P);
    bf16* QS = (bf16*)(KWS + WS_QS); bf16* KS2 = (bf16*)(KWS + WS_KS2); bf16* KW2 = (bf16*)(KWS + WS_KW2);
    const float* qg = KIN(I_QN) + l * 64; const float* kg = KIN(I_KN) + l * 192;
    const int vec = F.lane >> 3, part = F.lane & 7;
    for (int t = F.gw; t < T; t += F.NGW) {
#pragma unroll
        for (int pass = 0; pass < 2; ++pass) {
            if (pass == 1 && vec >= 4) continue;
            const int col = pass == 0 ? vec * 64 : (vec < 2 ? C_KS + vec * 64 : C_KW + (vec - 2) * 64);
            const float* gp = pass == 0 ? qg : (vec < 2 ? kg + 64 : kg + 128);
            const float gs = pass == 0 ? 0.125f * LOG2E : 1.0f;
            bf16* dst = pass == 0 ? QS + ((size_t)vec * T + t) * 64 : (vec < 2 ? KS2 + ((size_t)vec * T + t) * 64 : KW2 + ((size_t)(vec - 2) * T + t) * 64);
            const u32x4 raw = *(const u32x4*)(P + (size_t)t * NPAD + col + part * 8);
            float x[8] = {bflo(raw.x), bfhi(raw.x), bflo(raw.y), bfhi(raw.y), bflo(raw.z), bfhi(raw.z), bflo(raw.w), bfhi(raw.w)};
            float ss = 0.f;
#pragma unroll
            for (int e = 0; e < 8; ++e) ss += x[e] * x[e];
            ss += __shfl_xor(ss, 1); ss += __shfl_xor(ss, 2); ss += __shfl_xor(ss, 4);
            const float rstd = gs / sqrtf(ss * (1.0f / 64.0f) + EPS);
            const f32x4 g0 = *(const f32x4*)(gp + part * 8), g1 = *(const f32x4*)(gp + part * 8 + 4);
            u32x4 o; o.x = pk2(x[0] * rstd * g0.x, x[1] * rstd * g0.y); o.y = pk2(x[2] * rstd * g0.z, x[3] * rstd * g0.w); o.z = pk2(x[4] * rstd * g1.x, x[5] * rstd * g1.y); o.w = pk2(x[6] * rstd * g1.z, x[7] * rstd * g1.w);
            *(u32x4*)(dst + part * 8) = o;
        }
    }
    LAS bf16* tile = (LAS bf16*)(F.lds + F.wave * 16384);
    for (int it = F.gw; it < 2 * 2 * (T / 64); it += F.NGW) {
        const int kind = it / (2 * (T / 64)), q = it % (2 * (T / 64)), g = q / (T / 64), tb = q % (T / 64);
        const bf16* src = P + (size_t)(tb * 64) * NPAD + (kind == 0 ? C_VS : C_VW) + g * 64;
        bf16* dst = (bf16*)(KWS + (kind == 0 ? WS_VST : WS_VWT)) + (size_t)g * 64 * T + tb * 64;
#pragma unroll
        for (int i = 0; i < 8; ++i) { const int tok = vec + 8 * i; *(LAS u32x4*)(tile + tok * 72 + part * 8) = *(const u32x4*)(src + (size_t)tok * NPAD + part * 8); }
        WSYNC();
#pragma unroll
        for (int c = 0; c < 8; ++c) { unsigned w[4];
#pragma unroll
            for (int k = 0; k < 4; ++k) { const int p0 = (c & 1) * 8 + 2 * k, p1 = p0 + 1;
                const int k0 = (c >> 1) * 16 + ((p0 & 3) | ((p0 & 4) << 1) | ((p0 & 8) >> 1)), k1 = (c >> 1) * 16 + ((p1 & 3) | ((p1 & 4) << 1) | ((p1 & 8) >> 1));
                w[k] = (unsigned)tile[k0 * 72 + F.lane] | ((unsigned)tile[k1 * 72 + F.lane] << 16); }
            *(u32x4*)(dst + (size_t)F.lane * T + c * 8) = (u32x4){w[0], w[1], w[2], w[3]}; }
        WSYNC();
    }
}

__device__ __forceinline__ void phase_compress2(Frame& F, int l) {
    KA;
    LAS float* av = (LAS float*)(F.lds + F.wave * 16384);
    const bf16* P = (const bf16*)(KWS + WS_P);
    bf16* KCB = (bf16*)(KWS + WS_KCB); bf16* VCT = (bf16*)(KWS + WS_KCB + 131072);
    for (int it = F.gw; it < 2 * 2 * 512; it += F.NGW) {
        const int kind = it >> 10, g = (it >> 9) & 1, n = it & 511;
        if (n == 511) { if (kind == 0) KCB[((size_t)g * 512 + 511) * 64 + F.lane] = 0; else VCT[((size_t)g * 64 + F.lane) * 512 + 511] = 0; continue; }
        const bf16* src = P + (size_t)(16 * n) * NPAD + (kind == 0 ? C_KC : C_VC) + g * 64;
        const float* pe = KIN(I_PE) + ((size_t)l * 2 + kind) * 2048;
        const float* w1 = KIN(I_W1) + ((size_t)l * 2 + kind) * 2048 * 64;
        const float* w2 = KIN(I_W2) + ((size_t)l * 2 + kind) * 64 * 64;
#pragma unroll 4
        for (int c = 0; c < 32; ++c) av[c * 64 + F.lane] = bf2f(src[(size_t)c * NPAD + F.lane]) + pe[c * 64 + F.lane];
        WSYNC();
        float acc = 0.f;
#pragma unroll 8
        for (int i = 0; i < 2048; ++i) acc += av[i] * w1[i * 64 + F.lane];
        const float hid = gelu_tanh(acc);
        WSYNC();
        av[F.lane] = hid;
        WSYNC();
        float o = 0.f;
#pragma unroll 8
        for (int i = 0; i < 64; ++i) o += av[i] * w2[i * 64 + F.lane];
        WSYNC();
        if (kind == 0) { const float ss = wave_sum(o * o); o = o * (1.0f / sqrtf(ss * (1.0f / 64.0f) + EPS)) * KIN(I_KN)[l * 192 + F.lane]; KCB[((size_t)g * 512 + n) * 64 + F.lane] = (bf16)f2bf(o); }
        else VCT[((size_t)g * 64 + F.lane) * 512 + ((n & ~15) | perm16(n & 15))] = (bf16)f2bf(o);
    }
}

__device__ __forceinline__ void phase_compress3(Frame& F, int l) {
    KA;
    const bf16* P = (const bf16*)(KWS + WS_P);
    bf16* KCB = (bf16*)(KWS + WS_KCB); bf16* VCT = (bf16*)(KWS + WS_KCB + 131072);
    LAS float* red = (LAS float*)F.lds;
    LAS bf16* hid = (LAS bf16*)(F.lds + 32768);
    const int r16 = F.lane & 15, kq = F.lane >> 4;
    for (int unit = F.bid; unit < 128; unit += F.G) {
        const int kind = unit >> 6, mt = unit & 63, g = mt >> 5, n0 = (mt & 31) * 16;
        const bf16* W1T = (const bf16*)(KWS + WS_CW) + (size_t)(l * 2 + kind) * 64 * 2048; const bf16* W2T = (const bf16*)(KWS + WS_CW + 1048576) + (size_t)(l * 2 + kind) * 4096;
        const float* B1 = (const float*)(KWS + WS_CW + 1572864) + (l * 2 + kind) * 64;
        const bf16* arow = P + (size_t)(16 * (n0 + r16)) * NPAD + (kind == 0 ? C_KC : C_VC) + g * 64;
        f32x4 acc[4];
#pragma unroll
        for (int nt = 0; nt < 4; ++nt) acc[nt] = (f32x4){0.f, 0.f, 0.f, 0.f};
#pragma unroll 2
        for (int ks = 0; ks < 8; ++ks) { const int c0 = F.wave * 256 + 32 * ks + 8 * kq;
            const bf16x8 a = *(const bf16x8*)(arow + (size_t)(c0 >> 6) * NPAD + (c0 & 63));
#pragma unroll
            for (int nt = 0; nt < 4; ++nt) { const bf16x8 b = *(const bf16x8*)(W1T + (size_t)(16 * nt + r16) * 2048 + c0); acc[nt] = __builtin_amdgcn_mfma_f32_16x16x32_bf16(a, b, acc[nt], 0, 0, 0); } }
#pragma unroll
        for (int nt = 0; nt < 4; ++nt) *(LAS f32x4*)(red + ((F.wave * 4 + nt) * 64 + F.lane) * 4) = acc[nt];
        __syncthreads();
        if (F.tid < 256) { const int nt = F.tid >> 6, ln = F.tid & 63; f32x4 v = {0.f, 0.f, 0.f, 0.f};
#pragma unroll
            for (int w = 0; w < 8; ++w) v += *(const LAS f32x4*)(red + ((w * 4 + nt) * 64 + ln) * 4);
            const int col = 16 * nt + (ln & 15); const float b1 = B1[col];
#pragma unroll
            for (int i = 0; i < 4; ++i) hid[(4 * (ln >> 4) + i) * 72 + col] = (bf16)f2bf(gelu_tanh(v[i] + b1)); }
        __syncthreads();
        if (F.wave == 0) {
            f32x4 o[4];
#pragma unroll
            for (int nt = 0; nt < 4; ++nt) o[nt] = (f32x4){0.f, 0.f, 0.f, 0.f};
#pragma unroll
            for (int ks = 0; ks < 2; ++ks) { const bf16x8 a = *(const LAS bf16x8*)(hid + r16 * 72 + 32 * ks + 8 * kq);
#pragma unroll
                for (int nt = 0; nt < 4; ++nt) { const bf16x8 b = *(const bf16x8*)(W2T + (16 * nt + r16) * 64 + 32 * ks + 8 * kq); o[nt] = __builtin_amdgcn_mfma_f32_16x16x32_bf16(a, b, o[nt], 0, 0, 0); } }
            if (kind == 0) {
#pragma unroll
                for (int i = 0; i < 4; ++i) { float ss = o[0][i] * o[0][i] + o[1][i] * o[1][i] + o[2][i] * o[2][i] + o[3][i] * o[3][i];
                    ss += __shfl_xor(ss, 1); ss += __shfl_xor(ss, 2); ss += __shfl_xor(ss, 4); ss += __shfl_xor(ss, 8);
                    const float rstd = 1.0f / sqrtf(ss * (1.0f / 64.0f) + EPS); const int n = n0 + 4 * kq + i;
#pragma unroll
                    for (int nt = 0; nt < 4; ++nt) { const int col = 16 * nt + r16; KCB[((size_t)g * 512 + n) * 64 + col] = n < 511 ? (bf16)f2bf(o[nt][i] * rstd * KIN(I_KN)[l * 192 + col]) : (bf16)0; } }
            } else {
#pragma unroll
                for (int i = 0; i < 4; ++i) { const int n = n0 + 4 * kq + i;
#pragma unroll
                    for (int nt = 0; nt < 4; ++nt) { const int col = 16 * nt + r16; VCT[((size_t)g * 64 + col) * 512 + ((n & ~15) | perm16(n & 15))] = n < 511 ? (bf16)f2bf(o[nt][i]) : (bf16)0; } }
            }
        }
        __syncthreads();
    }
}

constexpr int NSA_SCA = 65536, NSA_SCB = 99328;
constexpr int NSA_QM = 133120, NSA_UM = 134144;
static_assert(NSA_UM + 16 <= MISC_OFF, "NSA LDS map");
__device__ __forceinline__ int next_set(unsigned long long m0, unsigned long long m1, int from) {
    if (from < 64) { const unsigned long long x = m0 & (~0ull << from); if (x) return __builtin_ctzll(x); from = 64; }
    if (from < 128) { const unsigned long long x = m1 & (~0ull << (from - 64)); if (x) return 64 + __builtin_ctzll(x); }
    return 128;
}
__device__ __forceinline__ void nsa_issue(LAS unsigned char* lds, int slot, const bf16* Kg, const bf16* VTg, int vt_len, int j, int tid, int wave) {
    const int row = tid >> 3, c = (tid & 7) ^ ((row >> 1) & 7);
    __builtin_amdgcn_global_load_lds((const unsigned*)(Kg + (size_t)(64 * j + row) * 64 + c * 8), (LAS unsigned*)(lds + slot * 16384 + wave * 1024), 16, 0, 0);
    __builtin_amdgcn_global_load_lds((const unsigned*)(VTg + (size_t)row * vt_len + 64 * j + c * 8), (LAS unsigned*)(lds + slot * 16384 + 8192 + wave * 1024), 16, 0, 0);
}
template <int MODE> __device__ __forceinline__ void nsa_branch(Frame& F, const bf16* Kg, const bf16* VTg, int vt_len, unsigned long long m0, unsigned long long m1,
        const bf16x8 (&Qf)[4], int t, int cblk, float slope2, float inv_l, const unsigned (&qsel)[4], int hi_cmp, unsigned wm_lo_dummy, f32x16 (&oacc)[2], float& lsum) {
    LAS unsigned char* lds = F.lds;
    const int lane = F.lane, c32 = lane & 31, h = lane >> 5, tid = F.tid;
    const int sw = (c32 >> 1) & 7;
    int j0 = next_set(m0, m1, 0);
    if (j0 >= 128) return;
    int j1 = next_set(m0, m1, j0 + 1), j2 = j1 < 128 ? next_set(m0, m1, j1 + 1) : 128;
    nsa_issue(lds, 0, Kg, VTg, vt_len, j0, tid, F.wave);
    if (j1 < 128) nsa_issue(lds, 1, Kg, VTg, vt_len, j1, tid, F.wave);
    if (j2 < 128) nsa_issue(lds, 2, Kg, VTg, vt_len, j2, tid, F.wave);
    int slot = 0;
    const float kslope2 = (MODE < 2) ? 16.0f * slope2 : slope2;
    const float qpos = (MODE < 2) ? (float)(t - 31) : (float)t;
    while (j0 < 128) {
        const int j = j0;
        if (j2 < 128) asm volatile("s_waitcnt vmcnt(4)" ::: "memory"); else if (j1 < 128) asm volatile("s_waitcnt vmcnt(2)" ::: "memory"); else asm volatile("s_waitcnt vmcnt(0)" ::: "memory");
        __builtin_amdgcn_s_barrier(); asm volatile("" ::: "memory");
        const int j3 = j2 < 128 ? next_set(m0, m1, j2 + 1) : 128;
        if (j3 < 128) nsa_issue(lds, (slot + 3) & 3, Kg, VTg, vt_len, j3, tid, F.wave);
        bool need = true;
        if (MODE == 2) { const unsigned myw = j < 32 ? qsel[0] : (j < 64 ? qsel[1] : (j < 96 ? qsel[2] : qsel[3])); need = __any((myw >> (j & 31)) & 1u); }
        if (need) {
            const int kb = slot * 16384, vb = slot * 16384 + 8192;
            const int kbase = 64 * j;
            float lb2 = -slope2 * qpos + kslope2 * (float)(kbase + 4 * h) - NSA_SHIFT2;
            if (MODE == 2) { const unsigned myw = j < 32 ? qsel[0] : (j < 64 ? qsel[1] : (j < 96 ? qsel[2] : qsel[3])); if (!((myw >> (j & 31)) & 1u)) lb2 = -1e30f; }
            f32x16 sacc[2];
#pragma unroll
            for (int sub = 0; sub < 2; ++sub)
#pragma unroll
                for (int i = 0; i < 16; ++i) sacc[sub][i] = fmaf(kslope2, (float)(32 * sub + (i & 3) + 8 * (i >> 2)), lb2);
#pragma unroll
            for (int sub = 0; sub < 2; ++sub) {
#pragma unroll
                for (int kp = 0; kp < 2; ++kp) { bf16x8 ka2[2];
#pragma unroll
                    for (int k2 = 0; k2 < 2; ++k2) ka2[k2] = *(const LAS bf16x8*)(lds + kb + (32 * sub + c32) * 128 + (((2 * (2 * kp + k2) + h) ^ sw) * 16));
                    asm volatile("" ::: "memory");
#pragma unroll
                    for (int k2 = 0; k2 < 2; ++k2) sacc[sub] = __builtin_amdgcn_mfma_f32_32x32x16_bf16(ka2[k2], Qf[2 * kp + k2], sacc[sub], 0, 0, 0);
                    asm volatile("" ::: "memory"); } }
#pragma unroll
            for (int sub = 0; sub < 2; ++sub)
#pragma unroll
                for (int i = 0; i < 16; ++i) sacc[sub][i] = __builtin_amdgcn_exp2f(sacc[sub][i]);
            bool mhi = false, mlo = false; int hi = 0, lo = 0;
            if (MODE < 2) { mhi = true; hi = hi_cmp; }
            if (MODE == 2) { mhi = (j == cblk); hi = t; }
            if (MODE == 3) { mhi = (j == cblk); hi = t; mlo = (j == cblk - 8); lo = t - 511; }
            if (mhi || mlo) {
#pragma unroll
                for (int sub = 0; sub < 2; ++sub)
#pragma unroll
                    for (int i = 0; i < 16; ++i) { const int idx = kbase + 4 * h + 32 * sub + (i & 3) + 8 * (i >> 2); if ((mhi && idx > hi) || (mlo && idx < lo)) sacc[sub][i] = 0.f; }
            }
            float ls = 0.f;
#pragma unroll
            for (int sub = 0; sub < 2; ++sub)
#pragma unroll
                for (int i = 0; i < 16; ++i) ls += sacc[sub][i];
            lsum += ls;
            if (MODE == 1) {
                LAS float* scA = (LAS float*)(lds + NSA_SCA); LAS float* scB = (LAS float*)(lds + NSA_SCB);
                const int q = F.wave * 8 + (c32 >> 2);
#pragma unroll
                for (int sub = 0; sub < 2; ++sub)
#pragma unroll
                    for (int g4 = 0; g4 < 4; ++g4) { float x[4];
#pragma unroll
                        for (int e = 0; e < 4; ++e) { float v = sacc[sub][4 * g4 + e] * inv_l; v += __shfl_xor(v, 1); v += __shfl_xor(v, 2); x[e] = v; }
                        const int jb = 16 * j + 8 * sub + 2 * g4 + h;
                        if ((c32 & 3) == 0) { scA[q * 132 + jb] = 2.0f * (x[0] + x[1] + x[2]) + x[3]; scB[q * 132 + jb + 1] = x[3]; } }
            }
            if (MODE != 0) {
                bf16x8 pf[2][2];
#pragma unroll
                for (int sub = 0; sub < 2; ++sub)
#pragma unroll
                    for (int s2 = 0; s2 < 2; ++s2) { u32x4 w; w.x = pkbf(sacc[sub][8 * s2], sacc[sub][8 * s2 + 1]); w.y = pkbf(sacc[sub][8 * s2 + 2], sacc[sub][8 * s2 + 3]); w.z = pkbf(sacc[sub][8 * s2 + 4], sacc[sub][8 * s2 + 5]); w.w = pkbf(sacc[sub][8 * s2 + 6], sacc[sub][8 * s2 + 7]);
                        pf[sub][s2] = __builtin_bit_cast(bf16x8, w); }
                asm volatile("" ::: "memory");
#pragma unroll
                for (int ds = 0; ds < 2; ++ds) {
#pragma unroll
                    for (int qp = 0; qp < 2; ++qp) { bf16x8 va2[2];
#pragma unroll
                        for (int k2 = 0; k2 < 2; ++k2) va2[k2] = *(const LAS bf16x8*)(lds + vb + (32 * ds + c32) * 128 + (((2 * (2 * qp + k2) + h) ^ sw) * 16));
                        asm volatile("" ::: "memory");
#pragma unroll
                        for (int k2 = 0; k2 < 2; ++k2) oacc[ds] = __builtin_amdgcn_mfma_f32_32x32x16_bf16(va2[k2], pf[qp][k2], oacc[ds], 0, 0, 0);
                        asm volatile("" ::: "memory"); } }
            }
        }
        j0 = j1; j1 = j2; j2 = j3; slot = (slot + 1) & 3;
    }
    asm volatile("s_waitcnt lgkmcnt(0)" ::: "memory"); __builtin_amdgcn_s_barrier(); asm volatile("" ::: "memory");
}
__device__ __forceinline__ void nsa_stash_put(LAS unsigned char* lds, int wave, int lane, const f32x16 (&o)[2], float sc) {
    LAS unsigned* st = (LAS unsigned*)(lds + NSA_SCA) + wave * 1024 + lane;
#pragma unroll
    for (int ds = 0; ds < 2; ++ds)
#pragma unroll
        for (int k = 0; k < 8; ++k) st[(ds * 8 + k) * 64] = pkbf(o[ds][2 * k] * sc, o[ds][2 * k + 1] * sc);
}
__device__ __forceinline__ void phase_nsa2(Frame& F, int l) {
    KA;
    LAS unsigned char* lds = F.lds;
    const bf16* P = (const bf16*)(KWS + WS_P); bf16* OCAT = (bf16*)(KWS + WS_OCAT);
    const bf16* QS = (const bf16*)(KWS + WS_QS);
    const int lane = F.lane, c32 = lane & 31, h = lane >> 5, q8 = c32 >> 2, r = c32 & 3;
    for (int unit = F.bid; unit < 256; unit += F.G) {
        const int g = unit & 1, cblk = unit >> 1, t0 = cblk * 64, head = g * 4 + r, t = t0 + F.wave * 8 + q8;
        const float slope2 = exp2f(-(float)(head + 1)) * LOG2E;
        bf16x8 Qf[4];
#pragma unroll
        for (int ks = 0; ks < 4; ++ks) Qf[ks] = *(const bf16x8*)(QS + ((size_t)head * T + t) * 64 + 16 * ks + 8 * h);
        for (int u = F.tid; u < (NSA_UM + 16 - NSA_SCA) / 4; u += 512) ((LAS unsigned*)(lds + NSA_SCA))[u] = 0u;
        __syncthreads();
        f32x16 oacc[2];
#pragma unroll
        for (int ds = 0; ds < 2; ++ds)
#pragma unroll
            for (int i = 0; i < 16; ++i) oacc[ds][i] = 0.f;
        unsigned qsel[4] = {0u, 0u, 0u, 0u};
        float sc_cmp;
        {
            const int ntile = (4 * cblk + 2) / 64 + 1;
            const unsigned long long cm0 = ntile >= 64 ? ~0ull : ((1ull << ntile) - 1ull);
            const int hi_cmp = t >= 31 ? (t - 31) / 16 : -1;
            const bf16* Kg = (const bf16*)(KWS + WS_KCB) + (size_t)g * 512 * 64; const bf16* VTg = (const bf16*)(KWS + WS_KCB + 131072) + (size_t)g * 64 * 512;
            float l1 = 0.f;
            nsa_branch<0>(F, Kg, VTg, 512, cm0, 0ull, Qf, t, cblk, slope2, 0.f, qsel, hi_cmp, 0u, oacc, l1);
            l1 += __shfl_xor(l1, 32);
            const float inv_l = l1 > 0.f ? 1.0f / l1 : 0.f;
            float l2 = 0.f;
            nsa_branch<1>(F, Kg, VTg, 512, cm0, 0ull, Qf, t, cblk, slope2, inv_l, qsel, hi_cmp, 0u, oacc, l2);
            sc_cmp = sigmoidf_(bf2f(P[(size_t)t * NPAD + C_NG + head])) * inv_l;
        }
        {
            LAS float* scA = (LAS float*)(lds + NSA_SCA); LAS float* scB = (LAS float*)(lds + NSA_SCB);
            LAS unsigned* qm = (LAS unsigned*)(lds + NSA_QM); LAS unsigned* um = (LAS unsigned*)(lds + NSA_UM);
            WSYNC();
            const int qq = F.wave * 8 + (lane >> 3), jj = lane & 7;
            unsigned key[16];
#pragma unroll
            for (int m = 0; m < 16; ++m) { const int jb = jj + 8 * m; float sv = scA[qq * 132 + jb] + scB[qq * 132 + jb];
                if (jb == 0 || jb == cblk || jb == cblk - 1) sv = 1e4f;
                key[m] = (__builtin_bit_cast(unsigned, sv) & ~127u) | (unsigned)(127 - jb); }
            WSYNC();
#pragma unroll
            for (int m = 0; m < 16; ++m) ((LAS unsigned*)scA)[qq * 132 + jj + 8 * m] = key[m];
            WSYNC();
            unsigned bits[4] = {0u, 0u, 0u, 0u};
#pragma unroll
            for (int half = 0; half < 2; ++half) { int rank[8];
#pragma unroll
                for (int m = 0; m < 8; ++m) rank[m] = 0;
#pragma unroll 2
                for (int i = 0; i <= cblk; ++i) { const unsigned ki = ((const LAS unsigned*)scA)[qq * 132 + i];
#pragma unroll
                    for (int m = 0; m < 8; ++m) rank[m] += ki > key[8 * half + m] ? 1 : 0; }
#pragma unroll
                for (int m = 0; m < 8; ++m) { const int jb = jj + 8 * (8 * half + m); if (jb <= cblk && rank[m] < 16) bits[(8 * half + m) >> 2] |= 1u << (jb & 31); } }
#pragma unroll
            for (int w = 0; w < 4; ++w) if (bits[w]) { atomicOr((unsigned*)(qm + qq * 4 + w), bits[w]); atomicOr((unsigned*)(um + w), bits[w]); }
            __syncthreads();
#pragma unroll
            for (int w = 0; w < 4; ++w) qsel[w] = qm[(F.wave * 8 + q8) * 4 + w];
        }
        nsa_stash_put(lds, F.wave, lane, oacc, sc_cmp);
#pragma unroll
        for (int ds = 0; ds < 2; ++ds)
#pragma unroll
            for (int i = 0; i < 16; ++i) oacc[ds][i] = 0.f;
        {
            LAS unsigned* um = (LAS unsigned*)(lds + NSA_UM);
            const unsigned long long sm0 = (unsigned long long)__builtin_amdgcn_readfirstlane(um[0]) | ((unsigned long long)__builtin_amdgcn_readfirstlane(um[1]) << 32);
            const unsigned long long sm1 = (unsigned long long)__builtin_amdgcn_readfirstlane(um[2]) | ((unsigned long long)__builtin_amdgcn_readfirstlane(um[3]) << 32);
            float ls = 0.f;
            nsa_branch<2>(F, (const bf16*)(KWS + WS_KS2) + (size_t)g * T * 64, (const bf16*)(KWS + WS_VST) + (size_t)g * 64 * T, T, sm0, sm1, Qf, t, cblk, slope2, 0.f, qsel, 0, 0u, oacc, ls);
            ls += __shfl_xor(ls, 32);
            const float sc = sigmoidf_(bf2f(P[(size_t)t * NPAD + C_NG + 8 + head])) / ls;
            LAS unsigned* st = (LAS unsigned*)(lds + NSA_SCA) + F.wave * 1024 + lane;
#pragma unroll
            for (int ds = 0; ds < 2; ++ds)
#pragma unroll
                for (int k = 0; k < 8; ++k) { const unsigned w = st[(ds * 8 + k) * 64]; st[(ds * 8 + k) * 64] = pkbf(bflo(w) + sc * oacc[ds][2 * k], bfhi(w) + sc * oacc[ds][2 * k + 1]); oacc[ds][2 * k] = 0.f; oacc[ds][2 * k + 1] = 0.f; }
        }
        {
            const int j0 = cblk >= 8 ? cblk - 8 : 0;
            unsigned long long wm0 = 0ull, wm1 = 0ull;
            for (int jb = j0; jb <= cblk; ++jb) { if (jb < 64) wm0 |= 1ull << jb; else wm1 |= 1ull << (jb - 64); }
            float ls = 0.f;
            nsa_branch<3>(F, (const bf16*)(KWS + WS_KW2) + (size_t)g * T * 64, (const bf16*)(KWS + WS_VWT) + (size_t)g * 64 * T, T, wm0, wm1, Qf, t, cblk, slope2, 0.f, qsel, 0, 0u, oacc, ls);
            ls += __shfl_xor(ls, 32);
            const float sc = sigmoidf_(bf2f(P[(size_t)t * NPAD + C_NG + 16 + head])) / ls;
            const LAS unsigned* st = (const LAS unsigned*)(lds + NSA_SCA) + F.wave * 1024 + lane;
#pragma unroll
            for (int ds = 0; ds < 2; ++ds)
#pragma unroll
                for (int g4 = 0; g4 < 4; ++g4) { const unsigned w0 = st[(ds * 8 + 2 * g4) * 64], w1 = st[(ds * 8 + 2 * g4 + 1) * 64];
                    u32x2 w; w.x = pkbf(bflo(w0) + sc * oacc[ds][4 * g4], bfhi(w0) + sc * oacc[ds][4 * g4 + 1]); w.y = pkbf(bflo(w1) + sc * oacc[ds][4 * g4 + 2], bfhi(w1) + sc * oacc[ds][4 * g4 + 3]);
                    *(u32x2*)(OCAT + (size_t)t * 1536 + head * 64 + 32 * ds + 8 * g4 + 4 * h) = w; }
        }
        __syncthreads();
    }
}

__device__ __forceinline__ void phase_merge(Frame& F) {
    KA;
    const bf16* P = (const bf16*)(KWS + WS_P); const bf16* PROJ = (const bf16*)(KWS + WS_PROJ); bf16* MG = (bf16*)(KWS + WS_MERGED);
    const size_t total = (size_t)T * D / 8;
    for (size_t it = (size_t)F.gw * 64 + F.lane; it < total; it += (size_t)F.NGW * 64) {
        const size_t t = it / (D / 8); const int d = (int)(it % (D / 8)) * 8;
        float acc[8];
#pragma unroll
        for (int k = 0; k < 8; ++k) acc[k] = 0.f;
#pragma unroll
        for (int n = 0; n < 3; ++n) { const u32x4 gq = *(const u32x4*)(P + t * NPAD + C_MG + n * D + d); const u32x4 pq = *(const u32x4*)(PROJ + ((size_t)n * T + t) * D + d);
            acc[0] += sigmoidf_(bflo(gq.x)) * bflo(pq.x); acc[1] += sigmoidf_(bfhi(gq.x)) * bfhi(pq.x); acc[2] += sigmoidf_(bflo(gq.y)) * bflo(pq.y); acc[3] += sigmoidf_(bfhi(gq.y)) * bfhi(pq.y);
            acc[4] += sigmoidf_(bflo(gq.z)) * bflo(pq.z); acc[5] += sigmoidf_(bfhi(gq.z)) * bfhi(pq.z); acc[6] += sigmoidf_(bflo(gq.w)) * bflo(pq.w); acc[7] += sigmoidf_(bfhi(gq.w)) * bfhi(pq.w); }
        u32x4 o; o.x = pk2(acc[0], acc[1]); o.y = pk2(acc[2], acc[3]); o.z = pk2(acc[4], acc[5]); o.w = pk2(acc[6], acc[7]);
        *(u32x4*)(MG + t * D + d) = o;
    }
}
__device__ __forceinline__ void phase_router(Frame& F, int l) {
    KA;
    const float* X1 = (const float*)(KWS + WS_X1); bf16* H = (bf16*)(KWS + WS_H);
    int* EID = (int*)(KWS + WS_ROUTE); float* EW = (float*)(KWS + WS_ROUTE + 65536);
    const float* gain = KIN(I_NFFN) + (size_t)l * D; const float* wg = KIN(I_WGRP) + (size_t)l * D * 4; const float* we = KIN(I_WEXP) + (size_t)l * D * 32;
    const float* bg = KIN(I_BGRP) + l * 4; const float* be = KIN(I_BEXP) + l * 32;
    for (int t = F.gw; t < T; t += F.NGW) {
        const float* xrow = X1 + (size_t)t * D;
        float ss = 0.f;
#pragma unroll 4
        for (int k = 0; k < 32; ++k) { const float x = xrow[F.lane + 64 * k]; ss += x * x; }
        const float rstd = 1.0f / sqrtf(wave_sum(ss) * (1.0f / D) + EPS);
        float ag[4] = {0.f, 0.f, 0.f, 0.f}, ae[32];
#pragma unroll
        for (int e = 0; e < 32; ++e) ae[e] = 0.f;
#pragma unroll 1
        for (int k = 0; k < 32; ++k) { const int d = F.lane + 64 * k;
            const float hv = xrow[d] * rstd * gain[d];
            H[(size_t)t * D + d] = (bf16)f2bf(hv);
            const f32x4 w4 = *(const f32x4*)(wg + (size_t)d * 4);
            ag[0] += hv * w4.x; ag[1] += hv * w4.y; ag[2] += hv * w4.z; ag[3] += hv * w4.w;
#pragma unroll
            for (int c = 0; c < 8; ++c) { const f32x4 w = *(const f32x4*)(we + (size_t)d * 32 + c * 4); ae[c * 4] += hv * w.x; ae[c * 4 + 1] += hv * w.y; ae[c * 4 + 2] += hv * w.z; ae[c * 4 + 3] += hv * w.w; } }
#pragma unroll
        for (int e = 0; e < 4; ++e) ag[e] = wave_sum(ag[e]) + bg[e];
#pragma unroll
        for (int e = 0; e < 32; ++e) ae[e] = wave_sum(ae[e]) + be[e];
        int gi = 0; float gm = ag[0];
#pragma unroll
        for (int e = 1; e < 4; ++e) if (ag[e] > gm) { gm = ag[e]; gi = e; }
        float gs = 0.f;
#pragma unroll
        for (int e = 0; e < 4; ++e) gs += expf(ag[e] - gm);
        const float gw_ = 1.0f / gs;
        float el[8];
#pragma unroll
        for (int e = 0; e < 8; ++e) { el[e] = gi == 0 ? ae[e] : (gi == 1 ? ae[8 + e] : (gi == 2 ? ae[16 + e] : ae[24 + e])); }
        int i1 = 0; float m1 = el[0];
#pragma unroll
        for (int e = 1; e < 8; ++e) if (el[e] > m1) { m1 = el[e]; i1 = e; }
        int i2 = -1; float m2 = -3.0e38f;
#pragma unroll
        for (int e = 0; e < 8; ++e) if (e != i1 && el[e] > m2) { m2 = el[e]; i2 = e; }
        const float p2 = expf(m2 - m1);
        const float w1 = 1.0f / (1.0f + p2), w2 = p2 / (1.0f + p2);
        if (F.lane == 0) { EID[2 * t] = gi * 8 + i1; EID[2 * t + 1] = gi * 8 + i2; EW[2 * t] = gw_ * w1; EW[2 * t + 1] = gw_ * w2; }
    }
}

__device__ __forceinline__ void phase_router2(Frame& F, int l) {
    KA;
    const float* X1 = (const float*)(KWS + WS_X1); bf16* H = (bf16*)(KWS + WS_H);
    int* EID = (int*)(KWS + WS_ROUTE); float* EW = (float*)(KWS + WS_ROUTE + 65536); int* HIST = (int*)(KWS + WS_HIST);
    const float* WRT = (const float*)(KWS + WS_WRT) + (size_t)l * 48 * D;
    const float* gain = KIN(I_NFFN) + (size_t)l * D; const float* bg = KIN(I_BGRP) + l * 4; const float* be = KIN(I_BEXP) + l * 32;
    LAS float* red = (LAS float*)F.lds;
    LAS float* ssq = (LAS float*)(F.lds + 24576);
    LAS float* lg = (LAS float*)(F.lds + 25088);
    LAS float* rs = (LAS float*)(F.lds + 30208);
    LAS int* eidl = (LAS int*)(F.lds + 30336);
    const int r16 = F.lane & 15, kq = F.lane >> 4, tg = F.wave >> 2, kq4 = F.wave & 3;
    for (int blk = F.bid; blk < T / 32; blk += F.G) {
        const int tok0 = blk * 32;
        const float* xa = X1 + (size_t)(tok0 + 16 * tg + r16) * D + kq4 * 512 + 4 * kq;
        const float* wb = WRT + (size_t)r16 * D + kq4 * 512 + 4 * kq;
        f32x4 acc[3]; float sq = 0.f;
#pragma unroll
        for (int nt = 0; nt < 3; ++nt) acc[nt] = (f32x4){0.f, 0.f, 0.f, 0.f};
#pragma unroll 2
        for (int s = 0; s < 32; ++s) { const f32x4 a = *(const f32x4*)(xa + 16 * s);
            f32x4 b[3];
#pragma unroll
            for (int nt = 0; nt < 3; ++nt) b[nt] = *(const f32x4*)(wb + (size_t)(16 * nt) * D + 16 * s);
            sq += a.x * a.x + a.y * a.y + a.z * a.z + a.w * a.w;
#pragma unroll
            for (int j = 0; j < 4; ++j)
#pragma unroll
                for (int nt = 0; nt < 3; ++nt) acc[nt] = __builtin_amdgcn_mfma_f32_16x16x4f32(a[j], b[nt][j], acc[nt], 0, 0, 0); }
        sq += __shfl_xor(sq, 16); sq += __shfl_xor(sq, 32);
#pragma unroll
        for (int nt = 0; nt < 3; ++nt) *(LAS f32x4*)(red + ((F.wave * 3 + nt) * 64 + F.lane) * 4) = acc[nt];
        if (kq == 0) ssq[F.wave * 16 + r16] = sq;
        __syncthreads();
        if (F.tid < 384) { const int tg2 = F.tid / 192, rem = F.tid % 192, nt = rem / 64, ln = rem % 64; f32x4 v = {0.f, 0.f, 0.f, 0.f};
#pragma unroll
            for (int q = 0; q < 4; ++q) v += *(const LAS f32x4*)(red + (((tg2 * 4 + q) * 3 + nt) * 64 + ln) * 4);
            const int col = 16 * nt + (ln & 15);
            if (col < 36) {
#pragma unroll
                for (int i = 0; i < 4; ++i) lg[(16 * tg2 + 4 * (ln >> 4) + i) * 40 + col] = v[i]; } }
        if (F.tid >= 384 && F.tid < 416) { const int tk = F.tid - 384, tg2 = tk >> 4, rr = tk & 15; float q2 = 0.f;
#pragma unroll
            for (int q = 0; q < 4; ++q) q2 += ssq[(tg2 * 4 + q) * 16 + rr];
            rs[tk] = 1.0f / sqrtf(q2 * (1.0f / D) + EPS); }
        __syncthreads();
        if (F.tid < 32) { const int tk = F.tid, t = tok0 + tk; const float rstd = rs[tk];
            float ag[4], el[8];
#pragma unroll
            for (int e = 0; e < 4; ++e) ag[e] = lg[tk * 40 + 32 + e] * rstd + bg[e];
            int gi = 0; float gm = ag[0];
#pragma unroll
            for (int e = 1; e < 4; ++e) if (ag[e] > gm) { gm = ag[e]; gi = e; }
            float gs = 0.f;
#pragma unroll
            for (int e = 0; e < 4; ++e) gs += expf(ag[e] - gm);
            const float gw_ = 1.0f / gs;
#pragma unroll
            for (int e = 0; e < 8; ++e) el[e] = lg[tk * 40 + gi * 8 + e] * rstd + be[gi * 8 + e];
            int i1 = 0; float m1 = el[0];
#pragma unroll
            for (int e = 1; e < 8; ++e) if (el[e] > m1) { m1 = el[e]; i1 = e; }
            int i2 = -1; float m2 = -3.0e38f;
#pragma unroll
            for (int e = 0; e < 8; ++e) if (e != i1 && el[e] > m2) { m2 = el[e]; i2 = e; }
            const float p2 = expf(m2 - m1), w1 = 1.0f / (1.0f + p2), w2 = p2 / (1.0f + p2);
            EID[2 * t] = gi * 8 + i1; EID[2 * t + 1] = gi * 8 + i2; EW[2 * t] = gw_ * w1; EW[2 * t + 1] = gw_ * w2;
            eidl[2 * tk] = gi * 8 + i1; eidl[2 * tk + 1] = gi * 8 + i2; }
        __syncthreads();
        if (F.tid < 32) { int c = 0;
#pragma unroll 8
            for (int i = 0; i < 64; ++i) c += eidl[i] == F.tid ? 1 : 0;
            HIST[blk * 32 + F.tid] = c; }
#pragma unroll 1
        for (int q = 0; q < 4; ++q) { const int tk = F.wave * 4 + q; const float rstd = rs[tk];
            const f32x4* xr = (const f32x4*)(X1 + (size_t)(tok0 + tk) * D) + F.lane;
#pragma unroll
            for (int j = 0; j < 8; ++j) { const f32x4 v = xr[64 * j]; const f32x4 g = *((const f32x4*)gain + F.lane + 64 * j);
                u32x2 o; o.x = pk2(v.x * rstd * g.x, v.y * rstd * g.y); o.y = pk2(v.z * rstd * g.z, v.w * rstd * g.w);
                *((u32x2*)(H + (size_t)(tok0 + tk) * D) + F.lane + 64 * j) = o; } }
        __syncthreads();
    }
}
__device__ __forceinline__ void phase_lists2(Frame& F) {
    KA;
    const int* EID = (const int*)(KWS + WS_ROUTE); int* CNT = (int*)(KWS + WS_ROUTE + 131072); int* LIST = (int*)(KWS + WS_ROUTE + 262144); const int* HIST = (const int*)(KWS + WS_HIST);
    LAS int* off = (LAS int*)F.lds; LAS int* eidl = off + 32;
    for (int blk = F.bid; blk < T / 32; blk += F.G) {
        if (F.tid < 32) { int a = 0;
#pragma unroll 8
            for (int b2 = 0; b2 < blk; ++b2) a += HIST[b2 * 32 + F.tid];
            off[F.tid] = a;
            if (blk == T / 32 - 1) CNT[F.tid] = a + HIST[blk * 32 + F.tid]; }
        if (F.tid >= 64 && F.tid < 128) eidl[F.tid - 64] = EID[blk * 64 + F.tid - 64];
        __syncthreads();
        if (F.tid < 64) { const int e = eidl[F.tid]; int rk = 0;
            for (int i = 0; i < F.tid; ++i) rk += eidl[i] == e ? 1 : 0;
            LIST[e * 8192 + off[e] + rk] = blk * 64 + F.tid; }
        __syncthreads();
    }
}

__device__ __forceinline__ void phase_lists(Frame& F) {
    KA;
    const int e = F.bid;
    if (e >= NE) return;
    const int* EID = (const int*)(KWS + WS_ROUTE); int* CNT = (int*)(KWS + WS_ROUTE + 131072); int* LIST = (int*)(KWS + WS_ROUTE + 262144);
    LAS int* wc = (LAS int*)F.lds;
    int run = 0;
    for (int base = 0; base < 2 * T; base += 512) {
        const int idx = base + F.tid; const bool match = EID[idx] == e;
        const unsigned long long b = __ballot(match);
        if (F.lane == 0) wc[F.wave] = __popcll(b);
        __syncthreads();
        int pre = 0, tot = 0;
#pragma unroll
        for (int w = 0; w < 8; ++w) { const int c = wc[w]; pre += w < F.wave ? c : 0; tot += c; }
        if (match) LIST[e * 8192 + run + pre + __popcll(b & ((1ull << F.lane) - 1ull))] = idx;
        run += tot;
        __syncthreads();
    }
    if (F.tid == 0) CNT[e] = run;
}
__device__ __forceinline__ void moe_table(Frame& F, LAS int* tb) {
    KA;
    const int* CNT = (const int*)(KWS + WS_ROUTE + 131072);
    if (F.tid == 0) { int a = 0, f = 0, h = 0;
        for (int e = 0; e < NE; ++e) { const int n = CNT[e], nt = (n + 255) / 256, lastv = n - (nt - 1) * 256, hh = (nt > 0 && lastv <= 128) ? 1 : 0;
            tb[e] = a; tb[33 + e] = f; tb[66 + e] = h; a += nt; f += nt - hh; h += hh; }
        tb[NE] = a; tb[33 + NE] = f; tb[66 + NE] = h; }
    __syncthreads();
}

constexpr int PH_PER_LAYER = 11, N_PHASES = 1 + NL * PH_PER_LAYER + 1;

__global__ void __launch_bounds__(512, 2) mk_fwd(Args args) {
    extern __shared__ __attribute__((aligned(16))) unsigned char lds_raw[];
#define FRAME Frame F; F.lds = (LAS unsigned char*)lds_raw; F.MISC = (volatile LAS unsigned*)(F.lds + MISC_OFF); F.tid = ltid(); F.lane = F.tid & 63; F.wave = __builtin_amdgcn_readfirstlane(F.tid >> 6); \
    F.G = gridDim.x; F.bid = lbid(); F.vcu = (F.G % 8 == 0) ? (F.bid % 8) * (F.G / 8) + F.bid / 8 : F.bid; F.gw = F.bid * 8 + F.wave; F.NGW = F.G * 8;
    unsigned* const ctl = (unsigned*)((unsigned char*)args.ws + WS_CTL);
    for (int u = threadIdx.x; u < (LDS_BYTES - MISC_OFF) / 4; u += 512) ((LAS unsigned*)(lds_raw + MISC_OFF))[u] = 0u;
    __syncthreads();
    const int lo = args.ph_lo, hi = args.ph_hi;
    XcdBarrier bar; bar.bar = ctl + CW_BAR + args.li * XCD_BAR_WORDS; bar.x = 0; bar.st = nullptr;
    if (hi - lo > 1) bar = xcd_barrier_post(ctl + CW_BAR + args.li * XCD_BAR_WORDS, (volatile LAS unsigned*)((LAS unsigned char*)lds_raw + MISC_OFF));
    int ph = 0;
#define RUN(k) ((k) >= lo && (k) < hi)
#ifndef MK_PROBE_MASK
#define MK_PROBE_MASK 0
#endif
    volatile LAS unsigned long long* const tacc = (volatile LAS unsigned long long*)((LAS unsigned char*)lds_raw + MISC_OFF + 512);
    if (MK_PROBE_MASK != 0 && blockIdx.x == 0 && threadIdx.x == 0) tacc[16] = wall_clock64();
#define STAMP(slot) do { if (MK_PROBE_MASK != 0 && lbid() == 0 && ltid() == 0) { const unsigned long long _n = wall_clock64(); tacc[slot] += _n - tacc[16]; tacc[16] = _n; } } while (0)
#define SEAM(k, slot) do { if ((k) + 1 < hi) xcd_barrier(bar); STAMP(slot); } while (0)
    LAS int* const tb = (LAS int*)((LAS unsigned char*)lds_raw + MISC_OFF + 64);

    if (RUN(ph)) { KA; FRAME; phase_prologue(F); phase_norm1<0>(F, KIN(I_X), nullptr, nullptr, KIN(I_NMIX), (bf16*)(KWS + WS_H)); SEAM(ph, 0); }
    ++ph;
    for (int l = 0; l < NL; ++l) {
        if (RUN(ph)) { KA; FRAME; pg8::PlainSched S; S.init((const bf16*)(KWS + WS_H), D, (const bf16*)(KWS + WS_WIN) + (size_t)l * NPAD * D, T, NPAD, D, F.G, F.bid, 4);
            pg8::EpiBf16 E{(bf16*)(KWS + WS_P), NPAD};
            pg8::gemm_phase<pg8::EpiBf16, pg8::PlainSched, true>(F.lds, D, S, E); SEAM(ph, 1); }
        ++ph;
        if (RUN(ph)) { KA; FRAME; phase_prep3(F, l); SEAM(ph, 2); }
        ++ph;
        if (RUN(ph)) { KA; FRAME; phase_compress3(F, l); phase_rec_local(F, l); SEAM(ph, 3); }
        ++ph;
        if (RUN(ph)) { KA; FRAME; phase_rec_scan(F); SEAM(ph, 4); }
        ++ph;
        if (RUN(ph)) { KA; FRAME; phase_nsa2(F, l); if (MK_PROBE_MASK != 0) { xcd_barrier(bar); STAMP(7); } phase_rec_out(F, l); SEAM(ph, 5); }
        ++ph;
        if (RUN(ph)) { KA; FRAME;
            for (int n = 0; n < 3; ++n) { pg8::PlainSched S; S.init((const bf16*)(KWS + WS_OCAT) + n * 512, 1536, (const bf16*)(KWS + WS_WBR) + ((size_t)l * 3 + n) * D * 512, T, D, 512, F.G, F.bid);
                pg8::EpiMerge E{(bf16*)(KWS + WS_MERGED), (const bf16*)(KWS + WS_P) + C_MG + n * D, n == 0 ? 1 : 0};
                pg8::gemm_phase<pg8::EpiMerge, pg8::PlainSched, true>(F.lds, 512, S, E); __syncthreads(); }
            SEAM(ph, 6); }
        ++ph;

        if (RUN(ph)) { KA; FRAME; pg8::PlainSched S; S.init((const bf16*)(KWS + WS_MERGED), D, (const bf16*)(KWS + WS_WOUT) + (size_t)l * D * D, T, D, D, F.G, F.bid);
            pg8::EpiResF32 E{l == 0 ? KIN(I_X) : (const float*)(KWS + WS_XRES), (float*)(KWS + WS_X1), D};
            pg8::gemm_phase<pg8::EpiResF32, pg8::PlainSched, false>(F.lds, D, S, E); SEAM(ph, 8); }
        ++ph;
        if (RUN(ph)) { KA; FRAME; phase_router2(F, l); SEAM(ph, 9); }
        ++ph;
        if (RUN(ph)) { KA; FRAME; phase_lists2(F); SEAM(ph, 10); }
        ++ph;
        if (RUN(ph)) { KA; FRAME; moe_table(F, tb);
            pg8::MoeSched<1> S; S.init(F.G, F.vcu, tb, (const int*)(KWS + WS_ROUTE + 131072), (const int*)(KWS + WS_ROUTE + 262144), KWS + WS_H, (const bf16*)(KWS + WS_WGU) + (size_t)l * NE * 1024 * D);
            pg8::EpiMoe1 E{(bf16*)(KWS + WS_ACT), (const int*)(KWS + WS_ROUTE + 262144), (const float*)(KWS + WS_ROUTE + 65536)};
            pg8::gemm_phase<pg8::EpiMoe1, pg8::MoeSched<1>, true>(F.lds, D, S, E); SEAM(ph, 11); }
        ++ph;
        if (RUN(ph)) { KA; FRAME; moe_table(F, tb);
            pg8::MoeSched<2> S; S.init(F.G, F.vcu, tb, (const int*)(KWS + WS_ROUTE + 131072), (const int*)(KWS + WS_ROUTE + 262144), KWS + WS_ACT, (const bf16*)(KWS + WS_WDN) + (size_t)l * NE * D * FF);
            pg8::EpiMoe2 E{(bf16*)(KWS + WS_CONTRIB), (const int*)(KWS + WS_ROUTE + 262144)};
            pg8::gemm_phase<pg8::EpiMoe2, pg8::MoeSched<2>, true>(F.lds, FF, S, E); SEAM(ph, 12); }
        ++ph;
        if (l + 1 < NL) { if (RUN(ph)) { KA; FRAME; phase_norm1<1>(F, (const float*)(KWS + WS_X1), (const bf16*)(KWS + WS_CONTRIB), (float*)(KWS + WS_XRES), KIN(I_NMIX) + (size_t)(l + 1) * D, (bf16*)(KWS + WS_H)); SEAM(ph, 13); } ++ph; }
    }
    if (RUN(ph)) { KA; FRAME; phase_norm1<2>(F, (const float*)(KWS + WS_X1), (const bf16*)(KWS + WS_CONTRIB), KOUT, nullptr, nullptr); }
    if (MK_PROBE_MASK != 0 && lbid() == 0 && ltid() == 0) {
        asm volatile("s_waitcnt vmcnt(0)" ::: "memory"); STAMP(15);
        unsigned long long tot = 0ull;
        for (int k2 = 0; k2 < 16; ++k2) if ((MK_PROBE_MASK >> k2) & 1) tot += tacc[k2];
        const unsigned long long t_end = wall_clock64() + 4ull * tot;
        while (wall_clock64() < t_end) __builtin_amdgcn_s_sleep(8);
    }
#undef RUN
#undef SEAM
}

#ifndef MK_PER_PHASE
#define MK_PER_PHASE 0
#endif
extern "C" void kernel_launch(void* const* d_in, const int* in_sizes, int n_in, void* d_out, int out_size, void* d_ws, size_t ws_size, hipStream_t stream) {
    static int grid = 0;
    if (grid == 0) {
        if (n_in != 22 || out_size != T * D || ws_size < WS_END) { fprintf(stderr, "kernel_launch: unexpected sizes (n_in %d out %d ws %zu)\n", n_in, out_size, ws_size); grid = -1; return; }
        int dev = 0, cus = 0, per_cu = 0;
        if (hipGetDevice(&dev) != hipSuccess || hipDeviceGetAttribute(&cus, hipDeviceAttributeMultiprocessorCount, dev) != hipSuccess) { grid = -1; return; }
        if (hipFuncSetAttribute((const void*)mk_fwd, hipFuncAttributeMaxDynamicSharedMemorySize, LDS_BYTES) != hipSuccess) { fprintf(stderr, "kernel_launch: hipFuncSetAttribute failed\n"); grid = -1; return; }
        if (hipOccupancyMaxActiveBlocksPerMultiprocessor(&per_cu, (const void*)mk_fwd, 512, LDS_BYTES) != hipSuccess || per_cu < 1) { fprintf(stderr, "kernel_launch: occupancy query says %d\n", per_cu); }
        (void)hipGetLastError();
        grid = cus;
    }
    if (grid < 0) return;
    if (hipMemsetAsync((char*)d_ws + WS_CTL, 0, CTL_ZERO_BYTES, stream) != hipSuccess) return;
    Args a{};
    for (int i = 0; i < 22; ++i) a.in[i] = (const GAS float*)d_in[i];
    a.out = (GAS float*)d_out; a.ws = (GAS unsigned char*)d_ws;
#if MK_PER_PHASE
    const int total = 1 + NL * PH_PER_LAYER + (NL - 1) + 1;
    for (int k = 0; k < total; ++k) { a.ph_lo = k; a.ph_hi = k + 1; a.li = 0; hipLaunchKernelGGL(mk_fwd, dim3(grid), dim3(512), LDS_BYTES, stream, a); }
#else
    a.ph_lo = 0; a.ph_hi = 1000; a.li = 0;
    hipLaunchKernelGGL(mk_fwd, dim3(grid), dim3(512), LDS_BYTES, stream, a);
#endif
    const hipError_t le = hipPeekAtLastError();
    if (le != hipSuccess) fprintf(stderr, "kernel_launch: launch failed: %s\n", hipGetErrorName(le));
}
```

```cpp
#include <hip/hip_runtime.h>
#include <cstdio>
#include <cstdint>

#ifndef MK_PROBE_MASK
#define MK_PROBE_MASK 0
#endif
#ifndef MK_PROBE_BID
#define MK_PROBE_BID 0
#endif
#define GAS __attribute__((address_space(1)))
#define LAS __attribute__((address_space(3)))
typedef unsigned short bf16;
typedef short bf16x8 __attribute__((ext_vector_type(8)));
typedef float f32x4 __attribute__((ext_vector_type(4)));
typedef float f32x2 __attribute__((ext_vector_type(2)));
typedef unsigned u32x4 __attribute__((ext_vector_type(4)));
typedef unsigned u32x2 __attribute__((ext_vector_type(2)));

constexpr int T = 8192, D = 2048, NL = 2, INC = 11048, NPAD = 11264;
constexpr int NE = 32, FF = 512, NCH = T / 64;
constexpr float EPS = 1e-6f, NEGB = -1e30f;
constexpr int C_Q = 0, C_KC = 512, C_VC = 640, C_KS = 768, C_VS = 896, C_KW = 1024, C_VW = 1152;
constexpr int C_HQ = 1280, C_HF = 1792, C_HI = 2304, C_HG = 2816, C_GQ = 3328, C_GK = 3584, C_GV = 3840, C_GR = 4352;
constexpr int C_MG = 4864, C_NG = 11008, C_GA = 11032;

constexpr size_t MiB = 1u << 20;
constexpr size_t WS_CTL = 0, CTL_ZERO_BYTES = 1 * MiB;
constexpr size_t WS_WIN = 2 * MiB;
constexpr size_t WS_WBR = 90 * MiB;
constexpr size_t WS_WOUT = 102 * MiB;
constexpr size_t WS_WGU = 118 * MiB;
constexpr size_t WS_WDN = 374 * MiB;
constexpr size_t WS_H = 502 * MiB;
constexpr size_t WS_P = 534 * MiB;
constexpr size_t WS_OCAT = 710 * MiB;
constexpr size_t WS_PROJ = 734 * MiB;
constexpr size_t WS_MERGED = 830 * MiB;
constexpr size_t WS_X1 = 862 * MiB;
constexpr size_t WS_XRES = 926 * MiB;
constexpr size_t WS_CONTRIB = 990 * MiB;
constexpr size_t WS_ACT = 1054 * MiB;
constexpr size_t WS_QN = 1078 * MiB;
constexpr size_t WS_KV = 1094 * MiB;
constexpr size_t WS_KC = 1118 * MiB;
constexpr size_t WS_ORAW = 1119 * MiB;
constexpr size_t WS_ROUTE = 1151 * MiB;
constexpr size_t WS_SLOC_HG = 1153 * MiB;
constexpr size_t WS_SLOC_GL = 1185 * MiB;
constexpr size_t WS_SPREV_HG = 1201 * MiB;
constexpr size_t WS_SPREV_GL = 1217 * MiB;
constexpr size_t WS_DEC = 1225 * MiB;
constexpr size_t WS_QS = 1226 * MiB;
constexpr size_t WS_KS2 = 1234 * MiB;
constexpr size_t WS_KW2 = 1236 * MiB;
constexpr size_t WS_VST = 1238 * MiB;
constexpr size_t WS_VWT = 1240 * MiB;
constexpr size_t WS_KCB = 1242 * MiB;
constexpr size_t WS_WRT = 1243 * MiB;
constexpr size_t WS_HIST = 1244 * MiB;
constexpr size_t WS_CW = 1245 * MiB;
constexpr size_t WS_RSTD = 1247 * MiB;
constexpr size_t WS_END = 1248 * MiB;
constexpr size_t KV_STRIDE = (size_t)2 * T * 64;
constexpr int CW_BAR = 4096;

constexpr int RING_BYTES = 131072;
constexpr int LDS_BYTES = 147456;
constexpr int MISC_OFF = LDS_BYTES - 2048;

#define LDS_WAIT() asm volatile("s_waitcnt lgkmcnt(0)" ::: "memory")
#define VM_WAIT() asm volatile("s_waitcnt vmcnt(0)" ::: "memory")
#define WSYNC() asm volatile("s_waitcnt lgkmcnt(0)" ::: "memory")

__device__ __forceinline__ unsigned f2bf(float f) { unsigned u = __builtin_bit_cast(unsigned, f); return (u + 0x7fffu + ((u >> 16) & 1u)) >> 16; }
__device__ __forceinline__ unsigned pk2(float lo, float hi) { return f2bf(lo) | (f2bf(hi) << 16); }
__device__ __forceinline__ float bf2f(unsigned b) { return __builtin_bit_cast(float, (b & 0xffffu) << 16); }
__device__ __forceinline__ float bflo(unsigned w) { return __builtin_bit_cast(float, w << 16); }
__device__ __forceinline__ float bfhi(unsigned w) { return __builtin_bit_cast(float, w & 0xffff0000u); }
__device__ __forceinline__ float wave_sum(float v) {
#pragma unroll
    for (int o = 1; o < 64; o <<= 1) v += __shfl_xor(v, o);
    return v;
}
__device__ __forceinline__ float wave_max(float v) {
#pragma unroll
    for (int o = 1; o < 64; o <<= 1) v = fmaxf(v, __shfl_xor(v, o));
    return v;
}
__device__ __forceinline__ int ltid() { int t = threadIdx.x; asm volatile("" : "+v"(t)); return t; }
__device__ __forceinline__ int lbid() { int b = blockIdx.x; asm volatile("" : "+s"(b)); return b; }
typedef __bf16 bf16x2_t __attribute__((ext_vector_type(2)));
__device__ __forceinline__ unsigned pkbf(float lo, float hi) { const f32x2 v = {lo, hi}; return __builtin_bit_cast(unsigned, __builtin_convertvector(v, bf16x2_t)); }
constexpr float LOG2E = 1.4426950408889634f;
__device__ __forceinline__ float sigmoidf_(float x) { return 1.0f / (1.0f + expf(-x)); }
__device__ __forceinline__ float fsig(float x) { return __builtin_amdgcn_rcpf(1.0f + __builtin_amdgcn_exp2f(-LOG2E * x)); }

#define GSTAMP(lds_, slot) do { if (MK_PROBE_MASK != 0 && lbid() == MK_PROBE_BID && ltid() == 0) { volatile LAS unsigned long long* _ta = (volatile LAS unsigned long long*)((lds_) + MISC_OFF + 512); const unsigned long long _n = wall_clock64(); _ta[slot] += _n - _ta[16]; _ta[16] = _n; } } while (0)
#define XB_TMO      128
#define XB_XCNT(j)  (256  + 64 * (j))
#define XB_XSUB(j)  (1280 + 64 * (j))
#define XB_XGEN(j)  (2304 + 64 * (j))
#define XB_TOP      3328
#define XB_TOPGEN   3392
#define XCD_BAR_WORDS 3456
#define XB_SPIN_CAP (1u << 25)

__device__ __forceinline__ unsigned xb_ld(unsigned* p)              { return __hip_atomic_load(p, __ATOMIC_RELAXED, __HIP_MEMORY_SCOPE_AGENT); }
__device__ __forceinline__ unsigned xb_add(unsigned* p, unsigned v) { return __hip_atomic_fetch_add(p, v, __ATOMIC_RELAXED, __HIP_MEMORY_SCOPE_AGENT); }
__device__ __forceinline__ unsigned xb_xcc_id() { return (unsigned)__builtin_amdgcn_s_getreg((3 << 11) | 20) & 0xFu; }
#define XB_SPIN(cond, bar) do { unsigned _sp = 0; while (cond) { __builtin_amdgcn_s_sleep(1); \
    if ((++_sp & 255u) == 0u) { if (xb_ld(&(bar)[XB_TMO])) break; if (_sp > XB_SPIN_CAP) { atomicAdd(&(bar)[XB_TMO], 1u); break; } } } } while (0)

struct XcdBarrier { unsigned* bar; unsigned x; volatile LAS unsigned* st; };

__device__ __forceinline__ XcdBarrier xcd_barrier_post(unsigned* bar, volatile LAS unsigned* st) {
    XcdBarrier b; b.bar = bar; b.x = xb_xcc_id(); b.st = st;
    if (threadIdx.x == 0) (void)xb_add(&bar[XB_XCNT(b.x)], 1u);
    return b;
}
__device__ __forceinline__ void xcd_barrier_complete(unsigned* bar, unsigned x, unsigned& nloc, unsigned& nx) {
    const unsigned G = gridDim.x * gridDim.y * gridDim.z;
    unsigned sum, cnt, mine, sp = 0u;
    for (;;) {
        sum = 0u; cnt = 0u; mine = 0u;
#pragma unroll
        for (unsigned j = 0; j < 16; ++j) { const unsigned c = xb_ld(&bar[XB_XCNT(j)]); sum += c; cnt += (c > 0u) ? 1u : 0u; mine = (j == x) ? c : mine; }
        if (sum == G) break;
        __builtin_amdgcn_s_sleep(1);
        if ((++sp & 255u) == 0u) { if (xb_ld(&bar[XB_TMO])) break; if (sp > XB_SPIN_CAP) { atomicAdd(&bar[XB_TMO], 1u); break; } }
    }
    nloc = mine > 0u ? mine : 1u; nx = cnt > 0u ? cnt : 1u;
}
__device__ __forceinline__ void xcd_barrier(const XcdBarrier& b) {
    asm volatile("s_waitcnt vmcnt(0)" ::: "memory");
    __syncthreads();
    if (threadIdx.x == 0) {
        unsigned* bar = b.bar;
        __builtin_amdgcn_s_waitcnt(0);
        unsigned nloc = b.st[0], nx = b.st[1];
        if (nloc == 0u) { xcd_barrier_complete(bar, b.x, nloc, nx); b.st[0] = nloc; b.st[1] = nx; }
        const unsigned old = xb_add(&bar[XB_XSUB(b.x)], 1u);
        const unsigned gen = old / nloc;
        if (old + 1u == (gen + 1u) * nloc) {
            __builtin_amdgcn_fence(__ATOMIC_RELEASE, "agent");
            asm volatile("s_waitcnt vmcnt(0)" ::: "memory");
            const unsigned og = xb_add(&bar[XB_TOP], 1u);
            const unsigned tg = og / nx;
            if (og + 1u == (tg + 1u) * nx) xb_add(&bar[XB_TOPGEN], 1u);
            else XB_SPIN(xb_ld(&bar[XB_TOPGEN]) == tg, bar);
            __builtin_amdgcn_fence(__ATOMIC_ACQUIRE, "agent");
            xb_add(&bar[XB_XGEN(b.x)], 1u);
            asm volatile("s_waitcnt vmcnt(0)" ::: "memory");
        } else {
            XB_SPIN(xb_ld(&bar[XB_XGEN(b.x)]) == gen, bar);
            __builtin_amdgcn_fence(__ATOMIC_ACQUIRE, "agent");
            asm volatile("s_waitcnt vmcnt(0)" ::: "memory");
        }
    }
    __syncthreads();
}

namespace pg8 {
constexpr int BM = 256, BK = 64, HALF = 128, HTB = HALF * BK * 2, STAGE_BYTES = 8 * HTB, NXCD = 8, WGM = 8;
__host__ __device__ __forceinline__ int lds_byte(int r, int c) { const int st = (r >> 4) * 2 + (c >> 5), rr = r & 15, cc = c & 31, ob = rr * 64 + cc * 2; return st * 1024 + (ob ^ (((ob >> 9) & 1) << 5)); }
__host__ __device__ __forceinline__ void stage_rc(int b, int& R, int& C) { const int st = b / 1024, sb = b % 1024, swz = sb ^ (((sb >> 9) & 1) << 5); R = (st >> 1) * 16 + swz / 64; C = (st & 1) * 32 + (swz % 64) / 2; }
__host__ __device__ __forceinline__ int perm32(int rho) { const int n = rho >> 4, i = rho & 15; return 8 * (i >> 2) + 4 * n + (i & 3); }

struct Unit { int pm, pn, e, nvalid, slot0, half, row0; const char *A0, *A1, *B0, *B1; unsigned va[2][2]; };

__device__ __forceinline__ unsigned cvt_pk_bf16(float lo, float hi) { unsigned r; asm volatile("v_cvt_pk_bf16_f32 %0, %1, %2" : "=v"(r) : "v"(lo), "v"(hi)); return r; }

template <class Epi, class Sched, bool ALIGN_EPI>
__device__ __forceinline__ void gemm_phase(LAS unsigned char* lds, const int K, const Sched& S, const Epi& E) {
    const int tid = ltid(), wid = __builtin_amdgcn_readfirstlane(tid >> 6), lane = tid & 63, wr = wid >> 2, wc = wid & 3, fr = lane & 15, fq = lane >> 4;
    const int nt = K / BK;
    unsigned voffB[2];
#pragma unroll
    for (int i = 0; i < 2; ++i) { int R, C; stage_rc(tid * 16 + i * 8192, R, C); const int Rb = Epi::PERM ? ((R & ~31) + perm32(R & 31)) : R; voffB[i] = (unsigned)(Rb * K + C) * 2u; }
    const size_t kstep = (size_t)(BK * 2);
    const unsigned ldsw = (unsigned)wid * 1024u;
    const int aoff = lds_byte(wr * 64 + fr, fq * 8), boff = lds_byte(wc * 32 + fr, fq * 8);
#define PG8_SA(b, h) (((b) * 2 + (h)) * HTB)
#define PG8_SB(b, h) ((4 + (b) * 2 + (h)) * HTB)
#define PG8_STAGE(bufoff, gbase, voff) do { _Pragma("unroll") for (int _i = 0; _i < 2; ++_i) \
        __builtin_amdgcn_global_load_lds((const unsigned*)((const char*)(gbase) + (voff)[_i]), (LAS unsigned*)(lds + (bufoff) + ldsw + _i * 8192), 16, 0, 0); } while (0)
#define PG8_LDA(dst, b, h) do { _Pragma("unroll") for (int m = 0; m < 4; ++m) _Pragma("unroll") for (int k = 0; k < 2; ++k) dst[m][k] = *(const LAS bf16x8*)(lds + PG8_SA(b, h) + aoff + m * 2048 + k * 1024); } while (0)
#define PG8_LDB(dst, b, h) do { _Pragma("unroll") for (int n = 0; n < 2; ++n) _Pragma("unroll") for (int k = 0; k < 2; ++k) dst[n][k] = *(const LAS bf16x8*)(lds + PG8_SB(b, h) + boff + n * 2048 + k * 1024); } while (0)
#define PG8_MMA(ai, bj, At, Bt) do { __builtin_amdgcn_s_setprio(1); _Pragma("unroll") for (int m = 0; m < 4; ++m) _Pragma("unroll") for (int n = 0; n < 2; ++n) _Pragma("unroll") for (int k = 0; k < 2; ++k) \
        acc[ai][bj][m][n] = __builtin_amdgcn_mfma_f32_16x16x32_bf16(Bt[n][k], At[m][k], acc[ai][bj][m][n], 0, 0, 0); __builtin_amdgcn_s_setprio(0); } while (0)
#define PG8_WAIT_V(n) asm volatile("s_waitcnt vmcnt(" #n ")" ::: "memory")
#define PG8_WAIT_L(n) asm volatile("s_waitcnt lgkmcnt(" #n ")" ::: "memory")
#define PG8_BAR __builtin_amdgcn_s_barrier()
#define PG8_SCHED __builtin_amdgcn_sched_barrier(0)
#define VA(u, h) (Sched::GATHER ? (u).va[h] : S.va)
    Unit cur, nxt; int ui = 0;
    if (!S.next(0, cur)) return;
    if (S.probe) GSTAMP(lds, 27);
    f32x4 acc[2][2][4][2];
#pragma unroll
    for (int a = 0; a < 2; ++a)
#pragma unroll
        for (int b = 0; b < 2; ++b)
#pragma unroll
            for (int m = 0; m < 4; ++m)
#pragma unroll
                for (int n = 0; n < 2; ++n) acc[a][b][m][n] = (f32x4){0.f, 0.f, 0.f, 0.f};
    bf16x8 At[4][2], B0[2][2], B1[2][2];
    PG8_STAGE(PG8_SB(0, 0), cur.B0, voffB); PG8_STAGE(PG8_SB(0, 1), cur.B1, voffB); PG8_STAGE(PG8_SA(0, 0), cur.A0, VA(cur, 0)); PG8_STAGE(PG8_SA(0, 1), cur.A1, VA(cur, 1));
    if (wr == 1) PG8_BAR;
    PG8_WAIT_V(2); PG8_BAR;
    PG8_STAGE(PG8_SB(1, 0), cur.B0 + kstep, voffB); PG8_STAGE(PG8_SA(1, 0), cur.A0 + kstep, VA(cur, 0)); PG8_STAGE(PG8_SB(1, 1), cur.B1 + kstep, voffB);
    PG8_WAIT_V(6); PG8_BAR;
    for (;;) {
        const bool has_next = S.next(ui + 1, nxt);
        if (!has_next) nxt = cur;
        for (int t = 0; t < nt; t += 2) {
            const bool last = (t == nt - 2);
            const char* a1h1 = cur.A1 + (size_t)(t + 1) * kstep;
            const char* a2h0 = last ? nxt.A0 : cur.A0 + (size_t)(t + 2) * kstep; const char* a2h1 = last ? nxt.A1 : cur.A1 + (size_t)(t + 2) * kstep;
            const char* b2h0 = last ? nxt.B0 : cur.B0 + (size_t)(t + 2) * kstep; const char* b2h1 = last ? nxt.B1 : cur.B1 + (size_t)(t + 2) * kstep;
            unsigned v2h0[2], v2h1[2];
#pragma unroll
            for (int i = 0; i < 2; ++i) { if constexpr (Sched::GATHER) { v2h0[i] = last ? nxt.va[0][i] : cur.va[0][i]; v2h1[i] = last ? nxt.va[1][i] : cur.va[1][i]; } else { v2h0[i] = S.va[i]; v2h1[i] = S.va[i]; } }
            PG8_LDB(B0, 0, 0); PG8_LDB(B1, 0, 1); PG8_SCHED; PG8_LDA(At, 0, 0); PG8_STAGE(PG8_SA(1, 1), a1h1, VA(cur, 1));
            PG8_WAIT_V(8); PG8_WAIT_L(0); PG8_BAR; PG8_MMA(0, 0, At, B0); PG8_MMA(0, 1, At, B1); PG8_BAR; PG8_SCHED;
            if (!cur.half) PG8_LDA(At, 0, 1);
            PG8_STAGE(PG8_SB(0, 0), b2h0, voffB); PG8_STAGE(PG8_SB(0, 1), b2h1, voffB); PG8_STAGE(PG8_SA(0, 0), a2h0, v2h0);
            PG8_WAIT_V(8); PG8_WAIT_L(0); PG8_BAR; if (!cur.half) { PG8_MMA(1, 0, At, B0); PG8_MMA(1, 1, At, B1); } PG8_BAR; PG8_SCHED;
            PG8_LDB(B0, 1, 0); PG8_LDB(B1, 1, 1); PG8_SCHED; PG8_LDA(At, 1, 0); PG8_STAGE(PG8_SA(0, 1), a2h1, v2h1);
            PG8_WAIT_V(8); PG8_WAIT_L(0); PG8_BAR; PG8_MMA(0, 0, At, B0); PG8_MMA(0, 1, At, B1); PG8_BAR; PG8_SCHED;
            if (!cur.half) PG8_LDA(At, 1, 1);
            PG8_STAGE(PG8_SB(1, 0), b2h0 + kstep, voffB); PG8_STAGE(PG8_SB(1, 1), b2h1 + kstep, voffB); PG8_STAGE(PG8_SA(1, 0), a2h0 + kstep, v2h0);
            PG8_WAIT_V(8); PG8_WAIT_L(0); PG8_BAR; if (!cur.half) { PG8_MMA(1, 0, At, B0); PG8_MMA(1, 1, At, B1); } PG8_BAR; PG8_SCHED;
        }
        if (S.probe) GSTAMP(lds, 25);
        if constexpr (ALIGN_EPI) { if (wr == 0) PG8_BAR; }
        E(acc, cur, wr, wc, fr, fq);
        if (S.probe) { asm volatile("s_waitcnt vmcnt(0)" ::: "memory"); GSTAMP(lds, 26); }
        if (!has_next) break;
#pragma unroll
        for (int a = 0; a < 2; ++a)
#pragma unroll
            for (int b = 0; b < 2; ++b)
#pragma unroll
                for (int m = 0; m < 4; ++m)
#pragma unroll
                    for (int n = 0; n < 2; ++n) acc[a][b][m][n] = (f32x4){0.f, 0.f, 0.f, 0.f};
        cur = nxt; ++ui;
        if constexpr (ALIGN_EPI) { if (wr == 1) PG8_BAR; }
    }
    PG8_WAIT_V(0);
    if constexpr (!ALIGN_EPI) { if (wr == 0) PG8_BAR; }
    PG8_BAR;
#undef VA
#undef PG8_SA
#undef PG8_SB
#undef PG8_STAGE
#undef PG8_LDA
#undef PG8_LDB
#undef PG8_MMA
#undef PG8_WAIT_V
#undef PG8_WAIT_L
#undef PG8_BAR
#undef PG8_SCHED
}

struct PlainSched {
    static constexpr bool GATHER = false;
    int nM, nN, nwg, G, c, lda, K, nNh, probe = 0; const char* A; const char* Bt; unsigned va[2];
    __device__ __forceinline__ void init(const bf16* A_, int lda_, const bf16* Bt_, int M, int N, int K_, int G_, int c_, int nNh_ = 0) {
        nM = M / BM; nN = N / BM - nNh_; nNh = nNh_; nwg = nM * nN; G = G_; c = c_; lda = lda_; K = K_; A = (const char*)A_; Bt = (const char*)Bt_;
#pragma unroll
        for (int i = 0; i < 2; ++i) { int R, C; stage_rc((int)ltid() * 16 + i * 8192, R, C); va[i] = (unsigned)(R * lda + C) * 2u; }
    }
    __device__ __forceinline__ bool next(int i, Unit& u) const {
        const long L = (long)i * G + c;
        u.e = 0; u.nvalid = 256; u.slot0 = 0; u.va[0][0] = 0u; u.va[0][1] = 0u; u.va[1][0] = 0u; u.va[1][1] = 0u;
        if (L >= nwg) { const int hL = (int)(L - nwg); if (hL >= 2 * nM * nNh) return false;
            const int hm = hL / nNh, pn = nN + hL % nNh;
            u.pm = hm >> 1; u.pn = pn; u.half = 1; u.row0 = hm * HALF;
            u.A0 = A + (size_t)hm * HALF * lda * 2; u.A1 = u.A0;
            u.B0 = Bt + (size_t)pn * BM * K * 2; u.B1 = u.B0 + (size_t)HALF * K * 2;
            return true; }
        int wgid = (int)L; { const int q = nwg / NXCD, r = nwg % NXCD, xcd = wgid % NXCD, off = wgid / NXCD; wgid = (xcd < r ? xcd * (q + 1) : r * (q + 1) + (xcd - r) * q) + off; }
        const int nig = WGM * nN, gid = wgid / nig, fm = gid * WGM, gsz = (nM - fm) < WGM ? (nM - fm) : WGM;
        u.pm = fm + ((wgid % nig) % gsz); u.pn = (wgid % nig) / gsz; u.half = 0; u.row0 = u.pm * BM;
        u.A0 = A + (size_t)u.pm * BM * lda * 2; u.A1 = u.A0 + (size_t)HALF * lda * 2;
        u.B0 = Bt + (size_t)u.pn * BM * K * 2; u.B1 = u.B0 + (size_t)HALF * K * 2;
        return true;
    }
};
struct BranchSched {
    static constexpr bool GATHER = false;
    int G, c, probe = 0; const char* A; const char* Bt; unsigned va[2];
    __device__ __forceinline__ void init(const bf16* OC, const bf16* WBRl, int G_, int c_) { G = G_; c = c_; A = (const char*)OC; Bt = (const char*)WBRl;
#pragma unroll
        for (int i = 0; i < 2; ++i) { int R, C; stage_rc((int)ltid() * 16 + i * 8192, R, C); va[i] = (unsigned)(R * 1536 + C) * 2u; } }
    __device__ __forceinline__ bool next(int i, Unit& u) const {
        const int tile = (i / 3) * G + c, n = i % 3; if (tile >= (T / BM) * (D / BM)) return false;
        int wgid = tile; { const int nwg = 256, q = nwg / NXCD, xcd = wgid % NXCD, off = wgid / NXCD; wgid = xcd * q + off; }
        const int nN = D / BM, nig = WGM * nN, gid = wgid / nig, fm = gid * WGM;
        u.pm = fm + ((wgid % nig) % WGM); u.pn = (wgid % nig) / WGM; u.e = n; u.nvalid = 256; u.slot0 = 0; u.half = 0; u.row0 = u.pm * BM;
        u.va[0][0] = 0u; u.va[0][1] = 0u; u.va[1][0] = 0u; u.va[1][1] = 0u;
        u.A0 = A + (size_t)u.pm * BM * 1536 * 2 + (size_t)n * 512 * 2; u.A1 = u.A0 + (size_t)HALF * 1536 * 2;
        u.B0 = Bt + (size_t)n * D * 512 * 2 + (size_t)u.pn * BM * 512 * 2; u.B1 = u.B0 + (size_t)HALF * 512 * 2;
        return true;
    }
};
template <int MODE> struct MoeSched {
    static constexpr int NPN = MODE == 1 ? 4 : 8;
    static constexpr bool GATHER = MODE == 1;
    int G, c, probe = 0; const LAS int* tb; const int* cnt; const int* list; const char* A; const char* W; unsigned va[2];
    __device__ __forceinline__ void init(int G_, int c_, const LAS int* tb_, const int* cnt_, const int* list_, const void* A_, const void* W_) {
        G = G_; c = c_; tb = tb_; cnt = cnt_; list = list_; A = (const char*)A_; W = (const char*)W_;
#pragma unroll
        for (int i = 0; i < 2; ++i) { int R, C; stage_rc((int)ltid() * 16 + i * 8192, R, C); va[i] = (unsigned)(R * FF + C) * 2u; }
    }
    __device__ __forceinline__ bool next(int i, Unit& u) const {
        const int L = i * G + c, nfull = __builtin_amdgcn_readfirstlane(tb[33 + NE]), nhalf = __builtin_amdgcn_readfirstlane(tb[66 + NE]);
        if (L >= (nfull + nhalf) * NPN) return false;
        const bool half = L >= nfull * NPN; const int Lr = half ? L - nfull * NPN : L, base = half ? 66 : 33;
        const int tq = Lr / NPN, pn = Lr % NPN; int e = 0;
        while (e < NE - 1 && __builtin_amdgcn_readfirstlane(tb[base + e + 1]) <= tq) ++e;
        const int ne = __builtin_amdgcn_readfirstlane(cnt[e]);
        const int pm = half ? (ne - 1) / 256 : tq - __builtin_amdgcn_readfirstlane(tb[33 + e]);
        const int tl = __builtin_amdgcn_readfirstlane(tb[e]) + pm;
        u.pm = pm; u.pn = pn; u.e = e; u.nvalid = ne - pm * 256; u.slot0 = tl * 256; u.half = half ? 1 : 0; u.row0 = 0;
        if (MODE == 1) {
            u.A0 = A; u.A1 = A;
#pragma unroll
            for (int h = 0; h < 2; ++h)
#pragma unroll
                for (int k = 0; k < 2; ++k) { int Rk, Ck; stage_rc((int)ltid() * 16 + k * 8192, Rk, Ck); int idx = pm * 256 + h * 128 + Rk; idx = idx < ne ? idx : ne - 1; const int entry = list[e * 8192 + idx]; u.va[h][k] = (unsigned)(entry >> 1) * (unsigned)(D * 2) + (unsigned)Ck * 2u; }
            const char* we = W + (size_t)e * 1024 * D * 2;
            u.B0 = we + (size_t)(pn * 128) * D * 2; u.B1 = we + (size_t)(512 + pn * 128) * D * 2;
        } else {
            u.va[0][0] = 0u; u.va[0][1] = 0u; u.va[1][0] = 0u; u.va[1][1] = 0u;
            u.A0 = A + (size_t)tl * 256 * FF * 2; u.A1 = u.A0 + (size_t)HALF * FF * 2;
            const char* we = W + (size_t)e * D * FF * 2;
            u.B0 = we + (size_t)(pn * 256) * FF * 2; u.B1 = u.B0 + (size_t)HALF * FF * 2;
        }
        return true;
    }
};

struct EpiBf16 {
    static constexpr bool PERM = true;
    bf16* O; int ldc;
    __device__ __forceinline__ void operator()(const f32x4 (&acc)[2][2][4][2], const Unit& u, int wr, int wc, int fr, int fq) const {
        const int row0 = u.row0 + wr * 64 + fr, col0 = u.pn * BM + wc * 32 + 8 * fq;
#pragma unroll
        for (int ai = 0; ai < 2; ++ai) if (ai == 0 || !u.half)
#pragma unroll
            for (int m = 0; m < 4; ++m) { bf16* rowp = O + (size_t)(row0 + ai * HALF + m * 16) * ldc + col0;
#pragma unroll
                for (int bj = 0; bj < 2; ++bj) { const f32x4 v0 = acc[ai][bj][m][0], v1 = acc[ai][bj][m][1];
                    u32x4 w; w.x = cvt_pk_bf16(v0[0], v0[1]); w.y = cvt_pk_bf16(v0[2], v0[3]); w.z = cvt_pk_bf16(v1[0], v1[1]); w.w = cvt_pk_bf16(v1[2], v1[3]);
                    *(u32x4*)(rowp + bj * HALF) = w; } }
    }
};
struct EpiMerge {
    static constexpr bool PERM = true;
    bf16* MG; const bf16* gate0;
    __device__ __forceinline__ void operator()(const f32x4 (&acc)[2][2][4][2], const Unit& u, int wr, int wc, int fr, int fq) const {
        const int row0 = u.row0 + wr * 64 + fr, col0 = u.pn * BM + wc * 32 + 8 * fq; const bf16* __restrict__ gate = gate0 + (size_t)u.e * D; const bool first = u.e == 0;
        bf16* __restrict__ MGp = MG;
        u32x4 gq[2][2], pv[2][2];
#define EMG_LOAD(buf, g) do { const size_t row_ = (size_t)(row0 + ((g) >> 2) * HALF + ((g) & 3) * 16); \
            _Pragma("unroll") for (int bj_ = 0; bj_ < 2; ++bj_) { gq[buf][bj_] = *(const u32x4*)(gate + row_ * NPAD + col0 + bj_ * HALF); \
                pv[buf][bj_] = first ? (u32x4){0u, 0u, 0u, 0u} : *(const u32x4*)(MGp + row_ * D + col0 + bj_ * HALF); } } while (0)
        EMG_LOAD(0, 0);
#pragma unroll
        for (int g = 0; g < 8; ++g) { if (g + 1 < 8) EMG_LOAD((g + 1) & 1, g + 1);
            const int ai = g >> 2, m = g & 3; const size_t row = (size_t)(row0 + ai * HALF + m * 16);
#pragma unroll
            for (int bj = 0; bj < 2; ++bj) { const f32x4 v0 = acc[ai][bj][m][0], v1 = acc[ai][bj][m][1]; float o[8];
                const unsigned gw[4] = {gq[g & 1][bj].x, gq[g & 1][bj].y, gq[g & 1][bj].z, gq[g & 1][bj].w}, pw[4] = {pv[g & 1][bj].x, pv[g & 1][bj].y, pv[g & 1][bj].z, pv[g & 1][bj].w};
#pragma unroll
                for (int k = 0; k < 4; ++k) { const float a0 = k < 2 ? v0[2 * k] : v1[2 * k - 4], a1 = k < 2 ? v0[2 * k + 1] : v1[2 * k - 3];
                    const float g0 = __builtin_bit_cast(float, gw[k] << 16), g1 = __builtin_bit_cast(float, gw[k] & 0xffff0000u);
                    o[2 * k] = fmaf(a0, fsig(g0), __builtin_bit_cast(float, pw[k] << 16)); o[2 * k + 1] = fmaf(a1, fsig(g1), __builtin_bit_cast(float, pw[k] & 0xffff0000u)); }
                u32x4 w; w.x = cvt_pk_bf16(o[0], o[1]); w.y = cvt_pk_bf16(o[2], o[3]); w.z = cvt_pk_bf16(o[4], o[5]); w.w = cvt_pk_bf16(o[6], o[7]);
                *(u32x4*)(MGp + row * D + col0 + bj * HALF) = w; } }
#undef EMG_LOAD
    }
};
struct EpiResF32 {
    static constexpr bool PERM = false;
    const float* R; float* O; int ldc;
    __device__ __forceinline__ void operator()(const f32x4 (&acc)[2][2][4][2], const Unit& u, int wr, int wc, int fr, int fq) const {
        const int row0 = u.row0 + wr * 64 + fr, col0 = u.pn * BM + wc * 32 + 4 * fq;
        const float* __restrict__ Rp = R; float* __restrict__ Op = O;
        f32x4 rv[2][4];
#define ERES_LOAD(buf, g) do { const size_t off_ = (size_t)(row0 + ((g) >> 2) * HALF + ((g) & 3) * 16) * ldc + col0; \
            _Pragma("unroll") for (int q_ = 0; q_ < 4; ++q_) rv[buf][q_] = *(const f32x4*)(Rp + off_ + (q_ >> 1) * HALF + (q_ & 1) * 16); } while (0)
        ERES_LOAD(0, 0);
#pragma unroll
        for (int g = 0; g < 8; ++g) { if (g + 1 < 8) ERES_LOAD((g + 1) & 1, g + 1);
            const int ai = g >> 2, m = g & 3; const size_t off = (size_t)(row0 + ai * HALF + m * 16) * ldc + col0;
            if (ai == 0 || !u.half) {
#pragma unroll
                for (int q = 0; q < 4; ++q) *(f32x4*)(Op + off + (q >> 1) * HALF + (q & 1) * 16) = acc[ai][q >> 1][m][q & 1] + rv[g & 1][q]; } }
#undef ERES_LOAD
    }
};
struct EpiMoe1 {
    static constexpr bool PERM = true;
    bf16* ACT; const int* list; const float* ew; const float* rstd;
    __device__ __forceinline__ void operator()(const f32x4 (&acc)[2][2][4][2], const Unit& u, int wr, int wc, int fr, int fq) const {
        const int col0 = u.pn * 128 + wc * 32 + 8 * fq;
#pragma unroll
        for (int ai = 0; ai < 2; ++ai) if (ai == 0 || !u.half)
#pragma unroll
            for (int m = 0; m < 4; ++m) { const int r = ai * HALF + wr * 64 + m * 16 + fr; float w = 0.f, rsd = 0.f;
                if (r < u.nvalid) { const int entry = list[u.e * 8192 + u.pm * 256 + r]; w = ew[entry]; rsd = rstd[entry >> 1]; }
                float o[8];
#pragma unroll
                for (int n = 0; n < 2; ++n)
#pragma unroll
                    for (int j = 0; j < 4; ++j) { const float g = acc[ai][0][m][n][j] * rsd, up = acc[ai][1][m][n][j] * rsd; o[n * 4 + j] = g * fsig(g) * up * w; }
                u32x4 pk; pk.x = cvt_pk_bf16(o[0], o[1]); pk.y = cvt_pk_bf16(o[2], o[3]); pk.z = cvt_pk_bf16(o[4], o[5]); pk.w = cvt_pk_bf16(o[6], o[7]);
                *(u32x4*)(ACT + (size_t)(u.slot0 + r) * FF + col0) = pk; }
    }
};
struct EpiMoe2 {
    static constexpr bool PERM = true;
    bf16* CO; const int* list;
    __device__ __forceinline__ void operator()(const f32x4 (&acc)[2][2][4][2], const Unit& u, int wr, int wc, int fr, int fq) const {
        const int col0 = u.pn * BM + wc * 32 + 8 * fq;
#pragma unroll
        for (int ai = 0; ai < 2; ++ai) if (ai == 0 || !u.half)
#pragma unroll
            for (int m = 0; m < 4; ++m) { const int r = ai * HALF + wr * 64 + m * 16 + fr;
                if (r < u.nvalid) { const int entry = list[u.e * 8192 + u.pm * 256 + r]; bf16* rowp = CO + (size_t)entry * D + col0;
#pragma unroll
                    for (int bj = 0; bj < 2; ++bj) { const f32x4 v0 = acc[ai][bj][m][0], v1 = acc[ai][bj][m][1];
                        u32x4 w; w.x = cvt_pk_bf16(v0[0], v0[1]); w.y = cvt_pk_bf16(v0[2], v0[3]); w.z = cvt_pk_bf16(v1[0], v1[1]); w.w = cvt_pk_bf16(v1[2], v1[3]);
                        *(u32x4*)(rowp + bj * HALF) = w; } } }
    }
};
}

struct Frame {
    LAS unsigned char* lds; volatile LAS unsigned* MISC;
    int tid, lane, wave, vcu, G, gw, NGW, bid;
};
struct Args { const GAS float* in[22]; GAS float* out; GAS unsigned char* ws; int ph_lo, ph_hi, li, pad; };
typedef const __attribute__((address_space(4))) Args KArgs;
__device__ __forceinline__ KArgs* ka_fresh() { unsigned long long p = (unsigned long long)__builtin_amdgcn_kernarg_segment_ptr(); asm volatile("" : "+s"(p)); return (KArgs*)p; }
#define KA KArgs* const ka = ka_fresh()
#define KIN(i) ((const float*)ka->in[i])
#define KWS ((unsigned char*)ka->ws)
#define KOUT ((float*)ka->out)
enum { I_X = 0, I_NMIX, I_WIN, I_PE, I_W1, I_W2, I_QN, I_KN, I_LB, I_HGN, I_WA2, I_BA, I_GLAN, I_WBR, I_WOUT, I_NFFN, I_WGRP, I_BGRP, I_WEXP, I_BEXP, I_WGU, I_WDN };

__device__ __forceinline__ void tr_item(const float* W, size_t ldw, int c0, int nv, bf16* WT, size_t ldt, int r0, int k0, LAS float* scr, int lane) {
    const int nn = lane & 31;
    float tv[32];
#pragma unroll
    for (int i = 0; i < 32; ++i) { const int kk = 2 * i + (lane >> 5); tv[i] = nn < nv ? __builtin_nontemporal_load(W + (size_t)(k0 + kk) * ldw + c0 + nn) : 0.f; }
#pragma unroll
    for (int i = 0; i < 32; ++i) { const int kk = 2 * i + (lane >> 5); scr[kk * 33 + nn] = tv[i]; }
    LDS_WAIT();
    const int c = lane & 7;
#pragma unroll
    for (int j = 0; j < 4; ++j) { const int n = (lane >> 3) + 8 * j; const LAS float* s = scr + (8 * c) * 33 + n;
        u32x4 o; o.x = pk2(s[0 * 33], s[1 * 33]); o.y = pk2(s[2 * 33], s[3 * 33]); o.z = pk2(s[4 * 33], s[5 * 33]); o.w = pk2(s[6 * 33], s[7 * 33]);
        if (n < nv) __builtin_nontemporal_store(o, (u32x4*)(WT + (size_t)(r0 + n) * ldt + k0 + 8 * c)); }
    LDS_WAIT();
}
__device__ __forceinline__ void phase_prologue(Frame& F) {
    KA;
    {
      bf16* W1T = (bf16*)(KWS + WS_CW); bf16* W2T = (bf16*)(KWS + WS_CW + 1048576); float* B1 = (float*)(KWS + WS_CW + 1572864);
      for (int i = F.bid * 512 + F.tid; i < NL * 2 * 64 * 2048; i += F.G * 512) { const int lk = i / (64 * 2048), j = (i / 2048) % 64, c = i % 2048; W1T[i] = (bf16)f2bf(KIN(I_W1)[((size_t)lk * 2048 + c) * 64 + j]); }
      for (int i = F.bid * 512 + F.tid; i < NL * 2 * 64 * 64; i += F.G * 512) { const int lk = i / 4096, j2 = (i / 64) % 64, j = i % 64; W2T[i] = (bf16)f2bf(KIN(I_W2)[((size_t)lk * 64 + j) * 64 + j2]); }
      if (F.bid < NL * 2) { const int lk = F.bid, j = F.tid & 63, part = F.tid >> 6; float a = 0.f;
#pragma unroll 8
          for (int c = part * 256; c < part * 256 + 256; ++c) a += KIN(I_PE)[(size_t)lk * 2048 + c] * KIN(I_W1)[((size_t)lk * 2048 + c) * 64 + j];
          LAS float* rd = (LAS float*)F.lds; rd[F.tid] = a; __syncthreads();
          if (F.tid < 64) { float t2 = 0.f;
#pragma unroll
              for (int p = 0; p < 8; ++p) t2 += rd[p * 64 + F.tid];
              B1[lk * 64 + F.tid] = t2; }
          __syncthreads(); } }
    { float* WRT = (float*)(KWS + WS_WRT);
      for (int i = F.bid * 512 + F.tid; i < NL * 48 * D; i += F.G * 512) { const int l = i / (48 * D), n = (i / D) % 48, k = i % D; const float g = KIN(I_NFFN)[l * D + k];
          WRT[i] = n < 32 ? g * KIN(I_WEXP)[((size_t)l * D + k) * 32 + n] : (n < 36 ? g * KIN(I_WGRP)[((size_t)l * D + k) * 4 + (n - 32)] : 0.f); } }
    LAS float* scr = (LAS float*)(F.lds + F.wave * 16384);
    constexpr int IT_WIN = 32 * 346, IT_WBR = 3 * 8 * 64, IT_WOUT = 32 * 64, IT_WGU = 32 * 32 * 32, IT_WDN = 32 * 8 * 64, IT_L = IT_WIN + IT_WBR + IT_WOUT + IT_WGU + IT_WDN;
    for (int it = F.gw; it < NL * IT_L; it += F.NGW) {
        const int l = it / IT_L; int r = it % IT_L;
        if (r < IT_WIN) { const int kb = r / 346, nb = r % 346; int src, dst, nv = 32;
            if (nb < 40) { src = nb * 32; dst = nb * 32; }
            else if (nb == 40) { src = 1280; dst = C_NG; nv = 24; }
            else if (nb < 153) { src = 1304 + 32 * (nb - 41); dst = 1280 + 32 * (nb - 41); }
            else if (nb == 153) { src = 4888; dst = C_GA; nv = 16; }
            else { src = 4904 + 32 * (nb - 154); dst = C_MG + 32 * (nb - 154); }
            tr_item(KIN(I_WIN) + (size_t)l * D * INC, INC, src, nv, (bf16*)(KWS + WS_WIN) + (size_t)l * NPAD * D, D, dst, kb * 64, scr, F.lane); continue; }
        r -= IT_WIN;
        if (r < IT_WBR) { const int n = r / 512, q = r % 512, kb = q / 64, nb = q % 64;
            tr_item(KIN(I_WBR) + ((size_t)l * 3 + n) * 512 * D, D, nb * 32, 32, (bf16*)(KWS + WS_WBR) + ((size_t)l * 3 + n) * D * 512, 512, nb * 32, kb * 64, scr, F.lane); continue; }
        r -= IT_WBR;
        if (r < IT_WOUT) { const int kb = r / 64, nb = r % 64;
            tr_item(KIN(I_WOUT) + (size_t)l * D * D, D, nb * 32, 32, (bf16*)(KWS + WS_WOUT) + (size_t)l * D * D, D, nb * 32, kb * 64, scr, F.lane); continue; }
        r -= IT_WOUT;
        if (r < IT_WGU) { const int e = r / 1024, q = r % 1024, kb = q / 32, nb = q % 32;
            tr_item(KIN(I_WGU) + ((size_t)l * NE + e) * D * 1024, 1024, nb * 32, 32, (bf16*)(KWS + WS_WGU) + ((size_t)l * NE + e) * 1024 * D, D, nb * 32, kb * 64, scr, F.lane); continue; }
        r -= IT_WGU;
        { const int e = r / 512, q = r % 512, kb = q / 64, nb = q % 64;
            tr_item(KIN(I_WDN) + ((size_t)l * NE + e) * FF * D, D, nb * 32, 32, (bf16*)(KWS + WS_WDN) + ((size_t)l * NE + e) * D * FF, FF, nb * 32, kb * 64, scr, F.lane); }
    }
}

template <int MODE> __device__ __forceinline__ void phase_norm1(Frame& F, const float* xin, const bf16* contrib, float* xout, const float* gain, bf16* H) {
    for (int t0 = F.gw; t0 < T; t0 += 2 * F.NGW) {
        f32x4 v[2][8]; float ss[2] = {0.f, 0.f};
#pragma unroll
        for (int rr = 0; rr < 2; ++rr) { const int t = t0 + rr * F.NGW; if (t < T) {
            const f32x4* xr = (const f32x4*)(xin + (size_t)t * D) + F.lane;
#pragma unroll
            for (int j = 0; j < 8; ++j) v[rr][j] = xr[64 * j]; } }
        u32x2 c0[2][8], c1[2][8];
        if (MODE != 0) {
#pragma unroll
            for (int rr = 0; rr < 2; ++rr) { const int t = t0 + rr * F.NGW; if (t < T) {
#pragma unroll
                for (int j = 0; j < 8; ++j) { c0[rr][j] = *((const u32x2*)(contrib + (size_t)(2 * t) * D) + F.lane + 64 * j); c1[rr][j] = *((const u32x2*)(contrib + (size_t)(2 * t + 1) * D) + F.lane + 64 * j); } } } }
#pragma unroll
        for (int rr = 0; rr < 2; ++rr) { const int t = t0 + rr * F.NGW; if (t < T) {
#pragma unroll
            for (int j = 0; j < 8; ++j) {
                if (MODE != 0) { v[rr][j].x += bflo(c0[rr][j].x) + bflo(c1[rr][j].x); v[rr][j].y += bfhi(c0[rr][j].x) + bfhi(c1[rr][j].x); v[rr][j].z += bflo(c0[rr][j].y) + bflo(c1[rr][j].y); v[rr][j].w += bfhi(c0[rr][j].y) + bfhi(c1[rr][j].y);
                    *((f32x4*)(xout + (size_t)t * D) + F.lane + 64 * j) = v[rr][j]; }
                ss[rr] += v[rr][j].x * v[rr][j].x + v[rr][j].y * v[rr][j].y + v[rr][j].z * v[rr][j].z + v[rr][j].w * v[rr][j].w; } } }
        if (MODE != 2) {
#pragma unroll
            for (int rr = 0; rr < 2; ++rr) { const int t = t0 + rr * F.NGW; if (t < T) {
                const float rstd = 1.0f / sqrtf(wave_sum(ss[rr]) * (1.0f / D) + EPS);
#pragma unroll
                for (int j = 0; j < 8; ++j) { const f32x4 g = *((const f32x4*)gain + F.lane + 64 * j);
                    u32x2 o; o.x = pkbf(v[rr][j].x * rstd * g.x, v[rr][j].y * rstd * g.y); o.y = pkbf(v[rr][j].z * rstd * g.z, v[rr][j].w * rstd * g.w);
                    *((u32x2*)(H + (size_t)t * D) + F.lane + 64 * j) = o; } } }
        }
    }
}

__device__ __forceinline__ void phase_prep(Frame& F, int l) {
    KA;
    const bf16* P = (const bf16*)(KWS + WS_P);
    float* QN = (float*)(KWS + WS_QN); float* KV = (float*)(KWS + WS_KV);
    const float* qg = KIN(I_QN) + l * 64; const float* kg = KIN(I_KN) + l * 192;
    for (int it = F.gw; it < T * 20; it += F.NGW) {
        const int t = it / 20, v = it % 20;
        float x = bf2f(P[(size_t)t * NPAD + v * 64 + F.lane]);
        const bool isq = v < 8, nk1 = (v == 12 || v == 13), nk2 = (v == 16 || v == 17);
        if (isq || nk1 || nk2) { const float ss = wave_sum(x * x); const float g = isq ? qg[F.lane] : (nk1 ? kg[64 + F.lane] : kg[128 + F.lane]); x = x * (1.0f / sqrtf(ss * (1.0f / 64.0f) + EPS)) * g; }
        if (isq) QN[((size_t)v * T + t) * 64 + F.lane] = x;
        else { const int w = v - 8, tens = w >> 1, g = w & 1; KV[(size_t)tens * KV_STRIDE + ((size_t)g * T + t) * 64 + F.lane] = x; }
    }
}
__device__ __forceinline__ float gelu_tanh(float x) { const float u = 0.7978845608028654f * (x + 0.044715f * x * x * x); return 0.5f * x * (1.0f + tanhf(u)); }
__device__ __forceinline__ void phase_compress(Frame& F, int l) {
    KA;
    LAS float* av = (LAS float*)(F.lds + F.wave * 16384);
    const float* KV = (const float*)(KWS + WS_KV); float* KC = (float*)(KWS + WS_KC);
    for (int it = F.gw; it < 2 * 2 * 511; it += F.NGW) {
        const int kind = it / 1022, q = it % 1022, g = q / 511, n = q % 511;
        const float* src = KV + (size_t)kind * KV_STRIDE + ((size_t)g * T + 16 * n) * 64;
        const float* pe = KIN(I_PE) + ((size_t)l * 2 + kind) * 2048;
        const float* w1 = KIN(I_W1) + ((size_t)l * 2 + kind) * 2048 * 64;
        const float* w2 = KIN(I_W2) + ((size_t)l * 2 + kind) * 64 * 64;
#pragma unroll 4
        for (int c = 0; c < 32; ++c) av[c * 64 + F.lane] = src[c * 64 + F.lane] + pe[c * 64 + F.lane];
        WSYNC();
        float acc = 0.f;
#pragma unroll 8
        for (int i = 0; i < 2048; ++i) acc += av[i] * w1[i * 64 + F.lane];
        const float hid = gelu_tanh(acc);
        WSYNC();
        av[F.lane] = hid;
        WSYNC();
        float o = 0.f;
#pragma unroll 8
        for (int i = 0; i < 64; ++i) o += av[i] * w2[i * 64 + F.lane];
        WSYNC();
        if (kind == 0) { const float ss = wave_sum(o * o); o = o * (1.0f / sqrtf(ss * (1.0f / 64.0f) + EPS)) * KIN(I_KN)[l * 192 + F.lane]; }
        KC[(size_t)kind * (2 * 512 * 64) + ((size_t)g * 512 + n) * 64 + F.lane] = o;
    }
}
__device__ __forceinline__ void phase_recur(Frame& F, int l) {
    KA;
    const bf16* P = (const bf16*)(KWS + WS_P); float* ORAW = (float*)(KWS + WS_ORAW);
    for (int it = F.gw; it < 1024; it += F.NGW) {
        const int kind = it >> 9, head = (it >> 7) & 3, j = it & 127;
        if (kind == 0) {
            const int d0 = F.lane, d1 = F.lane + 64;
            const float* lbl = KIN(I_LB);
            float lb0, lb1;
            { const float a0 = lbl[head * 128 + d0], b0 = lbl[512 + head * 128 + d0], a1 = lbl[head * 128 + d1], b1 = lbl[512 + head * 128 + d1];
              lb0 = l == 0 ? 0.f : 1.0f / (1.0f + expf(a0 - b0)); lb1 = l == 0 ? 0.f : 1.0f / (1.0f + expf(a1 - b1)); }
            const bf16* Pq = P + C_HQ + head * 128; const bf16* Pf = P + C_HF + head * 128; const bf16* Pi = P + C_HI + head * 128 + j;
            float S0 = 0.f, S1 = 0.f;
            for (int t0 = 0; t0 < T; t0 += 8) {
                bf16 zq0[8], zq1[8], zf0[8], zf1[8], vi[8];
#pragma unroll
                for (int u = 0; u < 8; ++u) { const size_t row = (size_t)(t0 + u) * NPAD; zq0[u] = Pq[row + d0]; zq1[u] = Pq[row + d1]; zf0[u] = Pf[row + d0]; zf1[u] = Pf[row + d1]; vi[u] = Pi[row]; }
                float part[8];
#pragma unroll
                for (int u = 0; u < 8; ++u) { const float v = bf2f(vi[u]);
                    const float s0 = sigmoidf_(bf2f(zf0[u])), s1 = sigmoidf_(bf2f(zf1[u]));
                    const float f0 = lb0 + (1.0f - lb0) * s0, f1 = lb1 + (1.0f - lb1) * s1;
                    const float k0 = (1.0f - lb0) * (1.0f - s0), k1 = (1.0f - lb1) * (1.0f - s1);
                    S0 = f0 * S0 + k0 * v; S1 = f1 * S1 + k1 * v;
                    part[u] = bf2f(zq0[u]) * S0 + bf2f(zq1[u]) * S1; }
                float mine = 0.f;
#pragma unroll
                for (int u = 0; u < 8; ++u) { const float s = wave_sum(part[u]); mine = (F.lane == u) ? s : mine; }
                if (F.lane < 8) ORAW[(size_t)(t0 + F.lane) * 1024 + head * 128 + j] = mine;
            }
        } else {
            const int d = F.lane, c = head * 64 + d;
            float wa[16];
#pragma unroll
            for (int r = 0; r < 16; ++r) wa[r] = KIN(I_WA2)[((size_t)l * 16 + r) * 256 + c];
            const float ba = KIN(I_BA)[l * 256 + c];
            const bf16* Pq = P + C_GQ + c; const bf16* Pk = P + C_GK + c; const bf16* Pv = P + C_GV + head * 128 + j; const bf16* Pa = P + C_GA;
            float S = 0.f;
            for (int t0 = 0; t0 < T; t0 += 8) {
                bf16 zq[8], zk[8], zv[8]; u32x4 ga0[8], ga1[8];
#pragma unroll
                for (int u = 0; u < 8; ++u) { const size_t row = (size_t)(t0 + u) * NPAD; zq[u] = Pq[row]; zk[u] = Pk[row]; zv[u] = Pv[row]; ga0[u] = *(const u32x4*)(Pa + row); ga1[u] = *(const u32x4*)(Pa + row + 8); }
                float part[8];
#pragma unroll
                for (int u = 0; u < 8; ++u) {
                    float a = ba;
                    a += bflo(ga0[u].x) * wa[0] + bfhi(ga0[u].x) * wa[1] + bflo(ga0[u].y) * wa[2] + bfhi(ga0[u].y) * wa[3] + bflo(ga0[u].z) * wa[4] + bfhi(ga0[u].z) * wa[5] + bflo(ga0[u].w) * wa[6] + bfhi(ga0[u].w) * wa[7];
                    a += bflo(ga1[u].x) * wa[8] + bfhi(ga1[u].x) * wa[9] + bflo(ga1[u].y) * wa[10] + bfhi(ga1[u].y) * wa[11] + bflo(ga1[u].z) * wa[12] + bfhi(ga1[u].z) * wa[13] + bflo(ga1[u].w) * wa[14] + bfhi(ga1[u].w) * wa[15];
                    const float ls = fminf(a, 0.f) - log1pf(expf(-fabsf(a)));
                    const float f = expf(ls * (1.0f / 16.0f));
                    S = f * S + bf2f(zk[u]) * bf2f(zv[u]);
                    part[u] = bf2f(zq[u]) * 0.125f * S; }
                float mine = 0.f;
#pragma unroll
                for (int u = 0; u < 8; ++u) { const float s = wave_sum(part[u]); mine = (F.lane == u) ? s : mine; }
                if (F.lane < 8) ORAW[(size_t)(t0 + F.lane) * 1024 + 512 + head * 128 + j] = mine;
            }
        }
    }
}
__device__ __forceinline__ void phase_recur_out(Frame& F, int l) {
    KA;
    const bf16* P = (const bf16*)(KWS + WS_P); const float* ORAW = (const float*)(KWS + WS_ORAW); bf16* OCAT = (bf16*)(KWS + WS_OCAT);
    for (int it = F.gw; it < T * 8; it += F.NGW) {
        const int t = it >> 3, kind = (it >> 2) & 1, head = it & 3;
        const float* gn = (kind == 0 ? KIN(I_HGN) : KIN(I_GLAN)) + l * 128;
        const int cg = (kind == 0 ? C_HG : C_GR) + head * 128;
        const float r0 = ORAW[(size_t)t * 1024 + kind * 512 + head * 128 + F.lane], r1 = ORAW[(size_t)t * 1024 + kind * 512 + head * 128 + 64 + F.lane];
        const float rstd = 1.0f / sqrtf(wave_sum(r0 * r0 + r1 * r1) * (1.0f / 128.0f) + EPS);
        const float g0 = bf2f(P[(size_t)t * NPAD + cg + F.lane]), g1 = bf2f(P[(size_t)t * NPAD + cg + 64 + F.lane]);
        const float a0 = kind == 0 ? sigmoidf_(g0) : g0 * sigmoidf_(g0), a1 = kind == 0 ? sigmoidf_(g1) : g1 * sigmoidf_(g1);
        OCAT[(size_t)t * 1536 + 512 + kind * 512 + head * 128 + F.lane] = (bf16)f2bf(r0 * rstd * gn[F.lane] * a0);
        OCAT[(size_t)t * 1536 + 512 + kind * 512 + head * 128 + 64 + F.lane] = (bf16)f2bf(r1 * rstd * gn[64 + F.lane] * a1);
    }
}


template <int KIND> struct RecCfg { static constexpr int DK = KIND == 0 ? 128 : 64, NSEG = 512 / DK, TPS = 64 / NSEG, QROW = (DK + 8) * 2; };
constexpr int REC_VT_OFF = 0;
constexpr int REC_KD_OFF = 18432;
constexpr int REC_QS_OFF = 36864;
constexpr int REC_KS_OFF = 54272;
constexpr int REC_QD_OFF = 71680;
constexpr int REC_RED_OFF = 89088;
constexpr int REC_TOT_OFF = 91136;
__device__ __forceinline__ float expc(float x2) { return __builtin_amdgcn_exp2f(fminf(x2, 110.0f)); }
template <int KIND> __device__ __forceinline__ void rec_elem(KArgs* ka, int l, int head, int chunk, int tid, LAS float* tot,
        float (&qv)[RecCfg<KIND>::TPS], float (&kv)[RecCfg<KIND>::TPS], float (&bv)[RecCfg<KIND>::TPS], float& bend, float& bref) {
    constexpr int DK = RecCfg<KIND>::DK, NSEG = RecCfg<KIND>::NSEG, TPS = RecCfg<KIND>::TPS;
    const int d = tid % DK, seg = tid / DK, t0 = chunk * 64 + seg * TPS;
    const bf16* P = (const bf16*)(KWS + WS_P);
    float run = 0.f;
    if (KIND == 0) {
        const int c = head * 128 + d;
        float lb = 0.f;
        if (l > 0) { const float a0 = KIN(I_LB)[c], b0 = KIN(I_LB)[512 + c]; lb = 1.0f / (1.0f + expf(a0 - b0)); }
        const float omlb = 1.0f - lb;
        unsigned zr[TPS], qr[TPS];
#pragma unroll
        for (int u = 0; u < TPS; ++u) { const size_t row = (size_t)(t0 + u) * NPAD; zr[u] = P[row + C_HF + c]; qr[u] = P[row + C_HQ + c]; }
#pragma unroll
        for (int u = 0; u < TPS; ++u) {
            const float z = bf2f(zr[u]); qv[u] = bf2f(qr[u]);
            const float e = __builtin_amdgcn_exp2f(-LOG2E * z), sg = __builtin_amdgcn_rcpf(1.0f + e), f = fmaf(omlb, sg, lb);
            kv[u] = omlb * (e * sg);
            run += __builtin_amdgcn_logf(fmaxf(f, 1e-30f)); bv[u] = run; }
    } else {
        const int c = head * 64 + d;
        float wa[16];
#pragma unroll
        for (int r = 0; r < 16; ++r) wa[r] = KIN(I_WA2)[((size_t)l * 16 + r) * 256 + c];
        const float ba = KIN(I_BA)[l * 256 + c];
        u32x4 g0r[TPS], g1r[TPS]; unsigned qr[TPS], kr[TPS];
#pragma unroll
        for (int u = 0; u < TPS; ++u) { const size_t row = (size_t)(t0 + u) * NPAD; g0r[u] = *(const u32x4*)(P + row + C_GA); g1r[u] = *(const u32x4*)(P + row + C_GA + 8); qr[u] = P[row + C_GQ + c]; kr[u] = P[row + C_GK + c]; }
#pragma unroll
        for (int u = 0; u < TPS; ++u) { const u32x4 g0 = g0r[u], g1 = g1r[u];
            float a = ba;
            a += bflo(g0.x) * wa[0] + bfhi(g0.x) * wa[1] + bflo(g0.y) * wa[2] + bfhi(g0.y) * wa[3] + bflo(g0.z) * wa[4] + bfhi(g0.z) * wa[5] + bflo(g0.w) * wa[6] + bfhi(g0.w) * wa[7];
            a += bflo(g1.x) * wa[8] + bfhi(g1.x) * wa[9] + bflo(g1.y) * wa[10] + bfhi(g1.y) * wa[11] + bflo(g1.z) * wa[12] + bfhi(g1.z) * wa[13] + bflo(g1.w) * wa[14] + bfhi(g1.w) * wa[15];
            const float ls2 = fminf(a, 0.f) * LOG2E - __builtin_amdgcn_logf(1.0f + __builtin_amdgcn_exp2f(-LOG2E * fabsf(a)));
            qv[u] = bf2f(qr[u]) * 0.125f; kv[u] = bf2f(kr[u]);
            run += ls2 * (1.0f / 16.0f); bv[u] = run; }
    }
    tot[seg * DK + d] = run;
    __syncthreads();
    float off = 0.f; bend = 0.f; bref = 0.f;
#pragma unroll
    for (int sgi = 0; sgi < NSEG; ++sgi) { const float v = tot[sgi * DK + d]; off += sgi < seg ? v : 0.f; bref += sgi < NSEG / 2 ? v : 0.f; bend += v; }
#pragma unroll
    for (int u = 0; u < TPS; ++u) bv[u] += off;
}
template <int KIND> __device__ __forceinline__ void rec_vt_load(KArgs* ka, int head, int chunk, int tid, unsigned (&w)[8]) {
    const bf16* P = (const bf16*)(KWS + WS_P) + (KIND == 0 ? C_HI : C_GV) + head * 128;
    const int v = tid & 127, sv = tid >> 7;
#pragma unroll
    for (int u = 0; u < 8; ++u) { const unsigned a = P[(size_t)(chunk * 64 + sv * 16 + 2 * u) * NPAD + v], b = P[(size_t)(chunk * 64 + sv * 16 + 2 * u + 1) * NPAD + v]; w[u] = a | (b << 16); }
}
__device__ __forceinline__ void rec_vt_store(int tid, LAS unsigned char* lds, const unsigned (&w)[8]) {
    const int v = tid & 127, sv = tid >> 7;
    LAS u32x4* dst = (LAS u32x4*)(lds + REC_VT_OFF + v * 144 + sv * 32);
    dst[0] = (u32x4){w[0], w[1], w[2], w[3]}; dst[1] = (u32x4){w[4], w[5], w[6], w[7]};
}
template <int KIND> __device__ __forceinline__ void rec_local_unit(KArgs* ka, Frame& F, int l, int head, int chunk) {
    constexpr int DK = RecCfg<KIND>::DK, TPS = RecCfg<KIND>::TPS;
    LAS unsigned char* lds = F.lds; LAS float* tot = (LAS float*)(lds + REC_TOT_OFF);
    float qv[TPS], kv[TPS], bv[TPS], bend, bref;
    unsigned vraw[8];
    rec_vt_load<KIND>(ka, head, chunk, F.tid, vraw);
    rec_elem<KIND>(ka, l, head, chunk, F.tid, tot, qv, kv, bv, bend, bref);
    const int d = F.tid % DK, seg = F.tid / DK, unit = chunk * 4 + head;
    { unsigned w[TPS / 2];
#pragma unroll
      for (int u = 0; u < TPS / 2; ++u) w[u] = pkbf(kv[2 * u] * expc(bend - bv[2 * u]), kv[2 * u + 1] * expc(bend - bv[2 * u + 1]));
      LAS u32x4* dst = (LAS u32x4*)(lds + REC_KD_OFF + d * 144 + seg * TPS * 2);
      dst[0] = (u32x4){w[0], w[1], w[2], w[3]};
      if constexpr (TPS == 16) dst[1] = (u32x4){w[4], w[5], w[6], w[7]}; }
    if (seg == 0) ((float*)(KWS + WS_DEC + (KIND == 0 ? 0 : 262144)))[(size_t)unit * DK + d] = __builtin_amdgcn_exp2f(bend);
    rec_vt_store(F.tid, lds, vraw);
    __syncthreads();
    const int r = F.lane & 15, kq = F.lane >> 4;
    const int dt = KIND == 0 ? F.wave : (F.wave & 3), vt0 = KIND == 0 ? 0 : (F.wave >> 2) * 4, nvt = KIND == 0 ? 8 : 4;
    bf16x8 a[2];
#pragma unroll
    for (int ks = 0; ks < 2; ++ks) a[ks] = *(const LAS bf16x8*)(lds + REC_KD_OFF + (16 * dt + r) * 144 + (32 * ks + 8 * kq) * 2);
    float* Sl = (float*)(KWS + (KIND == 0 ? WS_SLOC_HG : WS_SLOC_GL)) + (size_t)unit * 128 * DK;
#pragma unroll
    for (int vi = 0; vi < nvt; ++vi) { const int vt = vt0 + vi; f32x4 acc = {0.f, 0.f, 0.f, 0.f};
#pragma unroll
        for (int ks = 0; ks < 2; ++ks) { const bf16x8 b = *(const LAS bf16x8*)(lds + REC_VT_OFF + (16 * vt + r) * 144 + (32 * ks + 8 * kq) * 2); acc = __builtin_amdgcn_mfma_f32_16x16x32_bf16(a[ks], b, acc, 0, 0, 0); }
        *(f32x4*)(Sl + (size_t)(16 * vt + r) * DK + 16 * dt + 4 * kq) = acc; }
    __syncthreads();
}
__device__ __forceinline__ void phase_rec_local(Frame& F, int l) {
    KA;
    for (int it = F.bid; it < 1024; it += F.G) { const int kind = it >> 9, chunk = (it >> 2) & 127, head = it & 3;
        if (kind == 0) rec_local_unit<0>(ka, F, l, head, chunk); else rec_local_unit<1>(ka, F, l, head, chunk); }
}
__device__ __forceinline__ void phase_rec_scan(Frame& F) {
    KA;
    const int gt = F.bid * 512 + F.tid;
    if (gt >= 49152) return;
    const bool hg = gt < 32768; const int q = hg ? gt : gt - 32768;
    const int DK = hg ? 128 : 64, dp = q % (DK / 2), v = (q / (DK / 2)) & 127, head = q / (DK / 2 * 128);
    const float* Sl = (const float*)(KWS + (hg ? WS_SLOC_HG : WS_SLOC_GL)) + ((size_t)head * 128 + v) * DK + 2 * dp;
    bf16* Sp = (bf16*)(KWS + (hg ? WS_SPREV_HG : WS_SPREV_GL)) + ((size_t)head * 128 + v) * DK + 2 * dp;
    const float* De = (const float*)(KWS + WS_DEC + (hg ? 0 : 262144)) + (size_t)head * DK + 2 * dp;
    const size_t ustr = (size_t)4 * 128 * DK, dstr = (size_t)4 * DK;
    float s0 = 0.f, s1 = 0.f;
    for (int c0 = 0; c0 < NCH; c0 += 16) { f32x2 x[16], dc[16];
#pragma unroll
        for (int u = 0; u < 16; ++u) { x[u] = *(const f32x2*)(Sl + (size_t)(c0 + u) * ustr); dc[u] = *(const f32x2*)(De + (size_t)(c0 + u) * dstr); }
#pragma unroll
        for (int u = 0; u < 16; ++u) { *(unsigned*)(Sp + (size_t)(c0 + u) * ustr) = pkbf(s0, s1); s0 = dc[u].x * s0 + x[u].x; s1 = dc[u].y * s1 + x[u].y; } }
}
template <int KIND> __device__ __forceinline__ void rec_out_unit(KArgs* ka, Frame& F, int l, int head, int chunk) {
    constexpr int DK = RecCfg<KIND>::DK, TPS = RecCfg<KIND>::TPS, QROW = RecCfg<KIND>::QROW, NKS = DK / 32;
    LAS unsigned char* lds = F.lds; LAS float* tot = (LAS float*)(lds + REC_TOT_OFF); LAS float* red = (LAS float*)(lds + REC_RED_OFF);
    const int r = F.lane & 15, kq = F.lane >> 4, unit = chunk * 4 + head, vt = F.wave;
    bf16x8 sa[NKS];
    { const bf16* Sp = (const bf16*)(KWS + (KIND == 0 ? WS_SPREV_HG : WS_SPREV_GL)) + (size_t)unit * 128 * DK + (size_t)(16 * vt + r) * DK + 8 * kq;
#pragma unroll
      for (int ks = 0; ks < NKS; ++ks) sa[ks] = *(const bf16x8*)(Sp + 32 * ks); }
    float qv[TPS], kv[TPS], bv[TPS], bend, bref;
    unsigned vraw[8];
    rec_vt_load<KIND>(ka, head, chunk, F.tid, vraw);
    const bf16* P = (const bf16*)(KWS + WS_P); bf16* OCAT = (bf16*)(KWS + WS_OCAT);
    const int v0 = 16 * vt + 4 * kq;
    const f32x4 gn = *(const f32x4*)((KIND == 0 ? KIN(I_HGN) : KIN(I_GLAN)) + l * 128 + v0);
    u32x2 gq4[4];
#pragma unroll
    for (int it = 0; it < 4; ++it) gq4[it] = *(const u32x2*)(P + (size_t)(chunk * 64 + 16 * it + r) * NPAD + (KIND == 0 ? C_HG : C_GR) + head * 128 + v0);
    rec_elem<KIND>(ka, l, head, chunk, F.tid, tot, qv, kv, bv, bend, bref);
    { const int d = F.tid % DK, seg = F.tid / DK; const float eref = __builtin_amdgcn_exp2f(fmaxf(bref, -120.f));
#pragma unroll
      for (int u = 0; u < TPS; u += 2) { const int o = (seg * TPS + u) * QROW + d * 2;
          const float x0 = __builtin_amdgcn_exp2f(fminf(fmaxf(bv[u] - bref, -110.f), 110.f)), x1 = __builtin_amdgcn_exp2f(fminf(fmaxf(bv[u + 1] - bref, -110.f), 110.f));
          const float qs0 = qv[u] * x0, qs1 = qv[u + 1] * x1;
          const unsigned w0 = pkbf(qs0, qs1), w1 = pkbf(kv[u] * __builtin_amdgcn_rcpf(x0), kv[u + 1] * __builtin_amdgcn_rcpf(x1)), w2 = pkbf(qs0 * eref, qs1 * eref);
          *(LAS bf16*)(lds + REC_QS_OFF + o) = (bf16)w0; *(LAS bf16*)(lds + REC_QS_OFF + o + QROW) = (bf16)(w0 >> 16);
          *(LAS bf16*)(lds + REC_KS_OFF + o) = (bf16)w1; *(LAS bf16*)(lds + REC_KS_OFF + o + QROW) = (bf16)(w1 >> 16);
          *(LAS bf16*)(lds + REC_QD_OFF + o) = (bf16)w2; *(LAS bf16*)(lds + REC_QD_OFF + o + QROW) = (bf16)(w2 >> 16); } }
    rec_vt_store(F.tid, lds, vraw);
    __syncthreads();
#pragma unroll
    for (int tt = 0; tt < 2; ++tt) { const int tile = F.wave * 2 + tt, jt = tile >> 2, it = tile & 3; f32x4 acc = {0.f, 0.f, 0.f, 0.f};
        if (jt <= it) {
#pragma unroll
            for (int ks = 0; ks < NKS; ++ks) { const bf16x8 a = *(const LAS bf16x8*)(lds + REC_KS_OFF + (16 * jt + r) * QROW + (32 * ks + 8 * kq) * 2), b = *(const LAS bf16x8*)(lds + REC_QS_OFF + (16 * it + r) * QROW + (32 * ks + 8 * kq) * 2);
                acc = __builtin_amdgcn_mfma_f32_16x16x32_bf16(a, b, acc, 0, 0, 0); } }
        const int i = 16 * it + r, j0 = 16 * jt + 4 * kq;
        u32x2 w; w.x = pk2(j0 <= i ? acc[0] : 0.f, j0 + 1 <= i ? acc[1] : 0.f); w.y = pk2(j0 + 2 <= i ? acc[2] : 0.f, j0 + 3 <= i ? acc[3] : 0.f);
        *(LAS u32x2*)(lds + REC_KD_OFF + i * 144 + j0 * 2) = w; }
    __syncthreads();
    f32x4 acc[4];
#pragma unroll
    for (int it = 0; it < 4; ++it) acc[it] = (f32x4){0.f, 0.f, 0.f, 0.f};
#pragma unroll
    for (int ks = 0; ks < 2; ++ks) { const bf16x8 a = *(const LAS bf16x8*)(lds + REC_VT_OFF + (16 * vt + r) * 144 + (32 * ks + 8 * kq) * 2);
#pragma unroll
        for (int it = 0; it < 4; ++it) { const bf16x8 b = *(const LAS bf16x8*)(lds + REC_KD_OFF + (16 * it + r) * 144 + (32 * ks + 8 * kq) * 2); acc[it] = __builtin_amdgcn_mfma_f32_16x16x32_bf16(a, b, acc[it], 0, 0, 0); } }
#pragma unroll
    for (int ks = 0; ks < NKS; ++ks) {
#pragma unroll
        for (int it = 0; it < 4; ++it) { const bf16x8 b = *(const LAS bf16x8*)(lds + REC_QD_OFF + (16 * it + r) * QROW + (32 * ks + 8 * kq) * 2); acc[it] = __builtin_amdgcn_mfma_f32_16x16x32_bf16(sa[ks], b, acc[it], 0, 0, 0); } }
#pragma unroll
    for (int it = 0; it < 4; ++it) { float ss = acc[it][0] * acc[it][0] + acc[it][1] * acc[it][1] + acc[it][2] * acc[it][2] + acc[it][3] * acc[it][3];
        ss += __shfl_xor(ss, 16); ss += __shfl_xor(ss, 32);
        if (kq == 0) red[F.wave * 64 + 16 * it + r] = ss; }
    __syncthreads();
#pragma unroll
    for (int it = 0; it < 4; ++it) { const int i = 16 * it + r, t = chunk * 64 + i; float tot_ = 0.f;
#pragma unroll
        for (int w = 0; w < 8; ++w) tot_ += red[w * 64 + i];
        const float rstd = 1.0f / sqrtf(tot_ * (1.0f / 128.0f) + EPS);
        const u32x2 gq = gq4[it];
        float gt[4] = {bflo(gq.x), bfhi(gq.x), bflo(gq.y), bfhi(gq.y)}, o[4];
#pragma unroll
        for (int e = 0; e < 4; ++e) { const float sg = fsig(gt[e]); o[e] = acc[it][e] * rstd * gn[e] * (KIND == 0 ? sg : gt[e] * sg); }
        u32x2 w; w.x = pkbf(o[0], o[1]); w.y = pkbf(o[2], o[3]);
        *(u32x2*)(OCAT + (size_t)t * 1536 + 512 + KIND * 512 + head * 128 + v0) = w; }
    __syncthreads();
}
__device__ __forceinline__ void phase_rec_out(Frame& F, int l) {
    KA;
    for (int it = F.bid; it < 1024; it += F.G) { const int kind = it >> 9, chunk = (it >> 2) & 127, head = it & 3;
        if (kind == 0) rec_out_unit<0>(ka, F, l, head, chunk); else rec_out_unit<1>(ka, F, l, head, chunk); }
}

template <bool WIN> __device__ __forceinline__ void nsa_block(const float* Kg, const float* Vg, int j, int t, int lane, const LAS float* qs, LAS float* pb, const float (&slope)[4], float (&M)[4], float (&L)[4], float (&o)[4]) {
    const int pos = 64 * j + lane, dist = t - pos;
    const bool valid = WIN ? (dist >= 0 && dist < 512) : (dist >= 0);
    float dot[4] = {0.f, 0.f, 0.f, 0.f};
    const f32x4* kr = (const f32x4*)(Kg + (size_t)pos * 64);
#pragma unroll 2
    for (int c = 0; c < 16; ++c) { const f32x4 kv = kr[c];
#pragma unroll
        for (int r = 0; r < 4; ++r) { const f32x4 qv = *(const LAS f32x4*)(qs + r * 64 + c * 4); dot[r] += kv.x * qv.x + kv.y * qv.y + kv.z * qv.z + kv.w * qv.w; } }
#pragma unroll
    for (int r = 0; r < 4; ++r) {
        const float s = valid ? dot[r] * 0.125f - slope[r] * (float)dist : NEGB;
        const float nm = fmaxf(M[r], wave_max(s)), sc = expf(M[r] - nm), p = valid ? expf(s - nm) : 0.f;
        L[r] = L[r] * sc + wave_sum(p); o[r] *= sc; M[r] = nm; pb[r * 64 + lane] = p;
    }
    WSYNC();
#pragma unroll 4
    for (int k = 0; k < 64; ++k) { const float v = Vg[(size_t)(64 * j + k) * 64 + lane];
#pragma unroll
        for (int r = 0; r < 4; ++r) o[r] += pb[r * 64 + k] * v; }
    WSYNC();
}
__device__ __forceinline__ void phase_nsa(Frame& F, int l) {
    KA;
    LAS float* qs = (LAS float*)(F.lds + F.wave * 8192);
    LAS float* pbuf = qs + 256;
    LAS float* scb = pbuf + 512;
    LAS float* pb = scb + 128;
    LAS float* impb = pb + 256;
    LAS float* ocb = impb + 512;
    const bf16* P = (const bf16*)(KWS + WS_P); bf16* OCAT = (bf16*)(KWS + WS_OCAT);
    const float* QN = (const float*)(KWS + WS_QN); const float* KV = (const float*)(KWS + WS_KV); const float* KC = (const float*)(KWS + WS_KC);
    const int lane = F.lane;
    for (int it = F.gw; it < T * 2; it += F.NGW) {
        const int t = it >> 1, g = it & 1;
        float slope[4];
#pragma unroll
        for (int r = 0; r < 4; ++r) { slope[r] = exp2f(-(float)(g * 4 + r + 1)); qs[r * 64 + lane] = QN[((size_t)(g * 4 + r) * T + t) * 64 + lane]; }
        WSYNC();
        int nvis = t >= 31 ? (t - 31) / 16 + 1 : 0; nvis = nvis > 511 ? 511 : nvis;
        const float* KCg = KC + (size_t)g * 512 * 64; const float* VCg = KC + (size_t)(2 * 512 * 64) + (size_t)g * 512 * 64;
#pragma unroll 1
        for (int i = 0; i < 8; ++i) impb[lane + 64 * i] = 0.f;
#pragma unroll 1
        for (int r = 0; r < 4; ++r) {
            const float sl = exp2f(-(float)(g * 4 + r + 1));
            float mx = NEGB;
#pragma unroll 1
            for (int i = 0; i < 8; ++i) { const int n = lane + 64 * i; float sv = NEGB;
                if (n < nvis) { const f32x4* kr = (const f32x4*)(KCg + (size_t)n * 64); float dot = 0.f;
#pragma unroll 4
                    for (int c = 0; c < 16; ++c) { const f32x4 kv = kr[c]; const f32x4 qv = *(const LAS f32x4*)(qs + r * 64 + c * 4); dot += kv.x * qv.x + kv.y * qv.y + kv.z * qv.z + kv.w * qv.w; }
                    sv = dot * 0.125f - sl * (float)(t - 16 * n - 31); }
                pbuf[n] = sv; mx = fmaxf(mx, sv); }
            mx = wave_max(mx);
            float sum = 0.f;
#pragma unroll 1
            for (int i = 0; i < 8; ++i) { const int n = lane + 64 * i; const float e = n < nvis ? expf(pbuf[n] - mx) : 0.f; pbuf[n] = e; sum += e; }
            sum = wave_sum(sum);
            const float inv = nvis > 0 ? 1.0f / sum : 0.f;
#pragma unroll 1
            for (int i = 0; i < 8; ++i) { const int n = lane + 64 * i; const float p = pbuf[n] * inv; pbuf[n] = p; impb[n] += p; }
            WSYNC();
            float oc = 0.f;
#pragma unroll 4
            for (int n = 0; n < nvis; ++n) oc += pbuf[n] * VCg[(size_t)n * 64 + lane];
            ocb[r * 64 + lane] = oc;
            WSYNC();
        }
        const int cur = t >> 6;
        float sc2[2];
#pragma unroll
        for (int jj = 0; jj < 2; ++jj) { const int j = lane + 64 * jj;
            float v = (j > 0 ? impb[4 * j - 1] : 0.f) + 2.0f * (impb[4 * j] + impb[4 * j + 1] + impb[4 * j + 2]) + impb[4 * j + 3];
            if (j == 0 || j == cur || j == cur - 1) v = 1e4f;
            if (j > cur) v = -1.0f;
            sc2[jj] = v; scb[j] = v; }
        WSYNC();
        unsigned long long msk[2];
#pragma unroll
        for (int jj = 0; jj < 2; ++jj) { const int j = lane + 64 * jj; int rank = 0;
#pragma unroll 4
            for (int i = 0; i < 128; ++i) { const float si = scb[i]; rank += (si > sc2[jj] || (si == sc2[jj] && i < j)) ? 1 : 0; }
            msk[jj] = __ballot(rank < 16); }
        WSYNC();
        float M[4], L[4], os[4], ow[4];
#pragma unroll
        for (int r = 0; r < 4; ++r) { M[r] = NEGB; L[r] = 0.f; os[r] = 0.f; }
        { const float* Kg = KV + 2 * KV_STRIDE + (size_t)g * T * 64; const float* Vg = KV + 3 * KV_STRIDE + (size_t)g * T * 64;
#pragma unroll 1
          for (int j = 0; j <= cur; ++j) { const bool sel = ((j < 64 ? msk[0] >> j : msk[1] >> (j - 64)) & 1ull) != 0ull; if (sel) nsa_block<false>(Kg, Vg, j, t, lane, qs, pb, slope, M, L, os); } }
#pragma unroll
        for (int r = 0; r < 4; ++r) { os[r] = os[r] / L[r]; M[r] = NEGB; L[r] = 0.f; ow[r] = 0.f; }
        { const float* Kg = KV + 4 * KV_STRIDE + (size_t)g * T * 64; const float* Vg = KV + 5 * KV_STRIDE + (size_t)g * T * 64;
          const int j0 = t >= 511 ? (t - 511) >> 6 : 0;
#pragma unroll 1
          for (int j = j0; j <= cur; ++j) nsa_block<true>(Kg, Vg, j, t, lane, qs, pb, slope, M, L, ow); }
#pragma unroll
        for (int r = 0; r < 4; ++r) { const int h = g * 4 + r;
            const float g0 = sigmoidf_(bf2f(P[(size_t)t * NPAD + C_NG + h])), g1 = sigmoidf_(bf2f(P[(size_t)t * NPAD + C_NG + 8 + h])), g2 = sigmoidf_(bf2f(P[(size_t)t * NPAD + C_NG + 16 + h]));
            OCAT[(size_t)t * 1536 + h * 64 + lane] = (bf16)f2bf(g0 * ocb[r * 64 + lane] + g1 * os[r] + g2 * (ow[r] / L[r])); }
        WSYNC();
    }
}

typedef float f32x16 __attribute__((ext_vector_type(16)));
constexpr float NSA_SHIFT2 = 8.0f;
__device__ __forceinline__ int perm16(int b) { return (b & 3) | ((b & 4) << 1) | ((b & 8) >> 1); }
__device__ __forceinline__ void phase_prep2(Frame& F, int l) {
    KA;
    const bf16* P = (const bf16*)(KWS + WS_P);
    bf16* QS = (bf16*)(KWS + WS_QS); bf16* KS2 = (bf16*)(KWS + WS_KS2); bf16* KW2 = (bf16*)(KWS + WS_KW2);
    const float* qg = KIN(I_QN) + l * 64; const float* kg = KIN(I_KN) + l * 192;
    for (int it = F.gw; it < T * 12; it += F.NGW) {
        const int t = it / 12, v = it % 12;
        const int col = v < 8 ? v * 64 : (v < 10 ? C_KS + (v - 8) * 64 : C_KW + (v - 10) * 64);
        float x = bf2f(P[(size_t)t * NPAD + col + F.lane]);
        const float ss = wave_sum(x * x);
        const float g = v < 8 ? qg[F.lane] * (0.125f * LOG2E) : (v < 10 ? kg[64 + F.lane] : kg[128 + F.lane]);
        x = x * (1.0f / sqrtf(ss * (1.0f / 64.0f) + EPS)) * g;
        bf16* dst = v < 8 ? QS + ((size_t)v * T + t) * 64 : (v < 10 ? KS2 + ((size_t)(v - 8) * T + t) * 64 : KW2 + ((size_t)(v - 10) * T + t) * 64);
        dst[F.lane] = (bf16)f2bf(x);
    }
    LAS bf16* tile = (LAS bf16*)(F.lds + F.wave * 16384);
    for (int it = F.gw; it < 2 * 2 * (T / 64); it += F.NGW) {
        const int kind = it / (2 * (T / 64)), q = it % (2 * (T / 64)), g = q / (T / 64), tb = q % (T / 64);
        const bf16* src = P + (size_t)(tb * 64) * NPAD + (kind == 0 ? C_VS : C_VW) + g * 64;
        bf16* dst = (bf16*)(KWS + (kind == 0 ? WS_VST : WS_VWT)) + (size_t)g * 64 * T + tb * 64;
#pragma unroll 4
        for (int r = 0; r < 64; ++r) tile[r * 66 + F.lane] = src[(size_t)r * NPAD + F.lane];
        WSYNC();
        const int pl = (F.lane & ~15) | perm16(F.lane & 15);
#pragma unroll 4
        for (int d = 0; d < 64; ++d) dst[(size_t)d * T + pl] = tile[F.lane * 66 + d];
        WSYNC();
    }
}

__device__ __forceinline__ void phase_prep3(Frame& F, int l) {
    KA;
    const bf16* P = (const bf16*)(KWS + WS_P);
    bf16* QS = (bf16*)(KWS + WS_QS); bf16* KS2 = (bf16*)(KWS + WS_KS2); bf16* KW2 = (bf16*)(KWS + WS_KW2);
    const float* qg = KIN(I_QN) + l * 64; const float* kg = KIN(I_KN) + l * 192;
    const int vec = F.lane >> 3, part = F.lane & 7;
    for (int t = F.gw; t < T; t += F.NGW) {
#pragma unroll
        for (int pass = 0; pass < 2; ++pass) {
            if (pass == 1 && vec >= 4) continue;
            const int col = pass == 0 ? vec * 64 : (vec < 2 ? C_KS + vec * 64 : C_KW + (vec - 2) * 64);
            const float* gp = pass == 0 ? qg : (vec < 2 ? kg + 64 : kg + 128);
            const float gs = pass == 0 ? 0.125f * LOG2E : 1.0f;
            bf16* dst = pass == 0 ? QS + ((size_t)vec * T + t) * 64 : (vec < 2 ? KS2 + ((size_t)vec * T + t) * 64 : KW2 + ((size_t)(vec - 2) * T + t) * 64);
            const u32x4 raw = *(const u32x4*)(P + (size_t)t * NPAD + col + part * 8);
            float x[8] = {bflo(raw.x), bfhi(raw.x), bflo(raw.y), bfhi(raw.y), bflo(raw.z), bfhi(raw.z), bflo(raw.w), bfhi(raw.w)};
            float ss = 0.f;
#pragma unroll
            for (int e = 0; e < 8; ++e) ss += x[e] * x[e];
            ss += __shfl_xor(ss, 1); ss += __shfl_xor(ss, 2); ss += __shfl_xor(ss, 4);
            const float rstd = gs / sqrtf(ss * (1.0f / 64.0f) + EPS);
            const f32x4 g0 = *(const f32x4*)(gp + part * 8), g1 = *(const f32x4*)(gp + part * 8 + 4);
            u32x4 o; o.x = pk2(x[0] * rstd * g0.x, x[1] * rstd * g0.y); o.y = pk2(x[2] * rstd * g0.z, x[3] * rstd * g0.w); o.z = pk2(x[4] * rstd * g1.x, x[5] * rstd * g1.y); o.w = pk2(x[6] * rstd * g1.z, x[7] * rstd * g1.w);
            *(u32x4*)(dst + part * 8) = o;
        }
    }
    LAS bf16* tile = (LAS bf16*)(F.lds + F.wave * 16384);
    for (int it = F.gw; it < 2 * 2 * (T / 64); it += F.NGW) {
        const int kind = it / (2 * (T / 64)), q = it % (2 * (T / 64)), g = q / (T / 64), tb = q % (T / 64);
        const bf16* src = P + (size_t)(tb * 64) * NPAD + (kind == 0 ? C_VS : C_VW) + g * 64;
        bf16* dst = (bf16*)(KWS + (kind == 0 ? WS_VST : WS_VWT)) + (size_t)g * 64 * T + tb * 64;
#pragma unroll
        for (int i = 0; i < 8; ++i) { const int tok = vec + 8 * i; *(LAS u32x4*)(tile + tok * 72 + part * 8) = *(const u32x4*)(src + (size_t)tok * NPAD + part * 8); }
        WSYNC();
#pragma unroll
        for (int c = 0; c < 8; ++c) { unsigned w[4];
#pragma unroll
            for (int k = 0; k < 4; ++k) { const int p0 = (c & 1) * 8 + 2 * k, p1 = p0 + 1;
                const int k0 = (c >> 1) * 16 + ((p0 & 3) | ((p0 & 4) << 1) | ((p0 & 8) >> 1)), k1 = (c >> 1) * 16 + ((p1 & 3) | ((p1 & 4) << 1) | ((p1 & 8) >> 1));
                w[k] = (unsigned)tile[k0 * 72 + F.lane] | ((unsigned)tile[k1 * 72 + F.lane] << 16); }
            *(u32x4*)(dst + (size_t)F.lane * T + c * 8) = (u32x4){w[0], w[1], w[2], w[3]}; }
        WSYNC();
    }
}

__device__ __forceinline__ void phase_compress2(Frame& F, int l) {
    KA;
    LAS float* av = (LAS float*)(F.lds + F.wave * 16384);
    const bf16* P = (const bf16*)(KWS + WS_P);
    bf16* KCB = (bf16*)(KWS + WS_KCB); bf16* VCT = (bf16*)(KWS + WS_KCB + 131072);
    for (int it = F.gw; it < 2 * 2 * 512; it += F.NGW) {
        const int kind = it >> 10, g = (it >> 9) & 1, n = it & 511;
        if (n == 511) { if (kind == 0) KCB[((size_t)g * 512 + 511) * 64 + F.lane] = 0; else VCT[((size_t)g * 64 + F.lane) * 512 + 511] = 0; continue; }
        const bf16* src = P + (size_t)(16 * n) * NPAD + (kind == 0 ? C_KC : C_VC) + g * 64;
        const float* pe = KIN(I_PE) + ((size_t)l * 2 + kind) * 2048;
        const float* w1 = KIN(I_W1) + ((size_t)l * 2 + kind) * 2048 * 64;
        const float* w2 = KIN(I_W2) + ((size_t)l * 2 + kind) * 64 * 64;
#pragma unroll 4
        for (int c = 0; c < 32; ++c) av[c * 64 + F.lane] = bf2f(src[(size_t)c * NPAD + F.lane]) + pe[c * 64 + F.lane];
        WSYNC();
        float acc = 0.f;
#pragma unroll 8
        for (int i = 0; i < 2048; ++i) acc += av[i] * w1[i * 64 + F.lane];
        const float hid = gelu_tanh(acc);
        WSYNC();
        av[F.lane] = hid;
        WSYNC();
        float o = 0.f;
#pragma unroll 8
        for (int i = 0; i < 64; ++i) o += av[i] * w2[i * 64 + F.lane];
        WSYNC();
        if (kind == 0) { const float ss = wave_sum(o * o); o = o * (1.0f / sqrtf(ss * (1.0f / 64.0f) + EPS)) * KIN(I_KN)[l * 192 + F.lane]; KCB[((size_t)g * 512 + n) * 64 + F.lane] = (bf16)f2bf(o); }
        else VCT[((size_t)g * 64 + F.lane) * 512 + ((n & ~15) | perm16(n & 15))] = (bf16)f2bf(o);
    }
}

__device__ __forceinline__ void phase_compress3(Frame& F, int l) {
    KA;
    const bf16* P = (const bf16*)(KWS + WS_P);
    bf16* KCB = (bf16*)(KWS + WS_KCB); bf16* VCT = (bf16*)(KWS + WS_KCB + 131072);
    LAS float* red = (LAS float*)F.lds;
    LAS bf16* hid = (LAS bf16*)(F.lds + 32768);
    const int r16 = F.lane & 15, kq = F.lane >> 4;
    for (int unit = F.bid; unit < 128; unit += F.G) {
        const int kind = unit >> 6, mt = unit & 63, g = mt >> 5, n0 = (mt & 31) * 16;
        const bf16* W1T = (const bf16*)(KWS + WS_CW) + (size_t)(l * 2 + kind) * 64 * 2048; const bf16* W2T = (const bf16*)(KWS + WS_CW + 1048576) + (size_t)(l * 2 + kind) * 4096;
        const float* B1 = (const float*)(KWS + WS_CW + 1572864) + (l * 2 + kind) * 64;
        const bf16* arow = P + (size_t)(16 * (n0 + r16)) * NPAD + (kind == 0 ? C_KC : C_VC) + g * 64;
        f32x4 acc[4];
#pragma unroll
        for (int nt = 0; nt < 4; ++nt) acc[nt] = (f32x4){0.f, 0.f, 0.f, 0.f};
#pragma unroll 2
        for (int ks = 0; ks < 8; ++ks) { const int c0 = F.wave * 256 + 32 * ks + 8 * kq;
            const bf16x8 a = *(const bf16x8*)(arow + (size_t)(c0 >> 6) * NPAD + (c0 & 63));
#pragma unroll
            for (int nt = 0; nt < 4; ++nt) { const bf16x8 b = *(const bf16x8*)(W1T + (size_t)(16 * nt + r16) * 2048 + c0); acc[nt] = __builtin_amdgcn_mfma_f32_16x16x32_bf16(a, b, acc[nt], 0, 0, 0); } }
#pragma unroll
        for (int nt = 0; nt < 4; ++nt) *(LAS f32x4*)(red + ((F.wave * 4 + nt) * 64 + F.lane) * 4) = acc[nt];
        __syncthreads();
        if (F.tid < 256) { const int nt = F.tid >> 6, ln = F.tid & 63; f32x4 v = {0.f, 0.f, 0.f, 0.f};
#pragma unroll
            for (int w = 0; w < 8; ++w) v += *(const LAS f32x4*)(red + ((w * 4 + nt) * 64 + ln) * 4);
            const int col = 16 * nt + (ln & 15); const float b1 = B1[col];
#pragma unroll
            for (int i = 0; i < 4; ++i) hid[(4 * (ln >> 4) + i) * 72 + col] = (bf16)f2bf(gelu_tanh(v[i] + b1)); }
        __syncthreads();
        if (F.wave == 0) {
            f32x4 o[4];
#pragma unroll
            for (int nt = 0; nt < 4; ++nt) o[nt] = (f32x4){0.f, 0.f, 0.f, 0.f};
#pragma unroll
            for (int ks = 0; ks < 2; ++ks) { const bf16x8 a = *(const LAS bf16x8*)(hid + r16 * 72 + 32 * ks + 8 * kq);
#pragma unroll
                for (int nt = 0; nt < 4; ++nt) { const bf16x8 b = *(const bf16x8*)(W2T + (16 * nt + r16) * 64 + 32 * ks + 8 * kq); o[nt] = __builtin_amdgcn_mfma_f32_16x16x32_bf16(a, b, o[nt], 0, 0, 0); } }
            if (kind == 0) {
#pragma unroll
                for (int i = 0; i < 4; ++i) { float ss = o[0][i] * o[0][i] + o[1][i] * o[1][i] + o[2][i] * o[2][i] + o[3][i] * o[3][i];
                    ss += __shfl_xor(ss, 1); ss += __shfl_xor(ss, 2); ss += __shfl_xor(ss, 4); ss += __shfl_xor(ss, 8);
                    const float rstd = 1.0f / sqrtf(ss * (1.0f / 64.0f) + EPS); const int n = n0 + 4 * kq + i;
#pragma unroll
                    for (int nt = 0; nt < 4; ++nt) { const int col = 16 * nt + r16; KCB[((size_t)g * 512 + n) * 64 + col] = n < 511 ? (bf16)f2bf(o[nt][i] * rstd * KIN(I_KN)[l * 192 + col]) : (bf16)0; } }
            } else {
#pragma unroll
                for (int i = 0; i < 4; ++i) { const int n = n0 + 4 * kq + i;
#pragma unroll
                    for (int nt = 0; nt < 4; ++nt) { const int col = 16 * nt + r16; VCT[((size_t)g * 64 + col) * 512 + ((n & ~15) | perm16(n & 15))] = n < 511 ? (bf16)f2bf(o[nt][i]) : (bf16)0; } }
            }
        }
        __syncthreads();
    }
}

constexpr int NSA_SCA = 65536, NSA_SCB = 99328;
constexpr int NSA_QM = 133120, NSA_UM = 134144;
static_assert(NSA_UM + 16 <= MISC_OFF, "NSA LDS map");
__device__ __forceinline__ int next_set(unsigned long long m0, unsigned long long m1, int from) {
    if (from < 64) { const unsigned long long x = m0 & (~0ull << from); if (x) return __builtin_ctzll(x); from = 64; }
    if (from < 128) { const unsigned long long x = m1 & (~0ull << (from - 64)); if (x) return 64 + __builtin_ctzll(x); }
    return 128;
}
__device__ __forceinline__ void nsa_issue(LAS unsigned char* lds, int slot, const bf16* Kg, const bf16* VTg, int vt_len, int j, int tid, int wave) {
    const int row = tid >> 3, c = (tid & 7) ^ ((row >> 1) & 7);
    __builtin_amdgcn_global_load_lds((const unsigned*)(Kg + (size_t)(64 * j + row) * 64 + c * 8), (LAS unsigned*)(lds + slot * 16384 + wave * 1024), 16, 0, 0);
    __builtin_amdgcn_global_load_lds((const unsigned*)(VTg + (size_t)row * vt_len + 64 * j + c * 8), (LAS unsigned*)(lds + slot * 16384 + 8192 + wave * 1024), 16, 0, 0);
}
template <int MODE> __device__ __forceinline__ void nsa_branch(Frame& F, const bf16* Kg, const bf16* VTg, int vt_len, unsigned long long m0, unsigned long long m1,
        const bf16x8 (&Qf)[4], int t, int cblk, u32x4 qxw, int tref, float inv_l, const unsigned (&qsel)[4], int hi_cmp, unsigned wm_lo_dummy, f32x16 (&oacc)[2], float& lsum) {
    LAS unsigned char* lds = F.lds;
    const int lane = F.lane, c32 = lane & 31, h = lane >> 5, tid = F.tid;
    const int sw = (c32 >> 1) & 7;
    int j0 = next_set(m0, m1, 0);
    if (j0 >= 128) return;
    int j1 = next_set(m0, m1, j0 + 1), j2 = j1 < 128 ? next_set(m0, m1, j1 + 1) : 128;
    nsa_issue(lds, 0, Kg, VTg, vt_len, j0, tid, F.wave);
    if (j1 < 128) nsa_issue(lds, 1, Kg, VTg, vt_len, j1, tid, F.wave);
    if (j2 < 128) nsa_issue(lds, 2, Kg, VTg, vt_len, j2, tid, F.wave);
    int slot = 0;
    while (j0 < 128) {
        const int j = j0;
        if (j2 < 128) asm volatile("s_waitcnt vmcnt(4)" ::: "memory"); else if (j1 < 128) asm volatile("s_waitcnt vmcnt(2)" ::: "memory"); else asm volatile("s_waitcnt vmcnt(0)" ::: "memory");
        __builtin_amdgcn_s_barrier(); asm volatile("" ::: "memory");
        const int j3 = j2 < 128 ? next_set(m0, m1, j2 + 1) : 128;
        if (j3 < 128) nsa_issue(lds, (slot + 3) & 3, Kg, VTg, vt_len, j3, tid, F.wave);
        bool need = true;
        if (MODE == 2) { const unsigned myw = j < 32 ? qsel[0] : (j < 64 ? qsel[1] : (j < 96 ? qsel[2] : qsel[3])); need = __any((myw >> (j & 31)) & 1u); }
        if (need) {
            const int kb = slot * 16384, vb = slot * 16384 + 8192;
            const int kbase = 64 * j;
            u32x4 qx = qxw;
            if (MODE == 2) { const unsigned myw = j < 32 ? qsel[0] : (j < 64 ? qsel[1] : (j < 96 ? qsel[2] : qsel[3])); if (!((myw >> (j & 31)) & 1u) && h == 0) qx.z = 0xF149u; }
            const bf16x8 qxf = __builtin_bit_cast(bf16x8, qx);
            f32x16 sacc[2];
#pragma unroll
            for (int sub = 0; sub < 2; ++sub)
#pragma unroll
                for (int i = 0; i < 16; ++i) sacc[sub][i] = 0.f;
#pragma unroll
            for (int sub = 0; sub < 2; ++sub) {
#pragma unroll
                for (int kp = 0; kp < 2; ++kp) { bf16x8 ka2[2];
#pragma unroll
                    for (int k2 = 0; k2 < 2; ++k2) ka2[k2] = *(const LAS bf16x8*)(lds + kb + (32 * sub + c32) * 128 + (((2 * (2 * kp + k2) + h) ^ sw) * 16));
                    asm volatile("" ::: "memory");
#pragma unroll
                    for (int k2 = 0; k2 < 2; ++k2) sacc[sub] = __builtin_amdgcn_mfma_f32_32x32x16_bf16(ka2[k2], Qf[2 * kp + k2], sacc[sub], 0, 0, 0);
                    asm volatile("" ::: "memory"); }
                { const int kidx = kbase + 32 * sub + c32, pos = MODE < 2 ? 16 * kidx + 31 : kidx, dd = tref - pos;
                  const unsigned w = pkbf(-(float)((dd >> 8) * 256), -(float)(dd & 255));
                  u32x4 kx; kx.x = h == 0 ? w : 0u; kx.y = kx.x; kx.z = h == 0 ? 0x3F80u : 0u; kx.w = 0u;
                  sacc[sub] = __builtin_amdgcn_mfma_f32_32x32x16_bf16(__builtin_bit_cast(bf16x8, kx), qxf, sacc[sub], 0, 0, 0); } }
#pragma unroll
            for (int sub = 0; sub < 2; ++sub)
#pragma unroll
                for (int i = 0; i < 16; ++i) sacc[sub][i] = __builtin_amdgcn_exp2f(sacc[sub][i]);
            bool mhi = false, mlo = false; int hi = 0, lo = 0;
            if (MODE < 2) { mhi = (kbase + 63 > (tref - 63 - 31) / 16 - 1); hi = hi_cmp; }
            if (MODE == 2) { mhi = (j == cblk); hi = t; }
            if (MODE == 3) { mhi = (j == cblk); hi = t; mlo = (j == cblk - 8); lo = t - 511; }
            if (mhi || mlo) {
#pragma unroll
                for (int sub = 0; sub < 2; ++sub)
#pragma unroll
                    for (int i = 0; i < 16; ++i) { const int idx = kbase + 4 * h + 32 * sub + (i & 3) + 8 * (i >> 2); if ((mhi && idx > hi) || (mlo && idx < lo)) sacc[sub][i] = 0.f; }
            }
            float ls = 0.f;
#pragma unroll
            for (int sub = 0; sub < 2; ++sub)
#pragma unroll
                for (int i = 0; i < 16; ++i) ls += sacc[sub][i];
            lsum += ls;
            if (MODE == 1) {
                LAS float* scA = (LAS float*)(lds + NSA_SCA); LAS float* scB = (LAS float*)(lds + NSA_SCB);
                const int q = F.wave * 8 + (c32 >> 2);
#pragma unroll
                for (int sub = 0; sub < 2; ++sub)
#pragma unroll
                    for (int g4 = 0; g4 < 4; ++g4) { float x[4];
#pragma unroll
                        for (int e = 0; e < 4; ++e) { float v = sacc[sub][4 * g4 + e] * inv_l;
                            v += __builtin_bit_cast(float, __builtin_amdgcn_mov_dpp(__builtin_bit_cast(int, v), 0xB1, 0xF, 0xF, true));
                            v += __builtin_bit_cast(float, __builtin_amdgcn_mov_dpp(__builtin_bit_cast(int, v), 0x4E, 0xF, 0xF, true));
                            x[e] = v; }
                        const int jb = 16 * j + 8 * sub + 2 * g4 + h;
                        if ((c32 & 3) == 0) { scA[q * 132 + jb] = 2.0f * (x[0] + x[1] + x[2]) + x[3]; scB[q * 132 + jb + 1] = x[3]; } }
            }
            if (MODE != 0) {
                bf16x8 pf[2][2];
#pragma unroll
                for (int sub = 0; sub < 2; ++sub)
#pragma unroll
                    for (int s2 = 0; s2 < 2; ++s2) { u32x4 w; w.x = pkbf(sacc[sub][8 * s2], sacc[sub][8 * s2 + 1]); w.y = pkbf(sacc[sub][8 * s2 + 2], sacc[sub][8 * s2 + 3]); w.z = pkbf(sacc[sub][8 * s2 + 4], sacc[sub][8 * s2 + 5]); w.w = pkbf(sacc[sub][8 * s2 + 6], sacc[sub][8 * s2 + 7]);
                        pf[sub][s2] = __builtin_bit_cast(bf16x8, w); }
                asm volatile("" ::: "memory");
#pragma unroll
                for (int ds = 0; ds < 2; ++ds) {
#pragma unroll
                    for (int qp = 0; qp < 2; ++qp) { bf16x8 va2[2];
#pragma unroll
                        for (int k2 = 0; k2 < 2; ++k2) va2[k2] = *(const LAS bf16x8*)(lds + vb + (32 * ds + c32) * 128 + (((2 * (2 * qp + k2) + h) ^ sw) * 16));
                        asm volatile("" ::: "memory");
#pragma unroll
                        for (int k2 = 0; k2 < 2; ++k2) oacc[ds] = __builtin_amdgcn_mfma_f32_32x32x16_bf16(va2[k2], pf[qp][k2], oacc[ds], 0, 0, 0);
                        asm volatile("" ::: "memory"); } }
            }
        }
        j0 = j1; j1 = j2; j2 = j3; slot = (slot + 1) & 3;
    }
    asm volatile("s_waitcnt lgkmcnt(0)" ::: "memory"); __builtin_amdgcn_s_barrier(); asm volatile("" ::: "memory");
}
__device__ __forceinline__ void nsa_stash_put(LAS unsigned char* lds, int wave, int lane, const f32x16 (&o)[2], float sc) {
    LAS unsigned* st = (LAS unsigned*)(lds + NSA_SCA) + wave * 1024 + lane;
#pragma unroll
    for (int ds = 0; ds < 2; ++ds)
#pragma unroll
        for (int k = 0; k < 8; ++k) st[(ds * 8 + k) * 64] = pkbf(o[ds][2 * k] * sc, o[ds][2 * k + 1] * sc);
}
#define PSTAMP(slot) do { if (MK_PROBE_MASK != 0 && F.bid == MK_PROBE_BID && F.tid == 0) { volatile LAS unsigned long long* _ta = (volatile LAS unsigned long long*)(F.lds + MISC_OFF + 512); const unsigned long long _n = wall_clock64(); _ta[slot] += _n - _ta[16]; _ta[16] = _n; } } while (0)
__device__ __forceinline__ void phase_nsa2(Frame& F, int l) {
    KA;
    LAS unsigned char* lds = F.lds;
    const bf16* P = (const bf16*)(KWS + WS_P); bf16* OCAT = (bf16*)(KWS + WS_OCAT);
    const bf16* QS = (const bf16*)(KWS + WS_QS);
    const int lane = F.lane, c32 = lane & 31, h = lane >> 5, q8 = c32 >> 2, r = c32 & 3;
    for (int unit = F.bid; unit < 256; unit += F.G) {
        const int g = unit & 1, cblk = unit >> 1, t0 = cblk * 64, head = g * 4 + r, t = t0 + F.wave * 8 + q8;
        u32x4 qxw;
        { const float s2 = exp2f(-(float)(head + 1)) * LOG2E; const unsigned sh = f2bf(s2); const float rem = s2 - bf2f(sh); const unsigned sl = f2bf(rem);
          qxw.x = h == 0 ? (sh | (sh << 16)) : 0u; qxw.y = h == 0 ? (sl | (sl << 16)) : 0u; qxw.z = 0u; qxw.w = 0u; }
        const int tref = t0 + 63;
        bf16x8 Qf[4];
#pragma unroll
        for (int ks = 0; ks < 4; ++ks) Qf[ks] = *(const bf16x8*)(QS + ((size_t)head * T + t) * 64 + 16 * ks + 8 * h);
        for (int u = F.tid; u < (NSA_UM + 16 - NSA_SCA) / 4; u += 512) ((LAS unsigned*)(lds + NSA_SCA))[u] = 0u;
        __syncthreads();
        f32x16 oacc[2];
#pragma unroll
        for (int ds = 0; ds < 2; ++ds)
#pragma unroll
            for (int i = 0; i < 16; ++i) oacc[ds][i] = 0.f;
        unsigned qsel[4] = {0u, 0u, 0u, 0u};
        float sc_cmp;
        PSTAMP(24);
        {
            const int ntile = (4 * cblk + 2) / 64 + 1;
            const unsigned long long cm0 = ntile >= 64 ? ~0ull : ((1ull << ntile) - 1ull);
            const int hi_cmp = t >= 31 ? (t - 31) / 16 : -1;
            const bf16* Kg = (const bf16*)(KWS + WS_KCB) + (size_t)g * 512 * 64; const bf16* VTg = (const bf16*)(KWS + WS_KCB + 131072) + (size_t)g * 64 * 512;
            float l1 = 0.f;
            nsa_branch<0>(F, Kg, VTg, 512, cm0, 0ull, Qf, t, cblk, qxw, tref, 0.f, qsel, hi_cmp, 0u, oacc, l1);
            l1 += __shfl_xor(l1, 32);
            const float inv_l = l1 > 0.f ? 1.0f / l1 : 0.f;
            float l2 = 0.f;
            nsa_branch<1>(F, Kg, VTg, 512, cm0, 0ull, Qf, t, cblk, qxw, tref, inv_l, qsel, hi_cmp, 0u, oacc, l2);
            sc_cmp = sigmoidf_(bf2f(P[(size_t)t * NPAD + C_NG + head])) * inv_l;
        }
        PSTAMP(20);
        {
            LAS float* scA = (LAS float*)(lds + NSA_SCA); LAS float* scB = (LAS float*)(lds + NSA_SCB);
            LAS unsigned* qm = (LAS unsigned*)(lds + NSA_QM); LAS unsigned* um = (LAS unsigned*)(lds + NSA_UM);
            WSYNC();
            const int qq = F.wave * 8 + (lane >> 3), jj = lane & 7;
            unsigned key[16];
#pragma unroll
            for (int m = 0; m < 16; ++m) { const int jb = jj + 8 * m; float sv = scA[qq * 132 + jb] + scB[qq * 132 + jb];
                if (jb == 0 || jb == cblk || jb == cblk - 1) sv = 1e4f;
                key[m] = jb <= cblk ? ((__builtin_bit_cast(unsigned, sv) & ~127u) | (unsigned)(127 - jb)) : 0u; }
            WSYNC();
#pragma unroll
            for (int m = 0; m < 16; ++m) ((LAS unsigned*)scA)[qq * 132 + jj + 8 * m] = key[m];
            WSYNC();
            unsigned bits[4] = {0u, 0u, 0u, 0u};
#pragma unroll
            for (int half = 0; half < 2; ++half) { int rank[8];
#pragma unroll
                for (int m = 0; m < 8; ++m) rank[m] = 0;
#pragma unroll 2
                for (int i = 0; i <= cblk; i += 4) { const u32x4 k4 = *(const LAS u32x4*)((const LAS unsigned*)scA + qq * 132 + i);
#pragma unroll
                    for (int m = 0; m < 8; ++m) rank[m] += (k4.x > key[8 * half + m] ? 1 : 0) + (k4.y > key[8 * half + m] ? 1 : 0) + (k4.z > key[8 * half + m] ? 1 : 0) + (k4.w > key[8 * half + m] ? 1 : 0); }
#pragma unroll
                for (int m = 0; m < 8; ++m) { const int jb = jj + 8 * (8 * half + m); if (jb <= cblk && rank[m] < 16) bits[(8 * half + m) >> 2] |= 1u << (jb & 31); } }
#pragma unroll
            for (int w = 0; w < 4; ++w) if (bits[w]) { atomicOr((unsigned*)(qm + qq * 4 + w), bits[w]); atomicOr((unsigned*)(um + w), bits[w]); }
            __syncthreads();
#pragma unroll
            for (int w = 0; w < 4; ++w) qsel[w] = qm[(F.wave * 8 + q8) * 4 + w];
        }
        PSTAMP(21);
        nsa_stash_put(lds, F.wave, lane, oacc, sc_cmp);
#pragma unroll
        for (int ds = 0; ds < 2; ++ds)
#pragma unroll
            for (int i = 0; i < 16; ++i) oacc[ds][i] = 0.f;
        {
            LAS unsigned* um = (LAS unsigned*)(lds + NSA_UM);
            const unsigned long long sm0 = (unsigned long long)__builtin_amdgcn_readfirstlane(um[0]) | ((unsigned long long)__builtin_amdgcn_readfirstlane(um[1]) << 32);
            const unsigned long long sm1 = (unsigned long long)__builtin_amdgcn_readfirstlane(um[2]) | ((unsigned long long)__builtin_amdgcn_readfirstlane(um[3]) << 32);
            float ls = 0.f;
            nsa_branch<2>(F, (const bf16*)(KWS + WS_KS2) + (size_t)g * T * 64, (const bf16*)(KWS + WS_VST) + (size_t)g * 64 * T, T, sm0, sm1, Qf, t, cblk, qxw, tref, 0.f, qsel, 0, 0u, oacc, ls);
            ls += __shfl_xor(ls, 32);
            const float sc = sigmoidf_(bf2f(P[(size_t)t * NPAD + C_NG + 8 + head])) / ls;
            LAS unsigned* st = (LAS unsigned*)(lds + NSA_SCA) + F.wave * 1024 + lane;
#pragma unroll
            for (int ds = 0; ds < 2; ++ds)
#pragma unroll
                for (int k = 0; k < 8; ++k) { const unsigned w = st[(ds * 8 + k) * 64]; st[(ds * 8 + k) * 64] = pkbf(bflo(w) + sc * oacc[ds][2 * k], bfhi(w) + sc * oacc[ds][2 * k + 1]); oacc[ds][2 * k] = 0.f; oacc[ds][2 * k + 1] = 0.f; }
        }
        PSTAMP(22);
        {
            const int j0 = cblk >= 8 ? cblk - 8 : 0;
            unsigned long long wm0 = 0ull, wm1 = 0ull;
            for (int jb = j0; jb <= cblk; ++jb) { if (jb < 64) wm0 |= 1ull << jb; else wm1 |= 1ull << (jb - 64); }
            float ls = 0.f;
            nsa_branch<3>(F, (const bf16*)(KWS + WS_KW2) + (size_t)g * T * 64, (const bf16*)(KWS + WS_VWT) + (size_t)g * 64 * T, T, wm0, wm1, Qf, t, cblk, qxw, tref, 0.f, qsel, 0, 0u, oacc, ls);
            ls += __shfl_xor(ls, 32);
            const float sc = sigmoidf_(bf2f(P[(size_t)t * NPAD + C_NG + 16 + head])) / ls;
            const LAS unsigned* st = (const LAS unsigned*)(lds + NSA_SCA) + F.wave * 1024 + lane;
#pragma unroll
            for (int ds = 0; ds < 2; ++ds)
#pragma unroll
                for (int g4 = 0; g4 < 4; ++g4) { const unsigned w0 = st[(ds * 8 + 2 * g4) * 64], w1 = st[(ds * 8 + 2 * g4 + 1) * 64];
                    u32x2 w; w.x = pkbf(bflo(w0) + sc * oacc[ds][4 * g4], bfhi(w0) + sc * oacc[ds][4 * g4 + 1]); w.y = pkbf(bflo(w1) + sc * oacc[ds][4 * g4 + 2], bfhi(w1) + sc * oacc[ds][4 * g4 + 3]);
                    *(u32x2*)(OCAT + (size_t)t * 1536 + head * 64 + 32 * ds + 8 * g4 + 4 * h) = w; }
        }
        __syncthreads();
        PSTAMP(23);
    }
}

__device__ __forceinline__ void phase_merge(Frame& F) {
    KA;
    const bf16* P = (const bf16*)(KWS + WS_P); const bf16* PROJ = (const bf16*)(KWS + WS_PROJ); bf16* MG = (bf16*)(KWS + WS_MERGED);
    const size_t total = (size_t)T * D / 8;
    for (size_t it = (size_t)F.gw * 64 + F.lane; it < total; it += (size_t)F.NGW * 64) {
        const size_t t = it / (D / 8); const int d = (int)(it % (D / 8)) * 8;
        float acc[8];
#pragma unroll
        for (int k = 0; k < 8; ++k) acc[k] = 0.f;
#pragma unroll
        for (int n = 0; n < 3; ++n) { const u32x4 gq = *(const u32x4*)(P + t * NPAD + C_MG + n * D + d); const u32x4 pq = *(const u32x4*)(PROJ + ((size_t)n * T + t) * D + d);
            acc[0] += sigmoidf_(bflo(gq.x)) * bflo(pq.x); acc[1] += sigmoidf_(bfhi(gq.x)) * bfhi(pq.x); acc[2] += sigmoidf_(bflo(gq.y)) * bflo(pq.y); acc[3] += sigmoidf_(bfhi(gq.y)) * bfhi(pq.y);
            acc[4] += sigmoidf_(bflo(gq.z)) * bflo(pq.z); acc[5] += sigmoidf_(bfhi(gq.z)) * bfhi(pq.z); acc[6] += sigmoidf_(bflo(gq.w)) * bflo(pq.w); acc[7] += sigmoidf_(bfhi(gq.w)) * bfhi(pq.w); }
        u32x4 o; o.x = pk2(acc[0], acc[1]); o.y = pk2(acc[2], acc[3]); o.z = pk2(acc[4], acc[5]); o.w = pk2(acc[6], acc[7]);
        *(u32x4*)(MG + t * D + d) = o;
    }
}
__device__ __forceinline__ void phase_router(Frame& F, int l) {
    KA;
    const float* X1 = (const float*)(KWS + WS_X1); bf16* H = (bf16*)(KWS + WS_H);
    int* EID = (int*)(KWS + WS_ROUTE); float* EW = (float*)(KWS + WS_ROUTE + 65536);
    const float* gain = KIN(I_NFFN) + (size_t)l * D; const float* wg = KIN(I_WGRP) + (size_t)l * D * 4; const float* we = KIN(I_WEXP) + (size_t)l * D * 32;
    const float* bg = KIN(I_BGRP) + l * 4; const float* be = KIN(I_BEXP) + l * 32;
    for (int t = F.gw; t < T; t += F.NGW) {
        const float* xrow = X1 + (size_t)t * D;
        float ss = 0.f;
#pragma unroll 4
        for (int k = 0; k < 32; ++k) { const float x = xrow[F.lane + 64 * k]; ss += x * x; }
        const float rstd = 1.0f / sqrtf(wave_sum(ss) * (1.0f / D) + EPS);
        float ag[4] = {0.f, 0.f, 0.f, 0.f}, ae[32];
#pragma unroll
        for (int e = 0; e < 32; ++e) ae[e] = 0.f;
#pragma unroll 1
        for (int k = 0; k < 32; ++k) { const int d = F.lane + 64 * k;
            const float hv = xrow[d] * rstd * gain[d];
            H[(size_t)t * D + d] = (bf16)f2bf(hv);
            const f32x4 w4 = *(const f32x4*)(wg + (size_t)d * 4);
            ag[0] += hv * w4.x; ag[1] += hv * w4.y; ag[2] += hv * w4.z; ag[3] += hv * w4.w;
#pragma unroll
            for (int c = 0; c < 8; ++c) { const f32x4 w = *(const f32x4*)(we + (size_t)d * 32 + c * 4); ae[c * 4] += hv * w.x; ae[c * 4 + 1] += hv * w.y; ae[c * 4 + 2] += hv * w.z; ae[c * 4 + 3] += hv * w.w; } }
#pragma unroll
        for (int e = 0; e < 4; ++e) ag[e] = wave_sum(ag[e]) + bg[e];
#pragma unroll
        for (int e = 0; e < 32; ++e) ae[e] = wave_sum(ae[e]) + be[e];
        int gi = 0; float gm = ag[0];
#pragma unroll
        for (int e = 1; e < 4; ++e) if (ag[e] > gm) { gm = ag[e]; gi = e; }
        float gs = 0.f;
#pragma unroll
        for (int e = 0; e < 4; ++e) gs += expf(ag[e] - gm);
        const float gw_ = 1.0f / gs;
        float el[8];
#pragma unroll
        for (int e = 0; e < 8; ++e) { el[e] = gi == 0 ? ae[e] : (gi == 1 ? ae[8 + e] : (gi == 2 ? ae[16 + e] : ae[24 + e])); }
        int i1 = 0; float m1 = el[0];
#pragma unroll
        for (int e = 1; e < 8; ++e) if (el[e] > m1) { m1 = el[e]; i1 = e; }
        int i2 = -1; float m2 = -3.0e38f;
#pragma unroll
        for (int e = 0; e < 8; ++e) if (e != i1 && el[e] > m2) { m2 = el[e]; i2 = e; }
        const float p2 = expf(m2 - m1);
        const float w1 = 1.0f / (1.0f + p2), w2 = p2 / (1.0f + p2);
        if (F.lane == 0) { EID[2 * t] = gi * 8 + i1; EID[2 * t + 1] = gi * 8 + i2; EW[2 * t] = gw_ * w1; EW[2 * t + 1] = gw_ * w2; }
    }
}

__device__ __forceinline__ void phase_router3(Frame& F, int l) {
    KA;
    const float* X1 = (const float*)(KWS + WS_X1); bf16* H = (bf16*)(KWS + WS_H);
    int* EID = (int*)(KWS + WS_ROUTE); float* EW = (float*)(KWS + WS_ROUTE + 65536); int* HIST = (int*)(KWS + WS_HIST); float* RSTD = (float*)(KWS + WS_RSTD);
    const float* WRT = (const float*)(KWS + WS_WRT) + (size_t)l * 48 * D;
    const float* gain = KIN(I_NFFN) + (size_t)l * D; const float* bg = KIN(I_BGRP) + l * 4; const float* be = KIN(I_BEXP) + l * 32;
    LAS float* red = (LAS float*)F.lds;
    LAS float* ssq = (LAS float*)(F.lds + 49152);
    LAS float* lg = (LAS float*)(F.lds + 50176);
    LAS float* rs = (LAS float*)(F.lds + 55296);
    LAS int* eidl = (LAS int*)(F.lds + 55424);
    const int r16 = F.lane & 15, kq = F.lane >> 4;
    for (int blk = F.bid; blk < T / 32; blk += F.G) {
        const int tok0 = blk * 32, kb0 = F.wave * 256 + 4 * kq;
        const float* xa = X1 + (size_t)(tok0 + r16) * D + kb0;
        const float* wb = WRT + (size_t)r16 * D + kb0;
        bf16* hp = H + (size_t)(tok0 + r16) * D + kb0;
        f32x4 acc[2][3]; float sq[2] = {0.f, 0.f};
#pragma unroll
        for (int tg = 0; tg < 2; ++tg)
#pragma unroll
            for (int nt = 0; nt < 3; ++nt) acc[tg][nt] = (f32x4){0.f, 0.f, 0.f, 0.f};
#pragma unroll 2
        for (int s = 0; s < 16; ++s) { f32x4 a[2], b[3];
#pragma unroll
            for (int tg = 0; tg < 2; ++tg) a[tg] = *(const f32x4*)(xa + (size_t)(16 * tg) * D + 16 * s);
#pragma unroll
            for (int nt = 0; nt < 3; ++nt) b[nt] = *(const f32x4*)(wb + (size_t)(16 * nt) * D + 16 * s);
            const f32x4 g = *(const f32x4*)(gain + kb0 + 16 * s);
#pragma unroll
            for (int tg = 0; tg < 2; ++tg) { sq[tg] += a[tg].x * a[tg].x + a[tg].y * a[tg].y + a[tg].z * a[tg].z + a[tg].w * a[tg].w;
                u32x2 o; o.x = pkbf(a[tg].x * g.x, a[tg].y * g.y); o.y = pkbf(a[tg].z * g.z, a[tg].w * g.w);
                *(u32x2*)(hp + (size_t)(16 * tg) * D + 16 * s) = o;
#pragma unroll
                for (int j = 0; j < 4; ++j)
#pragma unroll
                    for (int nt = 0; nt < 3; ++nt) acc[tg][nt] = __builtin_amdgcn_mfma_f32_16x16x4f32(a[tg][j], b[nt][j], acc[tg][nt], 0, 0, 0); } }
#pragma unroll
        for (int tg = 0; tg < 2; ++tg) { sq[tg] += __shfl_xor(sq[tg], 16); sq[tg] += __shfl_xor(sq[tg], 32);
            if (kq == 0) ssq[F.wave * 32 + 16 * tg + r16] = sq[tg];
#pragma unroll
            for (int nt = 0; nt < 3; ++nt) *(LAS f32x4*)(red + (((F.wave * 2 + tg) * 3 + nt) * 64 + F.lane) * 4) = acc[tg][nt]; }
        __syncthreads();
        if (F.tid < 384) { const int tg2 = F.tid / 192, rem = F.tid % 192, nt = rem / 64, ln = rem % 64; f32x4 v = {0.f, 0.f, 0.f, 0.f};
#pragma unroll
            for (int w = 0; w < 8; ++w) v += *(const LAS f32x4*)(red + (((w * 2 + tg2) * 3 + nt) * 64 + ln) * 4);
            const int col = 16 * nt + (ln & 15);
            if (col < 36) {
#pragma unroll
                for (int i = 0; i < 4; ++i) lg[(16 * tg2 + 4 * (ln >> 4) + i) * 40 + col] = v[i]; } }
        if (F.tid >= 384 && F.tid < 416) { const int tk = F.tid - 384; float q2 = 0.f;
#pragma unroll
            for (int w = 0; w < 8; ++w) q2 += ssq[w * 32 + tk];
            const float r = 1.0f / sqrtf(q2 * (1.0f / D) + EPS); rs[tk] = r; RSTD[tok0 + tk] = r; }
        __syncthreads();
        if (F.tid < 32) { const int tk = F.tid, t = tok0 + tk; const float rstd = rs[tk];
            float ag[4], el[8];
#pragma unroll
            for (int e = 0; e < 4; ++e) ag[e] = lg[tk * 40 + 32 + e] * rstd + bg[e];
            int gi = 0; float gm = ag[0];
#pragma unroll
            for (int e = 1; e < 4; ++e) if (ag[e] > gm) { gm = ag[e]; gi = e; }
            float gs = 0.f;
#pragma unroll
            for (int e = 0; e < 4; ++e) gs += expf(ag[e] - gm);
            const float gw_ = 1.0f / gs;
#pragma unroll
            for (int e = 0; e < 8; ++e) el[e] = lg[tk * 40 + gi * 8 + e] * rstd + be[gi * 8 + e];
            int i1 = 0; float m1 = el[0];
#pragma unroll
            for (int e = 1; e < 8; ++e) if (el[e] > m1) { m1 = el[e]; i1 = e; }
            int i2 = -1; float m2 = -3.0e38f;
#pragma unroll
            for (int e = 0; e < 8; ++e) if (e != i1 && el[e] > m2) { m2 = el[e]; i2 = e; }
            const float p2 = expf(m2 - m1), w1 = 1.0f / (1.0f + p2), w2 = p2 / (1.0f + p2);
            EID[2 * t] = gi * 8 + i1; EID[2 * t + 1] = gi * 8 + i2; EW[2 * t] = gw_ * w1; EW[2 * t + 1] = gw_ * w2;
            eidl[2 * tk] = gi * 8 + i1; eidl[2 * tk + 1] = gi * 8 + i2; }
        __syncthreads();
        if (F.tid < 32) { int c = 0;
#pragma unroll 8
            for (int i = 0; i < 64; ++i) c += eidl[i] == F.tid ? 1 : 0;
            HIST[blk * 32 + F.tid] = c; }
        __syncthreads();
    }
}
__device__ __forceinline__ void phase_lists2(Frame& F) {
    KA;
    const int* EID = (const int*)(KWS + WS_ROUTE); int* CNT = (int*)(KWS + WS_ROUTE + 131072); int* LIST = (int*)(KWS + WS_ROUTE + 262144); const int* HIST = (const int*)(KWS + WS_HIST);
    LAS int* off = (LAS int*)F.lds; LAS int* eidl = off + 32; LAS int* psum = off + 128;
    for (int blk = F.bid; blk < T / 32; blk += F.G) {
        { const int e = F.tid & 31, part = F.tid >> 5; int a = 0;
#pragma unroll 4
          for (int b2 = part; b2 < blk; b2 += 16) a += HIST[b2 * 32 + e];
          psum[part * 32 + e] = a; }
        __syncthreads();
        if (F.tid < 32) { int a = 0;
#pragma unroll
            for (int p = 0; p < 16; ++p) a += psum[p * 32 + F.tid];
            off[F.tid] = a;
            if (blk == T / 32 - 1) CNT[F.tid] = a + HIST[blk * 32 + F.tid]; }
        if (F.tid >= 64 && F.tid < 128) eidl[F.tid - 64] = EID[blk * 64 + F.tid - 64];
        __syncthreads();
        if (F.tid < 64) { const int e = eidl[F.tid]; int rk = 0;
            for (int i = 0; i < F.tid; ++i) rk += eidl[i] == e ? 1 : 0;
            LIST[e * 8192 + off[e] + rk] = blk * 64 + F.tid; }
        __syncthreads();
    }
}

__device__ __forceinline__ void phase_lists(Frame& F) {
    KA;
    const int e = F.bid;
    if (e >= NE) return;
    const int* EID = (const int*)(KWS + WS_ROUTE); int* CNT = (int*)(KWS + WS_ROUTE + 131072); int* LIST = (int*)(KWS + WS_ROUTE + 262144);
    LAS int* wc = (LAS int*)F.lds;
    int run = 0;
    for (int base = 0; base < 2 * T; base += 512) {
        const int idx = base + F.tid; const bool match = EID[idx] == e;
        const unsigned long long b = __ballot(match);
        if (F.lane == 0) wc[F.wave] = __popcll(b);
        __syncthreads();
        int pre = 0, tot = 0;
#pragma unroll
        for (int w = 0; w < 8; ++w) { const int c = wc[w]; pre += w < F.wave ? c : 0; tot += c; }
        if (match) LIST[e * 8192 + run + pre + __popcll(b & ((1ull << F.lane) - 1ull))] = idx;
        run += tot;
        __syncthreads();
    }
    if (F.tid == 0) CNT[e] = run;
}
__device__ __forceinline__ void moe_table(Frame& F, LAS int* tb) {
    KA;
    const int* CNT = (const int*)(KWS + WS_ROUTE + 131072);
    if (F.tid == 0) { int a = 0, f = 0, h = 0;
        for (int e = 0; e < NE; ++e) { const int n = CNT[e], nt = (n + 255) / 256, lastv = n - (nt - 1) * 256, hh = (nt > 0 && lastv <= 128) ? 1 : 0;
            tb[e] = a; tb[33 + e] = f; tb[66 + e] = h; a += nt; f += nt - hh; h += hh; }
        tb[NE] = a; tb[33 + NE] = f; tb[66 + NE] = h; }
    __syncthreads();
}

constexpr int PH_PER_LAYER = 10, N_PHASES = 1 + NL * PH_PER_LAYER + 1;

__global__ void __launch_bounds__(512, 2) mk_fwd(Args args) {
    extern __shared__ __attribute__((aligned(16))) unsigned char lds_raw[];
#define FRAME Frame F; F.lds = (LAS unsigned char*)lds_raw; F.MISC = (volatile LAS unsigned*)(F.lds + MISC_OFF); F.tid = ltid(); F.lane = F.tid & 63; F.wave = __builtin_amdgcn_readfirstlane(F.tid >> 6); \
    F.G = gridDim.x; F.bid = lbid(); F.vcu = (F.G % 8 == 0) ? (F.bid % 8) * (F.G / 8) + F.bid / 8 : F.bid; F.gw = F.bid * 8 + F.wave; F.NGW = F.G * 8;
    unsigned* const ctl = (unsigned*)((unsigned char*)args.ws + WS_CTL);
    for (int u = threadIdx.x; u < (LDS_BYTES - MISC_OFF) / 4; u += 512) ((LAS unsigned*)(lds_raw + MISC_OFF))[u] = 0u;
    __syncthreads();
    const int lo = args.ph_lo, hi = args.ph_hi;
    XcdBarrier bar; bar.bar = ctl + CW_BAR + args.li * XCD_BAR_WORDS; bar.x = 0; bar.st = nullptr;
    if (hi - lo > 1) bar = xcd_barrier_post(ctl + CW_BAR + args.li * XCD_BAR_WORDS, (volatile LAS unsigned*)((LAS unsigned char*)lds_raw + MISC_OFF));
    int ph = 0;
#define RUN(k) ((k) >= lo && (k) < hi)

    volatile LAS unsigned long long* const tacc = (volatile LAS unsigned long long*)((LAS unsigned char*)lds_raw + MISC_OFF + 512);
    if (MK_PROBE_MASK != 0 && blockIdx.x == MK_PROBE_BID && threadIdx.x == 0) tacc[16] = wall_clock64();
#define STAMP(slot) do { if (MK_PROBE_MASK != 0 && lbid() == MK_PROBE_BID && ltid() == 0) { const unsigned long long _n = wall_clock64(); tacc[slot] += _n - tacc[16]; tacc[16] = _n; } } while (0)
#define SEAM(k, slot) do { if ((k) + 1 < hi) xcd_barrier(bar); STAMP(slot); } while (0)
    LAS int* const tb = (LAS int*)((LAS unsigned char*)lds_raw + MISC_OFF + 64);

    if (RUN(ph)) { KA; FRAME; phase_prologue(F); phase_norm1<0>(F, KIN(I_X), nullptr, nullptr, KIN(I_NMIX), (bf16*)(KWS + WS_H)); SEAM(ph, 0); }
    ++ph;
    for (int l = 0; l < NL; ++l) {
        if (RUN(ph)) { KA; FRAME; pg8::PlainSched S; S.init((const bf16*)(KWS + WS_H), D, (const bf16*)(KWS + WS_WIN) + (size_t)l * NPAD * D, T, NPAD, D, F.G, F.bid, 4); S.probe = 1;
            pg8::EpiBf16 E{(bf16*)(KWS + WS_P), NPAD};
            pg8::gemm_phase<pg8::EpiBf16, pg8::PlainSched, true>(F.lds, D, S, E); SEAM(ph, 1); }
        ++ph;
        if (RUN(ph)) { KA; FRAME; phase_prep3(F, l); __syncthreads(); phase_compress3(F, l); phase_rec_local(F, l); SEAM(ph, 3); }
        ++ph;
        if (RUN(ph)) { KA; FRAME; phase_rec_scan(F); SEAM(ph, 4); }
        ++ph;
        if (RUN(ph)) { KA; FRAME; phase_nsa2(F, l); if (MK_PROBE_MASK != 0) { xcd_barrier(bar); STAMP(7); } phase_rec_out(F, l); SEAM(ph, 5); }
        ++ph;
        if (RUN(ph)) { KA; FRAME;
            { pg8::BranchSched S; S.init((const bf16*)(KWS + WS_OCAT), (const bf16*)(KWS + WS_WBR) + (size_t)l * 3 * D * 512, F.G, F.bid);
              pg8::EpiMerge E{(bf16*)(KWS + WS_MERGED), (const bf16*)(KWS + WS_P) + C_MG};
              pg8::gemm_phase<pg8::EpiMerge, pg8::BranchSched, true>(F.lds, 512, S, E); }
            SEAM(ph, 6); }
        ++ph;

        if (RUN(ph)) { KA; FRAME; pg8::PlainSched S; S.init((const bf16*)(KWS + WS_MERGED), D, (const bf16*)(KWS + WS_WOUT) + (size_t)l * D * D, T, D, D, F.G, F.bid);
            pg8::EpiResF32 E{l == 0 ? KIN(I_X) : (const float*)(KWS + WS_XRES), (float*)(KWS + WS_X1), D};
            pg8::gemm_phase<pg8::EpiResF32, pg8::PlainSched, false>(F.lds, D, S, E); SEAM(ph, 8); }
        ++ph;
        if (RUN(ph)) { KA; FRAME; phase_router3(F, l); SEAM(ph, 9); }
        ++ph;
        if (RUN(ph)) { KA; FRAME; phase_lists2(F); SEAM(ph, 10); }
        ++ph;
        if (RUN(ph)) { KA; FRAME; moe_table(F, tb);
            pg8::MoeSched<1> S; S.init(F.G, F.vcu, tb, (const int*)(KWS + WS_ROUTE + 131072), (const int*)(KWS + WS_ROUTE + 262144), KWS + WS_H, (const bf16*)(KWS + WS_WGU) + (size_t)l * NE * 1024 * D);
            pg8::EpiMoe1 E{(bf16*)(KWS + WS_ACT), (const int*)(KWS + WS_ROUTE + 262144), (const float*)(KWS + WS_ROUTE + 65536), (const float*)(KWS + WS_RSTD)};
            pg8::gemm_phase<pg8::EpiMoe1, pg8::MoeSched<1>, true>(F.lds, D, S, E); SEAM(ph, 11); }
        ++ph;
        if (RUN(ph)) { KA; FRAME; moe_table(F, tb);
            pg8::MoeSched<2> S; S.init(F.G, F.vcu, tb, (const int*)(KWS + WS_ROUTE + 131072), (const int*)(KWS + WS_ROUTE + 262144), KWS + WS_ACT, (const bf16*)(KWS + WS_WDN) + (size_t)l * NE * D * FF);
            pg8::EpiMoe2 E{(bf16*)(KWS + WS_CONTRIB), (const int*)(KWS + WS_ROUTE + 262144)};
            pg8::gemm_phase<pg8::EpiMoe2, pg8::MoeSched<2>, true>(F.lds, FF, S, E); SEAM(ph, 12); }
        ++ph;
        if (l + 1 < NL) { if (RUN(ph)) { KA; FRAME; phase_norm1<1>(F, (const float*)(KWS + WS_X1), (const bf16*)(KWS + WS_CONTRIB), (float*)(KWS + WS_XRES), KIN(I_NMIX) + (size_t)(l + 1) * D, (bf16*)(KWS + WS_H)); SEAM(ph, 13); } ++ph; }
    }
    if (RUN(ph)) { KA; FRAME; phase_norm1<2>(F, (const float*)(KWS + WS_X1), (const bf16*)(KWS + WS_CONTRIB), KOUT, nullptr, nullptr); }
    if (MK_PROBE_MASK != 0 && lbid() == MK_PROBE_BID && ltid() == 0) {
        asm volatile("s_waitcnt vmcnt(0)" ::: "memory"); STAMP(15);
        unsigned long long tot = 0ull;
        for (int k2 = 0; k2 < 32; ++k2) if (k2 != 16 && ((MK_PROBE_MASK >> k2) & 1)) tot += tacc[k2];
        const unsigned long long t_end = wall_clock64() + 4ull * tot;
        while (wall_clock64() < t_end) __builtin_amdgcn_s_sleep(8);
    }
#undef RUN
#undef SEAM
}

#ifndef MK_PER_PHASE
#define MK_PER_PHASE 0
#endif
extern "C" void kernel_launch(void* const* d_in, const int* in_sizes, int n_in, void* d_out, int out_size, void* d_ws, size_t ws_size, hipStream_t stream) {
    static int grid = 0;
    if (grid == 0) {
        if (n_in != 22 || out_size != T * D || ws_size < WS_END) { fprintf(stderr, "kernel_launch: unexpected sizes (n_in %d out %d ws %zu)\n", n_in, out_size, ws_size); grid = -1; return; }
        int dev = 0, cus = 0, per_cu = 0;
        if (hipGetDevice(&dev) != hipSuccess || hipDeviceGetAttribute(&cus, hipDeviceAttributeMultiprocessorCount, dev) != hipSuccess) { grid = -1; return; }
        if (hipFuncSetAttribute((const void*)mk_fwd, hipFuncAttributeMaxDynamicSharedMemorySize, LDS_BYTES) != hipSuccess) { fprintf(stderr, "kernel_launch: hipFuncSetAttribute failed\n"); grid = -1; return; }
        if (hipOccupancyMaxActiveBlocksPerMultiprocessor(&per_cu, (const void*)mk_fwd, 512, LDS_BYTES) != hipSuccess || per_cu < 1) { fprintf(stderr, "kernel_launch: occupancy query says %d\n", per_cu); }
        (void)hipGetLastError();
        grid = cus;
    }
    if (grid < 0) return;
    if (hipMemsetAsync((char*)d_ws + WS_CTL, 0, CTL_ZERO_BYTES, stream) != hipSuccess) return;
    Args a{};
    for (int i = 0; i < 22; ++i) a.in[i] = (const GAS float*)d_in[i];
    a.out = (GAS float*)d_out; a.ws = (GAS unsigned char*)d_ws;
#if MK_PER_PHASE
    const int total = 1 + NL * PH_PER_LAYER + (NL - 1) + 1;
    for (int k = 0; k < total; ++k) { a.ph_lo = k; a.ph_hi = k + 1; a.li = 0; hipLaunchKernelGGL(mk_fwd, dim3(grid), dim3(512), LDS_BYTES, stream, a); }
#else
    a.ph_lo = 0; a.ph_hi = 1000; a.li = 0;
    hipLaunchKernelGGL(mk_fwd, dim3(grid), dim3(512), LDS_BYTES, stream, a);
#endif
    const hipError_t le = hipPeekAtLastError();
    if (le != hipSuccess) fprintf(stderr, "kernel_launch: launch failed: %s\n", hipGetErrorName(le));
}
```

```cpp
#include <hip/hip_runtime.h>
#include <cstdio>
#include <cstdint>

#ifndef MK_PROBE_MASK
#define MK_PROBE_MASK 0
#endif
#ifndef MK_PROBE_BID
#define MK_PROBE_BID 0
#endif
#define GAS __attribute__((address_space(1)))
#define LAS __attribute__((address_space(3)))
typedef unsigned short bf16;
typedef short bf16x8 __attribute__((ext_vector_type(8)));
typedef float f32x4 __attribute__((ext_vector_type(4)));
typedef float f32x2 __attribute__((ext_vector_type(2)));
typedef unsigned u32x4 __attribute__((ext_vector_type(4)));
typedef unsigned u32x2 __attribute__((ext_vector_type(2)));

constexpr int T = 8192, D = 2048, NL = 2, INC = 11048, NPAD = 11264;
constexpr int NE = 32, FF = 512, NCH = T / 64;
constexpr float EPS = 1e-6f, NEGB = -1e30f;
constexpr int C_Q = 0, C_KC = 512, C_VC = 640, C_KS = 768, C_VS = 896, C_KW = 1024, C_VW = 1152;
constexpr int C_HQ = 1280, C_HF = 1792, C_HI = 2304, C_HG = 2816, C_GQ = 3328, C_GK = 3584, C_GV = 3840, C_GR = 4352;
constexpr int C_MG = 4864, C_NG = 11008, C_GA = 11032;

constexpr size_t MiB = 1u << 20;
constexpr size_t WS_CTL = 0, CTL_ZERO_BYTES = 1 * MiB;
constexpr size_t WS_WIN = 2 * MiB;
constexpr size_t WS_WBR = 90 * MiB;
constexpr size_t WS_WOUT = 102 * MiB;
constexpr size_t WS_WGU = 118 * MiB;
constexpr size_t WS_WDN = 374 * MiB;
constexpr size_t WS_H = 502 * MiB;
constexpr size_t WS_P = 534 * MiB;
constexpr size_t WS_OCAT = 710 * MiB;
constexpr size_t WS_PROJ = 734 * MiB;
constexpr size_t WS_MERGED = 830 * MiB;
constexpr size_t WS_X1 = 862 * MiB;
constexpr size_t WS_XRES = 926 * MiB;
constexpr size_t WS_CONTRIB = 990 * MiB;
constexpr size_t WS_ACT = 1054 * MiB;
constexpr size_t WS_QN = 1078 * MiB;
constexpr size_t WS_KV = 1094 * MiB;
constexpr size_t WS_KC = 1118 * MiB;
constexpr size_t WS_ORAW = 1119 * MiB;
constexpr size_t WS_ROUTE = 1151 * MiB;
constexpr size_t WS_SLOC_HG = 1153 * MiB;
constexpr size_t WS_SLOC_GL = 1185 * MiB;
constexpr size_t WS_SPREV_HG = 1201 * MiB;
constexpr size_t WS_SPREV_GL = 1217 * MiB;
constexpr size_t WS_DEC = 1225 * MiB;
constexpr size_t WS_QS = 1226 * MiB;
constexpr size_t WS_KS2 = 1234 * MiB;
constexpr size_t WS_KW2 = 1236 * MiB;
constexpr size_t WS_VST = 1238 * MiB;
constexpr size_t WS_VWT = 1240 * MiB;
constexpr size_t WS_KCB = 1242 * MiB;
constexpr size_t WS_WRT = 1243 * MiB;
constexpr size_t WS_HIST = 1244 * MiB;
constexpr size_t WS_CW = 1245 * MiB;
constexpr size_t WS_RSTD = 1247 * MiB;
constexpr size_t WS_END = 1248 * MiB;
constexpr size_t KV_STRIDE = (size_t)2 * T * 64;
constexpr int CW_BAR = 4096;

constexpr int RING_BYTES = 131072;
constexpr int LDS_BYTES = 147456;
constexpr int MISC_OFF = LDS_BYTES - 2048;

#define LDS_WAIT() asm volatile("s_waitcnt lgkmcnt(0)" ::: "memory")
#define VM_WAIT() asm volatile("s_waitcnt vmcnt(0)" ::: "memory")
#define WSYNC() asm volatile("s_waitcnt lgkmcnt(0)" ::: "memory")

__device__ __forceinline__ unsigned f2bf(float f) { unsigned u = __builtin_bit_cast(unsigned, f); return (u + 0x7fffu + ((u >> 16) & 1u)) >> 16; }
__device__ __forceinline__ unsigned pk2(float lo, float hi) { return f2bf(lo) | (f2bf(hi) << 16); }
__device__ __forceinline__ float bf2f(unsigned b) { return __builtin_bit_cast(float, (b & 0xffffu) << 16); }
__device__ __forceinline__ float bflo(unsigned w) { return __builtin_bit_cast(float, w << 16); }
__device__ __forceinline__ float bfhi(unsigned w) { return __builtin_bit_cast(float, w & 0xffff0000u); }
__device__ __forceinline__ float wave_sum(float v) {
#pragma unroll
    for (int o = 1; o < 64; o <<= 1) v += __shfl_xor(v, o);
    return v;
}
__device__ __forceinline__ float wave_max(float v) {
#pragma unroll
    for (int o = 1; o < 64; o <<= 1) v = fmaxf(v, __shfl_xor(v, o));
    return v;
}
__device__ __forceinline__ int ltid() { int t = threadIdx.x; asm volatile("" : "+v"(t)); return t; }
__device__ __forceinline__ int lbid() { int b = blockIdx.x; asm volatile("" : "+s"(b)); return b; }
typedef __bf16 bf16x2_t __attribute__((ext_vector_type(2)));
__device__ __forceinline__ unsigned pkbf(float lo, float hi) { const f32x2 v = {lo, hi}; return __builtin_bit_cast(unsigned, __builtin_convertvector(v, bf16x2_t)); }
constexpr float LOG2E = 1.4426950408889634f;
__device__ __forceinline__ float sigmoidf_(float x) { return 1.0f / (1.0f + expf(-x)); }
__device__ __forceinline__ float fsig(float x) { return __builtin_amdgcn_rcpf(1.0f + __builtin_amdgcn_exp2f(-LOG2E * x)); }

#define GSTAMP(lds_, slot) do { if (MK_PROBE_MASK != 0 && lbid() == MK_PROBE_BID && ltid() == 0) { volatile LAS unsigned long long* _ta = (volatile LAS unsigned long long*)((lds_) + MISC_OFF + 512); const unsigned long long _n = wall_clock64(); _ta[slot] += _n - _ta[16]; _ta[16] = _n; } } while (0)
#define XB_TMO      128
#define XB_XCNT(j)  (256  + 64 * (j))
#define XB_XSUB(j)  (1280 + 64 * (j))
#define XB_XGEN(j)  (2304 + 64 * (j))
#define XB_TOP      3328
#define XB_TOPGEN   3392
#define XCD_BAR_WORDS 3456
#define XB_SPIN_CAP (1u << 25)

__device__ __forceinline__ unsigned xb_ld(unsigned* p)              { return __hip_atomic_load(p, __ATOMIC_RELAXED, __HIP_MEMORY_SCOPE_AGENT); }
__device__ __forceinline__ unsigned xb_add(unsigned* p, unsigned v) { return __hip_atomic_fetch_add(p, v, __ATOMIC_RELAXED, __HIP_MEMORY_SCOPE_AGENT); }
__device__ __forceinline__ unsigned xb_xcc_id() { return (unsigned)__builtin_amdgcn_s_getreg((3 << 11) | 20) & 0xFu; }
#define XB_SPIN(cond, bar) do { unsigned _sp = 0; while (cond) { __builtin_amdgcn_s_sleep(1); \
    if ((++_sp & 255u) == 0u) { if (xb_ld(&(bar)[XB_TMO])) break; if (_sp > XB_SPIN_CAP) { atomicAdd(&(bar)[XB_TMO], 1u); break; } } } } while (0)

struct XcdBarrier { unsigned* bar; unsigned x; volatile LAS unsigned* st; };

__device__ __forceinline__ XcdBarrier xcd_barrier_post(unsigned* bar, volatile LAS unsigned* st) {
    XcdBarrier b; b.bar = bar; b.x = xb_xcc_id(); b.st = st;
    if (threadIdx.x == 0) (void)xb_add(&bar[XB_XCNT(b.x)], 1u);
    return b;
}
__device__ __forceinline__ void xcd_barrier_complete(unsigned* bar, unsigned x, unsigned& nloc, unsigned& nx) {
    const unsigned G = gridDim.x * gridDim.y * gridDim.z;
    unsigned sum, cnt, mine, sp = 0u;
    for (;;) {
        sum = 0u; cnt = 0u; mine = 0u;
#pragma unroll
        for (unsigned j = 0; j < 16; ++j) { const unsigned c = xb_ld(&bar[XB_XCNT(j)]); sum += c; cnt += (c > 0u) ? 1u : 0u; mine = (j == x) ? c : mine; }
        if (sum == G) break;
        __builtin_amdgcn_s_sleep(1);
        if ((++sp & 255u) == 0u) { if (xb_ld(&bar[XB_TMO])) break; if (sp > XB_SPIN_CAP) { atomicAdd(&bar[XB_TMO], 1u); break; } }
    }
    nloc = mine > 0u ? mine : 1u; nx = cnt > 0u ? cnt : 1u;
}
__device__ __forceinline__ void xcd_barrier(const XcdBarrier& b) {
    asm volatile("s_waitcnt vmcnt(0)" ::: "memory");
    __syncthreads();
    if (threadIdx.x == 0) {
        unsigned* bar = b.bar;
        __builtin_amdgcn_s_waitcnt(0);
        unsigned nloc = b.st[0], nx = b.st[1];
        if (nloc == 0u) { xcd_barrier_complete(bar, b.x, nloc, nx); b.st[0] = nloc; b.st[1] = nx; }
        const unsigned old = xb_add(&bar[XB_XSUB(b.x)], 1u);
        const unsigned gen = old / nloc;
        if (old + 1u == (gen + 1u) * nloc) {
            __builtin_amdgcn_fence(__ATOMIC_RELEASE, "agent");
            asm volatile("s_waitcnt vmcnt(0)" ::: "memory");
            const unsigned og = xb_add(&bar[XB_TOP], 1u);
            const unsigned tg = og / nx;
            if (og + 1u == (tg + 1u) * nx) xb_add(&bar[XB_TOPGEN], 1u);
            else XB_SPIN(xb_ld(&bar[XB_TOPGEN]) == tg, bar);
            __builtin_amdgcn_fence(__ATOMIC_ACQUIRE, "agent");
            xb_add(&bar[XB_XGEN(b.x)], 1u);
            asm volatile("s_waitcnt vmcnt(0)" ::: "memory");
        } else {
            XB_SPIN(xb_ld(&bar[XB_XGEN(b.x)]) == gen, bar);
            __builtin_amdgcn_fence(__ATOMIC_ACQUIRE, "agent");
            asm volatile("s_waitcnt vmcnt(0)" ::: "memory");
        }
    }
    __syncthreads();
}

namespace pg8 {
constexpr int BM = 256, BK = 64, HALF = 128, HTB = HALF * BK * 2, STAGE_BYTES = 8 * HTB, NXCD = 8, WGM = 8;
__host__ __device__ __forceinline__ int lds_byte(int r, int c) { const int st = (r >> 4) * 2 + (c >> 5), rr = r & 15, cc = c & 31, ob = rr * 64 + cc * 2; return st * 1024 + (ob ^ (((ob >> 9) & 1) << 5)); }
__host__ __device__ __forceinline__ void stage_rc(int b, int& R, int& C) { const int st = b / 1024, sb = b % 1024, swz = sb ^ (((sb >> 9) & 1) << 5); R = (st >> 1) * 16 + swz / 64; C = (st & 1) * 32 + (swz % 64) / 2; }
__host__ __device__ __forceinline__ int perm32(int rho) { const int n = rho >> 4, i = rho & 15; return 8 * (i >> 2) + 4 * n + (i & 3); }

struct Unit { int pm, pn, e, nvalid, slot0, half, row0; const char *A0, *A1, *B0, *B1; unsigned va[2][2]; };

__device__ __forceinline__ unsigned cvt_pk_bf16(float lo, float hi) { unsigned r; asm volatile("v_cvt_pk_bf16_f32 %0, %1, %2" : "=v"(r) : "v"(lo), "v"(hi)); return r; }

template <class Epi, class Sched, bool ALIGN_EPI>
__device__ __forceinline__ void gemm_phase(LAS unsigned char* lds, const int K, const Sched& S, const Epi& E) {
    const int tid = ltid(), wid = __builtin_amdgcn_readfirstlane(tid >> 6), lane = tid & 63, wr = wid >> 2, wc = wid & 3, fr = lane & 15, fq = lane >> 4;
    const int nt = K / BK;
    unsigned voffB[2];
#pragma unroll
    for (int i = 0; i < 2; ++i) { int R, C; stage_rc(tid * 16 + i * 8192, R, C); const int Rb = Epi::PERM ? ((R & ~31) + perm32(R & 31)) : R; voffB[i] = (unsigned)(Rb * K + C) * 2u; }
    const size_t kstep = (size_t)(BK * 2);
    const unsigned ldsw = (unsigned)wid * 1024u;
    const int aoff = lds_byte(wr * 64 + fr, fq * 8), boff = lds_byte(wc * 32 + fr, fq * 8);
#define PG8_SA(b, h) (((b) * 2 + (h)) * HTB)
#define PG8_SB(b, h) ((4 + (b) * 2 + (h)) * HTB)
#define PG8_STAGE(bufoff, gbase, voff) do { _Pragma("unroll") for (int _i = 0; _i < 2; ++_i) \
        __builtin_amdgcn_global_load_lds((const unsigned*)((const char*)(gbase) + (voff)[_i]), (LAS unsigned*)(lds + (bufoff) + ldsw + _i * 8192), 16, 0, 0); } while (0)
#define PG8_LDA(dst, b, h) do { _Pragma("unroll") for (int m = 0; m < 4; ++m) _Pragma("unroll") for (int k = 0; k < 2; ++k) dst[m][k] = *(const LAS bf16x8*)(lds + PG8_SA(b, h) + aoff + m * 2048 + k * 1024); } while (0)
#define PG8_LDB(dst, b, h) do { _Pragma("unroll") for (int n = 0; n < 2; ++n) _Pragma("unroll") for (int k = 0; k < 2; ++k) dst[n][k] = *(const LAS bf16x8*)(lds + PG8_SB(b, h) + boff + n * 2048 + k * 1024); } while (0)
#define PG8_MMA(ai, bj, At, Bt) do { __builtin_amdgcn_s_setprio(1); _Pragma("unroll") for (int m = 0; m < 4; ++m) _Pragma("unroll") for (int n = 0; n < 2; ++n) _Pragma("unroll") for (int k = 0; k < 2; ++k) \
        acc[ai][bj][m][n] = __builtin_amdgcn_mfma_f32_16x16x32_bf16(Bt[n][k], At[m][k], acc[ai][bj][m][n], 0, 0, 0); __builtin_amdgcn_s_setprio(0); } while (0)
#define PG8_WAIT_V(n) asm volatile("s_waitcnt vmcnt(" #n ")" ::: "memory")
#define PG8_WAIT_L(n) asm volatile("s_waitcnt lgkmcnt(" #n ")" ::: "memory")
#define PG8_BAR __builtin_amdgcn_s_barrier()
#define PG8_SCHED __builtin_amdgcn_sched_barrier(0)
#define VA(u, h) (Sched::GATHER ? (u).va[h] : S.va)
    Unit cur, nxt; int ui = 0;
    if (!S.next(0, cur)) return;
    if (S.probe) GSTAMP(lds, 27);
    f32x4 acc[2][2][4][2];
#pragma unroll
    for (int a = 0; a < 2; ++a)
#pragma unroll
        for (int b = 0; b < 2; ++b)
#pragma unroll
            for (int m = 0; m < 4; ++m)
#pragma unroll
                for (int n = 0; n < 2; ++n) acc[a][b][m][n] = (f32x4){0.f, 0.f, 0.f, 0.f};
    bf16x8 At[4][2], B0[2][2], B1[2][2];
    PG8_STAGE(PG8_SB(0, 0), cur.B0, voffB); PG8_STAGE(PG8_SB(0, 1), cur.B1, voffB); PG8_STAGE(PG8_SA(0, 0), cur.A0, VA(cur, 0)); PG8_STAGE(PG8_SA(0, 1), cur.A1, VA(cur, 1));
    if (wr == 1) PG8_BAR;
    PG8_WAIT_V(2); PG8_BAR;
    PG8_STAGE(PG8_SB(1, 0), cur.B0 + kstep, voffB); PG8_STAGE(PG8_SA(1, 0), cur.A0 + kstep, VA(cur, 0)); PG8_STAGE(PG8_SB(1, 1), cur.B1 + kstep, voffB);
    PG8_WAIT_V(6); PG8_BAR;
    for (;;) {
        const bool has_next = S.next(ui + 1, nxt);
        if (!has_next) nxt = cur;
        for (int t = 0; t < nt; t += 2) {
            const bool last = (t == nt - 2);
            const char* a1h1 = cur.A1 + (size_t)(t + 1) * kstep;
            const char* a2h0 = last ? nxt.A0 : cur.A0 + (size_t)(t + 2) * kstep; const char* a2h1 = last ? nxt.A1 : cur.A1 + (size_t)(t + 2) * kstep;
            const char* b2h0 = last ? nxt.B0 : cur.B0 + (size_t)(t + 2) * kstep; const char* b2h1 = last ? nxt.B1 : cur.B1 + (size_t)(t + 2) * kstep;
            unsigned v2h0[2], v2h1[2];
#pragma unroll
            for (int i = 0; i < 2; ++i) { if constexpr (Sched::GATHER) { v2h0[i] = last ? nxt.va[0][i] : cur.va[0][i]; v2h1[i] = last ? nxt.va[1][i] : cur.va[1][i]; } else { v2h0[i] = S.va[i]; v2h1[i] = S.va[i]; } }
            PG8_LDB(B0, 0, 0); PG8_LDB(B1, 0, 1); PG8_SCHED; PG8_LDA(At, 0, 0); PG8_STAGE(PG8_SA(1, 1), a1h1, VA(cur, 1));
            PG8_WAIT_V(8); PG8_WAIT_L(0); PG8_BAR; PG8_MMA(0, 0, At, B0); PG8_MMA(0, 1, At, B1); PG8_BAR; PG8_SCHED;
            if (!cur.half) PG8_LDA(At, 0, 1);
            PG8_STAGE(PG8_SB(0, 0), b2h0, voffB); PG8_STAGE(PG8_SB(0, 1), b2h1, voffB); PG8_STAGE(PG8_SA(0, 0), a2h0, v2h0);
            PG8_WAIT_V(8); PG8_WAIT_L(0); PG8_BAR; if (!cur.half) { PG8_MMA(1, 0, At, B0); PG8_MMA(1, 1, At, B1); } PG8_BAR; PG8_SCHED;
            PG8_LDB(B0, 1, 0); PG8_LDB(B1, 1, 1); PG8_SCHED; PG8_LDA(At, 1, 0); PG8_STAGE(PG8_SA(0, 1), a2h1, v2h1);
            PG8_WAIT_V(8); PG8_WAIT_L(0); PG8_BAR; PG8_MMA(0, 0, At, B0); PG8_MMA(0, 1, At, B1); PG8_BAR; PG8_SCHED;
            if (!cur.half) PG8_LDA(At, 1, 1);
            PG8_STAGE(PG8_SB(1, 0), b2h0 + kstep, voffB); PG8_STAGE(PG8_SB(1, 1), b2h1 + kstep, voffB); PG8_STAGE(PG8_SA(1, 0), a2h0 + kstep, v2h0);
            PG8_WAIT_V(8); PG8_WAIT_L(0); PG8_BAR; if (!cur.half) { PG8_MMA(1, 0, At, B0); PG8_MMA(1, 1, At, B1); } PG8_BAR; PG8_SCHED;
        }
        if (S.probe) GSTAMP(lds, 25);
        if constexpr (ALIGN_EPI) { if (wr == 0) PG8_BAR; }
        if constexpr (Sched::CHAIN) E.chain(acc, cur, wr, wc, fr, fq); else E(acc, cur, wr, wc, fr, fq);
        if (S.probe) { asm volatile("s_waitcnt vmcnt(0)" ::: "memory"); GSTAMP(lds, 26); }
        if (!has_next) break;
        if (!Sched::CHAIN || nxt.e == 0) {
#pragma unroll
        for (int a = 0; a < 2; ++a)
#pragma unroll
            for (int b = 0; b < 2; ++b)
#pragma unroll
                for (int m = 0; m < 4; ++m)
#pragma unroll
                    for (int n = 0; n < 2; ++n) acc[a][b][m][n] = (f32x4){0.f, 0.f, 0.f, 0.f};
        }
        cur = nxt; ++ui;
        if constexpr (ALIGN_EPI) { if (wr == 1) PG8_BAR; }
    }
    PG8_WAIT_V(0);
    if constexpr (!ALIGN_EPI) { if (wr == 0) PG8_BAR; }
    PG8_BAR;
#undef VA
#undef PG8_SA
#undef PG8_SB
#undef PG8_STAGE
#undef PG8_LDA
#undef PG8_LDB
#undef PG8_MMA
#undef PG8_WAIT_V
#undef PG8_WAIT_L
#undef PG8_BAR
#undef PG8_SCHED
}

struct PlainSched {
    static constexpr bool GATHER = false, CHAIN = false;
    int nM, nN, nwg, G, c, lda, K, nNh, probe = 0; const char* A; const char* Bt; unsigned va[2];
    __device__ __forceinline__ void init(const bf16* A_, int lda_, const bf16* Bt_, int M, int N, int K_, int G_, int c_, int nNh_ = 0) {
        nM = M / BM; nN = N / BM - nNh_; nNh = nNh_; nwg = nM * nN; G = G_; c = c_; lda = lda_; K = K_; A = (const char*)A_; Bt = (const char*)Bt_;
#pragma unroll
        for (int i = 0; i < 2; ++i) { int R, C; stage_rc((int)ltid() * 16 + i * 8192, R, C); va[i] = (unsigned)(R * lda + C) * 2u; }
    }
    __device__ __forceinline__ bool next(int i, Unit& u) const {
        const long L = (long)i * G + c;
        u.e = 0; u.nvalid = 256; u.slot0 = 0; u.va[0][0] = 0u; u.va[0][1] = 0u; u.va[1][0] = 0u; u.va[1][1] = 0u;
        if (L >= nwg) { const int hL = (int)(L - nwg); if (hL >= 2 * nM * nNh) return false;
            const int hm = hL / nNh, pn = nN + hL % nNh;
            u.pm = hm >> 1; u.pn = pn; u.half = 1; u.row0 = hm * HALF;
            u.A0 = A + (size_t)hm * HALF * lda * 2; u.A1 = u.A0;
            u.B0 = Bt + (size_t)pn * BM * K * 2; u.B1 = u.B0 + (size_t)HALF * K * 2;
            return true; }
        int wgid = (int)L; { const int q = nwg / NXCD, r = nwg % NXCD, xcd = wgid % NXCD, off = wgid / NXCD; wgid = (xcd < r ? xcd * (q + 1) : r * (q + 1) + (xcd - r) * q) + off; }
        const int nig = WGM * nN, gid = wgid / nig, fm = gid * WGM, gsz = (nM - fm) < WGM ? (nM - fm) : WGM;
        u.pm = fm + ((wgid % nig) % gsz); u.pn = (wgid % nig) / gsz; u.half = 0; u.row0 = u.pm * BM;
        u.A0 = A + (size_t)u.pm * BM * lda * 2; u.A1 = u.A0 + (size_t)HALF * lda * 2;
        u.B0 = Bt + (size_t)u.pn * BM * K * 2; u.B1 = u.B0 + (size_t)HALF * K * 2;
        return true;
    }
};
struct BranchSched {
    static constexpr bool GATHER = false, CHAIN = true;
    int G, c, probe = 0; const char* A; const char* Bt; unsigned va[2];
    __device__ __forceinline__ void init(const bf16* OC, const bf16* WBRl, int G_, int c_) { G = G_; c = c_; A = (const char*)OC; Bt = (const char*)WBRl;
#pragma unroll
        for (int i = 0; i < 2; ++i) { int R, C; stage_rc((int)ltid() * 16 + i * 8192, R, C); va[i] = (unsigned)(R * 1536 + C) * 2u; } }
    __device__ __forceinline__ bool next(int i, Unit& u) const {
        const int tile = (i / 3) * G + c, n = i % 3; if (tile >= (T / BM) * (D / BM)) return false;
        int wgid = tile; { const int nwg = 256, q = nwg / NXCD, xcd = wgid % NXCD, off = wgid / NXCD; wgid = xcd * q + off; }
        const int nN = D / BM, nig = WGM * nN, gid = wgid / nig, fm = gid * WGM;
        u.pm = fm + ((wgid % nig) % WGM); u.pn = (wgid % nig) / WGM; u.e = n; u.nvalid = 256; u.slot0 = 0; u.half = 0; u.row0 = u.pm * BM;
        u.va[0][0] = 0u; u.va[0][1] = 0u; u.va[1][0] = 0u; u.va[1][1] = 0u;
        u.A0 = A + (size_t)u.pm * BM * 1536 * 2 + (size_t)n * 512 * 2; u.A1 = u.A0 + (size_t)HALF * 1536 * 2;
        u.B0 = Bt + (size_t)n * D * 512 * 2 + (size_t)u.pn * BM * 512 * 2; u.B1 = u.B0 + (size_t)HALF * 512 * 2;
        return true;
    }
};
template <int MODE> struct MoeSched {
    static constexpr int NPN = MODE == 1 ? 4 : 8;
    static constexpr bool GATHER = MODE == 1, CHAIN = false;
    int G, c, probe = 0; const LAS int* tb; const int* cnt; const int* list; const char* A; const char* W; unsigned va[2];
    __device__ __forceinline__ void init(int G_, int c_, const LAS int* tb_, const int* cnt_, const int* list_, const void* A_, const void* W_) {
        G = G_; c = c_; tb = tb_; cnt = cnt_; list = list_; A = (const char*)A_; W = (const char*)W_;
#pragma unroll
        for (int i = 0; i < 2; ++i) { int R, C; stage_rc((int)ltid() * 16 + i * 8192, R, C); va[i] = (unsigned)(R * FF + C) * 2u; }
    }
    __device__ __forceinline__ bool next(int i, Unit& u) const {
        const int L = i * G + c, nfull = __builtin_amdgcn_readfirstlane(tb[33 + NE]), nhalf = __builtin_amdgcn_readfirstlane(tb[66 + NE]);
        if (L >= (nfull + nhalf) * NPN) return false;
        const bool half = L >= nfull * NPN; const int Lr = half ? L - nfull * NPN : L, base = half ? 66 : 33;
        const int tq = Lr / NPN, pn = Lr % NPN; int e = 0;
        while (e < NE - 1 && __builtin_amdgcn_readfirstlane(tb[base + e + 1]) <= tq) ++e;
        const int ne = __builtin_amdgcn_readfirstlane(cnt[e]);
        const int pm = half ? (ne - 1) / 256 : tq - __builtin_amdgcn_readfirstlane(tb[33 + e]);
        const int tl = __builtin_amdgcn_readfirstlane(tb[e]) + pm;
        u.pm = pm; u.pn = pn; u.e = e; u.nvalid = ne - pm * 256; u.slot0 = tl * 256; u.half = half ? 1 : 0; u.row0 = 0;
        if (MODE == 1) {
            u.A0 = A; u.A1 = A;
#pragma unroll
            for (int h = 0; h < 2; ++h)
#pragma unroll
                for (int k = 0; k < 2; ++k) { int Rk, Ck; stage_rc((int)ltid() * 16 + k * 8192, Rk, Ck); int idx = pm * 256 + h * 128 + Rk; idx = idx < ne ? idx : ne - 1; const int entry = list[e * 8192 + idx]; u.va[h][k] = (unsigned)(entry >> 1) * (unsigned)(D * 2) + (unsigned)Ck * 2u; }
            const char* we = W + (size_t)e * 1024 * D * 2;
            u.B0 = we + (size_t)(pn * 128) * D * 2; u.B1 = we + (size_t)(512 + pn * 128) * D * 2;
        } else {
            u.va[0][0] = 0u; u.va[0][1] = 0u; u.va[1][0] = 0u; u.va[1][1] = 0u;
            u.A0 = A + (size_t)tl * 256 * FF * 2; u.A1 = u.A0 + (size_t)HALF * FF * 2;
            const char* we = W + (size_t)e * D * FF * 2;
            u.B0 = we + (size_t)(pn * 256) * FF * 2; u.B1 = u.B0 + (size_t)HALF * FF * 2;
        }
        return true;
    }
};

struct EpiBf16 {
    static constexpr bool PERM = true;
    bf16* O; int ldc;
    __device__ __forceinline__ void operator()(const f32x4 (&acc)[2][2][4][2], const Unit& u, int wr, int wc, int fr, int fq) const {
        const int row0 = u.row0 + wr * 64 + fr, col0 = u.pn * BM + wc * 32 + 8 * fq;
#pragma unroll
        for (int ai = 0; ai < 2; ++ai) if (ai == 0 || !u.half)
#pragma unroll
            for (int m = 0; m < 4; ++m) { bf16* rowp = O + (size_t)(row0 + ai * HALF + m * 16) * ldc + col0;
#pragma unroll
                for (int bj = 0; bj < 2; ++bj) { const f32x4 v0 = acc[ai][bj][m][0], v1 = acc[ai][bj][m][1];
                    u32x4 w; w.x = cvt_pk_bf16(v0[0], v0[1]); w.y = cvt_pk_bf16(v0[2], v0[3]); w.z = cvt_pk_bf16(v1[0], v1[1]); w.w = cvt_pk_bf16(v1[2], v1[3]);
                    *(u32x4*)(rowp + bj * HALF) = w; } }
    }
};
struct EpiMerge {
    static constexpr bool PERM = true;
    bf16* MG; const bf16* gate0;
    __device__ __forceinline__ void operator()(const f32x4 (&acc)[2][2][4][2], const Unit& u, int wr, int wc, int fr, int fq) const {}
    __device__ __forceinline__ void chain(f32x4 (&acc)[2][2][4][2], const Unit& u, int wr, int wc, int fr, int fq) const {
        const int row0 = u.row0 + wr * 64 + fr, col0 = u.pn * BM + wc * 32 + 8 * fq; const bool last = u.e == 2;
        const bf16* __restrict__ ga = gate0 + (size_t)u.e * D; const bf16* __restrict__ gb = gate0 + (size_t)(last ? 2 : u.e + 1) * D;
        bf16* __restrict__ MGp = MG;
        u32x4 qa[2][2], qb[2][2];
#define EMG_LOAD(buf, g) do { const size_t row_ = (size_t)(row0 + ((g) >> 2) * HALF + ((g) & 3) * 16); \
            _Pragma("unroll") for (int bj_ = 0; bj_ < 2; ++bj_) { qa[buf][bj_] = *(const u32x4*)(ga + row_ * NPAD + col0 + bj_ * HALF); qb[buf][bj_] = *(const u32x4*)(gb + row_ * NPAD + col0 + bj_ * HALF); } } while (0)
        EMG_LOAD(0, 0);
#pragma unroll
        for (int g = 0; g < 8; ++g) { if (g + 1 < 8) EMG_LOAD((g + 1) & 1, g + 1);
            const int ai = g >> 2, m = g & 3; const size_t row = (size_t)(row0 + ai * HALF + m * 16);
#pragma unroll
            for (int bj = 0; bj < 2; ++bj) { float o[8];
                const unsigned wa[4] = {qa[g & 1][bj].x, qa[g & 1][bj].y, qa[g & 1][bj].z, qa[g & 1][bj].w}, wb[4] = {qb[g & 1][bj].x, qb[g & 1][bj].y, qb[g & 1][bj].z, qb[g & 1][bj].w};
#pragma unroll
                for (int k = 0; k < 8; ++k) { const float a = acc[ai][bj][m][k >> 2][k & 3];
                    const float xa = __builtin_bit_cast(float, (k & 1) ? (wa[k >> 1] & 0xffff0000u) : (wa[k >> 1] << 16)), xb = __builtin_bit_cast(float, (k & 1) ? (wb[k >> 1] & 0xffff0000u) : (wb[k >> 1] << 16));
                    const float ea = __builtin_amdgcn_exp2f(-LOG2E * xa), eb = __builtin_amdgcn_exp2f(-LOG2E * xb);
                    const float f = (last ? 1.0f : 1.0f + eb) * __builtin_amdgcn_rcpf(1.0f + ea);
                    o[k] = a * f; acc[ai][bj][m][k >> 2][k & 3] = o[k]; }
                if (last) { u32x4 w; w.x = cvt_pk_bf16(o[0], o[1]); w.y = cvt_pk_bf16(o[2], o[3]); w.z = cvt_pk_bf16(o[4], o[5]); w.w = cvt_pk_bf16(o[6], o[7]);
                    *(u32x4*)(MGp + row * D + col0 + bj * HALF) = w; } } }
#undef EMG_LOAD
    }
};
struct EpiResF32 {
    static constexpr bool PERM = false;
    const float* R; float* O; int ldc;
    __device__ __forceinline__ void operator()(const f32x4 (&acc)[2][2][4][2], const Unit& u, int wr, int wc, int fr, int fq) const {
        const int row0 = u.row0 + wr * 64 + fr, col0 = u.pn * BM + wc * 32 + 4 * fq;
        const float* __restrict__ Rp = R; float* __restrict__ Op = O;
        f32x4 rv[2][4];
#define ERES_LOAD(buf, g) do { const size_t off_ = (size_t)(row0 + ((g) >> 2) * HALF + ((g) & 3) * 16) * ldc + col0; \
            _Pragma("unroll") for (int q_ = 0; q_ < 4; ++q_) rv[buf][q_] = *(const f32x4*)(Rp + off_ + (q_ >> 1) * HALF + (q_ & 1) * 16); } while (0)
        ERES_LOAD(0, 0);
#pragma unroll
        for (int g = 0; g < 8; ++g) { if (g + 1 < 8) ERES_LOAD((g + 1) & 1, g + 1);
            const int ai = g >> 2, m = g & 3; const size_t off = (size_t)(row0 + ai * HALF + m * 16) * ldc + col0;
            if (ai == 0 || !u.half) {
#pragma unroll
                for (int q = 0; q < 4; ++q) *(f32x4*)(Op + off + (q >> 1) * HALF + (q & 1) * 16) = acc[ai][q >> 1][m][q & 1] + rv[g & 1][q]; } }
#undef ERES_LOAD
    }
};
struct EpiMoe1 {
    static constexpr bool PERM = true;
    bf16* ACT; const int* list; const float* ew; const float* rstd;
    __device__ __forceinline__ void operator()(const f32x4 (&acc)[2][2][4][2], const Unit& u, int wr, int wc, int fr, int fq) const {
        const int col0 = u.pn * 128 + wc * 32 + 8 * fq;
#pragma unroll
        for (int ai = 0; ai < 2; ++ai) if (ai == 0 || !u.half)
#pragma unroll
            for (int m = 0; m < 4; ++m) { const int r = ai * HALF + wr * 64 + m * 16 + fr; float w = 0.f, rsd = 0.f;
                if (r < u.nvalid) { const int entry = list[u.e * 8192 + u.pm * 256 + r]; w = ew[entry]; rsd = rstd[entry >> 1]; }
                float o[8];
#pragma unroll
                for (int n = 0; n < 2; ++n)
#pragma unroll
                    for (int j = 0; j < 4; ++j) { const float g = acc[ai][0][m][n][j] * rsd, up = acc[ai][1][m][n][j] * rsd; o[n * 4 + j] = g * fsig(g) * up * w; }
                u32x4 pk; pk.x = cvt_pk_bf16(o[0], o[1]); pk.y = cvt_pk_bf16(o[2], o[3]); pk.z = cvt_pk_bf16(o[4], o[5]); pk.w = cvt_pk_bf16(o[6], o[7]);
                *(u32x4*)(ACT + (size_t)(u.slot0 + r) * FF + col0) = pk; }
    }
};
struct EpiMoe2 {
    static constexpr bool PERM = true;
    bf16* CO; const int* list;
    __device__ __forceinline__ void operator()(const f32x4 (&acc)[2][2][4][2], const Unit& u, int wr, int wc, int fr, int fq) const {
        const int col0 = u.pn * BM + wc * 32 + 8 * fq;
#pragma unroll
        for (int ai = 0; ai < 2; ++ai) if (ai == 0 || !u.half)
#pragma unroll
            for (int m = 0; m < 4; ++m) { const int r = ai * HALF + wr * 64 + m * 16 + fr;
                if (r < u.nvalid) { const int entry = list[u.e * 8192 + u.pm * 256 + r]; bf16* rowp = CO + (size_t)entry * D + col0;
#pragma unroll
                    for (int bj = 0; bj < 2; ++bj) { const f32x4 v0 = acc[ai][bj][m][0], v1 = acc[ai][bj][m][1];
                        u32x4 w; w.x = cvt_pk_bf16(v0[0], v0[1]); w.y = cvt_pk_bf16(v0[2], v0[3]); w.z = cvt_pk_bf16(v1[0], v1[1]); w.w = cvt_pk_bf16(v1[2], v1[3]);
                        *(u32x4*)(rowp + bj * HALF) = w; } } }
    }
};
}

struct Frame {
    LAS unsigned char* lds; volatile LAS unsigned* MISC;
    int tid, lane, wave, vcu, G, gw, NGW, bid;
};
struct Args { const GAS float* in[22]; GAS float* out; GAS unsigned char* ws; int ph_lo, ph_hi, li, pad; };
typedef const __attribute__((address_space(4))) Args KArgs;
__device__ __forceinline__ KArgs* ka_fresh() { unsigned long long p = (unsigned long long)__builtin_amdgcn_kernarg_segment_ptr(); asm volatile("" : "+s"(p)); return (KArgs*)p; }
#define KA KArgs* const ka = ka_fresh()
#define KIN(i) ((const float*)ka->in[i])
#define KWS ((unsigned char*)ka->ws)
#define KOUT ((float*)ka->out)
enum { I_X = 0, I_NMIX, I_WIN, I_PE, I_W1, I_W2, I_QN, I_KN, I_LB, I_HGN, I_WA2, I_BA, I_GLAN, I_WBR, I_WOUT, I_NFFN, I_WGRP, I_BGRP, I_WEXP, I_BEXP, I_WGU, I_WDN };

__device__ __forceinline__ void tr_item(const float* W, size_t ldw, int c0, int nv, bf16* WT, size_t ldt, int r0, int k0, LAS float* scr, int lane) {
    const int nn = lane & 31;
    float tv[32];
#pragma unroll
    for (int i = 0; i < 32; ++i) { const int kk = 2 * i + (lane >> 5); tv[i] = nn < nv ? __builtin_nontemporal_load(W + (size_t)(k0 + kk) * ldw + c0 + nn) : 0.f; }
#pragma unroll
    for (int i = 0; i < 32; ++i) { const int kk = 2 * i + (lane >> 5); scr[kk * 33 + nn] = tv[i]; }
    LDS_WAIT();
    const int c = lane & 7;
#pragma unroll
    for (int j = 0; j < 4; ++j) { const int n = (lane >> 3) + 8 * j; const LAS float* s = scr + (8 * c) * 33 + n;
        u32x4 o; o.x = pk2(s[0 * 33], s[1 * 33]); o.y = pk2(s[2 * 33], s[3 * 33]); o.z = pk2(s[4 * 33], s[5 * 33]); o.w = pk2(s[6 * 33], s[7 * 33]);
        if (n < nv) __builtin_nontemporal_store(o, (u32x4*)(WT + (size_t)(r0 + n) * ldt + k0 + 8 * c)); }
    LDS_WAIT();
}
__device__ __forceinline__ void phase_prologue(Frame& F) {
    KA;
    {
      bf16* W1T = (bf16*)(KWS + WS_CW); bf16* W2T = (bf16*)(KWS + WS_CW + 1048576); float* B1 = (float*)(KWS + WS_CW + 1572864);
      for (int i = F.bid * 512 + F.tid; i < NL * 2 * 64 * 2048; i += F.G * 512) { const int lk = i / (64 * 2048), j = (i / 2048) % 64, c = i % 2048; W1T[i] = (bf16)f2bf(KIN(I_W1)[((size_t)lk * 2048 + c) * 64 + j]); }
      for (int i = F.bid * 512 + F.tid; i < NL * 2 * 64 * 64; i += F.G * 512) { const int lk = i / 4096, j2 = (i / 64) % 64, j = i % 64; W2T[i] = (bf16)f2bf(KIN(I_W2)[((size_t)lk * 64 + j) * 64 + j2]); }
      if (F.bid < NL * 2) { const int lk = F.bid, j = F.tid & 63, part = F.tid >> 6; float a = 0.f;
#pragma unroll 8
          for (int c = part * 256; c < part * 256 + 256; ++c) a += KIN(I_PE)[(size_t)lk * 2048 + c] * KIN(I_W1)[((size_t)lk * 2048 + c) * 64 + j];
          LAS float* rd = (LAS float*)F.lds; rd[F.tid] = a; __syncthreads();
          if (F.tid < 64) { float t2 = 0.f;
#pragma unroll
              for (int p = 0; p < 8; ++p) t2 += rd[p * 64 + F.tid];
              B1[lk * 64 + F.tid] = t2; }
          __syncthreads(); } }
    { float* WRT = (float*)(KWS + WS_WRT);
      for (int i = F.bid * 512 + F.tid; i < NL * 48 * D; i += F.G * 512) { const int l = i / (48 * D), n = (i / D) % 48, k = i % D; const float g = KIN(I_NFFN)[l * D + k];
          WRT[i] = n < 32 ? g * KIN(I_WEXP)[((size_t)l * D + k) * 32 + n] : (n < 36 ? g * KIN(I_WGRP)[((size_t)l * D + k) * 4 + (n - 32)] : 0.f); } }
    LAS float* scr = (LAS float*)(F.lds + F.wave * 16384);
    constexpr int IT_WIN = 32 * 346, IT_WBR = 3 * 8 * 64, IT_WOUT = 32 * 64, IT_WGU = 32 * 32 * 32, IT_WDN = 32 * 8 * 64, IT_L = IT_WIN + IT_WBR + IT_WOUT + IT_WGU + IT_WDN;
    for (int it = F.gw; it < NL * IT_L; it += F.NGW) {
        const int l = it / IT_L; int r = it % IT_L;
        if (r < IT_WIN) { const int kb = r / 346, nb = r % 346; int src, dst, nv = 32;
            if (nb < 40) { src = nb * 32; dst = nb * 32; }
            else if (nb == 40) { src = 1280; dst = C_NG; nv = 24; }
            else if (nb < 153) { src = 1304 + 32 * (nb - 41); dst = 1280 + 32 * (nb - 41); }
            else if (nb == 153) { src = 4888; dst = C_GA; nv = 16; }
            else { src = 4904 + 32 * (nb - 154); dst = C_MG + 32 * (nb - 154); }
            tr_item(KIN(I_WIN) + (size_t)l * D * INC, INC, src, nv, (bf16*)(KWS + WS_WIN) + (size_t)l * NPAD * D, D, dst, kb * 64, scr, F.lane); continue; }
        r -= IT_WIN;
        if (r < IT_WBR) { const int n = r / 512, q = r % 512, kb = q / 64, nb = q % 64;
            tr_item(KIN(I_WBR) + ((size_t)l * 3 + n) * 512 * D, D, nb * 32, 32, (bf16*)(KWS + WS_WBR) + ((size_t)l * 3 + n) * D * 512, 512, nb * 32, kb * 64, scr, F.lane); continue; }
        r -= IT_WBR;
        if (r < IT_WOUT) { const int kb = r / 64, nb = r % 64;
            tr_item(KIN(I_WOUT) + (size_t)l * D * D, D, nb * 32, 32, (bf16*)(KWS + WS_WOUT) + (size_t)l * D * D, D, nb * 32, kb * 64, scr, F.lane); continue; }
        r -= IT_WOUT;
        if (r < IT_WGU) { const int e = r / 1024, q = r % 1024, kb = q / 32, nb = q % 32;
            tr_item(KIN(I_WGU) + ((size_t)l * NE + e) * D * 1024, 1024, nb * 32, 32, (bf16*)(KWS + WS_WGU) + ((size_t)l * NE + e) * 1024 * D, D, nb * 32, kb * 64, scr, F.lane); continue; }
        r -= IT_WGU;
        { const int e = r / 512, q = r % 512, kb = q / 64, nb = q % 64;
            tr_item(KIN(I_WDN) + ((size_t)l * NE + e) * FF * D, D, nb * 32, 32, (bf16*)(KWS + WS_WDN) + ((size_t)l * NE + e) * D * FF, FF, nb * 32, kb * 64, scr, F.lane); }
    }
}

template <int MODE> __device__ __forceinline__ void phase_norm1(Frame& F, const float* xin, const bf16* contrib, float* xout, const float* gain, bf16* H) {
    for (int t0 = F.gw; t0 < T; t0 += 2 * F.NGW) {
        f32x4 v[2][8]; float ss[2] = {0.f, 0.f};
#pragma unroll
        for (int rr = 0; rr < 2; ++rr) { const int t = t0 + rr * F.NGW; if (t < T) {
            const f32x4* xr = (const f32x4*)(xin + (size_t)t * D) + F.lane;
#pragma unroll
            for (int j = 0; j < 8; ++j) v[rr][j] = xr[64 * j]; } }
        u32x2 c0[2][8], c1[2][8];
        if (MODE != 0) {
#pragma unroll
            for (int rr = 0; rr < 2; ++rr) { const int t = t0 + rr * F.NGW; if (t < T) {
#pragma unroll
                for (int j = 0; j < 8; ++j) { c0[rr][j] = *((const u32x2*)(contrib + (size_t)(2 * t) * D) + F.lane + 64 * j); c1[rr][j] = *((const u32x2*)(contrib + (size_t)(2 * t + 1) * D) + F.lane + 64 * j); } } } }
#pragma unroll
        for (int rr = 0; rr < 2; ++rr) { const int t = t0 + rr * F.NGW; if (t < T) {
#pragma unroll
            for (int j = 0; j < 8; ++j) {
                if (MODE != 0) { v[rr][j].x += bflo(c0[rr][j].x) + bflo(c1[rr][j].x); v[rr][j].y += bfhi(c0[rr][j].x) + bfhi(c1[rr][j].x); v[rr][j].z += bflo(c0[rr][j].y) + bflo(c1[rr][j].y); v[rr][j].w += bfhi(c0[rr][j].y) + bfhi(c1[rr][j].y);
                    *((f32x4*)(xout + (size_t)t * D) + F.lane + 64 * j) = v[rr][j]; }
                ss[rr] += v[rr][j].x * v[rr][j].x + v[rr][j].y * v[rr][j].y + v[rr][j].z * v[rr][j].z + v[rr][j].w * v[rr][j].w; } } }
        if (MODE != 2) {
#pragma unroll
            for (int rr = 0; rr < 2; ++rr) { const int t = t0 + rr * F.NGW; if (t < T) {
                const float rstd = 1.0f / sqrtf(wave_sum(ss[rr]) * (1.0f / D) + EPS);
#pragma unroll
                for (int j = 0; j < 8; ++j) { const f32x4 g = *((const f32x4*)gain + F.lane + 64 * j);
                    u32x2 o; o.x = pkbf(v[rr][j].x * rstd * g.x, v[rr][j].y * rstd * g.y); o.y = pkbf(v[rr][j].z * rstd * g.z, v[rr][j].w * rstd * g.w);
                    *((u32x2*)(H + (size_t)t * D) + F.lane + 64 * j) = o; } } }
        }
    }
}

__device__ __forceinline__ void phase_prep(Frame& F, int l) {
    KA;
    const bf16* P = (const bf16*)(KWS + WS_P);
    float* QN = (float*)(KWS + WS_QN); float* KV = (float*)(KWS + WS_KV);
    const float* qg = KIN(I_QN) + l * 64; const float* kg = KIN(I_KN) + l * 192;
    for (int it = F.gw; it < T * 20; it += F.NGW) {
        const int t = it / 20, v = it % 20;
        float x = bf2f(P[(size_t)t * NPAD + v * 64 + F.lane]);
        const bool isq = v < 8, nk1 = (v == 12 || v == 13), nk2 = (v == 16 || v == 17);
        if (isq || nk1 || nk2) { const float ss = wave_sum(x * x); const float g = isq ? qg[F.lane] : (nk1 ? kg[64 + F.lane] : kg[128 + F.lane]); x = x * (1.0f / sqrtf(ss * (1.0f / 64.0f) + EPS)) * g; }
        if (isq) QN[((size_t)v * T + t) * 64 + F.lane] = x;
        else { const int w = v - 8, tens = w >> 1, g = w & 1; KV[(size_t)tens * KV_STRIDE + ((size_t)g * T + t) * 64 + F.lane] = x; }
    }
}
__device__ __forceinline__ float gelu_tanh(float x) { const float u = 0.7978845608028654f * (x + 0.044715f * x * x * x); return 0.5f * x * (1.0f + tanhf(u)); }
__device__ __forceinline__ void phase_compress(Frame& F, int l) {
    KA;
    LAS float* av = (LAS float*)(F.lds + F.wave * 16384);
    const float* KV = (const float*)(KWS + WS_KV); float* KC = (float*)(KWS + WS_KC);
    for (int it = F.gw; it < 2 * 2 * 511; it += F.NGW) {
        const int kind = it / 1022, q = it % 1022, g = q / 511, n = q % 511;
        const float* src = KV + (size_t)kind * KV_STRIDE + ((size_t)g * T + 16 * n) * 64;
        const float* pe = KIN(I_PE) + ((size_t)l * 2 + kind) * 2048;
        const float* w1 = KIN(I_W1) + ((size_t)l * 2 + kind) * 2048 * 64;
        const float* w2 = KIN(I_W2) + ((size_t)l * 2 + kind) * 64 * 64;
#pragma unroll 4
        for (int c = 0; c < 32; ++c) av[c * 64 + F.lane] = src[c * 64 + F.lane] + pe[c * 64 + F.lane];
        WSYNC();
        float acc = 0.f;
#pragma unroll 8
        for (int i = 0; i < 2048; ++i) acc += av[i] * w1[i * 64 + F.lane];
        const float hid = gelu_tanh(acc);
        WSYNC();
        av[F.lane] = hid;
        WSYNC();
        float o = 0.f;
#pragma unroll 8
        for (int i = 0; i < 64; ++i) o += av[i] * w2[i * 64 + F.lane];
        WSYNC();
        if (kind == 0) { const float ss = wave_sum(o * o); o = o * (1.0f / sqrtf(ss * (1.0f / 64.0f) + EPS)) * KIN(I_KN)[l * 192 + F.lane]; }
        KC[(size_t)kind * (2 * 512 * 64) + ((size_t)g * 512 + n) * 64 + F.lane] = o;
    }
}
__device__ __forceinline__ void phase_recur(Frame& F, int l) {
    KA;
    const bf16* P = (const bf16*)(KWS + WS_P); float* ORAW = (float*)(KWS + WS_ORAW);
    for (int it = F.gw; it < 1024; it += F.NGW) {
        const int kind = it >> 9, head = (it >> 7) & 3, j = it & 127;
        if (kind == 0) {
            const int d0 = F.lane, d1 = F.lane + 64;
            const float* lbl = KIN(I_LB);
            float lb0, lb1;
            { const float a0 = lbl[head * 128 + d0], b0 = lbl[512 + head * 128 + d0], a1 = lbl[head * 128 + d1], b1 = lbl[512 + head * 128 + d1];
              lb0 = l == 0 ? 0.f : 1.0f / (1.0f + expf(a0 - b0)); lb1 = l == 0 ? 0.f : 1.0f / (1.0f + expf(a1 - b1)); }
            const bf16* Pq = P + C_HQ + head * 128; const bf16* Pf = P + C_HF + head * 128; const bf16* Pi = P + C_HI + head * 128 + j;
            float S0 = 0.f, S1 = 0.f;
            for (int t0 = 0; t0 < T; t0 += 8) {
                bf16 zq0[8], zq1[8], zf0[8], zf1[8], vi[8];
#pragma unroll
                for (int u = 0; u < 8; ++u) { const size_t row = (size_t)(t0 + u) * NPAD; zq0[u] = Pq[row + d0]; zq1[u] = Pq[row + d1]; zf0[u] = Pf[row + d0]; zf1[u] = Pf[row + d1]; vi[u] = Pi[row]; }
                float part[8];
#pragma unroll
                for (int u = 0; u < 8; ++u) { const float v = bf2f(vi[u]);
                    const float s0 = sigmoidf_(bf2f(zf0[u])), s1 = sigmoidf_(bf2f(zf1[u]));
                    const float f0 = lb0 + (1.0f - lb0) * s0, f1 = lb1 + (1.0f - lb1) * s1;
                    const float k0 = (1.0f - lb0) * (1.0f - s0), k1 = (1.0f - lb1) * (1.0f - s1);
                    S0 = f0 * S0 + k0 * v; S1 = f1 * S1 + k1 * v;
                    part[u] = bf2f(zq0[u]) * S0 + bf2f(zq1[u]) * S1; }
                float mine = 0.f;
#pragma unroll
                for (int u = 0; u < 8; ++u) { const float s = wave_sum(part[u]); mine = (F.lane == u) ? s : mine; }
                if (F.lane < 8) ORAW[(size_t)(t0 + F.lane) * 1024 + head * 128 + j] = mine;
            }
        } else {
            const int d = F.lane, c = head * 64 + d;
            float wa[16];
#pragma unroll
            for (int r = 0; r < 16; ++r) wa[r] = KIN(I_WA2)[((size_t)l * 16 + r) * 256 + c];
            const float ba = KIN(I_BA)[l * 256 + c];
            const bf16* Pq = P + C_GQ + c; const bf16* Pk = P + C_GK + c; const bf16* Pv = P + C_GV + head * 128 + j; const bf16* Pa = P + C_GA;
            float S = 0.f;
            for (int t0 = 0; t0 < T; t0 += 8) {
                bf16 zq[8], zk[8], zv[8]; u32x4 ga0[8], ga1[8];
#pragma unroll
                for (int u = 0; u < 8; ++u) { const size_t row = (size_t)(t0 + u) * NPAD; zq[u] = Pq[row]; zk[u] = Pk[row]; zv[u] = Pv[row]; ga0[u] = *(const u32x4*)(Pa + row); ga1[u] = *(const u32x4*)(Pa + row + 8); }
                float part[8];
#pragma unroll
                for (int u = 0; u < 8; ++u) {
                    float a = ba;
                    a += bflo(ga0[u].x) * wa[0] + bfhi(ga0[u].x) * wa[1] + bflo(ga0[u].y) * wa[2] + bfhi(ga0[u].y) * wa[3] + bflo(ga0[u].z) * wa[4] + bfhi(ga0[u].z) * wa[5] + bflo(ga0[u].w) * wa[6] + bfhi(ga0[u].w) * wa[7];
                    a += bflo(ga1[u].x) * wa[8] + bfhi(ga1[u].x) * wa[9] + bflo(ga1[u].y) * wa[10] + bfhi(ga1[u].y) * wa[11] + bflo(ga1[u].z) * wa[12] + bfhi(ga1[u].z) * wa[13] + bflo(ga1[u].w) * wa[14] + bfhi(ga1[u].w) * wa[15];
                    const float ls = fminf(a, 0.f) - log1pf(expf(-fabsf(a)));
                    const float f = expf(ls * (1.0f / 16.0f));
                    S = f * S + bf2f(zk[u]) * bf2f(zv[u]);
                    part[u] = bf2f(zq[u]) * 0.125f * S; }
                float mine = 0.f;
#pragma unroll
                for (int u = 0; u < 8; ++u) { const float s = wave_sum(part[u]); mine = (F.lane == u) ? s : mine; }
                if (F.lane < 8) ORAW[(size_t)(t0 + F.lane) * 1024 + 512 + head * 128 + j] = mine;
            }
        }
    }
}
__device__ __forceinline__ void phase_recur_out(Frame& F, int l) {
    KA;
    const bf16* P = (const bf16*)(KWS + WS_P); const float* ORAW = (const float*)(KWS + WS_ORAW); bf16* OCAT = (bf16*)(KWS + WS_OCAT);
    for (int it = F.gw; it < T * 8; it += F.NGW) {
        const int t = it >> 3, kind = (it >> 2) & 1, head = it & 3;
        const float* gn = (kind == 0 ? KIN(I_HGN) : KIN(I_GLAN)) + l * 128;
        const int cg = (kind == 0 ? C_HG : C_GR) + head * 128;
        const float r0 = ORAW[(size_t)t * 1024 + kind * 512 + head * 128 + F.lane], r1 = ORAW[(size_t)t * 1024 + kind * 512 + head * 128 + 64 + F.lane];
        const float rstd = 1.0f / sqrtf(wave_sum(r0 * r0 + r1 * r1) * (1.0f / 128.0f) + EPS);
        const float g0 = bf2f(P[(size_t)t * NPAD + cg + F.lane]), g1 = bf2f(P[(size_t)t * NPAD + cg + 64 + F.lane]);
        const float a0 = kind == 0 ? sigmoidf_(g0) : g0 * sigmoidf_(g0), a1 = kind == 0 ? sigmoidf_(g1) : g1 * sigmoidf_(g1);
        OCAT[(size_t)t * 1536 + 512 + kind * 512 + head * 128 + F.lane] = (bf16)f2bf(r0 * rstd * gn[F.lane] * a0);
        OCAT[(size_t)t * 1536 + 512 + kind * 512 + head * 128 + 64 + F.lane] = (bf16)f2bf(r1 * rstd * gn[64 + F.lane] * a1);
    }
}


template <int KIND> struct RecCfg { static constexpr int DK = KIND == 0 ? 128 : 64, NSEG = 512 / DK, TPS = 64 / NSEG, QROW = (DK + 8) * 2; };
constexpr int REC_VT_OFF = 0;
constexpr int REC_KD_OFF = 18432;
constexpr int REC_QS_OFF = 36864;
constexpr int REC_KS_OFF = 54272;
constexpr int REC_QD_OFF = 71680;
constexpr int REC_RED_OFF = 89088;
constexpr int REC_TOT_OFF = 91136;
__device__ __forceinline__ float expc(float x2) { return __builtin_amdgcn_exp2f(fminf(x2, 110.0f)); }
template <int KIND> __device__ __forceinline__ void rec_elem(KArgs* ka, int l, int head, int chunk, int tid, LAS float* tot,
        float (&qv)[RecCfg<KIND>::TPS], float (&kv)[RecCfg<KIND>::TPS], float (&bv)[RecCfg<KIND>::TPS], float& bend, float& bref) {
    constexpr int DK = RecCfg<KIND>::DK, NSEG = RecCfg<KIND>::NSEG, TPS = RecCfg<KIND>::TPS;
    const int d = tid % DK, seg = tid / DK, t0 = chunk * 64 + seg * TPS;
    const bf16* P = (const bf16*)(KWS + WS_P);
    float run = 0.f;
    if (KIND == 0) {
        const int c = head * 128 + d;
        float lb = 0.f;
        if (l > 0) { const float a0 = KIN(I_LB)[c], b0 = KIN(I_LB)[512 + c]; lb = 1.0f / (1.0f + expf(a0 - b0)); }
        const float omlb = 1.0f - lb;
        unsigned zr[TPS], qr[TPS];
#pragma unroll
        for (int u = 0; u < TPS; ++u) { const size_t row = (size_t)(t0 + u) * NPAD; zr[u] = P[row + C_HF + c]; qr[u] = P[row + C_HQ + c]; }
#pragma unroll
        for (int u = 0; u < TPS; ++u) {
            const float z = bf2f(zr[u]); qv[u] = bf2f(qr[u]);
            const float e = __builtin_amdgcn_exp2f(-LOG2E * z), sg = __builtin_amdgcn_rcpf(1.0f + e), f = fmaf(omlb, sg, lb);
            kv[u] = omlb * (e * sg);
            run += __builtin_amdgcn_logf(fmaxf(f, 1e-30f)); bv[u] = run; }
    } else {
        const int c = head * 64 + d;
        float wa[16];
#pragma unroll
        for (int r = 0; r < 16; ++r) wa[r] = KIN(I_WA2)[((size_t)l * 16 + r) * 256 + c];
        const float ba = KIN(I_BA)[l * 256 + c];
        u32x4 g0r[TPS], g1r[TPS]; unsigned qr[TPS], kr[TPS];
#pragma unroll
        for (int u = 0; u < TPS; ++u) { const size_t row = (size_t)(t0 + u) * NPAD; g0r[u] = *(const u32x4*)(P + row + C_GA); g1r[u] = *(const u32x4*)(P + row + C_GA + 8); qr[u] = P[row + C_GQ + c]; kr[u] = P[row + C_GK + c]; }
#pragma unroll
        for (int u = 0; u < TPS; ++u) { const u32x4 g0 = g0r[u], g1 = g1r[u];
            float a = ba;
            a += bflo(g0.x) * wa[0] + bfhi(g0.x) * wa[1] + bflo(g0.y) * wa[2] + bfhi(g0.y) * wa[3] + bflo(g0.z) * wa[4] + bfhi(g0.z) * wa[5] + bflo(g0.w) * wa[6] + bfhi(g0.w) * wa[7];
            a += bflo(g1.x) * wa[8] + bfhi(g1.x) * wa[9] + bflo(g1.y) * wa[10] + bfhi(g1.y) * wa[11] + bflo(g1.z) * wa[12] + bfhi(g1.z) * wa[13] + bflo(g1.w) * wa[14] + bfhi(g1.w) * wa[15];
            const float ls2 = fminf(a, 0.f) * LOG2E - __builtin_amdgcn_logf(1.0f + __builtin_amdgcn_exp2f(-LOG2E * fabsf(a)));
            qv[u] = bf2f(qr[u]) * 0.125f; kv[u] = bf2f(kr[u]);
            run += ls2 * (1.0f / 16.0f); bv[u] = run; }
    }
    tot[seg * DK + d] = run;
    __syncthreads();
    float off = 0.f; bend = 0.f; bref = 0.f;
#pragma unroll
    for (int sgi = 0; sgi < NSEG; ++sgi) { const float v = tot[sgi * DK + d]; off += sgi < seg ? v : 0.f; bref += sgi < NSEG / 2 ? v : 0.f; bend += v; }
#pragma unroll
    for (int u = 0; u < TPS; ++u) bv[u] += off;
}
template <int KIND> __device__ __forceinline__ void rec_vt_load(KArgs* ka, int head, int chunk, int tid, unsigned (&w)[8]) {
    const bf16* P = (const bf16*)(KWS + WS_P) + (KIND == 0 ? C_HI : C_GV) + head * 128;
    const int v = tid & 127, sv = tid >> 7;
#pragma unroll
    for (int u = 0; u < 8; ++u) { const unsigned a = P[(size_t)(chunk * 64 + sv * 16 + 2 * u) * NPAD + v], b = P[(size_t)(chunk * 64 + sv * 16 + 2 * u + 1) * NPAD + v]; w[u] = a | (b << 16); }
}
__device__ __forceinline__ void rec_vt_store(int tid, LAS unsigned char* lds, const unsigned (&w)[8]) {
    const int v = tid & 127, sv = tid >> 7;
    LAS u32x4* dst = (LAS u32x4*)(lds + REC_VT_OFF + v * 144 + sv * 32);
    dst[0] = (u32x4){w[0], w[1], w[2], w[3]}; dst[1] = (u32x4){w[4], w[5], w[6], w[7]};
}
template <int KIND> __device__ __forceinline__ void rec_local_unit(KArgs* ka, Frame& F, int l, int head, int chunk) {
    constexpr int DK = RecCfg<KIND>::DK, TPS = RecCfg<KIND>::TPS;
    LAS unsigned char* lds = F.lds; LAS float* tot = (LAS float*)(lds + REC_TOT_OFF);
    float qv[TPS], kv[TPS], bv[TPS], bend, bref;
    unsigned vraw[8];
    rec_vt_load<KIND>(ka, head, chunk, F.tid, vraw);
    rec_elem<KIND>(ka, l, head, chunk, F.tid, tot, qv, kv, bv, bend, bref);
    const int d = F.tid % DK, seg = F.tid / DK, unit = chunk * 4 + head;
    { unsigned w[TPS / 2];
#pragma unroll
      for (int u = 0; u < TPS / 2; ++u) w[u] = pkbf(kv[2 * u] * expc(bend - bv[2 * u]), kv[2 * u + 1] * expc(bend - bv[2 * u + 1]));
      LAS u32x4* dst = (LAS u32x4*)(lds + REC_KD_OFF + d * 144 + seg * TPS * 2);
      dst[0] = (u32x4){w[0], w[1], w[2], w[3]};
      if constexpr (TPS == 16) dst[1] = (u32x4){w[4], w[5], w[6], w[7]}; }
    if (seg == 0) ((float*)(KWS + WS_DEC + (KIND == 0 ? 0 : 262144)))[(size_t)unit * DK + d] = __builtin_amdgcn_exp2f(bend);
    rec_vt_store(F.tid, lds, vraw);
    __syncthreads();
    const int r = F.lane & 15, kq = F.lane >> 4;
    const int dt = KIND == 0 ? F.wave : (F.wave & 3), vt0 = KIND == 0 ? 0 : (F.wave >> 2) * 4, nvt = KIND == 0 ? 8 : 4;
    bf16x8 a[2];
#pragma unroll
    for (int ks = 0; ks < 2; ++ks) a[ks] = *(const LAS bf16x8*)(lds + REC_KD_OFF + (16 * dt + r) * 144 + (32 * ks + 8 * kq) * 2);
    bf16* Sl = (bf16*)(KWS + (KIND == 0 ? WS_SLOC_HG : WS_SLOC_GL)) + (size_t)unit * 128 * DK;
#pragma unroll
    for (int vi = 0; vi < nvt; ++vi) { const int vt = vt0 + vi; f32x4 acc = {0.f, 0.f, 0.f, 0.f};
#pragma unroll
        for (int ks = 0; ks < 2; ++ks) { const bf16x8 b = *(const LAS bf16x8*)(lds + REC_VT_OFF + (16 * vt + r) * 144 + (32 * ks + 8 * kq) * 2); acc = __builtin_amdgcn_mfma_f32_16x16x32_bf16(a[ks], b, acc, 0, 0, 0); }
        u32x2 w2; w2.x = pkbf(acc[0], acc[1]); w2.y = pkbf(acc[2], acc[3]);
        *(u32x2*)(Sl + (size_t)(16 * vt + r) * DK + 16 * dt + 4 * kq) = w2; }
    __syncthreads();
}
__device__ __forceinline__ void phase_rec_local(Frame& F, int l) {
    KA;
    for (int it = F.bid; it < 1024; it += F.G) { const int kind = it >> 9, chunk = (it >> 2) & 127, head = it & 3;
        if (kind == 0) rec_local_unit<0>(ka, F, l, head, chunk); else rec_local_unit<1>(ka, F, l, head, chunk); }
}
__device__ __forceinline__ void phase_rec_scan(Frame& F) {
    KA;
    const int gt = F.bid * 512 + F.tid;
    if (gt >= 49152) return;
    const bool hg = gt < 32768; const int q = hg ? gt : gt - 32768;
    const int DK = hg ? 128 : 64, dp = q % (DK / 2), v = (q / (DK / 2)) & 127, head = q / (DK / 2 * 128);
    const bf16* Sl = (const bf16*)(KWS + (hg ? WS_SLOC_HG : WS_SLOC_GL)) + ((size_t)head * 128 + v) * DK + 2 * dp;
    bf16* Sp = (bf16*)(KWS + (hg ? WS_SPREV_HG : WS_SPREV_GL)) + ((size_t)head * 128 + v) * DK + 2 * dp;
    const float* De = (const float*)(KWS + WS_DEC + (hg ? 0 : 262144)) + (size_t)head * DK + 2 * dp;
    const size_t ustr = (size_t)4 * 128 * DK, dstr = (size_t)4 * DK;
    float s0 = 0.f, s1 = 0.f;
    for (int c0 = 0; c0 < NCH; c0 += 16) { unsigned x[16]; f32x2 dc[16];
#pragma unroll
        for (int u = 0; u < 16; ++u) { x[u] = *(const unsigned*)(Sl + (size_t)(c0 + u) * ustr); dc[u] = *(const f32x2*)(De + (size_t)(c0 + u) * dstr); }
#pragma unroll
        for (int u = 0; u < 16; ++u) { *(unsigned*)(Sp + (size_t)(c0 + u) * ustr) = pkbf(s0, s1); s0 = dc[u].x * s0 + bflo(x[u]); s1 = dc[u].y * s1 + bfhi(x[u]); } }
}
template <int KIND> __device__ __forceinline__ void rec_out_unit(KArgs* ka, Frame& F, int l, int head, int chunk) {
    constexpr int DK = RecCfg<KIND>::DK, TPS = RecCfg<KIND>::TPS, QROW = RecCfg<KIND>::QROW, NKS = DK / 32;
    LAS unsigned char* lds = F.lds; LAS float* tot = (LAS float*)(lds + REC_TOT_OFF); LAS float* red = (LAS float*)(lds + REC_RED_OFF);
    const int r = F.lane & 15, kq = F.lane >> 4, unit = chunk * 4 + head, vt = F.wave;
    bf16x8 sa[NKS];
    { const bf16* Sp = (const bf16*)(KWS + (KIND == 0 ? WS_SPREV_HG : WS_SPREV_GL)) + (size_t)unit * 128 * DK + (size_t)(16 * vt + r) * DK + 8 * kq;
#pragma unroll
      for (int ks = 0; ks < NKS; ++ks) sa[ks] = *(const bf16x8*)(Sp + 32 * ks); }
    float qv[TPS], kv[TPS], bv[TPS], bend, bref;
    unsigned vraw[8];
    rec_vt_load<KIND>(ka, head, chunk, F.tid, vraw);
    const bf16* P = (const bf16*)(KWS + WS_P); bf16* OCAT = (bf16*)(KWS + WS_OCAT);
    const int v0 = 16 * vt + 4 * kq;
    const f32x4 gn = *(const f32x4*)((KIND == 0 ? KIN(I_HGN) : KIN(I_GLAN)) + l * 128 + v0);
    u32x2 gq4[4];
#pragma unroll
    for (int it = 0; it < 4; ++it) gq4[it] = *(const u32x2*)(P + (size_t)(chunk * 64 + 16 * it + r) * NPAD + (KIND == 0 ? C_HG : C_GR) + head * 128 + v0);
    rec_elem<KIND>(ka, l, head, chunk, F.tid, tot, qv, kv, bv, bend, bref);
    { const int d = F.tid % DK, seg = F.tid / DK; const float eref = __builtin_amdgcn_exp2f(fmaxf(bref, -120.f));
#pragma unroll
      for (int u = 0; u < TPS; u += 2) { const int o = (seg * TPS + u) * QROW + d * 2;
          const float x0 = __builtin_amdgcn_exp2f(fminf(fmaxf(bv[u] - bref, -110.f), 110.f)), x1 = __builtin_amdgcn_exp2f(fminf(fmaxf(bv[u + 1] - bref, -110.f), 110.f));
          const float qs0 = qv[u] * x0, qs1 = qv[u + 1] * x1;
          const unsigned w0 = pkbf(qs0, qs1), w1 = pkbf(kv[u] * __builtin_amdgcn_rcpf(x0), kv[u + 1] * __builtin_amdgcn_rcpf(x1)), w2 = pkbf(qs0 * eref, qs1 * eref);
          *(LAS bf16*)(lds + REC_QS_OFF + o) = (bf16)w0; *(LAS bf16*)(lds + REC_QS_OFF + o + QROW) = (bf16)(w0 >> 16);
          *(LAS bf16*)(lds + REC_KS_OFF + o) = (bf16)w1; *(LAS bf16*)(lds + REC_KS_OFF + o + QROW) = (bf16)(w1 >> 16);
          *(LAS bf16*)(lds + REC_QD_OFF + o) = (bf16)w2; *(LAS bf16*)(lds + REC_QD_OFF + o + QROW) = (bf16)(w2 >> 16); } }
    rec_vt_store(F.tid, lds, vraw);
    __syncthreads();
#pragma unroll
    for (int tt = 0; tt < 2; ++tt) { const int tile = F.wave * 2 + tt, jt = tile >> 2, it = tile & 3; f32x4 acc = {0.f, 0.f, 0.f, 0.f};
        if (jt <= it) {
#pragma unroll
            for (int ks = 0; ks < NKS; ++ks) { const bf16x8 a = *(const LAS bf16x8*)(lds + REC_KS_OFF + (16 * jt + r) * QROW + (32 * ks + 8 * kq) * 2), b = *(const LAS bf16x8*)(lds + REC_QS_OFF + (16 * it + r) * QROW + (32 * ks + 8 * kq) * 2);
                acc = __builtin_amdgcn_mfma_f32_16x16x32_bf16(a, b, acc, 0, 0, 0); } }
        const int i = 16 * it + r, j0 = 16 * jt + 4 * kq;
        u32x2 w; w.x = pk2(j0 <= i ? acc[0] : 0.f, j0 + 1 <= i ? acc[1] : 0.f); w.y = pk2(j0 + 2 <= i ? acc[2] : 0.f, j0 + 3 <= i ? acc[3] : 0.f);
        *(LAS u32x2*)(lds + REC_KD_OFF + i * 144 + j0 * 2) = w; }
    __syncthreads();
    f32x4 acc[4];
#pragma unroll
    for (int it = 0; it < 4; ++it) acc[it] = (f32x4){0.f, 0.f, 0.f, 0.f};
#pragma unroll
    for (int ks = 0; ks < 2; ++ks) { const bf16x8 a = *(const LAS bf16x8*)(lds + REC_VT_OFF + (16 * vt + r) * 144 + (32 * ks + 8 * kq) * 2);
#pragma unroll
        for (int it = 0; it < 4; ++it) { const bf16x8 b = *(const LAS bf16x8*)(lds + REC_KD_OFF + (16 * it + r) * 144 + (32 * ks + 8 * kq) * 2); acc[it] = __builtin_amdgcn_mfma_f32_16x16x32_bf16(a, b, acc[it], 0, 0, 0); } }
#pragma unroll
    for (int ks = 0; ks < NKS; ++ks) {
#pragma unroll
        for (int it = 0; it < 4; ++it) { const bf16x8 b = *(const LAS bf16x8*)(lds + REC_QD_OFF + (16 * it + r) * QROW + (32 * ks + 8 * kq) * 2); acc[it] = __builtin_amdgcn_mfma_f32_16x16x32_bf16(sa[ks], b, acc[it], 0, 0, 0); } }
#pragma unroll
    for (int it = 0; it < 4; ++it) { float ss = acc[it][0] * acc[it][0] + acc[it][1] * acc[it][1] + acc[it][2] * acc[it][2] + acc[it][3] * acc[it][3];
        ss += __shfl_xor(ss, 16); ss += __shfl_xor(ss, 32);
        if (kq == 0) red[F.wave * 64 + 16 * it + r] = ss; }
    __syncthreads();
#pragma unroll
    for (int it = 0; it < 4; ++it) { const int i = 16 * it + r, t = chunk * 64 + i; float tot_ = 0.f;
#pragma unroll
        for (int w = 0; w < 8; ++w) tot_ += red[w * 64 + i];
        const float rstd = 1.0f / sqrtf(tot_ * (1.0f / 128.0f) + EPS);
        const u32x2 gq = gq4[it];
        float gt[4] = {bflo(gq.x), bfhi(gq.x), bflo(gq.y), bfhi(gq.y)}, o[4];
#pragma unroll
        for (int e = 0; e < 4; ++e) { const float sg = fsig(gt[e]); o[e] = acc[it][e] * rstd * gn[e] * (KIND == 0 ? sg : gt[e] * sg); }
        u32x2 w; w.x = pkbf(o[0], o[1]); w.y = pkbf(o[2], o[3]);
        *(u32x2*)(OCAT + (size_t)t * 1536 + 512 + KIND * 512 + head * 128 + v0) = w; }
    __syncthreads();
}
__device__ __forceinline__ void phase_rec_out(Frame& F, int l) {
    KA;
    for (int it = F.bid; it < 1024; it += F.G) { const int kind = it >> 9, chunk = (it >> 2) & 127, head = it & 3;
        if (kind == 0) rec_out_unit<0>(ka, F, l, head, chunk); else rec_out_unit<1>(ka, F, l, head, chunk); }
}

template <bool WIN> __device__ __forceinline__ void nsa_block(const float* Kg, const float* Vg, int j, int t, int lane, const LAS float* qs, LAS float* pb, const float (&slope)[4], float (&M)[4], float (&L)[4], float (&o)[4]) {
    const int pos = 64 * j + lane, dist = t - pos;
    const bool valid = WIN ? (dist >= 0 && dist < 512) : (dist >= 0);
    float dot[4] = {0.f, 0.f, 0.f, 0.f};
    const f32x4* kr = (const f32x4*)(Kg + (size_t)pos * 64);
#pragma unroll 2
    for (int c = 0; c < 16; ++c) { const f32x4 kv = kr[c];
#pragma unroll
        for (int r = 0; r < 4; ++r) { const f32x4 qv = *(const LAS f32x4*)(qs + r * 64 + c * 4); dot[r] += kv.x * qv.x + kv.y * qv.y + kv.z * qv.z + kv.w * qv.w; } }
#pragma unroll
    for (int r = 0; r < 4; ++r) {
        const float s = valid ? dot[r] * 0.125f - slope[r] * (float)dist : NEGB;
        const float nm = fmaxf(M[r], wave_max(s)), sc = expf(M[r] - nm), p = valid ? expf(s - nm) : 0.f;
        L[r] = L[r] * sc + wave_sum(p); o[r] *= sc; M[r] = nm; pb[r * 64 + lane] = p;
    }
    WSYNC();
#pragma unroll 4
    for (int k = 0; k < 64; ++k) { const float v = Vg[(size_t)(64 * j + k) * 64 + lane];
#pragma unroll
        for (int r = 0; r < 4; ++r) o[r] += pb[r * 64 + k] * v; }
    WSYNC();
}
__device__ __forceinline__ void phase_nsa(Frame& F, int l) {
    KA;
    LAS float* qs = (LAS float*)(F.lds + F.wave * 8192);
    LAS float* pbuf = qs + 256;
    LAS float* scb = pbuf + 512;
    LAS float* pb = scb + 128;
    LAS float* impb = pb + 256;
    LAS float* ocb = impb + 512;
    const bf16* P = (const bf16*)(KWS + WS_P); bf16* OCAT = (bf16*)(KWS + WS_OCAT);
    const float* QN = (const float*)(KWS + WS_QN); const float* KV = (const float*)(KWS + WS_KV); const float* KC = (const float*)(KWS + WS_KC);
    const int lane = F.lane;
    for (int it = F.gw; it < T * 2; it += F.NGW) {
        const int t = it >> 1, g = it & 1;
        float slope[4];
#pragma unroll
        for (int r = 0; r < 4; ++r) { slope[r] = exp2f(-(float)(g * 4 + r + 1)); qs[r * 64 + lane] = QN[((size_t)(g * 4 + r) * T + t) * 64 + lane]; }
        WSYNC();
        int nvis = t >= 31 ? (t - 31) / 16 + 1 : 0; nvis = nvis > 511 ? 511 : nvis;
        const float* KCg = KC + (size_t)g * 512 * 64; const float* VCg = KC + (size_t)(2 * 512 * 64) + (size_t)g * 512 * 64;
#pragma unroll 1
        for (int i = 0; i < 8; ++i) impb[lane + 64 * i] = 0.f;
#pragma unroll 1
        for (int r = 0; r < 4; ++r) {
            const float sl = exp2f(-(float)(g * 4 + r + 1));
            float mx = NEGB;
#pragma unroll 1
            for (int i = 0; i < 8; ++i) { const int n = lane + 64 * i; float sv = NEGB;
                if (n < nvis) { const f32x4* kr = (const f32x4*)(KCg + (size_t)n * 64); float dot = 0.f;
#pragma unroll 4
                    for (int c = 0; c < 16; ++c) { const f32x4 kv = kr[c]; const f32x4 qv = *(const LAS f32x4*)(qs + r * 64 + c * 4); dot += kv.x * qv.x + kv.y * qv.y + kv.z * qv.z + kv.w * qv.w; }
                    sv = dot * 0.125f - sl * (float)(t - 16 * n - 31); }
                pbuf[n] = sv; mx = fmaxf(mx, sv); }
            mx = wave_max(mx);
            float sum = 0.f;
#pragma unroll 1
            for (int i = 0; i < 8; ++i) { const int n = lane + 64 * i; const float e = n < nvis ? expf(pbuf[n] - mx) : 0.f; pbuf[n] = e; sum += e; }
            sum = wave_sum(sum);
            const float inv = nvis > 0 ? 1.0f / sum : 0.f;
#pragma unroll 1
            for (int i = 0; i < 8; ++i) { const int n = lane + 64 * i; const float p = pbuf[n] * inv; pbuf[n] = p; impb[n] += p; }
            WSYNC();
            float oc = 0.f;
#pragma unroll 4
            for (int n = 0; n < nvis; ++n) oc += pbuf[n] * VCg[(size_t)n * 64 + lane];
            ocb[r * 64 + lane] = oc;
            WSYNC();
        }
        const int cur = t >> 6;
        float sc2[2];
#pragma unroll
        for (int jj = 0; jj < 2; ++jj) { const int j = lane + 64 * jj;
            float v = (j > 0 ? impb[4 * j - 1] : 0.f) + 2.0f * (impb[4 * j] + impb[4 * j + 1] + impb[4 * j + 2]) + impb[4 * j + 3];
            if (j == 0 || j == cur || j == cur - 1) v = 1e4f;
            if (j > cur) v = -1.0f;
            sc2[jj] = v; scb[j] = v; }
        WSYNC();
        unsigned long long msk[2];
#pragma unroll
        for (int jj = 0; jj < 2; ++jj) { const int j = lane + 64 * jj; int rank = 0;
#pragma unroll 4
            for (int i = 0; i < 128; ++i) { const float si = scb[i]; rank += (si > sc2[jj] || (si == sc2[jj] && i < j)) ? 1 : 0; }
            msk[jj] = __ballot(rank < 16); }
        WSYNC();
        float M[4], L[4], os[4], ow[4];
#pragma unroll
        for (int r = 0; r < 4; ++r) { M[r] = NEGB; L[r] = 0.f; os[r] = 0.f; }
        { const float* Kg = KV + 2 * KV_STRIDE + (size_t)g * T * 64; const float* Vg = KV + 3 * KV_STRIDE + (size_t)g * T * 64;
#pragma unroll 1
          for (int j = 0; j <= cur; ++j) { const bool sel = ((j < 64 ? msk[0] >> j : msk[1] >> (j - 64)) & 1ull) != 0ull; if (sel) nsa_block<false>(Kg, Vg, j, t, lane, qs, pb, slope, M, L, os); } }
#pragma unroll
        for (int r = 0; r < 4; ++r) { os[r] = os[r] / L[r]; M[r] = NEGB; L[r] = 0.f; ow[r] = 0.f; }
        { const float* Kg = KV + 4 * KV_STRIDE + (size_t)g * T * 64; const float* Vg = KV + 5 * KV_STRIDE + (size_t)g * T * 64;
          const int j0 = t >= 511 ? (t - 511) >> 6 : 0;
#pragma unroll 1
          for (int j = j0; j <= cur; ++j) nsa_block<true>(Kg, Vg, j, t, lane, qs, pb, slope, M, L, ow); }
#pragma unroll
        for (int r = 0; r < 4; ++r) { const int h = g * 4 + r;
            const float g0 = sigmoidf_(bf2f(P[(size_t)t * NPAD + C_NG + h])), g1 = sigmoidf_(bf2f(P[(size_t)t * NPAD + C_NG + 8 + h])), g2 = sigmoidf_(bf2f(P[(size_t)t * NPAD + C_NG + 16 + h]));
            OCAT[(size_t)t * 1536 + h * 64 + lane] = (bf16)f2bf(g0 * ocb[r * 64 + lane] + g1 * os[r] + g2 * (ow[r] / L[r])); }
        WSYNC();
    }
}

typedef float f32x16 __attribute__((ext_vector_type(16)));
constexpr float NSA_SHIFT2 = 8.0f;
__device__ __forceinline__ int perm16(int b) { return (b & 3) | ((b & 4) << 1) | ((b & 8) >> 1); }
__device__ __forceinline__ void phase_prep2(Frame& F, int l) {
    KA;
    const bf16* P = (const bf16*)(KWS + WS_P);
    bf16* QS = (bf16*)(KWS + WS_QS); bf16* KS2 = (bf16*)(KWS + WS_KS2); bf16* KW2 = (bf16*)(KWS + WS_KW2);
    const float* qg = KIN(I_QN) + l * 64; const float* kg = KIN(I_KN) + l * 192;
    for (int it = F.gw; it < T * 12; it += F.NGW) {
        const int t = it / 12, v = it % 12;
        const int col = v < 8 ? v * 64 : (v < 10 ? C_KS + (v - 8) * 64 : C_KW + (v - 10) * 64);
        float x = bf2f(P[(size_t)t * NPAD + col + F.lane]);
        const float ss = wave_sum(x * x);
        const float g = v < 8 ? qg[F.lane] * (0.125f * LOG2E) : (v < 10 ? kg[64 + F.lane] : kg[128 + F.lane]);
        x = x * (1.0f / sqrtf(ss * (1.0f / 64.0f) + EPS)) * g;
        bf16* dst = v < 8 ? QS + ((size_t)v * T + t) * 64 : (v < 10 ? KS2 + ((size_t)(v - 8) * T + t) * 64 : KW2 + ((size_t)(v - 10) * T + t) * 64);
        dst[F.lane] = (bf16)f2bf(x);
    }
    LAS bf16* tile = (LAS bf16*)(F.lds + F.wave * 16384);
    for (int it = F.gw; it < 2 * 2 * (T / 64); it += F.NGW) {
        const int kind = it / (2 * (T / 64)), q = it % (2 * (T / 64)), g = q / (T / 64), tb = q % (T / 64);
        const bf16* src = P + (size_t)(tb * 64) * NPAD + (kind == 0 ? C_VS : C_VW) + g * 64;
        bf16* dst = (bf16*)(KWS + (kind == 0 ? WS_VST : WS_VWT)) + (size_t)g * 64 * T + tb * 64;
#pragma unroll 4
        for (int r = 0; r < 64; ++r) tile[r * 66 + F.lane] = src[(size_t)r * NPAD + F.lane];
        WSYNC();
        const int pl = (F.lane & ~15) | perm16(F.lane & 15);
#pragma unroll 4
        for (int d = 0; d < 64; ++d) dst[(size_t)d * T + pl] = tile[F.lane * 66 + d];
        WSYNC();
    }
}

__device__ __forceinline__ void phase_prep3(Frame& F, int l) {
    KA;
    const bf16* P = (const bf16*)(KWS + WS_P);
    bf16* QS = (bf16*)(KWS + WS_QS); bf16* KS2 = (bf16*)(KWS + WS_KS2); bf16* KW2 = (bf16*)(KWS + WS_KW2);
    const float* qg = KIN(I_QN) + l * 64; const float* kg = KIN(I_KN) + l * 192;
    const int vec = F.lane >> 3, part = F.lane & 7;
    for (int t = F.gw; t < T; t += F.NGW) {
#pragma unroll
        for (int pass = 0; pass < 2; ++pass) {
            if (pass == 1 && vec >= 4) continue;
            const int col = pass == 0 ? vec * 64 : (vec < 2 ? C_KS + vec * 64 : C_KW + (vec - 2) * 64);
            const float* gp = pass == 0 ? qg : (vec < 2 ? kg + 64 : kg + 128);
            const float gs = pass == 0 ? 0.125f * LOG2E : 1.0f;
            bf16* dst = pass == 0 ? QS + ((size_t)vec * T + t) * 64 : (vec < 2 ? KS2 + ((size_t)vec * T + t) * 64 : KW2 + ((size_t)(vec - 2) * T + t) * 64);
            const u32x4 raw = *(const u32x4*)(P + (size_t)t * NPAD + col + part * 8);
            float x[8] = {bflo(raw.x), bfhi(raw.x), bflo(raw.y), bfhi(raw.y), bflo(raw.z), bfhi(raw.z), bflo(raw.w), bfhi(raw.w)};
            float ss = 0.f;
#pragma unroll
            for (int e = 0; e < 8; ++e) ss += x[e] * x[e];
            ss += __shfl_xor(ss, 1); ss += __shfl_xor(ss, 2); ss += __shfl_xor(ss, 4);
            const float rstd = gs / sqrtf(ss * (1.0f / 64.0f) + EPS);
            const f32x4 g0 = *(const f32x4*)(gp + part * 8), g1 = *(const f32x4*)(gp + part * 8 + 4);
            u32x4 o; o.x = pk2(x[0] * rstd * g0.x, x[1] * rstd * g0.y); o.y = pk2(x[2] * rstd * g0.z, x[3] * rstd * g0.w); o.z = pk2(x[4] * rstd * g1.x, x[5] * rstd * g1.y); o.w = pk2(x[6] * rstd * g1.z, x[7] * rstd * g1.w);
            *(u32x4*)(dst + part * 8) = o;
        }
    }
    LAS bf16* tile = (LAS bf16*)(F.lds + F.wave * 16384);
    for (int it = F.gw; it < 2 * 2 * (T / 64); it += F.NGW) {
        const int kind = it / (2 * (T / 64)), q = it % (2 * (T / 64)), g = q / (T / 64), tb = q % (T / 64);
        const bf16* src = P + (size_t)(tb * 64) * NPAD + (kind == 0 ? C_VS : C_VW) + g * 64;
        bf16* dst = (bf16*)(KWS + (kind == 0 ? WS_VST : WS_VWT)) + (size_t)g * 64 * T + tb * 64;
#pragma unroll
        for (int i = 0; i < 8; ++i) { const int tok = vec + 8 * i; *(LAS u32x4*)(tile + tok * 72 + part * 8) = *(const u32x4*)(src + (size_t)tok * NPAD + part * 8); }
        WSYNC();
#pragma unroll
        for (int c = 0; c < 8; ++c) { unsigned w[4];
#pragma unroll
            for (int k = 0; k < 4; ++k) { const int p0 = (c & 1) * 8 + 2 * k, p1 = p0 + 1;
                const int k0 = (c >> 1) * 16 + ((p0 & 3) | ((p0 & 4) << 1) | ((p0 & 8) >> 1)), k1 = (c >> 1) * 16 + ((p1 & 3) | ((p1 & 4) << 1) | ((p1 & 8) >> 1));
                w[k] = (unsigned)tile[k0 * 72 + F.lane] | ((unsigned)tile[k1 * 72 + F.lane] << 16); }
            *(u32x4*)(dst + (size_t)F.lane * T + c * 8) = (u32x4){w[0], w[1], w[2], w[3]}; }
        WSYNC();
    }
}

__device__ __forceinline__ void phase_compress2(Frame& F, int l) {
    KA;
    LAS float* av = (LAS float*)(F.lds + F.wave * 16384);
    const bf16* P = (const bf16*)(KWS + WS_P);
    bf16* KCB = (bf16*)(KWS + WS_KCB); bf16* VCT = (bf16*)(KWS + WS_KCB + 131072);
    for (int it = F.gw; it < 2 * 2 * 512; it += F.NGW) {
        const int kind = it >> 10, g = (it >> 9) & 1, n = it & 511;
        if (n == 511) { if (kind == 0) KCB[((size_t)g * 512 + 511) * 64 + F.lane] = 0; else VCT[((size_t)g * 64 + F.lane) * 512 + 511] = 0; continue; }
        const bf16* src = P + (size_t)(16 * n) * NPAD + (kind == 0 ? C_KC : C_VC) + g * 64;
        const float* pe = KIN(I_PE) + ((size_t)l * 2 + kind) * 2048;
        const float* w1 = KIN(I_W1) + ((size_t)l * 2 + kind) * 2048 * 64;
        const float* w2 = KIN(I_W2) + ((size_t)l * 2 + kind) * 64 * 64;
#pragma unroll 4
        for (int c = 0; c < 32; ++c) av[c * 64 + F.lane] = bf2f(src[(size_t)c * NPAD + F.lane]) + pe[c * 64 + F.lane];
        WSYNC();
        float acc = 0.f;
#pragma unroll 8
        for (int i = 0; i < 2048; ++i) acc += av[i] * w1[i * 64 + F.lane];
        const float hid = gelu_tanh(acc);
        WSYNC();
        av[F.lane] = hid;
        WSYNC();
        float o = 0.f;
#pragma unroll 8
        for (int i = 0; i < 64; ++i) o += av[i] * w2[i * 64 + F.lane];
        WSYNC();
        if (kind == 0) { const float ss = wave_sum(o * o); o = o * (1.0f / sqrtf(ss * (1.0f / 64.0f) + EPS)) * KIN(I_KN)[l * 192 + F.lane]; KCB[((size_t)g * 512 + n) * 64 + F.lane] = (bf16)f2bf(o); }
        else VCT[((size_t)g * 64 + F.lane) * 512 + ((n & ~15) | perm16(n & 15))] = (bf16)f2bf(o);
    }
}

__device__ __forceinline__ void phase_compress3(Frame& F, int l) {
    KA;
    const bf16* P = (const bf16*)(KWS + WS_P);
    bf16* KCB = (bf16*)(KWS + WS_KCB); bf16* VCT = (bf16*)(KWS + WS_KCB + 131072);
    LAS float* red = (LAS float*)F.lds;
    LAS bf16* hid = (LAS bf16*)(F.lds + 32768);
    const int r16 = F.lane & 15, kq = F.lane >> 4;
    for (int unit = F.bid; unit < 128; unit += F.G) {
        const int kind = unit >> 6, mt = unit & 63, g = mt >> 5, n0 = (mt & 31) * 16;
        const bf16* W1T = (const bf16*)(KWS + WS_CW) + (size_t)(l * 2 + kind) * 64 * 2048; const bf16* W2T = (const bf16*)(KWS + WS_CW + 1048576) + (size_t)(l * 2 + kind) * 4096;
        const float* B1 = (const float*)(KWS + WS_CW + 1572864) + (l * 2 + kind) * 64;
        const bf16* arow = P + (size_t)(16 * (n0 + r16)) * NPAD + (kind == 0 ? C_KC : C_VC) + g * 64;
        f32x4 acc[4];
#pragma unroll
        for (int nt = 0; nt < 4; ++nt) acc[nt] = (f32x4){0.f, 0.f, 0.f, 0.f};
#pragma unroll 2
        for (int ks = 0; ks < 8; ++ks) { const int c0 = F.wave * 256 + 32 * ks + 8 * kq;
            const bf16x8 a = *(const bf16x8*)(arow + (size_t)(c0 >> 6) * NPAD + (c0 & 63));
#pragma unroll
            for (int nt = 0; nt < 4; ++nt) { const bf16x8 b = *(const bf16x8*)(W1T + (size_t)(16 * nt + r16) * 2048 + c0); acc[nt] = __builtin_amdgcn_mfma_f32_16x16x32_bf16(a, b, acc[nt], 0, 0, 0); } }
#pragma unroll
        for (int nt = 0; nt < 4; ++nt) *(LAS f32x4*)(red + ((F.wave * 4 + nt) * 64 + F.lane) * 4) = acc[nt];
        __syncthreads();
        if (F.tid < 256) { const int nt = F.tid >> 6, ln = F.tid & 63; f32x4 v = {0.f, 0.f, 0.f, 0.f};
#pragma unroll
            for (int w = 0; w < 8; ++w) v += *(const LAS f32x4*)(red + ((w * 4 + nt) * 64 + ln) * 4);
            const int col = 16 * nt + (ln & 15); const float b1 = B1[col];
#pragma unroll
            for (int i = 0; i < 4; ++i) hid[(4 * (ln >> 4) + i) * 72 + col] = (bf16)f2bf(gelu_tanh(v[i] + b1)); }
        __syncthreads();
        if (F.wave == 0) {
            f32x4 o[4];
#pragma unroll
            for (int nt = 0; nt < 4; ++nt) o[nt] = (f32x4){0.f, 0.f, 0.f, 0.f};
#pragma unroll
            for (int ks = 0; ks < 2; ++ks) { const bf16x8 a = *(const LAS bf16x8*)(hid + r16 * 72 + 32 * ks + 8 * kq);
#pragma unroll
                for (int nt = 0; nt < 4; ++nt) { const bf16x8 b = *(const bf16x8*)(W2T + (16 * nt + r16) * 64 + 32 * ks + 8 * kq); o[nt] = __builtin_amdgcn_mfma_f32_16x16x32_bf16(a, b, o[nt], 0, 0, 0); } }
            if (kind == 0) {
#pragma unroll
                for (int i = 0; i < 4; ++i) { float ss = o[0][i] * o[0][i] + o[1][i] * o[1][i] + o[2][i] * o[2][i] + o[3][i] * o[3][i];
                    ss += __shfl_xor(ss, 1); ss += __shfl_xor(ss, 2); ss += __shfl_xor(ss, 4); ss += __shfl_xor(ss, 8);
                    const float rstd = 1.0f / sqrtf(ss * (1.0f / 64.0f) + EPS); const int n = n0 + 4 * kq + i;
#pragma unroll
                    for (int nt = 0; nt < 4; ++nt) { const int col = 16 * nt + r16; KCB[((size_t)g * 512 + n) * 64 + col] = n < 511 ? (bf16)f2bf(o[nt][i] * rstd * KIN(I_KN)[l * 192 + col]) : (bf16)0; } }
            } else {
#pragma unroll
                for (int i = 0; i < 4; ++i) { const int n = n0 + 4 * kq + i;
#pragma unroll
                    for (int nt = 0; nt < 4; ++nt) { const int col = 16 * nt + r16; VCT[((size_t)g * 64 + col) * 512 + ((n & ~15) | perm16(n & 15))] = n < 511 ? (bf16)f2bf(o[nt][i]) : (bf16)0; } }
            }
        }
        __syncthreads();
    }
}

constexpr int NSA_SCA = 65536, NSA_SCB = 99328;
constexpr int NSA_QM = 133120, NSA_UM = 134144;
static_assert(NSA_UM + 16 <= MISC_OFF, "NSA LDS map");
__device__ __forceinline__ int next_set(unsigned long long m0, unsigned long long m1, int from) {
    if (from < 64) { const unsigned long long x = m0 & (~0ull << from); if (x) return __builtin_ctzll(x); from = 64; }
    if (from < 128) { const unsigned long long x = m1 & (~0ull << (from - 64)); if (x) return 64 + __builtin_ctzll(x); }
    return 128;
}
__device__ __forceinline__ void nsa_issue(LAS unsigned char* lds, int slot, const bf16* Kg, const bf16* VTg, int vt_len, int j, int tid, int wave) {
    const int row = tid >> 3, c = (tid & 7) ^ ((row >> 1) & 7);
    __builtin_amdgcn_global_load_lds((const unsigned*)(Kg + (size_t)(64 * j + row) * 64 + c * 8), (LAS unsigned*)(lds + slot * 16384 + wave * 1024), 16, 0, 0);
    __builtin_amdgcn_global_load_lds((const unsigned*)(VTg + (size_t)row * vt_len + 64 * j + c * 8), (LAS unsigned*)(lds + slot * 16384 + 8192 + wave * 1024), 16, 0, 0);
}
template <int MODE> __device__ __forceinline__ void nsa_branch(Frame& F, const bf16* Kg, const bf16* VTg, int vt_len, unsigned long long m0, unsigned long long m1,
        const bf16x8 (&Qf)[4], int t, int cblk, u32x4 qxw, int tref, float inv_l, const unsigned (&qsel)[4], int hi_cmp, unsigned wm_lo_dummy, f32x16 (&oacc)[2], float& lsum) {
    LAS unsigned char* lds = F.lds;
    const int lane = F.lane, c32 = lane & 31, h = lane >> 5, tid = F.tid;
    const int sw = (c32 >> 1) & 7;
    int j0 = next_set(m0, m1, 0);
    if (j0 >= 128) return;
    int j1 = next_set(m0, m1, j0 + 1), j2 = j1 < 128 ? next_set(m0, m1, j1 + 1) : 128;
    nsa_issue(lds, 0, Kg, VTg, vt_len, j0, tid, F.wave);
    if (j1 < 128) nsa_issue(lds, 1, Kg, VTg, vt_len, j1, tid, F.wave);
    if (j2 < 128) nsa_issue(lds, 2, Kg, VTg, vt_len, j2, tid, F.wave);
    int slot = 0;
    while (j0 < 128) {
        const int j = j0;
        if (j2 < 128) asm volatile("s_waitcnt vmcnt(4)" ::: "memory"); else if (j1 < 128) asm volatile("s_waitcnt vmcnt(2)" ::: "memory"); else asm volatile("s_waitcnt vmcnt(0)" ::: "memory");
        __builtin_amdgcn_s_barrier(); asm volatile("" ::: "memory");
        const int j3 = j2 < 128 ? next_set(m0, m1, j2 + 1) : 128;
        if (j3 < 128) nsa_issue(lds, (slot + 3) & 3, Kg, VTg, vt_len, j3, tid, F.wave);
        bool need = true;
        if (MODE == 2) { const unsigned myw = j < 32 ? qsel[0] : (j < 64 ? qsel[1] : (j < 96 ? qsel[2] : qsel[3])); need = __any((myw >> (j & 31)) & 1u); }
        if (need) {
            const int kb = slot * 16384, vb = slot * 16384 + 8192;
            const int kbase = 64 * j;
            u32x4 qx = qxw;
            if (MODE == 2) { const unsigned myw = j < 32 ? qsel[0] : (j < 64 ? qsel[1] : (j < 96 ? qsel[2] : qsel[3])); if (!((myw >> (j & 31)) & 1u) && h == 0) qx.z = 0xF149u; }
            const bf16x8 qxf = __builtin_bit_cast(bf16x8, qx);
            f32x16 sacc[2];
#pragma unroll
            for (int sub = 0; sub < 2; ++sub)
#pragma unroll
                for (int i = 0; i < 16; ++i) sacc[sub][i] = 0.f;
#pragma unroll
            for (int sub = 0; sub < 2; ++sub) {
#pragma unroll
                for (int kp = 0; kp < 2; ++kp) { bf16x8 ka2[2];
#pragma unroll
                    for (int k2 = 0; k2 < 2; ++k2) ka2[k2] = *(const LAS bf16x8*)(lds + kb + (32 * sub + c32) * 128 + (((2 * (2 * kp + k2) + h) ^ sw) * 16));
                    asm volatile("" ::: "memory");
#pragma unroll
                    for (int k2 = 0; k2 < 2; ++k2) sacc[sub] = __builtin_amdgcn_mfma_f32_32x32x16_bf16(ka2[k2], Qf[2 * kp + k2], sacc[sub], 0, 0, 0);
                    asm volatile("" ::: "memory"); }
                { const int kidx = kbase + 32 * sub + c32, pos = MODE < 2 ? 16 * kidx + 31 : kidx, dd = tref - pos;
                  const unsigned w = pkbf(-(float)((dd >> 8) * 256), -(float)(dd & 255));
                  u32x4 kx; kx.x = h == 0 ? w : 0u; kx.y = kx.x; kx.z = h == 0 ? 0x3F80u : 0u; kx.w = 0u;
                  sacc[sub] = __builtin_amdgcn_mfma_f32_32x32x16_bf16(__builtin_bit_cast(bf16x8, kx), qxf, sacc[sub], 0, 0, 0); } }
#pragma unroll
            for (int sub = 0; sub < 2; ++sub)
#pragma unroll
                for (int i = 0; i < 16; ++i) sacc[sub][i] = __builtin_amdgcn_exp2f(sacc[sub][i]);
            bool mhi = false, mlo = false; int hi = 0, lo = 0;
            if (MODE < 2) { mhi = (kbase + 63 > (tref - 63 - 31) / 16 - 1); hi = hi_cmp; }
            if (MODE == 2) { mhi = (j == cblk); hi = t; }
            if (MODE == 3) { mhi = (j == cblk); hi = t; mlo = (j == cblk - 8); lo = t - 511; }
            if (mhi || mlo) {
#pragma unroll
                for (int sub = 0; sub < 2; ++sub)
#pragma unroll
                    for (int i = 0; i < 16; ++i) { const int idx = kbase + 4 * h + 32 * sub + (i & 3) + 8 * (i >> 2); if ((mhi && idx > hi) || (mlo && idx < lo)) sacc[sub][i] = 0.f; }
            }
            float ls = 0.f;
#pragma unroll
            for (int sub = 0; sub < 2; ++sub)
#pragma unroll
                for (int i = 0; i < 16; ++i) ls += sacc[sub][i];
            lsum += ls;
            if (MODE == 1) {
                LAS float* scA = (LAS float*)(lds + NSA_SCA); LAS float* scB = (LAS float*)(lds + NSA_SCB);
                const int q = F.wave * 8 + (c32 >> 2);
#pragma unroll
                for (int sub = 0; sub < 2; ++sub)
#pragma unroll
                    for (int g4 = 0; g4 < 4; ++g4) { float x[4];
#pragma unroll
                        for (int e = 0; e < 4; ++e) { float v = sacc[sub][4 * g4 + e] * inv_l;
                            v += __builtin_bit_cast(float, __builtin_amdgcn_mov_dpp(__builtin_bit_cast(int, v), 0xB1, 0xF, 0xF, true));
                            v += __builtin_bit_cast(float, __builtin_amdgcn_mov_dpp(__builtin_bit_cast(int, v), 0x4E, 0xF, 0xF, true));
                            x[e] = v; }
                        const int jb = 16 * j + 8 * sub + 2 * g4 + h;
                        if ((c32 & 3) == 0) { scA[q * 132 + jb] = 2.0f * (x[0] + x[1] + x[2]) + x[3]; scB[q * 132 + jb + 1] = x[3]; } }
            }
            if (MODE != 0) {
                bf16x8 pf[2][2];
#pragma unroll
                for (int sub = 0; sub < 2; ++sub)
#pragma unroll
                    for (int s2 = 0; s2 < 2; ++s2) { u32x4 w; w.x = pkbf(sacc[sub][8 * s2], sacc[sub][8 * s2 + 1]); w.y = pkbf(sacc[sub][8 * s2 + 2], sacc[sub][8 * s2 + 3]); w.z = pkbf(sacc[sub][8 * s2 + 4], sacc[sub][8 * s2 + 5]); w.w = pkbf(sacc[sub][8 * s2 + 6], sacc[sub][8 * s2 + 7]);
                        pf[sub][s2] = __builtin_bit_cast(bf16x8, w); }
                asm volatile("" ::: "memory");
#pragma unroll
                for (int ds = 0; ds < 2; ++ds) {
#pragma unroll
                    for (int qp = 0; qp < 2; ++qp) { bf16x8 va2[2];
#pragma unroll
                        for (int k2 = 0; k2 < 2; ++k2) va2[k2] = *(const LAS bf16x8*)(lds + vb + (32 * ds + c32) * 128 + (((2 * (2 * qp + k2) + h) ^ sw) * 16));
                        asm volatile("" ::: "memory");
#pragma unroll
                        for (int k2 = 0; k2 < 2; ++k2) oacc[ds] = __builtin_amdgcn_mfma_f32_32x32x16_bf16(va2[k2], pf[qp][k2], oacc[ds], 0, 0, 0);
                        asm volatile("" ::: "memory"); } }
            }
        }
        j0 = j1; j1 = j2; j2 = j3; slot = (slot + 1) & 3;
    }
    asm volatile("s_waitcnt lgkmcnt(0)" ::: "memory"); __builtin_amdgcn_s_barrier(); asm volatile("" ::: "memory");
}
__device__ __forceinline__ void nsa_stash_put(LAS unsigned char* lds, int wave, int lane, const f32x16 (&o)[2], float sc) {
    LAS unsigned* st = (LAS unsigned*)(lds + NSA_SCA) + wave * 1024 + lane;
#pragma unroll
    for (int ds = 0; ds < 2; ++ds)
#pragma unroll
        for (int k = 0; k < 8; ++k) st[(ds * 8 + k) * 64] = pkbf(o[ds][2 * k] * sc, o[ds][2 * k + 1] * sc);
}
#define PSTAMP(slot) do { if (MK_PROBE_MASK != 0 && F.bid == MK_PROBE_BID && F.tid == 0) { volatile LAS unsigned long long* _ta = (volatile LAS unsigned long long*)(F.lds + MISC_OFF + 512); const unsigned long long _n = wall_clock64(); _ta[slot] += _n - _ta[16]; _ta[16] = _n; } } while (0)
__device__ __forceinline__ void phase_nsa2(Frame& F, int l) {
    KA;
    LAS unsigned char* lds = F.lds;
    const bf16* P = (const bf16*)(KWS + WS_P); bf16* OCAT = (bf16*)(KWS + WS_OCAT);
    const bf16* QS = (const bf16*)(KWS + WS_QS);
    const int lane = F.lane, c32 = lane & 31, h = lane >> 5, q8 = c32 >> 2, r = c32 & 3;
    for (int unit = F.bid; unit < 256; unit += F.G) {
        const int g = unit & 1, cblk = unit >> 1, t0 = cblk * 64, head = g * 4 + r, t = t0 + F.wave * 8 + q8;
        u32x4 qxw;
        { const float s2 = exp2f(-(float)(head + 1)) * LOG2E; const unsigned sh = f2bf(s2); const float rem = s2 - bf2f(sh); const unsigned sl = f2bf(rem);
          qxw.x = h == 0 ? (sh | (sh << 16)) : 0u; qxw.y = h == 0 ? (sl | (sl << 16)) : 0u; qxw.z = 0u; qxw.w = 0u; }
        const int tref = t0 + 63;
        bf16x8 Qf[4];
#pragma unroll
        for (int ks = 0; ks < 4; ++ks) Qf[ks] = *(const bf16x8*)(QS + ((size_t)head * T + t) * 64 + 16 * ks + 8 * h);
        for (int u = F.tid; u < (NSA_UM + 16 - NSA_SCA) / 4; u += 512) ((LAS unsigned*)(lds + NSA_SCA))[u] = 0u;
        __syncthreads();
        f32x16 oacc[2];
#pragma unroll
        for (int ds = 0; ds < 2; ++ds)
#pragma unroll
            for (int i = 0; i < 16; ++i) oacc[ds][i] = 0.f;
        unsigned qsel[4] = {0u, 0u, 0u, 0u};
        float sc_cmp;
        PSTAMP(24);
        {
            const int ntile = (4 * cblk + 2) / 64 + 1;
            const unsigned long long cm0 = ntile >= 64 ? ~0ull : ((1ull << ntile) - 1ull);
            const int hi_cmp = t >= 31 ? (t - 31) / 16 : -1;
            const bf16* Kg = (const bf16*)(KWS + WS_KCB) + (size_t)g * 512 * 64; const bf16* VTg = (const bf16*)(KWS + WS_KCB + 131072) + (size_t)g * 64 * 512;
            float l1 = 0.f;
            nsa_branch<0>(F, Kg, VTg, 512, cm0, 0ull, Qf, t, cblk, qxw, tref, 0.f, qsel, hi_cmp, 0u, oacc, l1);
            l1 += __shfl_xor(l1, 32);
            const float inv_l = l1 > 0.f ? 1.0f / l1 : 0.f;
            float l2 = 0.f;
            nsa_branch<1>(F, Kg, VTg, 512, cm0, 0ull, Qf, t, cblk, qxw, tref, inv_l, qsel, hi_cmp, 0u, oacc, l2);
            sc_cmp = sigmoidf_(bf2f(P[(size_t)t * NPAD + C_NG + head])) * inv_l;
        }
        PSTAMP(20);
        {
            LAS float* scA = (LAS float*)(lds + NSA_SCA); LAS float* scB = (LAS float*)(lds + NSA_SCB);
            LAS unsigned* qm = (LAS unsigned*)(lds + NSA_QM); LAS unsigned* um = (LAS unsigned*)(lds + NSA_UM);
            WSYNC();
            const int qq = F.wave * 8 + (lane >> 3), jj = lane & 7;
            unsigned key[16];
#pragma unroll
            for (int m = 0; m < 16; ++m) { const int jb = jj + 8 * m; float sv = scA[qq * 132 + jb] + scB[qq * 132 + jb];
                if (jb == 0 || jb == cblk || jb == cblk - 1) sv = 1e4f;
                key[m] = jb <= cblk ? ((__builtin_bit_cast(unsigned, sv) & ~127u) | (unsigned)(127 - jb)) : 0u; }
            WSYNC();
#pragma unroll
            for (int m = 0; m < 16; ++m) ((LAS unsigned*)scA)[qq * 132 + jj + 8 * m] = key[m];
            WSYNC();
            unsigned bits[4] = {0u, 0u, 0u, 0u};
#pragma unroll
            for (int half = 0; half < 2; ++half) { int rank[8];
#pragma unroll
                for (int m = 0; m < 8; ++m) rank[m] = 0;
#pragma unroll 2
                for (int i = 0; i <= cblk; i += 4) { const u32x4 k4 = *(const LAS u32x4*)((const LAS unsigned*)scA + qq * 132 + i);
#pragma unroll
                    for (int m = 0; m < 8; ++m) rank[m] += (k4.x > key[8 * half + m] ? 1 : 0) + (k4.y > key[8 * half + m] ? 1 : 0) + (k4.z > key[8 * half + m] ? 1 : 0) + (k4.w > key[8 * half + m] ? 1 : 0); }
#pragma unroll
                for (int m = 0; m < 8; ++m) { const int jb = jj + 8 * (8 * half + m); if (jb <= cblk && rank[m] < 16) bits[(8 * half + m) >> 2] |= 1u << (jb & 31); } }
#pragma unroll
            for (int w = 0; w < 4; ++w) if (bits[w]) { atomicOr((unsigned*)(qm + qq * 4 + w), bits[w]); atomicOr((unsigned*)(um + w), bits[w]); }
            __syncthreads();
#pragma unroll
            for (int w = 0; w < 4; ++w) qsel[w] = qm[(F.wave * 8 + q8) * 4 + w];
        }
        PSTAMP(21);
        nsa_stash_put(lds, F.wave, lane, oacc, sc_cmp);
#pragma unroll
        for (int ds = 0; ds < 2; ++ds)
#pragma unroll
            for (int i = 0; i < 16; ++i) oacc[ds][i] = 0.f;
        {
            LAS unsigned* um = (LAS unsigned*)(lds + NSA_UM);
            const unsigned long long sm0 = (unsigned long long)__builtin_amdgcn_readfirstlane(um[0]) | ((unsigned long long)__builtin_amdgcn_readfirstlane(um[1]) << 32);
            const unsigned long long sm1 = (unsigned long long)__builtin_amdgcn_readfirstlane(um[2]) | ((unsigned long long)__builtin_amdgcn_readfirstlane(um[3]) << 32);
            float ls = 0.f;
            nsa_branch<2>(F, (const bf16*)(KWS + WS_KS2) + (size_t)g * T * 64, (const bf16*)(KWS + WS_VST) + (size_t)g * 64 * T, T, sm0, sm1, Qf, t, cblk, qxw, tref, 0.f, qsel, 0, 0u, oacc, ls);
            ls += __shfl_xor(ls, 32);
            const float sc = sigmoidf_(bf2f(P[(size_t)t * NPAD + C_NG + 8 + head])) / ls;
            LAS unsigned* st = (LAS unsigned*)(lds + NSA_SCA) + F.wave * 1024 + lane;
#pragma unroll
            for (int ds = 0; ds < 2; ++ds)
#pragma unroll
                for (int k = 0; k < 8; ++k) { const unsigned w = st[(ds * 8 + k) * 64]; st[(ds * 8 + k) * 64] = pkbf(bflo(w) + sc * oacc[ds][2 * k], bfhi(w) + sc * oacc[ds][2 * k + 1]); oacc[ds][2 * k] = 0.f; oacc[ds][2 * k + 1] = 0.f; }
        }
        PSTAMP(22);
        {
            const int j0 = cblk >= 8 ? cblk - 8 : 0;
            unsigned long long wm0 = 0ull, wm1 = 0ull;
            for (int jb = j0; jb <= cblk; ++jb) { if (jb < 64) wm0 |= 1ull << jb; else wm1 |= 1ull << (jb - 64); }
            float ls = 0.f;
            nsa_branch<3>(F, (const bf16*)(KWS + WS_KW2) + (size_t)g * T * 64, (const bf16*)(KWS + WS_VWT) + (size_t)g * 64 * T, T, wm0, wm1, Qf, t, cblk, qxw, tref, 0.f, qsel, 0, 0u, oacc, ls);
            ls += __shfl_xor(ls, 32);
            const float sc = sigmoidf_(bf2f(P[(size_t)t * NPAD + C_NG + 16 + head])) / ls;
            const LAS unsigned* st = (const LAS unsigned*)(lds + NSA_SCA) + F.wave * 1024 + lane;
#pragma unroll
            for (int ds = 0; ds < 2; ++ds)
#pragma unroll
                for (int g4 = 0; g4 < 4; ++g4) { const unsigned w0 = st[(ds * 8 + 2 * g4) * 64], w1 = st[(ds * 8 + 2 * g4 + 1) * 64];
                    u32x2 w; w.x = pkbf(bflo(w0) + sc * oacc[ds][4 * g4], bfhi(w0) + sc * oacc[ds][4 * g4 + 1]); w.y = pkbf(bflo(w1) + sc * oacc[ds][4 * g4 + 2], bfhi(w1) + sc * oacc[ds][4 * g4 + 3]);
                    *(u32x2*)(OCAT + (size_t)t * 1536 + head * 64 + 32 * ds + 8 * g4 + 4 * h) = w; }
        }
        __syncthreads();
        PSTAMP(23);
    }
}

__device__ __forceinline__ void phase_merge(Frame& F) {
    KA;
    const bf16* P = (const bf16*)(KWS + WS_P); const bf16* PROJ = (const bf16*)(KWS + WS_PROJ); bf16* MG = (bf16*)(KWS + WS_MERGED);
    const size_t total = (size_t)T * D / 8;
    for (size_t it = (size_t)F.gw * 64 + F.lane; it < total; it += (size_t)F.NGW * 64) {
        const size_t t = it / (D / 8); const int d = (int)(it % (D / 8)) * 8;
        float acc[8];
#pragma unroll
        for (int k = 0; k < 8; ++k) acc[k] = 0.f;
#pragma unroll
        for (int n = 0; n < 3; ++n) { const u32x4 gq = *(const u32x4*)(P + t * NPAD + C_MG + n * D + d); const u32x4 pq = *(const u32x4*)(PROJ + ((size_t)n * T + t) * D + d);
            acc[0] += sigmoidf_(bflo(gq.x)) * bflo(pq.x); acc[1] += sigmoidf_(bfhi(gq.x)) * bfhi(pq.x); acc[2] += sigmoidf_(bflo(gq.y)) * bflo(pq.y); acc[3] += sigmoidf_(bfhi(gq.y)) * bfhi(pq.y);
            acc[4] += sigmoidf_(bflo(gq.z)) * bflo(pq.z); acc[5] += sigmoidf_(bfhi(gq.z)) * bfhi(pq.z); acc[6] += sigmoidf_(bflo(gq.w)) * bflo(pq.w); acc[7] += sigmoidf_(bfhi(gq.w)) * bfhi(pq.w); }
        u32x4 o; o.x = pk2(acc[0], acc[1]); o.y = pk2(acc[2], acc[3]); o.z = pk2(acc[4], acc[5]); o.w = pk2(acc[6], acc[7]);
        *(u32x4*)(MG + t * D + d) = o;
    }
}
__device__ __forceinline__ void phase_router(Frame& F, int l) {
    KA;
    const float* X1 = (const float*)(KWS + WS_X1); bf16* H = (bf16*)(KWS + WS_H);
    int* EID = (int*)(KWS + WS_ROUTE); float* EW = (float*)(KWS + WS_ROUTE + 65536);
    const float* gain = KIN(I_NFFN) + (size_t)l * D; const float* wg = KIN(I_WGRP) + (size_t)l * D * 4; const float* we = KIN(I_WEXP) + (size_t)l * D * 32;
    const float* bg = KIN(I_BGRP) + l * 4; const float* be = KIN(I_BEXP) + l * 32;
    for (int t = F.gw; t < T; t += F.NGW) {
        const float* xrow = X1 + (size_t)t * D;
        float ss = 0.f;
#pragma unroll 4
        for (int k = 0; k < 32; ++k) { const float x = xrow[F.lane + 64 * k]; ss += x * x; }
        const float rstd = 1.0f / sqrtf(wave_sum(ss) * (1.0f / D) + EPS);
        float ag[4] = {0.f, 0.f, 0.f, 0.f}, ae[32];
#pragma unroll
        for (int e = 0; e < 32; ++e) ae[e] = 0.f;
#pragma unroll 1
        for (int k = 0; k < 32; ++k) { const int d = F.lane + 64 * k;
            const float hv = xrow[d] * rstd * gain[d];
            H[(size_t)t * D + d] = (bf16)f2bf(hv);
            const f32x4 w4 = *(const f32x4*)(wg + (size_t)d * 4);
            ag[0] += hv * w4.x; ag[1] += hv * w4.y; ag[2] += hv * w4.z; ag[3] += hv * w4.w;
#pragma unroll
            for (int c = 0; c < 8; ++c) { const f32x4 w = *(const f32x4*)(we + (size_t)d * 32 + c * 4); ae[c * 4] += hv * w.x; ae[c * 4 + 1] += hv * w.y; ae[c * 4 + 2] += hv * w.z; ae[c * 4 + 3] += hv * w.w; } }
#pragma unroll
        for (int e = 0; e < 4; ++e) ag[e] = wave_sum(ag[e]) + bg[e];
#pragma unroll
        for (int e = 0; e < 32; ++e) ae[e] = wave_sum(ae[e]) + be[e];
        int gi = 0; float gm = ag[0];
#pragma unroll
        for (int e = 1; e < 4; ++e) if (ag[e] > gm) { gm = ag[e]; gi = e; }
        float gs = 0.f;
#pragma unroll
        for (int e = 0; e < 4; ++e) gs += expf(ag[e] - gm);
        const float gw_ = 1.0f / gs;
        float el[8];
#pragma unroll
        for (int e = 0; e < 8; ++e) { el[e] = gi == 0 ? ae[e] : (gi == 1 ? ae[8 + e] : (gi == 2 ? ae[16 + e] : ae[24 + e])); }
        int i1 = 0; float m1 = el[0];
#pragma unroll
        for (int e = 1; e < 8; ++e) if (el[e] > m1) { m1 = el[e]; i1 = e; }
        int i2 = -1; float m2 = -3.0e38f;
#pragma unroll
        for (int e = 0; e < 8; ++e) if (e != i1 && el[e] > m2) { m2 = el[e]; i2 = e; }
        const float p2 = expf(m2 - m1);
        const float w1 = 1.0f / (1.0f + p2), w2 = p2 / (1.0f + p2);
        if (F.lane == 0) { EID[2 * t] = gi * 8 + i1; EID[2 * t + 1] = gi * 8 + i2; EW[2 * t] = gw_ * w1; EW[2 * t + 1] = gw_ * w2; }
    }
}

__device__ __forceinline__ void phase_router3(Frame& F, int l) {
    KA;
    const float* X1 = (const float*)(KWS + WS_X1); bf16* H = (bf16*)(KWS + WS_H);
    int* EID = (int*)(KWS + WS_ROUTE); float* EW = (float*)(KWS + WS_ROUTE + 65536); int* HIST = (int*)(KWS + WS_HIST); float* RSTD = (float*)(KWS + WS_RSTD);
    const float* WRT = (const float*)(KWS + WS_WRT) + (size_t)l * 48 * D;
    const float* gain = KIN(I_NFFN) + (size_t)l * D; const float* bg = KIN(I_BGRP) + l * 4; const float* be = KIN(I_BEXP) + l * 32;
    LAS float* red = (LAS float*)F.lds;
    LAS float* ssq = (LAS float*)(F.lds + 49152);
    LAS float* lg = (LAS float*)(F.lds + 50176);
    LAS float* rs = (LAS float*)(F.lds + 55296);
    LAS int* eidl = (LAS int*)(F.lds + 55424);
    const int r16 = F.lane & 15, kq = F.lane >> 4;
    for (int blk = F.bid; blk < T / 32; blk += F.G) {
        const int tok0 = blk * 32, kb0 = F.wave * 256 + 4 * kq;
        const float* xa = X1 + (size_t)(tok0 + r16) * D + kb0;
        const float* wb = WRT + (size_t)r16 * D + kb0;
        bf16* hp = H + (size_t)(tok0 + r16) * D + kb0;
        f32x4 acc[2][3]; float sq[2] = {0.f, 0.f};
#pragma unroll
        for (int tg = 0; tg < 2; ++tg)
#pragma unroll
            for (int nt = 0; nt < 3; ++nt) acc[tg][nt] = (f32x4){0.f, 0.f, 0.f, 0.f};
#pragma unroll 2
        for (int s = 0; s < 16; ++s) { f32x4 a[2], b[3];
#pragma unroll
            for (int tg = 0; tg < 2; ++tg) a[tg] = *(const f32x4*)(xa + (size_t)(16 * tg) * D + 16 * s);
#pragma unroll
            for (int nt = 0; nt < 3; ++nt) b[nt] = *(const f32x4*)(wb + (size_t)(16 * nt) * D + 16 * s);
            const f32x4 g = *(const f32x4*)(gain + kb0 + 16 * s);
#pragma unroll
            for (int tg = 0; tg < 2; ++tg) { sq[tg] += a[tg].x * a[tg].x + a[tg].y * a[tg].y + a[tg].z * a[tg].z + a[tg].w * a[tg].w;
                u32x2 o; o.x = pkbf(a[tg].x * g.x, a[tg].y * g.y); o.y = pkbf(a[tg].z * g.z, a[tg].w * g.w);
                *(u32x2*)(hp + (size_t)(16 * tg) * D + 16 * s) = o;
#pragma unroll
                for (int j = 0; j < 4; ++j)
#pragma unroll
                    for (int nt = 0; nt < 3; ++nt) acc[tg][nt] = __builtin_amdgcn_mfma_f32_16x16x4f32(a[tg][j], b[nt][j], acc[tg][nt], 0, 0, 0); } }
#pragma unroll
        for (int tg = 0; tg < 2; ++tg) { sq[tg] += __shfl_xor(sq[tg], 16); sq[tg] += __shfl_xor(sq[tg], 32);
            if (kq == 0) ssq[F.wave * 32 + 16 * tg + r16] = sq[tg];
#pragma unroll
            for (int nt = 0; nt < 3; ++nt) *(LAS f32x4*)(red + (((F.wave * 2 + tg) * 3 + nt) * 64 + F.lane) * 4) = acc[tg][nt]; }
        __syncthreads();
        if (F.tid < 384) { const int tg2 = F.tid / 192, rem = F.tid % 192, nt = rem / 64, ln = rem % 64; f32x4 v = {0.f, 0.f, 0.f, 0.f};
#pragma unroll
            for (int w = 0; w < 8; ++w) v += *(const LAS f32x4*)(red + (((w * 2 + tg2) * 3 + nt) * 64 + ln) * 4);
            const int col = 16 * nt + (ln & 15);
            if (col < 36) {
#pragma unroll
                for (int i = 0; i < 4; ++i) lg[(16 * tg2 + 4 * (ln >> 4) + i) * 40 + col] = v[i]; } }
        if (F.tid >= 384 && F.tid < 416) { const int tk = F.tid - 384; float q2 = 0.f;
#pragma unroll
            for (int w = 0; w < 8; ++w) q2 += ssq[w * 32 + tk];
            const float r = 1.0f / sqrtf(q2 * (1.0f / D) + EPS); rs[tk] = r; RSTD[tok0 + tk] = r; }
        __syncthreads();
        if (F.tid < 32) { const int tk = F.tid, t = tok0 + tk; const float rstd = rs[tk];
            float ag[4], el[8];
#pragma unroll
            for (int e = 0; e < 4; ++e) ag[e] = lg[tk * 40 + 32 + e] * rstd + bg[e];
            int gi = 0; float gm = ag[0];
#pragma unroll
            for (int e = 1; e < 4; ++e) if (ag[e] > gm) { gm = ag[e]; gi = e; }
            float gs = 0.f;
#pragma unroll
            for (int e = 0; e < 4; ++e) gs += expf(ag[e] - gm);
            const float gw_ = 1.0f / gs;
#pragma unroll
            for (int e = 0; e < 8; ++e) el[e] = lg[tk * 40 + gi * 8 + e] * rstd + be[gi * 8 + e];
            int i1 = 0; float m1 = el[0];
#pragma unroll
            for (int e = 1; e < 8; ++e) if (el[e] > m1) { m1 = el[e]; i1 = e; }
            int i2 = -1; float m2 = -3.0e38f;
#pragma unroll
            for (int e = 0; e < 8; ++e) if (e != i1 && el[e] > m2) { m2 = el[e]; i2 = e; }
            const float p2 = expf(m2 - m1), w1 = 1.0f / (1.0f + p2), w2 = p2 / (1.0f + p2);
            EID[2 * t] = gi * 8 + i1; EID[2 * t + 1] = gi * 8 + i2; EW[2 * t] = gw_ * w1; EW[2 * t + 1] = gw_ * w2;
            eidl[2 * tk] = gi * 8 + i1; eidl[2 * tk + 1] = gi * 8 + i2; }
        __syncthreads();
        if (F.tid < 32) { int c = 0;
#pragma unroll 8
            for (int i = 0; i < 64; ++i) c += eidl[i] == F.tid ? 1 : 0;
            HIST[blk * 32 + F.tid] = c; }
        __syncthreads();
    }
}
__device__ __forceinline__ void phase_lists2(Frame& F) {
    KA;
    const int* EID = (const int*)(KWS + WS_ROUTE); int* CNT = (int*)(KWS + WS_ROUTE + 131072); int* LIST = (int*)(KWS + WS_ROUTE + 262144); const int* HIST = (const int*)(KWS + WS_HIST);
    LAS int* off = (LAS int*)F.lds; LAS int* eidl = off + 32; LAS int* psum = off + 128;
    for (int blk = F.bid; blk < T / 32; blk += F.G) {
        { const int e = F.tid & 31, part = F.tid >> 5; int a = 0;
#pragma unroll 4
          for (int b2 = part; b2 < blk; b2 += 16) a += HIST[b2 * 32 + e];
          psum[part * 32 + e] = a; }
        __syncthreads();
        if (F.tid < 32) { int a = 0;
#pragma unroll
            for (int p = 0; p < 16; ++p) a += psum[p * 32 + F.tid];
            off[F.tid] = a;
            if (blk == T / 32 - 1) CNT[F.tid] = a + HIST[blk * 32 + F.tid]; }
        if (F.tid >= 64 && F.tid < 128) eidl[F.tid - 64] = EID[blk * 64 + F.tid - 64];
        __syncthreads();
        if (F.tid < 64) { const int e = eidl[F.tid]; int rk = 0;
            for (int i = 0; i < F.tid; ++i) rk += eidl[i] == e ? 1 : 0;
            LIST[e * 8192 + off[e] + rk] = blk * 64 + F.tid; }
        __syncthreads();
    }
}

__device__ __forceinline__ void phase_lists(Frame& F) {
    KA;
    const int e = F.bid;
    if (e >= NE) return;
    const int* EID = (const int*)(KWS + WS_ROUTE); int* CNT = (int*)(KWS + WS_ROUTE + 131072); int* LIST = (int*)(KWS + WS_ROUTE + 262144);
    LAS int* wc = (LAS int*)F.lds;
    int run = 0;
    for (int base = 0; base < 2 * T; base += 512) {
        const int idx = base + F.tid; const bool match = EID[idx] == e;
        const unsigned long long b = __ballot(match);
        if (F.lane == 0) wc[F.wave] = __popcll(b);
        __syncthreads();
        int pre = 0, tot = 0;
#pragma unroll
        for (int w = 0; w < 8; ++w) { const int c = wc[w]; pre += w < F.wave ? c : 0; tot += c; }
        if (match) LIST[e * 8192 + run + pre + __popcll(b & ((1ull << F.lane) - 1ull))] = idx;
        run += tot;
        __syncthreads();
    }
    if (F.tid == 0) CNT[e] = run;
}
__device__ __forceinline__ void moe_table(Frame& F, LAS int* tb) {
    KA;
    const int* CNT = (const int*)(KWS + WS_ROUTE + 131072);
    if (F.tid == 0) { int a = 0, f = 0, h = 0;
        for (int e = 0; e < NE; ++e) { const int n = CNT[e], nt = (n + 255) / 256, lastv = n - (nt - 1) * 256, hh = (nt > 0 && lastv <= 128) ? 1 : 0;
            tb[e] = a; tb[33 + e] = f; tb[66 + e] = h; a += nt; f += nt - hh; h += hh; }
        tb[NE] = a; tb[33 + NE] = f; tb[66 + NE] = h; }
    __syncthreads();
}

constexpr int PH_PER_LAYER = 10, N_PHASES = 1 + NL * PH_PER_LAYER + 1;

__global__ void __launch_bounds__(512, 2) mk_fwd(Args args) {
    extern __shared__ __attribute__((aligned(16))) unsigned char lds_raw[];
#define FRAME Frame F; F.lds = (LAS unsigned char*)lds_raw; F.MISC = (volatile LAS unsigned*)(F.lds + MISC_OFF); F.tid = ltid(); F.lane = F.tid & 63; F.wave = __builtin_amdgcn_readfirstlane(F.tid >> 6); \
    F.G = gridDim.x; F.bid = lbid(); F.vcu = (F.G % 8 == 0) ? (F.bid % 8) * (F.G / 8) + F.bid / 8 : F.bid; F.gw = F.bid * 8 + F.wave; F.NGW = F.G * 8;
    unsigned* const ctl = (unsigned*)((unsigned char*)args.ws + WS_CTL);
    for (int u = threadIdx.x; u < (LDS_BYTES - MISC_OFF) / 4; u += 512) ((LAS unsigned*)(lds_raw + MISC_OFF))[u] = 0u;
    __syncthreads();
    const int lo = args.ph_lo, hi = args.ph_hi;
    XcdBarrier bar; bar.bar = ctl + CW_BAR + args.li * XCD_BAR_WORDS; bar.x = 0; bar.st = nullptr;
    if (hi - lo > 1) bar = xcd_barrier_post(ctl + CW_BAR + args.li * XCD_BAR_WORDS, (volatile LAS unsigned*)((LAS unsigned char*)lds_raw + MISC_OFF));
    int ph = 0;
#define RUN(k) ((k) >= lo && (k) < hi)

    volatile LAS unsigned long long* const tacc = (volatile LAS unsigned long long*)((LAS unsigned char*)lds_raw + MISC_OFF + 512);
    if (MK_PROBE_MASK != 0 && blockIdx.x == MK_PROBE_BID && threadIdx.x == 0) tacc[16] = wall_clock64();
#define STAMP(slot) do { if (MK_PROBE_MASK != 0 && lbid() == MK_PROBE_BID && ltid() == 0) { const unsigned long long _n = wall_clock64(); tacc[slot] += _n - tacc[16]; tacc[16] = _n; } } while (0)
#define SEAM(k, slot) do { if ((k) + 1 < hi) xcd_barrier(bar); STAMP(slot); } while (0)
    LAS int* const tb = (LAS int*)((LAS unsigned char*)lds_raw + MISC_OFF + 64);

    if (RUN(ph)) { KA; FRAME; phase_prologue(F); phase_norm1<0>(F, KIN(I_X), nullptr, nullptr, KIN(I_NMIX), (bf16*)(KWS + WS_H)); SEAM(ph, 0); }
    ++ph;
    for (int l = 0; l < NL; ++l) {
        if (RUN(ph)) { KA; FRAME; pg8::PlainSched S; S.init((const bf16*)(KWS + WS_H), D, (const bf16*)(KWS + WS_WIN) + (size_t)l * NPAD * D, T, NPAD, D, F.G, F.bid, 4); S.probe = 1;
            pg8::EpiBf16 E{(bf16*)(KWS + WS_P), NPAD};
            pg8::gemm_phase<pg8::EpiBf16, pg8::PlainSched, true>(F.lds, D, S, E); SEAM(ph, 1); }
        ++ph;
        if (RUN(ph)) { KA; FRAME; phase_prep3(F, l); __syncthreads(); phase_compress3(F, l); phase_rec_local(F, l); SEAM(ph, 3); }
        ++ph;
        if (RUN(ph)) { KA; FRAME; phase_rec_scan(F); SEAM(ph, 4); }
        ++ph;
        if (RUN(ph)) { KA; FRAME; phase_nsa2(F, l); if (MK_PROBE_MASK != 0) { xcd_barrier(bar); STAMP(7); } phase_rec_out(F, l); SEAM(ph, 5); }
        ++ph;
        if (RUN(ph)) { KA; FRAME;
            { pg8::BranchSched S; S.init((const bf16*)(KWS + WS_OCAT), (const bf16*)(KWS + WS_WBR) + (size_t)l * 3 * D * 512, F.G, F.bid);
              pg8::EpiMerge E{(bf16*)(KWS + WS_MERGED), (const bf16*)(KWS + WS_P) + C_MG};
              pg8::gemm_phase<pg8::EpiMerge, pg8::BranchSched, true>(F.lds, 512, S, E); }
            SEAM(ph, 6); }
        ++ph;

        if (RUN(ph)) { KA; FRAME; pg8::PlainSched S; S.init((const bf16*)(KWS + WS_MERGED), D, (const bf16*)(KWS + WS_WOUT) + (size_t)l * D * D, T, D, D, F.G, F.bid);
            pg8::EpiResF32 E{l == 0 ? KIN(I_X) : (const float*)(KWS + WS_XRES), (float*)(KWS + WS_X1), D};
            pg8::gemm_phase<pg8::EpiResF32, pg8::PlainSched, false>(F.lds, D, S, E); SEAM(ph, 8); }
        ++ph;
        if (RUN(ph)) { KA; FRAME; phase_router3(F, l); SEAM(ph, 9); }
        ++ph;
        if (RUN(ph)) { KA; FRAME; phase_lists2(F); SEAM(ph, 10); }
        ++ph;
        if (RUN(ph)) { KA; FRAME; moe_table(F, tb);
            pg8::MoeSched<1> S; S.init(F.G, F.vcu, tb, (const int*)(KWS + WS_ROUTE + 131072), (const int*)(KWS + WS_ROUTE + 262144), KWS + WS_H, (const bf16*)(KWS + WS_WGU) + (size_t)l * NE * 1024 * D);
            pg8::EpiMoe1 E{(bf16*)(KWS + WS_ACT), (const int*)(KWS + WS_ROUTE + 262144), (const float*)(KWS + WS_ROUTE + 65536), (const float*)(KWS + WS_RSTD)};
            pg8::gemm_phase<pg8::EpiMoe1, pg8::MoeSched<1>, true>(F.lds, D, S, E); SEAM(ph, 11); }
        ++ph;
        if (RUN(ph)) { KA; FRAME; moe_table(F, tb);
            pg8::MoeSched<2> S; S.init(F.G, F.vcu, tb, (const int*)(KWS + WS_ROUTE + 131072), (const int*)(KWS + WS_ROUTE + 262144), KWS + WS_ACT, (const bf16*)(KWS + WS_WDN) + (size_t)l * NE * D * FF);
            pg8::EpiMoe2 E{(bf16*)(KWS + WS_CONTRIB), (const int*)(KWS + WS_ROUTE + 262144)};
            pg8::gemm_phase<pg8::EpiMoe2, pg8::MoeSched<2>, true>(F.lds, FF, S, E); SEAM(ph, 12); }
        ++ph;
        if (l + 1 < NL) { if (RUN(ph)) { KA; FRAME; phase_norm1<1>(F, (const float*)(KWS + WS_X1), (const bf16*)(KWS + WS_CONTRIB), (float*)(KWS + WS_XRES), KIN(I_NMIX) + (size_t)(l + 1) * D, (bf16*)(KWS + WS_H)); SEAM(ph, 13); } ++ph; }
    }
    if (RUN(ph)) { KA; FRAME; phase_norm1<2>(F, (const float*)(KWS + WS_X1), (const bf16*)(KWS + WS_CONTRIB), KOUT, nullptr, nullptr); }
    if (MK_PROBE_MASK != 0 && lbid() == MK_PROBE_BID && ltid() == 0) {
        asm volatile("s_waitcnt vmcnt(0)" ::: "memory"); STAMP(15);
        unsigned long long tot = 0ull;
        for (int k2 = 0; k2 < 32; ++k2) if (k2 != 16 && ((MK_PROBE_MASK >> k2) & 1)) tot += tacc[k2];
        const unsigned long long t_end = wall_clock64() + 4ull * tot;
        while (wall_clock64() < t_end) __builtin_amdgcn_s_sleep(8);
    }
#undef RUN
#undef SEAM
}

#ifndef MK_PER_PHASE
#define MK_PER_PHASE 0
#endif
extern "C" void kernel_launch(void* const* d_in, const int* in_sizes, int n_in, void* d_out, int out_size, void* d_ws, size_t ws_size, hipStream_t stream) {
    static int grid = 0;
    if (grid == 0) {
        if (n_in != 22 || out_size != T * D || ws_size < WS_END) { fprintf(stderr, "kernel_launch: unexpected sizes (n_in %d out %d ws %zu)\n", n_in, out_size, ws_size); grid = -1; return; }
        int dev = 0, cus = 0, per_cu = 0;
        if (hipGetDevice(&dev) != hipSuccess || hipDeviceGetAttribute(&cus, hipDeviceAttributeMultiprocessorCount, dev) != hipSuccess) { grid = -1; return; }
        if (hipFuncSetAttribute((const void*)mk_fwd, hipFuncAttributeMaxDynamicSharedMemorySize, LDS_BYTES) != hipSuccess) { fprintf(stderr, "kernel_launch: hipFuncSetAttribute failed\n"); grid = -1; return; }
        if (hipOccupancyMaxActiveBlocksPerMultiprocessor(&per_cu, (const void*)mk_fwd, 512, LDS_BYTES) != hipSuccess || per_cu < 1) { fprintf(stderr, "kernel_launch: occupancy query says %d\n", per_cu); }
        (void)hipGetLastError();
        grid = cus;
    }
    if (grid < 0) return;
    if (hipMemsetAsync((char*)d_ws + WS_CTL, 0, CTL_ZERO_BYTES, stream) != hipSuccess) return;
    Args a{};
    for (int i = 0; i < 22; ++i) a.in[i] = (const GAS float*)d_in[i];
    a.out = (GAS float*)d_out; a.ws = (GAS unsigned char*)d_ws;
#if MK_PER_PHASE
    const int total = 1 + NL * PH_PER_LAYER + (NL - 1) + 1;
    for (int k = 0; k < total; ++k) { a.ph_lo = k; a.ph_hi = k + 1; a.li = 0; hipLaunchKernelGGL(mk_fwd, dim3(grid), dim3(512), LDS_BYTES, stream, a); }
#else
    a.ph_lo = 0; a.ph_hi = 1000; a.li = 0;
    hipLaunchKernelGGL(mk_fwd, dim3(grid), dim3(512), LDS_BYTES, stream, a);
#endif
    const hipError_t le = hipPeekAtLastError();
    if (le != hipSuccess) fprintf(stderr, "kernel_launch: launch failed: %s\n", hipGetErrorName(le));
}
```

```cpp
#include <hip/hip_runtime.h>
#include <cstdio>
#include <cstdint>

#ifndef MK_PROBE_MASK
#define MK_PROBE_MASK 0
#endif
#ifndef MK_PROBE_BID
#define MK_PROBE_BID 0
#endif
#define GAS __attribute__((address_space(1)))
#define LAS __attribute__((address_space(3)))
typedef unsigned short bf16;
typedef short bf16x8 __attribute__((ext_vector_type(8)));
typedef float f32x4 __attribute__((ext_vector_type(4)));
typedef float f32x2 __attribute__((ext_vector_type(2)));
typedef unsigned u32x4 __attribute__((ext_vector_type(4)));
typedef unsigned u32x2 __attribute__((ext_vector_type(2)));

constexpr int T = 8192, D = 2048, NL = 2, INC = 11048, NPAD = 11264;
constexpr int NE = 32, FF = 512, NCH = T / 64;
constexpr float EPS = 1e-6f, NEGB = -1e30f;
constexpr int C_Q = 0, C_KC = 512, C_VC = 640, C_KS = 768, C_VS = 896, C_KW = 1024, C_VW = 1152;
constexpr int C_HQ = 1280, C_HF = 1792, C_HI = 2304, C_HG = 2816, C_GQ = 3328, C_GK = 3584, C_GV = 3840, C_GR = 4352;
constexpr int C_MG = 4864, C_NG = 11008, C_GA = 11032;

constexpr size_t MiB = 1u << 20;
constexpr size_t WS_CTL = 0, CTL_ZERO_BYTES = 1 * MiB;
constexpr size_t WS_WIN = 2 * MiB;
constexpr size_t WS_WBR = 90 * MiB;
constexpr size_t WS_WOUT = 102 * MiB;
constexpr size_t WS_WGU = 118 * MiB;
constexpr size_t WS_WDN = 374 * MiB;
constexpr size_t WS_H = 502 * MiB;
constexpr size_t WS_P = 534 * MiB;
constexpr size_t WS_OCAT = 710 * MiB;
constexpr size_t WS_PROJ = 734 * MiB;
constexpr size_t WS_MERGED = 830 * MiB;
constexpr size_t WS_X1 = 862 * MiB;
constexpr size_t WS_XRES = 926 * MiB;
constexpr size_t WS_CONTRIB = 990 * MiB;
constexpr size_t WS_ACT = 1054 * MiB;
constexpr size_t WS_QN = 1078 * MiB;
constexpr size_t WS_KV = 1094 * MiB;
constexpr size_t WS_KC = 1118 * MiB;
constexpr size_t WS_ORAW = 1119 * MiB;
constexpr size_t WS_ROUTE = 1151 * MiB;
constexpr size_t WS_SLOC_HG = 1153 * MiB;
constexpr size_t WS_SLOC_GL = 1185 * MiB;
constexpr size_t WS_SPREV_HG = 1201 * MiB;
constexpr size_t WS_SPREV_GL = 1217 * MiB;
constexpr size_t WS_DEC = 1225 * MiB;
constexpr size_t WS_QS = 1226 * MiB;
constexpr size_t WS_KS2 = 1234 * MiB;
constexpr size_t WS_KW2 = 1236 * MiB;
constexpr size_t WS_VST = 1238 * MiB;
constexpr size_t WS_VWT = 1240 * MiB;
constexpr size_t WS_KCB = 1242 * MiB;
constexpr size_t WS_WRT = 1243 * MiB;
constexpr size_t WS_HIST = 1244 * MiB;
constexpr size_t WS_CW = 1245 * MiB;
constexpr size_t WS_RSTD = 1247 * MiB;
constexpr size_t WS_END = 1248 * MiB;
constexpr size_t KV_STRIDE = (size_t)2 * T * 64;
constexpr int CW_BAR = 4096;

constexpr int RING_BYTES = 131072;
constexpr int LDS_BYTES = 147456;
constexpr int MISC_OFF = LDS_BYTES - 2048;

#define LDS_WAIT() asm volatile("s_waitcnt lgkmcnt(0)" ::: "memory")
#define VM_WAIT() asm volatile("s_waitcnt vmcnt(0)" ::: "memory")
#define WSYNC() asm volatile("s_waitcnt lgkmcnt(0)" ::: "memory")

__device__ __forceinline__ unsigned f2bf(float f) { unsigned u = __builtin_bit_cast(unsigned, f); return (u + 0x7fffu + ((u >> 16) & 1u)) >> 16; }
__device__ __forceinline__ unsigned pk2(float lo, float hi) { return f2bf(lo) | (f2bf(hi) << 16); }
__device__ __forceinline__ float bf2f(unsigned b) { return __builtin_bit_cast(float, (b & 0xffffu) << 16); }
__device__ __forceinline__ float bflo(unsigned w) { return __builtin_bit_cast(float, w << 16); }
__device__ __forceinline__ float bfhi(unsigned w) { return __builtin_bit_cast(float, w & 0xffff0000u); }
__device__ __forceinline__ float wave_sum(float v) {
#pragma unroll
    for (int o = 1; o < 64; o <<= 1) v += __shfl_xor(v, o);
    return v;
}
__device__ __forceinline__ float wave_max(float v) {
#pragma unroll
    for (int o = 1; o < 64; o <<= 1) v = fmaxf(v, __shfl_xor(v, o));
    return v;
}
__device__ __forceinline__ int ltid() { int t = threadIdx.x; asm volatile("" : "+v"(t)); return t; }
__device__ __forceinline__ int lbid() { int b = blockIdx.x; asm volatile("" : "+s"(b)); return b; }
typedef __bf16 bf16x2_t __attribute__((ext_vector_type(2)));
__device__ __forceinline__ unsigned pkbf(float lo, float hi) { const f32x2 v = {lo, hi}; return __builtin_bit_cast(unsigned, __builtin_convertvector(v, bf16x2_t)); }
constexpr float LOG2E = 1.4426950408889634f;
__device__ __forceinline__ float sigmoidf_(float x) { return 1.0f / (1.0f + expf(-x)); }
__device__ __forceinline__ float fsig(float x) { return __builtin_amdgcn_rcpf(1.0f + __builtin_amdgcn_exp2f(-LOG2E * x)); }

#define GSTAMP(lds_, slot) do { if (MK_PROBE_MASK != 0 && lbid() == MK_PROBE_BID && ltid() == 0) { volatile LAS unsigned long long* _ta = (volatile LAS unsigned long long*)((lds_) + MISC_OFF + 512); const unsigned long long _n = wall_clock64(); _ta[slot] += _n - _ta[16]; _ta[16] = _n; } } while (0)
#define XB_TMO      128
#define XB_XCNT(j)  (256  + 64 * (j))
#define XB_XSUB(j)  (1280 + 64 * (j))
#define XB_XGEN(j)  (2304 + 64 * (j))
#define XB_TOP      3328
#define XB_TOPGEN   3392
#define XCD_BAR_WORDS 3456
#define XB_SPIN_CAP (1u << 25)

__device__ __forceinline__ unsigned xb_ld(unsigned* p)              { return __hip_atomic_load(p, __ATOMIC_RELAXED, __HIP_MEMORY_SCOPE_AGENT); }
__device__ __forceinline__ unsigned xb_add(unsigned* p, unsigned v) { return __hip_atomic_fetch_add(p, v, __ATOMIC_RELAXED, __HIP_MEMORY_SCOPE_AGENT); }
__device__ __forceinline__ unsigned xb_xcc_id() { return (unsigned)__builtin_amdgcn_s_getreg((3 << 11) | 20) & 0xFu; }
#define XB_SPIN(cond, bar) do { unsigned _sp = 0; while (cond) { __builtin_amdgcn_s_sleep(1); \
    if ((++_sp & 255u) == 0u) { if (xb_ld(&(bar)[XB_TMO])) break; if (_sp > XB_SPIN_CAP) { atomicAdd(&(bar)[XB_TMO], 1u); break; } } } } while (0)

struct XcdBarrier { unsigned* bar; unsigned x; volatile LAS unsigned* st; };

__device__ __forceinline__ XcdBarrier xcd_barrier_post(unsigned* bar, volatile LAS unsigned* st) {
    XcdBarrier b; b.bar = bar; b.x = xb_xcc_id(); b.st = st;
    if (threadIdx.x == 0) (void)xb_add(&bar[XB_XCNT(b.x)], 1u);
    return b;
}
__device__ __forceinline__ void xcd_barrier_complete(unsigned* bar, unsigned x, unsigned& nloc, unsigned& nx) {
    const unsigned G = gridDim.x * gridDim.y * gridDim.z;
    unsigned sum, cnt, mine, sp = 0u;
    for (;;) {
        sum = 0u; cnt = 0u; mine = 0u;
#pragma unroll
        for (unsigned j = 0; j < 16; ++j) { const unsigned c = xb_ld(&bar[XB_XCNT(j)]); sum += c; cnt += (c > 0u) ? 1u : 0u; mine = (j == x) ? c : mine; }
        if (sum == G) break;
        __builtin_amdgcn_s_sleep(1);
        if ((++sp & 255u) == 0u) { if (xb_ld(&bar[XB_TMO])) break; if (sp > XB_SPIN_CAP) { atomicAdd(&bar[XB_TMO], 1u); break; } }
    }
    nloc = mine > 0u ? mine : 1u; nx = cnt > 0u ? cnt : 1u;
}
__device__ __forceinline__ void xcd_barrier(const XcdBarrier& b) {
    asm volatile("s_waitcnt vmcnt(0)" ::: "memory");
    __syncthreads();
    if (threadIdx.x == 0) {
        unsigned* bar = b.bar;
        __builtin_amdgcn_s_waitcnt(0);
        unsigned nloc = b.st[0], nx = b.st[1];
        if (nloc == 0u) { xcd_barrier_complete(bar, b.x, nloc, nx); b.st[0] = nloc; b.st[1] = nx; }
        const unsigned old = xb_add(&bar[XB_XSUB(b.x)], 1u);
        const unsigned gen = old / nloc;
        if (old + 1u == (gen + 1u) * nloc) {
            __builtin_amdgcn_fence(__ATOMIC_RELEASE, "agent");
            asm volatile("s_waitcnt vmcnt(0)" ::: "memory");
            const unsigned og = xb_add(&bar[XB_TOP], 1u);
            const unsigned tg = og / nx;
            if (og + 1u == (tg + 1u) * nx) xb_add(&bar[XB_TOPGEN], 1u);
            else XB_SPIN(xb_ld(&bar[XB_TOPGEN]) == tg, bar);
            __builtin_amdgcn_fence(__ATOMIC_ACQUIRE, "agent");
            xb_add(&bar[XB_XGEN(b.x)], 1u);
            asm volatile("s_waitcnt vmcnt(0)" ::: "memory");
        } else {
            XB_SPIN(xb_ld(&bar[XB_XGEN(b.x)]) == gen, bar);
            __builtin_amdgcn_fence(__ATOMIC_ACQUIRE, "agent");
            asm volatile("s_waitcnt vmcnt(0)" ::: "memory");
        }
    }
    __syncthreads();
}

namespace pg8 {
constexpr int BM = 256, BK = 64, HALF = 128, HTB = HALF * BK * 2, STAGE_BYTES = 8 * HTB, NXCD = 8, WGM = 8;
__host__ __device__ __forceinline__ int lds_byte(int r, int c) { const int st = (r >> 4) * 2 + (c >> 5), rr = r & 15, cc = c & 31, ob = rr * 64 + cc * 2; return st * 1024 + (ob ^ (((ob >> 9) & 1) << 5)); }
__host__ __device__ __forceinline__ void stage_rc(int b, int& R, int& C) { const int st = b / 1024, sb = b % 1024, swz = sb ^ (((sb >> 9) & 1) << 5); R = (st >> 1) * 16 + swz / 64; C = (st & 1) * 32 + (swz % 64) / 2; }
__host__ __device__ __forceinline__ int perm32(int rho) { const int n = rho >> 4, i = rho & 15; return 8 * (i >> 2) + 4 * n + (i & 3); }

struct Unit { int pm, pn, e, nvalid, slot0, half, row0; const char *A0, *A1, *B0, *B1; unsigned va[2][2]; };

__device__ __forceinline__ unsigned cvt_pk_bf16(float lo, float hi) { unsigned r; asm volatile("v_cvt_pk_bf16_f32 %0, %1, %2" : "=v"(r) : "v"(lo), "v"(hi)); return r; }

template <class Epi, class Sched, bool ALIGN_EPI>
__device__ __forceinline__ void gemm_phase(LAS unsigned char* lds, const int K, const Sched& S, const Epi& E) {
    const int tid = ltid(), wid = __builtin_amdgcn_readfirstlane(tid >> 6), lane = tid & 63, wr = wid >> 2, wc = wid & 3, fr = lane & 15, fq = lane >> 4;
    const int nt = K / BK;
    unsigned voffB[2];
#pragma unroll
    for (int i = 0; i < 2; ++i) { int R, C; stage_rc(tid * 16 + i * 8192, R, C); const int Rb = Epi::PERM ? ((R & ~31) + perm32(R & 31)) : R; voffB[i] = (unsigned)(Rb * K + C) * 2u; }
    const size_t kstep = (size_t)(BK * 2);
    const unsigned ldsw = (unsigned)wid * 1024u;
    const int aoff = lds_byte(wr * 64 + fr, fq * 8), boff = lds_byte(wc * 32 + fr, fq * 8);
#define PG8_SA(b, h) (((b) * 2 + (h)) * HTB)
#define PG8_SB(b, h) ((4 + (b) * 2 + (h)) * HTB)
#define PG8_STAGE(bufoff, gbase, voff) do { _Pragma("unroll") for (int _i = 0; _i < 2; ++_i) \
        __builtin_amdgcn_global_load_lds((const unsigned*)((const char*)(gbase) + (voff)[_i]), (LAS unsigned*)(lds + (bufoff) + ldsw + _i * 8192), 16, 0, 0); } while (0)
#define PG8_LDA(dst, b, h) do { _Pragma("unroll") for (int m = 0; m < 4; ++m) _Pragma("unroll") for (int k = 0; k < 2; ++k) dst[m][k] = *(const LAS bf16x8*)(lds + PG8_SA(b, h) + aoff + m * 2048 + k * 1024); } while (0)
#define PG8_LDB(dst, b, h) do { _Pragma("unroll") for (int n = 0; n < 2; ++n) _Pragma("unroll") for (int k = 0; k < 2; ++k) dst[n][k] = *(const LAS bf16x8*)(lds + PG8_SB(b, h) + boff + n * 2048 + k * 1024); } while (0)
#define PG8_MMA(ai, bj, At, Bt) do { __builtin_amdgcn_s_setprio(1); _Pragma("unroll") for (int m = 0; m < 4; ++m) _Pragma("unroll") for (int n = 0; n < 2; ++n) _Pragma("unroll") for (int k = 0; k < 2; ++k) \
        acc[ai][bj][m][n] = __builtin_amdgcn_mfma_f32_16x16x32_bf16(Bt[n][k], At[m][k], acc[ai][bj][m][n], 0, 0, 0); __builtin_amdgcn_s_setprio(0); } while (0)
#define PG8_WAIT_V(n) asm volatile("s_waitcnt vmcnt(" #n ")" ::: "memory")
#define PG8_WAIT_L(n) asm volatile("s_waitcnt lgkmcnt(" #n ")" ::: "memory")
#define PG8_BAR __builtin_amdgcn_s_barrier()
#define PG8_SCHED __builtin_amdgcn_sched_barrier(0)
#define VA(u, h) (Sched::GATHER ? (u).va[h] : S.va)
    Unit cur, nxt; int ui = 0;
    if (!S.next(0, cur)) return;
    if (S.probe) GSTAMP(lds, 27);
    f32x4 acc[2][2][4][2];
#pragma unroll
    for (int a = 0; a < 2; ++a)
#pragma unroll
        for (int b = 0; b < 2; ++b)
#pragma unroll
            for (int m = 0; m < 4; ++m)
#pragma unroll
                for (int n = 0; n < 2; ++n) acc[a][b][m][n] = (f32x4){0.f, 0.f, 0.f, 0.f};
    bf16x8 At[4][2], B0[2][2], B1[2][2];
    PG8_STAGE(PG8_SB(0, 0), cur.B0, voffB); PG8_STAGE(PG8_SB(0, 1), cur.B1, voffB); PG8_STAGE(PG8_SA(0, 0), cur.A0, VA(cur, 0)); PG8_STAGE(PG8_SA(0, 1), cur.A1, VA(cur, 1));
    if (wr == 1) PG8_BAR;
    PG8_WAIT_V(2); PG8_BAR;
    PG8_STAGE(PG8_SB(1, 0), cur.B0 + kstep, voffB); PG8_STAGE(PG8_SA(1, 0), cur.A0 + kstep, VA(cur, 0)); PG8_STAGE(PG8_SB(1, 1), cur.B1 + kstep, voffB);
    PG8_WAIT_V(6); PG8_BAR;
    for (;;) {
        const bool has_next = S.next(ui + 1, nxt);
        if (!has_next) nxt = cur;
        for (int t = 0; t < nt; t += 2) {
            const bool last = (t == nt - 2);
            const char* a1h1 = cur.A1 + (size_t)(t + 1) * kstep;
            const char* a2h0 = last ? nxt.A0 : cur.A0 + (size_t)(t + 2) * kstep; const char* a2h1 = last ? nxt.A1 : cur.A1 + (size_t)(t + 2) * kstep;
            const char* b2h0 = last ? nxt.B0 : cur.B0 + (size_t)(t + 2) * kstep; const char* b2h1 = last ? nxt.B1 : cur.B1 + (size_t)(t + 2) * kstep;
            unsigned v2h0[2], v2h1[2];
#pragma unroll
            for (int i = 0; i < 2; ++i) { if constexpr (Sched::GATHER) { v2h0[i] = last ? nxt.va[0][i] : cur.va[0][i]; v2h1[i] = last ? nxt.va[1][i] : cur.va[1][i]; } else { v2h0[i] = S.va[i]; v2h1[i] = S.va[i]; } }
            PG8_LDB(B0, 0, 0); PG8_LDB(B1, 0, 1); PG8_SCHED; PG8_LDA(At, 0, 0); PG8_STAGE(PG8_SA(1, 1), a1h1, VA(cur, 1));
            PG8_WAIT_V(8); PG8_WAIT_L(0); PG8_BAR; PG8_MMA(0, 0, At, B0); PG8_MMA(0, 1, At, B1); PG8_BAR; PG8_SCHED;
            if (!cur.half) PG8_LDA(At, 0, 1);
            PG8_STAGE(PG8_SB(0, 0), b2h0, voffB); PG8_STAGE(PG8_SB(0, 1), b2h1, voffB); PG8_STAGE(PG8_SA(0, 0), a2h0, v2h0);
            PG8_WAIT_V(8); PG8_WAIT_L(0); PG8_BAR; if (!cur.half) { PG8_MMA(1, 0, At, B0); PG8_MMA(1, 1, At, B1); } PG8_BAR; PG8_SCHED;
            PG8_LDB(B0, 1, 0); PG8_LDB(B1, 1, 1); PG8_SCHED; PG8_LDA(At, 1, 0); PG8_STAGE(PG8_SA(0, 1), a2h1, v2h1);
            PG8_WAIT_V(8); PG8_WAIT_L(0); PG8_BAR; PG8_MMA(0, 0, At, B0); PG8_MMA(0, 1, At, B1); PG8_BAR; PG8_SCHED;
            if (!cur.half) PG8_LDA(At, 1, 1);
            PG8_STAGE(PG8_SB(1, 0), b2h0 + kstep, voffB); PG8_STAGE(PG8_SB(1, 1), b2h1 + kstep, voffB); PG8_STAGE(PG8_SA(1, 0), a2h0 + kstep, v2h0);
            PG8_WAIT_V(8); PG8_WAIT_L(0); PG8_BAR; if (!cur.half) { PG8_MMA(1, 0, At, B0); PG8_MMA(1, 1, At, B1); } PG8_BAR; PG8_SCHED;
        }
        if (S.probe) GSTAMP(lds, 25);
        if constexpr (ALIGN_EPI) { if (wr == 0) PG8_BAR; }
        if constexpr (Sched::CHAIN) E.chain(acc, cur, wr, wc, fr, fq); else E(acc, cur, wr, wc, fr, fq);
        if (S.probe) { asm volatile("s_waitcnt vmcnt(0)" ::: "memory"); GSTAMP(lds, 26); }
        if (!has_next) break;
        if (!Sched::CHAIN || nxt.e == 0) {
#pragma unroll
        for (int a = 0; a < 2; ++a)
#pragma unroll
            for (int b = 0; b < 2; ++b)
#pragma unroll
                for (int m = 0; m < 4; ++m)
#pragma unroll
                    for (int n = 0; n < 2; ++n) acc[a][b][m][n] = (f32x4){0.f, 0.f, 0.f, 0.f};
        }
        cur = nxt; ++ui;
        if constexpr (ALIGN_EPI) { if (wr == 1) PG8_BAR; }
    }
    PG8_WAIT_V(0);
    if constexpr (!ALIGN_EPI) { if (wr == 0) PG8_BAR; }
    PG8_BAR;
#undef VA
#undef PG8_SA
#undef PG8_SB
#undef PG8_STAGE
#undef PG8_LDA
#undef PG8_LDB
#undef PG8_MMA
#undef PG8_WAIT_V
#undef PG8_WAIT_L
#undef PG8_BAR
#undef PG8_SCHED
}

struct PlainSched {
    static constexpr bool GATHER = false, CHAIN = false;
    int nM, nN, nwg, G, c, lda, K, nNh, probe = 0; const char* A; const char* Bt; unsigned va[2];
    __device__ __forceinline__ void init(const bf16* A_, int lda_, const bf16* Bt_, int M, int N, int K_, int G_, int c_, int nNh_ = 0) {
        nM = M / BM; nN = N / BM - nNh_; nNh = nNh_; nwg = nM * nN; G = G_; c = c_; lda = lda_; K = K_; A = (const char*)A_; Bt = (const char*)Bt_;
#pragma unroll
        for (int i = 0; i < 2; ++i) { int R, C; stage_rc((int)ltid() * 16 + i * 8192, R, C); va[i] = (unsigned)(R * lda + C) * 2u; }
    }
    __device__ __forceinline__ bool next(int i, Unit& u) const {
        const long L = (long)i * G + c;
        u.e = 0; u.nvalid = 256; u.slot0 = 0; u.va[0][0] = 0u; u.va[0][1] = 0u; u.va[1][0] = 0u; u.va[1][1] = 0u;
        if (L >= nwg) { const int hL = (int)(L - nwg); if (hL >= 2 * nM * nNh) return false;
            const int hm = hL / nNh, pn = nN + hL % nNh;
            u.pm = hm >> 1; u.pn = pn; u.half = 1; u.row0 = hm * HALF;
            u.A0 = A + (size_t)hm * HALF * lda * 2; u.A1 = u.A0;
            u.B0 = Bt + (size_t)pn * BM * K * 2; u.B1 = u.B0 + (size_t)HALF * K * 2;
            return true; }
        int wgid = (int)L; { const int q = nwg / NXCD, r = nwg % NXCD, xcd = wgid % NXCD, off = wgid / NXCD; wgid = (xcd < r ? xcd * (q + 1) : r * (q + 1) + (xcd - r) * q) + off; }
        const int nig = WGM * nN, gid = wgid / nig, fm = gid * WGM, gsz = (nM - fm) < WGM ? (nM - fm) : WGM;
        u.pm = fm + ((wgid % nig) % gsz); u.pn = (wgid % nig) / gsz; u.half = 0; u.row0 = u.pm * BM;
        u.A0 = A + (size_t)u.pm * BM * lda * 2; u.A1 = u.A0 + (size_t)HALF * lda * 2;
        u.B0 = Bt + (size_t)u.pn * BM * K * 2; u.B1 = u.B0 + (size_t)HALF * K * 2;
        return true;
    }
};
struct BranchSched {
    static constexpr bool GATHER = false, CHAIN = true;
    int G, c, probe = 0; const char* A; const char* Bt; unsigned va[2];
    __device__ __forceinline__ void init(const bf16* OC, const bf16* WBRl, int G_, int c_) { G = G_; c = c_; A = (const char*)OC; Bt = (const char*)WBRl;
#pragma unroll
        for (int i = 0; i < 2; ++i) { int R, C; stage_rc((int)ltid() * 16 + i * 8192, R, C); va[i] = (unsigned)(R * 1536 + C) * 2u; } }
    __device__ __forceinline__ bool next(int i, Unit& u) const {
        const int tile = (i / 3) * G + c, n = i % 3; if (tile >= (T / BM) * (D / BM)) return false;
        int wgid = tile; { const int nwg = 256, q = nwg / NXCD, xcd = wgid % NXCD, off = wgid / NXCD; wgid = xcd * q + off; }
        const int nN = D / BM, nig = WGM * nN, gid = wgid / nig, fm = gid * WGM;
        u.pm = fm + ((wgid % nig) % WGM); u.pn = (wgid % nig) / WGM; u.e = n; u.nvalid = 256; u.slot0 = 0; u.half = 0; u.row0 = u.pm * BM;
        u.va[0][0] = 0u; u.va[0][1] = 0u; u.va[1][0] = 0u; u.va[1][1] = 0u;
        u.A0 = A + (size_t)u.pm * BM * 1536 * 2 + (size_t)n * 512 * 2; u.A1 = u.A0 + (size_t)HALF * 1536 * 2;
        u.B0 = Bt + (size_t)n * D * 512 * 2 + (size_t)u.pn * BM * 512 * 2; u.B1 = u.B0 + (size_t)HALF * 512 * 2;
        return true;
    }
};
template <int MODE> struct MoeSched {
    static constexpr int NPN = MODE == 1 ? 4 : 8;
    static constexpr bool GATHER = MODE == 1, CHAIN = false;
    int G, c, probe = 0; const LAS int* tb; const int* cnt; const int* list; const char* A; const char* W; unsigned va[2];
    __device__ __forceinline__ void init(int G_, int c_, const LAS int* tb_, const int* cnt_, const int* list_, const void* A_, const void* W_) {
        G = G_; c = c_; tb = tb_; cnt = cnt_; list = list_; A = (const char*)A_; W = (const char*)W_;
#pragma unroll
        for (int i = 0; i < 2; ++i) { int R, C; stage_rc((int)ltid() * 16 + i * 8192, R, C); va[i] = (unsigned)(R * FF + C) * 2u; }
    }
    __device__ __forceinline__ bool next(int i, Unit& u) const {
        const int L = i * G + c, nfull = __builtin_amdgcn_readfirstlane(tb[33 + NE]), nhalf = __builtin_amdgcn_readfirstlane(tb[66 + NE]);
        if (L >= (nfull + nhalf) * NPN) return false;
        const bool half = L >= nfull * NPN; const int Lr = half ? L - nfull * NPN : L, base = half ? 66 : 33;
        const int tq = Lr / NPN, pn = Lr % NPN; int e = 0;
        while (e < NE - 1 && __builtin_amdgcn_readfirstlane(tb[base + e + 1]) <= tq) ++e;
        const int ne = __builtin_amdgcn_readfirstlane(cnt[e]);
        const int pm = half ? (ne - 1) / 256 : tq - __builtin_amdgcn_readfirstlane(tb[33 + e]);
        const int tl = __builtin_amdgcn_readfirstlane(tb[e]) + pm;
        u.pm = pm; u.pn = pn; u.e = e; u.nvalid = ne - pm * 256; u.slot0 = tl * 256; u.half = half ? 1 : 0; u.row0 = 0;
        if (MODE == 1) {
            u.A0 = A; u.A1 = A;
#pragma unroll
            for (int h = 0; h < 2; ++h)
#pragma unroll
                for (int k = 0; k < 2; ++k) { int Rk, Ck; stage_rc((int)ltid() * 16 + k * 8192, Rk, Ck); int idx = pm * 256 + h * 128 + Rk; idx = idx < ne ? idx : ne - 1; const int entry = list[e * 8192 + idx]; u.va[h][k] = (unsigned)(entry >> 1) * (unsigned)(D * 2) + (unsigned)Ck * 2u; }
            const char* we = W + (size_t)e * 1024 * D * 2;
            u.B0 = we + (size_t)(pn * 128) * D * 2; u.B1 = we + (size_t)(512 + pn * 128) * D * 2;
        } else {
            u.va[0][0] = 0u; u.va[0][1] = 0u; u.va[1][0] = 0u; u.va[1][1] = 0u;
            u.A0 = A + (size_t)tl * 256 * FF * 2; u.A1 = u.A0 + (size_t)HALF * FF * 2;
            const char* we = W + (size_t)e * D * FF * 2;
            u.B0 = we + (size_t)(pn * 256) * FF * 2; u.B1 = u.B0 + (size_t)HALF * FF * 2;
        }
        return true;
    }
};

struct EpiBf16 {
    static constexpr bool PERM = true;
    bf16* O; int ldc;
    __device__ __forceinline__ void operator()(const f32x4 (&acc)[2][2][4][2], const Unit& u, int wr, int wc, int fr, int fq) const {
        const int row0 = u.row0 + wr * 64 + fr, col0 = u.pn * BM + wc * 32 + 8 * fq;
#pragma unroll
        for (int ai = 0; ai < 2; ++ai) if (ai == 0 || !u.half)
#pragma unroll
            for (int m = 0; m < 4; ++m) { bf16* rowp = O + (size_t)(row0 + ai * HALF + m * 16) * ldc + col0;
#pragma unroll
                for (int bj = 0; bj < 2; ++bj) { const f32x4 v0 = acc[ai][bj][m][0], v1 = acc[ai][bj][m][1];
                    u32x4 w; w.x = cvt_pk_bf16(v0[0], v0[1]); w.y = cvt_pk_bf16(v0[2], v0[3]); w.z = cvt_pk_bf16(v1[0], v1[1]); w.w = cvt_pk_bf16(v1[2], v1[3]);
                    *(u32x4*)(rowp + bj * HALF) = w; } }
    }
};
struct EpiMerge {
    static constexpr bool PERM = true;
    bf16* MG; const bf16* gate0;
    __device__ __forceinline__ void operator()(const f32x4 (&acc)[2][2][4][2], const Unit& u, int wr, int wc, int fr, int fq) const {}
    __device__ __forceinline__ void chain(f32x4 (&acc)[2][2][4][2], const Unit& u, int wr, int wc, int fr, int fq) const {
        const int row0 = u.row0 + wr * 64 + fr, col0 = u.pn * BM + wc * 32 + 8 * fq; const bool last = u.e == 2;
        const bf16* __restrict__ ga = gate0 + (size_t)u.e * D; const bf16* __restrict__ gb = gate0 + (size_t)(last ? 2 : u.e + 1) * D;
        bf16* __restrict__ MGp = MG;
        u32x4 qa[2][2], qb[2][2];
#define EMG_LOAD(buf, g) do { const size_t row_ = (size_t)(row0 + ((g) >> 2) * HALF + ((g) & 3) * 16); \
            _Pragma("unroll") for (int bj_ = 0; bj_ < 2; ++bj_) { qa[buf][bj_] = *(const u32x4*)(ga + row_ * NPAD + col0 + bj_ * HALF); qb[buf][bj_] = *(const u32x4*)(gb + row_ * NPAD + col0 + bj_ * HALF); } } while (0)
        EMG_LOAD(0, 0);
#pragma unroll
        for (int g = 0; g < 8; ++g) { if (g + 1 < 8) EMG_LOAD((g + 1) & 1, g + 1);
            const int ai = g >> 2, m = g & 3; const size_t row = (size_t)(row0 + ai * HALF + m * 16);
#pragma unroll
            for (int bj = 0; bj < 2; ++bj) { float o[8];
                const unsigned wa[4] = {qa[g & 1][bj].x, qa[g & 1][bj].y, qa[g & 1][bj].z, qa[g & 1][bj].w}, wb[4] = {qb[g & 1][bj].x, qb[g & 1][bj].y, qb[g & 1][bj].z, qb[g & 1][bj].w};
#pragma unroll
                for (int k = 0; k < 8; ++k) { const float a = acc[ai][bj][m][k >> 2][k & 3];
                    const float xa = __builtin_bit_cast(float, (k & 1) ? (wa[k >> 1] & 0xffff0000u) : (wa[k >> 1] << 16)), xb = __builtin_bit_cast(float, (k & 1) ? (wb[k >> 1] & 0xffff0000u) : (wb[k >> 1] << 16));
                    const float ea = __builtin_amdgcn_exp2f(-LOG2E * xa), eb = __builtin_amdgcn_exp2f(-LOG2E * xb);
                    const float f = (last ? 1.0f : 1.0f + eb) * __builtin_amdgcn_rcpf(1.0f + ea);
                    o[k] = a * f; acc[ai][bj][m][k >> 2][k & 3] = o[k]; }
                if (last) { u32x4 w; w.x = cvt_pk_bf16(o[0], o[1]); w.y = cvt_pk_bf16(o[2], o[3]); w.z = cvt_pk_bf16(o[4], o[5]); w.w = cvt_pk_bf16(o[6], o[7]);
                    *(u32x4*)(MGp + row * D + col0 + bj * HALF) = w; } } }
#undef EMG_LOAD
    }
};
struct EpiResF32 {
    static constexpr bool PERM = false;
    const float* R; float* O; int ldc;
    __device__ __forceinline__ void operator()(const f32x4 (&acc)[2][2][4][2], const Unit& u, int wr, int wc, int fr, int fq) const {
        const int row0 = u.row0 + wr * 64 + fr, col0 = u.pn * BM + wc * 32 + 4 * fq;
        const float* __restrict__ Rp = R; float* __restrict__ Op = O;
        f32x4 rv[2][4];
#define ERES_LOAD(buf, g) do { const size_t off_ = (size_t)(row0 + ((g) >> 2) * HALF + ((g) & 3) * 16) * ldc + col0; \
            _Pragma("unroll") for (int q_ = 0; q_ < 4; ++q_) rv[buf][q_] = *(const f32x4*)(Rp + off_ + (q_ >> 1) * HALF + (q_ & 1) * 16); } while (0)
        ERES_LOAD(0, 0);
#pragma unroll
        for (int g = 0; g < 8; ++g) { if (g + 1 < 8) ERES_LOAD((g + 1) & 1, g + 1);
            const int ai = g >> 2, m = g & 3; const size_t off = (size_t)(row0 + ai * HALF + m * 16) * ldc + col0;
            if (ai == 0 || !u.half) {
#pragma unroll
                for (int q = 0; q < 4; ++q) *(f32x4*)(Op + off + (q >> 1) * HALF + (q & 1) * 16) = acc[ai][q >> 1][m][q & 1] + rv[g & 1][q]; } }
#undef ERES_LOAD
    }
};
struct EpiMoe1 {
    static constexpr bool PERM = true;
    bf16* ACT; const int* list; const float* ew; const float* rstd;
    __device__ __forceinline__ void operator()(const f32x4 (&acc)[2][2][4][2], const Unit& u, int wr, int wc, int fr, int fq) const {
        const int col0 = u.pn * 128 + wc * 32 + 8 * fq;
#pragma unroll
        for (int ai = 0; ai < 2; ++ai) if (ai == 0 || !u.half)
#pragma unroll
            for (int m = 0; m < 4; ++m) { const int r = ai * HALF + wr * 64 + m * 16 + fr; float w = 0.f, rsd = 0.f;
                if (r < u.nvalid) { const int entry = list[u.e * 8192 + u.pm * 256 + r]; w = ew[entry]; rsd = rstd[entry >> 1]; }
                float o[8];
#pragma unroll
                for (int n = 0; n < 2; ++n)
#pragma unroll
                    for (int j = 0; j < 4; ++j) { const float g = acc[ai][0][m][n][j] * rsd, up = acc[ai][1][m][n][j] * rsd; o[n * 4 + j] = g * fsig(g) * up * w; }
                u32x4 pk; pk.x = cvt_pk_bf16(o[0], o[1]); pk.y = cvt_pk_bf16(o[2], o[3]); pk.z = cvt_pk_bf16(o[4], o[5]); pk.w = cvt_pk_bf16(o[6], o[7]);
                *(u32x4*)(ACT + (size_t)(u.slot0 + r) * FF + col0) = pk; }
    }
};
struct EpiMoe2 {
    static constexpr bool PERM = true;
    bf16* CO; const int* list;
    __device__ __forceinline__ void operator()(const f32x4 (&acc)[2][2][4][2], const Unit& u, int wr, int wc, int fr, int fq) const {
        const int col0 = u.pn * BM + wc * 32 + 8 * fq;
#pragma unroll
        for (int ai = 0; ai < 2; ++ai) if (ai == 0 || !u.half)
#pragma unroll
            for (int m = 0; m < 4; ++m) { const int r = ai * HALF + wr * 64 + m * 16 + fr;
                if (r < u.nvalid) { const int entry = list[u.e * 8192 + u.pm * 256 + r]; bf16* rowp = CO + (size_t)entry * D + col0;
#pragma unroll
                    for (int bj = 0; bj < 2; ++bj) { const f32x4 v0 = acc[ai][bj][m][0], v1 = acc[ai][bj][m][1];
                        u32x4 w; w.x = cvt_pk_bf16(v0[0], v0[1]); w.y = cvt_pk_bf16(v0[2], v0[3]); w.z = cvt_pk_bf16(v1[0], v1[1]); w.w = cvt_pk_bf16(v1[2], v1[3]);
                        *(u32x4*)(rowp + bj * HALF) = w; } } }
    }
};
}

struct Frame {
    LAS unsigned char* lds; volatile LAS unsigned* MISC;
    int tid, lane, wave, vcu, G, gw, NGW, bid;
};
struct Args { const GAS float* in[22]; GAS float* out; GAS unsigned char* ws; int ph_lo, ph_hi, li, pad; };
typedef const __attribute__((address_space(4))) Args KArgs;
__device__ __forceinline__ KArgs* ka_fresh() { unsigned long long p = (unsigned long long)__builtin_amdgcn_kernarg_segment_ptr(); asm volatile("" : "+s"(p)); return (KArgs*)p; }
#define KA KArgs* const ka = ka_fresh()
#define KIN(i) ((const float*)ka->in[i])
#define KWS ((unsigned char*)ka->ws)
#define KOUT ((float*)ka->out)
enum { I_X = 0, I_NMIX, I_WIN, I_PE, I_W1, I_W2, I_QN, I_KN, I_LB, I_HGN, I_WA2, I_BA, I_GLAN, I_WBR, I_WOUT, I_NFFN, I_WGRP, I_BGRP, I_WEXP, I_BEXP, I_WGU, I_WDN };

__device__ __forceinline__ void tr_item(const float* W, size_t ldw, int c0, int nv, bf16* WT, size_t ldt, int r0, int k0, LAS float* scr, int lane) {
    const int nn = lane & 31;
    float tv[32];
#pragma unroll
    for (int i = 0; i < 32; ++i) { const int kk = 2 * i + (lane >> 5); tv[i] = nn < nv ? __builtin_nontemporal_load(W + (size_t)(k0 + kk) * ldw + c0 + nn) : 0.f; }
#pragma unroll
    for (int i = 0; i < 32; ++i) { const int kk = 2 * i + (lane >> 5); scr[kk * 33 + nn] = tv[i]; }
    LDS_WAIT();
    const int c = lane & 7;
#pragma unroll
    for (int j = 0; j < 4; ++j) { const int n = (lane >> 3) + 8 * j; const LAS float* s = scr + (8 * c) * 33 + n;
        u32x4 o; o.x = pk2(s[0 * 33], s[1 * 33]); o.y = pk2(s[2 * 33], s[3 * 33]); o.z = pk2(s[4 * 33], s[5 * 33]); o.w = pk2(s[6 * 33], s[7 * 33]);
        if (n < nv) __builtin_nontemporal_store(o, (u32x4*)(WT + (size_t)(r0 + n) * ldt + k0 + 8 * c)); }
    LDS_WAIT();
}
__device__ __forceinline__ void phase_prologue(Frame& F) {
    KA;
    {
      bf16* W1T = (bf16*)(KWS + WS_CW); bf16* W2T = (bf16*)(KWS + WS_CW + 1048576); float* B1 = (float*)(KWS + WS_CW + 1572864);
      for (int i = F.bid * 512 + F.tid; i < NL * 2 * 64 * 2048; i += F.G * 512) { const int lk = i / (64 * 2048), j = (i / 2048) % 64, c = i % 2048; W1T[i] = (bf16)f2bf(KIN(I_W1)[((size_t)lk * 2048 + c) * 64 + j]); }
      for (int i = F.bid * 512 + F.tid; i < NL * 2 * 64 * 64; i += F.G * 512) { const int lk = i / 4096, j2 = (i / 64) % 64, j = i % 64; W2T[i] = (bf16)f2bf(KIN(I_W2)[((size_t)lk * 64 + j) * 64 + j2]); }
      if (F.bid < NL * 2) { const int lk = F.bid, j = F.tid & 63, part = F.tid >> 6; float a = 0.f;
#pragma unroll 8
          for (int c = part * 256; c < part * 256 + 256; ++c) a += KIN(I_PE)[(size_t)lk * 2048 + c] * KIN(I_W1)[((size_t)lk * 2048 + c) * 64 + j];
          LAS float* rd = (LAS float*)F.lds; rd[F.tid] = a; __syncthreads();
          if (F.tid < 64) { float t2 = 0.f;
#pragma unroll
              for (int p = 0; p < 8; ++p) t2 += rd[p * 64 + F.tid];
              B1[lk * 64 + F.tid] = t2; }
          __syncthreads(); } }
    { float* WRT = (float*)(KWS + WS_WRT);
      for (int i = F.bid * 512 + F.tid; i < NL * 48 * D; i += F.G * 512) { const int l = i / (48 * D), n = (i / D) % 48, k = i % D; const float g = KIN(I_NFFN)[l * D + k];
          WRT[i] = n < 32 ? g * KIN(I_WEXP)[((size_t)l * D + k) * 32 + n] : (n < 36 ? g * KIN(I_WGRP)[((size_t)l * D + k) * 4 + (n - 32)] : 0.f); } }
    LAS float* scr = (LAS float*)(F.lds + F.wave * 16384);
    constexpr int IT_WIN = 32 * 346, IT_WBR = 3 * 8 * 64, IT_WOUT = 32 * 64, IT_WGU = 32 * 32 * 32, IT_WDN = 32 * 8 * 64, IT_L = IT_WIN + IT_WBR + IT_WOUT + IT_WGU + IT_WDN;
    for (int it = F.gw; it < NL * IT_L; it += F.NGW) {
        const int l = it / IT_L; int r = it % IT_L;
        if (r < IT_WIN) { const int kb = r / 346, nb = r % 346; int src, dst, nv = 32;
            if (nb < 40) { src = nb * 32; dst = nb * 32; }
            else if (nb == 40) { src = 1280; dst = C_NG; nv = 24; }
            else if (nb < 153) { src = 1304 + 32 * (nb - 41); dst = 1280 + 32 * (nb - 41); }
            else if (nb == 153) { src = 4888; dst = C_GA; nv = 16; }
            else { src = 4904 + 32 * (nb - 154); dst = C_MG + 32 * (nb - 154); }
            tr_item(KIN(I_WIN) + (size_t)l * D * INC, INC, src, nv, (bf16*)(KWS + WS_WIN) + (size_t)l * NPAD * D, D, dst, kb * 64, scr, F.lane); continue; }
        r -= IT_WIN;
        if (r < IT_WBR) { const int n = r / 512, q = r % 512, kb = q / 64, nb = q % 64;
            tr_item(KIN(I_WBR) + ((size_t)l * 3 + n) * 512 * D, D, nb * 32, 32, (bf16*)(KWS + WS_WBR) + ((size_t)l * 3 + n) * D * 512, 512, nb * 32, kb * 64, scr, F.lane); continue; }
        r -= IT_WBR;
        if (r < IT_WOUT) { const int kb = r / 64, nb = r % 64;
            tr_item(KIN(I_WOUT) + (size_t)l * D * D, D, nb * 32, 32, (bf16*)(KWS + WS_WOUT) + (size_t)l * D * D, D, nb * 32, kb * 64, scr, F.lane); continue; }
        r -= IT_WOUT;
        if (r < IT_WGU) { const int e = r / 1024, q = r % 1024, kb = q / 32, nb = q % 32;
            tr_item(KIN(I_WGU) + ((size_t)l * NE + e) * D * 1024, 1024, nb * 32, 32, (bf16*)(KWS + WS_WGU) + ((size_t)l * NE + e) * 1024 * D, D, nb * 32, kb * 64, scr, F.lane); continue; }
        r -= IT_WGU;
        { const int e = r / 512, q = r % 512, kb = q / 64, nb = q % 64;
            tr_item(KIN(I_WDN) + ((size_t)l * NE + e) * FF * D, D, nb * 32, 32, (bf16*)(KWS + WS_WDN) + ((size_t)l * NE + e) * D * FF, FF, nb * 32, kb * 64, scr, F.lane); }
    }
}

template <int MODE> __device__ __forceinline__ void phase_norm1(Frame& F, const float* xin, const bf16* contrib, float* xout, const float* gain, bf16* H) {
    for (int t0 = F.gw; t0 < T; t0 += 2 * F.NGW) {
        f32x4 v[2][8]; float ss[2] = {0.f, 0.f};
#pragma unroll
        for (int rr = 0; rr < 2; ++rr) { const int t = t0 + rr * F.NGW; if (t < T) {
            const f32x4* xr = (const f32x4*)(xin + (size_t)t * D) + F.lane;
#pragma unroll
            for (int j = 0; j < 8; ++j) v[rr][j] = xr[64 * j]; } }
        u32x2 c0[2][8], c1[2][8];
        if (MODE != 0) {
#pragma unroll
            for (int rr = 0; rr < 2; ++rr) { const int t = t0 + rr * F.NGW; if (t < T) {
#pragma unroll
                for (int j = 0; j < 8; ++j) { c0[rr][j] = *((const u32x2*)(contrib + (size_t)(2 * t) * D) + F.lane + 64 * j); c1[rr][j] = *((const u32x2*)(contrib + (size_t)(2 * t + 1) * D) + F.lane + 64 * j); } } } }
#pragma unroll
        for (int rr = 0; rr < 2; ++rr) { const int t = t0 + rr * F.NGW; if (t < T) {
#pragma unroll
            for (int j = 0; j < 8; ++j) {
                if (MODE != 0) { v[rr][j].x += bflo(c0[rr][j].x) + bflo(c1[rr][j].x); v[rr][j].y += bfhi(c0[rr][j].x) + bfhi(c1[rr][j].x); v[rr][j].z += bflo(c0[rr][j].y) + bflo(c1[rr][j].y); v[rr][j].w += bfhi(c0[rr][j].y) + bfhi(c1[rr][j].y);
                    *((f32x4*)(xout + (size_t)t * D) + F.lane + 64 * j) = v[rr][j]; }
                ss[rr] += v[rr][j].x * v[rr][j].x + v[rr][j].y * v[rr][j].y + v[rr][j].z * v[rr][j].z + v[rr][j].w * v[rr][j].w; } } }
        if (MODE != 2) {
#pragma unroll
            for (int rr = 0; rr < 2; ++rr) { const int t = t0 + rr * F.NGW; if (t < T) {
                const float rstd = 1.0f / sqrtf(wave_sum(ss[rr]) * (1.0f / D) + EPS);
#pragma unroll
                for (int j = 0; j < 8; ++j) { const f32x4 g = *((const f32x4*)gain + F.lane + 64 * j);
                    u32x2 o; o.x = pkbf(v[rr][j].x * rstd * g.x, v[rr][j].y * rstd * g.y); o.y = pkbf(v[rr][j].z * rstd * g.z, v[rr][j].w * rstd * g.w);
                    *((u32x2*)(H + (size_t)t * D) + F.lane + 64 * j) = o; } } }
        }
    }
}

__device__ __forceinline__ void phase_prep(Frame& F, int l) {
    KA;
    const bf16* P = (const bf16*)(KWS + WS_P);
    float* QN = (float*)(KWS + WS_QN); float* KV = (float*)(KWS + WS_KV);
    const float* qg = KIN(I_QN) + l * 64; const float* kg = KIN(I_KN) + l * 192;
    for (int it = F.gw; it < T * 20; it += F.NGW) {
        const int t = it / 20, v = it % 20;
        float x = bf2f(P[(size_t)t * NPAD + v * 64 + F.lane]);
        const bool isq = v < 8, nk1 = (v == 12 || v == 13), nk2 = (v == 16 || v == 17);
        if (isq || nk1 || nk2) { const float ss = wave_sum(x * x); const float g = isq ? qg[F.lane] : (nk1 ? kg[64 + F.lane] : kg[128 + F.lane]); x = x * (1.0f / sqrtf(ss * (1.0f / 64.0f) + EPS)) * g; }
        if (isq) QN[((size_t)v * T + t) * 64 + F.lane] = x;
        else { const int w = v - 8, tens = w >> 1, g = w & 1; KV[(size_t)tens * KV_STRIDE + ((size_t)g * T + t) * 64 + F.lane] = x; }
    }
}
__device__ __forceinline__ float gelu_tanh(float x) { const float u = 0.7978845608028654f * (x + 0.044715f * x * x * x); return 0.5f * x * (1.0f + tanhf(u)); }
__device__ __forceinline__ void phase_compress(Frame& F, int l) {
    KA;
    LAS float* av = (LAS float*)(F.lds + F.wave * 16384);
    const float* KV = (const float*)(KWS + WS_KV); float* KC = (float*)(KWS + WS_KC);
    for (int it = F.gw; it < 2 * 2 * 511; it += F.NGW) {
        const int kind = it / 1022, q = it % 1022, g = q / 511, n = q % 511;
        const float* src = KV + (size_t)kind * KV_STRIDE + ((size_t)g * T + 16 * n) * 64;
        const float* pe = KIN(I_PE) + ((size_t)l * 2 + kind) * 2048;
        const float* w1 = KIN(I_W1) + ((size_t)l * 2 + kind) * 2048 * 64;
        const float* w2 = KIN(I_W2) + ((size_t)l * 2 + kind) * 64 * 64;
#pragma unroll 4
        for (int c = 0; c < 32; ++c) av[c * 64 + F.lane] = src[c * 64 + F.lane] + pe[c * 64 + F.lane];
        WSYNC();
        float acc = 0.f;
#pragma unroll 8
        for (int i = 0; i < 2048; ++i) acc += av[i] * w1[i * 64 + F.lane];
        const float hid = gelu_tanh(acc);
        WSYNC();
        av[F.lane] = hid;
        WSYNC();
        float o = 0.f;
#pragma unroll 8
        for (int i = 0; i < 64; ++i) o += av[i] * w2[i * 64 + F.lane];
        WSYNC();
        if (kind == 0) { const float ss = wave_sum(o * o); o = o * (1.0f / sqrtf(ss * (1.0f / 64.0f) + EPS)) * KIN(I_KN)[l * 192 + F.lane]; }
        KC[(size_t)kind * (2 * 512 * 64) + ((size_t)g * 512 + n) * 64 + F.lane] = o;
    }
}
__device__ __forceinline__ void phase_recur(Frame& F, int l) {
    KA;
    const bf16* P = (const bf16*)(KWS + WS_P); float* ORAW = (float*)(KWS + WS_ORAW);
    for (int it = F.gw; it < 1024; it += F.NGW) {
        const int kind = it >> 9, head = (it >> 7) & 3, j = it & 127;
        if (kind == 0) {
            const int d0 = F.lane, d1 = F.lane + 64;
            const float* lbl = KIN(I_LB);
            float lb0, lb1;
            { const float a0 = lbl[head * 128 + d0], b0 = lbl[512 + head * 128 + d0], a1 = lbl[head * 128 + d1], b1 = lbl[512 + head * 128 + d1];
              lb0 = l == 0 ? 0.f : 1.0f / (1.0f + expf(a0 - b0)); lb1 = l == 0 ? 0.f : 1.0f / (1.0f + expf(a1 - b1)); }
            const bf16* Pq = P + C_HQ + head * 128; const bf16* Pf = P + C_HF + head * 128; const bf16* Pi = P + C_HI + head * 128 + j;
            float S0 = 0.f, S1 = 0.f;
            for (int t0 = 0; t0 < T; t0 += 8) {
                bf16 zq0[8], zq1[8], zf0[8], zf1[8], vi[8];
#pragma unroll
                for (int u = 0; u < 8; ++u) { const size_t row = (size_t)(t0 + u) * NPAD; zq0[u] = Pq[row + d0]; zq1[u] = Pq[row + d1]; zf0[u] = Pf[row + d0]; zf1[u] = Pf[row + d1]; vi[u] = Pi[row]; }
                float part[8];
#pragma unroll
                for (int u = 0; u < 8; ++u) { const float v = bf2f(vi[u]);
                    const float s0 = sigmoidf_(bf2f(zf0[u])), s1 = sigmoidf_(bf2f(zf1[u]));
                    const float f0 = lb0 + (1.0f - lb0) * s0, f1 = lb1 + (1.0f - lb1) * s1;
                    const float k0 = (1.0f - lb0) * (1.0f - s0), k1 = (1.0f - lb1) * (1.0f - s1);
                    S0 = f0 * S0 + k0 * v; S1 = f1 * S1 + k1 * v;
                    part[u] = bf2f(zq0[u]) * S0 + bf2f(zq1[u]) * S1; }
                float mine = 0.f;
#pragma unroll
                for (int u = 0; u < 8; ++u) { const float s = wave_sum(part[u]); mine = (F.lane == u) ? s : mine; }
                if (F.lane < 8) ORAW[(size_t)(t0 + F.lane) * 1024 + head * 128 + j] = mine;
            }
        } else {
            const int d = F.lane, c = head * 64 + d;
            float wa[16];
#pragma unroll
            for (int r = 0; r < 16; ++r) wa[r] = KIN(I_WA2)[((size_t)l * 16 + r) * 256 + c];
            const float ba = KIN(I_BA)[l * 256 + c];
            const bf16* Pq = P + C_GQ + c; const bf16* Pk = P + C_GK + c; const bf16* Pv = P + C_GV + head * 128 + j; const bf16* Pa = P + C_GA;
            float S = 0.f;
            for (int t0 = 0; t0 < T; t0 += 8) {
                bf16 zq[8], zk[8], zv[8]; u32x4 ga0[8], ga1[8];
#pragma unroll
                for (int u = 0; u < 8; ++u) { const size_t row = (size_t)(t0 + u) * NPAD; zq[u] = Pq[row]; zk[u] = Pk[row]; zv[u] = Pv[row]; ga0[u] = *(const u32x4*)(Pa + row); ga1[u] = *(const u32x4*)(Pa + row + 8); }
                float part[8];
#pragma unroll
                for (int u = 0; u < 8; ++u) {
                    float a = ba;
                    a += bflo(ga0[u].x) * wa[0] + bfhi(ga0[u].x) * wa[1] + bflo(ga0[u].y) * wa[2] + bfhi(ga0[u].y) * wa[3] + bflo(ga0[u].z) * wa[4] + bfhi(ga0[u].z) * wa[5] + bflo(ga0[u].w) * wa[6] + bfhi(ga0[u].w) * wa[7];
                    a += bflo(ga1[u].x) * wa[8] + bfhi(ga1[u].x) * wa[9] + bflo(ga1[u].y) * wa[10] + bfhi(ga1[u].y) * wa[11] + bflo(ga1[u].z) * wa[12] + bfhi(ga1[u].z) * wa[13] + bflo(ga1[u].w) * wa[14] + bfhi(ga1[u].w) * wa[15];
                    const float ls = fminf(a, 0.f) - log1pf(expf(-fabsf(a)));
                    const float f = expf(ls * (1.0f / 16.0f));
                    S = f * S + bf2f(zk[u]) * bf2f(zv[u]);
                    part[u] = bf2f(zq[u]) * 0.125f * S; }
                float mine = 0.f;
#pragma unroll
                for (int u = 0; u < 8; ++u) { const float s = wave_sum(part[u]); mine = (F.lane == u) ? s : mine; }
                if (F.lane < 8) ORAW[(size_t)(t0 + F.lane) * 1024 + 512 + head * 128 + j] = mine;
            }
        }
    }
}
__device__ __forceinline__ void phase_recur_out(Frame& F, int l) {
    KA;
    const bf16* P = (const bf16*)(KWS + WS_P); const float* ORAW = (const float*)(KWS + WS_ORAW); bf16* OCAT = (bf16*)(KWS + WS_OCAT);
    for (int it = F.gw; it < T * 8; it += F.NGW) {
        const int t = it >> 3, kind = (it >> 2) & 1, head = it & 3;
        const float* gn = (kind == 0 ? KIN(I_HGN) : KIN(I_GLAN)) + l * 128;
        const int cg = (kind == 0 ? C_HG : C_GR) + head * 128;
        const float r0 = ORAW[(size_t)t * 1024 + kind * 512 + head * 128 + F.lane], r1 = ORAW[(size_t)t * 1024 + kind * 512 + head * 128 + 64 + F.lane];
        const float rstd = 1.0f / sqrtf(wave_sum(r0 * r0 + r1 * r1) * (1.0f / 128.0f) + EPS);
        const float g0 = bf2f(P[(size_t)t * NPAD + cg + F.lane]), g1 = bf2f(P[(size_t)t * NPAD + cg + 64 + F.lane]);
        const float a0 = kind == 0 ? sigmoidf_(g0) : g0 * sigmoidf_(g0), a1 = kind == 0 ? sigmoidf_(g1) : g1 * sigmoidf_(g1);
        OCAT[(size_t)t * 1536 + 512 + kind * 512 + head * 128 + F.lane] = (bf16)f2bf(r0 * rstd * gn[F.lane] * a0);
        OCAT[(size_t)t * 1536 + 512 + kind * 512 + head * 128 + 64 + F.lane] = (bf16)f2bf(r1 * rstd * gn[64 + F.lane] * a1);
    }
}


template <int KIND> struct RecCfg { static constexpr int DK = KIND == 0 ? 128 : 64, NSEG = 512 / DK, TPS = 64 / NSEG, QROW = (DK + 8) * 2; };
constexpr int REC_VT_OFF = 0;
constexpr int REC_KD_OFF = 18432;
constexpr int REC_QS_OFF = 36864;
constexpr int REC_KS_OFF = 54272;
constexpr int REC_QD_OFF = 71680;
constexpr int REC_RED_OFF = 89088;
constexpr int REC_TOT_OFF = 91136;
__device__ __forceinline__ float expc(float x2) { return __builtin_amdgcn_exp2f(fminf(x2, 110.0f)); }
template <int KIND> __device__ __forceinline__ void rec_elem(KArgs* ka, int l, int head, int chunk, int tid, LAS float* tot,
        float (&qv)[RecCfg<KIND>::TPS], float (&kv)[RecCfg<KIND>::TPS], float (&bv)[RecCfg<KIND>::TPS], float& bend, float& bref) {
    constexpr int DK = RecCfg<KIND>::DK, NSEG = RecCfg<KIND>::NSEG, TPS = RecCfg<KIND>::TPS;
    const int d = tid % DK, seg = tid / DK, t0 = chunk * 64 + seg * TPS;
    const bf16* P = (const bf16*)(KWS + WS_P);
    float run = 0.f;
    if (KIND == 0) {
        const int c = head * 128 + d;
        float lb = 0.f;
        if (l > 0) { const float a0 = KIN(I_LB)[c], b0 = KIN(I_LB)[512 + c]; lb = 1.0f / (1.0f + expf(a0 - b0)); }
        const float omlb = 1.0f - lb;
        unsigned zr[TPS], qr[TPS];
#pragma unroll
        for (int u = 0; u < TPS; ++u) { const size_t row = (size_t)(t0 + u) * NPAD; zr[u] = P[row + C_HF + c]; qr[u] = P[row + C_HQ + c]; }
#pragma unroll
        for (int u = 0; u < TPS; ++u) {
            const float z = bf2f(zr[u]); qv[u] = bf2f(qr[u]);
            const float e = __builtin_amdgcn_exp2f(-LOG2E * z), sg = __builtin_amdgcn_rcpf(1.0f + e), f = fmaf(omlb, sg, lb);
            kv[u] = omlb * (e * sg);
            run += __builtin_amdgcn_logf(fmaxf(f, 1e-30f)); bv[u] = run; }
    } else {
        const int c = head * 64 + d;
        float wa[16];
#pragma unroll
        for (int r = 0; r < 16; ++r) wa[r] = KIN(I_WA2)[((size_t)l * 16 + r) * 256 + c];
        const float ba = KIN(I_BA)[l * 256 + c];
        u32x4 g0r[TPS], g1r[TPS]; unsigned qr[TPS], kr[TPS];
#pragma unroll
        for (int u = 0; u < TPS; ++u) { const size_t row = (size_t)(t0 + u) * NPAD; g0r[u] = *(const u32x4*)(P + row + C_GA); g1r[u] = *(const u32x4*)(P + row + C_GA + 8); qr[u] = P[row + C_GQ + c]; kr[u] = P[row + C_GK + c]; }
#pragma unroll
        for (int u = 0; u < TPS; ++u) { const u32x4 g0 = g0r[u], g1 = g1r[u];
            float a = ba;
            a += bflo(g0.x) * wa[0] + bfhi(g0.x) * wa[1] + bflo(g0.y) * wa[2] + bfhi(g0.y) * wa[3] + bflo(g0.z) * wa[4] + bfhi(g0.z) * wa[5] + bflo(g0.w) * wa[6] + bfhi(g0.w) * wa[7];
            a += bflo(g1.x) * wa[8] + bfhi(g1.x) * wa[9] + bflo(g1.y) * wa[10] + bfhi(g1.y) * wa[11] + bflo(g1.z) * wa[12] + bfhi(g1.z) * wa[13] + bflo(g1.w) * wa[14] + bfhi(g1.w) * wa[15];
            const float ls2 = fminf(a, 0.f) * LOG2E - __builtin_amdgcn_logf(1.0f + __builtin_amdgcn_exp2f(-LOG2E * fabsf(a)));
            qv[u] = bf2f(qr[u]) * 0.125f; kv[u] = bf2f(kr[u]);
            run += ls2 * (1.0f / 16.0f); bv[u] = run; }
    }
    tot[seg * DK + d] = run;
    __syncthreads();
    float off = 0.f; bend = 0.f; bref = 0.f;
#pragma unroll
    for (int sgi = 0; sgi < NSEG; ++sgi) { const float v = tot[sgi * DK + d]; off += sgi < seg ? v : 0.f; bref += sgi < NSEG / 2 ? v : 0.f; bend += v; }
#pragma unroll
    for (int u = 0; u < TPS; ++u) bv[u] += off;
}
template <int KIND> __device__ __forceinline__ void rec_vt_load(KArgs* ka, int head, int chunk, int tid, unsigned (&w)[8]) {
    const bf16* P = (const bf16*)(KWS + WS_P) + (KIND == 0 ? C_HI : C_GV) + head * 128;
    const int v = tid & 127, sv = tid >> 7;
#pragma unroll
    for (int u = 0; u < 8; ++u) { const unsigned a = P[(size_t)(chunk * 64 + sv * 16 + 2 * u) * NPAD + v], b = P[(size_t)(chunk * 64 + sv * 16 + 2 * u + 1) * NPAD + v]; w[u] = a | (b << 16); }
}
__device__ __forceinline__ void rec_vt_store(int tid, LAS unsigned char* lds, const unsigned (&w)[8]) {
    const int v = tid & 127, sv = tid >> 7;
    LAS u32x4* dst = (LAS u32x4*)(lds + REC_VT_OFF + v * 144 + sv * 32);
    dst[0] = (u32x4){w[0], w[1], w[2], w[3]}; dst[1] = (u32x4){w[4], w[5], w[6], w[7]};
}
template <int KIND> __device__ __forceinline__ void rec_local_unit(KArgs* ka, Frame& F, int l, int head, int chunk) {
    constexpr int DK = RecCfg<KIND>::DK, TPS = RecCfg<KIND>::TPS;
    LAS unsigned char* lds = F.lds; LAS float* tot = (LAS float*)(lds + REC_TOT_OFF);
    float qv[TPS], kv[TPS], bv[TPS], bend, bref;
    unsigned vraw[8];
    rec_vt_load<KIND>(ka, head, chunk, F.tid, vraw);
    rec_elem<KIND>(ka, l, head, chunk, F.tid, tot, qv, kv, bv, bend, bref);
    const int d = F.tid % DK, seg = F.tid / DK, unit = chunk * 4 + head;
    { unsigned w[TPS / 2];
#pragma unroll
      for (int u = 0; u < TPS / 2; ++u) w[u] = pkbf(kv[2 * u] * expc(bend - bv[2 * u]), kv[2 * u + 1] * expc(bend - bv[2 * u + 1]));
      LAS u32x4* dst = (LAS u32x4*)(lds + REC_KD_OFF + d * 144 + seg * TPS * 2);
      dst[0] = (u32x4){w[0], w[1], w[2], w[3]};
      if constexpr (TPS == 16) dst[1] = (u32x4){w[4], w[5], w[6], w[7]}; }
    if (seg == 0) ((float*)(KWS + WS_DEC + (KIND == 0 ? 0 : 262144)))[(size_t)unit * DK + d] = __builtin_amdgcn_exp2f(bend);
    rec_vt_store(F.tid, lds, vraw);
    __syncthreads();
    const int r = F.lane & 15, kq = F.lane >> 4;
    const int dt = KIND == 0 ? F.wave : (F.wave & 3), vt0 = KIND == 0 ? 0 : (F.wave >> 2) * 4, nvt = KIND == 0 ? 8 : 4;
    bf16x8 a[2];
#pragma unroll
    for (int ks = 0; ks < 2; ++ks) a[ks] = *(const LAS bf16x8*)(lds + REC_KD_OFF + (16 * dt + r) * 144 + (32 * ks + 8 * kq) * 2);
    bf16* Sl = (bf16*)(KWS + (KIND == 0 ? WS_SLOC_HG : WS_SLOC_GL)) + (size_t)unit * 128 * DK;
#pragma unroll
    for (int vi = 0; vi < nvt; ++vi) { const int vt = vt0 + vi; f32x4 acc = {0.f, 0.f, 0.f, 0.f};
#pragma unroll
        for (int ks = 0; ks < 2; ++ks) { const bf16x8 b = *(const LAS bf16x8*)(lds + REC_VT_OFF + (16 * vt + r) * 144 + (32 * ks + 8 * kq) * 2); acc = __builtin_amdgcn_mfma_f32_16x16x32_bf16(a[ks], b, acc, 0, 0, 0); }
        u32x2 w2; w2.x = pkbf(acc[0], acc[1]); w2.y = pkbf(acc[2], acc[3]);
        *(u32x2*)(Sl + (size_t)(16 * vt + r) * DK + 16 * dt + 4 * kq) = w2; }
    __syncthreads();
}
__device__ __forceinline__ void phase_rec_local(Frame& F, int l) {
    KA;
    for (int it = F.bid; it < 1024; it += F.G) { const int kind = it >> 9, chunk = (it >> 2) & 127, head = it & 3;
        if (kind == 0) rec_local_unit<0>(ka, F, l, head, chunk); else rec_local_unit<1>(ka, F, l, head, chunk); }
}
__device__ __forceinline__ void phase_rec_scan(Frame& F) {
    KA;
    const int gt = F.bid * 512 + F.tid;
    if (gt >= 49152) return;
    const bool hg = gt < 32768; const int q = hg ? gt : gt - 32768;
    const int DK = hg ? 128 : 64, dp = q % (DK / 2), v = (q / (DK / 2)) & 127, head = q / (DK / 2 * 128);
    const bf16* Sl = (const bf16*)(KWS + (hg ? WS_SLOC_HG : WS_SLOC_GL)) + ((size_t)head * 128 + v) * DK + 2 * dp;
    bf16* Sp = (bf16*)(KWS + (hg ? WS_SPREV_HG : WS_SPREV_GL)) + ((size_t)head * 128 + v) * DK + 2 * dp;
    const float* De = (const float*)(KWS + WS_DEC + (hg ? 0 : 262144)) + (size_t)head * DK + 2 * dp;
    const size_t ustr = (size_t)4 * 128 * DK, dstr = (size_t)4 * DK;
    float s0 = 0.f, s1 = 0.f;
    for (int c0 = 0; c0 < NCH; c0 += 16) { unsigned x[16]; f32x2 dc[16];
#pragma unroll
        for (int u = 0; u < 16; ++u) { x[u] = *(const unsigned*)(Sl + (size_t)(c0 + u) * ustr); dc[u] = *(const f32x2*)(De + (size_t)(c0 + u) * dstr); }
#pragma unroll
        for (int u = 0; u < 16; ++u) { *(unsigned*)(Sp + (size_t)(c0 + u) * ustr) = pkbf(s0, s1); s0 = dc[u].x * s0 + bflo(x[u]); s1 = dc[u].y * s1 + bfhi(x[u]); } }
}
template <int KIND> __device__ __forceinline__ void rec_out_unit(KArgs* ka, Frame& F, int l, int head, int chunk) {
    constexpr int DK = RecCfg<KIND>::DK, TPS = RecCfg<KIND>::TPS, QROW = RecCfg<KIND>::QROW, NKS = DK / 32;
    LAS unsigned char* lds = F.lds; LAS float* tot = (LAS float*)(lds + REC_TOT_OFF); LAS float* red = (LAS float*)(lds + REC_RED_OFF);
    const int r = F.lane & 15, kq = F.lane >> 4, unit = chunk * 4 + head, vt = F.wave;
    bf16x8 sa[NKS];
    { const bf16* Sp = (const bf16*)(KWS + (KIND == 0 ? WS_SPREV_HG : WS_SPREV_GL)) + (size_t)unit * 128 * DK + (size_t)(16 * vt + r) * DK + 8 * kq;
#pragma unroll
      for (int ks = 0; ks < NKS; ++ks) sa[ks] = *(const bf16x8*)(Sp + 32 * ks); }
    float qv[TPS], kv[TPS], bv[TPS], bend, bref;
    unsigned vraw[8];
    rec_vt_load<KIND>(ka, head, chunk, F.tid, vraw);
    const bf16* P = (const bf16*)(KWS + WS_P); bf16* OCAT = (bf16*)(KWS + WS_OCAT);
    const int v0 = 16 * vt + 4 * kq;
    const f32x4 gn = *(const f32x4*)((KIND == 0 ? KIN(I_HGN) : KIN(I_GLAN)) + l * 128 + v0);
    u32x2 gq4[4];
#pragma unroll
    for (int it = 0; it < 4; ++it) gq4[it] = *(const u32x2*)(P + (size_t)(chunk * 64 + 16 * it + r) * NPAD + (KIND == 0 ? C_HG : C_GR) + head * 128 + v0);
    rec_elem<KIND>(ka, l, head, chunk, F.tid, tot, qv, kv, bv, bend, bref);
    { const int d = F.tid % DK, seg = F.tid / DK; const float eref = __builtin_amdgcn_exp2f(fmaxf(bref, -120.f));
#pragma unroll
      for (int u = 0; u < TPS; u += 2) { const int o = (seg * TPS + u) * QROW + d * 2;
          const float x0 = __builtin_amdgcn_exp2f(fminf(fmaxf(bv[u] - bref, -110.f), 110.f)), x1 = __builtin_amdgcn_exp2f(fminf(fmaxf(bv[u + 1] - bref, -110.f), 110.f));
          const float qs0 = qv[u] * x0, qs1 = qv[u + 1] * x1;
          const unsigned w0 = pkbf(qs0, qs1), w1 = pkbf(kv[u] * __builtin_amdgcn_rcpf(x0), kv[u + 1] * __builtin_amdgcn_rcpf(x1)), w2 = pkbf(qs0 * eref, qs1 * eref);
          *(LAS bf16*)(lds + REC_QS_OFF + o) = (bf16)w0; *(LAS bf16*)(lds + REC_QS_OFF + o + QROW) = (bf16)(w0 >> 16);
          *(LAS bf16*)(lds + REC_KS_OFF + o) = (bf16)w1; *(LAS bf16*)(lds + REC_KS_OFF + o + QROW) = (bf16)(w1 >> 16);
          *(LAS bf16*)(lds + REC_QD_OFF + o) = (bf16)w2; *(LAS bf16*)(lds + REC_QD_OFF + o + QROW) = (bf16)(w2 >> 16); } }
    rec_vt_store(F.tid, lds, vraw);
    __syncthreads();
#pragma unroll
    for (int tt = 0; tt < 2; ++tt) { const int tile = F.wave * 2 + tt, jt = tile >> 2, it = tile & 3; f32x4 acc = {0.f, 0.f, 0.f, 0.f};
        if (jt <= it) {
#pragma unroll
            for (int ks = 0; ks < NKS; ++ks) { const bf16x8 a = *(const LAS bf16x8*)(lds + REC_KS_OFF + (16 * jt + r) * QROW + (32 * ks + 8 * kq) * 2), b = *(const LAS bf16x8*)(lds + REC_QS_OFF + (16 * it + r) * QROW + (32 * ks + 8 * kq) * 2);
                acc = __builtin_amdgcn_mfma_f32_16x16x32_bf16(a, b, acc, 0, 0, 0); } }
        const int i = 16 * it + r, j0 = 16 * jt + 4 * kq;
        u32x2 w; w.x = pk2(j0 <= i ? acc[0] : 0.f, j0 + 1 <= i ? acc[1] : 0.f); w.y = pk2(j0 + 2 <= i ? acc[2] : 0.f, j0 + 3 <= i ? acc[3] : 0.f);
        *(LAS u32x2*)(lds + REC_KD_OFF + i * 144 + j0 * 2) = w; }
    __syncthreads();
    f32x4 acc[4];
#pragma unroll
    for (int it = 0; it < 4; ++it) acc[it] = (f32x4){0.f, 0.f, 0.f, 0.f};
#pragma unroll
    for (int ks = 0; ks < 2; ++ks) { const bf16x8 a = *(const LAS bf16x8*)(lds + REC_VT_OFF + (16 * vt + r) * 144 + (32 * ks + 8 * kq) * 2);
#pragma unroll
        for (int it = 0; it < 4; ++it) { const bf16x8 b = *(const LAS bf16x8*)(lds + REC_KD_OFF + (16 * it + r) * 144 + (32 * ks + 8 * kq) * 2); acc[it] = __builtin_amdgcn_mfma_f32_16x16x32_bf16(a, b, acc[it], 0, 0, 0); } }
#pragma unroll
    for (int ks = 0; ks < NKS; ++ks) {
#pragma unroll
        for (int it = 0; it < 4; ++it) { const bf16x8 b = *(const LAS bf16x8*)(lds + REC_QD_OFF + (16 * it + r) * QROW + (32 * ks + 8 * kq) * 2); acc[it] = __builtin_amdgcn_mfma_f32_16x16x32_bf16(sa[ks], b, acc[it], 0, 0, 0); } }
#pragma unroll
    for (int it = 0; it < 4; ++it) { float ss = acc[it][0] * acc[it][0] + acc[it][1] * acc[it][1] + acc[it][2] * acc[it][2] + acc[it][3] * acc[it][3];
        ss += __shfl_xor(ss, 16); ss += __shfl_xor(ss, 32);
        if (kq == 0) red[F.wave * 64 + 16 * it + r] = ss; }
    __syncthreads();
#pragma unroll
    for (int it = 0; it < 4; ++it) { const int i = 16 * it + r, t = chunk * 64 + i; float tot_ = 0.f;
#pragma unroll
        for (int w = 0; w < 8; ++w) tot_ += red[w * 64 + i];
        const float rstd = 1.0f / sqrtf(tot_ * (1.0f / 128.0f) + EPS);
        const u32x2 gq = gq4[it];
        float gt[4] = {bflo(gq.x), bfhi(gq.x), bflo(gq.y), bfhi(gq.y)}, o[4];
#pragma unroll
        for (int e = 0; e < 4; ++e) { const float sg = fsig(gt[e]); o[e] = acc[it][e] * rstd * gn[e] * (KIND == 0 ? sg : gt[e] * sg); }
        u32x2 w; w.x = pkbf(o[0], o[1]); w.y = pkbf(o[2], o[3]);
        *(u32x2*)(OCAT + (size_t)t * 1536 + 512 + KIND * 512 + head * 128 + v0) = w; }
    __syncthreads();
}
__device__ __forceinline__ void phase_rec_out(Frame& F, int l) {
    KA;
    unsigned* qctr = (unsigned*)(KWS + WS_CTL) + 2048 + 64 * l;
    volatile LAS int* qslot = (volatile LAS int*)(F.lds + MISC_OFF + 1024);
    int mine = 0;
    if (F.tid == 0) { mine = (int)__hip_atomic_fetch_add(qctr, 1u, __ATOMIC_RELAXED, __HIP_MEMORY_SCOPE_AGENT);
        unsigned* sdone = (unsigned*)(KWS + WS_CTL) + 2048 + 64 * (4 + l); unsigned sp = 0;
        while (__hip_atomic_load(sdone, __ATOMIC_RELAXED, __HIP_MEMORY_SCOPE_AGENT) < 96u) { __builtin_amdgcn_s_sleep(2); if (++sp > (1u << 24)) break; }
        __builtin_amdgcn_fence(__ATOMIC_ACQUIRE, "agent"); asm volatile("s_waitcnt vmcnt(0)" ::: "memory"); }
    for (;;) {
        if (F.tid == 0) *qslot = mine;
        __syncthreads();
        const int it = __builtin_amdgcn_readfirstlane(*qslot);
        __syncthreads();
        if (it >= 1024) break;
        if (F.tid == 0) mine = (int)__hip_atomic_fetch_add(qctr, 1u, __ATOMIC_RELAXED, __HIP_MEMORY_SCOPE_AGENT);
        const int kind = it >> 9, chunk = (it >> 2) & 127, head = it & 3;
        if (kind == 0) rec_out_unit<0>(ka, F, l, head, chunk); else rec_out_unit<1>(ka, F, l, head, chunk);
    }
}

typedef float f32x16 __attribute__((ext_vector_type(16)));
constexpr float NSA_SHIFT2 = 8.0f;
__device__ __forceinline__ int perm16(int b) { return (b & 3) | ((b & 4) << 1) | ((b & 8) >> 1); }
__device__ __forceinline__ void phase_prep2(Frame& F, int l) {
    KA;
    const bf16* P = (const bf16*)(KWS + WS_P);
    bf16* QS = (bf16*)(KWS + WS_QS); bf16* KS2 = (bf16*)(KWS + WS_KS2); bf16* KW2 = (bf16*)(KWS + WS_KW2);
    const float* qg = KIN(I_QN) + l * 64; const float* kg = KIN(I_KN) + l * 192;
    for (int it = F.gw; it < T * 12; it += F.NGW) {
        const int t = it / 12, v = it % 12;
        const int col = v < 8 ? v * 64 : (v < 10 ? C_KS + (v - 8) * 64 : C_KW + (v - 10) * 64);
        float x = bf2f(P[(size_t)t * NPAD + col + F.lane]);
        const float ss = wave_sum(x * x);
        const float g = v < 8 ? qg[F.lane] * (0.125f * LOG2E) : (v < 10 ? kg[64 + F.lane] : kg[128 + F.lane]);
        x = x * (1.0f / sqrtf(ss * (1.0f / 64.0f) + EPS)) * g;
        bf16* dst = v < 8 ? QS + ((size_t)v * T + t) * 64 : (v < 10 ? KS2 + ((size_t)(v - 8) * T + t) * 64 : KW2 + ((size_t)(v - 10) * T + t) * 64);
        dst[F.lane] = (bf16)f2bf(x);
    }
    LAS bf16* tile = (LAS bf16*)(F.lds + F.wave * 16384);
    for (int it = F.gw; it < 2 * 2 * (T / 64); it += F.NGW) {
        const int kind = it / (2 * (T / 64)), q = it % (2 * (T / 64)), g = q / (T / 64), tb = q % (T / 64);
        const bf16* src = P + (size_t)(tb * 64) * NPAD + (kind == 0 ? C_VS : C_VW) + g * 64;
        bf16* dst = (bf16*)(KWS + (kind == 0 ? WS_VST : WS_VWT)) + (size_t)g * 64 * T + tb * 64;
#pragma unroll 4
        for (int r = 0; r < 64; ++r) tile[r * 66 + F.lane] = src[(size_t)r * NPAD + F.lane];
        WSYNC();
        const int pl = (F.lane & ~15) | perm16(F.lane & 15);
#pragma unroll 4
        for (int d = 0; d < 64; ++d) dst[(size_t)d * T + pl] = tile[F.lane * 66 + d];
        WSYNC();
    }
}

__device__ __forceinline__ void phase_prep3(Frame& F, int l) {
    KA;
    const bf16* P = (const bf16*)(KWS + WS_P);
    bf16* QS = (bf16*)(KWS + WS_QS); bf16* KS2 = (bf16*)(KWS + WS_KS2); bf16* KW2 = (bf16*)(KWS + WS_KW2);
    const float* qg = KIN(I_QN) + l * 64; const float* kg = KIN(I_KN) + l * 192;
    const int vec = F.lane >> 3, part = F.lane & 7;
    for (int t = F.gw; t < T; t += F.NGW) {
#pragma unroll
        for (int pass = 0; pass < 2; ++pass) {
            if (pass == 1 && vec >= 4) continue;
            const int col = pass == 0 ? vec * 64 : (vec < 2 ? C_KS + vec * 64 : C_KW + (vec - 2) * 64);
            const float* gp = pass == 0 ? qg : (vec < 2 ? kg + 64 : kg + 128);
            const float gs = pass == 0 ? 0.125f * LOG2E : 1.0f;
            bf16* dst = pass == 0 ? QS + ((size_t)vec * T + t) * 64 : (vec < 2 ? KS2 + ((size_t)vec * T + t) * 64 : KW2 + ((size_t)(vec - 2) * T + t) * 64);
            const u32x4 raw = *(const u32x4*)(P + (size_t)t * NPAD + col + part * 8);
            float x[8] = {bflo(raw.x), bfhi(raw.x), bflo(raw.y), bfhi(raw.y), bflo(raw.z), bfhi(raw.z), bflo(raw.w), bfhi(raw.w)};
            float ss = 0.f;
#pragma unroll
            for (int e = 0; e < 8; ++e) ss += x[e] * x[e];
            ss += __shfl_xor(ss, 1); ss += __shfl_xor(ss, 2); ss += __shfl_xor(ss, 4);
            const float rstd = gs / sqrtf(ss * (1.0f / 64.0f) + EPS);
            const f32x4 g0 = *(const f32x4*)(gp + part * 8), g1 = *(const f32x4*)(gp + part * 8 + 4);
            u32x4 o; o.x = pk2(x[0] * rstd * g0.x, x[1] * rstd * g0.y); o.y = pk2(x[2] * rstd * g0.z, x[3] * rstd * g0.w); o.z = pk2(x[4] * rstd * g1.x, x[5] * rstd * g1.y); o.w = pk2(x[6] * rstd * g1.z, x[7] * rstd * g1.w);
            *(u32x4*)(dst + part * 8) = o;
        }
    }
    LAS bf16* tile = (LAS bf16*)(F.lds + F.wave * 16384);
    for (int it = F.gw; it < 2 * 2 * (T / 64); it += F.NGW) {
        const int kind = it / (2 * (T / 64)), q = it % (2 * (T / 64)), g = q / (T / 64), tb = q % (T / 64);
        const bf16* src = P + (size_t)(tb * 64) * NPAD + (kind == 0 ? C_VS : C_VW) + g * 64;
        bf16* dst = (bf16*)(KWS + (kind == 0 ? WS_VST : WS_VWT)) + (size_t)g * 64 * T + tb * 64;
#pragma unroll
        for (int i = 0; i < 8; ++i) { const int tok = vec + 8 * i; *(LAS u32x4*)(tile + tok * 72 + part * 8) = *(const u32x4*)(src + (size_t)tok * NPAD + part * 8); }
        WSYNC();
#pragma unroll
        for (int c = 0; c < 8; ++c) { unsigned w[4];
#pragma unroll
            for (int k = 0; k < 4; ++k) { const int p0 = (c & 1) * 8 + 2 * k, p1 = p0 + 1;
                const int k0 = (c >> 1) * 16 + ((p0 & 3) | ((p0 & 4) << 1) | ((p0 & 8) >> 1)), k1 = (c >> 1) * 16 + ((p1 & 3) | ((p1 & 4) << 1) | ((p1 & 8) >> 1));
                w[k] = (unsigned)tile[k0 * 72 + F.lane] | ((unsigned)tile[k1 * 72 + F.lane] << 16); }
            *(u32x4*)(dst + (size_t)F.lane * T + c * 8) = (u32x4){w[0], w[1], w[2], w[3]}; }
        WSYNC();
    }
}

__device__ __forceinline__ void phase_compress2(Frame& F, int l) {
    KA;
    LAS float* av = (LAS float*)(F.lds + F.wave * 16384);
    const bf16* P = (const bf16*)(KWS + WS_P);
    bf16* KCB = (bf16*)(KWS + WS_KCB); bf16* VCT = (bf16*)(KWS + WS_KCB + 131072);
    for (int it = F.gw; it < 2 * 2 * 512; it += F.NGW) {
        const int kind = it >> 10, g = (it >> 9) & 1, n = it & 511;
        if (n == 511) { if (kind == 0) KCB[((size_t)g * 512 + 511) * 64 + F.lane] = 0; else VCT[((size_t)g * 64 + F.lane) * 512 + 511] = 0; continue; }
        const bf16* src = P + (size_t)(16 * n) * NPAD + (kind == 0 ? C_KC : C_VC) + g * 64;
        const float* pe = KIN(I_PE) + ((size_t)l * 2 + kind) * 2048;
        const float* w1 = KIN(I_W1) + ((size_t)l * 2 + kind) * 2048 * 64;
        const float* w2 = KIN(I_W2) + ((size_t)l * 2 + kind) * 64 * 64;
#pragma unroll 4
        for (int c = 0; c < 32; ++c) av[c * 64 + F.lane] = bf2f(src[(size_t)c * NPAD + F.lane]) + pe[c * 64 + F.lane];
        WSYNC();
        float acc = 0.f;
#pragma unroll 8
        for (int i = 0; i < 2048; ++i) acc += av[i] * w1[i * 64 + F.lane];
        const float hid = gelu_tanh(acc);
        WSYNC();
        av[F.lane] = hid;
        WSYNC();
        float o = 0.f;
#pragma unroll 8
        for (int i = 0; i < 64; ++i) o += av[i] * w2[i * 64 + F.lane];
        WSYNC();
        if (kind == 0) { const float ss = wave_sum(o * o); o = o * (1.0f / sqrtf(ss * (1.0f / 64.0f) + EPS)) * KIN(I_KN)[l * 192 + F.lane]; KCB[((size_t)g * 512 + n) * 64 + F.lane] = (bf16)f2bf(o); }
        else VCT[((size_t)g * 64 + F.lane) * 512 + ((n & ~15) | perm16(n & 15))] = (bf16)f2bf(o);
    }
}

__device__ __forceinline__ void phase_compress3(Frame& F, int l) {
    KA;
    const bf16* P = (const bf16*)(KWS + WS_P);
    bf16* KCB = (bf16*)(KWS + WS_KCB); bf16* VCT = (bf16*)(KWS + WS_KCB + 131072);
    LAS float* red = (LAS float*)F.lds;
    LAS bf16* hid = (LAS bf16*)(F.lds + 32768);
    const int r16 = F.lane & 15, kq = F.lane >> 4;
    for (int unit = F.bid; unit < 128; unit += F.G) {
        const int kind = unit >> 6, mt = unit & 63, g = mt >> 5, n0 = (mt & 31) * 16;
        const bf16* W1T = (const bf16*)(KWS + WS_CW) + (size_t)(l * 2 + kind) * 64 * 2048; const bf16* W2T = (const bf16*)(KWS + WS_CW + 1048576) + (size_t)(l * 2 + kind) * 4096;
        const float* B1 = (const float*)(KWS + WS_CW + 1572864) + (l * 2 + kind) * 64;
        const bf16* arow = P + (size_t)(16 * (n0 + r16)) * NPAD + (kind == 0 ? C_KC : C_VC) + g * 64;
        f32x4 acc[4];
#pragma unroll
        for (int nt = 0; nt < 4; ++nt) acc[nt] = (f32x4){0.f, 0.f, 0.f, 0.f};
#pragma unroll 2
        for (int ks = 0; ks < 8; ++ks) { const int c0 = F.wave * 256 + 32 * ks + 8 * kq;
            const bf16x8 a = *(const bf16x8*)(arow + (size_t)(c0 >> 6) * NPAD + (c0 & 63));
#pragma unroll
            for (int nt = 0; nt < 4; ++nt) { const bf16x8 b = *(const bf16x8*)(W1T + (size_t)(16 * nt + r16) * 2048 + c0); acc[nt] = __builtin_amdgcn_mfma_f32_16x16x32_bf16(a, b, acc[nt], 0, 0, 0); } }
#pragma unroll
        for (int nt = 0; nt < 4; ++nt) *(LAS f32x4*)(red + ((F.wave * 4 + nt) * 64 + F.lane) * 4) = acc[nt];
        __syncthreads();
        if (F.tid < 256) { const int nt = F.tid >> 6, ln = F.tid & 63; f32x4 v = {0.f, 0.f, 0.f, 0.f};
#pragma unroll
            for (int w = 0; w < 8; ++w) v += *(const LAS f32x4*)(red + ((w * 4 + nt) * 64 + ln) * 4);
            const int col = 16 * nt + (ln & 15); const float b1 = B1[col];
#pragma unroll
            for (int i = 0; i < 4; ++i) hid[(4 * (ln >> 4) + i) * 72 + col] = (bf16)f2bf(gelu_tanh(v[i] + b1)); }
        __syncthreads();
        if (F.wave == 0) {
            f32x4 o[4];
#pragma unroll
            for (int nt = 0; nt < 4; ++nt) o[nt] = (f32x4){0.f, 0.f, 0.f, 0.f};
#pragma unroll
            for (int ks = 0; ks < 2; ++ks) { const bf16x8 a = *(const LAS bf16x8*)(hid + r16 * 72 + 32 * ks + 8 * kq);
#pragma unroll
                for (int nt = 0; nt < 4; ++nt) { const bf16x8 b = *(const bf16x8*)(W2T + (16 * nt + r16) * 64 + 32 * ks + 8 * kq); o[nt] = __builtin_amdgcn_mfma_f32_16x16x32_bf16(a, b, o[nt], 0, 0, 0); } }
            if (kind == 0) {
#pragma unroll
                for (int i = 0; i < 4; ++i) { float ss = o[0][i] * o[0][i] + o[1][i] * o[1][i] + o[2][i] * o[2][i] + o[3][i] * o[3][i];
                    ss += __shfl_xor(ss, 1); ss += __shfl_xor(ss, 2); ss += __shfl_xor(ss, 4); ss += __shfl_xor(ss, 8);
                    const float rstd = 1.0f / sqrtf(ss * (1.0f / 64.0f) + EPS); const int n = n0 + 4 * kq + i;
#pragma unroll
                    for (int nt = 0; nt < 4; ++nt) { const int col = 16 * nt + r16; KCB[((size_t)g * 512 + n) * 64 + col] = n < 511 ? (bf16)f2bf(o[nt][i] * rstd * KIN(I_KN)[l * 192 + col]) : (bf16)0; } }
            } else {
#pragma unroll
                for (int i = 0; i < 4; ++i) { const int n = n0 + 4 * kq + i;
#pragma unroll
                    for (int nt = 0; nt < 4; ++nt) { const int col = 16 * nt + r16; VCT[((size_t)g * 64 + col) * 512 + ((n & ~15) | perm16(n & 15))] = n < 511 ? (bf16)f2bf(o[nt][i]) : (bf16)0; } }
            }
        }
        __syncthreads();
    }
}

constexpr int NSA_SCA = 65536, NSA_SCB = 99328;
constexpr int NSA_QM = 133120, NSA_UM = 134144;
static_assert(NSA_UM + 16 <= MISC_OFF, "NSA LDS map");
__device__ __forceinline__ int next_set(unsigned long long m0, unsigned long long m1, int from) {
    if (from < 64) { const unsigned long long x = m0 & (~0ull << from); if (x) return __builtin_ctzll(x); from = 64; }
    if (from < 128) { const unsigned long long x = m1 & (~0ull << (from - 64)); if (x) return 64 + __builtin_ctzll(x); }
    return 128;
}
__device__ __forceinline__ void nsa_issue(LAS unsigned char* lds, int slot, const bf16* Kg, const bf16* VTg, int vt_len, int j, int tid, int wave) {
    const int row = tid >> 3, c = (tid & 7) ^ ((row >> 1) & 7);
    __builtin_amdgcn_global_load_lds((const unsigned*)(Kg + (size_t)(64 * j + row) * 64 + c * 8), (LAS unsigned*)(lds + slot * 16384 + wave * 1024), 16, 0, 0);
    __builtin_amdgcn_global_load_lds((const unsigned*)(VTg + (size_t)row * vt_len + 64 * j + c * 8), (LAS unsigned*)(lds + slot * 16384 + 8192 + wave * 1024), 16, 0, 0);
}
template <int MODE> __device__ __forceinline__ void nsa_branch(Frame& F, const bf16* Kg, const bf16* VTg, int vt_len, unsigned long long m0, unsigned long long m1,
        const bf16x8 (&Qf)[4], int t, int cblk, u32x4 qxw, int tref, float inv_l, const unsigned (&qsel)[4], int hi_cmp, unsigned wm_lo_dummy, f32x16 (&oacc)[2], float& lsum) {
    LAS unsigned char* lds = F.lds;
    const int lane = F.lane, c32 = lane & 31, h = lane >> 5, tid = F.tid;
    const int sw = (c32 >> 1) & 7;
    int j0 = next_set(m0, m1, 0);
    if (j0 >= 128) return;
    int j1 = next_set(m0, m1, j0 + 1), j2 = j1 < 128 ? next_set(m0, m1, j1 + 1) : 128;
    nsa_issue(lds, 0, Kg, VTg, vt_len, j0, tid, F.wave);
    if (j1 < 128) nsa_issue(lds, 1, Kg, VTg, vt_len, j1, tid, F.wave);
    if (j2 < 128) nsa_issue(lds, 2, Kg, VTg, vt_len, j2, tid, F.wave);
    int slot = 0;
    while (j0 < 128) {
        const int j = j0;
        if (j2 < 128) asm volatile("s_waitcnt vmcnt(4)" ::: "memory"); else if (j1 < 128) asm volatile("s_waitcnt vmcnt(2)" ::: "memory"); else asm volatile("s_waitcnt vmcnt(0)" ::: "memory");
        __builtin_amdgcn_s_barrier(); asm volatile("" ::: "memory");
        const int j3 = j2 < 128 ? next_set(m0, m1, j2 + 1) : 128;
        if (j3 < 128) nsa_issue(lds, (slot + 3) & 3, Kg, VTg, vt_len, j3, tid, F.wave);
        bool need = true;
        if (MODE == 2) { const unsigned myw = j < 32 ? qsel[0] : (j < 64 ? qsel[1] : (j < 96 ? qsel[2] : qsel[3])); need = __any((myw >> (j & 31)) & 1u); }
        if (need) {
            const int kb = slot * 16384, vb = slot * 16384 + 8192;
            const int kbase = 64 * j;
            u32x4 qx = qxw;
            if (MODE == 2) { const unsigned myw = j < 32 ? qsel[0] : (j < 64 ? qsel[1] : (j < 96 ? qsel[2] : qsel[3])); if (!((myw >> (j & 31)) & 1u) && h == 0) qx.z = 0xF149u; }
            const bf16x8 qxf = __builtin_bit_cast(bf16x8, qx);
            f32x16 sacc[2];
#pragma unroll
            for (int sub = 0; sub < 2; ++sub)
#pragma unroll
                for (int i = 0; i < 16; ++i) sacc[sub][i] = 0.f;
#pragma unroll
            for (int sub = 0; sub < 2; ++sub) {
#pragma unroll
                for (int kp = 0; kp < 2; ++kp) { bf16x8 ka2[2];
#pragma unroll
                    for (int k2 = 0; k2 < 2; ++k2) ka2[k2] = *(const LAS bf16x8*)(lds + kb + (32 * sub + c32) * 128 + (((2 * (2 * kp + k2) + h) ^ sw) * 16));
                    asm volatile("" ::: "memory");
#pragma unroll
                    for (int k2 = 0; k2 < 2; ++k2) sacc[sub] = __builtin_amdgcn_mfma_f32_32x32x16_bf16(ka2[k2], Qf[2 * kp + k2], sacc[sub], 0, 0, 0);
                    asm volatile("" ::: "memory"); }
                { const int kidx = kbase + 32 * sub + c32, pos = MODE < 2 ? 16 * kidx + 31 : kidx, dd = tref - pos;
                  const unsigned w = pkbf(-(float)((dd >> 8) * 256), -(float)(dd & 255));
                  u32x4 kx; kx.x = h == 0 ? w : 0u; kx.y = kx.x; kx.z = h == 0 ? 0x3F80u : 0u; kx.w = 0u;
                  sacc[sub] = __builtin_amdgcn_mfma_f32_32x32x16_bf16(__builtin_bit_cast(bf16x8, kx), qxf, sacc[sub], 0, 0, 0); } }
#pragma unroll
            for (int sub = 0; sub < 2; ++sub)
#pragma unroll
                for (int i = 0; i < 16; ++i) sacc[sub][i] = __builtin_amdgcn_exp2f(sacc[sub][i]);
            bool mhi = false, mlo = false; int hi = 0, lo = 0;
            if (MODE < 2) { mhi = (kbase + 63 > (tref - 63 - 31) / 16 - 1); hi = hi_cmp; }
            if (MODE == 2) { mhi = (j == cblk); hi = t; }
            if (MODE == 3) { mhi = (j == cblk); hi = t; mlo = (j == cblk - 8); lo = t - 511; }
            if (mhi || mlo) {
#pragma unroll
                for (int sub = 0; sub < 2; ++sub)
#pragma unroll
                    for (int i = 0; i < 16; ++i) { const int idx = kbase + 4 * h + 32 * sub + (i & 3) + 8 * (i >> 2); if ((mhi && idx > hi) || (mlo && idx < lo)) sacc[sub][i] = 0.f; }
            }
            float ls = 0.f;
#pragma unroll
            for (int sub = 0; sub < 2; ++sub)
#pragma unroll
                for (int i = 0; i < 16; ++i) ls += sacc[sub][i];
            lsum += ls;
            if (MODE == 1) {
                LAS float* scA = (LAS float*)(lds + NSA_SCA); LAS float* scB = (LAS float*)(lds + NSA_SCB);
                const int q = F.wave * 8 + (c32 >> 2);
#pragma unroll
                for (int sub = 0; sub < 2; ++sub)
#pragma unroll
                    for (int g4 = 0; g4 < 4; ++g4) { float x[4];
#pragma unroll
                        for (int e = 0; e < 4; ++e) { float v = sacc[sub][4 * g4 + e] * inv_l;
                            v += __builtin_bit_cast(float, __builtin_amdgcn_mov_dpp(__builtin_bit_cast(int, v), 0xB1, 0xF, 0xF, true));
                            v += __builtin_bit_cast(float, __builtin_amdgcn_mov_dpp(__builtin_bit_cast(int, v), 0x4E, 0xF, 0xF, true));
                            x[e] = v; }
                        const int jb = 16 * j + 8 * sub + 2 * g4 + h;
                        if ((c32 & 3) == 0) { scA[q * 132 + jb] = 2.0f * (x[0] + x[1] + x[2]) + x[3]; scB[q * 132 + jb + 1] = x[3]; } }
            }
            if (MODE != 0) {
                bf16x8 pf[2][2];
#pragma unroll
                for (int sub = 0; sub < 2; ++sub)
#pragma unroll
                    for (int s2 = 0; s2 < 2; ++s2) { u32x4 w; w.x = pkbf(sacc[sub][8 * s2], sacc[sub][8 * s2 + 1]); w.y = pkbf(sacc[sub][8 * s2 + 2], sacc[sub][8 * s2 + 3]); w.z = pkbf(sacc[sub][8 * s2 + 4], sacc[sub][8 * s2 + 5]); w.w = pkbf(sacc[sub][8 * s2 + 6], sacc[sub][8 * s2 + 7]);
                        pf[sub][s2] = __builtin_bit_cast(bf16x8, w); }
                asm volatile("" ::: "memory");
#pragma unroll
                for (int ds = 0; ds < 2; ++ds) {
#pragma unroll
                    for (int qp = 0; qp < 2; ++qp) { bf16x8 va2[2];
#pragma unroll
                        for (int k2 = 0; k2 < 2; ++k2) va2[k2] = *(const LAS bf16x8*)(lds + vb + (32 * ds + c32) * 128 + (((2 * (2 * qp + k2) + h) ^ sw) * 16));
                        asm volatile("" ::: "memory");
#pragma unroll
                        for (int k2 = 0; k2 < 2; ++k2) oacc[ds] = __builtin_amdgcn_mfma_f32_32x32x16_bf16(va2[k2], pf[qp][k2], oacc[ds], 0, 0, 0);
                        asm volatile("" ::: "memory"); } }
            }
        }
        j0 = j1; j1 = j2; j2 = j3; slot = (slot + 1) & 3;
    }
    asm volatile("s_waitcnt lgkmcnt(0)" ::: "memory"); __builtin_amdgcn_s_barrier(); asm volatile("" ::: "memory");
}
__device__ __forceinline__ void nsa_stash_put(LAS unsigned char* lds, int wave, int lane, const f32x16 (&o)[2], float sc) {
    LAS unsigned* st = (LAS unsigned*)(lds + NSA_SCA) + wave * 1024 + lane;
#pragma unroll
    for (int ds = 0; ds < 2; ++ds)
#pragma unroll
        for (int k = 0; k < 8; ++k) st[(ds * 8 + k) * 64] = pkbf(o[ds][2 * k] * sc, o[ds][2 * k + 1] * sc);
}
#define PSTAMP(slot) do { if (MK_PROBE_MASK != 0 && F.bid == MK_PROBE_BID && F.tid == 0) { volatile LAS unsigned long long* _ta = (volatile LAS unsigned long long*)(F.lds + MISC_OFF + 512); const unsigned long long _n = wall_clock64(); _ta[slot] += _n - _ta[16]; _ta[16] = _n; } } while (0)
__device__ __forceinline__ void phase_nsa2(Frame& F, int l) {
    KA;
    LAS unsigned char* lds = F.lds;
    const bf16* P = (const bf16*)(KWS + WS_P); bf16* OCAT = (bf16*)(KWS + WS_OCAT);
    const bf16* QS = (const bf16*)(KWS + WS_QS);
    const int lane = F.lane, c32 = lane & 31, h = lane >> 5, q8 = c32 >> 2, r = c32 & 3;
    for (int unit = F.bid; unit < 256; unit += F.G) {
        const int g = unit & 1, cblk = unit >> 1, t0 = cblk * 64, head = g * 4 + r, t = t0 + F.wave * 8 + q8;
        u32x4 qxw;
        { const float s2 = exp2f(-(float)(head + 1)) * LOG2E; const unsigned sh = f2bf(s2); const float rem = s2 - bf2f(sh); const unsigned sl = f2bf(rem);
          qxw.x = h == 0 ? (sh | (sh << 16)) : 0u; qxw.y = h == 0 ? (sl | (sl << 16)) : 0u; qxw.z = 0u; qxw.w = 0u; }
        const int tref = t0 + 63;
        bf16x8 Qf[4];
#pragma unroll
        for (int ks = 0; ks < 4; ++ks) Qf[ks] = *(const bf16x8*)(QS + ((size_t)head * T + t) * 64 + 16 * ks + 8 * h);
        for (int u = F.tid; u < (NSA_UM + 16 - NSA_SCA) / 4; u += 512) ((LAS unsigned*)(lds + NSA_SCA))[u] = 0u;
        __syncthreads();
        f32x16 oacc[2];
#pragma unroll
        for (int ds = 0; ds < 2; ++ds)
#pragma unroll
            for (int i = 0; i < 16; ++i) oacc[ds][i] = 0.f;
        unsigned qsel[4] = {0u, 0u, 0u, 0u};
        float sc_cmp;
        PSTAMP(24);
        {
            const int ntile = (4 * cblk + 2) / 64 + 1;
            const unsigned long long cm0 = ntile >= 64 ? ~0ull : ((1ull << ntile) - 1ull);
            const int hi_cmp = t >= 31 ? (t - 31) / 16 : -1;
            const bf16* Kg = (const bf16*)(KWS + WS_KCB) + (size_t)g * 512 * 64; const bf16* VTg = (const bf16*)(KWS + WS_KCB + 131072) + (size_t)g * 64 * 512;
            float l1 = 0.f;
            nsa_branch<0>(F, Kg, VTg, 512, cm0, 0ull, Qf, t, cblk, qxw, tref, 0.f, qsel, hi_cmp, 0u, oacc, l1);
            l1 += __shfl_xor(l1, 32);
            const float inv_l = l1 > 0.f ? 1.0f / l1 : 0.f;
            float l2 = 0.f;
            nsa_branch<1>(F, Kg, VTg, 512, cm0, 0ull, Qf, t, cblk, qxw, tref, inv_l, qsel, hi_cmp, 0u, oacc, l2);
            sc_cmp = sigmoidf_(bf2f(P[(size_t)t * NPAD + C_NG + head])) * inv_l;
        }
        PSTAMP(20);
        {
            LAS float* scA = (LAS float*)(lds + NSA_SCA); LAS float* scB = (LAS float*)(lds + NSA_SCB);
            LAS unsigned* qm = (LAS unsigned*)(lds + NSA_QM); LAS unsigned* um = (LAS unsigned*)(lds + NSA_UM);
            WSYNC();
            const int qq = F.wave * 8 + (lane >> 3), jj = lane & 7;
            unsigned key[16];
#pragma unroll
            for (int m = 0; m < 16; ++m) { const int jb = jj + 8 * m; float sv = scA[qq * 132 + jb] + scB[qq * 132 + jb];
                if (jb == 0 || jb == cblk || jb == cblk - 1) sv = 1e4f;
                key[m] = jb <= cblk ? ((__builtin_bit_cast(unsigned, sv) & ~127u) | (unsigned)(127 - jb)) : 0u; }
            WSYNC();
#pragma unroll
            for (int m = 0; m < 16; ++m) ((LAS unsigned*)scA)[qq * 132 + jj + 8 * m] = key[m];
            WSYNC();
            unsigned bits[4] = {0u, 0u, 0u, 0u};
#pragma unroll
            for (int half = 0; half < 2; ++half) { int rank[8];
#pragma unroll
                for (int m = 0; m < 8; ++m) rank[m] = 0;
#pragma unroll 2
                for (int i = 0; i <= cblk; i += 4) { const u32x4 k4 = *(const LAS u32x4*)((const LAS unsigned*)scA + qq * 132 + i);
#pragma unroll
                    for (int m = 0; m < 8; ++m) rank[m] += (k4.x > key[8 * half + m] ? 1 : 0) + (k4.y > key[8 * half + m] ? 1 : 0) + (k4.z > key[8 * half + m] ? 1 : 0) + (k4.w > key[8 * half + m] ? 1 : 0); }
#pragma unroll
                for (int m = 0; m < 8; ++m) { const int jb = jj + 8 * (8 * half + m); if (jb <= cblk && rank[m] < 16) bits[(8 * half + m) >> 2] |= 1u << (jb & 31); } }
#pragma unroll
            for (int w = 0; w < 4; ++w) if (bits[w]) { atomicOr((unsigned*)(qm + qq * 4 + w), bits[w]); atomicOr((unsigned*)(um + w), bits[w]); }
            __syncthreads();
#pragma unroll
            for (int w = 0; w < 4; ++w) qsel[w] = qm[(F.wave * 8 + q8) * 4 + w];
        }
        PSTAMP(21);
        nsa_stash_put(lds, F.wave, lane, oacc, sc_cmp);
#pragma unroll
        for (int ds = 0; ds < 2; ++ds)
#pragma unroll
            for (int i = 0; i < 16; ++i) oacc[ds][i] = 0.f;
        {
            LAS unsigned* um = (LAS unsigned*)(lds + NSA_UM);
            const unsigned long long sm0 = (unsigned long long)__builtin_amdgcn_readfirstlane(um[0]) | ((unsigned long long)__builtin_amdgcn_readfirstlane(um[1]) << 32);
            const unsigned long long sm1 = (unsigned long long)__builtin_amdgcn_readfirstlane(um[2]) | ((unsigned long long)__builtin_amdgcn_readfirstlane(um[3]) << 32);
            float ls = 0.f;
            nsa_branch<2>(F, (const bf16*)(KWS + WS_KS2) + (size_t)g * T * 64, (const bf16*)(KWS + WS_VST) + (size_t)g * 64 * T, T, sm0, sm1, Qf, t, cblk, qxw, tref, 0.f, qsel, 0, 0u, oacc, ls);
            ls += __shfl_xor(ls, 32);
            const float sc = sigmoidf_(bf2f(P[(size_t)t * NPAD + C_NG + 8 + head])) / ls;
            LAS unsigned* st = (LAS unsigned*)(lds + NSA_SCA) + F.wave * 1024 + lane;
#pragma unroll
            for (int ds = 0; ds < 2; ++ds)
#pragma unroll
                for (int k = 0; k < 8; ++k) { const unsigned w = st[(ds * 8 + k) * 64]; st[(ds * 8 + k) * 64] = pkbf(bflo(w) + sc * oacc[ds][2 * k], bfhi(w) + sc * oacc[ds][2 * k + 1]); oacc[ds][2 * k] = 0.f; oacc[ds][2 * k + 1] = 0.f; }
        }
        PSTAMP(22);
        {
            const int j0 = cblk >= 8 ? cblk - 8 : 0;
            unsigned long long wm0 = 0ull, wm1 = 0ull;
            for (int jb = j0; jb <= cblk; ++jb) { if (jb < 64) wm0 |= 1ull << jb; else wm1 |= 1ull << (jb - 64); }
            float ls = 0.f;
            nsa_branch<3>(F, (const bf16*)(KWS + WS_KW2) + (size_t)g * T * 64, (const bf16*)(KWS + WS_VWT) + (size_t)g * 64 * T, T, wm0, wm1, Qf, t, cblk, qxw, tref, 0.f, qsel, 0, 0u, oacc, ls);
            ls += __shfl_xor(ls, 32);
            const float sc = sigmoidf_(bf2f(P[(size_t)t * NPAD + C_NG + 16 + head])) / ls;
            const LAS unsigned* st = (const LAS unsigned*)(lds + NSA_SCA) + F.wave * 1024 + lane;
#pragma unroll
            for (int ds = 0; ds < 2; ++ds)
#pragma unroll
                for (int g4 = 0; g4 < 4; ++g4) { const unsigned w0 = st[(ds * 8 + 2 * g4) * 64], w1 = st[(ds * 8 + 2 * g4 + 1) * 64];
                    u32x2 w; w.x = pkbf(bflo(w0) + sc * oacc[ds][4 * g4], bfhi(w0) + sc * oacc[ds][4 * g4 + 1]); w.y = pkbf(bflo(w1) + sc * oacc[ds][4 * g4 + 2], bfhi(w1) + sc * oacc[ds][4 * g4 + 3]);
                    *(u32x2*)(OCAT + (size_t)t * 1536 + head * 64 + 32 * ds + 8 * g4 + 4 * h) = w; }
        }
        __syncthreads();
        PSTAMP(23);
    }
}

__device__ __forceinline__ void phase_merge(Frame& F) {
    KA;
    const bf16* P = (const bf16*)(KWS + WS_P); const bf16* PROJ = (const bf16*)(KWS + WS_PROJ); bf16* MG = (bf16*)(KWS + WS_MERGED);
    const size_t total = (size_t)T * D / 8;
    for (size_t it = (size_t)F.gw * 64 + F.lane; it < total; it += (size_t)F.NGW * 64) {
        const size_t t = it / (D / 8); const int d = (int)(it % (D / 8)) * 8;
        float acc[8];
#pragma unroll
        for (int k = 0; k < 8; ++k) acc[k] = 0.f;
#pragma unroll
        for (int n = 0; n < 3; ++n) { const u32x4 gq = *(const u32x4*)(P + t * NPAD + C_MG + n * D + d); const u32x4 pq = *(const u32x4*)(PROJ + ((size_t)n * T + t) * D + d);
            acc[0] += sigmoidf_(bflo(gq.x)) * bflo(pq.x); acc[1] += sigmoidf_(bfhi(gq.x)) * bfhi(pq.x); acc[2] += sigmoidf_(bflo(gq.y)) * bflo(pq.y); acc[3] += sigmoidf_(bfhi(gq.y)) * bfhi(pq.y);
            acc[4] += sigmoidf_(bflo(gq.z)) * bflo(pq.z); acc[5] += sigmoidf_(bfhi(gq.z)) * bfhi(pq.z); acc[6] += sigmoidf_(bflo(gq.w)) * bflo(pq.w); acc[7] += sigmoidf_(bfhi(gq.w)) * bfhi(pq.w); }
        u32x4 o; o.x = pk2(acc[0], acc[1]); o.y = pk2(acc[2], acc[3]); o.z = pk2(acc[4], acc[5]); o.w = pk2(acc[6], acc[7]);
        *(u32x4*)(MG + t * D + d) = o;
    }
}
__device__ __forceinline__ void phase_router(Frame& F, int l) {
    KA;
    const float* X1 = (const float*)(KWS + WS_X1); bf16* H = (bf16*)(KWS + WS_H);
    int* EID = (int*)(KWS + WS_ROUTE); float* EW = (float*)(KWS + WS_ROUTE + 65536);
    const float* gain = KIN(I_NFFN) + (size_t)l * D; const float* wg = KIN(I_WGRP) + (size_t)l * D * 4; const float* we = KIN(I_WEXP) + (size_t)l * D * 32;
    const float* bg = KIN(I_BGRP) + l * 4; const float* be = KIN(I_BEXP) + l * 32;
    for (int t = F.gw; t < T; t += F.NGW) {
        const float* xrow = X1 + (size_t)t * D;
        float ss = 0.f;
#pragma unroll 4
        for (int k = 0; k < 32; ++k) { const float x = xrow[F.lane + 64 * k]; ss += x * x; }
        const float rstd = 1.0f / sqrtf(wave_sum(ss) * (1.0f / D) + EPS);
        float ag[4] = {0.f, 0.f, 0.f, 0.f}, ae[32];
#pragma unroll
        for (int e = 0; e < 32; ++e) ae[e] = 0.f;
#pragma unroll 1
        for (int k = 0; k < 32; ++k) { const int d = F.lane + 64 * k;
            const float hv = xrow[d] * rstd * gain[d];
            H[(size_t)t * D + d] = (bf16)f2bf(hv);
            const f32x4 w4 = *(const f32x4*)(wg + (size_t)d * 4);
            ag[0] += hv * w4.x; ag[1] += hv * w4.y; ag[2] += hv * w4.z; ag[3] += hv * w4.w;
#pragma unroll
            for (int c = 0; c < 8; ++c) { const f32x4 w = *(const f32x4*)(we + (size_t)d * 32 + c * 4); ae[c * 4] += hv * w.x; ae[c * 4 + 1] += hv * w.y; ae[c * 4 + 2] += hv * w.z; ae[c * 4 + 3] += hv * w.w; } }
#pragma unroll
        for (int e = 0; e < 4; ++e) ag[e] = wave_sum(ag[e]) + bg[e];
#pragma unroll
        for (int e = 0; e < 32; ++e) ae[e] = wave_sum(ae[e]) + be[e];
        int gi = 0; float gm = ag[0];
#pragma unroll
        for (int e = 1; e < 4; ++e) if (ag[e] > gm) { gm = ag[e]; gi = e; }
        float gs = 0.f;
#pragma unroll
        for (int e = 0; e < 4; ++e) gs += expf(ag[e] - gm);
        const float gw_ = 1.0f / gs;
        float el[8];
#pragma unroll
        for (int e = 0; e < 8; ++e) { el[e] = gi == 0 ? ae[e] : (gi == 1 ? ae[8 + e] : (gi == 2 ? ae[16 + e] : ae[24 + e])); }
        int i1 = 0; float m1 = el[0];
#pragma unroll
        for (int e = 1; e < 8; ++e) if (el[e] > m1) { m1 = el[e]; i1 = e; }
        int i2 = -1; float m2 = -3.0e38f;
#pragma unroll
        for (int e = 0; e < 8; ++e) if (e != i1 && el[e] > m2) { m2 = el[e]; i2 = e; }
        const float p2 = expf(m2 - m1);
        const float w1 = 1.0f / (1.0f + p2), w2 = p2 / (1.0f + p2);
        if (F.lane == 0) { EID[2 * t] = gi * 8 + i1; EID[2 * t + 1] = gi * 8 + i2; EW[2 * t] = gw_ * w1; EW[2 * t + 1] = gw_ * w2; }
    }
}

__device__ __forceinline__ void phase_router3(Frame& F, int l) {
    KA;
    const float* X1 = (const float*)(KWS + WS_X1); bf16* H = (bf16*)(KWS + WS_H);
    int* EID = (int*)(KWS + WS_ROUTE); float* EW = (float*)(KWS + WS_ROUTE + 65536); int* HIST = (int*)(KWS + WS_HIST); float* RSTD = (float*)(KWS + WS_RSTD);
    const float* WRT = (const float*)(KWS + WS_WRT) + (size_t)l * 48 * D;
    const float* gain = KIN(I_NFFN) + (size_t)l * D; const float* bg = KIN(I_BGRP) + l * 4; const float* be = KIN(I_BEXP) + l * 32;
    LAS float* red = (LAS float*)F.lds;
    LAS float* ssq = (LAS float*)(F.lds + 49152);
    LAS float* lg = (LAS float*)(F.lds + 50176);
    LAS float* rs = (LAS float*)(F.lds + 55296);
    LAS int* eidl = (LAS int*)(F.lds + 55424);
    const int r16 = F.lane & 15, kq = F.lane >> 4;
    for (int blk = F.bid; blk < T / 32; blk += F.G) {
        const int tok0 = blk * 32, kb0 = F.wave * 256 + 4 * kq;
        const float* xa = X1 + (size_t)(tok0 + r16) * D + kb0;
        const float* wb = WRT + (size_t)r16 * D + kb0;
        bf16* hp = H + (size_t)(tok0 + r16) * D + kb0;
        f32x4 acc[2][3]; float sq[2] = {0.f, 0.f};
#pragma unroll
        for (int tg = 0; tg < 2; ++tg)
#pragma unroll
            for (int nt = 0; nt < 3; ++nt) acc[tg][nt] = (f32x4){0.f, 0.f, 0.f, 0.f};
#pragma unroll 2
        for (int s = 0; s < 16; ++s) { f32x4 a[2], b[3];
#pragma unroll
            for (int tg = 0; tg < 2; ++tg) a[tg] = *(const f32x4*)(xa + (size_t)(16 * tg) * D + 16 * s);
#pragma unroll
            for (int nt = 0; nt < 3; ++nt) b[nt] = *(const f32x4*)(wb + (size_t)(16 * nt) * D + 16 * s);
            const f32x4 g = *(const f32x4*)(gain + kb0 + 16 * s);
#pragma unroll
            for (int tg = 0; tg < 2; ++tg) { sq[tg] += a[tg].x * a[tg].x + a[tg].y * a[tg].y + a[tg].z * a[tg].z + a[tg].w * a[tg].w;
                u32x2 o; o.x = pkbf(a[tg].x * g.x, a[tg].y * g.y); o.y = pkbf(a[tg].z * g.z, a[tg].w * g.w);
                *(u32x2*)(hp + (size_t)(16 * tg) * D + 16 * s) = o;
#pragma unroll
                for (int j = 0; j < 4; ++j)
#pragma unroll
                    for (int nt = 0; nt < 3; ++nt) acc[tg][nt] = __builtin_amdgcn_mfma_f32_16x16x4f32(a[tg][j], b[nt][j], acc[tg][nt], 0, 0, 0); } }
#pragma unroll
        for (int tg = 0; tg < 2; ++tg) { sq[tg] += __shfl_xor(sq[tg], 16); sq[tg] += __shfl_xor(sq[tg], 32);
            if (kq == 0) ssq[F.wave * 32 + 16 * tg + r16] = sq[tg];
#pragma unroll
            for (int nt = 0; nt < 3; ++nt) *(LAS f32x4*)(red + (((F.wave * 2 + tg) * 3 + nt) * 64 + F.lane) * 4) = acc[tg][nt]; }
        __syncthreads();
        if (F.tid < 384) { const int tg2 = F.tid / 192, rem = F.tid % 192, nt = rem / 64, ln = rem % 64; f32x4 v = {0.f, 0.f, 0.f, 0.f};
#pragma unroll
            for (int w = 0; w < 8; ++w) v += *(const LAS f32x4*)(red + (((w * 2 + tg2) * 3 + nt) * 64 + ln) * 4);
            const int col = 16 * nt + (ln & 15);
            if (col < 36) {
#pragma unroll
                for (int i = 0; i < 4; ++i) lg[(16 * tg2 + 4 * (ln >> 4) + i) * 40 + col] = v[i]; } }
        if (F.tid >= 384 && F.tid < 416) { const int tk = F.tid - 384; float q2 = 0.f;
#pragma unroll
            for (int w = 0; w < 8; ++w) q2 += ssq[w * 32 + tk];
            const float r = 1.0f / sqrtf(q2 * (1.0f / D) + EPS); rs[tk] = r; RSTD[tok0 + tk] = r; }
        __syncthreads();
        if (F.tid < 32) { const int tk = F.tid, t = tok0 + tk; const float rstd = rs[tk];
            float ag[4], el[8];
#pragma unroll
            for (int e = 0; e < 4; ++e) ag[e] = lg[tk * 40 + 32 + e] * rstd + bg[e];
            int gi = 0; float gm = ag[0];
#pragma unroll
            for (int e = 1; e < 4; ++e) if (ag[e] > gm) { gm = ag[e]; gi = e; }
            float gs = 0.f;
#pragma unroll
            for (int e = 0; e < 4; ++e) gs += expf(ag[e] - gm);
            const float gw_ = 1.0f / gs;
#pragma unroll
            for (int e = 0; e < 8; ++e) el[e] = lg[tk * 40 + gi * 8 + e] * rstd + be[gi * 8 + e];
            int i1 = 0; float m1 = el[0];
#pragma unroll
            for (int e = 1; e < 8; ++e) if (el[e] > m1) { m1 = el[e]; i1 = e; }
            int i2 = -1; float m2 = -3.0e38f;
#pragma unroll
            for (int e = 0; e < 8; ++e) if (e != i1 && el[e] > m2) { m2 = el[e]; i2 = e; }
            const float p2 = expf(m2 - m1), w1 = 1.0f / (1.0f + p2), w2 = p2 / (1.0f + p2);
            EID[2 * t] = gi * 8 + i1; EID[2 * t + 1] = gi * 8 + i2; EW[2 * t] = gw_ * w1; EW[2 * t + 1] = gw_ * w2;
            eidl[2 * tk] = gi * 8 + i1; eidl[2 * tk + 1] = gi * 8 + i2; }
        __syncthreads();
        if (F.tid < 32) { int c = 0;
#pragma unroll 8
            for (int i = 0; i < 64; ++i) c += eidl[i] == F.tid ? 1 : 0;
            HIST[blk * 32 + F.tid] = c; }
        __syncthreads();
    }
}
__device__ __forceinline__ void phase_lists2(Frame& F) {
    KA;
    const int* EID = (const int*)(KWS + WS_ROUTE); int* CNT = (int*)(KWS + WS_ROUTE + 131072); int* LIST = (int*)(KWS + WS_ROUTE + 262144); const int* HIST = (const int*)(KWS + WS_HIST);
    LAS int* off = (LAS int*)F.lds; LAS int* eidl = off + 32; LAS int* psum = off + 128;
    for (int blk = F.bid; blk < T / 32; blk += F.G) {
        { const int e = F.tid & 31, part = F.tid >> 5; int a = 0;
#pragma unroll 4
          for (int b2 = part; b2 < blk; b2 += 16) a += HIST[b2 * 32 + e];
          psum[part * 32 + e] = a; }
        __syncthreads();
        if (F.tid < 32) { int a = 0;
#pragma unroll
            for (int p = 0; p < 16; ++p) a += psum[p * 32 + F.tid];
            off[F.tid] = a;
            if (blk == T / 32 - 1) CNT[F.tid] = a + HIST[blk * 32 + F.tid]; }
        if (F.tid >= 64 && F.tid < 128) eidl[F.tid - 64] = EID[blk * 64 + F.tid - 64];
        __syncthreads();
        if (F.tid < 64) { const int e = eidl[F.tid]; int rk = 0;
            for (int i = 0; i < F.tid; ++i) rk += eidl[i] == e ? 1 : 0;
            LIST[e * 8192 + off[e] + rk] = blk * 64 + F.tid; }
        __syncthreads();
    }
}

__device__ __forceinline__ void phase_lists(Frame& F) {
    KA;
    const int e = F.bid;
    if (e >= NE) return;
    const int* EID = (const int*)(KWS + WS_ROUTE); int* CNT = (int*)(KWS + WS_ROUTE + 131072); int* LIST = (int*)(KWS + WS_ROUTE + 262144);
    LAS int* wc = (LAS int*)F.lds;
    int run = 0;
    for (int base = 0; base < 2 * T; base += 512) {
        const int idx = base + F.tid; const bool match = EID[idx] == e;
        const unsigned long long b = __ballot(match);
        if (F.lane == 0) wc[F.wave] = __popcll(b);
        __syncthreads();
        int pre = 0, tot = 0;
#pragma unroll
        for (int w = 0; w < 8; ++w) { const int c = wc[w]; pre += w < F.wave ? c : 0; tot += c; }
        if (match) LIST[e * 8192 + run + pre + __popcll(b & ((1ull << F.lane) - 1ull))] = idx;
        run += tot;
        __syncthreads();
    }
    if (F.tid == 0) CNT[e] = run;
}
__device__ __forceinline__ void moe_table(Frame& F, LAS int* tb) {
    KA;
    const int* CNT = (const int*)(KWS + WS_ROUTE + 131072);
    if (F.tid == 0) { int a = 0, f = 0, h = 0;
        for (int e = 0; e < NE; ++e) { const int n = CNT[e], nt = (n + 255) / 256, lastv = n - (nt - 1) * 256, hh = (nt > 0 && lastv <= 128) ? 1 : 0;
            tb[e] = a; tb[33 + e] = f; tb[66 + e] = h; a += nt; f += nt - hh; h += hh; }
        tb[NE] = a; tb[33 + NE] = f; tb[66 + NE] = h; }
    __syncthreads();
}

constexpr int PH_PER_LAYER = 9, N_PHASES = 1 + NL * PH_PER_LAYER + 1;

__global__ void __launch_bounds__(512, 2) mk_fwd(Args args) {
    extern __shared__ __attribute__((aligned(16))) unsigned char lds_raw[];
#define FRAME Frame F; F.lds = (LAS unsigned char*)lds_raw; F.MISC = (volatile LAS unsigned*)(F.lds + MISC_OFF); F.tid = ltid(); F.lane = F.tid & 63; F.wave = __builtin_amdgcn_readfirstlane(F.tid >> 6); \
    F.G = gridDim.x; F.bid = lbid(); F.vcu = (F.G % 8 == 0) ? (F.bid % 8) * (F.G / 8) + F.bid / 8 : F.bid; F.gw = F.bid * 8 + F.wave; F.NGW = F.G * 8;
    unsigned* const ctl = (unsigned*)((unsigned char*)args.ws + WS_CTL);
    for (int u = threadIdx.x; u < (LDS_BYTES - MISC_OFF) / 4; u += 512) ((LAS unsigned*)(lds_raw + MISC_OFF))[u] = 0u;
    __syncthreads();
    const int lo = args.ph_lo, hi = args.ph_hi;
    XcdBarrier bar; bar.bar = ctl + CW_BAR + args.li * XCD_BAR_WORDS; bar.x = 0; bar.st = nullptr;
    if (hi - lo > 1) bar = xcd_barrier_post(ctl + CW_BAR + args.li * XCD_BAR_WORDS, (volatile LAS unsigned*)((LAS unsigned char*)lds_raw + MISC_OFF));
    int ph = 0;
#define RUN(k) ((k) >= lo && (k) < hi)

    volatile LAS unsigned long long* const tacc = (volatile LAS unsigned long long*)((LAS unsigned char*)lds_raw + MISC_OFF + 512);
    if (MK_PROBE_MASK != 0 && blockIdx.x == MK_PROBE_BID && threadIdx.x == 0) tacc[16] = wall_clock64();
#define STAMP(slot) do { if (MK_PROBE_MASK != 0 && lbid() == MK_PROBE_BID && ltid() == 0) { const unsigned long long _n = wall_clock64(); tacc[slot] += _n - tacc[16]; tacc[16] = _n; } } while (0)
#define SEAM(k, slot) do { if ((k) + 1 < hi) xcd_barrier(bar); STAMP(slot); } while (0)
    LAS int* const tb = (LAS int*)((LAS unsigned char*)lds_raw + MISC_OFF + 64);

    if (RUN(ph)) { KA; FRAME; phase_prologue(F); phase_norm1<0>(F, KIN(I_X), nullptr, nullptr, KIN(I_NMIX), (bf16*)(KWS + WS_H)); SEAM(ph, 0); }
    ++ph;
    for (int l = 0; l < NL; ++l) {
        if (RUN(ph)) { KA; FRAME; pg8::PlainSched S; S.init((const bf16*)(KWS + WS_H), D, (const bf16*)(KWS + WS_WIN) + (size_t)l * NPAD * D, T, NPAD, D, F.G, F.bid, 4); S.probe = 1;
            pg8::EpiBf16 E{(bf16*)(KWS + WS_P), NPAD};
            pg8::gemm_phase<pg8::EpiBf16, pg8::PlainSched, true>(F.lds, D, S, E); SEAM(ph, 1); }
        ++ph;
        if (RUN(ph)) { KA; FRAME; phase_prep3(F, l); __syncthreads(); phase_compress3(F, l); phase_rec_local(F, l); SEAM(ph, 3); }
        ++ph;
        if (RUN(ph)) { KA; FRAME; if (F.bid < 96) { phase_rec_scan(F);
                asm volatile("s_waitcnt vmcnt(0)" ::: "memory"); __syncthreads();
                if (F.tid == 0) { __builtin_amdgcn_fence(__ATOMIC_RELEASE, "agent"); asm volatile("s_waitcnt vmcnt(0)" ::: "memory");
                    __hip_atomic_fetch_add((unsigned*)(KWS + WS_CTL) + 2048 + 64 * (4 + l), 1u, __ATOMIC_RELAXED, __HIP_MEMORY_SCOPE_AGENT); } }
            phase_nsa2(F, l); phase_rec_out(F, l); SEAM(ph, 5); }
        ++ph;
        if (RUN(ph)) { KA; FRAME;
            { pg8::BranchSched S; S.init((const bf16*)(KWS + WS_OCAT), (const bf16*)(KWS + WS_WBR) + (size_t)l * 3 * D * 512, F.G, F.bid);
              pg8::EpiMerge E{(bf16*)(KWS + WS_MERGED), (const bf16*)(KWS + WS_P) + C_MG};
              pg8::gemm_phase<pg8::EpiMerge, pg8::BranchSched, true>(F.lds, 512, S, E); }
            SEAM(ph, 6); }
        ++ph;

        if (RUN(ph)) { KA; FRAME; pg8::PlainSched S; S.init((const bf16*)(KWS + WS_MERGED), D, (const bf16*)(KWS + WS_WOUT) + (size_t)l * D * D, T, D, D, F.G, F.bid);
            pg8::EpiResF32 E{l == 0 ? KIN(I_X) : (const float*)(KWS + WS_XRES), (float*)(KWS + WS_X1), D};
            pg8::gemm_phase<pg8::EpiResF32, pg8::PlainSched, false>(F.lds, D, S, E); SEAM(ph, 8); }
        ++ph;
        if (RUN(ph)) { KA; FRAME; phase_router3(F, l); SEAM(ph, 9); }
        ++ph;
        if (RUN(ph)) { KA; FRAME; phase_lists2(F); SEAM(ph, 10); }
        ++ph;
        if (RUN(ph)) { KA; FRAME; moe_table(F, tb);
            pg8::MoeSched<1> S; S.init(F.G, F.vcu, tb, (const int*)(KWS + WS_ROUTE + 131072), (const int*)(KWS + WS_ROUTE + 262144), KWS + WS_H, (const bf16*)(KWS + WS_WGU) + (size_t)l * NE * 1024 * D);
            pg8::EpiMoe1 E{(bf16*)(KWS + WS_ACT), (const int*)(KWS + WS_ROUTE + 262144), (const float*)(KWS + WS_ROUTE + 65536), (const float*)(KWS + WS_RSTD)};
            pg8::gemm_phase<pg8::EpiMoe1, pg8::MoeSched<1>, true>(F.lds, D, S, E); SEAM(ph, 11); }
        ++ph;
        if (RUN(ph)) { KA; FRAME; moe_table(F, tb);
            pg8::MoeSched<2> S; S.init(F.G, F.vcu, tb, (const int*)(KWS + WS_ROUTE + 131072), (const int*)(KWS + WS_ROUTE + 262144), KWS + WS_ACT, (const bf16*)(KWS + WS_WDN) + (size_t)l * NE * D * FF);
            pg8::EpiMoe2 E{(bf16*)(KWS + WS_CONTRIB), (const int*)(KWS + WS_ROUTE + 262144)};
            pg8::gemm_phase<pg8::EpiMoe2, pg8::MoeSched<2>, true>(F.lds, FF, S, E); SEAM(ph, 12); }
        ++ph;
        if (l + 1 < NL) { if (RUN(ph)) { KA; FRAME; phase_norm1<1>(F, (const float*)(KWS + WS_X1), (const bf16*)(KWS + WS_CONTRIB), (float*)(KWS + WS_XRES), KIN(I_NMIX) + (size_t)(l + 1) * D, (bf16*)(KWS + WS_H)); SEAM(ph, 13); } ++ph; }
    }
    if (RUN(ph)) { KA; FRAME; phase_norm1<2>(F, (const float*)(KWS + WS_X1), (const bf16*)(KWS + WS_CONTRIB), KOUT, nullptr, nullptr); }
    if (MK_PROBE_MASK != 0 && lbid() == MK_PROBE_BID && ltid() == 0) {
        asm volatile("s_waitcnt vmcnt(0)" ::: "memory"); STAMP(15);
        unsigned long long tot = 0ull;
        for (int k2 = 0; k2 < 32; ++k2) if (k2 != 16 && ((MK_PROBE_MASK >> k2) & 1)) tot += tacc[k2];
        const unsigned long long t_end = wall_clock64() + 4ull * tot;
        while (wall_clock64() < t_end) __builtin_amdgcn_s_sleep(8);
    }
#undef RUN
#undef SEAM
}

#ifndef MK_PER_PHASE
#define MK_PER_PHASE 0
#endif
extern "C" void kernel_launch(void* const* d_in, const int* in_sizes, int n_in, void* d_out, int out_size, void* d_ws, size_t ws_size, hipStream_t stream) {
    static int grid = 0;
    if (grid == 0) {
        if (n_in != 22 || out_size != T * D || ws_size < WS_END) { fprintf(stderr, "kernel_launch: unexpected sizes (n_in %d out %d ws %zu)\n", n_in, out_size, ws_size); grid = -1; return; }
        int dev = 0, cus = 0, per_cu = 0;
        if (hipGetDevice(&dev) != hipSuccess || hipDeviceGetAttribute(&cus, hipDeviceAttributeMultiprocessorCount, dev) != hipSuccess) { grid = -1; return; }
        if (hipFuncSetAttribute((const void*)mk_fwd, hipFuncAttributeMaxDynamicSharedMemorySize, LDS_BYTES) != hipSuccess) { fprintf(stderr, "kernel_launch: hipFuncSetAttribute failed\n"); grid = -1; return; }
        if (hipOccupancyMaxActiveBlocksPerMultiprocessor(&per_cu, (const void*)mk_fwd, 512, LDS_BYTES) != hipSuccess || per_cu < 1) { fprintf(stderr, "kernel_launch: occupancy query says %d\n", per_cu); }
        (void)hipGetLastError();
        grid = cus;
    }
    if (grid < 0) return;
    if (hipMemsetAsync((char*)d_ws + WS_CTL, 0, CTL_ZERO_BYTES, stream) != hipSuccess) return;
    Args a{};
    for (int i = 0; i < 22; ++i) a.in[i] = (const GAS float*)d_in[i];
    a.out = (GAS float*)d_out; a.ws = (GAS unsigned char*)d_ws;
#if MK_PER_PHASE
    const int total = 1 + NL * PH_PER_LAYER + (NL - 1) + 1;
    for (int k = 0; k < total; ++k) { a.ph_lo = k; a.ph_hi = k + 1; a.li = 0; hipLaunchKernelGGL(mk_fwd, dim3(grid), dim3(512), LDS_BYTES, stream, a); }
#else
    a.ph_lo = 0; a.ph_hi = 1000; a.li = 0;
    hipLaunchKernelGGL(mk_fwd, dim3(grid), dim3(512), LDS_BYTES, stream, a);
#endif
    const hipError_t le = hipPeekAtLastError();
    if (le != hipSuccess) fprintf(stderr, "kernel_launch: launch failed: %s\n", hipGetErrorName(le));
}
```

```cpp
#include <hip/hip_runtime.h>
#include <cstdio>
#include <cstdint>

#ifndef MK_PROBE_MASK
#define MK_PROBE_MASK 0
#endif
#ifndef MK_PROBE_BID
#define MK_PROBE_BID 0
#endif
#define GAS __attribute__((address_space(1)))
#define LAS __attribute__((address_space(3)))
typedef unsigned short bf16;
typedef short bf16x8 __attribute__((ext_vector_type(8)));
typedef float f32x4 __attribute__((ext_vector_type(4)));
typedef float f32x2 __attribute__((ext_vector_type(2)));
typedef unsigned u32x4 __attribute__((ext_vector_type(4)));
typedef unsigned u32x2 __attribute__((ext_vector_type(2)));

constexpr int T = 8192, D = 2048, NL = 2, INC = 11048, NPAD = 11264;
constexpr int NE = 32, FF = 512, NCH = T / 64;
constexpr float EPS = 1e-6f, NEGB = -1e30f;
constexpr int C_Q = 0, C_KC = 512, C_VC = 640, C_KS = 768, C_VS = 896, C_KW = 1024, C_VW = 1152;
constexpr int C_HQ = 1280, C_HF = 1792, C_HI = 2304, C_HG = 2816, C_GQ = 3328, C_GK = 3584, C_GV = 3840, C_GR = 4352;
constexpr int C_MG = 4864, C_NG = 11008, C_GA = 11032;

constexpr size_t MiB = 1u << 20;
constexpr size_t WS_CTL = 0, CTL_ZERO_BYTES = 1 * MiB;
constexpr size_t WS_WIN = 2 * MiB;
constexpr size_t WS_WBR = 90 * MiB;
constexpr size_t WS_WOUT = 102 * MiB;
constexpr size_t WS_WGU = 118 * MiB;
constexpr size_t WS_WDN = 374 * MiB;
constexpr size_t WS_H = 502 * MiB;
constexpr size_t WS_P = 534 * MiB;
constexpr size_t WS_OCAT = 710 * MiB;
constexpr size_t WS_PROJ = 734 * MiB;
constexpr size_t WS_MERGED = 830 * MiB;
constexpr size_t WS_X1 = 862 * MiB;
constexpr size_t WS_XRES = 926 * MiB;
constexpr size_t WS_CONTRIB = 990 * MiB;
constexpr size_t WS_ACT = 1054 * MiB;
constexpr size_t WS_QN = 1078 * MiB;
constexpr size_t WS_KV = 1094 * MiB;
constexpr size_t WS_KC = 1118 * MiB;
constexpr size_t WS_ORAW = 1119 * MiB;
constexpr size_t WS_ROUTE = 1151 * MiB;
constexpr size_t WS_SLOC_HG = 1153 * MiB;
constexpr size_t WS_SLOC_GL = 1185 * MiB;
constexpr size_t WS_SPREV_HG = 1201 * MiB;
constexpr size_t WS_SPREV_GL = 1217 * MiB;
constexpr size_t WS_DEC = 1225 * MiB;
constexpr size_t WS_QS = 1226 * MiB;
constexpr size_t WS_KS2 = 1234 * MiB;
constexpr size_t WS_KW2 = 1236 * MiB;
constexpr size_t WS_VST = 1238 * MiB;
constexpr size_t WS_VWT = 1240 * MiB;
constexpr size_t WS_KCB = 1242 * MiB;
constexpr size_t WS_WRT = 1243 * MiB;
constexpr size_t WS_HIST = 1244 * MiB;
constexpr size_t WS_CW = 1245 * MiB;
constexpr size_t WS_RSTD = 1247 * MiB;
constexpr size_t WS_END = 1248 * MiB;
constexpr size_t KV_STRIDE = (size_t)2 * T * 64;
constexpr int CW_BAR = 4096;

constexpr int RING_BYTES = 131072;
constexpr int LDS_BYTES = 147456;
constexpr int MISC_OFF = LDS_BYTES - 2048;

#define LDS_WAIT() asm volatile("s_waitcnt lgkmcnt(0)" ::: "memory")
#define VM_WAIT() asm volatile("s_waitcnt vmcnt(0)" ::: "memory")
#define WSYNC() asm volatile("s_waitcnt lgkmcnt(0)" ::: "memory")

__device__ __forceinline__ unsigned f2bf(float f) { unsigned u = __builtin_bit_cast(unsigned, f); return (u + 0x7fffu + ((u >> 16) & 1u)) >> 16; }
__device__ __forceinline__ unsigned pk2(float lo, float hi) { return f2bf(lo) | (f2bf(hi) << 16); }
__device__ __forceinline__ float bf2f(unsigned b) { return __builtin_bit_cast(float, (b & 0xffffu) << 16); }
__device__ __forceinline__ float bflo(unsigned w) { return __builtin_bit_cast(float, w << 16); }
__device__ __forceinline__ float bfhi(unsigned w) { return __builtin_bit_cast(float, w & 0xffff0000u); }
__device__ __forceinline__ float wave_sum(float v) {
#pragma unroll
    for (int o = 1; o < 64; o <<= 1) v += __shfl_xor(v, o);
    return v;
}
__device__ __forceinline__ float wave_max(float v) {
#pragma unroll
    for (int o = 1; o < 64; o <<= 1) v = fmaxf(v, __shfl_xor(v, o));
    return v;
}
__device__ __forceinline__ int ltid() { int t = threadIdx.x; asm volatile("" : "+v"(t)); return t; }
__device__ __forceinline__ int lbid() { int b = blockIdx.x; asm volatile("" : "+s"(b)); return b; }
typedef __bf16 bf16x2_t __attribute__((ext_vector_type(2)));
__device__ __forceinline__ unsigned pkbf(float lo, float hi) { const f32x2 v = {lo, hi}; return __builtin_bit_cast(unsigned, __builtin_convertvector(v, bf16x2_t)); }
constexpr float LOG2E = 1.4426950408889634f;
__device__ __forceinline__ float sigmoidf_(float x) { return 1.0f / (1.0f + expf(-x)); }
__device__ __forceinline__ float fsig(float x) { return __builtin_amdgcn_rcpf(1.0f + __builtin_amdgcn_exp2f(-LOG2E * x)); }

#define GSTAMP(lds_, slot) do { if (MK_PROBE_MASK != 0 && lbid() == MK_PROBE_BID && ltid() == 0) { volatile LAS unsigned long long* _ta = (volatile LAS unsigned long long*)((lds_) + MISC_OFF + 512); const unsigned long long _n = wall_clock64(); _ta[slot] += _n - _ta[16]; _ta[16] = _n; } } while (0)
#define XB_TMO      128
#define XB_XCNT(j)  (256  + 64 * (j))
#define XB_XSUB(j)  (1280 + 64 * (j))
#define XB_XGEN(j)  (2304 + 64 * (j))
#define XB_TOP      3328
#define XB_TOPGEN   3392
#define XCD_BAR_WORDS 3456
#define XB_SPIN_CAP (1u << 25)

__device__ __forceinline__ unsigned xb_ld(unsigned* p)              { return __hip_atomic_load(p, __ATOMIC_RELAXED, __HIP_MEMORY_SCOPE_AGENT); }
__device__ __forceinline__ unsigned xb_add(unsigned* p, unsigned v) { return __hip_atomic_fetch_add(p, v, __ATOMIC_RELAXED, __HIP_MEMORY_SCOPE_AGENT); }
__device__ __forceinline__ unsigned xb_xcc_id() { return (unsigned)__builtin_amdgcn_s_getreg((3 << 11) | 20) & 0xFu; }
#define XB_SPIN(cond, bar) do { unsigned _sp = 0; while (cond) { __builtin_amdgcn_s_sleep(1); \
    if ((++_sp & 255u) == 0u) { if (xb_ld(&(bar)[XB_TMO])) break; if (_sp > XB_SPIN_CAP) { atomicAdd(&(bar)[XB_TMO], 1u); break; } } } } while (0)

struct XcdBarrier { unsigned* bar; unsigned x; volatile LAS unsigned* st; };

__device__ __forceinline__ XcdBarrier xcd_barrier_post(unsigned* bar, volatile LAS unsigned* st) {
    XcdBarrier b; b.bar = bar; b.x = xb_xcc_id(); b.st = st;
    if (threadIdx.x == 0) (void)xb_add(&bar[XB_XCNT(b.x)], 1u);
    return b;
}
__device__ __forceinline__ void xcd_barrier_complete(unsigned* bar, unsigned x, unsigned& nloc, unsigned& nx) {
    const unsigned G = gridDim.x * gridDim.y * gridDim.z;
    unsigned sum, cnt, mine, sp = 0u;
    for (;;) {
        sum = 0u; cnt = 0u; mine = 0u;
#pragma unroll
        for (unsigned j = 0; j < 16; ++j) { const unsigned c = xb_ld(&bar[XB_XCNT(j)]); sum += c; cnt += (c > 0u) ? 1u : 0u; mine = (j == x) ? c : mine; }
        if (sum == G) break;
        __builtin_amdgcn_s_sleep(1);
        if ((++sp & 255u) == 0u) { if (xb_ld(&bar[XB_TMO])) break; if (sp > XB_SPIN_CAP) { atomicAdd(&bar[XB_TMO], 1u); break; } }
    }
    nloc = mine > 0u ? mine : 1u; nx = cnt > 0u ? cnt : 1u;
}
__device__ __forceinline__ void xcd_barrier(const XcdBarrier& b) {
    asm volatile("s_waitcnt vmcnt(0)" ::: "memory");
    __syncthreads();
    if (threadIdx.x == 0) {
        unsigned* bar = b.bar;
        __builtin_amdgcn_s_waitcnt(0);
        unsigned nloc = b.st[0], nx = b.st[1];
        if (nloc == 0u) { xcd_barrier_complete(bar, b.x, nloc, nx); b.st[0] = nloc; b.st[1] = nx; }
        const unsigned old = xb_add(&bar[XB_XSUB(b.x)], 1u);
        const unsigned gen = old / nloc;
        if (old + 1u == (gen + 1u) * nloc) {
            __builtin_amdgcn_fence(__ATOMIC_RELEASE, "agent");
            asm volatile("s_waitcnt vmcnt(0)" ::: "memory");
            const unsigned og = xb_add(&bar[XB_TOP], 1u);
            const unsigned tg = og / nx;
            if (og + 1u == (tg + 1u) * nx) xb_add(&bar[XB_TOPGEN], 1u);
            else XB_SPIN(xb_ld(&bar[XB_TOPGEN]) == tg, bar);
            __builtin_amdgcn_fence(__ATOMIC_ACQUIRE, "agent");
            xb_add(&bar[XB_XGEN(b.x)], 1u);
            asm volatile("s_waitcnt vmcnt(0)" ::: "memory");
        } else {
            XB_SPIN(xb_ld(&bar[XB_XGEN(b.x)]) == gen, bar);
            __builtin_amdgcn_fence(__ATOMIC_ACQUIRE, "agent");
            asm volatile("s_waitcnt vmcnt(0)" ::: "memory");
        }
    }
    __syncthreads();
}

namespace pg8 {
constexpr int BM = 256, BK = 64, HALF = 128, HTB = HALF * BK * 2, STAGE_BYTES = 8 * HTB, NXCD = 8, WGM = 8;
__host__ __device__ __forceinline__ int lds_byte(int r, int c) { const int st = (r >> 4) * 2 + (c >> 5), rr = r & 15, cc = c & 31, ob = rr * 64 + cc * 2; return st * 1024 + (ob ^ (((ob >> 9) & 1) << 5)); }
__host__ __device__ __forceinline__ void stage_rc(int b, int& R, int& C) { const int st = b / 1024, sb = b % 1024, swz = sb ^ (((sb >> 9) & 1) << 5); R = (st >> 1) * 16 + swz / 64; C = (st & 1) * 32 + (swz % 64) / 2; }
__host__ __device__ __forceinline__ int perm32(int rho) { const int n = rho >> 4, i = rho & 15; return 8 * (i >> 2) + 4 * n + (i & 3); }

struct Unit { int pm, pn, e, nvalid, slot0, half, row0; const char *A0, *A1, *B0, *B1; unsigned va[2][2]; };

__device__ __forceinline__ unsigned cvt_pk_bf16(float lo, float hi) { unsigned r; asm volatile("v_cvt_pk_bf16_f32 %0, %1, %2" : "=v"(r) : "v"(lo), "v"(hi)); return r; }

template <class Epi, class Sched, bool ALIGN_EPI>
__device__ __forceinline__ void gemm_phase(LAS unsigned char* lds, const int K, const Sched& S, const Epi& E) {
    const int tid = ltid(), wid = __builtin_amdgcn_readfirstlane(tid >> 6), lane = tid & 63, wr = wid >> 2, wc = wid & 3, fr = lane & 15, fq = lane >> 4;
    const int nt = K / BK;
    unsigned voffB[2];
#pragma unroll
    for (int i = 0; i < 2; ++i) { int R, C; stage_rc(tid * 16 + i * 8192, R, C); const int Rb = Epi::PERM ? ((R & ~31) + perm32(R & 31)) : R; voffB[i] = (unsigned)(Rb * K + C) * 2u; }
    const size_t kstep = (size_t)(BK * 2);
    const unsigned ldsw = (unsigned)wid * 1024u;
    const int aoff = lds_byte(wr * 64 + fr, fq * 8), boff = lds_byte(wc * 32 + fr, fq * 8);
#define PG8_SA(b, h) (((b) * 2 + (h)) * HTB)
#define PG8_SB(b, h) ((4 + (b) * 2 + (h)) * HTB)
#define PG8_STAGE(bufoff, gbase, voff) do { _Pragma("unroll") for (int _i = 0; _i < 2; ++_i) \
        __builtin_amdgcn_global_load_lds((const unsigned*)((const char*)(gbase) + (voff)[_i]), (LAS unsigned*)(lds + (bufoff) + ldsw + _i * 8192), 16, 0, 0); } while (0)
#define PG8_LDA(dst, b, h) do { _Pragma("unroll") for (int m = 0; m < 4; ++m) _Pragma("unroll") for (int k = 0; k < 2; ++k) dst[m][k] = *(const LAS bf16x8*)(lds + PG8_SA(b, h) + aoff + m * 2048 + k * 1024); } while (0)
#define PG8_LDB(dst, b, h) do { _Pragma("unroll") for (int n = 0; n < 2; ++n) _Pragma("unroll") for (int k = 0; k < 2; ++k) dst[n][k] = *(const LAS bf16x8*)(lds + PG8_SB(b, h) + boff + n * 2048 + k * 1024); } while (0)
#define PG8_MMA(ai, bj, At, Bt) do { __builtin_amdgcn_s_setprio(1); _Pragma("unroll") for (int m = 0; m < 4; ++m) _Pragma("unroll") for (int n = 0; n < 2; ++n) _Pragma("unroll") for (int k = 0; k < 2; ++k) \
        acc[ai][bj][m][n] = __builtin_amdgcn_mfma_f32_16x16x32_bf16(Bt[n][k], At[m][k], acc[ai][bj][m][n], 0, 0, 0); __builtin_amdgcn_s_setprio(0); } while (0)
#define PG8_WAIT_V(n) asm volatile("s_waitcnt vmcnt(" #n ")" ::: "memory")
#define PG8_WAIT_L(n) asm volatile("s_waitcnt lgkmcnt(" #n ")" ::: "memory")
#define PG8_BAR __builtin_amdgcn_s_barrier()
#define PG8_SCHED __builtin_amdgcn_sched_barrier(0)
#define VA(u, h) (Sched::GATHER ? (u).va[h] : S.va)
    Unit cur, nxt; int ui = 0;
    if constexpr (Sched::DYN) { S.ticket_issue(); S.ticket_publish(); __syncthreads(); }
    if (!S.next(0, cur)) return;
    S.a_ready(cur);
    if (S.probe) GSTAMP(lds, 27);
    f32x4 acc[2][2][4][2];
#pragma unroll
    for (int a = 0; a < 2; ++a)
#pragma unroll
        for (int b = 0; b < 2; ++b)
#pragma unroll
            for (int m = 0; m < 4; ++m)
#pragma unroll
                for (int n = 0; n < 2; ++n) acc[a][b][m][n] = (f32x4){0.f, 0.f, 0.f, 0.f};
    bf16x8 At[4][2], B0[2][2], B1[2][2];
    PG8_STAGE(PG8_SB(0, 0), cur.B0, voffB); PG8_STAGE(PG8_SB(0, 1), cur.B1, voffB); PG8_STAGE(PG8_SA(0, 0), cur.A0, VA(cur, 0)); PG8_STAGE(PG8_SA(0, 1), cur.A1, VA(cur, 1));
    if (wr == 1) PG8_BAR;
    PG8_WAIT_V(2); PG8_BAR;
    PG8_STAGE(PG8_SB(1, 0), cur.B0 + kstep, voffB); PG8_STAGE(PG8_SA(1, 0), cur.A0 + kstep, VA(cur, 0)); PG8_STAGE(PG8_SB(1, 1), cur.B1 + kstep, voffB);
    PG8_WAIT_V(6); PG8_BAR;
    for (;;) {
        bool has_next = false;
        if constexpr (Sched::DYN) { S.ticket_issue(); nxt = cur; }
        else { has_next = S.next(ui + 1, nxt); if (!has_next) nxt = cur; }
        for (int t = 0; t < nt; t += 2) {
            if constexpr (Sched::DYN) { if (t == 2) S.ticket_publish(); if (t == nt - 4) { has_next = S.next(ui + 1, nxt); if (!has_next) nxt = cur; } }
            const bool last = (t == nt - 2);
            if (last && has_next) S.a_ready(nxt);
            const char* a1h1 = cur.A1 + (size_t)(t + 1) * kstep;
            const char* a2h0 = last ? nxt.A0 : cur.A0 + (size_t)(t + 2) * kstep; const char* a2h1 = last ? nxt.A1 : cur.A1 + (size_t)(t + 2) * kstep;
            const char* b2h0 = last ? nxt.B0 : cur.B0 + (size_t)(t + 2) * kstep; const char* b2h1 = last ? nxt.B1 : cur.B1 + (size_t)(t + 2) * kstep;
            unsigned v2h0[2], v2h1[2];
#pragma unroll
            for (int i = 0; i < 2; ++i) { if constexpr (Sched::GATHER) { v2h0[i] = last ? nxt.va[0][i] : cur.va[0][i]; v2h1[i] = last ? nxt.va[1][i] : cur.va[1][i]; } else { v2h0[i] = S.va[i]; v2h1[i] = S.va[i]; } }
            PG8_LDB(B0, 0, 0); PG8_LDB(B1, 0, 1); PG8_SCHED; PG8_LDA(At, 0, 0); PG8_STAGE(PG8_SA(1, 1), a1h1, VA(cur, 1));
            PG8_WAIT_V(8); PG8_WAIT_L(0); PG8_BAR; PG8_MMA(0, 0, At, B0); PG8_MMA(0, 1, At, B1); PG8_BAR; PG8_SCHED;
            if (!cur.half) PG8_LDA(At, 0, 1);
            PG8_STAGE(PG8_SB(0, 0), b2h0, voffB); PG8_STAGE(PG8_SB(0, 1), b2h1, voffB); PG8_STAGE(PG8_SA(0, 0), a2h0, v2h0);
            PG8_WAIT_V(8); PG8_WAIT_L(0); PG8_BAR; if (!cur.half) { PG8_MMA(1, 0, At, B0); PG8_MMA(1, 1, At, B1); } PG8_BAR; PG8_SCHED;
            PG8_LDB(B0, 1, 0); PG8_LDB(B1, 1, 1); PG8_SCHED; PG8_LDA(At, 1, 0); PG8_STAGE(PG8_SA(0, 1), a2h1, v2h1);
            PG8_WAIT_V(8); PG8_WAIT_L(0); PG8_BAR; PG8_MMA(0, 0, At, B0); PG8_MMA(0, 1, At, B1); PG8_BAR; PG8_SCHED;
            if (!cur.half) PG8_LDA(At, 1, 1);
            PG8_STAGE(PG8_SB(1, 0), b2h0 + kstep, voffB); PG8_STAGE(PG8_SB(1, 1), b2h1 + kstep, voffB); PG8_STAGE(PG8_SA(1, 0), a2h0 + kstep, v2h0);
            PG8_WAIT_V(8); PG8_WAIT_L(0); PG8_BAR; if (!cur.half) { PG8_MMA(1, 0, At, B0); PG8_MMA(1, 1, At, B1); } PG8_BAR; PG8_SCHED;
        }
        if (S.probe) GSTAMP(lds, 25);
        if constexpr (ALIGN_EPI) { if (wr == 0) PG8_BAR; }
        if constexpr (Sched::CHAIN) E.chain(acc, cur, wr, wc, fr, fq); else E(acc, cur, wr, wc, fr, fq);
        S.done(cur);
        if (S.probe) { asm volatile("s_waitcnt vmcnt(0)" ::: "memory"); GSTAMP(lds, 26); }
        if (!has_next) break;
        if (!Sched::CHAIN || nxt.e == 0) {
#pragma unroll
        for (int a = 0; a < 2; ++a)
#pragma unroll
            for (int b = 0; b < 2; ++b)
#pragma unroll
                for (int m = 0; m < 4; ++m)
#pragma unroll
                    for (int n = 0; n < 2; ++n) acc[a][b][m][n] = (f32x4){0.f, 0.f, 0.f, 0.f};
        }
        cur = nxt; ++ui;
        if constexpr (ALIGN_EPI) { if (wr == 1) PG8_BAR; }
    }
    PG8_WAIT_V(0);
    if constexpr (!ALIGN_EPI) { if (wr == 0) PG8_BAR; }
    PG8_BAR;
#undef VA
#undef PG8_SA
#undef PG8_SB
#undef PG8_STAGE
#undef PG8_LDA
#undef PG8_LDB
#undef PG8_MMA
#undef PG8_WAIT_V
#undef PG8_WAIT_L
#undef PG8_BAR
#undef PG8_SCHED
}

struct PlainSched {
    static constexpr bool GATHER = false, CHAIN = false, DYN = false;
    __device__ __forceinline__ void a_ready(const Unit&) const {}
    __device__ __forceinline__ void done(const Unit&) const {}
    int nM, nN, nwg, G, c, lda, K, nNh, probe = 0; const char* A; const char* Bt; unsigned va[2];
    __device__ __forceinline__ void init(const bf16* A_, int lda_, const bf16* Bt_, int M, int N, int K_, int G_, int c_, int nNh_ = 0) {
        nM = M / BM; nN = N / BM - nNh_; nNh = nNh_; nwg = nM * nN; G = G_; c = c_; lda = lda_; K = K_; A = (const char*)A_; Bt = (const char*)Bt_;
#pragma unroll
        for (int i = 0; i < 2; ++i) { int R, C; stage_rc((int)ltid() * 16 + i * 8192, R, C); va[i] = (unsigned)(R * lda + C) * 2u; }
    }
    __device__ __forceinline__ bool next(int i, Unit& u) const {
        const long L = (long)i * G + c;
        u.e = 0; u.nvalid = 256; u.slot0 = 0; u.va[0][0] = 0u; u.va[0][1] = 0u; u.va[1][0] = 0u; u.va[1][1] = 0u;
        if (L >= nwg) { const int hL = (int)(L - nwg); if (hL >= 2 * nM * nNh) return false;
            const int hm = hL / nNh, pn = nN + hL % nNh;
            u.pm = hm >> 1; u.pn = pn; u.half = 1; u.row0 = hm * HALF;
            u.A0 = A + (size_t)hm * HALF * lda * 2; u.A1 = u.A0;
            u.B0 = Bt + (size_t)pn * BM * K * 2; u.B1 = u.B0 + (size_t)HALF * K * 2;
            return true; }
        int wgid = (int)L; { const int q = nwg / NXCD, r = nwg % NXCD, xcd = wgid % NXCD, off = wgid / NXCD; wgid = (xcd < r ? xcd * (q + 1) : r * (q + 1) + (xcd - r) * q) + off; }
        const int nig = WGM * nN, gid = wgid / nig, fm = gid * WGM, gsz = (nM - fm) < WGM ? (nM - fm) : WGM;
        u.pm = fm + ((wgid % nig) % gsz); u.pn = (wgid % nig) / gsz; u.half = 0; u.row0 = u.pm * BM;
        u.A0 = A + (size_t)u.pm * BM * lda * 2; u.A1 = u.A0 + (size_t)HALF * lda * 2;
        u.B0 = Bt + (size_t)u.pn * BM * K * 2; u.B1 = u.B0 + (size_t)HALF * K * 2;
        return true;
    }
};
struct BranchSched {
    static constexpr bool GATHER = false, CHAIN = true, DYN = false;
    __device__ __forceinline__ void a_ready(const Unit&) const {}
    __device__ __forceinline__ void done(const Unit&) const {}
    int G, c, probe = 0; const char* A; const char* Bt; unsigned va[2];
    __device__ __forceinline__ void init(const bf16* OC, const bf16* WBRl, int G_, int c_) { G = G_; c = c_; A = (const char*)OC; Bt = (const char*)WBRl;
#pragma unroll
        for (int i = 0; i < 2; ++i) { int R, C; stage_rc((int)ltid() * 16 + i * 8192, R, C); va[i] = (unsigned)(R * 1536 + C) * 2u; } }
    __device__ __forceinline__ bool next(int i, Unit& u) const {
        const int tile = (i / 3) * G + c, n = i % 3; if (tile >= (T / BM) * (D / BM)) return false;
        int wgid = tile; { const int nwg = 256, q = nwg / NXCD, xcd = wgid % NXCD, off = wgid / NXCD; wgid = xcd * q + off; }
        const int nN = D / BM, nig = WGM * nN, gid = wgid / nig, fm = gid * WGM;
        u.pm = fm + ((wgid % nig) % WGM); u.pn = (wgid % nig) / WGM; u.e = n; u.nvalid = 256; u.slot0 = 0; u.half = 0; u.row0 = u.pm * BM;
        u.va[0][0] = 0u; u.va[0][1] = 0u; u.va[1][0] = 0u; u.va[1][1] = 0u;
        u.A0 = A + (size_t)u.pm * BM * 1536 * 2 + (size_t)n * 512 * 2; u.A1 = u.A0 + (size_t)HALF * 1536 * 2;
        u.B0 = Bt + (size_t)n * D * 512 * 2 + (size_t)u.pn * BM * 512 * 2; u.B1 = u.B0 + (size_t)HALF * 512 * 2;
        return true;
    }
};
template <int MODE> struct MoeSched {
    static constexpr int NPN = MODE == 1 ? 4 : 8;
    static constexpr bool GATHER = MODE == 1, CHAIN = false, DYN = MODE == 2;
    unsigned* tilecnt; unsigned* tick; volatile LAS int* tslot; mutable int myticket;
    __device__ __forceinline__ void ticket_issue() const { if (ltid() == 0) myticket = (int)__hip_atomic_fetch_add(tick, 1u, __ATOMIC_RELAXED, __HIP_MEMORY_SCOPE_AGENT); }
    __device__ __forceinline__ void ticket_publish() const { if (ltid() == 0) *tslot = myticket; }
    __device__ __forceinline__ void a_ready(const Unit& u) const {
        if (MODE == 2) {
            if (ltid() < 64) { unsigned* p = tilecnt + 64 * (u.slot0 >> 8); unsigned sp = 0;
                while ((unsigned)__builtin_amdgcn_readfirstlane(__hip_atomic_load(p, __ATOMIC_RELAXED, __HIP_MEMORY_SCOPE_AGENT)) < 32u) { __builtin_amdgcn_s_sleep(2); if (++sp > (1u << 22)) break; }
                __builtin_amdgcn_fence(__ATOMIC_ACQUIRE, "agent"); asm volatile("s_waitcnt vmcnt(0)" ::: "memory"); }
            asm volatile("" ::: "memory"); __builtin_amdgcn_s_barrier(); asm volatile("" ::: "memory"); }
    }
    __device__ __forceinline__ void done(const Unit& u) const {
        if (MODE == 1) { asm volatile("s_waitcnt vmcnt(0)" ::: "memory");
            if ((ltid() & 63) == 0) __hip_atomic_fetch_add(tilecnt + 64 * (u.slot0 >> 8), 1u, __ATOMIC_RELAXED, __HIP_MEMORY_SCOPE_AGENT); }
    }
    int G, c, probe = 0; const LAS int* tb; const int* cnt; const int* list; const char* A; const char* W; unsigned va[2];
    __device__ __forceinline__ void init(int G_, int c_, const LAS int* tb_, const int* cnt_, const int* list_, const void* A_, const void* W_) {
        G = G_; c = c_; tb = tb_; cnt = cnt_; list = list_; A = (const char*)A_; W = (const char*)W_;
#pragma unroll
        for (int i = 0; i < 2; ++i) { int R, C; stage_rc((int)ltid() * 16 + i * 8192, R, C); va[i] = (unsigned)(R * FF + C) * 2u; }
    }
    __device__ __forceinline__ bool next(int i, Unit& u) const {
        const int L = MODE == 2 ? __builtin_amdgcn_readfirstlane(*tslot) : i * G + c, nfull = __builtin_amdgcn_readfirstlane(tb[33 + NE]), nhalf = __builtin_amdgcn_readfirstlane(tb[66 + NE]);
        if (L >= (nfull + nhalf) * NPN) return false;
        const bool half = L >= nfull * NPN; const int Lr = half ? L - nfull * NPN : L, base = half ? 66 : 33;
        const int tq = Lr / NPN, pn = Lr % NPN; int e = 0;
        while (e < NE - 1 && __builtin_amdgcn_readfirstlane(tb[base + e + 1]) <= tq) ++e;
        const int ne = __builtin_amdgcn_readfirstlane(cnt[e]);
        const int pm = half ? (ne - 1) / 256 : tq - __builtin_amdgcn_readfirstlane(tb[33 + e]);
        const int tl = __builtin_amdgcn_readfirstlane(tb[e]) + pm;
        u.pm = pm; u.pn = pn; u.e = e; u.nvalid = ne - pm * 256; u.slot0 = tl * 256; u.half = half ? 1 : 0; u.row0 = 0;
        if (MODE == 1) {
            u.A0 = A; u.A1 = A;
#pragma unroll
            for (int h = 0; h < 2; ++h)
#pragma unroll
                for (int k = 0; k < 2; ++k) { int Rk, Ck; stage_rc((int)ltid() * 16 + k * 8192, Rk, Ck); int idx = pm * 256 + h * 128 + Rk; idx = idx < ne ? idx : ne - 1; const int entry = list[e * 8192 + idx]; u.va[h][k] = (unsigned)(entry >> 1) * (unsigned)(D * 2) + (unsigned)Ck * 2u; }
            const char* we = W + (size_t)e * 1024 * D * 2;
            u.B0 = we + (size_t)(pn * 128) * D * 2; u.B1 = we + (size_t)(512 + pn * 128) * D * 2;
        } else {
            u.va[0][0] = 0u; u.va[0][1] = 0u; u.va[1][0] = 0u; u.va[1][1] = 0u;
            u.A0 = A + (size_t)tl * 256 * FF * 2; u.A1 = u.A0 + (size_t)HALF * FF * 2;
            const char* we = W + (size_t)e * D * FF * 2;
            u.B0 = we + (size_t)(pn * 256) * FF * 2; u.B1 = u.B0 + (size_t)HALF * FF * 2;
        }
        return true;
    }
};

struct EpiBf16 {
    static constexpr bool PERM = true;
    bf16* O; int ldc;
    __device__ __forceinline__ void operator()(const f32x4 (&acc)[2][2][4][2], const Unit& u, int wr, int wc, int fr, int fq) const {
        const int row0 = u.row0 + wr * 64 + fr, col0 = u.pn * BM + wc * 32 + 8 * fq;
#pragma unroll
        for (int ai = 0; ai < 2; ++ai) if (ai == 0 || !u.half)
#pragma unroll
            for (int m = 0; m < 4; ++m) { bf16* rowp = O + (size_t)(row0 + ai * HALF + m * 16) * ldc + col0;
#pragma unroll
                for (int bj = 0; bj < 2; ++bj) { const f32x4 v0 = acc[ai][bj][m][0], v1 = acc[ai][bj][m][1];
                    u32x4 w; w.x = cvt_pk_bf16(v0[0], v0[1]); w.y = cvt_pk_bf16(v0[2], v0[3]); w.z = cvt_pk_bf16(v1[0], v1[1]); w.w = cvt_pk_bf16(v1[2], v1[3]);
                    *(u32x4*)(rowp + bj * HALF) = w; } }
    }
};
struct EpiMerge {
    static constexpr bool PERM = true;
    bf16* MG; const bf16* gate0;
    __device__ __forceinline__ void operator()(const f32x4 (&acc)[2][2][4][2], const Unit& u, int wr, int wc, int fr, int fq) const {}
    __device__ __forceinline__ void chain(f32x4 (&acc)[2][2][4][2], const Unit& u, int wr, int wc, int fr, int fq) const {
        const int row0 = u.row0 + wr * 64 + fr, col0 = u.pn * BM + wc * 32 + 8 * fq; const bool last = u.e == 2;
        const bf16* __restrict__ ga = gate0 + (size_t)u.e * D; const bf16* __restrict__ gb = gate0 + (size_t)(last ? 2 : u.e + 1) * D;
        bf16* __restrict__ MGp = MG;
        u32x4 qa[2][2], qb[2][2];
#define EMG_LOAD(buf, g) do { const size_t row_ = (size_t)(row0 + ((g) >> 2) * HALF + ((g) & 3) * 16); \
            _Pragma("unroll") for (int bj_ = 0; bj_ < 2; ++bj_) { qa[buf][bj_] = *(const u32x4*)(ga + row_ * NPAD + col0 + bj_ * HALF); qb[buf][bj_] = *(const u32x4*)(gb + row_ * NPAD + col0 + bj_ * HALF); } } while (0)
        EMG_LOAD(0, 0);
#pragma unroll
        for (int g = 0; g < 8; ++g) { if (g + 1 < 8) EMG_LOAD((g + 1) & 1, g + 1);
            const int ai = g >> 2, m = g & 3; const size_t row = (size_t)(row0 + ai * HALF + m * 16);
#pragma unroll
            for (int bj = 0; bj < 2; ++bj) { float o[8];
                const unsigned wa[4] = {qa[g & 1][bj].x, qa[g & 1][bj].y, qa[g & 1][bj].z, qa[g & 1][bj].w}, wb[4] = {qb[g & 1][bj].x, qb[g & 1][bj].y, qb[g & 1][bj].z, qb[g & 1][bj].w};
#pragma unroll
                for (int k = 0; k < 8; ++k) { const float a = acc[ai][bj][m][k >> 2][k & 3];
                    const float xa = __builtin_bit_cast(float, (k & 1) ? (wa[k >> 1] & 0xffff0000u) : (wa[k >> 1] << 16)), xb = __builtin_bit_cast(float, (k & 1) ? (wb[k >> 1] & 0xffff0000u) : (wb[k >> 1] << 16));
                    const float ea = __builtin_amdgcn_exp2f(-LOG2E * xa), eb = __builtin_amdgcn_exp2f(-LOG2E * xb);
                    const float f = (last ? 1.0f : 1.0f + eb) * __builtin_amdgcn_rcpf(1.0f + ea);
                    o[k] = a * f; acc[ai][bj][m][k >> 2][k & 3] = o[k]; }
                if (last) { u32x4 w; w.x = cvt_pk_bf16(o[0], o[1]); w.y = cvt_pk_bf16(o[2], o[3]); w.z = cvt_pk_bf16(o[4], o[5]); w.w = cvt_pk_bf16(o[6], o[7]);
                    *(u32x4*)(MGp + row * D + col0 + bj * HALF) = w; } } }
#undef EMG_LOAD
    }
};
struct EpiResF32 {
    static constexpr bool PERM = false;
    const float* R; float* O; int ldc;
    __device__ __forceinline__ void operator()(const f32x4 (&acc)[2][2][4][2], const Unit& u, int wr, int wc, int fr, int fq) const {
        const int row0 = u.row0 + wr * 64 + fr, col0 = u.pn * BM + wc * 32 + 4 * fq;
        const float* __restrict__ Rp = R; float* __restrict__ Op = O;
        f32x4 rv[2][4];
#define ERES_LOAD(buf, g) do { const size_t off_ = (size_t)(row0 + ((g) >> 2) * HALF + ((g) & 3) * 16) * ldc + col0; \
            _Pragma("unroll") for (int q_ = 0; q_ < 4; ++q_) rv[buf][q_] = *(const f32x4*)(Rp + off_ + (q_ >> 1) * HALF + (q_ & 1) * 16); } while (0)
        ERES_LOAD(0, 0);
#pragma unroll
        for (int g = 0; g < 8; ++g) { if (g + 1 < 8) ERES_LOAD((g + 1) & 1, g + 1);
            const int ai = g >> 2, m = g & 3; const size_t off = (size_t)(row0 + ai * HALF + m * 16) * ldc + col0;
            if (ai == 0 || !u.half) {
#pragma unroll
                for (int q = 0; q < 4; ++q) *(f32x4*)(Op + off + (q >> 1) * HALF + (q & 1) * 16) = acc[ai][q >> 1][m][q & 1] + rv[g & 1][q]; } }
#undef ERES_LOAD
    }
};
struct EpiMoe1 {
    static constexpr bool PERM = true;
    bf16* ACT; const int* list; const float* ew; const float* rstd;
    __device__ __forceinline__ void operator()(const f32x4 (&acc)[2][2][4][2], const Unit& u, int wr, int wc, int fr, int fq) const {
        const int col0 = u.pn * 128 + wc * 32 + 8 * fq;
#pragma unroll
        for (int ai = 0; ai < 2; ++ai) if (ai == 0 || !u.half)
#pragma unroll
            for (int m = 0; m < 4; ++m) { const int r = ai * HALF + wr * 64 + m * 16 + fr; float w = 0.f, rsd = 0.f;
                if (r < u.nvalid) { const int entry = list[u.e * 8192 + u.pm * 256 + r]; w = ew[entry]; rsd = rstd[entry >> 1]; }
                float o[8];
#pragma unroll
                for (int n = 0; n < 2; ++n)
#pragma unroll
                    for (int j = 0; j < 4; ++j) { const float g = acc[ai][0][m][n][j] * rsd, up = acc[ai][1][m][n][j] * rsd; o[n * 4 + j] = g * fsig(g) * up * w; }
                u32x4 pk; pk.x = cvt_pk_bf16(o[0], o[1]); pk.y = cvt_pk_bf16(o[2], o[3]); pk.z = cvt_pk_bf16(o[4], o[5]); pk.w = cvt_pk_bf16(o[6], o[7]);
                unsigned long long* dst = (unsigned long long*)(ACT + (size_t)(u.slot0 + r) * FF + col0);
                __hip_atomic_store(dst, (unsigned long long)pk.x | ((unsigned long long)pk.y << 32), __ATOMIC_RELAXED, __HIP_MEMORY_SCOPE_AGENT);
                __hip_atomic_store(dst + 1, (unsigned long long)pk.z | ((unsigned long long)pk.w << 32), __ATOMIC_RELAXED, __HIP_MEMORY_SCOPE_AGENT); }
    }
};
struct EpiMoe2 {
    static constexpr bool PERM = true;
    bf16* CO; const int* list;
    __device__ __forceinline__ void operator()(const f32x4 (&acc)[2][2][4][2], const Unit& u, int wr, int wc, int fr, int fq) const {
        const int col0 = u.pn * BM + wc * 32 + 8 * fq;
#pragma unroll
        for (int ai = 0; ai < 2; ++ai) if (ai == 0 || !u.half)
#pragma unroll
            for (int m = 0; m < 4; ++m) { const int r = ai * HALF + wr * 64 + m * 16 + fr;
                if (r < u.nvalid) { const int entry = list[u.e * 8192 + u.pm * 256 + r]; bf16* rowp = CO + (size_t)entry * D + col0;
#pragma unroll
                    for (int bj = 0; bj < 2; ++bj) { const f32x4 v0 = acc[ai][bj][m][0], v1 = acc[ai][bj][m][1];
                        u32x4 w; w.x = cvt_pk_bf16(v0[0], v0[1]); w.y = cvt_pk_bf16(v0[2], v0[3]); w.z = cvt_pk_bf16(v1[0], v1[1]); w.w = cvt_pk_bf16(v1[2], v1[3]);
                        *(u32x4*)(rowp + bj * HALF) = w; } } }
    }
};
}

struct Frame {
    LAS unsigned char* lds; volatile LAS unsigned* MISC;
    int tid, lane, wave, vcu, G, gw, NGW, bid;
};
struct Args { const GAS float* in[22]; GAS float* out; GAS unsigned char* ws; int ph_lo, ph_hi, li, pad; };
typedef const __attribute__((address_space(4))) Args KArgs;
__device__ __forceinline__ KArgs* ka_fresh() { unsigned long long p = (unsigned long long)__builtin_amdgcn_kernarg_segment_ptr(); asm volatile("" : "+s"(p)); return (KArgs*)p; }
#define KA KArgs* const ka = ka_fresh()
#define KIN(i) ((const float*)ka->in[i])
#define KWS ((unsigned char*)ka->ws)
#define KOUT ((float*)ka->out)
enum { I_X = 0, I_NMIX, I_WIN, I_PE, I_W1, I_W2, I_QN, I_KN, I_LB, I_HGN, I_WA2, I_BA, I_GLAN, I_WBR, I_WOUT, I_NFFN, I_WGRP, I_BGRP, I_WEXP, I_BEXP, I_WGU, I_WDN };

__device__ __forceinline__ void tr_item(const float* W, size_t ldw, int c0, int nv, bf16* WT, size_t ldt, int r0, int k0, LAS float* scr, int lane) {
    const int nn = lane & 31;
    float tv[32];
#pragma unroll
    for (int i = 0; i < 32; ++i) { const int kk = 2 * i + (lane >> 5); tv[i] = nn < nv ? __builtin_nontemporal_load(W + (size_t)(k0 + kk) * ldw + c0 + nn) : 0.f; }
#pragma unroll
    for (int i = 0; i < 32; ++i) { const int kk = 2 * i + (lane >> 5); scr[kk * 33 + nn] = tv[i]; }
    LDS_WAIT();
    const int c = lane & 7;
#pragma unroll
    for (int j = 0; j < 4; ++j) { const int n = (lane >> 3) + 8 * j; const LAS float* s = scr + (8 * c) * 33 + n;
        u32x4 o; o.x = pk2(s[0 * 33], s[1 * 33]); o.y = pk2(s[2 * 33], s[3 * 33]); o.z = pk2(s[4 * 33], s[5 * 33]); o.w = pk2(s[6 * 33], s[7 * 33]);
        if (n < nv) __builtin_nontemporal_store(o, (u32x4*)(WT + (size_t)(r0 + n) * ldt + k0 + 8 * c)); }
    LDS_WAIT();
}
__device__ __forceinline__ void phase_prologue(Frame& F) {
    KA;
    {
      bf16* W1T = (bf16*)(KWS + WS_CW); bf16* W2T = (bf16*)(KWS + WS_CW + 1048576); float* B1 = (float*)(KWS + WS_CW + 1572864);
      for (int i = F.bid * 512 + F.tid; i < NL * 2 * 64 * 2048; i += F.G * 512) { const int lk = i / (64 * 2048), j = (i / 2048) % 64, c = i % 2048; W1T[i] = (bf16)f2bf(KIN(I_W1)[((size_t)lk * 2048 + c) * 64 + j]); }
      for (int i = F.bid * 512 + F.tid; i < NL * 2 * 64 * 64; i += F.G * 512) { const int lk = i / 4096, j2 = (i / 64) % 64, j = i % 64; W2T[i] = (bf16)f2bf(KIN(I_W2)[((size_t)lk * 64 + j) * 64 + j2]); }
      if (F.bid < NL * 2) { const int lk = F.bid, j = F.tid & 63, part = F.tid >> 6; float a = 0.f;
#pragma unroll 8
          for (int c = part * 256; c < part * 256 + 256; ++c) a += KIN(I_PE)[(size_t)lk * 2048 + c] * KIN(I_W1)[((size_t)lk * 2048 + c) * 64 + j];
          LAS float* rd = (LAS float*)F.lds; rd[F.tid] = a; __syncthreads();
          if (F.tid < 64) { float t2 = 0.f;
#pragma unroll
              for (int p = 0; p < 8; ++p) t2 += rd[p * 64 + F.tid];
              B1[lk * 64 + F.tid] = t2; }
          __syncthreads(); } }
    { float* WRT = (float*)(KWS + WS_WRT);
      for (int i = F.bid * 512 + F.tid; i < NL * 48 * D; i += F.G * 512) { const int l = i / (48 * D), n = (i / D) % 48, k = i % D; const float g = KIN(I_NFFN)[l * D + k];
          WRT[i] = n < 32 ? g * KIN(I_WEXP)[((size_t)l * D + k) * 32 + n] : (n < 36 ? g * KIN(I_WGRP)[((size_t)l * D + k) * 4 + (n - 32)] : 0.f); } }
    LAS float* scr = (LAS float*)(F.lds + F.wave * 16384);
    constexpr int IT_WIN = 32 * 346, IT_WBR = 3 * 8 * 64, IT_WOUT = 32 * 64, IT_WGU = 32 * 32 * 32, IT_WDN = 32 * 8 * 64, IT_L = IT_WIN + IT_WBR + IT_WOUT + IT_WGU + IT_WDN;
    for (int it = F.gw; it < NL * IT_L; it += F.NGW) {
        const int l = it / IT_L; int r = it % IT_L;
        if (r < IT_WIN) { const int kb = r / 346, nb = r % 346; int src, dst, nv = 32;
            if (nb < 40) { src = nb * 32; dst = nb * 32; }
            else if (nb == 40) { src = 1280; dst = C_NG; nv = 24; }
            else if (nb < 153) { src = 1304 + 32 * (nb - 41); dst = 1280 + 32 * (nb - 41); }
            else if (nb == 153) { src = 4888; dst = C_GA; nv = 16; }
            else { src = 4904 + 32 * (nb - 154); dst = C_MG + 32 * (nb - 154); }
            tr_item(KIN(I_WIN) + (size_t)l * D * INC, INC, src, nv, (bf16*)(KWS + WS_WIN) + (size_t)l * NPAD * D, D, dst, kb * 64, scr, F.lane); continue; }
        r -= IT_WIN;
        if (r < IT_WBR) { const int n = r / 512, q = r % 512, kb = q / 64, nb = q % 64;
            tr_item(KIN(I_WBR) + ((size_t)l * 3 + n) * 512 * D, D, nb * 32, 32, (bf16*)(KWS + WS_WBR) + ((size_t)l * 3 + n) * D * 512, 512, nb * 32, kb * 64, scr, F.lane); continue; }
        r -= IT_WBR;
        if (r < IT_WOUT) { const int kb = r / 64, nb = r % 64;
            tr_item(KIN(I_WOUT) + (size_t)l * D * D, D, nb * 32, 32, (bf16*)(KWS + WS_WOUT) + (size_t)l * D * D, D, nb * 32, kb * 64, scr, F.lane); continue; }
        r -= IT_WOUT;
        if (r < IT_WGU) { const int e = r / 1024, q = r % 1024, kb = q / 32, nb = q % 32;
            tr_item(KIN(I_WGU) + ((size_t)l * NE + e) * D * 1024, 1024, nb * 32, 32, (bf16*)(KWS + WS_WGU) + ((size_t)l * NE + e) * 1024 * D, D, nb * 32, kb * 64, scr, F.lane); continue; }
        r -= IT_WGU;
        { const int e = r / 512, q = r % 512, kb = q / 64, nb = q % 64;
            tr_item(KIN(I_WDN) + ((size_t)l * NE + e) * FF * D, D, nb * 32, 32, (bf16*)(KWS + WS_WDN) + ((size_t)l * NE + e) * D * FF, FF, nb * 32, kb * 64, scr, F.lane); }
    }
}

template <int MODE> __device__ __forceinline__ void phase_norm1(Frame& F, const float* xin, const bf16* contrib, float* xout, const float* gain, bf16* H) {
    for (int t0 = F.gw; t0 < T; t0 += 2 * F.NGW) {
        f32x4 v[2][8]; float ss[2] = {0.f, 0.f};
#pragma unroll
        for (int rr = 0; rr < 2; ++rr) { const int t = t0 + rr * F.NGW; if (t < T) {
            const f32x4* xr = (const f32x4*)(xin + (size_t)t * D) + F.lane;
#pragma unroll
            for (int j = 0; j < 8; ++j) v[rr][j] = xr[64 * j]; } }
        u32x2 c0[2][8], c1[2][8];
        if (MODE != 0) {
#pragma unroll
            for (int rr = 0; rr < 2; ++rr) { const int t = t0 + rr * F.NGW; if (t < T) {
#pragma unroll
                for (int j = 0; j < 8; ++j) { c0[rr][j] = *((const u32x2*)(contrib + (size_t)(2 * t) * D) + F.lane + 64 * j); c1[rr][j] = *((const u32x2*)(contrib + (size_t)(2 * t + 1) * D) + F.lane + 64 * j); } } } }
#pragma unroll
        for (int rr = 0; rr < 2; ++rr) { const int t = t0 + rr * F.NGW; if (t < T) {
#pragma unroll
            for (int j = 0; j < 8; ++j) {
                if (MODE != 0) { v[rr][j].x += bflo(c0[rr][j].x) + bflo(c1[rr][j].x); v[rr][j].y += bfhi(c0[rr][j].x) + bfhi(c1[rr][j].x); v[rr][j].z += bflo(c0[rr][j].y) + bflo(c1[rr][j].y); v[rr][j].w += bfhi(c0[rr][j].y) + bfhi(c1[rr][j].y);
                    *((f32x4*)(xout + (size_t)t * D) + F.lane + 64 * j) = v[rr][j]; }
                ss[rr] += v[rr][j].x * v[rr][j].x + v[rr][j].y * v[rr][j].y + v[rr][j].z * v[rr][j].z + v[rr][j].w * v[rr][j].w; } } }
        if (MODE != 2) {
#pragma unroll
            for (int rr = 0; rr < 2; ++rr) { const int t = t0 + rr * F.NGW; if (t < T) {
                const float rstd = 1.0f / sqrtf(wave_sum(ss[rr]) * (1.0f / D) + EPS);
#pragma unroll
                for (int j = 0; j < 8; ++j) { const f32x4 g = *((const f32x4*)gain + F.lane + 64 * j);
                    u32x2 o; o.x = pkbf(v[rr][j].x * rstd * g.x, v[rr][j].y * rstd * g.y); o.y = pkbf(v[rr][j].z * rstd * g.z, v[rr][j].w * rstd * g.w);
                    *((u32x2*)(H + (size_t)t * D) + F.lane + 64 * j) = o; } } }
        }
    }
}

__device__ __forceinline__ void phase_prep(Frame& F, int l) {
    KA;
    const bf16* P = (const bf16*)(KWS + WS_P);
    float* QN = (float*)(KWS + WS_QN); float* KV = (float*)(KWS + WS_KV);
    const float* qg = KIN(I_QN) + l * 64; const float* kg = KIN(I_KN) + l * 192;
    for (int it = F.gw; it < T * 20; it += F.NGW) {
        const int t = it / 20, v = it % 20;
        float x = bf2f(P[(size_t)t * NPAD + v * 64 + F.lane]);
        const bool isq = v < 8, nk1 = (v == 12 || v == 13), nk2 = (v == 16 || v == 17);
        if (isq || nk1 || nk2) { const float ss = wave_sum(x * x); const float g = isq ? qg[F.lane] : (nk1 ? kg[64 + F.lane] : kg[128 + F.lane]); x = x * (1.0f / sqrtf(ss * (1.0f / 64.0f) + EPS)) * g; }
        if (isq) QN[((size_t)v * T + t) * 64 + F.lane] = x;
        else { const int w = v - 8, tens = w >> 1, g = w & 1; KV[(size_t)tens * KV_STRIDE + ((size_t)g * T + t) * 64 + F.lane] = x; }
    }
}
__device__ __forceinline__ float gelu_tanh(float x) { const float u = 0.7978845608028654f * (x + 0.044715f * x * x * x); return 0.5f * x * (1.0f + tanhf(u)); }
__device__ __forceinline__ void phase_compress(Frame& F, int l) {
    KA;
    LAS float* av = (LAS float*)(F.lds + F.wave * 16384);
    const float* KV = (const float*)(KWS + WS_KV); float* KC = (float*)(KWS + WS_KC);
    for (int it = F.gw; it < 2 * 2 * 511; it += F.NGW) {
        const int kind = it / 1022, q = it % 1022, g = q / 511, n = q % 511;
        const float* src = KV + (size_t)kind * KV_STRIDE + ((size_t)g * T + 16 * n) * 64;
        const float* pe = KIN(I_PE) + ((size_t)l * 2 + kind) * 2048;
        const float* w1 = KIN(I_W1) + ((size_t)l * 2 + kind) * 2048 * 64;
        const float* w2 = KIN(I_W2) + ((size_t)l * 2 + kind) * 64 * 64;
#pragma unroll 4
        for (int c = 0; c < 32; ++c) av[c * 64 + F.lane] = src[c * 64 + F.lane] + pe[c * 64 + F.lane];
        WSYNC();
        float acc = 0.f;
#pragma unroll 8
        for (int i = 0; i < 2048; ++i) acc += av[i] * w1[i * 64 + F.lane];
        const float hid = gelu_tanh(acc);
        WSYNC();
        av[F.lane] = hid;
        WSYNC();
        float o = 0.f;
#pragma unroll 8
        for (int i = 0; i < 64; ++i) o += av[i] * w2[i * 64 + F.lane];
        WSYNC();
        if (kind == 0) { const float ss = wave_sum(o * o); o = o * (1.0f / sqrtf(ss * (1.0f / 64.0f) + EPS)) * KIN(I_KN)[l * 192 + F.lane]; }
        KC[(size_t)kind * (2 * 512 * 64) + ((size_t)g * 512 + n) * 64 + F.lane] = o;
    }
}
__device__ __forceinline__ void phase_recur(Frame& F, int l) {
    KA;
    const bf16* P = (const bf16*)(KWS + WS_P); float* ORAW = (float*)(KWS + WS_ORAW);
    for (int it = F.gw; it < 1024; it += F.NGW) {
        const int kind = it >> 9, head = (it >> 7) & 3, j = it & 127;
        if (kind == 0) {
            const int d0 = F.lane, d1 = F.lane + 64;
            const float* lbl = KIN(I_LB);
            float lb0, lb1;
            { const float a0 = lbl[head * 128 + d0], b0 = lbl[512 + head * 128 + d0], a1 = lbl[head * 128 + d1], b1 = lbl[512 + head * 128 + d1];
              lb0 = l == 0 ? 0.f : 1.0f / (1.0f + expf(a0 - b0)); lb1 = l == 0 ? 0.f : 1.0f / (1.0f + expf(a1 - b1)); }
            const bf16* Pq = P + C_HQ + head * 128; const bf16* Pf = P + C_HF + head * 128; const bf16* Pi = P + C_HI + head * 128 + j;
            float S0 = 0.f, S1 = 0.f;
            for (int t0 = 0; t0 < T; t0 += 8) {
                bf16 zq0[8], zq1[8], zf0[8], zf1[8], vi[8];
#pragma unroll
                for (int u = 0; u < 8; ++u) { const size_t row = (size_t)(t0 + u) * NPAD; zq0[u] = Pq[row + d0]; zq1[u] = Pq[row + d1]; zf0[u] = Pf[row + d0]; zf1[u] = Pf[row + d1]; vi[u] = Pi[row]; }
                float part[8];
#pragma unroll
                for (int u = 0; u < 8; ++u) { const float v = bf2f(vi[u]);
                    const float s0 = sigmoidf_(bf2f(zf0[u])), s1 = sigmoidf_(bf2f(zf1[u]));
                    const float f0 = lb0 + (1.0f - lb0) * s0, f1 = lb1 + (1.0f - lb1) * s1;
                    const float k0 = (1.0f - lb0) * (1.0f - s0), k1 = (1.0f - lb1) * (1.0f - s1);
                    S0 = f0 * S0 + k0 * v; S1 = f1 * S1 + k1 * v;
                    part[u] = bf2f(zq0[u]) * S0 + bf2f(zq1[u]) * S1; }
                float mine = 0.f;
#pragma unroll
                for (int u = 0; u < 8; ++u) { const float s = wave_sum(part[u]); mine = (F.lane == u) ? s : mine; }
                if (F.lane < 8) ORAW[(size_t)(t0 + F.lane) * 1024 + head * 128 + j] = mine;
            }
        } else {
            const int d = F.lane, c = head * 64 + d;
            float wa[16];
#pragma unroll
            for (int r = 0; r < 16; ++r) wa[r] = KIN(I_WA2)[((size_t)l * 16 + r) * 256 + c];
            const float ba = KIN(I_BA)[l * 256 + c];
            const bf16* Pq = P + C_GQ + c; const bf16* Pk = P + C_GK + c; const bf16* Pv = P + C_GV + head * 128 + j; const bf16* Pa = P + C_GA;
            float S = 0.f;
            for (int t0 = 0; t0 < T; t0 += 8) {
                bf16 zq[8], zk[8], zv[8]; u32x4 ga0[8], ga1[8];
#pragma unroll
                for (int u = 0; u < 8; ++u) { const size_t row = (size_t)(t0 + u) * NPAD; zq[u] = Pq[row]; zk[u] = Pk[row]; zv[u] = Pv[row]; ga0[u] = *(const u32x4*)(Pa + row); ga1[u] = *(const u32x4*)(Pa + row + 8); }
                float part[8];
#pragma unroll
                for (int u = 0; u < 8; ++u) {
                    float a = ba;
                    a += bflo(ga0[u].x) * wa[0] + bfhi(ga0[u].x) * wa[1] + bflo(ga0[u].y) * wa[2] + bfhi(ga0[u].y) * wa[3] + bflo(ga0[u].z) * wa[4] + bfhi(ga0[u].z) * wa[5] + bflo(ga0[u].w) * wa[6] + bfhi(ga0[u].w) * wa[7];
                    a += bflo(ga1[u].x) * wa[8] + bfhi(ga1[u].x) * wa[9] + bflo(ga1[u].y) * wa[10] + bfhi(ga1[u].y) * wa[11] + bflo(ga1[u].z) * wa[12] + bfhi(ga1[u].z) * wa[13] + bflo(ga1[u].w) * wa[14] + bfhi(ga1[u].w) * wa[15];
                    const float ls = fminf(a, 0.f) - log1pf(expf(-fabsf(a)));
                    const float f = expf(ls * (1.0f / 16.0f));
                    S = f * S + bf2f(zk[u]) * bf2f(zv[u]);
                    part[u] = bf2f(zq[u]) * 0.125f * S; }
                float mine = 0.f;
#pragma unroll
                for (int u = 0; u < 8; ++u) { const float s = wave_sum(part[u]); mine = (F.lane == u) ? s : mine; }
                if (F.lane < 8) ORAW[(size_t)(t0 + F.lane) * 1024 + 512 + head * 128 + j] = mine;
            }
        }
    }
}
__device__ __forceinline__ void phase_recur_out(Frame& F, int l) {
    KA;
    const bf16* P = (const bf16*)(KWS + WS_P); const float* ORAW = (const float*)(KWS + WS_ORAW); bf16* OCAT = (bf16*)(KWS + WS_OCAT);
    for (int it = F.gw; it < T * 8; it += F.NGW) {
        const int t = it >> 3, kind = (it >> 2) & 1, head = it & 3;
        const float* gn = (kind == 0 ? KIN(I_HGN) : KIN(I_GLAN)) + l * 128;
        const int cg = (kind == 0 ? C_HG : C_GR) + head * 128;
        const float r0 = ORAW[(size_t)t * 1024 + kind * 512 + head * 128 + F.lane], r1 = ORAW[(size_t)t * 1024 + kind * 512 + head * 128 + 64 + F.lane];
        const float rstd = 1.0f / sqrtf(wave_sum(r0 * r0 + r1 * r1) * (1.0f / 128.0f) + EPS);
        const float g0 = bf2f(P[(size_t)t * NPAD + cg + F.lane]), g1 = bf2f(P[(size_t)t * NPAD + cg + 64 + F.lane]);
        const float a0 = kind == 0 ? sigmoidf_(g0) : g0 * sigmoidf_(g0), a1 = kind == 0 ? sigmoidf_(g1) : g1 * sigmoidf_(g1);
        OCAT[(size_t)t * 1536 + 512 + kind * 512 + head * 128 + F.lane] = (bf16)f2bf(r0 * rstd * gn[F.lane] * a0);
        OCAT[(size_t)t * 1536 + 512 + kind * 512 + head * 128 + 64 + F.lane] = (bf16)f2bf(r1 * rstd * gn[64 + F.lane] * a1);
    }
}


template <int KIND> struct RecCfg { static constexpr int DK = KIND == 0 ? 128 : 64, NSEG = 512 / DK, TPS = 64 / NSEG, QROW = (DK + 8) * 2; };
constexpr int REC_VT_OFF = 0;
constexpr int REC_KD_OFF = 18432;
constexpr int REC_QS_OFF = 36864;
constexpr int REC_KS_OFF = 54272;
constexpr int REC_QD_OFF = 71680;
constexpr int REC_RED_OFF = 89088;
constexpr int REC_TOT_OFF = 91136;
__device__ __forceinline__ float expc(float x2) { return __builtin_amdgcn_exp2f(fminf(x2, 110.0f)); }
template <int KIND> __device__ __forceinline__ void rec_elem(KArgs* ka, int l, int head, int chunk, int tid, LAS float* tot,
        float (&qv)[RecCfg<KIND>::TPS], float (&kv)[RecCfg<KIND>::TPS], float (&bv)[RecCfg<KIND>::TPS], float& bend, float& bref) {
    constexpr int DK = RecCfg<KIND>::DK, NSEG = RecCfg<KIND>::NSEG, TPS = RecCfg<KIND>::TPS;
    const int d = tid % DK, seg = tid / DK, t0 = chunk * 64 + seg * TPS;
    const bf16* P = (const bf16*)(KWS + WS_P);
    float run = 0.f;
    if (KIND == 0) {
        const int c = head * 128 + d;
        float lb = 0.f;
        if (l > 0) { const float a0 = KIN(I_LB)[c], b0 = KIN(I_LB)[512 + c]; lb = 1.0f / (1.0f + expf(a0 - b0)); }
        const float omlb = 1.0f - lb;
        unsigned zr[TPS], qr[TPS];
#pragma unroll
        for (int u = 0; u < TPS; ++u) { const size_t row = (size_t)(t0 + u) * NPAD; zr[u] = P[row + C_HF + c]; qr[u] = P[row + C_HQ + c]; }
#pragma unroll
        for (int u = 0; u < TPS; ++u) {
            const float z = bf2f(zr[u]); qv[u] = bf2f(qr[u]);
            const float e = __builtin_amdgcn_exp2f(-LOG2E * z), sg = __builtin_amdgcn_rcpf(1.0f + e), f = fmaf(omlb, sg, lb);
            kv[u] = omlb * (e * sg);
            run += __builtin_amdgcn_logf(fmaxf(f, 1e-30f)); bv[u] = run; }
    } else {
        const int c = head * 64 + d;
        float wa[16];
#pragma unroll
        for (int r = 0; r < 16; ++r) wa[r] = KIN(I_WA2)[((size_t)l * 16 + r) * 256 + c];
        const float ba = KIN(I_BA)[l * 256 + c];
        u32x4 g0r[TPS], g1r[TPS]; unsigned qr[TPS], kr[TPS];
#pragma unroll
        for (int u = 0; u < TPS; ++u) { const size_t row = (size_t)(t0 + u) * NPAD; g0r[u] = *(const u32x4*)(P + row + C_GA); g1r[u] = *(const u32x4*)(P + row + C_GA + 8); qr[u] = P[row + C_GQ + c]; kr[u] = P[row + C_GK + c]; }
#pragma unroll
        for (int u = 0; u < TPS; ++u) { const u32x4 g0 = g0r[u], g1 = g1r[u];
            float a = ba;
            a += bflo(g0.x) * wa[0] + bfhi(g0.x) * wa[1] + bflo(g0.y) * wa[2] + bfhi(g0.y) * wa[3] + bflo(g0.z) * wa[4] + bfhi(g0.z) * wa[5] + bflo(g0.w) * wa[6] + bfhi(g0.w) * wa[7];
            a += bflo(g1.x) * wa[8] + bfhi(g1.x) * wa[9] + bflo(g1.y) * wa[10] + bfhi(g1.y) * wa[11] + bflo(g1.z) * wa[12] + bfhi(g1.z) * wa[13] + bflo(g1.w) * wa[14] + bfhi(g1.w) * wa[15];
            const float ls2 = fminf(a, 0.f) * LOG2E - __builtin_amdgcn_logf(1.0f + __builtin_amdgcn_exp2f(-LOG2E * fabsf(a)));
            qv[u] = bf2f(qr[u]) * 0.125f; kv[u] = bf2f(kr[u]);
            run += ls2 * (1.0f / 16.0f); bv[u] = run; }
    }
    tot[seg * DK + d] = run;
    __syncthreads();
    float off = 0.f; bend = 0.f; bref = 0.f;
#pragma unroll
    for (int sgi = 0; sgi < NSEG; ++sgi) { const float v = tot[sgi * DK + d]; off += sgi < seg ? v : 0.f; bref += sgi < NSEG / 2 ? v : 0.f; bend += v; }
#pragma unroll
    for (int u = 0; u < TPS; ++u) bv[u] += off;
}
template <int KIND> __device__ __forceinline__ void rec_vt_load(KArgs* ka, int head, int chunk, int tid, unsigned (&w)[8]) {
    const bf16* P = (const bf16*)(KWS + WS_P) + (KIND == 0 ? C_HI : C_GV) + head * 128;
    const int v = tid & 127, sv = tid >> 7;
#pragma unroll
    for (int u = 0; u < 8; ++u) { const unsigned a = P[(size_t)(chunk * 64 + sv * 16 + 2 * u) * NPAD + v], b = P[(size_t)(chunk * 64 + sv * 16 + 2 * u + 1) * NPAD + v]; w[u] = a | (b << 16); }
}
__device__ __forceinline__ void rec_vt_store(int tid, LAS unsigned char* lds, const unsigned (&w)[8]) {
    const int v = tid & 127, sv = tid >> 7;
    LAS u32x4* dst = (LAS u32x4*)(lds + REC_VT_OFF + v * 144 + sv * 32);
    dst[0] = (u32x4){w[0], w[1], w[2], w[3]}; dst[1] = (u32x4){w[4], w[5], w[6], w[7]};
}
template <int KIND> __device__ __forceinline__ void rec_local_unit(KArgs* ka, Frame& F, int l, int head, int chunk) {
    constexpr int DK = RecCfg<KIND>::DK, TPS = RecCfg<KIND>::TPS;
    LAS unsigned char* lds = F.lds; LAS float* tot = (LAS float*)(lds + REC_TOT_OFF);
    float qv[TPS], kv[TPS], bv[TPS], bend, bref;
    unsigned vraw[8];
    rec_vt_load<KIND>(ka, head, chunk, F.tid, vraw);
    rec_elem<KIND>(ka, l, head, chunk, F.tid, tot, qv, kv, bv, bend, bref);
    const int d = F.tid % DK, seg = F.tid / DK, unit = chunk * 4 + head;
    { unsigned w[TPS / 2];
#pragma unroll
      for (int u = 0; u < TPS / 2; ++u) w[u] = pkbf(kv[2 * u] * expc(bend - bv[2 * u]), kv[2 * u + 1] * expc(bend - bv[2 * u + 1]));
      LAS u32x4* dst = (LAS u32x4*)(lds + REC_KD_OFF + d * 144 + seg * TPS * 2);
      dst[0] = (u32x4){w[0], w[1], w[2], w[3]};
      if constexpr (TPS == 16) dst[1] = (u32x4){w[4], w[5], w[6], w[7]}; }
    if (seg == 0) ((float*)(KWS + WS_DEC + (KIND == 0 ? 0 : 262144)))[(size_t)unit * DK + d] = __builtin_amdgcn_exp2f(bend);
    rec_vt_store(F.tid, lds, vraw);
    __syncthreads();
    const int r = F.lane & 15, kq = F.lane >> 4;
    const int dt = KIND == 0 ? F.wave : (F.wave & 3), vt0 = KIND == 0 ? 0 : (F.wave >> 2) * 4, nvt = KIND == 0 ? 8 : 4;
    bf16x8 a[2];
#pragma unroll
    for (int ks = 0; ks < 2; ++ks) a[ks] = *(const LAS bf16x8*)(lds + REC_KD_OFF + (16 * dt + r) * 144 + (32 * ks + 8 * kq) * 2);
    bf16* Sl = (bf16*)(KWS + (KIND == 0 ? WS_SLOC_HG : WS_SLOC_GL)) + (size_t)unit * 128 * DK;
#pragma unroll
    for (int vi = 0; vi < nvt; ++vi) { const int vt = vt0 + vi; f32x4 acc = {0.f, 0.f, 0.f, 0.f};
#pragma unroll
        for (int ks = 0; ks < 2; ++ks) { const bf16x8 b = *(const LAS bf16x8*)(lds + REC_VT_OFF + (16 * vt + r) * 144 + (32 * ks + 8 * kq) * 2); acc = __builtin_amdgcn_mfma_f32_16x16x32_bf16(a[ks], b, acc, 0, 0, 0); }
        u32x2 w2; w2.x = pkbf(acc[0], acc[1]); w2.y = pkbf(acc[2], acc[3]);
        *(u32x2*)(Sl + (size_t)(16 * vt + r) * DK + 16 * dt + 4 * kq) = w2; }
    __syncthreads();
}
__device__ __forceinline__ void phase_rec_local(Frame& F, int l) {
    KA;
    for (int it = F.bid; it < 1024; it += F.G) { const int kind = it >> 9, chunk = (it >> 2) & 127, head = it & 3;
        if (kind == 0) rec_local_unit<0>(ka, F, l, head, chunk); else rec_local_unit<1>(ka, F, l, head, chunk); }
}
__device__ __forceinline__ void phase_rec_scan(Frame& F) {
    KA;
    const int gt = F.bid * 512 + F.tid;
    if (gt >= 49152) return;
    const bool hg = gt < 32768; const int q = hg ? gt : gt - 32768;
    const int DK = hg ? 128 : 64, dp = q % (DK / 2), v = (q / (DK / 2)) & 127, head = q / (DK / 2 * 128);
    const bf16* Sl = (const bf16*)(KWS + (hg ? WS_SLOC_HG : WS_SLOC_GL)) + ((size_t)head * 128 + v) * DK + 2 * dp;
    bf16* Sp = (bf16*)(KWS + (hg ? WS_SPREV_HG : WS_SPREV_GL)) + ((size_t)head * 128 + v) * DK + 2 * dp;
    const float* De = (const float*)(KWS + WS_DEC + (hg ? 0 : 262144)) + (size_t)head * DK + 2 * dp;
    const size_t ustr = (size_t)4 * 128 * DK, dstr = (size_t)4 * DK;
    float s0 = 0.f, s1 = 0.f;
    for (int c0 = 0; c0 < NCH; c0 += 16) { unsigned x[16]; f32x2 dc[16];
#pragma unroll
        for (int u = 0; u < 16; ++u) { x[u] = *(const unsigned*)(Sl + (size_t)(c0 + u) * ustr); dc[u] = *(const f32x2*)(De + (size_t)(c0 + u) * dstr); }
#pragma unroll
        for (int u = 0; u < 16; ++u) { *(unsigned*)(Sp + (size_t)(c0 + u) * ustr) = pkbf(s0, s1); s0 = dc[u].x * s0 + bflo(x[u]); s1 = dc[u].y * s1 + bfhi(x[u]); } }
}
template <int KIND> __device__ __forceinline__ void rec_out_unit(KArgs* ka, Frame& F, int l, int head, int chunk) {
    constexpr int DK = RecCfg<KIND>::DK, TPS = RecCfg<KIND>::TPS, QROW = RecCfg<KIND>::QROW, NKS = DK / 32;
    LAS unsigned char* lds = F.lds; LAS float* tot = (LAS float*)(lds + REC_TOT_OFF); LAS float* red = (LAS float*)(lds + REC_RED_OFF);
    const int r = F.lane & 15, kq = F.lane >> 4, unit = chunk * 4 + head, vt = F.wave;
    bf16x8 sa[NKS];
    { const bf16* Sp = (const bf16*)(KWS + (KIND == 0 ? WS_SPREV_HG : WS_SPREV_GL)) + (size_t)unit * 128 * DK + (size_t)(16 * vt + r) * DK + 8 * kq;
#pragma unroll
      for (int ks = 0; ks < NKS; ++ks) sa[ks] = *(const bf16x8*)(Sp + 32 * ks); }
    float qv[TPS], kv[TPS], bv[TPS], bend, bref;
    unsigned vraw[8];
    rec_vt_load<KIND>(ka, head, chunk, F.tid, vraw);
    const bf16* P = (const bf16*)(KWS + WS_P); bf16* OCAT = (bf16*)(KWS + WS_OCAT);
    const int v0 = 16 * vt + 4 * kq;
    const f32x4 gn = *(const f32x4*)((KIND == 0 ? KIN(I_HGN) : KIN(I_GLAN)) + l * 128 + v0);
    u32x2 gq4[4];
#pragma unroll
    for (int it = 0; it < 4; ++it) gq4[it] = *(const u32x2*)(P + (size_t)(chunk * 64 + 16 * it + r) * NPAD + (KIND == 0 ? C_HG : C_GR) + head * 128 + v0);
    rec_elem<KIND>(ka, l, head, chunk, F.tid, tot, qv, kv, bv, bend, bref);
    { const int d = F.tid % DK, seg = F.tid / DK; const float eref = __builtin_amdgcn_exp2f(fmaxf(bref, -120.f));
#pragma unroll
      for (int u = 0; u < TPS; u += 2) { const int o = (seg * TPS + u) * QROW + d * 2;
          const float x0 = __builtin_amdgcn_exp2f(fminf(fmaxf(bv[u] - bref, -110.f), 110.f)), x1 = __builtin_amdgcn_exp2f(fminf(fmaxf(bv[u + 1] - bref, -110.f), 110.f));
          const float qs0 = qv[u] * x0, qs1 = qv[u + 1] * x1;
          const unsigned w0 = pkbf(qs0, qs1), w1 = pkbf(kv[u] * __builtin_amdgcn_rcpf(x0), kv[u + 1] * __builtin_amdgcn_rcpf(x1)), w2 = pkbf(qs0 * eref, qs1 * eref);
          *(LAS bf16*)(lds + REC_QS_OFF + o) = (bf16)w0; *(LAS bf16*)(lds + REC_QS_OFF + o + QROW) = (bf16)(w0 >> 16);
          *(LAS bf16*)(lds + REC_KS_OFF + o) = (bf16)w1; *(LAS bf16*)(lds + REC_KS_OFF + o + QROW) = (bf16)(w1 >> 16);
          *(LAS bf16*)(lds + REC_QD_OFF + o) = (bf16)w2; *(LAS bf16*)(lds + REC_QD_OFF + o + QROW) = (bf16)(w2 >> 16); } }
    rec_vt_store(F.tid, lds, vraw);
    __syncthreads();
#pragma unroll
    for (int tt = 0; tt < 2; ++tt) { const int tile = F.wave * 2 + tt, jt = tile >> 2, it = tile & 3; f32x4 acc = {0.f, 0.f, 0.f, 0.f};
        if (jt <= it) {
#pragma unroll
            for (int ks = 0; ks < NKS; ++ks) { const bf16x8 a = *(const LAS bf16x8*)(lds + REC_KS_OFF + (16 * jt + r) * QROW + (32 * ks + 8 * kq) * 2), b = *(const LAS bf16x8*)(lds + REC_QS_OFF + (16 * it + r) * QROW + (32 * ks + 8 * kq) * 2);
                acc = __builtin_amdgcn_mfma_f32_16x16x32_bf16(a, b, acc, 0, 0, 0); } }
        const int i = 16 * it + r, j0 = 16 * jt + 4 * kq;
        u32x2 w; w.x = pk2(j0 <= i ? acc[0] : 0.f, j0 + 1 <= i ? acc[1] : 0.f); w.y = pk2(j0 + 2 <= i ? acc[2] : 0.f, j0 + 3 <= i ? acc[3] : 0.f);
        *(LAS u32x2*)(lds + REC_KD_OFF + i * 144 + j0 * 2) = w; }
    __syncthreads();
    f32x4 acc[4];
#pragma unroll
    for (int it = 0; it < 4; ++it) acc[it] = (f32x4){0.f, 0.f, 0.f, 0.f};
#pragma unroll
    for (int ks = 0; ks < 2; ++ks) { const bf16x8 a = *(const LAS bf16x8*)(lds + REC_VT_OFF + (16 * vt + r) * 144 + (32 * ks + 8 * kq) * 2);
#pragma unroll
        for (int it = 0; it < 4; ++it) { const bf16x8 b = *(const LAS bf16x8*)(lds + REC_KD_OFF + (16 * it + r) * 144 + (32 * ks + 8 * kq) * 2); acc[it] = __builtin_amdgcn_mfma_f32_16x16x32_bf16(a, b, acc[it], 0, 0, 0); } }
#pragma unroll
    for (int ks = 0; ks < NKS; ++ks) {
#pragma unroll
        for (int it = 0; it < 4; ++it) { const bf16x8 b = *(const LAS bf16x8*)(lds + REC_QD_OFF + (16 * it + r) * QROW + (32 * ks + 8 * kq) * 2); acc[it] = __builtin_amdgcn_mfma_f32_16x16x32_bf16(sa[ks], b, acc[it], 0, 0, 0); } }
#pragma unroll
    for (int it = 0; it < 4; ++it) { float ss = acc[it][0] * acc[it][0] + acc[it][1] * acc[it][1] + acc[it][2] * acc[it][2] + acc[it][3] * acc[it][3];
        ss += __shfl_xor(ss, 16); ss += __shfl_xor(ss, 32);
        if (kq == 0) red[F.wave * 64 + 16 * it + r] = ss; }
    __syncthreads();
#pragma unroll
    for (int it = 0; it < 4; ++it) { const int i = 16 * it + r, t = chunk * 64 + i; float tot_ = 0.f;
#pragma unroll
        for (int w = 0; w < 8; ++w) tot_ += red[w * 64 + i];
        const float rstd = 1.0f / sqrtf(tot_ * (1.0f / 128.0f) + EPS);
        const u32x2 gq = gq4[it];
        float gt[4] = {bflo(gq.x), bfhi(gq.x), bflo(gq.y), bfhi(gq.y)}, o[4];
#pragma unroll
        for (int e = 0; e < 4; ++e) { const float sg = fsig(gt[e]); o[e] = acc[it][e] * rstd * gn[e] * (KIND == 0 ? sg : gt[e] * sg); }
        u32x2 w; w.x = pkbf(o[0], o[1]); w.y = pkbf(o[2], o[3]);
        *(u32x2*)(OCAT + (size_t)t * 1536 + 512 + KIND * 512 + head * 128 + v0) = w; }
    __syncthreads();
}
__device__ __forceinline__ void phase_rec_out(Frame& F, int l) {
    KA;
    unsigned* qctr = (unsigned*)(KWS + WS_CTL) + 2048 + 64 * l;
    volatile LAS int* qslot = (volatile LAS int*)(F.lds + MISC_OFF + 1024);
    int mine = 0;
    if (F.tid == 0) { mine = (int)__hip_atomic_fetch_add(qctr, 1u, __ATOMIC_RELAXED, __HIP_MEMORY_SCOPE_AGENT);
        unsigned* sdone = (unsigned*)(KWS + WS_CTL) + 2048 + 64 * (4 + l); unsigned sp = 0;
        while (__hip_atomic_load(sdone, __ATOMIC_RELAXED, __HIP_MEMORY_SCOPE_AGENT) < 96u) { __builtin_amdgcn_s_sleep(2); if (++sp > (1u << 24)) break; }
        __builtin_amdgcn_fence(__ATOMIC_ACQUIRE, "agent"); asm volatile("s_waitcnt vmcnt(0)" ::: "memory"); }
    for (;;) {
        if (F.tid == 0) *qslot = mine;
        __syncthreads();
        const int it = __builtin_amdgcn_readfirstlane(*qslot);
        __syncthreads();
        if (it >= 1024) break;
        if (F.tid == 0) mine = (int)__hip_atomic_fetch_add(qctr, 1u, __ATOMIC_RELAXED, __HIP_MEMORY_SCOPE_AGENT);
        const int kind = it >> 9, chunk = (it >> 2) & 127, head = it & 3;
        if (kind == 0) rec_out_unit<0>(ka, F, l, head, chunk); else rec_out_unit<1>(ka, F, l, head, chunk);
    }
}

typedef float f32x16 __attribute__((ext_vector_type(16)));
constexpr float NSA_SHIFT2 = 8.0f;
__device__ __forceinline__ int perm16(int b) { return (b & 3) | ((b & 4) << 1) | ((b & 8) >> 1); }
__device__ __forceinline__ void phase_prep2(Frame& F, int l) {
    KA;
    const bf16* P = (const bf16*)(KWS + WS_P);
    bf16* QS = (bf16*)(KWS + WS_QS); bf16* KS2 = (bf16*)(KWS + WS_KS2); bf16* KW2 = (bf16*)(KWS + WS_KW2);
    const float* qg = KIN(I_QN) + l * 64; const float* kg = KIN(I_KN) + l * 192;
    for (int it = F.gw; it < T * 12; it += F.NGW) {
        const int t = it / 12, v = it % 12;
        const int col = v < 8 ? v * 64 : (v < 10 ? C_KS + (v - 8) * 64 : C_KW + (v - 10) * 64);
        float x = bf2f(P[(size_t)t * NPAD + col + F.lane]);
        const float ss = wave_sum(x * x);
        const float g = v < 8 ? qg[F.lane] * (0.125f * LOG2E) : (v < 10 ? kg[64 + F.lane] : kg[128 + F.lane]);
        x = x * (1.0f / sqrtf(ss * (1.0f / 64.0f) + EPS)) * g;
        bf16* dst = v < 8 ? QS + ((size_t)v * T + t) * 64 : (v < 10 ? KS2 + ((size_t)(v - 8) * T + t) * 64 : KW2 + ((size_t)(v - 10) * T + t) * 64);
        dst[F.lane] = (bf16)f2bf(x);
    }
    LAS bf16* tile = (LAS bf16*)(F.lds + F.wave * 16384);
    for (int it = F.gw; it < 2 * 2 * (T / 64); it += F.NGW) {
        const int kind = it / (2 * (T / 64)), q = it % (2 * (T / 64)), g = q / (T / 64), tb = q % (T / 64);
        const bf16* src = P + (size_t)(tb * 64) * NPAD + (kind == 0 ? C_VS : C_VW) + g * 64;
        bf16* dst = (bf16*)(KWS + (kind == 0 ? WS_VST : WS_VWT)) + (size_t)g * 64 * T + tb * 64;
#pragma unroll 4
        for (int r = 0; r < 64; ++r) tile[r * 66 + F.lane] = src[(size_t)r * NPAD + F.lane];
        WSYNC();
        const int pl = (F.lane & ~15) | perm16(F.lane & 15);
#pragma unroll 4
        for (int d = 0; d < 64; ++d) dst[(size_t)d * T + pl] = tile[F.lane * 66 + d];
        WSYNC();
    }
}

__device__ __forceinline__ void phase_prep3(Frame& F, int l) {
    KA;
    const bf16* P = (const bf16*)(KWS + WS_P);
    bf16* QS = (bf16*)(KWS + WS_QS); bf16* KS2 = (bf16*)(KWS + WS_KS2); bf16* KW2 = (bf16*)(KWS + WS_KW2);
    const float* qg = KIN(I_QN) + l * 64; const float* kg = KIN(I_KN) + l * 192;
    const int vec = F.lane >> 3, part = F.lane & 7;
    for (int t = F.gw; t < T; t += F.NGW) {
#pragma unroll
        for (int pass = 0; pass < 2; ++pass) {
            if (pass == 1 && vec >= 4) continue;
            const int col = pass == 0 ? vec * 64 : (vec < 2 ? C_KS + vec * 64 : C_KW + (vec - 2) * 64);
            const float* gp = pass == 0 ? qg : (vec < 2 ? kg + 64 : kg + 128);
            const float gs = pass == 0 ? 0.125f * LOG2E : 1.0f;
            bf16* dst = pass == 0 ? QS + ((size_t)vec * T + t) * 64 : (vec < 2 ? KS2 + ((size_t)vec * T + t) * 64 : KW2 + ((size_t)(vec - 2) * T + t) * 64);
            const u32x4 raw = *(const u32x4*)(P + (size_t)t * NPAD + col + part * 8);
            float x[8] = {bflo(raw.x), bfhi(raw.x), bflo(raw.y), bfhi(raw.y), bflo(raw.z), bfhi(raw.z), bflo(raw.w), bfhi(raw.w)};
            float ss = 0.f;
#pragma unroll
            for (int e = 0; e < 8; ++e) ss += x[e] * x[e];
            ss += __shfl_xor(ss, 1); ss += __shfl_xor(ss, 2); ss += __shfl_xor(ss, 4);
            const float rstd = gs / sqrtf(ss * (1.0f / 64.0f) + EPS);
            const f32x4 g0 = *(const f32x4*)(gp + part * 8), g1 = *(const f32x4*)(gp + part * 8 + 4);
            u32x4 o; o.x = pk2(x[0] * rstd * g0.x, x[1] * rstd * g0.y); o.y = pk2(x[2] * rstd * g0.z, x[3] * rstd * g0.w); o.z = pk2(x[4] * rstd * g1.x, x[5] * rstd * g1.y); o.w = pk2(x[6] * rstd * g1.z, x[7] * rstd * g1.w);
            *(u32x4*)(dst + part * 8) = o;
        }
    }
    LAS bf16* tile = (LAS bf16*)(F.lds + F.wave * 16384);
    for (int it = F.gw; it < 2 * 2 * (T / 64); it += F.NGW) {
        const int kind = it / (2 * (T / 64)), q = it % (2 * (T / 64)), g = q / (T / 64), tb = q % (T / 64);
        const bf16* src = P + (size_t)(tb * 64) * NPAD + (kind == 0 ? C_VS : C_VW) + g * 64;
        bf16* dst = (bf16*)(KWS + (kind == 0 ? WS_VST : WS_VWT)) + (size_t)g * 64 * T + tb * 64;
#pragma unroll
        for (int i = 0; i < 8; ++i) { const int tok = vec + 8 * i; *(LAS u32x4*)(tile + tok * 72 + part * 8) = *(const u32x4*)(src + (size_t)tok * NPAD + part * 8); }
        WSYNC();
#pragma unroll
        for (int c = 0; c < 8; ++c) { unsigned w[4];
#pragma unroll
            for (int k = 0; k < 4; ++k) { const int p0 = (c & 1) * 8 + 2 * k, p1 = p0 + 1;
                const int k0 = (c >> 1) * 16 + ((p0 & 3) | ((p0 & 4) << 1) | ((p0 & 8) >> 1)), k1 = (c >> 1) * 16 + ((p1 & 3) | ((p1 & 4) << 1) | ((p1 & 8) >> 1));
                w[k] = (unsigned)tile[k0 * 72 + F.lane] | ((unsigned)tile[k1 * 72 + F.lane] << 16); }
            *(u32x4*)(dst + (size_t)F.lane * T + c * 8) = (u32x4){w[0], w[1], w[2], w[3]}; }
        WSYNC();
    }
}

__device__ __forceinline__ void phase_compress2(Frame& F, int l) {
    KA;
    LAS float* av = (LAS float*)(F.lds + F.wave * 16384);
    const bf16* P = (const bf16*)(KWS + WS_P);
    bf16* KCB = (bf16*)(KWS + WS_KCB); bf16* VCT = (bf16*)(KWS + WS_KCB + 131072);
    for (int it = F.gw; it < 2 * 2 * 512; it += F.NGW) {
        const int kind = it >> 10, g = (it >> 9) & 1, n = it & 511;
        if (n == 511) { if (kind == 0) KCB[((size_t)g * 512 + 511) * 64 + F.lane] = 0; else VCT[((size_t)g * 64 + F.lane) * 512 + 511] = 0; continue; }
        const bf16* src = P + (size_t)(16 * n) * NPAD + (kind == 0 ? C_KC : C_VC) + g * 64;
        const float* pe = KIN(I_PE) + ((size_t)l * 2 + kind) * 2048;
        const float* w1 = KIN(I_W1) + ((size_t)l * 2 + kind) * 2048 * 64;
        const float* w2 = KIN(I_W2) + ((size_t)l * 2 + kind) * 64 * 64;
#pragma unroll 4
        for (int c = 0; c < 32; ++c) av[c * 64 + F.lane] = bf2f(src[(size_t)c * NPAD + F.lane]) + pe[c * 64 + F.lane];
        WSYNC();
        float acc = 0.f;
#pragma unroll 8
        for (int i = 0; i < 2048; ++i) acc += av[i] * w1[i * 64 + F.lane];
        const float hid = gelu_tanh(acc);
        WSYNC();
        av[F.lane] = hid;
        WSYNC();
        float o = 0.f;
#pragma unroll 8
        for (int i = 0; i < 64; ++i) o += av[i] * w2[i * 64 + F.lane];
        WSYNC();
        if (kind == 0) { const float ss = wave_sum(o * o); o = o * (1.0f / sqrtf(ss * (1.0f / 64.0f) + EPS)) * KIN(I_KN)[l * 192 + F.lane]; KCB[((size_t)g * 512 + n) * 64 + F.lane] = (bf16)f2bf(o); }
        else VCT[((size_t)g * 64 + F.lane) * 512 + ((n & ~15) | perm16(n & 15))] = (bf16)f2bf(o);
    }
}

__device__ __forceinline__ void phase_compress3(Frame& F, int l) {
    KA;
    const bf16* P = (const bf16*)(KWS + WS_P);
    bf16* KCB = (bf16*)(KWS + WS_KCB); bf16* VCT = (bf16*)(KWS + WS_KCB + 131072);
    LAS float* red = (LAS float*)F.lds;
    LAS bf16* hid = (LAS bf16*)(F.lds + 32768);
    const int r16 = F.lane & 15, kq = F.lane >> 4;
    for (int unit = F.bid; unit < 128; unit += F.G) {
        const int kind = unit >> 6, mt = unit & 63, g = mt >> 5, n0 = (mt & 31) * 16;
        const bf16* W1T = (const bf16*)(KWS + WS_CW) + (size_t)(l * 2 + kind) * 64 * 2048; const bf16* W2T = (const bf16*)(KWS + WS_CW + 1048576) + (size_t)(l * 2 + kind) * 4096;
        const float* B1 = (const float*)(KWS + WS_CW + 1572864) + (l * 2 + kind) * 64;
        const bf16* arow = P + (size_t)(16 * (n0 + r16)) * NPAD + (kind == 0 ? C_KC : C_VC) + g * 64;
        f32x4 acc[4];
#pragma unroll
        for (int nt = 0; nt < 4; ++nt) acc[nt] = (f32x4){0.f, 0.f, 0.f, 0.f};
#pragma unroll 2
        for (int ks = 0; ks < 8; ++ks) { const int c0 = F.wave * 256 + 32 * ks + 8 * kq;
            const bf16x8 a = *(const bf16x8*)(arow + (size_t)(c0 >> 6) * NPAD + (c0 & 63));
#pragma unroll
            for (int nt = 0; nt < 4; ++nt) { const bf16x8 b = *(const bf16x8*)(W1T + (size_t)(16 * nt + r16) * 2048 + c0); acc[nt] = __builtin_amdgcn_mfma_f32_16x16x32_bf16(a, b, acc[nt], 0, 0, 0); } }
#pragma unroll
        for (int nt = 0; nt < 4; ++nt) *(LAS f32x4*)(red + ((F.wave * 4 + nt) * 64 + F.lane) * 4) = acc[nt];
        __syncthreads();
        if (F.tid < 256) { const int nt = F.tid >> 6, ln = F.tid & 63; f32x4 v = {0.f, 0.f, 0.f, 0.f};
#pragma unroll
            for (int w = 0; w < 8; ++w) v += *(const LAS f32x4*)(red + ((w * 4 + nt) * 64 + ln) * 4);
            const int col = 16 * nt + (ln & 15); const float b1 = B1[col];
#pragma unroll
            for (int i = 0; i < 4; ++i) hid[(4 * (ln >> 4) + i) * 72 + col] = (bf16)f2bf(gelu_tanh(v[i] + b1)); }
        __syncthreads();
        if (F.wave == 0) {
            f32x4 o[4];
#pragma unroll
            for (int nt = 0; nt < 4; ++nt) o[nt] = (f32x4){0.f, 0.f, 0.f, 0.f};
#pragma unroll
            for (int ks = 0; ks < 2; ++ks) { const bf16x8 a = *(const LAS bf16x8*)(hid + r16 * 72 + 32 * ks + 8 * kq);
#pragma unroll
                for (int nt = 0; nt < 4; ++nt) { const bf16x8 b = *(const bf16x8*)(W2T + (16 * nt + r16) * 64 + 32 * ks + 8 * kq); o[nt] = __builtin_amdgcn_mfma_f32_16x16x32_bf16(a, b, o[nt], 0, 0, 0); } }
            if (kind == 0) {
#pragma unroll
                for (int i = 0; i < 4; ++i) { float ss = o[0][i] * o[0][i] + o[1][i] * o[1][i] + o[2][i] * o[2][i] + o[3][i] * o[3][i];
                    ss += __shfl_xor(ss, 1); ss += __shfl_xor(ss, 2); ss += __shfl_xor(ss, 4); ss += __shfl_xor(ss, 8);
                    const float rstd = 1.0f / sqrtf(ss * (1.0f / 64.0f) + EPS); const int n = n0 + 4 * kq + i;
#pragma unroll
                    for (int nt = 0; nt < 4; ++nt) { const int col = 16 * nt + r16; KCB[((size_t)g * 512 + n) * 64 + col] = n < 511 ? (bf16)f2bf(o[nt][i] * rstd * KIN(I_KN)[l * 192 + col]) : (bf16)0; } }
            } else {
#pragma unroll
                for (int i = 0; i < 4; ++i) { const int n = n0 + 4 * kq + i;
#pragma unroll
                    for (int nt = 0; nt < 4; ++nt) { const int col = 16 * nt + r16; VCT[((size_t)g * 64 + col) * 512 + ((n & ~15) | perm16(n & 15))] = n < 511 ? (bf16)f2bf(o[nt][i]) : (bf16)0; } }
            }
        }
        __syncthreads();
    }
}

constexpr int NSA_SCA = 65536, NSA_SCB = 99328;
constexpr int NSA_QM = 133120, NSA_UM = 134144;
static_assert(NSA_UM + 16 <= MISC_OFF, "NSA LDS map");
__device__ __forceinline__ int next_set(unsigned long long m0, unsigned long long m1, int from) {
    if (from < 64) { const unsigned long long x = m0 & (~0ull << from); if (x) return __builtin_ctzll(x); from = 64; }
    if (from < 128) { const unsigned long long x = m1 & (~0ull << (from - 64)); if (x) return 64 + __builtin_ctzll(x); }
    return 128;
}
__device__ __forceinline__ void nsa_issue(LAS unsigned char* lds, int slot, const bf16* Kg, const bf16* VTg, int vt_len, int j, int tid, int wave) {
    const int row = tid >> 3, c = (tid & 7) ^ ((row >> 1) & 7);
    __builtin_amdgcn_global_load_lds((const unsigned*)(Kg + (size_t)(64 * j + row) * 64 + c * 8), (LAS unsigned*)(lds + slot * 16384 + wave * 1024), 16, 0, 0);
    __builtin_amdgcn_global_load_lds((const unsigned*)(VTg + (size_t)row * vt_len + 64 * j + c * 8), (LAS unsigned*)(lds + slot * 16384 + 8192 + wave * 1024), 16, 0, 0);
}
template <int MODE> __device__ __forceinline__ void nsa_branch(Frame& F, const bf16* Kg, const bf16* VTg, int vt_len, unsigned long long m0, unsigned long long m1,
        const bf16x8 (&Qf)[4], int t, int cblk, u32x4 qxw, int tref, float inv_l, const unsigned (&qsel)[4], int hi_cmp, unsigned wm_lo_dummy, f32x16 (&oacc)[2], float& lsum) {
    LAS unsigned char* lds = F.lds;
    const int lane = F.lane, c32 = lane & 31, h = lane >> 5, tid = F.tid;
    const int sw = (c32 >> 1) & 7;
    int j0 = next_set(m0, m1, 0);
    if (j0 >= 128) return;
    int j1 = next_set(m0, m1, j0 + 1), j2 = j1 < 128 ? next_set(m0, m1, j1 + 1) : 128;
    nsa_issue(lds, 0, Kg, VTg, vt_len, j0, tid, F.wave);
    if (j1 < 128) nsa_issue(lds, 1, Kg, VTg, vt_len, j1, tid, F.wave);
    if (j2 < 128) nsa_issue(lds, 2, Kg, VTg, vt_len, j2, tid, F.wave);
    int slot = 0;
    while (j0 < 128) {
        const int j = j0;
        if (j2 < 128) asm volatile("s_waitcnt vmcnt(4)" ::: "memory"); else if (j1 < 128) asm volatile("s_waitcnt vmcnt(2)" ::: "memory"); else asm volatile("s_waitcnt vmcnt(0)" ::: "memory");
        __builtin_amdgcn_s_barrier(); asm volatile("" ::: "memory");
        const int j3 = j2 < 128 ? next_set(m0, m1, j2 + 1) : 128;
        if (j3 < 128) nsa_issue(lds, (slot + 3) & 3, Kg, VTg, vt_len, j3, tid, F.wave);
        bool need = true;
        if (MODE == 2) { const unsigned myw = j < 32 ? qsel[0] : (j < 64 ? qsel[1] : (j < 96 ? qsel[2] : qsel[3])); need = __any((myw >> (j & 31)) & 1u); }
        if (need) {
            const int kb = slot * 16384, vb = slot * 16384 + 8192;
            const int kbase = 64 * j;
            u32x4 qx = qxw;
            if (MODE == 2) { const unsigned myw = j < 32 ? qsel[0] : (j < 64 ? qsel[1] : (j < 96 ? qsel[2] : qsel[3])); if (!((myw >> (j & 31)) & 1u) && h == 0) qx.z = 0xF149u; }
            const bf16x8 qxf = __builtin_bit_cast(bf16x8, qx);
            f32x16 sacc[2];
#pragma unroll
            for (int sub = 0; sub < 2; ++sub)
#pragma unroll
                for (int i = 0; i < 16; ++i) sacc[sub][i] = 0.f;
#pragma unroll
            for (int sub = 0; sub < 2; ++sub) {
#pragma unroll
                for (int kp = 0; kp < 2; ++kp) { bf16x8 ka2[2];
#pragma unroll
                    for (int k2 = 0; k2 < 2; ++k2) ka2[k2] = *(const LAS bf16x8*)(lds + kb + (32 * sub + c32) * 128 + (((2 * (2 * kp + k2) + h) ^ sw) * 16));
                    asm volatile("" ::: "memory");
#pragma unroll
                    for (int k2 = 0; k2 < 2; ++k2) sacc[sub] = __builtin_amdgcn_mfma_f32_32x32x16_bf16(ka2[k2], Qf[2 * kp + k2], sacc[sub], 0, 0, 0);
                    asm volatile("" ::: "memory"); }
                { const int kidx = kbase + 32 * sub + c32, pos = MODE < 2 ? 16 * kidx + 31 : kidx, dd = tref - pos;
                  const unsigned w = pkbf(-(float)((dd >> 8) * 256), -(float)(dd & 255));
                  u32x4 kx; kx.x = h == 0 ? w : 0u; kx.y = kx.x; kx.z = h == 0 ? 0x3F80u : 0u; kx.w = 0u;
                  sacc[sub] = __builtin_amdgcn_mfma_f32_32x32x16_bf16(__builtin_bit_cast(bf16x8, kx), qxf, sacc[sub], 0, 0, 0); } }
#pragma unroll
            for (int sub = 0; sub < 2; ++sub)
#pragma unroll
                for (int i = 0; i < 16; ++i) sacc[sub][i] = __builtin_amdgcn_exp2f(sacc[sub][i]);
            bool mhi = false, mlo = false; int hi = 0, lo = 0;
            if (MODE < 2) { mhi = (kbase + 63 > (tref - 63 - 31) / 16 - 1); hi = hi_cmp; }
            if (MODE == 2) { mhi = (j == cblk); hi = t; }
            if (MODE == 3) { mhi = (j == cblk); hi = t; mlo = (j == cblk - 8); lo = t - 511; }
            if (mhi || mlo) {
#pragma unroll
                for (int sub = 0; sub < 2; ++sub)
#pragma unroll
                    for (int i = 0; i < 16; ++i) { const int idx = kbase + 4 * h + 32 * sub + (i & 3) + 8 * (i >> 2); if ((mhi && idx > hi) || (mlo && idx < lo)) sacc[sub][i] = 0.f; }
            }
            float ls = 0.f;
#pragma unroll
            for (int sub = 0; sub < 2; ++sub)
#pragma unroll
                for (int i = 0; i < 16; ++i) ls += sacc[sub][i];
            lsum += ls;
            if (MODE == 1) {
                LAS float* scA = (LAS float*)(lds + NSA_SCA); LAS float* scB = (LAS float*)(lds + NSA_SCB);
                const int q = F.wave * 8 + (c32 >> 2);
#pragma unroll
                for (int sub = 0; sub < 2; ++sub)
#pragma unroll
                    for (int g4 = 0; g4 < 4; ++g4) { float x[4];
#pragma unroll
                        for (int e = 0; e < 4; ++e) { float v = sacc[sub][4 * g4 + e] * inv_l;
                            v += __builtin_bit_cast(float, __builtin_amdgcn_mov_dpp(__builtin_bit_cast(int, v), 0xB1, 0xF, 0xF, true));
                            v += __builtin_bit_cast(float, __builtin_amdgcn_mov_dpp(__builtin_bit_cast(int, v), 0x4E, 0xF, 0xF, true));
                            x[e] = v; }
                        const int jb = 16 * j + 8 * sub + 2 * g4 + h;
                        if ((c32 & 3) == 0) { scA[q * 132 + jb] = 2.0f * (x[0] + x[1] + x[2]) + x[3]; scB[q * 132 + jb + 1] = x[3]; } }
            }
            if (MODE != 0) {
                bf16x8 pf[2][2];
#pragma unroll
                for (int sub = 0; sub < 2; ++sub)
#pragma unroll
                    for (int s2 = 0; s2 < 2; ++s2) { u32x4 w; w.x = pkbf(sacc[sub][8 * s2], sacc[sub][8 * s2 + 1]); w.y = pkbf(sacc[sub][8 * s2 + 2], sacc[sub][8 * s2 + 3]); w.z = pkbf(sacc[sub][8 * s2 + 4], sacc[sub][8 * s2 + 5]); w.w = pkbf(sacc[sub][8 * s2 + 6], sacc[sub][8 * s2 + 7]);
                        pf[sub][s2] = __builtin_bit_cast(bf16x8, w); }
                asm volatile("" ::: "memory");
#pragma unroll
                for (int ds = 0; ds < 2; ++ds) {
#pragma unroll
                    for (int qp = 0; qp < 2; ++qp) { bf16x8 va2[2];
#pragma unroll
                        for (int k2 = 0; k2 < 2; ++k2) va2[k2] = *(const LAS bf16x8*)(lds + vb + (32 * ds + c32) * 128 + (((2 * (2 * qp + k2) + h) ^ sw) * 16));
                        asm volatile("" ::: "memory");
#pragma unroll
                        for (int k2 = 0; k2 < 2; ++k2) oacc[ds] = __builtin_amdgcn_mfma_f32_32x32x16_bf16(va2[k2], pf[qp][k2], oacc[ds], 0, 0, 0);
                        asm volatile("" ::: "memory"); } }
            }
        }
        j0 = j1; j1 = j2; j2 = j3; slot = (slot + 1) & 3;
    }
    asm volatile("s_waitcnt lgkmcnt(0)" ::: "memory"); __builtin_amdgcn_s_barrier(); asm volatile("" ::: "memory");
}
__device__ __forceinline__ void nsa_stash_put(LAS unsigned char* lds, int wave, int lane, const f32x16 (&o)[2], float sc) {
    LAS unsigned* st = (LAS unsigned*)(lds + NSA_SCA) + wave * 1024 + lane;
#pragma unroll
    for (int ds = 0; ds < 2; ++ds)
#pragma unroll
        for (int k = 0; k < 8; ++k) st[(ds * 8 + k) * 64] = pkbf(o[ds][2 * k] * sc, o[ds][2 * k + 1] * sc);
}
#define PSTAMP(slot) do { if (MK_PROBE_MASK != 0 && F.bid == MK_PROBE_BID && F.tid == 0) { volatile LAS unsigned long long* _ta = (volatile LAS unsigned long long*)(F.lds + MISC_OFF + 512); const unsigned long long _n = wall_clock64(); _ta[slot] += _n - _ta[16]; _ta[16] = _n; } } while (0)
__device__ __forceinline__ void phase_nsa2(Frame& F, int l) {
    KA;
    LAS unsigned char* lds = F.lds;
    const bf16* P = (const bf16*)(KWS + WS_P); bf16* OCAT = (bf16*)(KWS + WS_OCAT);
    const bf16* QS = (const bf16*)(KWS + WS_QS);
    const int lane = F.lane, c32 = lane & 31, h = lane >> 5, q8 = c32 >> 2, r = c32 & 3;
    for (int unit = F.bid; unit < 256; unit += F.G) {
        const int g = unit & 1, cblk = unit >> 1, t0 = cblk * 64, head = g * 4 + r, t = t0 + F.wave * 8 + q8;
        u32x4 qxw;
        { const float s2 = exp2f(-(float)(head + 1)) * LOG2E; const unsigned sh = f2bf(s2); const float rem = s2 - bf2f(sh); const unsigned sl = f2bf(rem);
          qxw.x = h == 0 ? (sh | (sh << 16)) : 0u; qxw.y = h == 0 ? (sl | (sl << 16)) : 0u; qxw.z = 0u; qxw.w = 0u; }
        const int tref = t0 + 63;
        bf16x8 Qf[4];
#pragma unroll
        for (int ks = 0; ks < 4; ++ks) Qf[ks] = *(const bf16x8*)(QS + ((size_t)head * T + t) * 64 + 16 * ks + 8 * h);
        for (int u = F.tid; u < (NSA_UM + 16 - NSA_SCA) / 4; u += 512) ((LAS unsigned*)(lds + NSA_SCA))[u] = 0u;
        __syncthreads();
        f32x16 oacc[2];
#pragma unroll
        for (int ds = 0; ds < 2; ++ds)
#pragma unroll
            for (int i = 0; i < 16; ++i) oacc[ds][i] = 0.f;
        unsigned qsel[4] = {0u, 0u, 0u, 0u};
        float sc_cmp;
        PSTAMP(24);
        {
            const int ntile = (4 * cblk + 2) / 64 + 1;
            const unsigned long long cm0 = ntile >= 64 ? ~0ull : ((1ull << ntile) - 1ull);
            const int hi_cmp = t >= 31 ? (t - 31) / 16 : -1;
            const bf16* Kg = (const bf16*)(KWS + WS_KCB) + (size_t)g * 512 * 64; const bf16* VTg = (const bf16*)(KWS + WS_KCB + 131072) + (size_t)g * 64 * 512;
            float l1 = 0.f;
            nsa_branch<0>(F, Kg, VTg, 512, cm0, 0ull, Qf, t, cblk, qxw, tref, 0.f, qsel, hi_cmp, 0u, oacc, l1);
            l1 += __shfl_xor(l1, 32);
            const float inv_l = l1 > 0.f ? 1.0f / l1 : 0.f;
            float l2 = 0.f;
            nsa_branch<1>(F, Kg, VTg, 512, cm0, 0ull, Qf, t, cblk, qxw, tref, inv_l, qsel, hi_cmp, 0u, oacc, l2);
            sc_cmp = sigmoidf_(bf2f(P[(size_t)t * NPAD + C_NG + head])) * inv_l;
        }
        PSTAMP(20);
        {
            LAS float* scA = (LAS float*)(lds + NSA_SCA); LAS float* scB = (LAS float*)(lds + NSA_SCB);
            LAS unsigned* qm = (LAS unsigned*)(lds + NSA_QM); LAS unsigned* um = (LAS unsigned*)(lds + NSA_UM);
            WSYNC();
            const int qq = F.wave * 8 + (lane >> 3), jj = lane & 7;
            unsigned key[16];
#pragma unroll
            for (int m = 0; m < 16; ++m) { const int jb = jj + 8 * m; float sv = scA[qq * 132 + jb] + scB[qq * 132 + jb];
                if (jb == 0 || jb == cblk || jb == cblk - 1) sv = 1e4f;
                key[m] = jb <= cblk ? ((__builtin_bit_cast(unsigned, sv) & ~127u) | (unsigned)(127 - jb)) : 0u; }
            WSYNC();
#pragma unroll
            for (int m = 0; m < 16; ++m) ((LAS unsigned*)scA)[qq * 132 + jj + 8 * m] = key[m];
            WSYNC();
            unsigned bits[4] = {0u, 0u, 0u, 0u};
#pragma unroll
            for (int half = 0; half < 2; ++half) { int rank[8];
#pragma unroll
                for (int m = 0; m < 8; ++m) rank[m] = 0;
#pragma unroll 2
                for (int i = 0; i <= cblk; i += 4) { const u32x4 k4 = *(const LAS u32x4*)((const LAS unsigned*)scA + qq * 132 + i);
#pragma unroll
                    for (int m = 0; m < 8; ++m) rank[m] += (k4.x > key[8 * half + m] ? 1 : 0) + (k4.y > key[8 * half + m] ? 1 : 0) + (k4.z > key[8 * half + m] ? 1 : 0) + (k4.w > key[8 * half + m] ? 1 : 0); }
#pragma unroll
                for (int m = 0; m < 8; ++m) { const int jb = jj + 8 * (8 * half + m); if (jb <= cblk && rank[m] < 16) bits[(8 * half + m) >> 2] |= 1u << (jb & 31); } }
#pragma unroll
            for (int w = 0; w < 4; ++w) if (bits[w]) { atomicOr((unsigned*)(qm + qq * 4 + w), bits[w]); atomicOr((unsigned*)(um + w), bits[w]); }
            __syncthreads();
#pragma unroll
            for (int w = 0; w < 4; ++w) qsel[w] = qm[(F.wave * 8 + q8) * 4 + w];
        }
        PSTAMP(21);
        nsa_stash_put(lds, F.wave, lane, oacc, sc_cmp);
#pragma unroll
        for (int ds = 0; ds < 2; ++ds)
#pragma unroll
            for (int i = 0; i < 16; ++i) oacc[ds][i] = 0.f;
        {
            LAS unsigned* um = (LAS unsigned*)(lds + NSA_UM);
            const unsigned long long sm0 = (unsigned long long)__builtin_amdgcn_readfirstlane(um[0]) | ((unsigned long long)__builtin_amdgcn_readfirstlane(um[1]) << 32);
            const unsigned long long sm1 = (unsigned long long)__builtin_amdgcn_readfirstlane(um[2]) | ((unsigned long long)__builtin_amdgcn_readfirstlane(um[3]) << 32);
            float ls = 0.f;
            nsa_branch<2>(F, (const bf16*)(KWS + WS_KS2) + (size_t)g * T * 64, (const bf16*)(KWS + WS_VST) + (size_t)g * 64 * T, T, sm0, sm1, Qf, t, cblk, qxw, tref, 0.f, qsel, 0, 0u, oacc, ls);
            ls += __shfl_xor(ls, 32);
            const float sc = sigmoidf_(bf2f(P[(size_t)t * NPAD + C_NG + 8 + head])) / ls;
            LAS unsigned* st = (LAS unsigned*)(lds + NSA_SCA) + F.wave * 1024 + lane;
#pragma unroll
            for (int ds = 0; ds < 2; ++ds)
#pragma unroll
                for (int k = 0; k < 8; ++k) { const unsigned w = st[(ds * 8 + k) * 64]; st[(ds * 8 + k) * 64] = pkbf(bflo(w) + sc * oacc[ds][2 * k], bfhi(w) + sc * oacc[ds][2 * k + 1]); oacc[ds][2 * k] = 0.f; oacc[ds][2 * k + 1] = 0.f; }
        }
        PSTAMP(22);
        {
            const int j0 = cblk >= 8 ? cblk - 8 : 0;
            unsigned long long wm0 = 0ull, wm1 = 0ull;
            for (int jb = j0; jb <= cblk; ++jb) { if (jb < 64) wm0 |= 1ull << jb; else wm1 |= 1ull << (jb - 64); }
            float ls = 0.f;
            nsa_branch<3>(F, (const bf16*)(KWS + WS_KW2) + (size_t)g * T * 64, (const bf16*)(KWS + WS_VWT) + (size_t)g * 64 * T, T, wm0, wm1, Qf, t, cblk, qxw, tref, 0.f, qsel, 0, 0u, oacc, ls);
            ls += __shfl_xor(ls, 32);
            const float sc = sigmoidf_(bf2f(P[(size_t)t * NPAD + C_NG + 16 + head])) / ls;
            const LAS unsigned* st = (const LAS unsigned*)(lds + NSA_SCA) + F.wave * 1024 + lane;
#pragma unroll
            for (int ds = 0; ds < 2; ++ds)
#pragma unroll
                for (int g4 = 0; g4 < 4; ++g4) { const unsigned w0 = st[(ds * 8 + 2 * g4) * 64], w1 = st[(ds * 8 + 2 * g4 + 1) * 64];
                    u32x2 w; w.x = pkbf(bflo(w0) + sc * oacc[ds][4 * g4], bfhi(w0) + sc * oacc[ds][4 * g4 + 1]); w.y = pkbf(bflo(w1) + sc * oacc[ds][4 * g4 + 2], bfhi(w1) + sc * oacc[ds][4 * g4 + 3]);
                    *(u32x2*)(OCAT + (size_t)t * 1536 + head * 64 + 32 * ds + 8 * g4 + 4 * h) = w; }
        }
        __syncthreads();
        PSTAMP(23);
    }
}

__device__ __forceinline__ void phase_merge(Frame& F) {
    KA;
    const bf16* P = (const bf16*)(KWS + WS_P); const bf16* PROJ = (const bf16*)(KWS + WS_PROJ); bf16* MG = (bf16*)(KWS + WS_MERGED);
    const size_t total = (size_t)T * D / 8;
    for (size_t it = (size_t)F.gw * 64 + F.lane; it < total; it += (size_t)F.NGW * 64) {
        const size_t t = it / (D / 8); const int d = (int)(it % (D / 8)) * 8;
        float acc[8];
#pragma unroll
        for (int k = 0; k < 8; ++k) acc[k] = 0.f;
#pragma unroll
        for (int n = 0; n < 3; ++n) { const u32x4 gq = *(const u32x4*)(P + t * NPAD + C_MG + n * D + d); const u32x4 pq = *(const u32x4*)(PROJ + ((size_t)n * T + t) * D + d);
            acc[0] += sigmoidf_(bflo(gq.x)) * bflo(pq.x); acc[1] += sigmoidf_(bfhi(gq.x)) * bfhi(pq.x); acc[2] += sigmoidf_(bflo(gq.y)) * bflo(pq.y); acc[3] += sigmoidf_(bfhi(gq.y)) * bfhi(pq.y);
            acc[4] += sigmoidf_(bflo(gq.z)) * bflo(pq.z); acc[5] += sigmoidf_(bfhi(gq.z)) * bfhi(pq.z); acc[6] += sigmoidf_(bflo(gq.w)) * bflo(pq.w); acc[7] += sigmoidf_(bfhi(gq.w)) * bfhi(pq.w); }
        u32x4 o; o.x = pk2(acc[0], acc[1]); o.y = pk2(acc[2], acc[3]); o.z = pk2(acc[4], acc[5]); o.w = pk2(acc[6], acc[7]);
        *(u32x4*)(MG + t * D + d) = o;
    }
}
__device__ __forceinline__ void phase_router(Frame& F, int l) {
    KA;
    const float* X1 = (const float*)(KWS + WS_X1); bf16* H = (bf16*)(KWS + WS_H);
    int* EID = (int*)(KWS + WS_ROUTE); float* EW = (float*)(KWS + WS_ROUTE + 65536);
    const float* gain = KIN(I_NFFN) + (size_t)l * D; const float* wg = KIN(I_WGRP) + (size_t)l * D * 4; const float* we = KIN(I_WEXP) + (size_t)l * D * 32;
    const float* bg = KIN(I_BGRP) + l * 4; const float* be = KIN(I_BEXP) + l * 32;
    for (int t = F.gw; t < T; t += F.NGW) {
        const float* xrow = X1 + (size_t)t * D;
        float ss = 0.f;
#pragma unroll 4
        for (int k = 0; k < 32; ++k) { const float x = xrow[F.lane + 64 * k]; ss += x * x; }
        const float rstd = 1.0f / sqrtf(wave_sum(ss) * (1.0f / D) + EPS);
        float ag[4] = {0.f, 0.f, 0.f, 0.f}, ae[32];
#pragma unroll
        for (int e = 0; e < 32; ++e) ae[e] = 0.f;
#pragma unroll 1
        for (int k = 0; k < 32; ++k) { const int d = F.lane + 64 * k;
            const float hv = xrow[d] * rstd * gain[d];
            H[(size_t)t * D + d] = (bf16)f2bf(hv);
            const f32x4 w4 = *(const f32x4*)(wg + (size_t)d * 4);
            ag[0] += hv * w4.x; ag[1] += hv * w4.y; ag[2] += hv * w4.z; ag[3] += hv * w4.w;
#pragma unroll
            for (int c = 0; c < 8; ++c) { const f32x4 w = *(const f32x4*)(we + (size_t)d * 32 + c * 4); ae[c * 4] += hv * w.x; ae[c * 4 + 1] += hv * w.y; ae[c * 4 + 2] += hv * w.z; ae[c * 4 + 3] += hv * w.w; } }
#pragma unroll
        for (int e = 0; e < 4; ++e) ag[e] = wave_sum(ag[e]) + bg[e];
#pragma unroll
        for (int e = 0; e < 32; ++e) ae[e] = wave_sum(ae[e]) + be[e];
        int gi = 0; float gm = ag[0];
#pragma unroll
        for (int e = 1; e < 4; ++e) if (ag[e] > gm) { gm = ag[e]; gi = e; }
        float gs = 0.f;
#pragma unroll
        for (int e = 0; e < 4; ++e) gs += expf(ag[e] - gm);
        const float gw_ = 1.0f / gs;
        float el[8];
#pragma unroll
        for (int e = 0; e < 8; ++e) { el[e] = gi == 0 ? ae[e] : (gi == 1 ? ae[8 + e] : (gi == 2 ? ae[16 + e] : ae[24 + e])); }
        int i1 = 0; float m1 = el[0];
#pragma unroll
        for (int e = 1; e < 8; ++e) if (el[e] > m1) { m1 = el[e]; i1 = e; }
        int i2 = -1; float m2 = -3.0e38f;
#pragma unroll
        for (int e = 0; e < 8; ++e) if (e != i1 && el[e] > m2) { m2 = el[e]; i2 = e; }
        const float p2 = expf(m2 - m1);
        const float w1 = 1.0f / (1.0f + p2), w2 = p2 / (1.0f + p2);
        if (F.lane == 0) { EID[2 * t] = gi * 8 + i1; EID[2 * t + 1] = gi * 8 + i2; EW[2 * t] = gw_ * w1; EW[2 * t + 1] = gw_ * w2; }
    }
}

__device__ __forceinline__ void phase_router3(Frame& F, int l) {
    KA;
    const float* X1 = (const float*)(KWS + WS_X1); bf16* H = (bf16*)(KWS + WS_H);
    int* EID = (int*)(KWS + WS_ROUTE); float* EW = (float*)(KWS + WS_ROUTE + 65536); int* HIST = (int*)(KWS + WS_HIST); float* RSTD = (float*)(KWS + WS_RSTD);
    const float* WRT = (const float*)(KWS + WS_WRT) + (size_t)l * 48 * D;
    const float* gain = KIN(I_NFFN) + (size_t)l * D; const float* bg = KIN(I_BGRP) + l * 4; const float* be = KIN(I_BEXP) + l * 32;
    LAS float* red = (LAS float*)F.lds;
    LAS float* ssq = (LAS float*)(F.lds + 49152);
    LAS float* lg = (LAS float*)(F.lds + 50176);
    LAS float* rs = (LAS float*)(F.lds + 55296);
    LAS int* eidl = (LAS int*)(F.lds + 55424);
    const int r16 = F.lane & 15, kq = F.lane >> 4;
    for (int blk = F.bid; blk < T / 32; blk += F.G) {
        const int tok0 = blk * 32, kb0 = F.wave * 256 + 4 * kq;
        const float* xa = X1 + (size_t)(tok0 + r16) * D + kb0;
        const float* wb = WRT + (size_t)r16 * D + kb0;
        bf16* hp = H + (size_t)(tok0 + r16) * D + kb0;
        f32x4 acc[2][3]; float sq[2] = {0.f, 0.f};
#pragma unroll
        for (int tg = 0; tg < 2; ++tg)
#pragma unroll
            for (int nt = 0; nt < 3; ++nt) acc[tg][nt] = (f32x4){0.f, 0.f, 0.f, 0.f};
#pragma unroll 2
        for (int s = 0; s < 16; ++s) { f32x4 a[2], b[3];
#pragma unroll
            for (int tg = 0; tg < 2; ++tg) a[tg] = *(const f32x4*)(xa + (size_t)(16 * tg) * D + 16 * s);
#pragma unroll
            for (int nt = 0; nt < 3; ++nt) b[nt] = *(const f32x4*)(wb + (size_t)(16 * nt) * D + 16 * s);
            const f32x4 g = *(const f32x4*)(gain + kb0 + 16 * s);
#pragma unroll
            for (int tg = 0; tg < 2; ++tg) { sq[tg] += a[tg].x * a[tg].x + a[tg].y * a[tg].y + a[tg].z * a[tg].z + a[tg].w * a[tg].w;
                u32x2 o; o.x = pkbf(a[tg].x * g.x, a[tg].y * g.y); o.y = pkbf(a[tg].z * g.z, a[tg].w * g.w);
                *(u32x2*)(hp + (size_t)(16 * tg) * D + 16 * s) = o;
#pragma unroll
                for (int j = 0; j < 4; ++j)
#pragma unroll
                    for (int nt = 0; nt < 3; ++nt) acc[tg][nt] = __builtin_amdgcn_mfma_f32_16x16x4f32(a[tg][j], b[nt][j], acc[tg][nt], 0, 0, 0); } }
#pragma unroll
        for (int tg = 0; tg < 2; ++tg) { sq[tg] += __shfl_xor(sq[tg], 16); sq[tg] += __shfl_xor(sq[tg], 32);
            if (kq == 0) ssq[F.wave * 32 + 16 * tg + r16] = sq[tg];
#pragma unroll
            for (int nt = 0; nt < 3; ++nt) *(LAS f32x4*)(red + (((F.wave * 2 + tg) * 3 + nt) * 64 + F.lane) * 4) = acc[tg][nt]; }
        __syncthreads();
        if (F.tid < 384) { const int tg2 = F.tid / 192, rem = F.tid % 192, nt = rem / 64, ln = rem % 64; f32x4 v = {0.f, 0.f, 0.f, 0.f};
#pragma unroll
            for (int w = 0; w < 8; ++w) v += *(const LAS f32x4*)(red + (((w * 2 + tg2) * 3 + nt) * 64 + ln) * 4);
            const int col = 16 * nt + (ln & 15);
            if (col < 36) {
#pragma unroll
                for (int i = 0; i < 4; ++i) lg[(16 * tg2 + 4 * (ln >> 4) + i) * 40 + col] = v[i]; } }
        if (F.tid >= 384 && F.tid < 416) { const int tk = F.tid - 384; float q2 = 0.f;
#pragma unroll
            for (int w = 0; w < 8; ++w) q2 += ssq[w * 32 + tk];
            const float r = 1.0f / sqrtf(q2 * (1.0f / D) + EPS); rs[tk] = r; RSTD[tok0 + tk] = r; }
        __syncthreads();
        if (F.tid < 32) { const int tk = F.tid, t = tok0 + tk; const float rstd = rs[tk];
            float ag[4], el[8];
#pragma unroll
            for (int e = 0; e < 4; ++e) ag[e] = lg[tk * 40 + 32 + e] * rstd + bg[e];
            int gi = 0; float gm = ag[0];
#pragma unroll
            for (int e = 1; e < 4; ++e) if (ag[e] > gm) { gm = ag[e]; gi = e; }
            float gs = 0.f;
#pragma unroll
            for (int e = 0; e < 4; ++e) gs += expf(ag[e] - gm);
            const float gw_ = 1.0f / gs;
#pragma unroll
            for (int e = 0; e < 8; ++e) el[e] = lg[tk * 40 + gi * 8 + e] * rstd + be[gi * 8 + e];
            int i1 = 0; float m1 = el[0];
#pragma unroll
            for (int e = 1; e < 8; ++e) if (el[e] > m1) { m1 = el[e]; i1 = e; }
            int i2 = -1; float m2 = -3.0e38f;
#pragma unroll
            for (int e = 0; e < 8; ++e) if (e != i1 && el[e] > m2) { m2 = el[e]; i2 = e; }
            const float p2 = expf(m2 - m1), w1 = 1.0f / (1.0f + p2), w2 = p2 / (1.0f + p2);
            EID[2 * t] = gi * 8 + i1; EID[2 * t + 1] = gi * 8 + i2; EW[2 * t] = gw_ * w1; EW[2 * t + 1] = gw_ * w2;
            eidl[2 * tk] = gi * 8 + i1; eidl[2 * tk + 1] = gi * 8 + i2; }
        __syncthreads();
        if (F.tid < 32) { int c = 0;
#pragma unroll 8
            for (int i = 0; i < 64; ++i) c += eidl[i] == F.tid ? 1 : 0;
            HIST[blk * 32 + F.tid] = c; }
        __syncthreads();
    }
}
__device__ __forceinline__ void phase_lists2(Frame& F) {
    KA;
    const int* EID = (const int*)(KWS + WS_ROUTE); int* CNT = (int*)(KWS + WS_ROUTE + 131072); int* LIST = (int*)(KWS + WS_ROUTE + 262144); const int* HIST = (const int*)(KWS + WS_HIST);
    LAS int* off = (LAS int*)F.lds; LAS int* eidl = off + 32; LAS int* psum = off + 128;
    for (int blk = F.bid; blk < T / 32; blk += F.G) {
        { const int e = F.tid & 31, part = F.tid >> 5; int a = 0;
#pragma unroll 4
          for (int b2 = part; b2 < blk; b2 += 16) a += HIST[b2 * 32 + e];
          psum[part * 32 + e] = a; }
        __syncthreads();
        if (F.tid < 32) { int a = 0;
#pragma unroll
            for (int p = 0; p < 16; ++p) a += psum[p * 32 + F.tid];
            off[F.tid] = a;
            if (blk == T / 32 - 1) CNT[F.tid] = a + HIST[blk * 32 + F.tid]; }
        if (F.tid >= 64 && F.tid < 128) eidl[F.tid - 64] = EID[blk * 64 + F.tid - 64];
        __syncthreads();
        if (F.tid < 64) { const int e = eidl[F.tid]; int rk = 0;
            for (int i = 0; i < F.tid; ++i) rk += eidl[i] == e ? 1 : 0;
            LIST[e * 8192 + off[e] + rk] = blk * 64 + F.tid; }
        __syncthreads();
    }
}

__device__ __forceinline__ void phase_lists(Frame& F) {
    KA;
    const int e = F.bid;
    if (e >= NE) return;
    const int* EID = (const int*)(KWS + WS_ROUTE); int* CNT = (int*)(KWS + WS_ROUTE + 131072); int* LIST = (int*)(KWS + WS_ROUTE + 262144);
    LAS int* wc = (LAS int*)F.lds;
    int run = 0;
    for (int base = 0; base < 2 * T; base += 512) {
        const int idx = base + F.tid; const bool match = EID[idx] == e;
        const unsigned long long b = __ballot(match);
        if (F.lane == 0) wc[F.wave] = __popcll(b);
        __syncthreads();
        int pre = 0, tot = 0;
#pragma unroll
        for (int w = 0; w < 8; ++w) { const int c = wc[w]; pre += w < F.wave ? c : 0; tot += c; }
        if (match) LIST[e * 8192 + run + pre + __popcll(b & ((1ull << F.lane) - 1ull))] = idx;
        run += tot;
        __syncthreads();
    }
    if (F.tid == 0) CNT[e] = run;
}
__device__ __forceinline__ void moe_table(Frame& F, LAS int* tb) {
    KA;
    const int* CNT = (const int*)(KWS + WS_ROUTE + 131072);
    if (F.tid == 0) { int a = 0, f = 0, h = 0;
        for (int e = 0; e < NE; ++e) { const int n = CNT[e], nt = (n + 255) / 256, lastv = n - (nt - 1) * 256, hh = (nt > 0 && lastv <= 128) ? 1 : 0;
            tb[e] = a; tb[33 + e] = f; tb[66 + e] = h; a += nt; f += nt - hh; h += hh; }
        tb[NE] = a; tb[33 + NE] = f; tb[66 + NE] = h; }
    __syncthreads();
}

constexpr int PH_PER_LAYER = 8, N_PHASES = 1 + NL * PH_PER_LAYER + 1;

__global__ void __launch_bounds__(512, 2) mk_fwd(Args args) {
    extern __shared__ __attribute__((aligned(16))) unsigned char lds_raw[];
#define FRAME Frame F; F.lds = (LAS unsigned char*)lds_raw; F.MISC = (volatile LAS unsigned*)(F.lds + MISC_OFF); F.tid = ltid(); F.lane = F.tid & 63; F.wave = __builtin_amdgcn_readfirstlane(F.tid >> 6); \
    F.G = gridDim.x; F.bid = lbid(); F.vcu = (F.G % 8 == 0) ? (F.bid % 8) * (F.G / 8) + F.bid / 8 : F.bid; F.gw = F.bid * 8 + F.wave; F.NGW = F.G * 8;
    unsigned* const ctl = (unsigned*)((unsigned char*)args.ws + WS_CTL);
    for (int u = threadIdx.x; u < (LDS_BYTES - MISC_OFF) / 4; u += 512) ((LAS unsigned*)(lds_raw + MISC_OFF))[u] = 0u;
    __syncthreads();
    const int lo = args.ph_lo, hi = args.ph_hi;
    XcdBarrier bar; bar.bar = ctl + CW_BAR + args.li * XCD_BAR_WORDS; bar.x = 0; bar.st = nullptr;
    if (hi - lo > 1) bar = xcd_barrier_post(ctl + CW_BAR + args.li * XCD_BAR_WORDS, (volatile LAS unsigned*)((LAS unsigned char*)lds_raw + MISC_OFF));
    int ph = 0;
#define RUN(k) ((k) >= lo && (k) < hi)

    volatile LAS unsigned long long* const tacc = (volatile LAS unsigned long long*)((LAS unsigned char*)lds_raw + MISC_OFF + 512);
    if (MK_PROBE_MASK != 0 && blockIdx.x == MK_PROBE_BID && threadIdx.x == 0) tacc[16] = wall_clock64();
#define STAMP(slot) do { if (MK_PROBE_MASK != 0 && lbid() == MK_PROBE_BID && ltid() == 0) { const unsigned long long _n = wall_clock64(); tacc[slot] += _n - tacc[16]; tacc[16] = _n; } } while (0)
#define SEAM(k, slot) do { if ((k) + 1 < hi) xcd_barrier(bar); STAMP(slot); } while (0)
    LAS int* const tb = (LAS int*)((LAS unsigned char*)lds_raw + MISC_OFF + 64);

    if (RUN(ph)) { KA; FRAME; phase_prologue(F); phase_norm1<0>(F, KIN(I_X), nullptr, nullptr, KIN(I_NMIX), (bf16*)(KWS + WS_H)); SEAM(ph, 0); }
    ++ph;
    for (int l = 0; l < NL; ++l) {
        if (RUN(ph)) { KA; FRAME; pg8::PlainSched S; S.init((const bf16*)(KWS + WS_H), D, (const bf16*)(KWS + WS_WIN) + (size_t)l * NPAD * D, T, NPAD, D, F.G, F.bid, 4); S.probe = 1;
            pg8::EpiBf16 E{(bf16*)(KWS + WS_P), NPAD};
            pg8::gemm_phase<pg8::EpiBf16, pg8::PlainSched, true>(F.lds, D, S, E); SEAM(ph, 1); }
        ++ph;
        if (RUN(ph)) { KA; FRAME; phase_prep3(F, l); __syncthreads(); phase_compress3(F, l); phase_rec_local(F, l); SEAM(ph, 3); }
        ++ph;
        if (RUN(ph)) { KA; FRAME; if (F.bid < 96) { phase_rec_scan(F);
                asm volatile("s_waitcnt vmcnt(0)" ::: "memory"); __syncthreads();
                if (F.tid == 0) { __builtin_amdgcn_fence(__ATOMIC_RELEASE, "agent"); asm volatile("s_waitcnt vmcnt(0)" ::: "memory");
                    __hip_atomic_fetch_add((unsigned*)(KWS + WS_CTL) + 2048 + 64 * (4 + l), 1u, __ATOMIC_RELAXED, __HIP_MEMORY_SCOPE_AGENT); } }
            phase_nsa2(F, l); phase_rec_out(F, l); SEAM(ph, 5); }
        ++ph;
        if (RUN(ph)) { KA; FRAME;
            { pg8::BranchSched S; S.init((const bf16*)(KWS + WS_OCAT), (const bf16*)(KWS + WS_WBR) + (size_t)l * 3 * D * 512, F.G, F.bid);
              pg8::EpiMerge E{(bf16*)(KWS + WS_MERGED), (const bf16*)(KWS + WS_P) + C_MG};
              pg8::gemm_phase<pg8::EpiMerge, pg8::BranchSched, true>(F.lds, 512, S, E); }
            SEAM(ph, 6); }
        ++ph;

        if (RUN(ph)) { KA; FRAME; pg8::PlainSched S; S.init((const bf16*)(KWS + WS_MERGED), D, (const bf16*)(KWS + WS_WOUT) + (size_t)l * D * D, T, D, D, F.G, F.bid);
            pg8::EpiResF32 E{l == 0 ? KIN(I_X) : (const float*)(KWS + WS_XRES), (float*)(KWS + WS_X1), D};
            pg8::gemm_phase<pg8::EpiResF32, pg8::PlainSched, false>(F.lds, D, S, E); SEAM(ph, 8); }
        ++ph;
        if (RUN(ph)) { KA; FRAME; phase_router3(F, l); SEAM(ph, 9); }
        ++ph;
        if (RUN(ph)) { KA; FRAME; phase_lists2(F); SEAM(ph, 10); }
        ++ph;
        if (RUN(ph)) { KA; FRAME; moe_table(F, tb);
            unsigned* tilecnt = (unsigned*)(KWS + WS_CTL) + 131072 + (size_t)l * 128 * 64;
            { pg8::MoeSched<1> S; S.init(F.G, F.vcu, tb, (const int*)(KWS + WS_ROUTE + 131072), (const int*)(KWS + WS_ROUTE + 262144), KWS + WS_H, (const bf16*)(KWS + WS_WGU) + (size_t)l * NE * 1024 * D);
              S.tilecnt = tilecnt; S.tick = nullptr; S.tslot = nullptr; S.myticket = 0;
              pg8::EpiMoe1 E{(bf16*)(KWS + WS_ACT), (const int*)(KWS + WS_ROUTE + 262144), (const float*)(KWS + WS_ROUTE + 65536), (const float*)(KWS + WS_RSTD)};
              pg8::gemm_phase<pg8::EpiMoe1, pg8::MoeSched<1>, true>(F.lds, D, S, E); }
            __syncthreads();
            { pg8::MoeSched<2> S; S.init(F.G, F.vcu, tb, (const int*)(KWS + WS_ROUTE + 131072), (const int*)(KWS + WS_ROUTE + 262144), KWS + WS_ACT, (const bf16*)(KWS + WS_WDN) + (size_t)l * NE * D * FF);
              S.tilecnt = tilecnt; S.tick = (unsigned*)(KWS + WS_CTL) + 2048 + 64 * (6 + l); S.tslot = (volatile LAS int*)(F.lds + MISC_OFF + 1028); S.myticket = 0;
              pg8::EpiMoe2 E{(bf16*)(KWS + WS_CONTRIB), (const int*)(KWS + WS_ROUTE + 262144)};
              pg8::gemm_phase<pg8::EpiMoe2, pg8::MoeSched<2>, true>(F.lds, FF, S, E); }
            SEAM(ph, 12); }
        ++ph;
        if (l + 1 < NL) { if (RUN(ph)) { KA; FRAME; phase_norm1<1>(F, (const float*)(KWS + WS_X1), (const bf16*)(KWS + WS_CONTRIB), (float*)(KWS + WS_XRES), KIN(I_NMIX) + (size_t)(l + 1) * D, (bf16*)(KWS + WS_H)); SEAM(ph, 13); } ++ph; }
    }
    if (RUN(ph)) { KA; FRAME; phase_norm1<2>(F, (const float*)(KWS + WS_X1), (const bf16*)(KWS + WS_CONTRIB), KOUT, nullptr, nullptr); }
    if (MK_PROBE_MASK != 0 && lbid() == MK_PROBE_BID && ltid() == 0) {
        asm volatile("s_waitcnt vmcnt(0)" ::: "memory"); STAMP(15);
        unsigned long long tot = 0ull;
        for (int k2 = 0; k2 < 32; ++k2) if (k2 != 16 && ((MK_PROBE_MASK >> k2) & 1)) tot += tacc[k2];
        const unsigned long long t_end = wall_clock64() + 4ull * tot;
        while (wall_clock64() < t_end) __builtin_amdgcn_s_sleep(8);
    }
#undef RUN
#undef SEAM
}

#ifndef MK_PER_PHASE
#define MK_PER_PHASE 0
#endif
extern "C" void kernel_launch(void* const* d_in, const int* in_sizes, int n_in, void* d_out, int out_size, void* d_ws, size_t ws_size, hipStream_t stream) {
    static int grid = 0;
    if (grid == 0) {
        if (n_in != 22 || out_size != T * D || ws_size < WS_END) { fprintf(stderr, "kernel_launch: unexpected sizes (n_in %d out %d ws %zu)\n", n_in, out_size, ws_size); grid = -1; return; }
        int dev = 0, cus = 0, per_cu = 0;
        if (hipGetDevice(&dev) != hipSuccess || hipDeviceGetAttribute(&cus, hipDeviceAttributeMultiprocessorCount, dev) != hipSuccess) { grid = -1; return; }
        if (hipFuncSetAttribute((const void*)mk_fwd, hipFuncAttributeMaxDynamicSharedMemorySize, LDS_BYTES) != hipSuccess) { fprintf(stderr, "kernel_launch: hipFuncSetAttribute failed\n"); grid = -1; return; }
        if (hipOccupancyMaxActiveBlocksPerMultiprocessor(&per_cu, (const void*)mk_fwd, 512, LDS_BYTES) != hipSuccess || per_cu < 1) { fprintf(stderr, "kernel_launch: occupancy query says %d\n", per_cu); }
        (void)hipGetLastError();
        grid = cus;
    }
    if (grid < 0) return;
    if (hipMemsetAsync((char*)d_ws + WS_CTL, 0, CTL_ZERO_BYTES, stream) != hipSuccess) return;
    Args a{};
    for (int i = 0; i < 22; ++i) a.in[i] = (const GAS float*)d_in[i];
    a.out = (GAS float*)d_out; a.ws = (GAS unsigned char*)d_ws;
#if MK_PER_PHASE
    const int total = 1 + NL * PH_PER_LAYER + (NL - 1) + 1;
    for (int k = 0; k < total; ++k) { a.ph_lo = k; a.ph_hi = k + 1; a.li = 0; hipLaunchKernelGGL(mk_fwd, dim3(grid), dim3(512), LDS_BYTES, stream, a); }
#else
    a.ph_lo = 0; a.ph_hi = 1000; a.li = 0;
    hipLaunchKernelGGL(mk_fwd, dim3(grid), dim3(512), LDS_BYTES, stream, a);
#endif
    const hipError_t le = hipPeekAtLastError();
    if (le != hipSuccess) fprintf(stderr, "kernel_launch: launch failed: %s\n", hipGetErrorName(le));
}
```

```cpp
#include <hip/hip_runtime.h>
#include <cstdio>
#include <cstdint>

#ifndef MK_PROBE_MASK
#define MK_PROBE_MASK 0
#endif
#ifndef MK_PROBE_BID
#define MK_PROBE_BID 0
#endif
#define GAS __attribute__((address_space(1)))
#define LAS __attribute__((address_space(3)))
typedef unsigned short bf16;
typedef short bf16x8 __attribute__((ext_vector_type(8)));
typedef float f32x4 __attribute__((ext_vector_type(4)));
typedef float f32x2 __attribute__((ext_vector_type(2)));
typedef unsigned u32x4 __attribute__((ext_vector_type(4)));
typedef unsigned u32x2 __attribute__((ext_vector_type(2)));

constexpr int T = 8192, D = 2048, NL = 2, INC = 11048, NPAD = 11264;
constexpr int NE = 32, FF = 512, NCH = T / 64;
constexpr float EPS = 1e-6f, NEGB = -1e30f;
constexpr int C_Q = 0, C_KC = 512, C_VC = 640, C_KS = 768, C_VS = 896, C_KW = 1024, C_VW = 1152;
constexpr int C_HQ = 1280, C_HF = 1792, C_HI = 2304, C_HG = 2816, C_GQ = 3328, C_GK = 3584, C_GV = 3840, C_GR = 4352;
constexpr int C_MG = 4864, C_NG = 11008, C_GA = 11032;

constexpr size_t MiB = 1u << 20;
constexpr size_t WS_CTL = 0, CTL_ZERO_BYTES = 1 * MiB;
constexpr size_t WS_WIN = 2 * MiB;
constexpr size_t WS_WBR = 90 * MiB;
constexpr size_t WS_WOUT = 102 * MiB;
constexpr size_t WS_WGU = 118 * MiB;
constexpr size_t WS_WDN = 374 * MiB;
constexpr size_t WS_H = 502 * MiB;
constexpr size_t WS_P = 534 * MiB;
constexpr size_t WS_OCAT = 710 * MiB;
constexpr size_t WS_PROJ = 734 * MiB;
constexpr size_t WS_MERGED = 830 * MiB;
constexpr size_t WS_X1 = 862 * MiB;
constexpr size_t WS_XRES = 926 * MiB;
constexpr size_t WS_CONTRIB = 990 * MiB;
constexpr size_t WS_ACT = 1054 * MiB;
constexpr size_t WS_QN = 1078 * MiB;
constexpr size_t WS_KV = 1094 * MiB;
constexpr size_t WS_KC = 1118 * MiB;
constexpr size_t WS_ORAW = 1119 * MiB;
constexpr size_t WS_ROUTE = 1151 * MiB;
constexpr size_t WS_SLOC_HG = 1153 * MiB;
constexpr size_t WS_SLOC_GL = 1185 * MiB;
constexpr size_t WS_SPREV_HG = 1201 * MiB;
constexpr size_t WS_SPREV_GL = 1217 * MiB;
constexpr size_t WS_DEC = 1225 * MiB;
constexpr size_t WS_QS = 1226 * MiB;
constexpr size_t WS_KS2 = 1234 * MiB;
constexpr size_t WS_KW2 = 1236 * MiB;
constexpr size_t WS_VST = 1238 * MiB;
constexpr size_t WS_VWT = 1240 * MiB;
constexpr size_t WS_KCB = 1242 * MiB;
constexpr size_t WS_WRT = 1243 * MiB;
constexpr size_t WS_HIST = 1244 * MiB;
constexpr size_t WS_CW = 1245 * MiB;
constexpr size_t WS_RSTD = 1247 * MiB;
constexpr size_t WS_END = 1248 * MiB;
constexpr size_t KV_STRIDE = (size_t)2 * T * 64;
constexpr int CW_BAR = 4096;
constexpr int CW_CNT = 3072;

constexpr int RING_BYTES = 131072;
constexpr int LDS_BYTES = 147456;
constexpr int MISC_OFF = LDS_BYTES - 2048;

#define LDS_WAIT() asm volatile("s_waitcnt lgkmcnt(0)" ::: "memory")
#define VM_WAIT() asm volatile("s_waitcnt vmcnt(0)" ::: "memory")
#define WSYNC() asm volatile("s_waitcnt lgkmcnt(0)" ::: "memory")

__device__ __forceinline__ unsigned f2bf(float f) { unsigned u = __builtin_bit_cast(unsigned, f); return (u + 0x7fffu + ((u >> 16) & 1u)) >> 16; }
__device__ __forceinline__ unsigned pk2(float lo, float hi) { return f2bf(lo) | (f2bf(hi) << 16); }
__device__ __forceinline__ float bf2f(unsigned b) { return __builtin_bit_cast(float, (b & 0xffffu) << 16); }
__device__ __forceinline__ float bflo(unsigned w) { return __builtin_bit_cast(float, w << 16); }
__device__ __forceinline__ float bfhi(unsigned w) { return __builtin_bit_cast(float, w & 0xffff0000u); }
__device__ __forceinline__ float wave_sum(float v) {
#pragma unroll
    for (int o = 1; o < 64; o <<= 1) v += __shfl_xor(v, o);
    return v;
}
__device__ __forceinline__ float wave_max(float v) {
#pragma unroll
    for (int o = 1; o < 64; o <<= 1) v = fmaxf(v, __shfl_xor(v, o));
    return v;
}
__device__ __forceinline__ int ltid() { int t = threadIdx.x; asm volatile("" : "+v"(t)); return t; }
__device__ __forceinline__ int lbid() { int b = blockIdx.x; asm volatile("" : "+s"(b)); return b; }
typedef __bf16 bf16x2_t __attribute__((ext_vector_type(2)));
__device__ __forceinline__ unsigned pkbf(float lo, float hi) { const f32x2 v = {lo, hi}; return __builtin_bit_cast(unsigned, __builtin_convertvector(v, bf16x2_t)); }
constexpr float LOG2E = 1.4426950408889634f;
__device__ __forceinline__ float sigmoidf_(float x) { return 1.0f / (1.0f + expf(-x)); }
__device__ __forceinline__ float fsig(float x) { return __builtin_amdgcn_rcpf(1.0f + __builtin_amdgcn_exp2f(-LOG2E * x)); }

#define GSTAMP(lds_, slot) do { if (MK_PROBE_MASK != 0 && lbid() == MK_PROBE_BID && ltid() == 0) { volatile LAS unsigned long long* _ta = (volatile LAS unsigned long long*)((lds_) + MISC_OFF + 512); const unsigned long long _n = wall_clock64(); _ta[slot] += _n - _ta[16]; _ta[16] = _n; } } while (0)
#define XB_TMO      128
#define XB_XCNT(j)  (256  + 64 * (j))
#define XB_XSUB(j)  (1280 + 64 * (j))
#define XB_XGEN(j)  (2304 + 64 * (j))
#define XB_TOP      3328
#define XB_TOPGEN   3392
#define XCD_BAR_WORDS 3456
#define XB_SPIN_CAP (1u << 25)

__device__ __forceinline__ unsigned xb_ld(unsigned* p)              { return __hip_atomic_load(p, __ATOMIC_RELAXED, __HIP_MEMORY_SCOPE_AGENT); }
__device__ __forceinline__ unsigned xb_add(unsigned* p, unsigned v) { return __hip_atomic_fetch_add(p, v, __ATOMIC_RELAXED, __HIP_MEMORY_SCOPE_AGENT); }
__device__ __forceinline__ unsigned xb_xcc_id() { return (unsigned)__builtin_amdgcn_s_getreg((3 << 11) | 20) & 0xFu; }
#define XB_SPIN(cond, bar) do { unsigned _sp = 0; while (cond) { __builtin_amdgcn_s_sleep(1); \
    if ((++_sp & 255u) == 0u) { if (xb_ld(&(bar)[XB_TMO])) break; if (_sp > XB_SPIN_CAP) { atomicAdd(&(bar)[XB_TMO], 1u); break; } } } } while (0)

struct XcdBarrier { unsigned* bar; unsigned x; volatile LAS unsigned* st; };

__device__ __forceinline__ XcdBarrier xcd_barrier_post(unsigned* bar, volatile LAS unsigned* st) {
    XcdBarrier b; b.bar = bar; b.x = xb_xcc_id(); b.st = st;
    if (threadIdx.x == 0) (void)xb_add(&bar[XB_XCNT(b.x)], 1u);
    return b;
}
__device__ __forceinline__ void xcd_barrier_complete(unsigned* bar, unsigned x, unsigned& nloc, unsigned& nx) {
    const unsigned G = gridDim.x * gridDim.y * gridDim.z;
    unsigned sum, cnt, mine, sp = 0u;
    for (;;) {
        sum = 0u; cnt = 0u; mine = 0u;
#pragma unroll
        for (unsigned j = 0; j < 16; ++j) { const unsigned c = xb_ld(&bar[XB_XCNT(j)]); sum += c; cnt += (c > 0u) ? 1u : 0u; mine = (j == x) ? c : mine; }
        if (sum == G) break;
        __builtin_amdgcn_s_sleep(1);
        if ((++sp & 255u) == 0u) { if (xb_ld(&bar[XB_TMO])) break; if (sp > XB_SPIN_CAP) { atomicAdd(&bar[XB_TMO], 1u); break; } }
    }
    nloc = mine > 0u ? mine : 1u; nx = cnt > 0u ? cnt : 1u;
}
__device__ __forceinline__ void xcd_barrier(const XcdBarrier& b) {
    asm volatile("s_waitcnt vmcnt(0)" ::: "memory");
    __syncthreads();
    if (threadIdx.x == 0) {
        unsigned* bar = b.bar;
        __builtin_amdgcn_s_waitcnt(0);
        unsigned nloc = b.st[0], nx = b.st[1];
        if (nloc == 0u) { xcd_barrier_complete(bar, b.x, nloc, nx); b.st[0] = nloc; b.st[1] = nx; }
        const unsigned old = xb_add(&bar[XB_XSUB(b.x)], 1u);
        const unsigned gen = old / nloc;
        if (old + 1u == (gen + 1u) * nloc) {
            __builtin_amdgcn_fence(__ATOMIC_RELEASE, "agent");
            asm volatile("s_waitcnt vmcnt(0)" ::: "memory");
            const unsigned og = xb_add(&bar[XB_TOP], 1u);
            const unsigned tg = og / nx;
            if (og + 1u == (tg + 1u) * nx) xb_add(&bar[XB_TOPGEN], 1u);
            else XB_SPIN(xb_ld(&bar[XB_TOPGEN]) == tg, bar);
            __builtin_amdgcn_fence(__ATOMIC_ACQUIRE, "agent");
            xb_add(&bar[XB_XGEN(b.x)], 1u);
            asm volatile("s_waitcnt vmcnt(0)" ::: "memory");
        } else {
            XB_SPIN(xb_ld(&bar[XB_XGEN(b.x)]) == gen, bar);
            __builtin_amdgcn_fence(__ATOMIC_ACQUIRE, "agent");
            asm volatile("s_waitcnt vmcnt(0)" ::: "memory");
        }
    }
    __syncthreads();
}

namespace pg8 {
constexpr int BM = 256, BK = 64, HALF = 128, HTB = HALF * BK * 2, STAGE_BYTES = 8 * HTB, NXCD = 8, WGM = 8;
__host__ __device__ __forceinline__ int lds_byte(int r, int c) { const int st = (r >> 4) * 2 + (c >> 5), rr = r & 15, cc = c & 31, ob = rr * 64 + cc * 2; return st * 1024 + (ob ^ (((ob >> 9) & 1) << 5)); }
__host__ __device__ __forceinline__ void stage_rc(int b, int& R, int& C) { const int st = b / 1024, sb = b % 1024, swz = sb ^ (((sb >> 9) & 1) << 5); R = (st >> 1) * 16 + swz / 64; C = (st & 1) * 32 + (swz % 64) / 2; }
__host__ __device__ __forceinline__ int perm32(int rho) { const int n = rho >> 4, i = rho & 15; return 8 * (i >> 2) + 4 * n + (i & 3); }

struct Unit { int pm, pn, e, nvalid, slot0, half, row0; const char *A0, *A1, *B0, *B1; unsigned va[2][2]; };

__device__ __forceinline__ unsigned cvt_pk_bf16(float lo, float hi) { unsigned r; asm volatile("v_cvt_pk_bf16_f32 %0, %1, %2" : "=v"(r) : "v"(lo), "v"(hi)); return r; }

template <class Epi, class Sched, bool ALIGN_EPI>
__device__ __forceinline__ void gemm_phase(LAS unsigned char* lds, const int K, const Sched& S, const Epi& E) {
    const int tid = ltid(), wid = __builtin_amdgcn_readfirstlane(tid >> 6), lane = tid & 63, wr = wid >> 2, wc = wid & 3, fr = lane & 15, fq = lane >> 4;
    const int nt = K / BK;
    unsigned voffB[2];
#pragma unroll
    for (int i = 0; i < 2; ++i) { int R, C; stage_rc(tid * 16 + i * 8192, R, C); const int Rb = Epi::PERM ? ((R & ~31) + perm32(R & 31)) : R; voffB[i] = (unsigned)(Rb * K + C) * 2u; }
    const size_t kstep = (size_t)(BK * 2);
    const unsigned ldsw = (unsigned)wid * 1024u;
    const int aoff = lds_byte(wr * 64 + fr, fq * 8), boff = lds_byte(wc * 32 + fr, fq * 8);
#define PG8_SA(b, h) (((b) * 2 + (h)) * HTB)
#define PG8_SB(b, h) ((4 + (b) * 2 + (h)) * HTB)
#define PG8_STAGE(bufoff, gbase, voff) do { _Pragma("unroll") for (int _i = 0; _i < 2; ++_i) \
        __builtin_amdgcn_global_load_lds((const unsigned*)((const char*)(gbase) + (voff)[_i]), (LAS unsigned*)(lds + (bufoff) + ldsw + _i * 8192), 16, 0, 0); } while (0)
#define PG8_LDA(dst, b, h) do { _Pragma("unroll") for (int m = 0; m < 4; ++m) _Pragma("unroll") for (int k = 0; k < 2; ++k) dst[m][k] = *(const LAS bf16x8*)(lds + PG8_SA(b, h) + aoff + m * 2048 + k * 1024); } while (0)
#define PG8_LDB(dst, b, h) do { _Pragma("unroll") for (int n = 0; n < 2; ++n) _Pragma("unroll") for (int k = 0; k < 2; ++k) dst[n][k] = *(const LAS bf16x8*)(lds + PG8_SB(b, h) + boff + n * 2048 + k * 1024); } while (0)
#define PG8_MMA(ai, bj, At, Bt) do { __builtin_amdgcn_s_setprio(1); _Pragma("unroll") for (int m = 0; m < 4; ++m) _Pragma("unroll") for (int n = 0; n < 2; ++n) _Pragma("unroll") for (int k = 0; k < 2; ++k) \
        acc[ai][bj][m][n] = __builtin_amdgcn_mfma_f32_16x16x32_bf16(Bt[n][k], At[m][k], acc[ai][bj][m][n], 0, 0, 0); __builtin_amdgcn_s_setprio(0); } while (0)
#define PG8_WAIT_V(n) asm volatile("s_waitcnt vmcnt(" #n ")" ::: "memory")
#define PG8_WAIT_L(n) asm volatile("s_waitcnt lgkmcnt(" #n ")" ::: "memory")
#define PG8_BAR __builtin_amdgcn_s_barrier()
#define PG8_SCHED __builtin_amdgcn_sched_barrier(0)
#define VA(u, h) (Sched::GATHER ? (u).va[h] : S.va)
    Unit cur, nxt; int ui = 0;
    if constexpr (Sched::DYN) { S.ticket_issue(); S.ticket_publish(); __syncthreads(); }
    if (!S.next(0, cur)) return;
    S.a_ready(cur);
    if (S.probe) GSTAMP(lds, 27);
    f32x4 acc[2][2][4][2];
#pragma unroll
    for (int a = 0; a < 2; ++a)
#pragma unroll
        for (int b = 0; b < 2; ++b)
#pragma unroll
            for (int m = 0; m < 4; ++m)
#pragma unroll
                for (int n = 0; n < 2; ++n) acc[a][b][m][n] = (f32x4){0.f, 0.f, 0.f, 0.f};
    bf16x8 At[4][2], B0[2][2], B1[2][2];
    PG8_STAGE(PG8_SB(0, 0), cur.B0, voffB); PG8_STAGE(PG8_SB(0, 1), cur.B1, voffB); PG8_STAGE(PG8_SA(0, 0), cur.A0, VA(cur, 0)); PG8_STAGE(PG8_SA(0, 1), cur.A1, VA(cur, 1));
    if (wr == 1) PG8_BAR;
    PG8_WAIT_V(2); PG8_BAR;
    PG8_STAGE(PG8_SB(1, 0), cur.B0 + kstep, voffB); PG8_STAGE(PG8_SA(1, 0), cur.A0 + kstep, VA(cur, 0)); PG8_STAGE(PG8_SB(1, 1), cur.B1 + kstep, voffB);
    PG8_WAIT_V(6); PG8_BAR;
    for (;;) {
        bool has_next = false;
        if constexpr (Sched::DYN) { S.ticket_issue(); nxt = cur; }
        else { has_next = S.next(ui + 1, nxt); if (!has_next) nxt = cur; }
        for (int t = 0; t < nt; t += 2) {
            if constexpr (Sched::DYN) { if (t == 2) S.ticket_publish(); if (t == nt - 4) { has_next = S.next(ui + 1, nxt); if (!has_next) nxt = cur; } }
            const bool last = (t == nt - 2);
            if (last && has_next) S.a_ready(nxt);
            const char* a1h1 = cur.A1 + (size_t)(t + 1) * kstep;
            const char* a2h0 = last ? nxt.A0 : cur.A0 + (size_t)(t + 2) * kstep; const char* a2h1 = last ? nxt.A1 : cur.A1 + (size_t)(t + 2) * kstep;
            const char* b2h0 = last ? nxt.B0 : cur.B0 + (size_t)(t + 2) * kstep; const char* b2h1 = last ? nxt.B1 : cur.B1 + (size_t)(t + 2) * kstep;
            unsigned v2h0[2], v2h1[2];
#pragma unroll
            for (int i = 0; i < 2; ++i) { if constexpr (Sched::GATHER) { v2h0[i] = last ? nxt.va[0][i] : cur.va[0][i]; v2h1[i] = last ? nxt.va[1][i] : cur.va[1][i]; } else { v2h0[i] = S.va[i]; v2h1[i] = S.va[i]; } }
            PG8_LDB(B0, 0, 0); PG8_LDB(B1, 0, 1); PG8_SCHED; PG8_LDA(At, 0, 0); PG8_STAGE(PG8_SA(1, 1), a1h1, VA(cur, 1));
            PG8_WAIT_V(8); PG8_WAIT_L(0); PG8_BAR; PG8_MMA(0, 0, At, B0); PG8_MMA(0, 1, At, B1); PG8_BAR; PG8_SCHED;
            if (!cur.half) PG8_LDA(At, 0, 1);
            PG8_STAGE(PG8_SB(0, 0), b2h0, voffB); PG8_STAGE(PG8_SB(0, 1), b2h1, voffB); PG8_STAGE(PG8_SA(0, 0), a2h0, v2h0);
            PG8_WAIT_V(8); PG8_WAIT_L(0); PG8_BAR; if (!cur.half) { PG8_MMA(1, 0, At, B0); PG8_MMA(1, 1, At, B1); } PG8_BAR; PG8_SCHED;
            PG8_LDB(B0, 1, 0); PG8_LDB(B1, 1, 1); PG8_SCHED; PG8_LDA(At, 1, 0); PG8_STAGE(PG8_SA(0, 1), a2h1, v2h1);
            PG8_WAIT_V(8); PG8_WAIT_L(0); PG8_BAR; PG8_MMA(0, 0, At, B0); PG8_MMA(0, 1, At, B1); PG8_BAR; PG8_SCHED;
            if (!cur.half) PG8_LDA(At, 1, 1);
            PG8_STAGE(PG8_SB(1, 0), b2h0 + kstep, voffB); PG8_STAGE(PG8_SB(1, 1), b2h1 + kstep, voffB); PG8_STAGE(PG8_SA(1, 0), a2h0 + kstep, v2h0);
            PG8_WAIT_V(8); PG8_WAIT_L(0); PG8_BAR; if (!cur.half) { PG8_MMA(1, 0, At, B0); PG8_MMA(1, 1, At, B1); } PG8_BAR; PG8_SCHED;
        }
        if (S.probe) GSTAMP(lds, 25);
        if constexpr (ALIGN_EPI) { if (wr == 0) PG8_BAR; }
        if constexpr (Sched::CHAIN) E.chain(acc, cur, wr, wc, fr, fq); else E(acc, cur, wr, wc, fr, fq);
        S.done(cur);
        if (S.probe) { asm volatile("s_waitcnt vmcnt(0)" ::: "memory"); GSTAMP(lds, 26); }
        if (!has_next) break;
        if (!Sched::CHAIN || nxt.e == 0) {
#pragma unroll
        for (int a = 0; a < 2; ++a)
#pragma unroll
            for (int b = 0; b < 2; ++b)
#pragma unroll
                for (int m = 0; m < 4; ++m)
#pragma unroll
                    for (int n = 0; n < 2; ++n) acc[a][b][m][n] = (f32x4){0.f, 0.f, 0.f, 0.f};
        }
        cur = nxt; ++ui;
        if constexpr (ALIGN_EPI) { if (wr == 1) PG8_BAR; }
    }
    PG8_WAIT_V(0);
    if constexpr (!ALIGN_EPI) { if (wr == 0) PG8_BAR; }
    PG8_BAR;
#undef VA
#undef PG8_SA
#undef PG8_SB
#undef PG8_STAGE
#undef PG8_LDA
#undef PG8_LDB
#undef PG8_MMA
#undef PG8_WAIT_V
#undef PG8_WAIT_L
#undef PG8_BAR
#undef PG8_SCHED
}

struct PlainSched {
    static constexpr bool GATHER = false, CHAIN = false, DYN = false;
    __device__ __forceinline__ void a_ready(const Unit&) const {}
    __device__ __forceinline__ void done(const Unit&) const {}
    int nM, nN, nwg, G, c, lda, K, nNh, probe = 0; const char* A; const char* Bt; unsigned va[2];
    __device__ __forceinline__ void init(const bf16* A_, int lda_, const bf16* Bt_, int M, int N, int K_, int G_, int c_, int nNh_ = 0) {
        nM = M / BM; nN = N / BM - nNh_; nNh = nNh_; nwg = nM * nN; G = G_; c = c_; lda = lda_; K = K_; A = (const char*)A_; Bt = (const char*)Bt_;
#pragma unroll
        for (int i = 0; i < 2; ++i) { int R, C; stage_rc((int)ltid() * 16 + i * 8192, R, C); va[i] = (unsigned)(R * lda + C) * 2u; }
    }
    __device__ __forceinline__ bool next(int i, Unit& u) const {
        const long L = (long)i * G + c;
        u.e = 0; u.nvalid = 256; u.slot0 = 0; u.va[0][0] = 0u; u.va[0][1] = 0u; u.va[1][0] = 0u; u.va[1][1] = 0u;
        if (L >= nwg) { const int hL = (int)(L - nwg); if (hL >= 2 * nM * nNh) return false;
            const int hm = hL / nNh, pn = nN + hL % nNh;
            u.pm = hm >> 1; u.pn = pn; u.half = 1; u.row0 = hm * HALF;
            u.A0 = A + (size_t)hm * HALF * lda * 2; u.A1 = u.A0;
            u.B0 = Bt + (size_t)pn * BM * K * 2; u.B1 = u.B0 + (size_t)HALF * K * 2;
            return true; }
        int wgid = (int)L; { const int q = nwg / NXCD, r = nwg % NXCD, xcd = wgid % NXCD, off = wgid / NXCD; wgid = (xcd < r ? xcd * (q + 1) : r * (q + 1) + (xcd - r) * q) + off; }
        const int nig = WGM * nN, gid = wgid / nig, fm = gid * WGM, gsz = (nM - fm) < WGM ? (nM - fm) : WGM;
        u.pm = fm + ((wgid % nig) % gsz); u.pn = (wgid % nig) / gsz; u.half = 0; u.row0 = u.pm * BM;
        u.A0 = A + (size_t)u.pm * BM * lda * 2; u.A1 = u.A0 + (size_t)HALF * lda * 2;
        u.B0 = Bt + (size_t)u.pn * BM * K * 2; u.B1 = u.B0 + (size_t)HALF * K * 2;
        return true;
    }
};
struct BranchSched {
    static constexpr bool GATHER = false, CHAIN = true, DYN = false;
    __device__ __forceinline__ void a_ready(const Unit&) const {}
    __device__ __forceinline__ void done(const Unit&) const {}
    int G, c, probe = 0; const char* A; const char* Bt; unsigned va[2];
    __device__ __forceinline__ void init(const bf16* OC, const bf16* WBRl, int G_, int c_) { G = G_; c = c_; A = (const char*)OC; Bt = (const char*)WBRl;
#pragma unroll
        for (int i = 0; i < 2; ++i) { int R, C; stage_rc((int)ltid() * 16 + i * 8192, R, C); va[i] = (unsigned)(R * 1536 + C) * 2u; } }
    __device__ __forceinline__ bool next(int i, Unit& u) const {
        const int tile = (i / 3) * G + c, n = i % 3; if (tile >= (T / BM) * (D / BM)) return false;
        int wgid = tile; { const int nwg = 256, q = nwg / NXCD, xcd = wgid % NXCD, off = wgid / NXCD; wgid = xcd * q + off; }
        const int nN = D / BM, nig = WGM * nN, gid = wgid / nig, fm = gid * WGM;
        u.pm = fm + ((wgid % nig) % WGM); u.pn = (wgid % nig) / WGM; u.e = n; u.nvalid = 256; u.slot0 = 0; u.half = 0; u.row0 = u.pm * BM;
        u.va[0][0] = 0u; u.va[0][1] = 0u; u.va[1][0] = 0u; u.va[1][1] = 0u;
        u.A0 = A + (size_t)u.pm * BM * 1536 * 2 + (size_t)n * 512 * 2; u.A1 = u.A0 + (size_t)HALF * 1536 * 2;
        u.B0 = Bt + (size_t)n * D * 512 * 2 + (size_t)u.pn * BM * 512 * 2; u.B1 = u.B0 + (size_t)HALF * 512 * 2;
        return true;
    }
};
template <int MODE> struct MoeSched {
    static constexpr int NPN = MODE == 1 ? 4 : 8;
    static constexpr bool GATHER = MODE == 1, CHAIN = false, DYN = MODE == 2;
    unsigned* tilecnt; unsigned* tick; volatile LAS int* tslot; mutable int myticket;
    __device__ __forceinline__ void ticket_issue() const { if (ltid() == 0) myticket = (int)__hip_atomic_fetch_add(tick, 1u, __ATOMIC_RELAXED, __HIP_MEMORY_SCOPE_AGENT); }
    __device__ __forceinline__ void ticket_publish() const { if (ltid() == 0) *tslot = myticket; }
    __device__ __forceinline__ void a_ready(const Unit& u) const {
        if (MODE == 2) {
            if (ltid() < 64) { unsigned* p = tilecnt + 64 * (u.slot0 >> 8); unsigned sp = 0;
                while ((unsigned)__builtin_amdgcn_readfirstlane(__hip_atomic_load(p, __ATOMIC_RELAXED, __HIP_MEMORY_SCOPE_AGENT)) < 32u) { __builtin_amdgcn_s_sleep(2); if (++sp > (1u << 22)) break; }
                __builtin_amdgcn_fence(__ATOMIC_ACQUIRE, "agent"); asm volatile("s_waitcnt vmcnt(0)" ::: "memory"); }
            asm volatile("" ::: "memory"); __builtin_amdgcn_s_barrier(); asm volatile("" ::: "memory"); }
    }
    __device__ __forceinline__ void done(const Unit& u) const {
        if (MODE == 1) { asm volatile("s_waitcnt vmcnt(0)" ::: "memory");
            if ((ltid() & 63) == 0) __hip_atomic_fetch_add(tilecnt + 64 * (u.slot0 >> 8), 1u, __ATOMIC_RELAXED, __HIP_MEMORY_SCOPE_AGENT); }
    }
    int G, c, probe = 0; const LAS int* tb; const int* cnt; const int* list; const char* A; const char* W; unsigned va[2];
    __device__ __forceinline__ void init(int G_, int c_, const LAS int* tb_, const int* cnt_, const int* list_, const void* A_, const void* W_) {
        G = G_; c = c_; tb = tb_; cnt = cnt_; list = list_; A = (const char*)A_; W = (const char*)W_;
#pragma unroll
        for (int i = 0; i < 2; ++i) { int R, C; stage_rc((int)ltid() * 16 + i * 8192, R, C); va[i] = (unsigned)(R * FF + C) * 2u; }
    }
    __device__ __forceinline__ bool next(int i, Unit& u) const {
        const int L = MODE == 2 ? __builtin_amdgcn_readfirstlane(*tslot) : i * G + c, nfull = __builtin_amdgcn_readfirstlane(tb[33 + NE]), nhalf = __builtin_amdgcn_readfirstlane(tb[66 + NE]);
        if (L >= (nfull + nhalf) * NPN) return false;
        const bool half = L >= nfull * NPN; const int Lr = half ? L - nfull * NPN : L, base = half ? 66 : 33;
        const int tq = Lr / NPN, pn = Lr % NPN; int e = 0;
        while (e < NE - 1 && __builtin_amdgcn_readfirstlane(tb[base + e + 1]) <= tq) ++e;
        const int ne = __builtin_amdgcn_readfirstlane(cnt[e]);
        const int pm = half ? (ne - 1) / 256 : tq - __builtin_amdgcn_readfirstlane(tb[33 + e]);
        const int tl = __builtin_amdgcn_readfirstlane(tb[e]) + pm;
        u.pm = pm; u.pn = pn; u.e = e; u.nvalid = ne - pm * 256; u.slot0 = tl * 256; u.half = half ? 1 : 0; u.row0 = 0;
        if (MODE == 1) {
            u.A0 = A; u.A1 = A;
#pragma unroll
            for (int h = 0; h < 2; ++h)
#pragma unroll
                for (int k = 0; k < 2; ++k) { int Rk, Ck; stage_rc((int)ltid() * 16 + k * 8192, Rk, Ck); int idx = pm * 256 + h * 128 + Rk; idx = idx < ne ? idx : ne - 1; const int entry = list[e * 8192 + idx]; u.va[h][k] = (unsigned)(entry >> 1) * (unsigned)(D * 2) + (unsigned)Ck * 2u; }
            const char* we = W + (size_t)e * 1024 * D * 2;
            u.B0 = we + (size_t)(pn * 128) * D * 2; u.B1 = we + (size_t)(512 + pn * 128) * D * 2;
        } else {
            u.va[0][0] = 0u; u.va[0][1] = 0u; u.va[1][0] = 0u; u.va[1][1] = 0u;
            u.A0 = A + (size_t)tl * 256 * FF * 2; u.A1 = u.A0 + (size_t)HALF * FF * 2;
            const char* we = W + (size_t)e * D * FF * 2;
            u.B0 = we + (size_t)(pn * 256) * FF * 2; u.B1 = u.B0 + (size_t)HALF * FF * 2;
        }
        return true;
    }
};

struct EpiBf16 {
    static constexpr bool PERM = true;
    bf16* O; int ldc;
    __device__ __forceinline__ void operator()(const f32x4 (&acc)[2][2][4][2], const Unit& u, int wr, int wc, int fr, int fq) const {
        const int row0 = u.row0 + wr * 64 + fr, col0 = u.pn * BM + wc * 32 + 8 * fq;
#pragma unroll
        for (int ai = 0; ai < 2; ++ai) if (ai == 0 || !u.half)
#pragma unroll
            for (int m = 0; m < 4; ++m) { bf16* rowp = O + (size_t)(row0 + ai * HALF + m * 16) * ldc + col0;
#pragma unroll
                for (int bj = 0; bj < 2; ++bj) { const f32x4 v0 = acc[ai][bj][m][0], v1 = acc[ai][bj][m][1];
                    u32x4 w; w.x = cvt_pk_bf16(v0[0], v0[1]); w.y = cvt_pk_bf16(v0[2], v0[3]); w.z = cvt_pk_bf16(v1[0], v1[1]); w.w = cvt_pk_bf16(v1[2], v1[3]);
                    *(u32x4*)(rowp + bj * HALF) = w; } }
    }
};
struct EpiMerge {
    static constexpr bool PERM = true;
    bf16* MG; const bf16* gate0;
    __device__ __forceinline__ void operator()(const f32x4 (&acc)[2][2][4][2], const Unit& u, int wr, int wc, int fr, int fq) const {}
    __device__ __forceinline__ void chain(f32x4 (&acc)[2][2][4][2], const Unit& u, int wr, int wc, int fr, int fq) const {
        const int row0 = u.row0 + wr * 64 + fr, col0 = u.pn * BM + wc * 32 + 8 * fq; const bool last = u.e == 2;
        const bf16* __restrict__ ga = gate0 + (size_t)u.e * D; const bf16* __restrict__ gb = gate0 + (size_t)(last ? 2 : u.e + 1) * D;
        bf16* __restrict__ MGp = MG;
        u32x4 qa[2][2], qb[2][2];
#define EMG_LOAD(buf, g) do { const size_t row_ = (size_t)(row0 + ((g) >> 2) * HALF + ((g) & 3) * 16); \
            _Pragma("unroll") for (int bj_ = 0; bj_ < 2; ++bj_) { qa[buf][bj_] = *(const u32x4*)(ga + row_ * NPAD + col0 + bj_ * HALF); qb[buf][bj_] = *(const u32x4*)(gb + row_ * NPAD + col0 + bj_ * HALF); } } while (0)
        EMG_LOAD(0, 0);
#pragma unroll
        for (int g = 0; g < 8; ++g) { if (g + 1 < 8) EMG_LOAD((g + 1) & 1, g + 1);
            const int ai = g >> 2, m = g & 3; const size_t row = (size_t)(row0 + ai * HALF + m * 16);
#pragma unroll
            for (int bj = 0; bj < 2; ++bj) { float o[8];
                const unsigned wa[4] = {qa[g & 1][bj].x, qa[g & 1][bj].y, qa[g & 1][bj].z, qa[g & 1][bj].w}, wb[4] = {qb[g & 1][bj].x, qb[g & 1][bj].y, qb[g & 1][bj].z, qb[g & 1][bj].w};
#pragma unroll
                for (int k = 0; k < 8; ++k) { const float a = acc[ai][bj][m][k >> 2][k & 3];
                    const float xa = __builtin_bit_cast(float, (k & 1) ? (wa[k >> 1] & 0xffff0000u) : (wa[k >> 1] << 16)), xb = __builtin_bit_cast(float, (k & 1) ? (wb[k >> 1] & 0xffff0000u) : (wb[k >> 1] << 16));
                    const float ea = __builtin_amdgcn_exp2f(-LOG2E * xa), eb = __builtin_amdgcn_exp2f(-LOG2E * xb);
                    const float f = (last ? 1.0f : 1.0f + eb) * __builtin_amdgcn_rcpf(1.0f + ea);
                    o[k] = a * f; acc[ai][bj][m][k >> 2][k & 3] = o[k]; }
                if (last) { u32x4 w; w.x = cvt_pk_bf16(o[0], o[1]); w.y = cvt_pk_bf16(o[2], o[3]); w.z = cvt_pk_bf16(o[4], o[5]); w.w = cvt_pk_bf16(o[6], o[7]);
                    *(u32x4*)(MGp + row * D + col0 + bj * HALF) = w; } } }
#undef EMG_LOAD
    }
};
struct EpiResF32 {
    static constexpr bool PERM = false;
    const float* R; float* O; int ldc;
    __device__ __forceinline__ void operator()(const f32x4 (&acc)[2][2][4][2], const Unit& u, int wr, int wc, int fr, int fq) const {
        const int row0 = u.row0 + wr * 64 + fr, col0 = u.pn * BM + wc * 32 + 4 * fq;
        const float* __restrict__ Rp = R; float* __restrict__ Op = O;
        f32x4 rv[2][4];
#define ERES_LOAD(buf, g) do { const size_t off_ = (size_t)(row0 + ((g) >> 2) * HALF + ((g) & 3) * 16) * ldc + col0; \
            _Pragma("unroll") for (int q_ = 0; q_ < 4; ++q_) rv[buf][q_] = *(const f32x4*)(Rp + off_ + (q_ >> 1) * HALF + (q_ & 1) * 16); } while (0)
        ERES_LOAD(0, 0);
#pragma unroll
        for (int g = 0; g < 8; ++g) { if (g + 1 < 8) ERES_LOAD((g + 1) & 1, g + 1);
            const int ai = g >> 2, m = g & 3; const size_t off = (size_t)(row0 + ai * HALF + m * 16) * ldc + col0;
            if (ai == 0 || !u.half) {
#pragma unroll
                for (int q = 0; q < 4; ++q) *(f32x4*)(Op + off + (q >> 1) * HALF + (q & 1) * 16) = acc[ai][q >> 1][m][q & 1] + rv[g & 1][q]; } }
#undef ERES_LOAD
    }
};
struct EpiMoe1 {
    static constexpr bool PERM = true;
    bf16* ACT; const int* list; const float* ew; const float* rstd;
    __device__ __forceinline__ void operator()(const f32x4 (&acc)[2][2][4][2], const Unit& u, int wr, int wc, int fr, int fq) const {
        const int col0 = u.pn * 128 + wc * 32 + 8 * fq;
#pragma unroll
        for (int ai = 0; ai < 2; ++ai) if (ai == 0 || !u.half)
#pragma unroll
            for (int m = 0; m < 4; ++m) { const int r = ai * HALF + wr * 64 + m * 16 + fr; float w = 0.f, rsd = 0.f;
                if (r < u.nvalid) { const int entry = list[u.e * 8192 + u.pm * 256 + r]; w = ew[entry]; rsd = rstd[entry >> 1]; }
                float o[8];
#pragma unroll
                for (int n = 0; n < 2; ++n)
#pragma unroll
                    for (int j = 0; j < 4; ++j) { const float g = acc[ai][0][m][n][j] * rsd, up = acc[ai][1][m][n][j] * rsd; o[n * 4 + j] = g * fsig(g) * up * w; }
                u32x4 pk; pk.x = cvt_pk_bf16(o[0], o[1]); pk.y = cvt_pk_bf16(o[2], o[3]); pk.z = cvt_pk_bf16(o[4], o[5]); pk.w = cvt_pk_bf16(o[6], o[7]);
                unsigned long long* dst = (unsigned long long*)(ACT + (size_t)(u.slot0 + r) * FF + col0);
                __hip_atomic_store(dst, (unsigned long long)pk.x | ((unsigned long long)pk.y << 32), __ATOMIC_RELAXED, __HIP_MEMORY_SCOPE_AGENT);
                __hip_atomic_store(dst + 1, (unsigned long long)pk.z | ((unsigned long long)pk.w << 32), __ATOMIC_RELAXED, __HIP_MEMORY_SCOPE_AGENT); }
    }
};
struct EpiMoe2 {
    static constexpr bool PERM = true;
    bf16* CO; const int* list;
    __device__ __forceinline__ void operator()(const f32x4 (&acc)[2][2][4][2], const Unit& u, int wr, int wc, int fr, int fq) const {
        const int col0 = u.pn * BM + wc * 32 + 8 * fq;
#pragma unroll
        for (int ai = 0; ai < 2; ++ai) if (ai == 0 || !u.half)
#pragma unroll
            for (int m = 0; m < 4; ++m) { const int r = ai * HALF + wr * 64 + m * 16 + fr;
                if (r < u.nvalid) { const int entry = list[u.e * 8192 + u.pm * 256 + r]; bf16* rowp = CO + (size_t)entry * D + col0;
#pragma unroll
                    for (int bj = 0; bj < 2; ++bj) { const f32x4 v0 = acc[ai][bj][m][0], v1 = acc[ai][bj][m][1];
                        u32x4 w; w.x = cvt_pk_bf16(v0[0], v0[1]); w.y = cvt_pk_bf16(v0[2], v0[3]); w.z = cvt_pk_bf16(v1[0], v1[1]); w.w = cvt_pk_bf16(v1[2], v1[3]);
                        *(u32x4*)(rowp + bj * HALF) = w; } } }
    }
};
}

struct Frame {
    LAS unsigned char* lds; volatile LAS unsigned* MISC;
    int tid, lane, wave, vcu, G, gw, NGW, bid;
};
struct Args { const GAS float* in[22]; GAS float* out; GAS unsigned char* ws; int ph_lo, ph_hi, li, pad; };
typedef const __attribute__((address_space(4))) Args KArgs;
__device__ __forceinline__ KArgs* ka_fresh() { unsigned long long p = (unsigned long long)__builtin_amdgcn_kernarg_segment_ptr(); asm volatile("" : "+s"(p)); return (KArgs*)p; }
#define KA KArgs* const ka = ka_fresh()
#define KIN(i) ((const float*)ka->in[i])
#define KWS ((unsigned char*)ka->ws)
#define KOUT ((float*)ka->out)
enum { I_X = 0, I_NMIX, I_WIN, I_PE, I_W1, I_W2, I_QN, I_KN, I_LB, I_HGN, I_WA2, I_BA, I_GLAN, I_WBR, I_WOUT, I_NFFN, I_WGRP, I_BGRP, I_WEXP, I_BEXP, I_WGU, I_WDN };

__device__ __forceinline__ void tr_item(const float* W, size_t ldw, int c0, int nv, bf16* WT, size_t ldt, int r0, int k0, LAS float* scr, int lane) {
    const int nn = lane & 31;
    float tv[32];
#pragma unroll
    for (int i = 0; i < 32; ++i) { const int kk = 2 * i + (lane >> 5); tv[i] = nn < nv ? __builtin_nontemporal_load(W + (size_t)(k0 + kk) * ldw + c0 + nn) : 0.f; }
#pragma unroll
    for (int i = 0; i < 32; ++i) { const int kk = 2 * i + (lane >> 5); scr[kk * 33 + nn] = tv[i]; }
    LDS_WAIT();
    const int c = lane & 7;
#pragma unroll
    for (int j = 0; j < 4; ++j) { const int n = (lane >> 3) + 8 * j; const LAS float* s = scr + (8 * c) * 33 + n;
        u32x4 o; o.x = pk2(s[0 * 33], s[1 * 33]); o.y = pk2(s[2 * 33], s[3 * 33]); o.z = pk2(s[4 * 33], s[5 * 33]); o.w = pk2(s[6 * 33], s[7 * 33]);
        if (n < nv) __builtin_nontemporal_store(o, (u32x4*)(WT + (size_t)(r0 + n) * ldt + k0 + 8 * c)); }
    LDS_WAIT();
}
__device__ __forceinline__ void phase_prologue(Frame& F) {
    KA;
    {
      bf16* W1T = (bf16*)(KWS + WS_CW); bf16* W2T = (bf16*)(KWS + WS_CW + 1048576); float* B1 = (float*)(KWS + WS_CW + 1572864);
      for (int i = F.bid * 512 + F.tid; i < NL * 2 * 64 * 2048; i += F.G * 512) { const int lk = i / (64 * 2048), j = (i / 2048) % 64, c = i % 2048; W1T[i] = (bf16)f2bf(KIN(I_W1)[((size_t)lk * 2048 + c) * 64 + j]); }
      for (int i = F.bid * 512 + F.tid; i < NL * 2 * 64 * 64; i += F.G * 512) { const int lk = i / 4096, j2 = (i / 64) % 64, j = i % 64; W2T[i] = (bf16)f2bf(KIN(I_W2)[((size_t)lk * 64 + j) * 64 + j2]); }
      if (F.bid < NL * 2) { const int lk = F.bid, j = F.tid & 63, part = F.tid >> 6; float a = 0.f;
#pragma unroll 8
          for (int c = part * 256; c < part * 256 + 256; ++c) a += KIN(I_PE)[(size_t)lk * 2048 + c] * KIN(I_W1)[((size_t)lk * 2048 + c) * 64 + j];
          LAS float* rd = (LAS float*)F.lds; rd[F.tid] = a; __syncthreads();
          if (F.tid < 64) { float t2 = 0.f;
#pragma unroll
              for (int p = 0; p < 8; ++p) t2 += rd[p * 64 + F.tid];
              B1[lk * 64 + F.tid] = t2; }
          __syncthreads(); } }
    { float* WRT = (float*)(KWS + WS_WRT);
      for (int i = F.bid * 512 + F.tid; i < NL * 48 * D; i += F.G * 512) { const int l = i / (48 * D), n = (i / D) % 48, k = i % D; const float g = KIN(I_NFFN)[l * D + k];
          WRT[i] = n < 32 ? g * KIN(I_WEXP)[((size_t)l * D + k) * 32 + n] : (n < 36 ? g * KIN(I_WGRP)[((size_t)l * D + k) * 4 + (n - 32)] : 0.f); } }
    LAS float* scr = (LAS float*)(F.lds + F.wave * 16384);
    constexpr int IT_WIN = 32 * 346, IT_WBR = 3 * 8 * 64, IT_WOUT = 32 * 64, IT_WGU = 32 * 32 * 32, IT_WDN = 32 * 8 * 64, IT_L = IT_WIN + IT_WBR + IT_WOUT + IT_WGU + IT_WDN;
    for (int it = F.gw; it < NL * IT_L; it += F.NGW) {
        const int l = it / IT_L; int r = it % IT_L;
        if (r < IT_WIN) { const int kb = r / 346, nb = r % 346; int src, dst, nv = 32;
            if (nb < 40) { src = nb * 32; dst = nb * 32; }
            else if (nb == 40) { src = 1280; dst = C_NG; nv = 24; }
            else if (nb < 153) { src = 1304 + 32 * (nb - 41); dst = 1280 + 32 * (nb - 41); }
            else if (nb == 153) { src = 4888; dst = C_GA; nv = 16; }
            else { src = 4904 + 32 * (nb - 154); dst = C_MG + 32 * (nb - 154); }
            tr_item(KIN(I_WIN) + (size_t)l * D * INC, INC, src, nv, (bf16*)(KWS + WS_WIN) + (size_t)l * NPAD * D, D, dst, kb * 64, scr, F.lane); continue; }
        r -= IT_WIN;
        if (r < IT_WBR) { const int n = r / 512, q = r % 512, kb = q / 64, nb = q % 64;
            tr_item(KIN(I_WBR) + ((size_t)l * 3 + n) * 512 * D, D, nb * 32, 32, (bf16*)(KWS + WS_WBR) + ((size_t)l * 3 + n) * D * 512, 512, nb * 32, kb * 64, scr, F.lane); continue; }
        r -= IT_WBR;
        if (r < IT_WOUT) { const int kb = r / 64, nb = r % 64;
            tr_item(KIN(I_WOUT) + (size_t)l * D * D, D, nb * 32, 32, (bf16*)(KWS + WS_WOUT) + (size_t)l * D * D, D, nb * 32, kb * 64, scr, F.lane); continue; }
        r -= IT_WOUT;
        if (r < IT_WGU) { const int e = r / 1024, q = r % 1024, kb = q / 32, nb = q % 32;
            tr_item(KIN(I_WGU) + ((size_t)l * NE + e) * D * 1024, 1024, nb * 32, 32, (bf16*)(KWS + WS_WGU) + ((size_t)l * NE + e) * 1024 * D, D, nb * 32, kb * 64, scr, F.lane); continue; }
        r -= IT_WGU;
        { const int e = r / 512, q = r % 512, kb = q / 64, nb = q % 64;
            tr_item(KIN(I_WDN) + ((size_t)l * NE + e) * FF * D, D, nb * 32, 32, (bf16*)(KWS + WS_WDN) + ((size_t)l * NE + e) * D * FF, FF, nb * 32, kb * 64, scr, F.lane); }
    }
}

template <int MODE> __device__ __forceinline__ void phase_norm1(Frame& F, const float* xin, const bf16* contrib, float* xout, const float* gain, bf16* H) {
    for (int t0 = F.gw; t0 < T; t0 += 2 * F.NGW) {
        f32x4 v[2][8]; float ss[2] = {0.f, 0.f};
#pragma unroll
        for (int rr = 0; rr < 2; ++rr) { const int t = t0 + rr * F.NGW; if (t < T) {
            const f32x4* xr = (const f32x4*)(xin + (size_t)t * D) + F.lane;
#pragma unroll
            for (int j = 0; j < 8; ++j) v[rr][j] = xr[64 * j]; } }
        u32x2 c0[2][8], c1[2][8];
        if (MODE != 0) {
#pragma unroll
            for (int rr = 0; rr < 2; ++rr) { const int t = t0 + rr * F.NGW; if (t < T) {
#pragma unroll
                for (int j = 0; j < 8; ++j) { c0[rr][j] = *((const u32x2*)(contrib + (size_t)(2 * t) * D) + F.lane + 64 * j); c1[rr][j] = *((const u32x2*)(contrib + (size_t)(2 * t + 1) * D) + F.lane + 64 * j); } } } }
#pragma unroll
        for (int rr = 0; rr < 2; ++rr) { const int t = t0 + rr * F.NGW; if (t < T) {
#pragma unroll
            for (int j = 0; j < 8; ++j) {
                if (MODE != 0) { v[rr][j].x += bflo(c0[rr][j].x) + bflo(c1[rr][j].x); v[rr][j].y += bfhi(c0[rr][j].x) + bfhi(c1[rr][j].x); v[rr][j].z += bflo(c0[rr][j].y) + bflo(c1[rr][j].y); v[rr][j].w += bfhi(c0[rr][j].y) + bfhi(c1[rr][j].y);
                    *((f32x4*)(xout + (size_t)t * D) + F.lane + 64 * j) = v[rr][j]; }
                ss[rr] += v[rr][j].x * v[rr][j].x + v[rr][j].y * v[rr][j].y + v[rr][j].z * v[rr][j].z + v[rr][j].w * v[rr][j].w; } } }
        if (MODE != 2) {
#pragma unroll
            for (int rr = 0; rr < 2; ++rr) { const int t = t0 + rr * F.NGW; if (t < T) {
                const float rstd = 1.0f / sqrtf(wave_sum(ss[rr]) * (1.0f / D) + EPS);
#pragma unroll
                for (int j = 0; j < 8; ++j) { const f32x4 g = *((const f32x4*)gain + F.lane + 64 * j);
                    u32x2 o; o.x = pkbf(v[rr][j].x * rstd * g.x, v[rr][j].y * rstd * g.y); o.y = pkbf(v[rr][j].z * rstd * g.z, v[rr][j].w * rstd * g.w);
                    *((u32x2*)(H + (size_t)t * D) + F.lane + 64 * j) = o; } } }
        }
    }
}

__device__ __forceinline__ void phase_prep(Frame& F, int l) {
    KA;
    const bf16* P = (const bf16*)(KWS + WS_P);
    float* QN = (float*)(KWS + WS_QN); float* KV = (float*)(KWS + WS_KV);
    const float* qg = KIN(I_QN) + l * 64; const float* kg = KIN(I_KN) + l * 192;
    for (int it = F.gw; it < T * 20; it += F.NGW) {
        const int t = it / 20, v = it % 20;
        float x = bf2f(P[(size_t)t * NPAD + v * 64 + F.lane]);
        const bool isq = v < 8, nk1 = (v == 12 || v == 13), nk2 = (v == 16 || v == 17);
        if (isq || nk1 || nk2) { const float ss = wave_sum(x * x); const float g = isq ? qg[F.lane] : (nk1 ? kg[64 + F.lane] : kg[128 + F.lane]); x = x * (1.0f / sqrtf(ss * (1.0f / 64.0f) + EPS)) * g; }
        if (isq) QN[((size_t)v * T + t) * 64 + F.lane] = x;
        else { const int w = v - 8, tens = w >> 1, g = w & 1; KV[(size_t)tens * KV_STRIDE + ((size_t)g * T + t) * 64 + F.lane] = x; }
    }
}
__device__ __forceinline__ float gelu_tanh(float x) { const float u = 0.7978845608028654f * (x + 0.044715f * x * x * x); return 0.5f * x * (1.0f + tanhf(u)); }
__device__ __forceinline__ void phase_compress(Frame& F, int l) {
    KA;
    LAS float* av = (LAS float*)(F.lds + F.wave * 16384);
    const float* KV = (const float*)(KWS + WS_KV); float* KC = (float*)(KWS + WS_KC);
    for (int it = F.gw; it < 2 * 2 * 511; it += F.NGW) {
        const int kind = it / 1022, q = it % 1022, g = q / 511, n = q % 511;
        const float* src = KV + (size_t)kind * KV_STRIDE + ((size_t)g * T + 16 * n) * 64;
        const float* pe = KIN(I_PE) + ((size_t)l * 2 + kind) * 2048;
        const float* w1 = KIN(I_W1) + ((size_t)l * 2 + kind) * 2048 * 64;
        const float* w2 = KIN(I_W2) + ((size_t)l * 2 + kind) * 64 * 64;
#pragma unroll 4
        for (int c = 0; c < 32; ++c) av[c * 64 + F.lane] = src[c * 64 + F.lane] + pe[c * 64 + F.lane];
        WSYNC();
        float acc = 0.f;
#pragma unroll 8
        for (int i = 0; i < 2048; ++i) acc += av[i] * w1[i * 64 + F.lane];
        const float hid = gelu_tanh(acc);
        WSYNC();
        av[F.lane] = hid;
        WSYNC();
        float o = 0.f;
#pragma unroll 8
        for (int i = 0; i < 64; ++i) o += av[i] * w2[i * 64 + F.lane];
        WSYNC();
        if (kind == 0) { const float ss = wave_sum(o * o); o = o * (1.0f / sqrtf(ss * (1.0f / 64.0f) + EPS)) * KIN(I_KN)[l * 192 + F.lane]; }
        KC[(size_t)kind * (2 * 512 * 64) + ((size_t)g * 512 + n) * 64 + F.lane] = o;
    }
}
__device__ __forceinline__ void phase_recur(Frame& F, int l) {
    KA;
    const bf16* P = (const bf16*)(KWS + WS_P); float* ORAW = (float*)(KWS + WS_ORAW);
    for (int it = F.gw; it < 1024; it += F.NGW) {
        const int kind = it >> 9, head = (it >> 7) & 3, j = it & 127;
        if (kind == 0) {
            const int d0 = F.lane, d1 = F.lane + 64;
            const float* lbl = KIN(I_LB);
            float lb0, lb1;
            { const float a0 = lbl[head * 128 + d0], b0 = lbl[512 + head * 128 + d0], a1 = lbl[head * 128 + d1], b1 = lbl[512 + head * 128 + d1];
              lb0 = l == 0 ? 0.f : 1.0f / (1.0f + expf(a0 - b0)); lb1 = l == 0 ? 0.f : 1.0f / (1.0f + expf(a1 - b1)); }
            const bf16* Pq = P + C_HQ + head * 128; const bf16* Pf = P + C_HF + head * 128; const bf16* Pi = P + C_HI + head * 128 + j;
            float S0 = 0.f, S1 = 0.f;
            for (int t0 = 0; t0 < T; t0 += 8) {
                bf16 zq0[8], zq1[8], zf0[8], zf1[8], vi[8];
#pragma unroll
                for (int u = 0; u < 8; ++u) { const size_t row = (size_t)(t0 + u) * NPAD; zq0[u] = Pq[row + d0]; zq1[u] = Pq[row + d1]; zf0[u] = Pf[row + d0]; zf1[u] = Pf[row + d1]; vi[u] = Pi[row]; }
                float part[8];
#pragma unroll
                for (int u = 0; u < 8; ++u) { const float v = bf2f(vi[u]);
                    const float s0 = sigmoidf_(bf2f(zf0[u])), s1 = sigmoidf_(bf2f(zf1[u]));
                    const float f0 = lb0 + (1.0f - lb0) * s0, f1 = lb1 + (1.0f - lb1) * s1;
                    const float k0 = (1.0f - lb0) * (1.0f - s0), k1 = (1.0f - lb1) * (1.0f - s1);
                    S0 = f0 * S0 + k0 * v; S1 = f1 * S1 + k1 * v;
                    part[u] = bf2f(zq0[u]) * S0 + bf2f(zq1[u]) * S1; }
                float mine = 0.f;
#pragma unroll
                for (int u = 0; u < 8; ++u) { const float s = wave_sum(part[u]); mine = (F.lane == u) ? s : mine; }
                if (F.lane < 8) ORAW[(size_t)(t0 + F.lane) * 1024 + head * 128 + j] = mine;
            }
        } else {
            const int d = F.lane, c = head * 64 + d;
            float wa[16];
#pragma unroll
            for (int r = 0; r < 16; ++r) wa[r] = KIN(I_WA2)[((size_t)l * 16 + r) * 256 + c];
            const float ba = KIN(I_BA)[l * 256 + c];
            const bf16* Pq = P + C_GQ + c; const bf16* Pk = P + C_GK + c; const bf16* Pv = P + C_GV + head * 128 + j; const bf16* Pa = P + C_GA;
            float S = 0.f;
            for (int t0 = 0; t0 < T; t0 += 8) {
                bf16 zq[8], zk[8], zv[8]; u32x4 ga0[8], ga1[8];
#pragma unroll
                for (int u = 0; u < 8; ++u) { const size_t row = (size_t)(t0 + u) * NPAD; zq[u] = Pq[row]; zk[u] = Pk[row]; zv[u] = Pv[row]; ga0[u] = *(const u32x4*)(Pa + row); ga1[u] = *(const u32x4*)(Pa + row + 8); }
                float part[8];
#pragma unroll
                for (int u = 0; u < 8; ++u) {
                    float a = ba;
                    a += bflo(ga0[u].x) * wa[0] + bfhi(ga0[u].x) * wa[1] + bflo(ga0[u].y) * wa[2] + bfhi(ga0[u].y) * wa[3] + bflo(ga0[u].z) * wa[4] + bfhi(ga0[u].z) * wa[5] + bflo(ga0[u].w) * wa[6] + bfhi(ga0[u].w) * wa[7];
                    a += bflo(ga1[u].x) * wa[8] + bfhi(ga1[u].x) * wa[9] + bflo(ga1[u].y) * wa[10] + bfhi(ga1[u].y) * wa[11] + bflo(ga1[u].z) * wa[12] + bfhi(ga1[u].z) * wa[13] + bflo(ga1[u].w) * wa[14] + bfhi(ga1[u].w) * wa[15];
                    const float ls = fminf(a, 0.f) - log1pf(expf(-fabsf(a)));
                    const float f = expf(ls * (1.0f / 16.0f));
                    S = f * S + bf2f(zk[u]) * bf2f(zv[u]);
                    part[u] = bf2f(zq[u]) * 0.125f * S; }
                float mine = 0.f;
#pragma unroll
                for (int u = 0; u < 8; ++u) { const float s = wave_sum(part[u]); mine = (F.lane == u) ? s : mine; }
                if (F.lane < 8) ORAW[(size_t)(t0 + F.lane) * 1024 + 512 + head * 128 + j] = mine;
            }
        }
    }
}
__device__ __forceinline__ void phase_recur_out(Frame& F, int l) {
    KA;
    const bf16* P = (const bf16*)(KWS + WS_P); const float* ORAW = (const float*)(KWS + WS_ORAW); bf16* OCAT = (bf16*)(KWS + WS_OCAT);
    for (int it = F.gw; it < T * 8; it += F.NGW) {
        const int t = it >> 3, kind = (it >> 2) & 1, head = it & 3;
        const float* gn = (kind == 0 ? KIN(I_HGN) : KIN(I_GLAN)) + l * 128;
        const int cg = (kind == 0 ? C_HG : C_GR) + head * 128;
        const float r0 = ORAW[(size_t)t * 1024 + kind * 512 + head * 128 + F.lane], r1 = ORAW[(size_t)t * 1024 + kind * 512 + head * 128 + 64 + F.lane];
        const float rstd = 1.0f / sqrtf(wave_sum(r0 * r0 + r1 * r1) * (1.0f / 128.0f) + EPS);
        const float g0 = bf2f(P[(size_t)t * NPAD + cg + F.lane]), g1 = bf2f(P[(size_t)t * NPAD + cg + 64 + F.lane]);
        const float a0 = kind == 0 ? sigmoidf_(g0) : g0 * sigmoidf_(g0), a1 = kind == 0 ? sigmoidf_(g1) : g1 * sigmoidf_(g1);
        OCAT[(size_t)t * 1536 + 512 + kind * 512 + head * 128 + F.lane] = (bf16)f2bf(r0 * rstd * gn[F.lane] * a0);
        OCAT[(size_t)t * 1536 + 512 + kind * 512 + head * 128 + 64 + F.lane] = (bf16)f2bf(r1 * rstd * gn[64 + F.lane] * a1);
    }
}


template <int KIND> struct RecCfg { static constexpr int DK = KIND == 0 ? 128 : 64, NSEG = 512 / DK, TPS = 64 / NSEG, QROW = (DK + 8) * 2; };
constexpr int REC_VT_OFF = 0;
constexpr int REC_KD_OFF = 18432;
constexpr int REC_QS_OFF = 36864;
constexpr int REC_KS_OFF = 54272;
constexpr int REC_QD_OFF = 71680;
constexpr int REC_RED_OFF = 89088;
constexpr int REC_TOT_OFF = 91136;
__device__ __forceinline__ float expc(float x2) { return __builtin_amdgcn_exp2f(fminf(x2, 110.0f)); }
template <int KIND> __device__ __forceinline__ void rec_elem(KArgs* ka, int l, int head, int chunk, int tid, LAS float* tot,
        float (&qv)[RecCfg<KIND>::TPS], float (&kv)[RecCfg<KIND>::TPS], float (&bv)[RecCfg<KIND>::TPS], float& bend, float& bref) {
    constexpr int DK = RecCfg<KIND>::DK, NSEG = RecCfg<KIND>::NSEG, TPS = RecCfg<KIND>::TPS;
    const int d = tid % DK, seg = tid / DK, t0 = chunk * 64 + seg * TPS;
    const bf16* P = (const bf16*)(KWS + WS_P);
    float run = 0.f;
    if (KIND == 0) {
        const int c = head * 128 + d;
        float lb = 0.f;
        if (l > 0) { const float a0 = KIN(I_LB)[c], b0 = KIN(I_LB)[512 + c]; lb = 1.0f / (1.0f + expf(a0 - b0)); }
        const float omlb = 1.0f - lb;
        unsigned zr[TPS], qr[TPS];
#pragma unroll
        for (int u = 0; u < TPS; ++u) { const size_t row = (size_t)(t0 + u) * NPAD; zr[u] = P[row + C_HF + c]; qr[u] = P[row + C_HQ + c]; }
#pragma unroll
        for (int u = 0; u < TPS; ++u) {
            const float z = bf2f(zr[u]); qv[u] = bf2f(qr[u]);
            const float e = __builtin_amdgcn_exp2f(-LOG2E * z), sg = __builtin_amdgcn_rcpf(1.0f + e), f = fmaf(omlb, sg, lb);
            kv[u] = omlb * (e * sg);
            run += __builtin_amdgcn_logf(fmaxf(f, 1e-30f)); bv[u] = run; }
    } else {
        const int c = head * 64 + d;
        float wa[16];
#pragma unroll
        for (int r = 0; r < 16; ++r) wa[r] = KIN(I_WA2)[((size_t)l * 16 + r) * 256 + c];
        const float ba = KIN(I_BA)[l * 256 + c];
        u32x4 g0r[TPS], g1r[TPS]; unsigned qr[TPS], kr[TPS];
#pragma unroll
        for (int u = 0; u < TPS; ++u) { const size_t row = (size_t)(t0 + u) * NPAD; g0r[u] = *(const u32x4*)(P + row + C_GA); g1r[u] = *(const u32x4*)(P + row + C_GA + 8); qr[u] = P[row + C_GQ + c]; kr[u] = P[row + C_GK + c]; }
#pragma unroll
        for (int u = 0; u < TPS; ++u) { const u32x4 g0 = g0r[u], g1 = g1r[u];
            float a = ba;
            a += bflo(g0.x) * wa[0] + bfhi(g0.x) * wa[1] + bflo(g0.y) * wa[2] + bfhi(g0.y) * wa[3] + bflo(g0.z) * wa[4] + bfhi(g0.z) * wa[5] + bflo(g0.w) * wa[6] + bfhi(g0.w) * wa[7];
            a += bflo(g1.x) * wa[8] + bfhi(g1.x) * wa[9] + bflo(g1.y) * wa[10] + bfhi(g1.y) * wa[11] + bflo(g1.z) * wa[12] + bfhi(g1.z) * wa[13] + bflo(g1.w) * wa[14] + bfhi(g1.w) * wa[15];
            const float ls2 = fminf(a, 0.f) * LOG2E - __builtin_amdgcn_logf(1.0f + __builtin_amdgcn_exp2f(-LOG2E * fabsf(a)));
            qv[u] = bf2f(qr[u]) * 0.125f; kv[u] = bf2f(kr[u]);
            run += ls2 * (1.0f / 16.0f); bv[u] = run; }
    }
    tot[seg * DK + d] = run;
    __syncthreads();
    float off = 0.f; bend = 0.f; bref = 0.f;
#pragma unroll
    for (int sgi = 0; sgi < NSEG; ++sgi) { const float v = tot[sgi * DK + d]; off += sgi < seg ? v : 0.f; bref += sgi < NSEG / 2 ? v : 0.f; bend += v; }
#pragma unroll
    for (int u = 0; u < TPS; ++u) bv[u] += off;
}
template <int KIND> __device__ __forceinline__ void rec_vt_load(KArgs* ka, int head, int chunk, int tid, unsigned (&w)[8]) {
    const bf16* P = (const bf16*)(KWS + WS_P) + (KIND == 0 ? C_HI : C_GV) + head * 128;
    const int v = tid & 127, sv = tid >> 7;
#pragma unroll
    for (int u = 0; u < 8; ++u) { const unsigned a = P[(size_t)(chunk * 64 + sv * 16 + 2 * u) * NPAD + v], b = P[(size_t)(chunk * 64 + sv * 16 + 2 * u + 1) * NPAD + v]; w[u] = a | (b << 16); }
}
__device__ __forceinline__ void rec_vt_store(int tid, LAS unsigned char* lds, const unsigned (&w)[8]) {
    const int v = tid & 127, sv = tid >> 7;
    LAS u32x4* dst = (LAS u32x4*)(lds + REC_VT_OFF + v * 144 + sv * 32);
    dst[0] = (u32x4){w[0], w[1], w[2], w[3]}; dst[1] = (u32x4){w[4], w[5], w[6], w[7]};
}
template <int KIND> __device__ __forceinline__ void rec_local_unit(KArgs* ka, Frame& F, int l, int head, int chunk) {
    constexpr int DK = RecCfg<KIND>::DK, TPS = RecCfg<KIND>::TPS;
    LAS unsigned char* lds = F.lds; LAS float* tot = (LAS float*)(lds + REC_TOT_OFF);
    float qv[TPS], kv[TPS], bv[TPS], bend, bref;
    unsigned vraw[8];
    rec_vt_load<KIND>(ka, head, chunk, F.tid, vraw);
    rec_elem<KIND>(ka, l, head, chunk, F.tid, tot, qv, kv, bv, bend, bref);
    const int d = F.tid % DK, seg = F.tid / DK, unit = chunk * 4 + head;
    { unsigned w[TPS / 2];
#pragma unroll
      for (int u = 0; u < TPS / 2; ++u) w[u] = pkbf(kv[2 * u] * expc(bend - bv[2 * u]), kv[2 * u + 1] * expc(bend - bv[2 * u + 1]));
      LAS u32x4* dst = (LAS u32x4*)(lds + REC_KD_OFF + d * 144 + seg * TPS * 2);
      dst[0] = (u32x4){w[0], w[1], w[2], w[3]};
      if constexpr (TPS == 16) dst[1] = (u32x4){w[4], w[5], w[6], w[7]}; }
    if (seg == 0) ((float*)(KWS + WS_DEC + (KIND == 0 ? 0 : 262144)))[(size_t)unit * DK + d] = __builtin_amdgcn_exp2f(bend);
    rec_vt_store(F.tid, lds, vraw);
    __syncthreads();
    const int r = F.lane & 15, kq = F.lane >> 4;
    const int dt = KIND == 0 ? F.wave : (F.wave & 3), vt0 = KIND == 0 ? 0 : (F.wave >> 2) * 4, nvt = KIND == 0 ? 8 : 4;
    bf16x8 a[2];
#pragma unroll
    for (int ks = 0; ks < 2; ++ks) a[ks] = *(const LAS bf16x8*)(lds + REC_KD_OFF + (16 * dt + r) * 144 + (32 * ks + 8 * kq) * 2);
    bf16* Sl = (bf16*)(KWS + (KIND == 0 ? WS_SLOC_HG : WS_SLOC_GL)) + (size_t)unit * 128 * DK;
#pragma unroll
    for (int vi = 0; vi < nvt; ++vi) { const int vt = vt0 + vi; f32x4 acc = {0.f, 0.f, 0.f, 0.f};
#pragma unroll
        for (int ks = 0; ks < 2; ++ks) { const bf16x8 b = *(const LAS bf16x8*)(lds + REC_VT_OFF + (16 * vt + r) * 144 + (32 * ks + 8 * kq) * 2); acc = __builtin_amdgcn_mfma_f32_16x16x32_bf16(a[ks], b, acc, 0, 0, 0); }
        u32x2 w2; w2.x = pkbf(acc[0], acc[1]); w2.y = pkbf(acc[2], acc[3]);
        *(u32x2*)(Sl + (size_t)(16 * vt + r) * DK + 16 * dt + 4 * kq) = w2; }
    __syncthreads();
}
__device__ __forceinline__ void phase_rec_local(Frame& F, int l) {
    KA;
    for (int it = F.bid; it < 1024; it += F.G) { const int kind = it >> 9, chunk = (it >> 2) & 127, head = it & 3;
        if (kind == 0) rec_local_unit<0>(ka, F, l, head, chunk); else rec_local_unit<1>(ka, F, l, head, chunk); }
}
__device__ __forceinline__ void phase_rec_scan(Frame& F) {
    KA;
    const int gt = F.bid * 512 + F.tid;
    if (gt >= 49152) return;
    const bool hg = gt < 32768; const int q = hg ? gt : gt - 32768;
    const int DK = hg ? 128 : 64, dp = q % (DK / 2), v = (q / (DK / 2)) & 127, head = q / (DK / 2 * 128);
    const bf16* Sl = (const bf16*)(KWS + (hg ? WS_SLOC_HG : WS_SLOC_GL)) + ((size_t)head * 128 + v) * DK + 2 * dp;
    bf16* Sp = (bf16*)(KWS + (hg ? WS_SPREV_HG : WS_SPREV_GL)) + ((size_t)head * 128 + v) * DK + 2 * dp;
    const float* De = (const float*)(KWS + WS_DEC + (hg ? 0 : 262144)) + (size_t)head * DK + 2 * dp;
    const size_t ustr = (size_t)4 * 128 * DK, dstr = (size_t)4 * DK;
    float s0 = 0.f, s1 = 0.f;
    for (int c0 = 0; c0 < NCH; c0 += 16) { unsigned x[16]; f32x2 dc[16];
#pragma unroll
        for (int u = 0; u < 16; ++u) { x[u] = *(const unsigned*)(Sl + (size_t)(c0 + u) * ustr); dc[u] = *(const f32x2*)(De + (size_t)(c0 + u) * dstr); }
#pragma unroll
        for (int u = 0; u < 16; ++u) { *(unsigned*)(Sp + (size_t)(c0 + u) * ustr) = pkbf(s0, s1); s0 = dc[u].x * s0 + bflo(x[u]); s1 = dc[u].y * s1 + bfhi(x[u]); } }
}
template <int KIND> __device__ __forceinline__ void rec_out_unit(KArgs* ka, Frame& F, int l, int head, int chunk) {
    constexpr int DK = RecCfg<KIND>::DK, TPS = RecCfg<KIND>::TPS, QROW = RecCfg<KIND>::QROW, NKS = DK / 32;
    LAS unsigned char* lds = F.lds; LAS float* tot = (LAS float*)(lds + REC_TOT_OFF); LAS float* red = (LAS float*)(lds + REC_RED_OFF);
    const int r = F.lane & 15, kq = F.lane >> 4, unit = chunk * 4 + head, vt = F.wave;
    bf16x8 sa[NKS];
    { const bf16* Sp = (const bf16*)(KWS + (KIND == 0 ? WS_SPREV_HG : WS_SPREV_GL)) + (size_t)unit * 128 * DK + (size_t)(16 * vt + r) * DK + 8 * kq;
#pragma unroll
      for (int ks = 0; ks < NKS; ++ks) sa[ks] = *(const bf16x8*)(Sp + 32 * ks); }
    float qv[TPS], kv[TPS], bv[TPS], bend, bref;
    unsigned vraw[8];
    rec_vt_load<KIND>(ka, head, chunk, F.tid, vraw);
    const bf16* P = (const bf16*)(KWS + WS_P); bf16* OCAT = (bf16*)(KWS + WS_OCAT);
    const int v0 = 16 * vt + 4 * kq;
    const f32x4 gn = *(const f32x4*)((KIND == 0 ? KIN(I_HGN) : KIN(I_GLAN)) + l * 128 + v0);
    u32x2 gq4[4];
#pragma unroll
    for (int it = 0; it < 4; ++it) gq4[it] = *(const u32x2*)(P + (size_t)(chunk * 64 + 16 * it + r) * NPAD + (KIND == 0 ? C_HG : C_GR) + head * 128 + v0);
    rec_elem<KIND>(ka, l, head, chunk, F.tid, tot, qv, kv, bv, bend, bref);
    { const int d = F.tid % DK, seg = F.tid / DK; const float eref = __builtin_amdgcn_exp2f(fmaxf(bref, -120.f));
#pragma unroll
      for (int u = 0; u < TPS; u += 2) { const int o = (seg * TPS + u) * QROW + d * 2;
          const float x0 = __builtin_amdgcn_exp2f(fminf(fmaxf(bv[u] - bref, -110.f), 110.f)), x1 = __builtin_amdgcn_exp2f(fminf(fmaxf(bv[u + 1] - bref, -110.f), 110.f));
          const float qs0 = qv[u] * x0, qs1 = qv[u + 1] * x1;
          const unsigned w0 = pkbf(qs0, qs1), w1 = pkbf(kv[u] * __builtin_amdgcn_rcpf(x0), kv[u + 1] * __builtin_amdgcn_rcpf(x1)), w2 = pkbf(qs0 * eref, qs1 * eref);
          *(LAS bf16*)(lds + REC_QS_OFF + o) = (bf16)w0; *(LAS bf16*)(lds + REC_QS_OFF + o + QROW) = (bf16)(w0 >> 16);
          *(LAS bf16*)(lds + REC_KS_OFF + o) = (bf16)w1; *(LAS bf16*)(lds + REC_KS_OFF + o + QROW) = (bf16)(w1 >> 16);
          *(LAS bf16*)(lds + REC_QD_OFF + o) = (bf16)w2; *(LAS bf16*)(lds + REC_QD_OFF + o + QROW) = (bf16)(w2 >> 16); } }
    rec_vt_store(F.tid, lds, vraw);
    __syncthreads();
#pragma unroll
    for (int tt = 0; tt < 2; ++tt) { const int tile = F.wave * 2 + tt, jt = tile >> 2, it = tile & 3; f32x4 acc = {0.f, 0.f, 0.f, 0.f};
        if (jt <= it) {
#pragma unroll
            for (int ks = 0; ks < NKS; ++ks) { const bf16x8 a = *(const LAS bf16x8*)(lds + REC_KS_OFF + (16 * jt + r) * QROW + (32 * ks + 8 * kq) * 2), b = *(const LAS bf16x8*)(lds + REC_QS_OFF + (16 * it + r) * QROW + (32 * ks + 8 * kq) * 2);
                acc = __builtin_amdgcn_mfma_f32_16x16x32_bf16(a, b, acc, 0, 0, 0); } }
        const int i = 16 * it + r, j0 = 16 * jt + 4 * kq;
        u32x2 w; w.x = pk2(j0 <= i ? acc[0] : 0.f, j0 + 1 <= i ? acc[1] : 0.f); w.y = pk2(j0 + 2 <= i ? acc[2] : 0.f, j0 + 3 <= i ? acc[3] : 0.f);
        *(LAS u32x2*)(lds + REC_KD_OFF + i * 144 + j0 * 2) = w; }
    __syncthreads();
    f32x4 acc[4];
#pragma unroll
    for (int it = 0; it < 4; ++it) acc[it] = (f32x4){0.f, 0.f, 0.f, 0.f};
#pragma unroll
    for (int ks = 0; ks < 2; ++ks) { const bf16x8 a = *(const LAS bf16x8*)(lds + REC_VT_OFF + (16 * vt + r) * 144 + (32 * ks + 8 * kq) * 2);
#pragma unroll
        for (int it = 0; it < 4; ++it) { const bf16x8 b = *(const LAS bf16x8*)(lds + REC_KD_OFF + (16 * it + r) * 144 + (32 * ks + 8 * kq) * 2); acc[it] = __builtin_amdgcn_mfma_f32_16x16x32_bf16(a, b, acc[it], 0, 0, 0); } }
#pragma unroll
    for (int ks = 0; ks < NKS; ++ks) {
#pragma unroll
        for (int it = 0; it < 4; ++it) { const bf16x8 b = *(const LAS bf16x8*)(lds + REC_QD_OFF + (16 * it + r) * QROW + (32 * ks + 8 * kq) * 2); acc[it] = __builtin_amdgcn_mfma_f32_16x16x32_bf16(sa[ks], b, acc[it], 0, 0, 0); } }
#pragma unroll
    for (int it = 0; it < 4; ++it) { float ss = acc[it][0] * acc[it][0] + acc[it][1] * acc[it][1] + acc[it][2] * acc[it][2] + acc[it][3] * acc[it][3];
        ss += __shfl_xor(ss, 16); ss += __shfl_xor(ss, 32);
        if (kq == 0) red[F.wave * 64 + 16 * it + r] = ss; }
    __syncthreads();
#pragma unroll
    for (int it = 0; it < 4; ++it) { const int i = 16 * it + r, t = chunk * 64 + i; float tot_ = 0.f;
#pragma unroll
        for (int w = 0; w < 8; ++w) tot_ += red[w * 64 + i];
        const float rstd = 1.0f / sqrtf(tot_ * (1.0f / 128.0f) + EPS);
        const u32x2 gq = gq4[it];
        float gt[4] = {bflo(gq.x), bfhi(gq.x), bflo(gq.y), bfhi(gq.y)}, o[4];
#pragma unroll
        for (int e = 0; e < 4; ++e) { const float sg = fsig(gt[e]); o[e] = acc[it][e] * rstd * gn[e] * (KIND == 0 ? sg : gt[e] * sg); }
        u32x2 w; w.x = pkbf(o[0], o[1]); w.y = pkbf(o[2], o[3]);
        *(u32x2*)(OCAT + (size_t)t * 1536 + 512 + KIND * 512 + head * 128 + v0) = w; }
    __syncthreads();
}
__device__ __forceinline__ void phase_rec_out(Frame& F, int l) {
    KA;
    unsigned* qctr = (unsigned*)(KWS + WS_CTL) + 2048 + 64 * l;
    volatile LAS int* qslot = (volatile LAS int*)(F.lds + MISC_OFF + 1024);
    int mine = 0;
    if (F.tid == 0) { mine = (int)__hip_atomic_fetch_add(qctr, 1u, __ATOMIC_RELAXED, __HIP_MEMORY_SCOPE_AGENT);
        unsigned* sdone = (unsigned*)(KWS + WS_CTL) + 2048 + 64 * (4 + l); unsigned sp = 0;
        while (__hip_atomic_load(sdone, __ATOMIC_RELAXED, __HIP_MEMORY_SCOPE_AGENT) < 96u) { __builtin_amdgcn_s_sleep(2); if (++sp > (1u << 24)) break; }
        __builtin_amdgcn_fence(__ATOMIC_ACQUIRE, "agent"); asm volatile("s_waitcnt vmcnt(0)" ::: "memory"); }
    for (;;) {
        if (F.tid == 0) *qslot = mine;
        __syncthreads();
        const int it = __builtin_amdgcn_readfirstlane(*qslot);
        __syncthreads();
        if (it >= 1024) break;
        if (F.tid == 0) mine = (int)__hip_atomic_fetch_add(qctr, 1u, __ATOMIC_RELAXED, __HIP_MEMORY_SCOPE_AGENT);
        const int kind = it >> 9, chunk = (it >> 2) & 127, head = it & 3;
        if (kind == 0) rec_out_unit<0>(ka, F, l, head, chunk); else rec_out_unit<1>(ka, F, l, head, chunk);
    }
}

typedef float f32x16 __attribute__((ext_vector_type(16)));
constexpr float NSA_SHIFT2 = 8.0f;
__device__ __forceinline__ int perm16(int b) { return (b & 3) | ((b & 4) << 1) | ((b & 8) >> 1); }
__device__ __forceinline__ void phase_prep2(Frame& F, int l) {
    KA;
    const bf16* P = (const bf16*)(KWS + WS_P);
    bf16* QS = (bf16*)(KWS + WS_QS); bf16* KS2 = (bf16*)(KWS + WS_KS2); bf16* KW2 = (bf16*)(KWS + WS_KW2);
    const float* qg = KIN(I_QN) + l * 64; const float* kg = KIN(I_KN) + l * 192;
    for (int it = F.gw; it < T * 12; it += F.NGW) {
        const int t = it / 12, v = it % 12;
        const int col = v < 8 ? v * 64 : (v < 10 ? C_KS + (v - 8) * 64 : C_KW + (v - 10) * 64);
        float x = bf2f(P[(size_t)t * NPAD + col + F.lane]);
        const float ss = wave_sum(x * x);
        const float g = v < 8 ? qg[F.lane] * (0.125f * LOG2E) : (v < 10 ? kg[64 + F.lane] : kg[128 + F.lane]);
        x = x * (1.0f / sqrtf(ss * (1.0f / 64.0f) + EPS)) * g;
        bf16* dst = v < 8 ? QS + ((size_t)v * T + t) * 64 : (v < 10 ? KS2 + ((size_t)(v - 8) * T + t) * 64 : KW2 + ((size_t)(v - 10) * T + t) * 64);
        dst[F.lane] = (bf16)f2bf(x);
    }
    LAS bf16* tile = (LAS bf16*)(F.lds + F.wave * 16384);
    for (int it = F.gw; it < 2 * 2 * (T / 64); it += F.NGW) {
        const int kind = it / (2 * (T / 64)), q = it % (2 * (T / 64)), g = q / (T / 64), tb = q % (T / 64);
        const bf16* src = P + (size_t)(tb * 64) * NPAD + (kind == 0 ? C_VS : C_VW) + g * 64;
        bf16* dst = (bf16*)(KWS + (kind == 0 ? WS_VST : WS_VWT)) + (size_t)g * 64 * T + tb * 64;
#pragma unroll 4
        for (int r = 0; r < 64; ++r) tile[r * 66 + F.lane] = src[(size_t)r * NPAD + F.lane];
        WSYNC();
        const int pl = (F.lane & ~15) | perm16(F.lane & 15);
#pragma unroll 4
        for (int d = 0; d < 64; ++d) dst[(size_t)d * T + pl] = tile[F.lane * 66 + d];
        WSYNC();
    }
}

__device__ __forceinline__ void phase_prep3(Frame& F, int l) {
    KA;
    const bf16* P = (const bf16*)(KWS + WS_P);
    bf16* QS = (bf16*)(KWS + WS_QS); bf16* KS2 = (bf16*)(KWS + WS_KS2); bf16* KW2 = (bf16*)(KWS + WS_KW2);
    const float* qg = KIN(I_QN) + l * 64; const float* kg = KIN(I_KN) + l * 192;
    const int vec = F.lane >> 3, part = F.lane & 7;
    for (int t = F.gw; t < T; t += F.NGW) {
#pragma unroll
        for (int pass = 0; pass < 2; ++pass) {
            if (pass == 1 && vec >= 4) continue;
            const int col = pass == 0 ? vec * 64 : (vec < 2 ? C_KS + vec * 64 : C_KW + (vec - 2) * 64);
            const float* gp = pass == 0 ? qg : (vec < 2 ? kg + 64 : kg + 128);
            const float gs = pass == 0 ? 0.125f * LOG2E : 1.0f;
            bf16* dst = pass == 0 ? QS + ((size_t)vec * T + t) * 64 : (vec < 2 ? KS2 + ((size_t)vec * T + t) * 64 : KW2 + ((size_t)(vec - 2) * T + t) * 64);
            const u32x4 raw = *(const u32x4*)(P + (size_t)t * NPAD + col + part * 8);
            float x[8] = {bflo(raw.x), bfhi(raw.x), bflo(raw.y), bfhi(raw.y), bflo(raw.z), bfhi(raw.z), bflo(raw.w), bfhi(raw.w)};
            float ss = 0.f;
#pragma unroll
            for (int e = 0; e < 8; ++e) ss += x[e] * x[e];
            ss += __shfl_xor(ss, 1); ss += __shfl_xor(ss, 2); ss += __shfl_xor(ss, 4);
            const float rstd = gs / sqrtf(ss * (1.0f / 64.0f) + EPS);
            const f32x4 g0 = *(const f32x4*)(gp + part * 8), g1 = *(const f32x4*)(gp + part * 8 + 4);
            u32x4 o; o.x = pk2(x[0] * rstd * g0.x, x[1] * rstd * g0.y); o.y = pk2(x[2] * rstd * g0.z, x[3] * rstd * g0.w); o.z = pk2(x[4] * rstd * g1.x, x[5] * rstd * g1.y); o.w = pk2(x[6] * rstd * g1.z, x[7] * rstd * g1.w);
            *(u32x4*)(dst + part * 8) = o;
        }
    }
    LAS bf16* tile = (LAS bf16*)(F.lds + F.wave * 16384);
    for (int it = F.gw; it < 2 * 2 * (T / 64); it += F.NGW) {
        const int kind = it / (2 * (T / 64)), q = it % (2 * (T / 64)), g = q / (T / 64), tb = q % (T / 64);
        const bf16* src = P + (size_t)(tb * 64) * NPAD + (kind == 0 ? C_VS : C_VW) + g * 64;
        bf16* dst = (bf16*)(KWS + (kind == 0 ? WS_VST : WS_VWT)) + (size_t)g * 64 * T + tb * 64;
#pragma unroll
        for (int i = 0; i < 8; ++i) { const int tok = vec + 8 * i; *(LAS u32x4*)(tile + tok * 72 + part * 8) = *(const u32x4*)(src + (size_t)tok * NPAD + part * 8); }
        WSYNC();
#pragma unroll
        for (int c = 0; c < 8; ++c) { unsigned w[4];
#pragma unroll
            for (int k = 0; k < 4; ++k) { const int p0 = (c & 1) * 8 + 2 * k, p1 = p0 + 1;
                const int k0 = (c >> 1) * 16 + ((p0 & 3) | ((p0 & 4) << 1) | ((p0 & 8) >> 1)), k1 = (c >> 1) * 16 + ((p1 & 3) | ((p1 & 4) << 1) | ((p1 & 8) >> 1));
                w[k] = (unsigned)tile[k0 * 72 + F.lane] | ((unsigned)tile[k1 * 72 + F.lane] << 16); }
            *(u32x4*)(dst + (size_t)F.lane * T + c * 8) = (u32x4){w[0], w[1], w[2], w[3]}; }
        WSYNC();
    }
}

__device__ __forceinline__ void phase_compress2(Frame& F, int l) {
    KA;
    LAS float* av = (LAS float*)(F.lds + F.wave * 16384);
    const bf16* P = (const bf16*)(KWS + WS_P);
    bf16* KCB = (bf16*)(KWS + WS_KCB); bf16* VCT = (bf16*)(KWS + WS_KCB + 131072);
    for (int it = F.gw; it < 2 * 2 * 512; it += F.NGW) {
        const int kind = it >> 10, g = (it >> 9) & 1, n = it & 511;
        if (n == 511) { if (kind == 0) KCB[((size_t)g * 512 + 511) * 64 + F.lane] = 0; else VCT[((size_t)g * 64 + F.lane) * 512 + 511] = 0; continue; }
        const bf16* src = P + (size_t)(16 * n) * NPAD + (kind == 0 ? C_KC : C_VC) + g * 64;
        const float* pe = KIN(I_PE) + ((size_t)l * 2 + kind) * 2048;
        const float* w1 = KIN(I_W1) + ((size_t)l * 2 + kind) * 2048 * 64;
        const float* w2 = KIN(I_W2) + ((size_t)l * 2 + kind) * 64 * 64;
#pragma unroll 4
        for (int c = 0; c < 32; ++c) av[c * 64 + F.lane] = bf2f(src[(size_t)c * NPAD + F.lane]) + pe[c * 64 + F.lane];
        WSYNC();
        float acc = 0.f;
#pragma unroll 8
        for (int i = 0; i < 2048; ++i) acc += av[i] * w1[i * 64 + F.lane];
        const float hid = gelu_tanh(acc);
        WSYNC();
        av[F.lane] = hid;
        WSYNC();
        float o = 0.f;
#pragma unroll 8
        for (int i = 0; i < 64; ++i) o += av[i] * w2[i * 64 + F.lane];
        WSYNC();
        if (kind == 0) { const float ss = wave_sum(o * o); o = o * (1.0f / sqrtf(ss * (1.0f / 64.0f) + EPS)) * KIN(I_KN)[l * 192 + F.lane]; KCB[((size_t)g * 512 + n) * 64 + F.lane] = (bf16)f2bf(o); }
        else VCT[((size_t)g * 64 + F.lane) * 512 + ((n & ~15) | perm16(n & 15))] = (bf16)f2bf(o);
    }
}

__device__ __forceinline__ void phase_compress3(Frame& F, int l) {
    KA;
    const bf16* P = (const bf16*)(KWS + WS_P);
    bf16* KCB = (bf16*)(KWS + WS_KCB); bf16* VCT = (bf16*)(KWS + WS_KCB + 131072);
    LAS float* red = (LAS float*)F.lds;
    LAS bf16* hid = (LAS bf16*)(F.lds + 32768);
    const int r16 = F.lane & 15, kq = F.lane >> 4;
    for (int unit = F.bid; unit < 128; unit += F.G) {
        const int kind = unit >> 6, mt = unit & 63, g = mt >> 5, n0 = (mt & 31) * 16;
        const bf16* W1T = (const bf16*)(KWS + WS_CW) + (size_t)(l * 2 + kind) * 64 * 2048; const bf16* W2T = (const bf16*)(KWS + WS_CW + 1048576) + (size_t)(l * 2 + kind) * 4096;
        const float* B1 = (const float*)(KWS + WS_CW + 1572864) + (l * 2 + kind) * 64;
        const bf16* arow = P + (size_t)(16 * (n0 + r16)) * NPAD + (kind == 0 ? C_KC : C_VC) + g * 64;
        f32x4 acc[4];
#pragma unroll
        for (int nt = 0; nt < 4; ++nt) acc[nt] = (f32x4){0.f, 0.f, 0.f, 0.f};
#pragma unroll 2
        for (int ks = 0; ks < 8; ++ks) { const int c0 = F.wave * 256 + 32 * ks + 8 * kq;
            const bf16x8 a = *(const bf16x8*)(arow + (size_t)(c0 >> 6) * NPAD + (c0 & 63));
#pragma unroll
            for (int nt = 0; nt < 4; ++nt) { const bf16x8 b = *(const bf16x8*)(W1T + (size_t)(16 * nt + r16) * 2048 + c0); acc[nt] = __builtin_amdgcn_mfma_f32_16x16x32_bf16(a, b, acc[nt], 0, 0, 0); } }
#pragma unroll
        for (int nt = 0; nt < 4; ++nt) *(LAS f32x4*)(red + ((F.wave * 4 + nt) * 64 + F.lane) * 4) = acc[nt];
        __syncthreads();
        if (F.tid < 256) { const int nt = F.tid >> 6, ln = F.tid & 63; f32x4 v = {0.f, 0.f, 0.f, 0.f};
#pragma unroll
            for (int w = 0; w < 8; ++w) v += *(const LAS f32x4*)(red + ((w * 4 + nt) * 64 + ln) * 4);
            const int col = 16 * nt + (ln & 15); const float b1 = B1[col];
#pragma unroll
            for (int i = 0; i < 4; ++i) hid[(4 * (ln >> 4) + i) * 72 + col] = (bf16)f2bf(gelu_tanh(v[i] + b1)); }
        __syncthreads();
        if (F.wave == 0) {
            f32x4 o[4];
#pragma unroll
            for (int nt = 0; nt < 4; ++nt) o[nt] = (f32x4){0.f, 0.f, 0.f, 0.f};
#pragma unroll
            for (int ks = 0; ks < 2; ++ks) { const bf16x8 a = *(const LAS bf16x8*)(hid + r16 * 72 + 32 * ks + 8 * kq);
#pragma unroll
                for (int nt = 0; nt < 4; ++nt) { const bf16x8 b = *(const bf16x8*)(W2T + (16 * nt + r16) * 64 + 32 * ks + 8 * kq); o[nt] = __builtin_amdgcn_mfma_f32_16x16x32_bf16(a, b, o[nt], 0, 0, 0); } }
            if (kind == 0) {
#pragma unroll
                for (int i = 0; i < 4; ++i) { float ss = o[0][i] * o[0][i] + o[1][i] * o[1][i] + o[2][i] * o[2][i] + o[3][i] * o[3][i];
                    ss += __shfl_xor(ss, 1); ss += __shfl_xor(ss, 2); ss += __shfl_xor(ss, 4); ss += __shfl_xor(ss, 8);
                    const float rstd = 1.0f / sqrtf(ss * (1.0f / 64.0f) + EPS); const int n = n0 + 4 * kq + i;
#pragma unroll
                    for (int nt = 0; nt < 4; ++nt) { const int col = 16 * nt + r16; KCB[((size_t)g * 512 + n) * 64 + col] = n < 511 ? (bf16)f2bf(o[nt][i] * rstd * KIN(I_KN)[l * 192 + col]) : (bf16)0; } }
            } else {
#pragma unroll
                for (int i = 0; i < 4; ++i) { const int n = n0 + 4 * kq + i;
#pragma unroll
                    for (int nt = 0; nt < 4; ++nt) { const int col = 16 * nt + r16; VCT[((size_t)g * 64 + col) * 512 + ((n & ~15) | perm16(n & 15))] = n < 511 ? (bf16)f2bf(o[nt][i]) : (bf16)0; } }
            }
        }
        __syncthreads();
    }
}

constexpr int NSA_SCA = 65536, NSA_SCB = 99328;
constexpr int NSA_QM = 133120, NSA_UM = 134144;
static_assert(NSA_UM + 16 <= MISC_OFF, "NSA LDS map");
__device__ __forceinline__ int next_set(unsigned long long m0, unsigned long long m1, int from) {
    if (from < 64) { const unsigned long long x = m0 & (~0ull << from); if (x) return __builtin_ctzll(x); from = 64; }
    if (from < 128) { const unsigned long long x = m1 & (~0ull << (from - 64)); if (x) return 64 + __builtin_ctzll(x); }
    return 128;
}
__device__ __forceinline__ void nsa_issue(LAS unsigned char* lds, int slot, const bf16* Kg, const bf16* VTg, int vt_len, int j, int tid, int wave) {
    const int row = tid >> 3, c = (tid & 7) ^ ((row >> 1) & 7);
    __builtin_amdgcn_global_load_lds((const unsigned*)(Kg + (size_t)(64 * j + row) * 64 + c * 8), (LAS unsigned*)(lds + slot * 16384 + wave * 1024), 16, 0, 0);
    __builtin_amdgcn_global_load_lds((const unsigned*)(VTg + (size_t)row * vt_len + 64 * j + c * 8), (LAS unsigned*)(lds + slot * 16384 + 8192 + wave * 1024), 16, 0, 0);
}
template <int MODE> __device__ __forceinline__ void nsa_branch(Frame& F, const bf16* Kg, const bf16* VTg, int vt_len, unsigned long long m0, unsigned long long m1,
        const bf16x8 (&Qf)[4], int t, int cblk, u32x4 qxw, int tref, float inv_l, const unsigned (&qsel)[4], int hi_cmp, unsigned wm_lo_dummy, f32x16 (&oacc)[2], float& lsum) {
    LAS unsigned char* lds = F.lds;
    const int lane = F.lane, c32 = lane & 31, h = lane >> 5, tid = F.tid;
    const int sw = (c32 >> 1) & 7;
    int j0 = next_set(m0, m1, 0);
    if (j0 >= 128) return;
    int j1 = next_set(m0, m1, j0 + 1), j2 = j1 < 128 ? next_set(m0, m1, j1 + 1) : 128;
    nsa_issue(lds, 0, Kg, VTg, vt_len, j0, tid, F.wave);
    if (j1 < 128) nsa_issue(lds, 1, Kg, VTg, vt_len, j1, tid, F.wave);
    if (j2 < 128) nsa_issue(lds, 2, Kg, VTg, vt_len, j2, tid, F.wave);
    int slot = 0;
    while (j0 < 128) {
        const int j = j0;
        if (j2 < 128) asm volatile("s_waitcnt vmcnt(4)" ::: "memory"); else if (j1 < 128) asm volatile("s_waitcnt vmcnt(2)" ::: "memory"); else asm volatile("s_waitcnt vmcnt(0)" ::: "memory");
        __builtin_amdgcn_s_barrier(); asm volatile("" ::: "memory");
        const int j3 = j2 < 128 ? next_set(m0, m1, j2 + 1) : 128;
        if (j3 < 128) nsa_issue(lds, (slot + 3) & 3, Kg, VTg, vt_len, j3, tid, F.wave);
        bool need = true;
        if (MODE == 2) { const unsigned myw = j < 32 ? qsel[0] : (j < 64 ? qsel[1] : (j < 96 ? qsel[2] : qsel[3])); need = __any((myw >> (j & 31)) & 1u); }
        if (need) {
            const int kb = slot * 16384, vb = slot * 16384 + 8192;
            const int kbase = 64 * j;
            u32x4 qx = qxw;
            if (MODE == 2) { const unsigned myw = j < 32 ? qsel[0] : (j < 64 ? qsel[1] : (j < 96 ? qsel[2] : qsel[3])); if (!((myw >> (j & 31)) & 1u) && h == 0) qx.z = 0xF149u; }
            const bf16x8 qxf = __builtin_bit_cast(bf16x8, qx);
            f32x16 sacc[2];
#pragma unroll
            for (int sub = 0; sub < 2; ++sub)
#pragma unroll
                for (int i = 0; i < 16; ++i) sacc[sub][i] = 0.f;
#pragma unroll
            for (int sub = 0; sub < 2; ++sub) {
#pragma unroll
                for (int kp = 0; kp < 2; ++kp) { bf16x8 ka2[2];
#pragma unroll
                    for (int k2 = 0; k2 < 2; ++k2) ka2[k2] = *(const LAS bf16x8*)(lds + kb + (32 * sub + c32) * 128 + (((2 * (2 * kp + k2) + h) ^ sw) * 16));
                    asm volatile("" ::: "memory");
#pragma unroll
                    for (int k2 = 0; k2 < 2; ++k2) sacc[sub] = __builtin_amdgcn_mfma_f32_32x32x16_bf16(ka2[k2], Qf[2 * kp + k2], sacc[sub], 0, 0, 0);
                    asm volatile("" ::: "memory"); }
                { const int kidx = kbase + 32 * sub + c32, pos = MODE < 2 ? 16 * kidx + 31 : kidx, dd = tref - pos;
                  const unsigned w = pkbf(-(float)((dd >> 8) * 256), -(float)(dd & 255));
                  u32x4 kx; kx.x = h == 0 ? w : 0u; kx.y = kx.x; kx.z = h == 0 ? 0x3F80u : 0u; kx.w = 0u;
                  sacc[sub] = __builtin_amdgcn_mfma_f32_32x32x16_bf16(__builtin_bit_cast(bf16x8, kx), qxf, sacc[sub], 0, 0, 0); } }
#pragma unroll
            for (int sub = 0; sub < 2; ++sub)
#pragma unroll
                for (int i = 0; i < 16; ++i) sacc[sub][i] = __builtin_amdgcn_exp2f(sacc[sub][i]);
            bool mhi = false, mlo = false; int hi = 0, lo = 0;
            if (MODE < 2) { mhi = (kbase + 63 > (tref - 63 - 31) / 16 - 1); hi = hi_cmp; }
            if (MODE == 2) { mhi = (j == cblk); hi = t; }
            if (MODE == 3) { mhi = (j == cblk); hi = t; mlo = (j == cblk - 8); lo = t - 511; }
            if (mhi || mlo) {
#pragma unroll
                for (int sub = 0; sub < 2; ++sub)
#pragma unroll
                    for (int i = 0; i < 16; ++i) { const int idx = kbase + 4 * h + 32 * sub + (i & 3) + 8 * (i >> 2); if ((mhi && idx > hi) || (mlo && idx < lo)) sacc[sub][i] = 0.f; }
            }
            float ls = 0.f;
#pragma unroll
            for (int sub = 0; sub < 2; ++sub)
#pragma unroll
                for (int i = 0; i < 16; ++i) ls += sacc[sub][i];
            lsum += ls;
            if (MODE == 1) {
                LAS float* scA = (LAS float*)(lds + NSA_SCA); LAS float* scB = (LAS float*)(lds + NSA_SCB);
                const int q = F.wave * 8 + (c32 >> 2);
#pragma unroll
                for (int sub = 0; sub < 2; ++sub)
#pragma unroll
                    for (int g4 = 0; g4 < 4; ++g4) { float x[4];
#pragma unroll
                        for (int e = 0; e < 4; ++e) { float v = sacc[sub][4 * g4 + e] * inv_l;
                            v += __builtin_bit_cast(float, __builtin_amdgcn_mov_dpp(__builtin_bit_cast(int, v), 0xB1, 0xF, 0xF, true));
                            v += __builtin_bit_cast(float, __builtin_amdgcn_mov_dpp(__builtin_bit_cast(int, v), 0x4E, 0xF, 0xF, true));
                            x[e] = v; }
                        const int jb = 16 * j + 8 * sub + 2 * g4 + h;
                        if ((c32 & 3) == 0) { scA[q * 132 + jb] = 2.0f * (x[0] + x[1] + x[2]) + x[3]; scB[q * 132 + jb + 1] = x[3]; } }
            }
            if (MODE != 0) {
                bf16x8 pf[2][2];
#pragma unroll
                for (int sub = 0; sub < 2; ++sub)
#pragma unroll
                    for (int s2 = 0; s2 < 2; ++s2) { u32x4 w; w.x = pkbf(sacc[sub][8 * s2], sacc[sub][8 * s2 + 1]); w.y = pkbf(sacc[sub][8 * s2 + 2], sacc[sub][8 * s2 + 3]); w.z = pkbf(sacc[sub][8 * s2 + 4], sacc[sub][8 * s2 + 5]); w.w = pkbf(sacc[sub][8 * s2 + 6], sacc[sub][8 * s2 + 7]);
                        pf[sub][s2] = __builtin_bit_cast(bf16x8, w); }
                asm volatile("" ::: "memory");
#pragma unroll
                for (int ds = 0; ds < 2; ++ds) {
#pragma unroll
                    for (int qp = 0; qp < 2; ++qp) { bf16x8 va2[2];
#pragma unroll
                        for (int k2 = 0; k2 < 2; ++k2) va2[k2] = *(const LAS bf16x8*)(lds + vb + (32 * ds + c32) * 128 + (((2 * (2 * qp + k2) + h) ^ sw) * 16));
                        asm volatile("" ::: "memory");
#pragma unroll
                        for (int k2 = 0; k2 < 2; ++k2) oacc[ds] = __builtin_amdgcn_mfma_f32_32x32x16_bf16(va2[k2], pf[qp][k2], oacc[ds], 0, 0, 0);
                        asm volatile("" ::: "memory"); } }
            }
        }
        j0 = j1; j1 = j2; j2 = j3; slot = (slot + 1) & 3;
    }
    asm volatile("s_waitcnt lgkmcnt(0)" ::: "memory"); __builtin_amdgcn_s_barrier(); asm volatile("" ::: "memory");
}
__device__ __forceinline__ void nsa_stash_put(LAS unsigned char* lds, int wave, int lane, const f32x16 (&o)[2], float sc) {
    LAS unsigned* st = (LAS unsigned*)(lds + NSA_SCA) + wave * 1024 + lane;
#pragma unroll
    for (int ds = 0; ds < 2; ++ds)
#pragma unroll
        for (int k = 0; k < 8; ++k) st[(ds * 8 + k) * 64] = pkbf(o[ds][2 * k] * sc, o[ds][2 * k + 1] * sc);
}
#define PSTAMP(slot) do { if (MK_PROBE_MASK != 0 && F.bid == MK_PROBE_BID && F.tid == 0) { volatile LAS unsigned long long* _ta = (volatile LAS unsigned long long*)(F.lds + MISC_OFF + 512); const unsigned long long _n = wall_clock64(); _ta[slot] += _n - _ta[16]; _ta[16] = _n; } } while (0)
__device__ __forceinline__ void phase_nsa2(Frame& F, int l) {
    KA;
    LAS unsigned char* lds = F.lds;
    const bf16* P = (const bf16*)(KWS + WS_P); bf16* OCAT = (bf16*)(KWS + WS_OCAT);
    const bf16* QS = (const bf16*)(KWS + WS_QS);
    const int lane = F.lane, c32 = lane & 31, h = lane >> 5, q8 = c32 >> 2, r = c32 & 3;
    for (int unit = F.bid; unit < 256; unit += F.G) {
        const int g = unit & 1, cblk = unit >> 1, t0 = cblk * 64, head = g * 4 + r, t = t0 + F.wave * 8 + q8;
        u32x4 qxw;
        { const float s2 = exp2f(-(float)(head + 1)) * LOG2E; const unsigned sh = f2bf(s2); const float rem = s2 - bf2f(sh); const unsigned sl = f2bf(rem);
          qxw.x = h == 0 ? (sh | (sh << 16)) : 0u; qxw.y = h == 0 ? (sl | (sl << 16)) : 0u; qxw.z = 0u; qxw.w = 0u; }
        const int tref = t0 + 63;
        bf16x8 Qf[4];
#pragma unroll
        for (int ks = 0; ks < 4; ++ks) Qf[ks] = *(const bf16x8*)(QS + ((size_t)head * T + t) * 64 + 16 * ks + 8 * h);
        for (int u = F.tid; u < (NSA_UM + 16 - NSA_SCA) / 4; u += 512) ((LAS unsigned*)(lds + NSA_SCA))[u] = 0u;
        __syncthreads();
        f32x16 oacc[2];
#pragma unroll
        for (int ds = 0; ds < 2; ++ds)
#pragma unroll
            for (int i = 0; i < 16; ++i) oacc[ds][i] = 0.f;
        unsigned qsel[4] = {0u, 0u, 0u, 0u};
        float sc_cmp;
        PSTAMP(24);
        {
            const int ntile = (4 * cblk + 2) / 64 + 1;
            const unsigned long long cm0 = ntile >= 64 ? ~0ull : ((1ull << ntile) - 1ull);
            const int hi_cmp = t >= 31 ? (t - 31) / 16 : -1;
            const bf16* Kg = (const bf16*)(KWS + WS_KCB) + (size_t)g * 512 * 64; const bf16* VTg = (const bf16*)(KWS + WS_KCB + 131072) + (size_t)g * 64 * 512;
            float l1 = 0.f;
            nsa_branch<0>(F, Kg, VTg, 512, cm0, 0ull, Qf, t, cblk, qxw, tref, 0.f, qsel, hi_cmp, 0u, oacc, l1);
            l1 += __shfl_xor(l1, 32);
            const float inv_l = l1 > 0.f ? 1.0f / l1 : 0.f;
            float l2 = 0.f;
            nsa_branch<1>(F, Kg, VTg, 512, cm0, 0ull, Qf, t, cblk, qxw, tref, inv_l, qsel, hi_cmp, 0u, oacc, l2);
            sc_cmp = sigmoidf_(bf2f(P[(size_t)t * NPAD + C_NG + head])) * inv_l;
        }
        PSTAMP(20);
        {
            LAS float* scA = (LAS float*)(lds + NSA_SCA); LAS float* scB = (LAS float*)(lds + NSA_SCB);
            LAS unsigned* qm = (LAS unsigned*)(lds + NSA_QM); LAS unsigned* um = (LAS unsigned*)(lds + NSA_UM);
            WSYNC();
            const int qq = F.wave * 8 + (lane >> 3), jj = lane & 7;
            unsigned key[16];
#pragma unroll
            for (int m = 0; m < 16; ++m) { const int jb = jj + 8 * m; float sv = scA[qq * 132 + jb] + scB[qq * 132 + jb];
                if (jb == 0 || jb == cblk || jb == cblk - 1) sv = 1e4f;
                key[m] = jb <= cblk ? ((__builtin_bit_cast(unsigned, sv) & ~127u) | (unsigned)(127 - jb)) : 0u; }
            WSYNC();
#pragma unroll
            for (int m = 0; m < 16; ++m) ((LAS unsigned*)scA)[qq * 132 + jj + 8 * m] = key[m];
            WSYNC();
            unsigned bits[4] = {0u, 0u, 0u, 0u};
#pragma unroll
            for (int half = 0; half < 2; ++half) { int rank[8];
#pragma unroll
                for (int m = 0; m < 8; ++m) rank[m] = 0;
#pragma unroll 2
                for (int i = 0; i <= cblk; i += 4) { const u32x4 k4 = *(const LAS u32x4*)((const LAS unsigned*)scA + qq * 132 + i);
#pragma unroll
                    for (int m = 0; m < 8; ++m) rank[m] += (k4.x > key[8 * half + m] ? 1 : 0) + (k4.y > key[8 * half + m] ? 1 : 0) + (k4.z > key[8 * half + m] ? 1 : 0) + (k4.w > key[8 * half + m] ? 1 : 0); }
#pragma unroll
                for (int m = 0; m < 8; ++m) { const int jb = jj + 8 * (8 * half + m); if (jb <= cblk && rank[m] < 16) bits[(8 * half + m) >> 2] |= 1u << (jb & 31); } }
#pragma unroll
            for (int w = 0; w < 4; ++w) if (bits[w]) { atomicOr((unsigned*)(qm + qq * 4 + w), bits[w]); atomicOr((unsigned*)(um + w), bits[w]); }
            __syncthreads();
#pragma unroll
            for (int w = 0; w < 4; ++w) qsel[w] = qm[(F.wave * 8 + q8) * 4 + w];
        }
        PSTAMP(21);
        nsa_stash_put(lds, F.wave, lane, oacc, sc_cmp);
#pragma unroll
        for (int ds = 0; ds < 2; ++ds)
#pragma unroll
            for (int i = 0; i < 16; ++i) oacc[ds][i] = 0.f;
        {
            LAS unsigned* um = (LAS unsigned*)(lds + NSA_UM);
            const unsigned long long sm0 = (unsigned long long)__builtin_amdgcn_readfirstlane(um[0]) | ((unsigned long long)__builtin_amdgcn_readfirstlane(um[1]) << 32);
            const unsigned long long sm1 = (unsigned long long)__builtin_amdgcn_readfirstlane(um[2]) | ((unsigned long long)__builtin_amdgcn_readfirstlane(um[3]) << 32);
            float ls = 0.f;
            nsa_branch<2>(F, (const bf16*)(KWS + WS_KS2) + (size_t)g * T * 64, (const bf16*)(KWS + WS_VST) + (size_t)g * 64 * T, T, sm0, sm1, Qf, t, cblk, qxw, tref, 0.f, qsel, 0, 0u, oacc, ls);
            ls += __shfl_xor(ls, 32);
            const float sc = sigmoidf_(bf2f(P[(size_t)t * NPAD + C_NG + 8 + head])) / ls;
            LAS unsigned* st = (LAS unsigned*)(lds + NSA_SCA) + F.wave * 1024 + lane;
#pragma unroll
            for (int ds = 0; ds < 2; ++ds)
#pragma unroll
                for (int k = 0; k < 8; ++k) { const unsigned w = st[(ds * 8 + k) * 64]; st[(ds * 8 + k) * 64] = pkbf(bflo(w) + sc * oacc[ds][2 * k], bfhi(w) + sc * oacc[ds][2 * k + 1]); oacc[ds][2 * k] = 0.f; oacc[ds][2 * k + 1] = 0.f; }
        }
        PSTAMP(22);
        {
            const int j0 = cblk >= 8 ? cblk - 8 : 0;
            unsigned long long wm0 = 0ull, wm1 = 0ull;
            for (int jb = j0; jb <= cblk; ++jb) { if (jb < 64) wm0 |= 1ull << jb; else wm1 |= 1ull << (jb - 64); }
            float ls = 0.f;
            nsa_branch<3>(F, (const bf16*)(KWS + WS_KW2) + (size_t)g * T * 64, (const bf16*)(KWS + WS_VWT) + (size_t)g * 64 * T, T, wm0, wm1, Qf, t, cblk, qxw, tref, 0.f, qsel, 0, 0u, oacc, ls);
            ls += __shfl_xor(ls, 32);
            const float sc = sigmoidf_(bf2f(P[(size_t)t * NPAD + C_NG + 16 + head])) / ls;
            const LAS unsigned* st = (const LAS unsigned*)(lds + NSA_SCA) + F.wave * 1024 + lane;
#pragma unroll
            for (int ds = 0; ds < 2; ++ds)
#pragma unroll
                for (int g4 = 0; g4 < 4; ++g4) { const unsigned w0 = st[(ds * 8 + 2 * g4) * 64], w1 = st[(ds * 8 + 2 * g4 + 1) * 64];
                    u32x2 w; w.x = pkbf(bflo(w0) + sc * oacc[ds][4 * g4], bfhi(w0) + sc * oacc[ds][4 * g4 + 1]); w.y = pkbf(bflo(w1) + sc * oacc[ds][4 * g4 + 2], bfhi(w1) + sc * oacc[ds][4 * g4 + 3]);
                    *(u32x2*)(OCAT + (size_t)t * 1536 + head * 64 + 32 * ds + 8 * g4 + 4 * h) = w; }
        }
        __syncthreads();
        PSTAMP(23);
    }
}

__device__ __forceinline__ void phase_merge(Frame& F) {
    KA;
    const bf16* P = (const bf16*)(KWS + WS_P); const bf16* PROJ = (const bf16*)(KWS + WS_PROJ); bf16* MG = (bf16*)(KWS + WS_MERGED);
    const size_t total = (size_t)T * D / 8;
    for (size_t it = (size_t)F.gw * 64 + F.lane; it < total; it += (size_t)F.NGW * 64) {
        const size_t t = it / (D / 8); const int d = (int)(it % (D / 8)) * 8;
        float acc[8];
#pragma unroll
        for (int k = 0; k < 8; ++k) acc[k] = 0.f;
#pragma unroll
        for (int n = 0; n < 3; ++n) { const u32x4 gq = *(const u32x4*)(P + t * NPAD + C_MG + n * D + d); const u32x4 pq = *(const u32x4*)(PROJ + ((size_t)n * T + t) * D + d);
            acc[0] += sigmoidf_(bflo(gq.x)) * bflo(pq.x); acc[1] += sigmoidf_(bfhi(gq.x)) * bfhi(pq.x); acc[2] += sigmoidf_(bflo(gq.y)) * bflo(pq.y); acc[3] += sigmoidf_(bfhi(gq.y)) * bfhi(pq.y);
            acc[4] += sigmoidf_(bflo(gq.z)) * bflo(pq.z); acc[5] += sigmoidf_(bfhi(gq.z)) * bfhi(pq.z); acc[6] += sigmoidf_(bflo(gq.w)) * bflo(pq.w); acc[7] += sigmoidf_(bfhi(gq.w)) * bfhi(pq.w); }
        u32x4 o; o.x = pk2(acc[0], acc[1]); o.y = pk2(acc[2], acc[3]); o.z = pk2(acc[4], acc[5]); o.w = pk2(acc[6], acc[7]);
        *(u32x4*)(MG + t * D + d) = o;
    }
}
__device__ __forceinline__ void phase_router(Frame& F, int l) {
    KA;
    const float* X1 = (const float*)(KWS + WS_X1); bf16* H = (bf16*)(KWS + WS_H);
    int* EID = (int*)(KWS + WS_ROUTE); float* EW = (float*)(KWS + WS_ROUTE + 65536);
    const float* gain = KIN(I_NFFN) + (size_t)l * D; const float* wg = KIN(I_WGRP) + (size_t)l * D * 4; const float* we = KIN(I_WEXP) + (size_t)l * D * 32;
    const float* bg = KIN(I_BGRP) + l * 4; const float* be = KIN(I_BEXP) + l * 32;
    for (int t = F.gw; t < T; t += F.NGW) {
        const float* xrow = X1 + (size_t)t * D;
        float ss = 0.f;
#pragma unroll 4
        for (int k = 0; k < 32; ++k) { const float x = xrow[F.lane + 64 * k]; ss += x * x; }
        const float rstd = 1.0f / sqrtf(wave_sum(ss) * (1.0f / D) + EPS);
        float ag[4] = {0.f, 0.f, 0.f, 0.f}, ae[32];
#pragma unroll
        for (int e = 0; e < 32; ++e) ae[e] = 0.f;
#pragma unroll 1
        for (int k = 0; k < 32; ++k) { const int d = F.lane + 64 * k;
            const float hv = xrow[d] * rstd * gain[d];
            H[(size_t)t * D + d] = (bf16)f2bf(hv);
            const f32x4 w4 = *(const f32x4*)(wg + (size_t)d * 4);
            ag[0] += hv * w4.x; ag[1] += hv * w4.y; ag[2] += hv * w4.z; ag[3] += hv * w4.w;
#pragma unroll
            for (int c = 0; c < 8; ++c) { const f32x4 w = *(const f32x4*)(we + (size_t)d * 32 + c * 4); ae[c * 4] += hv * w.x; ae[c * 4 + 1] += hv * w.y; ae[c * 4 + 2] += hv * w.z; ae[c * 4 + 3] += hv * w.w; } }
#pragma unroll
        for (int e = 0; e < 4; ++e) ag[e] = wave_sum(ag[e]) + bg[e];
#pragma unroll
        for (int e = 0; e < 32; ++e) ae[e] = wave_sum(ae[e]) + be[e];
        int gi = 0; float gm = ag[0];
#pragma unroll
        for (int e = 1; e < 4; ++e) if (ag[e] > gm) { gm = ag[e]; gi = e; }
        float gs = 0.f;
#pragma unroll
        for (int e = 0; e < 4; ++e) gs += expf(ag[e] - gm);
        const float gw_ = 1.0f / gs;
        float el[8];
#pragma unroll
        for (int e = 0; e < 8; ++e) { el[e] = gi == 0 ? ae[e] : (gi == 1 ? ae[8 + e] : (gi == 2 ? ae[16 + e] : ae[24 + e])); }
        int i1 = 0; float m1 = el[0];
#pragma unroll
        for (int e = 1; e < 8; ++e) if (el[e] > m1) { m1 = el[e]; i1 = e; }
        int i2 = -1; float m2 = -3.0e38f;
#pragma unroll
        for (int e = 0; e < 8; ++e) if (e != i1 && el[e] > m2) { m2 = el[e]; i2 = e; }
        const float p2 = expf(m2 - m1);
        const float w1 = 1.0f / (1.0f + p2), w2 = p2 / (1.0f + p2);
        if (F.lane == 0) { EID[2 * t] = gi * 8 + i1; EID[2 * t + 1] = gi * 8 + i2; EW[2 * t] = gw_ * w1; EW[2 * t + 1] = gw_ * w2; }
    }
}

__device__ __forceinline__ void phase_router3(Frame& F, int l) {
    KA;
    const float* X1 = (const float*)(KWS + WS_X1); bf16* H = (bf16*)(KWS + WS_H);
    int* EID = (int*)(KWS + WS_ROUTE); float* EW = (float*)(KWS + WS_ROUTE + 65536); float* RSTD = (float*)(KWS + WS_RSTD);
    unsigned* CNTg = (unsigned*)(KWS + WS_CTL) + CW_CNT + 64 * l; int* LIST = (int*)(KWS + WS_ROUTE + 262144);
    const float* WRT = (const float*)(KWS + WS_WRT) + (size_t)l * 48 * D;
    const float* gain = KIN(I_NFFN) + (size_t)l * D; const float* bg = KIN(I_BGRP) + l * 4; const float* be = KIN(I_BEXP) + l * 32;
    LAS float* red = (LAS float*)F.lds;
    LAS float* ssq = (LAS float*)(F.lds + 49152);
    LAS float* lg = (LAS float*)(F.lds + 50176);
    LAS float* rs = (LAS float*)(F.lds + 55296);
    LAS int* eidl = (LAS int*)(F.lds + 55424);
    const int r16 = F.lane & 15, kq = F.lane >> 4;
    for (int blk = F.bid; blk < T / 32; blk += F.G) {
        const int tok0 = blk * 32, kb0 = F.wave * 256 + 4 * kq;
        const float* xa = X1 + (size_t)(tok0 + r16) * D + kb0;
        const float* wb = WRT + (size_t)r16 * D + kb0;
        bf16* hp = H + (size_t)(tok0 + r16) * D + kb0;
        f32x4 acc[2][3]; float sq[2] = {0.f, 0.f};
#pragma unroll
        for (int tg = 0; tg < 2; ++tg)
#pragma unroll
            for (int nt = 0; nt < 3; ++nt) acc[tg][nt] = (f32x4){0.f, 0.f, 0.f, 0.f};
#pragma unroll 2
        for (int s = 0; s < 16; ++s) { f32x4 a[2], b[3];
#pragma unroll
            for (int tg = 0; tg < 2; ++tg) a[tg] = *(const f32x4*)(xa + (size_t)(16 * tg) * D + 16 * s);
#pragma unroll
            for (int nt = 0; nt < 3; ++nt) b[nt] = *(const f32x4*)(wb + (size_t)(16 * nt) * D + 16 * s);
            const f32x4 g = *(const f32x4*)(gain + kb0 + 16 * s);
#pragma unroll
            for (int tg = 0; tg < 2; ++tg) { sq[tg] += a[tg].x * a[tg].x + a[tg].y * a[tg].y + a[tg].z * a[tg].z + a[tg].w * a[tg].w;
                u32x2 o; o.x = pkbf(a[tg].x * g.x, a[tg].y * g.y); o.y = pkbf(a[tg].z * g.z, a[tg].w * g.w);
                *(u32x2*)(hp + (size_t)(16 * tg) * D + 16 * s) = o;
#pragma unroll
                for (int j = 0; j < 4; ++j)
#pragma unroll
                    for (int nt = 0; nt < 3; ++nt) acc[tg][nt] = __builtin_amdgcn_mfma_f32_16x16x4f32(a[tg][j], b[nt][j], acc[tg][nt], 0, 0, 0); } }
#pragma unroll
        for (int tg = 0; tg < 2; ++tg) { sq[tg] += __shfl_xor(sq[tg], 16); sq[tg] += __shfl_xor(sq[tg], 32);
            if (kq == 0) ssq[F.wave * 32 + 16 * tg + r16] = sq[tg];
#pragma unroll
            for (int nt = 0; nt < 3; ++nt) *(LAS f32x4*)(red + (((F.wave * 2 + tg) * 3 + nt) * 64 + F.lane) * 4) = acc[tg][nt]; }
        __syncthreads();
        if (F.tid < 384) { const int tg2 = F.tid / 192, rem = F.tid % 192, nt = rem / 64, ln = rem % 64; f32x4 v = {0.f, 0.f, 0.f, 0.f};
#pragma unroll
            for (int w = 0; w < 8; ++w) v += *(const LAS f32x4*)(red + (((w * 2 + tg2) * 3 + nt) * 64 + ln) * 4);
            const int col = 16 * nt + (ln & 15);
            if (col < 36) {
#pragma unroll
                for (int i = 0; i < 4; ++i) lg[(16 * tg2 + 4 * (ln >> 4) + i) * 40 + col] = v[i]; } }
        if (F.tid >= 384 && F.tid < 416) { const int tk = F.tid - 384; float q2 = 0.f;
#pragma unroll
            for (int w = 0; w < 8; ++w) q2 += ssq[w * 32 + tk];
            const float r = 1.0f / sqrtf(q2 * (1.0f / D) + EPS); rs[tk] = r; RSTD[tok0 + tk] = r; }
        __syncthreads();
        if (F.tid < 32) { const int tk = F.tid, t = tok0 + tk; const float rstd = rs[tk];
            float ag[4], el[8];
#pragma unroll
            for (int e = 0; e < 4; ++e) ag[e] = lg[tk * 40 + 32 + e] * rstd + bg[e];
            int gi = 0; float gm = ag[0];
#pragma unroll
            for (int e = 1; e < 4; ++e) if (ag[e] > gm) { gm = ag[e]; gi = e; }
            float gs = 0.f;
#pragma unroll
            for (int e = 0; e < 4; ++e) gs += expf(ag[e] - gm);
            const float gw_ = 1.0f / gs;
#pragma unroll
            for (int e = 0; e < 8; ++e) el[e] = lg[tk * 40 + gi * 8 + e] * rstd + be[gi * 8 + e];
            int i1 = 0; float m1 = el[0];
#pragma unroll
            for (int e = 1; e < 8; ++e) if (el[e] > m1) { m1 = el[e]; i1 = e; }
            int i2 = -1; float m2 = -3.0e38f;
#pragma unroll
            for (int e = 0; e < 8; ++e) if (e != i1 && el[e] > m2) { m2 = el[e]; i2 = e; }
            const float p2 = expf(m2 - m1), w1 = 1.0f / (1.0f + p2), w2 = p2 / (1.0f + p2);
            EID[2 * t] = gi * 8 + i1; EID[2 * t + 1] = gi * 8 + i2; EW[2 * t] = gw_ * w1; EW[2 * t + 1] = gw_ * w2;
            eidl[2 * tk] = gi * 8 + i1; eidl[2 * tk + 1] = gi * 8 + i2; }
        __syncthreads();
        LAS int* base = eidl + 64;
        if (F.tid < 32) { int c = 0;
#pragma unroll 8
            for (int i = 0; i < 64; ++i) c += eidl[i] == F.tid ? 1 : 0;
            base[F.tid] = c > 0 ? (int)__hip_atomic_fetch_add(CNTg + F.tid, (unsigned)c, __ATOMIC_RELAXED, __HIP_MEMORY_SCOPE_AGENT) : 0; }
        __syncthreads();
        if (F.tid < 64) { const int e = eidl[F.tid]; int rk = 0;
            for (int i = 0; i < F.tid; ++i) rk += eidl[i] == e ? 1 : 0;
            LIST[e * 8192 + base[e] + rk] = blk * 64 + F.tid; }
        __syncthreads();
    }
}
__device__ __forceinline__ void phase_lists2(Frame& F) {
    KA;
    const int* EID = (const int*)(KWS + WS_ROUTE); int* CNT = (int*)(KWS + WS_ROUTE + 131072); int* LIST = (int*)(KWS + WS_ROUTE + 262144); const int* HIST = (const int*)(KWS + WS_HIST);
    LAS int* off = (LAS int*)F.lds; LAS int* eidl = off + 32; LAS int* psum = off + 128;
    for (int blk = F.bid; blk < T / 32; blk += F.G) {
        { const int e = F.tid & 31, part = F.tid >> 5; int a = 0;
#pragma unroll 4
          for (int b2 = part; b2 < blk; b2 += 16) a += HIST[b2 * 32 + e];
          psum[part * 32 + e] = a; }
        __syncthreads();
        if (F.tid < 32) { int a = 0;
#pragma unroll
            for (int p = 0; p < 16; ++p) a += psum[p * 32 + F.tid];
            off[F.tid] = a;
            if (blk == T / 32 - 1) CNT[F.tid] = a + HIST[blk * 32 + F.tid]; }
        if (F.tid >= 64 && F.tid < 128) eidl[F.tid - 64] = EID[blk * 64 + F.tid - 64];
        __syncthreads();
        if (F.tid < 64) { const int e = eidl[F.tid]; int rk = 0;
            for (int i = 0; i < F.tid; ++i) rk += eidl[i] == e ? 1 : 0;
            LIST[e * 8192 + off[e] + rk] = blk * 64 + F.tid; }
        __syncthreads();
    }
}

__device__ __forceinline__ void phase_lists(Frame& F) {
    KA;
    const int e = F.bid;
    if (e >= NE) return;
    const int* EID = (const int*)(KWS + WS_ROUTE); int* CNT = (int*)(KWS + WS_ROUTE + 131072); int* LIST = (int*)(KWS + WS_ROUTE + 262144);
    LAS int* wc = (LAS int*)F.lds;
    int run = 0;
    for (int base = 0; base < 2 * T; base += 512) {
        const int idx = base + F.tid; const bool match = EID[idx] == e;
        const unsigned long long b = __ballot(match);
        if (F.lane == 0) wc[F.wave] = __popcll(b);
        __syncthreads();
        int pre = 0, tot = 0;
#pragma unroll
        for (int w = 0; w < 8; ++w) { const int c = wc[w]; pre += w < F.wave ? c : 0; tot += c; }
        if (match) LIST[e * 8192 + run + pre + __popcll(b & ((1ull << F.lane) - 1ull))] = idx;
        run += tot;
        __syncthreads();
    }
    if (F.tid == 0) CNT[e] = run;
}
__device__ __forceinline__ void moe_table(Frame& F, LAS int* tb, int l) {
    KA;
    const int* CNT = (const int*)(KWS + WS_CTL) + CW_CNT + 64 * l;
    if (F.tid == 0) { int a = 0, f = 0, h = 0;
        for (int e = 0; e < NE; ++e) { const int n = CNT[e], nt = (n + 255) / 256, lastv = n - (nt - 1) * 256, hh = (nt > 0 && lastv <= 128) ? 1 : 0;
            tb[e] = a; tb[33 + e] = f; tb[66 + e] = h; a += nt; f += nt - hh; h += hh; }
        tb[NE] = a; tb[33 + NE] = f; tb[66 + NE] = h; }
    __syncthreads();
}

constexpr int PH_PER_LAYER = 7, N_PHASES = 1 + NL * PH_PER_LAYER + 1;

__global__ void __launch_bounds__(512, 2) mk_fwd(Args args) {
    extern __shared__ __attribute__((aligned(16))) unsigned char lds_raw[];
#define FRAME Frame F; F.lds = (LAS unsigned char*)lds_raw; F.MISC = (volatile LAS unsigned*)(F.lds + MISC_OFF); F.tid = ltid(); F.lane = F.tid & 63; F.wave = __builtin_amdgcn_readfirstlane(F.tid >> 6); \
    F.G = gridDim.x; F.bid = lbid(); F.vcu = (F.G % 8 == 0) ? (F.bid % 8) * (F.G / 8) + F.bid / 8 : F.bid; F.gw = F.bid * 8 + F.wave; F.NGW = F.G * 8;
    unsigned* const ctl = (unsigned*)((unsigned char*)args.ws + WS_CTL);
    for (int u = threadIdx.x; u < (LDS_BYTES - MISC_OFF) / 4; u += 512) ((LAS unsigned*)(lds_raw + MISC_OFF))[u] = 0u;
    __syncthreads();
    const int lo = args.ph_lo, hi = args.ph_hi;
    XcdBarrier bar; bar.bar = ctl + CW_BAR + args.li * XCD_BAR_WORDS; bar.x = 0; bar.st = nullptr;
    if (hi - lo > 1) bar = xcd_barrier_post(ctl + CW_BAR + args.li * XCD_BAR_WORDS, (volatile LAS unsigned*)((LAS unsigned char*)lds_raw + MISC_OFF));
    int ph = 0;
#define RUN(k) ((k) >= lo && (k) < hi)

    volatile LAS unsigned long long* const tacc = (volatile LAS unsigned long long*)((LAS unsigned char*)lds_raw + MISC_OFF + 512);
    if (MK_PROBE_MASK != 0 && blockIdx.x == MK_PROBE_BID && threadIdx.x == 0) tacc[16] = wall_clock64();
#define STAMP(slot) do { if (MK_PROBE_MASK != 0 && lbid() == MK_PROBE_BID && ltid() == 0) { const unsigned long long _n = wall_clock64(); tacc[slot] += _n - tacc[16]; tacc[16] = _n; } } while (0)
#define SEAM(k, slot) do { if ((k) + 1 < hi) xcd_barrier(bar); STAMP(slot); } while (0)
    LAS int* const tb = (LAS int*)((LAS unsigned char*)lds_raw + MISC_OFF + 64);

    if (RUN(ph)) { KA; FRAME; phase_prologue(F); phase_norm1<0>(F, KIN(I_X), nullptr, nullptr, KIN(I_NMIX), (bf16*)(KWS + WS_H)); SEAM(ph, 0); }
    ++ph;
    for (int l = 0; l < NL; ++l) {
        if (RUN(ph)) { KA; FRAME; pg8::PlainSched S; S.init((const bf16*)(KWS + WS_H), D, (const bf16*)(KWS + WS_WIN) + (size_t)l * NPAD * D, T, NPAD, D, F.G, F.bid, 4); S.probe = 1;
            pg8::EpiBf16 E{(bf16*)(KWS + WS_P), NPAD};
            pg8::gemm_phase<pg8::EpiBf16, pg8::PlainSched, true>(F.lds, D, S, E); SEAM(ph, 1); }
        ++ph;
        if (RUN(ph)) { KA; FRAME; phase_prep3(F, l); __syncthreads(); phase_compress3(F, l); phase_rec_local(F, l); SEAM(ph, 3); }
        ++ph;
        if (RUN(ph)) { KA; FRAME; if (F.bid < 96) { phase_rec_scan(F);
                asm volatile("s_waitcnt vmcnt(0)" ::: "memory"); __syncthreads();
                if (F.tid == 0) { __builtin_amdgcn_fence(__ATOMIC_RELEASE, "agent"); asm volatile("s_waitcnt vmcnt(0)" ::: "memory");
                    __hip_atomic_fetch_add((unsigned*)(KWS + WS_CTL) + 2048 + 64 * (4 + l), 1u, __ATOMIC_RELAXED, __HIP_MEMORY_SCOPE_AGENT); } }
            phase_nsa2(F, l); phase_rec_out(F, l); SEAM(ph, 5); }
        ++ph;
        if (RUN(ph)) { KA; FRAME;
            { pg8::BranchSched S; S.init((const bf16*)(KWS + WS_OCAT), (const bf16*)(KWS + WS_WBR) + (size_t)l * 3 * D * 512, F.G, F.bid);
              pg8::EpiMerge E{(bf16*)(KWS + WS_MERGED), (const bf16*)(KWS + WS_P) + C_MG};
              pg8::gemm_phase<pg8::EpiMerge, pg8::BranchSched, true>(F.lds, 512, S, E); }
            SEAM(ph, 6); }
        ++ph;

        if (RUN(ph)) { KA; FRAME; pg8::PlainSched S; S.init((const bf16*)(KWS + WS_MERGED), D, (const bf16*)(KWS + WS_WOUT) + (size_t)l * D * D, T, D, D, F.G, F.bid);
            pg8::EpiResF32 E{l == 0 ? KIN(I_X) : (const float*)(KWS + WS_XRES), (float*)(KWS + WS_X1), D};
            pg8::gemm_phase<pg8::EpiResF32, pg8::PlainSched, false>(F.lds, D, S, E); SEAM(ph, 8); }
        ++ph;
        if (RUN(ph)) { KA; FRAME; phase_router3(F, l); SEAM(ph, 9); }
        ++ph;
        if (RUN(ph)) { KA; FRAME; moe_table(F, tb, l);
            unsigned* tilecnt = (unsigned*)(KWS + WS_CTL) + 131072 + (size_t)l * 128 * 64;
            { pg8::MoeSched<1> S; S.init(F.G, F.vcu, tb, (const int*)(KWS + WS_CTL) + CW_CNT + 64 * l, (const int*)(KWS + WS_ROUTE + 262144), KWS + WS_H, (const bf16*)(KWS + WS_WGU) + (size_t)l * NE * 1024 * D);
              S.tilecnt = tilecnt; S.tick = nullptr; S.tslot = nullptr; S.myticket = 0;
              pg8::EpiMoe1 E{(bf16*)(KWS + WS_ACT), (const int*)(KWS + WS_ROUTE + 262144), (const float*)(KWS + WS_ROUTE + 65536), (const float*)(KWS + WS_RSTD)};
              pg8::gemm_phase<pg8::EpiMoe1, pg8::MoeSched<1>, true>(F.lds, D, S, E); }
            __syncthreads();
            { pg8::MoeSched<2> S; S.init(F.G, F.vcu, tb, (const int*)(KWS + WS_CTL) + CW_CNT + 64 * l, (const int*)(KWS + WS_ROUTE + 262144), KWS + WS_ACT, (const bf16*)(KWS + WS_WDN) + (size_t)l * NE * D * FF);
              S.tilecnt = tilecnt; S.tick = (unsigned*)(KWS + WS_CTL) + 2048 + 64 * (6 + l); S.tslot = (volatile LAS int*)(F.lds + MISC_OFF + 1028); S.myticket = 0;
              pg8::EpiMoe2 E{(bf16*)(KWS + WS_CONTRIB), (const int*)(KWS + WS_ROUTE + 262144)};
              pg8::gemm_phase<pg8::EpiMoe2, pg8::MoeSched<2>, true>(F.lds, FF, S, E); }
            SEAM(ph, 12); }
        ++ph;
        if (l + 1 < NL) { if (RUN(ph)) { KA; FRAME; phase_norm1<1>(F, (const float*)(KWS + WS_X1), (const bf16*)(KWS + WS_CONTRIB), (float*)(KWS + WS_XRES), KIN(I_NMIX) + (size_t)(l + 1) * D, (bf16*)(KWS + WS_H)); SEAM(ph, 13); } ++ph; }
    }
    if (RUN(ph)) { KA; FRAME; phase_norm1<2>(F, (const float*)(KWS + WS_X1), (const bf16*)(KWS + WS_CONTRIB), KOUT, nullptr, nullptr); }
    if (MK_PROBE_MASK != 0 && lbid() == MK_PROBE_BID && ltid() == 0) {
        asm volatile("s_waitcnt vmcnt(0)" ::: "memory"); STAMP(15);
        unsigned long long tot = 0ull;
        for (int k2 = 0; k2 < 32; ++k2) if (k2 != 16 && ((MK_PROBE_MASK >> k2) & 1)) tot += tacc[k2];
        const unsigned long long t_end = wall_clock64() + 4ull * tot;
        while (wall_clock64() < t_end) __builtin_amdgcn_s_sleep(8);
    }
#undef RUN
#undef SEAM
}

#ifndef MK_PER_PHASE
#define MK_PER_PHASE 0
#endif
extern "C" void kernel_launch(void* const* d_in, const int* in_sizes, int n_in, void* d_out, int out_size, void* d_ws, size_t ws_size, hipStream_t stream) {
    static int grid = 0;
    if (grid == 0) {
        if (n_in != 22 || out_size != T * D || ws_size < WS_END) { fprintf(stderr, "kernel_launch: unexpected sizes (n_in %d out %d ws %zu)\n", n_in, out_size, ws_size); grid = -1; return; }
        int dev = 0, cus = 0, per_cu = 0;
        if (hipGetDevice(&dev) != hipSuccess || hipDeviceGetAttribute(&cus, hipDeviceAttributeMultiprocessorCount, dev) != hipSuccess) { grid = -1; return; }
        if (hipFuncSetAttribute((const void*)mk_fwd, hipFuncAttributeMaxDynamicSharedMemorySize, LDS_BYTES) != hipSuccess) { fprintf(stderr, "kernel_launch: hipFuncSetAttribute failed\n"); grid = -1; return; }
        if (hipOccupancyMaxActiveBlocksPerMultiprocessor(&per_cu, (const void*)mk_fwd, 512, LDS_BYTES) != hipSuccess || per_cu < 1) { fprintf(stderr, "kernel_launch: occupancy query says %d\n", per_cu); }
        (void)hipGetLastError();
        grid = cus;
    }
    if (grid < 0) return;
    if (hipMemsetAsync((char*)d_ws + WS_CTL, 0, CTL_ZERO_BYTES, stream) != hipSuccess) return;
    Args a{};
    for (int i = 0; i < 22; ++i) a.in[i] = (const GAS float*)d_in[i];
    a.out = (GAS float*)d_out; a.ws = (GAS unsigned char*)d_ws;
#if MK_PER_PHASE
    const int total = 1 + NL * PH_PER_LAYER + (NL - 1) + 1;
    for (int k = 0; k < total; ++k) { a.ph_lo = k; a.ph_hi = k + 1; a.li = 0; hipLaunchKernelGGL(mk_fwd, dim3(grid), dim3(512), LDS_BYTES, stream, a); }
#else
    a.ph_lo = 0; a.ph_hi = 1000; a.li = 0;
    hipLaunchKernelGGL(mk_fwd, dim3(grid), dim3(512), LDS_BYTES, stream, a);
#endif
    const hipError_t le = hipPeekAtLastError();
    if (le != hipSuccess) fprintf(stderr, "kernel_launch: launch failed: %s\n", hipGetErrorName(le));
}
```

```cpp
#include <hip/hip_runtime.h>
#include <cstdio>
#include <cstdint>

#ifndef MK_PROBE_MASK
#define MK_PROBE_MASK 0
#endif
#ifndef MK_PROBE_BID
#define MK_PROBE_BID 0
#endif
#define GAS __attribute__((address_space(1)))
#define LAS __attribute__((address_space(3)))
typedef unsigned short bf16;
typedef short bf16x8 __attribute__((ext_vector_type(8)));
typedef float f32x4 __attribute__((ext_vector_type(4)));
typedef float f32x2 __attribute__((ext_vector_type(2)));
typedef unsigned u32x4 __attribute__((ext_vector_type(4)));
typedef unsigned u32x2 __attribute__((ext_vector_type(2)));
typedef long i64x2 __attribute__((ext_vector_type(2)));

constexpr int T = 8192, D = 2048, NL = 2, INC = 11048, NPAD = 11264;
constexpr int NE = 32, FF = 512, NCH = T / 64;
constexpr float EPS = 1e-6f, NEGB = -1e30f;
constexpr int C_Q = 0, C_KC = 512, C_VC = 640, C_KS = 768, C_VS = 896, C_KW = 1024, C_VW = 1152;
constexpr int C_HQ = 1280, C_HF = 1792, C_HI = 2304, C_HG = 2816, C_GQ = 3328, C_GK = 3584, C_GV = 3840, C_GR = 4352;
constexpr int C_MG = 4864, C_NG = 11008, C_GA = 11032;

constexpr size_t MiB = 1u << 20;
constexpr size_t WS_CTL = 0, CTL_ZERO_BYTES = 1 * MiB;
constexpr size_t WS_WIN = 2 * MiB;
constexpr size_t WS_WBR = 90 * MiB;
constexpr size_t WS_WOUT = 102 * MiB;
constexpr size_t WS_WGU = 118 * MiB;
constexpr size_t WS_WDN = 374 * MiB;
constexpr size_t WS_H = 502 * MiB;
constexpr size_t WS_P = 534 * MiB;
constexpr size_t WS_OCAT = 710 * MiB;
constexpr size_t WS_PROJ = 734 * MiB;
constexpr size_t WS_MERGED = 830 * MiB;
constexpr size_t WS_X1 = 862 * MiB;
constexpr size_t WS_XRES = 926 * MiB;
constexpr size_t WS_CONTRIB = 990 * MiB;
constexpr size_t WS_ACT = 1054 * MiB;
constexpr size_t WS_QN = 1078 * MiB;
constexpr size_t WS_KV = 1094 * MiB;
constexpr size_t WS_KC = 1118 * MiB;
constexpr size_t WS_ORAW = 1119 * MiB;
constexpr size_t WS_ROUTE = 1151 * MiB;
constexpr size_t WS_SLOC_HG = 1153 * MiB;
constexpr size_t WS_SLOC_GL = 1185 * MiB;
constexpr size_t WS_SPREV_HG = 1201 * MiB;
constexpr size_t WS_SPREV_GL = 1217 * MiB;
constexpr size_t WS_DEC = 1225 * MiB;
constexpr size_t WS_QS = 1226 * MiB;
constexpr size_t WS_KS2 = 1234 * MiB;
constexpr size_t WS_KW2 = 1236 * MiB;
constexpr size_t WS_VST = 1238 * MiB;
constexpr size_t WS_VWT = 1240 * MiB;
constexpr size_t WS_KCB = 1242 * MiB;
constexpr size_t WS_WRT = 1243 * MiB;
constexpr size_t WS_HIST = 1244 * MiB;
constexpr size_t WS_CW = 1245 * MiB;
constexpr size_t WS_H8 = 1248 * MiB;
constexpr size_t WS_RSTD = 1247 * MiB;
constexpr size_t WS_WIN8 = 1264 * MiB;
constexpr size_t WS_END = 1288 * MiB;
constexpr size_t KV_STRIDE = (size_t)2 * T * 64;
constexpr int CW_BAR = 4096;
constexpr int CW_CNT = 3072;

constexpr int RING_BYTES = 131072;
constexpr int LDS_BYTES = 147456;
constexpr int MISC_OFF = LDS_BYTES - 2048;

#define LDS_WAIT() asm volatile("s_waitcnt lgkmcnt(0)" ::: "memory")
#define VM_WAIT() asm volatile("s_waitcnt vmcnt(0)" ::: "memory")
#define WSYNC() asm volatile("s_waitcnt lgkmcnt(0)" ::: "memory")

__device__ __forceinline__ unsigned f2bf(float f) { unsigned u = __builtin_bit_cast(unsigned, f); return (u + 0x7fffu + ((u >> 16) & 1u)) >> 16; }
__device__ __forceinline__ unsigned pk2(float lo, float hi) { return f2bf(lo) | (f2bf(hi) << 16); }
__device__ __forceinline__ float bf2f(unsigned b) { return __builtin_bit_cast(float, (b & 0xffffu) << 16); }
__device__ __forceinline__ float bflo(unsigned w) { return __builtin_bit_cast(float, w << 16); }
__device__ __forceinline__ float bfhi(unsigned w) { return __builtin_bit_cast(float, w & 0xffff0000u); }
__device__ __forceinline__ float wave_sum(float v) {
#pragma unroll
    for (int o = 1; o < 64; o <<= 1) v += __shfl_xor(v, o);
    return v;
}
__device__ __forceinline__ float wave_max(float v) {
#pragma unroll
    for (int o = 1; o < 64; o <<= 1) v = fmaxf(v, __shfl_xor(v, o));
    return v;
}
__device__ __forceinline__ int ltid() { int t = threadIdx.x; asm volatile("" : "+v"(t)); return t; }
__device__ __forceinline__ int lbid() { int b = blockIdx.x; asm volatile("" : "+s"(b)); return b; }
constexpr float S_A1 = 16.f, S_W1 = 1024.f, S_ACT = 8.f, S_W2 = 512.f, S_H = 16.f, S_WG = 1024.f;
__device__ __forceinline__ float clamp8(float v) { return fminf(fmaxf(v, -224.f), 224.f); }
__device__ __forceinline__ unsigned pk4_fp8(float a, float b, float c, float d) { int w = __builtin_amdgcn_cvt_pk_fp8_f32(clamp8(a), clamp8(b), 0, false); w = __builtin_amdgcn_cvt_pk_fp8_f32(clamp8(c), clamp8(d), w, true); return (unsigned)w; }
typedef __bf16 bf16x2_t __attribute__((ext_vector_type(2)));
__device__ __forceinline__ unsigned pkbf(float lo, float hi) { const f32x2 v = {lo, hi}; return __builtin_bit_cast(unsigned, __builtin_convertvector(v, bf16x2_t)); }
constexpr float LOG2E = 1.4426950408889634f;
__device__ __forceinline__ float sigmoidf_(float x) { return 1.0f / (1.0f + expf(-x)); }
__device__ __forceinline__ float fsig(float x) { return __builtin_amdgcn_rcpf(1.0f + __builtin_amdgcn_exp2f(-LOG2E * x)); }

#define GSTAMP(lds_, slot) do { if (MK_PROBE_MASK != 0 && lbid() == MK_PROBE_BID && ltid() == 0) { volatile LAS unsigned long long* _ta = (volatile LAS unsigned long long*)((lds_) + MISC_OFF + 512); const unsigned long long _n = wall_clock64(); _ta[slot] += _n - _ta[16]; _ta[16] = _n; } } while (0)
#define XB_TMO      128
#define XB_XCNT(j)  (256  + 64 * (j))
#define XB_XSUB(j)  (1280 + 64 * (j))
#define XB_XGEN(j)  (2304 + 64 * (j))
#define XB_TOP      3328
#define XB_TOPGEN   3392
#define XCD_BAR_WORDS 3456
#define XB_SPIN_CAP (1u << 25)

__device__ __forceinline__ unsigned xb_ld(unsigned* p)              { return __hip_atomic_load(p, __ATOMIC_RELAXED, __HIP_MEMORY_SCOPE_AGENT); }
__device__ __forceinline__ unsigned xb_add(unsigned* p, unsigned v) { return __hip_atomic_fetch_add(p, v, __ATOMIC_RELAXED, __HIP_MEMORY_SCOPE_AGENT); }
__device__ __forceinline__ unsigned xb_xcc_id() { return (unsigned)__builtin_amdgcn_s_getreg((3 << 11) | 20) & 0xFu; }
#define XB_SPIN(cond, bar) do { unsigned _sp = 0; while (cond) { __builtin_amdgcn_s_sleep(1); \
    if ((++_sp & 255u) == 0u) { if (xb_ld(&(bar)[XB_TMO])) break; if (_sp > XB_SPIN_CAP) { atomicAdd(&(bar)[XB_TMO], 1u); break; } } } } while (0)

struct XcdBarrier { unsigned* bar; unsigned x; volatile LAS unsigned* st; };

__device__ __forceinline__ XcdBarrier xcd_barrier_post(unsigned* bar, volatile LAS unsigned* st) {
    XcdBarrier b; b.bar = bar; b.x = xb_xcc_id(); b.st = st;
    if (threadIdx.x == 0) (void)xb_add(&bar[XB_XCNT(b.x)], 1u);
    return b;
}
__device__ __forceinline__ void xcd_barrier_complete(unsigned* bar, unsigned x, unsigned& nloc, unsigned& nx) {
    const unsigned G = gridDim.x * gridDim.y * gridDim.z;
    unsigned sum, cnt, mine, sp = 0u;
    for (;;) {
        sum = 0u; cnt = 0u; mine = 0u;
#pragma unroll
        for (unsigned j = 0; j < 16; ++j) { const unsigned c = xb_ld(&bar[XB_XCNT(j)]); sum += c; cnt += (c > 0u) ? 1u : 0u; mine = (j == x) ? c : mine; }
        if (sum == G) break;
        __builtin_amdgcn_s_sleep(1);
        if ((++sp & 255u) == 0u) { if (xb_ld(&bar[XB_TMO])) break; if (sp > XB_SPIN_CAP) { atomicAdd(&bar[XB_TMO], 1u); break; } }
    }
    nloc = mine > 0u ? mine : 1u; nx = cnt > 0u ? cnt : 1u;
}
__device__ __forceinline__ void xcd_barrier(const XcdBarrier& b) {
    asm volatile("s_waitcnt vmcnt(0)" ::: "memory");
    __syncthreads();
    if (threadIdx.x == 0) {
        unsigned* bar = b.bar;
        __builtin_amdgcn_s_waitcnt(0);
        unsigned nloc = b.st[0], nx = b.st[1];
        if (nloc == 0u) { xcd_barrier_complete(bar, b.x, nloc, nx); b.st[0] = nloc; b.st[1] = nx; }
        const unsigned old = xb_add(&bar[XB_XSUB(b.x)], 1u);
        const unsigned gen = old / nloc;
        if (old + 1u == (gen + 1u) * nloc) {
            __builtin_amdgcn_fence(__ATOMIC_RELEASE, "agent");
            asm volatile("s_waitcnt vmcnt(0)" ::: "memory");
            const unsigned og = xb_add(&bar[XB_TOP], 1u);
            const unsigned tg = og / nx;
            if (og + 1u == (tg + 1u) * nx) xb_add(&bar[XB_TOPGEN], 1u);
            else XB_SPIN(xb_ld(&bar[XB_TOPGEN]) == tg, bar);
            __builtin_amdgcn_fence(__ATOMIC_ACQUIRE, "agent");
            xb_add(&bar[XB_XGEN(b.x)], 1u);
            asm volatile("s_waitcnt vmcnt(0)" ::: "memory");
        } else {
            XB_SPIN(xb_ld(&bar[XB_XGEN(b.x)]) == gen, bar);
            __builtin_amdgcn_fence(__ATOMIC_ACQUIRE, "agent");
            asm volatile("s_waitcnt vmcnt(0)" ::: "memory");
        }
    }
    __syncthreads();
}

namespace pg8 {
constexpr int BM = 256, BK = 64, HALF = 128, HTB = HALF * BK * 2, STAGE_BYTES = 8 * HTB, NXCD = 8, WGM = 8;
__host__ __device__ __forceinline__ int lds_byte(int r, int c) { const int st = (r >> 4) * 2 + (c >> 5), rr = r & 15, cc = c & 31, ob = rr * 64 + cc * 2; return st * 1024 + (ob ^ (((ob >> 9) & 1) << 5)); }
__host__ __device__ __forceinline__ void stage_rc(int b, int& R, int& C) { const int st = b / 1024, sb = b % 1024, swz = sb ^ (((sb >> 9) & 1) << 5); R = (st >> 1) * 16 + swz / 64; C = (st & 1) * 32 + (swz % 64) / 2; }
__host__ __device__ __forceinline__ int perm32(int rho) { const int n = rho >> 4, i = rho & 15; return 8 * (i >> 2) + 4 * n + (i & 3); }

struct Unit { int pm, pn, e, nvalid, slot0, half, row0; const char *A0, *A1, *B0, *B1; unsigned va[2][2]; };

__device__ __forceinline__ unsigned cvt_pk_bf16(float lo, float hi) { unsigned r; asm volatile("v_cvt_pk_bf16_f32 %0, %1, %2" : "=v"(r) : "v"(lo), "v"(hi)); return r; }

template <class Epi, class Sched, bool ALIGN_EPI>
__device__ __forceinline__ void gemm_phase(LAS unsigned char* lds, const int K, const Sched& S, const Epi& E) {
    const int tid = ltid(), wid = __builtin_amdgcn_readfirstlane(tid >> 6), lane = tid & 63, wr = wid >> 2, wc = wid & 3, fr = lane & 15, fq = lane >> 4;
    const int nt = Sched::FP8 ? K / 128 : K / BK;
    unsigned voffB[2];
#pragma unroll
    for (int i = 0; i < 2; ++i) { int R, C; stage_rc(tid * 16 + i * 8192, R, C); const int Rb = Epi::PERM ? ((R & ~31) + perm32(R & 31)) : R; voffB[i] = Sched::FP8 ? (unsigned)(Rb * K + C * 2) : (unsigned)(Rb * K + C) * 2u; }
    const size_t kstep = (size_t)(BK * 2);
    const unsigned ldsw = (unsigned)wid * 1024u;
    const int aoff = lds_byte(wr * 64 + fr, fq * 8), boff = lds_byte(wc * 32 + fr, fq * 8);
#define PG8_SA(b, h) (((b) * 2 + (h)) * HTB)
#define PG8_SB(b, h) ((4 + (b) * 2 + (h)) * HTB)
#define PG8_STAGE(bufoff, gbase, voff) do { _Pragma("unroll") for (int _i = 0; _i < 2; ++_i) \
        __builtin_amdgcn_global_load_lds((const unsigned*)((const char*)(gbase) + (voff)[_i]), (LAS unsigned*)(lds + (bufoff) + ldsw + _i * 8192), 16, 0, 0); } while (0)
#define PG8_LDA(dst, b, h) do { _Pragma("unroll") for (int m = 0; m < 4; ++m) _Pragma("unroll") for (int k = 0; k < 2; ++k) dst[m][k] = *(const LAS bf16x8*)(lds + PG8_SA(b, h) + aoff + m * 2048 + k * 1024); } while (0)
#define PG8_LDB(dst, b, h) do { _Pragma("unroll") for (int n = 0; n < 2; ++n) _Pragma("unroll") for (int k = 0; k < 2; ++k) dst[n][k] = *(const LAS bf16x8*)(lds + PG8_SB(b, h) + boff + n * 2048 + k * 1024); } while (0)
#define PG8_MMA(ai, bj, At, Bt) do { __builtin_amdgcn_s_setprio(1); _Pragma("unroll") for (int m = 0; m < 4; ++m) _Pragma("unroll") for (int n = 0; n < 2; ++n) _Pragma("unroll") for (int k = 0; k < 2; ++k) { \
        if constexpr (Sched::FP8) { const i64x2 b8_ = __builtin_bit_cast(i64x2, Bt[n][k]), a8_ = __builtin_bit_cast(i64x2, At[m][k]); \
            acc[ai][bj][m][n] = __builtin_amdgcn_mfma_f32_16x16x32_fp8_fp8(b8_[0], a8_[0], acc[ai][bj][m][n], 0, 0, 0); acc[ai][bj][m][n] = __builtin_amdgcn_mfma_f32_16x16x32_fp8_fp8(b8_[1], a8_[1], acc[ai][bj][m][n], 0, 0, 0); } \
        else acc[ai][bj][m][n] = __builtin_amdgcn_mfma_f32_16x16x32_bf16(Bt[n][k], At[m][k], acc[ai][bj][m][n], 0, 0, 0); } __builtin_amdgcn_s_setprio(0); } while (0)
#define PG8_WAIT_V(n) asm volatile("s_waitcnt vmcnt(" #n ")" ::: "memory")
#define PG8_WAIT_L(n) asm volatile("s_waitcnt lgkmcnt(" #n ")" ::: "memory")
#define PG8_BAR __builtin_amdgcn_s_barrier()
#define PG8_SCHED __builtin_amdgcn_sched_barrier(0)
#define VA(u, h) (Sched::GATHER ? (u).va[h] : S.va)
    Unit cur, nxt; int ui = 0;
    if constexpr (Sched::DYN) { S.ticket_issue(); S.ticket_publish(); __syncthreads(); }
    if (!S.next(0, cur)) return;
    if constexpr (Sched::DYN) { __syncthreads(); S.ticket_issue(); S.ticket_publish(); __syncthreads(); }
    S.a_ready(cur);
    if (S.probe) GSTAMP(lds, 27);
    f32x4 acc[2][2][4][2];
#pragma unroll
    for (int a = 0; a < 2; ++a)
#pragma unroll
        for (int b = 0; b < 2; ++b)
#pragma unroll
            for (int m = 0; m < 4; ++m)
#pragma unroll
                for (int n = 0; n < 2; ++n) acc[a][b][m][n] = (f32x4){0.f, 0.f, 0.f, 0.f};
    bf16x8 At[4][2], B0[2][2], B1[2][2];
    PG8_STAGE(PG8_SB(0, 0), cur.B0, voffB); PG8_STAGE(PG8_SB(0, 1), cur.B1, voffB); PG8_STAGE(PG8_SA(0, 0), cur.A0, VA(cur, 0)); PG8_STAGE(PG8_SA(0, 1), cur.A1, VA(cur, 1));
    if (wr == 1) PG8_BAR;
    PG8_WAIT_V(2); PG8_BAR;
    PG8_STAGE(PG8_SB(1, 0), cur.B0 + kstep, voffB); PG8_STAGE(PG8_SA(1, 0), cur.A0 + kstep, VA(cur, 0)); PG8_STAGE(PG8_SB(1, 1), cur.B1 + kstep, voffB);
    PG8_WAIT_V(6); PG8_BAR;
    for (;;) {
        bool has_next = false;
        if constexpr (Sched::DYN) { S.ticket_issue(); nxt = cur; }
        else { has_next = S.next(ui + 1, nxt); if (!has_next) nxt = cur; }
        for (int t = 0; t < nt; t += 2) {
            if constexpr (Sched::DYN) { if (t == nt - 4) { has_next = S.next(ui + 1, nxt); if (!has_next) nxt = cur; } if (t == nt - 2) S.ticket_publish(); }
            const bool last = (t == nt - 2);
            if (last && has_next) S.a_ready(nxt);
            const char* a1h1 = cur.A1 + (size_t)(t + 1) * kstep;
            const char* a2h0 = last ? nxt.A0 : cur.A0 + (size_t)(t + 2) * kstep; const char* a2h1 = last ? nxt.A1 : cur.A1 + (size_t)(t + 2) * kstep;
            const char* b2h0 = last ? nxt.B0 : cur.B0 + (size_t)(t + 2) * kstep; const char* b2h1 = last ? nxt.B1 : cur.B1 + (size_t)(t + 2) * kstep;
            unsigned v2h0[2], v2h1[2];
#pragma unroll
            for (int i = 0; i < 2; ++i) { if constexpr (Sched::GATHER) { v2h0[i] = last ? nxt.va[0][i] : cur.va[0][i]; v2h1[i] = last ? nxt.va[1][i] : cur.va[1][i]; } else { v2h0[i] = S.va[i]; v2h1[i] = S.va[i]; } }
            PG8_LDB(B0, 0, 0); PG8_LDB(B1, 0, 1); PG8_SCHED; PG8_LDA(At, 0, 0); PG8_STAGE(PG8_SA(1, 1), a1h1, VA(cur, 1));
            PG8_WAIT_V(8); PG8_WAIT_L(0); PG8_BAR; PG8_MMA(0, 0, At, B0); PG8_MMA(0, 1, At, B1); PG8_BAR; PG8_SCHED;
            if (!cur.half) PG8_LDA(At, 0, 1);
            PG8_STAGE(PG8_SB(0, 0), b2h0, voffB); PG8_STAGE(PG8_SB(0, 1), b2h1, voffB); PG8_STAGE(PG8_SA(0, 0), a2h0, v2h0);
            PG8_WAIT_V(8); PG8_WAIT_L(0); PG8_BAR; if (!cur.half) { PG8_MMA(1, 0, At, B0); PG8_MMA(1, 1, At, B1); } PG8_BAR; PG8_SCHED;
            PG8_LDB(B0, 1, 0); PG8_LDB(B1, 1, 1); PG8_SCHED; PG8_LDA(At, 1, 0); PG8_STAGE(PG8_SA(0, 1), a2h1, v2h1);
            PG8_WAIT_V(8); PG8_WAIT_L(0); PG8_BAR; PG8_MMA(0, 0, At, B0); PG8_MMA(0, 1, At, B1); PG8_BAR; PG8_SCHED;
            if (!cur.half) PG8_LDA(At, 1, 1);
            PG8_STAGE(PG8_SB(1, 0), b2h0 + kstep, voffB); PG8_STAGE(PG8_SB(1, 1), b2h1 + kstep, voffB); PG8_STAGE(PG8_SA(1, 0), a2h0 + kstep, v2h0);
            PG8_WAIT_V(8); PG8_WAIT_L(0); PG8_BAR; if (!cur.half) { PG8_MMA(1, 0, At, B0); PG8_MMA(1, 1, At, B1); } PG8_BAR; PG8_SCHED;
        }
        if (S.probe) GSTAMP(lds, 25);
        if constexpr (ALIGN_EPI) { if (wr == 0) PG8_BAR; }
        if constexpr (Sched::CHAIN) E.chain(acc, cur, wr, wc, fr, fq); else E(acc, cur, wr, wc, fr, fq);
        S.done(cur);
        if (S.probe) { asm volatile("s_waitcnt vmcnt(0)" ::: "memory"); GSTAMP(lds, 26); }
        if (!has_next) break;
        if (!Sched::CHAIN || nxt.e == 0) {
#pragma unroll
        for (int a = 0; a < 2; ++a)
#pragma unroll
            for (int b = 0; b < 2; ++b)
#pragma unroll
                for (int m = 0; m < 4; ++m)
#pragma unroll
                    for (int n = 0; n < 2; ++n) acc[a][b][m][n] = (f32x4){0.f, 0.f, 0.f, 0.f};
        }
        cur = nxt; ++ui;
        if constexpr (ALIGN_EPI) { if (wr == 1) PG8_BAR; }
    }
    PG8_WAIT_V(0);
    if constexpr (!ALIGN_EPI) { if (wr == 0) PG8_BAR; }
    PG8_BAR;
#undef VA
#undef PG8_SA
#undef PG8_SB
#undef PG8_STAGE
#undef PG8_LDA
#undef PG8_LDB
#undef PG8_MMA
#undef PG8_WAIT_V
#undef PG8_WAIT_L
#undef PG8_BAR
#undef PG8_SCHED
}

template <bool F8> struct PlainSchedT {
    static constexpr bool GATHER = false, CHAIN = false, DYN = false, FP8 = F8;
    static constexpr int EB = F8 ? 1 : 2;
    __device__ __forceinline__ void a_ready(const Unit&) const {}
    __device__ __forceinline__ void done(const Unit&) const {}
    int nM, nN, nwg, G, c, lda, K, nNh, probe = 0, pn_from = -1, pn_to = -1; const char* A; const char* Bt; unsigned va[2];
    __device__ __forceinline__ void init(const void* A_, int lda_, const void* Bt_, int M, int N, int K_, int G_, int c_, int nNh_ = 0) {
        nM = M / BM; nN = N / BM - nNh_; nNh = nNh_; nwg = nM * nN; G = G_; c = c_; lda = lda_; K = K_; A = (const char*)A_; Bt = (const char*)Bt_;
#pragma unroll
        for (int i = 0; i < 2; ++i) { int R, C; stage_rc((int)ltid() * 16 + i * 8192, R, C); va[i] = (unsigned)(R * lda * EB + C * 2); }
    }
    __device__ __forceinline__ bool next(int i, Unit& u) const {
        const long L = (long)i * G + c;
        u.e = 0; u.nvalid = 256; u.slot0 = 0; u.va[0][0] = 0u; u.va[0][1] = 0u; u.va[1][0] = 0u; u.va[1][1] = 0u;
        if (L >= nwg) { const int hL = (int)(L - nwg); if (hL >= 2 * nM * nNh) return false;
            const int hm = hL / nNh; int pn = nN + hL % nNh; if (pn == pn_from) pn = pn_to;
            u.pm = hm >> 1; u.pn = pn; u.half = 1; u.row0 = hm * HALF;
            u.A0 = A + (size_t)hm * HALF * lda * EB; u.A1 = u.A0;
            u.B0 = Bt + (size_t)pn * BM * K * EB; u.B1 = u.B0 + (size_t)HALF * K * EB;
            return true; }
        int wgid = (int)L; { const int q = nwg / NXCD, r = nwg % NXCD, xcd = wgid % NXCD, off = wgid / NXCD; wgid = (xcd < r ? xcd * (q + 1) : r * (q + 1) + (xcd - r) * q) + off; }
        const int nig = WGM * nN, gid = wgid / nig, fm = gid * WGM, gsz = (nM - fm) < WGM ? (nM - fm) : WGM;
        u.pm = fm + ((wgid % nig) % gsz); u.pn = (wgid % nig) / gsz; if (u.pn == pn_from) u.pn = pn_to; u.half = 0; u.row0 = u.pm * BM;
        u.A0 = A + (size_t)u.pm * BM * lda * EB; u.A1 = u.A0 + (size_t)HALF * lda * EB;
        u.B0 = Bt + (size_t)u.pn * BM * K * EB; u.B1 = u.B0 + (size_t)HALF * K * EB;
        return true;
    }
};
typedef PlainSchedT<false> PlainSched;
struct BranchSched {
    static constexpr bool GATHER = false, CHAIN = true, DYN = false, FP8 = false;
    __device__ __forceinline__ void a_ready(const Unit&) const {}
    __device__ __forceinline__ void done(const Unit&) const {}
    int G, c, probe = 0; const char* A; const char* Bt; unsigned va[2];
    __device__ __forceinline__ void init(const bf16* OC, const bf16* WBRl, int G_, int c_) { G = G_; c = c_; A = (const char*)OC; Bt = (const char*)WBRl;
#pragma unroll
        for (int i = 0; i < 2; ++i) { int R, C; stage_rc((int)ltid() * 16 + i * 8192, R, C); va[i] = (unsigned)(R * 1536 + C) * 2u; } }
    __device__ __forceinline__ bool next(int i, Unit& u) const {
        const int tile = (i / 3) * G + c, n = i % 3; if (tile >= (T / BM) * (D / BM)) return false;
        int wgid = tile; { const int nwg = 256, q = nwg / NXCD, xcd = wgid % NXCD, off = wgid / NXCD; wgid = xcd * q + off; }
        const int nN = D / BM, nig = WGM * nN, gid = wgid / nig, fm = gid * WGM;
        u.pm = fm + ((wgid % nig) % WGM); u.pn = (wgid % nig) / WGM; u.e = n; u.nvalid = 256; u.slot0 = 0; u.half = 0; u.row0 = u.pm * BM;
        u.va[0][0] = 0u; u.va[0][1] = 0u; u.va[1][0] = 0u; u.va[1][1] = 0u;
        u.A0 = A + (size_t)u.pm * BM * 1536 * 2 + (size_t)n * 512 * 2; u.A1 = u.A0 + (size_t)HALF * 1536 * 2;
        u.B0 = Bt + (size_t)n * D * 512 * 2 + (size_t)u.pn * BM * 512 * 2; u.B1 = u.B0 + (size_t)HALF * 512 * 2;
        return true;
    }
};
template <int MODE> struct MoeSched {
    static constexpr int NPN = MODE == 1 ? 4 : 8;
    static constexpr bool GATHER = MODE == 1, CHAIN = false, DYN = MODE == 2, FP8 = true;
    unsigned* tilecnt; unsigned* tick; volatile LAS int* tslot; mutable int myticket;
    __device__ __forceinline__ void ticket_issue() const { if (ltid() == 0) myticket = (int)__hip_atomic_fetch_add(tick, 1u, __ATOMIC_RELAXED, __HIP_MEMORY_SCOPE_AGENT); }
    __device__ __forceinline__ void ticket_publish() const { if (ltid() == 0) *tslot = myticket; }
    __device__ __forceinline__ void a_ready(const Unit& u) const {
        if (MODE == 2) {
            if (ltid() < 64) { unsigned* p = tilecnt + 64 * (u.slot0 >> 8); unsigned sp = 0;
                while ((unsigned)__builtin_amdgcn_readfirstlane(__hip_atomic_load(p, __ATOMIC_RELAXED, __HIP_MEMORY_SCOPE_AGENT)) < 32u) { __builtin_amdgcn_s_sleep(2); if (++sp > (1u << 22)) break; }
                __builtin_amdgcn_fence(__ATOMIC_ACQUIRE, "agent"); asm volatile("s_waitcnt vmcnt(0)" ::: "memory"); }
            asm volatile("" ::: "memory"); __builtin_amdgcn_s_barrier(); asm volatile("" ::: "memory"); }
    }
    __device__ __forceinline__ void done(const Unit& u) const {
        if (MODE == 1) { asm volatile("s_waitcnt vmcnt(0)" ::: "memory");
            if ((ltid() & 63) == 0) __hip_atomic_fetch_add(tilecnt + 64 * (u.slot0 >> 8), 1u, __ATOMIC_RELAXED, __HIP_MEMORY_SCOPE_AGENT); }
    }
    int G, c, probe = 0; const LAS int* tb; const int* cnt; const int* list; const char* A; const char* W; unsigned va[2];
    __device__ __forceinline__ void init(int G_, int c_, const LAS int* tb_, const int* cnt_, const int* list_, const void* A_, const void* W_) {
        G = G_; c = c_; tb = tb_; cnt = cnt_; list = list_; A = (const char*)A_; W = (const char*)W_;
#pragma unroll
        for (int i = 0; i < 2; ++i) { int R, C; stage_rc((int)ltid() * 16 + i * 8192, R, C); va[i] = (unsigned)(R * FF + C * 2); }
    }
    __device__ __forceinline__ bool next(int i, Unit& u) const {
        const int L = MODE == 2 ? __builtin_amdgcn_readfirstlane(*tslot) : i * G + c, nfull = __builtin_amdgcn_readfirstlane(tb[33 + NE]), nhalf = __builtin_amdgcn_readfirstlane(tb[66 + NE]);
        if (L >= (nfull + nhalf) * NPN) return false;
        const bool half = L >= nfull * NPN; const int Lr = half ? L - nfull * NPN : L, base = half ? 66 : 33;
        const int tq = Lr / NPN, pn = Lr % NPN; int e = 0;
        while (e < NE - 1 && __builtin_amdgcn_readfirstlane(tb[base + e + 1]) <= tq) ++e;
        const int ne = __builtin_amdgcn_readfirstlane(cnt[e]);
        const int pm = half ? (ne - 1) / 256 : tq - __builtin_amdgcn_readfirstlane(tb[33 + e]);
        const int tl = __builtin_amdgcn_readfirstlane(tb[e]) + pm;
        u.pm = pm; u.pn = pn; u.e = e; u.nvalid = ne - pm * 256; u.slot0 = tl * 256; u.half = half ? 1 : 0; u.row0 = 0;
        if (MODE == 1) {
            u.A0 = A; u.A1 = A;
#pragma unroll
            for (int h = 0; h < 2; ++h)
#pragma unroll
                for (int k = 0; k < 2; ++k) { int Rk, Ck; stage_rc((int)ltid() * 16 + k * 8192, Rk, Ck); int idx = pm * 256 + h * 128 + Rk; idx = idx < ne ? idx : ne - 1; const int entry = list[e * 8192 + idx]; u.va[h][k] = (unsigned)(entry >> 1) * (unsigned)D + (unsigned)Ck * 2u; }
            const char* we = W + (size_t)e * 1024 * D;
            u.B0 = we + (size_t)(pn * 128) * D; u.B1 = we + (size_t)(512 + pn * 128) * D;
        } else {
            u.va[0][0] = 0u; u.va[0][1] = 0u; u.va[1][0] = 0u; u.va[1][1] = 0u;
            u.A0 = A + (size_t)tl * 256 * FF; u.A1 = u.A0 + (size_t)HALF * FF;
            const char* we = W + (size_t)e * D * FF;
            u.B0 = we + (size_t)(pn * 256) * FF; u.B1 = u.B0 + (size_t)HALF * FF;
        }
        return true;
    }
};

struct EpiBf16 {
    static constexpr bool PERM = true;
    bf16* O; int ldc; float scale;
    __device__ __forceinline__ void operator()(const f32x4 (&acc)[2][2][4][2], const Unit& u, int wr, int wc, int fr, int fq) const {
        const int row0 = u.row0 + wr * 64 + fr, col0 = u.pn * BM + wc * 32 + 8 * fq;
#pragma unroll
        for (int ai = 0; ai < 2; ++ai) if (ai == 0 || !u.half)
#pragma unroll
            for (int m = 0; m < 4; ++m) { bf16* rowp = O + (size_t)(row0 + ai * HALF + m * 16) * ldc + col0;
#pragma unroll
                for (int bj = 0; bj < 2; ++bj) { const f32x4 v0 = acc[ai][bj][m][0] * scale, v1 = acc[ai][bj][m][1] * scale;
                    u32x4 w; w.x = cvt_pk_bf16(v0[0], v0[1]); w.y = cvt_pk_bf16(v0[2], v0[3]); w.z = cvt_pk_bf16(v1[0], v1[1]); w.w = cvt_pk_bf16(v1[2], v1[3]);
                    *(u32x4*)(rowp + bj * HALF) = w; } }
    }
};
struct EpiMerge {
    static constexpr bool PERM = true;
    bf16* MG; const bf16* gate0;
    __device__ __forceinline__ void operator()(const f32x4 (&acc)[2][2][4][2], const Unit& u, int wr, int wc, int fr, int fq) const {}
    __device__ __forceinline__ void chain(f32x4 (&acc)[2][2][4][2], const Unit& u, int wr, int wc, int fr, int fq) const {
        const int row0 = u.row0 + wr * 64 + fr, col0 = u.pn * BM + wc * 32 + 8 * fq; const bool last = u.e == 2;
        const bf16* __restrict__ ga = gate0 + (size_t)u.e * D; const bf16* __restrict__ gb = gate0 + (size_t)(last ? 2 : u.e + 1) * D;
        bf16* __restrict__ MGp = MG;
        u32x4 qa[2][2], qb[2][2];
#define EMG_LOAD(buf, g) do { const size_t row_ = (size_t)(row0 + ((g) >> 2) * HALF + ((g) & 3) * 16); \
            _Pragma("unroll") for (int bj_ = 0; bj_ < 2; ++bj_) { qa[buf][bj_] = *(const u32x4*)(ga + row_ * NPAD + col0 + bj_ * HALF); qb[buf][bj_] = *(const u32x4*)(gb + row_ * NPAD + col0 + bj_ * HALF); } } while (0)
        EMG_LOAD(0, 0);
#pragma unroll
        for (int g = 0; g < 8; ++g) { if (g + 1 < 8) EMG_LOAD((g + 1) & 1, g + 1);
            const int ai = g >> 2, m = g & 3; const size_t row = (size_t)(row0 + ai * HALF + m * 16);
#pragma unroll
            for (int bj = 0; bj < 2; ++bj) { float o[8];
                const unsigned wa[4] = {qa[g & 1][bj].x, qa[g & 1][bj].y, qa[g & 1][bj].z, qa[g & 1][bj].w}, wb[4] = {qb[g & 1][bj].x, qb[g & 1][bj].y, qb[g & 1][bj].z, qb[g & 1][bj].w};
#pragma unroll
                for (int k = 0; k < 8; ++k) { const float a = acc[ai][bj][m][k >> 2][k & 3];
                    const float xa = __builtin_bit_cast(float, (k & 1) ? (wa[k >> 1] & 0xffff0000u) : (wa[k >> 1] << 16)), xb = __builtin_bit_cast(float, (k & 1) ? (wb[k >> 1] & 0xffff0000u) : (wb[k >> 1] << 16));
                    const float ea = __builtin_amdgcn_exp2f(-LOG2E * xa), eb = __builtin_amdgcn_exp2f(-LOG2E * xb);
                    const float f = (last ? 1.0f : 1.0f + eb) * __builtin_amdgcn_rcpf(1.0f + ea);
                    o[k] = a * f; acc[ai][bj][m][k >> 2][k & 3] = o[k]; }
                if (last) { u32x4 w; w.x = cvt_pk_bf16(o[0], o[1]); w.y = cvt_pk_bf16(o[2], o[3]); w.z = cvt_pk_bf16(o[4], o[5]); w.w = cvt_pk_bf16(o[6], o[7]);
                    *(u32x4*)(MGp + row * D + col0 + bj * HALF) = w; } } }
#undef EMG_LOAD
    }
};
struct EpiResF32 {
    static constexpr bool PERM = false;
    const float* R; float* O; int ldc;
    __device__ __forceinline__ void operator()(const f32x4 (&acc)[2][2][4][2], const Unit& u, int wr, int wc, int fr, int fq) const {
        const int row0 = u.row0 + wr * 64 + fr, col0 = u.pn * BM + wc * 32 + 4 * fq;
        const float* __restrict__ Rp = R; float* __restrict__ Op = O;
        f32x4 rv[2][4];
#define ERES_LOAD(buf, g) do { const size_t off_ = (size_t)(row0 + ((g) >> 2) * HALF + ((g) & 3) * 16) * ldc + col0; \
            _Pragma("unroll") for (int q_ = 0; q_ < 4; ++q_) rv[buf][q_] = *(const f32x4*)(Rp + off_ + (q_ >> 1) * HALF + (q_ & 1) * 16); } while (0)
        ERES_LOAD(0, 0);
#pragma unroll
        for (int g = 0; g < 8; ++g) { if (g + 1 < 8) ERES_LOAD((g + 1) & 1, g + 1);
            const int ai = g >> 2, m = g & 3; const size_t off = (size_t)(row0 + ai * HALF + m * 16) * ldc + col0;
            if (ai == 0 || !u.half) {
#pragma unroll
                for (int q = 0; q < 4; ++q) *(f32x4*)(Op + off + (q >> 1) * HALF + (q & 1) * 16) = acc[ai][q >> 1][m][q & 1] + rv[g & 1][q]; } }
#undef ERES_LOAD
    }
};
struct EpiMoe1 {
    static constexpr bool PERM = true;
    unsigned char* ACT; const int* list; const float* ew; const float* rstd;
    __device__ __forceinline__ void operator()(const f32x4 (&acc)[2][2][4][2], const Unit& u, int wr, int wc, int fr, int fq) const {
        const int col0 = u.pn * 128 + wc * 32 + 8 * fq;
#pragma unroll
        for (int ai = 0; ai < 2; ++ai) if (ai == 0 || !u.half)
#pragma unroll
            for (int m = 0; m < 4; ++m) { const int r = ai * HALF + wr * 64 + m * 16 + fr; float w = 0.f, rsd = 0.f;
                if (r < u.nvalid) { const int entry = list[u.e * 8192 + u.pm * 256 + r]; w = ew[entry] * S_ACT; rsd = rstd[entry >> 1] * (1.0f / (S_A1 * S_W1)); }
                float o[8];
#pragma unroll
                for (int n = 0; n < 2; ++n)
#pragma unroll
                    for (int j = 0; j < 4; ++j) { const float g = acc[ai][0][m][n][j] * rsd, up = acc[ai][1][m][n][j] * rsd; o[n * 4 + j] = g * fsig(g) * up * w; }
                const unsigned lo = pk4_fp8(o[0], o[1], o[2], o[3]), hi = pk4_fp8(o[4], o[5], o[6], o[7]);
                __hip_atomic_store((unsigned long long*)(ACT + (size_t)(u.slot0 + r) * FF + col0), (unsigned long long)lo | ((unsigned long long)hi << 32), __ATOMIC_RELAXED, __HIP_MEMORY_SCOPE_AGENT); }
    }
};
struct EpiMoe2 {
    static constexpr bool PERM = true;
    bf16* CO; const int* list;
    __device__ __forceinline__ void operator()(const f32x4 (&acc)[2][2][4][2], const Unit& u, int wr, int wc, int fr, int fq) const {
        const int col0 = u.pn * BM + wc * 32 + 8 * fq;
#pragma unroll
        for (int ai = 0; ai < 2; ++ai) if (ai == 0 || !u.half)
#pragma unroll
            for (int m = 0; m < 4; ++m) { const int r = ai * HALF + wr * 64 + m * 16 + fr;
                if (r < u.nvalid) { const int entry = list[u.e * 8192 + u.pm * 256 + r]; bf16* rowp = CO + (size_t)entry * D + col0;
#pragma unroll
                    for (int bj = 0; bj < 2; ++bj) { const f32x4 v0 = acc[ai][bj][m][0] * (1.0f / (S_ACT * S_W2)), v1 = acc[ai][bj][m][1] * (1.0f / (S_ACT * S_W2));
                        u32x4 w; w.x = cvt_pk_bf16(v0[0], v0[1]); w.y = cvt_pk_bf16(v0[2], v0[3]); w.z = cvt_pk_bf16(v1[0], v1[1]); w.w = cvt_pk_bf16(v1[2], v1[3]);
                        *(u32x4*)(rowp + bj * HALF) = w; } } }
    }
};
}

struct Frame {
    LAS unsigned char* lds; volatile LAS unsigned* MISC;
    int tid, lane, wave, vcu, G, gw, NGW, bid;
};
struct Args { const GAS float* in[22]; GAS float* out; GAS unsigned char* ws; int ph_lo, ph_hi, li, pad; };
typedef const __attribute__((address_space(4))) Args KArgs;
__device__ __forceinline__ KArgs* ka_fresh() { unsigned long long p = (unsigned long long)__builtin_amdgcn_kernarg_segment_ptr(); asm volatile("" : "+s"(p)); return (KArgs*)p; }
#define KA KArgs* const ka = ka_fresh()
#define KIN(i) ((const float*)ka->in[i])
#define KWS ((unsigned char*)ka->ws)
#define KOUT ((float*)ka->out)
enum { I_X = 0, I_NMIX, I_WIN, I_PE, I_W1, I_W2, I_QN, I_KN, I_LB, I_HGN, I_WA2, I_BA, I_GLAN, I_WBR, I_WOUT, I_NFFN, I_WGRP, I_BGRP, I_WEXP, I_BEXP, I_WGU, I_WDN };

__device__ __forceinline__ void tr_item(const float* W, size_t ldw, int c0, int nv, bf16* WT, size_t ldt, int r0, int k0, LAS float* scr, int lane) {
    const int nn = lane & 31;
    float tv[32];
#pragma unroll
    for (int i = 0; i < 32; ++i) { const int kk = 2 * i + (lane >> 5); tv[i] = nn < nv ? __builtin_nontemporal_load(W + (size_t)(k0 + kk) * ldw + c0 + nn) : 0.f; }
#pragma unroll
    for (int i = 0; i < 32; ++i) { const int kk = 2 * i + (lane >> 5); scr[kk * 33 + nn] = tv[i]; }
    LDS_WAIT();
    const int c = lane & 7;
#pragma unroll
    for (int j = 0; j < 4; ++j) { const int n = (lane >> 3) + 8 * j; const LAS float* s = scr + (8 * c) * 33 + n;
        u32x4 o; o.x = pk2(s[0 * 33], s[1 * 33]); o.y = pk2(s[2 * 33], s[3 * 33]); o.z = pk2(s[4 * 33], s[5 * 33]); o.w = pk2(s[6 * 33], s[7 * 33]);
        if (n < nv) __builtin_nontemporal_store(o, (u32x4*)(WT + (size_t)(r0 + n) * ldt + k0 + 8 * c)); }
    LDS_WAIT();
}
__device__ __forceinline__ void tr_item8(const float* W, size_t ldw, int c0, unsigned char* WT8, size_t ldt, int r0, int k0, float sc, LAS float* scr, int lane) {
    const int nn = lane & 31;
    float tv[64];
#pragma unroll
    for (int i = 0; i < 64; ++i) { const int kk = 2 * i + (lane >> 5); tv[i] = __builtin_nontemporal_load(W + (size_t)(k0 + kk) * ldw + c0 + nn); }
#pragma unroll
    for (int i = 0; i < 64; ++i) { const int kk = 2 * i + (lane >> 5); scr[kk * 33 + nn] = tv[i] * sc; }
    LDS_WAIT();
    const int c = lane & 7;
#pragma unroll
    for (int j = 0; j < 4; ++j) { const int n = (lane >> 3) + 8 * j; const LAS float* sp = scr + (16 * c) * 33 + n;
        u32x4 o; o.x = pk4_fp8(sp[0 * 33], sp[1 * 33], sp[2 * 33], sp[3 * 33]); o.y = pk4_fp8(sp[4 * 33], sp[5 * 33], sp[6 * 33], sp[7 * 33]);
        o.z = pk4_fp8(sp[8 * 33], sp[9 * 33], sp[10 * 33], sp[11 * 33]); o.w = pk4_fp8(sp[12 * 33], sp[13 * 33], sp[14 * 33], sp[15 * 33]);
        __builtin_nontemporal_store(o, (u32x4*)(WT8 + (size_t)(r0 + n) * ldt + k0 + 16 * c)); }
    LDS_WAIT();
}
__device__ __forceinline__ void phase_prologue(Frame& F) {
    KA;
    {
      bf16* W1T = (bf16*)(KWS + WS_CW); bf16* W2T = (bf16*)(KWS + WS_CW + 1048576); float* B1 = (float*)(KWS + WS_CW + 1572864);
      for (int i = F.bid * 512 + F.tid; i < NL * 2 * 64 * 2048; i += F.G * 512) { const int lk = i / (64 * 2048), j = (i / 2048) % 64, c = i % 2048; W1T[i] = (bf16)f2bf(KIN(I_W1)[((size_t)lk * 2048 + c) * 64 + j]); }
      for (int i = F.bid * 512 + F.tid; i < NL * 2 * 64 * 64; i += F.G * 512) { const int lk = i / 4096, j2 = (i / 64) % 64, j = i % 64; W2T[i] = (bf16)f2bf(KIN(I_W2)[((size_t)lk * 64 + j) * 64 + j2]); }
      if (F.bid < NL * 2) { const int lk = F.bid, j = F.tid & 63, part = F.tid >> 6; float a = 0.f;
#pragma unroll 8
          for (int c = part * 256; c < part * 256 + 256; ++c) a += KIN(I_PE)[(size_t)lk * 2048 + c] * KIN(I_W1)[((size_t)lk * 2048 + c) * 64 + j];
          LAS float* rd = (LAS float*)F.lds; rd[F.tid] = a; __syncthreads();
          if (F.tid < 64) { float t2 = 0.f;
#pragma unroll
              for (int p = 0; p < 8; ++p) t2 += rd[p * 64 + F.tid];
              B1[lk * 64 + F.tid] = t2; }
          __syncthreads(); } }
    { float* WRT = (float*)(KWS + WS_WRT);
      for (int i = F.bid * 512 + F.tid; i < NL * 48 * D; i += F.G * 512) { const int l = i / (48 * D), n = (i / D) % 48, k = i % D; const float g = KIN(I_NFFN)[l * D + k];
          WRT[i] = n < 32 ? g * KIN(I_WEXP)[((size_t)l * D + k) * 32 + n] : (n < 36 ? g * KIN(I_WGRP)[((size_t)l * D + k) * 4 + (n - 32)] : 0.f); } }
    LAS float* scr = (LAS float*)(F.lds + F.wave * 17408);
    constexpr int IT_WIN = 32 * 154, IT_WG8 = 16 * 192, IT_WBR = 3 * 8 * 64, IT_WOUT = 32 * 64, IT_WGU = 32 * 16 * 32, IT_WDN = 32 * 4 * 64, IT_L = IT_WIN + IT_WG8 + IT_WBR + IT_WOUT + IT_WGU + IT_WDN;
    for (int it = F.gw; it < NL * IT_L; it += F.NGW) {
        const int l = it / IT_L; int r = it % IT_L;
        if (r < IT_WIN) { const int kb = r / 154, nb = r % 154; int src, dst, nv = 32;
            if (nb < 40) { src = nb * 32; dst = nb * 32; }
            else if (nb == 40) { src = 1280; dst = C_NG; nv = 24; }
            else if (nb < 153) { src = 1304 + 32 * (nb - 41); dst = 1280 + 32 * (nb - 41); }
            else { src = 4888; dst = C_GA; nv = 16; }
            tr_item(KIN(I_WIN) + (size_t)l * D * INC, INC, src, nv, (bf16*)(KWS + WS_WIN) + (size_t)l * NPAD * D, D, dst, kb * 64, scr, F.lane); continue; }
        r -= IT_WIN;
        if (r < IT_WG8) { const int kb = r / 192, nb = r % 192;
            tr_item8(KIN(I_WIN) + (size_t)l * D * INC, INC, 4904 + 32 * nb, (unsigned char*)(KWS + WS_WIN8) + (size_t)l * 6144 * D, D, nb * 32, kb * 128, S_WG, scr, F.lane); continue; }
        r -= IT_WG8;
        if (r < IT_WBR) { const int n = r / 512, q = r % 512, kb = q / 64, nb = q % 64;
            tr_item(KIN(I_WBR) + ((size_t)l * 3 + n) * 512 * D, D, nb * 32, 32, (bf16*)(KWS + WS_WBR) + ((size_t)l * 3 + n) * D * 512, 512, nb * 32, kb * 64, scr, F.lane); continue; }
        r -= IT_WBR;
        if (r < IT_WOUT) { const int kb = r / 64, nb = r % 64;
            tr_item(KIN(I_WOUT) + (size_t)l * D * D, D, nb * 32, 32, (bf16*)(KWS + WS_WOUT) + (size_t)l * D * D, D, nb * 32, kb * 64, scr, F.lane); continue; }
        r -= IT_WOUT;
        if (r < IT_WGU) { const int e = r / 512, q = r % 512, kb = q / 32, nb = q % 32;
            tr_item8(KIN(I_WGU) + ((size_t)l * NE + e) * D * 1024, 1024, nb * 32, (unsigned char*)(KWS + WS_WGU) + ((size_t)l * NE + e) * 1024 * D, D, nb * 32, kb * 128, S_W1, scr, F.lane); continue; }
        r -= IT_WGU;
        { const int e = r / 256, q = r % 256, kb = q / 64, nb = q % 64;
            tr_item8(KIN(I_WDN) + ((size_t)l * NE + e) * FF * D, D, nb * 32, (unsigned char*)(KWS + WS_WDN) + ((size_t)l * NE + e) * D * FF, FF, nb * 32, kb * 128, S_W2, scr, F.lane); }
    }
}

template <int MODE> __device__ __forceinline__ void phase_norm1(Frame& F, const float* xin, const bf16* contrib, float* xout, const float* gain, bf16* H, unsigned char* H8n = nullptr) {
    for (int t0 = F.gw; t0 < T; t0 += 2 * F.NGW) {
        f32x4 v[2][8]; float ss[2] = {0.f, 0.f};
#pragma unroll
        for (int rr = 0; rr < 2; ++rr) { const int t = t0 + rr * F.NGW; if (t < T) {
            const f32x4* xr = (const f32x4*)(xin + (size_t)t * D) + F.lane;
#pragma unroll
            for (int j = 0; j < 8; ++j) v[rr][j] = xr[64 * j]; } }
        u32x2 c0[2][8], c1[2][8];
        if (MODE != 0) {
#pragma unroll
            for (int rr = 0; rr < 2; ++rr) { const int t = t0 + rr * F.NGW; if (t < T) {
#pragma unroll
                for (int j = 0; j < 8; ++j) { c0[rr][j] = *((const u32x2*)(contrib + (size_t)(2 * t) * D) + F.lane + 64 * j); c1[rr][j] = *((const u32x2*)(contrib + (size_t)(2 * t + 1) * D) + F.lane + 64 * j); } } } }
#pragma unroll
        for (int rr = 0; rr < 2; ++rr) { const int t = t0 + rr * F.NGW; if (t < T) {
#pragma unroll
            for (int j = 0; j < 8; ++j) {
                if (MODE != 0) { v[rr][j].x += bflo(c0[rr][j].x) + bflo(c1[rr][j].x); v[rr][j].y += bfhi(c0[rr][j].x) + bfhi(c1[rr][j].x); v[rr][j].z += bflo(c0[rr][j].y) + bflo(c1[rr][j].y); v[rr][j].w += bfhi(c0[rr][j].y) + bfhi(c1[rr][j].y);
                    *((f32x4*)(xout + (size_t)t * D) + F.lane + 64 * j) = v[rr][j]; }
                ss[rr] += v[rr][j].x * v[rr][j].x + v[rr][j].y * v[rr][j].y + v[rr][j].z * v[rr][j].z + v[rr][j].w * v[rr][j].w; } } }
        if (MODE != 2) {
#pragma unroll
            for (int rr = 0; rr < 2; ++rr) { const int t = t0 + rr * F.NGW; if (t < T) {
                const float rstd = 1.0f / sqrtf(wave_sum(ss[rr]) * (1.0f / D) + EPS);
#pragma unroll
                for (int j = 0; j < 8; ++j) { const f32x4 g = *((const f32x4*)gain + F.lane + 64 * j);
                    const float h0 = v[rr][j].x * rstd * g.x, h1 = v[rr][j].y * rstd * g.y, h2 = v[rr][j].z * rstd * g.z, h3 = v[rr][j].w * rstd * g.w;
                    u32x2 o; o.x = pkbf(h0, h1); o.y = pkbf(h2, h3);
                    *((u32x2*)(H + (size_t)t * D) + F.lane + 64 * j) = o;
                    *((unsigned*)(H8n + (size_t)t * D) + F.lane + 64 * j) = pk4_fp8(h0 * S_H, h1 * S_H, h2 * S_H, h3 * S_H); } } }
        }
    }
}

__device__ __forceinline__ void phase_prep(Frame& F, int l) {
    KA;
    const bf16* P = (const bf16*)(KWS + WS_P);
    float* QN = (float*)(KWS + WS_QN); float* KV = (float*)(KWS + WS_KV);
    const float* qg = KIN(I_QN) + l * 64; const float* kg = KIN(I_KN) + l * 192;
    for (int it = F.gw; it < T * 20; it += F.NGW) {
        const int t = it / 20, v = it % 20;
        float x = bf2f(P[(size_t)t * NPAD + v * 64 + F.lane]);
        const bool isq = v < 8, nk1 = (v == 12 || v == 13), nk2 = (v == 16 || v == 17);
        if (isq || nk1 || nk2) { const float ss = wave_sum(x * x); const float g = isq ? qg[F.lane] : (nk1 ? kg[64 + F.lane] : kg[128 + F.lane]); x = x * (1.0f / sqrtf(ss * (1.0f / 64.0f) + EPS)) * g; }
        if (isq) QN[((size_t)v * T + t) * 64 + F.lane] = x;
        else { const int w = v - 8, tens = w >> 1, g = w & 1; KV[(size_t)tens * KV_STRIDE + ((size_t)g * T + t) * 64 + F.lane] = x; }
    }
}
__device__ __forceinline__ float gelu_tanh(float x) { const float u = 0.7978845608028654f * (x + 0.044715f * x * x * x); return 0.5f * x * (1.0f + tanhf(u)); }
__device__ __forceinline__ void phase_compress(Frame& F, int l) {
    KA;
    LAS float* av = (LAS float*)(F.lds + F.wave * 16384);
    const float* KV = (const float*)(KWS + WS_KV); float* KC = (float*)(KWS + WS_KC);
    for (int it = F.gw; it < 2 * 2 * 511; it += F.NGW) {
        const int kind = it / 1022, q = it % 1022, g = q / 511, n = q % 511;
        const float* src = KV + (size_t)kind * KV_STRIDE + ((size_t)g * T + 16 * n) * 64;
        const float* pe = KIN(I_PE) + ((size_t)l * 2 + kind) * 2048;
        const float* w1 = KIN(I_W1) + ((size_t)l * 2 + kind) * 2048 * 64;
        const float* w2 = KIN(I_W2) + ((size_t)l * 2 + kind) * 64 * 64;
#pragma unroll 4
        for (int c = 0; c < 32; ++c) av[c * 64 + F.lane] = src[c * 64 + F.lane] + pe[c * 64 + F.lane];
        WSYNC();
        float acc = 0.f;
#pragma unroll 8
        for (int i = 0; i < 2048; ++i) acc += av[i] * w1[i * 64 + F.lane];
        const float hid = gelu_tanh(acc);
        WSYNC();
        av[F.lane] = hid;
        WSYNC();
        float o = 0.f;
#pragma unroll 8
        for (int i = 0; i < 64; ++i) o += av[i] * w2[i * 64 + F.lane];
        WSYNC();
        if (kind == 0) { const float ss = wave_sum(o * o); o = o * (1.0f / sqrtf(ss * (1.0f / 64.0f) + EPS)) * KIN(I_KN)[l * 192 + F.lane]; }
        KC[(size_t)kind * (2 * 512 * 64) + ((size_t)g * 512 + n) * 64 + F.lane] = o;
    }
}
__device__ __forceinline__ void phase_recur(Frame& F, int l) {
    KA;
    const bf16* P = (const bf16*)(KWS + WS_P); float* ORAW = (float*)(KWS + WS_ORAW);
    for (int it = F.gw; it < 1024; it += F.NGW) {
        const int kind = it >> 9, head = (it >> 7) & 3, j = it & 127;
        if (kind == 0) {
            const int d0 = F.lane, d1 = F.lane + 64;
            const float* lbl = KIN(I_LB);
            float lb0, lb1;
            { const float a0 = lbl[head * 128 + d0], b0 = lbl[512 + head * 128 + d0], a1 = lbl[head * 128 + d1], b1 = lbl[512 + head * 128 + d1];
              lb0 = l == 0 ? 0.f : 1.0f / (1.0f + expf(a0 - b0)); lb1 = l == 0 ? 0.f : 1.0f / (1.0f + expf(a1 - b1)); }
            const bf16* Pq = P + C_HQ + head * 128; const bf16* Pf = P + C_HF + head * 128; const bf16* Pi = P + C_HI + head * 128 + j;
            float S0 = 0.f, S1 = 0.f;
            for (int t0 = 0; t0 < T; t0 += 8) {
                bf16 zq0[8], zq1[8], zf0[8], zf1[8], vi[8];
#pragma unroll
                for (int u = 0; u < 8; ++u) { const size_t row = (size_t)(t0 + u) * NPAD; zq0[u] = Pq[row + d0]; zq1[u] = Pq[row + d1]; zf0[u] = Pf[row + d0]; zf1[u] = Pf[row + d1]; vi[u] = Pi[row]; }
                float part[8];
#pragma unroll
                for (int u = 0; u < 8; ++u) { const float v = bf2f(vi[u]);
                    const float s0 = sigmoidf_(bf2f(zf0[u])), s1 = sigmoidf_(bf2f(zf1[u]));
                    const float f0 = lb0 + (1.0f - lb0) * s0, f1 = lb1 + (1.0f - lb1) * s1;
                    const float k0 = (1.0f - lb0) * (1.0f - s0), k1 = (1.0f - lb1) * (1.0f - s1);
                    S0 = f0 * S0 + k0 * v; S1 = f1 * S1 + k1 * v;
                    part[u] = bf2f(zq0[u]) * S0 + bf2f(zq1[u]) * S1; }
                float mine = 0.f;
#pragma unroll
                for (int u = 0; u < 8; ++u) { const float s = wave_sum(part[u]); mine = (F.lane == u) ? s : mine; }
                if (F.lane < 8) ORAW[(size_t)(t0 + F.lane) * 1024 + head * 128 + j] = mine;
            }
        } else {
            const int d = F.lane, c = head * 64 + d;
            float wa[16];
#pragma unroll
            for (int r = 0; r < 16; ++r) wa[r] = KIN(I_WA2)[((size_t)l * 16 + r) * 256 + c];
            const float ba = KIN(I_BA)[l * 256 + c];
            const bf16* Pq = P + C_GQ + c; const bf16* Pk = P + C_GK + c; const bf16* Pv = P + C_GV + head * 128 + j; const bf16* Pa = P + C_GA;
            float S = 0.f;
            for (int t0 = 0; t0 < T; t0 += 8) {
                bf16 zq[8], zk[8], zv[8]; u32x4 ga0[8], ga1[8];
#pragma unroll
                for (int u = 0; u < 8; ++u) { const size_t row = (size_t)(t0 + u) * NPAD; zq[u] = Pq[row]; zk[u] = Pk[row]; zv[u] = Pv[row]; ga0[u] = *(const u32x4*)(Pa + row); ga1[u] = *(const u32x4*)(Pa + row + 8); }
                float part[8];
#pragma unroll
                for (int u = 0; u < 8; ++u) {
                    float a = ba;
                    a += bflo(ga0[u].x) * wa[0] + bfhi(ga0[u].x) * wa[1] + bflo(ga0[u].y) * wa[2] + bfhi(ga0[u].y) * wa[3] + bflo(ga0[u].z) * wa[4] + bfhi(ga0[u].z) * wa[5] + bflo(ga0[u].w) * wa[6] + bfhi(ga0[u].w) * wa[7];
                    a += bflo(ga1[u].x) * wa[8] + bfhi(ga1[u].x) * wa[9] + bflo(ga1[u].y) * wa[10] + bfhi(ga1[u].y) * wa[11] + bflo(ga1[u].z) * wa[12] + bfhi(ga1[u].z) * wa[13] + bflo(ga1[u].w) * wa[14] + bfhi(ga1[u].w) * wa[15];
                    const float ls = fminf(a, 0.f) - log1pf(expf(-fabsf(a)));
                    const float f = expf(ls * (1.0f / 16.0f));
                    S = f * S + bf2f(zk[u]) * bf2f(zv[u]);
                    part[u] = bf2f(zq[u]) * 0.125f * S; }
                float mine = 0.f;
#pragma unroll
                for (int u = 0; u < 8; ++u) { const float s = wave_sum(part[u]); mine = (F.lane == u) ? s : mine; }
                if (F.lane < 8) ORAW[(size_t)(t0 + F.lane) * 1024 + 512 + head * 128 + j] = mine;
            }
        }
    }
}
__device__ __forceinline__ void phase_recur_out(Frame& F, int l) {
    KA;
    const bf16* P = (const bf16*)(KWS + WS_P); const float* ORAW = (const float*)(KWS + WS_ORAW); bf16* OCAT = (bf16*)(KWS + WS_OCAT);
    for (int it = F.gw; it < T * 8; it += F.NGW) {
        const int t = it >> 3, kind = (it >> 2) & 1, head = it & 3;
        const float* gn = (kind == 0 ? KIN(I_HGN) : KIN(I_GLAN)) + l * 128;
        const int cg = (kind == 0 ? C_HG : C_GR) + head * 128;
        const float r0 = ORAW[(size_t)t * 1024 + kind * 512 + head * 128 + F.lane], r1 = ORAW[(size_t)t * 1024 + kind * 512 + head * 128 + 64 + F.lane];
        const float rstd = 1.0f / sqrtf(wave_sum(r0 * r0 + r1 * r1) * (1.0f / 128.0f) + EPS);
        const float g0 = bf2f(P[(size_t)t * NPAD + cg + F.lane]), g1 = bf2f(P[(size_t)t * NPAD + cg + 64 + F.lane]);
        const float a0 = kind == 0 ? sigmoidf_(g0) : g0 * sigmoidf_(g0), a1 = kind == 0 ? sigmoidf_(g1) : g1 * sigmoidf_(g1);
        OCAT[(size_t)t * 1536 + 512 + kind * 512 + head * 128 + F.lane] = (bf16)f2bf(r0 * rstd * gn[F.lane] * a0);
        OCAT[(size_t)t * 1536 + 512 + kind * 512 + head * 128 + 64 + F.lane] = (bf16)f2bf(r1 * rstd * gn[64 + F.lane] * a1);
    }
}


template <int KIND> struct RecCfg { static constexpr int DK = KIND == 0 ? 128 : 64, NSEG = 512 / DK, TPS = 64 / NSEG, QROW = (DK + 8) * 2; };
constexpr int REC_VT_OFF = 0;
constexpr int REC_KD_OFF = 18432;
constexpr int REC_QS_OFF = 36864;
constexpr int REC_KS_OFF = 54272;
constexpr int REC_QD_OFF = 71680;
constexpr int REC_RED_OFF = 89088;
constexpr int REC_TOT_OFF = 91136;
__device__ __forceinline__ float expc(float x2) { return __builtin_amdgcn_exp2f(fminf(x2, 110.0f)); }
template <int KIND> __device__ __forceinline__ void rec_elem(KArgs* ka, int l, int head, int chunk, int tid, LAS float* tot,
        float (&qv)[RecCfg<KIND>::TPS], float (&kv)[RecCfg<KIND>::TPS], float (&bv)[RecCfg<KIND>::TPS], float& bend, float& bref) {
    constexpr int DK = RecCfg<KIND>::DK, NSEG = RecCfg<KIND>::NSEG, TPS = RecCfg<KIND>::TPS;
    const int d = tid % DK, seg = tid / DK, t0 = chunk * 64 + seg * TPS;
    const bf16* P = (const bf16*)(KWS + WS_P);
    float run = 0.f;
    if (KIND == 0) {
        const int c = head * 128 + d;
        float lb = 0.f;
        if (l > 0) { const float a0 = KIN(I_LB)[c], b0 = KIN(I_LB)[512 + c]; lb = 1.0f / (1.0f + expf(a0 - b0)); }
        const float omlb = 1.0f - lb;
        unsigned zr[TPS], qr[TPS];
#pragma unroll
        for (int u = 0; u < TPS; ++u) { const size_t row = (size_t)(t0 + u) * NPAD; zr[u] = P[row + C_HF + c]; qr[u] = P[row + C_HQ + c]; }
#pragma unroll
        for (int u = 0; u < TPS; ++u) {
            const float z = bf2f(zr[u]); qv[u] = bf2f(qr[u]);
            const float e = __builtin_amdgcn_exp2f(-LOG2E * z), sg = __builtin_amdgcn_rcpf(1.0f + e), f = fmaf(omlb, sg, lb);
            kv[u] = omlb * (e * sg);
            run += __builtin_amdgcn_logf(fmaxf(f, 1e-30f)); bv[u] = run; }
    } else {
        const int c = head * 64 + d;
        float wa[16];
#pragma unroll
        for (int r = 0; r < 16; ++r) wa[r] = KIN(I_WA2)[((size_t)l * 16 + r) * 256 + c];
        const float ba = KIN(I_BA)[l * 256 + c];
        u32x4 g0r[TPS], g1r[TPS]; unsigned qr[TPS], kr[TPS];
#pragma unroll
        for (int u = 0; u < TPS; ++u) { const size_t row = (size_t)(t0 + u) * NPAD; g0r[u] = *(const u32x4*)(P + row + C_GA); g1r[u] = *(const u32x4*)(P + row + C_GA + 8); qr[u] = P[row + C_GQ + c]; kr[u] = P[row + C_GK + c]; }
#pragma unroll
        for (int u = 0; u < TPS; ++u) { const u32x4 g0 = g0r[u], g1 = g1r[u];
            float a = ba;
            a += bflo(g0.x) * wa[0] + bfhi(g0.x) * wa[1] + bflo(g0.y) * wa[2] + bfhi(g0.y) * wa[3] + bflo(g0.z) * wa[4] + bfhi(g0.z) * wa[5] + bflo(g0.w) * wa[6] + bfhi(g0.w) * wa[7];
            a += bflo(g1.x) * wa[8] + bfhi(g1.x) * wa[9] + bflo(g1.y) * wa[10] + bfhi(g1.y) * wa[11] + bflo(g1.z) * wa[12] + bfhi(g1.z) * wa[13] + bflo(g1.w) * wa[14] + bfhi(g1.w) * wa[15];
            const float ls2 = fminf(a, 0.f) * LOG2E - __builtin_amdgcn_logf(1.0f + __builtin_amdgcn_exp2f(-LOG2E * fabsf(a)));
            qv[u] = bf2f(qr[u]) * 0.125f; kv[u] = bf2f(kr[u]);
            run += ls2 * (1.0f / 16.0f); bv[u] = run; }
    }
    tot[seg * DK + d] = run;
    __syncthreads();
    float off = 0.f; bend = 0.f; bref = 0.f;
#pragma unroll
    for (int sgi = 0; sgi < NSEG; ++sgi) { const float v = tot[sgi * DK + d]; off += sgi < seg ? v : 0.f; bref += sgi < NSEG / 2 ? v : 0.f; bend += v; }
#pragma unroll
    for (int u = 0; u < TPS; ++u) bv[u] += off;
}
template <int KIND> __device__ __forceinline__ void rec_vt_load(KArgs* ka, int head, int chunk, int tid, unsigned (&w)[8]) {
    const bf16* P = (const bf16*)(KWS + WS_P) + (KIND == 0 ? C_HI : C_GV) + head * 128;
    const int v = tid & 127, sv = tid >> 7;
#pragma unroll
    for (int u = 0; u < 8; ++u) { const unsigned a = P[(size_t)(chunk * 64 + sv * 16 + 2 * u) * NPAD + v], b = P[(size_t)(chunk * 64 + sv * 16 + 2 * u + 1) * NPAD + v]; w[u] = a | (b << 16); }
}
__device__ __forceinline__ void rec_vt_store(int tid, LAS unsigned char* lds, const unsigned (&w)[8]) {
    const int v = tid & 127, sv = tid >> 7;
    LAS u32x4* dst = (LAS u32x4*)(lds + REC_VT_OFF + v * 144 + sv * 32);
    dst[0] = (u32x4){w[0], w[1], w[2], w[3]}; dst[1] = (u32x4){w[4], w[5], w[6], w[7]};
}
template <int KIND> __device__ __forceinline__ void rec_local_unit(KArgs* ka, Frame& F, int l, int head, int chunk) {
    constexpr int DK = RecCfg<KIND>::DK, TPS = RecCfg<KIND>::TPS;
    LAS unsigned char* lds = F.lds; LAS float* tot = (LAS float*)(lds + REC_TOT_OFF);
    float qv[TPS], kv[TPS], bv[TPS], bend, bref;
    unsigned vraw[8];
    rec_vt_load<KIND>(ka, head, chunk, F.tid, vraw);
    rec_elem<KIND>(ka, l, head, chunk, F.tid, tot, qv, kv, bv, bend, bref);
    const int d = F.tid % DK, seg = F.tid / DK, unit = chunk * 4 + head;
    { unsigned w[TPS / 2];
#pragma unroll
      for (int u = 0; u < TPS / 2; ++u) w[u] = pkbf(kv[2 * u] * expc(bend - bv[2 * u]), kv[2 * u + 1] * expc(bend - bv[2 * u + 1]));
      LAS u32x4* dst = (LAS u32x4*)(lds + REC_KD_OFF + d * 144 + seg * TPS * 2);
      dst[0] = (u32x4){w[0], w[1], w[2], w[3]};
      if constexpr (TPS == 16) dst[1] = (u32x4){w[4], w[5], w[6], w[7]}; }
    if (seg == 0) ((float*)(KWS + WS_DEC + (KIND == 0 ? 0 : 262144)))[(size_t)unit * DK + d] = __builtin_amdgcn_exp2f(bend);
    rec_vt_store(F.tid, lds, vraw);
    __syncthreads();
    const int r = F.lane & 15, kq = F.lane >> 4;
    const int dt = KIND == 0 ? F.wave : (F.wave & 3), vt0 = KIND == 0 ? 0 : (F.wave >> 2) * 4, nvt = KIND == 0 ? 8 : 4;
    bf16x8 a[2];
#pragma unroll
    for (int ks = 0; ks < 2; ++ks) a[ks] = *(const LAS bf16x8*)(lds + REC_KD_OFF + (16 * dt + r) * 144 + (32 * ks + 8 * kq) * 2);
    bf16* Sl = (bf16*)(KWS + (KIND == 0 ? WS_SLOC_HG : WS_SLOC_GL)) + (size_t)unit * 128 * DK;
#pragma unroll
    for (int vi = 0; vi < nvt; ++vi) { const int vt = vt0 + vi; f32x4 acc = {0.f, 0.f, 0.f, 0.f};
#pragma unroll
        for (int ks = 0; ks < 2; ++ks) { const bf16x8 b = *(const LAS bf16x8*)(lds + REC_VT_OFF + (16 * vt + r) * 144 + (32 * ks + 8 * kq) * 2); acc = __builtin_amdgcn_mfma_f32_16x16x32_bf16(a[ks], b, acc, 0, 0, 0); }
        u32x2 w2; w2.x = pkbf(acc[0], acc[1]); w2.y = pkbf(acc[2], acc[3]);
        *(u32x2*)(Sl + (size_t)(16 * vt + r) * DK + 16 * dt + 4 * kq) = w2; }
    __syncthreads();
}
__device__ __forceinline__ void phase_rec_local(Frame& F, int l) {
    KA;
    for (int it = F.bid; it < 1024; it += F.G) { const int kind = it >> 9, chunk = (it >> 2) & 127, head = it & 3;
        if (kind == 0) rec_local_unit<0>(ka, F, l, head, chunk); else rec_local_unit<1>(ka, F, l, head, chunk); }
}
__device__ __forceinline__ void phase_rec_scan(Frame& F) {
    KA;
    const int gt = F.bid * 512 + F.tid;
    if (gt >= 49152) return;
    const bool hg = gt < 32768; const int q = hg ? gt : gt - 32768;
    const int DK = hg ? 128 : 64, dp = q % (DK / 2), v = (q / (DK / 2)) & 127, head = q / (DK / 2 * 128);
    const bf16* Sl = (const bf16*)(KWS + (hg ? WS_SLOC_HG : WS_SLOC_GL)) + ((size_t)head * 128 + v) * DK + 2 * dp;
    bf16* Sp = (bf16*)(KWS + (hg ? WS_SPREV_HG : WS_SPREV_GL)) + ((size_t)head * 128 + v) * DK + 2 * dp;
    const float* De = (const float*)(KWS + WS_DEC + (hg ? 0 : 262144)) + (size_t)head * DK + 2 * dp;
    const size_t ustr = (size_t)4 * 128 * DK, dstr = (size_t)4 * DK;
    float s0 = 0.f, s1 = 0.f;
    for (int c0 = 0; c0 < NCH; c0 += 16) { unsigned x[16]; f32x2 dc[16];
#pragma unroll
        for (int u = 0; u < 16; ++u) { x[u] = *(const unsigned*)(Sl + (size_t)(c0 + u) * ustr); dc[u] = *(const f32x2*)(De + (size_t)(c0 + u) * dstr); }
#pragma unroll
        for (int u = 0; u < 16; ++u) { *(unsigned*)(Sp + (size_t)(c0 + u) * ustr) = pkbf(s0, s1); s0 = dc[u].x * s0 + bflo(x[u]); s1 = dc[u].y * s1 + bfhi(x[u]); } }
}
template <int KIND> __device__ __forceinline__ void rec_out_unit(KArgs* ka, Frame& F, int l, int head, int chunk) {
    constexpr int DK = RecCfg<KIND>::DK, TPS = RecCfg<KIND>::TPS, QROW = RecCfg<KIND>::QROW, NKS = DK / 32;
    LAS unsigned char* lds = F.lds; LAS float* tot = (LAS float*)(lds + REC_TOT_OFF); LAS float* red = (LAS float*)(lds + REC_RED_OFF);
    const int r = F.lane & 15, kq = F.lane >> 4, unit = chunk * 4 + head, vt = F.wave;
    bf16x8 sa[NKS];
    { const bf16* Sp = (const bf16*)(KWS + (KIND == 0 ? WS_SPREV_HG : WS_SPREV_GL)) + (size_t)unit * 128 * DK + (size_t)(16 * vt + r) * DK + 8 * kq;
#pragma unroll
      for (int ks = 0; ks < NKS; ++ks) sa[ks] = *(const bf16x8*)(Sp + 32 * ks); }
    float qv[TPS], kv[TPS], bv[TPS], bend, bref;
    unsigned vraw[8];
    rec_vt_load<KIND>(ka, head, chunk, F.tid, vraw);
    const bf16* P = (const bf16*)(KWS + WS_P); bf16* OCAT = (bf16*)(KWS + WS_OCAT);
    const int v0 = 16 * vt + 4 * kq;
    const f32x4 gn = *(const f32x4*)((KIND == 0 ? KIN(I_HGN) : KIN(I_GLAN)) + l * 128 + v0);
    u32x2 gq4[4];
#pragma unroll
    for (int it = 0; it < 4; ++it) gq4[it] = *(const u32x2*)(P + (size_t)(chunk * 64 + 16 * it + r) * NPAD + (KIND == 0 ? C_HG : C_GR) + head * 128 + v0);
    rec_elem<KIND>(ka, l, head, chunk, F.tid, tot, qv, kv, bv, bend, bref);
    { const int d = F.tid % DK, seg = F.tid / DK; const float eref = __builtin_amdgcn_exp2f(fmaxf(bref, -120.f));
#pragma unroll
      for (int u = 0; u < TPS; u += 2) { const int o = (seg * TPS + u) * QROW + d * 2;
          const float x0 = __builtin_amdgcn_exp2f(fminf(fmaxf(bv[u] - bref, -110.f), 110.f)), x1 = __builtin_amdgcn_exp2f(fminf(fmaxf(bv[u + 1] - bref, -110.f), 110.f));
          const float qs0 = qv[u] * x0, qs1 = qv[u + 1] * x1;
          const unsigned w0 = pkbf(qs0, qs1), w1 = pkbf(kv[u] * __builtin_amdgcn_rcpf(x0), kv[u + 1] * __builtin_amdgcn_rcpf(x1)), w2 = pkbf(qs0 * eref, qs1 * eref);
          *(LAS bf16*)(lds + REC_QS_OFF + o) = (bf16)w0; *(LAS bf16*)(lds + REC_QS_OFF + o + QROW) = (bf16)(w0 >> 16);
          *(LAS bf16*)(lds + REC_KS_OFF + o) = (bf16)w1; *(LAS bf16*)(lds + REC_KS_OFF + o + QROW) = (bf16)(w1 >> 16);
          *(LAS bf16*)(lds + REC_QD_OFF + o) = (bf16)w2; *(LAS bf16*)(lds + REC_QD_OFF + o + QROW) = (bf16)(w2 >> 16); } }
    rec_vt_store(F.tid, lds, vraw);
    __syncthreads();
#pragma unroll
    for (int tt = 0; tt < 2; ++tt) { const int tile = F.wave * 2 + tt, jt = tile >> 2, it = tile & 3; f32x4 acc = {0.f, 0.f, 0.f, 0.f};
        if (jt <= it) {
#pragma unroll
            for (int ks = 0; ks < NKS; ++ks) { const bf16x8 a = *(const LAS bf16x8*)(lds + REC_KS_OFF + (16 * jt + r) * QROW + (32 * ks + 8 * kq) * 2), b = *(const LAS bf16x8*)(lds + REC_QS_OFF + (16 * it + r) * QROW + (32 * ks + 8 * kq) * 2);
                acc = __builtin_amdgcn_mfma_f32_16x16x32_bf16(a, b, acc, 0, 0, 0); } }
        const int i = 16 * it + r, j0 = 16 * jt + 4 * kq;
        u32x2 w; w.x = pk2(j0 <= i ? acc[0] : 0.f, j0 + 1 <= i ? acc[1] : 0.f); w.y = pk2(j0 + 2 <= i ? acc[2] : 0.f, j0 + 3 <= i ? acc[3] : 0.f);
        *(LAS u32x2*)(lds + REC_KD_OFF + i * 144 + j0 * 2) = w; }
    __syncthreads();
    f32x4 acc[4];
#pragma unroll
    for (int it = 0; it < 4; ++it) acc[it] = (f32x4){0.f, 0.f, 0.f, 0.f};
#pragma unroll
    for (int ks = 0; ks < 2; ++ks) { const bf16x8 a = *(const LAS bf16x8*)(lds + REC_VT_OFF + (16 * vt + r) * 144 + (32 * ks + 8 * kq) * 2);
#pragma unroll
        for (int it = 0; it < 4; ++it) { const bf16x8 b = *(const LAS bf16x8*)(lds + REC_KD_OFF + (16 * it + r) * 144 + (32 * ks + 8 * kq) * 2); acc[it] = __builtin_amdgcn_mfma_f32_16x16x32_bf16(a, b, acc[it], 0, 0, 0); } }
#pragma unroll
    for (int ks = 0; ks < NKS; ++ks) {
#pragma unroll
        for (int it = 0; it < 4; ++it) { const bf16x8 b = *(const LAS bf16x8*)(lds + REC_QD_OFF + (16 * it + r) * QROW + (32 * ks + 8 * kq) * 2); acc[it] = __builtin_amdgcn_mfma_f32_16x16x32_bf16(sa[ks], b, acc[it], 0, 0, 0); } }
#pragma unroll
    for (int it = 0; it < 4; ++it) { float ss = acc[it][0] * acc[it][0] + acc[it][1] * acc[it][1] + acc[it][2] * acc[it][2] + acc[it][3] * acc[it][3];
        ss += __shfl_xor(ss, 16); ss += __shfl_xor(ss, 32);
        if (kq == 0) red[F.wave * 64 + 16 * it + r] = ss; }
    __syncthreads();
#pragma unroll
    for (int it = 0; it < 4; ++it) { const int i = 16 * it + r, t = chunk * 64 + i; float tot_ = 0.f;
#pragma unroll
        for (int w = 0; w < 8; ++w) tot_ += red[w * 64 + i];
        const float rstd = 1.0f / sqrtf(tot_ * (1.0f / 128.0f) + EPS);
        const u32x2 gq = gq4[it];
        float gt[4] = {bflo(gq.x), bfhi(gq.x), bflo(gq.y), bfhi(gq.y)}, o[4];
#pragma unroll
        for (int e = 0; e < 4; ++e) { const float sg = fsig(gt[e]); o[e] = acc[it][e] * rstd * gn[e] * (KIND == 0 ? sg : gt[e] * sg); }
        u32x2 w; w.x = pkbf(o[0], o[1]); w.y = pkbf(o[2], o[3]);
        *(u32x2*)(OCAT + (size_t)t * 1536 + 512 + KIND * 512 + head * 128 + v0) = w; }
    __syncthreads();
}
__device__ __forceinline__ void phase_rec_out(Frame& F, int l) {
    KA;
    unsigned* qctr = (unsigned*)(KWS + WS_CTL) + 2048 + 64 * l;
    volatile LAS int* qslot = (volatile LAS int*)(F.lds + MISC_OFF + 1024);
    int mine = 0;
    if (F.tid == 0) { mine = (int)__hip_atomic_fetch_add(qctr, 1u, __ATOMIC_RELAXED, __HIP_MEMORY_SCOPE_AGENT);
        unsigned* sdone = (unsigned*)(KWS + WS_CTL) + 2048 + 64 * (4 + l); unsigned sp = 0;
        while (__hip_atomic_load(sdone, __ATOMIC_RELAXED, __HIP_MEMORY_SCOPE_AGENT) < 96u) { __builtin_amdgcn_s_sleep(2); if (++sp > (1u << 24)) break; }
        __builtin_amdgcn_fence(__ATOMIC_ACQUIRE, "agent"); asm volatile("s_waitcnt vmcnt(0)" ::: "memory"); }
    for (;;) {
        if (F.tid == 0) *qslot = mine;
        __syncthreads();
        const int it = __builtin_amdgcn_readfirstlane(*qslot);
        __syncthreads();
        if (it >= 1024) break;
        if (F.tid == 0) mine = (int)__hip_atomic_fetch_add(qctr, 1u, __ATOMIC_RELAXED, __HIP_MEMORY_SCOPE_AGENT);
        const int kind = it >> 9, chunk = (it >> 2) & 127, head = it & 3;
        if (kind == 0) rec_out_unit<0>(ka, F, l, head, chunk); else rec_out_unit<1>(ka, F, l, head, chunk);
    }
}

typedef float f32x16 __attribute__((ext_vector_type(16)));
constexpr float NSA_SHIFT2 = 8.0f;
__device__ __forceinline__ int perm16(int b) { return (b & 3) | ((b & 4) << 1) | ((b & 8) >> 1); }
__device__ __forceinline__ void phase_prep2(Frame& F, int l) {
    KA;
    const bf16* P = (const bf16*)(KWS + WS_P);
    bf16* QS = (bf16*)(KWS + WS_QS); bf16* KS2 = (bf16*)(KWS + WS_KS2); bf16* KW2 = (bf16*)(KWS + WS_KW2);
    const float* qg = KIN(I_QN) + l * 64; const float* kg = KIN(I_KN) + l * 192;
    for (int it = F.gw; it < T * 12; it += F.NGW) {
        const int t = it / 12, v = it % 12;
        const int col = v < 8 ? v * 64 : (v < 10 ? C_KS + (v - 8) * 64 : C_KW + (v - 10) * 64);
        float x = bf2f(P[(size_t)t * NPAD + col + F.lane]);
        const float ss = wave_sum(x * x);
        const float g = v < 8 ? qg[F.lane] * (0.125f * LOG2E) : (v < 10 ? kg[64 + F.lane] : kg[128 + F.lane]);
        x = x * (1.0f / sqrtf(ss * (1.0f / 64.0f) + EPS)) * g;
        bf16* dst = v < 8 ? QS + ((size_t)v * T + t) * 64 : (v < 10 ? KS2 + ((size_t)(v - 8) * T + t) * 64 : KW2 + ((size_t)(v - 10) * T + t) * 64);
        dst[F.lane] = (bf16)f2bf(x);
    }
    LAS bf16* tile = (LAS bf16*)(F.lds + F.wave * 16384);
    for (int it = F.gw; it < 2 * 2 * (T / 64); it += F.NGW) {
        const int kind = it / (2 * (T / 64)), q = it % (2 * (T / 64)), g = q / (T / 64), tb = q % (T / 64);
        const bf16* src = P + (size_t)(tb * 64) * NPAD + (kind == 0 ? C_VS : C_VW) + g * 64;
        bf16* dst = (bf16*)(KWS + (kind == 0 ? WS_VST : WS_VWT)) + (size_t)g * 64 * T + tb * 64;
#pragma unroll 4
        for (int r = 0; r < 64; ++r) tile[r * 66 + F.lane] = src[(size_t)r * NPAD + F.lane];
        WSYNC();
        const int pl = (F.lane & ~15) | perm16(F.lane & 15);
#pragma unroll 4
        for (int d = 0; d < 64; ++d) dst[(size_t)d * T + pl] = tile[F.lane * 66 + d];
        WSYNC();
    }
}

__device__ __forceinline__ void phase_prep3(Frame& F, int l) {
    KA;
    const bf16* P = (const bf16*)(KWS + WS_P);
    bf16* QS = (bf16*)(KWS + WS_QS); bf16* KS2 = (bf16*)(KWS + WS_KS2); bf16* KW2 = (bf16*)(KWS + WS_KW2);
    const float* qg = KIN(I_QN) + l * 64; const float* kg = KIN(I_KN) + l * 192;
    const int vec = F.lane >> 3, part = F.lane & 7;
    for (int t = F.gw; t < T; t += F.NGW) {
#pragma unroll
        for (int pass = 0; pass < 2; ++pass) {
            if (pass == 1 && vec >= 4) continue;
            const int col = pass == 0 ? vec * 64 : (vec < 2 ? C_KS + vec * 64 : C_KW + (vec - 2) * 64);
            const float* gp = pass == 0 ? qg : (vec < 2 ? kg + 64 : kg + 128);
            const float gs = pass == 0 ? 0.125f * LOG2E : 1.0f;
            bf16* dst = pass == 0 ? QS + ((size_t)vec * T + t) * 64 : (vec < 2 ? KS2 + ((size_t)vec * T + t) * 64 : KW2 + ((size_t)(vec - 2) * T + t) * 64);
            const u32x4 raw = *(const u32x4*)(P + (size_t)t * NPAD + col + part * 8);
            float x[8] = {bflo(raw.x), bfhi(raw.x), bflo(raw.y), bfhi(raw.y), bflo(raw.z), bfhi(raw.z), bflo(raw.w), bfhi(raw.w)};
            float ss = 0.f;
#pragma unroll
            for (int e = 0; e < 8; ++e) ss += x[e] * x[e];
            ss += __shfl_xor(ss, 1); ss += __shfl_xor(ss, 2); ss += __shfl_xor(ss, 4);
            const float rstd = gs / sqrtf(ss * (1.0f / 64.0f) + EPS);
            const f32x4 g0 = *(const f32x4*)(gp + part * 8), g1 = *(const f32x4*)(gp + part * 8 + 4);
            u32x4 o; o.x = pk2(x[0] * rstd * g0.x, x[1] * rstd * g0.y); o.y = pk2(x[2] * rstd * g0.z, x[3] * rstd * g0.w); o.z = pk2(x[4] * rstd * g1.x, x[5] * rstd * g1.y); o.w = pk2(x[6] * rstd * g1.z, x[7] * rstd * g1.w);
            *(u32x4*)(dst + part * 8) = o;
        }
    }
    LAS bf16* tile = (LAS bf16*)(F.lds + F.wave * 16384);
    for (int it = F.gw; it < 2 * 2 * (T / 64); it += F.NGW) {
        const int kind = it / (2 * (T / 64)), q = it % (2 * (T / 64)), g = q / (T / 64), tb = q % (T / 64);
        const bf16* src = P + (size_t)(tb * 64) * NPAD + (kind == 0 ? C_VS : C_VW) + g * 64;
        bf16* dst = (bf16*)(KWS + (kind == 0 ? WS_VST : WS_VWT)) + (size_t)g * 64 * T + tb * 64;
#pragma unroll
        for (int i = 0; i < 8; ++i) { const int tok = vec + 8 * i; *(LAS u32x4*)(tile + tok * 72 + part * 8) = *(const u32x4*)(src + (size_t)tok * NPAD + part * 8); }
        WSYNC();
#pragma unroll
        for (int c = 0; c < 8; ++c) { unsigned w[4];
#pragma unroll
            for (int k = 0; k < 4; ++k) { const int p0 = (c & 1) * 8 + 2 * k, p1 = p0 + 1;
                const int k0 = (c >> 1) * 16 + ((p0 & 3) | ((p0 & 4) << 1) | ((p0 & 8) >> 1)), k1 = (c >> 1) * 16 + ((p1 & 3) | ((p1 & 4) << 1) | ((p1 & 8) >> 1));
                w[k] = (unsigned)tile[k0 * 72 + F.lane] | ((unsigned)tile[k1 * 72 + F.lane] << 16); }
            *(u32x4*)(dst + (size_t)F.lane * T + c * 8) = (u32x4){w[0], w[1], w[2], w[3]}; }
        WSYNC();
    }
}

__device__ __forceinline__ void phase_compress2(Frame& F, int l) {
    KA;
    LAS float* av = (LAS float*)(F.lds + F.wave * 16384);
    const bf16* P = (const bf16*)(KWS + WS_P);
    bf16* KCB = (bf16*)(KWS + WS_KCB); bf16* VCT = (bf16*)(KWS + WS_KCB + 131072);
    for (int it = F.gw; it < 2 * 2 * 512; it += F.NGW) {
        const int kind = it >> 10, g = (it >> 9) & 1, n = it & 511;
        if (n == 511) { if (kind == 0) KCB[((size_t)g * 512 + 511) * 64 + F.lane] = 0; else VCT[((size_t)g * 64 + F.lane) * 512 + 511] = 0; continue; }
        const bf16* src = P + (size_t)(16 * n) * NPAD + (kind == 0 ? C_KC : C_VC) + g * 64;
        const float* pe = KIN(I_PE) + ((size_t)l * 2 + kind) * 2048;
        const float* w1 = KIN(I_W1) + ((size_t)l * 2 + kind) * 2048 * 64;
        const float* w2 = KIN(I_W2) + ((size_t)l * 2 + kind) * 64 * 64;
#pragma unroll 4
        for (int c = 0; c < 32; ++c) av[c * 64 + F.lane] = bf2f(src[(size_t)c * NPAD + F.lane]) + pe[c * 64 + F.lane];
        WSYNC();
        float acc = 0.f;
#pragma unroll 8
        for (int i = 0; i < 2048; ++i) acc += av[i] * w1[i * 64 + F.lane];
        const float hid = gelu_tanh(acc);
        WSYNC();
        av[F.lane] = hid;
        WSYNC();
        float o = 0.f;
#pragma unroll 8
        for (int i = 0; i < 64; ++i) o += av[i] * w2[i * 64 + F.lane];
        WSYNC();
        if (kind == 0) { const float ss = wave_sum(o * o); o = o * (1.0f / sqrtf(ss * (1.0f / 64.0f) + EPS)) * KIN(I_KN)[l * 192 + F.lane]; KCB[((size_t)g * 512 + n) * 64 + F.lane] = (bf16)f2bf(o); }
        else VCT[((size_t)g * 64 + F.lane) * 512 + ((n & ~15) | perm16(n & 15))] = (bf16)f2bf(o);
    }
}

__device__ __forceinline__ void phase_compress3(Frame& F, int l) {
    KA;
    const bf16* P = (const bf16*)(KWS + WS_P);
    bf16* KCB = (bf16*)(KWS + WS_KCB); bf16* VCT = (bf16*)(KWS + WS_KCB + 131072);
    LAS float* red = (LAS float*)F.lds;
    LAS bf16* hid = (LAS bf16*)(F.lds + 32768);
    const int r16 = F.lane & 15, kq = F.lane >> 4;
    for (int unit = F.bid; unit < 128; unit += F.G) {
        const int kind = unit >> 6, mt = unit & 63, g = mt >> 5, n0 = (mt & 31) * 16;
        const bf16* W1T = (const bf16*)(KWS + WS_CW) + (size_t)(l * 2 + kind) * 64 * 2048; const bf16* W2T = (const bf16*)(KWS + WS_CW + 1048576) + (size_t)(l * 2 + kind) * 4096;
        const float* B1 = (const float*)(KWS + WS_CW + 1572864) + (l * 2 + kind) * 64;
        const bf16* arow = P + (size_t)(16 * (n0 + r16)) * NPAD + (kind == 0 ? C_KC : C_VC) + g * 64;
        f32x4 acc[4];
#pragma unroll
        for (int nt = 0; nt < 4; ++nt) acc[nt] = (f32x4){0.f, 0.f, 0.f, 0.f};
#pragma unroll 2
        for (int ks = 0; ks < 8; ++ks) { const int c0 = F.wave * 256 + 32 * ks + 8 * kq;
            const bf16x8 a = *(const bf16x8*)(arow + (size_t)(c0 >> 6) * NPAD + (c0 & 63));
#pragma unroll
            for (int nt = 0; nt < 4; ++nt) { const bf16x8 b = *(const bf16x8*)(W1T + (size_t)(16 * nt + r16) * 2048 + c0); acc[nt] = __builtin_amdgcn_mfma_f32_16x16x32_bf16(a, b, acc[nt], 0, 0, 0); } }
#pragma unroll
        for (int nt = 0; nt < 4; ++nt) *(LAS f32x4*)(red + ((F.wave * 4 + nt) * 64 + F.lane) * 4) = acc[nt];
        __syncthreads();
        if (F.tid < 256) { const int nt = F.tid >> 6, ln = F.tid & 63; f32x4 v = {0.f, 0.f, 0.f, 0.f};
#pragma unroll
            for (int w = 0; w < 8; ++w) v += *(const LAS f32x4*)(red + ((w * 4 + nt) * 64 + ln) * 4);
            const int col = 16 * nt + (ln & 15); const float b1 = B1[col];
#pragma unroll
            for (int i = 0; i < 4; ++i) hid[(4 * (ln >> 4) + i) * 72 + col] = (bf16)f2bf(gelu_tanh(v[i] + b1)); }
        __syncthreads();
        if (F.wave == 0) {
            f32x4 o[4];
#pragma unroll
            for (int nt = 0; nt < 4; ++nt) o[nt] = (f32x4){0.f, 0.f, 0.f, 0.f};
#pragma unroll
            for (int ks = 0; ks < 2; ++ks) { const bf16x8 a = *(const LAS bf16x8*)(hid + r16 * 72 + 32 * ks + 8 * kq);
#pragma unroll
                for (int nt = 0; nt < 4; ++nt) { const bf16x8 b = *(const bf16x8*)(W2T + (16 * nt + r16) * 64 + 32 * ks + 8 * kq); o[nt] = __builtin_amdgcn_mfma_f32_16x16x32_bf16(a, b, o[nt], 0, 0, 0); } }
            if (kind == 0) {
#pragma unroll
                for (int i = 0; i < 4; ++i) { float ss = o[0][i] * o[0][i] + o[1][i] * o[1][i] + o[2][i] * o[2][i] + o[3][i] * o[3][i];
                    ss += __shfl_xor(ss, 1); ss += __shfl_xor(ss, 2); ss += __shfl_xor(ss, 4); ss += __shfl_xor(ss, 8);
                    const float rstd = 1.0f / sqrtf(ss * (1.0f / 64.0f) + EPS); const int n = n0 + 4 * kq + i;
#pragma unroll
                    for (int nt = 0; nt < 4; ++nt) { const int col = 16 * nt + r16; KCB[((size_t)g * 512 + n) * 64 + col] = n < 511 ? (bf16)f2bf(o[nt][i] * rstd * KIN(I_KN)[l * 192 + col]) : (bf16)0; } }
            } else {
#pragma unroll
                for (int i = 0; i < 4; ++i) { const int n = n0 + 4 * kq + i;
#pragma unroll
                    for (int nt = 0; nt < 4; ++nt) { const int col = 16 * nt + r16; VCT[((size_t)g * 64 + col) * 512 + ((n & ~15) | perm16(n & 15))] = n < 511 ? (bf16)f2bf(o[nt][i]) : (bf16)0; } }
            }
        }
        __syncthreads();
    }
}

constexpr int NSA_SCA = 65536, NSA_SCB = 99328;
constexpr int NSA_QM = 133120, NSA_UM = 134144;
static_assert(NSA_UM + 16 <= MISC_OFF, "NSA LDS map");
__device__ __forceinline__ int next_set(unsigned long long m0, unsigned long long m1, int from) {
    if (from < 64) { const unsigned long long x = m0 & (~0ull << from); if (x) return __builtin_ctzll(x); from = 64; }
    if (from < 128) { const unsigned long long x = m1 & (~0ull << (from - 64)); if (x) return 64 + __builtin_ctzll(x); }
    return 128;
}
__device__ __forceinline__ void nsa_issue(LAS unsigned char* lds, int slot, const bf16* Kg, const bf16* VTg, int vt_len, int j, int tid, int wave) {
    const int row = tid >> 3, c = (tid & 7) ^ ((row >> 1) & 7);
    __builtin_amdgcn_global_load_lds((const unsigned*)(Kg + (size_t)(64 * j + row) * 64 + c * 8), (LAS unsigned*)(lds + slot * 16384 + wave * 1024), 16, 0, 0);
    __builtin_amdgcn_global_load_lds((const unsigned*)(VTg + (size_t)row * vt_len + 64 * j + c * 8), (LAS unsigned*)(lds + slot * 16384 + 8192 + wave * 1024), 16, 0, 0);
}
template <int MODE> __device__ __forceinline__ void nsa_branch(Frame& F, const bf16* Kg, const bf16* VTg, int vt_len, unsigned long long m0, unsigned long long m1,
        const bf16x8 (&Qf)[4], int t, int cblk, u32x4 qxw, int tref, float inv_l, const unsigned (&qsel)[4], int hi_cmp, unsigned wm_lo_dummy, f32x16 (&oacc)[2], float& lsum) {
    LAS unsigned char* lds = F.lds;
    const int lane = F.lane, c32 = lane & 31, h = lane >> 5, tid = F.tid;
    const int sw = (c32 >> 1) & 7;
    int j0 = next_set(m0, m1, 0);
    if (j0 >= 128) return;
    int j1 = next_set(m0, m1, j0 + 1), j2 = j1 < 128 ? next_set(m0, m1, j1 + 1) : 128;
    nsa_issue(lds, 0, Kg, VTg, vt_len, j0, tid, F.wave);
    if (j1 < 128) nsa_issue(lds, 1, Kg, VTg, vt_len, j1, tid, F.wave);
    if (j2 < 128) nsa_issue(lds, 2, Kg, VTg, vt_len, j2, tid, F.wave);
    int slot = 0;
    while (j0 < 128) {
        const int j = j0;
        if (j2 < 128) asm volatile("s_waitcnt vmcnt(4)" ::: "memory"); else if (j1 < 128) asm volatile("s_waitcnt vmcnt(2)" ::: "memory"); else asm volatile("s_waitcnt vmcnt(0)" ::: "memory");
        __builtin_amdgcn_s_barrier(); asm volatile("" ::: "memory");
        const int j3 = j2 < 128 ? next_set(m0, m1, j2 + 1) : 128;
        if (j3 < 128) nsa_issue(lds, (slot + 3) & 3, Kg, VTg, vt_len, j3, tid, F.wave);
        bool need = true;
        if (MODE == 2) { const unsigned myw = j < 32 ? qsel[0] : (j < 64 ? qsel[1] : (j < 96 ? qsel[2] : qsel[3])); need = __any((myw >> (j & 31)) & 1u); }
        if (need) {
            const int kb = slot * 16384, vb = slot * 16384 + 8192;
            const int kbase = 64 * j;
            u32x4 qx = qxw;
            if (MODE == 2) { const unsigned myw = j < 32 ? qsel[0] : (j < 64 ? qsel[1] : (j < 96 ? qsel[2] : qsel[3])); if (!((myw >> (j & 31)) & 1u) && h == 0) qx.z = 0xF149u; }
            const bf16x8 qxf = __builtin_bit_cast(bf16x8, qx);
            f32x16 sacc[2];
#pragma unroll
            for (int sub = 0; sub < 2; ++sub)
#pragma unroll
                for (int i = 0; i < 16; ++i) sacc[sub][i] = 0.f;
#pragma unroll
            for (int sub = 0; sub < 2; ++sub) {
#pragma unroll
                for (int kp = 0; kp < 2; ++kp) { bf16x8 ka2[2];
#pragma unroll
                    for (int k2 = 0; k2 < 2; ++k2) ka2[k2] = *(const LAS bf16x8*)(lds + kb + (32 * sub + c32) * 128 + (((2 * (2 * kp + k2) + h) ^ sw) * 16));
                    asm volatile("" ::: "memory");
#pragma unroll
                    for (int k2 = 0; k2 < 2; ++k2) sacc[sub] = __builtin_amdgcn_mfma_f32_32x32x16_bf16(ka2[k2], Qf[2 * kp + k2], sacc[sub], 0, 0, 0);
                    asm volatile("" ::: "memory"); }
                { const int kidx = kbase + 32 * sub + c32, pos = MODE < 2 ? 16 * kidx + 31 : kidx, dd = tref - pos;
                  const unsigned w = pkbf(-(float)((dd >> 8) * 256), -(float)(dd & 255));
                  u32x4 kx; kx.x = h == 0 ? w : 0u; kx.y = kx.x; kx.z = h == 0 ? 0x3F80u : 0u; kx.w = 0u;
                  sacc[sub] = __builtin_amdgcn_mfma_f32_32x32x16_bf16(__builtin_bit_cast(bf16x8, kx), qxf, sacc[sub], 0, 0, 0); } }
#pragma unroll
            for (int sub = 0; sub < 2; ++sub)
#pragma unroll
                for (int i = 0; i < 16; ++i) sacc[sub][i] = __builtin_amdgcn_exp2f(sacc[sub][i]);
            bool mhi = false, mlo = false; int hi = 0, lo = 0;
            if (MODE < 2) { mhi = (kbase + 63 > (tref - 63 - 31) / 16 - 1); hi = hi_cmp; }
            if (MODE == 2) { mhi = (j == cblk); hi = t; }
            if (MODE == 3) { mhi = (j == cblk); hi = t; mlo = (j == cblk - 8); lo = t - 511; }
            if (mhi || mlo) {
#pragma unroll
                for (int sub = 0; sub < 2; ++sub)
#pragma unroll
                    for (int i = 0; i < 16; ++i) { const int idx = kbase + 4 * h + 32 * sub + (i & 3) + 8 * (i >> 2); if ((mhi && idx > hi) || (mlo && idx < lo)) sacc[sub][i] = 0.f; }
            }
            float ls = 0.f;
#pragma unroll
            for (int sub = 0; sub < 2; ++sub)
#pragma unroll
                for (int i = 0; i < 16; ++i) ls += sacc[sub][i];
            lsum += ls;
            if (MODE == 1) {
                LAS float* scA = (LAS float*)(lds + NSA_SCA); LAS float* scB = (LAS float*)(lds + NSA_SCB);
                const int q = F.wave * 8 + (c32 >> 2);
#pragma unroll
                for (int sub = 0; sub < 2; ++sub)
#pragma unroll
                    for (int g4 = 0; g4 < 4; ++g4) { float x[4];
#pragma unroll
                        for (int e = 0; e < 4; ++e) { float v = sacc[sub][4 * g4 + e] * inv_l;
                            v += __builtin_bit_cast(float, __builtin_amdgcn_mov_dpp(__builtin_bit_cast(int, v), 0xB1, 0xF, 0xF, true));
                            v += __builtin_bit_cast(float, __builtin_amdgcn_mov_dpp(__builtin_bit_cast(int, v), 0x4E, 0xF, 0xF, true));
                            x[e] = v; }
                        const int jb = 16 * j + 8 * sub + 2 * g4 + h;
                        if ((c32 & 3) == 0) { scA[q * 132 + jb] = 2.0f * (x[0] + x[1] + x[2]) + x[3]; scB[q * 132 + jb + 1] = x[3]; } }
            }
            if (MODE != 0) {
                bf16x8 pf[2][2];
#pragma unroll
                for (int sub = 0; sub < 2; ++sub)
#pragma unroll
                    for (int s2 = 0; s2 < 2; ++s2) { u32x4 w; w.x = pkbf(sacc[sub][8 * s2], sacc[sub][8 * s2 + 1]); w.y = pkbf(sacc[sub][8 * s2 + 2], sacc[sub][8 * s2 + 3]); w.z = pkbf(sacc[sub][8 * s2 + 4], sacc[sub][8 * s2 + 5]); w.w = pkbf(sacc[sub][8 * s2 + 6], sacc[sub][8 * s2 + 7]);
                        pf[sub][s2] = __builtin_bit_cast(bf16x8, w); }
                asm volatile("" ::: "memory");
#pragma unroll
                for (int ds = 0; ds < 2; ++ds) {
#pragma unroll
                    for (int qp = 0; qp < 2; ++qp) { bf16x8 va2[2];
#pragma unroll
                        for (int k2 = 0; k2 < 2; ++k2) va2[k2] = *(const LAS bf16x8*)(lds + vb + (32 * ds + c32) * 128 + (((2 * (2 * qp + k2) + h) ^ sw) * 16));
                        asm volatile("" ::: "memory");
#pragma unroll
                        for (int k2 = 0; k2 < 2; ++k2) oacc[ds] = __builtin_amdgcn_mfma_f32_32x32x16_bf16(va2[k2], pf[qp][k2], oacc[ds], 0, 0, 0);
                        asm volatile("" ::: "memory"); } }
            }
        }
        j0 = j1; j1 = j2; j2 = j3; slot = (slot + 1) & 3;
    }
    asm volatile("s_waitcnt lgkmcnt(0)" ::: "memory"); __builtin_amdgcn_s_barrier(); asm volatile("" ::: "memory");
}
__device__ __forceinline__ void nsa_stash_put(LAS unsigned char* lds, int wave, int lane, const f32x16 (&o)[2], float sc) {
    LAS unsigned* st = (LAS unsigned*)(lds + NSA_SCA) + wave * 1024 + lane;
#pragma unroll
    for (int ds = 0; ds < 2; ++ds)
#pragma unroll
        for (int k = 0; k < 8; ++k) st[(ds * 8 + k) * 64] = pkbf(o[ds][2 * k] * sc, o[ds][2 * k + 1] * sc);
}
#define PSTAMP(slot) do { if (MK_PROBE_MASK != 0 && F.bid == MK_PROBE_BID && F.tid == 0) { volatile LAS unsigned long long* _ta = (volatile LAS unsigned long long*)(F.lds + MISC_OFF + 512); const unsigned long long _n = wall_clock64(); _ta[slot] += _n - _ta[16]; _ta[16] = _n; } } while (0)
__device__ __forceinline__ void phase_nsa2(Frame& F, int l) {
    KA;
    LAS unsigned char* lds = F.lds;
    const bf16* P = (const bf16*)(KWS + WS_P); bf16* OCAT = (bf16*)(KWS + WS_OCAT);
    const bf16* QS = (const bf16*)(KWS + WS_QS);
    const int lane = F.lane, c32 = lane & 31, h = lane >> 5, q8 = c32 >> 2, r = c32 & 3;
    for (int unit = F.bid; unit < 256; unit += F.G) {
        const int g = unit & 1, cblk = unit >> 1, t0 = cblk * 64, head = g * 4 + r, t = t0 + F.wave * 8 + q8;
        u32x4 qxw;
        { const float s2 = exp2f(-(float)(head + 1)) * LOG2E; const unsigned sh = f2bf(s2); const float rem = s2 - bf2f(sh); const unsigned sl = f2bf(rem);
          qxw.x = h == 0 ? (sh | (sh << 16)) : 0u; qxw.y = h == 0 ? (sl | (sl << 16)) : 0u; qxw.z = 0u; qxw.w = 0u; }
        const int tref = t0 + 63;
        bf16x8 Qf[4];
#pragma unroll
        for (int ks = 0; ks < 4; ++ks) Qf[ks] = *(const bf16x8*)(QS + ((size_t)head * T + t) * 64 + 16 * ks + 8 * h);
        for (int u = F.tid; u < (NSA_UM + 16 - NSA_SCA) / 4; u += 512) ((LAS unsigned*)(lds + NSA_SCA))[u] = 0u;
        __syncthreads();
        f32x16 oacc[2];
#pragma unroll
        for (int ds = 0; ds < 2; ++ds)
#pragma unroll
            for (int i = 0; i < 16; ++i) oacc[ds][i] = 0.f;
        unsigned qsel[4] = {0u, 0u, 0u, 0u};
        float sc_cmp;
        PSTAMP(24);
        {
            const int ntile = (4 * cblk + 2) / 64 + 1;
            const unsigned long long cm0 = ntile >= 64 ? ~0ull : ((1ull << ntile) - 1ull);
            const int hi_cmp = t >= 31 ? (t - 31) / 16 : -1;
            const bf16* Kg = (const bf16*)(KWS + WS_KCB) + (size_t)g * 512 * 64; const bf16* VTg = (const bf16*)(KWS + WS_KCB + 131072) + (size_t)g * 64 * 512;
            float l1 = 0.f;
            nsa_branch<0>(F, Kg, VTg, 512, cm0, 0ull, Qf, t, cblk, qxw, tref, 0.f, qsel, hi_cmp, 0u, oacc, l1);
            l1 += __shfl_xor(l1, 32);
            const float inv_l = l1 > 0.f ? 1.0f / l1 : 0.f;
            float l2 = 0.f;
            nsa_branch<1>(F, Kg, VTg, 512, cm0, 0ull, Qf, t, cblk, qxw, tref, inv_l, qsel, hi_cmp, 0u, oacc, l2);
            sc_cmp = sigmoidf_(bf2f(P[(size_t)t * NPAD + C_NG + head])) * inv_l;
        }
        PSTAMP(20);
        {
            LAS float* scA = (LAS float*)(lds + NSA_SCA); LAS float* scB = (LAS float*)(lds + NSA_SCB);
            LAS unsigned* qm = (LAS unsigned*)(lds + NSA_QM); LAS unsigned* um = (LAS unsigned*)(lds + NSA_UM);
            WSYNC();
            const int qq = F.wave * 8 + (lane >> 3), jj = lane & 7;
            unsigned key[16];
#pragma unroll
            for (int m = 0; m < 16; ++m) { const int jb = jj + 8 * m; float sv = scA[qq * 132 + jb] + scB[qq * 132 + jb];
                if (jb == 0 || jb == cblk || jb == cblk - 1) sv = 1e4f;
                key[m] = jb <= cblk ? ((__builtin_bit_cast(unsigned, sv) & ~127u) | (unsigned)(127 - jb)) : 0u; }
            WSYNC();
#pragma unroll
            for (int m = 0; m < 16; ++m) ((LAS unsigned*)scA)[qq * 132 + jj + 8 * m] = key[m];
            WSYNC();
            unsigned bits[4] = {0u, 0u, 0u, 0u};
#pragma unroll
            for (int half = 0; half < 2; ++half) { int rank[8];
#pragma unroll
                for (int m = 0; m < 8; ++m) rank[m] = 0;
#pragma unroll 2
                for (int i = 0; i <= cblk; i += 4) { const u32x4 k4 = *(const LAS u32x4*)((const LAS unsigned*)scA + qq * 132 + i);
#pragma unroll
                    for (int m = 0; m < 8; ++m) rank[m] += (k4.x > key[8 * half + m] ? 1 : 0) + (k4.y > key[8 * half + m] ? 1 : 0) + (k4.z > key[8 * half + m] ? 1 : 0) + (k4.w > key[8 * half + m] ? 1 : 0); }
#pragma unroll
                for (int m = 0; m < 8; ++m) { const int jb = jj + 8 * (8 * half + m); if (jb <= cblk && rank[m] < 16) bits[(8 * half + m) >> 2] |= 1u << (jb & 31); } }
#pragma unroll
            for (int w = 0; w < 4; ++w) if (bits[w]) { atomicOr((unsigned*)(qm + qq * 4 + w), bits[w]); atomicOr((unsigned*)(um + w), bits[w]); }
            __syncthreads();
#pragma unroll
            for (int w = 0; w < 4; ++w) qsel[w] = qm[(F.wave * 8 + q8) * 4 + w];
        }
        PSTAMP(21);
        nsa_stash_put(lds, F.wave, lane, oacc, sc_cmp);
#pragma unroll
        for (int ds = 0; ds < 2; ++ds)
#pragma unroll
            for (int i = 0; i < 16; ++i) oacc[ds][i] = 0.f;
        {
            LAS unsigned* um = (LAS unsigned*)(lds + NSA_UM);
            const unsigned long long sm0 = (unsigned long long)__builtin_amdgcn_readfirstlane(um[0]) | ((unsigned long long)__builtin_amdgcn_readfirstlane(um[1]) << 32);
            const unsigned long long sm1 = (unsigned long long)__builtin_amdgcn_readfirstlane(um[2]) | ((unsigned long long)__builtin_amdgcn_readfirstlane(um[3]) << 32);
            float ls = 0.f;
            nsa_branch<2>(F, (const bf16*)(KWS + WS_KS2) + (size_t)g * T * 64, (const bf16*)(KWS + WS_VST) + (size_t)g * 64 * T, T, sm0, sm1, Qf, t, cblk, qxw, tref, 0.f, qsel, 0, 0u, oacc, ls);
            ls += __shfl_xor(ls, 32);
            const float sc = sigmoidf_(bf2f(P[(size_t)t * NPAD + C_NG + 8 + head])) / ls;
            LAS unsigned* st = (LAS unsigned*)(lds + NSA_SCA) + F.wave * 1024 + lane;
#pragma unroll
            for (int ds = 0; ds < 2; ++ds)
#pragma unroll
                for (int k = 0; k < 8; ++k) { const unsigned w = st[(ds * 8 + k) * 64]; st[(ds * 8 + k) * 64] = pkbf(bflo(w) + sc * oacc[ds][2 * k], bfhi(w) + sc * oacc[ds][2 * k + 1]); oacc[ds][2 * k] = 0.f; oacc[ds][2 * k + 1] = 0.f; }
        }
        PSTAMP(22);
        {
            const int j0 = cblk >= 8 ? cblk - 8 : 0;
            unsigned long long wm0 = 0ull, wm1 = 0ull;
            for (int jb = j0; jb <= cblk; ++jb) { if (jb < 64) wm0 |= 1ull << jb; else wm1 |= 1ull << (jb - 64); }
            float ls = 0.f;
            nsa_branch<3>(F, (const bf16*)(KWS + WS_KW2) + (size_t)g * T * 64, (const bf16*)(KWS + WS_VWT) + (size_t)g * 64 * T, T, wm0, wm1, Qf, t, cblk, qxw, tref, 0.f, qsel, 0, 0u, oacc, ls);
            ls += __shfl_xor(ls, 32);
            const float sc = sigmoidf_(bf2f(P[(size_t)t * NPAD + C_NG + 16 + head])) / ls;
            const LAS unsigned* st = (const LAS unsigned*)(lds + NSA_SCA) + F.wave * 1024 + lane;
#pragma unroll
            for (int ds = 0; ds < 2; ++ds)
#pragma unroll
                for (int g4 = 0; g4 < 4; ++g4) { const unsigned w0 = st[(ds * 8 + 2 * g4) * 64], w1 = st[(ds * 8 + 2 * g4 + 1) * 64];
                    u32x2 w; w.x = pkbf(bflo(w0) + sc * oacc[ds][4 * g4], bfhi(w0) + sc * oacc[ds][4 * g4 + 1]); w.y = pkbf(bflo(w1) + sc * oacc[ds][4 * g4 + 2], bfhi(w1) + sc * oacc[ds][4 * g4 + 3]);
                    *(u32x2*)(OCAT + (size_t)t * 1536 + head * 64 + 32 * ds + 8 * g4 + 4 * h) = w; }
        }
        __syncthreads();
        PSTAMP(23);
    }
}

__device__ __forceinline__ void phase_merge(Frame& F) {
    KA;
    const bf16* P = (const bf16*)(KWS + WS_P); const bf16* PROJ = (const bf16*)(KWS + WS_PROJ); bf16* MG = (bf16*)(KWS + WS_MERGED);
    const size_t total = (size_t)T * D / 8;
    for (size_t it = (size_t)F.gw * 64 + F.lane; it < total; it += (size_t)F.NGW * 64) {
        const size_t t = it / (D / 8); const int d = (int)(it % (D / 8)) * 8;
        float acc[8];
#pragma unroll
        for (int k = 0; k < 8; ++k) acc[k] = 0.f;
#pragma unroll
        for (int n = 0; n < 3; ++n) { const u32x4 gq = *(const u32x4*)(P + t * NPAD + C_MG + n * D + d); const u32x4 pq = *(const u32x4*)(PROJ + ((size_t)n * T + t) * D + d);
            acc[0] += sigmoidf_(bflo(gq.x)) * bflo(pq.x); acc[1] += sigmoidf_(bfhi(gq.x)) * bfhi(pq.x); acc[2] += sigmoidf_(bflo(gq.y)) * bflo(pq.y); acc[3] += sigmoidf_(bfhi(gq.y)) * bfhi(pq.y);
            acc[4] += sigmoidf_(bflo(gq.z)) * bflo(pq.z); acc[5] += sigmoidf_(bfhi(gq.z)) * bfhi(pq.z); acc[6] += sigmoidf_(bflo(gq.w)) * bflo(pq.w); acc[7] += sigmoidf_(bfhi(gq.w)) * bfhi(pq.w); }
        u32x4 o; o.x = pk2(acc[0], acc[1]); o.y = pk2(acc[2], acc[3]); o.z = pk2(acc[4], acc[5]); o.w = pk2(acc[6], acc[7]);
        *(u32x4*)(MG + t * D + d) = o;
    }
}
__device__ __forceinline__ void phase_router(Frame& F, int l) {
    KA;
    const float* X1 = (const float*)(KWS + WS_X1); bf16* H = (bf16*)(KWS + WS_H);
    int* EID = (int*)(KWS + WS_ROUTE); float* EW = (float*)(KWS + WS_ROUTE + 65536);
    const float* gain = KIN(I_NFFN) + (size_t)l * D; const float* wg = KIN(I_WGRP) + (size_t)l * D * 4; const float* we = KIN(I_WEXP) + (size_t)l * D * 32;
    const float* bg = KIN(I_BGRP) + l * 4; const float* be = KIN(I_BEXP) + l * 32;
    for (int t = F.gw; t < T; t += F.NGW) {
        const float* xrow = X1 + (size_t)t * D;
        float ss = 0.f;
#pragma unroll 4
        for (int k = 0; k < 32; ++k) { const float x = xrow[F.lane + 64 * k]; ss += x * x; }
        const float rstd = 1.0f / sqrtf(wave_sum(ss) * (1.0f / D) + EPS);
        float ag[4] = {0.f, 0.f, 0.f, 0.f}, ae[32];
#pragma unroll
        for (int e = 0; e < 32; ++e) ae[e] = 0.f;
#pragma unroll 1
        for (int k = 0; k < 32; ++k) { const int d = F.lane + 64 * k;
            const float hv = xrow[d] * rstd * gain[d];
            H[(size_t)t * D + d] = (bf16)f2bf(hv);
            const f32x4 w4 = *(const f32x4*)(wg + (size_t)d * 4);
            ag[0] += hv * w4.x; ag[1] += hv * w4.y; ag[2] += hv * w4.z; ag[3] += hv * w4.w;
#pragma unroll
            for (int c = 0; c < 8; ++c) { const f32x4 w = *(const f32x4*)(we + (size_t)d * 32 + c * 4); ae[c * 4] += hv * w.x; ae[c * 4 + 1] += hv * w.y; ae[c * 4 + 2] += hv * w.z; ae[c * 4 + 3] += hv * w.w; } }
#pragma unroll
        for (int e = 0; e < 4; ++e) ag[e] = wave_sum(ag[e]) + bg[e];
#pragma unroll
        for (int e = 0; e < 32; ++e) ae[e] = wave_sum(ae[e]) + be[e];
        int gi = 0; float gm = ag[0];
#pragma unroll
        for (int e = 1; e < 4; ++e) if (ag[e] > gm) { gm = ag[e]; gi = e; }
        float gs = 0.f;
#pragma unroll
        for (int e = 0; e < 4; ++e) gs += expf(ag[e] - gm);
        const float gw_ = 1.0f / gs;
        float el[8];
#pragma unroll
        for (int e = 0; e < 8; ++e) { el[e] = gi == 0 ? ae[e] : (gi == 1 ? ae[8 + e] : (gi == 2 ? ae[16 + e] : ae[24 + e])); }
        int i1 = 0; float m1 = el[0];
#pragma unroll
        for (int e = 1; e < 8; ++e) if (el[e] > m1) { m1 = el[e]; i1 = e; }
        int i2 = -1; float m2 = -3.0e38f;
#pragma unroll
        for (int e = 0; e < 8; ++e) if (e != i1 && el[e] > m2) { m2 = el[e]; i2 = e; }
        const float p2 = expf(m2 - m1);
        const float w1 = 1.0f / (1.0f + p2), w2 = p2 / (1.0f + p2);
        if (F.lane == 0) { EID[2 * t] = gi * 8 + i1; EID[2 * t + 1] = gi * 8 + i2; EW[2 * t] = gw_ * w1; EW[2 * t + 1] = gw_ * w2; }
    }
}

__device__ __forceinline__ void phase_router3(Frame& F, int l) {
    KA;
    const float* X1 = (const float*)(KWS + WS_X1); unsigned char* H8 = (unsigned char*)(KWS + WS_H8);
    int* EID = (int*)(KWS + WS_ROUTE); float* EW = (float*)(KWS + WS_ROUTE + 65536); float* RSTD = (float*)(KWS + WS_RSTD);
    unsigned* CNTg = (unsigned*)(KWS + WS_CTL) + CW_CNT + 64 * l; int* LIST = (int*)(KWS + WS_ROUTE + 262144);
    const float* WRT = (const float*)(KWS + WS_WRT) + (size_t)l * 48 * D;
    const float* gain = KIN(I_NFFN) + (size_t)l * D; const float* bg = KIN(I_BGRP) + l * 4; const float* be = KIN(I_BEXP) + l * 32;
    LAS float* red = (LAS float*)F.lds;
    LAS float* ssq = (LAS float*)(F.lds + 49152);
    LAS float* lg = (LAS float*)(F.lds + 50176);
    LAS float* rs = (LAS float*)(F.lds + 55296);
    LAS int* eidl = (LAS int*)(F.lds + 55424);
    const int r16 = F.lane & 15, kq = F.lane >> 4;
    for (int blk = F.bid; blk < T / 32; blk += F.G) {
        const int tok0 = blk * 32, kb0 = F.wave * 256 + 4 * kq;
        const float* xa = X1 + (size_t)(tok0 + r16) * D + kb0;
        const float* wb = WRT + (size_t)r16 * D + kb0;
        unsigned char* hp = H8 + (size_t)(tok0 + r16) * D + kb0;
        f32x4 acc[2][3]; float sq[2] = {0.f, 0.f};
#pragma unroll
        for (int tg = 0; tg < 2; ++tg)
#pragma unroll
            for (int nt = 0; nt < 3; ++nt) acc[tg][nt] = (f32x4){0.f, 0.f, 0.f, 0.f};
#pragma unroll 2
        for (int s = 0; s < 16; ++s) { f32x4 a[2], b[3];
#pragma unroll
            for (int tg = 0; tg < 2; ++tg) a[tg] = *(const f32x4*)(xa + (size_t)(16 * tg) * D + 16 * s);
#pragma unroll
            for (int nt = 0; nt < 3; ++nt) b[nt] = *(const f32x4*)(wb + (size_t)(16 * nt) * D + 16 * s);
            const f32x4 g = *(const f32x4*)(gain + kb0 + 16 * s);
#pragma unroll
            for (int tg = 0; tg < 2; ++tg) { sq[tg] += a[tg].x * a[tg].x + a[tg].y * a[tg].y + a[tg].z * a[tg].z + a[tg].w * a[tg].w;
                *(unsigned*)(hp + (size_t)(16 * tg) * D + 16 * s) = pk4_fp8(a[tg].x * g.x * S_A1, a[tg].y * g.y * S_A1, a[tg].z * g.z * S_A1, a[tg].w * g.w * S_A1);
#pragma unroll
                for (int j = 0; j < 4; ++j)
#pragma unroll
                    for (int nt = 0; nt < 3; ++nt) acc[tg][nt] = __builtin_amdgcn_mfma_f32_16x16x4f32(a[tg][j], b[nt][j], acc[tg][nt], 0, 0, 0); } }
#pragma unroll
        for (int tg = 0; tg < 2; ++tg) { sq[tg] += __shfl_xor(sq[tg], 16); sq[tg] += __shfl_xor(sq[tg], 32);
            if (kq == 0) ssq[F.wave * 32 + 16 * tg + r16] = sq[tg];
#pragma unroll
            for (int nt = 0; nt < 3; ++nt) *(LAS f32x4*)(red + (((F.wave * 2 + tg) * 3 + nt) * 64 + F.lane) * 4) = acc[tg][nt]; }
        __syncthreads();
        if (F.tid < 384) { const int tg2 = F.tid / 192, rem = F.tid % 192, nt = rem / 64, ln = rem % 64; f32x4 v = {0.f, 0.f, 0.f, 0.f};
#pragma unroll
            for (int w = 0; w < 8; ++w) v += *(const LAS f32x4*)(red + (((w * 2 + tg2) * 3 + nt) * 64 + ln) * 4);
            const int col = 16 * nt + (ln & 15);
            if (col < 36) {
#pragma unroll
                for (int i = 0; i < 4; ++i) lg[(16 * tg2 + 4 * (ln >> 4) + i) * 40 + col] = v[i]; } }
        if (F.tid >= 384 && F.tid < 416) { const int tk = F.tid - 384; float q2 = 0.f;
#pragma unroll
            for (int w = 0; w < 8; ++w) q2 += ssq[w * 32 + tk];
            const float r = 1.0f / sqrtf(q2 * (1.0f / D) + EPS); rs[tk] = r; RSTD[tok0 + tk] = r; }
        __syncthreads();
        if (F.tid < 32) { const int tk = F.tid, t = tok0 + tk; const float rstd = rs[tk];
            float ag[4], el[8];
#pragma unroll
            for (int e = 0; e < 4; ++e) ag[e] = lg[tk * 40 + 32 + e] * rstd + bg[e];
            int gi = 0; float gm = ag[0];
#pragma unroll
            for (int e = 1; e < 4; ++e) if (ag[e] > gm) { gm = ag[e]; gi = e; }
            float gs = 0.f;
#pragma unroll
            for (int e = 0; e < 4; ++e) gs += expf(ag[e] - gm);
            const float gw_ = 1.0f / gs;
#pragma unroll
            for (int e = 0; e < 8; ++e) el[e] = lg[tk * 40 + gi * 8 + e] * rstd + be[gi * 8 + e];
            int i1 = 0; float m1 = el[0];
#pragma unroll
            for (int e = 1; e < 8; ++e) if (el[e] > m1) { m1 = el[e]; i1 = e; }
            int i2 = -1; float m2 = -3.0e38f;
#pragma unroll
            for (int e = 0; e < 8; ++e) if (e != i1 && el[e] > m2) { m2 = el[e]; i2 = e; }
            const float p2 = expf(m2 - m1), w1 = 1.0f / (1.0f + p2), w2 = p2 / (1.0f + p2);
            EID[2 * t] = gi * 8 + i1; EID[2 * t + 1] = gi * 8 + i2; EW[2 * t] = gw_ * w1; EW[2 * t + 1] = gw_ * w2;
            eidl[2 * tk] = gi * 8 + i1; eidl[2 * tk + 1] = gi * 8 + i2; }
        __syncthreads();
        LAS int* base = eidl + 64;
        if (F.tid < 32) { int c = 0;
#pragma unroll 8
            for (int i = 0; i < 64; ++i) c += eidl[i] == F.tid ? 1 : 0;
            base[F.tid] = c > 0 ? (int)__hip_atomic_fetch_add(CNTg + F.tid, (unsigned)c, __ATOMIC_RELAXED, __HIP_MEMORY_SCOPE_AGENT) : 0; }
        __syncthreads();
        if (F.tid < 64) { const int e = eidl[F.tid]; int rk = 0;
            for (int i = 0; i < F.tid; ++i) rk += eidl[i] == e ? 1 : 0;
            LIST[e * 8192 + base[e] + rk] = blk * 64 + F.tid; }
        __syncthreads();
    }
}
__device__ __forceinline__ void phase_lists2(Frame& F) {
    KA;
    const int* EID = (const int*)(KWS + WS_ROUTE); int* CNT = (int*)(KWS + WS_ROUTE + 131072); int* LIST = (int*)(KWS + WS_ROUTE + 262144); const int* HIST = (const int*)(KWS + WS_HIST);
    LAS int* off = (LAS int*)F.lds; LAS int* eidl = off + 32; LAS int* psum = off + 128;
    for (int blk = F.bid; blk < T / 32; blk += F.G) {
        { const int e = F.tid & 31, part = F.tid >> 5; int a = 0;
#pragma unroll 4
          for (int b2 = part; b2 < blk; b2 += 16) a += HIST[b2 * 32 + e];
          psum[part * 32 + e] = a; }
        __syncthreads();
        if (F.tid < 32) { int a = 0;
#pragma unroll
            for (int p = 0; p < 16; ++p) a += psum[p * 32 + F.tid];
            off[F.tid] = a;
            if (blk == T / 32 - 1) CNT[F.tid] = a + HIST[blk * 32 + F.tid]; }
        if (F.tid >= 64 && F.tid < 128) eidl[F.tid - 64] = EID[blk * 64 + F.tid - 64];
        __syncthreads();
        if (F.tid < 64) { const int e = eidl[F.tid]; int rk = 0;
            for (int i = 0; i < F.tid; ++i) rk += eidl[i] == e ? 1 : 0;
            LIST[e * 8192 + off[e] + rk] = blk * 64 + F.tid; }
        __syncthreads();
    }
}

__device__ __forceinline__ void phase_lists(Frame& F) {
    KA;
    const int e = F.bid;
    if (e >= NE) return;
    const int* EID = (const int*)(KWS + WS_ROUTE); int* CNT = (int*)(KWS + WS_ROUTE + 131072); int* LIST = (int*)(KWS + WS_ROUTE + 262144);
    LAS int* wc = (LAS int*)F.lds;
    int run = 0;
    for (int base = 0; base < 2 * T; base += 512) {
        const int idx = base + F.tid; const bool match = EID[idx] == e;
        const unsigned long long b = __ballot(match);
        if (F.lane == 0) wc[F.wave] = __popcll(b);
        __syncthreads();
        int pre = 0, tot = 0;
#pragma unroll
        for (int w = 0; w < 8; ++w) { const int c = wc[w]; pre += w < F.wave ? c : 0; tot += c; }
        if (match) LIST[e * 8192 + run + pre + __popcll(b & ((1ull << F.lane) - 1ull))] = idx;
        run += tot;
        __syncthreads();
    }
    if (F.tid == 0) CNT[e] = run;
}
__device__ __forceinline__ void moe_table(Frame& F, LAS int* tb, int l) {
    KA;
    const int* CNT = (const int*)(KWS + WS_CTL) + CW_CNT + 64 * l;
    if (F.tid == 0) { int a = 0, f = 0, h = 0;
        for (int e = 0; e < NE; ++e) { const int n = CNT[e], nt = (n + 255) / 256, lastv = n - (nt - 1) * 256, hh = (nt > 0 && lastv <= 128) ? 1 : 0;
            tb[e] = a; tb[33 + e] = f; tb[66 + e] = h; a += nt; f += nt - hh; h += hh; }
        tb[NE] = a; tb[33 + NE] = f; tb[66 + NE] = h; }
    __syncthreads();
}

constexpr int PH_PER_LAYER = 7, N_PHASES = 1 + NL * PH_PER_LAYER + 1;

__global__ void __launch_bounds__(512, 2) mk_fwd(Args args) {
    extern __shared__ __attribute__((aligned(16))) unsigned char lds_raw[];
#define FRAME Frame F; F.lds = (LAS unsigned char*)lds_raw; F.MISC = (volatile LAS unsigned*)(F.lds + MISC_OFF); F.tid = ltid(); F.lane = F.tid & 63; F.wave = __builtin_amdgcn_readfirstlane(F.tid >> 6); \
    F.G = gridDim.x; F.bid = lbid(); F.vcu = (F.G % 8 == 0) ? (F.bid % 8) * (F.G / 8) + F.bid / 8 : F.bid; F.gw = F.bid * 8 + F.wave; F.NGW = F.G * 8;
    unsigned* const ctl = (unsigned*)((unsigned char*)args.ws + WS_CTL);
    for (int u = threadIdx.x; u < (LDS_BYTES - MISC_OFF) / 4; u += 512) ((LAS unsigned*)(lds_raw + MISC_OFF))[u] = 0u;
    __syncthreads();
    const int lo = args.ph_lo, hi = args.ph_hi;
    XcdBarrier bar; bar.bar = ctl + CW_BAR + args.li * XCD_BAR_WORDS; bar.x = 0; bar.st = nullptr;
    if (hi - lo > 1) bar = xcd_barrier_post(ctl + CW_BAR + args.li * XCD_BAR_WORDS, (volatile LAS unsigned*)((LAS unsigned char*)lds_raw + MISC_OFF));
    int ph = 0;
#define RUN(k) ((k) >= lo && (k) < hi)

    volatile LAS unsigned long long* const tacc = (volatile LAS unsigned long long*)((LAS unsigned char*)lds_raw + MISC_OFF + 512);
    if (MK_PROBE_MASK != 0 && blockIdx.x == MK_PROBE_BID && threadIdx.x == 0) tacc[16] = wall_clock64();
#define STAMP(slot) do { if (MK_PROBE_MASK != 0 && lbid() == MK_PROBE_BID && ltid() == 0) { const unsigned long long _n = wall_clock64(); tacc[slot] += _n - tacc[16]; tacc[16] = _n; } } while (0)
#define SEAM(k, slot) do { if ((k) + 1 < hi) xcd_barrier(bar); STAMP(slot); } while (0)
    LAS int* const tb = (LAS int*)((LAS unsigned char*)lds_raw + MISC_OFF + 64);

    if (RUN(ph)) { KA; FRAME; phase_prologue(F); phase_norm1<0>(F, KIN(I_X), nullptr, nullptr, KIN(I_NMIX), (bf16*)(KWS + WS_H), (unsigned char*)(KWS + WS_H8)); SEAM(ph, 0); }
    ++ph;
    for (int l = 0; l < NL; ++l) {
        if (RUN(ph)) { KA; FRAME;
            {
              pg8::PlainSched S; S.init(KWS + WS_H, D, (const bf16*)(KWS + WS_WIN) + (size_t)l * NPAD * D, T, 20 * 256, D, F.G, F.bid, 4); S.pn_from = 19; S.pn_to = 43;
              pg8::EpiBf16 E{(bf16*)(KWS + WS_P), NPAD, 1.0f};
              pg8::gemm_phase<pg8::EpiBf16, pg8::PlainSched, true>(F.lds, D, S, E); }
            __syncthreads();
            {
              pg8::PlainSchedT<true> S; S.init(KWS + WS_H8, D, (const unsigned char*)(KWS + WS_WIN8) + (size_t)l * 6144 * D, T, 6144, D, F.G, F.bid, 0);
              pg8::EpiBf16 E{(bf16*)(KWS + WS_P) + C_MG, NPAD, 1.0f / (S_H * S_WG)};
              pg8::gemm_phase<pg8::EpiBf16, pg8::PlainSchedT<true>, true>(F.lds, D, S, E); }
            SEAM(ph, 1); }
        ++ph;
        if (RUN(ph)) { KA; FRAME; phase_prep3(F, l); __syncthreads(); phase_compress3(F, l); phase_rec_local(F, l); SEAM(ph, 3); }
        ++ph;
        if (RUN(ph)) { KA; FRAME; if (F.bid < 96) { phase_rec_scan(F);
                asm volatile("s_waitcnt vmcnt(0)" ::: "memory"); __syncthreads();
                if (F.tid == 0) { __builtin_amdgcn_fence(__ATOMIC_RELEASE, "agent"); asm volatile("s_waitcnt vmcnt(0)" ::: "memory");
                    __hip_atomic_fetch_add((unsigned*)(KWS + WS_CTL) + 2048 + 64 * (4 + l), 1u, __ATOMIC_RELAXED, __HIP_MEMORY_SCOPE_AGENT); } }
            phase_nsa2(F, l); phase_rec_out(F, l); SEAM(ph, 5); }
        ++ph;
        if (RUN(ph)) { KA; FRAME;
            { pg8::BranchSched S; S.init((const bf16*)(KWS + WS_OCAT), (const bf16*)(KWS + WS_WBR) + (size_t)l * 3 * D * 512, F.G, F.bid);
              pg8::EpiMerge E{(bf16*)(KWS + WS_MERGED), (const bf16*)(KWS + WS_P) + C_MG};
              pg8::gemm_phase<pg8::EpiMerge, pg8::BranchSched, true>(F.lds, 512, S, E); }
            SEAM(ph, 6); }
        ++ph;

        if (RUN(ph)) { KA; FRAME; pg8::PlainSched S; S.init((const bf16*)(KWS + WS_MERGED), D, (const bf16*)(KWS + WS_WOUT) + (size_t)l * D * D, T, D, D, F.G, F.bid);
            pg8::EpiResF32 E{l == 0 ? KIN(I_X) : (const float*)(KWS + WS_XRES), (float*)(KWS + WS_X1), D};
            pg8::gemm_phase<pg8::EpiResF32, pg8::PlainSched, false>(F.lds, D, S, E); SEAM(ph, 8); }
        ++ph;
        if (RUN(ph)) { KA; FRAME; phase_router3(F, l); SEAM(ph, 9); }
        ++ph;
        if (RUN(ph)) { KA; FRAME; moe_table(F, tb, l);
            unsigned* tilecnt = (unsigned*)(KWS + WS_CTL) + 131072 + (size_t)l * 128 * 64;
            { pg8::MoeSched<1> S; S.init(F.G, F.vcu, tb, (const int*)(KWS + WS_CTL) + CW_CNT + 64 * l, (const int*)(KWS + WS_ROUTE + 262144), KWS + WS_H8, (const unsigned char*)(KWS + WS_WGU) + (size_t)l * NE * 1024 * D);
              S.tilecnt = tilecnt; S.tick = nullptr; S.tslot = nullptr; S.myticket = 0;
              pg8::EpiMoe1 E{(unsigned char*)(KWS + WS_ACT), (const int*)(KWS + WS_ROUTE + 262144), (const float*)(KWS + WS_ROUTE + 65536), (const float*)(KWS + WS_RSTD)};
              pg8::gemm_phase<pg8::EpiMoe1, pg8::MoeSched<1>, true>(F.lds, D, S, E); }
            __syncthreads();
            { pg8::MoeSched<2> S; S.init(F.G, F.vcu, tb, (const int*)(KWS + WS_CTL) + CW_CNT + 64 * l, (const int*)(KWS + WS_ROUTE + 262144), KWS + WS_ACT, (const unsigned char*)(KWS + WS_WDN) + (size_t)l * NE * D * FF);
              S.tilecnt = tilecnt; S.tick = (unsigned*)(KWS + WS_CTL) + 2048 + 64 * (6 + l); S.tslot = (volatile LAS int*)(F.lds + MISC_OFF + 1028); S.myticket = 0;
              pg8::EpiMoe2 E{(bf16*)(KWS + WS_CONTRIB), (const int*)(KWS + WS_ROUTE + 262144)};
              pg8::gemm_phase<pg8::EpiMoe2, pg8::MoeSched<2>, true>(F.lds, FF, S, E); }
            SEAM(ph, 12); }
        ++ph;
        if (l + 1 < NL) { if (RUN(ph)) { KA; FRAME; phase_norm1<1>(F, (const float*)(KWS + WS_X1), (const bf16*)(KWS + WS_CONTRIB), (float*)(KWS + WS_XRES), KIN(I_NMIX) + (size_t)(l + 1) * D, (bf16*)(KWS + WS_H), (unsigned char*)(KWS + WS_H8)); SEAM(ph, 13); } ++ph; }
    }
    if (RUN(ph)) { KA; FRAME; phase_norm1<2>(F, (const float*)(KWS + WS_X1), (const bf16*)(KWS + WS_CONTRIB), KOUT, nullptr, nullptr); }
    if (MK_PROBE_MASK != 0 && lbid() == MK_PROBE_BID && ltid() == 0) {
        asm volatile("s_waitcnt vmcnt(0)" ::: "memory"); STAMP(15);
        unsigned long long tot = 0ull;
        for (int k2 = 0; k2 < 32; ++k2) if (k2 != 16 && ((MK_PROBE_MASK >> k2) & 1)) tot += tacc[k2];
        const unsigned long long t_end = wall_clock64() + 4ull * tot;
        while (wall_clock64() < t_end) __builtin_amdgcn_s_sleep(8);
    }
#undef RUN
#undef SEAM
}

#ifndef MK_PER_PHASE
#define MK_PER_PHASE 0
#endif
extern "C" void kernel_launch(void* const* d_in, const int* in_sizes, int n_in, void* d_out, int out_size, void* d_ws, size_t ws_size, hipStream_t stream) {
    static int grid = 0;
    if (grid == 0) {
        if (n_in != 22 || out_size != T * D || ws_size < WS_END) { fprintf(stderr, "kernel_launch: unexpected sizes (n_in %d out %d ws %zu)\n", n_in, out_size, ws_size); grid = -1; return; }
        int dev = 0, cus = 0, per_cu = 0;
        if (hipGetDevice(&dev) != hipSuccess || hipDeviceGetAttribute(&cus, hipDeviceAttributeMultiprocessorCount, dev) != hipSuccess) { grid = -1; return; }
        if (hipFuncSetAttribute((const void*)mk_fwd, hipFuncAttributeMaxDynamicSharedMemorySize, LDS_BYTES) != hipSuccess) { fprintf(stderr, "kernel_launch: hipFuncSetAttribute failed\n"); grid = -1; return; }
        if (hipOccupancyMaxActiveBlocksPerMultiprocessor(&per_cu, (const void*)mk_fwd, 512, LDS_BYTES) != hipSuccess || per_cu < 1) { fprintf(stderr, "kernel_launch: occupancy query says %d\n", per_cu); }
        (void)hipGetLastError();
        grid = cus;
    }
    if (grid < 0) return;
    if (hipMemsetAsync((char*)d_ws + WS_CTL, 0, CTL_ZERO_BYTES, stream) != hipSuccess) return;
    Args a{};
    for (int i = 0; i < 22; ++i) a.in[i] = (const GAS float*)d_in[i];
    a.out = (GAS float*)d_out; a.ws = (GAS unsigned char*)d_ws;
#if MK_PER_PHASE
    const int total = 1 + NL * PH_PER_LAYER + (NL - 1) + 1;
    for (int k = 0; k < total; ++k) { a.ph_lo = k; a.ph_hi = k + 1; a.li = 0; hipLaunchKernelGGL(mk_fwd, dim3(grid), dim3(512), LDS_BYTES, stream, a); }
#else
    a.ph_lo = 0; a.ph_hi = 1000; a.li = 0;
    hipLaunchKernelGGL(mk_fwd, dim3(grid), dim3(512), LDS_BYTES, stream, a);
#endif
    const hipError_t le = hipPeekAtLastError();
    if (le != hipSuccess) fprintf(stderr, "kernel_launch: launch failed: %s\n", hipGetErrorName(le));
}
```

```cpp
#include <hip/hip_runtime.h>
#include <cstdio>
#include <cstdint>

#ifndef MK_PROBE_MASK
#define MK_PROBE_MASK 0
#endif
#ifndef MK_PROBE_BID
#define MK_PROBE_BID 0
#endif
#define GAS __attribute__((address_space(1)))
#define LAS __attribute__((address_space(3)))
typedef unsigned short bf16;
typedef short bf16x8 __attribute__((ext_vector_type(8)));
typedef float f32x4 __attribute__((ext_vector_type(4)));
typedef float f32x2 __attribute__((ext_vector_type(2)));
typedef unsigned u32x4 __attribute__((ext_vector_type(4)));
typedef unsigned u32x2 __attribute__((ext_vector_type(2)));
typedef long i64x2 __attribute__((ext_vector_type(2)));
typedef int i32x4 __attribute__((ext_vector_type(4)));
typedef int i32x8 __attribute__((ext_vector_type(8)));
typedef long i64x4 __attribute__((ext_vector_type(4)));

constexpr int T = 8192, D = 2048, NL = 2, INC = 11048, NPAD = 11264;
constexpr int NE = 32, FF = 512, NCH = T / 64;
constexpr float EPS = 1e-6f, NEGB = -1e30f;
constexpr int C_Q = 0, C_KC = 512, C_VC = 640, C_KS = 768, C_VS = 896, C_KW = 1024, C_VW = 1152;
constexpr int C_HQ = 1280, C_HF = 1792, C_HI = 2304, C_HG = 2816, C_GQ = 3328, C_GK = 3584, C_GV = 3840, C_GR = 4352;
constexpr int C_MG = 4864, C_NG = 11008, C_GA = 11032;

constexpr size_t MiB = 1u << 20;
constexpr size_t WS_CTL = 0, CTL_ZERO_BYTES = 1 * MiB;
constexpr size_t WS_WIN = 2 * MiB;
constexpr size_t WS_WBR = 90 * MiB;
constexpr size_t WS_WOUT = 102 * MiB;
constexpr size_t WS_WGU = 118 * MiB;
constexpr size_t WS_WDN = 374 * MiB;
constexpr size_t WS_H = 502 * MiB;
constexpr size_t WS_P = 534 * MiB;
constexpr size_t WS_OCAT = 710 * MiB;
constexpr size_t WS_PROJ = 734 * MiB;
constexpr size_t WS_MERGED = 830 * MiB;
constexpr size_t WS_X1 = 862 * MiB;
constexpr size_t WS_XRES = 926 * MiB;
constexpr size_t WS_CONTRIB = 990 * MiB;
constexpr size_t WS_ACT = 1054 * MiB;
constexpr size_t WS_QN = 1078 * MiB;
constexpr size_t WS_KV = 1094 * MiB;
constexpr size_t WS_KC = 1118 * MiB;
constexpr size_t WS_ORAW = 1119 * MiB;
constexpr size_t WS_ROUTE = 1151 * MiB;
constexpr size_t WS_SLOC_HG = 1153 * MiB;
constexpr size_t WS_SLOC_GL = 1185 * MiB;
constexpr size_t WS_SPREV_HG = 1201 * MiB;
constexpr size_t WS_SPREV_GL = 1217 * MiB;
constexpr size_t WS_DEC = 1225 * MiB;
constexpr size_t WS_QS = 1226 * MiB;
constexpr size_t WS_KS2 = 1234 * MiB;
constexpr size_t WS_KW2 = 1236 * MiB;
constexpr size_t WS_VST = 1238 * MiB;
constexpr size_t WS_VWT = 1240 * MiB;
constexpr size_t WS_KCB = 1242 * MiB;
constexpr size_t WS_WRT = 1243 * MiB;
constexpr size_t WS_HIST = 1244 * MiB;
constexpr size_t WS_CW = 1245 * MiB;
constexpr size_t WS_H8 = 1248 * MiB;
constexpr size_t WS_RSTD = 1247 * MiB;
constexpr size_t WS_WIN8 = 1264 * MiB;
constexpr size_t WS_END = 1288 * MiB;
constexpr size_t KV_STRIDE = (size_t)2 * T * 64;
constexpr int CW_BAR = 4096;
constexpr int CW_CNT = 3072;

constexpr int RING_BYTES = 131072;
constexpr int LDS_BYTES = 147456;
constexpr int MISC_OFF = LDS_BYTES - 2048;

#define LDS_WAIT() asm volatile("s_waitcnt lgkmcnt(0)" ::: "memory")
#define VM_WAIT() asm volatile("s_waitcnt vmcnt(0)" ::: "memory")
#define WSYNC() asm volatile("s_waitcnt lgkmcnt(0)" ::: "memory")

__device__ __forceinline__ unsigned f2bf(float f) { unsigned u = __builtin_bit_cast(unsigned, f); return (u + 0x7fffu + ((u >> 16) & 1u)) >> 16; }
__device__ __forceinline__ unsigned pk2(float lo, float hi) { return f2bf(lo) | (f2bf(hi) << 16); }
__device__ __forceinline__ float bf2f(unsigned b) { return __builtin_bit_cast(float, (b & 0xffffu) << 16); }
__device__ __forceinline__ float bflo(unsigned w) { return __builtin_bit_cast(float, w << 16); }
__device__ __forceinline__ float bfhi(unsigned w) { return __builtin_bit_cast(float, w & 0xffff0000u); }
__device__ __forceinline__ int ltid();
__device__ __forceinline__ float lshx(float v, int o) { const int l = ltid() & 63; return __builtin_bit_cast(float, __builtin_amdgcn_ds_bpermute((l ^ o) << 2, __builtin_bit_cast(int, v))); }
__device__ __forceinline__ float wave_sum(float v) {
#pragma unroll
    for (int o = 1; o < 64; o <<= 1) v += lshx(v, o);
    return v;
}
__device__ __forceinline__ float wave_max(float v) {
#pragma unroll
    for (int o = 1; o < 64; o <<= 1) v = fmaxf(v, lshx(v, o));
    return v;
}
__device__ __forceinline__ int ltid() { int t = threadIdx.x; asm volatile("" : "+v"(t)); return t; }
__device__ __forceinline__ int lbid() { int b = blockIdx.x; asm volatile("" : "+s"(b)); return b; }
constexpr float S_A1 = 16.f, S_W1 = 1024.f, S_ACT = 8.f, S_W2 = 512.f, S_H = 16.f, S_WG = 1024.f;
__device__ __forceinline__ float clamp8(float v) { return fminf(fmaxf(v, -224.f), 224.f); }
__device__ __forceinline__ unsigned pk4_fp8(float a, float b, float c, float d) { int w = __builtin_amdgcn_cvt_pk_fp8_f32(clamp8(a), clamp8(b), 0, false); w = __builtin_amdgcn_cvt_pk_fp8_f32(clamp8(c), clamp8(d), w, true); return (unsigned)w; }
typedef __bf16 bf16x2_t __attribute__((ext_vector_type(2)));
__device__ __forceinline__ unsigned pkbf(float lo, float hi) { const f32x2 v = {lo, hi}; return __builtin_bit_cast(unsigned, __builtin_convertvector(v, bf16x2_t)); }
constexpr float LOG2E = 1.4426950408889634f;
__device__ __forceinline__ float sigmoidf_(float x) { return 1.0f / (1.0f + expf(-x)); }
__device__ __forceinline__ float fsig(float x) { return __builtin_amdgcn_rcpf(1.0f + __builtin_amdgcn_exp2f(-LOG2E * x)); }

#define GSTAMP(lds_, slot) do { if (MK_PROBE_MASK != 0 && lbid() == MK_PROBE_BID && ltid() == 0) { volatile LAS unsigned long long* _ta = (volatile LAS unsigned long long*)((lds_) + MISC_OFF + 512); const unsigned long long _n = wall_clock64(); _ta[slot] += _n - _ta[16]; _ta[16] = _n; } } while (0)
#define XB_TMO      128
#define XB_XCNT(j)  (256  + 64 * (j))
#define XB_XSUB(j)  (1280 + 64 * (j))
#define XB_XGEN(j)  (2304 + 64 * (j))
#define XB_TOP      3328
#define XB_TOPGEN   3392
#define XCD_BAR_WORDS 3456
#define XB_SPIN_CAP (1u << 25)

__device__ __forceinline__ unsigned xb_ld(unsigned* p)              { return __hip_atomic_load(p, __ATOMIC_RELAXED, __HIP_MEMORY_SCOPE_AGENT); }
__device__ __forceinline__ unsigned xb_add(unsigned* p, unsigned v) { return __hip_atomic_fetch_add(p, v, __ATOMIC_RELAXED, __HIP_MEMORY_SCOPE_AGENT); }
__device__ __forceinline__ unsigned xb_xcc_id() { return (unsigned)__builtin_amdgcn_s_getreg((3 << 11) | 20) & 0xFu; }
#define XB_SPIN(cond, bar) do { unsigned _sp = 0; while (cond) { __builtin_amdgcn_s_sleep(1); \
    if ((++_sp & 255u) == 0u) { if (xb_ld(&(bar)[XB_TMO])) break; if (_sp > XB_SPIN_CAP) { atomicAdd(&(bar)[XB_TMO], 1u); break; } } } } while (0)

struct XcdBarrier { unsigned* bar; unsigned x; volatile LAS unsigned* st; };

__device__ __forceinline__ XcdBarrier xcd_barrier_post(unsigned* bar, volatile LAS unsigned* st) {
    XcdBarrier b; b.bar = bar; b.x = xb_xcc_id(); b.st = st;
    if (threadIdx.x == 0) (void)xb_add(&bar[XB_XCNT(b.x)], 1u);
    return b;
}
__device__ __forceinline__ void xcd_barrier_complete(unsigned* bar, unsigned x, unsigned& nloc, unsigned& nx) {
    const unsigned G = gridDim.x * gridDim.y * gridDim.z;
    unsigned sum, cnt, mine, sp = 0u;
    for (;;) {
        sum = 0u; cnt = 0u; mine = 0u;
#pragma unroll
        for (unsigned j = 0; j < 16; ++j) { const unsigned c = xb_ld(&bar[XB_XCNT(j)]); sum += c; cnt += (c > 0u) ? 1u : 0u; mine = (j == x) ? c : mine; }
        if (sum == G) break;
        __builtin_amdgcn_s_sleep(1);
        if ((++sp & 255u) == 0u) { if (xb_ld(&bar[XB_TMO])) break; if (sp > XB_SPIN_CAP) { atomicAdd(&bar[XB_TMO], 1u); break; } }
    }
    nloc = mine > 0u ? mine : 1u; nx = cnt > 0u ? cnt : 1u;
}
__device__ __forceinline__ void xcd_barrier(const XcdBarrier& b) {
    asm volatile("s_waitcnt vmcnt(0)" ::: "memory");
    __syncthreads();
    if (threadIdx.x == 0) {
        unsigned* bar = b.bar;
        __builtin_amdgcn_s_waitcnt(0);
        unsigned nloc = b.st[0], nx = b.st[1];
        if (nloc == 0u) { xcd_barrier_complete(bar, b.x, nloc, nx); b.st[0] = nloc; b.st[1] = nx; }
        const unsigned old = xb_add(&bar[XB_XSUB(b.x)], 1u);
        const unsigned gen = old / nloc;
        if (old + 1u == (gen + 1u) * nloc) {
            __builtin_amdgcn_fence(__ATOMIC_RELEASE, "agent");
            asm volatile("s_waitcnt vmcnt(0)" ::: "memory");
            const unsigned og = xb_add(&bar[XB_TOP], 1u);
            const unsigned tg = og / nx;
            if (og + 1u == (tg + 1u) * nx) xb_add(&bar[XB_TOPGEN], 1u);
            else XB_SPIN(xb_ld(&bar[XB_TOPGEN]) == tg, bar);
            __builtin_amdgcn_fence(__ATOMIC_ACQUIRE, "agent");
            xb_add(&bar[XB_XGEN(b.x)], 1u);
            asm volatile("s_waitcnt vmcnt(0)" ::: "memory");
        } else {
            XB_SPIN(xb_ld(&bar[XB_XGEN(b.x)]) == gen, bar);
            __builtin_amdgcn_fence(__ATOMIC_ACQUIRE, "agent");
            asm volatile("s_waitcnt vmcnt(0)" ::: "memory");
        }
    }
    __syncthreads();
}

namespace pg8 {
constexpr int BM = 256, BK = 64, HALF = 128, HTB = HALF * BK * 2, STAGE_BYTES = 8 * HTB, NXCD = 8, WGM = 8;
__host__ __device__ __forceinline__ int lds_byte(int r, int c) { const int st = (r >> 4) * 2 + (c >> 5), rr = r & 15, cc = c & 31, ob = rr * 64 + cc * 2; return st * 1024 + (ob ^ (((ob >> 9) & 1) << 5)); }
__host__ __device__ __forceinline__ void stage_rc(int b, int& R, int& C) { const int st = b / 1024, sb = b % 1024, swz = sb ^ (((sb >> 9) & 1) << 5); R = (st >> 1) * 16 + swz / 64; C = (st & 1) * 32 + (swz % 64) / 2; }
__host__ __device__ __forceinline__ int perm32(int rho) { const int n = rho >> 4, i = rho & 15; return 8 * (i >> 2) + 4 * n + (i & 3); }

struct Unit { int pm, pn, e, nvalid, slot0, half, row0; const char *A0, *A1, *B0, *B1; unsigned va[2][2]; };

__device__ __forceinline__ unsigned cvt_pk_bf16(float lo, float hi) { unsigned r; asm volatile("v_cvt_pk_bf16_f32 %0, %1, %2" : "=v"(r) : "v"(lo), "v"(hi)); return r; }

template <class Epi, class Sched, bool ALIGN_EPI>
__device__ __forceinline__ void gemm_phase(LAS unsigned char* lds, const int K, const Sched& S, const Epi& E) {
    const int tid = ltid(), wid = __builtin_amdgcn_readfirstlane(tid >> 6), lane = tid & 63, wr = wid >> 2, wc = wid & 3, fr = lane & 15, fq = lane >> 4;
    const int nt = Sched::FP8 ? K / 128 : K / BK;
    unsigned voffB[2];
#pragma unroll
    for (int i = 0; i < 2; ++i) { int R, C; stage_rc(tid * 16 + i * 8192, R, C); const int Rb = Epi::PERM ? ((R & ~31) + perm32(R & 31)) : R; voffB[i] = Sched::FP8 ? (unsigned)(Rb * K + C * 2) : (unsigned)(Rb * K + C) * 2u; }
    const size_t kstep = (size_t)(BK * 2);
    const unsigned ldsw = (unsigned)wid * 1024u;
    const int aoff = lds_byte(wr * 64 + fr, fq * 8), boff = lds_byte(wc * 32 + fr, fq * 8);
#define PG8_SA(b, h) (((b) * 2 + (h)) * HTB)
#define PG8_SB(b, h) ((4 + (b) * 2 + (h)) * HTB)
#define PG8_STAGE(bufoff, gbase, voff) do { _Pragma("unroll") for (int _i = 0; _i < 2; ++_i) { \
        if constexpr (Sched::SC8) __builtin_amdgcn_raw_ptr_buffer_load_lds(rsrc, (LAS unsigned*)(lds + (bufoff) + ldsw + _i * 8192), 16, (int)(voff)[0], (int)((const char*)(gbase) - wsb) + _i * 64 * K, 0, 0); \
        else __builtin_amdgcn_global_load_lds((const unsigned*)((const char*)(gbase) + (voff)[_i]), (LAS unsigned*)(lds + (bufoff) + ldsw + _i * 8192), 16, 0, 0); } } while (0)
    const char* wsb = S.wsb;
    __amdgpu_buffer_rsrc_t rsrc = __builtin_amdgcn_make_buffer_rsrc((void*)wsb, 0, 0x7fffffff, 0x00020000);
#define PG8_LD16(off_) __builtin_bit_cast(i32x4, *(const LAS bf16x8*)(lds + (off_)))
#define PG8_LD16B(off_) __builtin_bit_cast(i32x4, *(const LAS bf16x8*)(ldsB + (off_)))
    LAS unsigned char* ldsB = lds + 4 * HTB + boff; asm volatile("" : "+v"(ldsB));
#define PG8_LDA(dst, b, h) do { if constexpr (Sched::SC8) { _Pragma("unroll") for (int m = 0; m < 4; ++m) dst##8[m] = __builtin_shufflevector(PG8_LD16(PG8_SA(b, h) + aoff + m * 2048), PG8_LD16(PG8_SA(b, h) + aoff + m * 2048 + 1024), 0, 1, 2, 3, 4, 5, 6, 7); } \
        else { _Pragma("unroll") for (int m = 0; m < 4; ++m) _Pragma("unroll") for (int k = 0; k < 2; ++k) dst[m][k] = *(const LAS bf16x8*)(lds + PG8_SA(b, h) + aoff + m * 2048 + k * 1024); } } while (0)
#define PG8_LDB(dst, b, h) do { if constexpr (Sched::SC8) { _Pragma("unroll") for (int n = 0; n < 2; ++n) dst##8[n] = __builtin_shufflevector(PG8_LD16B(((b) * 2 + (h)) * HTB + n * 2048), PG8_LD16B(((b) * 2 + (h)) * HTB + n * 2048 + 1024), 0, 1, 2, 3, 4, 5, 6, 7); } \
        else { _Pragma("unroll") for (int n = 0; n < 2; ++n) _Pragma("unroll") for (int k = 0; k < 2; ++k) dst[n][k] = *(const LAS bf16x8*)(lds + PG8_SB(b, h) + boff + n * 2048 + k * 1024); } } while (0)
#define PG8_MMA(ai, bj, At, Bt) do { __builtin_amdgcn_s_setprio(1); \
        if constexpr (Sched::SC8) {   \
            _Pragma("unroll") for (int m = 0; m < 4; ++m) _Pragma("unroll") for (int n = 0; n < 2; ++n) \
                acc[ai][bj][m][n] = __builtin_amdgcn_mfma_scale_f32_16x16x128_f8f6f4(Bt##8[n], At##8[m], acc[ai][bj][m][n], 0, 0, 0, 0x7f7f7f7f, 0, 0x7f7f7f7f); } \
        else if constexpr (Sched::FP8) { _Pragma("unroll") for (int m = 0; m < 4; ++m) _Pragma("unroll") for (int n = 0; n < 2; ++n) _Pragma("unroll") for (int k = 0; k < 2; ++k) { \
                const i64x2 b8_ = __builtin_bit_cast(i64x2, Bt[n][k]), a8_ = __builtin_bit_cast(i64x2, At[m][k]); \
                acc[ai][bj][m][n] = __builtin_amdgcn_mfma_f32_16x16x32_fp8_fp8(b8_[0], a8_[0], acc[ai][bj][m][n], 0, 0, 0); acc[ai][bj][m][n] = __builtin_amdgcn_mfma_f32_16x16x32_fp8_fp8(b8_[1], a8_[1], acc[ai][bj][m][n], 0, 0, 0); } } \
        else { _Pragma("unroll") for (int m = 0; m < 4; ++m) _Pragma("unroll") for (int n = 0; n < 2; ++n) _Pragma("unroll") for (int k = 0; k < 2; ++k) \
            acc[ai][bj][m][n] = __builtin_amdgcn_mfma_f32_16x16x32_bf16(Bt[n][k], At[m][k], acc[ai][bj][m][n], 0, 0, 0); } __builtin_amdgcn_s_setprio(0); } while (0)
#define PG8_WAIT_V(n) asm volatile("s_waitcnt vmcnt(" #n ")" ::: "memory")
#define PG8_WAIT_L(n) asm volatile("s_waitcnt lgkmcnt(" #n ")" ::: "memory")
#define PG8_BAR __builtin_amdgcn_s_barrier()
#define PG8_SCHED __builtin_amdgcn_sched_barrier(0)
#define VA(u, h) (Sched::GATHER ? (u).va[h] : S.va)
    Unit cur, nxt; int ui = 0;
    if constexpr (Sched::DYN) { S.ticket_issue(); S.ticket_publish(); __syncthreads(); }
    if (!S.next(0, cur)) return;
    if constexpr (Sched::DYN) { __syncthreads(); S.ticket_issue(); S.ticket_publish(); __syncthreads(); }
    S.a_ready(cur);
    if (S.probe) GSTAMP(lds, 27);
    f32x4 acc[2][2][4][2];
#define PG8_ZERO4(zz) f32x4 zz; asm volatile("v_mov_b32 %0, 0" : "=v"(zz[0])); asm volatile("v_mov_b32 %0, 0" : "=v"(zz[1])); asm volatile("v_mov_b32 %0, 0" : "=v"(zz[2])); asm volatile("v_mov_b32 %0, 0" : "=v"(zz[3]))
    if constexpr (!Sched::SC8) { PG8_ZERO4(zi);
#pragma unroll
    for (int a = 0; a < 2; ++a)
#pragma unroll
        for (int b = 0; b < 2; ++b)
#pragma unroll
            for (int m = 0; m < 4; ++m)
#pragma unroll
                for (int n = 0; n < 2; ++n) acc[a][b][m][n] = zi;
    }
    bf16x8 At[4][2], B0[2][2], B1[2][2];
    i32x8 At8[4], B08[2], B18[2];
    PG8_STAGE(PG8_SB(0, 0), cur.B0, voffB); PG8_STAGE(PG8_SB(0, 1), cur.B1, voffB); PG8_STAGE(PG8_SA(0, 0), cur.A0, VA(cur, 0)); PG8_STAGE(PG8_SA(0, 1), cur.A1, VA(cur, 1));
    if (wr == 1) PG8_BAR;
    PG8_WAIT_V(2); PG8_BAR;
    PG8_STAGE(PG8_SB(1, 0), cur.B0 + kstep, voffB); PG8_STAGE(PG8_SA(1, 0), cur.A0 + kstep, VA(cur, 0)); PG8_STAGE(PG8_SB(1, 1), cur.B1 + kstep, voffB);
    PG8_WAIT_V(6); PG8_BAR;
    for (;;) {
        bool has_next = false;
        if constexpr (Sched::SC8) {
            PG8_ZERO4(zz);
#pragma unroll
            for (int a = 0; a < 2; ++a)
#pragma unroll
                for (int b = 0; b < 2; ++b)
#pragma unroll
                    for (int m = 0; m < 4; ++m)
#pragma unroll
                        for (int n = 0; n < 2; ++n) acc[a][b][m][n] = zz;
        }
        if constexpr (Sched::DYN) { S.ticket_issue(); nxt = cur; }
        else { has_next = S.next(ui + 1, nxt); if (!has_next) nxt = cur; }
        for (int t = 0; t < nt; t += 2) {
            if constexpr (Sched::DYN) { if (t == nt - 4) { has_next = S.next(ui + 1, nxt); if (!has_next) nxt = cur; } if (t == nt - 2) S.ticket_publish(); }
            const bool last = (t == nt - 2);
            if (last && has_next) S.a_ready(nxt);
            const char* a1h1 = cur.A1 + (size_t)(t + 1) * kstep;
            const char* a2h0 = last ? nxt.A0 : cur.A0 + (size_t)(t + 2) * kstep; const char* a2h1 = last ? nxt.A1 : cur.A1 + (size_t)(t + 2) * kstep;
            const char* b2h0 = last ? nxt.B0 : cur.B0 + (size_t)(t + 2) * kstep; const char* b2h1 = last ? nxt.B1 : cur.B1 + (size_t)(t + 2) * kstep;
            unsigned v2h0[2], v2h1[2];
#pragma unroll
            for (int i = 0; i < 2; ++i) { if constexpr (Sched::GATHER) { v2h0[i] = last ? nxt.va[0][i] : cur.va[0][i]; v2h1[i] = last ? nxt.va[1][i] : cur.va[1][i]; } else { v2h0[i] = S.va[i]; v2h1[i] = S.va[i]; } }
            PG8_LDB(B0, 0, 0); if constexpr (!Sched::NB1) PG8_LDB(B1, 0, 1); PG8_SCHED; PG8_LDA(At, 0, 0); PG8_STAGE(PG8_SA(1, 1), a1h1, VA(cur, 1));
            PG8_WAIT_V(8); PG8_WAIT_L(0); PG8_BAR; PG8_MMA(0, 0, At, B0); if constexpr (!Sched::NB1) PG8_MMA(0, 1, At, B1); PG8_BAR; PG8_SCHED;
            if (!(Sched::HALVES && cur.half)) PG8_LDA(At, 0, 1);
            PG8_STAGE(PG8_SB(0, 0), b2h0, voffB); PG8_STAGE(PG8_SB(0, 1), b2h1, voffB); PG8_STAGE(PG8_SA(0, 0), a2h0, v2h0);
            PG8_WAIT_V(8); PG8_WAIT_L(0); PG8_BAR; if (!(Sched::HALVES && cur.half)) { PG8_MMA(1, 0, At, B0); if constexpr (!Sched::NB1) PG8_MMA(1, 1, At, B1); } PG8_BAR; PG8_SCHED;
            PG8_LDB(B0, 1, 0); if constexpr (!Sched::NB1) PG8_LDB(B1, 1, 1); PG8_SCHED; PG8_LDA(At, 1, 0); PG8_STAGE(PG8_SA(0, 1), a2h1, v2h1);
            PG8_WAIT_V(8); PG8_WAIT_L(0); PG8_BAR; PG8_MMA(0, 0, At, B0); if constexpr (!Sched::NB1) PG8_MMA(0, 1, At, B1); PG8_BAR; PG8_SCHED;
            if (!(Sched::HALVES && cur.half)) PG8_LDA(At, 1, 1);
            PG8_STAGE(PG8_SB(1, 0), b2h0 + kstep, voffB); PG8_STAGE(PG8_SB(1, 1), b2h1 + kstep, voffB); PG8_STAGE(PG8_SA(1, 0), a2h0 + kstep, v2h0);
            PG8_WAIT_V(8); PG8_WAIT_L(0); PG8_BAR; if (!(Sched::HALVES && cur.half)) { PG8_MMA(1, 0, At, B0); if constexpr (!Sched::NB1) PG8_MMA(1, 1, At, B1); } PG8_BAR; PG8_SCHED;
        }
        if (S.probe) GSTAMP(lds, 25);
        if constexpr (ALIGN_EPI) { if (wr == 0) PG8_BAR; }
        int frl = fr, fql = fq; if constexpr (Sched::SC8) { const int t2 = ltid(); frl = t2 & 15; fql = (t2 >> 4) & 3; }
        if constexpr (Sched::CHAIN) E.chain(acc, cur, wr, wc, frl, fql); else E(acc, cur, wr, wc, frl, fql);
        S.done(cur);
        if (S.probe) { asm volatile("s_waitcnt vmcnt(0)" ::: "memory"); GSTAMP(lds, 26); }
        if (!has_next) break;
        if constexpr (!Sched::SC8) { if (!Sched::CHAIN || nxt.e == 0) {
        PG8_ZERO4(ze);
#pragma unroll
        for (int a = 0; a < 2; ++a)
#pragma unroll
            for (int b = 0; b < 2; ++b)
#pragma unroll
                for (int m = 0; m < 4; ++m)
#pragma unroll
                    for (int n = 0; n < 2; ++n) acc[a][b][m][n] = ze;
        } }
        cur = nxt; ++ui;
        if constexpr (ALIGN_EPI) { if (wr == 1) PG8_BAR; }
    }
    PG8_WAIT_V(0);
    if constexpr (!ALIGN_EPI) { if (wr == 0) PG8_BAR; }
    PG8_BAR;
#undef VA
#undef PG8_SA
#undef PG8_SB
#undef PG8_STAGE
#undef PG8_LDA
#undef PG8_LDB
#undef PG8_LD16
#undef PG8_ZERO4
#undef PG8_MMA
#undef PG8_WAIT_V
#undef PG8_WAIT_L
#undef PG8_BAR
#undef PG8_SCHED
}

template <bool F8> struct PlainSchedT {
    static constexpr bool GATHER = false, CHAIN = false, DYN = false, FP8 = F8, NB1 = false, SC8 = F8, HALVES = !F8;
    static constexpr int BN = 256;
    static constexpr int EB = F8 ? 1 : 2;
    __device__ __forceinline__ void a_ready(const Unit&) const {}
    __device__ __forceinline__ void done(const Unit&) const {}
    int nM, nN, nwg, G, c, lda, K, nNh, probe = 0, pn_from = -1, pn_to = -1; const char* A; const char* Bt; const char* wsb = nullptr; unsigned va[2];
    __device__ __forceinline__ void init(const void* A_, int lda_, const void* Bt_, int M, int N, int K_, int G_, int c_, int nNh_ = 0) {
        nM = M / BM; nN = N / BN - nNh_; nNh = nNh_; nwg = nM * nN; G = G_; c = c_; lda = lda_; K = K_; A = (const char*)A_; Bt = (const char*)Bt_;
#pragma unroll
        for (int i = 0; i < 2; ++i) { int R, C; stage_rc((int)ltid() * 16 + i * 8192, R, C); va[i] = (unsigned)(R * lda * EB + C * 2); }
    }
    __device__ __forceinline__ bool next(int i, Unit& u) const {
        const long L = (long)i * G + c;
        u.e = 0; u.nvalid = 256; u.slot0 = 0; u.va[0][0] = 0u; u.va[0][1] = 0u; u.va[1][0] = 0u; u.va[1][1] = 0u;
        if (L >= nwg) { const int hL = (int)(L - nwg); if (hL >= 2 * nM * nNh) return false;
            const int hm = hL / nNh; int pn = nN + hL % nNh; if (pn == pn_from) pn = pn_to;
            u.pm = hm >> 1; u.pn = pn; u.half = 1; u.row0 = hm * HALF;
            u.A0 = A + (size_t)hm * HALF * lda * EB; u.A1 = u.A0;
            u.B0 = Bt + (size_t)pn * BN * K * EB; u.B1 = NB1 ? u.B0 : u.B0 + (size_t)HALF * K * EB;
            return true; }
        int wgid = (int)L; { const int q = nwg / NXCD, r = nwg % NXCD, xcd = wgid % NXCD, off = wgid / NXCD; wgid = (xcd < r ? xcd * (q + 1) : r * (q + 1) + (xcd - r) * q) + off; }
        const int nig = WGM * nN, gid = wgid / nig, fm = gid * WGM, gsz = (nM - fm) < WGM ? (nM - fm) : WGM;
        u.pm = fm + ((wgid % nig) % gsz); u.pn = (wgid % nig) / gsz; if (u.pn == pn_from) u.pn = pn_to; u.half = 0; u.row0 = u.pm * BM;
        u.A0 = A + (size_t)u.pm * BM * lda * EB; u.A1 = u.A0 + (size_t)HALF * lda * EB;
        u.B0 = Bt + (size_t)u.pn * BN * K * EB; u.B1 = NB1 ? u.B0 : u.B0 + (size_t)HALF * K * EB;
        return true;
    }
};
typedef PlainSchedT<false> PlainSched;
struct BranchSched {
    static constexpr bool GATHER = false, CHAIN = true, DYN = false, FP8 = false, NB1 = false, SC8 = false, HALVES = false;
    __device__ __forceinline__ void a_ready(const Unit&) const {}
    __device__ __forceinline__ void done(const Unit&) const {}
    int G, c, probe = 0; const char* A; const char* Bt; const char* wsb = nullptr; unsigned va[2];
    __device__ __forceinline__ void init(const bf16* OC, const bf16* WBRl, int G_, int c_) { G = G_; c = c_; A = (const char*)OC; Bt = (const char*)WBRl;
#pragma unroll
        for (int i = 0; i < 2; ++i) { int R, C; stage_rc((int)ltid() * 16 + i * 8192, R, C); va[i] = (unsigned)(R * 1536 + C) * 2u; } }
    __device__ __forceinline__ bool next(int i, Unit& u) const {
        const int tile = (i / 3) * G + c, n = i % 3; if (tile >= (T / BM) * (D / BM)) return false;
        int wgid = tile; { const int nwg = 256, q = nwg / NXCD, xcd = wgid % NXCD, off = wgid / NXCD; wgid = xcd * q + off; }
        const int nN = D / BM, nig = WGM * nN, gid = wgid / nig, fm = gid * WGM;
        u.pm = fm + ((wgid % nig) % WGM); u.pn = (wgid % nig) / WGM; u.e = n; u.nvalid = 256; u.slot0 = 0; u.half = 0; u.row0 = u.pm * BM;
        u.va[0][0] = 0u; u.va[0][1] = 0u; u.va[1][0] = 0u; u.va[1][1] = 0u;
        u.A0 = A + (size_t)u.pm * BM * 1536 * 2 + (size_t)n * 512 * 2; u.A1 = u.A0 + (size_t)HALF * 1536 * 2;
        u.B0 = Bt + (size_t)n * D * 512 * 2 + (size_t)u.pn * BM * 512 * 2; u.B1 = u.B0 + (size_t)HALF * 512 * 2;
        return true;
    }
};
template <int MODE> struct MoeSched {
    static constexpr int NPN = MODE == 1 ? 4 : 8;
    static constexpr bool GATHER = MODE == 1, CHAIN = false, DYN = MODE == 2, FP8 = true, NB1 = false, SC8 = false, HALVES = true;
    unsigned* tilecnt; unsigned* tick; volatile LAS int* tslot; mutable int myticket; const char* wsb = nullptr;
    __device__ __forceinline__ void ticket_issue() const { if (ltid() == 0) myticket = (int)__hip_atomic_fetch_add(tick, 1u, __ATOMIC_RELAXED, __HIP_MEMORY_SCOPE_AGENT); }
    __device__ __forceinline__ void ticket_publish() const { if (ltid() == 0) *tslot = myticket; }
    __device__ __forceinline__ void a_ready(const Unit& u) const {
        if (MODE == 2) {
            if (ltid() < 64) { unsigned* p = tilecnt + 64 * (u.slot0 >> 8); unsigned sp = 0;
                while ((unsigned)__builtin_amdgcn_readfirstlane(__hip_atomic_load(p, __ATOMIC_RELAXED, __HIP_MEMORY_SCOPE_AGENT)) < 32u) { __builtin_amdgcn_s_sleep(2); if (++sp > (1u << 22)) break; }
                __builtin_amdgcn_fence(__ATOMIC_ACQUIRE, "agent"); asm volatile("s_waitcnt vmcnt(0)" ::: "memory"); }
            asm volatile("" ::: "memory"); __builtin_amdgcn_s_barrier(); asm volatile("" ::: "memory"); }
    }
    __device__ __forceinline__ void done(const Unit& u) const {
        if (MODE == 1) { asm volatile("s_waitcnt vmcnt(0)" ::: "memory");
            if ((ltid() & 63) == 0) __hip_atomic_fetch_add(tilecnt + 64 * (u.slot0 >> 8), 1u, __ATOMIC_RELAXED, __HIP_MEMORY_SCOPE_AGENT); }
    }
    int G, c, probe = 0; const LAS int* tb; const int* cnt; const int* list; const char* A; const char* W; unsigned va[2];
    __device__ __forceinline__ void init(int G_, int c_, const LAS int* tb_, const int* cnt_, const int* list_, const void* A_, const void* W_) {
        G = G_; c = c_; tb = tb_; cnt = cnt_; list = list_; A = (const char*)A_; W = (const char*)W_;
#pragma unroll
        for (int i = 0; i < 2; ++i) { int R, C; stage_rc((int)ltid() * 16 + i * 8192, R, C); va[i] = (unsigned)(R * FF + C * 2); }
    }
    __device__ __forceinline__ bool next(int i, Unit& u) const {
        const int L = MODE == 2 ? __builtin_amdgcn_readfirstlane(*tslot) : i * G + c, nfull = __builtin_amdgcn_readfirstlane(tb[33 + NE]), nhalf = __builtin_amdgcn_readfirstlane(tb[66 + NE]);
        if (L >= (nfull + nhalf) * NPN) return false;
        const bool half = L >= nfull * NPN; const int Lr = half ? L - nfull * NPN : L, base = half ? 66 : 33;
        const int tq = Lr / NPN, pn = Lr % NPN; int e = 0;
        while (e < NE - 1 && __builtin_amdgcn_readfirstlane(tb[base + e + 1]) <= tq) ++e;
        const int ne = __builtin_amdgcn_readfirstlane(cnt[e]);
        const int pm = half ? (ne - 1) / 256 : tq - __builtin_amdgcn_readfirstlane(tb[33 + e]);
        const int tl = __builtin_amdgcn_readfirstlane(tb[e]) + pm;
        u.pm = pm; u.pn = pn; u.e = e; u.nvalid = ne - pm * 256; u.slot0 = tl * 256; u.half = half ? 1 : 0; u.row0 = 0;
        if (MODE == 1) {
            u.A0 = A; u.A1 = A;
#pragma unroll
            for (int h = 0; h < 2; ++h)
#pragma unroll
                for (int k = 0; k < 2; ++k) { int Rk, Ck; stage_rc((int)ltid() * 16 + k * 8192, Rk, Ck); int idx = pm * 256 + h * 128 + Rk; idx = idx < ne ? idx : ne - 1; const int entry = list[e * 8192 + idx]; u.va[h][k] = (unsigned)(entry >> 1) * (unsigned)D + (unsigned)Ck * 2u; }
            const char* we = W + (size_t)e * 1024 * D;
            u.B0 = we + (size_t)(pn * 128) * D; u.B1 = we + (size_t)(512 + pn * 128) * D;
        } else {
            u.va[0][0] = 0u; u.va[0][1] = 0u; u.va[1][0] = 0u; u.va[1][1] = 0u;
            u.A0 = A + (size_t)tl * 256 * FF; u.A1 = u.A0 + (size_t)HALF * FF;
            const char* we = W + (size_t)e * D * FF;
            u.B0 = we + (size_t)(pn * 256) * FF; u.B1 = u.B0 + (size_t)HALF * FF;
        }
        return true;
    }
};

struct EpiBf16 {
    static constexpr bool PERM = true;
    bf16* O; int ldc; float scale;
    __device__ __forceinline__ void operator()(const f32x4 (&acc)[2][2][4][2], const Unit& u, int wr, int wc, int fr, int fq) const {
        const int row0 = u.row0 + wr * 64 + fr, col0 = u.pn * BM + wc * 32 + 8 * fq;
#pragma unroll
        for (int ai = 0; ai < 2; ++ai) if (ai == 0 || !u.half)
#pragma unroll
            for (int m = 0; m < 4; ++m) { bf16* rowp = O + (size_t)(row0 + ai * HALF + m * 16) * ldc + col0;
#pragma unroll
                for (int bj = 0; bj < 2; ++bj) { const f32x4 v0 = acc[ai][bj][m][0] * scale, v1 = acc[ai][bj][m][1] * scale;
                    u32x4 w; w.x = cvt_pk_bf16(v0[0], v0[1]); w.y = cvt_pk_bf16(v0[2], v0[3]); w.z = cvt_pk_bf16(v1[0], v1[1]); w.w = cvt_pk_bf16(v1[2], v1[3]);
                    *(u32x4*)(rowp + bj * HALF) = w; } }
    }
};
struct EpiBf16N1 {
    static constexpr bool PERM = true;
    bf16* O; int ldc; float scale;
    __device__ __forceinline__ void operator()(const f32x4 (&acc)[2][2][4][2], const Unit& u, int wr, int wc, int fr, int fq) const {
        const int row0 = u.row0 + wr * 64 + fr, col0 = u.pn * 128 + wc * 32 + 8 * fq;
#pragma unroll
        for (int ai = 0; ai < 2; ++ai) if (ai == 0 || !u.half)
#pragma unroll
            for (int m = 0; m < 4; ++m) { const f32x4 v0 = acc[ai][0][m][0] * scale, v1 = acc[ai][0][m][1] * scale;
                u32x4 w; w.x = cvt_pk_bf16(v0[0], v0[1]); w.y = cvt_pk_bf16(v0[2], v0[3]); w.z = cvt_pk_bf16(v1[0], v1[1]); w.w = cvt_pk_bf16(v1[2], v1[3]);
                *(u32x4*)(O + (size_t)(row0 + ai * HALF + m * 16) * ldc + col0) = w; }
    }
};
struct EpiMerge {
    static constexpr bool PERM = true;
    bf16* MG; const bf16* gate0;
    __device__ __forceinline__ void operator()(const f32x4 (&acc)[2][2][4][2], const Unit& u, int wr, int wc, int fr, int fq) const {}
    __device__ __forceinline__ void chain(f32x4 (&acc)[2][2][4][2], const Unit& u, int wr, int wc, int fr, int fq) const {
        const int row0 = u.row0 + wr * 64 + fr, col0 = u.pn * BM + wc * 32 + 8 * fq; const bool last = u.e == 2;
        const bf16* __restrict__ ga = gate0 + (size_t)u.e * D; const bf16* __restrict__ gb = gate0 + (size_t)(last ? 2 : u.e + 1) * D;
        bf16* __restrict__ MGp = MG;
        u32x4 qa[2][2], qb[2][2];
#define EMG_LOAD(buf, g) do { const size_t row_ = (size_t)(row0 + ((g) >> 2) * HALF + ((g) & 3) * 16); \
            _Pragma("unroll") for (int bj_ = 0; bj_ < 2; ++bj_) { qa[buf][bj_] = *(const u32x4*)(ga + row_ * NPAD + col0 + bj_ * HALF); qb[buf][bj_] = *(const u32x4*)(gb + row_ * NPAD + col0 + bj_ * HALF); } } while (0)
        EMG_LOAD(0, 0);
#pragma unroll
        for (int g = 0; g < 8; ++g) { if (g + 1 < 8) EMG_LOAD((g + 1) & 1, g + 1);
            const int ai = g >> 2, m = g & 3; const size_t row = (size_t)(row0 + ai * HALF + m * 16);
#pragma unroll
            for (int bj = 0; bj < 2; ++bj) { float o[8];
                const unsigned wa[4] = {qa[g & 1][bj].x, qa[g & 1][bj].y, qa[g & 1][bj].z, qa[g & 1][bj].w}, wb[4] = {qb[g & 1][bj].x, qb[g & 1][bj].y, qb[g & 1][bj].z, qb[g & 1][bj].w};
#pragma unroll
                for (int k = 0; k < 8; ++k) { const float a = acc[ai][bj][m][k >> 2][k & 3];
                    const float xa = __builtin_bit_cast(float, (k & 1) ? (wa[k >> 1] & 0xffff0000u) : (wa[k >> 1] << 16)), xb = __builtin_bit_cast(float, (k & 1) ? (wb[k >> 1] & 0xffff0000u) : (wb[k >> 1] << 16));
                    const float ea = __builtin_amdgcn_exp2f(-LOG2E * xa), eb = __builtin_amdgcn_exp2f(-LOG2E * xb);
                    const float f = (last ? 1.0f : 1.0f + eb) * __builtin_amdgcn_rcpf(1.0f + ea);
                    o[k] = a * f; acc[ai][bj][m][k >> 2][k & 3] = o[k]; }
                if (last) { u32x4 w; w.x = cvt_pk_bf16(o[0], o[1]); w.y = cvt_pk_bf16(o[2], o[3]); w.z = cvt_pk_bf16(o[4], o[5]); w.w = cvt_pk_bf16(o[6], o[7]);
                    *(u32x4*)(MGp + row * D + col0 + bj * HALF) = w; } } }
#undef EMG_LOAD
    }
};
struct EpiResF32 {
    static constexpr bool PERM = false;
    const float* R; float* O; int ldc;
    __device__ __forceinline__ void operator()(const f32x4 (&acc)[2][2][4][2], const Unit& u, int wr, int wc, int fr, int fq) const {
        const int row0 = u.row0 + wr * 64 + fr, col0 = u.pn * BM + wc * 32 + 4 * fq;
        const float* __restrict__ Rp = R; float* __restrict__ Op = O;
        f32x4 rv[2][4];
#define ERES_LOAD(buf, g) do { const size_t off_ = (size_t)(row0 + ((g) >> 2) * HALF + ((g) & 3) * 16) * ldc + col0; \
            _Pragma("unroll") for (int q_ = 0; q_ < 4; ++q_) rv[buf][q_] = *(const f32x4*)(Rp + off_ + (q_ >> 1) * HALF + (q_ & 1) * 16); } while (0)
        ERES_LOAD(0, 0);
#pragma unroll
        for (int g = 0; g < 8; ++g) { if (g + 1 < 8) ERES_LOAD((g + 1) & 1, g + 1);
            const int ai = g >> 2, m = g & 3; const size_t off = (size_t)(row0 + ai * HALF + m * 16) * ldc + col0;
            if (ai == 0 || !u.half) {
#pragma unroll
                for (int q = 0; q < 4; ++q) *(f32x4*)(Op + off + (q >> 1) * HALF + (q & 1) * 16) = acc[ai][q >> 1][m][q & 1] + rv[g & 1][q]; } }
#undef ERES_LOAD
    }
};
struct EpiMoe1 {
    static constexpr bool PERM = true;
    unsigned char* ACT; const int* list; const float* ew; const float* rstd;
    __device__ __forceinline__ void operator()(const f32x4 (&acc)[2][2][4][2], const Unit& u, int wr, int wc, int fr, int fq) const {
        const int col0 = u.pn * 128 + wc * 32 + 8 * fq;
#pragma unroll
        for (int ai = 0; ai < 2; ++ai) if (ai == 0 || !u.half)
#pragma unroll
            for (int m = 0; m < 4; ++m) { const int r = ai * HALF + wr * 64 + m * 16 + fr; float w = 0.f, rsd = 0.f;
                if (r < u.nvalid) { const int entry = list[u.e * 8192 + u.pm * 256 + r]; w = ew[entry] * S_ACT; rsd = rstd[entry >> 1] * (1.0f / (S_A1 * S_W1)); }
                float o[8];
#pragma unroll
                for (int n = 0; n < 2; ++n)
#pragma unroll
                    for (int j = 0; j < 4; ++j) { const float g = acc[ai][0][m][n][j] * rsd, up = acc[ai][1][m][n][j] * rsd; o[n * 4 + j] = g * fsig(g) * up * w; }
                const unsigned lo = pk4_fp8(o[0], o[1], o[2], o[3]), hi = pk4_fp8(o[4], o[5], o[6], o[7]);
                __hip_atomic_store((unsigned long long*)(ACT + (size_t)(u.slot0 + r) * FF + col0), (unsigned long long)lo | ((unsigned long long)hi << 32), __ATOMIC_RELAXED, __HIP_MEMORY_SCOPE_AGENT); }
    }
};
struct EpiMoe2 {
    static constexpr bool PERM = true;
    bf16* CO; const int* list;
    __device__ __forceinline__ void operator()(const f32x4 (&acc)[2][2][4][2], const Unit& u, int wr, int wc, int fr, int fq) const {
        const int col0 = u.pn * BM + wc * 32 + 8 * fq;
#pragma unroll
        for (int ai = 0; ai < 2; ++ai) if (ai == 0 || !u.half)
#pragma unroll
            for (int m = 0; m < 4; ++m) { const int r = ai * HALF + wr * 64 + m * 16 + fr;
                if (r < u.nvalid) { const int entry = list[u.e * 8192 + u.pm * 256 + r]; bf16* rowp = CO + (size_t)entry * D + col0;
#pragma unroll
                    for (int bj = 0; bj < 2; ++bj) { const f32x4 v0 = acc[ai][bj][m][0] * (1.0f / (S_ACT * S_W2)), v1 = acc[ai][bj][m][1] * (1.0f / (S_ACT * S_W2));
                        u32x4 w; w.x = cvt_pk_bf16(v0[0], v0[1]); w.y = cvt_pk_bf16(v0[2], v0[3]); w.z = cvt_pk_bf16(v1[0], v1[1]); w.w = cvt_pk_bf16(v1[2], v1[3]);
                        *(u32x4*)(rowp + bj * HALF) = w; } } }
    }
};
}

struct Frame {
    LAS unsigned char* lds; volatile LAS unsigned* MISC;
    int tid, lane, wave, vcu, G, gw, NGW, bid;
};
struct Args { const GAS float* in[22]; GAS float* out; GAS unsigned char* ws; int ph_lo, ph_hi, li, pad; };
typedef const __attribute__((address_space(4))) Args KArgs;
__device__ __forceinline__ KArgs* ka_fresh() { unsigned long long p = (unsigned long long)__builtin_amdgcn_kernarg_segment_ptr(); asm volatile("" : "+s"(p)); return (KArgs*)p; }
#define KA KArgs* const ka = ka_fresh()
#define KIN(i) ((const float*)ka->in[i])
#define KWS ((unsigned char*)ka->ws)
#define KOUT ((float*)ka->out)
enum { I_X = 0, I_NMIX, I_WIN, I_PE, I_W1, I_W2, I_QN, I_KN, I_LB, I_HGN, I_WA2, I_BA, I_GLAN, I_WBR, I_WOUT, I_NFFN, I_WGRP, I_BGRP, I_WEXP, I_BEXP, I_WGU, I_WDN };

__device__ __forceinline__ void tr_item(const float* W, size_t ldw, int c0, int nv, bf16* WT, size_t ldt, int r0, int k0, LAS float* scr, int lane) {
    const int nn = lane & 31;
    float tv[32];
#pragma unroll
    for (int i = 0; i < 32; ++i) { const int kk = 2 * i + (lane >> 5); tv[i] = nn < nv ? __builtin_nontemporal_load(W + (size_t)(k0 + kk) * ldw + c0 + nn) : 0.f; }
#pragma unroll
    for (int i = 0; i < 32; ++i) { const int kk = 2 * i + (lane >> 5); scr[kk * 33 + nn] = tv[i]; }
    LDS_WAIT();
    const int c = lane & 7;
#pragma unroll
    for (int j = 0; j < 4; ++j) { const int n = (lane >> 3) + 8 * j; const LAS float* s = scr + (8 * c) * 33 + n;
        u32x4 o; o.x = pk2(s[0 * 33], s[1 * 33]); o.y = pk2(s[2 * 33], s[3 * 33]); o.z = pk2(s[4 * 33], s[5 * 33]); o.w = pk2(s[6 * 33], s[7 * 33]);
        if (n < nv) __builtin_nontemporal_store(o, (u32x4*)(WT + (size_t)(r0 + n) * ldt + k0 + 8 * c)); }
    LDS_WAIT();
}
__device__ __forceinline__ void tr_item8(const float* W, size_t ldw, int c0, unsigned char* WT8, size_t ldt, int r0, int k0, float sc, LAS float* scr, int lane) {
    const int nn = lane & 31;
    float tv[64];
#pragma unroll
    for (int i = 0; i < 64; ++i) { const int kk = 2 * i + (lane >> 5); tv[i] = __builtin_nontemporal_load(W + (size_t)(k0 + kk) * ldw + c0 + nn); }
#pragma unroll
    for (int i = 0; i < 64; ++i) { const int kk = 2 * i + (lane >> 5); scr[kk * 33 + nn] = tv[i] * sc; }
    LDS_WAIT();
    const int c = lane & 7;
#pragma unroll
    for (int j = 0; j < 4; ++j) { const int n = (lane >> 3) + 8 * j; const LAS float* sp = scr + (16 * c) * 33 + n;
        u32x4 o; o.x = pk4_fp8(sp[0 * 33], sp[1 * 33], sp[2 * 33], sp[3 * 33]); o.y = pk4_fp8(sp[4 * 33], sp[5 * 33], sp[6 * 33], sp[7 * 33]);
        o.z = pk4_fp8(sp[8 * 33], sp[9 * 33], sp[10 * 33], sp[11 * 33]); o.w = pk4_fp8(sp[12 * 33], sp[13 * 33], sp[14 * 33], sp[15 * 33]);
        __builtin_nontemporal_store(o, (u32x4*)(WT8 + (size_t)(r0 + n) * ldt + k0 + 16 * c)); }
    LDS_WAIT();
}
__device__ __forceinline__ void phase_prologue(Frame& F) {
    KA;
    {
      bf16* W1T = (bf16*)(KWS + WS_CW); bf16* W2T = (bf16*)(KWS + WS_CW + 1048576); float* B1 = (float*)(KWS + WS_CW + 1572864);
      for (int i = F.bid * 512 + F.tid; i < NL * 2 * 64 * 2048; i += F.G * 512) { const int lk = i / (64 * 2048), j = (i / 2048) % 64, c = i % 2048; W1T[i] = (bf16)f2bf(KIN(I_W1)[((size_t)lk * 2048 + c) * 64 + j]); }
      for (int i = F.bid * 512 + F.tid; i < NL * 2 * 64 * 64; i += F.G * 512) { const int lk = i / 4096, j2 = (i / 64) % 64, j = i % 64; W2T[i] = (bf16)f2bf(KIN(I_W2)[((size_t)lk * 64 + j) * 64 + j2]); }
      if (F.bid < NL * 2) { const int lk = F.bid, j = F.tid & 63, part = F.tid >> 6; float a = 0.f;
#pragma unroll 8
          for (int c = part * 256; c < part * 256 + 256; ++c) a += KIN(I_PE)[(size_t)lk * 2048 + c] * KIN(I_W1)[((size_t)lk * 2048 + c) * 64 + j];
          LAS float* rd = (LAS float*)F.lds; rd[F.tid] = a; __syncthreads();
          if (F.tid < 64) { float t2 = 0.f;
#pragma unroll
              for (int p = 0; p < 8; ++p) t2 += rd[p * 64 + F.tid];
              B1[lk * 64 + F.tid] = t2; }
          __syncthreads(); } }
    { float* WRT = (float*)(KWS + WS_WRT);
      for (int i = F.bid * 512 + F.tid; i < NL * 48 * D; i += F.G * 512) { const int l = i / (48 * D), n = (i / D) % 48, k = i % D; const float g = KIN(I_NFFN)[l * D + k];
          WRT[i] = n < 32 ? g * KIN(I_WEXP)[((size_t)l * D + k) * 32 + n] : (n < 36 ? g * KIN(I_WGRP)[((size_t)l * D + k) * 4 + (n - 32)] : 0.f); } }
    LAS float* scr = (LAS float*)(F.lds + F.wave * 17408);
    constexpr int IT_WIN = 32 * 154, IT_WG8 = 16 * 192, IT_WBR = 3 * 8 * 64, IT_WOUT = 32 * 64, IT_WGU = 32 * 16 * 32, IT_WDN = 32 * 4 * 64, IT_L = IT_WIN + IT_WG8 + IT_WBR + IT_WOUT + IT_WGU + IT_WDN;
    for (int it = F.gw; it < NL * IT_L; it += F.NGW) {
        const int l = it / IT_L; int r = it % IT_L;
        if (r < IT_WIN) { const int kb = r / 154, nb = r % 154; int src, dst, nv = 32;
            if (nb < 40) { src = nb * 32; dst = nb * 32; }
            else if (nb == 40) { src = 1280; dst = C_NG; nv = 24; }
            else if (nb < 153) { src = 1304 + 32 * (nb - 41); dst = 1280 + 32 * (nb - 41); }
            else { src = 4888; dst = C_GA; nv = 16; }
            tr_item(KIN(I_WIN) + (size_t)l * D * INC, INC, src, nv, (bf16*)(KWS + WS_WIN) + (size_t)l * NPAD * D, D, dst, kb * 64, scr, F.lane); continue; }
        r -= IT_WIN;
        if (r < IT_WG8) { const int kb = r / 192, nb = r % 192;
            tr_item8(KIN(I_WIN) + (size_t)l * D * INC, INC, 4904 + 32 * nb, (unsigned char*)(KWS + WS_WIN8) + (size_t)l * 6144 * D, D, nb * 32, kb * 128, S_WG, scr, F.lane); continue; }
        r -= IT_WG8;
        if (r < IT_WBR) { const int n = r / 512, q = r % 512, kb = q / 64, nb = q % 64;
            tr_item(KIN(I_WBR) + ((size_t)l * 3 + n) * 512 * D, D, nb * 32, 32, (bf16*)(KWS + WS_WBR) + ((size_t)l * 3 + n) * D * 512, 512, nb * 32, kb * 64, scr, F.lane); continue; }
        r -= IT_WBR;
        if (r < IT_WOUT) { const int kb = r / 64, nb = r % 64;
            tr_item(KIN(I_WOUT) + (size_t)l * D * D, D, nb * 32, 32, (bf16*)(KWS + WS_WOUT) + (size_t)l * D * D, D, nb * 32, kb * 64, scr, F.lane); continue; }
        r -= IT_WOUT;
        if (r < IT_WGU) { const int e = r / 512, q = r % 512, kb = q / 32, nb = q % 32;
            tr_item8(KIN(I_WGU) + ((size_t)l * NE + e) * D * 1024, 1024, nb * 32, (unsigned char*)(KWS + WS_WGU) + ((size_t)l * NE + e) * 1024 * D, D, nb * 32, kb * 128, S_W1, scr, F.lane); continue; }
        r -= IT_WGU;
        { const int e = r / 256, q = r % 256, kb = q / 64, nb = q % 64;
            tr_item8(KIN(I_WDN) + ((size_t)l * NE + e) * FF * D, D, nb * 32, (unsigned char*)(KWS + WS_WDN) + ((size_t)l * NE + e) * D * FF, FF, nb * 32, kb * 128, S_W2, scr, F.lane); }
    }
}

template <int MODE> __device__ __forceinline__ void phase_norm1(Frame& F, const float* xin, const bf16* contrib, float* xout, const float* gain, bf16* H, unsigned char* H8n = nullptr) {
    for (int t0 = F.gw; t0 < T; t0 += 2 * F.NGW) {
        f32x4 v[2][8]; float ss[2] = {0.f, 0.f};
#pragma unroll
        for (int rr = 0; rr < 2; ++rr) { const int t = t0 + rr * F.NGW; if (t < T) {
            const f32x4* xr = (const f32x4*)(xin + (size_t)t * D) + F.lane;
#pragma unroll
            for (int j = 0; j < 8; ++j) v[rr][j] = xr[64 * j]; } }
        u32x2 c0[2][8], c1[2][8];
        if (MODE != 0) {
#pragma unroll
            for (int rr = 0; rr < 2; ++rr) { const int t = t0 + rr * F.NGW; if (t < T) {
#pragma unroll
                for (int j = 0; j < 8; ++j) { c0[rr][j] = *((const u32x2*)(contrib + (size_t)(2 * t) * D) + F.lane + 64 * j); c1[rr][j] = *((const u32x2*)(contrib + (size_t)(2 * t + 1) * D) + F.lane + 64 * j); } } } }
#pragma unroll
        for (int rr = 0; rr < 2; ++rr) { const int t = t0 + rr * F.NGW; if (t < T) {
#pragma unroll
            for (int j = 0; j < 8; ++j) {
                if (MODE != 0) { v[rr][j].x += bflo(c0[rr][j].x) + bflo(c1[rr][j].x); v[rr][j].y += bfhi(c0[rr][j].x) + bfhi(c1[rr][j].x); v[rr][j].z += bflo(c0[rr][j].y) + bflo(c1[rr][j].y); v[rr][j].w += bfhi(c0[rr][j].y) + bfhi(c1[rr][j].y);
                    *((f32x4*)(xout + (size_t)t * D) + F.lane + 64 * j) = v[rr][j]; }
                ss[rr] += v[rr][j].x * v[rr][j].x + v[rr][j].y * v[rr][j].y + v[rr][j].z * v[rr][j].z + v[rr][j].w * v[rr][j].w; } } }
        if (MODE != 2) {
#pragma unroll
            for (int rr = 0; rr < 2; ++rr) { const int t = t0 + rr * F.NGW; if (t < T) {
                const float rstd = 1.0f / sqrtf(wave_sum(ss[rr]) * (1.0f / D) + EPS);
#pragma unroll
                for (int j = 0; j < 8; ++j) { const f32x4 g = *((const f32x4*)gain + F.lane + 64 * j);
                    const float h0 = v[rr][j].x * rstd * g.x, h1 = v[rr][j].y * rstd * g.y, h2 = v[rr][j].z * rstd * g.z, h3 = v[rr][j].w * rstd * g.w;
                    u32x2 o; o.x = pkbf(h0, h1); o.y = pkbf(h2, h3);
                    *((u32x2*)(H + (size_t)t * D) + F.lane + 64 * j) = o;
                    *((unsigned*)(H8n + (size_t)t * D) + F.lane + 64 * j) = pk4_fp8(h0 * S_H, h1 * S_H, h2 * S_H, h3 * S_H); } } }
        }
    }
}

__device__ __forceinline__ void phase_prep(Frame& F, int l) {
    KA;
    const bf16* P = (const bf16*)(KWS + WS_P);
    float* QN = (float*)(KWS + WS_QN); float* KV = (float*)(KWS + WS_KV);
    const float* qg = KIN(I_QN) + l * 64; const float* kg = KIN(I_KN) + l * 192;
    for (int it = F.gw; it < T * 20; it += F.NGW) {
        const int t = it / 20, v = it % 20;
        float x = bf2f(P[(size_t)t * NPAD + v * 64 + F.lane]);
        const bool isq = v < 8, nk1 = (v == 12 || v == 13), nk2 = (v == 16 || v == 17);
        if (isq || nk1 || nk2) { const float ss = wave_sum(x * x); const float g = isq ? qg[F.lane] : (nk1 ? kg[64 + F.lane] : kg[128 + F.lane]); x = x * (1.0f / sqrtf(ss * (1.0f / 64.0f) + EPS)) * g; }
        if (isq) QN[((size_t)v * T + t) * 64 + F.lane] = x;
        else { const int w = v - 8, tens = w >> 1, g = w & 1; KV[(size_t)tens * KV_STRIDE + ((size_t)g * T + t) * 64 + F.lane] = x; }
    }
}
__device__ __forceinline__ float gelu_tanh(float x) { const float u = 0.7978845608028654f * (x + 0.044715f * x * x * x); return 0.5f * x * (1.0f + tanhf(u)); }
__device__ __forceinline__ void phase_compress(Frame& F, int l) {
    KA;
    LAS float* av = (LAS float*)(F.lds + F.wave * 16384);
    const float* KV = (const float*)(KWS + WS_KV); float* KC = (float*)(KWS + WS_KC);
    for (int it = F.gw; it < 2 * 2 * 511; it += F.NGW) {
        const int kind = it / 1022, q = it % 1022, g = q / 511, n = q % 511;
        const float* src = KV + (size_t)kind * KV_STRIDE + ((size_t)g * T + 16 * n) * 64;
        const float* pe = KIN(I_PE) + ((size_t)l * 2 + kind) * 2048;
        const float* w1 = KIN(I_W1) + ((size_t)l * 2 + kind) * 2048 * 64;
        const float* w2 = KIN(I_W2) + ((size_t)l * 2 + kind) * 64 * 64;
#pragma unroll 4
        for (int c = 0; c < 32; ++c) av[c * 64 + F.lane] = src[c * 64 + F.lane] + pe[c * 64 + F.lane];
        WSYNC();
        float acc = 0.f;
#pragma unroll 8
        for (int i = 0; i < 2048; ++i) acc += av[i] * w1[i * 64 + F.lane];
        const float hid = gelu_tanh(acc);
        WSYNC();
        av[F.lane] = hid;
        WSYNC();
        float o = 0.f;
#pragma unroll 8
        for (int i = 0; i < 64; ++i) o += av[i] * w2[i * 64 + F.lane];
        WSYNC();
        if (kind == 0) { const float ss = wave_sum(o * o); o = o * (1.0f / sqrtf(ss * (1.0f / 64.0f) + EPS)) * KIN(I_KN)[l * 192 + F.lane]; }
        KC[(size_t)kind * (2 * 512 * 64) + ((size_t)g * 512 + n) * 64 + F.lane] = o;
    }
}
__device__ __forceinline__ void phase_recur(Frame& F, int l) {
    KA;
    const bf16* P = (const bf16*)(KWS + WS_P); float* ORAW = (float*)(KWS + WS_ORAW);
    for (int it = F.gw; it < 1024; it += F.NGW) {
        const int kind = it >> 9, head = (it >> 7) & 3, j = it & 127;
        if (kind == 0) {
            const int d0 = F.lane, d1 = F.lane + 64;
            const float* lbl = KIN(I_LB);
            float lb0, lb1;
            { const float a0 = lbl[head * 128 + d0], b0 = lbl[512 + head * 128 + d0], a1 = lbl[head * 128 + d1], b1 = lbl[512 + head * 128 + d1];
              lb0 = l == 0 ? 0.f : 1.0f / (1.0f + expf(a0 - b0)); lb1 = l == 0 ? 0.f : 1.0f / (1.0f + expf(a1 - b1)); }
            const bf16* Pq = P + C_HQ + head * 128; const bf16* Pf = P + C_HF + head * 128; const bf16* Pi = P + C_HI + head * 128 + j;
            float S0 = 0.f, S1 = 0.f;
            for (int t0 = 0; t0 < T; t0 += 8) {
                bf16 zq0[8], zq1[8], zf0[8], zf1[8], vi[8];
#pragma unroll
                for (int u = 0; u < 8; ++u) { const size_t row = (size_t)(t0 + u) * NPAD; zq0[u] = Pq[row + d0]; zq1[u] = Pq[row + d1]; zf0[u] = Pf[row + d0]; zf1[u] = Pf[row + d1]; vi[u] = Pi[row]; }
                float part[8];
#pragma unroll
                for (int u = 0; u < 8; ++u) { const float v = bf2f(vi[u]);
                    const float s0 = sigmoidf_(bf2f(zf0[u])), s1 = sigmoidf_(bf2f(zf1[u]));
                    const float f0 = lb0 + (1.0f - lb0) * s0, f1 = lb1 + (1.0f - lb1) * s1;
                    const float k0 = (1.0f - lb0) * (1.0f - s0), k1 = (1.0f - lb1) * (1.0f - s1);
                    S0 = f0 * S0 + k0 * v; S1 = f1 * S1 + k1 * v;
                    part[u] = bf2f(zq0[u]) * S0 + bf2f(zq1[u]) * S1; }
                float mine = 0.f;
#pragma unroll
                for (int u = 0; u < 8; ++u) { const float s = wave_sum(part[u]); mine = (F.lane == u) ? s : mine; }
                if (F.lane < 8) ORAW[(size_t)(t0 + F.lane) * 1024 + head * 128 + j] = mine;
            }
        } else {
            const int d = F.lane, c = head * 64 + d;
            float wa[16];
#pragma unroll
            for (int r = 0; r < 16; ++r) wa[r] = KIN(I_WA2)[((size_t)l * 16 + r) * 256 + c];
            const float ba = KIN(I_BA)[l * 256 + c];
            const bf16* Pq = P + C_GQ + c; const bf16* Pk = P + C_GK + c; const bf16* Pv = P + C_GV + head * 128 + j; const bf16* Pa = P + C_GA;
            float S = 0.f;
            for (int t0 = 0; t0 < T; t0 += 8) {
                bf16 zq[8], zk[8], zv[8]; u32x4 ga0[8], ga1[8];
#pragma unroll
                for (int u = 0; u < 8; ++u) { const size_t row = (size_t)(t0 + u) * NPAD; zq[u] = Pq[row]; zk[u] = Pk[row]; zv[u] = Pv[row]; ga0[u] = *(const u32x4*)(Pa + row); ga1[u] = *(const u32x4*)(Pa + row + 8); }
                float part[8];
#pragma unroll
                for (int u = 0; u < 8; ++u) {
                    float a = ba;
                    a += bflo(ga0[u].x) * wa[0] + bfhi(ga0[u].x) * wa[1] + bflo(ga0[u].y) * wa[2] + bfhi(ga0[u].y) * wa[3] + bflo(ga0[u].z) * wa[4] + bfhi(ga0[u].z) * wa[5] + bflo(ga0[u].w) * wa[6] + bfhi(ga0[u].w) * wa[7];
                    a += bflo(ga1[u].x) * wa[8] + bfhi(ga1[u].x) * wa[9] + bflo(ga1[u].y) * wa[10] + bfhi(ga1[u].y) * wa[11] + bflo(ga1[u].z) * wa[12] + bfhi(ga1[u].z) * wa[13] + bflo(ga1[u].w) * wa[14] + bfhi(ga1[u].w) * wa[15];
                    const float ls = fminf(a, 0.f) - log1pf(expf(-fabsf(a)));
                    const float f = expf(ls * (1.0f / 16.0f));
                    S = f * S + bf2f(zk[u]) * bf2f(zv[u]);
                    part[u] = bf2f(zq[u]) * 0.125f * S; }
                float mine = 0.f;
#pragma unroll
                for (int u = 0; u < 8; ++u) { const float s = wave_sum(part[u]); mine = (F.lane == u) ? s : mine; }
                if (F.lane < 8) ORAW[(size_t)(t0 + F.lane) * 1024 + 512 + head * 128 + j] = mine;
            }
        }
    }
}
__device__ __forceinline__ void phase_recur_out(Frame& F, int l) {
    KA;
    const bf16* P = (const bf16*)(KWS + WS_P); const float* ORAW = (const float*)(KWS + WS_ORAW); bf16* OCAT = (bf16*)(KWS + WS_OCAT);
    for (int it = F.gw; it < T * 8; it += F.NGW) {
        const int t = it >> 3, kind = (it >> 2) & 1, head = it & 3;
        const float* gn = (kind == 0 ? KIN(I_HGN) : KIN(I_GLAN)) + l * 128;
        const int cg = (kind == 0 ? C_HG : C_GR) + head * 128;
        const float r0 = ORAW[(size_t)t * 1024 + kind * 512 + head * 128 + F.lane], r1 = ORAW[(size_t)t * 1024 + kind * 512 + head * 128 + 64 + F.lane];
        const float rstd = 1.0f / sqrtf(wave_sum(r0 * r0 + r1 * r1) * (1.0f / 128.0f) + EPS);
        const float g0 = bf2f(P[(size_t)t * NPAD + cg + F.lane]), g1 = bf2f(P[(size_t)t * NPAD + cg + 64 + F.lane]);
        const float a0 = kind == 0 ? sigmoidf_(g0) : g0 * sigmoidf_(g0), a1 = kind == 0 ? sigmoidf_(g1) : g1 * sigmoidf_(g1);
        OCAT[(size_t)t * 1536 + 512 + kind * 512 + head * 128 + F.lane] = (bf16)f2bf(r0 * rstd * gn[F.lane] * a0);
        OCAT[(size_t)t * 1536 + 512 + kind * 512 + head * 128 + 64 + F.lane] = (bf16)f2bf(r1 * rstd * gn[64 + F.lane] * a1);
    }
}


template <int KIND> struct RecCfg { static constexpr int DK = KIND == 0 ? 128 : 64, NSEG = 512 / DK, TPS = 64 / NSEG, QROW = (DK + 8) * 2; };
constexpr int REC_VT_OFF = 0;
constexpr int REC_KD_OFF = 18432;
constexpr int REC_QS_OFF = 36864;
constexpr int REC_KS_OFF = 54272;
constexpr int REC_QD_OFF = 71680;
constexpr int REC_RED_OFF = 89088;
constexpr int REC_TOT_OFF = 91136;
__device__ __forceinline__ float expc(float x2) { return __builtin_amdgcn_exp2f(fminf(x2, 110.0f)); }
template <int KIND> __device__ __forceinline__ void rec_elem(KArgs* ka, int l, int head, int chunk, int tid, LAS float* tot,
        float (&qv)[RecCfg<KIND>::TPS], float (&kv)[RecCfg<KIND>::TPS], float (&bv)[RecCfg<KIND>::TPS], float& bend, float& bref) {
    constexpr int DK = RecCfg<KIND>::DK, NSEG = RecCfg<KIND>::NSEG, TPS = RecCfg<KIND>::TPS;
    const int d = tid % DK, seg = tid / DK, t0 = chunk * 64 + seg * TPS;
    const bf16* P = (const bf16*)(KWS + WS_P);
    float run = 0.f;
    if (KIND == 0) {
        const int c = head * 128 + d;
        float lb = 0.f;
        if (l > 0) { const float a0 = KIN(I_LB)[c], b0 = KIN(I_LB)[512 + c]; lb = 1.0f / (1.0f + expf(a0 - b0)); }
        const float omlb = 1.0f - lb;
        unsigned zr[TPS], qr[TPS];
#pragma unroll
        for (int u = 0; u < TPS; ++u) { const size_t row = (size_t)(t0 + u) * NPAD; zr[u] = P[row + C_HF + c]; qr[u] = P[row + C_HQ + c]; }
#pragma unroll
        for (int u = 0; u < TPS; ++u) {
            const float z = bf2f(zr[u]); qv[u] = bf2f(qr[u]);
            const float e = __builtin_amdgcn_exp2f(-LOG2E * z), sg = __builtin_amdgcn_rcpf(1.0f + e), f = fmaf(omlb, sg, lb);
            kv[u] = omlb * (e * sg);
            run += __builtin_amdgcn_logf(fmaxf(f, 1e-30f)); bv[u] = run; }
    } else {
        const int c = head * 64 + d;
        float wa[16];
#pragma unroll
        for (int r = 0; r < 16; ++r) wa[r] = KIN(I_WA2)[((size_t)l * 16 + r) * 256 + c];
        const float ba = KIN(I_BA)[l * 256 + c];
        u32x4 g0r[TPS], g1r[TPS]; unsigned qr[TPS], kr[TPS];
#pragma unroll
        for (int u = 0; u < TPS; ++u) { const size_t row = (size_t)(t0 + u) * NPAD; g0r[u] = *(const u32x4*)(P + row + C_GA); g1r[u] = *(const u32x4*)(P + row + C_GA + 8); qr[u] = P[row + C_GQ + c]; kr[u] = P[row + C_GK + c]; }
#pragma unroll
        for (int u = 0; u < TPS; ++u) { const u32x4 g0 = g0r[u], g1 = g1r[u];
            float a = ba;
            a += bflo(g0.x) * wa[0] + bfhi(g0.x) * wa[1] + bflo(g0.y) * wa[2] + bfhi(g0.y) * wa[3] + bflo(g0.z) * wa[4] + bfhi(g0.z) * wa[5] + bflo(g0.w) * wa[6] + bfhi(g0.w) * wa[7];
            a += bflo(g1.x) * wa[8] + bfhi(g1.x) * wa[9] + bflo(g1.y) * wa[10] + bfhi(g1.y) * wa[11] + bflo(g1.z) * wa[12] + bfhi(g1.z) * wa[13] + bflo(g1.w) * wa[14] + bfhi(g1.w) * wa[15];
            const float ls2 = fminf(a, 0.f) * LOG2E - __builtin_amdgcn_logf(1.0f + __builtin_amdgcn_exp2f(-LOG2E * fabsf(a)));
            qv[u] = bf2f(qr[u]) * 0.125f; kv[u] = bf2f(kr[u]);
            run += ls2 * (1.0f / 16.0f); bv[u] = run; }
    }
    tot[seg * DK + d] = run;
    __syncthreads();
    float off = 0.f; bend = 0.f; bref = 0.f;
#pragma unroll
    for (int sgi = 0; sgi < NSEG; ++sgi) { const float v = tot[sgi * DK + d]; off += sgi < seg ? v : 0.f; bref += sgi < NSEG / 2 ? v : 0.f; bend += v; }
#pragma unroll
    for (int u = 0; u < TPS; ++u) bv[u] += off;
}
template <int KIND> __device__ __forceinline__ void rec_vt_load(KArgs* ka, int head, int chunk, int tid, unsigned (&w)[8]) {
    const bf16* P = (const bf16*)(KWS + WS_P) + (KIND == 0 ? C_HI : C_GV) + head * 128;
    const int v = tid & 127, sv = tid >> 7;
#pragma unroll
    for (int u = 0; u < 8; ++u) { const unsigned a = P[(size_t)(chunk * 64 + sv * 16 + 2 * u) * NPAD + v], b = P[(size_t)(chunk * 64 + sv * 16 + 2 * u + 1) * NPAD + v]; w[u] = a | (b << 16); }
}
__device__ __forceinline__ void rec_vt_store(int tid, LAS unsigned char* lds, const unsigned (&w)[8]) {
    const int v = tid & 127, sv = tid >> 7;
    LAS u32x4* dst = (LAS u32x4*)(lds + REC_VT_OFF + v * 144 + sv * 32);
    dst[0] = (u32x4){w[0], w[1], w[2], w[3]}; dst[1] = (u32x4){w[4], w[5], w[6], w[7]};
}
template <int KIND> __device__ __forceinline__ void rec_local_unit(KArgs* ka, Frame& F, int l, int head, int chunk) {
    constexpr int DK = RecCfg<KIND>::DK, TPS = RecCfg<KIND>::TPS;
    LAS unsigned char* lds = F.lds; LAS float* tot = (LAS float*)(lds + REC_TOT_OFF);
    float qv[TPS], kv[TPS], bv[TPS], bend, bref;
    unsigned vraw[8];
    rec_vt_load<KIND>(ka, head, chunk, F.tid, vraw);
    rec_elem<KIND>(ka, l, head, chunk, F.tid, tot, qv, kv, bv, bend, bref);
    const int d = F.tid % DK, seg = F.tid / DK, unit = chunk * 4 + head;
    { unsigned w[TPS / 2];
#pragma unroll
      for (int u = 0; u < TPS / 2; ++u) w[u] = pkbf(kv[2 * u] * expc(bend - bv[2 * u]), kv[2 * u + 1] * expc(bend - bv[2 * u + 1]));
      LAS u32x4* dst = (LAS u32x4*)(lds + REC_KD_OFF + d * 144 + seg * TPS * 2);
      dst[0] = (u32x4){w[0], w[1], w[2], w[3]};
      if constexpr (TPS == 16) dst[1] = (u32x4){w[4], w[5], w[6], w[7]}; }
    if (seg == 0) ((float*)(KWS + WS_DEC + (KIND == 0 ? 0 : 262144)))[(size_t)unit * DK + d] = __builtin_amdgcn_exp2f(bend);
    rec_vt_store(F.tid, lds, vraw);
    __syncthreads();
    const int r = F.lane & 15, kq = F.lane >> 4;
    const int dt = KIND == 0 ? F.wave : (F.wave & 3), vt0 = KIND == 0 ? 0 : (F.wave >> 2) * 4, nvt = KIND == 0 ? 8 : 4;
    bf16x8 a[2];
#pragma unroll
    for (int ks = 0; ks < 2; ++ks) a[ks] = *(const LAS bf16x8*)(lds + REC_KD_OFF + (16 * dt + r) * 144 + (32 * ks + 8 * kq) * 2);
    bf16* Sl = (bf16*)(KWS + (KIND == 0 ? WS_SLOC_HG : WS_SLOC_GL)) + (size_t)unit * 128 * DK;
#pragma unroll
    for (int vi = 0; vi < nvt; ++vi) { const int vt = vt0 + vi; f32x4 acc = {0.f, 0.f, 0.f, 0.f};
#pragma unroll
        for (int ks = 0; ks < 2; ++ks) { const bf16x8 b = *(const LAS bf16x8*)(lds + REC_VT_OFF + (16 * vt + r) * 144 + (32 * ks + 8 * kq) * 2); acc = __builtin_amdgcn_mfma_f32_16x16x32_bf16(a[ks], b, acc, 0, 0, 0); }
        u32x2 w2; w2.x = pkbf(acc[0], acc[1]); w2.y = pkbf(acc[2], acc[3]);
        *(u32x2*)(Sl + (size_t)(16 * vt + r) * DK + 16 * dt + 4 * kq) = w2; }
    __syncthreads();
}
__device__ __forceinline__ void phase_rec_local(Frame& F, int l) {
    KA;
    for (int it = F.bid; it < 1024; it += F.G) { const int kind = it >> 9, chunk = (it >> 2) & 127, head = it & 3;
        if (kind == 0) rec_local_unit<0>(ka, F, l, head, chunk); else rec_local_unit<1>(ka, F, l, head, chunk); }
}
__device__ __forceinline__ void phase_rec_scan(Frame& F) {
    KA;
    const int gt = F.bid * 512 + F.tid;
    if (gt >= 49152) return;
    const bool hg = gt < 32768; const int q = hg ? gt : gt - 32768;
    const int DK = hg ? 128 : 64, dp = q % (DK / 2), v = (q / (DK / 2)) & 127, head = q / (DK / 2 * 128);
    const bf16* Sl = (const bf16*)(KWS + (hg ? WS_SLOC_HG : WS_SLOC_GL)) + ((size_t)head * 128 + v) * DK + 2 * dp;
    bf16* Sp = (bf16*)(KWS + (hg ? WS_SPREV_HG : WS_SPREV_GL)) + ((size_t)head * 128 + v) * DK + 2 * dp;
    const float* De = (const float*)(KWS + WS_DEC + (hg ? 0 : 262144)) + (size_t)head * DK + 2 * dp;
    const size_t ustr = (size_t)4 * 128 * DK, dstr = (size_t)4 * DK;
    float s0 = 0.f, s1 = 0.f;
    for (int c0 = 0; c0 < NCH; c0 += 16) { unsigned x[16]; f32x2 dc[16];
#pragma unroll
        for (int u = 0; u < 16; ++u) { x[u] = *(const unsigned*)(Sl + (size_t)(c0 + u) * ustr); dc[u] = *(const f32x2*)(De + (size_t)(c0 + u) * dstr); }
#pragma unroll
        for (int u = 0; u < 16; ++u) { *(unsigned*)(Sp + (size_t)(c0 + u) * ustr) = pkbf(s0, s1); s0 = dc[u].x * s0 + bflo(x[u]); s1 = dc[u].y * s1 + bfhi(x[u]); } }
}
template <int KIND> __device__ __forceinline__ void rec_out_unit(KArgs* ka, Frame& F, int l, int head, int chunk) {
    constexpr int DK = RecCfg<KIND>::DK, TPS = RecCfg<KIND>::TPS, QROW = RecCfg<KIND>::QROW, NKS = DK / 32;
    LAS unsigned char* lds = F.lds; LAS float* tot = (LAS float*)(lds + REC_TOT_OFF); LAS float* red = (LAS float*)(lds + REC_RED_OFF);
    const int r = F.lane & 15, kq = F.lane >> 4, unit = chunk * 4 + head, vt = F.wave;
    bf16x8 sa[NKS];
    { const bf16* Sp = (const bf16*)(KWS + (KIND == 0 ? WS_SPREV_HG : WS_SPREV_GL)) + (size_t)unit * 128 * DK + (size_t)(16 * vt + r) * DK + 8 * kq;
#pragma unroll
      for (int ks = 0; ks < NKS; ++ks) sa[ks] = *(const bf16x8*)(Sp + 32 * ks); }
    float qv[TPS], kv[TPS], bv[TPS], bend, bref;
    unsigned vraw[8];
    rec_vt_load<KIND>(ka, head, chunk, F.tid, vraw);
    const bf16* P = (const bf16*)(KWS + WS_P); bf16* OCAT = (bf16*)(KWS + WS_OCAT);
    const int v0 = 16 * vt + 4 * kq;
    const f32x4 gn = *(const f32x4*)((KIND == 0 ? KIN(I_HGN) : KIN(I_GLAN)) + l * 128 + v0);
    u32x2 gq4[4];
#pragma unroll
    for (int it = 0; it < 4; ++it) gq4[it] = *(const u32x2*)(P + (size_t)(chunk * 64 + 16 * it + r) * NPAD + (KIND == 0 ? C_HG : C_GR) + head * 128 + v0);
    rec_elem<KIND>(ka, l, head, chunk, F.tid, tot, qv, kv, bv, bend, bref);
    { const int d = F.tid % DK, seg = F.tid / DK; const float eref = __builtin_amdgcn_exp2f(fmaxf(bref, -120.f));
#pragma unroll
      for (int u = 0; u < TPS; u += 2) { const int o = (seg * TPS + u) * QROW + d * 2;
          const float x0 = __builtin_amdgcn_exp2f(fminf(fmaxf(bv[u] - bref, -110.f), 110.f)), x1 = __builtin_amdgcn_exp2f(fminf(fmaxf(bv[u + 1] - bref, -110.f), 110.f));
          const float qs0 = qv[u] * x0, qs1 = qv[u + 1] * x1;
          const unsigned w0 = pkbf(qs0, qs1), w1 = pkbf(kv[u] * __builtin_amdgcn_rcpf(x0), kv[u + 1] * __builtin_amdgcn_rcpf(x1)), w2 = pkbf(qs0 * eref, qs1 * eref);
          *(LAS bf16*)(lds + REC_QS_OFF + o) = (bf16)w0; *(LAS bf16*)(lds + REC_QS_OFF + o + QROW) = (bf16)(w0 >> 16);
          *(LAS bf16*)(lds + REC_KS_OFF + o) = (bf16)w1; *(LAS bf16*)(lds + REC_KS_OFF + o + QROW) = (bf16)(w1 >> 16);
          *(LAS bf16*)(lds + REC_QD_OFF + o) = (bf16)w2; *(LAS bf16*)(lds + REC_QD_OFF + o + QROW) = (bf16)(w2 >> 16); } }
    rec_vt_store(F.tid, lds, vraw);
    __syncthreads();
#pragma unroll
    for (int tt = 0; tt < 2; ++tt) { const int tile = F.wave * 2 + tt, jt = tile >> 2, it = tile & 3; f32x4 acc = {0.f, 0.f, 0.f, 0.f};
        if (jt <= it) {
#pragma unroll
            for (int ks = 0; ks < NKS; ++ks) { const bf16x8 a = *(const LAS bf16x8*)(lds + REC_KS_OFF + (16 * jt + r) * QROW + (32 * ks + 8 * kq) * 2), b = *(const LAS bf16x8*)(lds + REC_QS_OFF + (16 * it + r) * QROW + (32 * ks + 8 * kq) * 2);
                acc = __builtin_amdgcn_mfma_f32_16x16x32_bf16(a, b, acc, 0, 0, 0); } }
        const int i = 16 * it + r, j0 = 16 * jt + 4 * kq;
        u32x2 w; w.x = pk2(j0 <= i ? acc[0] : 0.f, j0 + 1 <= i ? acc[1] : 0.f); w.y = pk2(j0 + 2 <= i ? acc[2] : 0.f, j0 + 3 <= i ? acc[3] : 0.f);
        *(LAS u32x2*)(lds + REC_KD_OFF + i * 144 + j0 * 2) = w; }
    __syncthreads();
    f32x4 acc[4];
#pragma unroll
    for (int it = 0; it < 4; ++it) acc[it] = (f32x4){0.f, 0.f, 0.f, 0.f};
#pragma unroll
    for (int ks = 0; ks < 2; ++ks) { const bf16x8 a = *(const LAS bf16x8*)(lds + REC_VT_OFF + (16 * vt + r) * 144 + (32 * ks + 8 * kq) * 2);
#pragma unroll
        for (int it = 0; it < 4; ++it) { const bf16x8 b = *(const LAS bf16x8*)(lds + REC_KD_OFF + (16 * it + r) * 144 + (32 * ks + 8 * kq) * 2); acc[it] = __builtin_amdgcn_mfma_f32_16x16x32_bf16(a, b, acc[it], 0, 0, 0); } }
#pragma unroll
    for (int ks = 0; ks < NKS; ++ks) {
#pragma unroll
        for (int it = 0; it < 4; ++it) { const bf16x8 b = *(const LAS bf16x8*)(lds + REC_QD_OFF + (16 * it + r) * QROW + (32 * ks + 8 * kq) * 2); acc[it] = __builtin_amdgcn_mfma_f32_16x16x32_bf16(sa[ks], b, acc[it], 0, 0, 0); } }
#pragma unroll
    for (int it = 0; it < 4; ++it) { float ss = acc[it][0] * acc[it][0] + acc[it][1] * acc[it][1] + acc[it][2] * acc[it][2] + acc[it][3] * acc[it][3];
        ss += lshx(ss, 16); ss += lshx(ss, 32);
        if (kq == 0) red[F.wave * 64 + 16 * it + r] = ss; }
    __syncthreads();
#pragma unroll
    for (int it = 0; it < 4; ++it) { const int i = 16 * it + r, t = chunk * 64 + i; float tot_ = 0.f;
#pragma unroll
        for (int w = 0; w < 8; ++w) tot_ += red[w * 64 + i];
        const float rstd = 1.0f / sqrtf(tot_ * (1.0f / 128.0f) + EPS);
        const u32x2 gq = gq4[it];
        float gt[4] = {bflo(gq.x), bfhi(gq.x), bflo(gq.y), bfhi(gq.y)}, o[4];
#pragma unroll
        for (int e = 0; e < 4; ++e) { const float sg = fsig(gt[e]); o[e] = acc[it][e] * rstd * gn[e] * (KIND == 0 ? sg : gt[e] * sg); }
        u32x2 w; w.x = pkbf(o[0], o[1]); w.y = pkbf(o[2], o[3]);
        *(u32x2*)(OCAT + (size_t)t * 1536 + 512 + KIND * 512 + head * 128 + v0) = w; }
    __syncthreads();
}
__device__ __forceinline__ void phase_rec_out(Frame& F, int l) {
    KA;
    unsigned* qctr = (unsigned*)(KWS + WS_CTL) + 2048 + 64 * l;
    volatile LAS int* qslot = (volatile LAS int*)(F.lds + MISC_OFF + 1024);
    int mine = 0;
    if (F.tid == 0) { mine = (int)__hip_atomic_fetch_add(qctr, 1u, __ATOMIC_RELAXED, __HIP_MEMORY_SCOPE_AGENT);
        unsigned* sdone = (unsigned*)(KWS + WS_CTL) + 2048 + 64 * (4 + l); unsigned sp = 0;
        while (__hip_atomic_load(sdone, __ATOMIC_RELAXED, __HIP_MEMORY_SCOPE_AGENT) < 96u) { __builtin_amdgcn_s_sleep(2); if (++sp > (1u << 24)) break; }
        __builtin_amdgcn_fence(__ATOMIC_ACQUIRE, "agent"); asm volatile("s_waitcnt vmcnt(0)" ::: "memory"); }
    for (;;) {
        if (F.tid == 0) *qslot = mine;
        __syncthreads();
        const int it = __builtin_amdgcn_readfirstlane(*qslot);
        __syncthreads();
        if (it >= 1024) break;
        if (F.tid == 0) mine = (int)__hip_atomic_fetch_add(qctr, 1u, __ATOMIC_RELAXED, __HIP_MEMORY_SCOPE_AGENT);
        const int kind = it >> 9, chunk = (it >> 2) & 127, head = it & 3;
        if (kind == 0) rec_out_unit<0>(ka, F, l, head, chunk); else rec_out_unit<1>(ka, F, l, head, chunk);
    }
}

typedef float f32x16 __attribute__((ext_vector_type(16)));
constexpr float NSA_SHIFT2 = 8.0f;
__device__ __forceinline__ int perm16(int b) { return (b & 3) | ((b & 4) << 1) | ((b & 8) >> 1); }
__device__ __forceinline__ void phase_prep2(Frame& F, int l) {
    KA;
    const bf16* P = (const bf16*)(KWS + WS_P);
    bf16* QS = (bf16*)(KWS + WS_QS); bf16* KS2 = (bf16*)(KWS + WS_KS2); bf16* KW2 = (bf16*)(KWS + WS_KW2);
    const float* qg = KIN(I_QN) + l * 64; const float* kg = KIN(I_KN) + l * 192;
    for (int it = F.gw; it < T * 12; it += F.NGW) {
        const int t = it / 12, v = it % 12;
        const int col = v < 8 ? v * 64 : (v < 10 ? C_KS + (v - 8) * 64 : C_KW + (v - 10) * 64);
        float x = bf2f(P[(size_t)t * NPAD + col + F.lane]);
        const float ss = wave_sum(x * x);
        const float g = v < 8 ? qg[F.lane] * (0.125f * LOG2E) : (v < 10 ? kg[64 + F.lane] : kg[128 + F.lane]);
        x = x * (1.0f / sqrtf(ss * (1.0f / 64.0f) + EPS)) * g;
        bf16* dst = v < 8 ? QS + ((size_t)v * T + t) * 64 : (v < 10 ? KS2 + ((size_t)(v - 8) * T + t) * 64 : KW2 + ((size_t)(v - 10) * T + t) * 64);
        dst[F.lane] = (bf16)f2bf(x);
    }
    LAS bf16* tile = (LAS bf16*)(F.lds + F.wave * 16384);
    for (int it = F.gw; it < 2 * 2 * (T / 64); it += F.NGW) {
        const int kind = it / (2 * (T / 64)), q = it % (2 * (T / 64)), g = q / (T / 64), tb = q % (T / 64);
        const bf16* src = P + (size_t)(tb * 64) * NPAD + (kind == 0 ? C_VS : C_VW) + g * 64;
        bf16* dst = (bf16*)(KWS + (kind == 0 ? WS_VST : WS_VWT)) + (size_t)g * 64 * T + tb * 64;
#pragma unroll 4
        for (int r = 0; r < 64; ++r) tile[r * 66 + F.lane] = src[(size_t)r * NPAD + F.lane];
        WSYNC();
        const int pl = (F.lane & ~15) | perm16(F.lane & 15);
#pragma unroll 4
        for (int d = 0; d < 64; ++d) dst[(size_t)d * T + pl] = tile[F.lane * 66 + d];
        WSYNC();
    }
}

__device__ __forceinline__ void phase_prep3(Frame& F, int l) {
    KA;
    const bf16* P = (const bf16*)(KWS + WS_P);
    bf16* QS = (bf16*)(KWS + WS_QS); bf16* KS2 = (bf16*)(KWS + WS_KS2); bf16* KW2 = (bf16*)(KWS + WS_KW2);
    const float* qg = KIN(I_QN) + l * 64; const float* kg = KIN(I_KN) + l * 192;
    const int vec = F.lane >> 3, part = F.lane & 7;
    for (int t = F.gw; t < T; t += F.NGW) {
#pragma unroll
        for (int pass = 0; pass < 2; ++pass) {
            if (pass == 1 && vec >= 4) continue;
            const int col = pass == 0 ? vec * 64 : (vec < 2 ? C_KS + vec * 64 : C_KW + (vec - 2) * 64);
            const float* gp = pass == 0 ? qg : (vec < 2 ? kg + 64 : kg + 128);
            const float gs = pass == 0 ? 0.125f * LOG2E : 1.0f;
            bf16* dst = pass == 0 ? QS + ((size_t)vec * T + t) * 64 : (vec < 2 ? KS2 + ((size_t)vec * T + t) * 64 : KW2 + ((size_t)(vec - 2) * T + t) * 64);
            const u32x4 raw = *(const u32x4*)(P + (size_t)t * NPAD + col + part * 8);
            float x[8] = {bflo(raw.x), bfhi(raw.x), bflo(raw.y), bfhi(raw.y), bflo(raw.z), bfhi(raw.z), bflo(raw.w), bfhi(raw.w)};
            float ss = 0.f;
#pragma unroll
            for (int e = 0; e < 8; ++e) ss += x[e] * x[e];
            ss += lshx(ss, 1); ss += lshx(ss, 2); ss += lshx(ss, 4);
            const float rstd = gs / sqrtf(ss * (1.0f / 64.0f) + EPS);
            const f32x4 g0 = *(const f32x4*)(gp + part * 8), g1 = *(const f32x4*)(gp + part * 8 + 4);
            u32x4 o; o.x = pk2(x[0] * rstd * g0.x, x[1] * rstd * g0.y); o.y = pk2(x[2] * rstd * g0.z, x[3] * rstd * g0.w); o.z = pk2(x[4] * rstd * g1.x, x[5] * rstd * g1.y); o.w = pk2(x[6] * rstd * g1.z, x[7] * rstd * g1.w);
            *(u32x4*)(dst + part * 8) = o;
        }
    }
    LAS bf16* tile = (LAS bf16*)(F.lds + F.wave * 16384);
    for (int it = F.gw; it < 2 * 2 * (T / 64); it += F.NGW) {
        const int kind = it / (2 * (T / 64)), q = it % (2 * (T / 64)), g = q / (T / 64), tb = q % (T / 64);
        const bf16* src = P + (size_t)(tb * 64) * NPAD + (kind == 0 ? C_VS : C_VW) + g * 64;
        bf16* dst = (bf16*)(KWS + (kind == 0 ? WS_VST : WS_VWT)) + (size_t)g * 64 * T + tb * 64;
#pragma unroll
        for (int i = 0; i < 8; ++i) { const int tok = vec + 8 * i; *(LAS u32x4*)(tile + tok * 72 + part * 8) = *(const u32x4*)(src + (size_t)tok * NPAD + part * 8); }
        WSYNC();
#pragma unroll
        for (int c = 0; c < 8; ++c) { unsigned w[4];
#pragma unroll
            for (int k = 0; k < 4; ++k) { const int p0 = (c & 1) * 8 + 2 * k, p1 = p0 + 1;
                const int k0 = (c >> 1) * 16 + ((p0 & 3) | ((p0 & 4) << 1) | ((p0 & 8) >> 1)), k1 = (c >> 1) * 16 + ((p1 & 3) | ((p1 & 4) << 1) | ((p1 & 8) >> 1));
                w[k] = (unsigned)tile[k0 * 72 + F.lane] | ((unsigned)tile[k1 * 72 + F.lane] << 16); }
            *(u32x4*)(dst + (size_t)F.lane * T + c * 8) = (u32x4){w[0], w[1], w[2], w[3]}; }
        WSYNC();
    }
}

__device__ __forceinline__ void phase_compress2(Frame& F, int l) {
    KA;
    LAS float* av = (LAS float*)(F.lds + F.wave * 16384);
    const bf16* P = (const bf16*)(KWS + WS_P);
    bf16* KCB = (bf16*)(KWS + WS_KCB); bf16* VCT = (bf16*)(KWS + WS_KCB + 131072);
    for (int it = F.gw; it < 2 * 2 * 512; it += F.NGW) {
        const int kind = it >> 10, g = (it >> 9) & 1, n = it & 511;
        if (n == 511) { if (kind == 0) KCB[((size_t)g * 512 + 511) * 64 + F.lane] = 0; else VCT[((size_t)g * 64 + F.lane) * 512 + 511] = 0; continue; }
        const bf16* src = P + (size_t)(16 * n) * NPAD + (kind == 0 ? C_KC : C_VC) + g * 64;
        const float* pe = KIN(I_PE) + ((size_t)l * 2 + kind) * 2048;
        const float* w1 = KIN(I_W1) + ((size_t)l * 2 + kind) * 2048 * 64;
        const float* w2 = KIN(I_W2) + ((size_t)l * 2 + kind) * 64 * 64;
#pragma unroll 4
        for (int c = 0; c < 32; ++c) av[c * 64 + F.lane] = bf2f(src[(size_t)c * NPAD + F.lane]) + pe[c * 64 + F.lane];
        WSYNC();
        float acc = 0.f;
#pragma unroll 8
        for (int i = 0; i < 2048; ++i) acc += av[i] * w1[i * 64 + F.lane];
        const float hid = gelu_tanh(acc);
        WSYNC();
        av[F.lane] = hid;
        WSYNC();
        float o = 0.f;
#pragma unroll 8
        for (int i = 0; i < 64; ++i) o += av[i] * w2[i * 64 + F.lane];
        WSYNC();
        if (kind == 0) { const float ss = wave_sum(o * o); o = o * (1.0f / sqrtf(ss * (1.0f / 64.0f) + EPS)) * KIN(I_KN)[l * 192 + F.lane]; KCB[((size_t)g * 512 + n) * 64 + F.lane] = (bf16)f2bf(o); }
        else VCT[((size_t)g * 64 + F.lane) * 512 + ((n & ~15) | perm16(n & 15))] = (bf16)f2bf(o);
    }
}

__device__ __forceinline__ void phase_compress3(Frame& F, int l) {
    KA;
    const bf16* P = (const bf16*)(KWS + WS_P);
    bf16* KCB = (bf16*)(KWS + WS_KCB); bf16* VCT = (bf16*)(KWS + WS_KCB + 131072);
    LAS float* red = (LAS float*)F.lds;
    LAS bf16* hid = (LAS bf16*)(F.lds + 32768);
    const int r16 = F.lane & 15, kq = F.lane >> 4;
    for (int unit = F.bid; unit < 128; unit += F.G) {
        const int kind = unit >> 6, mt = unit & 63, g = mt >> 5, n0 = (mt & 31) * 16;
        const bf16* W1T = (const bf16*)(KWS + WS_CW) + (size_t)(l * 2 + kind) * 64 * 2048; const bf16* W2T = (const bf16*)(KWS + WS_CW + 1048576) + (size_t)(l * 2 + kind) * 4096;
        const float* B1 = (const float*)(KWS + WS_CW + 1572864) + (l * 2 + kind) * 64;
        const bf16* arow = P + (size_t)(16 * (n0 + r16)) * NPAD + (kind == 0 ? C_KC : C_VC) + g * 64;
        f32x4 acc[4];
#pragma unroll
        for (int nt = 0; nt < 4; ++nt) acc[nt] = (f32x4){0.f, 0.f, 0.f, 0.f};
#pragma unroll 2
        for (int ks = 0; ks < 8; ++ks) { const int c0 = F.wave * 256 + 32 * ks + 8 * kq;
            const bf16x8 a = *(const bf16x8*)(arow + (size_t)(c0 >> 6) * NPAD + (c0 & 63));
#pragma unroll
            for (int nt = 0; nt < 4; ++nt) { const bf16x8 b = *(const bf16x8*)(W1T + (size_t)(16 * nt + r16) * 2048 + c0); acc[nt] = __builtin_amdgcn_mfma_f32_16x16x32_bf16(a, b, acc[nt], 0, 0, 0); } }
#pragma unroll
        for (int nt = 0; nt < 4; ++nt) *(LAS f32x4*)(red + ((F.wave * 4 + nt) * 64 + F.lane) * 4) = acc[nt];
        __syncthreads();
        if (F.tid < 256) { const int nt = F.tid >> 6, ln = F.tid & 63; f32x4 v = {0.f, 0.f, 0.f, 0.f};
#pragma unroll
            for (int w = 0; w < 8; ++w) v += *(const LAS f32x4*)(red + ((w * 4 + nt) * 64 + ln) * 4);
            const int col = 16 * nt + (ln & 15); const float b1 = B1[col];
#pragma unroll
            for (int i = 0; i < 4; ++i) hid[(4 * (ln >> 4) + i) * 72 + col] = (bf16)f2bf(gelu_tanh(v[i] + b1)); }
        __syncthreads();
        if (F.wave == 0) {
            f32x4 o[4];
#pragma unroll
            for (int nt = 0; nt < 4; ++nt) o[nt] = (f32x4){0.f, 0.f, 0.f, 0.f};
#pragma unroll
            for (int ks = 0; ks < 2; ++ks) { const bf16x8 a = *(const LAS bf16x8*)(hid + r16 * 72 + 32 * ks + 8 * kq);
#pragma unroll
                for (int nt = 0; nt < 4; ++nt) { const bf16x8 b = *(const bf16x8*)(W2T + (16 * nt + r16) * 64 + 32 * ks + 8 * kq); o[nt] = __builtin_amdgcn_mfma_f32_16x16x32_bf16(a, b, o[nt], 0, 0, 0); } }
            if (kind == 0) {
#pragma unroll
                for (int i = 0; i < 4; ++i) { float ss = o[0][i] * o[0][i] + o[1][i] * o[1][i] + o[2][i] * o[2][i] + o[3][i] * o[3][i];
                    ss += lshx(ss, 1); ss += lshx(ss, 2); ss += lshx(ss, 4); ss += lshx(ss, 8);
                    const float rstd = 1.0f / sqrtf(ss * (1.0f / 64.0f) + EPS); const int n = n0 + 4 * kq + i;
#pragma unroll
                    for (int nt = 0; nt < 4; ++nt) { const int col = 16 * nt + r16; KCB[((size_t)g * 512 + n) * 64 + col] = n < 511 ? (bf16)f2bf(o[nt][i] * rstd * KIN(I_KN)[l * 192 + col]) : (bf16)0; } }
            } else {
#pragma unroll
                for (int i = 0; i < 4; ++i) { const int n = n0 + 4 * kq + i;
#pragma unroll
                    for (int nt = 0; nt < 4; ++nt) { const int col = 16 * nt + r16; VCT[((size_t)g * 64 + col) * 512 + ((n & ~15) | perm16(n & 15))] = n < 511 ? (bf16)f2bf(o[nt][i]) : (bf16)0; } }
            }
        }
        __syncthreads();
    }
}

constexpr int NSA_SCA = 65536, NSA_SCB = 99328;
constexpr int NSA_QM = 133120, NSA_UM = 134144;
static_assert(NSA_UM + 16 <= MISC_OFF, "NSA LDS map");
__device__ __forceinline__ int next_set(unsigned long long m0, unsigned long long m1, int from) {
    if (from < 64) { const unsigned long long x = m0 & (~0ull << from); if (x) return __builtin_ctzll(x); from = 64; }
    if (from < 128) { const unsigned long long x = m1 & (~0ull << (from - 64)); if (x) return 64 + __builtin_ctzll(x); }
    return 128;
}
__device__ __forceinline__ void nsa_issue(LAS unsigned char* lds, int slot, const bf16* Kg, const bf16* VTg, int vt_len, int j, int tid, int wave) {
    const int row = tid >> 3, c = (tid & 7) ^ ((row >> 1) & 7);
    __builtin_amdgcn_global_load_lds((const unsigned*)(Kg + (size_t)(64 * j + row) * 64 + c * 8), (LAS unsigned*)(lds + slot * 16384 + wave * 1024), 16, 0, 0);
    __builtin_amdgcn_global_load_lds((const unsigned*)(VTg + (size_t)row * vt_len + 64 * j + c * 8), (LAS unsigned*)(lds + slot * 16384 + 8192 + wave * 1024), 16, 0, 0);
}
template <int MODE> __device__ __forceinline__ void nsa_branch(Frame& F, const bf16* Kg, const bf16* VTg, int vt_len, unsigned long long m0, unsigned long long m1,
        const bf16x8 (&Qf)[4], int t, int cblk, u32x4 qxw, int tref, float inv_l, const unsigned (&qsel)[4], int hi_cmp, unsigned wm_lo_dummy, f32x16 (&oacc)[2], float& lsum) {
    LAS unsigned char* lds = F.lds;
    const int lane = F.lane, c32 = lane & 31, h = lane >> 5, tid = F.tid;
    const int sw = (c32 >> 1) & 7;
    int j0 = next_set(m0, m1, 0);
    if (j0 >= 128) return;
    int j1 = next_set(m0, m1, j0 + 1), j2 = j1 < 128 ? next_set(m0, m1, j1 + 1) : 128;
    nsa_issue(lds, 0, Kg, VTg, vt_len, j0, tid, F.wave);
    if (j1 < 128) nsa_issue(lds, 1, Kg, VTg, vt_len, j1, tid, F.wave);
    if (j2 < 128) nsa_issue(lds, 2, Kg, VTg, vt_len, j2, tid, F.wave);
    int slot = 0;
    while (j0 < 128) {
        const int j = j0;
        if (j2 < 128) asm volatile("s_waitcnt vmcnt(4)" ::: "memory"); else if (j1 < 128) asm volatile("s_waitcnt vmcnt(2)" ::: "memory"); else asm volatile("s_waitcnt vmcnt(0)" ::: "memory");
        __builtin_amdgcn_s_barrier(); asm volatile("" ::: "memory");
        const int j3 = j2 < 128 ? next_set(m0, m1, j2 + 1) : 128;
        if (j3 < 128) nsa_issue(lds, (slot + 3) & 3, Kg, VTg, vt_len, j3, tid, F.wave);
        bool need = true;
        if (MODE == 2) { const unsigned myw = j < 32 ? qsel[0] : (j < 64 ? qsel[1] : (j < 96 ? qsel[2] : qsel[3])); need = __any((myw >> (j & 31)) & 1u); }
        if (need) {
            const int kb = slot * 16384, vb = slot * 16384 + 8192;
            const int kbase = 64 * j;
            u32x4 qx = qxw;
            if (MODE == 2) { const unsigned myw = j < 32 ? qsel[0] : (j < 64 ? qsel[1] : (j < 96 ? qsel[2] : qsel[3])); if (!((myw >> (j & 31)) & 1u) && h == 0) qx.z = 0xF149u; }
            const bf16x8 qxf = __builtin_bit_cast(bf16x8, qx);
            f32x16 sacc[2];
#pragma unroll
            for (int sub = 0; sub < 2; ++sub)
#pragma unroll
                for (int i = 0; i < 16; ++i) sacc[sub][i] = 0.f;
#pragma unroll
            for (int sub = 0; sub < 2; ++sub) {
#pragma unroll
                for (int kp = 0; kp < 2; ++kp) { bf16x8 ka2[2];
#pragma unroll
                    for (int k2 = 0; k2 < 2; ++k2) ka2[k2] = *(const LAS bf16x8*)(lds + kb + (32 * sub + c32) * 128 + (((2 * (2 * kp + k2) + h) ^ sw) * 16));
                    asm volatile("" ::: "memory");
#pragma unroll
                    for (int k2 = 0; k2 < 2; ++k2) sacc[sub] = __builtin_amdgcn_mfma_f32_32x32x16_bf16(ka2[k2], Qf[2 * kp + k2], sacc[sub], 0, 0, 0);
                    asm volatile("" ::: "memory"); }
                { const int kidx = kbase + 32 * sub + c32, pos = MODE < 2 ? 16 * kidx + 31 : kidx, dd = tref - pos;
                  const unsigned w = pkbf(-(float)((dd >> 8) * 256), -(float)(dd & 255));
                  u32x4 kx; kx.x = h == 0 ? w : 0u; kx.y = kx.x; kx.z = h == 0 ? 0x3F80u : 0u; kx.w = 0u;
                  sacc[sub] = __builtin_amdgcn_mfma_f32_32x32x16_bf16(__builtin_bit_cast(bf16x8, kx), qxf, sacc[sub], 0, 0, 0); } }
#pragma unroll
            for (int sub = 0; sub < 2; ++sub)
#pragma unroll
                for (int i = 0; i < 16; ++i) sacc[sub][i] = __builtin_amdgcn_exp2f(sacc[sub][i]);
            bool mhi = false, mlo = false; int hi = 0, lo = 0;
            if (MODE < 2) { mhi = (kbase + 63 > (tref - 63 - 31) / 16 - 1); hi = hi_cmp; }
            if (MODE == 2) { mhi = (j == cblk); hi = t; }
            if (MODE == 3) { mhi = (j == cblk); hi = t; mlo = (j == cblk - 8); lo = t - 511; }
            if (mhi || mlo) {
#pragma unroll
                for (int sub = 0; sub < 2; ++sub)
#pragma unroll
                    for (int i = 0; i < 16; ++i) { const int idx = kbase + 4 * h + 32 * sub + (i & 3) + 8 * (i >> 2); if ((mhi && idx > hi) || (mlo && idx < lo)) sacc[sub][i] = 0.f; }
            }
            float ls = 0.f;
#pragma unroll
            for (int sub = 0; sub < 2; ++sub)
#pragma unroll
                for (int i = 0; i < 16; ++i) ls += sacc[sub][i];
            lsum += ls;
            if (MODE == 1) {
                LAS float* scA = (LAS float*)(lds + NSA_SCA); LAS float* scB = (LAS float*)(lds + NSA_SCB);
                const int q = F.wave * 8 + (c32 >> 2);
#pragma unroll
                for (int sub = 0; sub < 2; ++sub)
#pragma unroll
                    for (int g4 = 0; g4 < 4; ++g4) { float x[4];
#pragma unroll
                        for (int e = 0; e < 4; ++e) { float v = sacc[sub][4 * g4 + e] * inv_l;
                            v += __builtin_bit_cast(float, __builtin_amdgcn_mov_dpp(__builtin_bit_cast(int, v), 0xB1, 0xF, 0xF, true));
                            v += __builtin_bit_cast(float, __builtin_amdgcn_mov_dpp(__builtin_bit_cast(int, v), 0x4E, 0xF, 0xF, true));
                            x[e] = v; }
                        const int jb = 16 * j + 8 * sub + 2 * g4 + h;
                        if ((c32 & 3) == 0) { scA[q * 132 + jb] = 2.0f * (x[0] + x[1] + x[2]) + x[3]; scB[q * 132 + jb + 1] = x[3]; } }
            }
            if (MODE != 0) {
                bf16x8 pf[2][2];
#pragma unroll
                for (int sub = 0; sub < 2; ++sub)
#pragma unroll
                    for (int s2 = 0; s2 < 2; ++s2) { u32x4 w; w.x = pkbf(sacc[sub][8 * s2], sacc[sub][8 * s2 + 1]); w.y = pkbf(sacc[sub][8 * s2 + 2], sacc[sub][8 * s2 + 3]); w.z = pkbf(sacc[sub][8 * s2 + 4], sacc[sub][8 * s2 + 5]); w.w = pkbf(sacc[sub][8 * s2 + 6], sacc[sub][8 * s2 + 7]);
                        pf[sub][s2] = __builtin_bit_cast(bf16x8, w); }
                asm volatile("" ::: "memory");
#pragma unroll
                for (int ds = 0; ds < 2; ++ds) {
#pragma unroll
                    for (int qp = 0; qp < 2; ++qp) { bf16x8 va2[2];
#pragma unroll
                        for (int k2 = 0; k2 < 2; ++k2) va2[k2] = *(const LAS bf16x8*)(lds + vb + (32 * ds + c32) * 128 + (((2 * (2 * qp + k2) + h) ^ sw) * 16));
                        asm volatile("" ::: "memory");
#pragma unroll
                        for (int k2 = 0; k2 < 2; ++k2) oacc[ds] = __builtin_amdgcn_mfma_f32_32x32x16_bf16(va2[k2], pf[qp][k2], oacc[ds], 0, 0, 0);
                        asm volatile("" ::: "memory"); } }
            }
        }
        j0 = j1; j1 = j2; j2 = j3; slot = (slot + 1) & 3;
    }
    asm volatile("s_waitcnt lgkmcnt(0)" ::: "memory"); __builtin_amdgcn_s_barrier(); asm volatile("" ::: "memory");
}
__device__ __forceinline__ void nsa_stash_put(LAS unsigned char* lds, int wave, int lane, const f32x16 (&o)[2], float sc) {
    LAS unsigned* st = (LAS unsigned*)(lds + NSA_SCA) + wave * 1024 + lane;
#pragma unroll
    for (int ds = 0; ds < 2; ++ds)
#pragma unroll
        for (int k = 0; k < 8; ++k) st[(ds * 8 + k) * 64] = pkbf(o[ds][2 * k] * sc, o[ds][2 * k + 1] * sc);
}
#define PSTAMP(slot) do { if (MK_PROBE_MASK != 0 && F.bid == MK_PROBE_BID && F.tid == 0) { volatile LAS unsigned long long* _ta = (volatile LAS unsigned long long*)(F.lds + MISC_OFF + 512); const unsigned long long _n = wall_clock64(); _ta[slot] += _n - _ta[16]; _ta[16] = _n; } } while (0)
__device__ __forceinline__ void phase_nsa2(Frame& F, int l) {
    KA;
    LAS unsigned char* lds = F.lds;
    const bf16* P = (const bf16*)(KWS + WS_P); bf16* OCAT = (bf16*)(KWS + WS_OCAT);
    const bf16* QS = (const bf16*)(KWS + WS_QS);
    const int lane = F.lane, c32 = lane & 31, h = lane >> 5, q8 = c32 >> 2, r = c32 & 3;
    for (int unit = F.bid; unit < 256; unit += F.G) {
        const int g = unit & 1, cblk = unit >> 1, t0 = cblk * 64, head = g * 4 + r, t = t0 + F.wave * 8 + q8;
        u32x4 qxw;
        { const float s2 = exp2f(-(float)(head + 1)) * LOG2E; const unsigned sh = f2bf(s2); const float rem = s2 - bf2f(sh); const unsigned sl = f2bf(rem);
          qxw.x = h == 0 ? (sh | (sh << 16)) : 0u; qxw.y = h == 0 ? (sl | (sl << 16)) : 0u; qxw.z = 0u; qxw.w = 0u; }
        const int tref = t0 + 63;
        bf16x8 Qf[4];
#pragma unroll
        for (int ks = 0; ks < 4; ++ks) Qf[ks] = *(const bf16x8*)(QS + ((size_t)head * T + t) * 64 + 16 * ks + 8 * h);
        for (int u = F.tid; u < (NSA_UM + 16 - NSA_SCA) / 4; u += 512) ((LAS unsigned*)(lds + NSA_SCA))[u] = 0u;
        __syncthreads();
        f32x16 oacc[2];
#pragma unroll
        for (int ds = 0; ds < 2; ++ds)
#pragma unroll
            for (int i = 0; i < 16; ++i) oacc[ds][i] = 0.f;
        unsigned qsel[4] = {0u, 0u, 0u, 0u};
        float sc_cmp;
        PSTAMP(24);
        {
            const int ntile = (4 * cblk + 2) / 64 + 1;
            const unsigned long long cm0 = ntile >= 64 ? ~0ull : ((1ull << ntile) - 1ull);
            const int hi_cmp = t >= 31 ? (t - 31) / 16 : -1;
            const bf16* Kg = (const bf16*)(KWS + WS_KCB) + (size_t)g * 512 * 64; const bf16* VTg = (const bf16*)(KWS + WS_KCB + 131072) + (size_t)g * 64 * 512;
            float l1 = 0.f;
            nsa_branch<0>(F, Kg, VTg, 512, cm0, 0ull, Qf, t, cblk, qxw, tref, 0.f, qsel, hi_cmp, 0u, oacc, l1);
            l1 += lshx(l1, 32);
            const float inv_l = l1 > 0.f ? 1.0f / l1 : 0.f;
            float l2 = 0.f;
            nsa_branch<1>(F, Kg, VTg, 512, cm0, 0ull, Qf, t, cblk, qxw, tref, inv_l, qsel, hi_cmp, 0u, oacc, l2);
            sc_cmp = sigmoidf_(bf2f(P[(size_t)t * NPAD + C_NG + head])) * inv_l;
        }
        PSTAMP(20);
        {
            LAS float* scA = (LAS float*)(lds + NSA_SCA); LAS float* scB = (LAS float*)(lds + NSA_SCB);
            LAS unsigned* qm = (LAS unsigned*)(lds + NSA_QM); LAS unsigned* um = (LAS unsigned*)(lds + NSA_UM);
            WSYNC();
            const int qq = F.wave * 8 + (lane >> 3), jj = lane & 7;
            unsigned key[16];
#pragma unroll
            for (int m = 0; m < 16; ++m) { const int jb = jj + 8 * m; float sv = scA[qq * 132 + jb] + scB[qq * 132 + jb];
                if (jb == 0 || jb == cblk || jb == cblk - 1) sv = 1e4f;
                key[m] = jb <= cblk ? ((__builtin_bit_cast(unsigned, sv) & ~127u) | (unsigned)(127 - jb)) : 0u; }
            WSYNC();
#pragma unroll
            for (int m = 0; m < 16; ++m) ((LAS unsigned*)scA)[qq * 132 + jj + 8 * m] = key[m];
            WSYNC();
            unsigned bits[4] = {0u, 0u, 0u, 0u};
#pragma unroll
            for (int half = 0; half < 2; ++half) { int rank[8];
#pragma unroll
                for (int m = 0; m < 8; ++m) rank[m] = 0;
#pragma unroll 2
                for (int i = 0; i <= cblk; i += 4) { const u32x4 k4 = *(const LAS u32x4*)((const LAS unsigned*)scA + qq * 132 + i);
#pragma unroll
                    for (int m = 0; m < 8; ++m) rank[m] += (k4.x > key[8 * half + m] ? 1 : 0) + (k4.y > key[8 * half + m] ? 1 : 0) + (k4.z > key[8 * half + m] ? 1 : 0) + (k4.w > key[8 * half + m] ? 1 : 0); }
#pragma unroll
                for (int m = 0; m < 8; ++m) { const int jb = jj + 8 * (8 * half + m); if (jb <= cblk && rank[m] < 16) bits[(8 * half + m) >> 2] |= 1u << (jb & 31); } }
#pragma unroll
            for (int w = 0; w < 4; ++w) if (bits[w]) { atomicOr((unsigned*)(qm + qq * 4 + w), bits[w]); atomicOr((unsigned*)(um + w), bits[w]); }
            __syncthreads();
#pragma unroll
            for (int w = 0; w < 4; ++w) qsel[w] = qm[(F.wave * 8 + q8) * 4 + w];
        }
        PSTAMP(21);
        nsa_stash_put(lds, F.wave, lane, oacc, sc_cmp);
#pragma unroll
        for (int ds = 0; ds < 2; ++ds)
#pragma unroll
            for (int i = 0; i < 16; ++i) oacc[ds][i] = 0.f;
        {
            LAS unsigned* um = (LAS unsigned*)(lds + NSA_UM);
            const unsigned long long sm0 = (unsigned long long)__builtin_amdgcn_readfirstlane(um[0]) | ((unsigned long long)__builtin_amdgcn_readfirstlane(um[1]) << 32);
            const unsigned long long sm1 = (unsigned long long)__builtin_amdgcn_readfirstlane(um[2]) | ((unsigned long long)__builtin_amdgcn_readfirstlane(um[3]) << 32);
            float ls = 0.f;
            nsa_branch<2>(F, (const bf16*)(KWS + WS_KS2) + (size_t)g * T * 64, (const bf16*)(KWS + WS_VST) + (size_t)g * 64 * T, T, sm0, sm1, Qf, t, cblk, qxw, tref, 0.f, qsel, 0, 0u, oacc, ls);
            ls += lshx(ls, 32);
            const float sc = sigmoidf_(bf2f(P[(size_t)t * NPAD + C_NG + 8 + head])) / ls;
            LAS unsigned* st = (LAS unsigned*)(lds + NSA_SCA) + F.wave * 1024 + lane;
#pragma unroll
            for (int ds = 0; ds < 2; ++ds)
#pragma unroll
                for (int k = 0; k < 8; ++k) { const unsigned w = st[(ds * 8 + k) * 64]; st[(ds * 8 + k) * 64] = pkbf(bflo(w) + sc * oacc[ds][2 * k], bfhi(w) + sc * oacc[ds][2 * k + 1]); oacc[ds][2 * k] = 0.f; oacc[ds][2 * k + 1] = 0.f; }
        }
        PSTAMP(22);
        {
            const int j0 = cblk >= 8 ? cblk - 8 : 0;
            unsigned long long wm0 = 0ull, wm1 = 0ull;
            for (int jb = j0; jb <= cblk; ++jb) { if (jb < 64) wm0 |= 1ull << jb; else wm1 |= 1ull << (jb - 64); }
            float ls = 0.f;
            nsa_branch<3>(F, (const bf16*)(KWS + WS_KW2) + (size_t)g * T * 64, (const bf16*)(KWS + WS_VWT) + (size_t)g * 64 * T, T, wm0, wm1, Qf, t, cblk, qxw, tref, 0.f, qsel, 0, 0u, oacc, ls);
            ls += lshx(ls, 32);
            const float sc = sigmoidf_(bf2f(P[(size_t)t * NPAD + C_NG + 16 + head])) / ls;
            const LAS unsigned* st = (const LAS unsigned*)(lds + NSA_SCA) + F.wave * 1024 + lane;
#pragma unroll
            for (int ds = 0; ds < 2; ++ds)
#pragma unroll
                for (int g4 = 0; g4 < 4; ++g4) { const unsigned w0 = st[(ds * 8 + 2 * g4) * 64], w1 = st[(ds * 8 + 2 * g4 + 1) * 64];
                    u32x2 w; w.x = pkbf(bflo(w0) + sc * oacc[ds][4 * g4], bfhi(w0) + sc * oacc[ds][4 * g4 + 1]); w.y = pkbf(bflo(w1) + sc * oacc[ds][4 * g4 + 2], bfhi(w1) + sc * oacc[ds][4 * g4 + 3]);
                    *(u32x2*)(OCAT + (size_t)t * 1536 + head * 64 + 32 * ds + 8 * g4 + 4 * h) = w; }
        }
        __syncthreads();
        PSTAMP(23);
    }
}

__device__ __forceinline__ void phase_merge(Frame& F) {
    KA;
    const bf16* P = (const bf16*)(KWS + WS_P); const bf16* PROJ = (const bf16*)(KWS + WS_PROJ); bf16* MG = (bf16*)(KWS + WS_MERGED);
    const size_t total = (size_t)T * D / 8;
    for (size_t it = (size_t)F.gw * 64 + F.lane; it < total; it += (size_t)F.NGW * 64) {
        const size_t t = it / (D / 8); const int d = (int)(it % (D / 8)) * 8;
        float acc[8];
#pragma unroll
        for (int k = 0; k < 8; ++k) acc[k] = 0.f;
#pragma unroll
        for (int n = 0; n < 3; ++n) { const u32x4 gq = *(const u32x4*)(P + t * NPAD + C_MG + n * D + d); const u32x4 pq = *(const u32x4*)(PROJ + ((size_t)n * T + t) * D + d);
            acc[0] += sigmoidf_(bflo(gq.x)) * bflo(pq.x); acc[1] += sigmoidf_(bfhi(gq.x)) * bfhi(pq.x); acc[2] += sigmoidf_(bflo(gq.y)) * bflo(pq.y); acc[3] += sigmoidf_(bfhi(gq.y)) * bfhi(pq.y);
            acc[4] += sigmoidf_(bflo(gq.z)) * bflo(pq.z); acc[5] += sigmoidf_(bfhi(gq.z)) * bfhi(pq.z); acc[6] += sigmoidf_(bflo(gq.w)) * bflo(pq.w); acc[7] += sigmoidf_(bfhi(gq.w)) * bfhi(pq.w); }
        u32x4 o; o.x = pk2(acc[0], acc[1]); o.y = pk2(acc[2], acc[3]); o.z = pk2(acc[4], acc[5]); o.w = pk2(acc[6], acc[7]);
        *(u32x4*)(MG + t * D + d) = o;
    }
}
__device__ __forceinline__ void phase_router(Frame& F, int l) {
    KA;
    const float* X1 = (const float*)(KWS + WS_X1); bf16* H = (bf16*)(KWS + WS_H);
    int* EID = (int*)(KWS + WS_ROUTE); float* EW = (float*)(KWS + WS_ROUTE + 65536);
    const float* gain = KIN(I_NFFN) + (size_t)l * D; const float* wg = KIN(I_WGRP) + (size_t)l * D * 4; const float* we = KIN(I_WEXP) + (size_t)l * D * 32;
    const float* bg = KIN(I_BGRP) + l * 4; const float* be = KIN(I_BEXP) + l * 32;
    for (int t = F.gw; t < T; t += F.NGW) {
        const float* xrow = X1 + (size_t)t * D;
        float ss = 0.f;
#pragma unroll 4
        for (int k = 0; k < 32; ++k) { const float x = xrow[F.lane + 64 * k]; ss += x * x; }
        const float rstd = 1.0f / sqrtf(wave_sum(ss) * (1.0f / D) + EPS);
        float ag[4] = {0.f, 0.f, 0.f, 0.f}, ae[32];
#pragma unroll
        for (int e = 0; e < 32; ++e) ae[e] = 0.f;
#pragma unroll 1
        for (int k = 0; k < 32; ++k) { const int d = F.lane + 64 * k;
            const float hv = xrow[d] * rstd * gain[d];
            H[(size_t)t * D + d] = (bf16)f2bf(hv);
            const f32x4 w4 = *(const f32x4*)(wg + (size_t)d * 4);
            ag[0] += hv * w4.x; ag[1] += hv * w4.y; ag[2] += hv * w4.z; ag[3] += hv * w4.w;
#pragma unroll
            for (int c = 0; c < 8; ++c) { const f32x4 w = *(const f32x4*)(we + (size_t)d * 32 + c * 4); ae[c * 4] += hv * w.x; ae[c * 4 + 1] += hv * w.y; ae[c * 4 + 2] += hv * w.z; ae[c * 4 + 3] += hv * w.w; } }
#pragma unroll
        for (int e = 0; e < 4; ++e) ag[e] = wave_sum(ag[e]) + bg[e];
#pragma unroll
        for (int e = 0; e < 32; ++e) ae[e] = wave_sum(ae[e]) + be[e];
        int gi = 0; float gm = ag[0];
#pragma unroll
        for (int e = 1; e < 4; ++e) if (ag[e] > gm) { gm = ag[e]; gi = e; }
        float gs = 0.f;
#pragma unroll
        for (int e = 0; e < 4; ++e) gs += expf(ag[e] - gm);
        const float gw_ = 1.0f / gs;
        float el[8];
#pragma unroll
        for (int e = 0; e < 8; ++e) { el[e] = gi == 0 ? ae[e] : (gi == 1 ? ae[8 + e] : (gi == 2 ? ae[16 + e] : ae[24 + e])); }
        int i1 = 0; float m1 = el[0];
#pragma unroll
        for (int e = 1; e < 8; ++e) if (el[e] > m1) { m1 = el[e]; i1 = e; }
        int i2 = -1; float m2 = -3.0e38f;
#pragma unroll
        for (int e = 0; e < 8; ++e) if (e != i1 && el[e] > m2) { m2 = el[e]; i2 = e; }
        const float p2 = expf(m2 - m1);
        const float w1 = 1.0f / (1.0f + p2), w2 = p2 / (1.0f + p2);
        if (F.lane == 0) { EID[2 * t] = gi * 8 + i1; EID[2 * t + 1] = gi * 8 + i2; EW[2 * t] = gw_ * w1; EW[2 * t + 1] = gw_ * w2; }
    }
}

__device__ __forceinline__ void phase_router3(Frame& F, int l) {
    KA;
    const float* X1 = (const float*)(KWS + WS_X1); unsigned char* H8 = (unsigned char*)(KWS + WS_H8);
    int* EID = (int*)(KWS + WS_ROUTE); float* EW = (float*)(KWS + WS_ROUTE + 65536); float* RSTD = (float*)(KWS + WS_RSTD);
    unsigned* CNTg = (unsigned*)(KWS + WS_CTL) + CW_CNT + 64 * l; int* LIST = (int*)(KWS + WS_ROUTE + 262144);
    const float* WRT = (const float*)(KWS + WS_WRT) + (size_t)l * 48 * D;
    const float* gain = KIN(I_NFFN) + (size_t)l * D; const float* bg = KIN(I_BGRP) + l * 4; const float* be = KIN(I_BEXP) + l * 32;
    LAS float* red = (LAS float*)F.lds;
    LAS float* ssq = (LAS float*)(F.lds + 49152);
    LAS float* lg = (LAS float*)(F.lds + 50176);
    LAS float* rs = (LAS float*)(F.lds + 55296);
    LAS int* eidl = (LAS int*)(F.lds + 55424);
    const int r16 = F.lane & 15, kq = F.lane >> 4;
    for (int blk = F.bid; blk < T / 32; blk += F.G) {
        const int tok0 = blk * 32, kb0 = F.wave * 256 + 4 * kq;
        const float* xa = X1 + (size_t)(tok0 + r16) * D + kb0;
        const float* wb = WRT + (size_t)r16 * D + kb0;
        unsigned char* hp = H8 + (size_t)(tok0 + r16) * D + kb0;
        f32x4 acc[2][3]; float sq[2] = {0.f, 0.f};
#pragma unroll
        for (int tg = 0; tg < 2; ++tg)
#pragma unroll
            for (int nt = 0; nt < 3; ++nt) acc[tg][nt] = (f32x4){0.f, 0.f, 0.f, 0.f};
#pragma unroll 2
        for (int s = 0; s < 16; ++s) { f32x4 a[2], b[3];
#pragma unroll
            for (int tg = 0; tg < 2; ++tg) a[tg] = *(const f32x4*)(xa + (size_t)(16 * tg) * D + 16 * s);
#pragma unroll
            for (int nt = 0; nt < 3; ++nt) b[nt] = *(const f32x4*)(wb + (size_t)(16 * nt) * D + 16 * s);
            const f32x4 g = *(const f32x4*)(gain + kb0 + 16 * s);
#pragma unroll
            for (int tg = 0; tg < 2; ++tg) { sq[tg] += a[tg].x * a[tg].x + a[tg].y * a[tg].y + a[tg].z * a[tg].z + a[tg].w * a[tg].w;
                *(unsigned*)(hp + (size_t)(16 * tg) * D + 16 * s) = pk4_fp8(a[tg].x * g.x * S_A1, a[tg].y * g.y * S_A1, a[tg].z * g.z * S_A1, a[tg].w * g.w * S_A1);
#pragma unroll
                for (int j = 0; j < 4; ++j)
#pragma unroll
                    for (int nt = 0; nt < 3; ++nt) acc[tg][nt] = __builtin_amdgcn_mfma_f32_16x16x4f32(a[tg][j], b[nt][j], acc[tg][nt], 0, 0, 0); } }
#pragma unroll
        for (int tg = 0; tg < 2; ++tg) { sq[tg] += lshx(sq[tg], 16); sq[tg] += lshx(sq[tg], 32);
            if (kq == 0) ssq[F.wave * 32 + 16 * tg + r16] = sq[tg];
#pragma unroll
            for (int nt = 0; nt < 3; ++nt) *(LAS f32x4*)(red + (((F.wave * 2 + tg) * 3 + nt) * 64 + F.lane) * 4) = acc[tg][nt]; }
        __syncthreads();
        if (F.tid < 384) { const int tg2 = F.tid / 192, rem = F.tid % 192, nt = rem / 64, ln = rem % 64; f32x4 v = {0.f, 0.f, 0.f, 0.f};
#pragma unroll
            for (int w = 0; w < 8; ++w) v += *(const LAS f32x4*)(red + (((w * 2 + tg2) * 3 + nt) * 64 + ln) * 4);
            const int col = 16 * nt + (ln & 15);
            if (col < 36) {
#pragma unroll
                for (int i = 0; i < 4; ++i) lg[(16 * tg2 + 4 * (ln >> 4) + i) * 40 + col] = v[i]; } }
        if (F.tid >= 384 && F.tid < 416) { const int tk = F.tid - 384; float q2 = 0.f;
#pragma unroll
            for (int w = 0; w < 8; ++w) q2 += ssq[w * 32 + tk];
            const float r = 1.0f / sqrtf(q2 * (1.0f / D) + EPS); rs[tk] = r; RSTD[tok0 + tk] = r; }
        __syncthreads();
        if (F.tid < 32) { const int tk = F.tid, t = tok0 + tk; const float rstd = rs[tk];
            float ag[4], el[8];
#pragma unroll
            for (int e = 0; e < 4; ++e) ag[e] = lg[tk * 40 + 32 + e] * rstd + bg[e];
            int gi = 0; float gm = ag[0];
#pragma unroll
            for (int e = 1; e < 4; ++e) if (ag[e] > gm) { gm = ag[e]; gi = e; }
            float gs = 0.f;
#pragma unroll
            for (int e = 0; e < 4; ++e) gs += expf(ag[e] - gm);
            const float gw_ = 1.0f / gs;
#pragma unroll
            for (int e = 0; e < 8; ++e) el[e] = lg[tk * 40 + gi * 8 + e] * rstd + be[gi * 8 + e];
            int i1 = 0; float m1 = el[0];
#pragma unroll
            for (int e = 1; e < 8; ++e) if (el[e] > m1) { m1 = el[e]; i1 = e; }
            int i2 = -1; float m2 = -3.0e38f;
#pragma unroll
            for (int e = 0; e < 8; ++e) if (e != i1 && el[e] > m2) { m2 = el[e]; i2 = e; }
            const float p2 = expf(m2 - m1), w1 = 1.0f / (1.0f + p2), w2 = p2 / (1.0f + p2);
            EID[2 * t] = gi * 8 + i1; EID[2 * t + 1] = gi * 8 + i2; EW[2 * t] = gw_ * w1; EW[2 * t + 1] = gw_ * w2;
            eidl[2 * tk] = gi * 8 + i1; eidl[2 * tk + 1] = gi * 8 + i2; }
        __syncthreads();
        LAS int* base = eidl + 64;
        if (F.tid < 32) { int c = 0;
#pragma unroll 8
            for (int i = 0; i < 64; ++i) c += eidl[i] == F.tid ? 1 : 0;
            base[F.tid] = c > 0 ? (int)__hip_atomic_fetch_add(CNTg + F.tid, (unsigned)c, __ATOMIC_RELAXED, __HIP_MEMORY_SCOPE_AGENT) : 0; }
        __syncthreads();
        if (F.tid < 64) { const int e = eidl[F.tid]; int rk = 0;
            for (int i = 0; i < F.tid; ++i) rk += eidl[i] == e ? 1 : 0;
            LIST[e * 8192 + base[e] + rk] = blk * 64 + F.tid; }
        __syncthreads();
    }
}
__device__ __forceinline__ void phase_lists2(Frame& F) {
    KA;
    const int* EID = (const int*)(KWS + WS_ROUTE); int* CNT = (int*)(KWS + WS_ROUTE + 131072); int* LIST = (int*)(KWS + WS_ROUTE + 262144); const int* HIST = (const int*)(KWS + WS_HIST);
    LAS int* off = (LAS int*)F.lds; LAS int* eidl = off + 32; LAS int* psum = off + 128;
    for (int blk = F.bid; blk < T / 32; blk += F.G) {
        { const int e = F.tid & 31, part = F.tid >> 5; int a = 0;
#pragma unroll 4
          for (int b2 = part; b2 < blk; b2 += 16) a += HIST[b2 * 32 + e];
          psum[part * 32 + e] = a; }
        __syncthreads();
        if (F.tid < 32) { int a = 0;
#pragma unroll
            for (int p = 0; p < 16; ++p) a += psum[p * 32 + F.tid];
            off[F.tid] = a;
            if (blk == T / 32 - 1) CNT[F.tid] = a + HIST[blk * 32 + F.tid]; }
        if (F.tid >= 64 && F.tid < 128) eidl[F.tid - 64] = EID[blk * 64 + F.tid - 64];
        __syncthreads();
        if (F.tid < 64) { const int e = eidl[F.tid]; int rk = 0;
            for (int i = 0; i < F.tid; ++i) rk += eidl[i] == e ? 1 : 0;
            LIST[e * 8192 + off[e] + rk] = blk * 64 + F.tid; }
        __syncthreads();
    }
}

__device__ __forceinline__ void phase_lists(Frame& F) {
    KA;
    const int e = F.bid;
    if (e >= NE) return;
    const int* EID = (const int*)(KWS + WS_ROUTE); int* CNT = (int*)(KWS + WS_ROUTE + 131072); int* LIST = (int*)(KWS + WS_ROUTE + 262144);
    LAS int* wc = (LAS int*)F.lds;
    int run = 0;
    for (int base = 0; base < 2 * T; base += 512) {
        const int idx = base + F.tid; const bool match = EID[idx] == e;
        const unsigned long long b = __ballot(match);
        if (F.lane == 0) wc[F.wave] = __popcll(b);
        __syncthreads();
        int pre = 0, tot = 0;
#pragma unroll
        for (int w = 0; w < 8; ++w) { const int c = wc[w]; pre += w < F.wave ? c : 0; tot += c; }
        if (match) LIST[e * 8192 + run + pre + __popcll(b & ((1ull << F.lane) - 1ull))] = idx;
        run += tot;
        __syncthreads();
    }
    if (F.tid == 0) CNT[e] = run;
}
__device__ __forceinline__ void moe_table(Frame& F, LAS int* tb, int l) {
    KA;
    const int* CNT = (const int*)(KWS + WS_CTL) + CW_CNT + 64 * l;
    if (F.tid == 0) { int a = 0, f = 0, h = 0;
        for (int e = 0; e < NE; ++e) { const int n = CNT[e], nt = (n + 255) / 256, lastv = n - (nt - 1) * 256, hh = (nt > 0 && lastv <= 128) ? 1 : 0;
            tb[e] = a; tb[33 + e] = f; tb[66 + e] = h; a += nt; f += nt - hh; h += hh; }
        tb[NE] = a; tb[33 + NE] = f; tb[66 + NE] = h; }
    __syncthreads();
}

constexpr int PH_PER_LAYER = 7, N_PHASES = 1 + NL * PH_PER_LAYER + 1;

__global__ void __launch_bounds__(512, 2) mk_fwd(Args args) {
    extern __shared__ __attribute__((aligned(16))) unsigned char lds_raw[];
#define FRAME Frame F; F.lds = (LAS unsigned char*)lds_raw; F.MISC = (volatile LAS unsigned*)(F.lds + MISC_OFF); F.tid = ltid(); F.lane = F.tid & 63; F.wave = __builtin_amdgcn_readfirstlane(F.tid >> 6); \
    F.G = gridDim.x; F.bid = lbid(); F.vcu = (F.G % 8 == 0) ? (F.bid % 8) * (F.G / 8) + F.bid / 8 : F.bid; F.gw = F.bid * 8 + F.wave; F.NGW = F.G * 8;
    unsigned* const ctl = (unsigned*)((unsigned char*)args.ws + WS_CTL);
    for (int u = threadIdx.x; u < (LDS_BYTES - MISC_OFF) / 4; u += 512) ((LAS unsigned*)(lds_raw + MISC_OFF))[u] = 0u;
    __syncthreads();
    const int lo = args.ph_lo, hi = args.ph_hi;
    XcdBarrier bar; bar.bar = ctl + CW_BAR + args.li * XCD_BAR_WORDS; bar.x = 0; bar.st = nullptr;
    if (hi - lo > 1) bar = xcd_barrier_post(ctl + CW_BAR + args.li * XCD_BAR_WORDS, (volatile LAS unsigned*)((LAS unsigned char*)lds_raw + MISC_OFF));
    int ph = 0;
#define RUN(k) ((k) >= lo && (k) < hi)

    volatile LAS unsigned long long* const tacc = (volatile LAS unsigned long long*)((LAS unsigned char*)lds_raw + MISC_OFF + 512);
    if (MK_PROBE_MASK != 0 && blockIdx.x == MK_PROBE_BID && threadIdx.x == 0) tacc[16] = wall_clock64();
#define STAMP(slot) do { if (MK_PROBE_MASK != 0 && lbid() == MK_PROBE_BID && ltid() == 0) { const unsigned long long _n = wall_clock64(); tacc[slot] += _n - tacc[16]; tacc[16] = _n; } } while (0)
#define SEAM(k, slot) do { if ((k) + 1 < hi) xcd_barrier(bar); STAMP(slot); } while (0)
    LAS int* const tb = (LAS int*)((LAS unsigned char*)lds_raw + MISC_OFF + 64);

    if (RUN(ph)) { KA; FRAME; phase_prologue(F); phase_norm1<0>(F, KIN(I_X), nullptr, nullptr, KIN(I_NMIX), (bf16*)(KWS + WS_H), (unsigned char*)(KWS + WS_H8)); SEAM(ph, 0); }
    ++ph;
    for (int l = 0; l < NL; ++l) {
        if (RUN(ph)) { KA; FRAME;
            {
              pg8::PlainSched S; S.init(KWS + WS_H, D, (const bf16*)(KWS + WS_WIN) + (size_t)l * NPAD * D, T, 20 * 256, D, F.G, F.bid, 4); S.pn_from = 19; S.pn_to = 43;
              pg8::EpiBf16 E{(bf16*)(KWS + WS_P), NPAD, 1.0f};
              pg8::gemm_phase<pg8::EpiBf16, pg8::PlainSched, true>(F.lds, D, S, E); }
            __syncthreads();
            {
              pg8::PlainSchedT<true> S; S.init(KWS + WS_H8, D, (const unsigned char*)(KWS + WS_WIN8) + (size_t)l * 6144 * D, T, 6144, D, F.G, F.bid, 0); S.wsb = (const char*)KWS;
              pg8::EpiBf16 E{(bf16*)(KWS + WS_P) + C_MG, NPAD, 1.0f / (S_H * S_WG)};
              pg8::gemm_phase<pg8::EpiBf16, pg8::PlainSchedT<true>, true>(F.lds, D, S, E); }
            SEAM(ph, 1); }
        ++ph;
        if (RUN(ph)) { KA; FRAME; phase_prep3(F, l); __syncthreads(); phase_compress3(F, l); phase_rec_local(F, l); SEAM(ph, 3); }
        ++ph;
        if (RUN(ph)) { KA; FRAME; if (F.bid < 96) { phase_rec_scan(F);
                asm volatile("s_waitcnt vmcnt(0)" ::: "memory"); __syncthreads();
                if (F.tid == 0) { __builtin_amdgcn_fence(__ATOMIC_RELEASE, "agent"); asm volatile("s_waitcnt vmcnt(0)" ::: "memory");
                    __hip_atomic_fetch_add((unsigned*)(KWS + WS_CTL) + 2048 + 64 * (4 + l), 1u, __ATOMIC_RELAXED, __HIP_MEMORY_SCOPE_AGENT); } }
            phase_nsa2(F, l); phase_rec_out(F, l); SEAM(ph, 5); }
        ++ph;
        if (RUN(ph)) { KA; FRAME;
            { pg8::BranchSched S; S.init((const bf16*)(KWS + WS_OCAT), (const bf16*)(KWS + WS_WBR) + (size_t)l * 3 * D * 512, F.G, F.bid);
              pg8::EpiMerge E{(bf16*)(KWS + WS_MERGED), (const bf16*)(KWS + WS_P) + C_MG};
              pg8::gemm_phase<pg8::EpiMerge, pg8::BranchSched, true>(F.lds, 512, S, E); }
            SEAM(ph, 6); }
        ++ph;

        if (RUN(ph)) { KA; FRAME; pg8::PlainSched S; S.init((const bf16*)(KWS + WS_MERGED), D, (const bf16*)(KWS + WS_WOUT) + (size_t)l * D * D, T, D, D, F.G, F.bid);
            pg8::EpiResF32 E{l == 0 ? KIN(I_X) : (const float*)(KWS + WS_XRES), (float*)(KWS + WS_X1), D};
            pg8::gemm_phase<pg8::EpiResF32, pg8::PlainSched, false>(F.lds, D, S, E); SEAM(ph, 8); }
        ++ph;
        if (RUN(ph)) { KA; FRAME; phase_router3(F, l); SEAM(ph, 9); }
        ++ph;
        if (RUN(ph)) { KA; FRAME; moe_table(F, tb, l);
            unsigned* tilecnt = (unsigned*)(KWS + WS_CTL) + 131072 + (size_t)l * 128 * 64;
            { pg8::MoeSched<1> S; S.init(F.G, F.vcu, tb, (const int*)(KWS + WS_CTL) + CW_CNT + 64 * l, (const int*)(KWS + WS_ROUTE + 262144), KWS + WS_H8, (const unsigned char*)(KWS + WS_WGU) + (size_t)l * NE * 1024 * D);
              S.tilecnt = tilecnt; S.tick = nullptr; S.tslot = nullptr; S.myticket = 0;
              pg8::EpiMoe1 E{(unsigned char*)(KWS + WS_ACT), (const int*)(KWS + WS_ROUTE + 262144), (const float*)(KWS + WS_ROUTE + 65536), (const float*)(KWS + WS_RSTD)};
              pg8::gemm_phase<pg8::EpiMoe1, pg8::MoeSched<1>, true>(F.lds, D, S, E); }
            __syncthreads();
            { pg8::MoeSched<2> S; S.init(F.G, F.vcu, tb, (const int*)(KWS + WS_CTL) + CW_CNT + 64 * l, (const int*)(KWS + WS_ROUTE + 262144), KWS + WS_ACT, (const unsigned char*)(KWS + WS_WDN) + (size_t)l * NE * D * FF);
              S.tilecnt = tilecnt; S.tick = (unsigned*)(KWS + WS_CTL) + 2048 + 64 * (6 + l); S.tslot = (volatile LAS int*)(F.lds + MISC_OFF + 1028); S.myticket = 0;
              pg8::EpiMoe2 E{(bf16*)(KWS + WS_CONTRIB), (const int*)(KWS + WS_ROUTE + 262144)};
              pg8::gemm_phase<pg8::EpiMoe2, pg8::MoeSched<2>, true>(F.lds, FF, S, E); }
            SEAM(ph, 12); }
        ++ph;
        if (l + 1 < NL) { if (RUN(ph)) { KA; FRAME; phase_norm1<1>(F, (const float*)(KWS + WS_X1), (const bf16*)(KWS + WS_CONTRIB), (float*)(KWS + WS_XRES), KIN(I_NMIX) + (size_t)(l + 1) * D, (bf16*)(KWS + WS_H), (unsigned char*)(KWS + WS_H8)); SEAM(ph, 13); } ++ph; }
    }
    if (RUN(ph)) { KA; FRAME; phase_norm1<2>(F, (const float*)(KWS + WS_X1), (const bf16*)(KWS + WS_CONTRIB), KOUT, nullptr, nullptr); }
    if (MK_PROBE_MASK != 0 && lbid() == MK_PROBE_BID && ltid() == 0) {
        asm volatile("s_waitcnt vmcnt(0)" ::: "memory"); STAMP(15);
        unsigned long long tot = 0ull;
        for (int k2 = 0; k2 < 32; ++k2) if (k2 != 16 && ((MK_PROBE_MASK >> k2) & 1)) tot += tacc[k2];
        const unsigned long long t_end = wall_clock64() + 4ull * tot;
        while (wall_clock64() < t_end) __builtin_amdgcn_s_sleep(8);
    }
#undef RUN
#undef SEAM
}

#ifndef MK_PER_PHASE
#define MK_PER_PHASE 0
#endif
extern "C" void kernel_launch(void* const* d_in, const int* in_sizes, int n_in, void* d_out, int out_size, void* d_ws, size_t ws_size, hipStream_t stream) {
    static int grid = 0;
    if (grid == 0) {
        if (n_in != 22 || out_size != T * D || ws_size < WS_END) { fprintf(stderr, "kernel_launch: unexpected sizes (n_in %d out %d ws %zu)\n", n_in, out_size, ws_size); grid = -1; return; }
        int dev = 0, cus = 0, per_cu = 0;
        if (hipGetDevice(&dev) != hipSuccess || hipDeviceGetAttribute(&cus, hipDeviceAttributeMultiprocessorCount, dev) != hipSuccess) { grid = -1; return; }
        if (hipFuncSetAttribute((const void*)mk_fwd, hipFuncAttributeMaxDynamicSharedMemorySize, LDS_BYTES) != hipSuccess) { fprintf(stderr, "kernel_launch: hipFuncSetAttribute failed\n"); grid = -1; return; }
        if (hipOccupancyMaxActiveBlocksPerMultiprocessor(&per_cu, (const void*)mk_fwd, 512, LDS_BYTES) != hipSuccess || per_cu < 1) { fprintf(stderr, "kernel_launch: occupancy query says %d\n", per_cu); }
        (void)hipGetLastError();
        grid = cus;
    }
    if (grid < 0) return;
    if (hipMemsetAsync((char*)d_ws + WS_CTL, 0, CTL_ZERO_BYTES, stream) != hipSuccess) return;
    Args a{};
    for (int i = 0; i < 22; ++i) a.in[i] = (const GAS float*)d_in[i];
    a.out = (GAS float*)d_out; a.ws = (GAS unsigned char*)d_ws;
#if MK_PER_PHASE
    const int total = 1 + NL * PH_PER_LAYER + (NL - 1) + 1;
    for (int k = 0; k < total; ++k) { a.ph_lo = k; a.ph_hi = k + 1; a.li = 0; hipLaunchKernelGGL(mk_fwd, dim3(grid), dim3(512), LDS_BYTES, stream, a); }
#else
    a.ph_lo = 0; a.ph_hi = 1000; a.li = 0;
    hipLaunchKernelGGL(mk_fwd, dim3(grid), dim3(512), LDS_BYTES, stream, a);
#endif
    const hipError_t le = hipPeekAtLastError();
    if (le != hipSuccess) fprintf(stderr, "kernel_launch: launch failed: %s\n", hipGetErrorName(le));
}
```

```cpp
#include <hip/hip_runtime.h>
#include <cstdio>
#include <cstdint>

#ifndef MOESC
#define MOESC 3
#endif
#ifndef MK_PROBE_MASK
#define MK_PROBE_MASK 0
#endif
#ifndef MK_PROBE_BID
#define MK_PROBE_BID 0
#endif
#define GAS __attribute__((address_space(1)))
#define LAS __attribute__((address_space(3)))
typedef unsigned short bf16;
typedef short bf16x8 __attribute__((ext_vector_type(8)));
typedef float f32x4 __attribute__((ext_vector_type(4)));
typedef float f32x2 __attribute__((ext_vector_type(2)));
typedef unsigned u32x4 __attribute__((ext_vector_type(4)));
typedef unsigned u32x2 __attribute__((ext_vector_type(2)));
typedef long i64x2 __attribute__((ext_vector_type(2)));
typedef int i32x4 __attribute__((ext_vector_type(4)));
typedef int i32x8 __attribute__((ext_vector_type(8)));
typedef long i64x4 __attribute__((ext_vector_type(4)));

constexpr int T = 8192, D = 2048, NL = 2, INC = 11048, NPAD = 11264;
constexpr int NE = 32, FF = 512, NCH = T / 64;
constexpr float EPS = 1e-6f, NEGB = -1e30f;
constexpr int C_Q = 0, C_KC = 512, C_VC = 640, C_KS = 768, C_VS = 896, C_KW = 1024, C_VW = 1152;
constexpr int C_HQ = 1280, C_HF = 1792, C_HI = 2304, C_HG = 2816, C_GQ = 3328, C_GK = 3584, C_GV = 3840, C_GR = 4352;
constexpr int C_MG = 4864, C_NG = 11008, C_GA = 11032;

constexpr size_t MiB = 1u << 20;
constexpr size_t WS_CTL = 0, CTL_ZERO_BYTES = 1 * MiB;
constexpr size_t WS_WIN = 2 * MiB;
constexpr size_t WS_WBR = 90 * MiB;
constexpr size_t WS_WOUT = 102 * MiB;
constexpr size_t WS_WGU = 118 * MiB;
constexpr size_t WS_WDN = 374 * MiB;
constexpr size_t WS_H = 502 * MiB;
constexpr size_t WS_P = 534 * MiB;
constexpr size_t WS_OCAT = 710 * MiB;
constexpr size_t WS_PROJ = 734 * MiB;
constexpr size_t WS_MERGED = 830 * MiB;
constexpr size_t WS_X1 = 862 * MiB;
constexpr size_t WS_XRES = 926 * MiB;
constexpr size_t WS_CONTRIB = 990 * MiB;
constexpr size_t WS_ACT = 1054 * MiB;
constexpr size_t WS_QN = 1078 * MiB;
constexpr size_t WS_KV = 1094 * MiB;
constexpr size_t WS_KC = 1118 * MiB;
constexpr size_t WS_ORAW = 1119 * MiB;
constexpr size_t WS_ROUTE = 1151 * MiB;
constexpr size_t WS_SLOC_HG = 1153 * MiB;
constexpr size_t WS_SLOC_GL = 1185 * MiB;
constexpr size_t WS_SPREV_HG = 1201 * MiB;
constexpr size_t WS_SPREV_GL = 1217 * MiB;
constexpr size_t WS_DEC = 1225 * MiB;
constexpr size_t WS_QS = 1226 * MiB;
constexpr size_t WS_KS2 = 1234 * MiB;
constexpr size_t WS_KW2 = 1236 * MiB;
constexpr size_t WS_VST = 1238 * MiB;
constexpr size_t WS_VWT = 1240 * MiB;
constexpr size_t WS_KCB = 1242 * MiB;
constexpr size_t WS_WRT = 1243 * MiB;
constexpr size_t WS_HIST = 1244 * MiB;
constexpr size_t WS_CW = 1245 * MiB;
constexpr size_t WS_H8 = 1248 * MiB;
constexpr size_t WS_RSTD = 1247 * MiB;
constexpr size_t WS_WIN8 = 1264 * MiB;
constexpr size_t WS_END = 1288 * MiB;
constexpr size_t KV_STRIDE = (size_t)2 * T * 64;
constexpr int CW_BAR = 4096;
constexpr int CW_CNT = 3072;

constexpr int RING_BYTES = 131072;
constexpr int LDS_BYTES = 147456;
constexpr int MISC_OFF = LDS_BYTES - 2048;

#define LDS_WAIT() asm volatile("s_waitcnt lgkmcnt(0)" ::: "memory")
#define VM_WAIT() asm volatile("s_waitcnt vmcnt(0)" ::: "memory")
#define WSYNC() asm volatile("s_waitcnt lgkmcnt(0)" ::: "memory")

__device__ __forceinline__ unsigned f2bf(float f) { unsigned u = __builtin_bit_cast(unsigned, f); return (u + 0x7fffu + ((u >> 16) & 1u)) >> 16; }
__device__ __forceinline__ unsigned pk2(float lo, float hi) { return f2bf(lo) | (f2bf(hi) << 16); }
__device__ __forceinline__ float bf2f(unsigned b) { return __builtin_bit_cast(float, (b & 0xffffu) << 16); }
__device__ __forceinline__ float bflo(unsigned w) { return __builtin_bit_cast(float, w << 16); }
__device__ __forceinline__ float bfhi(unsigned w) { return __builtin_bit_cast(float, w & 0xffff0000u); }
__device__ __forceinline__ int ltid();
__device__ __forceinline__ float lshx(float v, int o) { const int l = ltid() & 63; return __builtin_bit_cast(float, __builtin_amdgcn_ds_bpermute((l ^ o) << 2, __builtin_bit_cast(int, v))); }
__device__ __forceinline__ float wave_sum(float v) {
#pragma unroll
    for (int o = 1; o < 64; o <<= 1) v += lshx(v, o);
    return v;
}
__device__ __forceinline__ float wave_max(float v) {
#pragma unroll
    for (int o = 1; o < 64; o <<= 1) v = fmaxf(v, lshx(v, o));
    return v;
}
__device__ __forceinline__ int ltid() { int t = threadIdx.x; asm volatile("" : "+v"(t)); return t; }
__device__ __forceinline__ int lbid() { int b = blockIdx.x; asm volatile("" : "+s"(b)); return b; }
constexpr float S_A1 = 16.f, S_W1 = 1024.f, S_ACT = 8.f, S_W2 = 512.f, S_H = 16.f, S_WG = 1024.f;
__device__ __forceinline__ float clamp8(float v) { return fminf(fmaxf(v, -224.f), 224.f); }
__device__ __forceinline__ unsigned pk4_fp8(float a, float b, float c, float d) { int w = __builtin_amdgcn_cvt_pk_fp8_f32(clamp8(a), clamp8(b), 0, false); w = __builtin_amdgcn_cvt_pk_fp8_f32(clamp8(c), clamp8(d), w, true); return (unsigned)w; }
typedef __bf16 bf16x2_t __attribute__((ext_vector_type(2)));
__device__ __forceinline__ unsigned pkbf(float lo, float hi) { const f32x2 v = {lo, hi}; return __builtin_bit_cast(unsigned, __builtin_convertvector(v, bf16x2_t)); }
constexpr float LOG2E = 1.4426950408889634f;
__device__ __forceinline__ float sigmoidf_(float x) { return 1.0f / (1.0f + expf(-x)); }
__device__ __forceinline__ float fsig(float x) { return __builtin_amdgcn_rcpf(1.0f + __builtin_amdgcn_exp2f(-LOG2E * x)); }

#define GSTAMP(lds_, slot) do { if (MK_PROBE_MASK != 0 && lbid() == MK_PROBE_BID && ltid() == 0) { volatile LAS unsigned long long* _ta = (volatile LAS unsigned long long*)((lds_) + MISC_OFF + 512); const unsigned long long _n = wall_clock64(); _ta[slot] += _n - _ta[16]; _ta[16] = _n; } } while (0)
#define XB_TMO      128
#define XB_XCNT(j)  (256  + 64 * (j))
#define XB_XSUB(j)  (1280 + 64 * (j))
#define XB_XGEN(j)  (2304 + 64 * (j))
#define XB_TOP      3328
#define XB_TOPGEN   3392
#define XCD_BAR_WORDS 3456
#define XB_SPIN_CAP (1u << 25)

__device__ __forceinline__ unsigned xb_ld(unsigned* p)              { return __hip_atomic_load(p, __ATOMIC_RELAXED, __HIP_MEMORY_SCOPE_AGENT); }
__device__ __forceinline__ unsigned xb_add(unsigned* p, unsigned v) { return __hip_atomic_fetch_add(p, v, __ATOMIC_RELAXED, __HIP_MEMORY_SCOPE_AGENT); }
__device__ __forceinline__ unsigned xb_xcc_id() { return (unsigned)__builtin_amdgcn_s_getreg((3 << 11) | 20) & 0xFu; }
#define XB_SPIN(cond, bar) do { unsigned _sp = 0; while (cond) { __builtin_amdgcn_s_sleep(1); \
    if ((++_sp & 255u) == 0u) { if (xb_ld(&(bar)[XB_TMO])) break; if (_sp > XB_SPIN_CAP) { atomicAdd(&(bar)[XB_TMO], 1u); break; } } } } while (0)

struct XcdBarrier { unsigned* bar; unsigned x; volatile LAS unsigned* st; };

__device__ __forceinline__ XcdBarrier xcd_barrier_post(unsigned* bar, volatile LAS unsigned* st) {
    XcdBarrier b; b.bar = bar; b.x = xb_xcc_id(); b.st = st;
    if (threadIdx.x == 0) (void)xb_add(&bar[XB_XCNT(b.x)], 1u);
    return b;
}
__device__ __forceinline__ void xcd_barrier_complete(unsigned* bar, unsigned x, unsigned& nloc, unsigned& nx) {
    const unsigned G = gridDim.x * gridDim.y * gridDim.z;
    unsigned sum, cnt, mine, sp = 0u;
    for (;;) {
        sum = 0u; cnt = 0u; mine = 0u;
#pragma unroll
        for (unsigned j = 0; j < 16; ++j) { const unsigned c = xb_ld(&bar[XB_XCNT(j)]); sum += c; cnt += (c > 0u) ? 1u : 0u; mine = (j == x) ? c : mine; }
        if (sum == G) break;
        __builtin_amdgcn_s_sleep(1);
        if ((++sp & 255u) == 0u) { if (xb_ld(&bar[XB_TMO])) break; if (sp > XB_SPIN_CAP) { atomicAdd(&bar[XB_TMO], 1u); break; } }
    }
    nloc = mine > 0u ? mine : 1u; nx = cnt > 0u ? cnt : 1u;
}
__device__ __forceinline__ void xcd_barrier(const XcdBarrier& b) {
    asm volatile("s_waitcnt vmcnt(0)" ::: "memory");
    __syncthreads();
    if (threadIdx.x == 0) {
        unsigned* bar = b.bar;
        __builtin_amdgcn_s_waitcnt(0);
        unsigned nloc = b.st[0], nx = b.st[1];
        if (nloc == 0u) { xcd_barrier_complete(bar, b.x, nloc, nx); b.st[0] = nloc; b.st[1] = nx; }
        const unsigned old = xb_add(&bar[XB_XSUB(b.x)], 1u);
        const unsigned gen = old / nloc;
        if (old + 1u == (gen + 1u) * nloc) {
            __builtin_amdgcn_fence(__ATOMIC_RELEASE, "agent");
            asm volatile("s_waitcnt vmcnt(0)" ::: "memory");
            const unsigned og = xb_add(&bar[XB_TOP], 1u);
            const unsigned tg = og / nx;
            if (og + 1u == (tg + 1u) * nx) xb_add(&bar[XB_TOPGEN], 1u);
            else XB_SPIN(xb_ld(&bar[XB_TOPGEN]) == tg, bar);
            __builtin_amdgcn_fence(__ATOMIC_ACQUIRE, "agent");
            xb_add(&bar[XB_XGEN(b.x)], 1u);
            asm volatile("s_waitcnt vmcnt(0)" ::: "memory");
        } else {
            XB_SPIN(xb_ld(&bar[XB_XGEN(b.x)]) == gen, bar);
            __builtin_amdgcn_fence(__ATOMIC_ACQUIRE, "agent");
            asm volatile("s_waitcnt vmcnt(0)" ::: "memory");
        }
    }
    __syncthreads();
}

namespace pg8 {
constexpr int BM = 256, BK = 64, HALF = 128, HTB = HALF * BK * 2, STAGE_BYTES = 8 * HTB, NXCD = 8, WGM = 8;
__host__ __device__ __forceinline__ int lds_byte(int r, int c) { const int st = (r >> 4) * 2 + (c >> 5), rr = r & 15, cc = c & 31, ob = rr * 64 + cc * 2; return st * 1024 + (ob ^ (((ob >> 9) & 1) << 5)); }
__host__ __device__ __forceinline__ void stage_rc(int b, int& R, int& C) { const int st = b / 1024, sb = b % 1024, swz = sb ^ (((sb >> 9) & 1) << 5); R = (st >> 1) * 16 + swz / 64; C = (st & 1) * 32 + (swz % 64) / 2; }
__host__ __device__ __forceinline__ int perm32(int rho) { const int n = rho >> 4, i = rho & 15; return 8 * (i >> 2) + 4 * n + (i & 3); }

struct Unit { int pm, pn, e, nvalid, slot0, half, row0; const char *A0, *A1, *B0, *B1; unsigned va[2][2]; };

__device__ __forceinline__ unsigned cvt_pk_bf16(float lo, float hi) { unsigned r; asm volatile("v_cvt_pk_bf16_f32 %0, %1, %2" : "=v"(r) : "v"(lo), "v"(hi)); return r; }

template <class Epi, class Sched, bool ALIGN_EPI>
__device__ __forceinline__ void gemm_phase(LAS unsigned char* lds, const int K, const Sched& S, const Epi& E) {
    const int tid = ltid(), wid = __builtin_amdgcn_readfirstlane(tid >> 6), lane = tid & 63, wr = wid >> 2, wc = wid & 3, fr = lane & 15, fq = lane >> 4;
    int nt = Sched::FP8 ? K / 128 : K / BK; if constexpr (Sched::SC8) asm volatile("" : "+s"(nt));
    unsigned voffB[2];
#pragma unroll
    for (int i = 0; i < 2; ++i) { int R, C; stage_rc(tid * 16 + i * 8192, R, C); const int Rb = Epi::PERM ? ((R & ~31) + perm32(R & 31)) : R; voffB[i] = Sched::FP8 ? (unsigned)(Rb * K + C * 2) : (unsigned)(Rb * K + C) * 2u; }
    const size_t kstep = (size_t)(BK * 2);
    const unsigned ldsw = (unsigned)wid * 1024u;
    const int aoff = lds_byte(wr * 64 + fr, fq * 8), boff = lds_byte(wc * 32 + fr, fq * 8);
#define PG8_SA(b, h) (((b) * 2 + (h)) * HTB)
#define PG8_SB(b, h) ((4 + (b) * 2 + (h)) * HTB)
#define PG8_STAGE(bufoff, gbase, voff) do { _Pragma("unroll") for (int _i = 0; _i < 2; ++_i) { \
        if constexpr (Sched::SC8) __builtin_amdgcn_raw_ptr_buffer_load_lds(rsrc, (LAS unsigned*)(lds + (bufoff) + ldsw + _i * 8192), 16, (int)(voff)[0], (int)((const char*)(gbase) - wsb) + _i * 64 * K, 0, 0); \
        else __builtin_amdgcn_global_load_lds((const unsigned*)((const char*)(gbase) + (voff)[_i]), (LAS unsigned*)(lds + (bufoff) + ldsw + _i * 8192), 16, 0, 0); } } while (0)
#define PG8_STAGE_A(bufoff, gbase, voff) do { if constexpr (Sched::SC8 && Sched::GATHER) { _Pragma("unroll") for (int _i = 0; _i < 2; ++_i) \
        __builtin_amdgcn_raw_ptr_buffer_load_lds(rsrc, (LAS unsigned*)(lds + (bufoff) + ldsw + _i * 8192), 16, (int)((((voff)[0] >> (16 * _i)) & 0xffffu) * (unsigned)K + ck2), (int)((const char*)(gbase) - wsb), 0, 0); } else PG8_STAGE(bufoff, gbase, voff); } while (0)
    int sc1 = 0x7f7f7f7f; asm volatile("" : "+v"(sc1));
    unsigned ck2 = 0; if constexpr (Sched::SC8 && Sched::GATHER) { int R0, C0; stage_rc(tid * 16, R0, C0); ck2 = (unsigned)C0 * 2u; }
    const char* wsb = S.wsb;
    __amdgpu_buffer_rsrc_t rsrc = __builtin_amdgcn_make_buffer_rsrc((void*)wsb, 0, 0x7fffffff, 0x00020000);
#define PG8_LD16(off_) __builtin_bit_cast(i32x4, *(const LAS bf16x8*)(lds + (off_)))
#define PG8_LD16B(off_) __builtin_bit_cast(i32x4, *(const LAS bf16x8*)(ldsB + (off_)))
    LAS unsigned char* ldsB = lds + 4 * HTB + boff; asm volatile("" : "+v"(ldsB));
#define PG8_LDA(dst, b, h) do { if constexpr (Sched::SC8) { _Pragma("unroll") for (int m = 0; m < 4; ++m) dst##8[m] = __builtin_shufflevector(PG8_LD16(PG8_SA(b, h) + aoff + m * 2048), PG8_LD16(PG8_SA(b, h) + aoff + m * 2048 + 1024), 0, 1, 2, 3, 4, 5, 6, 7); } \
        else { _Pragma("unroll") for (int m = 0; m < 4; ++m) _Pragma("unroll") for (int k = 0; k < 2; ++k) dst[m][k] = *(const LAS bf16x8*)(lds + PG8_SA(b, h) + aoff + m * 2048 + k * 1024); } } while (0)
#define PG8_LDB(dst, b, h) do { if constexpr (Sched::SC8) { _Pragma("unroll") for (int n = 0; n < 2; ++n) dst##8[n] = __builtin_shufflevector(PG8_LD16B(((b) * 2 + (h)) * HTB + n * 2048), PG8_LD16B(((b) * 2 + (h)) * HTB + n * 2048 + 1024), 0, 1, 2, 3, 4, 5, 6, 7); } \
        else { _Pragma("unroll") for (int n = 0; n < 2; ++n) _Pragma("unroll") for (int k = 0; k < 2; ++k) dst[n][k] = *(const LAS bf16x8*)(lds + PG8_SB(b, h) + boff + n * 2048 + k * 1024); } } while (0)
#define PG8_MMA(ai, bj, At, Bt) do { __builtin_amdgcn_s_setprio(1); \
        if constexpr (Sched::SC8) {   \
            _Pragma("unroll") for (int m = 0; m < 4; ++m) _Pragma("unroll") for (int n = 0; n < 2; ++n) \
                asm volatile("v_mfma_scale_f32_16x16x128_f8f6f4 %0, %1, %2, %0, %3, %3 op_sel_hi:[0,0,0]" : "+v"(acc[ai][bj][m][n]) : "v"(Bt##8[n]), "v"(At##8[m]), "v"(sc1)); } \
        else if constexpr (Sched::FP8) { _Pragma("unroll") for (int m = 0; m < 4; ++m) _Pragma("unroll") for (int n = 0; n < 2; ++n) _Pragma("unroll") for (int k = 0; k < 2; ++k) { \
                const i64x2 b8_ = __builtin_bit_cast(i64x2, Bt[n][k]), a8_ = __builtin_bit_cast(i64x2, At[m][k]); \
                acc[ai][bj][m][n] = __builtin_amdgcn_mfma_f32_16x16x32_fp8_fp8(b8_[0], a8_[0], acc[ai][bj][m][n], 0, 0, 0); acc[ai][bj][m][n] = __builtin_amdgcn_mfma_f32_16x16x32_fp8_fp8(b8_[1], a8_[1], acc[ai][bj][m][n], 0, 0, 0); } } \
        else { _Pragma("unroll") for (int m = 0; m < 4; ++m) _Pragma("unroll") for (int n = 0; n < 2; ++n) _Pragma("unroll") for (int k = 0; k < 2; ++k) \
            acc[ai][bj][m][n] = __builtin_amdgcn_mfma_f32_16x16x32_bf16(Bt[n][k], At[m][k], acc[ai][bj][m][n], 0, 0, 0); } __builtin_amdgcn_s_setprio(0); } while (0)
#define PG8_WAIT_V(n) asm volatile("s_waitcnt vmcnt(" #n ")" ::: "memory")
#define PG8_WAIT_L(n) asm volatile("s_waitcnt lgkmcnt(" #n ")" ::: "memory")
#define PG8_BAR __builtin_amdgcn_s_barrier()
#define PG8_SCHED __builtin_amdgcn_sched_barrier(0)
#define VA(u, h) (Sched::GATHER ? (u).va[h] : S.va)
    Unit cur, nxt; int ui = 0;
    if constexpr (Sched::DYN) { S.ticket_issue(); S.ticket_publish(); __syncthreads(); }
    if (!S.next(0, cur)) return;
    if constexpr (Sched::DYN) { __syncthreads(); S.ticket_issue(); S.ticket_publish(); __syncthreads(); }
    S.a_ready(cur);
    if (S.probe) GSTAMP(lds, 27);
    f32x4 acc[2][2][4][2];
#define PG8_ZERO4(zz) f32x4 zz; asm volatile("v_mov_b32 %0, 0" : "=v"(zz[0])); asm volatile("v_mov_b32 %0, 0" : "=v"(zz[1])); asm volatile("v_mov_b32 %0, 0" : "=v"(zz[2])); asm volatile("v_mov_b32 %0, 0" : "=v"(zz[3]))
    if constexpr (!Sched::SC8) { PG8_ZERO4(zi);
#pragma unroll
    for (int a = 0; a < 2; ++a)
#pragma unroll
        for (int b = 0; b < 2; ++b)
#pragma unroll
            for (int m = 0; m < 4; ++m)
#pragma unroll
                for (int n = 0; n < 2; ++n) acc[a][b][m][n] = zi;
    }
    bf16x8 At[4][2], B0[2][2], B1[2][2];
    i32x8 At8[4], B08[2], B18[2];
    PG8_STAGE(PG8_SB(0, 0), cur.B0, voffB); PG8_STAGE(PG8_SB(0, 1), cur.B1, voffB); PG8_STAGE_A(PG8_SA(0, 0), cur.A0, VA(cur, 0)); PG8_STAGE_A(PG8_SA(0, 1), cur.A1, VA(cur, 1));
    if (wr == 1) PG8_BAR;
    PG8_WAIT_V(2); PG8_BAR;
    PG8_STAGE(PG8_SB(1, 0), cur.B0 + kstep, voffB); PG8_STAGE_A(PG8_SA(1, 0), cur.A0 + kstep, VA(cur, 0)); PG8_STAGE(PG8_SB(1, 1), cur.B1 + kstep, voffB);
    PG8_WAIT_V(6); PG8_BAR;
    for (;;) {
        bool has_next = false;
        if constexpr (Sched::SC8) {
            PG8_ZERO4(zz);
#pragma unroll
            for (int a = 0; a < 2; ++a)
#pragma unroll
                for (int b = 0; b < 2; ++b)
#pragma unroll
                    for (int m = 0; m < 4; ++m)
#pragma unroll
                        for (int n = 0; n < 2; ++n) acc[a][b][m][n] = zz;
            asm volatile("s_nop 7" ::: "memory");
        }
        if constexpr (Sched::DYN) { S.ticket_issue(); nxt = cur; }
        else { has_next = S.next(ui + 1, nxt); if (!has_next) nxt = cur; }
        for (int t = 0; t < nt; t += 2) {
            if constexpr (Sched::DYN) { if (t == nt - 4) { has_next = S.next(ui + 1, nxt); if (!has_next) nxt = cur; } if (t == nt - 2) S.ticket_publish(); }
            const bool last = (t == nt - 2);
            if (last && has_next) S.a_ready(nxt);
            const char* a1h1 = cur.A1 + (size_t)(t + 1) * kstep;
            const char* a2h0 = last ? nxt.A0 : cur.A0 + (size_t)(t + 2) * kstep; const char* a2h1 = last ? nxt.A1 : cur.A1 + (size_t)(t + 2) * kstep;
            const char* b2h0 = last ? nxt.B0 : cur.B0 + (size_t)(t + 2) * kstep; const char* b2h1 = last ? nxt.B1 : cur.B1 + (size_t)(t + 2) * kstep;
            unsigned v2h0[2], v2h1[2];
#pragma unroll
            for (int i = 0; i < 2; ++i) { if constexpr (Sched::GATHER) { v2h0[i] = last ? nxt.va[0][i] : cur.va[0][i]; v2h1[i] = last ? nxt.va[1][i] : cur.va[1][i]; } else { v2h0[i] = S.va[i]; v2h1[i] = S.va[i]; } }
            PG8_LDB(B0, 0, 0); if constexpr (!Sched::NB1) PG8_LDB(B1, 0, 1); PG8_SCHED; PG8_LDA(At, 0, 0); PG8_STAGE_A(PG8_SA(1, 1), a1h1, VA(cur, 1));
            PG8_WAIT_V(8); PG8_WAIT_L(0); PG8_BAR; PG8_MMA(0, 0, At, B0); if constexpr (!Sched::NB1) PG8_MMA(0, 1, At, B1); PG8_BAR; PG8_SCHED;
            if (Sched::SC8 || !(Sched::HALVES && cur.half)) PG8_LDA(At, 0, 1);
            PG8_STAGE(PG8_SB(0, 0), b2h0, voffB); PG8_STAGE(PG8_SB(0, 1), b2h1, voffB); PG8_STAGE_A(PG8_SA(0, 0), a2h0, v2h0);
            PG8_WAIT_V(8); PG8_WAIT_L(0); PG8_BAR; if (!(Sched::HALVES && cur.half)) { PG8_MMA(1, 0, At, B0); if constexpr (!Sched::NB1) PG8_MMA(1, 1, At, B1); } PG8_BAR; PG8_SCHED;
            PG8_LDB(B0, 1, 0); if constexpr (!Sched::NB1) PG8_LDB(B1, 1, 1); PG8_SCHED; PG8_LDA(At, 1, 0); PG8_STAGE_A(PG8_SA(0, 1), a2h1, v2h1);
            PG8_WAIT_V(8); PG8_WAIT_L(0); PG8_BAR; PG8_MMA(0, 0, At, B0); if constexpr (!Sched::NB1) PG8_MMA(0, 1, At, B1); PG8_BAR; PG8_SCHED;
            if (Sched::SC8 || !(Sched::HALVES && cur.half)) PG8_LDA(At, 1, 1);
            PG8_STAGE(PG8_SB(1, 0), b2h0 + kstep, voffB); PG8_STAGE(PG8_SB(1, 1), b2h1 + kstep, voffB); PG8_STAGE_A(PG8_SA(1, 0), a2h0 + kstep, v2h0);
            PG8_WAIT_V(8); PG8_WAIT_L(0); PG8_BAR; if (!(Sched::HALVES && cur.half)) { PG8_MMA(1, 0, At, B0); if constexpr (!Sched::NB1) PG8_MMA(1, 1, At, B1); } PG8_BAR; PG8_SCHED;
        }
        if (S.probe) GSTAMP(lds, 25);
        if constexpr (Sched::SC8) asm volatile("s_nop 15\n\ts_nop 15" ::: "memory");
        if constexpr (ALIGN_EPI) { if (wr == 0) PG8_BAR; }
        int frl = fr, fql = fq; if constexpr (Sched::SC8) { const int t2 = ltid(); frl = t2 & 15; fql = (t2 >> 4) & 3; }
        if constexpr (Sched::CHAIN) E.chain(acc, cur, wr, wc, frl, fql); else E(acc, cur, wr, wc, frl, fql);
        S.done(cur);
        if (S.probe) { asm volatile("s_waitcnt vmcnt(0)" ::: "memory"); GSTAMP(lds, 26); }
        if (!has_next) break;
        if constexpr (!Sched::SC8) { if (!Sched::CHAIN || nxt.e == 0) {
        PG8_ZERO4(ze);
#pragma unroll
        for (int a = 0; a < 2; ++a)
#pragma unroll
            for (int b = 0; b < 2; ++b)
#pragma unroll
                for (int m = 0; m < 4; ++m)
#pragma unroll
                    for (int n = 0; n < 2; ++n) acc[a][b][m][n] = ze;
        } }
        cur = nxt; ++ui;
        if constexpr (ALIGN_EPI) { if (wr == 1) PG8_BAR; }
    }
    PG8_WAIT_V(0);
    if constexpr (!ALIGN_EPI) { if (wr == 0) PG8_BAR; }
    PG8_BAR;
#undef VA
#undef PG8_SA
#undef PG8_SB
#undef PG8_STAGE
#undef PG8_STAGE_A
#undef PG8_LDA
#undef PG8_LDB
#undef PG8_LD16
#undef PG8_ZERO4
#undef PG8_MMA
#undef PG8_WAIT_V
#undef PG8_WAIT_L
#undef PG8_BAR
#undef PG8_SCHED
}

template <bool F8> struct PlainSchedT {
    static constexpr bool GATHER = false, CHAIN = false, DYN = false, FP8 = F8, NB1 = false, SC8 = F8, HALVES = !F8;
    static constexpr int BN = 256;
    static constexpr int EB = F8 ? 1 : 2;
    __device__ __forceinline__ void a_ready(const Unit&) const {}
    __device__ __forceinline__ void done(const Unit&) const {}
    int nM, nN, nwg, G, c, lda, K, nNh, probe = 0, pn_from = -1, pn_to = -1; const char* A; const char* Bt; const char* wsb = nullptr; unsigned va[2];
    __device__ __forceinline__ void init(const void* A_, int lda_, const void* Bt_, int M, int N, int K_, int G_, int c_, int nNh_ = 0) {
        nM = M / BM; nN = N / BN - nNh_; nNh = nNh_; nwg = nM * nN; G = G_; c = c_; lda = lda_; K = K_; A = (const char*)A_; Bt = (const char*)Bt_;
#pragma unroll
        for (int i = 0; i < 2; ++i) { int R, C; stage_rc((int)ltid() * 16 + i * 8192, R, C); va[i] = (unsigned)(R * lda * EB + C * 2); }
    }
    __device__ __forceinline__ bool next(int i, Unit& u) const {
        const long L = (long)i * G + c;
        u.e = 0; u.nvalid = 256; u.slot0 = 0; u.va[0][0] = 0u; u.va[0][1] = 0u; u.va[1][0] = 0u; u.va[1][1] = 0u;
        if (L >= nwg) { const int hL = (int)(L - nwg); if (hL >= 2 * nM * nNh) return false;
            const int hm = hL / nNh; int pn = nN + hL % nNh; if (pn == pn_from) pn = pn_to;
            u.pm = hm >> 1; u.pn = pn; u.half = 1; u.row0 = hm * HALF;
            u.A0 = A + (size_t)hm * HALF * lda * EB; u.A1 = u.A0;
            u.B0 = Bt + (size_t)pn * BN * K * EB; u.B1 = NB1 ? u.B0 : u.B0 + (size_t)HALF * K * EB;
            return true; }
        int wgid = (int)L; { const int q = nwg / NXCD, r = nwg % NXCD, xcd = wgid % NXCD, off = wgid / NXCD; wgid = (xcd < r ? xcd * (q + 1) : r * (q + 1) + (xcd - r) * q) + off; }
        const int nig = WGM * nN, gid = wgid / nig, fm = gid * WGM, gsz = (nM - fm) < WGM ? (nM - fm) : WGM;
        u.pm = fm + ((wgid % nig) % gsz); u.pn = (wgid % nig) / gsz; if (u.pn == pn_from) u.pn = pn_to; u.half = 0; u.row0 = u.pm * BM;
        u.A0 = A + (size_t)u.pm * BM * lda * EB; u.A1 = u.A0 + (size_t)HALF * lda * EB;
        u.B0 = Bt + (size_t)u.pn * BN * K * EB; u.B1 = NB1 ? u.B0 : u.B0 + (size_t)HALF * K * EB;
        return true;
    }
};
typedef PlainSchedT<false> PlainSched;
struct BranchSched {
    static constexpr bool GATHER = false, CHAIN = true, DYN = false, FP8 = false, NB1 = false, SC8 = false, HALVES = false;
    __device__ __forceinline__ void a_ready(const Unit&) const {}
    __device__ __forceinline__ void done(const Unit&) const {}
    int G, c, probe = 0; const char* A; const char* Bt; const char* wsb = nullptr; unsigned va[2];
    __device__ __forceinline__ void init(const bf16* OC, const bf16* WBRl, int G_, int c_) { G = G_; c = c_; A = (const char*)OC; Bt = (const char*)WBRl;
#pragma unroll
        for (int i = 0; i < 2; ++i) { int R, C; stage_rc((int)ltid() * 16 + i * 8192, R, C); va[i] = (unsigned)(R * 1536 + C) * 2u; } }
    __device__ __forceinline__ bool next(int i, Unit& u) const {
        const int tile = (i / 3) * G + c, n = i % 3; if (tile >= (T / BM) * (D / BM)) return false;
        int wgid = tile; { const int nwg = 256, q = nwg / NXCD, xcd = wgid % NXCD, off = wgid / NXCD; wgid = xcd * q + off; }
        const int nN = D / BM, nig = WGM * nN, gid = wgid / nig, fm = gid * WGM;
        u.pm = fm + ((wgid % nig) % WGM); u.pn = (wgid % nig) / WGM; u.e = n; u.nvalid = 256; u.slot0 = 0; u.half = 0; u.row0 = u.pm * BM;
        u.va[0][0] = 0u; u.va[0][1] = 0u; u.va[1][0] = 0u; u.va[1][1] = 0u;
        u.A0 = A + (size_t)u.pm * BM * 1536 * 2 + (size_t)n * 512 * 2; u.A1 = u.A0 + (size_t)HALF * 1536 * 2;
        u.B0 = Bt + (size_t)n * D * 512 * 2 + (size_t)u.pn * BM * 512 * 2; u.B1 = u.B0 + (size_t)HALF * 512 * 2;
        return true;
    }
};
template <int MODE> struct MoeSched {
    static constexpr int NPN = MODE == 1 ? 4 : 8;
    static constexpr bool GATHER = MODE == 1, CHAIN = false, DYN = MODE == 2, FP8 = true, NB1 = false, SC8 = (MOESC & MODE) != 0, HALVES = true;
    unsigned* tilecnt; unsigned* tick; volatile LAS int* tslot; mutable int myticket; const char* wsb = nullptr;
    __device__ __forceinline__ void ticket_issue() const { if (ltid() == 0) myticket = (int)__hip_atomic_fetch_add(tick, 1u, __ATOMIC_RELAXED, __HIP_MEMORY_SCOPE_AGENT); }
    __device__ __forceinline__ void ticket_publish() const { if (ltid() == 0) *tslot = myticket; }
    __device__ __forceinline__ void a_ready(const Unit& u) const {
        if (MODE == 2) {
            if (ltid() < 64) { unsigned* p = tilecnt + 64 * (u.slot0 >> 8); unsigned sp = 0;
                while ((unsigned)__builtin_amdgcn_readfirstlane(__hip_atomic_load(p, __ATOMIC_RELAXED, __HIP_MEMORY_SCOPE_AGENT)) < 32u) { __builtin_amdgcn_s_sleep(2); if (++sp > (1u << 22)) break; }
                __builtin_amdgcn_fence(__ATOMIC_ACQUIRE, "agent"); asm volatile("s_waitcnt vmcnt(0)" ::: "memory"); }
            asm volatile("" ::: "memory"); __builtin_amdgcn_s_barrier(); asm volatile("" ::: "memory"); }
    }
    __device__ __forceinline__ void done(const Unit& u) const {
        if (MODE == 1) { asm volatile("s_waitcnt vmcnt(0)" ::: "memory");
            if ((ltid() & 63) == 0) __hip_atomic_fetch_add(tilecnt + 64 * (u.slot0 >> 8), 1u, __ATOMIC_RELAXED, __HIP_MEMORY_SCOPE_AGENT); }
    }
    int G, c, probe = 0; const LAS int* tb; const int* cnt; const int* list; const char* A; const char* W; unsigned va[2];
    __device__ __forceinline__ void init(int G_, int c_, const LAS int* tb_, const int* cnt_, const int* list_, const void* A_, const void* W_) {
        G = G_; c = c_; tb = tb_; cnt = cnt_; list = list_; A = (const char*)A_; W = (const char*)W_;
#pragma unroll
        for (int i = 0; i < 2; ++i) { int R, C; stage_rc((int)ltid() * 16 + i * 8192, R, C); va[i] = (unsigned)(R * FF + C * 2); }
    }
    __device__ __forceinline__ bool next(int i, Unit& u) const {
        const int L = MODE == 2 ? __builtin_amdgcn_readfirstlane(*tslot) : i * G + c, nfull = __builtin_amdgcn_readfirstlane(tb[33 + NE]), nhalf = __builtin_amdgcn_readfirstlane(tb[66 + NE]);
        if (L >= (nfull + nhalf) * NPN) return false;
        const bool half = L >= nfull * NPN; const int Lr = half ? L - nfull * NPN : L, base = half ? 66 : 33;
        const int tq = Lr / NPN, pn = Lr % NPN; int e = 0;
        while (e < NE - 1 && __builtin_amdgcn_readfirstlane(tb[base + e + 1]) <= tq) ++e;
        const int ne = __builtin_amdgcn_readfirstlane(cnt[e]);
        const int pm = half ? (ne - 1) / 256 : tq - __builtin_amdgcn_readfirstlane(tb[33 + e]);
        const int tl = __builtin_amdgcn_readfirstlane(tb[e]) + pm;
        u.pm = pm; u.pn = pn; u.e = e; u.nvalid = ne - pm * 256; u.slot0 = tl * 256; u.half = half ? 1 : 0; u.row0 = 0;
        if (MODE == 1) {
            u.A0 = A; u.A1 = A;
#pragma unroll
            for (int h = 0; h < 2; ++h)
#pragma unroll
                for (int k = 0; k < 2; ++k) { int Rk, Ck; stage_rc((int)ltid() * 16 + k * 8192, Rk, Ck); int idx = pm * 256 + h * 128 + Rk; idx = idx < ne ? idx : ne - 1; const int entry = list[e * 8192 + idx];
                    if (SC8) { if (k == 0) u.va[h][0] = (unsigned)(entry >> 1); else { u.va[h][0] |= (unsigned)(entry >> 1) << 16; u.va[h][1] = 0u; } }
                    else u.va[h][k] = (unsigned)(entry >> 1) * (unsigned)D + (unsigned)Ck * 2u; }
            const char* we = W + (size_t)e * 1024 * D;
            u.B0 = we + (size_t)(pn * 128) * D; u.B1 = we + (size_t)(512 + pn * 128) * D;
        } else {
            u.va[0][0] = 0u; u.va[0][1] = 0u; u.va[1][0] = 0u; u.va[1][1] = 0u;
            u.A0 = A + (size_t)tl * 256 * FF; u.A1 = u.A0 + (size_t)HALF * FF;
            const char* we = W + (size_t)e * D * FF;
            u.B0 = we + (size_t)(pn * 256) * FF; u.B1 = u.B0 + (size_t)HALF * FF;
        }
        return true;
    }
};

struct EpiBf16 {
    static constexpr bool PERM = true;
    bf16* O; int ldc; float scale;
    __device__ __forceinline__ void operator()(const f32x4 (&acc)[2][2][4][2], const Unit& u, int wr, int wc, int fr, int fq) const {
        const int row0 = u.row0 + wr * 64 + fr, col0 = u.pn * BM + wc * 32 + 8 * fq;
#pragma unroll
        for (int ai = 0; ai < 2; ++ai) if (ai == 0 || !u.half)
#pragma unroll
            for (int m = 0; m < 4; ++m) { bf16* rowp = O + (size_t)(row0 + ai * HALF + m * 16) * ldc + col0;
#pragma unroll
                for (int bj = 0; bj < 2; ++bj) { const f32x4 v0 = acc[ai][bj][m][0] * scale, v1 = acc[ai][bj][m][1] * scale;
                    u32x4 w; w.x = cvt_pk_bf16(v0[0], v0[1]); w.y = cvt_pk_bf16(v0[2], v0[3]); w.z = cvt_pk_bf16(v1[0], v1[1]); w.w = cvt_pk_bf16(v1[2], v1[3]);
                    *(u32x4*)(rowp + bj * HALF) = w; } }
    }
};
struct EpiBf16N1 {
    static constexpr bool PERM = true;
    bf16* O; int ldc; float scale;
    __device__ __forceinline__ void operator()(const f32x4 (&acc)[2][2][4][2], const Unit& u, int wr, int wc, int fr, int fq) const {
        const int row0 = u.row0 + wr * 64 + fr, col0 = u.pn * 128 + wc * 32 + 8 * fq;
#pragma unroll
        for (int ai = 0; ai < 2; ++ai) if (ai == 0 || !u.half)
#pragma unroll
            for (int m = 0; m < 4; ++m) { const f32x4 v0 = acc[ai][0][m][0] * scale, v1 = acc[ai][0][m][1] * scale;
                u32x4 w; w.x = cvt_pk_bf16(v0[0], v0[1]); w.y = cvt_pk_bf16(v0[2], v0[3]); w.z = cvt_pk_bf16(v1[0], v1[1]); w.w = cvt_pk_bf16(v1[2], v1[3]);
                *(u32x4*)(O + (size_t)(row0 + ai * HALF + m * 16) * ldc + col0) = w; }
    }
};
struct EpiMerge {
    static constexpr bool PERM = true;
    bf16* MG; const bf16* gate0;
    __device__ __forceinline__ void operator()(const f32x4 (&acc)[2][2][4][2], const Unit& u, int wr, int wc, int fr, int fq) const {}
    __device__ __forceinline__ void chain(f32x4 (&acc)[2][2][4][2], const Unit& u, int wr, int wc, int fr, int fq) const {
        const int row0 = u.row0 + wr * 64 + fr, col0 = u.pn * BM + wc * 32 + 8 * fq; const bool last = u.e == 2;
        const bf16* __restrict__ ga = gate0 + (size_t)u.e * D; const bf16* __restrict__ gb = gate0 + (size_t)(last ? 2 : u.e + 1) * D;
        bf16* __restrict__ MGp = MG;
        u32x4 qa[2][2], qb[2][2];
#define EMG_LOAD(buf, g) do { const size_t row_ = (size_t)(row0 + ((g) >> 2) * HALF + ((g) & 3) * 16); \
            _Pragma("unroll") for (int bj_ = 0; bj_ < 2; ++bj_) { qa[buf][bj_] = *(const u32x4*)(ga + row_ * NPAD + col0 + bj_ * HALF); qb[buf][bj_] = *(const u32x4*)(gb + row_ * NPAD + col0 + bj_ * HALF); } } while (0)
        EMG_LOAD(0, 0);
#pragma unroll
        for (int g = 0; g < 8; ++g) { if (g + 1 < 8) EMG_LOAD((g + 1) & 1, g + 1);
            const int ai = g >> 2, m = g & 3; const size_t row = (size_t)(row0 + ai * HALF + m * 16);
#pragma unroll
            for (int bj = 0; bj < 2; ++bj) { float o[8];
                const unsigned wa[4] = {qa[g & 1][bj].x, qa[g & 1][bj].y, qa[g & 1][bj].z, qa[g & 1][bj].w}, wb[4] = {qb[g & 1][bj].x, qb[g & 1][bj].y, qb[g & 1][bj].z, qb[g & 1][bj].w};
#pragma unroll
                for (int k = 0; k < 8; ++k) { const float a = acc[ai][bj][m][k >> 2][k & 3];
                    const float xa = __builtin_bit_cast(float, (k & 1) ? (wa[k >> 1] & 0xffff0000u) : (wa[k >> 1] << 16)), xb = __builtin_bit_cast(float, (k & 1) ? (wb[k >> 1] & 0xffff0000u) : (wb[k >> 1] << 16));
                    const float ea = __builtin_amdgcn_exp2f(-LOG2E * xa), eb = __builtin_amdgcn_exp2f(-LOG2E * xb);
                    const float f = (last ? 1.0f : 1.0f + eb) * __builtin_amdgcn_rcpf(1.0f + ea);
                    o[k] = a * f; acc[ai][bj][m][k >> 2][k & 3] = o[k]; }
                if (last) { u32x4 w; w.x = cvt_pk_bf16(o[0], o[1]); w.y = cvt_pk_bf16(o[2], o[3]); w.z = cvt_pk_bf16(o[4], o[5]); w.w = cvt_pk_bf16(o[6], o[7]);
                    *(u32x4*)(MGp + row * D + col0 + bj * HALF) = w; } } }
#undef EMG_LOAD
    }
};
struct EpiResF32 {
    static constexpr bool PERM = false;
    const float* R; float* O; int ldc;
    __device__ __forceinline__ void operator()(const f32x4 (&acc)[2][2][4][2], const Unit& u, int wr, int wc, int fr, int fq) const {
        const int row0 = u.row0 + wr * 64 + fr, col0 = u.pn * BM + wc * 32 + 4 * fq;
        const float* __restrict__ Rp = R; float* __restrict__ Op = O;
        f32x4 rv[2][4];
#define ERES_LOAD(buf, g) do { const size_t off_ = (size_t)(row0 + ((g) >> 2) * HALF + ((g) & 3) * 16) * ldc + col0; \
            _Pragma("unroll") for (int q_ = 0; q_ < 4; ++q_) rv[buf][q_] = *(const f32x4*)(Rp + off_ + (q_ >> 1) * HALF + (q_ & 1) * 16); } while (0)
        ERES_LOAD(0, 0);
#pragma unroll
        for (int g = 0; g < 8; ++g) { if (g + 1 < 8) ERES_LOAD((g + 1) & 1, g + 1);
            const int ai = g >> 2, m = g & 3; const size_t off = (size_t)(row0 + ai * HALF + m * 16) * ldc + col0;
            if (ai == 0 || !u.half) {
#pragma unroll
                for (int q = 0; q < 4; ++q) *(f32x4*)(Op + off + (q >> 1) * HALF + (q & 1) * 16) = acc[ai][q >> 1][m][q & 1] + rv[g & 1][q]; } }
#undef ERES_LOAD
    }
};
struct EpiMoe1 {
    static constexpr bool PERM = true;
    unsigned char* ACT; const int* list; const float* ew; const float* rstd;
    __device__ __forceinline__ void operator()(const f32x4 (&acc)[2][2][4][2], const Unit& u, int wr, int wc, int fr, int fq) const {
        const int col0 = u.pn * 128 + wc * 32 + 8 * fq;
#pragma unroll
        for (int ai = 0; ai < 2; ++ai) if (ai == 0 || !u.half)
#pragma unroll
            for (int m = 0; m < 4; ++m) { const int r = ai * HALF + wr * 64 + m * 16 + fr; float w = 0.f, rsd = 0.f;
                if (r < u.nvalid) { const int entry = list[u.e * 8192 + u.pm * 256 + r]; w = ew[entry] * S_ACT; rsd = rstd[entry >> 1] * (1.0f / (S_A1 * S_W1)); }
                float o[8];
#pragma unroll
                for (int n = 0; n < 2; ++n)
#pragma unroll
                    for (int j = 0; j < 4; ++j) { const float g = acc[ai][0][m][n][j] * rsd, up = acc[ai][1][m][n][j] * rsd; o[n * 4 + j] = g * fsig(g) * up * w; }
                const unsigned lo = pk4_fp8(o[0], o[1], o[2], o[3]), hi = pk4_fp8(o[4], o[5], o[6], o[7]);
                __hip_atomic_store((unsigned long long*)(ACT + (size_t)(u.slot0 + r) * FF + col0), (unsigned long long)lo | ((unsigned long long)hi << 32), __ATOMIC_RELAXED, __HIP_MEMORY_SCOPE_AGENT); }
    }
};
struct EpiMoe2 {
    static constexpr bool PERM = true;
    bf16* CO; const int* list;
    __device__ __forceinline__ void operator()(const f32x4 (&acc)[2][2][4][2], const Unit& u, int wr, int wc, int fr, int fq) const {
        const int col0 = u.pn * BM + wc * 32 + 8 * fq;
#pragma unroll
        for (int ai = 0; ai < 2; ++ai) if (ai == 0 || !u.half)
#pragma unroll
            for (int m = 0; m < 4; ++m) { const int r = ai * HALF + wr * 64 + m * 16 + fr;
                if (r < u.nvalid) { const int entry = list[u.e * 8192 + u.pm * 256 + r]; bf16* rowp = CO + (size_t)entry * D + col0;
#pragma unroll
                    for (int bj = 0; bj < 2; ++bj) { const f32x4 v0 = acc[ai][bj][m][0] * (1.0f / (S_ACT * S_W2)), v1 = acc[ai][bj][m][1] * (1.0f / (S_ACT * S_W2));
                        u32x4 w; w.x = cvt_pk_bf16(v0[0], v0[1]); w.y = cvt_pk_bf16(v0[2], v0[3]); w.z = cvt_pk_bf16(v1[0], v1[1]); w.w = cvt_pk_bf16(v1[2], v1[3]);
                        *(u32x4*)(rowp + bj * HALF) = w; } } }
    }
};
}

struct Frame {
    LAS unsigned char* lds; volatile LAS unsigned* MISC;
    int tid, lane, wave, vcu, G, gw, NGW, bid;
};
struct Args { const GAS float* in[22]; GAS float* out; GAS unsigned char* ws; int ph_lo, ph_hi, li, pad; };
typedef const __attribute__((address_space(4))) Args KArgs;
__device__ __forceinline__ KArgs* ka_fresh() { unsigned long long p = (unsigned long long)__builtin_amdgcn_kernarg_segment_ptr(); asm volatile("" : "+s"(p)); return (KArgs*)p; }
#define KA KArgs* const ka = ka_fresh()
#define KIN(i) ((const float*)ka->in[i])
#define KWS ((unsigned char*)ka->ws)
#define KOUT ((float*)ka->out)
enum { I_X = 0, I_NMIX, I_WIN, I_PE, I_W1, I_W2, I_QN, I_KN, I_LB, I_HGN, I_WA2, I_BA, I_GLAN, I_WBR, I_WOUT, I_NFFN, I_WGRP, I_BGRP, I_WEXP, I_BEXP, I_WGU, I_WDN };

__device__ __forceinline__ void tr_item(const float* W, size_t ldw, int c0, int nv, bf16* WT, size_t ldt, int r0, int k0, LAS float* scr, int lane) {
    const int nn = lane & 31;
    float tv[32];
#pragma unroll
    for (int i = 0; i < 32; ++i) { const int kk = 2 * i + (lane >> 5); tv[i] = nn < nv ? __builtin_nontemporal_load(W + (size_t)(k0 + kk) * ldw + c0 + nn) : 0.f; }
#pragma unroll
    for (int i = 0; i < 32; ++i) { const int kk = 2 * i + (lane >> 5); scr[kk * 33 + nn] = tv[i]; }
    LDS_WAIT();
    const int c = lane & 7;
#pragma unroll
    for (int j = 0; j < 4; ++j) { const int n = (lane >> 3) + 8 * j; const LAS float* s = scr + (8 * c) * 33 + n;
        u32x4 o; o.x = pk2(s[0 * 33], s[1 * 33]); o.y = pk2(s[2 * 33], s[3 * 33]); o.z = pk2(s[4 * 33], s[5 * 33]); o.w = pk2(s[6 * 33], s[7 * 33]);
        if (n < nv) __builtin_nontemporal_store(o, (u32x4*)(WT + (size_t)(r0 + n) * ldt + k0 + 8 * c)); }
    LDS_WAIT();
}
__device__ __forceinline__ void tr_item8(const float* W, size_t ldw, int c0, unsigned char* WT8, size_t ldt, int r0, int k0, float sc, LAS float* scr, int lane) {
    const int nn = lane & 31;
    float tv[64];
#pragma unroll
    for (int i = 0; i < 64; ++i) { const int kk = 2 * i + (lane >> 5); tv[i] = __builtin_nontemporal_load(W + (size_t)(k0 + kk) * ldw + c0 + nn); }
#pragma unroll
    for (int i = 0; i < 64; ++i) { const int kk = 2 * i + (lane >> 5); scr[kk * 33 + nn] = tv[i] * sc; }
    LDS_WAIT();
    const int c = lane & 7;
#pragma unroll
    for (int j = 0; j < 4; ++j) { const int n = (lane >> 3) + 8 * j; const LAS float* sp = scr + (16 * c) * 33 + n;
        u32x4 o; o.x = pk4_fp8(sp[0 * 33], sp[1 * 33], sp[2 * 33], sp[3 * 33]); o.y = pk4_fp8(sp[4 * 33], sp[5 * 33], sp[6 * 33], sp[7 * 33]);
        o.z = pk4_fp8(sp[8 * 33], sp[9 * 33], sp[10 * 33], sp[11 * 33]); o.w = pk4_fp8(sp[12 * 33], sp[13 * 33], sp[14 * 33], sp[15 * 33]);
        __builtin_nontemporal_store(o, (u32x4*)(WT8 + (size_t)(r0 + n) * ldt + k0 + 16 * c)); }
    LDS_WAIT();
}
__device__ __forceinline__ void phase_prologue(Frame& F) {
    KA;
    {
      bf16* W1T = (bf16*)(KWS + WS_CW); bf16* W2T = (bf16*)(KWS + WS_CW + 1048576); float* B1 = (float*)(KWS + WS_CW + 1572864);
      for (int i = F.bid * 512 + F.tid; i < NL * 2 * 64 * 2048; i += F.G * 512) { const int lk = i / (64 * 2048), j = (i / 2048) % 64, c = i % 2048; W1T[i] = (bf16)f2bf(KIN(I_W1)[((size_t)lk * 2048 + c) * 64 + j]); }
      for (int i = F.bid * 512 + F.tid; i < NL * 2 * 64 * 64; i += F.G * 512) { const int lk = i / 4096, j2 = (i / 64) % 64, j = i % 64; W2T[i] = (bf16)f2bf(KIN(I_W2)[((size_t)lk * 64 + j) * 64 + j2]); }
      if (F.bid < NL * 2) { const int lk = F.bid, j = F.tid & 63, part = F.tid >> 6; float a = 0.f;
#pragma unroll 8
          for (int c = part * 256; c < part * 256 + 256; ++c) a += KIN(I_PE)[(size_t)lk * 2048 + c] * KIN(I_W1)[((size_t)lk * 2048 + c) * 64 + j];
          LAS float* rd = (LAS float*)F.lds; rd[F.tid] = a; __syncthreads();
          if (F.tid < 64) { float t2 = 0.f;
#pragma unroll
              for (int p = 0; p < 8; ++p) t2 += rd[p * 64 + F.tid];
              B1[lk * 64 + F.tid] = t2; }
          __syncthreads(); } }
    { float* WRT = (float*)(KWS + WS_WRT);
      for (int i = F.bid * 512 + F.tid; i < NL * 48 * D; i += F.G * 512) { const int l = i / (48 * D), n = (i / D) % 48, k = i % D; const float g = KIN(I_NFFN)[l * D + k];
          WRT[i] = n < 32 ? g * KIN(I_WEXP)[((size_t)l * D + k) * 32 + n] : (n < 36 ? g * KIN(I_WGRP)[((size_t)l * D + k) * 4 + (n - 32)] : 0.f); } }
    LAS float* scr = (LAS float*)(F.lds + F.wave * 17408);
    constexpr int IT_WIN = 32 * 154, IT_WG8 = 16 * 192, IT_WBR = 3 * 8 * 64, IT_WOUT = 32 * 64, IT_WGU = 32 * 16 * 32, IT_WDN = 32 * 4 * 64, IT_L = IT_WIN + IT_WG8 + IT_WBR + IT_WOUT + IT_WGU + IT_WDN;
    for (int it = F.gw; it < NL * IT_L; it += F.NGW) {
        const int l = it / IT_L; int r = it % IT_L;
        if (r < IT_WIN) { const int kb = r / 154, nb = r % 154; int src, dst, nv = 32;
            if (nb < 40) { src = nb * 32; dst = nb * 32; }
            else if (nb == 40) { src = 1280; dst = C_NG; nv = 24; }
            else if (nb < 153) { src = 1304 + 32 * (nb - 41); dst = 1280 + 32 * (nb - 41); }
            else { src = 4888; dst = C_GA; nv = 16; }
            tr_item(KIN(I_WIN) + (size_t)l * D * INC, INC, src, nv, (bf16*)(KWS + WS_WIN) + (size_t)l * NPAD * D, D, dst, kb * 64, scr, F.lane); continue; }
        r -= IT_WIN;
        if (r < IT_WG8) { const int kb = r / 192, nb = r % 192;
            tr_item8(KIN(I_WIN) + (size_t)l * D * INC, INC, 4904 + 32 * nb, (unsigned char*)(KWS + WS_WIN8) + (size_t)l * 6144 * D, D, nb * 32, kb * 128, S_WG, scr, F.lane); continue; }
        r -= IT_WG8;
        if (r < IT_WBR) { const int n = r / 512, q = r % 512, kb = q / 64, nb = q % 64;
            tr_item(KIN(I_WBR) + ((size_t)l * 3 + n) * 512 * D, D, nb * 32, 32, (bf16*)(KWS + WS_WBR) + ((size_t)l * 3 + n) * D * 512, 512, nb * 32, kb * 64, scr, F.lane); continue; }
        r -= IT_WBR;
        if (r < IT_WOUT) { const int kb = r / 64, nb = r % 64;
            tr_item(KIN(I_WOUT) + (size_t)l * D * D, D, nb * 32, 32, (bf16*)(KWS + WS_WOUT) + (size_t)l * D * D, D, nb * 32, kb * 64, scr, F.lane); continue; }
        r -= IT_WOUT;
        if (r < IT_WGU) { const int e = r / 512, q = r % 512, kb = q / 32, nb = q % 32;
            tr_item8(KIN(I_WGU) + ((size_t)l * NE + e) * D * 1024, 1024, nb * 32, (unsigned char*)(KWS + WS_WGU) + ((size_t)l * NE + e) * 1024 * D, D, nb * 32, kb * 128, S_W1, scr, F.lane); continue; }
        r -= IT_WGU;
        { const int e = r / 256, q = r % 256, kb = q / 64, nb = q % 64;
            tr_item8(KIN(I_WDN) + ((size_t)l * NE + e) * FF * D, D, nb * 32, (unsigned char*)(KWS + WS_WDN) + ((size_t)l * NE + e) * D * FF, FF, nb * 32, kb * 128, S_W2, scr, F.lane); }
    }
}

template <int MODE> __device__ __forceinline__ void phase_norm1(Frame& F, const float* xin, const bf16* contrib, float* xout, const float* gain, bf16* H, unsigned char* H8n = nullptr) {
    for (int t0 = F.gw; t0 < T; t0 += 2 * F.NGW) {
        f32x4 v[2][8]; float ss[2] = {0.f, 0.f};
#pragma unroll
        for (int rr = 0; rr < 2; ++rr) { const int t = t0 + rr * F.NGW; if (t < T) {
            const f32x4* xr = (const f32x4*)(xin + (size_t)t * D) + F.lane;
#pragma unroll
            for (int j = 0; j < 8; ++j) v[rr][j] = xr[64 * j]; } }
        u32x2 c0[2][8], c1[2][8];
        if (MODE != 0) {
#pragma unroll
            for (int rr = 0; rr < 2; ++rr) { const int t = t0 + rr * F.NGW; if (t < T) {
#pragma unroll
                for (int j = 0; j < 8; ++j) { c0[rr][j] = *((const u32x2*)(contrib + (size_t)(2 * t) * D) + F.lane + 64 * j); c1[rr][j] = *((const u32x2*)(contrib + (size_t)(2 * t + 1) * D) + F.lane + 64 * j); } } } }
#pragma unroll
        for (int rr = 0; rr < 2; ++rr) { const int t = t0 + rr * F.NGW; if (t < T) {
#pragma unroll
            for (int j = 0; j < 8; ++j) {
                if (MODE != 0) { v[rr][j].x += bflo(c0[rr][j].x) + bflo(c1[rr][j].x); v[rr][j].y += bfhi(c0[rr][j].x) + bfhi(c1[rr][j].x); v[rr][j].z += bflo(c0[rr][j].y) + bflo(c1[rr][j].y); v[rr][j].w += bfhi(c0[rr][j].y) + bfhi(c1[rr][j].y);
                    *((f32x4*)(xout + (size_t)t * D) + F.lane + 64 * j) = v[rr][j]; }
                ss[rr] += v[rr][j].x * v[rr][j].x + v[rr][j].y * v[rr][j].y + v[rr][j].z * v[rr][j].z + v[rr][j].w * v[rr][j].w; } } }
        if (MODE != 2) {
#pragma unroll
            for (int rr = 0; rr < 2; ++rr) { const int t = t0 + rr * F.NGW; if (t < T) {
                const float rstd = 1.0f / sqrtf(wave_sum(ss[rr]) * (1.0f / D) + EPS);
#pragma unroll
                for (int j = 0; j < 8; ++j) { const f32x4 g = *((const f32x4*)gain + F.lane + 64 * j);
                    const float h0 = v[rr][j].x * rstd * g.x, h1 = v[rr][j].y * rstd * g.y, h2 = v[rr][j].z * rstd * g.z, h3 = v[rr][j].w * rstd * g.w;
                    u32x2 o; o.x = pkbf(h0, h1); o.y = pkbf(h2, h3);
                    *((u32x2*)(H + (size_t)t * D) + F.lane + 64 * j) = o;
                    *((unsigned*)(H8n + (size_t)t * D) + F.lane + 64 * j) = pk4_fp8(h0 * S_H, h1 * S_H, h2 * S_H, h3 * S_H); } } }
        }
    }
}

__device__ __forceinline__ void phase_prep(Frame& F, int l) {
    KA;
    const bf16* P = (const bf16*)(KWS + WS_P);
    float* QN = (float*)(KWS + WS_QN); float* KV = (float*)(KWS + WS_KV);
    const float* qg = KIN(I_QN) + l * 64; const float* kg = KIN(I_KN) + l * 192;
    for (int it = F.gw; it < T * 20; it += F.NGW) {
        const int t = it / 20, v = it % 20;
        float x = bf2f(P[(size_t)t * NPAD + v * 64 + F.lane]);
        const bool isq = v < 8, nk1 = (v == 12 || v == 13), nk2 = (v == 16 || v == 17);
        if (isq || nk1 || nk2) { const float ss = wave_sum(x * x); const float g = isq ? qg[F.lane] : (nk1 ? kg[64 + F.lane] : kg[128 + F.lane]); x = x * (1.0f / sqrtf(ss * (1.0f / 64.0f) + EPS)) * g; }
        if (isq) QN[((size_t)v * T + t) * 64 + F.lane] = x;
        else { const int w = v - 8, tens = w >> 1, g = w & 1; KV[(size_t)tens * KV_STRIDE + ((size_t)g * T + t) * 64 + F.lane] = x; }
    }
}
__device__ __forceinline__ float gelu_tanh(float x) { const float u = 0.7978845608028654f * (x + 0.044715f * x * x * x); return 0.5f * x * (1.0f + tanhf(u)); }
__device__ __forceinline__ void phase_compress(Frame& F, int l) {
    KA;
    LAS float* av = (LAS float*)(F.lds + F.wave * 16384);
    const float* KV = (const float*)(KWS + WS_KV); float* KC = (float*)(KWS + WS_KC);
    for (int it = F.gw; it < 2 * 2 * 511; it += F.NGW) {
        const int kind = it / 1022, q = it % 1022, g = q / 511, n = q % 511;
        const float* src = KV + (size_t)kind * KV_STRIDE + ((size_t)g * T + 16 * n) * 64;
        const float* pe = KIN(I_PE) + ((size_t)l * 2 + kind) * 2048;
        const float* w1 = KIN(I_W1) + ((size_t)l * 2 + kind) * 2048 * 64;
        const float* w2 = KIN(I_W2) + ((size_t)l * 2 + kind) * 64 * 64;
#pragma unroll 4
        for (int c = 0; c < 32; ++c) av[c * 64 + F.lane] = src[c * 64 + F.lane] + pe[c * 64 + F.lane];
        WSYNC();
        float acc = 0.f;
#pragma unroll 8
        for (int i = 0; i < 2048; ++i) acc += av[i] * w1[i * 64 + F.lane];
        const float hid = gelu_tanh(acc);
        WSYNC();
        av[F.lane] = hid;
        WSYNC();
        float o = 0.f;
#pragma unroll 8
        for (int i = 0; i < 64; ++i) o += av[i] * w2[i * 64 + F.lane];
        WSYNC();
        if (kind == 0) { const float ss = wave_sum(o * o); o = o * (1.0f / sqrtf(ss * (1.0f / 64.0f) + EPS)) * KIN(I_KN)[l * 192 + F.lane]; }
        KC[(size_t)kind * (2 * 512 * 64) + ((size_t)g * 512 + n) * 64 + F.lane] = o;
    }
}
__device__ __forceinline__ void phase_recur(Frame& F, int l) {
    KA;
    const bf16* P = (const bf16*)(KWS + WS_P); float* ORAW = (float*)(KWS + WS_ORAW);
    for (int it = F.gw; it < 1024; it += F.NGW) {
        const int kind = it >> 9, head = (it >> 7) & 3, j = it & 127;
        if (kind == 0) {
            const int d0 = F.lane, d1 = F.lane + 64;
            const float* lbl = KIN(I_LB);
            float lb0, lb1;
            { const float a0 = lbl[head * 128 + d0], b0 = lbl[512 + head * 128 + d0], a1 = lbl[head * 128 + d1], b1 = lbl[512 + head * 128 + d1];
              lb0 = l == 0 ? 0.f : 1.0f / (1.0f + expf(a0 - b0)); lb1 = l == 0 ? 0.f : 1.0f / (1.0f + expf(a1 - b1)); }
            const bf16* Pq = P + C_HQ + head * 128; const bf16* Pf = P + C_HF + head * 128; const bf16* Pi = P + C_HI + head * 128 + j;
            float S0 = 0.f, S1 = 0.f;
            for (int t0 = 0; t0 < T; t0 += 8) {
                bf16 zq0[8], zq1[8], zf0[8], zf1[8], vi[8];
#pragma unroll
                for (int u = 0; u < 8; ++u) { const size_t row = (size_t)(t0 + u) * NPAD; zq0[u] = Pq[row + d0]; zq1[u] = Pq[row + d1]; zf0[u] = Pf[row + d0]; zf1[u] = Pf[row + d1]; vi[u] = Pi[row]; }
                float part[8];
#pragma unroll
                for (int u = 0; u < 8; ++u) { const float v = bf2f(vi[u]);
                    const float s0 = sigmoidf_(bf2f(zf0[u])), s1 = sigmoidf_(bf2f(zf1[u]));
                    const float f0 = lb0 + (1.0f - lb0) * s0, f1 = lb1 + (1.0f - lb1) * s1;
                    const float k0 = (1.0f - lb0) * (1.0f - s0), k1 = (1.0f - lb1) * (1.0f - s1);
                    S0 = f0 * S0 + k0 * v; S1 = f1 * S1 + k1 * v;
                    part[u] = bf2f(zq0[u]) * S0 + bf2f(zq1[u]) * S1; }
                float mine = 0.f;
#pragma unroll
                for (int u = 0; u < 8; ++u) { const float s = wave_sum(part[u]); mine = (F.lane == u) ? s : mine; }
                if (F.lane < 8) ORAW[(size_t)(t0 + F.lane) * 1024 + head * 128 + j] = mine;
            }
        } else {
            const int d = F.lane, c = head * 64 + d;
            float wa[16];
#pragma unroll
            for (int r = 0; r < 16; ++r) wa[r] = KIN(I_WA2)[((size_t)l * 16 + r) * 256 + c];
            const float ba = KIN(I_BA)[l * 256 + c];
            const bf16* Pq = P + C_GQ + c; const bf16* Pk = P + C_GK + c; const bf16* Pv = P + C_GV + head * 128 + j; const bf16* Pa = P + C_GA;
            float S = 0.f;
            for (int t0 = 0; t0 < T; t0 += 8) {
                bf16 zq[8], zk[8], zv[8]; u32x4 ga0[8], ga1[8];
#pragma unroll
                for (int u = 0; u < 8; ++u) { const size_t row = (size_t)(t0 + u) * NPAD; zq[u] = Pq[row]; zk[u] = Pk[row]; zv[u] = Pv[row]; ga0[u] = *(const u32x4*)(Pa + row); ga1[u] = *(const u32x4*)(Pa + row + 8); }
                float part[8];
#pragma unroll
                for (int u = 0; u < 8; ++u) {
                    float a = ba;
                    a += bflo(ga0[u].x) * wa[0] + bfhi(ga0[u].x) * wa[1] + bflo(ga0[u].y) * wa[2] + bfhi(ga0[u].y) * wa[3] + bflo(ga0[u].z) * wa[4] + bfhi(ga0[u].z) * wa[5] + bflo(ga0[u].w) * wa[6] + bfhi(ga0[u].w) * wa[7];
                    a += bflo(ga1[u].x) * wa[8] + bfhi(ga1[u].x) * wa[9] + bflo(ga1[u].y) * wa[10] + bfhi(ga1[u].y) * wa[11] + bflo(ga1[u].z) * wa[12] + bfhi(ga1[u].z) * wa[13] + bflo(ga1[u].w) * wa[14] + bfhi(ga1[u].w) * wa[15];
                    const float ls = fminf(a, 0.f) - log1pf(expf(-fabsf(a)));
                    const float f = expf(ls * (1.0f / 16.0f));
                    S = f * S + bf2f(zk[u]) * bf2f(zv[u]);
                    part[u] = bf2f(zq[u]) * 0.125f * S; }
                float mine = 0.f;
#pragma unroll
                for (int u = 0; u < 8; ++u) { const float s = wave_sum(part[u]); mine = (F.lane == u) ? s : mine; }
                if (F.lane < 8) ORAW[(size_t)(t0 + F.lane) * 1024 + 512 + head * 128 + j] = mine;
            }
        }
    }
}
__device__ __forceinline__ void phase_recur_out(Frame& F, int l) {
    KA;
    const bf16* P = (const bf16*)(KWS + WS_P); const float* ORAW = (const float*)(KWS + WS_ORAW); bf16* OCAT = (bf16*)(KWS + WS_OCAT);
    for (int it = F.gw; it < T * 8; it += F.NGW) {
        const int t = it >> 3, kind = (it >> 2) & 1, head = it & 3;
        const float* gn = (kind == 0 ? KIN(I_HGN) : KIN(I_GLAN)) + l * 128;
        const int cg = (kind == 0 ? C_HG : C_GR) + head * 128;
        const float r0 = ORAW[(size_t)t * 1024 + kind * 512 + head * 128 + F.lane], r1 = ORAW[(size_t)t * 1024 + kind * 512 + head * 128 + 64 + F.lane];
        const float rstd = 1.0f / sqrtf(wave_sum(r0 * r0 + r1 * r1) * (1.0f / 128.0f) + EPS);
        const float g0 = bf2f(P[(size_t)t * NPAD + cg + F.lane]), g1 = bf2f(P[(size_t)t * NPAD + cg + 64 + F.lane]);
        const float a0 = kind == 0 ? sigmoidf_(g0) : g0 * sigmoidf_(g0), a1 = kind == 0 ? sigmoidf_(g1) : g1 * sigmoidf_(g1);
        OCAT[(size_t)t * 1536 + 512 + kind * 512 + head * 128 + F.lane] = (bf16)f2bf(r0 * rstd * gn[F.lane] * a0);
        OCAT[(size_t)t * 1536 + 512 + kind * 512 + head * 128 + 64 + F.lane] = (bf16)f2bf(r1 * rstd * gn[64 + F.lane] * a1);
    }
}


template <int KIND> struct RecCfg { static constexpr int DK = KIND == 0 ? 128 : 64, NSEG = 512 / DK, TPS = 64 / NSEG, QROW = (DK + 8) * 2; };
constexpr int REC_VT_OFF = 0;
constexpr int REC_KD_OFF = 18432;
constexpr int REC_QS_OFF = 36864;
constexpr int REC_KS_OFF = 54272;
constexpr int REC_QD_OFF = 71680;
constexpr int REC_RED_OFF = 89088;
constexpr int REC_TOT_OFF = 91136;
__device__ __forceinline__ float expc(float x2) { return __builtin_amdgcn_exp2f(fminf(x2, 110.0f)); }
template <int KIND> __device__ __forceinline__ void rec_elem(KArgs* ka, int l, int head, int chunk, int tid, LAS float* tot,
        float (&qv)[RecCfg<KIND>::TPS], float (&kv)[RecCfg<KIND>::TPS], float (&bv)[RecCfg<KIND>::TPS], float& bend, float& bref) {
    constexpr int DK = RecCfg<KIND>::DK, NSEG = RecCfg<KIND>::NSEG, TPS = RecCfg<KIND>::TPS;
    const int d = tid % DK, seg = tid / DK, t0 = chunk * 64 + seg * TPS;
    const bf16* P = (const bf16*)(KWS + WS_P);
    float run = 0.f;
    if (KIND == 0) {
        const int c = head * 128 + d;
        float lb = 0.f;
        if (l > 0) { const float a0 = KIN(I_LB)[c], b0 = KIN(I_LB)[512 + c]; lb = 1.0f / (1.0f + expf(a0 - b0)); }
        const float omlb = 1.0f - lb;
        unsigned zr[TPS], qr[TPS];
#pragma unroll
        for (int u = 0; u < TPS; ++u) { const size_t row = (size_t)(t0 + u) * NPAD; zr[u] = P[row + C_HF + c]; qr[u] = P[row + C_HQ + c]; }
#pragma unroll
        for (int u = 0; u < TPS; ++u) {
            const float z = bf2f(zr[u]); qv[u] = bf2f(qr[u]);
            const float e = __builtin_amdgcn_exp2f(-LOG2E * z), sg = __builtin_amdgcn_rcpf(1.0f + e), f = fmaf(omlb, sg, lb);
            kv[u] = omlb * (e * sg);
            run += __builtin_amdgcn_logf(fmaxf(f, 1e-30f)); bv[u] = run; }
    } else {
        const int c = head * 64 + d;
        float wa[16];
#pragma unroll
        for (int r = 0; r < 16; ++r) wa[r] = KIN(I_WA2)[((size_t)l * 16 + r) * 256 + c];
        const float ba = KIN(I_BA)[l * 256 + c];
        u32x4 g0r[TPS], g1r[TPS]; unsigned qr[TPS], kr[TPS];
#pragma unroll
        for (int u = 0; u < TPS; ++u) { const size_t row = (size_t)(t0 + u) * NPAD; g0r[u] = *(const u32x4*)(P + row + C_GA); g1r[u] = *(const u32x4*)(P + row + C_GA + 8); qr[u] = P[row + C_GQ + c]; kr[u] = P[row + C_GK + c]; }
#pragma unroll
        for (int u = 0; u < TPS; ++u) { const u32x4 g0 = g0r[u], g1 = g1r[u];
            float a = ba;
            a += bflo(g0.x) * wa[0] + bfhi(g0.x) * wa[1] + bflo(g0.y) * wa[2] + bfhi(g0.y) * wa[3] + bflo(g0.z) * wa[4] + bfhi(g0.z) * wa[5] + bflo(g0.w) * wa[6] + bfhi(g0.w) * wa[7];
            a += bflo(g1.x) * wa[8] + bfhi(g1.x) * wa[9] + bflo(g1.y) * wa[10] + bfhi(g1.y) * wa[11] + bflo(g1.z) * wa[12] + bfhi(g1.z) * wa[13] + bflo(g1.w) * wa[14] + bfhi(g1.w) * wa[15];
            const float ls2 = fminf(a, 0.f) * LOG2E - __builtin_amdgcn_logf(1.0f + __builtin_amdgcn_exp2f(-LOG2E * fabsf(a)));
            qv[u] = bf2f(qr[u]) * 0.125f; kv[u] = bf2f(kr[u]);
            run += ls2 * (1.0f / 16.0f); bv[u] = run; }
    }
    tot[seg * DK + d] = run;
    __syncthreads();
    float off = 0.f; bend = 0.f; bref = 0.f;
#pragma unroll
    for (int sgi = 0; sgi < NSEG; ++sgi) { const float v = tot[sgi * DK + d]; off += sgi < seg ? v : 0.f; bref += sgi < NSEG / 2 ? v : 0.f; bend += v; }
#pragma unroll
    for (int u = 0; u < TPS; ++u) bv[u] += off;
}
template <int KIND> __device__ __forceinline__ void rec_vt_load(KArgs* ka, int head, int chunk, int tid, unsigned (&w)[8]) {
    const bf16* P = (const bf16*)(KWS + WS_P) + (KIND == 0 ? C_HI : C_GV) + head * 128;
    const int v = tid & 127, sv = tid >> 7;
#pragma unroll
    for (int u = 0; u < 8; ++u) { const unsigned a = P[(size_t)(chunk * 64 + sv * 16 + 2 * u) * NPAD + v], b = P[(size_t)(chunk * 64 + sv * 16 + 2 * u + 1) * NPAD + v]; w[u] = a | (b << 16); }
}
__device__ __forceinline__ void rec_vt_store(int tid, LAS unsigned char* lds, const unsigned (&w)[8]) {
    const int v = tid & 127, sv = tid >> 7;
    LAS u32x4* dst = (LAS u32x4*)(lds + REC_VT_OFF + v * 144 + sv * 32);
    dst[0] = (u32x4){w[0], w[1], w[2], w[3]}; dst[1] = (u32x4){w[4], w[5], w[6], w[7]};
}
template <int KIND> __device__ __forceinline__ void rec_local_unit(KArgs* ka, Frame& F, int l, int head, int chunk) {
    constexpr int DK = RecCfg<KIND>::DK, TPS = RecCfg<KIND>::TPS;
    LAS unsigned char* lds = F.lds; LAS float* tot = (LAS float*)(lds + REC_TOT_OFF);
    float qv[TPS], kv[TPS], bv[TPS], bend, bref;
    unsigned vraw[8];
    rec_vt_load<KIND>(ka, head, chunk, F.tid, vraw);
    rec_elem<KIND>(ka, l, head, chunk, F.tid, tot, qv, kv, bv, bend, bref);
    const int d = F.tid % DK, seg = F.tid / DK, unit = chunk * 4 + head;
    { unsigned w[TPS / 2];
#pragma unroll
      for (int u = 0; u < TPS / 2; ++u) w[u] = pkbf(kv[2 * u] * expc(bend - bv[2 * u]), kv[2 * u + 1] * expc(bend - bv[2 * u + 1]));
      LAS u32x4* dst = (LAS u32x4*)(lds + REC_KD_OFF + d * 144 + seg * TPS * 2);
      dst[0] = (u32x4){w[0], w[1], w[2], w[3]};
      if constexpr (TPS == 16) dst[1] = (u32x4){w[4], w[5], w[6], w[7]}; }
    if (seg == 0) ((float*)(KWS + WS_DEC + (KIND == 0 ? 0 : 262144)))[(size_t)unit * DK + d] = __builtin_amdgcn_exp2f(bend);
    rec_vt_store(F.tid, lds, vraw);
    __syncthreads();
    const int r = F.lane & 15, kq = F.lane >> 4;
    const int dt = KIND == 0 ? F.wave : (F.wave & 3), vt0 = KIND == 0 ? 0 : (F.wave >> 2) * 4, nvt = KIND == 0 ? 8 : 4;
    bf16x8 a[2];
#pragma unroll
    for (int ks = 0; ks < 2; ++ks) a[ks] = *(const LAS bf16x8*)(lds + REC_KD_OFF + (16 * dt + r) * 144 + (32 * ks + 8 * kq) * 2);
    bf16* Sl = (bf16*)(KWS + (KIND == 0 ? WS_SLOC_HG : WS_SLOC_GL)) + (size_t)unit * 128 * DK;
#pragma unroll
    for (int vi = 0; vi < nvt; ++vi) { const int vt = vt0 + vi; f32x4 acc = {0.f, 0.f, 0.f, 0.f};
#pragma unroll
        for (int ks = 0; ks < 2; ++ks) { const bf16x8 b = *(const LAS bf16x8*)(lds + REC_VT_OFF + (16 * vt + r) * 144 + (32 * ks + 8 * kq) * 2); acc = __builtin_amdgcn_mfma_f32_16x16x32_bf16(a[ks], b, acc, 0, 0, 0); }
        u32x2 w2; w2.x = pkbf(acc[0], acc[1]); w2.y = pkbf(acc[2], acc[3]);
        *(u32x2*)(Sl + (size_t)(16 * vt + r) * DK + 16 * dt + 4 * kq) = w2; }
    __syncthreads();
}
__device__ __forceinline__ void phase_rec_local(Frame& F, int l) {
    KA;
    for (int it = F.bid; it < 1024; it += F.G) { const int kind = it >> 9, chunk = (it >> 2) & 127, head = it & 3;
        if (kind == 0) rec_local_unit<0>(ka, F, l, head, chunk); else rec_local_unit<1>(ka, F, l, head, chunk); }
}
__device__ __forceinline__ void phase_rec_scan(Frame& F) {
    KA;
    const int gt = F.bid * 512 + F.tid;
    if (gt >= 49152) return;
    const bool hg = gt < 32768; const int q = hg ? gt : gt - 32768;
    const int DK = hg ? 128 : 64, dp = q % (DK / 2), v = (q / (DK / 2)) & 127, head = q / (DK / 2 * 128);
    const bf16* Sl = (const bf16*)(KWS + (hg ? WS_SLOC_HG : WS_SLOC_GL)) + ((size_t)head * 128 + v) * DK + 2 * dp;
    bf16* Sp = (bf16*)(KWS + (hg ? WS_SPREV_HG : WS_SPREV_GL)) + ((size_t)head * 128 + v) * DK + 2 * dp;
    const float* De = (const float*)(KWS + WS_DEC + (hg ? 0 : 262144)) + (size_t)head * DK + 2 * dp;
    const size_t ustr = (size_t)4 * 128 * DK, dstr = (size_t)4 * DK;
    float s0 = 0.f, s1 = 0.f;
    for (int c0 = 0; c0 < NCH; c0 += 16) { unsigned x[16]; f32x2 dc[16];
#pragma unroll
        for (int u = 0; u < 16; ++u) { x[u] = *(const unsigned*)(Sl + (size_t)(c0 + u) * ustr); dc[u] = *(const f32x2*)(De + (size_t)(c0 + u) * dstr); }
#pragma unroll
        for (int u = 0; u < 16; ++u) { *(unsigned*)(Sp + (size_t)(c0 + u) * ustr) = pkbf(s0, s1); s0 = dc[u].x * s0 + bflo(x[u]); s1 = dc[u].y * s1 + bfhi(x[u]); } }
}
template <int KIND> __device__ __forceinline__ void rec_out_unit(KArgs* ka, Frame& F, int l, int head, int chunk) {
    constexpr int DK = RecCfg<KIND>::DK, TPS = RecCfg<KIND>::TPS, QROW = RecCfg<KIND>::QROW, NKS = DK / 32;
    LAS unsigned char* lds = F.lds; LAS float* tot = (LAS float*)(lds + REC_TOT_OFF); LAS float* red = (LAS float*)(lds + REC_RED_OFF);
    const int r = F.lane & 15, kq = F.lane >> 4, unit = chunk * 4 + head, vt = F.wave;
    bf16x8 sa[NKS];
    { const bf16* Sp = (const bf16*)(KWS + (KIND == 0 ? WS_SPREV_HG : WS_SPREV_GL)) + (size_t)unit * 128 * DK + (size_t)(16 * vt + r) * DK + 8 * kq;
#pragma unroll
      for (int ks = 0; ks < NKS; ++ks) sa[ks] = *(const bf16x8*)(Sp + 32 * ks); }
    float qv[TPS], kv[TPS], bv[TPS], bend, bref;
    unsigned vraw[8];
    rec_vt_load<KIND>(ka, head, chunk, F.tid, vraw);
    const bf16* P = (const bf16*)(KWS + WS_P); bf16* OCAT = (bf16*)(KWS + WS_OCAT);
    const int v0 = 16 * vt + 4 * kq;
    const f32x4 gn = *(const f32x4*)((KIND == 0 ? KIN(I_HGN) : KIN(I_GLAN)) + l * 128 + v0);
    u32x2 gq4[4];
#pragma unroll
    for (int it = 0; it < 4; ++it) gq4[it] = *(const u32x2*)(P + (size_t)(chunk * 64 + 16 * it + r) * NPAD + (KIND == 0 ? C_HG : C_GR) + head * 128 + v0);
    rec_elem<KIND>(ka, l, head, chunk, F.tid, tot, qv, kv, bv, bend, bref);
    { const int d = F.tid % DK, seg = F.tid / DK; const float eref = __builtin_amdgcn_exp2f(fmaxf(bref, -120.f));
#pragma unroll
      for (int u = 0; u < TPS; u += 2) { const int o = (seg * TPS + u) * QROW + d * 2;
          const float x0 = __builtin_amdgcn_exp2f(fminf(fmaxf(bv[u] - bref, -110.f), 110.f)), x1 = __builtin_amdgcn_exp2f(fminf(fmaxf(bv[u + 1] - bref, -110.f), 110.f));
          const float qs0 = qv[u] * x0, qs1 = qv[u + 1] * x1;
          const unsigned w0 = pkbf(qs0, qs1), w1 = pkbf(kv[u] * __builtin_amdgcn_rcpf(x0), kv[u + 1] * __builtin_amdgcn_rcpf(x1)), w2 = pkbf(qs0 * eref, qs1 * eref);
          *(LAS bf16*)(lds + REC_QS_OFF + o) = (bf16)w0; *(LAS bf16*)(lds + REC_QS_OFF + o + QROW) = (bf16)(w0 >> 16);
          *(LAS bf16*)(lds + REC_KS_OFF + o) = (bf16)w1; *(LAS bf16*)(lds + REC_KS_OFF + o + QROW) = (bf16)(w1 >> 16);
          *(LAS bf16*)(lds + REC_QD_OFF + o) = (bf16)w2; *(LAS bf16*)(lds + REC_QD_OFF + o + QROW) = (bf16)(w2 >> 16); } }
    rec_vt_store(F.tid, lds, vraw);
    __syncthreads();
#pragma unroll
    for (int tt = 0; tt < 2; ++tt) { const int tile = F.wave * 2 + tt, jt = tile >> 2, it = tile & 3; f32x4 acc = {0.f, 0.f, 0.f, 0.f};
        if (jt <= it) {
#pragma unroll
            for (int ks = 0; ks < NKS; ++ks) { const bf16x8 a = *(const LAS bf16x8*)(lds + REC_KS_OFF + (16 * jt + r) * QROW + (32 * ks + 8 * kq) * 2), b = *(const LAS bf16x8*)(lds + REC_QS_OFF + (16 * it + r) * QROW + (32 * ks + 8 * kq) * 2);
                acc = __builtin_amdgcn_mfma_f32_16x16x32_bf16(a, b, acc, 0, 0, 0); } }
        const int i = 16 * it + r, j0 = 16 * jt + 4 * kq;
        u32x2 w; w.x = pk2(j0 <= i ? acc[0] : 0.f, j0 + 1 <= i ? acc[1] : 0.f); w.y = pk2(j0 + 2 <= i ? acc[2] : 0.f, j0 + 3 <= i ? acc[3] : 0.f);
        *(LAS u32x2*)(lds + REC_KD_OFF + i * 144 + j0 * 2) = w; }
    __syncthreads();
    f32x4 acc[4];
#pragma unroll
    for (int it = 0; it < 4; ++it) acc[it] = (f32x4){0.f, 0.f, 0.f, 0.f};
#pragma unroll
    for (int ks = 0; ks < 2; ++ks) { const bf16x8 a = *(const LAS bf16x8*)(lds + REC_VT_OFF + (16 * vt + r) * 144 + (32 * ks + 8 * kq) * 2);
#pragma unroll
        for (int it = 0; it < 4; ++it) { const bf16x8 b = *(const LAS bf16x8*)(lds + REC_KD_OFF + (16 * it + r) * 144 + (32 * ks + 8 * kq) * 2); acc[it] = __builtin_amdgcn_mfma_f32_16x16x32_bf16(a, b, acc[it], 0, 0, 0); } }
#pragma unroll
    for (int ks = 0; ks < NKS; ++ks) {
#pragma unroll
        for (int it = 0; it < 4; ++it) { const bf16x8 b = *(const LAS bf16x8*)(lds + REC_QD_OFF + (16 * it + r) * QROW + (32 * ks + 8 * kq) * 2); acc[it] = __builtin_amdgcn_mfma_f32_16x16x32_bf16(sa[ks], b, acc[it], 0, 0, 0); } }
#pragma unroll
    for (int it = 0; it < 4; ++it) { float ss = acc[it][0] * acc[it][0] + acc[it][1] * acc[it][1] + acc[it][2] * acc[it][2] + acc[it][3] * acc[it][3];
        ss += lshx(ss, 16); ss += lshx(ss, 32);
        if (kq == 0) red[F.wave * 64 + 16 * it + r] = ss; }
    __syncthreads();
#pragma unroll
    for (int it = 0; it < 4; ++it) { const int i = 16 * it + r, t = chunk * 64 + i; float tot_ = 0.f;
#pragma unroll
        for (int w = 0; w < 8; ++w) tot_ += red[w * 64 + i];
        const float rstd = 1.0f / sqrtf(tot_ * (1.0f / 128.0f) + EPS);
        const u32x2 gq = gq4[it];
        float gt[4] = {bflo(gq.x), bfhi(gq.x), bflo(gq.y), bfhi(gq.y)}, o[4];
#pragma unroll
        for (int e = 0; e < 4; ++e) { const float sg = fsig(gt[e]); o[e] = acc[it][e] * rstd * gn[e] * (KIND == 0 ? sg : gt[e] * sg); }
        u32x2 w; w.x = pkbf(o[0], o[1]); w.y = pkbf(o[2], o[3]);
        *(u32x2*)(OCAT + (size_t)t * 1536 + 512 + KIND * 512 + head * 128 + v0) = w; }
    __syncthreads();
}
__device__ __forceinline__ void phase_rec_out(Frame& F, int l) {
    KA;
    unsigned* qctr = (unsigned*)(KWS + WS_CTL) + 2048 + 64 * l;
    volatile LAS int* qslot = (volatile LAS int*)(F.lds + MISC_OFF + 1024);
    int mine = 0;
    if (F.tid == 0) { mine = (int)__hip_atomic_fetch_add(qctr, 1u, __ATOMIC_RELAXED, __HIP_MEMORY_SCOPE_AGENT);
        unsigned* sdone = (unsigned*)(KWS + WS_CTL) + 2048 + 64 * (4 + l); unsigned sp = 0;
        while (__hip_atomic_load(sdone, __ATOMIC_RELAXED, __HIP_MEMORY_SCOPE_AGENT) < 96u) { __builtin_amdgcn_s_sleep(2); if (++sp > (1u << 24)) break; }
        __builtin_amdgcn_fence(__ATOMIC_ACQUIRE, "agent"); asm volatile("s_waitcnt vmcnt(0)" ::: "memory"); }
    for (;;) {
        if (F.tid == 0) *qslot = mine;
        __syncthreads();
        const int it = __builtin_amdgcn_readfirstlane(*qslot);
        __syncthreads();
        if (it >= 1024) break;
        if (F.tid == 0) mine = (int)__hip_atomic_fetch_add(qctr, 1u, __ATOMIC_RELAXED, __HIP_MEMORY_SCOPE_AGENT);
        const int kind = it >> 9, chunk = (it >> 2) & 127, head = it & 3;
        if (kind == 0) rec_out_unit<0>(ka, F, l, head, chunk); else rec_out_unit<1>(ka, F, l, head, chunk);
    }
}

typedef float f32x16 __attribute__((ext_vector_type(16)));
constexpr float NSA_SHIFT2 = 8.0f;
__device__ __forceinline__ int perm16(int b) { return (b & 3) | ((b & 4) << 1) | ((b & 8) >> 1); }
__device__ __forceinline__ void phase_prep2(Frame& F, int l) {
    KA;
    const bf16* P = (const bf16*)(KWS + WS_P);
    bf16* QS = (bf16*)(KWS + WS_QS); bf16* KS2 = (bf16*)(KWS + WS_KS2); bf16* KW2 = (bf16*)(KWS + WS_KW2);
    const float* qg = KIN(I_QN) + l * 64; const float* kg = KIN(I_KN) + l * 192;
    for (int it = F.gw; it < T * 12; it += F.NGW) {
        const int t = it / 12, v = it % 12;
        const int col = v < 8 ? v * 64 : (v < 10 ? C_KS + (v - 8) * 64 : C_KW + (v - 10) * 64);
        float x = bf2f(P[(size_t)t * NPAD + col + F.lane]);
        const float ss = wave_sum(x * x);
        const float g = v < 8 ? qg[F.lane] * (0.125f * LOG2E) : (v < 10 ? kg[64 + F.lane] : kg[128 + F.lane]);
        x = x * (1.0f / sqrtf(ss * (1.0f / 64.0f) + EPS)) * g;
        bf16* dst = v < 8 ? QS + ((size_t)v * T + t) * 64 : (v < 10 ? KS2 + ((size_t)(v - 8) * T + t) * 64 : KW2 + ((size_t)(v - 10) * T + t) * 64);
        dst[F.lane] = (bf16)f2bf(x);
    }
    LAS bf16* tile = (LAS bf16*)(F.lds + F.wave * 16384);
    for (int it = F.gw; it < 2 * 2 * (T / 64); it += F.NGW) {
        const int kind = it / (2 * (T / 64)), q = it % (2 * (T / 64)), g = q / (T / 64), tb = q % (T / 64);
        const bf16* src = P + (size_t)(tb * 64) * NPAD + (kind == 0 ? C_VS : C_VW) + g * 64;
        bf16* dst = (bf16*)(KWS + (kind == 0 ? WS_VST : WS_VWT)) + (size_t)g * 64 * T + tb * 64;
#pragma unroll 4
        for (int r = 0; r < 64; ++r) tile[r * 66 + F.lane] = src[(size_t)r * NPAD + F.lane];
        WSYNC();
        const int pl = (F.lane & ~15) | perm16(F.lane & 15);
#pragma unroll 4
        for (int d = 0; d < 64; ++d) dst[(size_t)d * T + pl] = tile[F.lane * 66 + d];
        WSYNC();
    }
}

__device__ __forceinline__ void phase_prep3(Frame& F, int l) {
    KA;
    const bf16* P = (const bf16*)(KWS + WS_P);
    bf16* QS = (bf16*)(KWS + WS_QS); bf16* KS2 = (bf16*)(KWS + WS_KS2); bf16* KW2 = (bf16*)(KWS + WS_KW2);
    const float* qg = KIN(I_QN) + l * 64; const float* kg = KIN(I_KN) + l * 192;
    const int vec = F.lane >> 3, part = F.lane & 7;
    for (int t = F.gw; t < T; t += F.NGW) {
#pragma unroll
        for (int pass = 0; pass < 2; ++pass) {
            if (pass == 1 && vec >= 4) continue;
            const int col = pass == 0 ? vec * 64 : (vec < 2 ? C_KS + vec * 64 : C_KW + (vec - 2) * 64);
            const float* gp = pass == 0 ? qg : (vec < 2 ? kg + 64 : kg + 128);
            const float gs = pass == 0 ? 0.125f * LOG2E : 1.0f;
            bf16* dst = pass == 0 ? QS + ((size_t)vec * T + t) * 64 : (vec < 2 ? KS2 + ((size_t)vec * T + t) * 64 : KW2 + ((size_t)(vec - 2) * T + t) * 64);
            const u32x4 raw = *(const u32x4*)(P + (size_t)t * NPAD + col + part * 8);
            float x[8] = {bflo(raw.x), bfhi(raw.x), bflo(raw.y), bfhi(raw.y), bflo(raw.z), bfhi(raw.z), bflo(raw.w), bfhi(raw.w)};
            float ss = 0.f;
#pragma unroll
            for (int e = 0; e < 8; ++e) ss += x[e] * x[e];
            ss += lshx(ss, 1); ss += lshx(ss, 2); ss += lshx(ss, 4);
            const float rstd = gs / sqrtf(ss * (1.0f / 64.0f) + EPS);
            const f32x4 g0 = *(const f32x4*)(gp + part * 8), g1 = *(const f32x4*)(gp + part * 8 + 4);
            u32x4 o; o.x = pk2(x[0] * rstd * g0.x, x[1] * rstd * g0.y); o.y = pk2(x[2] * rstd * g0.z, x[3] * rstd * g0.w); o.z = pk2(x[4] * rstd * g1.x, x[5] * rstd * g1.y); o.w = pk2(x[6] * rstd * g1.z, x[7] * rstd * g1.w);
            *(u32x4*)(dst + part * 8) = o;
        }
    }
    LAS bf16* tile = (LAS bf16*)(F.lds + F.wave * 16384);
    for (int it = F.gw; it < 2 * 2 * (T / 64); it += F.NGW) {
        const int kind = it / (2 * (T / 64)), q = it % (2 * (T / 64)), g = q / (T / 64), tb = q % (T / 64);
        const bf16* src = P + (size_t)(tb * 64) * NPAD + (kind == 0 ? C_VS : C_VW) + g * 64;
        bf16* dst = (bf16*)(KWS + (kind == 0 ? WS_VST : WS_VWT)) + (size_t)g * 64 * T + tb * 64;
#pragma unroll
        for (int i = 0; i < 8; ++i) { const int tok = vec + 8 * i; *(LAS u32x4*)(tile + tok * 72 + part * 8) = *(const u32x4*)(src + (size_t)tok * NPAD + part * 8); }
        WSYNC();
#pragma unroll
        for (int c = 0; c < 8; ++c) { unsigned w[4];
#pragma unroll
            for (int k = 0; k < 4; ++k) { const int p0 = (c & 1) * 8 + 2 * k, p1 = p0 + 1;
                const int k0 = (c >> 1) * 16 + ((p0 & 3) | ((p0 & 4) << 1) | ((p0 & 8) >> 1)), k1 = (c >> 1) * 16 + ((p1 & 3) | ((p1 & 4) << 1) | ((p1 & 8) >> 1));
                w[k] = (unsigned)tile[k0 * 72 + F.lane] | ((unsigned)tile[k1 * 72 + F.lane] << 16); }
            *(u32x4*)(dst + (size_t)F.lane * T + c * 8) = (u32x4){w[0], w[1], w[2], w[3]}; }
        WSYNC();
    }
}

__device__ __forceinline__ void phase_compress2(Frame& F, int l) {
    KA;
    LAS float* av = (LAS float*)(F.lds + F.wave * 16384);
    const bf16* P = (const bf16*)(KWS + WS_P);
    bf16* KCB = (bf16*)(KWS + WS_KCB); bf16* VCT = (bf16*)(KWS + WS_KCB + 131072);
    for (int it = F.gw; it < 2 * 2 * 512; it += F.NGW) {
        const int kind = it >> 10, g = (it >> 9) & 1, n = it & 511;
        if (n == 511) { if (kind == 0) KCB[((size_t)g * 512 + 511) * 64 + F.lane] = 0; else VCT[((size_t)g * 64 + F.lane) * 512 + 511] = 0; continue; }
        const bf16* src = P + (size_t)(16 * n) * NPAD + (kind == 0 ? C_KC : C_VC) + g * 64;
        const float* pe = KIN(I_PE) + ((size_t)l * 2 + kind) * 2048;
        const float* w1 = KIN(I_W1) + ((size_t)l * 2 + kind) * 2048 * 64;
        const float* w2 = KIN(I_W2) + ((size_t)l * 2 + kind) * 64 * 64;
#pragma unroll 4
        for (int c = 0; c < 32; ++c) av[c * 64 + F.lane] = bf2f(src[(size_t)c * NPAD + F.lane]) + pe[c * 64 + F.lane];
        WSYNC();
        float acc = 0.f;
#pragma unroll 8
        for (int i = 0; i < 2048; ++i) acc += av[i] * w1[i * 64 + F.lane];
        const float hid = gelu_tanh(acc);
        WSYNC();
        av[F.lane] = hid;
        WSYNC();
        float o = 0.f;
#pragma unroll 8
        for (int i = 0; i < 64; ++i) o += av[i] * w2[i * 64 + F.lane];
        WSYNC();
        if (kind == 0) { const float ss = wave_sum(o * o); o = o * (1.0f / sqrtf(ss * (1.0f / 64.0f) + EPS)) * KIN(I_KN)[l * 192 + F.lane]; KCB[((size_t)g * 512 + n) * 64 + F.lane] = (bf16)f2bf(o); }
        else VCT[((size_t)g * 64 + F.lane) * 512 + ((n & ~15) | perm16(n & 15))] = (bf16)f2bf(o);
    }
}

__device__ __forceinline__ void phase_compress3(Frame& F, int l) {
    KA;
    const bf16* P = (const bf16*)(KWS + WS_P);
    bf16* KCB = (bf16*)(KWS + WS_KCB); bf16* VCT = (bf16*)(KWS + WS_KCB + 131072);
    LAS float* red = (LAS float*)F.lds;
    LAS bf16* hid = (LAS bf16*)(F.lds + 32768);
    const int r16 = F.lane & 15, kq = F.lane >> 4;
    for (int unit = F.bid; unit < 128; unit += F.G) {
        const int kind = unit >> 6, mt = unit & 63, g = mt >> 5, n0 = (mt & 31) * 16;
        const bf16* W1T = (const bf16*)(KWS + WS_CW) + (size_t)(l * 2 + kind) * 64 * 2048; const bf16* W2T = (const bf16*)(KWS + WS_CW + 1048576) + (size_t)(l * 2 + kind) * 4096;
        const float* B1 = (const float*)(KWS + WS_CW + 1572864) + (l * 2 + kind) * 64;
        const bf16* arow = P + (size_t)(16 * (n0 + r16)) * NPAD + (kind == 0 ? C_KC : C_VC) + g * 64;
        f32x4 acc[4];
#pragma unroll
        for (int nt = 0; nt < 4; ++nt) acc[nt] = (f32x4){0.f, 0.f, 0.f, 0.f};
#pragma unroll 2
        for (int ks = 0; ks < 8; ++ks) { const int c0 = F.wave * 256 + 32 * ks + 8 * kq;
            const bf16x8 a = *(const bf16x8*)(arow + (size_t)(c0 >> 6) * NPAD + (c0 & 63));
#pragma unroll
            for (int nt = 0; nt < 4; ++nt) { const bf16x8 b = *(const bf16x8*)(W1T + (size_t)(16 * nt + r16) * 2048 + c0); acc[nt] = __builtin_amdgcn_mfma_f32_16x16x32_bf16(a, b, acc[nt], 0, 0, 0); } }
#pragma unroll
        for (int nt = 0; nt < 4; ++nt) *(LAS f32x4*)(red + ((F.wave * 4 + nt) * 64 + F.lane) * 4) = acc[nt];
        __syncthreads();
        if (F.tid < 256) { const int nt = F.tid >> 6, ln = F.tid & 63; f32x4 v = {0.f, 0.f, 0.f, 0.f};
#pragma unroll
            for (int w = 0; w < 8; ++w) v += *(const LAS f32x4*)(red + ((w * 4 + nt) * 64 + ln) * 4);
            const int col = 16 * nt + (ln & 15); const float b1 = B1[col];
#pragma unroll
            for (int i = 0; i < 4; ++i) hid[(4 * (ln >> 4) + i) * 72 + col] = (bf16)f2bf(gelu_tanh(v[i] + b1)); }
        __syncthreads();
        if (F.wave == 0) {
            f32x4 o[4];
#pragma unroll
            for (int nt = 0; nt < 4; ++nt) o[nt] = (f32x4){0.f, 0.f, 0.f, 0.f};
#pragma unroll
            for (int ks = 0; ks < 2; ++ks) { const bf16x8 a = *(const LAS bf16x8*)(hid + r16 * 72 + 32 * ks + 8 * kq);
#pragma unroll
                for (int nt = 0; nt < 4; ++nt) { const bf16x8 b = *(const bf16x8*)(W2T + (16 * nt + r16) * 64 + 32 * ks + 8 * kq); o[nt] = __builtin_amdgcn_mfma_f32_16x16x32_bf16(a, b, o[nt], 0, 0, 0); } }
            if (kind == 0) {
#pragma unroll
                for (int i = 0; i < 4; ++i) { float ss = o[0][i] * o[0][i] + o[1][i] * o[1][i] + o[2][i] * o[2][i] + o[3][i] * o[3][i];
                    ss += lshx(ss, 1); ss += lshx(ss, 2); ss += lshx(ss, 4); ss += lshx(ss, 8);
                    const float rstd = 1.0f / sqrtf(ss * (1.0f / 64.0f) + EPS); const int n = n0 + 4 * kq + i;
#pragma unroll
                    for (int nt = 0; nt < 4; ++nt) { const int col = 16 * nt + r16; KCB[((size_t)g * 512 + n) * 64 + col] = n < 511 ? (bf16)f2bf(o[nt][i] * rstd * KIN(I_KN)[l * 192 + col]) : (bf16)0; } }
            } else {
#pragma unroll
                for (int i = 0; i < 4; ++i) { const int n = n0 + 4 * kq + i;
#pragma unroll
                    for (int nt = 0; nt < 4; ++nt) { const int col = 16 * nt + r16; VCT[((size_t)g * 64 + col) * 512 + ((n & ~15) | perm16(n & 15))] = n < 511 ? (bf16)f2bf(o[nt][i]) : (bf16)0; } }
            }
        }
        __syncthreads();
    }
}

constexpr int NSA_SCA = 65536, NSA_SCB = 99328;
constexpr int NSA_QM = 133120, NSA_UM = 134144;
static_assert(NSA_UM + 16 <= MISC_OFF, "NSA LDS map");
__device__ __forceinline__ int next_set(unsigned long long m0, unsigned long long m1, int from) {
    if (from < 64) { const unsigned long long x = m0 & (~0ull << from); if (x) return __builtin_ctzll(x); from = 64; }
    if (from < 128) { const unsigned long long x = m1 & (~0ull << (from - 64)); if (x) return 64 + __builtin_ctzll(x); }
    return 128;
}
__device__ __forceinline__ void nsa_issue(LAS unsigned char* lds, int slot, const bf16* Kg, const bf16* VTg, int vt_len, int j, int tid, int wave) {
    const int row = tid >> 3, c = (tid & 7) ^ ((row >> 1) & 7);
    __builtin_amdgcn_global_load_lds((const unsigned*)(Kg + (size_t)(64 * j + row) * 64 + c * 8), (LAS unsigned*)(lds + slot * 16384 + wave * 1024), 16, 0, 0);
    __builtin_amdgcn_global_load_lds((const unsigned*)(VTg + (size_t)row * vt_len + 64 * j + c * 8), (LAS unsigned*)(lds + slot * 16384 + 8192 + wave * 1024), 16, 0, 0);
}
template <int MODE> __device__ __forceinline__ void nsa_branch(Frame& F, const bf16* Kg, const bf16* VTg, int vt_len, unsigned long long m0, unsigned long long m1,
        const bf16x8 (&Qf)[4], int t, int cblk, u32x4 qxw, int tref, float inv_l, const unsigned (&qsel)[4], int hi_cmp, unsigned wm_lo_dummy, f32x16 (&oacc)[2], float& lsum) {
    LAS unsigned char* lds = F.lds;
    const int lane = F.lane, c32 = lane & 31, h = lane >> 5, tid = F.tid;
    const int sw = (c32 >> 1) & 7;
    int j0 = next_set(m0, m1, 0);
    if (j0 >= 128) return;
    int j1 = next_set(m0, m1, j0 + 1), j2 = j1 < 128 ? next_set(m0, m1, j1 + 1) : 128;
    nsa_issue(lds, 0, Kg, VTg, vt_len, j0, tid, F.wave);
    if (j1 < 128) nsa_issue(lds, 1, Kg, VTg, vt_len, j1, tid, F.wave);
    if (j2 < 128) nsa_issue(lds, 2, Kg, VTg, vt_len, j2, tid, F.wave);
    int slot = 0;
    while (j0 < 128) {
        const int j = j0;
        if (j2 < 128) asm volatile("s_waitcnt vmcnt(4)" ::: "memory"); else if (j1 < 128) asm volatile("s_waitcnt vmcnt(2)" ::: "memory"); else asm volatile("s_waitcnt vmcnt(0)" ::: "memory");
        __builtin_amdgcn_s_barrier(); asm volatile("" ::: "memory");
        const int j3 = j2 < 128 ? next_set(m0, m1, j2 + 1) : 128;
        if (j3 < 128) nsa_issue(lds, (slot + 3) & 3, Kg, VTg, vt_len, j3, tid, F.wave);
        bool need = true;
        if (MODE == 2) { const unsigned myw = j < 32 ? qsel[0] : (j < 64 ? qsel[1] : (j < 96 ? qsel[2] : qsel[3])); need = __any((myw >> (j & 31)) & 1u); }
        if (need) {
            const int kb = slot * 16384, vb = slot * 16384 + 8192;
            const int kbase = 64 * j;
            u32x4 qx = qxw;
            if (MODE == 2) { const unsigned myw = j < 32 ? qsel[0] : (j < 64 ? qsel[1] : (j < 96 ? qsel[2] : qsel[3])); if (!((myw >> (j & 31)) & 1u) && h == 0) qx.z = 0xF149u; }
            const bf16x8 qxf = __builtin_bit_cast(bf16x8, qx);
            f32x16 sacc[2];
#pragma unroll
            for (int sub = 0; sub < 2; ++sub)
#pragma unroll
                for (int i = 0; i < 16; ++i) sacc[sub][i] = 0.f;
#pragma unroll
            for (int sub = 0; sub < 2; ++sub) {
#pragma unroll
                for (int kp = 0; kp < 2; ++kp) { bf16x8 ka2[2];
#pragma unroll
                    for (int k2 = 0; k2 < 2; ++k2) ka2[k2] = *(const LAS bf16x8*)(lds + kb + (32 * sub + c32) * 128 + (((2 * (2 * kp + k2) + h) ^ sw) * 16));
                    asm volatile("" ::: "memory");
#pragma unroll
                    for (int k2 = 0; k2 < 2; ++k2) sacc[sub] = __builtin_amdgcn_mfma_f32_32x32x16_bf16(ka2[k2], Qf[2 * kp + k2], sacc[sub], 0, 0, 0);
                    asm volatile("" ::: "memory"); }
                { const int kidx = kbase + 32 * sub + c32, pos = MODE < 2 ? 16 * kidx + 31 : kidx, dd = tref - pos;
                  const unsigned w = pkbf(-(float)((dd >> 8) * 256), -(float)(dd & 255));
                  u32x4 kx; kx.x = h == 0 ? w : 0u; kx.y = kx.x; kx.z = h == 0 ? 0x3F80u : 0u; kx.w = 0u;
                  sacc[sub] = __builtin_amdgcn_mfma_f32_32x32x16_bf16(__builtin_bit_cast(bf16x8, kx), qxf, sacc[sub], 0, 0, 0); } }
#pragma unroll
            for (int sub = 0; sub < 2; ++sub)
#pragma unroll
                for (int i = 0; i < 16; ++i) sacc[sub][i] = __builtin_amdgcn_exp2f(sacc[sub][i]);
            bool mhi = false, mlo = false; int hi = 0, lo = 0;
            if (MODE < 2) { mhi = (kbase + 63 > (tref - 63 - 31) / 16 - 1); hi = hi_cmp; }
            if (MODE == 2) { mhi = (j == cblk); hi = t; }
            if (MODE == 3) { mhi = (j == cblk); hi = t; mlo = (j == cblk - 8); lo = t - 511; }
            if (mhi || mlo) {
#pragma unroll
                for (int sub = 0; sub < 2; ++sub)
#pragma unroll
                    for (int i = 0; i < 16; ++i) { const int idx = kbase + 4 * h + 32 * sub + (i & 3) + 8 * (i >> 2); if ((mhi && idx > hi) || (mlo && idx < lo)) sacc[sub][i] = 0.f; }
            }
            float ls = 0.f;
#pragma unroll
            for (int sub = 0; sub < 2; ++sub)
#pragma unroll
                for (int i = 0; i < 16; ++i) ls += sacc[sub][i];
            lsum += ls;
            if (MODE == 1) {
                LAS float* scA = (LAS float*)(lds + NSA_SCA); LAS float* scB = (LAS float*)(lds + NSA_SCB);
                const int q = F.wave * 8 + (c32 >> 2);
#pragma unroll
                for (int sub = 0; sub < 2; ++sub)
#pragma unroll
                    for (int g4 = 0; g4 < 4; ++g4) { float x[4];
#pragma unroll
                        for (int e = 0; e < 4; ++e) { float v = sacc[sub][4 * g4 + e] * inv_l;
                            v += __builtin_bit_cast(float, __builtin_amdgcn_mov_dpp(__builtin_bit_cast(int, v), 0xB1, 0xF, 0xF, true));
                            v += __builtin_bit_cast(float, __builtin_amdgcn_mov_dpp(__builtin_bit_cast(int, v), 0x4E, 0xF, 0xF, true));
                            x[e] = v; }
                        const int jb = 16 * j + 8 * sub + 2 * g4 + h;
                        if ((c32 & 3) == 0) { scA[q * 132 + jb] = 2.0f * (x[0] + x[1] + x[2]) + x[3]; scB[q * 132 + jb + 1] = x[3]; } }
            }
            if (MODE != 0) {
                bf16x8 pf[2][2];
#pragma unroll
                for (int sub = 0; sub < 2; ++sub)
#pragma unroll
                    for (int s2 = 0; s2 < 2; ++s2) { u32x4 w; w.x = pkbf(sacc[sub][8 * s2], sacc[sub][8 * s2 + 1]); w.y = pkbf(sacc[sub][8 * s2 + 2], sacc[sub][8 * s2 + 3]); w.z = pkbf(sacc[sub][8 * s2 + 4], sacc[sub][8 * s2 + 5]); w.w = pkbf(sacc[sub][8 * s2 + 6], sacc[sub][8 * s2 + 7]);
                        pf[sub][s2] = __builtin_bit_cast(bf16x8, w); }
                asm volatile("" ::: "memory");
#pragma unroll
                for (int ds = 0; ds < 2; ++ds) {
#pragma unroll
                    for (int qp = 0; qp < 2; ++qp) { bf16x8 va2[2];
#pragma unroll
                        for (int k2 = 0; k2 < 2; ++k2) va2[k2] = *(const LAS bf16x8*)(lds + vb + (32 * ds + c32) * 128 + (((2 * (2 * qp + k2) + h) ^ sw) * 16));
                        asm volatile("" ::: "memory");
#pragma unroll
                        for (int k2 = 0; k2 < 2; ++k2) oacc[ds] = __builtin_amdgcn_mfma_f32_32x32x16_bf16(va2[k2], pf[qp][k2], oacc[ds], 0, 0, 0);
                        asm volatile("" ::: "memory"); } }
            }
        }
        j0 = j1; j1 = j2; j2 = j3; slot = (slot + 1) & 3;
    }
    asm volatile("s_waitcnt lgkmcnt(0)" ::: "memory"); __builtin_amdgcn_s_barrier(); asm volatile("" ::: "memory");
}
__device__ __forceinline__ void nsa_stash_put(LAS unsigned char* lds, int wave, int lane, const f32x16 (&o)[2], float sc) {
    LAS unsigned* st = (LAS unsigned*)(lds + NSA_SCA) + wave * 1024 + lane;
#pragma unroll
    for (int ds = 0; ds < 2; ++ds)
#pragma unroll
        for (int k = 0; k < 8; ++k) st[(ds * 8 + k) * 64] = pkbf(o[ds][2 * k] * sc, o[ds][2 * k + 1] * sc);
}
#define PSTAMP(slot) do { if (MK_PROBE_MASK != 0 && F.bid == MK_PROBE_BID && F.tid == 0) { volatile LAS unsigned long long* _ta = (volatile LAS unsigned long long*)(F.lds + MISC_OFF + 512); const unsigned long long _n = wall_clock64(); _ta[slot] += _n - _ta[16]; _ta[16] = _n; } } while (0)
__device__ __forceinline__ void phase_nsa2(Frame& F, int l) {
    KA;
    LAS unsigned char* lds = F.lds;
    const bf16* P = (const bf16*)(KWS + WS_P); bf16* OCAT = (bf16*)(KWS + WS_OCAT);
    const bf16* QS = (const bf16*)(KWS + WS_QS);
    const int lane = F.lane, c32 = lane & 31, h = lane >> 5, q8 = c32 >> 2, r = c32 & 3;
    for (int unit = F.bid; unit < 256; unit += F.G) {
        const int g = unit & 1, cblk = unit >> 1, t0 = cblk * 64, head = g * 4 + r, t = t0 + F.wave * 8 + q8;
        u32x4 qxw;
        { const float s2 = exp2f(-(float)(head + 1)) * LOG2E; const unsigned sh = f2bf(s2); const float rem = s2 - bf2f(sh); const unsigned sl = f2bf(rem);
          qxw.x = h == 0 ? (sh | (sh << 16)) : 0u; qxw.y = h == 0 ? (sl | (sl << 16)) : 0u; qxw.z = 0u; qxw.w = 0u; }
        const int tref = t0 + 63;
        bf16x8 Qf[4];
#pragma unroll
        for (int ks = 0; ks < 4; ++ks) Qf[ks] = *(const bf16x8*)(QS + ((size_t)head * T + t) * 64 + 16 * ks + 8 * h);
        for (int u = F.tid; u < (NSA_UM + 16 - NSA_SCA) / 4; u += 512) ((LAS unsigned*)(lds + NSA_SCA))[u] = 0u;
        __syncthreads();
        f32x16 oacc[2];
#pragma unroll
        for (int ds = 0; ds < 2; ++ds)
#pragma unroll
            for (int i = 0; i < 16; ++i) oacc[ds][i] = 0.f;
        unsigned qsel[4] = {0u, 0u, 0u, 0u};
        float sc_cmp;
        PSTAMP(24);
        {
            const int ntile = (4 * cblk + 2) / 64 + 1;
            const unsigned long long cm0 = ntile >= 64 ? ~0ull : ((1ull << ntile) - 1ull);
            const int hi_cmp = t >= 31 ? (t - 31) / 16 : -1;
            const bf16* Kg = (const bf16*)(KWS + WS_KCB) + (size_t)g * 512 * 64; const bf16* VTg = (const bf16*)(KWS + WS_KCB + 131072) + (size_t)g * 64 * 512;
            float l1 = 0.f;
            nsa_branch<0>(F, Kg, VTg, 512, cm0, 0ull, Qf, t, cblk, qxw, tref, 0.f, qsel, hi_cmp, 0u, oacc, l1);
            l1 += lshx(l1, 32);
            const float inv_l = l1 > 0.f ? 1.0f / l1 : 0.f;
            float l2 = 0.f;
            nsa_branch<1>(F, Kg, VTg, 512, cm0, 0ull, Qf, t, cblk, qxw, tref, inv_l, qsel, hi_cmp, 0u, oacc, l2);
            sc_cmp = sigmoidf_(bf2f(P[(size_t)t * NPAD + C_NG + head])) * inv_l;
        }
        PSTAMP(20);
        {
            LAS float* scA = (LAS float*)(lds + NSA_SCA); LAS float* scB = (LAS float*)(lds + NSA_SCB);
            LAS unsigned* qm = (LAS unsigned*)(lds + NSA_QM); LAS unsigned* um = (LAS unsigned*)(lds + NSA_UM);
            WSYNC();
            const int qq = F.wave * 8 + (lane >> 3), jj = lane & 7;
            unsigned key[16];
#pragma unroll
            for (int m = 0; m < 16; ++m) { const int jb = jj + 8 * m; float sv = scA[qq * 132 + jb] + scB[qq * 132 + jb];
                if (jb == 0 || jb == cblk || jb == cblk - 1) sv = 1e4f;
                key[m] = jb <= cblk ? ((__builtin_bit_cast(unsigned, sv) & ~127u) | (unsigned)(127 - jb)) : 0u; }
            WSYNC();
#pragma unroll
            for (int m = 0; m < 16; ++m) ((LAS unsigned*)scA)[qq * 132 + jj + 8 * m] = key[m];
            WSYNC();
            unsigned bits[4] = {0u, 0u, 0u, 0u};
#pragma unroll
            for (int half = 0; half < 2; ++half) { int rank[8];
#pragma unroll
                for (int m = 0; m < 8; ++m) rank[m] = 0;
#pragma unroll 2
                for (int i = 0; i <= cblk; i += 4) { const u32x4 k4 = *(const LAS u32x4*)((const LAS unsigned*)scA + qq * 132 + i);
#pragma unroll
                    for (int m = 0; m < 8; ++m) rank[m] += (k4.x > key[8 * half + m] ? 1 : 0) + (k4.y > key[8 * half + m] ? 1 : 0) + (k4.z > key[8 * half + m] ? 1 : 0) + (k4.w > key[8 * half + m] ? 1 : 0); }
#pragma unroll
                for (int m = 0; m < 8; ++m) { const int jb = jj + 8 * (8 * half + m); if (jb <= cblk && rank[m] < 16) bits[(8 * half + m) >> 2] |= 1u << (jb & 31); } }
#pragma unroll
            for (int w = 0; w < 4; ++w) if (bits[w]) { atomicOr((unsigned*)(qm + qq * 4 + w), bits[w]); atomicOr((unsigned*)(um + w), bits[w]); }
            __syncthreads();
#pragma unroll
            for (int w = 0; w < 4; ++w) qsel[w] = qm[(F.wave * 8 + q8) * 4 + w];
        }
        PSTAMP(21);
        nsa_stash_put(lds, F.wave, lane, oacc, sc_cmp);
#pragma unroll
        for (int ds = 0; ds < 2; ++ds)
#pragma unroll
            for (int i = 0; i < 16; ++i) oacc[ds][i] = 0.f;
        {
            LAS unsigned* um = (LAS unsigned*)(lds + NSA_UM);
            const unsigned long long sm0 = (unsigned long long)__builtin_amdgcn_readfirstlane(um[0]) | ((unsigned long long)__builtin_amdgcn_readfirstlane(um[1]) << 32);
            const unsigned long long sm1 = (unsigned long long)__builtin_amdgcn_readfirstlane(um[2]) | ((unsigned long long)__builtin_amdgcn_readfirstlane(um[3]) << 32);
            float ls = 0.f;
            nsa_branch<2>(F, (const bf16*)(KWS + WS_KS2) + (size_t)g * T * 64, (const bf16*)(KWS + WS_VST) + (size_t)g * 64 * T, T, sm0, sm1, Qf, t, cblk, qxw, tref, 0.f, qsel, 0, 0u, oacc, ls);
            ls += lshx(ls, 32);
            const float sc = sigmoidf_(bf2f(P[(size_t)t * NPAD + C_NG + 8 + head])) / ls;
            LAS unsigned* st = (LAS unsigned*)(lds + NSA_SCA) + F.wave * 1024 + lane;
#pragma unroll
            for (int ds = 0; ds < 2; ++ds)
#pragma unroll
                for (int k = 0; k < 8; ++k) { const unsigned w = st[(ds * 8 + k) * 64]; st[(ds * 8 + k) * 64] = pkbf(bflo(w) + sc * oacc[ds][2 * k], bfhi(w) + sc * oacc[ds][2 * k + 1]); oacc[ds][2 * k] = 0.f; oacc[ds][2 * k + 1] = 0.f; }
        }
        PSTAMP(22);
        {
            const int j0 = cblk >= 8 ? cblk - 8 : 0;
            unsigned long long wm0 = 0ull, wm1 = 0ull;
            for (int jb = j0; jb <= cblk; ++jb) { if (jb < 64) wm0 |= 1ull << jb; else wm1 |= 1ull << (jb - 64); }
            float ls = 0.f;
            nsa_branch<3>(F, (const bf16*)(KWS + WS_KW2) + (size_t)g * T * 64, (const bf16*)(KWS + WS_VWT) + (size_t)g * 64 * T, T, wm0, wm1, Qf, t, cblk, qxw, tref, 0.f, qsel, 0, 0u, oacc, ls);
            ls += lshx(ls, 32);
            const float sc = sigmoidf_(bf2f(P[(size_t)t * NPAD + C_NG + 16 + head])) / ls;
            const LAS unsigned* st = (const LAS unsigned*)(lds + NSA_SCA) + F.wave * 1024 + lane;
#pragma unroll
            for (int ds = 0; ds < 2; ++ds)
#pragma unroll
                for (int g4 = 0; g4 < 4; ++g4) { const unsigned w0 = st[(ds * 8 + 2 * g4) * 64], w1 = st[(ds * 8 + 2 * g4 + 1) * 64];
                    u32x2 w; w.x = pkbf(bflo(w0) + sc * oacc[ds][4 * g4], bfhi(w0) + sc * oacc[ds][4 * g4 + 1]); w.y = pkbf(bflo(w1) + sc * oacc[ds][4 * g4 + 2], bfhi(w1) + sc * oacc[ds][4 * g4 + 3]);
                    *(u32x2*)(OCAT + (size_t)t * 1536 + head * 64 + 32 * ds + 8 * g4 + 4 * h) = w; }
        }
        __syncthreads();
        PSTAMP(23);
    }
}

__device__ __forceinline__ void phase_merge(Frame& F) {
    KA;
    const bf16* P = (const bf16*)(KWS + WS_P); const bf16* PROJ = (const bf16*)(KWS + WS_PROJ); bf16* MG = (bf16*)(KWS + WS_MERGED);
    const size_t total = (size_t)T * D / 8;
    for (size_t it = (size_t)F.gw * 64 + F.lane; it < total; it += (size_t)F.NGW * 64) {
        const size_t t = it / (D / 8); const int d = (int)(it % (D / 8)) * 8;
        float acc[8];
#pragma unroll
        for (int k = 0; k < 8; ++k) acc[k] = 0.f;
#pragma unroll
        for (int n = 0; n < 3; ++n) { const u32x4 gq = *(const u32x4*)(P + t * NPAD + C_MG + n * D + d); const u32x4 pq = *(const u32x4*)(PROJ + ((size_t)n * T + t) * D + d);
            acc[0] += sigmoidf_(bflo(gq.x)) * bflo(pq.x); acc[1] += sigmoidf_(bfhi(gq.x)) * bfhi(pq.x); acc[2] += sigmoidf_(bflo(gq.y)) * bflo(pq.y); acc[3] += sigmoidf_(bfhi(gq.y)) * bfhi(pq.y);
            acc[4] += sigmoidf_(bflo(gq.z)) * bflo(pq.z); acc[5] += sigmoidf_(bfhi(gq.z)) * bfhi(pq.z); acc[6] += sigmoidf_(bflo(gq.w)) * bflo(pq.w); acc[7] += sigmoidf_(bfhi(gq.w)) * bfhi(pq.w); }
        u32x4 o; o.x = pk2(acc[0], acc[1]); o.y = pk2(acc[2], acc[3]); o.z = pk2(acc[4], acc[5]); o.w = pk2(acc[6], acc[7]);
        *(u32x4*)(MG + t * D + d) = o;
    }
}
__device__ __forceinline__ void phase_router(Frame& F, int l) {
    KA;
    const float* X1 = (const float*)(KWS + WS_X1); bf16* H = (bf16*)(KWS + WS_H);
    int* EID = (int*)(KWS + WS_ROUTE); float* EW = (float*)(KWS + WS_ROUTE + 65536);
    const float* gain = KIN(I_NFFN) + (size_t)l * D; const float* wg = KIN(I_WGRP) + (size_t)l * D * 4; const float* we = KIN(I_WEXP) + (size_t)l * D * 32;
    const float* bg = KIN(I_BGRP) + l * 4; const float* be = KIN(I_BEXP) + l * 32;
    for (int t = F.gw; t < T; t += F.NGW) {
        const float* xrow = X1 + (size_t)t * D;
        float ss = 0.f;
#pragma unroll 4
        for (int k = 0; k < 32; ++k) { const float x = xrow[F.lane + 64 * k]; ss += x * x; }
        const float rstd = 1.0f / sqrtf(wave_sum(ss) * (1.0f / D) + EPS);
        float ag[4] = {0.f, 0.f, 0.f, 0.f}, ae[32];
#pragma unroll
        for (int e = 0; e < 32; ++e) ae[e] = 0.f;
#pragma unroll 1
        for (int k = 0; k < 32; ++k) { const int d = F.lane + 64 * k;
            const float hv = xrow[d] * rstd * gain[d];
            H[(size_t)t * D + d] = (bf16)f2bf(hv);
            const f32x4 w4 = *(const f32x4*)(wg + (size_t)d * 4);
            ag[0] += hv * w4.x; ag[1] += hv * w4.y; ag[2] += hv * w4.z; ag[3] += hv * w4.w;
#pragma unroll
            for (int c = 0; c < 8; ++c) { const f32x4 w = *(const f32x4*)(we + (size_t)d * 32 + c * 4); ae[c * 4] += hv * w.x; ae[c * 4 + 1] += hv * w.y; ae[c * 4 + 2] += hv * w.z; ae[c * 4 + 3] += hv * w.w; } }
#pragma unroll
        for (int e = 0; e < 4; ++e) ag[e] = wave_sum(ag[e]) + bg[e];
#pragma unroll
        for (int e = 0; e < 32; ++e) ae[e] = wave_sum(ae[e]) + be[e];
        int gi = 0; float gm = ag[0];
#pragma unroll
        for (int e = 1; e < 4; ++e) if (ag[e] > gm) { gm = ag[e]; gi = e; }
        float gs = 0.f;
#pragma unroll
        for (int e = 0; e < 4; ++e) gs += expf(ag[e] - gm);
        const float gw_ = 1.0f / gs;
        float el[8];
#pragma unroll
        for (int e = 0; e < 8; ++e) { el[e] = gi == 0 ? ae[e] : (gi == 1 ? ae[8 + e] : (gi == 2 ? ae[16 + e] : ae[24 + e])); }
        int i1 = 0; float m1 = el[0];
#pragma unroll
        for (int e = 1; e < 8; ++e) if (el[e] > m1) { m1 = el[e]; i1 = e; }
        int i2 = -1; float m2 = -3.0e38f;
#pragma unroll
        for (int e = 0; e < 8; ++e) if (e != i1 && el[e] > m2) { m2 = el[e]; i2 = e; }
        const float p2 = expf(m2 - m1);
        const float w1 = 1.0f / (1.0f + p2), w2 = p2 / (1.0f + p2);
        if (F.lane == 0) { EID[2 * t] = gi * 8 + i1; EID[2 * t + 1] = gi * 8 + i2; EW[2 * t] = gw_ * w1; EW[2 * t + 1] = gw_ * w2; }
    }
}

__device__ __forceinline__ void phase_router3(Frame& F, int l) {
    KA;
    const float* X1 = (const float*)(KWS + WS_X1); unsigned char* H8 = (unsigned char*)(KWS + WS_H8);
    int* EID = (int*)(KWS + WS_ROUTE); float* EW = (float*)(KWS + WS_ROUTE + 65536); float* RSTD = (float*)(KWS + WS_RSTD);
    unsigned* CNTg = (unsigned*)(KWS + WS_CTL) + CW_CNT + 64 * l; int* LIST = (int*)(KWS + WS_ROUTE + 262144);
    const float* WRT = (const float*)(KWS + WS_WRT) + (size_t)l * 48 * D;
    const float* gain = KIN(I_NFFN) + (size_t)l * D; const float* bg = KIN(I_BGRP) + l * 4; const float* be = KIN(I_BEXP) + l * 32;
    LAS float* red = (LAS float*)F.lds;
    LAS float* ssq = (LAS float*)(F.lds + 49152);
    LAS float* lg = (LAS float*)(F.lds + 50176);
    LAS float* rs = (LAS float*)(F.lds + 55296);
    LAS int* eidl = (LAS int*)(F.lds + 55424);
    const int r16 = F.lane & 15, kq = F.lane >> 4;
    for (int blk = F.bid; blk < T / 32; blk += F.G) {
        const int tok0 = blk * 32, kb0 = F.wave * 256 + 4 * kq;
        const float* xa = X1 + (size_t)(tok0 + r16) * D + kb0;
        const float* wb = WRT + (size_t)r16 * D + kb0;
        unsigned char* hp = H8 + (size_t)(tok0 + r16) * D + kb0;
        f32x4 acc[2][3]; float sq[2] = {0.f, 0.f};
#pragma unroll
        for (int tg = 0; tg < 2; ++tg)
#pragma unroll
            for (int nt = 0; nt < 3; ++nt) acc[tg][nt] = (f32x4){0.f, 0.f, 0.f, 0.f};
#pragma unroll 2
        for (int s = 0; s < 16; ++s) { f32x4 a[2], b[3];
#pragma unroll
            for (int tg = 0; tg < 2; ++tg) a[tg] = *(const f32x4*)(xa + (size_t)(16 * tg) * D + 16 * s);
#pragma unroll
            for (int nt = 0; nt < 3; ++nt) b[nt] = *(const f32x4*)(wb + (size_t)(16 * nt) * D + 16 * s);
            const f32x4 g = *(const f32x4*)(gain + kb0 + 16 * s);
#pragma unroll
            for (int tg = 0; tg < 2; ++tg) { sq[tg] += a[tg].x * a[tg].x + a[tg].y * a[tg].y + a[tg].z * a[tg].z + a[tg].w * a[tg].w;
                *(unsigned*)(hp + (size_t)(16 * tg) * D + 16 * s) = pk4_fp8(a[tg].x * g.x * S_A1, a[tg].y * g.y * S_A1, a[tg].z * g.z * S_A1, a[tg].w * g.w * S_A1);
#pragma unroll
                for (int j = 0; j < 4; ++j)
#pragma unroll
                    for (int nt = 0; nt < 3; ++nt) acc[tg][nt] = __builtin_amdgcn_mfma_f32_16x16x4f32(a[tg][j], b[nt][j], acc[tg][nt], 0, 0, 0); } }
#pragma unroll
        for (int tg = 0; tg < 2; ++tg) { sq[tg] += lshx(sq[tg], 16); sq[tg] += lshx(sq[tg], 32);
            if (kq == 0) ssq[F.wave * 32 + 16 * tg + r16] = sq[tg];
#pragma unroll
            for (int nt = 0; nt < 3; ++nt) *(LAS f32x4*)(red + (((F.wave * 2 + tg) * 3 + nt) * 64 + F.lane) * 4) = acc[tg][nt]; }
        __syncthreads();
        if (F.tid < 384) { const int tg2 = F.tid / 192, rem = F.tid % 192, nt = rem / 64, ln = rem % 64; f32x4 v = {0.f, 0.f, 0.f, 0.f};
#pragma unroll
            for (int w = 0; w < 8; ++w) v += *(const LAS f32x4*)(red + (((w * 2 + tg2) * 3 + nt) * 64 + ln) * 4);
            const int col = 16 * nt + (ln & 15);
            if (col < 36) {
#pragma unroll
                for (int i = 0; i < 4; ++i) lg[(16 * tg2 + 4 * (ln >> 4) + i) * 40 + col] = v[i]; } }
        if (F.tid >= 384 && F.tid < 416) { const int tk = F.tid - 384; float q2 = 0.f;
#pragma unroll
            for (int w = 0; w < 8; ++w) q2 += ssq[w * 32 + tk];
            const float r = 1.0f / sqrtf(q2 * (1.0f / D) + EPS); rs[tk] = r; RSTD[tok0 + tk] = r; }
        __syncthreads();
        if (F.tid < 32) { const int tk = F.tid, t = tok0 + tk; const float rstd = rs[tk];
            float ag[4], el[8];
#pragma unroll
            for (int e = 0; e < 4; ++e) ag[e] = lg[tk * 40 + 32 + e] * rstd + bg[e];
            int gi = 0; float gm = ag[0];
#pragma unroll
            for (int e = 1; e < 4; ++e) if (ag[e] > gm) { gm = ag[e]; gi = e; }
            float gs = 0.f;
#pragma unroll
            for (int e = 0; e < 4; ++e) gs += expf(ag[e] - gm);
            const float gw_ = 1.0f / gs;
#pragma unroll
            for (int e = 0; e < 8; ++e) el[e] = lg[tk * 40 + gi * 8 + e] * rstd + be[gi * 8 + e];
            int i1 = 0; float m1 = el[0];
#pragma unroll
            for (int e = 1; e < 8; ++e) if (el[e] > m1) { m1 = el[e]; i1 = e; }
            int i2 = -1; float m2 = -3.0e38f;
#pragma unroll
            for (int e = 0; e < 8; ++e) if (e != i1 && el[e] > m2) { m2 = el[e]; i2 = e; }
            const float p2 = expf(m2 - m1), w1 = 1.0f / (1.0f + p2), w2 = p2 / (1.0f + p2);
            EID[2 * t] = gi * 8 + i1; EID[2 * t + 1] = gi * 8 + i2; EW[2 * t] = gw_ * w1; EW[2 * t + 1] = gw_ * w2;
            eidl[2 * tk] = gi * 8 + i1; eidl[2 * tk + 1] = gi * 8 + i2; }
        __syncthreads();
        LAS int* base = eidl + 64;
        if (F.tid < 32) { int c = 0;
#pragma unroll 8
            for (int i = 0; i < 64; ++i) c += eidl[i] == F.tid ? 1 : 0;
            base[F.tid] = c > 0 ? (int)__hip_atomic_fetch_add(CNTg + F.tid, (unsigned)c, __ATOMIC_RELAXED, __HIP_MEMORY_SCOPE_AGENT) : 0; }
        __syncthreads();
        if (F.tid < 64) { const int e = eidl[F.tid]; int rk = 0;
            for (int i = 0; i < F.tid; ++i) rk += eidl[i] == e ? 1 : 0;
            LIST[e * 8192 + base[e] + rk] = blk * 64 + F.tid; }
        __syncthreads();
    }
}
__device__ __forceinline__ void phase_lists2(Frame& F) {
    KA;
    const int* EID = (const int*)(KWS + WS_ROUTE); int* CNT = (int*)(KWS + WS_ROUTE + 131072); int* LIST = (int*)(KWS + WS_ROUTE + 262144); const int* HIST = (const int*)(KWS + WS_HIST);
    LAS int* off = (LAS int*)F.lds; LAS int* eidl = off + 32; LAS int* psum = off + 128;
    for (int blk = F.bid; blk < T / 32; blk += F.G) {
        { const int e = F.tid & 31, part = F.tid >> 5; int a = 0;
#pragma unroll 4
          for (int b2 = part; b2 < blk; b2 += 16) a += HIST[b2 * 32 + e];
          psum[part * 32 + e] = a; }
        __syncthreads();
        if (F.tid < 32) { int a = 0;
#pragma unroll
            for (int p = 0; p < 16; ++p) a += psum[p * 32 + F.tid];
            off[F.tid] = a;
            if (blk == T / 32 - 1) CNT[F.tid] = a + HIST[blk * 32 + F.tid]; }
        if (F.tid >= 64 && F.tid < 128) eidl[F.tid - 64] = EID[blk * 64 + F.tid - 64];
        __syncthreads();
        if (F.tid < 64) { const int e = eidl[F.tid]; int rk = 0;
            for (int i = 0; i < F.tid; ++i) rk += eidl[i] == e ? 1 : 0;
            LIST[e * 8192 + off[e] + rk] = blk * 64 + F.tid; }
        __syncthreads();
    }
}

__device__ __forceinline__ void phase_lists(Frame& F) {
    KA;
    const int e = F.bid;
    if (e >= NE) return;
    const int* EID = (const int*)(KWS + WS_ROUTE); int* CNT = (int*)(KWS + WS_ROUTE + 131072); int* LIST = (int*)(KWS + WS_ROUTE + 262144);
    LAS int* wc = (LAS int*)F.lds;
    int run = 0;
    for (int base = 0; base < 2 * T; base += 512) {
        const int idx = base + F.tid; const bool match = EID[idx] == e;
        const unsigned long long b = __ballot(match);
        if (F.lane == 0) wc[F.wave] = __popcll(b);
        __syncthreads();
        int pre = 0, tot = 0;
#pragma unroll
        for (int w = 0; w < 8; ++w) { const int c = wc[w]; pre += w < F.wave ? c : 0; tot += c; }
        if (match) LIST[e * 8192 + run + pre + __popcll(b & ((1ull << F.lane) - 1ull))] = idx;
        run += tot;
        __syncthreads();
    }
    if (F.tid == 0) CNT[e] = run;
}
__device__ __forceinline__ void moe_table(Frame& F, LAS int* tb, int l) {
    KA;
    const int* CNT = (const int*)(KWS + WS_CTL) + CW_CNT + 64 * l;
    if (F.tid == 0) { int a = 0, f = 0, h = 0;
        for (int e = 0; e < NE; ++e) { const int n = CNT[e], nt = (n + 255) / 256, lastv = n - (nt - 1) * 256, hh = (nt > 0 && lastv <= 128) ? 1 : 0;
            tb[e] = a; tb[33 + e] = f; tb[66 + e] = h; a += nt; f += nt - hh; h += hh; }
        tb[NE] = a; tb[33 + NE] = f; tb[66 + NE] = h; }
    __syncthreads();
}

constexpr int PH_PER_LAYER = 7, N_PHASES = 1 + NL * PH_PER_LAYER + 1;

__global__ void __launch_bounds__(512, 2) mk_fwd(Args args) {
    extern __shared__ __attribute__((aligned(16))) unsigned char lds_raw[];
#define FRAME Frame F; F.lds = (LAS unsigned char*)lds_raw; F.MISC = (volatile LAS unsigned*)(F.lds + MISC_OFF); F.tid = ltid(); F.lane = F.tid & 63; F.wave = __builtin_amdgcn_readfirstlane(F.tid >> 6); \
    F.G = gridDim.x; F.bid = lbid(); F.vcu = (F.G % 8 == 0) ? (F.bid % 8) * (F.G / 8) + F.bid / 8 : F.bid; F.gw = F.bid * 8 + F.wave; F.NGW = F.G * 8;
    unsigned* const ctl = (unsigned*)((unsigned char*)args.ws + WS_CTL);
    for (int u = threadIdx.x; u < (LDS_BYTES - MISC_OFF) / 4; u += 512) ((LAS unsigned*)(lds_raw + MISC_OFF))[u] = 0u;
    __syncthreads();
    const int lo = args.ph_lo, hi = args.ph_hi;
    XcdBarrier bar; bar.bar = ctl + CW_BAR + args.li * XCD_BAR_WORDS; bar.x = 0; bar.st = nullptr;
    if (hi - lo > 1) bar = xcd_barrier_post(ctl + CW_BAR + args.li * XCD_BAR_WORDS, (volatile LAS unsigned*)((LAS unsigned char*)lds_raw + MISC_OFF));
    int ph = 0;
#define RUN(k) ((k) >= lo && (k) < hi)

    volatile LAS unsigned long long* const tacc = (volatile LAS unsigned long long*)((LAS unsigned char*)lds_raw + MISC_OFF + 512);
    if (MK_PROBE_MASK != 0 && blockIdx.x == MK_PROBE_BID && threadIdx.x == 0) tacc[16] = wall_clock64();
#define STAMP(slot) do { if (MK_PROBE_MASK != 0 && lbid() == MK_PROBE_BID && ltid() == 0) { const unsigned long long _n = wall_clock64(); tacc[slot] += _n - tacc[16]; tacc[16] = _n; } } while (0)
#define SEAM(k, slot) do { if ((k) + 1 < hi) xcd_barrier(bar); STAMP(slot); } while (0)
    LAS int* const tb = (LAS int*)((LAS unsigned char*)lds_raw + MISC_OFF + 64);

    if (RUN(ph)) { KA; FRAME; phase_prologue(F); phase_norm1<0>(F, KIN(I_X), nullptr, nullptr, KIN(I_NMIX), (bf16*)(KWS + WS_H), (unsigned char*)(KWS + WS_H8)); SEAM(ph, 0); }
    ++ph;
    for (int l = 0; l < NL; ++l) {
        if (RUN(ph)) { KA; FRAME;
            {
              pg8::PlainSched S; S.init(KWS + WS_H, D, (const bf16*)(KWS + WS_WIN) + (size_t)l * NPAD * D, T, 20 * 256, D, F.G, F.bid, 4); S.pn_from = 19; S.pn_to = 43;
              pg8::EpiBf16 E{(bf16*)(KWS + WS_P), NPAD, 1.0f};
              pg8::gemm_phase<pg8::EpiBf16, pg8::PlainSched, true>(F.lds, D, S, E); }
            __syncthreads();
            {
              pg8::PlainSchedT<true> S; S.init(KWS + WS_H8, D, (const unsigned char*)(KWS + WS_WIN8) + (size_t)l * 6144 * D, T, 6144, D, F.G, F.bid, 0); S.wsb = (const char*)KWS;
              pg8::EpiBf16 E{(bf16*)(KWS + WS_P) + C_MG, NPAD, 1.0f / (S_H * S_WG)};
              pg8::gemm_phase<pg8::EpiBf16, pg8::PlainSchedT<true>, true>(F.lds, D, S, E); }
            SEAM(ph, 1); }
        ++ph;
        if (RUN(ph)) { KA; FRAME; phase_prep3(F, l); __syncthreads(); phase_compress3(F, l); phase_rec_local(F, l); SEAM(ph, 3); }
        ++ph;
        if (RUN(ph)) { KA; FRAME; if (F.bid < 96) { phase_rec_scan(F);
                asm volatile("s_waitcnt vmcnt(0)" ::: "memory"); __syncthreads();
                if (F.tid == 0) { __builtin_amdgcn_fence(__ATOMIC_RELEASE, "agent"); asm volatile("s_waitcnt vmcnt(0)" ::: "memory");
                    __hip_atomic_fetch_add((unsigned*)(KWS + WS_CTL) + 2048 + 64 * (4 + l), 1u, __ATOMIC_RELAXED, __HIP_MEMORY_SCOPE_AGENT); } }
            phase_nsa2(F, l); phase_rec_out(F, l); SEAM(ph, 5); }
        ++ph;
        if (RUN(ph)) { KA; FRAME;
            { pg8::BranchSched S; S.init((const bf16*)(KWS + WS_OCAT), (const bf16*)(KWS + WS_WBR) + (size_t)l * 3 * D * 512, F.G, F.bid);
              pg8::EpiMerge E{(bf16*)(KWS + WS_MERGED), (const bf16*)(KWS + WS_P) + C_MG};
              pg8::gemm_phase<pg8::EpiMerge, pg8::BranchSched, true>(F.lds, 512, S, E); }
            SEAM(ph, 6); }
        ++ph;

        if (RUN(ph)) { KA; FRAME; pg8::PlainSched S; S.init((const bf16*)(KWS + WS_MERGED), D, (const bf16*)(KWS + WS_WOUT) + (size_t)l * D * D, T, D, D, F.G, F.bid);
            pg8::EpiResF32 E{l == 0 ? KIN(I_X) : (const float*)(KWS + WS_XRES), (float*)(KWS + WS_X1), D};
            pg8::gemm_phase<pg8::EpiResF32, pg8::PlainSched, false>(F.lds, D, S, E); SEAM(ph, 8); }
        ++ph;
        if (RUN(ph)) { KA; FRAME; phase_router3(F, l); SEAM(ph, 9); }
        ++ph;
        if (RUN(ph)) { KA; FRAME; moe_table(F, tb, l);
            unsigned* tilecnt = (unsigned*)(KWS + WS_CTL) + 131072 + (size_t)l * 128 * 64;
            { pg8::MoeSched<1> S; S.init(F.G, F.vcu, tb, (const int*)(KWS + WS_CTL) + CW_CNT + 64 * l, (const int*)(KWS + WS_ROUTE + 262144), KWS + WS_H8, (const unsigned char*)(KWS + WS_WGU) + (size_t)l * NE * 1024 * D);
              S.tilecnt = tilecnt; S.tick = nullptr; S.tslot = nullptr; S.myticket = 0; S.wsb = (const char*)KWS;
              pg8::EpiMoe1 E{(unsigned char*)(KWS + WS_ACT), (const int*)(KWS + WS_ROUTE + 262144), (const float*)(KWS + WS_ROUTE + 65536), (const float*)(KWS + WS_RSTD)};
              pg8::gemm_phase<pg8::EpiMoe1, pg8::MoeSched<1>, true>(F.lds, D, S, E); }
            __syncthreads();
            { pg8::MoeSched<2> S; S.init(F.G, F.vcu, tb, (const int*)(KWS + WS_CTL) + CW_CNT + 64 * l, (const int*)(KWS + WS_ROUTE + 262144), KWS + WS_ACT, (const unsigned char*)(KWS + WS_WDN) + (size_t)l * NE * D * FF);
              S.tilecnt = tilecnt; S.tick = (unsigned*)(KWS + WS_CTL) + 2048 + 64 * (6 + l); S.tslot = (volatile LAS int*)(F.lds + MISC_OFF + 1028); S.myticket = 0; S.wsb = (const char*)KWS;
              pg8::EpiMoe2 E{(bf16*)(KWS + WS_CONTRIB), (const int*)(KWS + WS_ROUTE + 262144)};
              pg8::gemm_phase<pg8::EpiMoe2, pg8::MoeSched<2>, true>(F.lds, FF, S, E); }
            SEAM(ph, 12); }
        ++ph;
        if (l + 1 < NL) { if (RUN(ph)) { KA; FRAME; phase_norm1<1>(F, (const float*)(KWS + WS_X1), (const bf16*)(KWS + WS_CONTRIB), (float*)(KWS + WS_XRES), KIN(I_NMIX) + (size_t)(l + 1) * D, (bf16*)(KWS + WS_H), (unsigned char*)(KWS + WS_H8)); SEAM(ph, 13); } ++ph; }
    }
    if (RUN(ph)) { KA; FRAME; phase_norm1<2>(F, (const float*)(KWS + WS_X1), (const bf16*)(KWS + WS_CONTRIB), KOUT, nullptr, nullptr); }
    if (MK_PROBE_MASK != 0 && lbid() == MK_PROBE_BID && ltid() == 0) {
        asm volatile("s_waitcnt vmcnt(0)" ::: "memory"); STAMP(15);
        unsigned long long tot = 0ull;
        for (int k2 = 0; k2 < 32; ++k2) if (k2 != 16 && ((MK_PROBE_MASK >> k2) & 1)) tot += tacc[k2];
        const unsigned long long t_end = wall_clock64() + 4ull * tot;
        while (wall_clock64() < t_end) __builtin_amdgcn_s_sleep(8);
    }
#undef RUN
#undef SEAM
}

#ifndef MK_PER_PHASE
#define MK_PER_PHASE 0
#endif
extern "C" void kernel_launch(void* const* d_in, const int* in_sizes, int n_in, void* d_out, int out_size, void* d_ws, size_t ws_size, hipStream_t stream) {
    static int grid = 0;
    if (grid == 0) {
        if (n_in != 22 || out_size != T * D || ws_size < WS_END) { fprintf(stderr, "kernel_launch: unexpected sizes (n_in %d out %d ws %zu)\n", n_in, out_size, ws_size); grid = -1; return; }
        int dev = 0, cus = 0, per_cu = 0;
        if (hipGetDevice(&dev) != hipSuccess || hipDeviceGetAttribute(&cus, hipDeviceAttributeMultiprocessorCount, dev) != hipSuccess) { grid = -1; return; }
        if (hipFuncSetAttribute((const void*)mk_fwd, hipFuncAttributeMaxDynamicSharedMemorySize, LDS_BYTES) != hipSuccess) { fprintf(stderr, "kernel_launch: hipFuncSetAttribute failed\n"); grid = -1; return; }
        if (hipOccupancyMaxActiveBlocksPerMultiprocessor(&per_cu, (const void*)mk_fwd, 512, LDS_BYTES) != hipSuccess || per_cu < 1) { fprintf(stderr, "kernel_launch: occupancy query says %d\n", per_cu); }
        (void)hipGetLastError();
        grid = cus;
    }
    if (grid < 0) return;
    if (hipMemsetAsync((char*)d_ws + WS_CTL, 0, CTL_ZERO_BYTES, stream) != hipSuccess) return;
    Args a{};
    for (int i = 0; i < 22; ++i) a.in[i] = (const GAS float*)d_in[i];
    a.out = (GAS float*)d_out; a.ws = (GAS unsigned char*)d_ws;
#if MK_PER_PHASE
    const int total = 1 + NL * PH_PER_LAYER + (NL - 1) + 1;
    for (int k = 0; k < total; ++k) { a.ph_lo = k; a.ph_hi = k + 1; a.li = 0; hipLaunchKernelGGL(mk_fwd, dim3(grid), dim3(512), LDS_BYTES, stream, a); }
#else
    a.ph_lo = 0; a.ph_hi = 1000; a.li = 0;
    hipLaunchKernelGGL(mk_fwd, dim3(grid), dim3(512), LDS_BYTES, stream, a);
#endif
    const hipError_t le = hipPeekAtLastError();
    if (le != hipSuccess) fprintf(stderr, "kernel_launch: launch failed: %s\n", hipGetErrorName(le));
}
```
